# Optimizing an MI355X kernel written in HIP

```python
import math
import jax, jax.numpy as jnp
from jax import lax
import numpy as np


D_MODEL = 2048
BATCH = 1
SEQ = 16384
DEPTH = 2

CHUNK = 64
MIX_WIDTH = D_MODEL
WIDTH_A = MIX_WIDTH // 2
WIDTH_B = MIX_WIDTH - WIDTH_A
IN_WIDTH = 2 * WIDTH_A + WIDTH_B
GMLP_BLOCK = 128
GMLP_HEAD_DIM = 128
GMLP_HEADS = WIDTH_A // GMLP_HEAD_DIM
SSM_GROUP = 16
SSM_GROUPS = WIDTH_B // SSM_GROUP
SSM_STATE = 64
DT_MIN = 1e-3
DT_MAX = 1e-1
PEER_HEADS = 8
PEER_KEYS = 128
PEER_EXPERTS = PEER_KEYS * PEER_KEYS
PEER_TOPK = 16
PEER_QDIM = 256
PEER_HALF = PEER_QDIM // 2
PEER_TOKEN_BLOCK = 128
N_MOD = 6
EPS = 1e-6

kernel_name = "hymba_gmlp_s5_peer_adaln_block"


def _rmsnorm(x, gain):
    xf = x.astype(jnp.float32)
    y = xf * lax.rsqrt(jnp.mean(xf * xf, axis=-1, keepdims=True) + EPS)
    return (y * gain.astype(jnp.float32)).astype(x.dtype)


def _layernorm(x, gain, bias):
    xf = x.astype(jnp.float32)
    mu = jnp.mean(xf, axis=-1, keepdims=True)
    var = jnp.mean(jnp.square(xf - mu), axis=-1, keepdims=True)
    y = (xf - mu) * lax.rsqrt(var + EPS)
    return (y * gain.astype(jnp.float32) + bias.astype(jnp.float32)).astype(x.dtype)


def _chunk_causal_mask(n):
    blk = jnp.arange(n) // CHUNK
    return blk[:, None] >= blk[None, :]


def _spatial_gating(uv, ln_g, ln_b, w_s, b_s):
    b, l, _ = uv.shape
    z = jax.nn.gelu(uv)
    u, v = z[..., :WIDTH_A], z[..., WIDTH_A:]
    v = _layernorm(v, ln_g, ln_b)
    v = v.reshape(b, l // GMLP_BLOCK, GMLP_BLOCK, GMLP_HEADS, GMLP_HEAD_DIM)
    w = jnp.where(_chunk_causal_mask(GMLP_BLOCK)[None], w_s, 0.0)
    s = jnp.einsum('hij,bnjhc->bnihc', w, v) + b_s.T[None, None, :, :, None]
    return u * s.reshape(b, l, WIDTH_A)


def _ssm_combine(e1, e2):
    a1, s1 = e1
    a2, s2 = e2
    return a1 * a2, a2 * s1 + s2


def _s5(xb, lam_re, lam_im, log_dt, b_re, b_im, c_re, c_im, d_skip, glu_w, glu_b):
    b, l, _ = xb.shape
    out_dtype = xb.dtype
    f32 = jnp.float32
    x = xb.astype(f32).reshape(b, l, SSM_GROUPS, SSM_GROUP)
    lam = lax.complex(lam_re.astype(f32), lam_im.astype(f32))
    dt = jnp.exp(log_dt.astype(f32))[:, None]
    a_bar = jnp.exp(lam * dt)
    bmat = lax.complex(b_re.astype(f32), b_im.astype(f32))
    b_bar = ((a_bar - 1.0) / lam)[..., None] * bmat
    cmat = lax.complex(c_re.astype(f32), c_im.astype(f32))
    steps = jnp.arange(1, CHUNK + 1, dtype=f32)
    a_pow = jnp.exp(lam[None] * (dt[None] * steps[:, None, None]))
    xc = x.reshape(b, l // CHUNK, CHUNK, SSM_GROUPS, SSM_GROUP).transpose(1, 0, 2, 3, 4)

    def chunk_step(h, xk):
        bu = jnp.einsum('bcgh,gph->bcgp', xk.astype(jnp.complex64), b_bar)
        a = jnp.broadcast_to(a_bar, bu.shape)
        _, s = lax.associative_scan(_ssm_combine, (a, bu), axis=1)
        s = s + a_pow[None] * h[:, None]
        y = jnp.einsum('bcgp,ghp->bcgh', s, cmat).real
        return s[:, -1], y

    h0 = jnp.zeros((b, SSM_GROUPS, SSM_STATE), jnp.complex64)
    _, y = lax.scan(chunk_step, h0, xc)
    y = y.transpose(1, 0, 2, 3, 4).reshape(b, l, SSM_GROUPS, SSM_GROUP)
    y = y + d_skip.astype(f32).reshape(SSM_GROUPS, SSM_GROUP) * x
    g = jax.nn.gelu(y.reshape(b, l, WIDTH_B))
    out = g * jax.nn.sigmoid(g @ glu_w.astype(f32) + glu_b.astype(f32))
    return out.astype(out_dtype)


def _peer(h, w_q, sub_keys, u_tab, v_tab):
    b, l, d = h.shape
    tokens = h.reshape(-1, PEER_TOKEN_BLOCK, d)

    def block(hb):
        t = hb.shape[0]
        q = (hb @ w_q).reshape(t, PEER_HEADS, 2, PEER_HALF)
        scores = jnp.einsum('thsc,hsnc->thsn', q, sub_keys).astype(jnp.float32)
        top_s, top_i = lax.top_k(scores, PEER_TOPK)
        cand = (top_s[:, :, 0, :, None] + top_s[:, :, 1, None, :]).reshape(t, PEER_HEADS, PEER_TOPK * PEER_TOPK)
        cand_id = (top_i[:, :, 0, :, None] * PEER_KEYS + top_i[:, :, 1, None, :]).reshape(t, PEER_HEADS, PEER_TOPK * PEER_TOPK)
        best_s, best_j = lax.top_k(cand, PEER_TOPK)
        expert = jnp.take_along_axis(cand_id, best_j, axis=-1)
        gate = jax.nn.softmax(best_s, axis=-1)
        u = jnp.take(u_tab, expert, axis=0)
        v = jnp.take(v_tab, expert, axis=0)
        act = jax.nn.gelu(jnp.einsum('thkd,td->thk', u, hb).astype(jnp.float32))
        coef = (gate * act).astype(hb.dtype)
        return jnp.einsum('thk,thkd->td', coef, v)

    out = lax.map(block, tokens)
    return out.reshape(b, l, d)


def setup_inputs(seed: int = 0) -> dict:
    key = jax.random.key(seed)
    ks = jax.random.split(key, 29)
    f32 = jnp.float32
    nrm = lambda k, shape, std: jax.random.normal(k, shape, f32) * std
    d = D_MODEL
    lam_im_base = jnp.pi * jnp.arange(SSM_STATE, dtype=f32)
    return {
        'x': nrm(ks[0], (BATCH, SEQ, d), 1.0),
        'c': nrm(ks[1], (BATCH, d), 1.0),
        'w_mod': nrm(ks[2], (DEPTH, d, N_MOD * d), 0.5 * d ** -0.5),
        'b_mod': nrm(ks[3], (DEPTH, N_MOD * d), 0.02),
        'norm1_g': 1.0 + nrm(ks[4], (DEPTH, d), 0.02),
        'w_in': nrm(ks[5], (DEPTH, d, IN_WIDTH), d ** -0.5),
        'b_in': nrm(ks[6], (DEPTH, IN_WIDTH), 0.02),
        'gm_ln_g': 1.0 + nrm(ks[7], (DEPTH, WIDTH_A), 0.02),
        'gm_ln_b': nrm(ks[8], (DEPTH, WIDTH_A), 0.02),
        'gm_ws': nrm(ks[9], (DEPTH, GMLP_HEADS, GMLP_BLOCK, GMLP_BLOCK), GMLP_BLOCK ** -0.5),
        'gm_bs': 1.0 + nrm(ks[10], (DEPTH, GMLP_HEADS, GMLP_BLOCK), 0.02),
        'ssm_lam_re': -0.5 + nrm(ks[11], (DEPTH, SSM_GROUPS, SSM_STATE), 0.01),
        'ssm_lam_im': lam_im_base + nrm(ks[12], (DEPTH, SSM_GROUPS, SSM_STATE), 0.01),
        'ssm_log_dt': jax.random.uniform(ks[13], (DEPTH, SSM_GROUPS), f32, math.log(DT_MIN), math.log(DT_MAX)),
        'ssm_b_re': nrm(ks[14], (DEPTH, SSM_GROUPS, SSM_STATE, SSM_GROUP), (2 * SSM_GROUP) ** -0.5),
        'ssm_b_im': nrm(ks[15], (DEPTH, SSM_GROUPS, SSM_STATE, SSM_GROUP), (2 * SSM_GROUP) ** -0.5),
        'ssm_c_re': nrm(ks[16], (DEPTH, SSM_GROUPS, SSM_GROUP, SSM_STATE), (2 * SSM_STATE) ** -0.5),
        'ssm_c_im': nrm(ks[17], (DEPTH, SSM_GROUPS, SSM_GROUP, SSM_STATE), (2 * SSM_STATE) ** -0.5),
        'ssm_d': nrm(ks[18], (DEPTH, WIDTH_B), 1.0),
        'glu_w': nrm(ks[19], (DEPTH, WIDTH_B, WIDTH_B), WIDTH_B ** -0.5),
        'glu_b': nrm(ks[20], (DEPTH, WIDTH_B), 0.02),
        'branch_g': 1.0 + nrm(ks[21], (DEPTH, MIX_WIDTH), 0.02),
        'w_out': nrm(ks[22], (DEPTH, MIX_WIDTH, d), MIX_WIDTH ** -0.5),
        'norm2_g': 1.0 + nrm(ks[23], (DEPTH, d), 0.02),
        'peer_wq': nrm(ks[24], (DEPTH, d, PEER_HEADS * PEER_QDIM), d ** -0.5),
        'peer_keys': nrm(ks[25], (DEPTH, PEER_HEADS, 2, PEER_KEYS, PEER_HALF), PEER_HALF ** -0.5),
        'peer_u': nrm(ks[26], (DEPTH, PEER_EXPERTS, d), d ** -0.5),
        'peer_v': nrm(ks[27], (DEPTH, PEER_EXPERTS, d), 1.0),
        'final_g': 1.0 + nrm(ks[28], (d,), 0.02),
    }


def reference(x, c, w_mod, b_mod, norm1_g, w_in, b_in, gm_ln_g, gm_ln_b, gm_ws, gm_bs,
              ssm_lam_re, ssm_lam_im, ssm_log_dt, ssm_b_re, ssm_b_im, ssm_c_re, ssm_c_im,
              ssm_d, glu_w, glu_b, branch_g, w_out, norm2_g, peer_wq, peer_keys, peer_u,
              peer_v, final_g):
    b = x.shape[0]
    cond = jax.nn.silu(c)
    for i in range(DEPTH):
        mod = (cond @ w_mod[i] + b_mod[i]).reshape(b, N_MOD, D_MODEL)[:, :, None, :]
        shift1, scale1, gate1 = mod[:, 0], mod[:, 1], mod[:, 2]
        shift2, scale2, gate2 = mod[:, 3], mod[:, 4], mod[:, 5]

        h = _rmsnorm(x, norm1_g[i]) * (1.0 + scale1) + shift1
        proj = h @ w_in[i] + b_in[i]
        out_a = _spatial_gating(proj[..., :2 * WIDTH_A], gm_ln_g[i], gm_ln_b[i], gm_ws[i], gm_bs[i])
        out_b = _s5(proj[..., 2 * WIDTH_A:], ssm_lam_re[i], ssm_lam_im[i], ssm_log_dt[i],
                    ssm_b_re[i], ssm_b_im[i], ssm_c_re[i], ssm_c_im[i], ssm_d[i], glu_w[i], glu_b[i])
        mixed = jnp.concatenate([_rmsnorm(out_a, branch_g[i, :WIDTH_A]),
                                 _rmsnorm(out_b, branch_g[i, WIDTH_A:])], axis=-1)
        x = x + gate1 * (mixed @ w_out[i])

        h = _rmsnorm(x, norm2_g[i]) * (1.0 + scale2) + shift2
        x = x + gate2 * _peer(h, peer_wq[i], peer_keys[i], peer_u[i], peer_v[i])
    return _rmsnorm(x, final_g)
```

```cpp
#include <hip/hip_runtime.h>
#include <cstdio>
#include <cstdint>

#ifndef MK_PER_PHASE
#define MK_PER_PHASE 1
#endif

#define GAS __attribute__((address_space(1)))
#define LAS __attribute__((address_space(3)))
typedef unsigned short bf16;
typedef short bf16x8 __attribute__((ext_vector_type(8)));
typedef float f32x4 __attribute__((ext_vector_type(4)));
typedef float f32x2 __attribute__((ext_vector_type(2)));
typedef unsigned u32x4 __attribute__((ext_vector_type(4)));
typedef unsigned u32x2 __attribute__((ext_vector_type(2)));

constexpr int DM = 2048, SEQ = 16384, DEPTH = 2, M = SEQ;
constexpr int WA = 1024, WB = 1024, INW = 3072;
constexpr int NG = 64, NCH = 256;
constexpr int NEXP = 16384;
constexpr float EPS = 1e-6f;
constexpr int NWAVES = 8, NTHR = 512;

namespace pg8 {
#define PG8_LAS __attribute__((address_space(3)))
constexpr int BM = 256, BK = 64, HALF = 128, HTB = HALF * BK * 2, STAGE_BYTES = 8 * HTB, NXCD = 8, WGM = 8;
__host__ __device__ __forceinline__ int lds_byte(int r, int c) { const int st = (r >> 4) * 2 + (c >> 5), rr = r & 15, cc = c & 31, ob = rr * 64 + cc * 2; return st * 1024 + (ob ^ (((ob >> 9) & 1) << 5)); }
__host__ __device__ __forceinline__ void stage_rc(int b, int& R, int& C) { const int st = b / 1024, sb = b % 1024, swz = sb ^ (((sb >> 9) & 1) << 5); R = (st >> 1) * 16 + swz / 64; C = (st & 1) * 32 + (swz % 64) / 2; }
__host__ __device__ __forceinline__ int perm32(int rho) { const int n = rho >> 4, i = rho & 15; return 8 * (i >> 2) + 4 * n + (i & 3); }
struct Unit { int pm, pn; };
struct Gemm { const bf16* A; const bf16* Bt; int M, N, K; };
struct StaticOrder {
    int nM, nN, nwg, G, c;
    __host__ __device__ void init(int M_, int N_, int G_, int c_) { nM = M_ / BM; nN = N_ / BM; nwg = nM * nN; G = G_; c = c_; }
    __host__ __device__ bool next(int i, Unit& u) const {
        const long L = (long)i * G + c; if (L >= nwg) return false;
        int wgid = (int)L; { const int q = nwg / NXCD, r = nwg % NXCD, xcd = wgid % NXCD, off = wgid / NXCD; wgid = (xcd < r ? xcd * (q + 1) : r * (q + 1) + (xcd - r) * q) + off; }
        const int nig = WGM * nN, gid = wgid / nig, fm = gid * WGM, gsz = (nM - fm) < WGM ? (nM - fm) : WGM;
        u.pm = fm + ((wgid % nig) % gsz); u.pn = (wgid % nig) / gsz; return true;
    }
    __device__ __forceinline__ void a_ready(const Unit&) const {}
    __device__ __forceinline__ void done(const Unit&) const {}
};
__device__ __forceinline__ unsigned cvt_pk_bf16(float lo, float hi) { unsigned r; asm volatile("v_cvt_pk_bf16_f32 %0, %1, %2" : "=v"(r) : "v"(lo), "v"(hi)); return r; }

template <class Epi, class Sched, bool ALIGN_EPI = false, bool SP2 = false>
__device__ __forceinline__ void gemm_phase(PG8_LAS unsigned char* lds, const Gemm g, const Sched& S, const Epi& E) {
    int tid = threadIdx.x; asm volatile("" : "+v"(tid)); const int wid = __builtin_amdgcn_readfirstlane(tid >> 6), lane = tid & 63, wr = wid >> 2, wc = wid & 3, fr = lane & 15, fq = lane >> 4;
    const int K = g.K, nt = K / BK;
    unsigned voffA[2], voffB[2];
#pragma unroll
    for (int i = 0; i < 2; ++i) { int R, C; stage_rc(tid * 16 + i * 8192, R, C); const int Rb = Epi::PERM ? ((R & ~31) + perm32(R & 31)) : R;
        voffA[i] = (unsigned)(R * K + C) * 2u; voffB[i] = (unsigned)(Rb * K + C) * 2u; }
    const size_t kstep = (size_t)(BK * 2);
    const size_t hstep = (size_t)HALF * K * 2;
    const size_t tstep = 2 * hstep;
    const unsigned ldsw = (unsigned)wid * 1024u;
    const int aoff = lds_byte(wr * 64 + fr, fq * 8), boff = lds_byte(wc * 32 + fr, fq * 8);
#define PG8_SA(b, h) (((b) * 2 + (h)) * HTB)
#define PG8_SB(b, h) ((4 + (b) * 2 + (h)) * HTB)
#define PG8_STAGE(bufoff, gbase, voff) do { _Pragma("unroll") for (int _i = 0; _i < 2; ++_i) \
        __builtin_amdgcn_global_load_lds((const unsigned*)((const char*)(gbase) + (voff)[_i]), (PG8_LAS unsigned*)(lds + (bufoff) + ldsw + _i * 8192), 16, 0, 0); } while (0)
#define PG8_LDA(dst, b, h) do { _Pragma("unroll") for (int m = 0; m < 4; ++m) _Pragma("unroll") for (int k = 0; k < 2; ++k) dst[m][k] = *(const PG8_LAS bf16x8*)(lds + PG8_SA(b, h) + aoff + m * 2048 + k * 1024); } while (0)
#define PG8_LDB(dst, b, h) do { _Pragma("unroll") for (int n = 0; n < 2; ++n) _Pragma("unroll") for (int k = 0; k < 2; ++k) dst[n][k] = *(const PG8_LAS bf16x8*)(lds + PG8_SB(b, h) + boff + n * 2048 + k * 1024); } while (0)
#define PG8_MMA(ai, bj, At, Bt) do { __builtin_amdgcn_s_setprio(1); _Pragma("unroll") for (int m = 0; m < 4; ++m) _Pragma("unroll") for (int n = 0; n < 2; ++n) _Pragma("unroll") for (int k = 0; k < 2; ++k) \
        acc[ai][bj][m][n] = __builtin_amdgcn_mfma_f32_16x16x32_bf16(Bt[n][k], At[m][k], acc[ai][bj][m][n], 0, 0, 0); __builtin_amdgcn_s_setprio(0); } while (0)
#define PG8_WAIT_V(n) asm volatile("s_waitcnt vmcnt(" #n ")" ::: "memory")
#define PG8_WAIT_L(n) asm volatile("s_waitcnt lgkmcnt(" #n ")" ::: "memory")
#define PG8_BAR __builtin_amdgcn_s_barrier()
#define PG8_SCHED __builtin_amdgcn_sched_barrier(0)
    Unit cur, nxt; int ui = 0;
    if (!S.next(0, cur)) return;
    f32x4 acc[2][2][4][2];
#pragma unroll
    for (int a = 0; a < 2; ++a)
#pragma unroll
        for (int b = 0; b < 2; ++b)
#pragma unroll
            for (int m = 0; m < 4; ++m)
#pragma unroll
                for (int n = 0; n < 2; ++n) acc[a][b][m][n] = (f32x4){0.f, 0.f, 0.f, 0.f};
    bf16x8 At[4][2], B0[2][2], B1[2][2];
    const char* cA = (const char*)g.A + (size_t)cur.pm * tstep; const char* cB = (const char*)g.Bt + (size_t)cur.pn * tstep;
    S.a_ready(cur);
    if constexpr (SP2) {
        PG8_STAGE(PG8_SB(0, 0), cB, voffB); PG8_STAGE(PG8_SB(0, 1), cB + hstep, voffB); PG8_STAGE(PG8_SA(0, 0), cA, voffA); PG8_STAGE(PG8_SA(0, 1), cA + hstep, voffA);
        if (wr == 1) PG8_BAR;
        PG8_WAIT_V(2); PG8_BAR;
        PG8_STAGE(PG8_SB(1, 0), cB + kstep, voffB); PG8_STAGE(PG8_SA(1, 0), cA + kstep, voffA); PG8_STAGE(PG8_SB(1, 1), cB + hstep + kstep, voffB);
        PG8_WAIT_V(6); PG8_BAR;
    } else {
        PG8_STAGE(PG8_SB(0, 0), cB, voffB); PG8_STAGE(PG8_SA(0, 0), cA, voffA); PG8_STAGE(PG8_SB(0, 1), cB + hstep, voffB); PG8_STAGE(PG8_SA(0, 1), cA + hstep, voffA);
        if (wr == 1) PG8_BAR;
        PG8_WAIT_V(4); PG8_BAR;
        PG8_STAGE(PG8_SB(1, 0), cB + kstep, voffB); PG8_STAGE(PG8_SA(1, 0), cA + kstep, voffA); PG8_STAGE(PG8_SB(1, 1), cB + hstep + kstep, voffB);
        PG8_WAIT_V(6); PG8_BAR;
    }
    for (;;) {
        const bool has_next = S.next(ui + 1, nxt);
        const char* nA = has_next ? (const char*)g.A + (size_t)nxt.pm * tstep : cA; const char* nB = has_next ? (const char*)g.Bt + (size_t)nxt.pn * tstep : cB;
        for (int t = 0; t < nt; t += 2) {
            const bool last = (t == nt - 2);
            const char* a1 = cA + (size_t)(t + 1) * kstep;
            const char* a2 = last ? nA : cA + (size_t)(t + 2) * kstep; const char* b2 = last ? nB : cB + (size_t)(t + 2) * kstep;
            const char* a3 = a2 + kstep; const char* b3 = b2 + kstep;
            if (last && has_next) S.a_ready(nxt);
            if constexpr (SP2) {
            PG8_LDB(B0, 0, 0); PG8_LDB(B1, 0, 1); PG8_SCHED; PG8_LDA(At, 0, 0); PG8_STAGE(PG8_SA(1, 1), a1 + hstep, voffA);
            PG8_WAIT_V(8); PG8_WAIT_L(0); PG8_BAR; PG8_MMA(0, 0, At, B0); PG8_MMA(0, 1, At, B1); PG8_BAR; PG8_SCHED;
            PG8_LDA(At, 0, 1); PG8_STAGE(PG8_SB(0, 0), b2, voffB); PG8_STAGE(PG8_SB(0, 1), b2 + hstep, voffB); PG8_STAGE(PG8_SA(0, 0), a2, voffA);
            PG8_WAIT_V(8); PG8_WAIT_L(0); PG8_BAR; PG8_MMA(1, 0, At, B0); PG8_MMA(1, 1, At, B1); PG8_BAR; PG8_SCHED;
            PG8_LDB(B0, 1, 0); PG8_LDB(B1, 1, 1); PG8_SCHED; PG8_LDA(At, 1, 0); PG8_STAGE(PG8_SA(0, 1), a2 + hstep, voffA);
            PG8_WAIT_V(8); PG8_WAIT_L(0); PG8_BAR; PG8_MMA(0, 0, At, B0); PG8_MMA(0, 1, At, B1); PG8_BAR; PG8_SCHED;
            PG8_LDA(At, 1, 1); PG8_STAGE(PG8_SB(1, 0), b3, voffB); PG8_STAGE(PG8_SB(1, 1), b3 + hstep, voffB); PG8_STAGE(PG8_SA(1, 0), a3, voffA);
            PG8_WAIT_V(8); PG8_WAIT_L(0); PG8_BAR; PG8_MMA(1, 0, At, B0); PG8_MMA(1, 1, At, B1); PG8_BAR; PG8_SCHED;
            } else {
            PG8_LDB(B0, 0, 0); PG8_SCHED; PG8_LDA(At, 0, 0); PG8_STAGE(PG8_SA(1, 1), a1 + hstep, voffA);
            PG8_WAIT_L(8); PG8_BAR; PG8_WAIT_L(0); PG8_MMA(0, 0, At, B0); PG8_BAR; PG8_SCHED;
            PG8_LDB(B1, 0, 1); PG8_STAGE(PG8_SB(0, 0), b2, voffB);
            PG8_BAR; PG8_WAIT_L(0); PG8_MMA(0, 1, At, B1); PG8_BAR;
            PG8_LDA(At, 0, 1); PG8_STAGE(PG8_SA(0, 0), a2, voffA);
            PG8_BAR; PG8_WAIT_L(0); PG8_MMA(1, 0, At, B0); PG8_BAR; PG8_SCHED;
            PG8_STAGE(PG8_SB(0, 1), b2 + hstep, voffB);
            PG8_WAIT_V(6); PG8_BAR; PG8_MMA(1, 1, At, B1); PG8_BAR;
            PG8_LDB(B0, 1, 0); PG8_SCHED; PG8_LDA(At, 1, 0); PG8_STAGE(PG8_SA(0, 1), a2 + hstep, voffA);
            PG8_WAIT_L(8); PG8_BAR; PG8_WAIT_L(0); PG8_MMA(0, 0, At, B0); PG8_BAR; PG8_SCHED;
            PG8_LDB(B1, 1, 1); PG8_STAGE(PG8_SB(1, 0), b3, voffB);
            PG8_BAR; PG8_WAIT_L(0); PG8_MMA(0, 1, At, B1); PG8_BAR;
            PG8_LDA(At, 1, 1); PG8_STAGE(PG8_SA(1, 0), a3, voffA);
            PG8_BAR; PG8_WAIT_L(0); PG8_MMA(1, 0, At, B0); PG8_BAR; PG8_SCHED;
            PG8_STAGE(PG8_SB(1, 1), b3 + hstep, voffB);
            PG8_WAIT_V(6); PG8_BAR; PG8_MMA(1, 1, At, B1); PG8_BAR;
            }
        }
        if constexpr (ALIGN_EPI) { if (wr == 0) PG8_BAR; }
        E(acc, cur, wr, wc, fr, fq); S.done(cur);
        if (!has_next) break;
#pragma unroll
        for (int a = 0; a < 2; ++a)
#pragma unroll
            for (int b = 0; b < 2; ++b)
#pragma unroll
                for (int m = 0; m < 4; ++m)
#pragma unroll
                    for (int n = 0; n < 2; ++n) acc[a][b][m][n] = (f32x4){0.f, 0.f, 0.f, 0.f};
        cur = nxt; cA = nA; cB = nB; ++ui;
        if constexpr (ALIGN_EPI) { if (wr == 1) PG8_BAR; }
    }
    PG8_WAIT_V(0);
    if constexpr (!ALIGN_EPI) { if (wr == 0) PG8_BAR; }
    PG8_BAR;
#undef PG8_SA
#undef PG8_SB
#undef PG8_STAGE
#undef PG8_LDA
#undef PG8_LDB
#undef PG8_MMA
#undef PG8_WAIT_V
#undef PG8_WAIT_L
#undef PG8_BAR
#undef PG8_SCHED
}
}

__device__ __forceinline__ unsigned f2bf(float f) { unsigned u = __builtin_bit_cast(unsigned, f); return (u + 0x7fffu + ((u >> 16) & 1u)) >> 16; }
__device__ __forceinline__ unsigned pk2(float lo, float hi) { return f2bf(lo) | (f2bf(hi) << 16); }
__device__ __forceinline__ float bflo(unsigned w) { return __builtin_bit_cast(float, w << 16); }
__device__ __forceinline__ float bfhi(unsigned w) { return __builtin_bit_cast(float, w & 0xffff0000u); }
__device__ __forceinline__ float fast_sigmoid(float t) { return __builtin_amdgcn_rcpf(1.0f + __builtin_amdgcn_exp2f(-1.44269504089f * t)); }
__device__ __forceinline__ float gelu_tanh(float x) { const float t = x * (1.5957691216f + 0.0713548163f * x * x); return x * fast_sigmoid(t); }
__device__ __forceinline__ float wave_sum(float v) {
#pragma unroll
    for (int o = 1; o < 64; o <<= 1) v += __shfl_xor(v, o);
    return v;
}
#define LDS_WAIT() asm volatile("s_waitcnt lgkmcnt(0)" ::: "memory")
#define VM_WAIT() asm volatile("s_waitcnt vmcnt(0)" ::: "memory")
#define RLX_AGENT __ATOMIC_RELAXED, __HIP_MEMORY_SCOPE_AGENT

constexpr size_t MiB = 1u << 20;
constexpr size_t WS_CTL = 0, CTL_ZERO_BYTES = 1 * MiB;
constexpr size_t WS_MOD   = 1 * MiB;
constexpr size_t WS_AT    = WS_MOD + 128 * 1024;
constexpr size_t WS_STATS = WS_AT + 128 * 1024;
constexpr size_t WS_KEYS  = 2 * MiB;
constexpr size_t WS_GWS   = 3 * MiB;
constexpr size_t WS_WIN   = 4 * MiB;
constexpr size_t WS_GLU   = 28 * MiB;
constexpr size_t WS_WOUT  = 32 * MiB;
constexpr size_t WS_WQ    = 48 * MiB;
constexpr size_t WS_KTAB  = 64 * MiB;
constexpr size_t WS_WG    = 72 * MiB;
constexpr size_t WS_VG    = 104 * MiB;
constexpr size_t WS_UV    = 136 * MiB;
constexpr size_t WS_X     = 392 * MiB;
constexpr size_t WS_H     = 520 * MiB;
constexpr size_t WS_Z     = 584 * MiB;
constexpr size_t WS_XS    = 648 * MiB;
constexpr size_t WS_SLOC  = 680 * MiB;
constexpr size_t WS_HS    = 688 * MiB;
constexpr size_t WS_G     = 692 * MiB;
constexpr size_t WS_MIX   = 724 * MiB;
constexpr size_t WS_EID   = 788 * MiB;
constexpr size_t WS_GATE  = 796 * MiB;
constexpr size_t WS_END   = 804 * MiB;
constexpr int CW_BAR = 4096;
constexpr int CW_QUEUE = 16384;

constexpr int LDS_BYTES = 163840;
constexpr int MISC_OFF = LDS_BYTES - 256;

#define XB_TMO      128
#define XB_XCNT(j)  (256  + 64 * (j))
#define XB_XSUB(j)  (1280 + 64 * (j))
#define XB_XGEN(j)  (2304 + 64 * (j))
#define XB_TOP      3328
#define XB_TOPGEN   3392
#define XCD_BAR_WORDS 3456
#define XB_SPIN_CAP (1u << 24)
__device__ __forceinline__ unsigned xb_ld(unsigned* p)              { return __hip_atomic_load(p, __ATOMIC_RELAXED, __HIP_MEMORY_SCOPE_AGENT); }
__device__ __forceinline__ unsigned xb_add(unsigned* p, unsigned v) { return __hip_atomic_fetch_add(p, v, __ATOMIC_RELAXED, __HIP_MEMORY_SCOPE_AGENT); }
__device__ __forceinline__ unsigned xb_xcc_id() { return (unsigned)__builtin_amdgcn_s_getreg((3 << 11) | 20) & 0xFu; }
#define XB_SPIN(cond, bar) do { unsigned _sp = 0; while (cond) { __builtin_amdgcn_s_sleep(1); \
    if ((++_sp & 255u) == 0u) { if (xb_ld(&(bar)[XB_TMO])) break; if (_sp > XB_SPIN_CAP) { atomicAdd(&(bar)[XB_TMO], 1u); break; } } } } while (0)
struct XcdBarrier { unsigned* bar; unsigned x; volatile LAS unsigned* st; };
__device__ __forceinline__ XcdBarrier xcd_barrier_post(unsigned* bar, volatile LAS unsigned* st) {
    XcdBarrier b; b.bar = bar; b.x = xb_xcc_id(); b.st = st;
    if (threadIdx.x == 0) (void)xb_add(&bar[XB_XCNT(b.x)], 1u);
    return b;
}
__device__ __forceinline__ void xcd_barrier_complete(unsigned* bar, unsigned x, unsigned& nloc, unsigned& nx) {
    const unsigned G = gridDim.x * gridDim.y * gridDim.z;
    unsigned sum, cnt, mine, sp = 0u;
    for (;;) {
        sum = 0u; cnt = 0u; mine = 0u;
#pragma unroll
        for (unsigned j = 0; j < 16; ++j) { const unsigned c = xb_ld(&bar[XB_XCNT(j)]); sum += c; cnt += (c > 0u) ? 1u : 0u; mine = (j == x) ? c : mine; }
        if (sum == G) break;
        __builtin_amdgcn_s_sleep(1);
        if ((++sp & 255u) == 0u) { if (xb_ld(&bar[XB_TMO])) break; if (sp > XB_SPIN_CAP) { atomicAdd(&bar[XB_TMO], 1u); break; } }
    }
    nloc = mine > 0u ? mine : 1u; nx = cnt > 0u ? cnt : 1u;
}
__device__ __forceinline__ void xcd_barrier(const XcdBarrier& b) {
    asm volatile("s_waitcnt vmcnt(0)" ::: "memory");
    __syncthreads();
    if (threadIdx.x == 0) {
        unsigned* bar = b.bar;
        __builtin_amdgcn_s_waitcnt(0);
        unsigned nloc = b.st[0], nx = b.st[1];
        if (nloc == 0u) { xcd_barrier_complete(bar, b.x, nloc, nx); b.st[0] = nloc; b.st[1] = nx; }
        const unsigned old = xb_add(&bar[XB_XSUB(b.x)], 1u);
        const unsigned gen = old / nloc;
        if (old + 1u == (gen + 1u) * nloc) {
            __builtin_amdgcn_fence(__ATOMIC_RELEASE, "agent");
            asm volatile("s_waitcnt vmcnt(0)" ::: "memory");
            const unsigned og = xb_add(&bar[XB_TOP], 1u);
            const unsigned tg = og / nx;
            if (og + 1u == (tg + 1u) * nx) xb_add(&bar[XB_TOPGEN], 1u);
            else XB_SPIN(xb_ld(&bar[XB_TOPGEN]) == tg, bar);
            __builtin_amdgcn_fence(__ATOMIC_ACQUIRE, "agent");
            xb_add(&bar[XB_XGEN(b.x)], 1u);
            asm volatile("s_waitcnt vmcnt(0)" ::: "memory");
        } else {
            XB_SPIN(xb_ld(&bar[XB_XGEN(b.x)]) == gen, bar);
            __builtin_amdgcn_fence(__ATOMIC_ACQUIRE, "agent");
            asm volatile("s_waitcnt vmcnt(0)" ::: "memory");
        }
    }
    __syncthreads();
}

struct Args { const float* in[29]; float* out; unsigned char* ws; int ph_lo, ph_hi, li, pad; };
enum { I_X = 0, I_C, I_WMOD, I_BMOD, I_N1G, I_WIN, I_BIN, I_LNG, I_LNB, I_GWS, I_GBS, I_LRE, I_LIM, I_LDT, I_BRE, I_BIM, I_CRE, I_CIM, I_SD, I_GLUW, I_GLUB,
       I_BRG, I_WOUT, I_N2G, I_WQ, I_KEYS, I_PU, I_PV, I_FG };

struct Frame {
    LAS unsigned char* lds;
    unsigned char* ws;
    const float* const* in;
    float* out;
    int tid, lane, wave, vcu, G;
};

#define PH_LOCALS int tid = F.tid; asm volatile("" : "+v"(tid)); const int lane = tid & 63; const int wave = __builtin_amdgcn_readfirstlane(tid >> 6); (void)lane; (void)wave;

struct EpiIn {
    static constexpr bool PERM = true, AFTER_DRAIN = false;
    bf16* Z; bf16* XS; const float* bias;
    __device__ __forceinline__ void operator()(const f32x4 (&acc)[2][2][4][2], const pg8::Unit& u, int wr, int wc, int fr, int fq) const {
        const int row0 = u.pm * 256 + wr * 64 + fr, col0 = u.pn * 256 + wc * 32 + 8 * fq;
        f32x4 bv[2][2];
#pragma unroll
        for (int bj = 0; bj < 2; ++bj)
#pragma unroll
            for (int n = 0; n < 2; ++n) bv[bj][n] = *(const f32x4*)(bias + col0 + bj * 128 + 4 * n);
        const bool isz = (u.pn < 8);
#pragma unroll
        for (int ai = 0; ai < 2; ++ai)
#pragma unroll
            for (int m = 0; m < 4; ++m) {
                const int r = row0 + ai * 128 + m * 16;
#pragma unroll
                for (int bj = 0; bj < 2; ++bj) {
                    f32x4 v0 = acc[ai][bj][m][0] + bv[bj][0], v1 = acc[ai][bj][m][1] + bv[bj][1];
                    const int c = col0 + bj * 128;
                    u32x4 w;
                    if (isz) {
                        w.x = pg8::cvt_pk_bf16(gelu_tanh(v0[0]), gelu_tanh(v0[1])); w.y = pg8::cvt_pk_bf16(gelu_tanh(v0[2]), gelu_tanh(v0[3]));
                        w.z = pg8::cvt_pk_bf16(gelu_tanh(v1[0]), gelu_tanh(v1[1])); w.w = pg8::cvt_pk_bf16(gelu_tanh(v1[2]), gelu_tanh(v1[3]));
                        *(u32x4*)(Z + (size_t)r * 2048 + c) = w;
                    } else {
                        w.x = pg8::cvt_pk_bf16(v0[0], v0[1]); w.y = pg8::cvt_pk_bf16(v0[2], v0[3]); w.z = pg8::cvt_pk_bf16(v1[0], v1[1]); w.w = pg8::cvt_pk_bf16(v1[2], v1[3]);
                        const int cc = c - 2048, g = cc >> 4, i = cc & 15;
                        *(u32x4*)(XS + ((size_t)(g * 256 + (r >> 6)) * 64 + (r & 63)) * 16 + i) = w;
                    }
                }
            }
    }
};
struct EpiGlu {
    static constexpr bool PERM = true, AFTER_DRAIN = false;
    const bf16* Gb; bf16* MIX; const float* bias;
    __device__ __forceinline__ void operator()(const f32x4 (&acc)[2][2][4][2], const pg8::Unit& u, int wr, int wc, int fr, int fq) const {
        const int row0 = u.pm * 256 + wr * 64 + fr, col0 = u.pn * 256 + wc * 32 + 8 * fq;
        f32x4 bv[2][2];
#pragma unroll
        for (int bj = 0; bj < 2; ++bj)
#pragma unroll
            for (int n = 0; n < 2; ++n) bv[bj][n] = *(const f32x4*)(bias + col0 + bj * 128 + 4 * n);
#pragma unroll
        for (int ai = 0; ai < 2; ++ai)
#pragma unroll
            for (int m = 0; m < 4; ++m) {
                const int r = row0 + ai * 128 + m * 16;
#pragma unroll
                for (int bj = 0; bj < 2; ++bj) {
                    const f32x4 v0 = acc[ai][bj][m][0] + bv[bj][0], v1 = acc[ai][bj][m][1] + bv[bj][1];
                    const int c = col0 + bj * 128;
                    const u32x4 gw = *(const u32x4*)(Gb + (size_t)r * 1024 + c);
                    u32x4 w;
                    w.x = pg8::cvt_pk_bf16(bflo(gw.x) * fast_sigmoid(v0[0]), bfhi(gw.x) * fast_sigmoid(v0[1]));
                    w.y = pg8::cvt_pk_bf16(bflo(gw.y) * fast_sigmoid(v0[2]), bfhi(gw.y) * fast_sigmoid(v0[3]));
                    w.z = pg8::cvt_pk_bf16(bflo(gw.z) * fast_sigmoid(v1[0]), bfhi(gw.z) * fast_sigmoid(v1[1]));
                    w.w = pg8::cvt_pk_bf16(bflo(gw.w) * fast_sigmoid(v1[2]), bfhi(gw.w) * fast_sigmoid(v1[3]));
                    *(u32x4*)(MIX + (size_t)r * 2048 + 1024 + c) = w;
                }
            }
    }
};
struct EpiOut {
    static constexpr bool PERM = true, AFTER_DRAIN = false;
    const float* xin; float* X; const float* gate;
    __device__ __forceinline__ void operator()(const f32x4 (&acc)[2][2][4][2], const pg8::Unit& u, int wr, int wc, int fr, int fq) const {
        const int row0 = u.pm * 256 + wr * 64 + fr, col0 = u.pn * 256 + wc * 32 + 8 * fq;
        f32x4 gv[2][2];
#pragma unroll
        for (int bj = 0; bj < 2; ++bj)
#pragma unroll
            for (int n = 0; n < 2; ++n) gv[bj][n] = *(const f32x4*)(gate + col0 + bj * 128 + 4 * n);
#pragma unroll
        for (int ai = 0; ai < 2; ++ai)
#pragma unroll
            for (int m = 0; m < 4; ++m) {
                const int r = row0 + ai * 128 + m * 16;
#pragma unroll
                for (int bj = 0; bj < 2; ++bj) {
                    const size_t off = (size_t)r * 2048 + col0 + bj * 128;
                    const f32x4 x0 = *(const f32x4*)(xin + off), x1 = *(const f32x4*)(xin + off + 4);
                    *(f32x4*)(X + off) = x0 + gv[bj][0] * acc[ai][bj][m][0];
                    *(f32x4*)(X + off + 4) = x1 + gv[bj][1] * acc[ai][bj][m][1];
                }
            }
    }
};
struct EpiQ {
    static constexpr bool PERM = true, AFTER_DRAIN = false;
    bf16* Q;
    __device__ __forceinline__ void operator()(const f32x4 (&acc)[2][2][4][2], const pg8::Unit& u, int wr, int wc, int fr, int fq) const {
        const int row0 = u.pm * 256 + wr * 64 + fr, col0 = u.pn * 256 + wc * 32 + 8 * fq;
#pragma unroll
        for (int ai = 0; ai < 2; ++ai)
#pragma unroll
            for (int m = 0; m < 4; ++m) {
                const int r = row0 + ai * 128 + m * 16;
#pragma unroll
                for (int bj = 0; bj < 2; ++bj) {
                    const f32x4 v0 = acc[ai][bj][m][0], v1 = acc[ai][bj][m][1];
                    u32x4 w; w.x = pg8::cvt_pk_bf16(v0[0], v0[1]); w.y = pg8::cvt_pk_bf16(v0[2], v0[3]); w.z = pg8::cvt_pk_bf16(v1[0], v1[1]); w.w = pg8::cvt_pk_bf16(v1[2], v1[3]);
                    *(u32x4*)(Q + (size_t)r * 2048 + col0 + bj * 128) = w;
                }
            }
    }
};

__device__ __forceinline__ void p0_transpose_item(const float* W, int K, int N, bf16* WT, const float* kscale, LAS float* scr, int item, int lane) {
    const int nblk = N / 32, kb = item / nblk, nb = item % nblk, k0 = 64 * kb, n0 = 32 * nb;
#pragma unroll 8
    for (int i = 0; i < 32; ++i) { const int kk = 2 * i + (lane >> 5); float v = W[(size_t)(k0 + kk) * N + n0 + (lane & 31)]; if (kscale) v *= kscale[k0 + kk]; scr[kk * 33 + (lane & 31)] = v; }
    LDS_WAIT(); asm volatile("" ::: "memory");
    const int c = lane & 7;
#pragma unroll
    for (int j = 0; j < 4; ++j) { const int n = (lane >> 3) + 8 * j; const LAS float* s = scr + (8 * c) * 33 + n;
        u32x4 o; o.x = pk2(s[0 * 33], s[1 * 33]); o.y = pk2(s[2 * 33], s[3 * 33]); o.z = pk2(s[4 * 33], s[5 * 33]); o.w = pk2(s[6 * 33], s[7 * 33]);
        *(u32x4*)(WT + (size_t)(n0 + n) * K + k0 + 8 * c) = o; }
    LDS_WAIT(); asm volatile("" ::: "memory");
}

__device__ __forceinline__ void norm_mod_row(const f32x4 (&v)[4][2], const float* gain, const float* scale, const float* shift, int lane, u32x4 (&o)[4]) {
    float s = 0.f;
#pragma unroll
    for (int j = 0; j < 4; ++j)
#pragma unroll
        for (int h = 0; h < 2; ++h) s += (v[j][h][0] * v[j][h][0] + v[j][h][1] * v[j][h][1]) + (v[j][h][2] * v[j][h][2] + v[j][h][3] * v[j][h][3]);
    const float rr = 1.0f / sqrtf(wave_sum(s) * (1.0f / DM) + EPS);
#pragma unroll
    for (int j = 0; j < 4; ++j) {
        const int c = j * 512 + lane * 8;
        f32x4 y[2];
#pragma unroll
        for (int h = 0; h < 2; ++h) {
            const f32x4 g = *(const f32x4*)(gain + c + 4 * h);
            y[h] = v[j][h] * rr * g;
            const f32x4 sc = *(const f32x4*)(scale + c + 4 * h), sh = *(const f32x4*)(shift + c + 4 * h); y[h] = y[h] * (sc + 1.0f) + sh;
        }
        o[j].x = pk2(y[0][0], y[0][1]); o[j].y = pk2(y[0][2], y[0][3]); o[j].z = pk2(y[1][0], y[1][1]); o[j].w = pk2(y[1][2], y[1][3]);
    }
}
__device__ __forceinline__ void norm_row_pass(const float* xrow, bf16* hrow, const float* gain, const float* scale, const float* shift, int lane) {
    f32x4 v[4][2];
#pragma unroll
    for (int j = 0; j < 4; ++j) { v[j][0] = *(const f32x4*)(xrow + j * 512 + lane * 8); v[j][1] = *(const f32x4*)(xrow + j * 512 + lane * 8 + 4); }
    u32x4 o[4]; norm_mod_row(v, gain, scale, shift, lane, o);
#pragma unroll
    for (int j = 0; j < 4; ++j) *(u32x4*)(hrow + j * 512 + lane * 8) = o[j];
}

__device__ __forceinline__ void p0_prologue(Frame& F) {
    PH_LOCALS
    const int gw = F.vcu * NWAVES + wave, NGW = F.G * NWAVES;
    const int gt = F.vcu * NTHR + tid, NGT = F.G * NTHR;
    if ((int)blockIdx.x < 192) {
        const int l = blockIdx.x / 96, cb = blockIdx.x % 96;
        LAS float* sc = (LAS float*)F.lds;
        LAS float* red = (LAS float*)(F.lds + 8192);
        for (int k = tid; k < DM; k += NTHR) { const float c = F.in[I_C][k]; sc[k] = c * fast_sigmoid(c); }
        __syncthreads();
        const int tx = tid & 31, ty = tid >> 5;
        const float* W = F.in[I_WMOD] + (size_t)l * DM * 12288 + cb * 128 + tx * 4;
        f32x4 a = {0.f, 0.f, 0.f, 0.f};
#pragma unroll 8
        for (int k = ty; k < DM; k += 16) { const f32x4 w = *(const f32x4*)(W + (size_t)k * 12288); a += w * sc[k]; }
        *(LAS f32x4*)(red + ty * 128 + tx * 4) = a;
        __syncthreads();
        if (tid < 128) { float s = 0.f;
#pragma unroll
            for (int y = 0; y < 16; ++y) s += red[y * 128 + tid];
            ((float*)(F.ws + WS_MOD))[l * 12288 + cb * 128 + tid] = s + F.in[I_BMOD][l * 12288 + cb * 128 + tid]; }
        __syncthreads();
    }
    if ((int)blockIdx.x >= 128) {
        const int u = 255 - (int)blockIdx.x, l = u >> 6, g = u & 63;
        LAS float* apr = (LAS float*)F.lds;
        LAS float* api = apr + 65 * 64;
        LAS float* bbr = api + 65 * 64;
        LAS float* bbi = bbr + 1024;
        LAS float* ccr = bbi + 1024;
        LAS float* cci = ccr + 1024;
        const float dt = expf(F.in[I_LDT][l * 64 + g]);
        const float* lre = F.in[I_LRE] + (l * 64 + g) * 64; const float* lim = F.in[I_LIM] + (l * 64 + g) * 64;
        for (int idx = tid; idx < 65 * 64; idx += NTHR) { const int d = idx >> 6, p = idx & 63;
            const float mag = expf(lre[p] * dt * (float)d); float sn, cs; sincosf(lim[p] * dt * (float)d, &sn, &cs);
            apr[idx] = mag * cs; api[idx] = mag * sn; }
        for (int idx = tid; idx < 1024; idx += NTHR) { const int o = idx >> 6, p = idx & 63;
            ccr[idx] = F.in[I_CRE][((size_t)(l * 64 + g) * 16 + o) * 64 + p]; cci[idx] = F.in[I_CIM][((size_t)(l * 64 + g) * 16 + o) * 64 + p]; }
        __syncthreads();
        for (int idx = tid; idx < 1024; idx += NTHR) { const int p = idx >> 4, i = idx & 15;
            const float xr = apr[64 + p] - 1.0f, xi = api[64 + p], lr = lre[p], li = lim[p], den = 1.0f / (lr * lr + li * li);
            const float cr = (xr * lr + xi * li) * den, ci = (xi * lr - xr * li) * den;
            const float br = F.in[I_BRE][((size_t)(l * 64 + g) * 64 + p) * 16 + i], bi = F.in[I_BIM][((size_t)(l * 64 + g) * 64 + p) * 16 + i];
            bbr[idx] = cr * br - ci * bi; bbi[idx] = cr * bi + ci * br; }
        __syncthreads();
        bf16* KT = (bf16*)(F.ws + WS_KTAB) + (size_t)(l * 64 + g) * 65 * 256;
        for (int idx = tid; idx < 65 * 256; idx += NTHR) {
            const int d = (idx >> 8) - 1, o = (idx >> 4) & 15, i = idx & 15; float s = 0.f;
            if (d >= 0) {
                for (int p = 0; p < 64; ++p) { const float ar = apr[d * 64 + p], ai = api[d * 64 + p], cr = ccr[o * 64 + p], ci = cci[o * 64 + p];
                    const float er = cr * ar - ci * ai, ei = cr * ai + ci * ar; s += er * bbr[p * 16 + i] - ei * bbi[p * 16 + i]; }
                if (d == 0 && o == i) s += F.in[I_SD][l * 1024 + g * 16 + o];
            }
            KT[idx] = (bf16)f2bf(s);
        }
        bf16* WG = (bf16*)(F.ws + WS_WG) + (size_t)(l * 64 + g) * 128 * 1024;
        for (int idx = tid; idx < 64 * 1024; idx += NTHR) { const int p = idx >> 10, k = idx & 1023, tau = k >> 4, i = k & 15;
            const float ar = apr[(63 - tau) * 64 + p], ai = api[(63 - tau) * 64 + p], br = bbr[p * 16 + i], bi = bbi[p * 16 + i];
            WG[(size_t)p * 1024 + k] = (bf16)f2bf(ar * br - ai * bi); WG[(size_t)(64 + p) * 1024 + k] = (bf16)f2bf(ar * bi + ai * br); }
        bf16* VG = (bf16*)(F.ws + WS_VG) + (size_t)(l * 64 + g) * 1024 * 128;
        for (int idx = tid; idx < 1024 * 64; idx += NTHR) { const int m = idx >> 6, p = idx & 63, t = m >> 4, o = m & 15;
            const float ar = apr[(t + 1) * 64 + p], ai = api[(t + 1) * 64 + p], cr = ccr[o * 64 + p], ci = cci[o * 64 + p];
            VG[(size_t)m * 128 + p] = (bf16)f2bf(cr * ar - ci * ai); VG[(size_t)m * 128 + 64 + p] = (bf16)f2bf(-(cr * ai + ci * ar)); }
        if (tid < 64) { float* AT = (float*)(F.ws + WS_AT) + ((size_t)(l * 64 + g) * 64 + tid) * 2; AT[0] = apr[64 * 64 + tid]; AT[1] = api[64 * 64 + tid]; }
        __syncthreads();
    }
    {
        LAS float* scr = (LAS float*)(F.lds + wave * 16384);
        constexpr int I_IN = (DM / 64) * (INW / 32), I_GL = (WB / 64) * (WB / 32), I_OU = (DM / 64) * (DM / 32), I_Q = I_OU;
        constexpr int PER_L = I_IN + I_GL + I_OU + I_Q;
        for (int it = gw; it < 2 * PER_L; it += NGW) {
            const int l = it / PER_L; int r = it % PER_L;
            if (r < I_IN) { p0_transpose_item(F.in[I_WIN] + (size_t)l * DM * INW, DM, INW, (bf16*)(F.ws + WS_WIN) + (size_t)l * INW * DM, nullptr, scr, r, lane); continue; } r -= I_IN;
            if (r < I_GL) { p0_transpose_item(F.in[I_GLUW] + (size_t)l * WB * WB, WB, WB, (bf16*)(F.ws + WS_GLU) + (size_t)l * WB * WB, nullptr, scr, r, lane); continue; } r -= I_GL;
            if (r < I_OU) { p0_transpose_item(F.in[I_WOUT] + (size_t)l * DM * DM, DM, DM, (bf16*)(F.ws + WS_WOUT) + (size_t)l * DM * DM, F.in[I_BRG] + l * DM, scr, r, lane); continue; } r -= I_OU;
            p0_transpose_item(F.in[I_WQ] + (size_t)l * DM * DM, DM, DM, (bf16*)(F.ws + WS_WQ) + (size_t)l * DM * DM, nullptr, scr, r, lane);
        }
    }
    {
        bf16* KB = (bf16*)(F.ws + WS_KEYS);
        for (int i = gt; i < 2 * 8 * 2 * 128 * 128 / 8; i += NGT) { const f32x4 a = *(const f32x4*)(F.in[I_KEYS] + (size_t)i * 8), b = *(const f32x4*)(F.in[I_KEYS] + (size_t)i * 8 + 4);
            u32x4 o; o.x = pk2(a[0], a[1]); o.y = pk2(a[2], a[3]); o.z = pk2(b[0], b[1]); o.w = pk2(b[2], b[3]); *(u32x4*)(KB + (size_t)i * 8) = o; }
        bf16* GW = (bf16*)(F.ws + WS_GWS);
        for (int i = gt; i < 2 * 8 * 128 * 128 / 8; i += NGT) { const int e = i * 8, jj = e & 127, ii = (e >> 7) & 127; const bool keep = (ii >= 64) || (jj < 64);
            f32x4 a = *(const f32x4*)(F.in[I_GWS] + (size_t)i * 8), b = *(const f32x4*)(F.in[I_GWS] + (size_t)i * 8 + 4);
            if (!keep) { a = (f32x4){0.f, 0.f, 0.f, 0.f}; b = a; }
            u32x4 o; o.x = pk2(a[0], a[1]); o.y = pk2(a[2], a[3]); o.z = pk2(b[0], b[1]); o.w = pk2(b[2], b[3]); *(u32x4*)(GW + (size_t)i * 8) = o; }
        bf16* UV = (bf16*)(F.ws + WS_UV);
        const size_t nchunk = (size_t)2 * NEXP * 2048 / 8;
        for (size_t i = gt; i < nchunk; i += NGT) {
            const size_t row = i >> 8, c8 = i & 255;
            const f32x4 a = *(const f32x4*)(F.in[I_PU] + i * 8), b = *(const f32x4*)(F.in[I_PU] + i * 8 + 4);
            u32x4 o; o.x = pk2(a[0], a[1]); o.y = pk2(a[2], a[3]); o.z = pk2(b[0], b[1]); o.w = pk2(b[2], b[3]); *(u32x4*)(UV + row * 4096 + c8 * 8) = o;
            const f32x4 c = *(const f32x4*)(F.in[I_PV] + i * 8), d = *(const f32x4*)(F.in[I_PV] + i * 8 + 4);
            u32x4 q; q.x = pk2(c[0], c[1]); q.y = pk2(c[2], c[3]); q.z = pk2(d[0], d[1]); q.w = pk2(d[2], d[3]); *(u32x4*)(UV + row * 4096 + 2048 + c8 * 8) = q;
        }
    }
}

__device__ __forceinline__ void phase_norm(Frame& F, const float* xsrc, const float* gain, const float* scale, const float* shift) {
    PH_LOCALS
    const int gw = F.vcu * NWAVES + wave, NGW = F.G * NWAVES;
    bf16* H = (bf16*)(F.ws + WS_H);
    for (int m = gw; m < M; m += NGW) norm_row_pass(xsrc + (size_t)m * DM, H + (size_t)m * DM, gain, scale, shift, lane);
}
__device__ __forceinline__ void phase_lnstats(Frame& F) {
    PH_LOCALS
    const int gw = F.vcu * NWAVES + wave, NGW = F.G * NWAVES;
    const bf16* Z = (const bf16*)(F.ws + WS_Z); float* ST = (float*)(F.ws + WS_STATS);
    for (int m = gw; m < M; m += NGW) {
        float v[16];
#pragma unroll
        for (int j = 0; j < 2; ++j) { const u32x4 w = *(const u32x4*)(Z + (size_t)m * 2048 + 1024 + j * 512 + lane * 8);
            v[j * 8 + 0] = bflo(w.x); v[j * 8 + 1] = bfhi(w.x); v[j * 8 + 2] = bflo(w.y); v[j * 8 + 3] = bfhi(w.y); v[j * 8 + 4] = bflo(w.z); v[j * 8 + 5] = bfhi(w.z); v[j * 8 + 6] = bflo(w.w); v[j * 8 + 7] = bfhi(w.w); }
        float s = 0.f;
#pragma unroll
        for (int i = 0; i < 16; ++i) s += v[i];
        const float mean = wave_sum(s) * (1.0f / 1024.0f); float q = 0.f;
#pragma unroll
        for (int i = 0; i < 16; ++i) { const float d = v[i] - mean; q += d * d; }
        const float rstd = 1.0f / sqrtf(wave_sum(q) * (1.0f / 1024.0f) + EPS);
        if (lane == 0) { ST[2 * m] = mean; ST[2 * m + 1] = rstd; }
    }
}
__device__ __forceinline__ void phase_branchnorm(Frame& F) {
    PH_LOCALS
    const int gw = F.vcu * NWAVES + wave, NGW = F.G * NWAVES;
    bf16* MIX = (bf16*)(F.ws + WS_MIX);
    for (int m = gw; m < M; m += NGW) {
        u32x4 w[4]; float sa = 0.f, sb = 0.f;
#pragma unroll
        for (int j = 0; j < 4; ++j) { w[j] = *(const u32x4*)(MIX + (size_t)m * 2048 + j * 512 + lane * 8);
            float q = 0.f;
#pragma unroll
            for (int e = 0; e < 4; ++e) { const float a = bflo(w[j][e]), b = bfhi(w[j][e]); q += a * a + b * b; }
            if (j < 2) sa += q; else sb += q; }
        const float ra = 1.0f / sqrtf(wave_sum(sa) * (1.0f / 1024.0f) + EPS), rb = 1.0f / sqrtf(wave_sum(sb) * (1.0f / 1024.0f) + EPS);
#pragma unroll
        for (int j = 0; j < 4; ++j) { const float r = j < 2 ? ra : rb; u32x4 o;
#pragma unroll
            for (int e = 0; e < 4; ++e) o[e] = pk2(bflo(w[j][e]) * r, bfhi(w[j][e]) * r);
            *(u32x4*)(MIX + (size_t)m * 2048 + j * 512 + lane * 8) = o; }
    }
}

__device__ __forceinline__ void phase_sloc(Frame& F, int l) {
    PH_LOCALS
    const bf16* XS = (const bf16*)(F.ws + WS_XS); const bf16* WG = (const bf16*)(F.ws + WS_WG) + (size_t)l * 64 * 128 * 1024; float* SL = (float*)(F.ws + WS_SLOC);
    const int fr = lane & 15, fq = lane >> 4;
    for (int u = F.vcu; u < 256; u += F.G) {
        const int g = u >> 2, n0 = (u & 3) * 64 + (wave & 3) * 16, jh = wave >> 2;
        f32x4 acc[4];
#pragma unroll
        for (int t = 0; t < 4; ++t) acc[t] = (f32x4){0.f, 0.f, 0.f, 0.f};
        const bf16* xp = XS + ((size_t)(g * 256 + n0 + fr)) * 1024 + 8 * fq;
        const bf16* wp = WG + ((size_t)(g * 128 + jh * 64 + fr)) * 1024 + 8 * fq;
#pragma unroll 4
        for (int kb = 0; kb < 32; ++kb) {
            const bf16x8 xf = *(const bf16x8*)(xp + kb * 32);
#pragma unroll
            for (int t = 0; t < 4; ++t) { const bf16x8 wf = *(const bf16x8*)(wp + (size_t)t * 16 * 1024 + kb * 32); acc[t] = __builtin_amdgcn_mfma_f32_16x16x32_bf16(wf, xf, acc[t], 0, 0, 0); }
        }
#pragma unroll
        for (int t = 0; t < 4; ++t) *(f32x4*)(SL + ((size_t)(g * 256 + n0 + fr)) * 128 + jh * 64 + t * 16 + 4 * fq) = acc[t];
    }
}
__device__ __forceinline__ void s5_carry(Frame& F, int l) {
    PH_LOCALS
    if (F.vcu < 64 && wave == 0) {
        const int g = F.vcu, p = lane;
        const float* AT = (const float*)(F.ws + WS_AT) + ((size_t)(l * 64 + g) * 64 + p) * 2; const float ar = AT[0], ai = AT[1];
        const float* SL = (const float*)(F.ws + WS_SLOC) + (size_t)g * 256 * 128; bf16* HS = (bf16*)(F.ws + WS_HS) + (size_t)g * 256 * 128;
        float hr = 0.f, hi = 0.f;
        for (int n0 = 0; n0 < 256; n0 += 8) {
            float sr[8], si[8];
#pragma unroll
            for (int e = 0; e < 8; ++e) { sr[e] = SL[(size_t)(n0 + e) * 128 + p]; si[e] = SL[(size_t)(n0 + e) * 128 + 64 + p]; }
#pragma unroll
            for (int e = 0; e < 8; ++e) { HS[(size_t)(n0 + e) * 128 + p] = (bf16)f2bf(hr); HS[(size_t)(n0 + e) * 128 + 64 + p] = (bf16)f2bf(hi);
                const float nr = ar * hr - ai * hi + sr[e], ni = ar * hi + ai * hr + si[e]; hr = nr; hi = ni; }
        }
    }
}

__device__ __forceinline__ void gating_unit(Frame& F, int l, int unit) {
    PH_LOCALS
    const int nb = unit >> 3, hh = unit & 7, t0 = nb * 128, c0 = hh * 128;
    const bf16* Z = (const bf16*)(F.ws + WS_Z); const float* ST = (const float*)(F.ws + WS_STATS);
    const bf16* GW = (const bf16*)(F.ws + WS_GWS) + (size_t)(l * 8 + hh) * 128 * 128;
    bf16* MIX = (bf16*)(F.ws + WS_MIX);
    LAS bf16* VT = (LAS bf16*)F.lds;
    constexpr int VS = 136;
    {
        const int j = tid >> 2, cs = (tid & 3) * 32;
        const float mu = ST[2 * (t0 + j)], rs = ST[2 * (t0 + j) + 1];
        const float* lg = F.in[I_LNG] + l * 1024 + c0 + cs; const float* lb = F.in[I_LNB] + l * 1024 + c0 + cs;
#pragma unroll
        for (int q = 0; q < 4; ++q) {
            const u32x4 w = *(const u32x4*)(Z + (size_t)(t0 + j) * 2048 + 1024 + c0 + cs + q * 8);
#pragma unroll
            for (int e = 0; e < 4; ++e) { const int c = cs + q * 8 + 2 * e;
                const float a = (bflo(w[e]) - mu) * rs * lg[q * 8 + 2 * e] + lb[q * 8 + 2 * e], b = (bfhi(w[e]) - mu) * rs * lg[q * 8 + 2 * e + 1] + lb[q * 8 + 2 * e + 1];
                VT[c * VS + j] = (bf16)f2bf(a); VT[(c + 1) * VS + j] = (bf16)f2bf(b); }
        }
    }
    __syncthreads();
    {
        const int fr = lane & 15, fq = lane >> 4, w = wave;
        f32x4 acc[8];
#pragma unroll
        for (int ct = 0; ct < 8; ++ct) acc[ct] = (f32x4){0.f, 0.f, 0.f, 0.f};
        const int nkb = (w < 4) ? 2 : 4;
        for (int kb = 0; kb < nkb; ++kb) {
            const bf16x8 wf = *(const bf16x8*)(GW + (size_t)(16 * w + fr) * 128 + kb * 32 + 8 * fq);
#pragma unroll
            for (int ct = 0; ct < 8; ++ct) { const bf16x8 vf = *(const LAS bf16x8*)(VT + (ct * 16 + fr) * VS + kb * 32 + 8 * fq); acc[ct] = __builtin_amdgcn_mfma_f32_16x16x32_bf16(vf, wf, acc[ct], 0, 0, 0); }
        }
        const int tok = t0 + 16 * w + fr; const float bs = F.in[I_GBS][(l * 8 + hh) * 128 + 16 * w + fr];
#pragma unroll
        for (int ct = 0; ct < 8; ++ct) { const int c = c0 + ct * 16 + 4 * fq;
            const u32x2 uw = *(const u32x2*)(Z + (size_t)tok * 2048 + c);
            u32x2 o; o.x = pk2(bflo(uw.x) * (acc[ct][0] + bs), bfhi(uw.x) * (acc[ct][1] + bs)); o.y = pk2(bflo(uw.y) * (acc[ct][2] + bs), bfhi(uw.y) * (acc[ct][3] + bs));
            *(u32x2*)(MIX + (size_t)tok * 2048 + c) = o; }
    }
    __syncthreads();
}
__device__ __forceinline__ void phase_carry_gating(Frame& F, int l) {
    PH_LOCALS
    s5_carry(F, l);
    unsigned* head = (unsigned*)(F.ws + WS_CTL) + CW_QUEUE + 64 * l;
    LAS unsigned* slot = (LAS unsigned*)(F.lds + MISC_OFF) + 16;
    for (;;) {
        __syncthreads();
        if (tid == 0) slot[0] = __hip_atomic_fetch_add(head, 1u, RLX_AGENT);
        __syncthreads();
        const unsigned u = slot[0];
        if (u >= 1024u) break;
        gating_unit(F, l, (int)u);
    }
}

__device__ __forceinline__ void phase_s5out(Frame& F, int l) {
    PH_LOCALS
    const bf16* XS = (const bf16*)(F.ws + WS_XS); const bf16* HS = (const bf16*)(F.ws + WS_HS);
    bf16* Gb = (bf16*)(F.ws + WS_G);
    LAS bf16* KT = (LAS bf16*)F.lds;
    const int fr = lane & 15, fq = lane >> 4;
    for (int u = F.vcu; u < 512; u += F.G) {
        const int g = u >> 3, rc = (u >> 1) & 3, nh = u & 1;
        __syncthreads();
        { const u32x4* src = (const u32x4*)((const bf16*)(F.ws + WS_KTAB) + (size_t)(l * 64 + g) * 65 * 256);
          for (int i = tid; i < 65 * 256 / 8; i += NTHR) ((LAS u32x4*)KT)[i] = src[i]; }
        __syncthreads();
        const bf16* VG = (const bf16*)(F.ws + WS_VG) + (size_t)(l * 64 + g) * 1024 * 128;
        const int n = nh * 128 + 16 * wave + fr;
        f32x4 acc[16];
#pragma unroll
        for (int q = 0; q < 16; ++q) acc[q] = (f32x4){0.f, 0.f, 0.f, 0.f};
        const bf16* xp0 = XS + ((size_t)(g * 256 + n)) * 1024 + 8 * fq;
        bf16x8 x0 = *(const bf16x8*)xp0;
        for (int kb = 0; kb < 32; ++kb) {
            const int tau0 = 2 * kb;
            const bf16x8 c0 = x0;
            if (kb < 31) x0 = *(const bf16x8*)(xp0 + (kb + 1) * 32);
#pragma unroll
            for (int q = 0; q < 16; ++q) {
                const int t = rc + 4 * q;
                if (t >= tau0) {
                    const int d1 = t - tau0 - (fq >> 1) + 1;
                    const bf16x8 kf = *(const LAS bf16x8*)(KT + (d1 * 16 + fr) * 16 + 8 * (fq & 1));
                    acc[q] = __builtin_amdgcn_mfma_f32_16x16x32_bf16(kf, c0, acc[q], 0, 0, 0);
                }
            }
        }
        const bf16* hp0 = HS + ((size_t)(g * 256 + n)) * 128 + 8 * fq;
        for (int jb = 0; jb < 4; ++jb) {
            const bf16x8 h0 = *(const bf16x8*)(hp0 + jb * 32);
#pragma unroll
            for (int q = 0; q < 16; ++q) {
                const int t = rc + 4 * q;
                const bf16x8 vf = *(const bf16x8*)(VG + (size_t)(t * 16 + fr) * 128 + jb * 32 + 8 * fq);
                acc[q] = __builtin_amdgcn_mfma_f32_16x16x32_bf16(vf, h0, acc[q], 0, 0, 0);
            }
        }
#pragma unroll
        for (int q = 0; q < 16; ++q) {
            const int t = rc + 4 * q, tok = 64 * n + t;
            const f32x4 y = acc[q];
            u32x2 o; o.x = pk2(gelu_tanh(y[0]), gelu_tanh(y[1])); o.y = pk2(gelu_tanh(y[2]), gelu_tanh(y[3]));
            *(u32x2*)(Gb + (size_t)tok * 1024 + g * 16 + 4 * fq) = o;
        }
    }
}

__device__ __forceinline__ unsigned f2key(float v) { const unsigned u = __builtin_bit_cast(unsigned, v); return (u & 0x80000000u) ? ~u : (u | 0x80000000u); }
__device__ __forceinline__ float key2f(unsigned k) { const unsigned u = (k & 0x80000000u) ? (k & 0x7fffffffu) : ~k; return __builtin_bit_cast(float, u); }
__device__ __forceinline__ void phase_topk(Frame& F, int l) {
    PH_LOCALS
    const bf16* Q = (const bf16*)(F.ws + WS_Z);
    const bf16* KB = (const bf16*)(F.ws + WS_KEYS) + (size_t)l * 8 * 2 * 128 * 128;
    int* EID = (int*)(F.ws + WS_EID); float* GT = (float*)(F.ws + WS_GATE);
    LAS float* SC = (LAS float*)F.lds;
    LAS unsigned* LST = (LAS unsigned*)(F.lds + 128 * 260 * 4);
    const int fr = lane & 15, fq = lane >> 4;
    for (int u = F.vcu; u < 1024; u += F.G) {
        const int tt = u >> 3, hh = u & 7, t0 = tt * 128;
        __syncthreads();
        {
            f32x4 acc[2][8];
#pragma unroll
            for (int s = 0; s < 2; ++s)
#pragma unroll
                for (int nt = 0; nt < 8; ++nt) acc[s][nt] = (f32x4){0.f, 0.f, 0.f, 0.f};
#pragma unroll
            for (int s = 0; s < 2; ++s)
#pragma unroll
                for (int kb = 0; kb < 4; ++kb) {
                    const bf16x8 qf = *(const bf16x8*)(Q + (size_t)(t0 + 16 * wave + fr) * 2048 + hh * 256 + s * 128 + kb * 32 + 8 * fq);
#pragma unroll
                    for (int nt = 0; nt < 8; ++nt) { const bf16x8 kf = *(const bf16x8*)(KB + ((size_t)((hh * 2 + s) * 128 + nt * 16 + fr)) * 128 + kb * 32 + 8 * fq);
                        acc[s][nt] = __builtin_amdgcn_mfma_f32_16x16x32_bf16(kf, qf, acc[s][nt], 0, 0, 0); }
                }
#pragma unroll
            for (int s = 0; s < 2; ++s)
#pragma unroll
                for (int nt = 0; nt < 8; ++nt) *(LAS f32x4*)(SC + (16 * wave + fr) * 260 + s * 128 + nt * 16 + 4 * fq) = acc[s][nt];
        }
        __syncthreads();
        if (tid < 256) {
            const int tl = tid >> 1, s = tid & 1;
            unsigned top[16];
#pragma unroll
            for (int k = 0; k < 16; ++k) top[k] = 0u;
            const LAS float* row = SC + tl * 260 + s * 128;
            for (int n4 = 0; n4 < 32; ++n4) {
                const f32x4 v = *(const LAS f32x4*)(row + 4 * n4);
#pragma unroll
                for (int e = 0; e < 4; ++e) {
                    unsigned key = (f2key(v[e]) & ~0x7Fu) | (unsigned)(127 - (4 * n4 + e));
#pragma unroll
                    for (int k = 0; k < 16; ++k) { const unsigned hi = top[k] > key ? top[k] : key, lo = top[k] > key ? key : top[k]; top[k] = hi; key = lo; }
                }
            }
#pragma unroll
            for (int k = 0; k < 16; k += 4) *(LAS u32x4*)(LST + (tl * 2 + s) * 16 + k) = (u32x4){top[k], top[k + 1], top[k + 2], top[k + 3]};
        }
        __syncthreads();
        if (tid < 128) {
            const int tl = tid;
            float av[16], bv[16];
#pragma unroll
            for (int k = 0; k < 16; ++k) { av[k] = key2f(LST[(tl * 2 + 0) * 16 + k] & ~0x7Fu); bv[k] = key2f(LST[(tl * 2 + 1) * 16 + k] & ~0x7Fu); }
            unsigned top[16];
#pragma unroll
            for (int k = 0; k < 16; ++k) top[k] = 0u;
#pragma unroll
            for (int i = 0; i < 16; ++i)
#pragma unroll
                for (int j = 0; j < 16; ++j)
                    if ((i + 1) * (j + 1) <= 16) {
                        unsigned key = (f2key(av[i] + bv[j]) & ~0xFFu) | (unsigned)(255 - (i * 16 + j));
#pragma unroll
                        for (int k = 0; k < 16; ++k) { const unsigned hi = top[k] > key ? top[k] : key, lo = top[k] > key ? key : top[k]; top[k] = hi; key = lo; }
                    }
            float ev[16]; float sum = 0.f; const float mx = key2f(top[0] & ~0xFFu);
#pragma unroll
            for (int k = 0; k < 16; ++k) { ev[k] = __expf(key2f(top[k] & ~0xFFu) - mx); sum += ev[k]; }
            const float inv = 1.0f / sum;
            int* eo = EID + (size_t)(t0 + tl) * 128 + hh * 16; float* go = GT + (size_t)(t0 + tl) * 128 + hh * 16;
#pragma unroll
            for (int k = 0; k < 16; ++k) { const int flat = 255 - (int)(top[k] & 0xFFu), i = flat >> 4, j = flat & 15;
                const int ia = 127 - (int)(LST[(tl * 2 + 0) * 16 + i] & 0x7Fu), ib = 127 - (int)(LST[(tl * 2 + 1) * 16 + j] & 0x7Fu);
                eo[k] = ia * 128 + ib; go[k] = ev[k] * inv; }
        }
    }
    __syncthreads();
}

__device__ __forceinline__ float dot8(const u32x4 a, const u32x4 b, float acc) {
#pragma unroll
    for (int e = 0; e < 4; ++e) { acc = fmaf(bflo(a[e]), bflo(b[e]), acc); acc = fmaf(bfhi(a[e]), bfhi(b[e]), acc); }
    return acc;
}
__device__ __forceinline__ void phase_gather(Frame& F, int l) {
    PH_LOCALS
    const int gw = F.vcu * NWAVES + wave, NGW = F.G * NWAVES;
    const bf16* H = (const bf16*)(F.ws + WS_H); bf16* Hn = (bf16*)(F.ws + WS_H);
    const bf16* UV = (const bf16*)(F.ws + WS_UV) + (size_t)l * NEXP * 4096;
    const int* EID = (const int*)(F.ws + WS_EID); const float* GT = (const float*)(F.ws + WS_GATE);
    float* X = (float*)(F.ws + WS_X);
    const float* mod = (const float*)(F.ws + WS_MOD);
    const float* gate2 = mod + l * 12288 + 5 * 2048;
    const unsigned lane16 = (unsigned)lane * 16u;
    for (int t = gw; t < M; t += NGW) {
        const int e_lo = EID[(size_t)t * 128 + lane], e_hi = EID[(size_t)t * 128 + 64 + lane];
        const float g_lo = GT[(size_t)t * 128 + lane], g_hi = GT[(size_t)t * 128 + 64 + lane];
        u32x4 hp[4];
#pragma unroll
        for (int j = 0; j < 4; ++j) hp[j] = *(const u32x4*)(H + (size_t)t * 2048 + j * 512 + lane * 8);
        float out[32];
#pragma unroll
        for (int i = 0; i < 32; ++i) out[i] = 0.f;
        for (int b = 0; b < 32; ++b) {
            int e[4]; float gt[4];
#pragma unroll
            for (int h = 0; h < 4; ++h) { const int k = 4 * b + h;
                e[h] = __builtin_amdgcn_readlane(k < 64 ? e_lo : e_hi, k & 63);
                gt[h] = __builtin_bit_cast(float, __builtin_amdgcn_readlane(__builtin_bit_cast(int, k < 64 ? g_lo : g_hi), k & 63)); }
            const char* rowp[4];
#pragma unroll
            for (int h = 0; h < 4; ++h) rowp[h] = (const char*)UV + ((size_t)(unsigned)e[h] << 13);
            u32x4 ur[4][4];
#pragma unroll
            for (int h = 0; h < 4; ++h)
#pragma unroll
                for (int j = 0; j < 4; ++j) ur[h][j] = *(const u32x4*)(rowp[h] + lane16 + j * 1024);
            u32x4 vr[4][4];
#pragma unroll
            for (int h = 0; h < 4; ++h)
#pragma unroll
                for (int j = 0; j < 4; ++j) vr[h][j] = *(const u32x4*)(rowp[h] + lane16 + 4096 + j * 1024);
            float p[4];
#pragma unroll
            for (int h = 0; h < 4; ++h) { float a = 0.f;
#pragma unroll
                for (int j = 0; j < 4; ++j) a = dot8(ur[h][j], hp[j], a);
                p[h] = a; }
            const bool up = lane >= 32;
            const float s0 = up ? p[0] : p[2], s1 = up ? p[1] : p[3];
            const float r0 = __shfl_xor(s0, 32), r1 = __shfl_xor(s1, 32);
            const float k0 = (up ? p[2] : p[0]) + r0, k1 = (up ? p[3] : p[1]) + r1;
            const bool odd = (lane & 16) != 0;
            const float sx = odd ? k0 : k1;
            const float rx = __shfl_xor(sx, 16);
            float d = (odd ? k1 : k0) + rx;
            d += __shfl_xor(d, 8); d += __shfl_xor(d, 4); d += __shfl_xor(d, 2); d += __shfl_xor(d, 1);
            const int q = lane >> 4;
            const float gq = q == 0 ? gt[0] : q == 1 ? gt[1] : q == 2 ? gt[2] : gt[3];
            const float coefq = gq * gelu_tanh(d);
#pragma unroll
            for (int h = 0; h < 4; ++h) {
                const float cf = __builtin_bit_cast(float, __builtin_amdgcn_readlane(__builtin_bit_cast(int, coefq), 16 * h));
#pragma unroll
                for (int j = 0; j < 4; ++j)
#pragma unroll
                    for (int w = 0; w < 4; ++w) { out[j * 8 + 2 * w] = fmaf(cf, bflo(vr[h][j][w]), out[j * 8 + 2 * w]); out[j * 8 + 2 * w + 1] = fmaf(cf, bfhi(vr[h][j][w]), out[j * 8 + 2 * w + 1]); }
            }
        }
        int ln = lane; asm volatile("" : "+v"(ln));
        f32x4 xv[4][2];
#pragma unroll
        for (int j = 0; j < 4; ++j)
#pragma unroll
            for (int h = 0; h < 2; ++h) {
                const int c = j * 512 + ln * 8 + 4 * h;
                const f32x4 xo = *(const f32x4*)(X + (size_t)t * 2048 + c), g2 = *(const f32x4*)(gate2 + c);
                const f32x4 o = {out[j * 8 + 4 * h], out[j * 8 + 4 * h + 1], out[j * 8 + 4 * h + 2], out[j * 8 + 4 * h + 3]};
                xv[j][h] = xo + g2 * o;
            }
        if (l + 1 < DEPTH) {
#pragma unroll
            for (int j = 0; j < 4; ++j) { *(f32x4*)(X + (size_t)t * 2048 + j * 512 + ln * 8) = xv[j][0]; *(f32x4*)(X + (size_t)t * 2048 + j * 512 + ln * 8 + 4) = xv[j][1]; }
            const float* m2 = mod + (l + 1) * 12288;
            u32x4 o[4]; norm_mod_row(xv, F.in[I_N1G] + (l + 1) * 2048, m2 + 1 * 2048, m2 + 0 * 2048, ln, o);
#pragma unroll
            for (int j = 0; j < 4; ++j) *(u32x4*)(Hn + (size_t)t * 2048 + j * 512 + ln * 8) = o[j];
        } else {
            float s = 0.f;
#pragma unroll
            for (int j = 0; j < 4; ++j)
#pragma unroll
                for (int h = 0; h < 2; ++h) s += (xv[j][h][0] * xv[j][h][0] + xv[j][h][1] * xv[j][h][1]) + (xv[j][h][2] * xv[j][h][2] + xv[j][h][3] * xv[j][h][3]);
            const float rr = 1.0f / sqrtf(wave_sum(s) * (1.0f / DM) + EPS);
#pragma unroll
            for (int j = 0; j < 4; ++j)
#pragma unroll
                for (int h = 0; h < 2; ++h) { const int c = j * 512 + ln * 8 + 4 * h; const f32x4 fg = *(const f32x4*)(F.in[I_FG] + c);
                    *(f32x4*)(F.out + (size_t)t * 2048 + c) = xv[j][h] * rr * fg; }
        }
    }
}

__global__ void __launch_bounds__(NTHR, 2) fwd_kernel(Args args) {
    extern __shared__ __attribute__((aligned(16))) unsigned char lds_raw[];
    Frame F;
    F.lds = (LAS unsigned char*)lds_raw; F.ws = args.ws; F.in = args.in; F.out = args.out;
    F.tid = threadIdx.x; F.lane = F.tid & 63; F.wave = __builtin_amdgcn_readfirstlane(F.tid >> 6);
    F.G = gridDim.x; { const int bx = blockIdx.x; F.vcu = (F.G % 8 == 0) ? (bx % 8) * (F.G / 8) + bx / 8 : bx; }
    volatile LAS unsigned* MISC = (volatile LAS unsigned*)(F.lds + MISC_OFF);
    if (F.tid < 64) MISC[F.tid] = 0u;
    __syncthreads();
    unsigned* ctl = (unsigned*)(F.ws + WS_CTL);
    XcdBarrier bar; bar.bar = ctl + CW_BAR; bar.x = 0; bar.st = nullptr;
#if !MK_PER_PHASE
    bar = xcd_barrier_post(ctl + CW_BAR, MISC + 8);
#endif
    const int lo = args.ph_lo, hi = args.ph_hi;
#define IN(k) (lo <= (k) && (k) < hi)
#if MK_PER_PHASE
#define SEAM(k) do { } while (0)
#else
#define SEAM(k) do { if (IN(k) && IN((k) + 1)) xcd_barrier(bar); } while (0)
#endif
    const float* mod = (const float*)(F.ws + WS_MOD);

    if (IN(0)) { p0_prologue(F); } SEAM(0);
    for (int l = 0; l < DEPTH; ++l) {
        const int pb = 1 + 12 * l;
        const float* ml = mod + l * 12288;
        const float* xin = (l == 0) ? F.in[I_X] : (const float*)(F.ws + WS_X);
        if (IN(pb + 0)) { if (l == 0) phase_norm(F, xin, F.in[I_N1G] + l * 2048, ml + 1 * 2048, ml + 0 * 2048); } SEAM(pb + 0);
        if (IN(pb + 1)) {
            pg8::Gemm g{(const bf16*)(F.ws + WS_H), (const bf16*)(F.ws + WS_WIN) + (size_t)l * INW * DM, M, INW, DM}; pg8::StaticOrder S; S.init(M, INW, F.G, (int)blockIdx.x);
            EpiIn E{(bf16*)(F.ws + WS_Z), (bf16*)(F.ws + WS_XS), F.in[I_BIN] + l * INW};
            pg8::gemm_phase<EpiIn, pg8::StaticOrder, true, true>(F.lds, g, S, E);
        } SEAM(pb + 1);
        if (IN(pb + 2)) { phase_sloc(F, l); phase_lnstats(F); } SEAM(pb + 2);
        if (IN(pb + 3)) { phase_carry_gating(F, l); } SEAM(pb + 3);
        if (IN(pb + 4)) { phase_s5out(F, l); } SEAM(pb + 4);
        if (IN(pb + 5)) {
            pg8::Gemm g{(const bf16*)(F.ws + WS_G), (const bf16*)(F.ws + WS_GLU) + (size_t)l * WB * WB, M, WB, WB}; pg8::StaticOrder S; S.init(M, WB, F.G, (int)blockIdx.x);
            EpiGlu E{(const bf16*)(F.ws + WS_G), (bf16*)(F.ws + WS_MIX), F.in[I_GLUB] + l * WB};
            pg8::gemm_phase<EpiGlu, pg8::StaticOrder, true, true>(F.lds, g, S, E);
        } SEAM(pb + 5);
        if (IN(pb + 6)) { phase_branchnorm(F); } SEAM(pb + 6);
        if (IN(pb + 7)) {
            pg8::Gemm g{(const bf16*)(F.ws + WS_MIX), (const bf16*)(F.ws + WS_WOUT) + (size_t)l * DM * DM, M, DM, DM}; pg8::StaticOrder S; S.init(M, DM, F.G, (int)blockIdx.x);
            EpiOut E{xin, (float*)(F.ws + WS_X), ml + 2 * 2048};
            pg8::gemm_phase<EpiOut, pg8::StaticOrder, true, true>(F.lds, g, S, E);
        } SEAM(pb + 7);
        if (IN(pb + 8)) { phase_norm(F, (const float*)(F.ws + WS_X), F.in[I_N2G] + l * 2048, ml + 4 * 2048, ml + 3 * 2048); } SEAM(pb + 8);
        if (IN(pb + 9)) {
            pg8::Gemm g{(const bf16*)(F.ws + WS_H), (const bf16*)(F.ws + WS_WQ) + (size_t)l * DM * DM, M, DM, DM}; pg8::StaticOrder S; S.init(M, DM, F.G, (int)blockIdx.x);
            EpiQ E{(bf16*)(F.ws + WS_Z)};
            pg8::gemm_phase<EpiQ, pg8::StaticOrder, true, true>(F.lds, g, S, E);
        } SEAM(pb + 9);
        if (IN(pb + 10)) { phase_topk(F, l); } SEAM(pb + 10);
        if (IN(pb + 11)) { phase_gather(F, l); } SEAM(pb + 11);
    }
#undef IN
#undef SEAM
}

extern "C" void kernel_launch(void* const* d_in, const int* in_sizes, int n_in, void* d_out, int out_size, void* d_ws, size_t ws_size, hipStream_t stream) {
    static int grid = 0;
    if (grid == 0) {
        if (n_in != 29 || out_size != M * DM || ws_size < WS_END) { fprintf(stderr, "kernel_launch: unexpected shapes (n_in %d, out %d, ws %zu); nothing launched\n", n_in, out_size, ws_size); grid = -1; return; }
        int dev = 0, cus = 0;
        if (hipGetDevice(&dev) != hipSuccess || hipDeviceGetAttribute(&cus, hipDeviceAttributeMultiprocessorCount, dev) != hipSuccess) { grid = -1; return; }
        if (hipFuncSetAttribute((const void*)fwd_kernel, hipFuncAttributeMaxDynamicSharedMemorySize, LDS_BYTES) != hipSuccess) { fprintf(stderr, "kernel_launch: hipFuncSetAttribute failed\n"); grid = -1; return; }
        (void)hipGetLastError();
        grid = cus;
    }
    if (grid < 0) return;
    (void)hipMemsetAsync((char*)d_ws + WS_CTL, 0, CTL_ZERO_BYTES, stream);
    Args a{};
    for (int i = 0; i < 29; ++i) a.in[i] = (const float*)d_in[i];
    a.out = (float*)d_out; a.ws = (unsigned char*)d_ws;
#if MK_PER_PHASE
    for (int p = 0; p < 1 + 12 * DEPTH; ++p) {
        if (p == 13) continue;
        a.ph_lo = p; a.ph_hi = p + 1; a.li = p;
        hipLaunchKernelGGL(fwd_kernel, dim3(grid), dim3(NTHR), LDS_BYTES, stream, a);
    }
#else
    a.ph_lo = 0; a.ph_hi = 1 + 12 * DEPTH; a.li = 0;
    hipLaunchKernelGGL(fwd_kernel, dim3(grid), dim3(NTHR), LDS_BYTES, stream, a);
#endif
}
```

```cpp
#include <hip/hip_runtime.h>
#include <cstdio>
#include <cstdint>

#ifndef MK_PER_PHASE
#define MK_PER_PHASE 0
#endif

#define GAS __attribute__((address_space(1)))
#define LAS __attribute__((address_space(3)))
typedef unsigned short bf16;
typedef short bf16x8 __attribute__((ext_vector_type(8)));
typedef float f32x4 __attribute__((ext_vector_type(4)));
typedef float f32x2 __attribute__((ext_vector_type(2)));
typedef unsigned u32x4 __attribute__((ext_vector_type(4)));
typedef unsigned u32x2 __attribute__((ext_vector_type(2)));

constexpr int DM = 2048, SEQ = 16384, DEPTH = 2, M = SEQ;
constexpr int WA = 1024, WB = 1024, INW = 3072;
constexpr int NG = 64, NCH = 256;
constexpr int NEXP = 16384;
constexpr float EPS = 1e-6f;
constexpr int NWAVES = 8, NTHR = 512;

namespace pg8 {
#define PG8_LAS __attribute__((address_space(3)))
constexpr int BM = 256, BK = 64, HALF = 128, HTB = HALF * BK * 2, STAGE_BYTES = 8 * HTB, NXCD = 8, WGM = 8;
__host__ __device__ __forceinline__ int lds_byte(int r, int c) { const int st = (r >> 4) * 2 + (c >> 5), rr = r & 15, cc = c & 31, ob = rr * 64 + cc * 2; return st * 1024 + (ob ^ (((ob >> 9) & 1) << 5)); }
__host__ __device__ __forceinline__ void stage_rc(int b, int& R, int& C) { const int st = b / 1024, sb = b % 1024, swz = sb ^ (((sb >> 9) & 1) << 5); R = (st >> 1) * 16 + swz / 64; C = (st & 1) * 32 + (swz % 64) / 2; }
__host__ __device__ __forceinline__ int perm32(int rho) { const int n = rho >> 4, i = rho & 15; return 8 * (i >> 2) + 4 * n + (i & 3); }
struct Unit { int pm, pn; };
struct Gemm { const bf16* A; const bf16* Bt; int M, N, K; };
struct StaticOrder {
    int nM, nN, nwg, G, c;
    __host__ __device__ void init(int M_, int N_, int G_, int c_) { nM = M_ / BM; nN = N_ / BM; nwg = nM * nN; G = G_; c = c_; }
    __host__ __device__ bool next(int i, Unit& u) const {
        const long L = (long)i * G + c; if (L >= nwg) return false;
        int wgid = (int)L; { const int q = nwg / NXCD, r = nwg % NXCD, xcd = wgid % NXCD, off = wgid / NXCD; wgid = (xcd < r ? xcd * (q + 1) : r * (q + 1) + (xcd - r) * q) + off; }
        const int nig = WGM * nN, gid = wgid / nig, fm = gid * WGM, gsz = (nM - fm) < WGM ? (nM - fm) : WGM;
        u.pm = fm + ((wgid % nig) % gsz); u.pn = (wgid % nig) / gsz; return true;
    }
    __device__ __forceinline__ void a_ready(const Unit&) const {}
    __device__ __forceinline__ void done(const Unit&) const {}
};
__device__ __forceinline__ unsigned cvt_pk_bf16(float lo, float hi) { unsigned r; asm volatile("v_cvt_pk_bf16_f32 %0, %1, %2" : "=v"(r) : "v"(lo), "v"(hi)); return r; }

template <class Epi, class Sched, bool ALIGN_EPI = false, bool SP2 = false>
__device__ __forceinline__ void gemm_phase(PG8_LAS unsigned char* lds, const Gemm g, const Sched& S, const Epi& E) {
    int tid = threadIdx.x; asm volatile("" : "+v"(tid)); const int wid = __builtin_amdgcn_readfirstlane(tid >> 6), lane = tid & 63, wr = wid >> 2, wc = wid & 3, fr = lane & 15, fq = lane >> 4;
    const int K = g.K, nt = K / BK;
    unsigned voffA[2], voffB[2];
#pragma unroll
    for (int i = 0; i < 2; ++i) { int R, C; stage_rc(tid * 16 + i * 8192, R, C); const int Rb = Epi::PERM ? ((R & ~31) + perm32(R & 31)) : R;
        voffA[i] = (unsigned)(R * K + C) * 2u; voffB[i] = (unsigned)(Rb * K + C) * 2u; }
    const size_t kstep = (size_t)(BK * 2);
    const size_t hstep = (size_t)HALF * K * 2;
    const size_t tstep = 2 * hstep;
    const unsigned ldsw = (unsigned)wid * 1024u;
    const int aoff = lds_byte(wr * 64 + fr, fq * 8), boff = lds_byte(wc * 32 + fr, fq * 8);
#define PG8_SA(b, h) (((b) * 2 + (h)) * HTB)
#define PG8_SB(b, h) ((4 + (b) * 2 + (h)) * HTB)
#define PG8_STAGE(bufoff, gbase, voff) do { _Pragma("unroll") for (int _i = 0; _i < 2; ++_i) \
        __builtin_amdgcn_global_load_lds((const unsigned*)((const char*)(gbase) + (voff)[_i]), (PG8_LAS unsigned*)(lds + (bufoff) + ldsw + _i * 8192), 16, 0, 0); } while (0)
#define PG8_LDA(dst, b, h) do { _Pragma("unroll") for (int m = 0; m < 4; ++m) _Pragma("unroll") for (int k = 0; k < 2; ++k) dst[m][k] = *(const PG8_LAS bf16x8*)(lds + PG8_SA(b, h) + aoff + m * 2048 + k * 1024); } while (0)
#define PG8_LDB(dst, b, h) do { _Pragma("unroll") for (int n = 0; n < 2; ++n) _Pragma("unroll") for (int k = 0; k < 2; ++k) dst[n][k] = *(const PG8_LAS bf16x8*)(lds + PG8_SB(b, h) + boff + n * 2048 + k * 1024); } while (0)
#define PG8_MMA(ai, bj, At, Bt) do { __builtin_amdgcn_s_setprio(1); _Pragma("unroll") for (int m = 0; m < 4; ++m) _Pragma("unroll") for (int n = 0; n < 2; ++n) _Pragma("unroll") for (int k = 0; k < 2; ++k) \
        acc[ai][bj][m][n] = __builtin_amdgcn_mfma_f32_16x16x32_bf16(Bt[n][k], At[m][k], acc[ai][bj][m][n], 0, 0, 0); __builtin_amdgcn_s_setprio(0); } while (0)
#define PG8_WAIT_V(n) asm volatile("s_waitcnt vmcnt(" #n ")" ::: "memory")
#define PG8_WAIT_L(n) asm volatile("s_waitcnt lgkmcnt(" #n ")" ::: "memory")
#define PG8_BAR __builtin_amdgcn_s_barrier()
#define PG8_SCHED __builtin_amdgcn_sched_barrier(0)
    Unit cur, nxt; int ui = 0;
    if (!S.next(0, cur)) return;
    f32x4 acc[2][2][4][2];
#pragma unroll
    for (int a = 0; a < 2; ++a)
#pragma unroll
        for (int b = 0; b < 2; ++b)
#pragma unroll
            for (int m = 0; m < 4; ++m)
#pragma unroll
                for (int n = 0; n < 2; ++n) acc[a][b][m][n] = (f32x4){0.f, 0.f, 0.f, 0.f};
    bf16x8 At[4][2], B0[2][2], B1[2][2];
    const char* cA = (const char*)g.A + (size_t)cur.pm * tstep; const char* cB = (const char*)g.Bt + (size_t)cur.pn * tstep;
    S.a_ready(cur);
    if constexpr (SP2) {
        PG8_STAGE(PG8_SB(0, 0), cB, voffB); PG8_STAGE(PG8_SB(0, 1), cB + hstep, voffB); PG8_STAGE(PG8_SA(0, 0), cA, voffA); PG8_STAGE(PG8_SA(0, 1), cA + hstep, voffA);
        if (wr == 1) PG8_BAR;
        PG8_WAIT_V(2); PG8_BAR;
        PG8_STAGE(PG8_SB(1, 0), cB + kstep, voffB); PG8_STAGE(PG8_SA(1, 0), cA + kstep, voffA); PG8_STAGE(PG8_SB(1, 1), cB + hstep + kstep, voffB);
        PG8_WAIT_V(6); PG8_BAR;
    } else {
        PG8_STAGE(PG8_SB(0, 0), cB, voffB); PG8_STAGE(PG8_SA(0, 0), cA, voffA); PG8_STAGE(PG8_SB(0, 1), cB + hstep, voffB); PG8_STAGE(PG8_SA(0, 1), cA + hstep, voffA);
        if (wr == 1) PG8_BAR;
        PG8_WAIT_V(4); PG8_BAR;
        PG8_STAGE(PG8_SB(1, 0), cB + kstep, voffB); PG8_STAGE(PG8_SA(1, 0), cA + kstep, voffA); PG8_STAGE(PG8_SB(1, 1), cB + hstep + kstep, voffB);
        PG8_WAIT_V(6); PG8_BAR;
    }
    for (;;) {
        const bool has_next = S.next(ui + 1, nxt);
        const char* nA = has_next ? (const char*)g.A + (size_t)nxt.pm * tstep : cA; const char* nB = has_next ? (const char*)g.Bt + (size_t)nxt.pn * tstep : cB;
        for (int t = 0; t < nt; t += 2) {
            const bool last = (t == nt - 2);
            const char* a1 = cA + (size_t)(t + 1) * kstep;
            const char* a2 = last ? nA : cA + (size_t)(t + 2) * kstep; const char* b2 = last ? nB : cB + (size_t)(t + 2) * kstep;
            const char* a3 = a2 + kstep; const char* b3 = b2 + kstep;
            if (last && has_next) S.a_ready(nxt);
            if constexpr (SP2) {
            PG8_LDB(B0, 0, 0); PG8_LDB(B1, 0, 1); PG8_SCHED; PG8_LDA(At, 0, 0); PG8_STAGE(PG8_SA(1, 1), a1 + hstep, voffA);
            PG8_WAIT_V(8); PG8_WAIT_L(0); PG8_BAR; PG8_MMA(0, 0, At, B0); PG8_MMA(0, 1, At, B1); PG8_BAR; PG8_SCHED;
            PG8_LDA(At, 0, 1); PG8_STAGE(PG8_SB(0, 0), b2, voffB); PG8_STAGE(PG8_SB(0, 1), b2 + hstep, voffB); PG8_STAGE(PG8_SA(0, 0), a2, voffA);
            PG8_WAIT_V(8); PG8_WAIT_L(0); PG8_BAR; PG8_MMA(1, 0, At, B0); PG8_MMA(1, 1, At, B1); PG8_BAR; PG8_SCHED;
            PG8_LDB(B0, 1, 0); PG8_LDB(B1, 1, 1); PG8_SCHED; PG8_LDA(At, 1, 0); PG8_STAGE(PG8_SA(0, 1), a2 + hstep, voffA);
            PG8_WAIT_V(8); PG8_WAIT_L(0); PG8_BAR; PG8_MMA(0, 0, At, B0); PG8_MMA(0, 1, At, B1); PG8_BAR; PG8_SCHED;
            PG8_LDA(At, 1, 1); PG8_STAGE(PG8_SB(1, 0), b3, voffB); PG8_STAGE(PG8_SB(1, 1), b3 + hstep, voffB); PG8_STAGE(PG8_SA(1, 0), a3, voffA);
            PG8_WAIT_V(8); PG8_WAIT_L(0); PG8_BAR; PG8_MMA(1, 0, At, B0); PG8_MMA(1, 1, At, B1); PG8_BAR; PG8_SCHED;
            } else {
            PG8_LDB(B0, 0, 0); PG8_SCHED; PG8_LDA(At, 0, 0); PG8_STAGE(PG8_SA(1, 1), a1 + hstep, voffA);
            PG8_WAIT_L(8); PG8_BAR; PG8_WAIT_L(0); PG8_MMA(0, 0, At, B0); PG8_BAR; PG8_SCHED;
            PG8_LDB(B1, 0, 1); PG8_STAGE(PG8_SB(0, 0), b2, voffB);
            PG8_BAR; PG8_WAIT_L(0); PG8_MMA(0, 1, At, B1); PG8_BAR;
            PG8_LDA(At, 0, 1); PG8_STAGE(PG8_SA(0, 0), a2, voffA);
            PG8_BAR; PG8_WAIT_L(0); PG8_MMA(1, 0, At, B0); PG8_BAR; PG8_SCHED;
            PG8_STAGE(PG8_SB(0, 1), b2 + hstep, voffB);
            PG8_WAIT_V(6); PG8_BAR; PG8_MMA(1, 1, At, B1); PG8_BAR;
            PG8_LDB(B0, 1, 0); PG8_SCHED; PG8_LDA(At, 1, 0); PG8_STAGE(PG8_SA(0, 1), a2 + hstep, voffA);
            PG8_WAIT_L(8); PG8_BAR; PG8_WAIT_L(0); PG8_MMA(0, 0, At, B0); PG8_BAR; PG8_SCHED;
            PG8_LDB(B1, 1, 1); PG8_STAGE(PG8_SB(1, 0), b3, voffB);
            PG8_BAR; PG8_WAIT_L(0); PG8_MMA(0, 1, At, B1); PG8_BAR;
            PG8_LDA(At, 1, 1); PG8_STAGE(PG8_SA(1, 0), a3, voffA);
            PG8_BAR; PG8_WAIT_L(0); PG8_MMA(1, 0, At, B0); PG8_BAR; PG8_SCHED;
            PG8_STAGE(PG8_SB(1, 1), b3 + hstep, voffB);
            PG8_WAIT_V(6); PG8_BAR; PG8_MMA(1, 1, At, B1); PG8_BAR;
            }
        }
        if constexpr (ALIGN_EPI) { if (wr == 0) PG8_BAR; }
        E(acc, cur, wr, wc, fr, fq); S.done(cur);
        if (!has_next) break;
#pragma unroll
        for (int a = 0; a < 2; ++a)
#pragma unroll
            for (int b = 0; b < 2; ++b)
#pragma unroll
                for (int m = 0; m < 4; ++m)
#pragma unroll
                    for (int n = 0; n < 2; ++n) acc[a][b][m][n] = (f32x4){0.f, 0.f, 0.f, 0.f};
        cur = nxt; cA = nA; cB = nB; ++ui;
        if constexpr (ALIGN_EPI) { if (wr == 1) PG8_BAR; }
    }
    PG8_WAIT_V(0);
    if constexpr (!ALIGN_EPI) { if (wr == 0) PG8_BAR; }
    PG8_BAR;
#undef PG8_SA
#undef PG8_SB
#undef PG8_STAGE
#undef PG8_LDA
#undef PG8_LDB
#undef PG8_MMA
#undef PG8_WAIT_V
#undef PG8_WAIT_L
#undef PG8_BAR
#undef PG8_SCHED
}
}

__device__ __forceinline__ unsigned f2bf(float f) { unsigned u = __builtin_bit_cast(unsigned, f); return (u + 0x7fffu + ((u >> 16) & 1u)) >> 16; }
__device__ __forceinline__ unsigned pk2(float lo, float hi) { return f2bf(lo) | (f2bf(hi) << 16); }
__device__ __forceinline__ float bflo(unsigned w) { return __builtin_bit_cast(float, w << 16); }
__device__ __forceinline__ float bfhi(unsigned w) { return __builtin_bit_cast(float, w & 0xffff0000u); }
__device__ __forceinline__ float fast_sigmoid(float t) { return __builtin_amdgcn_rcpf(1.0f + __builtin_amdgcn_exp2f(-1.44269504089f * t)); }
__device__ __forceinline__ float gelu_tanh(float x) { const float t = x * (1.5957691216f + 0.0713548163f * x * x); return x * fast_sigmoid(t); }
__device__ __forceinline__ float wave_sum(float v) {
#pragma unroll
    for (int o = 1; o < 64; o <<= 1) v += __shfl_xor(v, o);
    return v;
}
#define LDS_WAIT() asm volatile("s_waitcnt lgkmcnt(0)" ::: "memory")
#define VM_WAIT() asm volatile("s_waitcnt vmcnt(0)" ::: "memory")
#define RLX_AGENT __ATOMIC_RELAXED, __HIP_MEMORY_SCOPE_AGENT

constexpr size_t MiB = 1u << 20;
constexpr size_t WS_CTL = 0, CTL_ZERO_BYTES = 1 * MiB;
constexpr size_t WS_MOD   = 1 * MiB;
constexpr size_t WS_AT    = WS_MOD + 128 * 1024;
constexpr size_t WS_STATS = WS_AT + 128 * 1024;
constexpr size_t WS_KEYS  = 2 * MiB;
constexpr size_t WS_GWS   = 3 * MiB;
constexpr size_t WS_WIN   = 4 * MiB;
constexpr size_t WS_GLU   = 28 * MiB;
constexpr size_t WS_WOUT  = 32 * MiB;
constexpr size_t WS_WQ    = 48 * MiB;
constexpr size_t WS_KTAB  = 64 * MiB;
constexpr size_t WS_WG    = 72 * MiB;
constexpr size_t WS_VG    = 104 * MiB;
constexpr size_t WS_UV    = 136 * MiB;
constexpr size_t WS_X     = 392 * MiB;
constexpr size_t WS_H     = 520 * MiB;
constexpr size_t WS_Z     = 584 * MiB;
constexpr size_t WS_XS    = 648 * MiB;
constexpr size_t WS_SLOC  = 680 * MiB;
constexpr size_t WS_HS    = 688 * MiB;
constexpr size_t WS_G     = 692 * MiB;
constexpr size_t WS_MIX   = 724 * MiB;
constexpr size_t WS_EID   = 788 * MiB;
constexpr size_t WS_GATE  = 796 * MiB;
constexpr size_t WS_END   = 804 * MiB;
constexpr int CW_BAR = 4096;
constexpr int CW_QUEUE = 16384;

constexpr int LDS_BYTES = 163840;
constexpr int MISC_OFF = LDS_BYTES - 256;

#define XB_TMO      128
#define XB_XCNT(j)  (256  + 64 * (j))
#define XB_XSUB(j)  (1280 + 64 * (j))
#define XB_XGEN(j)  (2304 + 64 * (j))
#define XB_TOP      3328
#define XB_TOPGEN   3392
#define XCD_BAR_WORDS 3456
#define XB_SPIN_CAP (1u << 24)
__device__ __forceinline__ unsigned xb_ld(unsigned* p)              { return __hip_atomic_load(p, __ATOMIC_RELAXED, __HIP_MEMORY_SCOPE_AGENT); }
__device__ __forceinline__ unsigned xb_add(unsigned* p, unsigned v) { return __hip_atomic_fetch_add(p, v, __ATOMIC_RELAXED, __HIP_MEMORY_SCOPE_AGENT); }
__device__ __forceinline__ unsigned xb_xcc_id() { return (unsigned)__builtin_amdgcn_s_getreg((3 << 11) | 20) & 0xFu; }
#define XB_SPIN(cond, bar) do { unsigned _sp = 0; while (cond) { __builtin_amdgcn_s_sleep(1); \
    if ((++_sp & 255u) == 0u) { if (xb_ld(&(bar)[XB_TMO])) break; if (_sp > XB_SPIN_CAP) { atomicAdd(&(bar)[XB_TMO], 1u); break; } } } } while (0)
struct XcdBarrier { unsigned* bar; unsigned x; volatile LAS unsigned* st; };
__device__ __forceinline__ XcdBarrier xcd_barrier_post(unsigned* bar, volatile LAS unsigned* st) {
    XcdBarrier b; b.bar = bar; b.x = xb_xcc_id(); b.st = st;
    if (threadIdx.x == 0) (void)xb_add(&bar[XB_XCNT(b.x)], 1u);
    return b;
}
__device__ __forceinline__ void xcd_barrier_complete(unsigned* bar, unsigned x, unsigned& nloc, unsigned& nx) {
    const unsigned G = gridDim.x * gridDim.y * gridDim.z;
    unsigned sum, cnt, mine, sp = 0u;
    for (;;) {
        sum = 0u; cnt = 0u; mine = 0u;
#pragma unroll
        for (unsigned j = 0; j < 16; ++j) { const unsigned c = xb_ld(&bar[XB_XCNT(j)]); sum += c; cnt += (c > 0u) ? 1u : 0u; mine = (j == x) ? c : mine; }
        if (sum == G) break;
        __builtin_amdgcn_s_sleep(1);
        if ((++sp & 255u) == 0u) { if (xb_ld(&bar[XB_TMO])) break; if (sp > XB_SPIN_CAP) { atomicAdd(&bar[XB_TMO], 1u); break; } }
    }
    nloc = mine > 0u ? mine : 1u; nx = cnt > 0u ? cnt : 1u;
}
__device__ __forceinline__ void xcd_barrier(const XcdBarrier& b) {
    asm volatile("s_waitcnt vmcnt(0)" ::: "memory");
    __syncthreads();
    if (threadIdx.x == 0) {
        unsigned* bar = b.bar;
        __builtin_amdgcn_s_waitcnt(0);
        unsigned nloc = b.st[0], nx = b.st[1];
        if (nloc == 0u) { xcd_barrier_complete(bar, b.x, nloc, nx); b.st[0] = nloc; b.st[1] = nx; }
        const unsigned old = xb_add(&bar[XB_XSUB(b.x)], 1u);
        const unsigned gen = old / nloc;
        if (old + 1u == (gen + 1u) * nloc) {
            __builtin_amdgcn_fence(__ATOMIC_RELEASE, "agent");
            asm volatile("s_waitcnt vmcnt(0)" ::: "memory");
            const unsigned og = xb_add(&bar[XB_TOP], 1u);
            const unsigned tg = og / nx;
            if (og + 1u == (tg + 1u) * nx) xb_add(&bar[XB_TOPGEN], 1u);
            else XB_SPIN(xb_ld(&bar[XB_TOPGEN]) == tg, bar);
            __builtin_amdgcn_fence(__ATOMIC_ACQUIRE, "agent");
            xb_add(&bar[XB_XGEN(b.x)], 1u);
            asm volatile("s_waitcnt vmcnt(0)" ::: "memory");
        } else {
            XB_SPIN(xb_ld(&bar[XB_XGEN(b.x)]) == gen, bar);
            __builtin_amdgcn_fence(__ATOMIC_ACQUIRE, "agent");
            asm volatile("s_waitcnt vmcnt(0)" ::: "memory");
        }
    }
    __syncthreads();
}

struct Args { const float* in[29]; float* out; unsigned char* ws; int ph_lo, ph_hi, li, pad; };
enum { I_X = 0, I_C, I_WMOD, I_BMOD, I_N1G, I_WIN, I_BIN, I_LNG, I_LNB, I_GWS, I_GBS, I_LRE, I_LIM, I_LDT, I_BRE, I_BIM, I_CRE, I_CIM, I_SD, I_GLUW, I_GLUB,
       I_BRG, I_WOUT, I_N2G, I_WQ, I_KEYS, I_PU, I_PV, I_FG };

struct Frame {
    LAS unsigned char* lds;
    unsigned char* ws;
    const float* const* in;
    float* out;
    int tid, lane, wave, vcu, G;
};

#define PH_LOCALS int tid = F.tid; asm volatile("" : "+v"(tid)); const int lane = tid & 63; const int wave = __builtin_amdgcn_readfirstlane(tid >> 6); (void)lane; (void)wave;

struct EpiIn {
    static constexpr bool PERM = true, AFTER_DRAIN = false;
    bf16* Z; bf16* XS; const float* bias;
    __device__ __forceinline__ void operator()(const f32x4 (&acc)[2][2][4][2], const pg8::Unit& u, int wr, int wc, int fr, int fq) const {
        const int row0 = u.pm * 256 + wr * 64 + fr, col0 = u.pn * 256 + wc * 32 + 8 * fq;
        f32x4 bv[2][2];
#pragma unroll
        for (int bj = 0; bj < 2; ++bj)
#pragma unroll
            for (int n = 0; n < 2; ++n) bv[bj][n] = *(const f32x4*)(bias + col0 + bj * 128 + 4 * n);
        const bool isz = (u.pn < 8);
#pragma unroll
        for (int ai = 0; ai < 2; ++ai)
#pragma unroll
            for (int m = 0; m < 4; ++m) {
                const int r = row0 + ai * 128 + m * 16;
#pragma unroll
                for (int bj = 0; bj < 2; ++bj) {
                    f32x4 v0 = acc[ai][bj][m][0] + bv[bj][0], v1 = acc[ai][bj][m][1] + bv[bj][1];
                    const int c = col0 + bj * 128;
                    u32x4 w;
                    if (isz) {
                        w.x = pg8::cvt_pk_bf16(gelu_tanh(v0[0]), gelu_tanh(v0[1])); w.y = pg8::cvt_pk_bf16(gelu_tanh(v0[2]), gelu_tanh(v0[3]));
                        w.z = pg8::cvt_pk_bf16(gelu_tanh(v1[0]), gelu_tanh(v1[1])); w.w = pg8::cvt_pk_bf16(gelu_tanh(v1[2]), gelu_tanh(v1[3]));
                        *(u32x4*)(Z + (size_t)r * 2048 + c) = w;
                    } else {
                        w.x = pg8::cvt_pk_bf16(v0[0], v0[1]); w.y = pg8::cvt_pk_bf16(v0[2], v0[3]); w.z = pg8::cvt_pk_bf16(v1[0], v1[1]); w.w = pg8::cvt_pk_bf16(v1[2], v1[3]);
                        const int cc = c - 2048, g = cc >> 4, i = cc & 15;
                        *(u32x4*)(XS + ((size_t)(g * 256 + (r >> 6)) * 64 + (r & 63)) * 16 + i) = w;
                    }
                }
            }
    }
};
struct EpiGlu {
    static constexpr bool PERM = true, AFTER_DRAIN = false;
    const bf16* Gb; bf16* MIX; const float* bias;
    __device__ __forceinline__ void operator()(const f32x4 (&acc)[2][2][4][2], const pg8::Unit& u, int wr, int wc, int fr, int fq) const {
        const int row0 = u.pm * 256 + wr * 64 + fr, col0 = u.pn * 256 + wc * 32 + 8 * fq;
        f32x4 bv[2][2];
#pragma unroll
        for (int bj = 0; bj < 2; ++bj)
#pragma unroll
            for (int n = 0; n < 2; ++n) bv[bj][n] = *(const f32x4*)(bias + col0 + bj * 128 + 4 * n);
#pragma unroll
        for (int ai = 0; ai < 2; ++ai)
#pragma unroll
            for (int m = 0; m < 4; ++m) {
                const int r = row0 + ai * 128 + m * 16;
#pragma unroll
                for (int bj = 0; bj < 2; ++bj) {
                    const f32x4 v0 = acc[ai][bj][m][0] + bv[bj][0], v1 = acc[ai][bj][m][1] + bv[bj][1];
                    const int c = col0 + bj * 128;
                    const u32x4 gw = *(const u32x4*)(Gb + (size_t)r * 1024 + c);
                    u32x4 w;
                    w.x = pg8::cvt_pk_bf16(bflo(gw.x) * fast_sigmoid(v0[0]), bfhi(gw.x) * fast_sigmoid(v0[1]));
                    w.y = pg8::cvt_pk_bf16(bflo(gw.y) * fast_sigmoid(v0[2]), bfhi(gw.y) * fast_sigmoid(v0[3]));
                    w.z = pg8::cvt_pk_bf16(bflo(gw.z) * fast_sigmoid(v1[0]), bfhi(gw.z) * fast_sigmoid(v1[1]));
                    w.w = pg8::cvt_pk_bf16(bflo(gw.w) * fast_sigmoid(v1[2]), bfhi(gw.w) * fast_sigmoid(v1[3]));
                    *(u32x4*)(MIX + (size_t)r * 2048 + 1024 + c) = w;
                }
            }
    }
};
struct EpiOut {
    static constexpr bool PERM = true, AFTER_DRAIN = false;
    const float* xin; float* X; const float* gate;
    __device__ __forceinline__ void operator()(const f32x4 (&acc)[2][2][4][2], const pg8::Unit& u, int wr, int wc, int fr, int fq) const {
        const int row0 = u.pm * 256 + wr * 64 + fr, col0 = u.pn * 256 + wc * 32 + 8 * fq;
        f32x4 gv[2][2];
#pragma unroll
        for (int bj = 0; bj < 2; ++bj)
#pragma unroll
            for (int n = 0; n < 2; ++n) gv[bj][n] = *(const f32x4*)(gate + col0 + bj * 128 + 4 * n);
#pragma unroll
        for (int ai = 0; ai < 2; ++ai)
#pragma unroll
            for (int m = 0; m < 4; ++m) {
                const int r = row0 + ai * 128 + m * 16;
#pragma unroll
                for (int bj = 0; bj < 2; ++bj) {
                    const size_t off = (size_t)r * 2048 + col0 + bj * 128;
                    const f32x4 x0 = *(const f32x4*)(xin + off), x1 = *(const f32x4*)(xin + off + 4);
                    *(f32x4*)(X + off) = x0 + gv[bj][0] * acc[ai][bj][m][0];
                    *(f32x4*)(X + off + 4) = x1 + gv[bj][1] * acc[ai][bj][m][1];
                }
            }
    }
};
struct EpiQ {
    static constexpr bool PERM = true, AFTER_DRAIN = false;
    bf16* Q;
    __device__ __forceinline__ void operator()(const f32x4 (&acc)[2][2][4][2], const pg8::Unit& u, int wr, int wc, int fr, int fq) const {
        const int row0 = u.pm * 256 + wr * 64 + fr, col0 = u.pn * 256 + wc * 32 + 8 * fq;
#pragma unroll
        for (int ai = 0; ai < 2; ++ai)
#pragma unroll
            for (int m = 0; m < 4; ++m) {
                const int r = row0 + ai * 128 + m * 16;
#pragma unroll
                for (int bj = 0; bj < 2; ++bj) {
                    const f32x4 v0 = acc[ai][bj][m][0], v1 = acc[ai][bj][m][1];
                    u32x4 w; w.x = pg8::cvt_pk_bf16(v0[0], v0[1]); w.y = pg8::cvt_pk_bf16(v0[2], v0[3]); w.z = pg8::cvt_pk_bf16(v1[0], v1[1]); w.w = pg8::cvt_pk_bf16(v1[2], v1[3]);
                    *(u32x4*)(Q + (size_t)r * 2048 + col0 + bj * 128) = w;
                }
            }
    }
};

__device__ __forceinline__ void p0_transpose_item(const float* W, int K, int N, bf16* WT, const float* kscale, LAS float* scr, int item, int lane) {
    const int nblk = N / 32, kb = item / nblk, nb = item % nblk, k0 = 64 * kb, n0 = 32 * nb;
#pragma unroll 8
    for (int i = 0; i < 32; ++i) { const int kk = 2 * i + (lane >> 5); float v = W[(size_t)(k0 + kk) * N + n0 + (lane & 31)]; if (kscale) v *= kscale[k0 + kk]; scr[kk * 33 + (lane & 31)] = v; }
    LDS_WAIT(); asm volatile("" ::: "memory");
    const int c = lane & 7;
#pragma unroll
    for (int j = 0; j < 4; ++j) { const int n = (lane >> 3) + 8 * j; const LAS float* s = scr + (8 * c) * 33 + n;
        u32x4 o; o.x = pk2(s[0 * 33], s[1 * 33]); o.y = pk2(s[2 * 33], s[3 * 33]); o.z = pk2(s[4 * 33], s[5 * 33]); o.w = pk2(s[6 * 33], s[7 * 33]);
        *(u32x4*)(WT + (size_t)(n0 + n) * K + k0 + 8 * c) = o; }
    LDS_WAIT(); asm volatile("" ::: "memory");
}

__device__ __forceinline__ void norm_mod_row(const f32x4 (&v)[4][2], const float* gain, const float* scale, const float* shift, int lane, u32x4 (&o)[4]) {
    float s = 0.f;
#pragma unroll
    for (int j = 0; j < 4; ++j)
#pragma unroll
        for (int h = 0; h < 2; ++h) s += (v[j][h][0] * v[j][h][0] + v[j][h][1] * v[j][h][1]) + (v[j][h][2] * v[j][h][2] + v[j][h][3] * v[j][h][3]);
    const float rr = 1.0f / sqrtf(wave_sum(s) * (1.0f / DM) + EPS);
#pragma unroll
    for (int j = 0; j < 4; ++j) {
        const int c = j * 512 + lane * 8;
        f32x4 y[2];
#pragma unroll
        for (int h = 0; h < 2; ++h) {
            const f32x4 g = *(const f32x4*)(gain + c + 4 * h);
            y[h] = v[j][h] * rr * g;
            const f32x4 sc = *(const f32x4*)(scale + c + 4 * h), sh = *(const f32x4*)(shift + c + 4 * h); y[h] = y[h] * (sc + 1.0f) + sh;
        }
        o[j].x = pk2(y[0][0], y[0][1]); o[j].y = pk2(y[0][2], y[0][3]); o[j].z = pk2(y[1][0], y[1][1]); o[j].w = pk2(y[1][2], y[1][3]);
    }
}
__device__ __forceinline__ void norm_row_pass(const float* xrow, bf16* hrow, const float* gain, const float* scale, const float* shift, int lane) {
    f32x4 v[4][2];
#pragma unroll
    for (int j = 0; j < 4; ++j) { v[j][0] = *(const f32x4*)(xrow + j * 512 + lane * 8); v[j][1] = *(const f32x4*)(xrow + j * 512 + lane * 8 + 4); }
    u32x4 o[4]; norm_mod_row(v, gain, scale, shift, lane, o);
#pragma unroll
    for (int j = 0; j < 4; ++j) *(u32x4*)(hrow + j * 512 + lane * 8) = o[j];
}

__device__ __forceinline__ void p0_prologue(Frame& F) {
    PH_LOCALS
    const int gw = F.vcu * NWAVES + wave, NGW = F.G * NWAVES;
    const int gt = F.vcu * NTHR + tid, NGT = F.G * NTHR;
    if ((int)blockIdx.x < 192) {
        const int l = blockIdx.x / 96, cb = blockIdx.x % 96;
        LAS float* sc = (LAS float*)F.lds;
        LAS float* red = (LAS float*)(F.lds + 8192);
        for (int k = tid; k < DM; k += NTHR) { const float c = F.in[I_C][k]; sc[k] = c * fast_sigmoid(c); }
        __syncthreads();
        const int tx = tid & 31, ty = tid >> 5;
        const float* W = F.in[I_WMOD] + (size_t)l * DM * 12288 + cb * 128 + tx * 4;
        f32x4 a = {0.f, 0.f, 0.f, 0.f};
#pragma unroll 8
        for (int k = ty; k < DM; k += 16) { const f32x4 w = *(const f32x4*)(W + (size_t)k * 12288); a += w * sc[k]; }
        *(LAS f32x4*)(red + ty * 128 + tx * 4) = a;
        __syncthreads();
        if (tid < 128) { float s = 0.f;
#pragma unroll
            for (int y = 0; y < 16; ++y) s += red[y * 128 + tid];
            ((float*)(F.ws + WS_MOD))[l * 12288 + cb * 128 + tid] = s + F.in[I_BMOD][l * 12288 + cb * 128 + tid]; }
        __syncthreads();
    }
    if ((int)blockIdx.x >= 128) {
        const int u = 255 - (int)blockIdx.x, l = u >> 6, g = u & 63;
        LAS float* apr = (LAS float*)F.lds;
        LAS float* api = apr + 65 * 64;
        LAS float* bbr = api + 65 * 64;
        LAS float* bbi = bbr + 1024;
        LAS float* ccr = bbi + 1024;
        LAS float* cci = ccr + 1024;
        const float dt = expf(F.in[I_LDT][l * 64 + g]);
        const float* lre = F.in[I_LRE] + (l * 64 + g) * 64; const float* lim = F.in[I_LIM] + (l * 64 + g) * 64;
        for (int idx = tid; idx < 65 * 64; idx += NTHR) { const int d = idx >> 6, p = idx & 63;
            const float mag = expf(lre[p] * dt * (float)d); float sn, cs; sincosf(lim[p] * dt * (float)d, &sn, &cs);
            apr[idx] = mag * cs; api[idx] = mag * sn; }
        for (int idx = tid; idx < 1024; idx += NTHR) { const int o = idx >> 6, p = idx & 63;
            ccr[idx] = F.in[I_CRE][((size_t)(l * 64 + g) * 16 + o) * 64 + p]; cci[idx] = F.in[I_CIM][((size_t)(l * 64 + g) * 16 + o) * 64 + p]; }
        __syncthreads();
        for (int idx = tid; idx < 1024; idx += NTHR) { const int p = idx >> 4, i = idx & 15;
            const float xr = apr[64 + p] - 1.0f, xi = api[64 + p], lr = lre[p], li = lim[p], den = 1.0f / (lr * lr + li * li);
            const float cr = (xr * lr + xi * li) * den, ci = (xi * lr - xr * li) * den;
            const float br = F.in[I_BRE][((size_t)(l * 64 + g) * 64 + p) * 16 + i], bi = F.in[I_BIM][((size_t)(l * 64 + g) * 64 + p) * 16 + i];
            bbr[idx] = cr * br - ci * bi; bbi[idx] = cr * bi + ci * br; }
        __syncthreads();
        bf16* KT = (bf16*)(F.ws + WS_KTAB) + (size_t)(l * 64 + g) * 65 * 256;
        for (int idx = tid; idx < 65 * 256; idx += NTHR) {
            const int d = (idx >> 8) - 1, o = (idx >> 4) & 15, i = idx & 15; float s = 0.f;
            if (d >= 0) {
                for (int p = 0; p < 64; ++p) { const float ar = apr[d * 64 + p], ai = api[d * 64 + p], cr = ccr[o * 64 + p], ci = cci[o * 64 + p];
                    const float er = cr * ar - ci * ai, ei = cr * ai + ci * ar; s += er * bbr[p * 16 + i] - ei * bbi[p * 16 + i]; }
                if (d == 0 && o == i) s += F.in[I_SD][l * 1024 + g * 16 + o];
            }
            KT[idx] = (bf16)f2bf(s);
        }
        bf16* WG = (bf16*)(F.ws + WS_WG) + (size_t)(l * 64 + g) * 128 * 1024;
        for (int idx = tid; idx < 64 * 1024; idx += NTHR) { const int p = idx >> 10, k = idx & 1023, tau = k >> 4, i = k & 15;
            const float ar = apr[(63 - tau) * 64 + p], ai = api[(63 - tau) * 64 + p], br = bbr[p * 16 + i], bi = bbi[p * 16 + i];
            WG[(size_t)p * 1024 + k] = (bf16)f2bf(ar * br - ai * bi); WG[(size_t)(64 + p) * 1024 + k] = (bf16)f2bf(ar * bi + ai * br); }
        bf16* VG = (bf16*)(F.ws + WS_VG) + (size_t)(l * 64 + g) * 1024 * 128;
        for (int idx = tid; idx < 1024 * 64; idx += NTHR) { const int m = idx >> 6, p = idx & 63, t = m >> 4, o = m & 15;
            const float ar = apr[(t + 1) * 64 + p], ai = api[(t + 1) * 64 + p], cr = ccr[o * 64 + p], ci = cci[o * 64 + p];
            VG[(size_t)m * 128 + p] = (bf16)f2bf(cr * ar - ci * ai); VG[(size_t)m * 128 + 64 + p] = (bf16)f2bf(-(cr * ai + ci * ar)); }
        if (tid < 64) { float* AT = (float*)(F.ws + WS_AT) + ((size_t)(l * 64 + g) * 64 + tid) * 2; AT[0] = apr[64 * 64 + tid]; AT[1] = api[64 * 64 + tid]; }
        __syncthreads();
    }
    {
        LAS float* scr = (LAS float*)(F.lds + wave * 16384);
        constexpr int I_IN = (DM / 64) * (INW / 32), I_GL = (WB / 64) * (WB / 32), I_OU = (DM / 64) * (DM / 32), I_Q = I_OU;
        constexpr int PER_L = I_IN + I_GL + I_OU + I_Q;
        for (int it = gw; it < 2 * PER_L; it += NGW) {
            const int l = it / PER_L; int r = it % PER_L;
            if (r < I_IN) { p0_transpose_item(F.in[I_WIN] + (size_t)l * DM * INW, DM, INW, (bf16*)(F.ws + WS_WIN) + (size_t)l * INW * DM, nullptr, scr, r, lane); continue; } r -= I_IN;
            if (r < I_GL) { p0_transpose_item(F.in[I_GLUW] + (size_t)l * WB * WB, WB, WB, (bf16*)(F.ws + WS_GLU) + (size_t)l * WB * WB, nullptr, scr, r, lane); continue; } r -= I_GL;
            if (r < I_OU) { p0_transpose_item(F.in[I_WOUT] + (size_t)l * DM * DM, DM, DM, (bf16*)(F.ws + WS_WOUT) + (size_t)l * DM * DM, F.in[I_BRG] + l * DM, scr, r, lane); continue; } r -= I_OU;
            p0_transpose_item(F.in[I_WQ] + (size_t)l * DM * DM, DM, DM, (bf16*)(F.ws + WS_WQ) + (size_t)l * DM * DM, nullptr, scr, r, lane);
        }
    }
    {
        bf16* KB = (bf16*)(F.ws + WS_KEYS);
        for (int i = gt; i < 2 * 8 * 2 * 128 * 128 / 8; i += NGT) { const f32x4 a = *(const f32x4*)(F.in[I_KEYS] + (size_t)i * 8), b = *(const f32x4*)(F.in[I_KEYS] + (size_t)i * 8 + 4);
            u32x4 o; o.x = pk2(a[0], a[1]); o.y = pk2(a[2], a[3]); o.z = pk2(b[0], b[1]); o.w = pk2(b[2], b[3]); *(u32x4*)(KB + (size_t)i * 8) = o; }
        bf16* GW = (bf16*)(F.ws + WS_GWS);
        for (int i = gt; i < 2 * 8 * 128 * 128 / 8; i += NGT) { const int e = i * 8, jj = e & 127, ii = (e >> 7) & 127; const bool keep = (ii >= 64) || (jj < 64);
            f32x4 a = *(const f32x4*)(F.in[I_GWS] + (size_t)i * 8), b = *(const f32x4*)(F.in[I_GWS] + (size_t)i * 8 + 4);
            if (!keep) { a = (f32x4){0.f, 0.f, 0.f, 0.f}; b = a; }
            u32x4 o; o.x = pk2(a[0], a[1]); o.y = pk2(a[2], a[3]); o.z = pk2(b[0], b[1]); o.w = pk2(b[2], b[3]); *(u32x4*)(GW + (size_t)i * 8) = o; }
        bf16* UV = (bf16*)(F.ws + WS_UV);
        const size_t nchunk = (size_t)2 * NEXP * 2048 / 8;
        for (size_t i = gt; i < nchunk; i += NGT) {
            const size_t row = i >> 8, c8 = i & 255;
            const f32x4 a = *(const f32x4*)(F.in[I_PU] + i * 8), b = *(const f32x4*)(F.in[I_PU] + i * 8 + 4);
            u32x4 o; o.x = pk2(a[0], a[1]); o.y = pk2(a[2], a[3]); o.z = pk2(b[0], b[1]); o.w = pk2(b[2], b[3]); *(u32x4*)(UV + row * 4096 + c8 * 8) = o;
            const f32x4 c = *(const f32x4*)(F.in[I_PV] + i * 8), d = *(const f32x4*)(F.in[I_PV] + i * 8 + 4);
            u32x4 q; q.x = pk2(c[0], c[1]); q.y = pk2(c[2], c[3]); q.z = pk2(d[0], d[1]); q.w = pk2(d[2], d[3]); *(u32x4*)(UV + row * 4096 + 2048 + c8 * 8) = q;
        }
    }
}

__device__ __forceinline__ void phase_norm(Frame& F, const float* xsrc, const float* gain, const float* scale, const float* shift) {
    PH_LOCALS
    const int gw = F.vcu * NWAVES + wave, NGW = F.G * NWAVES;
    bf16* H = (bf16*)(F.ws + WS_H);
    for (int m = gw; m < M; m += NGW) norm_row_pass(xsrc + (size_t)m * DM, H + (size_t)m * DM, gain, scale, shift, lane);
}
__device__ __forceinline__ void phase_lnstats(Frame& F) {
    PH_LOCALS
    const int gw = F.vcu * NWAVES + wave, NGW = F.G * NWAVES;
    const bf16* Z = (const bf16*)(F.ws + WS_Z); float* ST = (float*)(F.ws + WS_STATS);
    for (int m = gw; m < M; m += NGW) {
        float v[16];
#pragma unroll
        for (int j = 0; j < 2; ++j) { const u32x4 w = *(const u32x4*)(Z + (size_t)m * 2048 + 1024 + j * 512 + lane * 8);
            v[j * 8 + 0] = bflo(w.x); v[j * 8 + 1] = bfhi(w.x); v[j * 8 + 2] = bflo(w.y); v[j * 8 + 3] = bfhi(w.y); v[j * 8 + 4] = bflo(w.z); v[j * 8 + 5] = bfhi(w.z); v[j * 8 + 6] = bflo(w.w); v[j * 8 + 7] = bfhi(w.w); }
        float s = 0.f;
#pragma unroll
        for (int i = 0; i < 16; ++i) s += v[i];
        const float mean = wave_sum(s) * (1.0f / 1024.0f); float q = 0.f;
#pragma unroll
        for (int i = 0; i < 16; ++i) { const float d = v[i] - mean; q += d * d; }
        const float rstd = 1.0f / sqrtf(wave_sum(q) * (1.0f / 1024.0f) + EPS);
        if (lane == 0) { ST[2 * m] = mean; ST[2 * m + 1] = rstd; }
    }
}
__device__ __forceinline__ void phase_branchnorm(Frame& F) {
    PH_LOCALS
    const int gw = F.vcu * NWAVES + wave, NGW = F.G * NWAVES;
    bf16* MIX = (bf16*)(F.ws + WS_MIX);
    for (int m = gw; m < M; m += NGW) {
        u32x4 w[4]; float sa = 0.f, sb = 0.f;
#pragma unroll
        for (int j = 0; j < 4; ++j) { w[j] = *(const u32x4*)(MIX + (size_t)m * 2048 + j * 512 + lane * 8);
            float q = 0.f;
#pragma unroll
            for (int e = 0; e < 4; ++e) { const float a = bflo(w[j][e]), b = bfhi(w[j][e]); q += a * a + b * b; }
            if (j < 2) sa += q; else sb += q; }
        const float ra = 1.0f / sqrtf(wave_sum(sa) * (1.0f / 1024.0f) + EPS), rb = 1.0f / sqrtf(wave_sum(sb) * (1.0f / 1024.0f) + EPS);
#pragma unroll
        for (int j = 0; j < 4; ++j) { const float r = j < 2 ? ra : rb; u32x4 o;
#pragma unroll
            for (int e = 0; e < 4; ++e) o[e] = pk2(bflo(w[j][e]) * r, bfhi(w[j][e]) * r);
            *(u32x4*)(MIX + (size_t)m * 2048 + j * 512 + lane * 8) = o; }
    }
}

__device__ __forceinline__ void phase_sloc(Frame& F, int l) {
    PH_LOCALS
    const bf16* XS = (const bf16*)(F.ws + WS_XS); const bf16* WG = (const bf16*)(F.ws + WS_WG) + (size_t)l * 64 * 128 * 1024; float* SL = (float*)(F.ws + WS_SLOC);
    const int fr = lane & 15, fq = lane >> 4;
    for (int u = F.vcu; u < 256; u += F.G) {
        const int g = u >> 2, n0 = (u & 3) * 64 + (wave & 3) * 16, jh = wave >> 2;
        f32x4 acc[4];
#pragma unroll
        for (int t = 0; t < 4; ++t) acc[t] = (f32x4){0.f, 0.f, 0.f, 0.f};
        const bf16* xp = XS + ((size_t)(g * 256 + n0 + fr)) * 1024 + 8 * fq;
        const bf16* wp = WG + ((size_t)(g * 128 + jh * 64 + fr)) * 1024 + 8 * fq;
#pragma unroll 4
        for (int kb = 0; kb < 32; ++kb) {
            const bf16x8 xf = *(const bf16x8*)(xp + kb * 32);
#pragma unroll
            for (int t = 0; t < 4; ++t) { const bf16x8 wf = *(const bf16x8*)(wp + (size_t)t * 16 * 1024 + kb * 32); acc[t] = __builtin_amdgcn_mfma_f32_16x16x32_bf16(wf, xf, acc[t], 0, 0, 0); }
        }
#pragma unroll
        for (int t = 0; t < 4; ++t) *(f32x4*)(SL + ((size_t)(g * 256 + n0 + fr)) * 128 + jh * 64 + t * 16 + 4 * fq) = acc[t];
    }
}
__device__ __forceinline__ void s5_carry(Frame& F, int l) {
    PH_LOCALS
    if (F.vcu < 64 && wave == 0) {
        const int g = F.vcu, p = lane;
        const float* AT = (const float*)(F.ws + WS_AT) + ((size_t)(l * 64 + g) * 64 + p) * 2; const float ar = AT[0], ai = AT[1];
        const float* SL = (const float*)(F.ws + WS_SLOC) + (size_t)g * 256 * 128; bf16* HS = (bf16*)(F.ws + WS_HS) + (size_t)g * 256 * 128;
        float hr = 0.f, hi = 0.f;
        for (int n0 = 0; n0 < 256; n0 += 8) {
            float sr[8], si[8];
#pragma unroll
            for (int e = 0; e < 8; ++e) { sr[e] = SL[(size_t)(n0 + e) * 128 + p]; si[e] = SL[(size_t)(n0 + e) * 128 + 64 + p]; }
#pragma unroll
            for (int e = 0; e < 8; ++e) { HS[(size_t)(n0 + e) * 128 + p] = (bf16)f2bf(hr); HS[(size_t)(n0 + e) * 128 + 64 + p] = (bf16)f2bf(hi);
                const float nr = ar * hr - ai * hi + sr[e], ni = ar * hi + ai * hr + si[e]; hr = nr; hi = ni; }
        }
    }
}

__device__ __forceinline__ void gating_unit(Frame& F, int l, int unit) {
    PH_LOCALS
    const int nb = unit >> 3, hh = unit & 7, t0 = nb * 128, c0 = hh * 128;
    const bf16* Z = (const bf16*)(F.ws + WS_Z); const float* ST = (const float*)(F.ws + WS_STATS);
    const bf16* GW = (const bf16*)(F.ws + WS_GWS) + (size_t)(l * 8 + hh) * 128 * 128;
    bf16* MIX = (bf16*)(F.ws + WS_MIX);
    LAS bf16* VT = (LAS bf16*)F.lds;
    constexpr int VS = 136;
    {
        const int j = tid >> 2, cs = (tid & 3) * 32;
        const float mu = ST[2 * (t0 + j)], rs = ST[2 * (t0 + j) + 1];
        const float* lg = F.in[I_LNG] + l * 1024 + c0 + cs; const float* lb = F.in[I_LNB] + l * 1024 + c0 + cs;
#pragma unroll
        for (int q = 0; q < 4; ++q) {
            const u32x4 w = *(const u32x4*)(Z + (size_t)(t0 + j) * 2048 + 1024 + c0 + cs + q * 8);
#pragma unroll
            for (int e = 0; e < 4; ++e) { const int c = cs + q * 8 + 2 * e;
                const float a = (bflo(w[e]) - mu) * rs * lg[q * 8 + 2 * e] + lb[q * 8 + 2 * e], b = (bfhi(w[e]) - mu) * rs * lg[q * 8 + 2 * e + 1] + lb[q * 8 + 2 * e + 1];
                VT[c * VS + j] = (bf16)f2bf(a); VT[(c + 1) * VS + j] = (bf16)f2bf(b); }
        }
    }
    __syncthreads();
    {
        const int fr = lane & 15, fq = lane >> 4, w = wave;
        f32x4 acc[8];
#pragma unroll
        for (int ct = 0; ct < 8; ++ct) acc[ct] = (f32x4){0.f, 0.f, 0.f, 0.f};
        const int nkb = (w < 4) ? 2 : 4;
        for (int kb = 0; kb < nkb; ++kb) {
            const bf16x8 wf = *(const bf16x8*)(GW + (size_t)(16 * w + fr) * 128 + kb * 32 + 8 * fq);
#pragma unroll
            for (int ct = 0; ct < 8; ++ct) { const bf16x8 vf = *(const LAS bf16x8*)(VT + (ct * 16 + fr) * VS + kb * 32 + 8 * fq); acc[ct] = __builtin_amdgcn_mfma_f32_16x16x32_bf16(vf, wf, acc[ct], 0, 0, 0); }
        }
        const int tok = t0 + 16 * w + fr; const float bs = F.in[I_GBS][(l * 8 + hh) * 128 + 16 * w + fr];
#pragma unroll
        for (int ct = 0; ct < 8; ++ct) { const int c = c0 + ct * 16 + 4 * fq;
            const u32x2 uw = *(const u32x2*)(Z + (size_t)tok * 2048 + c);
            u32x2 o; o.x = pk2(bflo(uw.x) * (acc[ct][0] + bs), bfhi(uw.x) * (acc[ct][1] + bs)); o.y = pk2(bflo(uw.y) * (acc[ct][2] + bs), bfhi(uw.y) * (acc[ct][3] + bs));
            *(u32x2*)(MIX + (size_t)tok * 2048 + c) = o; }
    }
    __syncthreads();
}
__device__ __forceinline__ void phase_carry_gating(Frame& F, int l) {
    PH_LOCALS
    s5_carry(F, l);
    unsigned* head = (unsigned*)(F.ws + WS_CTL) + CW_QUEUE + 64 * l;
    LAS unsigned* slot = (LAS unsigned*)(F.lds + MISC_OFF) + 16;
    for (;;) {
        __syncthreads();
        if (tid == 0) slot[0] = __hip_atomic_fetch_add(head, 1u, RLX_AGENT);
        __syncthreads();
        const unsigned u = slot[0];
        if (u >= 1024u) break;
        gating_unit(F, l, (int)u);
    }
}

__device__ __forceinline__ void phase_s5out(Frame& F, int l) {
    PH_LOCALS
    const bf16* XS = (const bf16*)(F.ws + WS_XS); const bf16* HS = (const bf16*)(F.ws + WS_HS);
    bf16* Gb = (bf16*)(F.ws + WS_G);
    LAS bf16* KT = (LAS bf16*)F.lds;
    const int fr = lane & 15, fq = lane >> 4;
    for (int u = F.vcu; u < 512; u += F.G) {
        const int g = u >> 3, rc = (u >> 1) & 3, nh = u & 1;
        __syncthreads();
        { const u32x4* src = (const u32x4*)((const bf16*)(F.ws + WS_KTAB) + (size_t)(l * 64 + g) * 65 * 256);
          for (int i = tid; i < 65 * 256 / 8; i += NTHR) ((LAS u32x4*)KT)[i] = src[i]; }
        __syncthreads();
        const bf16* VG = (const bf16*)(F.ws + WS_VG) + (size_t)(l * 64 + g) * 1024 * 128;
        const int n = nh * 128 + 16 * wave + fr;
        f32x4 acc[16];
#pragma unroll
        for (int q = 0; q < 16; ++q) acc[q] = (f32x4){0.f, 0.f, 0.f, 0.f};
        const bf16* xp0 = XS + ((size_t)(g * 256 + n)) * 1024 + 8 * fq;
        bf16x8 x0 = *(const bf16x8*)xp0;
        for (int kb = 0; kb < 32; ++kb) {
            const int tau0 = 2 * kb;
            const bf16x8 c0 = x0;
            if (kb < 31) x0 = *(const bf16x8*)(xp0 + (kb + 1) * 32);
#pragma unroll
            for (int q = 0; q < 16; ++q) {
                const int t = rc + 4 * q;
                if (t >= tau0) {
                    const int d1 = t - tau0 - (fq >> 1) + 1;
                    const bf16x8 kf = *(const LAS bf16x8*)(KT + (d1 * 16 + fr) * 16 + 8 * (fq & 1));
                    acc[q] = __builtin_amdgcn_mfma_f32_16x16x32_bf16(kf, c0, acc[q], 0, 0, 0);
                }
            }
        }
        const bf16* hp0 = HS + ((size_t)(g * 256 + n)) * 128 + 8 * fq;
        for (int jb = 0; jb < 4; ++jb) {
            const bf16x8 h0 = *(const bf16x8*)(hp0 + jb * 32);
#pragma unroll
            for (int q = 0; q < 16; ++q) {
                const int t = rc + 4 * q;
                const bf16x8 vf = *(const bf16x8*)(VG + (size_t)(t * 16 + fr) * 128 + jb * 32 + 8 * fq);
                acc[q] = __builtin_amdgcn_mfma_f32_16x16x32_bf16(vf, h0, acc[q], 0, 0, 0);
            }
        }
#pragma unroll
        for (int q = 0; q < 16; ++q) {
            const int t = rc + 4 * q, tok = 64 * n + t;
            const f32x4 y = acc[q];
            u32x2 o; o.x = pk2(gelu_tanh(y[0]), gelu_tanh(y[1])); o.y = pk2(gelu_tanh(y[2]), gelu_tanh(y[3]));
            *(u32x2*)(Gb + (size_t)tok * 1024 + g * 16 + 4 * fq) = o;
        }
    }
}

__device__ __forceinline__ unsigned f2key(float v) { const unsigned u = __builtin_bit_cast(unsigned, v); return (u & 0x80000000u) ? ~u : (u | 0x80000000u); }
__device__ __forceinline__ float key2f(unsigned k) { const unsigned u = (k & 0x80000000u) ? (k & 0x7fffffffu) : ~k; return __builtin_bit_cast(float, u); }
__device__ __forceinline__ void phase_topk(Frame& F, int l) {
    PH_LOCALS
    const bf16* Q = (const bf16*)(F.ws + WS_Z);
    const bf16* KB = (const bf16*)(F.ws + WS_KEYS) + (size_t)l * 8 * 2 * 128 * 128;
    int* EID = (int*)(F.ws + WS_EID); float* GT = (float*)(F.ws + WS_GATE);
    LAS float* SC = (LAS float*)F.lds;
    LAS unsigned* LST = (LAS unsigned*)(F.lds + 128 * 260 * 4);
    const int fr = lane & 15, fq = lane >> 4;
    for (int u = F.vcu; u < 1024; u += F.G) {
        const int tt = u >> 3, hh = u & 7, t0 = tt * 128;
        __syncthreads();
        {
            f32x4 acc[2][8];
#pragma unroll
            for (int s = 0; s < 2; ++s)
#pragma unroll
                for (int nt = 0; nt < 8; ++nt) acc[s][nt] = (f32x4){0.f, 0.f, 0.f, 0.f};
#pragma unroll
            for (int s = 0; s < 2; ++s)
#pragma unroll
                for (int kb = 0; kb < 4; ++kb) {
                    const bf16x8 qf = *(const bf16x8*)(Q + (size_t)(t0 + 16 * wave + fr) * 2048 + hh * 256 + s * 128 + kb * 32 + 8 * fq);
#pragma unroll
                    for (int nt = 0; nt < 8; ++nt) { const bf16x8 kf = *(const bf16x8*)(KB + ((size_t)((hh * 2 + s) * 128 + nt * 16 + fr)) * 128 + kb * 32 + 8 * fq);
                        acc[s][nt] = __builtin_amdgcn_mfma_f32_16x16x32_bf16(kf, qf, acc[s][nt], 0, 0, 0); }
                }
#pragma unroll
            for (int s = 0; s < 2; ++s)
#pragma unroll
                for (int nt = 0; nt < 8; ++nt) *(LAS f32x4*)(SC + (16 * wave + fr) * 260 + s * 128 + nt * 16 + 4 * fq) = acc[s][nt];
        }
        __syncthreads();
        if (tid < 256) {
            const int tl = tid >> 1, s = tid & 1;
            unsigned top[16];
#pragma unroll
            for (int k = 0; k < 16; ++k) top[k] = 0u;
            const LAS float* row = SC + tl * 260 + s * 128;
            for (int n4 = 0; n4 < 32; ++n4) {
                const f32x4 v = *(const LAS f32x4*)(row + 4 * n4);
#pragma unroll
                for (int e = 0; e < 4; ++e) {
                    unsigned key = (f2key(v[e]) & ~0x7Fu) | (unsigned)(127 - (4 * n4 + e));
#pragma unroll
                    for (int k = 0; k < 16; ++k) { const unsigned hi = top[k] > key ? top[k] : key, lo = top[k] > key ? key : top[k]; top[k] = hi; key = lo; }
                }
            }
#pragma unroll
            for (int k = 0; k < 16; k += 4) *(LAS u32x4*)(LST + (tl * 2 + s) * 16 + k) = (u32x4){top[k], top[k + 1], top[k + 2], top[k + 3]};
        }
        __syncthreads();
        if (tid < 128) {
            const int tl = tid;
            float av[16], bv[16];
#pragma unroll
            for (int k = 0; k < 16; ++k) { av[k] = key2f(LST[(tl * 2 + 0) * 16 + k] & ~0x7Fu); bv[k] = key2f(LST[(tl * 2 + 1) * 16 + k] & ~0x7Fu); }
            unsigned top[16];
#pragma unroll
            for (int k = 0; k < 16; ++k) top[k] = 0u;
#pragma unroll
            for (int i = 0; i < 16; ++i)
#pragma unroll
                for (int j = 0; j < 16; ++j)
                    if ((i + 1) * (j + 1) <= 16) {
                        unsigned key = (f2key(av[i] + bv[j]) & ~0xFFu) | (unsigned)(255 - (i * 16 + j));
#pragma unroll
                        for (int k = 0; k < 16; ++k) { const unsigned hi = top[k] > key ? top[k] : key, lo = top[k] > key ? key : top[k]; top[k] = hi; key = lo; }
                    }
            float ev[16]; float sum = 0.f; const float mx = key2f(top[0] & ~0xFFu);
#pragma unroll
            for (int k = 0; k < 16; ++k) { ev[k] = __expf(key2f(top[k] & ~0xFFu) - mx); sum += ev[k]; }
            const float inv = 1.0f / sum;
            int* eo = EID + (size_t)(t0 + tl) * 128 + hh * 16; float* go = GT + (size_t)(t0 + tl) * 128 + hh * 16;
#pragma unroll
            for (int k = 0; k < 16; ++k) { const int flat = 255 - (int)(top[k] & 0xFFu), i = flat >> 4, j = flat & 15;
                const int ia = 127 - (int)(LST[(tl * 2 + 0) * 16 + i] & 0x7Fu), ib = 127 - (int)(LST[(tl * 2 + 1) * 16 + j] & 0x7Fu);
                eo[k] = ia * 128 + ib; go[k] = ev[k] * inv; }
        }
    }
    __syncthreads();
}

__device__ __forceinline__ float dot8(const u32x4 a, const u32x4 b, float acc) {
#pragma unroll
    for (int e = 0; e < 4; ++e) { acc = fmaf(bflo(a[e]), bflo(b[e]), acc); acc = fmaf(bfhi(a[e]), bfhi(b[e]), acc); }
    return acc;
}
__device__ __forceinline__ void phase_gather(Frame& F, int l) {
    PH_LOCALS
    const int gw = F.vcu * NWAVES + wave, NGW = F.G * NWAVES;
    const bf16* H = (const bf16*)(F.ws + WS_H); bf16* Hn = (bf16*)(F.ws + WS_H);
    const bf16* UV = (const bf16*)(F.ws + WS_UV) + (size_t)l * NEXP * 4096;
    const int* EID = (const int*)(F.ws + WS_EID); const float* GT = (const float*)(F.ws + WS_GATE);
    float* X = (float*)(F.ws + WS_X);
    const float* mod = (const float*)(F.ws + WS_MOD);
    const float* gate2 = mod + l * 12288 + 5 * 2048;
    const unsigned lane16 = (unsigned)lane * 16u;
    for (int t = gw; t < M; t += NGW) {
        const int e_lo = EID[(size_t)t * 128 + lane], e_hi = EID[(size_t)t * 128 + 64 + lane];
        const float g_lo = GT[(size_t)t * 128 + lane], g_hi = GT[(size_t)t * 128 + 64 + lane];
        u32x4 hp[4];
#pragma unroll
        for (int j = 0; j < 4; ++j) hp[j] = *(const u32x4*)(H + (size_t)t * 2048 + j * 512 + lane * 8);
        float out[32];
#pragma unroll
        for (int i = 0; i < 32; ++i) out[i] = 0.f;
        for (int b = 0; b < 32; ++b) {
            int e[4]; float gt[4];
#pragma unroll
            for (int h = 0; h < 4; ++h) { const int k = 4 * b + h;
                e[h] = __builtin_amdgcn_readlane(k < 64 ? e_lo : e_hi, k & 63);
                gt[h] = __builtin_bit_cast(float, __builtin_amdgcn_readlane(__builtin_bit_cast(int, k < 64 ? g_lo : g_hi), k & 63)); }
            const char* rowp[4];
#pragma unroll
            for (int h = 0; h < 4; ++h) rowp[h] = (const char*)UV + ((size_t)(unsigned)e[h] << 13);
            u32x4 ur[4][4];
#pragma unroll
            for (int h = 0; h < 4; ++h)
#pragma unroll
                for (int j = 0; j < 4; ++j) ur[h][j] = *(const u32x4*)(rowp[h] + lane16 + j * 1024);
            u32x4 vr[4][4];
#pragma unroll
            for (int h = 0; h < 4; ++h)
#pragma unroll
                for (int j = 0; j < 4; ++j) vr[h][j] = *(const u32x4*)(rowp[h] + lane16 + 4096 + j * 1024);
            float p[4];
#pragma unroll
            for (int h = 0; h < 4; ++h) { float a = 0.f;
#pragma unroll
                for (int j = 0; j < 4; ++j) a = dot8(ur[h][j], hp[j], a);
                p[h] = a; }
            const bool up = lane >= 32;
            const float s0 = up ? p[0] : p[2], s1 = up ? p[1] : p[3];
            const float r0 = __shfl_xor(s0, 32), r1 = __shfl_xor(s1, 32);
            const float k0 = (up ? p[2] : p[0]) + r0, k1 = (up ? p[3] : p[1]) + r1;
            const bool odd = (lane & 16) != 0;
            const float sx = odd ? k0 : k1;
            const float rx = __shfl_xor(sx, 16);
            float d = (odd ? k1 : k0) + rx;
            d += __shfl_xor(d, 8); d += __shfl_xor(d, 4); d += __shfl_xor(d, 2); d += __shfl_xor(d, 1);
            const int q = lane >> 4;
            const float gq = q == 0 ? gt[0] : q == 1 ? gt[1] : q == 2 ? gt[2] : gt[3];
            const float coefq = gq * gelu_tanh(d);
#pragma unroll
            for (int h = 0; h < 4; ++h) {
                const float cf = __builtin_bit_cast(float, __builtin_amdgcn_readlane(__builtin_bit_cast(int, coefq), 16 * h));
#pragma unroll
                for (int j = 0; j < 4; ++j)
#pragma unroll
                    for (int w = 0; w < 4; ++w) { out[j * 8 + 2 * w] = fmaf(cf, bflo(vr[h][j][w]), out[j * 8 + 2 * w]); out[j * 8 + 2 * w + 1] = fmaf(cf, bfhi(vr[h][j][w]), out[j * 8 + 2 * w + 1]); }
            }
        }
        int ln = lane; asm volatile("" : "+v"(ln));
        f32x4 xv[4][2];
#pragma unroll
        for (int j = 0; j < 4; ++j)
#pragma unroll
            for (int h = 0; h < 2; ++h) {
                const int c = j * 512 + ln * 8 + 4 * h;
                const f32x4 xo = *(const f32x4*)(X + (size_t)t * 2048 + c), g2 = *(const f32x4*)(gate2 + c);
                const f32x4 o = {out[j * 8 + 4 * h], out[j * 8 + 4 * h + 1], out[j * 8 + 4 * h + 2], out[j * 8 + 4 * h + 3]};
                xv[j][h] = xo + g2 * o;
            }
        if (l + 1 < DEPTH) {
#pragma unroll
            for (int j = 0; j < 4; ++j) { *(f32x4*)(X + (size_t)t * 2048 + j * 512 + ln * 8) = xv[j][0]; *(f32x4*)(X + (size_t)t * 2048 + j * 512 + ln * 8 + 4) = xv[j][1]; }
            const float* m2 = mod + (l + 1) * 12288;
            u32x4 o[4]; norm_mod_row(xv, F.in[I_N1G] + (l + 1) * 2048, m2 + 1 * 2048, m2 + 0 * 2048, ln, o);
#pragma unroll
            for (int j = 0; j < 4; ++j) *(u32x4*)(Hn + (size_t)t * 2048 + j * 512 + ln * 8) = o[j];
        } else {
            float s = 0.f;
#pragma unroll
            for (int j = 0; j < 4; ++j)
#pragma unroll
                for (int h = 0; h < 2; ++h) s += (xv[j][h][0] * xv[j][h][0] + xv[j][h][1] * xv[j][h][1]) + (xv[j][h][2] * xv[j][h][2] + xv[j][h][3] * xv[j][h][3]);
            const float rr = 1.0f / sqrtf(wave_sum(s) * (1.0f / DM) + EPS);
#pragma unroll
            for (int j = 0; j < 4; ++j)
#pragma unroll
                for (int h = 0; h < 2; ++h) { const int c = j * 512 + ln * 8 + 4 * h; const f32x4 fg = *(const f32x4*)(F.in[I_FG] + c);
                    *(f32x4*)(F.out + (size_t)t * 2048 + c) = xv[j][h] * rr * fg; }
        }
    }
}

__global__ void __launch_bounds__(NTHR, 2) fwd_kernel(Args args) {
    extern __shared__ __attribute__((aligned(16))) unsigned char lds_raw[];
    Frame F;
    F.lds = (LAS unsigned char*)lds_raw; F.ws = args.ws; F.in = args.in; F.out = args.out;
    F.tid = threadIdx.x; F.lane = F.tid & 63; F.wave = __builtin_amdgcn_readfirstlane(F.tid >> 6);
    F.G = gridDim.x; { const int bx = blockIdx.x; F.vcu = (F.G % 8 == 0) ? (bx % 8) * (F.G / 8) + bx / 8 : bx; }
    volatile LAS unsigned* MISC = (volatile LAS unsigned*)(F.lds + MISC_OFF);
    if (F.tid < 64) MISC[F.tid] = 0u;
    __syncthreads();
    unsigned* ctl = (unsigned*)(F.ws + WS_CTL);
    XcdBarrier bar; bar.bar = ctl + CW_BAR; bar.x = 0; bar.st = nullptr;
#if !MK_PER_PHASE
    bar = xcd_barrier_post(ctl + CW_BAR, MISC + 8);
#endif
    const int lo = args.ph_lo, hi = args.ph_hi;
#define IN(k) (lo <= (k) && (k) < hi)
#if MK_PER_PHASE
#define SEAM(k) do { } while (0)
#else
#define SEAM(k) do { if (IN(k) && IN((k) + 1)) xcd_barrier(bar); } while (0)
#endif
    const float* mod = (const float*)(F.ws + WS_MOD);

    if (IN(0)) { p0_prologue(F); } SEAM(0);
    for (int l = 0; l < DEPTH; ++l) {
        const int pb = 1 + 12 * l;
        const float* ml = mod + l * 12288;
        const float* xin = (l == 0) ? F.in[I_X] : (const float*)(F.ws + WS_X);
        if (IN(pb + 0)) { if (l == 0) phase_norm(F, xin, F.in[I_N1G] + l * 2048, ml + 1 * 2048, ml + 0 * 2048); } SEAM(pb + 0);
        if (IN(pb + 1)) {
            pg8::Gemm g{(const bf16*)(F.ws + WS_H), (const bf16*)(F.ws + WS_WIN) + (size_t)l * INW * DM, M, INW, DM}; pg8::StaticOrder S; S.init(M, INW, F.G, (int)blockIdx.x);
            EpiIn E{(bf16*)(F.ws + WS_Z), (bf16*)(F.ws + WS_XS), F.in[I_BIN] + l * INW};
            pg8::gemm_phase<EpiIn, pg8::StaticOrder, true, true>(F.lds, g, S, E);
        } SEAM(pb + 1);
        if (IN(pb + 2)) { phase_sloc(F, l); phase_lnstats(F); } SEAM(pb + 2);
        if (IN(pb + 3)) { phase_carry_gating(F, l); } SEAM(pb + 3);
        if (IN(pb + 4)) { phase_s5out(F, l); } SEAM(pb + 4);
        if (IN(pb + 5)) {
            pg8::Gemm g{(const bf16*)(F.ws + WS_G), (const bf16*)(F.ws + WS_GLU) + (size_t)l * WB * WB, M, WB, WB}; pg8::StaticOrder S; S.init(M, WB, F.G, (int)blockIdx.x);
            EpiGlu E{(const bf16*)(F.ws + WS_G), (bf16*)(F.ws + WS_MIX), F.in[I_GLUB] + l * WB};
            pg8::gemm_phase<EpiGlu, pg8::StaticOrder, true, true>(F.lds, g, S, E);
        } SEAM(pb + 5);
        if (IN(pb + 6)) { phase_branchnorm(F); } SEAM(pb + 6);
        if (IN(pb + 7)) {
            pg8::Gemm g{(const bf16*)(F.ws + WS_MIX), (const bf16*)(F.ws + WS_WOUT) + (size_t)l * DM * DM, M, DM, DM}; pg8::StaticOrder S; S.init(M, DM, F.G, (int)blockIdx.x);
            EpiOut E{xin, (float*)(F.ws + WS_X), ml + 2 * 2048};
            pg8::gemm_phase<EpiOut, pg8::StaticOrder, true, true>(F.lds, g, S, E);
        } SEAM(pb + 7);
        if (IN(pb + 8)) { phase_norm(F, (const float*)(F.ws + WS_X), F.in[I_N2G] + l * 2048, ml + 4 * 2048, ml + 3 * 2048); } SEAM(pb + 8);
        if (IN(pb + 9)) {
            pg8::Gemm g{(const bf16*)(F.ws + WS_H), (const bf16*)(F.ws + WS_WQ) + (size_t)l * DM * DM, M, DM, DM}; pg8::StaticOrder S; S.init(M, DM, F.G, (int)blockIdx.x);
            EpiQ E{(bf16*)(F.ws + WS_Z)};
            pg8::gemm_phase<EpiQ, pg8::StaticOrder, true, true>(F.lds, g, S, E);
        } SEAM(pb + 9);
        if (IN(pb + 10)) { phase_topk(F, l); } SEAM(pb + 10);
        if (IN(pb + 11)) { phase_gather(F, l); } SEAM(pb + 11);
    }
#undef IN
#undef SEAM
}

extern "C" void kernel_launch(void* const* d_in, const int* in_sizes, int n_in, void* d_out, int out_size, void* d_ws, size_t ws_size, hipStream_t stream) {
    static int grid = 0;
    if (grid == 0) {
        if (n_in != 29 || out_size != M * DM || ws_size < WS_END) { fprintf(stderr, "kernel_launch: unexpected shapes (n_in %d, out %d, ws %zu); nothing launched\n", n_in, out_size, ws_size); grid = -1; return; }
        int dev = 0, cus = 0;
        if (hipGetDevice(&dev) != hipSuccess || hipDeviceGetAttribute(&cus, hipDeviceAttributeMultiprocessorCount, dev) != hipSuccess) { grid = -1; return; }
        if (hipFuncSetAttribute((const void*)fwd_kernel, hipFuncAttributeMaxDynamicSharedMemorySize, LDS_BYTES) != hipSuccess) { fprintf(stderr, "kernel_launch: hipFuncSetAttribute failed\n"); grid = -1; return; }
        (void)hipGetLastError();
        grid = cus;
    }
    if (grid < 0) return;
    (void)hipMemsetAsync((char*)d_ws + WS_CTL, 0, CTL_ZERO_BYTES, stream);
    Args a{};
    for (int i = 0; i < 29; ++i) a.in[i] = (const float*)d_in[i];
    a.out = (float*)d_out; a.ws = (unsigned char*)d_ws;
#if MK_PER_PHASE
    for (int p = 0; p < 1 + 12 * DEPTH; ++p) {
        if (p == 13) continue;
        a.ph_lo = p; a.ph_hi = p + 1; a.li = p;
        hipLaunchKernelGGL(fwd_kernel, dim3(grid), dim3(NTHR), LDS_BYTES, stream, a);
    }
#else
    a.ph_lo = 0; a.ph_hi = 1 + 12 * DEPTH; a.li = 0;
    hipLaunchKernelGGL(fwd_kernel, dim3(grid), dim3(NTHR), LDS_BYTES, stream, a);
#endif
}
```

```cpp
#include <hip/hip_runtime.h>
#include <cstdio>
#include <cstdint>

#ifndef SELFTEST_S5
#define SELFTEST_S5 0
#endif
#ifndef REPEAT_PH
#define REPEAT_PH -1
#endif
#ifndef MK_PER_PHASE
#define MK_PER_PHASE 0
#endif

#define GAS __attribute__((address_space(1)))
#define LAS __attribute__((address_space(3)))
typedef unsigned short bf16;
typedef short bf16x8 __attribute__((ext_vector_type(8)));
typedef float f32x4 __attribute__((ext_vector_type(4)));
typedef float f32x2 __attribute__((ext_vector_type(2)));
typedef unsigned u32x4 __attribute__((ext_vector_type(4)));
typedef unsigned u32x2 __attribute__((ext_vector_type(2)));

constexpr int DM = 2048, SEQ = 16384, DEPTH = 2, M = SEQ;
constexpr int WA = 1024, WB = 1024, INW = 3072;
constexpr int NG = 64, NCH = 256;
constexpr int NEXP = 16384;
constexpr float EPS = 1e-6f;
constexpr int NWAVES = 8, NTHR = 512;

namespace pg8 {
#define PG8_LAS __attribute__((address_space(3)))
constexpr int BM = 256, BK = 64, HALF = 128, HTB = HALF * BK * 2, STAGE_BYTES = 8 * HTB, NXCD = 8, WGM = 8;
__host__ __device__ __forceinline__ int lds_byte(int r, int c) { const int st = (r >> 4) * 2 + (c >> 5), rr = r & 15, cc = c & 31, ob = rr * 64 + cc * 2; return st * 1024 + (ob ^ (((ob >> 9) & 1) << 5)); }
__host__ __device__ __forceinline__ void stage_rc(int b, int& R, int& C) { const int st = b / 1024, sb = b % 1024, swz = sb ^ (((sb >> 9) & 1) << 5); R = (st >> 1) * 16 + swz / 64; C = (st & 1) * 32 + (swz % 64) / 2; }
__host__ __device__ __forceinline__ int perm32(int rho) { const int n = rho >> 4, i = rho & 15; return 8 * (i >> 2) + 4 * n + (i & 3); }
struct Unit { int pm, pn; };
struct Gemm { const bf16* A; const bf16* Bt; int M, N, K; };
struct StaticOrder {
    int nM, nN, nwg, G, c;
    __host__ __device__ void init(int M_, int N_, int G_, int c_) { nM = M_ / BM; nN = N_ / BM; nwg = nM * nN; G = G_; c = c_; }
    __host__ __device__ bool next(int i, Unit& u) const {
        const long L = (long)i * G + c; if (L >= nwg) return false;
        int wgid = (int)L; { const int q = nwg / NXCD, r = nwg % NXCD, xcd = wgid % NXCD, off = wgid / NXCD; wgid = (xcd < r ? xcd * (q + 1) : r * (q + 1) + (xcd - r) * q) + off; }
        const int nig = WGM * nN, gid = wgid / nig, fm = gid * WGM, gsz = (nM - fm) < WGM ? (nM - fm) : WGM;
        u.pm = fm + ((wgid % nig) % gsz); u.pn = (wgid % nig) / gsz; return true;
    }
    __device__ __forceinline__ void a_ready(const Unit&) const {}
    __device__ __forceinline__ void done(const Unit&) const {}
};
__device__ __forceinline__ unsigned cvt_pk_bf16(float lo, float hi) { unsigned r; asm volatile("v_cvt_pk_bf16_f32 %0, %1, %2" : "=v"(r) : "v"(lo), "v"(hi)); return r; }

template <class Epi, class Sched, bool ALIGN_EPI = false, bool SP2 = false>
__device__ __forceinline__ void gemm_phase(PG8_LAS unsigned char* lds, const Gemm g, const Sched& S, const Epi& E) {
    int tid = threadIdx.x; asm volatile("" : "+v"(tid)); const int wid = __builtin_amdgcn_readfirstlane(tid >> 6), lane = tid & 63, wr = wid >> 2, wc = wid & 3, fr = lane & 15, fq = lane >> 4;
    const int K = g.K, nt = K / BK;
    unsigned voffA[2], voffB[2];
#pragma unroll
    for (int i = 0; i < 2; ++i) { int R, C; stage_rc(tid * 16 + i * 8192, R, C); const int Rb = Epi::PERM ? ((R & ~31) + perm32(R & 31)) : R;
        voffA[i] = (unsigned)(R * K + C) * 2u; voffB[i] = (unsigned)(Rb * K + C) * 2u; }
    const size_t kstep = (size_t)(BK * 2);
    const size_t hstep = (size_t)HALF * K * 2;
    const size_t tstep = 2 * hstep;
    const unsigned ldsw = (unsigned)wid * 1024u;
    const int aoff = lds_byte(wr * 64 + fr, fq * 8), boff = lds_byte(wc * 32 + fr, fq * 8);
#define PG8_SA(b, h) (((b) * 2 + (h)) * HTB)
#define PG8_SB(b, h) ((4 + (b) * 2 + (h)) * HTB)
#define PG8_STAGE(bufoff, gbase, voff) do { _Pragma("unroll") for (int _i = 0; _i < 2; ++_i) \
        __builtin_amdgcn_global_load_lds((const unsigned*)((const char*)(gbase) + (voff)[_i]), (PG8_LAS unsigned*)(lds + (bufoff) + ldsw + _i * 8192), 16, 0, 0); } while (0)
#define PG8_LDA(dst, b, h) do { _Pragma("unroll") for (int m = 0; m < 4; ++m) _Pragma("unroll") for (int k = 0; k < 2; ++k) dst[m][k] = *(const PG8_LAS bf16x8*)(lds + PG8_SA(b, h) + aoff + m * 2048 + k * 1024); } while (0)
#define PG8_LDB(dst, b, h) do { _Pragma("unroll") for (int n = 0; n < 2; ++n) _Pragma("unroll") for (int k = 0; k < 2; ++k) dst[n][k] = *(const PG8_LAS bf16x8*)(lds + PG8_SB(b, h) + boff + n * 2048 + k * 1024); } while (0)
#define PG8_MMA(ai, bj, At, Bt) do { __builtin_amdgcn_s_setprio(1); _Pragma("unroll") for (int m = 0; m < 4; ++m) _Pragma("unroll") for (int n = 0; n < 2; ++n) _Pragma("unroll") for (int k = 0; k < 2; ++k) \
        acc[ai][bj][m][n] = __builtin_amdgcn_mfma_f32_16x16x32_bf16(Bt[n][k], At[m][k], acc[ai][bj][m][n], 0, 0, 0); __builtin_amdgcn_s_setprio(0); } while (0)
#define PG8_WAIT_V(n) asm volatile("s_waitcnt vmcnt(" #n ")" ::: "memory")
#define PG8_WAIT_L(n) asm volatile("s_waitcnt lgkmcnt(" #n ")" ::: "memory")
#define PG8_BAR __builtin_amdgcn_s_barrier()
#define PG8_SCHED __builtin_amdgcn_sched_barrier(0)
    Unit cur, nxt; int ui = 0;
    if (!S.next(0, cur)) return;
    f32x4 acc[2][2][4][2];
#pragma unroll
    for (int a = 0; a < 2; ++a)
#pragma unroll
        for (int b = 0; b < 2; ++b)
#pragma unroll
            for (int m = 0; m < 4; ++m)
#pragma unroll
                for (int n = 0; n < 2; ++n) acc[a][b][m][n] = (f32x4){0.f, 0.f, 0.f, 0.f};
    bf16x8 At[4][2], B0[2][2], B1[2][2];
    const char* cA = (const char*)g.A + (size_t)cur.pm * tstep; const char* cB = (const char*)g.Bt + (size_t)cur.pn * tstep;
    S.a_ready(cur);
    if constexpr (SP2) {
        PG8_STAGE(PG8_SB(0, 0), cB, voffB); PG8_STAGE(PG8_SB(0, 1), cB + hstep, voffB); PG8_STAGE(PG8_SA(0, 0), cA, voffA); PG8_STAGE(PG8_SA(0, 1), cA + hstep, voffA);
        if (wr == 1) PG8_BAR;
        PG8_WAIT_V(2); PG8_BAR;
        PG8_STAGE(PG8_SB(1, 0), cB + kstep, voffB); PG8_STAGE(PG8_SA(1, 0), cA + kstep, voffA); PG8_STAGE(PG8_SB(1, 1), cB + hstep + kstep, voffB);
        PG8_WAIT_V(6); PG8_BAR;
    } else {
        PG8_STAGE(PG8_SB(0, 0), cB, voffB); PG8_STAGE(PG8_SA(0, 0), cA, voffA); PG8_STAGE(PG8_SB(0, 1), cB + hstep, voffB); PG8_STAGE(PG8_SA(0, 1), cA + hstep, voffA);
        if (wr == 1) PG8_BAR;
        PG8_WAIT_V(4); PG8_BAR;
        PG8_STAGE(PG8_SB(1, 0), cB + kstep, voffB); PG8_STAGE(PG8_SA(1, 0), cA + kstep, voffA); PG8_STAGE(PG8_SB(1, 1), cB + hstep + kstep, voffB);
        PG8_WAIT_V(6); PG8_BAR;
    }
    for (;;) {
        const bool has_next = S.next(ui + 1, nxt);
        const char* nA = has_next ? (const char*)g.A + (size_t)nxt.pm * tstep : cA; const char* nB = has_next ? (const char*)g.Bt + (size_t)nxt.pn * tstep : cB;
        for (int t = 0; t < nt; t += 2) {
            const bool last = (t == nt - 2);
            const char* a1 = cA + (size_t)(t + 1) * kstep;
            const char* a2 = last ? nA : cA + (size_t)(t + 2) * kstep; const char* b2 = last ? nB : cB + (size_t)(t + 2) * kstep;
            const char* a3 = a2 + kstep; const char* b3 = b2 + kstep;
            if (last && has_next) S.a_ready(nxt);
            if constexpr (SP2) {
            PG8_LDB(B0, 0, 0); PG8_LDB(B1, 0, 1); PG8_SCHED; PG8_LDA(At, 0, 0); PG8_STAGE(PG8_SA(1, 1), a1 + hstep, voffA);
            PG8_WAIT_V(8); PG8_WAIT_L(0); PG8_BAR; PG8_MMA(0, 0, At, B0); PG8_MMA(0, 1, At, B1); PG8_BAR; PG8_SCHED;
            PG8_LDA(At, 0, 1); PG8_STAGE(PG8_SB(0, 0), b2, voffB); PG8_STAGE(PG8_SB(0, 1), b2 + hstep, voffB); PG8_STAGE(PG8_SA(0, 0), a2, voffA);
            PG8_WAIT_V(8); PG8_WAIT_L(0); PG8_BAR; PG8_MMA(1, 0, At, B0); PG8_MMA(1, 1, At, B1); PG8_BAR; PG8_SCHED;
            PG8_LDB(B0, 1, 0); PG8_LDB(B1, 1, 1); PG8_SCHED; PG8_LDA(At, 1, 0); PG8_STAGE(PG8_SA(0, 1), a2 + hstep, voffA);
            PG8_WAIT_V(8); PG8_WAIT_L(0); PG8_BAR; PG8_MMA(0, 0, At, B0); PG8_MMA(0, 1, At, B1); PG8_BAR; PG8_SCHED;
            PG8_LDA(At, 1, 1); PG8_STAGE(PG8_SB(1, 0), b3, voffB); PG8_STAGE(PG8_SB(1, 1), b3 + hstep, voffB); PG8_STAGE(PG8_SA(1, 0), a3, voffA);
            PG8_WAIT_V(8); PG8_WAIT_L(0); PG8_BAR; PG8_MMA(1, 0, At, B0); PG8_MMA(1, 1, At, B1); PG8_BAR; PG8_SCHED;
            } else {
            PG8_LDB(B0, 0, 0); PG8_SCHED; PG8_LDA(At, 0, 0); PG8_STAGE(PG8_SA(1, 1), a1 + hstep, voffA);
            PG8_WAIT_L(8); PG8_BAR; PG8_WAIT_L(0); PG8_MMA(0, 0, At, B0); PG8_BAR; PG8_SCHED;
            PG8_LDB(B1, 0, 1); PG8_STAGE(PG8_SB(0, 0), b2, voffB);
            PG8_BAR; PG8_WAIT_L(0); PG8_MMA(0, 1, At, B1); PG8_BAR;
            PG8_LDA(At, 0, 1); PG8_STAGE(PG8_SA(0, 0), a2, voffA);
            PG8_BAR; PG8_WAIT_L(0); PG8_MMA(1, 0, At, B0); PG8_BAR; PG8_SCHED;
            PG8_STAGE(PG8_SB(0, 1), b2 + hstep, voffB);
            PG8_WAIT_V(6); PG8_BAR; PG8_MMA(1, 1, At, B1); PG8_BAR;
            PG8_LDB(B0, 1, 0); PG8_SCHED; PG8_LDA(At, 1, 0); PG8_STAGE(PG8_SA(0, 1), a2 + hstep, voffA);
            PG8_WAIT_L(8); PG8_BAR; PG8_WAIT_L(0); PG8_MMA(0, 0, At, B0); PG8_BAR; PG8_SCHED;
            PG8_LDB(B1, 1, 1); PG8_STAGE(PG8_SB(1, 0), b3, voffB);
            PG8_BAR; PG8_WAIT_L(0); PG8_MMA(0, 1, At, B1); PG8_BAR;
            PG8_LDA(At, 1, 1); PG8_STAGE(PG8_SA(1, 0), a3, voffA);
            PG8_BAR; PG8_WAIT_L(0); PG8_MMA(1, 0, At, B0); PG8_BAR; PG8_SCHED;
            PG8_STAGE(PG8_SB(1, 1), b3 + hstep, voffB);
            PG8_WAIT_V(6); PG8_BAR; PG8_MMA(1, 1, At, B1); PG8_BAR;
            }
        }
        if constexpr (ALIGN_EPI) { if (wr == 0) PG8_BAR; }
        E(acc, cur, wr, wc, fr, fq); S.done(cur);
        if (!has_next) break;
#pragma unroll
        for (int a = 0; a < 2; ++a)
#pragma unroll
            for (int b = 0; b < 2; ++b)
#pragma unroll
                for (int m = 0; m < 4; ++m)
#pragma unroll
                    for (int n = 0; n < 2; ++n) acc[a][b][m][n] = (f32x4){0.f, 0.f, 0.f, 0.f};
        cur = nxt; cA = nA; cB = nB; ++ui;
        if constexpr (ALIGN_EPI) { if (wr == 1) PG8_BAR; }
    }
    PG8_WAIT_V(0);
    if constexpr (!ALIGN_EPI) { if (wr == 0) PG8_BAR; }
    PG8_BAR;
#undef PG8_SA
#undef PG8_SB
#undef PG8_STAGE
#undef PG8_LDA
#undef PG8_LDB
#undef PG8_MMA
#undef PG8_WAIT_V
#undef PG8_WAIT_L
#undef PG8_BAR
#undef PG8_SCHED
}
}

__device__ __forceinline__ unsigned f2bf(float f) { unsigned u = __builtin_bit_cast(unsigned, f); return (u + 0x7fffu + ((u >> 16) & 1u)) >> 16; }
__device__ __forceinline__ unsigned pk2(float lo, float hi) { return f2bf(lo) | (f2bf(hi) << 16); }
__device__ __forceinline__ float bflo(unsigned w) { return __builtin_bit_cast(float, w << 16); }
__device__ __forceinline__ float bfhi(unsigned w) { return __builtin_bit_cast(float, w & 0xffff0000u); }
__device__ __forceinline__ float fast_sigmoid(float t) { return __builtin_amdgcn_rcpf(1.0f + __builtin_amdgcn_exp2f(-1.44269504089f * t)); }
__device__ __forceinline__ float gelu_tanh(float x) { const float t = x * (1.5957691216f + 0.0713548163f * x * x); return x * fast_sigmoid(t); }
__device__ __forceinline__ float wave_sum(float v) {
#pragma unroll
    for (int o = 1; o < 64; o <<= 1) v += __shfl_xor(v, o);
    return v;
}
#define LDS_WAIT() asm volatile("s_waitcnt lgkmcnt(0)" ::: "memory")
#define VM_WAIT() asm volatile("s_waitcnt vmcnt(0)" ::: "memory")
#define RLX_AGENT __ATOMIC_RELAXED, __HIP_MEMORY_SCOPE_AGENT

constexpr size_t MiB = 1u << 20;
constexpr size_t WS_CTL = 0, CTL_ZERO_BYTES = 1 * MiB;
constexpr size_t WS_MOD   = 1 * MiB;
constexpr size_t WS_AT    = WS_MOD + 128 * 1024;
constexpr size_t WS_STATS = WS_AT + 128 * 1024;
constexpr size_t WS_KEYS  = 2 * MiB;
constexpr size_t WS_GWS   = 3 * MiB;
constexpr size_t WS_WIN   = 4 * MiB;
constexpr size_t WS_GLU   = 28 * MiB;
constexpr size_t WS_WOUT  = 32 * MiB;
constexpr size_t WS_WQ    = 48 * MiB;
constexpr size_t WS_KTAB  = 64 * MiB;
constexpr size_t WS_WG    = 72 * MiB;
constexpr size_t WS_VG    = 104 * MiB;
constexpr size_t WS_UV    = 136 * MiB;
constexpr size_t WS_X     = 392 * MiB;
constexpr size_t WS_H     = 520 * MiB;
constexpr size_t WS_Z     = 584 * MiB;
constexpr size_t WS_XS    = 648 * MiB;
constexpr size_t WS_SLOC  = 680 * MiB;
constexpr size_t WS_HS    = 688 * MiB;
constexpr size_t WS_G     = 692 * MiB;
constexpr size_t WS_MIX   = 724 * MiB;
constexpr size_t WS_EID   = 788 * MiB;
constexpr size_t WS_GATE  = 796 * MiB;
constexpr size_t WS_END   = 804 * MiB;
constexpr size_t WS_DBG   = 804 * MiB;
constexpr int CW_BAR = 4096;
constexpr int CW_FLAG = 2048;
constexpr int CW_QUEUE = 16384;

constexpr int LDS_BYTES = 163840;
constexpr int MISC_OFF = LDS_BYTES - 256;

#define XB_TMO      128
#define XB_XCNT(j)  (256  + 64 * (j))
#define XB_XSUB(j)  (1280 + 64 * (j))
#define XB_XGEN(j)  (2304 + 64 * (j))
#define XB_TOP      3328
#define XB_TOPGEN   3392
#define XCD_BAR_WORDS 3456
#define XB_SPIN_CAP (1u << 24)
__device__ __forceinline__ unsigned xb_ld(unsigned* p)              { return __hip_atomic_load(p, __ATOMIC_RELAXED, __HIP_MEMORY_SCOPE_AGENT); }
__device__ __forceinline__ unsigned xb_add(unsigned* p, unsigned v) { return __hip_atomic_fetch_add(p, v, __ATOMIC_RELAXED, __HIP_MEMORY_SCOPE_AGENT); }
__device__ __forceinline__ unsigned xb_xcc_id() { return (unsigned)__builtin_amdgcn_s_getreg((3 << 11) | 20) & 0xFu; }
#define XB_SPIN(cond, bar) do { unsigned _sp = 0; while (cond) { __builtin_amdgcn_s_sleep(1); \
    if ((++_sp & 255u) == 0u) { if (xb_ld(&(bar)[XB_TMO])) break; if (_sp > XB_SPIN_CAP) { atomicAdd(&(bar)[XB_TMO], 1u); break; } } } } while (0)
struct XcdBarrier { unsigned* bar; unsigned x; volatile LAS unsigned* st; };
__device__ __forceinline__ XcdBarrier xcd_barrier_post(unsigned* bar, volatile LAS unsigned* st) {
    XcdBarrier b; b.bar = bar; b.x = xb_xcc_id(); b.st = st;
    if (threadIdx.x == 0) (void)xb_add(&bar[XB_XCNT(b.x)], 1u);
    return b;
}
__device__ __forceinline__ void xcd_barrier_complete(unsigned* bar, unsigned x, unsigned& nloc, unsigned& nx) {
    const unsigned G = gridDim.x * gridDim.y * gridDim.z;
    unsigned sum, cnt, mine, sp = 0u;
    for (;;) {
        sum = 0u; cnt = 0u; mine = 0u;
#pragma unroll
        for (unsigned j = 0; j < 16; ++j) { const unsigned c = xb_ld(&bar[XB_XCNT(j)]); sum += c; cnt += (c > 0u) ? 1u : 0u; mine = (j == x) ? c : mine; }
        if (sum == G) break;
        __builtin_amdgcn_s_sleep(1);
        if ((++sp & 255u) == 0u) { if (xb_ld(&bar[XB_TMO])) break; if (sp > XB_SPIN_CAP) { atomicAdd(&bar[XB_TMO], 1u); break; } }
    }
    nloc = mine > 0u ? mine : 1u; nx = cnt > 0u ? cnt : 1u;
}
__device__ __forceinline__ void xcd_barrier(const XcdBarrier& b) {
    asm volatile("s_waitcnt vmcnt(0)" ::: "memory");
    __syncthreads();
    if (threadIdx.x == 0) {
        unsigned* bar = b.bar;
        __builtin_amdgcn_s_waitcnt(0);
        unsigned nloc = b.st[0], nx = b.st[1];
        if (nloc == 0u) { xcd_barrier_complete(bar, b.x, nloc, nx); b.st[0] = nloc; b.st[1] = nx; }
        const unsigned old = xb_add(&bar[XB_XSUB(b.x)], 1u);
        const unsigned gen = old / nloc;
        if (old + 1u == (gen + 1u) * nloc) {
            __builtin_amdgcn_fence(__ATOMIC_RELEASE, "agent");
            asm volatile("s_waitcnt vmcnt(0)" ::: "memory");
            const unsigned og = xb_add(&bar[XB_TOP], 1u);
            const unsigned tg = og / nx;
            if (og + 1u == (tg + 1u) * nx) xb_add(&bar[XB_TOPGEN], 1u);
            else XB_SPIN(xb_ld(&bar[XB_TOPGEN]) == tg, bar);
            __builtin_amdgcn_fence(__ATOMIC_ACQUIRE, "agent");
            xb_add(&bar[XB_XGEN(b.x)], 1u);
            asm volatile("s_waitcnt vmcnt(0)" ::: "memory");
        } else {
            XB_SPIN(xb_ld(&bar[XB_XGEN(b.x)]) == gen, bar);
            __builtin_amdgcn_fence(__ATOMIC_ACQUIRE, "agent");
            asm volatile("s_waitcnt vmcnt(0)" ::: "memory");
        }
    }
    __syncthreads();
}

struct Args { const float* in[29]; float* out; unsigned char* ws; int ph_lo, ph_hi, li, pad; };
enum { I_X = 0, I_C, I_WMOD, I_BMOD, I_N1G, I_WIN, I_BIN, I_LNG, I_LNB, I_GWS, I_GBS, I_LRE, I_LIM, I_LDT, I_BRE, I_BIM, I_CRE, I_CIM, I_SD, I_GLUW, I_GLUB,
       I_BRG, I_WOUT, I_N2G, I_WQ, I_KEYS, I_PU, I_PV, I_FG };

struct Frame {
    LAS unsigned char* lds;
    unsigned char* ws;
    const float* const* in;
    float* out;
    int tid, lane, wave, vcu, G;
};

#define PH_LOCALS int tid = F.tid; asm volatile("" : "+v"(tid)); const int lane = tid & 63; const int wave = __builtin_amdgcn_readfirstlane(tid >> 6); (void)lane; (void)wave;

struct EpiIn {
    static constexpr bool PERM = true, AFTER_DRAIN = false;
    bf16* Z; bf16* XS; const float* bias;
    __device__ __forceinline__ void operator()(const f32x4 (&acc)[2][2][4][2], const pg8::Unit& u, int wr, int wc, int fr, int fq) const {
        const int row0 = u.pm * 256 + wr * 64 + fr, col0 = u.pn * 256 + wc * 32 + 8 * fq;
        f32x4 bv[2][2];
#pragma unroll
        for (int bj = 0; bj < 2; ++bj)
#pragma unroll
            for (int n = 0; n < 2; ++n) bv[bj][n] = *(const f32x4*)(bias + col0 + bj * 128 + 4 * n);
        const bool isz = (u.pn < 8);
#pragma unroll
        for (int ai = 0; ai < 2; ++ai)
#pragma unroll
            for (int m = 0; m < 4; ++m) {
                const int r = row0 + ai * 128 + m * 16;
#pragma unroll
                for (int bj = 0; bj < 2; ++bj) {
                    f32x4 v0 = acc[ai][bj][m][0] + bv[bj][0], v1 = acc[ai][bj][m][1] + bv[bj][1];
                    const int c = col0 + bj * 128;
                    u32x4 w;
                    if (isz) {
                        w.x = pg8::cvt_pk_bf16(gelu_tanh(v0[0]), gelu_tanh(v0[1])); w.y = pg8::cvt_pk_bf16(gelu_tanh(v0[2]), gelu_tanh(v0[3]));
                        w.z = pg8::cvt_pk_bf16(gelu_tanh(v1[0]), gelu_tanh(v1[1])); w.w = pg8::cvt_pk_bf16(gelu_tanh(v1[2]), gelu_tanh(v1[3]));
                        *(u32x4*)(Z + (size_t)r * 2048 + c) = w;
                    } else {
                        w.x = pg8::cvt_pk_bf16(v0[0], v0[1]); w.y = pg8::cvt_pk_bf16(v0[2], v0[3]); w.z = pg8::cvt_pk_bf16(v1[0], v1[1]); w.w = pg8::cvt_pk_bf16(v1[2], v1[3]);
                        const int cc = c - 2048, g = cc >> 4, i = cc & 15;
                        *(u32x4*)(XS + ((size_t)(g * 256 + (r >> 6)) * 64 + (r & 63)) * 16 + i) = w;
                    }
                }
            }
    }
};
struct EpiGlu {
    static constexpr bool PERM = true, AFTER_DRAIN = false;
    const bf16* Gb; bf16* MIX; const float* bias;
    __device__ __forceinline__ void operator()(const f32x4 (&acc)[2][2][4][2], const pg8::Unit& u, int wr, int wc, int fr, int fq) const {
        const int row0 = u.pm * 256 + wr * 64 + fr, col0 = u.pn * 256 + wc * 32 + 8 * fq;
        f32x4 bv[2][2];
#pragma unroll
        for (int bj = 0; bj < 2; ++bj)
#pragma unroll
            for (int n = 0; n < 2; ++n) bv[bj][n] = *(const f32x4*)(bias + col0 + bj * 128 + 4 * n);
#pragma unroll
        for (int ai = 0; ai < 2; ++ai)
#pragma unroll
            for (int m = 0; m < 4; ++m) {
                const int r = row0 + ai * 128 + m * 16;
#pragma unroll
                for (int bj = 0; bj < 2; ++bj) {
                    const f32x4 v0 = acc[ai][bj][m][0] + bv[bj][0], v1 = acc[ai][bj][m][1] + bv[bj][1];
                    const int c = col0 + bj * 128;
                    const u32x4 gw = *(const u32x4*)(Gb + (size_t)r * 1024 + c);
                    u32x4 w;
                    w.x = pg8::cvt_pk_bf16(bflo(gw.x) * fast_sigmoid(v0[0]), bfhi(gw.x) * fast_sigmoid(v0[1]));
                    w.y = pg8::cvt_pk_bf16(bflo(gw.y) * fast_sigmoid(v0[2]), bfhi(gw.y) * fast_sigmoid(v0[3]));
                    w.z = pg8::cvt_pk_bf16(bflo(gw.z) * fast_sigmoid(v1[0]), bfhi(gw.z) * fast_sigmoid(v1[1]));
                    w.w = pg8::cvt_pk_bf16(bflo(gw.w) * fast_sigmoid(v1[2]), bfhi(gw.w) * fast_sigmoid(v1[3]));
                    *(u32x4*)(MIX + (size_t)r * 2048 + 1024 + c) = w;
                }
            }
    }
};
struct EpiOut {
    static constexpr bool PERM = true, AFTER_DRAIN = false;
    const float* xin; float* X; const float* gate;
    __device__ __forceinline__ void operator()(const f32x4 (&acc)[2][2][4][2], const pg8::Unit& u, int wr, int wc, int fr, int fq) const {
        const int row0 = u.pm * 256 + wr * 64 + fr, col0 = u.pn * 256 + wc * 32 + 8 * fq;
        f32x4 gv[2][2];
#pragma unroll
        for (int bj = 0; bj < 2; ++bj)
#pragma unroll
            for (int n = 0; n < 2; ++n) gv[bj][n] = *(const f32x4*)(gate + col0 + bj * 128 + 4 * n);
#pragma unroll
        for (int ai = 0; ai < 2; ++ai)
#pragma unroll
            for (int m = 0; m < 4; ++m) {
                const int r = row0 + ai * 128 + m * 16;
#pragma unroll
                for (int bj = 0; bj < 2; ++bj) {
                    const size_t off = (size_t)r * 2048 + col0 + bj * 128;
                    const f32x4 x0 = *(const f32x4*)(xin + off), x1 = *(const f32x4*)(xin + off + 4);
                    *(f32x4*)(X + off) = x0 + gv[bj][0] * acc[ai][bj][m][0];
                    *(f32x4*)(X + off + 4) = x1 + gv[bj][1] * acc[ai][bj][m][1];
                }
            }
    }
};
struct EpiQ {
    static constexpr bool PERM = true, AFTER_DRAIN = false;
    bf16* Q;
    __device__ __forceinline__ void operator()(const f32x4 (&acc)[2][2][4][2], const pg8::Unit& u, int wr, int wc, int fr, int fq) const {
        const int row0 = u.pm * 256 + wr * 64 + fr, col0 = u.pn * 256 + wc * 32 + 8 * fq;
#pragma unroll
        for (int ai = 0; ai < 2; ++ai)
#pragma unroll
            for (int m = 0; m < 4; ++m) {
                const int r = row0 + ai * 128 + m * 16;
#pragma unroll
                for (int bj = 0; bj < 2; ++bj) {
                    const f32x4 v0 = acc[ai][bj][m][0], v1 = acc[ai][bj][m][1];
                    u32x4 w; w.x = pg8::cvt_pk_bf16(v0[0], v0[1]); w.y = pg8::cvt_pk_bf16(v0[2], v0[3]); w.z = pg8::cvt_pk_bf16(v1[0], v1[1]); w.w = pg8::cvt_pk_bf16(v1[2], v1[3]);
                    *(u32x4*)(Q + (size_t)r * 2048 + col0 + bj * 128) = w;
                }
            }
    }
};

__device__ __forceinline__ void p0_transpose_item(const float* W, int K, int N, bf16* WT, const float* kscale, LAS float* scr, int item, int lane) {
    const int nblk = N / 32, kb = item / nblk, nb = item % nblk, k0 = 64 * kb, n0 = 32 * nb;
#pragma unroll 8
    for (int i = 0; i < 32; ++i) { const int kk = 2 * i + (lane >> 5); float v = W[(size_t)(k0 + kk) * N + n0 + (lane & 31)]; if (kscale) v *= kscale[k0 + kk]; scr[kk * 33 + (lane & 31)] = v; }
    LDS_WAIT(); asm volatile("" ::: "memory");
    const int c = lane & 7;
#pragma unroll
    for (int j = 0; j < 4; ++j) { const int n = (lane >> 3) + 8 * j; const LAS float* s = scr + (8 * c) * 33 + n;
        u32x4 o; o.x = pk2(s[0 * 33], s[1 * 33]); o.y = pk2(s[2 * 33], s[3 * 33]); o.z = pk2(s[4 * 33], s[5 * 33]); o.w = pk2(s[6 * 33], s[7 * 33]);
        *(u32x4*)(WT + (size_t)(n0 + n) * K + k0 + 8 * c) = o; }
    LDS_WAIT(); asm volatile("" ::: "memory");
}

__device__ __forceinline__ void norm_mod_row(const f32x4 (&v)[4][2], const float* gain, const float* scale, const float* shift, int lane, u32x4 (&o)[4]) {
    float s = 0.f;
#pragma unroll
    for (int j = 0; j < 4; ++j)
#pragma unroll
        for (int h = 0; h < 2; ++h) s += (v[j][h][0] * v[j][h][0] + v[j][h][1] * v[j][h][1]) + (v[j][h][2] * v[j][h][2] + v[j][h][3] * v[j][h][3]);
    const float rr = 1.0f / sqrtf(wave_sum(s) * (1.0f / DM) + EPS);
#pragma unroll
    for (int j = 0; j < 4; ++j) {
        const int c = j * 512 + lane * 8;
        f32x4 y[2];
#pragma unroll
        for (int h = 0; h < 2; ++h) {
            const f32x4 g = *(const f32x4*)(gain + c + 4 * h);
            y[h] = v[j][h] * rr * g;
            const f32x4 sc = *(const f32x4*)(scale + c + 4 * h), sh = *(const f32x4*)(shift + c + 4 * h); y[h] = y[h] * (sc + 1.0f) + sh;
        }
        o[j].x = pk2(y[0][0], y[0][1]); o[j].y = pk2(y[0][2], y[0][3]); o[j].z = pk2(y[1][0], y[1][1]); o[j].w = pk2(y[1][2], y[1][3]);
    }
}
__device__ __forceinline__ void norm_row_pass(const float* xrow, bf16* hrow, const float* gain, const float* scale, const float* shift, int lane) {
    f32x4 v[4][2];
#pragma unroll
    for (int j = 0; j < 4; ++j) { v[j][0] = *(const f32x4*)(xrow + j * 512 + lane * 8); v[j][1] = *(const f32x4*)(xrow + j * 512 + lane * 8 + 4); }
    u32x4 o[4]; norm_mod_row(v, gain, scale, shift, lane, o);
#pragma unroll
    for (int j = 0; j < 4; ++j) *(u32x4*)(hrow + j * 512 + lane * 8) = o[j];
}

__device__ __forceinline__ void p0_prologue(Frame& F) {
    PH_LOCALS
    const int gw = F.vcu * NWAVES + wave, NGW = F.G * NWAVES;
    const int gt = F.vcu * NTHR + tid, NGT = F.G * NTHR;
    if ((int)blockIdx.x < 192) {
        const int l = blockIdx.x / 96, cb = blockIdx.x % 96;
        LAS float* sc = (LAS float*)F.lds;
        LAS float* red = (LAS float*)(F.lds + 8192);
        for (int k = tid; k < DM; k += NTHR) { const float c = F.in[I_C][k]; sc[k] = c * fast_sigmoid(c); }
        __syncthreads();
        const int tx = tid & 31, ty = tid >> 5;
        const float* W = F.in[I_WMOD] + (size_t)l * DM * 12288 + cb * 128 + tx * 4;
        f32x4 a = {0.f, 0.f, 0.f, 0.f};
#pragma unroll 8
        for (int k = ty; k < DM; k += 16) { const f32x4 w = *(const f32x4*)(W + (size_t)k * 12288); a += w * sc[k]; }
        *(LAS f32x4*)(red + ty * 128 + tx * 4) = a;
        __syncthreads();
        if (tid < 128) { float s = 0.f;
#pragma unroll
            for (int y = 0; y < 16; ++y) s += red[y * 128 + tid];
            ((float*)(F.ws + WS_MOD))[l * 12288 + cb * 128 + tid] = s + F.in[I_BMOD][l * 12288 + cb * 128 + tid]; }
        __syncthreads();
    }
    if ((int)blockIdx.x >= 128) {
        const int u = 255 - (int)blockIdx.x, l = u >> 6, g = u & 63;
        LAS float* apr = (LAS float*)F.lds;
        LAS float* api = apr + 65 * 64;
        LAS float* bbr = api + 65 * 64;
        LAS float* bbi = bbr + 1024;
        LAS float* ccr = bbi + 1024;
        LAS float* cci = ccr + 1024;
        const float dt = expf(F.in[I_LDT][l * 64 + g]);
        const float* lre = F.in[I_LRE] + (l * 64 + g) * 64; const float* lim = F.in[I_LIM] + (l * 64 + g) * 64;
        for (int idx = tid; idx < 65 * 64; idx += NTHR) { const int d = idx >> 6, p = idx & 63;
            const float mag = expf(lre[p] * dt * (float)d); float sn, cs; sincosf(lim[p] * dt * (float)d, &sn, &cs);
            apr[idx] = mag * cs; api[idx] = mag * sn; }
        for (int idx = tid; idx < 1024; idx += NTHR) { const int o = idx >> 6, p = idx & 63;
            ccr[idx] = F.in[I_CRE][((size_t)(l * 64 + g) * 16 + o) * 64 + p]; cci[idx] = F.in[I_CIM][((size_t)(l * 64 + g) * 16 + o) * 64 + p]; }
        __syncthreads();
        for (int idx = tid; idx < 1024; idx += NTHR) { const int p = idx >> 4, i = idx & 15;
            const float xr = apr[64 + p] - 1.0f, xi = api[64 + p], lr = lre[p], li = lim[p], den = 1.0f / (lr * lr + li * li);
            const float cr = (xr * lr + xi * li) * den, ci = (xi * lr - xr * li) * den;
            const float br = F.in[I_BRE][((size_t)(l * 64 + g) * 64 + p) * 16 + i], bi = F.in[I_BIM][((size_t)(l * 64 + g) * 64 + p) * 16 + i];
            bbr[idx] = cr * br - ci * bi; bbi[idx] = cr * bi + ci * br; }
        __syncthreads();
        bf16* KT = (bf16*)(F.ws + WS_KTAB) + (size_t)(l * 64 + g) * 65 * 256;
        for (int idx = tid; idx < 65 * 256; idx += NTHR) {
            const int d = (idx >> 8) - 1, o = (idx >> 4) & 15, i = idx & 15; float s = 0.f;
            if (d >= 0) {
                for (int p = 0; p < 64; ++p) { const float ar = apr[d * 64 + p], ai = api[d * 64 + p], cr = ccr[o * 64 + p], ci = cci[o * 64 + p];
                    const float er = cr * ar - ci * ai, ei = cr * ai + ci * ar; s += er * bbr[p * 16 + i] - ei * bbi[p * 16 + i]; }
#if !SELFTEST_S5
                if (d == 0 && o == i) s += F.in[I_SD][l * 1024 + g * 16 + o];
#endif
            }
            KT[idx] = (bf16)f2bf(s);
        }
        bf16* WG = (bf16*)(F.ws + WS_WG) + (size_t)(l * 64 + g) * 128 * 1024;
        for (int idx = tid; idx < 64 * 1024; idx += NTHR) { const int p = idx >> 10, k = idx & 1023, tau = k >> 4, i = k & 15;
            const float ar = apr[(63 - tau) * 64 + p], ai = api[(63 - tau) * 64 + p], br = bbr[p * 16 + i], bi = bbi[p * 16 + i];
            WG[(size_t)p * 1024 + k] = (bf16)f2bf(ar * br - ai * bi); WG[(size_t)(64 + p) * 1024 + k] = (bf16)f2bf(ar * bi + ai * br); }
        bf16* VG = (bf16*)(F.ws + WS_VG) + (size_t)(l * 64 + g) * 1024 * 128;
        for (int idx = tid; idx < 1024 * 64; idx += NTHR) { const int m = idx >> 6, p = idx & 63, t = m >> 4, o = m & 15;
            const float ar = apr[(t + 1) * 64 + p], ai = api[(t + 1) * 64 + p], cr = ccr[o * 64 + p], ci = cci[o * 64 + p];
            VG[(size_t)m * 128 + p] = (bf16)f2bf(cr * ar - ci * ai); VG[(size_t)m * 128 + 64 + p] = (bf16)f2bf(-(cr * ai + ci * ar)); }
        if (tid < 64) { float* AT = (float*)(F.ws + WS_AT) + ((size_t)(l * 64 + g) * 64 + tid) * 2; AT[0] = apr[64 * 64 + tid]; AT[1] = api[64 * 64 + tid]; }
        __syncthreads();
    }
    {
        LAS float* scr = (LAS float*)(F.lds + wave * 16384);
        constexpr int I_IN = (DM / 64) * (INW / 32), I_GL = (WB / 64) * (WB / 32), I_OU = (DM / 64) * (DM / 32), I_Q = I_OU;
        constexpr int PER_L = I_IN + I_GL + I_OU + I_Q;
        for (int it = gw; it < 2 * PER_L; it += NGW) {
            const int l = it / PER_L; int r = it % PER_L;
            if (r < I_IN) { p0_transpose_item(F.in[I_WIN] + (size_t)l * DM * INW, DM, INW, (bf16*)(F.ws + WS_WIN) + (size_t)l * INW * DM, nullptr, scr, r, lane); continue; } r -= I_IN;
            if (r < I_GL) { p0_transpose_item(F.in[I_GLUW] + (size_t)l * WB * WB, WB, WB, (bf16*)(F.ws + WS_GLU) + (size_t)l * WB * WB, nullptr, scr, r, lane); continue; } r -= I_GL;
            if (r < I_OU) { p0_transpose_item(F.in[I_WOUT] + (size_t)l * DM * DM, DM, DM, (bf16*)(F.ws + WS_WOUT) + (size_t)l * DM * DM, F.in[I_BRG] + l * DM, scr, r, lane); continue; } r -= I_OU;
            p0_transpose_item(F.in[I_WQ] + (size_t)l * DM * DM, DM, DM, (bf16*)(F.ws + WS_WQ) + (size_t)l * DM * DM, nullptr, scr, r, lane);
        }
    }
    {
        bf16* KB = (bf16*)(F.ws + WS_KEYS);
        for (int i = gt; i < 2 * 8 * 2 * 128 * 128 / 8; i += NGT) { const f32x4 a = *(const f32x4*)(F.in[I_KEYS] + (size_t)i * 8), b = *(const f32x4*)(F.in[I_KEYS] + (size_t)i * 8 + 4);
            u32x4 o; o.x = pk2(a[0], a[1]); o.y = pk2(a[2], a[3]); o.z = pk2(b[0], b[1]); o.w = pk2(b[2], b[3]); *(u32x4*)(KB + (size_t)i * 8) = o; }
        bf16* GW = (bf16*)(F.ws + WS_GWS);
        for (int i = gt; i < 2 * 8 * 128 * 128 / 8; i += NGT) { const int e = i * 8, jj = e & 127, ii = (e >> 7) & 127; const bool keep = (ii >= 64) || (jj < 64);
            f32x4 a = *(const f32x4*)(F.in[I_GWS] + (size_t)i * 8), b = *(const f32x4*)(F.in[I_GWS] + (size_t)i * 8 + 4);
            if (!keep) { a = (f32x4){0.f, 0.f, 0.f, 0.f}; b = a; }
            u32x4 o; o.x = pk2(a[0], a[1]); o.y = pk2(a[2], a[3]); o.z = pk2(b[0], b[1]); o.w = pk2(b[2], b[3]); *(u32x4*)(GW + (size_t)i * 8) = o; }
        unsigned char* UV = F.ws + WS_UV;
        const size_t nchunk = (size_t)2 * NEXP * 2048 / 16;
        for (size_t i = gt; i < nchunk; i += NGT) {
            const size_t row = i >> 7, c16 = i & 127;
            u32x4 o, q;
#pragma unroll
            for (int d = 0; d < 4; ++d) {
                const f32x4 a = *(const f32x4*)(F.in[I_PU] + i * 16 + 4 * d), c = *(const f32x4*)(F.in[I_PV] + i * 16 + 4 * d);
                int w = 0; w = __builtin_amdgcn_cvt_pk_fp8_f32(a[0] * 64.0f, a[1] * 64.0f, w, false); w = __builtin_amdgcn_cvt_pk_fp8_f32(a[2] * 64.0f, a[3] * 64.0f, w, true); o[d] = (unsigned)w;
                int x = 0; x = __builtin_amdgcn_cvt_pk_fp8_f32(c[0], c[1], x, false); x = __builtin_amdgcn_cvt_pk_fp8_f32(c[2], c[3], x, true); q[d] = (unsigned)x;
            }
            *(u32x4*)(UV + row * 4096 + c16 * 16) = o;
            *(u32x4*)(UV + row * 4096 + 2048 + c16 * 16) = q;
        }
    }
}

__device__ __forceinline__ void phase_norm(Frame& F, const float* xsrc, const float* gain, const float* scale, const float* shift) {
    PH_LOCALS
    const int gw = F.vcu * NWAVES + wave, NGW = F.G * NWAVES;
    bf16* H = (bf16*)(F.ws + WS_H);
    for (int m = gw; m < M; m += NGW) norm_row_pass(xsrc + (size_t)m * DM, H + (size_t)m * DM, gain, scale, shift, lane);
}
__device__ __forceinline__ void phase_lnstats(Frame& F) {
    PH_LOCALS
    const int gw = F.vcu * NWAVES + wave, NGW = F.G * NWAVES;
    const bf16* Z = (const bf16*)(F.ws + WS_Z); float* ST = (float*)(F.ws + WS_STATS);
    for (int m = gw; m < M; m += NGW) {
        float v[16];
#pragma unroll
        for (int j = 0; j < 2; ++j) { const u32x4 w = *(const u32x4*)(Z + (size_t)m * 2048 + 1024 + j * 512 + lane * 8);
            v[j * 8 + 0] = bflo(w.x); v[j * 8 + 1] = bfhi(w.x); v[j * 8 + 2] = bflo(w.y); v[j * 8 + 3] = bfhi(w.y); v[j * 8 + 4] = bflo(w.z); v[j * 8 + 5] = bfhi(w.z); v[j * 8 + 6] = bflo(w.w); v[j * 8 + 7] = bfhi(w.w); }
        float s = 0.f;
#pragma unroll
        for (int i = 0; i < 16; ++i) s += v[i];
        const float mean = wave_sum(s) * (1.0f / 1024.0f); float q = 0.f;
#pragma unroll
        for (int i = 0; i < 16; ++i) { const float d = v[i] - mean; q += d * d; }
        const float rstd = 1.0f / sqrtf(wave_sum(q) * (1.0f / 1024.0f) + EPS);
        if (lane == 0) { ST[2 * m] = mean; ST[2 * m + 1] = rstd; }
    }
}
__device__ __forceinline__ void phase_branchnorm(Frame& F) {
    PH_LOCALS
    const int gw = F.vcu * NWAVES + wave, NGW = F.G * NWAVES;
    bf16* MIX = (bf16*)(F.ws + WS_MIX);
    for (int m = gw; m < M; m += NGW) {
        u32x4 w[4]; float sa = 0.f, sb = 0.f;
#pragma unroll
        for (int j = 0; j < 4; ++j) { w[j] = *(const u32x4*)(MIX + (size_t)m * 2048 + j * 512 + lane * 8);
            float q = 0.f;
#pragma unroll
            for (int e = 0; e < 4; ++e) { const float a = bflo(w[j][e]), b = bfhi(w[j][e]); q += a * a + b * b; }
            if (j < 2) sa += q; else sb += q; }
        const float ra = 1.0f / sqrtf(wave_sum(sa) * (1.0f / 1024.0f) + EPS), rb = 1.0f / sqrtf(wave_sum(sb) * (1.0f / 1024.0f) + EPS);
#pragma unroll
        for (int j = 0; j < 4; ++j) { const float r = j < 2 ? ra : rb; u32x4 o;
#pragma unroll
            for (int e = 0; e < 4; ++e) o[e] = pk2(bflo(w[j][e]) * r, bfhi(w[j][e]) * r);
            *(u32x4*)(MIX + (size_t)m * 2048 + j * 512 + lane * 8) = o; }
    }
}

__device__ __forceinline__ void phase_sloc(Frame& F, int l) {
    PH_LOCALS
    const bf16* XS = (const bf16*)(F.ws + WS_XS); const bf16* WG = (const bf16*)(F.ws + WS_WG) + (size_t)l * 64 * 128 * 1024; float* SL = (float*)(F.ws + WS_SLOC);
    const int fr = lane & 15, fq = lane >> 4;
    for (int u = F.vcu; u < 256; u += F.G) {
        const int g = u >> 2, n0 = (u & 3) * 64 + (wave & 3) * 16, jh = wave >> 2;
        f32x4 acc[4];
#pragma unroll
        for (int t = 0; t < 4; ++t) acc[t] = (f32x4){0.f, 0.f, 0.f, 0.f};
        const bf16* xp = XS + ((size_t)(g * 256 + n0 + fr)) * 1024 + 8 * fq;
        const bf16* wp = WG + ((size_t)(g * 128 + jh * 64 + fr)) * 1024 + 8 * fq;
#pragma unroll 4
        for (int kb = 0; kb < 32; ++kb) {
            const bf16x8 xf = *(const bf16x8*)(xp + kb * 32);
#pragma unroll
            for (int t = 0; t < 4; ++t) { const bf16x8 wf = *(const bf16x8*)(wp + (size_t)t * 16 * 1024 + kb * 32); acc[t] = __builtin_amdgcn_mfma_f32_16x16x32_bf16(wf, xf, acc[t], 0, 0, 0); }
        }
#pragma unroll
        for (int t = 0; t < 4; ++t) *(f32x4*)(SL + ((size_t)(g * 256 + n0 + fr)) * 128 + jh * 64 + t * 16 + 4 * fq) = acc[t];
    }
}
__device__ __forceinline__ void s5_carry(Frame& F, int l) {
    PH_LOCALS
    if (F.vcu < 64 && wave == 0) {
        const int g = F.vcu, p = lane;
        const float* AT = (const float*)(F.ws + WS_AT) + ((size_t)(l * 64 + g) * 64 + p) * 2; const float ar = AT[0], ai = AT[1];
        const float* SL = (const float*)(F.ws + WS_SLOC) + (size_t)g * 256 * 128; bf16* HS = (bf16*)(F.ws + WS_HS) + (size_t)g * 256 * 128;
        float hr = 0.f, hi = 0.f;
        for (int n0 = 0; n0 < 256; n0 += 8) {
            float sr[8], si[8];
#pragma unroll
            for (int e = 0; e < 8; ++e) { sr[e] = SL[(size_t)(n0 + e) * 128 + p]; si[e] = SL[(size_t)(n0 + e) * 128 + 64 + p]; }
#pragma unroll
            for (int e = 0; e < 8; ++e) { HS[(size_t)(n0 + e) * 128 + p] = (bf16)f2bf(hr); HS[(size_t)(n0 + e) * 128 + 64 + p] = (bf16)f2bf(hi);
                const float nr = ar * hr - ai * hi + sr[e], ni = ar * hi + ai * hr + si[e]; hr = nr; hi = ni; }
        }
    }
}

__device__ __forceinline__ void gating_unit(Frame& F, int l, int unit) {
    PH_LOCALS
    const int nb = unit >> 3, hh = unit & 7, t0 = nb * 128, c0 = hh * 128;
    const bf16* Z = (const bf16*)(F.ws + WS_Z); const float* ST = (const float*)(F.ws + WS_STATS);
    const bf16* GW = (const bf16*)(F.ws + WS_GWS) + (size_t)(l * 8 + hh) * 128 * 128;
    bf16* MIX = (bf16*)(F.ws + WS_MIX);
    LAS bf16* VT = (LAS bf16*)F.lds;
    constexpr int VS = 136;
    {
        const int j = tid >> 2, cs = (tid & 3) * 32;
        const float mu = ST[2 * (t0 + j)], rs = ST[2 * (t0 + j) + 1];
        const float* lg = F.in[I_LNG] + l * 1024 + c0 + cs; const float* lb = F.in[I_LNB] + l * 1024 + c0 + cs;
#pragma unroll
        for (int q = 0; q < 4; ++q) {
            const u32x4 w = *(const u32x4*)(Z + (size_t)(t0 + j) * 2048 + 1024 + c0 + cs + q * 8);
#pragma unroll
            for (int e = 0; e < 4; ++e) { const int c = cs + q * 8 + 2 * e;
                const float a = (bflo(w[e]) - mu) * rs * lg[q * 8 + 2 * e] + lb[q * 8 + 2 * e], b = (bfhi(w[e]) - mu) * rs * lg[q * 8 + 2 * e + 1] + lb[q * 8 + 2 * e + 1];
                VT[c * VS + j] = (bf16)f2bf(a); VT[(c + 1) * VS + j] = (bf16)f2bf(b); }
        }
    }
    __syncthreads();
    {
        const int fr = lane & 15, fq = lane >> 4, w = wave;
        f32x4 acc[8];
#pragma unroll
        for (int ct = 0; ct < 8; ++ct) acc[ct] = (f32x4){0.f, 0.f, 0.f, 0.f};
        const int nkb = (w < 4) ? 2 : 4;
        for (int kb = 0; kb < nkb; ++kb) {
            const bf16x8 wf = *(const bf16x8*)(GW + (size_t)(16 * w + fr) * 128 + kb * 32 + 8 * fq);
#pragma unroll
            for (int ct = 0; ct < 8; ++ct) { const bf16x8 vf = *(const LAS bf16x8*)(VT + (ct * 16 + fr) * VS + kb * 32 + 8 * fq); acc[ct] = __builtin_amdgcn_mfma_f32_16x16x32_bf16(vf, wf, acc[ct], 0, 0, 0); }
        }
        const int tok = t0 + 16 * w + fr; const float bs = F.in[I_GBS][(l * 8 + hh) * 128 + 16 * w + fr];
#pragma unroll
        for (int ct = 0; ct < 8; ++ct) { const int c = c0 + ct * 16 + 4 * fq;
            const u32x2 uw = *(const u32x2*)(Z + (size_t)tok * 2048 + c);
            u32x2 o; o.x = pk2(bflo(uw.x) * (acc[ct][0] + bs), bfhi(uw.x) * (acc[ct][1] + bs)); o.y = pk2(bflo(uw.y) * (acc[ct][2] + bs), bfhi(uw.y) * (acc[ct][3] + bs));
            *(u32x2*)(MIX + (size_t)tok * 2048 + c) = o; }
    }
    __syncthreads();
}
__device__ __forceinline__ void phase_carry_gating(Frame& F, int l, int qi) {
    PH_LOCALS
    s5_carry(F, l);
    unsigned* head = (unsigned*)(F.ws + WS_CTL) + CW_QUEUE + 64 * qi;
    LAS unsigned* slot = (LAS unsigned*)(F.lds + MISC_OFF) + 16;
    for (;;) {
        __syncthreads();
        if (tid == 0) slot[0] = __hip_atomic_fetch_add(head, 1u, RLX_AGENT);
        __syncthreads();
        const unsigned u = slot[0];
        if (u >= 1024u) break;
        gating_unit(F, l, (int)u);
    }
}

__device__ __forceinline__ void phase_s5out(Frame& F, int l) {
    PH_LOCALS
    const bf16* XS = (const bf16*)(F.ws + WS_XS); const bf16* HS = (const bf16*)(F.ws + WS_HS);
    bf16* Gb = (bf16*)(F.ws + WS_G);
    LAS bf16* KT = (LAS bf16*)F.lds;
    const int fr = lane & 15, fq = lane >> 4;
    for (int u = F.vcu; u < 512; u += F.G) {
        const int g = u >> 3, rc = (u >> 1) & 3, nh = u & 1;
        __syncthreads();
        { const u32x4* src = (const u32x4*)((const bf16*)(F.ws + WS_KTAB) + (size_t)(l * 64 + g) * 65 * 256);
          for (int i = tid; i < 65 * 256 / 8; i += NTHR) ((LAS u32x4*)KT)[i] = src[i]; }
        __syncthreads();
        const bf16* VG = (const bf16*)(F.ws + WS_VG) + (size_t)(l * 64 + g) * 1024 * 128;
        const int n = nh * 128 + 16 * wave + fr;
        f32x4 acc[16];
#pragma unroll
        for (int q = 0; q < 16; ++q) acc[q] = (f32x4){0.f, 0.f, 0.f, 0.f};
        const bf16* xp0 = XS + ((size_t)(g * 256 + n)) * 1024 + 8 * fq;
        bf16x8 x0 = *(const bf16x8*)xp0;
        for (int kb = 0; kb < 32; ++kb) {
            const int tau0 = 2 * kb;
            const bf16x8 c0 = x0;
            if (kb < 31) x0 = *(const bf16x8*)(xp0 + (kb + 1) * 32);
#pragma unroll
            for (int q = 0; q < 16; ++q) {
                const int t = rc + 4 * q;
                if (t >= tau0) {
                    const int d1 = t - tau0 - (fq >> 1) + 1;
                    const bf16x8 kf = *(const LAS bf16x8*)(KT + (d1 * 16 + fr) * 16 + 8 * (fq & 1));
                    acc[q] = __builtin_amdgcn_mfma_f32_16x16x32_bf16(kf, c0, acc[q], 0, 0, 0);
                }
            }
        }
        const bf16* hp0 = HS + ((size_t)(g * 256 + n)) * 128 + 8 * fq;
        for (int jb = 0; jb < 4; ++jb) {
            const bf16x8 h0 = *(const bf16x8*)(hp0 + jb * 32);
#pragma unroll
            for (int q = 0; q < 16; ++q) {
                const int t = rc + 4 * q;
                const bf16x8 vf = *(const bf16x8*)(VG + (size_t)(t * 16 + fr) * 128 + jb * 32 + 8 * fq);
                acc[q] = __builtin_amdgcn_mfma_f32_16x16x32_bf16(vf, h0, acc[q], 0, 0, 0);
            }
        }
#pragma unroll
        for (int q = 0; q < 16; ++q) {
            const int t = rc + 4 * q, tok = 64 * n + t;
            const f32x4 y = acc[q];
            u32x2 o; o.x = pk2(gelu_tanh(y[0]), gelu_tanh(y[1])); o.y = pk2(gelu_tanh(y[2]), gelu_tanh(y[3]));
            *(u32x2*)(Gb + (size_t)tok * 1024 + g * 16 + 4 * fq) = o;
#if SELFTEST_S5
            if (tok < 256) *(f32x4*)((float*)(F.ws + WS_DBG) + (size_t)tok * 1024 + g * 16 + 4 * fq) = y;
#endif
        }
    }
}
#if SELFTEST_S5
__device__ __forceinline__ void selftest_s5(Frame& F, int l) {
    PH_LOCALS
    if (F.vcu < 64 && wave == 0) {
        const int g = F.vcu, p = lane;
        const float dt = expf(F.in[I_LDT][l * 64 + g]);
        const float lr = F.in[I_LRE][(l * 64 + g) * 64 + p], li = F.in[I_LIM][(l * 64 + g) * 64 + p];
        const float mag = expf(lr * dt); float sn, cs; sincosf(li * dt, &sn, &cs);
        const float ar = mag * cs, ai = mag * sn;
        const float xr = ar - 1.0f, xi = ai, den = 1.0f / (lr * lr + li * li);
        const float cr = (xr * lr + xi * li) * den, ci = (xi * lr - xr * li) * den;
        float bbr[16], bbi[16], ccr[16], cci[16];
#pragma unroll
        for (int i = 0; i < 16; ++i) { const float br = F.in[I_BRE][((size_t)(l * 64 + g) * 64 + p) * 16 + i], bi = F.in[I_BIM][((size_t)(l * 64 + g) * 64 + p) * 16 + i];
            bbr[i] = cr * br - ci * bi; bbi[i] = cr * bi + ci * br;
            ccr[i] = F.in[I_CRE][((size_t)(l * 64 + g) * 16 + i) * 64 + p]; cci[i] = F.in[I_CIM][((size_t)(l * 64 + g) * 16 + i) * 64 + p]; }
        const bf16* XS = (const bf16*)(F.ws + WS_XS) + (size_t)g * 256 * 1024;
        const float* DY = (const float*)(F.ws + WS_DBG);
        float sr = 0.f, si = 0.f, err = 0.f, ref = 0.f;
        for (int t = 0; t < 256; ++t) {
            float x[16];
#pragma unroll
            for (int i = 0; i < 16; ++i) x[i] = bflo((unsigned)XS[(size_t)t * 16 + i]);
            float ur = 0.f, ui = 0.f;
#pragma unroll
            for (int i = 0; i < 16; ++i) { ur += bbr[i] * x[i]; ui += bbi[i] * x[i]; }
            const float nr = ar * sr - ai * si + ur, ni = ar * si + ai * sr + ui; sr = nr; si = ni;
#pragma unroll
            for (int o = 0; o < 16; ++o) {
                const float yr = wave_sum(ccr[o] * sr - cci[o] * si);
                const float yf = DY[(size_t)t * 1024 + g * 16 + o];
                err += (yf - yr) * (yf - yr); ref += yr * yr;
            }
        }
        if (lane == 0 && !(err <= 2e-3f * ref)) __hip_atomic_fetch_or((unsigned*)(F.ws + WS_CTL) + CW_FLAG, 1u, RLX_AGENT);
    }
}
#endif

__device__ __forceinline__ unsigned f2key(float v) { const unsigned u = __builtin_bit_cast(unsigned, v); return (u & 0x80000000u) ? ~u : (u | 0x80000000u); }
__device__ __forceinline__ float key2f(unsigned k) { const unsigned u = (k & 0x80000000u) ? (k & 0x7fffffffu) : ~k; return __builtin_bit_cast(float, u); }
__device__ __forceinline__ void phase_topk(Frame& F, int l) {
    PH_LOCALS
    const bf16* Q = (const bf16*)(F.ws + WS_Z);
    const bf16* KB = (const bf16*)(F.ws + WS_KEYS) + (size_t)l * 8 * 2 * 128 * 128;
    int* EID = (int*)(F.ws + WS_EID); float* GT = (float*)(F.ws + WS_GATE);
    LAS float* SC = (LAS float*)F.lds;
    LAS unsigned* LST = (LAS unsigned*)(F.lds + 128 * 260 * 4);
    const int fr = lane & 15, fq = lane >> 4;
    for (int u = F.vcu; u < 1024; u += F.G) {
        const int tt = u >> 3, hh = u & 7, t0 = tt * 128;
        __syncthreads();
        {
            f32x4 acc[2][8];
#pragma unroll
            for (int s = 0; s < 2; ++s)
#pragma unroll
                for (int nt = 0; nt < 8; ++nt) acc[s][nt] = (f32x4){0.f, 0.f, 0.f, 0.f};
#pragma unroll
            for (int s = 0; s < 2; ++s)
#pragma unroll
                for (int kb = 0; kb < 4; ++kb) {
                    const bf16x8 qf = *(const bf16x8*)(Q + (size_t)(t0 + 16 * wave + fr) * 2048 + hh * 256 + s * 128 + kb * 32 + 8 * fq);
#pragma unroll
                    for (int nt = 0; nt < 8; ++nt) { const bf16x8 kf = *(const bf16x8*)(KB + ((size_t)((hh * 2 + s) * 128 + nt * 16 + fr)) * 128 + kb * 32 + 8 * fq);
                        acc[s][nt] = __builtin_amdgcn_mfma_f32_16x16x32_bf16(kf, qf, acc[s][nt], 0, 0, 0); }
                }
#pragma unroll
            for (int s = 0; s < 2; ++s)
#pragma unroll
                for (int nt = 0; nt < 8; ++nt) *(LAS f32x4*)(SC + (16 * wave + fr) * 260 + s * 128 + nt * 16 + 4 * fq) = acc[s][nt];
        }
        __syncthreads();
        if (tid < 256) {
            const int tl = tid >> 1, s = tid & 1;
            unsigned top[16];
#pragma unroll
            for (int k = 0; k < 16; ++k) top[k] = 0u;
            const LAS float* row = SC + tl * 260 + s * 128;
            for (int n4 = 0; n4 < 32; ++n4) {
                const f32x4 v = *(const LAS f32x4*)(row + 4 * n4);
#pragma unroll
                for (int e = 0; e < 4; ++e) {
                    unsigned key = (f2key(v[e]) & ~0x7Fu) | (unsigned)(127 - (4 * n4 + e));
#pragma unroll
                    for (int k = 0; k < 16; ++k) { const unsigned hi = top[k] > key ? top[k] : key, lo = top[k] > key ? key : top[k]; top[k] = hi; key = lo; }
                }
            }
#pragma unroll
            for (int k = 0; k < 16; k += 4) *(LAS u32x4*)(LST + (tl * 2 + s) * 16 + k) = (u32x4){top[k], top[k + 1], top[k + 2], top[k + 3]};
        }
        __syncthreads();
        if (tid < 128) {
            const int tl = tid;
            float av[16], bv[16];
#pragma unroll
            for (int k = 0; k < 16; ++k) { av[k] = key2f(LST[(tl * 2 + 0) * 16 + k] & ~0x7Fu); bv[k] = key2f(LST[(tl * 2 + 1) * 16 + k] & ~0x7Fu); }
            unsigned top[16];
#pragma unroll
            for (int k = 0; k < 16; ++k) top[k] = 0u;
#pragma unroll
            for (int i = 0; i < 16; ++i)
#pragma unroll
                for (int j = 0; j < 16; ++j)
                    if ((i + 1) * (j + 1) <= 16) {
                        unsigned key = (f2key(av[i] + bv[j]) & ~0xFFu) | (unsigned)(255 - (i * 16 + j));
#pragma unroll
                        for (int k = 0; k < 16; ++k) { const unsigned hi = top[k] > key ? top[k] : key, lo = top[k] > key ? key : top[k]; top[k] = hi; key = lo; }
                    }
            float ev[16]; float sum = 0.f; const float mx = key2f(top[0] & ~0xFFu);
#pragma unroll
            for (int k = 0; k < 16; ++k) { ev[k] = __expf(key2f(top[k] & ~0xFFu) - mx); sum += ev[k]; }
            const float inv = 1.0f / sum;
            int* eo = EID + (size_t)(t0 + tl) * 128 + hh * 16; float* go = GT + (size_t)(t0 + tl) * 128 + hh * 16;
#pragma unroll
            for (int k = 0; k < 16; ++k) { const int flat = 255 - (int)(top[k] & 0xFFu), i = flat >> 4, j = flat & 15;
                const int ia = 127 - (int)(LST[(tl * 2 + 0) * 16 + i] & 0x7Fu), ib = 127 - (int)(LST[(tl * 2 + 1) * 16 + j] & 0x7Fu);
                eo[k] = ia * 128 + ib; go[k] = ev[k] * inv; }
        }
    }
    __syncthreads();
}

__device__ __forceinline__ void phase_gather(Frame& F, int l, bool dummy = false) {
    PH_LOCALS
    const int gw = F.vcu * NWAVES + wave, NGW = F.G * NWAVES;
    const bf16* H = (const bf16*)(F.ws + WS_H); bf16* Hn = dummy ? (bf16*)(F.ws + WS_DBG + 128 * MiB) : (bf16*)(F.ws + WS_H);
    const unsigned char* UV = F.ws + WS_UV + (size_t)l * NEXP * 4096;
    const int* EID = (const int*)(F.ws + WS_EID); const float* GT = (const float*)(F.ws + WS_GATE);
    const float* X = (const float*)(F.ws + WS_X); float* Xo = dummy ? (float*)(F.ws + WS_DBG) : (float*)(F.ws + WS_X);
    const float* mod = (const float*)(F.ws + WS_MOD);
    const float* gate2 = mod + l * 12288 + 5 * 2048;
    const unsigned lane16 = (unsigned)lane * 16u;
    for (int t = gw; t < M; t += NGW) {
        const int e_lo = EID[(size_t)t * 128 + lane], e_hi = EID[(size_t)t * 128 + 64 + lane];
        const float g_lo = GT[(size_t)t * 128 + lane], g_hi = GT[(size_t)t * 128 + 64 + lane];
        f32x2 hh[2][4][2];
#pragma unroll
        for (int j = 0; j < 2; ++j) {
            const u32x4 w0 = *(const u32x4*)(H + (size_t)t * 2048 + j * 1024 + lane * 16), w1 = *(const u32x4*)(H + (size_t)t * 2048 + j * 1024 + lane * 16 + 8);
#pragma unroll
            for (int q = 0; q < 2; ++q) { hh[j][q][0] = (f32x2){bflo(w0[2 * q]), bfhi(w0[2 * q])}; hh[j][q][1] = (f32x2){bflo(w0[2 * q + 1]), bfhi(w0[2 * q + 1])};
                hh[j][2 + q][0] = (f32x2){bflo(w1[2 * q]), bfhi(w1[2 * q])}; hh[j][2 + q][1] = (f32x2){bflo(w1[2 * q + 1]), bfhi(w1[2 * q + 1])}; }
        }
        f32x2 of[2][4][2];
#pragma unroll
        for (int j = 0; j < 2; ++j)
#pragma unroll
            for (int q = 0; q < 4; ++q) { of[j][q][0] = (f32x2){0.f, 0.f}; of[j][q][1] = (f32x2){0.f, 0.f}; }
        for (int b = 0; b < 16; ++b) {
            const int esel = b < 8 ? e_lo : e_hi; const float gsel = b < 8 ? g_lo : g_hi;
            u32x4 ur[8][2], vr[8][2];
#pragma unroll
            for (int h = 0; h < 8; ++h) {
                const int e = __builtin_amdgcn_readlane(esel, (8 * b + h) & 63);
                const unsigned char* rowp = UV + ((size_t)(unsigned)e << 12);
#pragma unroll
                for (int j = 0; j < 2; ++j) { ur[h][j] = *(const u32x4*)(rowp + lane16 + j * 1024); vr[h][j] = *(const u32x4*)(rowp + lane16 + 2048 + j * 1024); }
            }
            float p[8];
#pragma unroll
            for (int h = 0; h < 8; ++h) {
                f32x2 a2 = {0.f, 0.f};
#pragma unroll
                for (int j = 0; j < 2; ++j)
#pragma unroll
                    for (int q = 0; q < 4; ++q) {
                        const f32x2 lo = __builtin_amdgcn_cvt_pk_f32_fp8((int)ur[h][j][q], false), hi = __builtin_amdgcn_cvt_pk_f32_fp8((int)ur[h][j][q], true);
                        a2 = lo * hh[j][q][0] + a2; a2 = hi * hh[j][q][1] + a2;
                    }
                p[h] = a2.x + a2.y;
            }
            const bool u32_ = (lane & 32) != 0, u16_ = (lane & 16) != 0, u8_ = (lane & 8) != 0;
            float a4[4];
#pragma unroll
            for (int i = 0; i < 4; ++i) { const float snd = u32_ ? p[i] : p[4 + i], kp = u32_ ? p[4 + i] : p[i]; a4[i] = kp + __shfl_xor(snd, 32); }
            float b2[2];
#pragma unroll
            for (int i = 0; i < 2; ++i) { const float snd = u16_ ? a4[i] : a4[2 + i], kp = u16_ ? a4[2 + i] : a4[i]; b2[i] = kp + __shfl_xor(snd, 16); }
            float d;
            { const float snd = u8_ ? b2[0] : b2[1], kp = u8_ ? b2[1] : b2[0]; d = kp + __shfl_xor(snd, 8); }
            d += __shfl_xor(d, 4); d += __shfl_xor(d, 2); d += __shfl_xor(d, 1);
            const float gq = __shfl(gsel, (8 * b + (lane >> 3)) & 63);
            const float coefq = gq * gelu_tanh(d * (1.0f / 64.0f));
#pragma unroll
            for (int h = 0; h < 8; ++h) {
                const float cf = __builtin_bit_cast(float, __builtin_amdgcn_readlane(__builtin_bit_cast(int, coefq), 8 * h));
                const f32x2 cf2 = {cf, cf};
#pragma unroll
                for (int j = 0; j < 2; ++j)
#pragma unroll
                    for (int q = 0; q < 4; ++q) {
                        const f32x2 lo = __builtin_amdgcn_cvt_pk_f32_fp8((int)vr[h][j][q], false), hi = __builtin_amdgcn_cvt_pk_f32_fp8((int)vr[h][j][q], true);
                        of[j][q][0] = lo * cf2 + of[j][q][0]; of[j][q][1] = hi * cf2 + of[j][q][1];
                    }
            }
        }
        int ln = lane; asm volatile("" : "+v"(ln));
        f32x4 xv[2][4]; float ss = 0.f;
#pragma unroll
        for (int j = 0; j < 2; ++j)
#pragma unroll
            for (int q = 0; q < 4; ++q) {
                const int c = j * 1024 + ln * 16 + 4 * q;
                const f32x4 xo = *(const f32x4*)(X + (size_t)t * 2048 + c), g2 = *(const f32x4*)(gate2 + c);
                const f32x4 o = {of[j][q][0].x, of[j][q][0].y, of[j][q][1].x, of[j][q][1].y};
                xv[j][q] = xo + g2 * o;
                ss += (xv[j][q][0] * xv[j][q][0] + xv[j][q][1] * xv[j][q][1]) + (xv[j][q][2] * xv[j][q][2] + xv[j][q][3] * xv[j][q][3]);
            }
        const float rr = 1.0f / sqrtf(wave_sum(ss) * (1.0f / DM) + EPS);
        if (l + 1 < DEPTH) {
            const float* m2 = mod + (l + 1) * 12288; const float* gain = F.in[I_N1G] + (l + 1) * 2048;
#pragma unroll
            for (int j = 0; j < 2; ++j) {
                unsigned w[8];
#pragma unroll
                for (int q = 0; q < 4; ++q) {
                    const int c = j * 1024 + ln * 16 + 4 * q;
                    *(f32x4*)(Xo + (size_t)t * 2048 + c) = xv[j][q];
                    const f32x4 g = *(const f32x4*)(gain + c), sc = *(const f32x4*)(m2 + 2048 + c), sh = *(const f32x4*)(m2 + c);
                    const f32x4 y = xv[j][q] * rr * g * (sc + 1.0f) + sh;
                    w[2 * q] = pk2(y[0], y[1]); w[2 * q + 1] = pk2(y[2], y[3]);
                }
                *(u32x4*)(Hn + (size_t)t * 2048 + j * 1024 + ln * 16) = (u32x4){w[0], w[1], w[2], w[3]};
                *(u32x4*)(Hn + (size_t)t * 2048 + j * 1024 + ln * 16 + 8) = (u32x4){w[4], w[5], w[6], w[7]};
            }
        } else {
#pragma unroll
            for (int j = 0; j < 2; ++j)
#pragma unroll
                for (int q = 0; q < 4; ++q) { const int c = j * 1024 + ln * 16 + 4 * q; const f32x4 fg = *(const f32x4*)(F.in[I_FG] + c);
                    f32x4 ov = xv[j][q] * rr * fg;
#if SELFTEST_S5
                    if (__hip_atomic_load((unsigned*)(F.ws + WS_CTL) + CW_FLAG, RLX_AGENT) != 0u) ov = (f32x4){1e30f, 1e30f, 1e30f, 1e30f};
#endif
                    *(f32x4*)(F.out + (size_t)t * 2048 + c) = ov; }
        }
    }
}

__global__ void __launch_bounds__(NTHR, 2) fwd_kernel(Args args) {
    extern __shared__ __attribute__((aligned(16))) unsigned char lds_raw[];
    Frame F;
    F.lds = (LAS unsigned char*)lds_raw; F.ws = args.ws; F.in = args.in; F.out = args.out;
    F.tid = threadIdx.x; F.lane = F.tid & 63; F.wave = __builtin_amdgcn_readfirstlane(F.tid >> 6);
    F.G = gridDim.x; { const int bx = blockIdx.x; F.vcu = (F.G % 8 == 0) ? (bx % 8) * (F.G / 8) + bx / 8 : bx; }
    volatile LAS unsigned* MISC = (volatile LAS unsigned*)(F.lds + MISC_OFF);
    if (F.tid < 64) MISC[F.tid] = 0u;
    __syncthreads();
    unsigned* ctl = (unsigned*)(F.ws + WS_CTL);
    XcdBarrier bar; bar.bar = ctl + CW_BAR; bar.x = 0; bar.st = nullptr;
#if !MK_PER_PHASE
    bar = xcd_barrier_post(ctl + CW_BAR, MISC + 8);
#endif
    const int lo = args.ph_lo, hi = args.ph_hi;
#define IN(k) (lo <= (k) && (k) < hi)
#if MK_PER_PHASE
#define SEAM(k) do { } while (0)
#else
#define SEAM(k) do { if (IN(k) && IN((k) + 1)) xcd_barrier(bar); } while (0)
#endif
    const float* mod = (const float*)(F.ws + WS_MOD);

#define REP(k) (REPEAT_PH == (k))
#define RUN2(k, first, real) do { if (REP(k)) { first; xcd_barrier(bar); } real; } while (0)
    if (IN(0)) { RUN2(0, p0_prologue(F), p0_prologue(F)); } SEAM(0);
    for (int l = 0; l < DEPTH; ++l) {
        const int pb = 1 + 12 * l;
        const float* ml = mod + l * 12288;
        const float* xin = (l == 0) ? F.in[I_X] : (const float*)(F.ws + WS_X);
        if (IN(pb + 0)) { if (l == 0) RUN2(1, phase_norm(F, xin, F.in[I_N1G] + l * 2048, ml + 1 * 2048, ml + 0 * 2048), phase_norm(F, xin, F.in[I_N1G] + l * 2048, ml + 1 * 2048, ml + 0 * 2048)); } SEAM(pb + 0);
        if (IN(pb + 1)) {
            pg8::Gemm g{(const bf16*)(F.ws + WS_H), (const bf16*)(F.ws + WS_WIN) + (size_t)l * INW * DM, M, INW, DM}; pg8::StaticOrder S; S.init(M, INW, F.G, (int)blockIdx.x);
            EpiIn E{(bf16*)(F.ws + WS_Z), (bf16*)(F.ws + WS_XS), F.in[I_BIN] + l * INW};
#define GEMM_IN pg8::gemm_phase<EpiIn, pg8::StaticOrder, true, true>(F.lds, g, S, E)
            RUN2(2, GEMM_IN, GEMM_IN);
        } SEAM(pb + 1);
        if (IN(pb + 2)) { RUN2(3, (phase_sloc(F, l), phase_lnstats(F)), (phase_sloc(F, l), phase_lnstats(F))); } SEAM(pb + 2);
        if (IN(pb + 3)) { RUN2(4, phase_carry_gating(F, l, l + 2), phase_carry_gating(F, l, l)); } SEAM(pb + 3);
        if (IN(pb + 4)) { RUN2(5, phase_s5out(F, l), phase_s5out(F, l));
#if SELFTEST_S5
            xcd_barrier(bar); selftest_s5(F, l);
#endif
        } SEAM(pb + 4);
        if (IN(pb + 5)) {
            pg8::Gemm g{(const bf16*)(F.ws + WS_G), (const bf16*)(F.ws + WS_GLU) + (size_t)l * WB * WB, M, WB, WB}; pg8::StaticOrder S; S.init(M, WB, F.G, (int)blockIdx.x);
            EpiGlu E{(const bf16*)(F.ws + WS_G), (bf16*)(F.ws + WS_MIX), F.in[I_GLUB] + l * WB};
#define GEMM_GLU pg8::gemm_phase<EpiGlu, pg8::StaticOrder, true, true>(F.lds, g, S, E)
            RUN2(6, GEMM_GLU, GEMM_GLU);
        } SEAM(pb + 5);
        if (IN(pb + 6)) { RUN2(7, phase_branchnorm(F), phase_branchnorm(F)); } SEAM(pb + 6);
        if (IN(pb + 7)) {
            pg8::Gemm g{(const bf16*)(F.ws + WS_MIX), (const bf16*)(F.ws + WS_WOUT) + (size_t)l * DM * DM, M, DM, DM}; pg8::StaticOrder S; S.init(M, DM, F.G, (int)blockIdx.x);
            EpiOut E{xin, (float*)(F.ws + WS_X), ml + 2 * 2048};
            EpiOut Ed{xin, (float*)(F.ws + WS_DBG), ml + 2 * 2048};
#define GEMM_OUT(EE) pg8::gemm_phase<EpiOut, pg8::StaticOrder, true, true>(F.lds, g, S, EE)
            RUN2(8, GEMM_OUT(Ed), GEMM_OUT(E));
        } SEAM(pb + 7);
        if (IN(pb + 8)) { RUN2(9, phase_norm(F, (const float*)(F.ws + WS_X), F.in[I_N2G] + l * 2048, ml + 4 * 2048, ml + 3 * 2048), phase_norm(F, (const float*)(F.ws + WS_X), F.in[I_N2G] + l * 2048, ml + 4 * 2048, ml + 3 * 2048)); } SEAM(pb + 8);
        if (IN(pb + 9)) {
            pg8::Gemm g{(const bf16*)(F.ws + WS_H), (const bf16*)(F.ws + WS_WQ) + (size_t)l * DM * DM, M, DM, DM}; pg8::StaticOrder S; S.init(M, DM, F.G, (int)blockIdx.x);
            EpiQ E{(bf16*)(F.ws + WS_Z)};
#define GEMM_Q pg8::gemm_phase<EpiQ, pg8::StaticOrder, true, true>(F.lds, g, S, E)
            RUN2(10, GEMM_Q, GEMM_Q);
        } SEAM(pb + 9);
        if (IN(pb + 10)) { RUN2(11, phase_topk(F, l), phase_topk(F, l)); } SEAM(pb + 10);
        if (IN(pb + 11)) { RUN2(12, phase_gather(F, l, true), phase_gather(F, l, false)); } SEAM(pb + 11);
    }
#undef IN
#undef SEAM
}

extern "C" void kernel_launch(void* const* d_in, const int* in_sizes, int n_in, void* d_out, int out_size, void* d_ws, size_t ws_size, hipStream_t stream) {
    static int grid = 0;
    if (grid == 0) {
        if (n_in != 29 || out_size != M * DM || ws_size < WS_END) { fprintf(stderr, "kernel_launch: unexpected shapes (n_in %d, out %d, ws %zu); nothing launched\n", n_in, out_size, ws_size); grid = -1; return; }
        int dev = 0, cus = 0;
        if (hipGetDevice(&dev) != hipSuccess || hipDeviceGetAttribute(&cus, hipDeviceAttributeMultiprocessorCount, dev) != hipSuccess) { grid = -1; return; }
        if (hipFuncSetAttribute((const void*)fwd_kernel, hipFuncAttributeMaxDynamicSharedMemorySize, LDS_BYTES) != hipSuccess) { fprintf(stderr, "kernel_launch: hipFuncSetAttribute failed\n"); grid = -1; return; }
        (void)hipGetLastError();
        grid = cus;
    }
    if (grid < 0) return;
    (void)hipMemsetAsync((char*)d_ws + WS_CTL, 0, CTL_ZERO_BYTES, stream);
    Args a{};
    for (int i = 0; i < 29; ++i) a.in[i] = (const float*)d_in[i];
    a.out = (float*)d_out; a.ws = (unsigned char*)d_ws;
#if MK_PER_PHASE
    for (int p = 0; p < 1 + 12 * DEPTH; ++p) {
        if (p == 13) continue;
        a.ph_lo = p; a.ph_hi = p + 1; a.li = p;
        hipLaunchKernelGGL(fwd_kernel, dim3(grid), dim3(NTHR), LDS_BYTES, stream, a);
    }
#else
    a.ph_lo = 0; a.ph_hi = 1 + 12 * DEPTH; a.li = 0;
    hipLaunchKernelGGL(fwd_kernel, dim3(grid), dim3(NTHR), LDS_BYTES, stream, a);
#endif
}
```

```cpp
#include <hip/hip_runtime.h>
#include <cstdio>
#include <cstdint>

#ifndef SELFTEST_S5
#define SELFTEST_S5 0
#endif
#ifndef REPEAT_PH
#define REPEAT_PH -1
#endif
#ifndef MK_PER_PHASE
#define MK_PER_PHASE 0
#endif

#define GAS __attribute__((address_space(1)))
#define LAS __attribute__((address_space(3)))
typedef unsigned short bf16;
typedef short bf16x8 __attribute__((ext_vector_type(8)));
typedef float f32x4 __attribute__((ext_vector_type(4)));
typedef float f32x2 __attribute__((ext_vector_type(2)));
typedef unsigned u32x4 __attribute__((ext_vector_type(4)));
typedef unsigned u32x2 __attribute__((ext_vector_type(2)));

constexpr int DM = 2048, SEQ = 16384, DEPTH = 2, M = SEQ;
constexpr int WA = 1024, WB = 1024, INW = 3072;
constexpr int NG = 64, NCH = 256;
constexpr int NEXP = 16384;
constexpr float EPS = 1e-6f;
constexpr int NWAVES = 8, NTHR = 512;

namespace pg8 {
#define PG8_LAS __attribute__((address_space(3)))
constexpr int BM = 256, BK = 64, HALF = 128, HTB = HALF * BK * 2, STAGE_BYTES = 8 * HTB, NXCD = 8, WGM = 8;
__host__ __device__ __forceinline__ int lds_byte(int r, int c) { const int st = (r >> 4) * 2 + (c >> 5), rr = r & 15, cc = c & 31, ob = rr * 64 + cc * 2; return st * 1024 + (ob ^ (((ob >> 9) & 1) << 5)); }
__host__ __device__ __forceinline__ void stage_rc(int b, int& R, int& C) { const int st = b / 1024, sb = b % 1024, swz = sb ^ (((sb >> 9) & 1) << 5); R = (st >> 1) * 16 + swz / 64; C = (st & 1) * 32 + (swz % 64) / 2; }
__host__ __device__ __forceinline__ int perm32(int rho) { const int n = rho >> 4, i = rho & 15; return 8 * (i >> 2) + 4 * n + (i & 3); }
struct Unit { int pm, pn; };
struct Gemm { const bf16* A; const bf16* Bt; int M, N, K; };
struct StaticOrder {
    int nM, nN, nwg, G, c;
    __host__ __device__ void init(int M_, int N_, int G_, int c_) { nM = M_ / BM; nN = N_ / BM; nwg = nM * nN; G = G_; c = c_; }
    __host__ __device__ bool next(int i, Unit& u) const {
        const long L = (long)i * G + c; if (L >= nwg) return false;
        int wgid = (int)L; { const int q = nwg / NXCD, r = nwg % NXCD, xcd = wgid % NXCD, off = wgid / NXCD; wgid = (xcd < r ? xcd * (q + 1) : r * (q + 1) + (xcd - r) * q) + off; }
        const int nig = WGM * nN, gid = wgid / nig, fm = gid * WGM, gsz = (nM - fm) < WGM ? (nM - fm) : WGM;
        u.pm = fm + ((wgid % nig) % gsz); u.pn = (wgid % nig) / gsz; return true;
    }
    __device__ __forceinline__ void a_ready(const Unit&) const {}
    __device__ __forceinline__ void done(const Unit&) const {}
};
__device__ __forceinline__ unsigned cvt_pk_bf16(float lo, float hi) { unsigned r; asm volatile("v_cvt_pk_bf16_f32 %0, %1, %2" : "=v"(r) : "v"(lo), "v"(hi)); return r; }

template <class Epi, class Sched, bool ALIGN_EPI = false, bool SP2 = false>
__device__ __forceinline__ void gemm_phase(PG8_LAS unsigned char* lds, const Gemm g, const Sched& S, const Epi& E) {
    int tid = threadIdx.x; asm volatile("" : "+v"(tid)); const int wid = __builtin_amdgcn_readfirstlane(tid >> 6), lane = tid & 63, wr = wid >> 2, wc = wid & 3, fr = lane & 15, fq = lane >> 4;
    const int K = g.K, nt = K / BK;
    unsigned voffA[2], voffB[2];
#pragma unroll
    for (int i = 0; i < 2; ++i) { int R, C; stage_rc(tid * 16 + i * 8192, R, C); const int Rb = Epi::PERM ? ((R & ~31) + perm32(R & 31)) : R;
        voffA[i] = (unsigned)(R * K + C) * 2u; voffB[i] = (unsigned)(Rb * K + C) * 2u; }
    const size_t kstep = (size_t)(BK * 2);
    const size_t hstep = (size_t)HALF * K * 2;
    const size_t tstep = 2 * hstep;
    const unsigned ldsw = (unsigned)wid * 1024u;
    const int aoff = lds_byte(wr * 64 + fr, fq * 8), boff = lds_byte(wc * 32 + fr, fq * 8);
#define PG8_SA(b, h) (((b) * 2 + (h)) * HTB)
#define PG8_SB(b, h) ((4 + (b) * 2 + (h)) * HTB)
#define PG8_STAGE(bufoff, gbase, voff) do { _Pragma("unroll") for (int _i = 0; _i < 2; ++_i) \
        __builtin_amdgcn_global_load_lds((const unsigned*)((const char*)(gbase) + (voff)[_i]), (PG8_LAS unsigned*)(lds + (bufoff) + ldsw + _i * 8192), 16, 0, 0); } while (0)
#define PG8_LDA(dst, b, h) do { _Pragma("unroll") for (int m = 0; m < 4; ++m) _Pragma("unroll") for (int k = 0; k < 2; ++k) dst[m][k] = *(const PG8_LAS bf16x8*)(lds + PG8_SA(b, h) + aoff + m * 2048 + k * 1024); } while (0)
#define PG8_LDB(dst, b, h) do { _Pragma("unroll") for (int n = 0; n < 2; ++n) _Pragma("unroll") for (int k = 0; k < 2; ++k) dst[n][k] = *(const PG8_LAS bf16x8*)(lds + PG8_SB(b, h) + boff + n * 2048 + k * 1024); } while (0)
#define PG8_MMA(ai, bj, At, Bt) do { __builtin_amdgcn_s_setprio(1); _Pragma("unroll") for (int m = 0; m < 4; ++m) _Pragma("unroll") for (int n = 0; n < 2; ++n) _Pragma("unroll") for (int k = 0; k < 2; ++k) \
        acc[ai][bj][m][n] = __builtin_amdgcn_mfma_f32_16x16x32_bf16(Bt[n][k], At[m][k], acc[ai][bj][m][n], 0, 0, 0); __builtin_amdgcn_s_setprio(0); } while (0)
#define PG8_WAIT_V(n) asm volatile("s_waitcnt vmcnt(" #n ")" ::: "memory")
#define PG8_WAIT_L(n) asm volatile("s_waitcnt lgkmcnt(" #n ")" ::: "memory")
#define PG8_BAR __builtin_amdgcn_s_barrier()
#define PG8_SCHED __builtin_amdgcn_sched_barrier(0)
    Unit cur, nxt; int ui = 0;
    if (!S.next(0, cur)) return;
    f32x4 acc[2][2][4][2];
#pragma unroll
    for (int a = 0; a < 2; ++a)
#pragma unroll
        for (int b = 0; b < 2; ++b)
#pragma unroll
            for (int m = 0; m < 4; ++m)
#pragma unroll
                for (int n = 0; n < 2; ++n) acc[a][b][m][n] = (f32x4){0.f, 0.f, 0.f, 0.f};
    bf16x8 At[4][2], B0[2][2], B1[2][2];
    const char* cA = (const char*)g.A + (size_t)cur.pm * tstep; const char* cB = (const char*)g.Bt + (size_t)cur.pn * tstep;
    S.a_ready(cur);
    if constexpr (SP2) {
        PG8_STAGE(PG8_SB(0, 0), cB, voffB); PG8_STAGE(PG8_SB(0, 1), cB + hstep, voffB); PG8_STAGE(PG8_SA(0, 0), cA, voffA); PG8_STAGE(PG8_SA(0, 1), cA + hstep, voffA);
        if (wr == 1) PG8_BAR;
        PG8_WAIT_V(2); PG8_BAR;
        PG8_STAGE(PG8_SB(1, 0), cB + kstep, voffB); PG8_STAGE(PG8_SA(1, 0), cA + kstep, voffA); PG8_STAGE(PG8_SB(1, 1), cB + hstep + kstep, voffB);
        PG8_WAIT_V(6); PG8_BAR;
    } else {
        PG8_STAGE(PG8_SB(0, 0), cB, voffB); PG8_STAGE(PG8_SA(0, 0), cA, voffA); PG8_STAGE(PG8_SB(0, 1), cB + hstep, voffB); PG8_STAGE(PG8_SA(0, 1), cA + hstep, voffA);
        if (wr == 1) PG8_BAR;
        PG8_WAIT_V(4); PG8_BAR;
        PG8_STAGE(PG8_SB(1, 0), cB + kstep, voffB); PG8_STAGE(PG8_SA(1, 0), cA + kstep, voffA); PG8_STAGE(PG8_SB(1, 1), cB + hstep + kstep, voffB);
        PG8_WAIT_V(6); PG8_BAR;
    }
    for (;;) {
        const bool has_next = S.next(ui + 1, nxt);
        const char* nA = has_next ? (const char*)g.A + (size_t)nxt.pm * tstep : cA; const char* nB = has_next ? (const char*)g.Bt + (size_t)nxt.pn * tstep : cB;
        for (int t = 0; t < nt; t += 2) {
            const bool last = (t == nt - 2);
            const char* a1 = cA + (size_t)(t + 1) * kstep;
            const char* a2 = last ? nA : cA + (size_t)(t + 2) * kstep; const char* b2 = last ? nB : cB + (size_t)(t + 2) * kstep;
            const char* a3 = a2 + kstep; const char* b3 = b2 + kstep;
            if (last && has_next) S.a_ready(nxt);
            if constexpr (SP2) {
            PG8_LDB(B0, 0, 0); PG8_LDB(B1, 0, 1); PG8_SCHED; PG8_LDA(At, 0, 0); PG8_STAGE(PG8_SA(1, 1), a1 + hstep, voffA);
            PG8_WAIT_V(8); PG8_WAIT_L(0); PG8_BAR; PG8_MMA(0, 0, At, B0); PG8_MMA(0, 1, At, B1); PG8_BAR; PG8_SCHED;
            PG8_LDA(At, 0, 1); PG8_STAGE(PG8_SB(0, 0), b2, voffB); PG8_STAGE(PG8_SB(0, 1), b2 + hstep, voffB); PG8_STAGE(PG8_SA(0, 0), a2, voffA);
            PG8_WAIT_V(8); PG8_WAIT_L(0); PG8_BAR; PG8_MMA(1, 0, At, B0); PG8_MMA(1, 1, At, B1); PG8_BAR; PG8_SCHED;
            PG8_LDB(B0, 1, 0); PG8_LDB(B1, 1, 1); PG8_SCHED; PG8_LDA(At, 1, 0); PG8_STAGE(PG8_SA(0, 1), a2 + hstep, voffA);
            PG8_WAIT_V(8); PG8_WAIT_L(0); PG8_BAR; PG8_MMA(0, 0, At, B0); PG8_MMA(0, 1, At, B1); PG8_BAR; PG8_SCHED;
            PG8_LDA(At, 1, 1); PG8_STAGE(PG8_SB(1, 0), b3, voffB); PG8_STAGE(PG8_SB(1, 1), b3 + hstep, voffB); PG8_STAGE(PG8_SA(1, 0), a3, voffA);
            PG8_WAIT_V(8); PG8_WAIT_L(0); PG8_BAR; PG8_MMA(1, 0, At, B0); PG8_MMA(1, 1, At, B1); PG8_BAR; PG8_SCHED;
            } else {
            PG8_LDB(B0, 0, 0); PG8_SCHED; PG8_LDA(At, 0, 0); PG8_STAGE(PG8_SA(1, 1), a1 + hstep, voffA);
            PG8_WAIT_L(8); PG8_BAR; PG8_WAIT_L(0); PG8_MMA(0, 0, At, B0); PG8_BAR; PG8_SCHED;
            PG8_LDB(B1, 0, 1); PG8_STAGE(PG8_SB(0, 0), b2, voffB);
            PG8_BAR; PG8_WAIT_L(0); PG8_MMA(0, 1, At, B1); PG8_BAR;
            PG8_LDA(At, 0, 1); PG8_STAGE(PG8_SA(0, 0), a2, voffA);
            PG8_BAR; PG8_WAIT_L(0); PG8_MMA(1, 0, At, B0); PG8_BAR; PG8_SCHED;
            PG8_STAGE(PG8_SB(0, 1), b2 + hstep, voffB);
            PG8_WAIT_V(6); PG8_BAR; PG8_MMA(1, 1, At, B1); PG8_BAR;
            PG8_LDB(B0, 1, 0); PG8_SCHED; PG8_LDA(At, 1, 0); PG8_STAGE(PG8_SA(0, 1), a2 + hstep, voffA);
            PG8_WAIT_L(8); PG8_BAR; PG8_WAIT_L(0); PG8_MMA(0, 0, At, B0); PG8_BAR; PG8_SCHED;
            PG8_LDB(B1, 1, 1); PG8_STAGE(PG8_SB(1, 0), b3, voffB);
            PG8_BAR; PG8_WAIT_L(0); PG8_MMA(0, 1, At, B1); PG8_BAR;
            PG8_LDA(At, 1, 1); PG8_STAGE(PG8_SA(1, 0), a3, voffA);
            PG8_BAR; PG8_WAIT_L(0); PG8_MMA(1, 0, At, B0); PG8_BAR; PG8_SCHED;
            PG8_STAGE(PG8_SB(1, 1), b3 + hstep, voffB);
            PG8_WAIT_V(6); PG8_BAR; PG8_MMA(1, 1, At, B1); PG8_BAR;
            }
        }
        if constexpr (ALIGN_EPI) { if (wr == 0) PG8_BAR; }
        E(acc, cur, wr, wc, fr, fq); S.done(cur);
        if (!has_next) break;
#pragma unroll
        for (int a = 0; a < 2; ++a)
#pragma unroll
            for (int b = 0; b < 2; ++b)
#pragma unroll
                for (int m = 0; m < 4; ++m)
#pragma unroll
                    for (int n = 0; n < 2; ++n) acc[a][b][m][n] = (f32x4){0.f, 0.f, 0.f, 0.f};
        cur = nxt; cA = nA; cB = nB; ++ui;
        if constexpr (ALIGN_EPI) { if (wr == 1) PG8_BAR; }
    }
    PG8_WAIT_V(0);
    if constexpr (!ALIGN_EPI) { if (wr == 0) PG8_BAR; }
    PG8_BAR;
#undef PG8_SA
#undef PG8_SB
#undef PG8_STAGE
#undef PG8_LDA
#undef PG8_LDB
#undef PG8_MMA
#undef PG8_WAIT_V
#undef PG8_WAIT_L
#undef PG8_BAR
#undef PG8_SCHED
}
}

__device__ __forceinline__ unsigned f2bf(float f) { unsigned u = __builtin_bit_cast(unsigned, f); return (u + 0x7fffu + ((u >> 16) & 1u)) >> 16; }
__device__ __forceinline__ unsigned pk2(float lo, float hi) { return f2bf(lo) | (f2bf(hi) << 16); }
__device__ __forceinline__ float bflo(unsigned w) { return __builtin_bit_cast(float, w << 16); }
__device__ __forceinline__ float bfhi(unsigned w) { return __builtin_bit_cast(float, w & 0xffff0000u); }
__device__ __forceinline__ float fast_sigmoid(float t) { return __builtin_amdgcn_rcpf(1.0f + __builtin_amdgcn_exp2f(-1.44269504089f * t)); }
__device__ __forceinline__ float gelu_tanh(float x) { const float t = x * (1.5957691216f + 0.0713548163f * x * x); return x * fast_sigmoid(t); }
__device__ __forceinline__ float wave_sum(float v) {
#pragma unroll
    for (int o = 1; o < 64; o <<= 1) v += __shfl_xor(v, o);
    return v;
}
#define LDS_WAIT() asm volatile("s_waitcnt lgkmcnt(0)" ::: "memory")
#define VM_WAIT() asm volatile("s_waitcnt vmcnt(0)" ::: "memory")
#define RLX_AGENT __ATOMIC_RELAXED, __HIP_MEMORY_SCOPE_AGENT

constexpr size_t MiB = 1u << 20;
constexpr size_t WS_CTL = 0, CTL_ZERO_BYTES = 1 * MiB;
constexpr size_t WS_MOD   = 1 * MiB;
constexpr size_t WS_AT    = WS_MOD + 128 * 1024;
constexpr size_t WS_STATS = WS_AT + 128 * 1024;
constexpr size_t WS_SCL   = 1 * MiB + 512 * 1024;
constexpr size_t WS_KEYS  = 2 * MiB;
constexpr size_t WS_GWS   = 3 * MiB;
constexpr size_t WS_WIN   = 4 * MiB;
constexpr size_t WS_GLU   = 28 * MiB;
constexpr size_t WS_WOUT  = 32 * MiB;
constexpr size_t WS_WQ    = 48 * MiB;
constexpr size_t WS_KTAB  = 64 * MiB;
constexpr size_t WS_WG    = 72 * MiB;
constexpr size_t WS_VG    = 104 * MiB;
constexpr size_t WS_UV    = 136 * MiB;
constexpr size_t WS_X     = 392 * MiB;
constexpr size_t WS_H     = 520 * MiB;
constexpr size_t WS_Z     = 584 * MiB;
constexpr size_t WS_XS    = 648 * MiB;
constexpr size_t WS_SLOC  = 680 * MiB;
constexpr size_t WS_HS    = 688 * MiB;
constexpr size_t WS_G     = 692 * MiB;
constexpr size_t WS_MIX   = 724 * MiB;
constexpr size_t WS_EID   = 788 * MiB;
constexpr size_t WS_GATE  = 796 * MiB;
constexpr size_t WS_SU    = 804 * MiB;
constexpr size_t WS_END   = 812 * MiB;
constexpr size_t WS_DBG   = 812 * MiB;
constexpr int CW_BAR = 4096;
constexpr int CW_FLAG = 2048;
constexpr int CW_QUEUE = 16384;

constexpr int LDS_BYTES = 163840;
constexpr int MISC_OFF = LDS_BYTES - 256;

#define XB_TMO      128
#define XB_XCNT(j)  (256  + 64 * (j))
#define XB_XSUB(j)  (1280 + 64 * (j))
#define XB_XGEN(j)  (2304 + 64 * (j))
#define XB_TOP      3328
#define XB_TOPGEN   3392
#define XCD_BAR_WORDS 3456
#define XB_SPIN_CAP (1u << 24)
__device__ __forceinline__ unsigned xb_ld(unsigned* p)              { return __hip_atomic_load(p, __ATOMIC_RELAXED, __HIP_MEMORY_SCOPE_AGENT); }
__device__ __forceinline__ unsigned xb_add(unsigned* p, unsigned v) { return __hip_atomic_fetch_add(p, v, __ATOMIC_RELAXED, __HIP_MEMORY_SCOPE_AGENT); }
__device__ __forceinline__ unsigned xb_xcc_id() { return (unsigned)__builtin_amdgcn_s_getreg((3 << 11) | 20) & 0xFu; }
#define XB_SPIN(cond, bar) do { unsigned _sp = 0; while (cond) { __builtin_amdgcn_s_sleep(1); \
    if ((++_sp & 255u) == 0u) { if (xb_ld(&(bar)[XB_TMO])) break; if (_sp > XB_SPIN_CAP) { atomicAdd(&(bar)[XB_TMO], 1u); break; } } } } while (0)
struct XcdBarrier { unsigned* bar; unsigned x; volatile LAS unsigned* st; };
__device__ __forceinline__ XcdBarrier xcd_barrier_post(unsigned* bar, volatile LAS unsigned* st) {
    XcdBarrier b; b.bar = bar; b.x = xb_xcc_id(); b.st = st;
    if (threadIdx.x == 0) (void)xb_add(&bar[XB_XCNT(b.x)], 1u);
    return b;
}
__device__ __forceinline__ void xcd_barrier_complete(unsigned* bar, unsigned x, unsigned& nloc, unsigned& nx) {
    const unsigned G = gridDim.x * gridDim.y * gridDim.z;
    unsigned sum, cnt, mine, sp = 0u;
    for (;;) {
        sum = 0u; cnt = 0u; mine = 0u;
#pragma unroll
        for (unsigned j = 0; j < 16; ++j) { const unsigned c = xb_ld(&bar[XB_XCNT(j)]); sum += c; cnt += (c > 0u) ? 1u : 0u; mine = (j == x) ? c : mine; }
        if (sum == G) break;
        __builtin_amdgcn_s_sleep(1);
        if ((++sp & 255u) == 0u) { if (xb_ld(&bar[XB_TMO])) break; if (sp > XB_SPIN_CAP) { atomicAdd(&bar[XB_TMO], 1u); break; } }
    }
    nloc = mine > 0u ? mine : 1u; nx = cnt > 0u ? cnt : 1u;
}
__device__ __forceinline__ void xcd_barrier(const XcdBarrier& b) {
    asm volatile("s_waitcnt vmcnt(0)" ::: "memory");
    __syncthreads();
    if (threadIdx.x == 0) {
        unsigned* bar = b.bar;
        __builtin_amdgcn_s_waitcnt(0);
        unsigned nloc = b.st[0], nx = b.st[1];
        if (nloc == 0u) { xcd_barrier_complete(bar, b.x, nloc, nx); b.st[0] = nloc; b.st[1] = nx; }
        const unsigned old = xb_add(&bar[XB_XSUB(b.x)], 1u);
        const unsigned gen = old / nloc;
        if (old + 1u == (gen + 1u) * nloc) {
            __builtin_amdgcn_fence(__ATOMIC_RELEASE, "agent");
            asm volatile("s_waitcnt vmcnt(0)" ::: "memory");
            const unsigned og = xb_add(&bar[XB_TOP], 1u);
            const unsigned tg = og / nx;
            if (og + 1u == (tg + 1u) * nx) xb_add(&bar[XB_TOPGEN], 1u);
            else XB_SPIN(xb_ld(&bar[XB_TOPGEN]) == tg, bar);
            __builtin_amdgcn_fence(__ATOMIC_ACQUIRE, "agent");
            xb_add(&bar[XB_XGEN(b.x)], 1u);
            asm volatile("s_waitcnt vmcnt(0)" ::: "memory");
        } else {
            XB_SPIN(xb_ld(&bar[XB_XGEN(b.x)]) == gen, bar);
            __builtin_amdgcn_fence(__ATOMIC_ACQUIRE, "agent");
            asm volatile("s_waitcnt vmcnt(0)" ::: "memory");
        }
    }
    __syncthreads();
}

struct Args { const float* in[29]; float* out; unsigned char* ws; int ph_lo, ph_hi, li, pad; };
enum { I_X = 0, I_C, I_WMOD, I_BMOD, I_N1G, I_WIN, I_BIN, I_LNG, I_LNB, I_GWS, I_GBS, I_LRE, I_LIM, I_LDT, I_BRE, I_BIM, I_CRE, I_CIM, I_SD, I_GLUW, I_GLUB,
       I_BRG, I_WOUT, I_N2G, I_WQ, I_KEYS, I_PU, I_PV, I_FG };

struct Frame {
    LAS unsigned char* lds;
    unsigned char* ws;
    const float* const* in;
    float* out;
    int tid, lane, wave, vcu, G;
};

#define PH_LOCALS int tid = F.tid; asm volatile("" : "+v"(tid)); const int lane = tid & 63; const int wave = __builtin_amdgcn_readfirstlane(tid >> 6); (void)lane; (void)wave;

struct EpiIn {
    static constexpr bool PERM = true, AFTER_DRAIN = false;
    bf16* Z; bf16* XS; const float* bias;
    __device__ __forceinline__ void operator()(const f32x4 (&acc)[2][2][4][2], const pg8::Unit& u, int wr, int wc, int fr, int fq) const {
        const int row0 = u.pm * 256 + wr * 64 + fr, col0 = u.pn * 256 + wc * 32 + 8 * fq;
        f32x4 bv[2][2];
#pragma unroll
        for (int bj = 0; bj < 2; ++bj)
#pragma unroll
            for (int n = 0; n < 2; ++n) bv[bj][n] = *(const f32x4*)(bias + col0 + bj * 128 + 4 * n);
        const bool isz = (u.pn < 8);
#pragma unroll
        for (int ai = 0; ai < 2; ++ai)
#pragma unroll
            for (int m = 0; m < 4; ++m) {
                const int r = row0 + ai * 128 + m * 16;
#pragma unroll
                for (int bj = 0; bj < 2; ++bj) {
                    f32x4 v0 = acc[ai][bj][m][0] + bv[bj][0], v1 = acc[ai][bj][m][1] + bv[bj][1];
                    const int c = col0 + bj * 128;
                    u32x4 w;
                    if (isz) {
                        w.x = pg8::cvt_pk_bf16(gelu_tanh(v0[0]), gelu_tanh(v0[1])); w.y = pg8::cvt_pk_bf16(gelu_tanh(v0[2]), gelu_tanh(v0[3]));
                        w.z = pg8::cvt_pk_bf16(gelu_tanh(v1[0]), gelu_tanh(v1[1])); w.w = pg8::cvt_pk_bf16(gelu_tanh(v1[2]), gelu_tanh(v1[3]));
                        *(u32x4*)(Z + (size_t)r * 2048 + c) = w;
                    } else {
                        w.x = pg8::cvt_pk_bf16(v0[0], v0[1]); w.y = pg8::cvt_pk_bf16(v0[2], v0[3]); w.z = pg8::cvt_pk_bf16(v1[0], v1[1]); w.w = pg8::cvt_pk_bf16(v1[2], v1[3]);
                        const int cc = c - 2048, g = cc >> 4, i = cc & 15;
                        *(u32x4*)(XS + ((size_t)(g * 256 + (r >> 6)) * 64 + (r & 63)) * 16 + i) = w;
                    }
                }
            }
    }
};
struct EpiGlu {
    static constexpr bool PERM = true, AFTER_DRAIN = false;
    const bf16* Gb; bf16* MIX; const float* bias;
    __device__ __forceinline__ void operator()(const f32x4 (&acc)[2][2][4][2], const pg8::Unit& u, int wr, int wc, int fr, int fq) const {
        const int row0 = u.pm * 256 + wr * 64 + fr, col0 = u.pn * 256 + wc * 32 + 8 * fq;
        f32x4 bv[2][2];
#pragma unroll
        for (int bj = 0; bj < 2; ++bj)
#pragma unroll
            for (int n = 0; n < 2; ++n) bv[bj][n] = *(const f32x4*)(bias + col0 + bj * 128 + 4 * n);
#pragma unroll
        for (int ai = 0; ai < 2; ++ai)
#pragma unroll
            for (int m = 0; m < 4; ++m) {
                const int r = row0 + ai * 128 + m * 16;
#pragma unroll
                for (int bj = 0; bj < 2; ++bj) {
                    const f32x4 v0 = acc[ai][bj][m][0] + bv[bj][0], v1 = acc[ai][bj][m][1] + bv[bj][1];
                    const int c = col0 + bj * 128;
                    const u32x4 gw = *(const u32x4*)(Gb + (size_t)r * 1024 + c);
                    u32x4 w;
                    w.x = pg8::cvt_pk_bf16(bflo(gw.x) * fast_sigmoid(v0[0]), bfhi(gw.x) * fast_sigmoid(v0[1]));
                    w.y = pg8::cvt_pk_bf16(bflo(gw.y) * fast_sigmoid(v0[2]), bfhi(gw.y) * fast_sigmoid(v0[3]));
                    w.z = pg8::cvt_pk_bf16(bflo(gw.z) * fast_sigmoid(v1[0]), bfhi(gw.z) * fast_sigmoid(v1[1]));
                    w.w = pg8::cvt_pk_bf16(bflo(gw.w) * fast_sigmoid(v1[2]), bfhi(gw.w) * fast_sigmoid(v1[3]));
                    *(u32x4*)(MIX + (size_t)r * 2048 + 1024 + c) = w;
                }
            }
    }
};
struct EpiOut {
    static constexpr bool PERM = true, AFTER_DRAIN = false;
    const float* xin; float* X; const float* gate;
    __device__ __forceinline__ void operator()(const f32x4 (&acc)[2][2][4][2], const pg8::Unit& u, int wr, int wc, int fr, int fq) const {
        const int row0 = u.pm * 256 + wr * 64 + fr, col0 = u.pn * 256 + wc * 32 + 8 * fq;
        f32x4 gv[2][2];
#pragma unroll
        for (int bj = 0; bj < 2; ++bj)
#pragma unroll
            for (int n = 0; n < 2; ++n) gv[bj][n] = *(const f32x4*)(gate + col0 + bj * 128 + 4 * n);
#pragma unroll
        for (int ai = 0; ai < 2; ++ai)
#pragma unroll
            for (int m = 0; m < 4; ++m) {
                const int r = row0 + ai * 128 + m * 16;
#pragma unroll
                for (int bj = 0; bj < 2; ++bj) {
                    const size_t off = (size_t)r * 2048 + col0 + bj * 128;
                    const f32x4 x0 = *(const f32x4*)(xin + off), x1 = *(const f32x4*)(xin + off + 4);
                    *(f32x4*)(X + off) = x0 + gv[bj][0] * acc[ai][bj][m][0];
                    *(f32x4*)(X + off + 4) = x1 + gv[bj][1] * acc[ai][bj][m][1];
                }
            }
    }
};
struct EpiQ {
    static constexpr bool PERM = true, AFTER_DRAIN = false;
    bf16* Q;
    __device__ __forceinline__ void operator()(const f32x4 (&acc)[2][2][4][2], const pg8::Unit& u, int wr, int wc, int fr, int fq) const {
        const int row0 = u.pm * 256 + wr * 64 + fr, col0 = u.pn * 256 + wc * 32 + 8 * fq;
#pragma unroll
        for (int ai = 0; ai < 2; ++ai)
#pragma unroll
            for (int m = 0; m < 4; ++m) {
                const int r = row0 + ai * 128 + m * 16;
#pragma unroll
                for (int bj = 0; bj < 2; ++bj) {
                    const f32x4 v0 = acc[ai][bj][m][0], v1 = acc[ai][bj][m][1];
                    u32x4 w; w.x = pg8::cvt_pk_bf16(v0[0], v0[1]); w.y = pg8::cvt_pk_bf16(v0[2], v0[3]); w.z = pg8::cvt_pk_bf16(v1[0], v1[1]); w.w = pg8::cvt_pk_bf16(v1[2], v1[3]);
                    *(u32x4*)(Q + (size_t)r * 2048 + col0 + bj * 128) = w;
                }
            }
    }
};

__device__ __forceinline__ void p0_transpose_item(const float* W, int K, int N, bf16* WT, const float* kscale, LAS float* scr, int item, int lane) {
    const int nblk = N / 32, kb = item / nblk, nb = item % nblk, k0 = 64 * kb, n0 = 32 * nb;
#pragma unroll 8
    for (int i = 0; i < 32; ++i) { const int kk = 2 * i + (lane >> 5); float v = W[(size_t)(k0 + kk) * N + n0 + (lane & 31)]; if (kscale) v *= kscale[k0 + kk]; scr[kk * 33 + (lane & 31)] = v; }
    LDS_WAIT(); asm volatile("" ::: "memory");
    const int c = lane & 7;
#pragma unroll
    for (int j = 0; j < 4; ++j) { const int n = (lane >> 3) + 8 * j; const LAS float* s = scr + (8 * c) * 33 + n;
        u32x4 o; o.x = pk2(s[0 * 33], s[1 * 33]); o.y = pk2(s[2 * 33], s[3 * 33]); o.z = pk2(s[4 * 33], s[5 * 33]); o.w = pk2(s[6 * 33], s[7 * 33]);
        *(u32x4*)(WT + (size_t)(n0 + n) * K + k0 + 8 * c) = o; }
    LDS_WAIT(); asm volatile("" ::: "memory");
}

__device__ __forceinline__ void norm_mod_row(const f32x4 (&v)[4][2], const float* gain, const float* scale, const float* shift, int lane, u32x4 (&o)[4]) {
    float s = 0.f;
#pragma unroll
    for (int j = 0; j < 4; ++j)
#pragma unroll
        for (int h = 0; h < 2; ++h) s += (v[j][h][0] * v[j][h][0] + v[j][h][1] * v[j][h][1]) + (v[j][h][2] * v[j][h][2] + v[j][h][3] * v[j][h][3]);
    const float rr = 1.0f / sqrtf(wave_sum(s) * (1.0f / DM) + EPS);
#pragma unroll
    for (int j = 0; j < 4; ++j) {
        const int c = j * 512 + lane * 8;
        f32x4 y[2];
#pragma unroll
        for (int h = 0; h < 2; ++h) {
            const f32x4 g = *(const f32x4*)(gain + c + 4 * h);
            y[h] = v[j][h] * rr * g;
            const f32x4 sc = *(const f32x4*)(scale + c + 4 * h), sh = *(const f32x4*)(shift + c + 4 * h); y[h] = y[h] * (sc + 1.0f) + sh;
        }
        o[j].x = pk2(y[0][0], y[0][1]); o[j].y = pk2(y[0][2], y[0][3]); o[j].z = pk2(y[1][0], y[1][1]); o[j].w = pk2(y[1][2], y[1][3]);
    }
}
__device__ __forceinline__ void norm_row_pass(const float* xrow, bf16* hrow, const float* gain, const float* scale, const float* shift, int lane) {
    f32x4 v[4][2];
#pragma unroll
    for (int j = 0; j < 4; ++j) { v[j][0] = *(const f32x4*)(xrow + j * 512 + lane * 8); v[j][1] = *(const f32x4*)(xrow + j * 512 + lane * 8 + 4); }
    u32x4 o[4]; norm_mod_row(v, gain, scale, shift, lane, o);
#pragma unroll
    for (int j = 0; j < 4; ++j) *(u32x4*)(hrow + j * 512 + lane * 8) = o[j];
}

__device__ __forceinline__ void p0_prologue(Frame& F) {
    PH_LOCALS
    const int gw = F.vcu * NWAVES + wave, NGW = F.G * NWAVES;
    const int gt = F.vcu * NTHR + tid, NGT = F.G * NTHR;
    if ((int)blockIdx.x < 192) {
        const int l = blockIdx.x / 96, cb = blockIdx.x % 96;
        LAS float* sc = (LAS float*)F.lds;
        LAS float* red = (LAS float*)(F.lds + 8192);
        for (int k = tid; k < DM; k += NTHR) { const float c = F.in[I_C][k]; sc[k] = c * fast_sigmoid(c); }
        __syncthreads();
        const int tx = tid & 31, ty = tid >> 5;
        const float* W = F.in[I_WMOD] + (size_t)l * DM * 12288 + cb * 128 + tx * 4;
        f32x4 a = {0.f, 0.f, 0.f, 0.f};
#pragma unroll 8
        for (int k = ty; k < DM; k += 16) { const f32x4 w = *(const f32x4*)(W + (size_t)k * 12288); a += w * sc[k]; }
        *(LAS f32x4*)(red + ty * 128 + tx * 4) = a;
        __syncthreads();
        if (tid < 128) { float s = 0.f;
#pragma unroll
            for (int y = 0; y < 16; ++y) s += red[y * 128 + tid];
            ((float*)(F.ws + WS_MOD))[l * 12288 + cb * 128 + tid] = s + F.in[I_BMOD][l * 12288 + cb * 128 + tid]; }
        __syncthreads();
    }
    if ((int)blockIdx.x >= 128) {
        const int u = 255 - (int)blockIdx.x, l = u >> 6, g = u & 63;
        LAS float* apr = (LAS float*)F.lds;
        LAS float* api = apr + 65 * 64;
        LAS float* bbr = api + 65 * 64;
        LAS float* bbi = bbr + 1024;
        LAS float* ccr = bbi + 1024;
        LAS float* cci = ccr + 1024;
        const float dt = expf(F.in[I_LDT][l * 64 + g]);
        const float* lre = F.in[I_LRE] + (l * 64 + g) * 64; const float* lim = F.in[I_LIM] + (l * 64 + g) * 64;
        for (int idx = tid; idx < 65 * 64; idx += NTHR) { const int d = idx >> 6, p = idx & 63;
            const float mag = expf(lre[p] * dt * (float)d); float sn, cs; sincosf(lim[p] * dt * (float)d, &sn, &cs);
            apr[idx] = mag * cs; api[idx] = mag * sn; }
        for (int idx = tid; idx < 1024; idx += NTHR) { const int o = idx >> 6, p = idx & 63;
            ccr[idx] = F.in[I_CRE][((size_t)(l * 64 + g) * 16 + o) * 64 + p]; cci[idx] = F.in[I_CIM][((size_t)(l * 64 + g) * 16 + o) * 64 + p]; }
        __syncthreads();
        for (int idx = tid; idx < 1024; idx += NTHR) { const int p = idx >> 4, i = idx & 15;
            const float xr = apr[64 + p] - 1.0f, xi = api[64 + p], lr = lre[p], li = lim[p], den = 1.0f / (lr * lr + li * li);
            const float cr = (xr * lr + xi * li) * den, ci = (xi * lr - xr * li) * den;
            const float br = F.in[I_BRE][((size_t)(l * 64 + g) * 64 + p) * 16 + i], bi = F.in[I_BIM][((size_t)(l * 64 + g) * 64 + p) * 16 + i];
            bbr[idx] = cr * br - ci * bi; bbi[idx] = cr * bi + ci * br; }
        __syncthreads();
        bf16* KT = (bf16*)(F.ws + WS_KTAB) + (size_t)(l * 64 + g) * 65 * 256;
        for (int idx = tid; idx < 65 * 256; idx += NTHR) {
            const int d = (idx >> 8) - 1, o = (idx >> 4) & 15, i = idx & 15; float s = 0.f;
            if (d >= 0) {
                for (int p = 0; p < 64; ++p) { const float ar = apr[d * 64 + p], ai = api[d * 64 + p], cr = ccr[o * 64 + p], ci = cci[o * 64 + p];
                    const float er = cr * ar - ci * ai, ei = cr * ai + ci * ar; s += er * bbr[p * 16 + i] - ei * bbi[p * 16 + i]; }
#if !SELFTEST_S5
                if (d == 0 && o == i) s += F.in[I_SD][l * 1024 + g * 16 + o];
#endif
            }
            KT[idx] = (bf16)f2bf(s);
        }
        bf16* WG = (bf16*)(F.ws + WS_WG) + (size_t)(l * 64 + g) * 128 * 1024;
        for (int idx = tid; idx < 64 * 1024; idx += NTHR) { const int p = idx >> 10, k = idx & 1023, tau = k >> 4, i = k & 15;
            const float ar = apr[(63 - tau) * 64 + p], ai = api[(63 - tau) * 64 + p], br = bbr[p * 16 + i], bi = bbi[p * 16 + i];
            WG[(size_t)p * 1024 + k] = (bf16)f2bf(ar * br - ai * bi); WG[(size_t)(64 + p) * 1024 + k] = (bf16)f2bf(ar * bi + ai * br); }
        bf16* VG = (bf16*)(F.ws + WS_VG) + (size_t)(l * 64 + g) * 1024 * 128;
        for (int idx = tid; idx < 1024 * 64; idx += NTHR) { const int m = idx >> 6, p = idx & 63, t = m >> 4, o = m & 15;
            const float ar = apr[(t + 1) * 64 + p], ai = api[(t + 1) * 64 + p], cr = ccr[o * 64 + p], ci = cci[o * 64 + p];
            VG[(size_t)m * 128 + p] = (bf16)f2bf(cr * ar - ci * ai); VG[(size_t)m * 128 + 64 + p] = (bf16)f2bf(-(cr * ai + ci * ar)); }
        if (tid < 64) { float* AT = (float*)(F.ws + WS_AT) + ((size_t)(l * 64 + g) * 64 + tid) * 2; AT[0] = apr[64 * 64 + tid]; AT[1] = api[64 * 64 + tid]; }
        __syncthreads();
    }
    {
        LAS float* scr = (LAS float*)(F.lds + wave * 16384);
        constexpr int I_IN = (DM / 64) * (INW / 32), I_GL = (WB / 64) * (WB / 32), I_OU = (DM / 64) * (DM / 32), I_Q = I_OU;
        constexpr int PER_L = I_IN + I_GL + I_OU + I_Q;
        for (int it = gw; it < 2 * PER_L; it += NGW) {
            const int l = it / PER_L; int r = it % PER_L;
            if (r < I_IN) { p0_transpose_item(F.in[I_WIN] + (size_t)l * DM * INW, DM, INW, (bf16*)(F.ws + WS_WIN) + (size_t)l * INW * DM, nullptr, scr, r, lane); continue; } r -= I_IN;
            if (r < I_GL) { p0_transpose_item(F.in[I_GLUW] + (size_t)l * WB * WB, WB, WB, (bf16*)(F.ws + WS_GLU) + (size_t)l * WB * WB, nullptr, scr, r, lane); continue; } r -= I_GL;
            if (r < I_OU) { p0_transpose_item(F.in[I_WOUT] + (size_t)l * DM * DM, DM, DM, (bf16*)(F.ws + WS_WOUT) + (size_t)l * DM * DM, F.in[I_BRG] + l * DM, scr, r, lane); continue; } r -= I_OU;
            p0_transpose_item(F.in[I_WQ] + (size_t)l * DM * DM, DM, DM, (bf16*)(F.ws + WS_WQ) + (size_t)l * DM * DM, nullptr, scr, r, lane);
        }
    }
    {
        bf16* KB = (bf16*)(F.ws + WS_KEYS);
        for (int i = gt; i < 2 * 8 * 2 * 128 * 128 / 8; i += NGT) { const f32x4 a = *(const f32x4*)(F.in[I_KEYS] + (size_t)i * 8), b = *(const f32x4*)(F.in[I_KEYS] + (size_t)i * 8 + 4);
            u32x4 o; o.x = pk2(a[0], a[1]); o.y = pk2(a[2], a[3]); o.z = pk2(b[0], b[1]); o.w = pk2(b[2], b[3]); *(u32x4*)(KB + (size_t)i * 8) = o; }
        bf16* GW = (bf16*)(F.ws + WS_GWS);
        for (int i = gt; i < 2 * 8 * 128 * 128 / 8; i += NGT) { const int e = i * 8, jj = e & 127, ii = (e >> 7) & 127; const bool keep = (ii >= 64) || (jj < 64);
            f32x4 a = *(const f32x4*)(F.in[I_GWS] + (size_t)i * 8), b = *(const f32x4*)(F.in[I_GWS] + (size_t)i * 8 + 4);
            if (!keep) { a = (f32x4){0.f, 0.f, 0.f, 0.f}; b = a; }
            u32x4 o; o.x = pk2(a[0], a[1]); o.y = pk2(a[2], a[3]); o.z = pk2(b[0], b[1]); o.w = pk2(b[2], b[3]); *(u32x4*)(GW + (size_t)i * 8) = o; }
    }
    {
        unsigned char* UV = F.ws + WS_UV; float* SCL = (float*)(F.ws + WS_SCL);
        for (int r = gw; r < 2 * 2 * NEXP; r += NGW) {
            const int tbl = r >> 15, rr = r & 32767;
            const float* srcp = (tbl ? F.in[I_PV] : F.in[I_PU]) + (size_t)rr * 2048 + lane * 4;
            f32x4 v[8]; float am = 0.f;
#pragma unroll
            for (int j = 0; j < 8; ++j) { v[j] = *(const f32x4*)(srcp + j * 256); am = fmaxf(am, fmaxf(fmaxf(fabsf(v[j][0]), fabsf(v[j][1])), fmaxf(fabsf(v[j][2]), fabsf(v[j][3])))); }
#pragma unroll
            for (int o = 1; o < 64; o <<= 1) am = fmaxf(am, __shfl_xor(am, o));
            const float scale = am > 0.f ? am * (1.0f / 6.0f) : 1.0f, inv = am > 0.f ? 6.0f / am : 1.0f;
            u32x4 o;
#pragma unroll
            for (int d = 0; d < 4; ++d) { unsigned w = 0u;
                w = __builtin_amdgcn_cvt_scalef32_pk_fp4_f32(w, v[2 * d][0] * inv, v[2 * d][1] * inv, 1.0f, 0);
                w = __builtin_amdgcn_cvt_scalef32_pk_fp4_f32(w, v[2 * d][2] * inv, v[2 * d][3] * inv, 1.0f, 1);
                w = __builtin_amdgcn_cvt_scalef32_pk_fp4_f32(w, v[2 * d + 1][0] * inv, v[2 * d + 1][1] * inv, 1.0f, 2);
                w = __builtin_amdgcn_cvt_scalef32_pk_fp4_f32(w, v[2 * d + 1][2] * inv, v[2 * d + 1][3] * inv, 1.0f, 3);
                o[d] = w; }
            *(u32x4*)(UV + (size_t)rr * 2048 + tbl * 1024 + lane * 16) = o;
            if (lane == 0) SCL[rr * 2 + tbl] = scale;
        }
    }
}

__device__ __forceinline__ void phase_norm(Frame& F, const float* xsrc, const float* gain, const float* scale, const float* shift) {
    PH_LOCALS
    const int gw = F.vcu * NWAVES + wave, NGW = F.G * NWAVES;
    bf16* H = (bf16*)(F.ws + WS_H);
    for (int m = gw; m < M; m += NGW) norm_row_pass(xsrc + (size_t)m * DM, H + (size_t)m * DM, gain, scale, shift, lane);
}
__device__ __forceinline__ void phase_lnstats(Frame& F) {
    PH_LOCALS
    const int gw = F.vcu * NWAVES + wave, NGW = F.G * NWAVES;
    const bf16* Z = (const bf16*)(F.ws + WS_Z); float* ST = (float*)(F.ws + WS_STATS);
    for (int m = gw; m < M; m += NGW) {
        float v[16];
#pragma unroll
        for (int j = 0; j < 2; ++j) { const u32x4 w = *(const u32x4*)(Z + (size_t)m * 2048 + 1024 + j * 512 + lane * 8);
            v[j * 8 + 0] = bflo(w.x); v[j * 8 + 1] = bfhi(w.x); v[j * 8 + 2] = bflo(w.y); v[j * 8 + 3] = bfhi(w.y); v[j * 8 + 4] = bflo(w.z); v[j * 8 + 5] = bfhi(w.z); v[j * 8 + 6] = bflo(w.w); v[j * 8 + 7] = bfhi(w.w); }
        float s = 0.f;
#pragma unroll
        for (int i = 0; i < 16; ++i) s += v[i];
        const float mean = wave_sum(s) * (1.0f / 1024.0f); float q = 0.f;
#pragma unroll
        for (int i = 0; i < 16; ++i) { const float d = v[i] - mean; q += d * d; }
        const float rstd = 1.0f / sqrtf(wave_sum(q) * (1.0f / 1024.0f) + EPS);
        if (lane == 0) { ST[2 * m] = mean; ST[2 * m + 1] = rstd; }
    }
}
__device__ __forceinline__ void phase_branchnorm(Frame& F) {
    PH_LOCALS
    const int gw = F.vcu * NWAVES + wave, NGW = F.G * NWAVES;
    bf16* MIX = (bf16*)(F.ws + WS_MIX);
    for (int m = gw; m < M; m += NGW) {
        u32x4 w[4]; float sa = 0.f, sb = 0.f;
#pragma unroll
        for (int j = 0; j < 4; ++j) { w[j] = *(const u32x4*)(MIX + (size_t)m * 2048 + j * 512 + lane * 8);
            float q = 0.f;
#pragma unroll
            for (int e = 0; e < 4; ++e) { const float a = bflo(w[j][e]), b = bfhi(w[j][e]); q += a * a + b * b; }
            if (j < 2) sa += q; else sb += q; }
        const float ra = 1.0f / sqrtf(wave_sum(sa) * (1.0f / 1024.0f) + EPS), rb = 1.0f / sqrtf(wave_sum(sb) * (1.0f / 1024.0f) + EPS);
#pragma unroll
        for (int j = 0; j < 4; ++j) { const float r = j < 2 ? ra : rb; u32x4 o;
#pragma unroll
            for (int e = 0; e < 4; ++e) o[e] = pk2(bflo(w[j][e]) * r, bfhi(w[j][e]) * r);
            *(u32x4*)(MIX + (size_t)m * 2048 + j * 512 + lane * 8) = o; }
    }
}

__device__ __forceinline__ void phase_sloc(Frame& F, int l) {
    PH_LOCALS
    const bf16* XS = (const bf16*)(F.ws + WS_XS); const bf16* WG = (const bf16*)(F.ws + WS_WG) + (size_t)l * 64 * 128 * 1024; float* SL = (float*)(F.ws + WS_SLOC);
    const int fr = lane & 15, fq = lane >> 4;
    for (int u = F.vcu; u < 256; u += F.G) {
        const int g = u >> 2, n0 = (u & 3) * 64 + (wave & 3) * 16, jh = wave >> 2;
        f32x4 acc[4];
#pragma unroll
        for (int t = 0; t < 4; ++t) acc[t] = (f32x4){0.f, 0.f, 0.f, 0.f};
        const bf16* xp = XS + ((size_t)(g * 256 + n0 + fr)) * 1024 + 8 * fq;
        const bf16* wp = WG + ((size_t)(g * 128 + jh * 64 + fr)) * 1024 + 8 * fq;
#pragma unroll 4
        for (int kb = 0; kb < 32; ++kb) {
            const bf16x8 xf = *(const bf16x8*)(xp + kb * 32);
#pragma unroll
            for (int t = 0; t < 4; ++t) { const bf16x8 wf = *(const bf16x8*)(wp + (size_t)t * 16 * 1024 + kb * 32); acc[t] = __builtin_amdgcn_mfma_f32_16x16x32_bf16(wf, xf, acc[t], 0, 0, 0); }
        }
#pragma unroll
        for (int t = 0; t < 4; ++t) *(f32x4*)(SL + ((size_t)(g * 256 + n0 + fr)) * 128 + jh * 64 + t * 16 + 4 * fq) = acc[t];
    }
}
__device__ __forceinline__ void s5_carry(Frame& F, int l) {
    PH_LOCALS
    if (F.vcu < 64 && wave == 0) {
        const int g = F.vcu, p = lane;
        const float* AT = (const float*)(F.ws + WS_AT) + ((size_t)(l * 64 + g) * 64 + p) * 2; const float ar = AT[0], ai = AT[1];
        const float* SL = (const float*)(F.ws + WS_SLOC) + (size_t)g * 256 * 128; bf16* HS = (bf16*)(F.ws + WS_HS) + (size_t)g * 256 * 128;
        float hr = 0.f, hi = 0.f;
        for (int n0 = 0; n0 < 256; n0 += 8) {
            float sr[8], si[8];
#pragma unroll
            for (int e = 0; e < 8; ++e) { sr[e] = SL[(size_t)(n0 + e) * 128 + p]; si[e] = SL[(size_t)(n0 + e) * 128 + 64 + p]; }
#pragma unroll
            for (int e = 0; e < 8; ++e) { HS[(size_t)(n0 + e) * 128 + p] = (bf16)f2bf(hr); HS[(size_t)(n0 + e) * 128 + 64 + p] = (bf16)f2bf(hi);
                const float nr = ar * hr - ai * hi + sr[e], ni = ar * hi + ai * hr + si[e]; hr = nr; hi = ni; }
        }
    }
}

__device__ __forceinline__ void gating_unit(Frame& F, int l, int unit) {
    PH_LOCALS
    const int nb = unit >> 3, hh = unit & 7, t0 = nb * 128, c0 = hh * 128;
    const bf16* Z = (const bf16*)(F.ws + WS_Z); const float* ST = (const float*)(F.ws + WS_STATS);
    const bf16* GW = (const bf16*)(F.ws + WS_GWS) + (size_t)(l * 8 + hh) * 128 * 128;
    bf16* MIX = (bf16*)(F.ws + WS_MIX);
    LAS bf16* VT = (LAS bf16*)F.lds;
    constexpr int VS = 136;
    {
        const int j = tid >> 2, cs = (tid & 3) * 32;
        const float mu = ST[2 * (t0 + j)], rs = ST[2 * (t0 + j) + 1];
        const float* lg = F.in[I_LNG] + l * 1024 + c0 + cs; const float* lb = F.in[I_LNB] + l * 1024 + c0 + cs;
#pragma unroll
        for (int q = 0; q < 4; ++q) {
            const u32x4 w = *(const u32x4*)(Z + (size_t)(t0 + j) * 2048 + 1024 + c0 + cs + q * 8);
#pragma unroll
            for (int e = 0; e < 4; ++e) { const int c = cs + q * 8 + 2 * e;
                const float a = (bflo(w[e]) - mu) * rs * lg[q * 8 + 2 * e] + lb[q * 8 + 2 * e], b = (bfhi(w[e]) - mu) * rs * lg[q * 8 + 2 * e + 1] + lb[q * 8 + 2 * e + 1];
                VT[c * VS + j] = (bf16)f2bf(a); VT[(c + 1) * VS + j] = (bf16)f2bf(b); }
        }
    }
    __syncthreads();
    {
        const int fr = lane & 15, fq = lane >> 4, w = wave;
        f32x4 acc[8];
#pragma unroll
        for (int ct = 0; ct < 8; ++ct) acc[ct] = (f32x4){0.f, 0.f, 0.f, 0.f};
        const int nkb = (w < 4) ? 2 : 4;
        for (int kb = 0; kb < nkb; ++kb) {
            const bf16x8 wf = *(const bf16x8*)(GW + (size_t)(16 * w + fr) * 128 + kb * 32 + 8 * fq);
#pragma unroll
            for (int ct = 0; ct < 8; ++ct) { const bf16x8 vf = *(const LAS bf16x8*)(VT + (ct * 16 + fr) * VS + kb * 32 + 8 * fq); acc[ct] = __builtin_amdgcn_mfma_f32_16x16x32_bf16(vf, wf, acc[ct], 0, 0, 0); }
        }
        const int tok = t0 + 16 * w + fr; const float bs = F.in[I_GBS][(l * 8 + hh) * 128 + 16 * w + fr];
#pragma unroll
        for (int ct = 0; ct < 8; ++ct) { const int c = c0 + ct * 16 + 4 * fq;
            const u32x2 uw = *(const u32x2*)(Z + (size_t)tok * 2048 + c);
            u32x2 o; o.x = pk2(bflo(uw.x) * (acc[ct][0] + bs), bfhi(uw.x) * (acc[ct][1] + bs)); o.y = pk2(bflo(uw.y) * (acc[ct][2] + bs), bfhi(uw.y) * (acc[ct][3] + bs));
            *(u32x2*)(MIX + (size_t)tok * 2048 + c) = o; }
    }
    __syncthreads();
}
__device__ __forceinline__ void phase_carry_gating(Frame& F, int l, int qi) {
    PH_LOCALS
    s5_carry(F, l);
    unsigned* head = (unsigned*)(F.ws + WS_CTL) + CW_QUEUE + 64 * qi;
    LAS unsigned* slot = (LAS unsigned*)(F.lds + MISC_OFF) + 16;
    for (;;) {
        __syncthreads();
        if (tid == 0) slot[0] = __hip_atomic_fetch_add(head, 1u, RLX_AGENT);
        __syncthreads();
        const unsigned u = slot[0];
        if (u >= 1024u) break;
        gating_unit(F, l, (int)u);
    }
}

__device__ __forceinline__ void phase_s5out(Frame& F, int l) {
    PH_LOCALS
    const bf16* XS = (const bf16*)(F.ws + WS_XS); const bf16* HS = (const bf16*)(F.ws + WS_HS);
    bf16* Gb = (bf16*)(F.ws + WS_G);
    LAS bf16* KT = (LAS bf16*)F.lds;
    const int fr = lane & 15, fq = lane >> 4;
    for (int u = F.vcu; u < 512; u += F.G) {
        const int g = u >> 3, rc = (u >> 1) & 3, nh = u & 1;
        __syncthreads();
        { const u32x4* src = (const u32x4*)((const bf16*)(F.ws + WS_KTAB) + (size_t)(l * 64 + g) * 65 * 256);
          for (int i = tid; i < 65 * 256 / 8; i += NTHR) ((LAS u32x4*)KT)[i] = src[i]; }
        __syncthreads();
        const bf16* VG = (const bf16*)(F.ws + WS_VG) + (size_t)(l * 64 + g) * 1024 * 128;
        const int n = nh * 128 + 16 * wave + fr;
        f32x4 acc[16];
#pragma unroll
        for (int q = 0; q < 16; ++q) acc[q] = (f32x4){0.f, 0.f, 0.f, 0.f};
        const bf16* xp0 = XS + ((size_t)(g * 256 + n)) * 1024 + 8 * fq;
        bf16x8 x0 = *(const bf16x8*)xp0;
        for (int kb = 0; kb < 32; ++kb) {
            const int tau0 = 2 * kb;
            const bf16x8 c0 = x0;
            if (kb < 31) x0 = *(const bf16x8*)(xp0 + (kb + 1) * 32);
#pragma unroll
            for (int q = 0; q < 16; ++q) {
                const int t = rc + 4 * q;
                if (t >= tau0) {
                    const int d1 = t - tau0 - (fq >> 1) + 1;
                    const bf16x8 kf = *(const LAS bf16x8*)(KT + (d1 * 16 + fr) * 16 + 8 * (fq & 1));
                    acc[q] = __builtin_amdgcn_mfma_f32_16x16x32_bf16(kf, c0, acc[q], 0, 0, 0);
                }
            }
        }
        const bf16* hp0 = HS + ((size_t)(g * 256 + n)) * 128 + 8 * fq;
        for (int jb = 0; jb < 4; ++jb) {
            const bf16x8 h0 = *(const bf16x8*)(hp0 + jb * 32);
#pragma unroll
            for (int q = 0; q < 16; ++q) {
                const int t = rc + 4 * q;
                const bf16x8 vf = *(const bf16x8*)(VG + (size_t)(t * 16 + fr) * 128 + jb * 32 + 8 * fq);
                acc[q] = __builtin_amdgcn_mfma_f32_16x16x32_bf16(vf, h0, acc[q], 0, 0, 0);
            }
        }
#pragma unroll
        for (int q = 0; q < 16; ++q) {
            const int t = rc + 4 * q, tok = 64 * n + t;
            const f32x4 y = acc[q];
            u32x2 o; o.x = pk2(gelu_tanh(y[0]), gelu_tanh(y[1])); o.y = pk2(gelu_tanh(y[2]), gelu_tanh(y[3]));
            *(u32x2*)(Gb + (size_t)tok * 1024 + g * 16 + 4 * fq) = o;
#if SELFTEST_S5
            if (tok < 256) *(f32x4*)((float*)(F.ws + WS_DBG) + (size_t)tok * 1024 + g * 16 + 4 * fq) = y;
#endif
        }
    }
}
#if SELFTEST_S5
__device__ __forceinline__ void selftest_s5(Frame& F, int l) {
    PH_LOCALS
    if (F.vcu < 64 && wave == 0) {
        const int g = F.vcu, p = lane;
        const float dt = expf(F.in[I_LDT][l * 64 + g]);
        const float lr = F.in[I_LRE][(l * 64 + g) * 64 + p], li = F.in[I_LIM][(l * 64 + g) * 64 + p];
        const float mag = expf(lr * dt); float sn, cs; sincosf(li * dt, &sn, &cs);
        const float ar = mag * cs, ai = mag * sn;
        const float xr = ar - 1.0f, xi = ai, den = 1.0f / (lr * lr + li * li);
        const float cr = (xr * lr + xi * li) * den, ci = (xi * lr - xr * li) * den;
        float bbr[16], bbi[16], ccr[16], cci[16];
#pragma unroll
        for (int i = 0; i < 16; ++i) { const float br = F.in[I_BRE][((size_t)(l * 64 + g) * 64 + p) * 16 + i], bi = F.in[I_BIM][((size_t)(l * 64 + g) * 64 + p) * 16 + i];
            bbr[i] = cr * br - ci * bi; bbi[i] = cr * bi + ci * br;
            ccr[i] = F.in[I_CRE][((size_t)(l * 64 + g) * 16 + i) * 64 + p]; cci[i] = F.in[I_CIM][((size_t)(l * 64 + g) * 16 + i) * 64 + p]; }
        const bf16* XS = (const bf16*)(F.ws + WS_XS) + (size_t)g * 256 * 1024;
        const float* DY = (const float*)(F.ws + WS_DBG);
        float sr = 0.f, si = 0.f, err = 0.f, ref = 0.f;
        for (int t = 0; t < 256; ++t) {
            float x[16];
#pragma unroll
            for (int i = 0; i < 16; ++i) x[i] = bflo((unsigned)XS[(size_t)t * 16 + i]);
            float ur = 0.f, ui = 0.f;
#pragma unroll
            for (int i = 0; i < 16; ++i) { ur += bbr[i] * x[i]; ui += bbi[i] * x[i]; }
            const float nr = ar * sr - ai * si + ur, ni = ar * si + ai * sr + ui; sr = nr; si = ni;
#pragma unroll
            for (int o = 0; o < 16; ++o) {
                const float yr = wave_sum(ccr[o] * sr - cci[o] * si);
                const float yf = DY[(size_t)t * 1024 + g * 16 + o];
                err += (yf - yr) * (yf - yr); ref += yr * yr;
            }
        }
        if (lane == 0 && !(err <= 2e-3f * ref)) __hip_atomic_fetch_or((unsigned*)(F.ws + WS_CTL) + CW_FLAG, 1u, RLX_AGENT);
    }
}
#endif

__device__ __forceinline__ unsigned f2key(float v) { const unsigned u = __builtin_bit_cast(unsigned, v); return (u & 0x80000000u) ? ~u : (u | 0x80000000u); }
__device__ __forceinline__ float key2f(unsigned k) { const unsigned u = (k & 0x80000000u) ? (k & 0x7fffffffu) : ~k; return __builtin_bit_cast(float, u); }
__device__ __forceinline__ void phase_topk(Frame& F, int l) {
    PH_LOCALS
    const bf16* Q = (const bf16*)(F.ws + WS_Z);
    const bf16* KB = (const bf16*)(F.ws + WS_KEYS) + (size_t)l * 8 * 2 * 128 * 128;
    int* EID = (int*)(F.ws + WS_EID); float* GT = (float*)(F.ws + WS_GATE); float* SUo = (float*)(F.ws + WS_SU);
    const float* SCL = (const float*)(F.ws + WS_SCL) + (size_t)l * NEXP * 2;
    LAS float* SC = (LAS float*)F.lds;
    LAS unsigned* LST = (LAS unsigned*)(F.lds + 128 * 260 * 4);
    const int fr = lane & 15, fq = lane >> 4;
    for (int u = F.vcu; u < 1024; u += F.G) {
        const int tt = u >> 3, hh = u & 7, t0 = tt * 128;
        __syncthreads();
        {
            f32x4 acc[2][8];
#pragma unroll
            for (int s = 0; s < 2; ++s)
#pragma unroll
                for (int nt = 0; nt < 8; ++nt) acc[s][nt] = (f32x4){0.f, 0.f, 0.f, 0.f};
#pragma unroll
            for (int s = 0; s < 2; ++s)
#pragma unroll
                for (int kb = 0; kb < 4; ++kb) {
                    const bf16x8 qf = *(const bf16x8*)(Q + (size_t)(t0 + 16 * wave + fr) * 2048 + hh * 256 + s * 128 + kb * 32 + 8 * fq);
#pragma unroll
                    for (int nt = 0; nt < 8; ++nt) { const bf16x8 kf = *(const bf16x8*)(KB + ((size_t)((hh * 2 + s) * 128 + nt * 16 + fr)) * 128 + kb * 32 + 8 * fq);
                        acc[s][nt] = __builtin_amdgcn_mfma_f32_16x16x32_bf16(kf, qf, acc[s][nt], 0, 0, 0); }
                }
#pragma unroll
            for (int s = 0; s < 2; ++s)
#pragma unroll
                for (int nt = 0; nt < 8; ++nt) *(LAS f32x4*)(SC + (16 * wave + fr) * 260 + s * 128 + nt * 16 + 4 * fq) = acc[s][nt];
        }
        __syncthreads();
        if (tid < 256) {
            const int tl = tid >> 1, s = tid & 1;
            unsigned top[16];
#pragma unroll
            for (int k = 0; k < 16; ++k) top[k] = 0u;
            const LAS float* row = SC + tl * 260 + s * 128;
            for (int n4 = 0; n4 < 32; ++n4) {
                const f32x4 v = *(const LAS f32x4*)(row + 4 * n4);
#pragma unroll
                for (int e = 0; e < 4; ++e) {
                    unsigned key = (f2key(v[e]) & ~0x7Fu) | (unsigned)(127 - (4 * n4 + e));
#pragma unroll
                    for (int k = 0; k < 16; ++k) { const unsigned hi = top[k] > key ? top[k] : key, lo = top[k] > key ? key : top[k]; top[k] = hi; key = lo; }
                }
            }
#pragma unroll
            for (int k = 0; k < 16; k += 4) *(LAS u32x4*)(LST + (tl * 2 + s) * 16 + k) = (u32x4){top[k], top[k + 1], top[k + 2], top[k + 3]};
        }
        __syncthreads();
        if (tid < 128) {
            const int tl = tid;
            float av[16], bv[16];
#pragma unroll
            for (int k = 0; k < 16; ++k) { av[k] = key2f(LST[(tl * 2 + 0) * 16 + k] & ~0x7Fu); bv[k] = key2f(LST[(tl * 2 + 1) * 16 + k] & ~0x7Fu); }
            unsigned top[16];
#pragma unroll
            for (int k = 0; k < 16; ++k) top[k] = 0u;
#pragma unroll
            for (int i = 0; i < 16; ++i)
#pragma unroll
                for (int j = 0; j < 16; ++j)
                    if ((i + 1) * (j + 1) <= 16) {
                        unsigned key = (f2key(av[i] + bv[j]) & ~0xFFu) | (unsigned)(255 - (i * 16 + j));
#pragma unroll
                        for (int k = 0; k < 16; ++k) { const unsigned hi = top[k] > key ? top[k] : key, lo = top[k] > key ? key : top[k]; top[k] = hi; key = lo; }
                    }
            float ev[16]; float sum = 0.f; const float mx = key2f(top[0] & ~0xFFu);
#pragma unroll
            for (int k = 0; k < 16; ++k) { ev[k] = __expf(key2f(top[k] & ~0xFFu) - mx); sum += ev[k]; }
            const float inv = 1.0f / sum;
            int* eo = EID + (size_t)(t0 + tl) * 128 + hh * 16; float* go = GT + (size_t)(t0 + tl) * 128 + hh * 16; float* so = SUo + (size_t)(t0 + tl) * 128 + hh * 16;
#pragma unroll
            for (int k = 0; k < 16; ++k) { const int flat = 255 - (int)(top[k] & 0xFFu), i = flat >> 4, j = flat & 15;
                const int ia = 127 - (int)(LST[(tl * 2 + 0) * 16 + i] & 0x7Fu), ib = 127 - (int)(LST[(tl * 2 + 1) * 16 + j] & 0x7Fu);
                const int e = ia * 128 + ib; const f32x2 sc = *(const f32x2*)(SCL + 2 * e);
                eo[k] = e; go[k] = ev[k] * inv * sc.y; so[k] = sc.x; }
        }
    }
    __syncthreads();
}

#define FP4X4(w, f0, f1, f2, f3) do { f0 = __builtin_amdgcn_cvt_scalef32_pk_f32_fp4((w), 1.0f, 0); f1 = __builtin_amdgcn_cvt_scalef32_pk_f32_fp4((w), 1.0f, 1); \
    f2 = __builtin_amdgcn_cvt_scalef32_pk_f32_fp4((w), 1.0f, 2); f3 = __builtin_amdgcn_cvt_scalef32_pk_f32_fp4((w), 1.0f, 3); } while (0)
__device__ __forceinline__ void phase_gather(Frame& F, int l, bool dummy = false) {
    PH_LOCALS
    const int gw = F.vcu * NWAVES + wave, NGW = F.G * NWAVES;
    const bf16* H = (const bf16*)(F.ws + WS_H); bf16* Hn = dummy ? (bf16*)(F.ws + WS_DBG + 128 * MiB) : (bf16*)(F.ws + WS_H);
    const unsigned char* UV = F.ws + WS_UV + (size_t)l * NEXP * 2048;
    const int* EID = (const int*)(F.ws + WS_EID); const float* GT = (const float*)(F.ws + WS_GATE); const float* SU = (const float*)(F.ws + WS_SU);
    const float* X = (const float*)(F.ws + WS_X); float* Xo = dummy ? (float*)(F.ws + WS_DBG) : (float*)(F.ws + WS_X);
    const float* mod = (const float*)(F.ws + WS_MOD);
    const float* gate2 = mod + l * 12288 + 5 * 2048;
    const unsigned lane16 = (unsigned)lane * 16u;
    constexpr int NB = 16;
    for (int t = gw; t < M; t += NGW) {
        const int e_lo = EID[(size_t)t * 128 + lane], e_hi = EID[(size_t)t * 128 + 64 + lane];
        const float g_lo = GT[(size_t)t * 128 + lane], g_hi = GT[(size_t)t * 128 + 64 + lane];
        const float s_lo = SU[(size_t)t * 128 + lane], s_hi = SU[(size_t)t * 128 + 64 + lane];
        f32x2 hh[8][2];
#pragma unroll
        for (int j = 0; j < 8; ++j) { const u32x2 w = *(const u32x2*)(H + (size_t)t * 2048 + j * 256 + lane * 4);
            hh[j][0] = (f32x2){bflo(w.x), bfhi(w.x)}; hh[j][1] = (f32x2){bflo(w.y), bfhi(w.y)}; }
        f32x2 of[8][2];
#pragma unroll
        for (int j = 0; j < 8; ++j) { of[j][0] = (f32x2){0.f, 0.f}; of[j][1] = (f32x2){0.f, 0.f}; }
        for (int b = 0; b < 128 / NB; ++b) {
            const bool first = (b * NB) < 64;
            const int esel = first ? e_lo : e_hi; const float gsel = first ? g_lo : g_hi, ssel = first ? s_lo : s_hi;
            u32x4 ur[NB], vr[NB];
#pragma unroll
            for (int h = 0; h < NB; ++h) {
                const int e = __builtin_amdgcn_readlane(esel, (NB * b + h) & 63);
                const unsigned char* rowp = UV + ((size_t)(unsigned)e << 11);
                ur[h] = *(const u32x4*)(rowp + lane16); vr[h] = *(const u32x4*)(rowp + 1024 + lane16);
            }
            float p[NB];
#pragma unroll
            for (int h = 0; h < NB; ++h) {
                f32x2 a2 = {0.f, 0.f};
#pragma unroll
                for (int d = 0; d < 4; ++d) { f32x2 f0, f1, f2, f3; FP4X4(ur[h][d], f0, f1, f2, f3);
                    a2 = f0 * hh[2 * d][0] + a2; a2 = f1 * hh[2 * d][1] + a2; a2 = f2 * hh[2 * d + 1][0] + a2; a2 = f3 * hh[2 * d + 1][1] + a2; }
                p[h] = a2.x + a2.y;
            }
            const bool u32_ = (lane & 32) != 0, u16_ = (lane & 16) != 0, u8_ = (lane & 8) != 0, u4_ = (lane & 4) != 0;
            float a8[8];
#pragma unroll
            for (int i = 0; i < 8; ++i) { const float snd = u32_ ? p[i] : p[8 + i], kp = u32_ ? p[8 + i] : p[i]; a8[i] = kp + __shfl_xor(snd, 32); }
            float a4[4];
#pragma unroll
            for (int i = 0; i < 4; ++i) { const float snd = u16_ ? a8[i] : a8[4 + i], kp = u16_ ? a8[4 + i] : a8[i]; a4[i] = kp + __shfl_xor(snd, 16); }
            float b2[2];
#pragma unroll
            for (int i = 0; i < 2; ++i) { const float snd = u8_ ? a4[i] : a4[2 + i], kp = u8_ ? a4[2 + i] : a4[i]; b2[i] = kp + __shfl_xor(snd, 8); }
            float d;
            { const float snd = u4_ ? b2[0] : b2[1], kp = u4_ ? b2[1] : b2[0]; d = kp + __shfl_xor(snd, 4); }
            d += __shfl_xor(d, 2); d += __shfl_xor(d, 1);
            const int hl = (NB * b + (lane >> 2)) & 63;
            const float gq = __shfl(gsel, hl), sq = __shfl(ssel, hl);
            const float coefq = gq * gelu_tanh(d * sq);
#pragma unroll
            for (int h = 0; h < NB; ++h) {
                const float cf = __builtin_bit_cast(float, __builtin_amdgcn_readlane(__builtin_bit_cast(int, coefq), 4 * h));
                const f32x2 cf2 = {cf, cf};
#pragma unroll
                for (int dd = 0; dd < 4; ++dd) { f32x2 f0, f1, f2, f3; FP4X4(vr[h][dd], f0, f1, f2, f3);
                    of[2 * dd][0] = f0 * cf2 + of[2 * dd][0]; of[2 * dd][1] = f1 * cf2 + of[2 * dd][1]; of[2 * dd + 1][0] = f2 * cf2 + of[2 * dd + 1][0]; of[2 * dd + 1][1] = f3 * cf2 + of[2 * dd + 1][1]; }
            }
        }
        int ln = lane; asm volatile("" : "+v"(ln));
        f32x4 xv[8]; float ss = 0.f;
#pragma unroll
        for (int j = 0; j < 8; ++j) {
            const int c = j * 256 + ln * 4;
            const f32x4 xo = *(const f32x4*)(X + (size_t)t * 2048 + c), g2 = *(const f32x4*)(gate2 + c);
            const f32x4 o = {of[j][0].x, of[j][0].y, of[j][1].x, of[j][1].y};
            xv[j] = xo + g2 * o;
            ss += (xv[j][0] * xv[j][0] + xv[j][1] * xv[j][1]) + (xv[j][2] * xv[j][2] + xv[j][3] * xv[j][3]);
        }
        const float rr = 1.0f / sqrtf(wave_sum(ss) * (1.0f / DM) + EPS);
        if (l + 1 < DEPTH) {
            const float* m2 = mod + (l + 1) * 12288; const float* gain = F.in[I_N1G] + (l + 1) * 2048;
#pragma unroll
            for (int j = 0; j < 8; ++j) {
                const int c = j * 256 + ln * 4;
                *(f32x4*)(Xo + (size_t)t * 2048 + c) = xv[j];
                const f32x4 g = *(const f32x4*)(gain + c), sc = *(const f32x4*)(m2 + 2048 + c), sh = *(const f32x4*)(m2 + c);
                const f32x4 y = xv[j] * rr * g * (sc + 1.0f) + sh;
                *(u32x2*)(Hn + (size_t)t * 2048 + c) = (u32x2){pk2(y[0], y[1]), pk2(y[2], y[3])};
            }
        } else {
#pragma unroll
            for (int j = 0; j < 8; ++j) { const int c = j * 256 + ln * 4; const f32x4 fg = *(const f32x4*)(F.in[I_FG] + c);
                f32x4 ov = xv[j] * rr * fg;
#if SELFTEST_S5
                if (__hip_atomic_load((unsigned*)(F.ws + WS_CTL) + CW_FLAG, RLX_AGENT) != 0u) ov = (f32x4){1e30f, 1e30f, 1e30f, 1e30f};
#endif
                *(f32x4*)(F.out + (size_t)t * 2048 + c) = ov; }
        }
    }
}

__global__ void __launch_bounds__(NTHR, 2) fwd_kernel(Args args) {
    extern __shared__ __attribute__((aligned(16))) unsigned char lds_raw[];
    Frame F;
    F.lds = (LAS unsigned char*)lds_raw; F.ws = args.ws; F.in = args.in; F.out = args.out;
    F.tid = threadIdx.x; F.lane = F.tid & 63; F.wave = __builtin_amdgcn_readfirstlane(F.tid >> 6);
    F.G = gridDim.x; { const int bx = blockIdx.x; F.vcu = (F.G % 8 == 0) ? (bx % 8) * (F.G / 8) + bx / 8 : bx; }
    volatile LAS unsigned* MISC = (volatile LAS unsigned*)(F.lds + MISC_OFF);
    if (F.tid < 64) MISC[F.tid] = 0u;
    __syncthreads();
    unsigned* ctl = (unsigned*)(F.ws + WS_CTL);
    XcdBarrier bar; bar.bar = ctl + CW_BAR; bar.x = 0; bar.st = nullptr;
#if !MK_PER_PHASE
    bar = xcd_barrier_post(ctl + CW_BAR, MISC + 8);
#endif
    const int lo = args.ph_lo, hi = args.ph_hi;
#define IN(k) (lo <= (k) && (k) < hi)
#if MK_PER_PHASE
#define SEAM(k) do { } while (0)
#else
#define SEAM(k) do { if (IN(k) && IN((k) + 1)) xcd_barrier(bar); } while (0)
#endif
    const float* mod = (const float*)(F.ws + WS_MOD);

#define REP(k) (REPEAT_PH == (k))
#define RUN2(k, first, real) do { if (REP(k)) { first; xcd_barrier(bar); } real; } while (0)
    if (IN(0)) { RUN2(0, p0_prologue(F), p0_prologue(F)); } SEAM(0);
    for (int l = 0; l < DEPTH; ++l) {
        const int pb = 1 + 12 * l;
        const float* ml = mod + l * 12288;
        const float* xin = (l == 0) ? F.in[I_X] : (const float*)(F.ws + WS_X);
        if (IN(pb + 0)) { if (l == 0) RUN2(1, phase_norm(F, xin, F.in[I_N1G] + l * 2048, ml + 1 * 2048, ml + 0 * 2048), phase_norm(F, xin, F.in[I_N1G] + l * 2048, ml + 1 * 2048, ml + 0 * 2048)); } SEAM(pb + 0);
        if (IN(pb + 1)) {
            pg8::Gemm g{(const bf16*)(F.ws + WS_H), (const bf16*)(F.ws + WS_WIN) + (size_t)l * INW * DM, M, INW, DM}; pg8::StaticOrder S; S.init(M, INW, F.G, (int)blockIdx.x);
            EpiIn E{(bf16*)(F.ws + WS_Z), (bf16*)(F.ws + WS_XS), F.in[I_BIN] + l * INW};
#define GEMM_IN pg8::gemm_phase<EpiIn, pg8::StaticOrder, true, true>(F.lds, g, S, E)
            RUN2(2, GEMM_IN, GEMM_IN);
        } SEAM(pb + 1);
        if (IN(pb + 2)) { RUN2(3, (phase_sloc(F, l), phase_lnstats(F)), (phase_sloc(F, l), phase_lnstats(F))); } SEAM(pb + 2);
        if (IN(pb + 3)) { RUN2(4, phase_carry_gating(F, l, l + 2), phase_carry_gating(F, l, l)); } SEAM(pb + 3);
        if (IN(pb + 4)) { RUN2(5, phase_s5out(F, l), phase_s5out(F, l));
#if SELFTEST_S5
            xcd_barrier(bar); selftest_s5(F, l);
#endif
        } SEAM(pb + 4);
        if (IN(pb + 5)) {
            pg8::Gemm g{(const bf16*)(F.ws + WS_G), (const bf16*)(F.ws + WS_GLU) + (size_t)l * WB * WB, M, WB, WB}; pg8::StaticOrder S; S.init(M, WB, F.G, (int)blockIdx.x);
            EpiGlu E{(const bf16*)(F.ws + WS_G), (bf16*)(F.ws + WS_MIX), F.in[I_GLUB] + l * WB};
#define GEMM_GLU pg8::gemm_phase<EpiGlu, pg8::StaticOrder, true, true>(F.lds, g, S, E)
            RUN2(6, GEMM_GLU, GEMM_GLU);
        } SEAM(pb + 5);
        if (IN(pb + 6)) { RUN2(7, phase_branchnorm(F), phase_branchnorm(F)); } SEAM(pb + 6);
        if (IN(pb + 7)) {
            pg8::Gemm g{(const bf16*)(F.ws + WS_MIX), (const bf16*)(F.ws + WS_WOUT) + (size_t)l * DM * DM, M, DM, DM}; pg8::StaticOrder S; S.init(M, DM, F.G, (int)blockIdx.x);
            EpiOut E{xin, (float*)(F.ws + WS_X), ml + 2 * 2048};
            EpiOut Ed{xin, (float*)(F.ws + WS_DBG), ml + 2 * 2048};
#define GEMM_OUT(EE) pg8::gemm_phase<EpiOut, pg8::StaticOrder, true, true>(F.lds, g, S, EE)
            RUN2(8, GEMM_OUT(Ed), GEMM_OUT(E));
        } SEAM(pb + 7);
        if (IN(pb + 8)) { RUN2(9, phase_norm(F, (const float*)(F.ws + WS_X), F.in[I_N2G] + l * 2048, ml + 4 * 2048, ml + 3 * 2048), phase_norm(F, (const float*)(F.ws + WS_X), F.in[I_N2G] + l * 2048, ml + 4 * 2048, ml + 3 * 2048)); } SEAM(pb + 8);
        if (IN(pb + 9)) {
            pg8::Gemm g{(const bf16*)(F.ws + WS_H), (const bf16*)(F.ws + WS_WQ) + (size_t)l * DM * DM, M, DM, DM}; pg8::StaticOrder S; S.init(M, DM, F.G, (int)blockIdx.x);
            EpiQ E{(bf16*)(F.ws + WS_Z)};
#define GEMM_Q pg8::gemm_phase<EpiQ, pg8::StaticOrder, true, true>(F.lds, g, S, E)
            RUN2(10, GEMM_Q, GEMM_Q);
        } SEAM(pb + 9);
        if (IN(pb + 10)) { RUN2(11, phase_topk(F, l), phase_topk(F, l)); } SEAM(pb + 10);
        if (IN(pb + 11)) { RUN2(12, phase_gather(F, l, true), phase_gather(F, l, false)); } SEAM(pb + 11);
    }
#undef IN
#undef SEAM
}

extern "C" void kernel_launch(void* const* d_in, const int* in_sizes, int n_in, void* d_out, int out_size, void* d_ws, size_t ws_size, hipStream_t stream) {
    static int grid = 0;
    if (grid == 0) {
        if (n_in != 29 || out_size != M * DM || ws_size < WS_END) { fprintf(stderr, "kernel_launch: unexpected shapes (n_in %d, out %d, ws %zu); nothing launched\n", n_in, out_size, ws_size); grid = -1; return; }
        int dev = 0, cus = 0;
        if (hipGetDevice(&dev) != hipSuccess || hipDeviceGetAttribute(&cus, hipDeviceAttributeMultiprocessorCount, dev) != hipSuccess) { grid = -1; return; }
        if (hipFuncSetAttribute((const void*)fwd_kernel, hipFuncAttributeMaxDynamicSharedMemorySize, LDS_BYTES) != hipSuccess) { fprintf(stderr, "kernel_launch: hipFuncSetAttribute failed\n"); grid = -1; return; }
        (void)hipGetLastError();
        grid = cus;
    }
    if (grid < 0) return;
    (void)hipMemsetAsync((char*)d_ws + WS_CTL, 0, CTL_ZERO_BYTES, stream);
    Args a{};
    for (int i = 0; i < 29; ++i) a.in[i] = (const float*)d_in[i];
    a.out = (float*)d_out; a.ws = (unsigned char*)d_ws;
#if MK_PER_PHASE
    for (int p = 0; p < 1 + 12 * DEPTH; ++p) {
        if (p == 13) continue;
        a.ph_lo = p; a.ph_hi = p + 1; a.li = p;
        hipLaunchKernelGGL(fwd_kernel, dim3(grid), dim3(NTHR), LDS_BYTES, stream, a);
    }
#else
    a.ph_lo = 0; a.ph_hi = 1 + 12 * DEPTH; a.li = 0;
    hipLaunchKernelGGL(fwd_kernel, dim3(grid), dim3(NTHR), LDS_BYTES, stream, a);
#endif
}
```

```cpp
#include <hip/hip_runtime.h>
#include <cstdio>
#include <cstdint>

#ifndef SELFTEST_S5
#define SELFTEST_S5 0
#endif
#ifndef REPEAT_PH
#define REPEAT_PH -1
#endif
#ifndef MK_PER_PHASE
#define MK_PER_PHASE 0
#endif

#define GAS __attribute__((address_space(1)))
#define LAS __attribute__((address_space(3)))
typedef unsigned short bf16;
typedef short bf16x8 __attribute__((ext_vector_type(8)));
typedef float f32x4 __attribute__((ext_vector_type(4)));
typedef float f32x2 __attribute__((ext_vector_type(2)));
typedef unsigned u32x4 __attribute__((ext_vector_type(4)));
typedef unsigned u32x2 __attribute__((ext_vector_type(2)));

constexpr int DM = 2048, SEQ = 16384, DEPTH = 2, M = SEQ;
constexpr int WA = 1024, WB = 1024, INW = 3072;
constexpr int NG = 64, NCH = 256;
constexpr int NEXP = 16384;
constexpr float EPS = 1e-6f;
constexpr int NWAVES = 8, NTHR = 512;

namespace pg8 {
#define PG8_LAS __attribute__((address_space(3)))
constexpr int BM = 256, BK = 64, HALF = 128, HTB = HALF * BK * 2, STAGE_BYTES = 8 * HTB, NXCD = 8, WGM = 8;
__host__ __device__ __forceinline__ int lds_byte(int r, int c) { const int st = (r >> 4) * 2 + (c >> 5), rr = r & 15, cc = c & 31, ob = rr * 64 + cc * 2; return st * 1024 + (ob ^ (((ob >> 9) & 1) << 5)); }
__host__ __device__ __forceinline__ void stage_rc(int b, int& R, int& C) { const int st = b / 1024, sb = b % 1024, swz = sb ^ (((sb >> 9) & 1) << 5); R = (st >> 1) * 16 + swz / 64; C = (st & 1) * 32 + (swz % 64) / 2; }
__host__ __device__ __forceinline__ int perm32(int rho) { const int n = rho >> 4, i = rho & 15; return 8 * (i >> 2) + 4 * n + (i & 3); }
struct Unit { int pm, pn; };
struct Gemm { const bf16* A; const bf16* Bt; int M, N, K; };
struct StaticOrder {
    int nM, nN, nwg, G, c;
    __host__ __device__ void init(int M_, int N_, int G_, int c_) { nM = M_ / BM; nN = N_ / BM; nwg = nM * nN; G = G_; c = c_; }
    __host__ __device__ bool next(int i, Unit& u) const {
        const long L = (long)i * G + c; if (L >= nwg) return false;
        int wgid = (int)L; { const int q = nwg / NXCD, r = nwg % NXCD, xcd = wgid % NXCD, off = wgid / NXCD; wgid = (xcd < r ? xcd * (q + 1) : r * (q + 1) + (xcd - r) * q) + off; }
        const int nig = WGM * nN, gid = wgid / nig, fm = gid * WGM, gsz = (nM - fm) < WGM ? (nM - fm) : WGM;
        u.pm = fm + ((wgid % nig) % gsz); u.pn = (wgid % nig) / gsz; return true;
    }
    __device__ __forceinline__ void a_ready(const Unit&) const {}
    __device__ __forceinline__ void done(const Unit&) const {}
};
__device__ __forceinline__ unsigned cvt_pk_bf16(float lo, float hi) { unsigned r; asm volatile("v_cvt_pk_bf16_f32 %0, %1, %2" : "=v"(r) : "v"(lo), "v"(hi)); return r; }

template <class Epi, class Sched, bool ALIGN_EPI = false, bool SP2 = false>
__device__ __forceinline__ void gemm_phase(PG8_LAS unsigned char* lds, const Gemm g, const Sched& S, const Epi& E) {
    int tid = threadIdx.x; asm volatile("" : "+v"(tid)); const int wid = __builtin_amdgcn_readfirstlane(tid >> 6), lane = tid & 63, wr = wid >> 2, wc = wid & 3, fr = lane & 15, fq = lane >> 4;
    const int K = g.K, nt = K / BK;
    unsigned voffA[2], voffB[2];
#pragma unroll
    for (int i = 0; i < 2; ++i) { int R, C; stage_rc(tid * 16 + i * 8192, R, C); const int Rb = Epi::PERM ? ((R & ~31) + perm32(R & 31)) : R;
        voffA[i] = (unsigned)(R * K + C) * 2u; voffB[i] = (unsigned)(Rb * K + C) * 2u; }
    const size_t kstep = (size_t)(BK * 2);
    const size_t hstep = (size_t)HALF * K * 2;
    const size_t tstep = 2 * hstep;
    const unsigned ldsw = (unsigned)wid * 1024u;
    const int aoff = lds_byte(wr * 64 + fr, fq * 8), boff = lds_byte(wc * 32 + fr, fq * 8);
#define PG8_SA(b, h) (((b) * 2 + (h)) * HTB)
#define PG8_SB(b, h) ((4 + (b) * 2 + (h)) * HTB)
#define PG8_STAGE(bufoff, gbase, voff) do { _Pragma("unroll") for (int _i = 0; _i < 2; ++_i) \
        __builtin_amdgcn_global_load_lds((const unsigned*)((const char*)(gbase) + (voff)[_i]), (PG8_LAS unsigned*)(lds + (bufoff) + ldsw + _i * 8192), 16, 0, 0); } while (0)
#define PG8_LDA(dst, b, h) do { _Pragma("unroll") for (int m = 0; m < 4; ++m) _Pragma("unroll") for (int k = 0; k < 2; ++k) dst[m][k] = *(const PG8_LAS bf16x8*)(lds + PG8_SA(b, h) + aoff + m * 2048 + k * 1024); } while (0)
#define PG8_LDB(dst, b, h) do { _Pragma("unroll") for (int n = 0; n < 2; ++n) _Pragma("unroll") for (int k = 0; k < 2; ++k) dst[n][k] = *(const PG8_LAS bf16x8*)(lds + PG8_SB(b, h) + boff + n * 2048 + k * 1024); } while (0)
#define PG8_MMA(ai, bj, At, Bt) do { __builtin_amdgcn_s_setprio(1); _Pragma("unroll") for (int m = 0; m < 4; ++m) _Pragma("unroll") for (int n = 0; n < 2; ++n) _Pragma("unroll") for (int k = 0; k < 2; ++k) \
        acc[ai][bj][m][n] = __builtin_amdgcn_mfma_f32_16x16x32_bf16(Bt[n][k], At[m][k], acc[ai][bj][m][n], 0, 0, 0); __builtin_amdgcn_s_setprio(0); } while (0)
#define PG8_WAIT_V(n) asm volatile("s_waitcnt vmcnt(" #n ")" ::: "memory")
#define PG8_WAIT_L(n) asm volatile("s_waitcnt lgkmcnt(" #n ")" ::: "memory")
#define PG8_BAR __builtin_amdgcn_s_barrier()
#define PG8_SCHED __builtin_amdgcn_sched_barrier(0)
    Unit cur, nxt; int ui = 0;
    if (!S.next(0, cur)) return;
    f32x4 acc[2][2][4][2];
#pragma unroll
    for (int a = 0; a < 2; ++a)
#pragma unroll
        for (int b = 0; b < 2; ++b)
#pragma unroll
            for (int m = 0; m < 4; ++m)
#pragma unroll
                for (int n = 0; n < 2; ++n) acc[a][b][m][n] = (f32x4){0.f, 0.f, 0.f, 0.f};
    bf16x8 At[4][2], B0[2][2], B1[2][2];
    const char* cA = (const char*)g.A + (size_t)cur.pm * tstep; const char* cB = (const char*)g.Bt + (size_t)cur.pn * tstep;
    S.a_ready(cur);
    if constexpr (SP2) {
        PG8_STAGE(PG8_SB(0, 0), cB, voffB); PG8_STAGE(PG8_SB(0, 1), cB + hstep, voffB); PG8_STAGE(PG8_SA(0, 0), cA, voffA); PG8_STAGE(PG8_SA(0, 1), cA + hstep, voffA);
        if (wr == 1) PG8_BAR;
        PG8_WAIT_V(2); PG8_BAR;
        PG8_STAGE(PG8_SB(1, 0), cB + kstep, voffB); PG8_STAGE(PG8_SA(1, 0), cA + kstep, voffA); PG8_STAGE(PG8_SB(1, 1), cB + hstep + kstep, voffB);
        PG8_WAIT_V(6); PG8_BAR;
    } else {
        PG8_STAGE(PG8_SB(0, 0), cB, voffB); PG8_STAGE(PG8_SA(0, 0), cA, voffA); PG8_STAGE(PG8_SB(0, 1), cB + hstep, voffB); PG8_STAGE(PG8_SA(0, 1), cA + hstep, voffA);
        if (wr == 1) PG8_BAR;
        PG8_WAIT_V(4); PG8_BAR;
        PG8_STAGE(PG8_SB(1, 0), cB + kstep, voffB); PG8_STAGE(PG8_SA(1, 0), cA + kstep, voffA); PG8_STAGE(PG8_SB(1, 1), cB + hstep + kstep, voffB);
        PG8_WAIT_V(6); PG8_BAR;
    }
    for (;;) {
        const bool has_next = S.next(ui + 1, nxt);
        const char* nA = has_next ? (const char*)g.A + (size_t)nxt.pm * tstep : cA; const char* nB = has_next ? (const char*)g.Bt + (size_t)nxt.pn * tstep : cB;
        for (int t = 0; t < nt; t += 2) {
            const bool last = (t == nt - 2);
            const char* a1 = cA + (size_t)(t + 1) * kstep;
            const char* a2 = last ? nA : cA + (size_t)(t + 2) * kstep; const char* b2 = last ? nB : cB + (size_t)(t + 2) * kstep;
            const char* a3 = a2 + kstep; const char* b3 = b2 + kstep;
            if (last && has_next) S.a_ready(nxt);
            if constexpr (SP2) {
            PG8_LDB(B0, 0, 0); PG8_LDB(B1, 0, 1); PG8_SCHED; PG8_LDA(At, 0, 0); PG8_STAGE(PG8_SA(1, 1), a1 + hstep, voffA);
            PG8_WAIT_V(8); PG8_WAIT_L(0); PG8_BAR; PG8_MMA(0, 0, At, B0); PG8_MMA(0, 1, At, B1); PG8_BAR; PG8_SCHED;
            PG8_LDA(At, 0, 1); PG8_STAGE(PG8_SB(0, 0), b2, voffB); PG8_STAGE(PG8_SB(0, 1), b2 + hstep, voffB); PG8_STAGE(PG8_SA(0, 0), a2, voffA);
            PG8_WAIT_V(8); PG8_WAIT_L(0); PG8_BAR; PG8_MMA(1, 0, At, B0); PG8_MMA(1, 1, At, B1); PG8_BAR; PG8_SCHED;
            PG8_LDB(B0, 1, 0); PG8_LDB(B1, 1, 1); PG8_SCHED; PG8_LDA(At, 1, 0); PG8_STAGE(PG8_SA(0, 1), a2 + hstep, voffA);
            PG8_WAIT_V(8); PG8_WAIT_L(0); PG8_BAR; PG8_MMA(0, 0, At, B0); PG8_MMA(0, 1, At, B1); PG8_BAR; PG8_SCHED;
            PG8_LDA(At, 1, 1); PG8_STAGE(PG8_SB(1, 0), b3, voffB); PG8_STAGE(PG8_SB(1, 1), b3 + hstep, voffB); PG8_STAGE(PG8_SA(1, 0), a3, voffA);
            PG8_WAIT_V(8); PG8_WAIT_L(0); PG8_BAR; PG8_MMA(1, 0, At, B0); PG8_MMA(1, 1, At, B1); PG8_BAR; PG8_SCHED;
            } else {
            PG8_LDB(B0, 0, 0); PG8_SCHED; PG8_LDA(At, 0, 0); PG8_STAGE(PG8_SA(1, 1), a1 + hstep, voffA);
            PG8_WAIT_L(8); PG8_BAR; PG8_WAIT_L(0); PG8_MMA(0, 0, At, B0); PG8_BAR; PG8_SCHED;
            PG8_LDB(B1, 0, 1); PG8_STAGE(PG8_SB(0, 0), b2, voffB);
            PG8_BAR; PG8_WAIT_L(0); PG8_MMA(0, 1, At, B1); PG8_BAR;
            PG8_LDA(At, 0, 1); PG8_STAGE(PG8_SA(0, 0), a2, voffA);
            PG8_BAR; PG8_WAIT_L(0); PG8_MMA(1, 0, At, B0); PG8_BAR; PG8_SCHED;
            PG8_STAGE(PG8_SB(0, 1), b2 + hstep, voffB);
            PG8_WAIT_V(6); PG8_BAR; PG8_MMA(1, 1, At, B1); PG8_BAR;
            PG8_LDB(B0, 1, 0); PG8_SCHED; PG8_LDA(At, 1, 0); PG8_STAGE(PG8_SA(0, 1), a2 + hstep, voffA);
            PG8_WAIT_L(8); PG8_BAR; PG8_WAIT_L(0); PG8_MMA(0, 0, At, B0); PG8_BAR; PG8_SCHED;
            PG8_LDB(B1, 1, 1); PG8_STAGE(PG8_SB(1, 0), b3, voffB);
            PG8_BAR; PG8_WAIT_L(0); PG8_MMA(0, 1, At, B1); PG8_BAR;
            PG8_LDA(At, 1, 1); PG8_STAGE(PG8_SA(1, 0), a3, voffA);
            PG8_BAR; PG8_WAIT_L(0); PG8_MMA(1, 0, At, B0); PG8_BAR; PG8_SCHED;
            PG8_STAGE(PG8_SB(1, 1), b3 + hstep, voffB);
            PG8_WAIT_V(6); PG8_BAR; PG8_MMA(1, 1, At, B1); PG8_BAR;
            }
        }
        if constexpr (ALIGN_EPI) { if (wr == 0) PG8_BAR; }
        E(acc, cur, wr, wc, fr, fq); S.done(cur);
        if (!has_next) break;
#pragma unroll
        for (int a = 0; a < 2; ++a)
#pragma unroll
            for (int b = 0; b < 2; ++b)
#pragma unroll
                for (int m = 0; m < 4; ++m)
#pragma unroll
                    for (int n = 0; n < 2; ++n) acc[a][b][m][n] = (f32x4){0.f, 0.f, 0.f, 0.f};
        cur = nxt; cA = nA; cB = nB; ++ui;
        if constexpr (ALIGN_EPI) { if (wr == 1) PG8_BAR; }
    }
    PG8_WAIT_V(0);
    if constexpr (!ALIGN_EPI) { if (wr == 0) PG8_BAR; }
    PG8_BAR;
#undef PG8_SA
#undef PG8_SB
#undef PG8_STAGE
#undef PG8_LDA
#undef PG8_LDB
#undef PG8_MMA
#undef PG8_WAIT_V
#undef PG8_WAIT_L
#undef PG8_BAR
#undef PG8_SCHED
}
}

__device__ __forceinline__ unsigned f2bf(float f) { unsigned u = __builtin_bit_cast(unsigned, f); return (u + 0x7fffu + ((u >> 16) & 1u)) >> 16; }
__device__ __forceinline__ unsigned pk2(float lo, float hi) { return f2bf(lo) | (f2bf(hi) << 16); }
__device__ __forceinline__ float bflo(unsigned w) { return __builtin_bit_cast(float, w << 16); }
__device__ __forceinline__ float bfhi(unsigned w) { return __builtin_bit_cast(float, w & 0xffff0000u); }
__device__ __forceinline__ float fast_sigmoid(float t) { return __builtin_amdgcn_rcpf(1.0f + __builtin_amdgcn_exp2f(-1.44269504089f * t)); }
__device__ __forceinline__ float gelu_tanh(float x) { const float t = x * (1.5957691216f + 0.0713548163f * x * x); return x * fast_sigmoid(t); }
__device__ __forceinline__ float wave_sum(float v) {
#pragma unroll
    for (int o = 1; o < 64; o <<= 1) v += __shfl_xor(v, o);
    return v;
}
#define LDS_WAIT() asm volatile("s_waitcnt lgkmcnt(0)" ::: "memory")
#define VM_WAIT() asm volatile("s_waitcnt vmcnt(0)" ::: "memory")
#define RLX_AGENT __ATOMIC_RELAXED, __HIP_MEMORY_SCOPE_AGENT

constexpr size_t MiB = 1u << 20;
constexpr size_t WS_CTL = 0, CTL_ZERO_BYTES = 1 * MiB;
constexpr size_t WS_MOD   = 1 * MiB;
constexpr size_t WS_AT    = WS_MOD + 128 * 1024;
constexpr size_t WS_STATS = WS_AT + 128 * 1024;
constexpr size_t WS_SCL   = 1 * MiB + 512 * 1024;
constexpr size_t WS_KEYS  = 2 * MiB;
constexpr size_t WS_GWS   = 3 * MiB;
constexpr size_t WS_WIN   = 4 * MiB;
constexpr size_t WS_GLU   = 28 * MiB;
constexpr size_t WS_WOUT  = 32 * MiB;
constexpr size_t WS_WQ    = 48 * MiB;
constexpr size_t WS_KTAB  = 64 * MiB;
constexpr size_t WS_WG    = 72 * MiB;
constexpr size_t WS_VG    = 104 * MiB;
constexpr size_t WS_UV    = 136 * MiB;
constexpr size_t WS_X     = 392 * MiB;
constexpr size_t WS_H     = 520 * MiB;
constexpr size_t WS_Z     = 584 * MiB;
constexpr size_t WS_XS    = 648 * MiB;
constexpr size_t WS_SLOC  = 680 * MiB;
constexpr size_t WS_HS    = 688 * MiB;
constexpr size_t WS_G     = 692 * MiB;
constexpr size_t WS_MIX   = 724 * MiB;
constexpr size_t WS_EID   = 788 * MiB;
constexpr size_t WS_GATE  = 796 * MiB;
constexpr size_t WS_SU    = 804 * MiB;
constexpr size_t WS_END   = 812 * MiB;
constexpr size_t WS_DBG   = 812 * MiB;
constexpr int CW_BAR = 4096;
constexpr int CW_FLAG = 2048;
constexpr int CW_QUEUE = 16384;

constexpr int LDS_BYTES = 163840;
constexpr int MISC_OFF = LDS_BYTES - 256;

#define XB_TMO      128
#define XB_XCNT(j)  (256  + 64 * (j))
#define XB_XSUB(j)  (1280 + 64 * (j))
#define XB_XGEN(j)  (2304 + 64 * (j))
#define XB_TOP      3328
#define XB_TOPGEN   3392
#define XCD_BAR_WORDS 3456
#define XB_SPIN_CAP (1u << 24)
__device__ __forceinline__ unsigned xb_ld(unsigned* p)              { return __hip_atomic_load(p, __ATOMIC_RELAXED, __HIP_MEMORY_SCOPE_AGENT); }
__device__ __forceinline__ unsigned xb_add(unsigned* p, unsigned v) { return __hip_atomic_fetch_add(p, v, __ATOMIC_RELAXED, __HIP_MEMORY_SCOPE_AGENT); }
__device__ __forceinline__ unsigned xb_xcc_id() { return (unsigned)__builtin_amdgcn_s_getreg((3 << 11) | 20) & 0xFu; }
#define XB_SPIN(cond, bar) do { unsigned _sp = 0; while (cond) { __builtin_amdgcn_s_sleep(1); \
    if ((++_sp & 255u) == 0u) { if (xb_ld(&(bar)[XB_TMO])) break; if (_sp > XB_SPIN_CAP) { atomicAdd(&(bar)[XB_TMO], 1u); break; } } } } while (0)
struct XcdBarrier { unsigned* bar; unsigned x; volatile LAS unsigned* st; };
__device__ __forceinline__ XcdBarrier xcd_barrier_post(unsigned* bar, volatile LAS unsigned* st) {
    XcdBarrier b; b.bar = bar; b.x = xb_xcc_id(); b.st = st;
    if (threadIdx.x == 0) (void)xb_add(&bar[XB_XCNT(b.x)], 1u);
    return b;
}
__device__ __forceinline__ void xcd_barrier_complete(unsigned* bar, unsigned x, unsigned& nloc, unsigned& nx) {
    const unsigned G = gridDim.x * gridDim.y * gridDim.z;
    unsigned sum, cnt, mine, sp = 0u;
    for (;;) {
        sum = 0u; cnt = 0u; mine = 0u;
#pragma unroll
        for (unsigned j = 0; j < 16; ++j) { const unsigned c = xb_ld(&bar[XB_XCNT(j)]); sum += c; cnt += (c > 0u) ? 1u : 0u; mine = (j == x) ? c : mine; }
        if (sum == G) break;
        __builtin_amdgcn_s_sleep(1);
        if ((++sp & 255u) == 0u) { if (xb_ld(&bar[XB_TMO])) break; if (sp > XB_SPIN_CAP) { atomicAdd(&bar[XB_TMO], 1u); break; } }
    }
    nloc = mine > 0u ? mine : 1u; nx = cnt > 0u ? cnt : 1u;
}
__device__ __forceinline__ void xcd_barrier(const XcdBarrier& b) {
    asm volatile("s_waitcnt vmcnt(0)" ::: "memory");
    __syncthreads();
    if (threadIdx.x == 0) {
        unsigned* bar = b.bar;
        __builtin_amdgcn_s_waitcnt(0);
        unsigned nloc = b.st[0], nx = b.st[1];
        if (nloc == 0u) { xcd_barrier_complete(bar, b.x, nloc, nx); b.st[0] = nloc; b.st[1] = nx; }
        const unsigned old = xb_add(&bar[XB_XSUB(b.x)], 1u);
        const unsigned gen = old / nloc;
        if (old + 1u == (gen + 1u) * nloc) {
            __builtin_amdgcn_fence(__ATOMIC_RELEASE, "agent");
            asm volatile("s_waitcnt vmcnt(0)" ::: "memory");
            const unsigned og = xb_add(&bar[XB_TOP], 1u);
            const unsigned tg = og / nx;
            if (og + 1u == (tg + 1u) * nx) xb_add(&bar[XB_TOPGEN], 1u);
            else XB_SPIN(xb_ld(&bar[XB_TOPGEN]) == tg, bar);
            __builtin_amdgcn_fence(__ATOMIC_ACQUIRE, "agent");
            xb_add(&bar[XB_XGEN(b.x)], 1u);
            asm volatile("s_waitcnt vmcnt(0)" ::: "memory");
        } else {
            XB_SPIN(xb_ld(&bar[XB_XGEN(b.x)]) == gen, bar);
            __builtin_amdgcn_fence(__ATOMIC_ACQUIRE, "agent");
            asm volatile("s_waitcnt vmcnt(0)" ::: "memory");
        }
    }
    __syncthreads();
}

struct Args { const float* in[29]; float* out; unsigned char* ws; int ph_lo, ph_hi, li, pad; };
enum { I_X = 0, I_C, I_WMOD, I_BMOD, I_N1G, I_WIN, I_BIN, I_LNG, I_LNB, I_GWS, I_GBS, I_LRE, I_LIM, I_LDT, I_BRE, I_BIM, I_CRE, I_CIM, I_SD, I_GLUW, I_GLUB,
       I_BRG, I_WOUT, I_N2G, I_WQ, I_KEYS, I_PU, I_PV, I_FG };

struct Frame {
    LAS unsigned char* lds;
    unsigned char* ws;
    const float* const* in;
    float* out;
    int tid, lane, wave, vcu, G;
};

#define PH_LOCALS int tid = F.tid; asm volatile("" : "+v"(tid)); const int lane = tid & 63; const int wave = __builtin_amdgcn_readfirstlane(tid >> 6); (void)lane; (void)wave;

struct EpiIn {
    static constexpr bool PERM = true, AFTER_DRAIN = false;
    bf16* Z; bf16* XS; const float* bias;
    __device__ __forceinline__ void operator()(const f32x4 (&acc)[2][2][4][2], const pg8::Unit& u, int wr, int wc, int fr, int fq) const {
        const int row0 = u.pm * 256 + wr * 64 + fr, col0 = u.pn * 256 + wc * 32 + 8 * fq;
        f32x4 bv[2][2];
#pragma unroll
        for (int bj = 0; bj < 2; ++bj)
#pragma unroll
            for (int n = 0; n < 2; ++n) bv[bj][n] = *(const f32x4*)(bias + col0 + bj * 128 + 4 * n);
        const bool isz = (u.pn < 8);
#pragma unroll
        for (int ai = 0; ai < 2; ++ai)
#pragma unroll
            for (int m = 0; m < 4; ++m) {
                const int r = row0 + ai * 128 + m * 16;
#pragma unroll
                for (int bj = 0; bj < 2; ++bj) {
                    f32x4 v0 = acc[ai][bj][m][0] + bv[bj][0], v1 = acc[ai][bj][m][1] + bv[bj][1];
                    const int c = col0 + bj * 128;
                    u32x4 w;
                    if (isz) {
                        w.x = pg8::cvt_pk_bf16(gelu_tanh(v0[0]), gelu_tanh(v0[1])); w.y = pg8::cvt_pk_bf16(gelu_tanh(v0[2]), gelu_tanh(v0[3]));
                        w.z = pg8::cvt_pk_bf16(gelu_tanh(v1[0]), gelu_tanh(v1[1])); w.w = pg8::cvt_pk_bf16(gelu_tanh(v1[2]), gelu_tanh(v1[3]));
                        *(u32x4*)(Z + (size_t)r * 2048 + c) = w;
                    } else {
                        w.x = pg8::cvt_pk_bf16(v0[0], v0[1]); w.y = pg8::cvt_pk_bf16(v0[2], v0[3]); w.z = pg8::cvt_pk_bf16(v1[0], v1[1]); w.w = pg8::cvt_pk_bf16(v1[2], v1[3]);
                        const int cc = c - 2048, g = cc >> 4, i = cc & 15;
                        *(u32x4*)(XS + ((size_t)(g * 256 + (r >> 6)) * 64 + (r & 63)) * 16 + i) = w;
                    }
                }
            }
    }
};
struct EpiGlu {
    static constexpr bool PERM = true, AFTER_DRAIN = false;
    const bf16* Gb; bf16* MIX; const float* bias;
    __device__ __forceinline__ void operator()(const f32x4 (&acc)[2][2][4][2], const pg8::Unit& u, int wr, int wc, int fr, int fq) const {
        const int row0 = u.pm * 256 + wr * 64 + fr, col0 = u.pn * 256 + wc * 32 + 8 * fq;
        f32x4 bv[2][2];
#pragma unroll
        for (int bj = 0; bj < 2; ++bj)
#pragma unroll
            for (int n = 0; n < 2; ++n) bv[bj][n] = *(const f32x4*)(bias + col0 + bj * 128 + 4 * n);
#pragma unroll
        for (int ai = 0; ai < 2; ++ai)
#pragma unroll
            for (int m = 0; m < 4; ++m) {
                const int r = row0 + ai * 128 + m * 16;
#pragma unroll
                for (int bj = 0; bj < 2; ++bj) {
                    const f32x4 v0 = acc[ai][bj][m][0] + bv[bj][0], v1 = acc[ai][bj][m][1] + bv[bj][1];
                    const int c = col0 + bj * 128;
                    const u32x4 gw = *(const u32x4*)(Gb + (size_t)r * 1024 + c);
                    u32x4 w;
                    w.x = pg8::cvt_pk_bf16(bflo(gw.x) * fast_sigmoid(v0[0]), bfhi(gw.x) * fast_sigmoid(v0[1]));
                    w.y = pg8::cvt_pk_bf16(bflo(gw.y) * fast_sigmoid(v0[2]), bfhi(gw.y) * fast_sigmoid(v0[3]));
                    w.z = pg8::cvt_pk_bf16(bflo(gw.z) * fast_sigmoid(v1[0]), bfhi(gw.z) * fast_sigmoid(v1[1]));
                    w.w = pg8::cvt_pk_bf16(bflo(gw.w) * fast_sigmoid(v1[2]), bfhi(gw.w) * fast_sigmoid(v1[3]));
                    *(u32x4*)(MIX + (size_t)r * 2048 + 1024 + c) = w;
                }
            }
    }
};
struct EpiOut {
    static constexpr bool PERM = true, AFTER_DRAIN = false;
    const float* xin; float* X; const float* gate;
    __device__ __forceinline__ void operator()(const f32x4 (&acc)[2][2][4][2], const pg8::Unit& u, int wr, int wc, int fr, int fq) const {
        const int row0 = u.pm * 256 + wr * 64 + fr, col0 = u.pn * 256 + wc * 32 + 8 * fq;
        f32x4 gv[2][2];
#pragma unroll
        for (int bj = 0; bj < 2; ++bj)
#pragma unroll
            for (int n = 0; n < 2; ++n) gv[bj][n] = *(const f32x4*)(gate + col0 + bj * 128 + 4 * n);
#pragma unroll
        for (int ai = 0; ai < 2; ++ai)
#pragma unroll
            for (int m = 0; m < 4; ++m) {
                const int r = row0 + ai * 128 + m * 16;
#pragma unroll
                for (int bj = 0; bj < 2; ++bj) {
                    const size_t off = (size_t)r * 2048 + col0 + bj * 128;
                    const f32x4 x0 = *(const f32x4*)(xin + off), x1 = *(const f32x4*)(xin + off + 4);
                    *(f32x4*)(X + off) = x0 + gv[bj][0] * acc[ai][bj][m][0];
                    *(f32x4*)(X + off + 4) = x1 + gv[bj][1] * acc[ai][bj][m][1];
                }
            }
    }
};
struct EpiQ {
    static constexpr bool PERM = true, AFTER_DRAIN = false;
    bf16* Q;
    __device__ __forceinline__ void operator()(const f32x4 (&acc)[2][2][4][2], const pg8::Unit& u, int wr, int wc, int fr, int fq) const {
        const int row0 = u.pm * 256 + wr * 64 + fr, col0 = u.pn * 256 + wc * 32 + 8 * fq;
#pragma unroll
        for (int ai = 0; ai < 2; ++ai)
#pragma unroll
            for (int m = 0; m < 4; ++m) {
                const int r = row0 + ai * 128 + m * 16;
#pragma unroll
                for (int bj = 0; bj < 2; ++bj) {
                    const f32x4 v0 = acc[ai][bj][m][0], v1 = acc[ai][bj][m][1];
                    u32x4 w; w.x = pg8::cvt_pk_bf16(v0[0], v0[1]); w.y = pg8::cvt_pk_bf16(v0[2], v0[3]); w.z = pg8::cvt_pk_bf16(v1[0], v1[1]); w.w = pg8::cvt_pk_bf16(v1[2], v1[3]);
                    *(u32x4*)(Q + (size_t)r * 2048 + col0 + bj * 128) = w;
                }
            }
    }
};

__device__ __forceinline__ void p0_transpose_item(const float* W, int K, int N, bf16* WT, const float* kscale, LAS float* scr, int item, int lane) {
    const int nblk = N / 32, kb = item / nblk, nb = item % nblk, k0 = 64 * kb, n0 = 32 * nb;
#pragma unroll 8
    for (int i = 0; i < 32; ++i) { const int kk = 2 * i + (lane >> 5); float v = W[(size_t)(k0 + kk) * N + n0 + (lane & 31)]; if (kscale) v *= kscale[k0 + kk]; scr[kk * 33 + (lane & 31)] = v; }
    LDS_WAIT(); asm volatile("" ::: "memory");
    const int c = lane & 7;
#pragma unroll
    for (int j = 0; j < 4; ++j) { const int n = (lane >> 3) + 8 * j; const LAS float* s = scr + (8 * c) * 33 + n;
        u32x4 o; o.x = pk2(s[0 * 33], s[1 * 33]); o.y = pk2(s[2 * 33], s[3 * 33]); o.z = pk2(s[4 * 33], s[5 * 33]); o.w = pk2(s[6 * 33], s[7 * 33]);
        *(u32x4*)(WT + (size_t)(n0 + n) * K + k0 + 8 * c) = o; }
    LDS_WAIT(); asm volatile("" ::: "memory");
}

__device__ __forceinline__ void norm_mod_row(const f32x4 (&v)[4][2], const float* gain, const float* scale, const float* shift, int lane, u32x4 (&o)[4]) {
    float s = 0.f;
#pragma unroll
    for (int j = 0; j < 4; ++j)
#pragma unroll
        for (int h = 0; h < 2; ++h) s += (v[j][h][0] * v[j][h][0] + v[j][h][1] * v[j][h][1]) + (v[j][h][2] * v[j][h][2] + v[j][h][3] * v[j][h][3]);
    const float rr = 1.0f / sqrtf(wave_sum(s) * (1.0f / DM) + EPS);
#pragma unroll
    for (int j = 0; j < 4; ++j) {
        const int c = j * 512 + lane * 8;
        f32x4 y[2];
#pragma unroll
        for (int h = 0; h < 2; ++h) {
            const f32x4 g = *(const f32x4*)(gain + c + 4 * h);
            y[h] = v[j][h] * rr * g;
            const f32x4 sc = *(const f32x4*)(scale + c + 4 * h), sh = *(const f32x4*)(shift + c + 4 * h); y[h] = y[h] * (sc + 1.0f) + sh;
        }
        o[j].x = pk2(y[0][0], y[0][1]); o[j].y = pk2(y[0][2], y[0][3]); o[j].z = pk2(y[1][0], y[1][1]); o[j].w = pk2(y[1][2], y[1][3]);
    }
}
__device__ __forceinline__ void norm_row_pass(const float* xrow, bf16* hrow, const float* gain, const float* scale, const float* shift, int lane) {
    f32x4 v[4][2];
#pragma unroll
    for (int j = 0; j < 4; ++j) { v[j][0] = *(const f32x4*)(xrow + j * 512 + lane * 8); v[j][1] = *(const f32x4*)(xrow + j * 512 + lane * 8 + 4); }
    u32x4 o[4]; norm_mod_row(v, gain, scale, shift, lane, o);
#pragma unroll
    for (int j = 0; j < 4; ++j) *(u32x4*)(hrow + j * 512 + lane * 8) = o[j];
}

__device__ __forceinline__ void p0_prologue(Frame& F) {
    PH_LOCALS
    const int gw = F.vcu * NWAVES + wave, NGW = F.G * NWAVES;
    const int gt = F.vcu * NTHR + tid, NGT = F.G * NTHR;
    if ((int)blockIdx.x < 192) {
        const int l = blockIdx.x / 96, cb = blockIdx.x % 96;
        LAS float* sc = (LAS float*)F.lds;
        LAS float* red = (LAS float*)(F.lds + 8192);
        for (int k = tid; k < DM; k += NTHR) { const float c = F.in[I_C][k]; sc[k] = c * fast_sigmoid(c); }
        __syncthreads();
        const int tx = tid & 31, ty = tid >> 5;
        const float* W = F.in[I_WMOD] + (size_t)l * DM * 12288 + cb * 128 + tx * 4;
        f32x4 a = {0.f, 0.f, 0.f, 0.f};
#pragma unroll 8
        for (int k = ty; k < DM; k += 16) { const f32x4 w = *(const f32x4*)(W + (size_t)k * 12288); a += w * sc[k]; }
        *(LAS f32x4*)(red + ty * 128 + tx * 4) = a;
        __syncthreads();
        if (tid < 128) { float s = 0.f;
#pragma unroll
            for (int y = 0; y < 16; ++y) s += red[y * 128 + tid];
            ((float*)(F.ws + WS_MOD))[l * 12288 + cb * 128 + tid] = s + F.in[I_BMOD][l * 12288 + cb * 128 + tid]; }
        __syncthreads();
    }
    if ((int)blockIdx.x >= 128) {
        const int u = 255 - (int)blockIdx.x, l = u >> 6, g = u & 63;
        LAS float* apr = (LAS float*)F.lds;
        LAS float* api = apr + 65 * 64;
        LAS float* bbr = api + 65 * 64;
        LAS float* bbi = bbr + 1024;
        LAS float* ccr = bbi + 1024;
        LAS float* cci = ccr + 1024;
        const float dt = expf(F.in[I_LDT][l * 64 + g]);
        const float* lre = F.in[I_LRE] + (l * 64 + g) * 64; const float* lim = F.in[I_LIM] + (l * 64 + g) * 64;
        for (int idx = tid; idx < 65 * 64; idx += NTHR) { const int d = idx >> 6, p = idx & 63;
            const float mag = expf(lre[p] * dt * (float)d); float sn, cs; sincosf(lim[p] * dt * (float)d, &sn, &cs);
            apr[idx] = mag * cs; api[idx] = mag * sn; }
        for (int idx = tid; idx < 1024; idx += NTHR) { const int o = idx >> 6, p = idx & 63;
            ccr[idx] = F.in[I_CRE][((size_t)(l * 64 + g) * 16 + o) * 64 + p]; cci[idx] = F.in[I_CIM][((size_t)(l * 64 + g) * 16 + o) * 64 + p]; }
        __syncthreads();
        for (int idx = tid; idx < 1024; idx += NTHR) { const int p = idx >> 4, i = idx & 15;
            const float xr = apr[64 + p] - 1.0f, xi = api[64 + p], lr = lre[p], li = lim[p], den = 1.0f / (lr * lr + li * li);
            const float cr = (xr * lr + xi * li) * den, ci = (xi * lr - xr * li) * den;
            const float br = F.in[I_BRE][((size_t)(l * 64 + g) * 64 + p) * 16 + i], bi = F.in[I_BIM][((size_t)(l * 64 + g) * 64 + p) * 16 + i];
            bbr[idx] = cr * br - ci * bi; bbi[idx] = cr * bi + ci * br; }
        __syncthreads();
        bf16* KT = (bf16*)(F.ws + WS_KTAB) + (size_t)(l * 64 + g) * 80 * 256;
        for (int idx = tid; idx < 80 * 256; idx += NTHR) {
            const int d = (idx >> 8) - 16, o = (idx >> 4) & 15, i = idx & 15; float s = 0.f;
            if (d >= 0) {
                for (int p = 0; p < 64; ++p) { const float ar = apr[d * 64 + p], ai = api[d * 64 + p], cr = ccr[o * 64 + p], ci = cci[o * 64 + p];
                    const float er = cr * ar - ci * ai, ei = cr * ai + ci * ar; s += er * bbr[p * 16 + i] - ei * bbi[p * 16 + i]; }
#if !SELFTEST_S5
                if (d == 0 && o == i) s += F.in[I_SD][l * 1024 + g * 16 + o];
#endif
            }
            KT[idx] = (bf16)f2bf(s);
        }
        bf16* WG = (bf16*)(F.ws + WS_WG) + (size_t)(l * 64 + g) * 128 * 1024;
        for (int idx = tid; idx < 64 * 1024; idx += NTHR) { const int p = idx >> 10, k = idx & 1023, tau = k >> 4, i = k & 15;
            const float ar = apr[(63 - tau) * 64 + p], ai = api[(63 - tau) * 64 + p], br = bbr[p * 16 + i], bi = bbi[p * 16 + i];
            WG[(size_t)p * 1024 + k] = (bf16)f2bf(ar * br - ai * bi); WG[(size_t)(64 + p) * 1024 + k] = (bf16)f2bf(ar * bi + ai * br); }
        bf16* VG = (bf16*)(F.ws + WS_VG) + (size_t)(l * 64 + g) * 1024 * 128;
        for (int idx = tid; idx < 1024 * 64; idx += NTHR) { const int m = idx >> 6, p = idx & 63, t = m >> 4, o = m & 15;
            const float ar = apr[(t + 1) * 64 + p], ai = api[(t + 1) * 64 + p], cr = ccr[o * 64 + p], ci = cci[o * 64 + p];
            VG[(size_t)m * 128 + p] = (bf16)f2bf(cr * ar - ci * ai); VG[(size_t)m * 128 + 64 + p] = (bf16)f2bf(-(cr * ai + ci * ar)); }
        if (tid < 64) { float* AT = (float*)(F.ws + WS_AT) + ((size_t)(l * 64 + g) * 64 + tid) * 2; AT[0] = apr[64 * 64 + tid]; AT[1] = api[64 * 64 + tid]; }
        __syncthreads();
    }
    {
        LAS float* scr = (LAS float*)(F.lds + wave * 16384);
        constexpr int I_IN = (DM / 64) * (INW / 32), I_GL = (WB / 64) * (WB / 32), I_OU = (DM / 64) * (DM / 32), I_Q = I_OU;
        constexpr int PER_L = I_IN + I_GL + I_OU + I_Q;
        for (int it = gw; it < 2 * PER_L; it += NGW) {
            const int l = it / PER_L; int r = it % PER_L;
            if (r < I_IN) { p0_transpose_item(F.in[I_WIN] + (size_t)l * DM * INW, DM, INW, (bf16*)(F.ws + WS_WIN) + (size_t)l * INW * DM, nullptr, scr, r, lane); continue; } r -= I_IN;
            if (r < I_GL) { p0_transpose_item(F.in[I_GLUW] + (size_t)l * WB * WB, WB, WB, (bf16*)(F.ws + WS_GLU) + (size_t)l * WB * WB, nullptr, scr, r, lane); continue; } r -= I_GL;
            if (r < I_OU) { p0_transpose_item(F.in[I_WOUT] + (size_t)l * DM * DM, DM, DM, (bf16*)(F.ws + WS_WOUT) + (size_t)l * DM * DM, F.in[I_BRG] + l * DM, scr, r, lane); continue; } r -= I_OU;
            p0_transpose_item(F.in[I_WQ] + (size_t)l * DM * DM, DM, DM, (bf16*)(F.ws + WS_WQ) + (size_t)l * DM * DM, nullptr, scr, r, lane);
        }
    }
    {
        bf16* KB = (bf16*)(F.ws + WS_KEYS);
        for (int i = gt; i < 2 * 8 * 2 * 128 * 128 / 8; i += NGT) { const f32x4 a = *(const f32x4*)(F.in[I_KEYS] + (size_t)i * 8), b = *(const f32x4*)(F.in[I_KEYS] + (size_t)i * 8 + 4);
            u32x4 o; o.x = pk2(a[0], a[1]); o.y = pk2(a[2], a[3]); o.z = pk2(b[0], b[1]); o.w = pk2(b[2], b[3]); *(u32x4*)(KB + (size_t)i * 8) = o; }
        bf16* GW = (bf16*)(F.ws + WS_GWS);
        for (int i = gt; i < 2 * 8 * 128 * 128 / 8; i += NGT) { const int e = i * 8, jj = e & 127, ii = (e >> 7) & 127; const bool keep = (ii >= 64) || (jj < 64);
            f32x4 a = *(const f32x4*)(F.in[I_GWS] + (size_t)i * 8), b = *(const f32x4*)(F.in[I_GWS] + (size_t)i * 8 + 4);
            if (!keep) { a = (f32x4){0.f, 0.f, 0.f, 0.f}; b = a; }
            u32x4 o; o.x = pk2(a[0], a[1]); o.y = pk2(a[2], a[3]); o.z = pk2(b[0], b[1]); o.w = pk2(b[2], b[3]); *(u32x4*)(GW + (size_t)i * 8) = o; }
    }
    {
        unsigned char* UV = F.ws + WS_UV; float* SCL = (float*)(F.ws + WS_SCL);
        for (int r = gw; r < 2 * 2 * NEXP; r += NGW) {
            const int tbl = r >> 15, rr = r & 32767;
            const float* srcp = (tbl ? F.in[I_PV] : F.in[I_PU]) + (size_t)rr * 2048 + lane * 4;
            f32x4 v[8]; float am = 0.f;
#pragma unroll
            for (int j = 0; j < 8; ++j) { v[j] = *(const f32x4*)(srcp + j * 256); am = fmaxf(am, fmaxf(fmaxf(fabsf(v[j][0]), fabsf(v[j][1])), fmaxf(fabsf(v[j][2]), fabsf(v[j][3])))); }
#pragma unroll
            for (int o = 1; o < 64; o <<= 1) am = fmaxf(am, __shfl_xor(am, o));
            const float scale = am > 0.f ? am * (1.0f / 6.0f) : 1.0f, inv = am > 0.f ? 6.0f / am : 1.0f;
            u32x4 o;
#pragma unroll
            for (int d = 0; d < 4; ++d) { unsigned w = 0u;
                w = __builtin_amdgcn_cvt_scalef32_pk_fp4_f32(w, v[2 * d][0] * inv, v[2 * d][1] * inv, 1.0f, 0);
                w = __builtin_amdgcn_cvt_scalef32_pk_fp4_f32(w, v[2 * d][2] * inv, v[2 * d][3] * inv, 1.0f, 1);
                w = __builtin_amdgcn_cvt_scalef32_pk_fp4_f32(w, v[2 * d + 1][0] * inv, v[2 * d + 1][1] * inv, 1.0f, 2);
                w = __builtin_amdgcn_cvt_scalef32_pk_fp4_f32(w, v[2 * d + 1][2] * inv, v[2 * d + 1][3] * inv, 1.0f, 3);
                o[d] = w; }
            *(u32x4*)(UV + (size_t)rr * 2048 + tbl * 1024 + lane * 16) = o;
            if (lane == 0) SCL[rr * 2 + tbl] = scale;
        }
    }
}

__device__ __forceinline__ void phase_norm(Frame& F, const float* xsrc, const float* gain, const float* scale, const float* shift) {
    PH_LOCALS
    const int gw = F.vcu * NWAVES + wave, NGW = F.G * NWAVES;
    bf16* H = (bf16*)(F.ws + WS_H);
    for (int m = gw; m < M; m += NGW) norm_row_pass(xsrc + (size_t)m * DM, H + (size_t)m * DM, gain, scale, shift, lane);
}
__device__ __forceinline__ void phase_lnstats(Frame& F) {
    PH_LOCALS
    const int gw = F.vcu * NWAVES + wave, NGW = F.G * NWAVES;
    const bf16* Z = (const bf16*)(F.ws + WS_Z); float* ST = (float*)(F.ws + WS_STATS);
    for (int m = gw; m < M; m += NGW) {
        float v[16];
#pragma unroll
        for (int j = 0; j < 2; ++j) { const u32x4 w = *(const u32x4*)(Z + (size_t)m * 2048 + 1024 + j * 512 + lane * 8);
            v[j * 8 + 0] = bflo(w.x); v[j * 8 + 1] = bfhi(w.x); v[j * 8 + 2] = bflo(w.y); v[j * 8 + 3] = bfhi(w.y); v[j * 8 + 4] = bflo(w.z); v[j * 8 + 5] = bfhi(w.z); v[j * 8 + 6] = bflo(w.w); v[j * 8 + 7] = bfhi(w.w); }
        float s = 0.f;
#pragma unroll
        for (int i = 0; i < 16; ++i) s += v[i];
        const float mean = wave_sum(s) * (1.0f / 1024.0f); float q = 0.f;
#pragma unroll
        for (int i = 0; i < 16; ++i) { const float d = v[i] - mean; q += d * d; }
        const float rstd = 1.0f / sqrtf(wave_sum(q) * (1.0f / 1024.0f) + EPS);
        if (lane == 0) { ST[2 * m] = mean; ST[2 * m + 1] = rstd; }
    }
}
__device__ __forceinline__ void phase_branchnorm(Frame& F) {
    PH_LOCALS
    const int gw = F.vcu * NWAVES + wave, NGW = F.G * NWAVES;
    bf16* MIX = (bf16*)(F.ws + WS_MIX);
    for (int m = gw; m < M; m += NGW) {
        u32x4 w[4]; float sa = 0.f, sb = 0.f;
#pragma unroll
        for (int j = 0; j < 4; ++j) { w[j] = *(const u32x4*)(MIX + (size_t)m * 2048 + j * 512 + lane * 8);
            float q = 0.f;
#pragma unroll
            for (int e = 0; e < 4; ++e) { const float a = bflo(w[j][e]), b = bfhi(w[j][e]); q += a * a + b * b; }
            if (j < 2) sa += q; else sb += q; }
        const float ra = 1.0f / sqrtf(wave_sum(sa) * (1.0f / 1024.0f) + EPS), rb = 1.0f / sqrtf(wave_sum(sb) * (1.0f / 1024.0f) + EPS);
#pragma unroll
        for (int j = 0; j < 4; ++j) { const float r = j < 2 ? ra : rb; u32x4 o;
#pragma unroll
            for (int e = 0; e < 4; ++e) o[e] = pk2(bflo(w[j][e]) * r, bfhi(w[j][e]) * r);
            *(u32x4*)(MIX + (size_t)m * 2048 + j * 512 + lane * 8) = o; }
    }
}

__device__ __forceinline__ void phase_sloc(Frame& F, int l) {
    PH_LOCALS
    const bf16* XS = (const bf16*)(F.ws + WS_XS); const bf16* WG = (const bf16*)(F.ws + WS_WG) + (size_t)l * 64 * 128 * 1024; float* SL = (float*)(F.ws + WS_SLOC);
    const int fr = lane & 15, fq = lane >> 4;
    for (int u = F.vcu; u < 256; u += F.G) {
        const int g = u >> 2, n0 = (u & 3) * 64 + (wave & 3) * 16, jh = wave >> 2;
        f32x4 acc[4];
#pragma unroll
        for (int t = 0; t < 4; ++t) acc[t] = (f32x4){0.f, 0.f, 0.f, 0.f};
        const bf16* xp = XS + ((size_t)(g * 256 + n0 + fr)) * 1024 + 8 * fq;
        const bf16* wp = WG + ((size_t)(g * 128 + jh * 64 + fr)) * 1024 + 8 * fq;
#pragma unroll 8
        for (int kb = 0; kb < 32; ++kb) {
            const bf16x8 xf = *(const bf16x8*)(xp + kb * 32);
#pragma unroll
            for (int t = 0; t < 4; ++t) { const bf16x8 wf = *(const bf16x8*)(wp + (size_t)t * 16 * 1024 + kb * 32); acc[t] = __builtin_amdgcn_mfma_f32_16x16x32_bf16(wf, xf, acc[t], 0, 0, 0); }
        }
#pragma unroll
        for (int t = 0; t < 4; ++t) *(f32x4*)(SL + ((size_t)(g * 256 + n0 + fr)) * 128 + jh * 64 + t * 16 + 4 * fq) = acc[t];
    }
}
__device__ __forceinline__ void s5_carry(Frame& F, int l) {
    PH_LOCALS
    if (F.vcu < 64 && wave == 0) {
        const int g = F.vcu, p = lane;
        const float* AT = (const float*)(F.ws + WS_AT) + ((size_t)(l * 64 + g) * 64 + p) * 2; const float ar = AT[0], ai = AT[1];
        const float* SL = (const float*)(F.ws + WS_SLOC) + (size_t)g * 256 * 128; bf16* HS = (bf16*)(F.ws + WS_HS) + (size_t)g * 256 * 128;
        float hr = 0.f, hi = 0.f;
        for (int n0 = 0; n0 < 256; n0 += 8) {
            float sr[8], si[8];
#pragma unroll
            for (int e = 0; e < 8; ++e) { sr[e] = SL[(size_t)(n0 + e) * 128 + p]; si[e] = SL[(size_t)(n0 + e) * 128 + 64 + p]; }
#pragma unroll
            for (int e = 0; e < 8; ++e) { HS[(size_t)(n0 + e) * 128 + p] = (bf16)f2bf(hr); HS[(size_t)(n0 + e) * 128 + 64 + p] = (bf16)f2bf(hi);
                const float nr = ar * hr - ai * hi + sr[e], ni = ar * hi + ai * hr + si[e]; hr = nr; hi = ni; }
        }
    }
}

__device__ __forceinline__ void gating_unit(Frame& F, int l, int unit) {
    PH_LOCALS
    const int nb = unit >> 3, hh = unit & 7, t0 = nb * 128, c0 = hh * 128;
    const bf16* Z = (const bf16*)(F.ws + WS_Z); const float* ST = (const float*)(F.ws + WS_STATS);
    const bf16* GW = (const bf16*)(F.ws + WS_GWS) + (size_t)(l * 8 + hh) * 128 * 128;
    bf16* MIX = (bf16*)(F.ws + WS_MIX);
    LAS bf16* VT = (LAS bf16*)F.lds;
    constexpr int VS = 136;
    {
        const int j = tid >> 2, cs = (tid & 3) * 32;
        const float mu = ST[2 * (t0 + j)], rs = ST[2 * (t0 + j) + 1];
        const float* lg = F.in[I_LNG] + l * 1024 + c0 + cs; const float* lb = F.in[I_LNB] + l * 1024 + c0 + cs;
#pragma unroll
        for (int q = 0; q < 4; ++q) {
            const u32x4 w = *(const u32x4*)(Z + (size_t)(t0 + j) * 2048 + 1024 + c0 + cs + q * 8);
#pragma unroll
            for (int e = 0; e < 4; ++e) { const int c = cs + q * 8 + 2 * e;
                const float a = (bflo(w[e]) - mu) * rs * lg[q * 8 + 2 * e] + lb[q * 8 + 2 * e], b = (bfhi(w[e]) - mu) * rs * lg[q * 8 + 2 * e + 1] + lb[q * 8 + 2 * e + 1];
                VT[c * VS + j] = (bf16)f2bf(a); VT[(c + 1) * VS + j] = (bf16)f2bf(b); }
        }
    }
    __syncthreads();
    {
        const int fr = lane & 15, fq = lane >> 4, w = wave;
        f32x4 acc[8];
#pragma unroll
        for (int ct = 0; ct < 8; ++ct) acc[ct] = (f32x4){0.f, 0.f, 0.f, 0.f};
        const int nkb = (w < 4) ? 2 : 4;
        for (int kb = 0; kb < nkb; ++kb) {
            const bf16x8 wf = *(const bf16x8*)(GW + (size_t)(16 * w + fr) * 128 + kb * 32 + 8 * fq);
#pragma unroll
            for (int ct = 0; ct < 8; ++ct) { const bf16x8 vf = *(const LAS bf16x8*)(VT + (ct * 16 + fr) * VS + kb * 32 + 8 * fq); acc[ct] = __builtin_amdgcn_mfma_f32_16x16x32_bf16(vf, wf, acc[ct], 0, 0, 0); }
        }
        const int tok = t0 + 16 * w + fr; const float bs = F.in[I_GBS][(l * 8 + hh) * 128 + 16 * w + fr];
#pragma unroll
        for (int ct = 0; ct < 8; ++ct) { const int c = c0 + ct * 16 + 4 * fq;
            const u32x2 uw = *(const u32x2*)(Z + (size_t)tok * 2048 + c);
            u32x2 o; o.x = pk2(bflo(uw.x) * (acc[ct][0] + bs), bfhi(uw.x) * (acc[ct][1] + bs)); o.y = pk2(bflo(uw.y) * (acc[ct][2] + bs), bfhi(uw.y) * (acc[ct][3] + bs));
            *(u32x2*)(MIX + (size_t)tok * 2048 + c) = o; }
    }
    __syncthreads();
}
__device__ __forceinline__ void phase_carry_gating(Frame& F, int l, int qi) {
    PH_LOCALS
    s5_carry(F, l);
    unsigned* head = (unsigned*)(F.ws + WS_CTL) + CW_QUEUE + 64 * qi;
    LAS unsigned* slot = (LAS unsigned*)(F.lds + MISC_OFF) + 16;
    for (;;) {
        __syncthreads();
        if (tid == 0) slot[0] = __hip_atomic_fetch_add(head, 1u, RLX_AGENT);
        __syncthreads();
        const unsigned u = slot[0];
        if (u >= 1024u) break;
        gating_unit(F, l, (int)u);
    }
}

__device__ __forceinline__ void phase_s5out(Frame& F, int l) {
    PH_LOCALS
    const bf16* XS = (const bf16*)(F.ws + WS_XS); const bf16* HS = (const bf16*)(F.ws + WS_HS);
    bf16* Gb = (bf16*)(F.ws + WS_G);
    LAS unsigned char* KT = F.lds + 32768;
    LAS unsigned char* VT = F.lds + 73728;
    const int fr = lane & 15, fq = lane >> 4;
    for (int u = F.vcu; u < 512; u += F.G) {
        const int g = u >> 3, rc = (u >> 1) & 3, nh = u & 1;
        const bf16* VG = (const bf16*)(F.ws + WS_VG) + (size_t)(l * 64 + g) * 1024 * 128;
        const int n = nh * 128 + 16 * wave + fr;
        const bf16* xp0 = XS + ((size_t)(g * 256 + n)) * 1024 + 8 * fq;
        const bf16* hp0 = HS + ((size_t)(g * 256 + n)) * 128 + 8 * fq;
        bf16x8 xa[4], xb[4];
#pragma unroll
        for (int i = 0; i < 4; ++i) xa[i] = *(const bf16x8*)(xp0 + i * 32);
        __syncthreads();
        { const u32x4* src = (const u32x4*)((const bf16*)(F.ws + WS_KTAB) + (size_t)(l * 64 + g) * 80 * 256);
          for (int i = tid; i < 80 * 256 / 8; i += NTHR) ((LAS u32x4*)KT)[i] = src[i];
#pragma unroll
          for (int ps = 0; ps < 8; ++ps) { const int row = ps * 32 + (tid >> 4), c = tid & 15, q = row >> 4, o = row & 15;
              *(LAS u32x4*)(VT + row * 272 + c * 16) = *(const u32x4*)(VG + (size_t)((rc + 4 * q) * 16 + o) * 128 + c * 8); } }
        __syncthreads();
        f32x4 acc[16];
#pragma unroll
        for (int q = 0; q < 16; ++q) acc[q] = (f32x4){0.f, 0.f, 0.f, 0.f};
        const int kb0 = ((rc - (fq >> 1) + 10) * 16 + fr) * 32 + 16 * (fq & 1);
#define S5_GROUP(XF, grp_) do { const LAS unsigned char* kp = KT + kb0 - (grp_) * 4096; \
            _Pragma("unroll") for (int q = 0; q < 16; ++q) { if (rc + 4 * q >= 8 * (grp_)) { \
                _Pragma("unroll") for (int i = 0; i < 4; ++i) { const bf16x8 kf = *(const LAS bf16x8*)(kp + (4 * q - 2 * i + 6) * 512); \
                    acc[q] = __builtin_amdgcn_mfma_f32_16x16x32_bf16(kf, XF[i], acc[q], 0, 0, 0); } } } } while (0)
#pragma unroll 1
        for (int gp = 0; gp < 4; ++gp) {
#pragma unroll
            for (int i = 0; i < 4; ++i) xb[i] = *(const bf16x8*)(xp0 + ((2 * gp + 1) * 4 + i) * 32);
            S5_GROUP(xa, 2 * gp);
            if (gp < 3) {
#pragma unroll
                for (int i = 0; i < 4; ++i) xa[i] = *(const bf16x8*)(xp0 + ((2 * gp + 2) * 4 + i) * 32);
            }
            S5_GROUP(xb, 2 * gp + 1);
        }
#undef S5_GROUP
#pragma unroll 1
        for (int jb = 0; jb < 4; ++jb) {
            const bf16x8 hf = *(const bf16x8*)(hp0 + jb * 32);
#pragma unroll
            for (int q = 0; q < 16; ++q) {
                const bf16x8 vf = *(const LAS bf16x8*)(VT + (q * 16 + fr) * 272 + (jb * 32 + 8 * fq) * 2);
                acc[q] = __builtin_amdgcn_mfma_f32_16x16x32_bf16(vf, hf, acc[q], 0, 0, 0);
            }
        }
#pragma unroll
        for (int q = 0; q < 16; ++q) {
            const int t = rc + 4 * q, tok = 64 * n + t;
            const f32x4 y = acc[q];
            u32x2 o; o.x = pk2(gelu_tanh(y[0]), gelu_tanh(y[1])); o.y = pk2(gelu_tanh(y[2]), gelu_tanh(y[3]));
            *(u32x2*)(Gb + (size_t)tok * 1024 + g * 16 + 4 * fq) = o;
#if SELFTEST_S5
            if (tok < 256) *(f32x4*)((float*)(F.ws + WS_DBG) + (size_t)tok * 1024 + g * 16 + 4 * fq) = y;
#endif
        }
    }
}
#if SELFTEST_S5
__device__ __forceinline__ void selftest_s5(Frame& F, int l) {
    PH_LOCALS
    if (F.vcu < 64 && wave == 0) {
        const int g = F.vcu, p = lane;
        const float dt = expf(F.in[I_LDT][l * 64 + g]);
        const float lr = F.in[I_LRE][(l * 64 + g) * 64 + p], li = F.in[I_LIM][(l * 64 + g) * 64 + p];
        const float mag = expf(lr * dt); float sn, cs; sincosf(li * dt, &sn, &cs);
        const float ar = mag * cs, ai = mag * sn;
        const float xr = ar - 1.0f, xi = ai, den = 1.0f / (lr * lr + li * li);
        const float cr = (xr * lr + xi * li) * den, ci = (xi * lr - xr * li) * den;
        float bbr[16], bbi[16], ccr[16], cci[16];
#pragma unroll
        for (int i = 0; i < 16; ++i) { const float br = F.in[I_BRE][((size_t)(l * 64 + g) * 64 + p) * 16 + i], bi = F.in[I_BIM][((size_t)(l * 64 + g) * 64 + p) * 16 + i];
            bbr[i] = cr * br - ci * bi; bbi[i] = cr * bi + ci * br;
            ccr[i] = F.in[I_CRE][((size_t)(l * 64 + g) * 16 + i) * 64 + p]; cci[i] = F.in[I_CIM][((size_t)(l * 64 + g) * 16 + i) * 64 + p]; }
        const bf16* XS = (const bf16*)(F.ws + WS_XS) + (size_t)g * 256 * 1024;
        const float* DY = (const float*)(F.ws + WS_DBG);
        float sr = 0.f, si = 0.f, err = 0.f, ref = 0.f;
        for (int t = 0; t < 256; ++t) {
            float x[16];
#pragma unroll
            for (int i = 0; i < 16; ++i) x[i] = bflo((unsigned)XS[(size_t)t * 16 + i]);
            float ur = 0.f, ui = 0.f;
#pragma unroll
            for (int i = 0; i < 16; ++i) { ur += bbr[i] * x[i]; ui += bbi[i] * x[i]; }
            const float nr = ar * sr - ai * si + ur, ni = ar * si + ai * sr + ui; sr = nr; si = ni;
#pragma unroll
            for (int o = 0; o < 16; ++o) {
                const float yr = wave_sum(ccr[o] * sr - cci[o] * si);
                const float yf = DY[(size_t)t * 1024 + g * 16 + o];
                err += (yf - yr) * (yf - yr); ref += yr * yr;
            }
        }
        if (lane == 0 && !(err <= 2e-3f * ref)) __hip_atomic_fetch_or((unsigned*)(F.ws + WS_CTL) + CW_FLAG, 1u, RLX_AGENT);
    }
}
#endif

__device__ __forceinline__ unsigned f2key(float v) { const unsigned u = __builtin_bit_cast(unsigned, v); return (u & 0x80000000u) ? ~u : (u | 0x80000000u); }
__device__ __forceinline__ float key2f(unsigned k) { const unsigned u = (k & 0x80000000u) ? (k & 0x7fffffffu) : ~k; return __builtin_bit_cast(float, u); }
__device__ __forceinline__ void phase_topk(Frame& F, int l) {
    PH_LOCALS
    const bf16* Q = (const bf16*)(F.ws + WS_Z);
    const bf16* KB = (const bf16*)(F.ws + WS_KEYS) + (size_t)l * 8 * 2 * 128 * 128;
    int* EID = (int*)(F.ws + WS_EID); float* GT = (float*)(F.ws + WS_GATE); float* SUo = (float*)(F.ws + WS_SU);
    const float* SCL = (const float*)(F.ws + WS_SCL) + (size_t)l * NEXP * 2;
    LAS float* SC = (LAS float*)F.lds;
    LAS unsigned* LST = (LAS unsigned*)(F.lds + 128 * 260 * 4);
    const int fr = lane & 15, fq = lane >> 4;
    for (int u = F.vcu; u < 1024; u += F.G) {
        const int tt = u >> 3, hh = u & 7, t0 = tt * 128;
        __syncthreads();
        {
            f32x4 acc[2][8];
#pragma unroll
            for (int s = 0; s < 2; ++s)
#pragma unroll
                for (int nt = 0; nt < 8; ++nt) acc[s][nt] = (f32x4){0.f, 0.f, 0.f, 0.f};
#pragma unroll
            for (int s = 0; s < 2; ++s)
#pragma unroll
                for (int kb = 0; kb < 4; ++kb) {
                    const bf16x8 qf = *(const bf16x8*)(Q + (size_t)(t0 + 16 * wave + fr) * 2048 + hh * 256 + s * 128 + kb * 32 + 8 * fq);
#pragma unroll
                    for (int nt = 0; nt < 8; ++nt) { const bf16x8 kf = *(const bf16x8*)(KB + ((size_t)((hh * 2 + s) * 128 + nt * 16 + fr)) * 128 + kb * 32 + 8 * fq);
                        acc[s][nt] = __builtin_amdgcn_mfma_f32_16x16x32_bf16(kf, qf, acc[s][nt], 0, 0, 0); }
                }
#pragma unroll
            for (int s = 0; s < 2; ++s)
#pragma unroll
                for (int nt = 0; nt < 8; ++nt) *(LAS f32x4*)(SC + (16 * wave + fr) * 260 + s * 128 + nt * 16 + 4 * fq) = acc[s][nt];
        }
        __syncthreads();
        if (tid < 256) {
            const int tl = tid >> 1, s = tid & 1;
            unsigned top[16];
#pragma unroll
            for (int k = 0; k < 16; ++k) top[k] = 0u;
            const LAS float* row = SC + tl * 260 + s * 128;
            for (int n4 = 0; n4 < 32; ++n4) {
                const f32x4 v = *(const LAS f32x4*)(row + 4 * n4);
#pragma unroll
                for (int e = 0; e < 4; ++e) {
                    unsigned key = (f2key(v[e]) & ~0x7Fu) | (unsigned)(127 - (4 * n4 + e));
#pragma unroll
                    for (int k = 0; k < 16; ++k) { const unsigned hi = top[k] > key ? top[k] : key, lo = top[k] > key ? key : top[k]; top[k] = hi; key = lo; }
                }
            }
#pragma unroll
            for (int k = 0; k < 16; k += 4) *(LAS u32x4*)(LST + (tl * 2 + s) * 16 + k) = (u32x4){top[k], top[k + 1], top[k + 2], top[k + 3]};
        }
        __syncthreads();
        if (tid < 128) {
            const int tl = tid;
            float av[16], bv[16];
#pragma unroll
            for (int k = 0; k < 16; ++k) { av[k] = key2f(LST[(tl * 2 + 0) * 16 + k] & ~0x7Fu); bv[k] = key2f(LST[(tl * 2 + 1) * 16 + k] & ~0x7Fu); }
            unsigned top[16];
#pragma unroll
            for (int k = 0; k < 16; ++k) top[k] = 0u;
#pragma unroll
            for (int i = 0; i < 16; ++i)
#pragma unroll
                for (int j = 0; j < 16; ++j)
                    if ((i + 1) * (j + 1) <= 16) {
                        unsigned key = (f2key(av[i] + bv[j]) & ~0xFFu) | (unsigned)(255 - (i * 16 + j));
#pragma unroll
                        for (int k = 0; k < 16; ++k) { const unsigned hi = top[k] > key ? top[k] : key, lo = top[k] > key ? key : top[k]; top[k] = hi; key = lo; }
                    }
            float ev[16]; float sum = 0.f; const float mx = key2f(top[0] & ~0xFFu);
#pragma unroll
            for (int k = 0; k < 16; ++k) { ev[k] = __expf(key2f(top[k] & ~0xFFu) - mx); sum += ev[k]; }
            const float inv = 1.0f / sum;
            int* eo = EID + (size_t)(t0 + tl) * 128 + hh * 16; float* go = GT + (size_t)(t0 + tl) * 128 + hh * 16; float* so = SUo + (size_t)(t0 + tl) * 128 + hh * 16;
#pragma unroll
            for (int k = 0; k < 16; ++k) { const int flat = 255 - (int)(top[k] & 0xFFu), i = flat >> 4, j = flat & 15;
                const int ia = 127 - (int)(LST[(tl * 2 + 0) * 16 + i] & 0x7Fu), ib = 127 - (int)(LST[(tl * 2 + 1) * 16 + j] & 0x7Fu);
                const int e = ia * 128 + ib; const f32x2 sc = *(const f32x2*)(SCL + 2 * e);
                eo[k] = e; go[k] = ev[k] * inv * sc.y; so[k] = sc.x; }
        }
    }
    __syncthreads();
}

#define FP4X4(w, f0, f1, f2, f3) do { f0 = __builtin_amdgcn_cvt_scalef32_pk_f32_fp4((w), 1.0f, 0); f1 = __builtin_amdgcn_cvt_scalef32_pk_f32_fp4((w), 1.0f, 1); \
    f2 = __builtin_amdgcn_cvt_scalef32_pk_f32_fp4((w), 1.0f, 2); f3 = __builtin_amdgcn_cvt_scalef32_pk_f32_fp4((w), 1.0f, 3); } while (0)
__device__ __forceinline__ void phase_gather(Frame& F, int l, bool dummy = false) {
    PH_LOCALS
    const int gw = F.vcu * NWAVES + wave, NGW = F.G * NWAVES;
    const bf16* H = (const bf16*)(F.ws + WS_H); bf16* Hn = dummy ? (bf16*)(F.ws + WS_DBG + 128 * MiB) : (bf16*)(F.ws + WS_H);
    const unsigned char* UV = F.ws + WS_UV + (size_t)l * NEXP * 2048;
    const int* EID = (const int*)(F.ws + WS_EID); const float* GT = (const float*)(F.ws + WS_GATE); const float* SU = (const float*)(F.ws + WS_SU);
    const float* X = (const float*)(F.ws + WS_X); float* Xo = dummy ? (float*)(F.ws + WS_DBG) : (float*)(F.ws + WS_X);
    const float* mod = (const float*)(F.ws + WS_MOD);
    const float* gate2 = mod + l * 12288 + 5 * 2048;
    const unsigned lane16 = (unsigned)lane * 16u;
    constexpr int NB = 16;
    for (int t = gw; t < M; t += NGW) {
        const int e_lo = EID[(size_t)t * 128 + lane], e_hi = EID[(size_t)t * 128 + 64 + lane];
        const float g_lo = GT[(size_t)t * 128 + lane], g_hi = GT[(size_t)t * 128 + 64 + lane];
        const float s_lo = SU[(size_t)t * 128 + lane], s_hi = SU[(size_t)t * 128 + 64 + lane];
        f32x2 hh[8][2];
#pragma unroll
        for (int j = 0; j < 8; ++j) { const u32x2 w = *(const u32x2*)(H + (size_t)t * 2048 + j * 256 + lane * 4);
            hh[j][0] = (f32x2){bflo(w.x), bfhi(w.x)}; hh[j][1] = (f32x2){bflo(w.y), bfhi(w.y)}; }
        f32x2 of[8][2];
#pragma unroll
        for (int j = 0; j < 8; ++j) { of[j][0] = (f32x2){0.f, 0.f}; of[j][1] = (f32x2){0.f, 0.f}; }
        for (int b = 0; b < 128 / NB; ++b) {
            const bool first = (b * NB) < 64;
            const int esel = first ? e_lo : e_hi; const float gsel = first ? g_lo : g_hi, ssel = first ? s_lo : s_hi;
            u32x4 ur[NB], vr[NB];
#pragma unroll
            for (int h = 0; h < NB; ++h) {
                const int e = __builtin_amdgcn_readlane(esel, (NB * b + h) & 63);
                const unsigned char* rowp = UV + ((size_t)(unsigned)e << 11);
                ur[h] = *(const u32x4*)(rowp + lane16); vr[h] = *(const u32x4*)(rowp + 1024 + lane16);
            }
            float p[NB];
#pragma unroll
            for (int h = 0; h < NB; ++h) {
                f32x2 a2 = {0.f, 0.f};
#pragma unroll
                for (int d = 0; d < 4; ++d) { f32x2 f0, f1, f2, f3; FP4X4(ur[h][d], f0, f1, f2, f3);
                    a2 = f0 * hh[2 * d][0] + a2; a2 = f1 * hh[2 * d][1] + a2; a2 = f2 * hh[2 * d + 1][0] + a2; a2 = f3 * hh[2 * d + 1][1] + a2; }
                p[h] = a2.x + a2.y;
            }
            const bool u32_ = (lane & 32) != 0, u16_ = (lane & 16) != 0, u8_ = (lane & 8) != 0, u4_ = (lane & 4) != 0;
            float a8[8];
#pragma unroll
            for (int i = 0; i < 8; ++i) { const float snd = u32_ ? p[i] : p[8 + i], kp = u32_ ? p[8 + i] : p[i]; a8[i] = kp + __shfl_xor(snd, 32); }
            float a4[4];
#pragma unroll
            for (int i = 0; i < 4; ++i) { const float snd = u16_ ? a8[i] : a8[4 + i], kp = u16_ ? a8[4 + i] : a8[i]; a4[i] = kp + __shfl_xor(snd, 16); }
            float b2[2];
#pragma unroll
            for (int i = 0; i < 2; ++i) { const float snd = u8_ ? a4[i] : a4[2 + i], kp = u8_ ? a4[2 + i] : a4[i]; b2[i] = kp + __shfl_xor(snd, 8); }
            float d;
            { const float snd = u4_ ? b2[0] : b2[1], kp = u4_ ? b2[1] : b2[0]; d = kp + __shfl_xor(snd, 4); }
            d += __shfl_xor(d, 2); d += __shfl_xor(d, 1);
            const int hl = (NB * b + (lane >> 2)) & 63;
            const float gq = __shfl(gsel, hl), sq = __shfl(ssel, hl);
            const float coefq = gq * gelu_tanh(d * sq);
#pragma unroll
            for (int h = 0; h < NB; ++h) {
                const float cf = __builtin_bit_cast(float, __builtin_amdgcn_readlane(__builtin_bit_cast(int, coefq), 4 * h));
                const f32x2 cf2 = {cf, cf};
#pragma unroll
                for (int dd = 0; dd < 4; ++dd) { f32x2 f0, f1, f2, f3; FP4X4(vr[h][dd], f0, f1, f2, f3);
                    of[2 * dd][0] = f0 * cf2 + of[2 * dd][0]; of[2 * dd][1] = f1 * cf2 + of[2 * dd][1]; of[2 * dd + 1][0] = f2 * cf2 + of[2 * dd + 1][0]; of[2 * dd + 1][1] = f3 * cf2 + of[2 * dd + 1][1]; }
            }
        }
        int ln = lane; asm volatile("" : "+v"(ln));
        f32x4 xv[8]; float ss = 0.f;
#pragma unroll
        for (int j = 0; j < 8; ++j) {
            const int c = j * 256 + ln * 4;
            const f32x4 xo = *(const f32x4*)(X + (size_t)t * 2048 + c), g2 = *(const f32x4*)(gate2 + c);
            const f32x4 o = {of[j][0].x, of[j][0].y, of[j][1].x, of[j][1].y};
            xv[j] = xo + g2 * o;
            ss += (xv[j][0] * xv[j][0] + xv[j][1] * xv[j][1]) + (xv[j][2] * xv[j][2] + xv[j][3] * xv[j][3]);
        }
        const float rr = 1.0f / sqrtf(wave_sum(ss) * (1.0f / DM) + EPS);
        if (l + 1 < DEPTH) {
            const float* m2 = mod + (l + 1) * 12288; const float* gain = F.in[I_N1G] + (l + 1) * 2048;
#pragma unroll
            for (int j = 0; j < 8; ++j) {
                const int c = j * 256 + ln * 4;
                *(f32x4*)(Xo + (size_t)t * 2048 + c) = xv[j];
                const f32x4 g = *(const f32x4*)(gain + c), sc = *(const f32x4*)(m2 + 2048 + c), sh = *(const f32x4*)(m2 + c);
                const f32x4 y = xv[j] * rr * g * (sc + 1.0f) + sh;
                *(u32x2*)(Hn + (size_t)t * 2048 + c) = (u32x2){pk2(y[0], y[1]), pk2(y[2], y[3])};
            }
        } else {
#pragma unroll
            for (int j = 0; j < 8; ++j) { const int c = j * 256 + ln * 4; const f32x4 fg = *(const f32x4*)(F.in[I_FG] + c);
                f32x4 ov = xv[j] * rr * fg;
#if SELFTEST_S5
                if (__hip_atomic_load((unsigned*)(F.ws + WS_CTL) + CW_FLAG, RLX_AGENT) != 0u) ov = (f32x4){1e30f, 1e30f, 1e30f, 1e30f};
#endif
                *(f32x4*)(F.out + (size_t)t * 2048 + c) = ov; }
        }
    }
}

__global__ void __launch_bounds__(NTHR, 2) fwd_kernel(Args args) {
    extern __shared__ __attribute__((aligned(16))) unsigned char lds_raw[];
    Frame F;
    F.lds = (LAS unsigned char*)lds_raw; F.ws = args.ws; F.in = args.in; F.out = args.out;
    F.tid = threadIdx.x; F.lane = F.tid & 63; F.wave = __builtin_amdgcn_readfirstlane(F.tid >> 6);
    F.G = gridDim.x; { const int bx = blockIdx.x; F.vcu = (F.G % 8 == 0) ? (bx % 8) * (F.G / 8) + bx / 8 : bx; }
    volatile LAS unsigned* MISC = (volatile LAS unsigned*)(F.lds + MISC_OFF);
    if (F.tid < 64) MISC[F.tid] = 0u;
    __syncthreads();
    unsigned* ctl = (unsigned*)(F.ws + WS_CTL);
    XcdBarrier bar; bar.bar = ctl + CW_BAR; bar.x = 0; bar.st = nullptr;
#if !MK_PER_PHASE
    bar = xcd_barrier_post(ctl + CW_BAR, MISC + 8);
#endif
    const int lo = args.ph_lo, hi = args.ph_hi;
#define IN(k) (lo <= (k) && (k) < hi)
#if MK_PER_PHASE
#define SEAM(k) do { } while (0)
#else
#define SEAM(k) do { if (IN(k) && IN((k) + 1)) xcd_barrier(bar); } while (0)
#endif
    const float* mod = (const float*)(F.ws + WS_MOD);

#define REP(k) (REPEAT_PH == (k))
#define RUN2(k, first, real) do { if (REP(k)) { first; xcd_barrier(bar); } real; } while (0)
    if (IN(0)) { RUN2(0, p0_prologue(F), p0_prologue(F)); } SEAM(0);
    for (int l = 0; l < DEPTH; ++l) {
        const int pb = 1 + 12 * l;
        const float* ml = mod + l * 12288;
        const float* xin = (l == 0) ? F.in[I_X] : (const float*)(F.ws + WS_X);
        if (IN(pb + 0)) { if (l == 0) RUN2(1, phase_norm(F, xin, F.in[I_N1G] + l * 2048, ml + 1 * 2048, ml + 0 * 2048), phase_norm(F, xin, F.in[I_N1G] + l * 2048, ml + 1 * 2048, ml + 0 * 2048)); } SEAM(pb + 0);
        if (IN(pb + 1)) {
            pg8::Gemm g{(const bf16*)(F.ws + WS_H), (const bf16*)(F.ws + WS_WIN) + (size_t)l * INW * DM, M, INW, DM}; pg8::StaticOrder S; S.init(M, INW, F.G, (int)blockIdx.x);
            EpiIn E{(bf16*)(F.ws + WS_Z), (bf16*)(F.ws + WS_XS), F.in[I_BIN] + l * INW};
#define GEMM_IN pg8::gemm_phase<EpiIn, pg8::StaticOrder, true, true>(F.lds, g, S, E)
            RUN2(2, GEMM_IN, GEMM_IN);
        } SEAM(pb + 1);
        if (IN(pb + 2)) { RUN2(3, (phase_sloc(F, l), phase_lnstats(F)), (phase_sloc(F, l), phase_lnstats(F))); } SEAM(pb + 2);
        if (IN(pb + 3)) { RUN2(4, phase_carry_gating(F, l, l + 2), phase_carry_gating(F, l, l)); } SEAM(pb + 3);
        if (IN(pb + 4)) { RUN2(5, phase_s5out(F, l), phase_s5out(F, l));
#if SELFTEST_S5
            xcd_barrier(bar); selftest_s5(F, l);
#endif
        } SEAM(pb + 4);
        if (IN(pb + 5)) {
            pg8::Gemm g{(const bf16*)(F.ws + WS_G), (const bf16*)(F.ws + WS_GLU) + (size_t)l * WB * WB, M, WB, WB}; pg8::StaticOrder S; S.init(M, WB, F.G, (int)blockIdx.x);
            EpiGlu E{(const bf16*)(F.ws + WS_G), (bf16*)(F.ws + WS_MIX), F.in[I_GLUB] + l * WB};
#define GEMM_GLU pg8::gemm_phase<EpiGlu, pg8::StaticOrder, true, true>(F.lds, g, S, E)
            RUN2(6, GEMM_GLU, GEMM_GLU);
        } SEAM(pb + 5);
        if (IN(pb + 6)) { RUN2(7, phase_branchnorm(F), phase_branchnorm(F)); } SEAM(pb + 6);
        if (IN(pb + 7)) {
            pg8::Gemm g{(const bf16*)(F.ws + WS_MIX), (const bf16*)(F.ws + WS_WOUT) + (size_t)l * DM * DM, M, DM, DM}; pg8::StaticOrder S; S.init(M, DM, F.G, (int)blockIdx.x);
            EpiOut E{xin, (float*)(F.ws + WS_X), ml + 2 * 2048};
            EpiOut Ed{xin, (float*)(F.ws + WS_DBG), ml + 2 * 2048};
#define GEMM_OUT(EE) pg8::gemm_phase<EpiOut, pg8::StaticOrder, true, true>(F.lds, g, S, EE)
            RUN2(8, GEMM_OUT(Ed), GEMM_OUT(E));
        } SEAM(pb + 7);
        if (IN(pb + 8)) { RUN2(9, phase_norm(F, (const float*)(F.ws + WS_X), F.in[I_N2G] + l * 2048, ml + 4 * 2048, ml + 3 * 2048), phase_norm(F, (const float*)(F.ws + WS_X), F.in[I_N2G] + l * 2048, ml + 4 * 2048, ml + 3 * 2048)); } SEAM(pb + 8);
        if (IN(pb + 9)) {
            pg8::Gemm g{(const bf16*)(F.ws + WS_H), (const bf16*)(F.ws + WS_WQ) + (size_t)l * DM * DM, M, DM, DM}; pg8::StaticOrder S; S.init(M, DM, F.G, (int)blockIdx.x);
            EpiQ E{(bf16*)(F.ws + WS_Z)};
#define GEMM_Q pg8::gemm_phase<EpiQ, pg8::StaticOrder, true, true>(F.lds, g, S, E)
            RUN2(10, GEMM_Q, GEMM_Q);
        } SEAM(pb + 9);
        if (IN(pb + 10)) { RUN2(11, phase_topk(F, l), phase_topk(F, l)); } SEAM(pb + 10);
        if (IN(pb + 11)) { RUN2(12, phase_gather(F, l, true), phase_gather(F, l, false)); } SEAM(pb + 11);
    }
#undef IN
#undef SEAM
}

extern "C" void kernel_launch(void* const* d_in, const int* in_sizes, int n_in, void* d_out, int out_size, void* d_ws, size_t ws_size, hipStream_t stream) {
    static int grid = 0;
    if (grid == 0) {
        if (n_in != 29 || out_size != M * DM || ws_size < WS_END) { fprintf(stderr, "kernel_launch: unexpected shapes (n_in %d, out %d, ws %zu); nothing launched\n", n_in, out_size, ws_size); grid = -1; return; }
        int dev = 0, cus = 0;
        if (hipGetDevice(&dev) != hipSuccess || hipDeviceGetAttribute(&cus, hipDeviceAttributeMultiprocessorCount, dev) != hipSuccess) { grid = -1; return; }
        if (hipFuncSetAttribute((const void*)fwd_kernel, hipFuncAttributeMaxDynamicSharedMemorySize, LDS_BYTES) != hipSuccess) { fprintf(stderr, "kernel_launch: hipFuncSetAttribute failed\n"); grid = -1; return; }
        (void)hipGetLastError();
        grid = cus;
    }
    if (grid < 0) return;
    (void)hipMemsetAsync((char*)d_ws + WS_CTL, 0, CTL_ZERO_BYTES, stream);
    Args a{};
    for (int i = 0; i < 29; ++i) a.in[i] = (const float*)d_in[i];
    a.out = (float*)d_out; a.ws = (unsigned char*)d_ws;
#if MK_PER_PHASE
    for (int p = 0; p < 1 + 12 * DEPTH; ++p) {
        if (p == 13) continue;
        a.ph_lo = p; a.ph_hi = p + 1; a.li = p;
        hipLaunchKernelGGL(fwd_kernel, dim3(grid), dim3(NTHR), LDS_BYTES, stream, a);
    }
#else
    a.ph_lo = 0; a.ph_hi = 1 + 12 * DEPTH; a.li = 0;
    hipLaunchKernelGGL(fwd_kernel, dim3(grid), dim3(NTHR), LDS_BYTES, stream, a);
#endif
}
```

```cpp
#include <hip/hip_runtime.h>
#include <cstdio>
#include <cstdint>

#ifndef SELFTEST_S5
#define SELFTEST_S5 0
#endif
#ifndef REPEAT_PH
#define REPEAT_PH -1
#endif
#ifndef MK_PER_PHASE
#define MK_PER_PHASE 0
#endif

#define GAS __attribute__((address_space(1)))
#define LAS __attribute__((address_space(3)))
typedef unsigned short bf16;
typedef short bf16x8 __attribute__((ext_vector_type(8)));
typedef float f32x4 __attribute__((ext_vector_type(4)));
typedef float f32x2 __attribute__((ext_vector_type(2)));
typedef unsigned u32x4 __attribute__((ext_vector_type(4)));
typedef unsigned u32x2 __attribute__((ext_vector_type(2)));

constexpr int DM = 2048, SEQ = 16384, DEPTH = 2, M = SEQ;
constexpr int WA = 1024, WB = 1024, INW = 3072;
constexpr int NG = 64, NCH = 256;
constexpr int NEXP = 16384;
constexpr float EPS = 1e-6f;
constexpr int NWAVES = 8, NTHR = 512;

namespace pg8 {
#define PG8_LAS __attribute__((address_space(3)))
constexpr int BM = 256, BK = 64, HALF = 128, HTB = HALF * BK * 2, STAGE_BYTES = 8 * HTB, NXCD = 8, WGM = 8;
__host__ __device__ __forceinline__ int lds_byte(int r, int c) { const int st = (r >> 4) * 2 + (c >> 5), rr = r & 15, cc = c & 31, ob = rr * 64 + cc * 2; return st * 1024 + (ob ^ (((ob >> 9) & 1) << 5)); }
__host__ __device__ __forceinline__ void stage_rc(int b, int& R, int& C) { const int st = b / 1024, sb = b % 1024, swz = sb ^ (((sb >> 9) & 1) << 5); R = (st >> 1) * 16 + swz / 64; C = (st & 1) * 32 + (swz % 64) / 2; }
__host__ __device__ __forceinline__ int perm32(int rho) { const int n = rho >> 4, i = rho & 15; return 8 * (i >> 2) + 4 * n + (i & 3); }
struct Unit { int pm, pn; };
struct Gemm { const bf16* A; const bf16* Bt; int M, N, K; };
struct StaticOrder {
    int nM, nN, nwg, G, c;
    __host__ __device__ void init(int M_, int N_, int G_, int c_) { nM = M_ / BM; nN = N_ / BM; nwg = nM * nN; G = G_; c = c_; }
    __host__ __device__ bool next(int i, Unit& u) const {
        const long L = (long)i * G + c; if (L >= nwg) return false;
        int wgid = (int)L; { const int q = nwg / NXCD, r = nwg % NXCD, xcd = wgid % NXCD, off = wgid / NXCD; wgid = (xcd < r ? xcd * (q + 1) : r * (q + 1) + (xcd - r) * q) + off; }
        const int nig = WGM * nN, gid = wgid / nig, fm = gid * WGM, gsz = (nM - fm) < WGM ? (nM - fm) : WGM;
        u.pm = fm + ((wgid % nig) % gsz); u.pn = (wgid % nig) / gsz; return true;
    }
    __device__ __forceinline__ void a_ready(const Unit&) const {}
    __device__ __forceinline__ void done(const Unit&) const {}
};
__device__ __forceinline__ unsigned cvt_pk_bf16(float lo, float hi) { unsigned r; asm volatile("v_cvt_pk_bf16_f32 %0, %1, %2" : "=v"(r) : "v"(lo), "v"(hi)); return r; }

template <class Epi, class Sched, bool ALIGN_EPI = false, bool SP2 = false>
__device__ __forceinline__ void gemm_phase(PG8_LAS unsigned char* lds, const Gemm g, const Sched& S, const Epi& E) {
    int tid = threadIdx.x; asm volatile("" : "+v"(tid)); const int wid = __builtin_amdgcn_readfirstlane(tid >> 6), lane = tid & 63, wr = wid >> 2, wc = wid & 3, fr = lane & 15, fq = lane >> 4;
    const int K = g.K, nt = K / BK;
    unsigned voffA[2], voffB[2];
#pragma unroll
    for (int i = 0; i < 2; ++i) { int R, C; stage_rc(tid * 16 + i * 8192, R, C); const int Rb = Epi::PERM ? ((R & ~31) + perm32(R & 31)) : R;
        voffA[i] = (unsigned)(R * K + C) * 2u; voffB[i] = (unsigned)(Rb * K + C) * 2u; }
    const size_t kstep = (size_t)(BK * 2);
    const size_t hstep = (size_t)HALF * K * 2;
    const size_t tstep = 2 * hstep;
    const unsigned ldsw = (unsigned)wid * 1024u;
    const int aoff = lds_byte(wr * 64 + fr, fq * 8), boff = lds_byte(wc * 32 + fr, fq * 8);
#define PG8_SA(b, h) (((b) * 2 + (h)) * HTB)
#define PG8_SB(b, h) ((4 + (b) * 2 + (h)) * HTB)
#define PG8_STAGE(bufoff, gbase, voff) do { _Pragma("unroll") for (int _i = 0; _i < 2; ++_i) \
        __builtin_amdgcn_global_load_lds((const unsigned*)((const char*)(gbase) + (voff)[_i]), (PG8_LAS unsigned*)(lds + (bufoff) + ldsw + _i * 8192), 16, 0, 0); } while (0)
#define PG8_LDA(dst, b, h) do { _Pragma("unroll") for (int m = 0; m < 4; ++m) _Pragma("unroll") for (int k = 0; k < 2; ++k) dst[m][k] = *(const PG8_LAS bf16x8*)(lds + PG8_SA(b, h) + aoff + m * 2048 + k * 1024); } while (0)
#define PG8_LDB(dst, b, h) do { _Pragma("unroll") for (int n = 0; n < 2; ++n) _Pragma("unroll") for (int k = 0; k < 2; ++k) dst[n][k] = *(const PG8_LAS bf16x8*)(lds + PG8_SB(b, h) + boff + n * 2048 + k * 1024); } while (0)
#define PG8_MMA(ai, bj, At, Bt) do { __builtin_amdgcn_s_setprio(1); _Pragma("unroll") for (int m = 0; m < 4; ++m) _Pragma("unroll") for (int n = 0; n < 2; ++n) _Pragma("unroll") for (int k = 0; k < 2; ++k) \
        acc[ai][bj][m][n] = __builtin_amdgcn_mfma_f32_16x16x32_bf16(Bt[n][k], At[m][k], acc[ai][bj][m][n], 0, 0, 0); __builtin_amdgcn_s_setprio(0); } while (0)
#define PG8_WAIT_V(n) asm volatile("s_waitcnt vmcnt(" #n ")" ::: "memory")
#define PG8_WAIT_L(n) asm volatile("s_waitcnt lgkmcnt(" #n ")" ::: "memory")
#define PG8_BAR __builtin_amdgcn_s_barrier()
#define PG8_SCHED __builtin_amdgcn_sched_barrier(0)
    Unit cur, nxt; int ui = 0;
    if (!S.next(0, cur)) return;
    f32x4 acc[2][2][4][2];
#pragma unroll
    for (int a = 0; a < 2; ++a)
#pragma unroll
        for (int b = 0; b < 2; ++b)
#pragma unroll
            for (int m = 0; m < 4; ++m)
#pragma unroll
                for (int n = 0; n < 2; ++n) acc[a][b][m][n] = (f32x4){0.f, 0.f, 0.f, 0.f};
    bf16x8 At[4][2], B0[2][2], B1[2][2];
    const char* cA = (const char*)g.A + (size_t)cur.pm * tstep; const char* cB = (const char*)g.Bt + (size_t)cur.pn * tstep;
    S.a_ready(cur);
    if constexpr (SP2) {
        PG8_STAGE(PG8_SB(0, 0), cB, voffB); PG8_STAGE(PG8_SB(0, 1), cB + hstep, voffB); PG8_STAGE(PG8_SA(0, 0), cA, voffA); PG8_STAGE(PG8_SA(0, 1), cA + hstep, voffA);
        if (wr == 1) PG8_BAR;
        PG8_WAIT_V(2); PG8_BAR;
        PG8_STAGE(PG8_SB(1, 0), cB + kstep, voffB); PG8_STAGE(PG8_SA(1, 0), cA + kstep, voffA); PG8_STAGE(PG8_SB(1, 1), cB + hstep + kstep, voffB);
        PG8_WAIT_V(6); PG8_BAR;
    } else {
        PG8_STAGE(PG8_SB(0, 0), cB, voffB); PG8_STAGE(PG8_SA(0, 0), cA, voffA); PG8_STAGE(PG8_SB(0, 1), cB + hstep, voffB); PG8_STAGE(PG8_SA(0, 1), cA + hstep, voffA);
        if (wr == 1) PG8_BAR;
        PG8_WAIT_V(4); PG8_BAR;
        PG8_STAGE(PG8_SB(1, 0), cB + kstep, voffB); PG8_STAGE(PG8_SA(1, 0), cA + kstep, voffA); PG8_STAGE(PG8_SB(1, 1), cB + hstep + kstep, voffB);
        PG8_WAIT_V(6); PG8_BAR;
    }
    for (;;) {
        const bool has_next = S.next(ui + 1, nxt);
        const char* nA = has_next ? (const char*)g.A + (size_t)nxt.pm * tstep : cA; const char* nB = has_next ? (const char*)g.Bt + (size_t)nxt.pn * tstep : cB;
        for (int t = 0; t < nt; t += 2) {
            const bool last = (t == nt - 2);
            const char* a1 = cA + (size_t)(t + 1) * kstep;
            const char* a2 = last ? nA : cA + (size_t)(t + 2) * kstep; const char* b2 = last ? nB : cB + (size_t)(t + 2) * kstep;
            const char* a3 = a2 + kstep; const char* b3 = b2 + kstep;
            if (last && has_next) S.a_ready(nxt);
            if constexpr (SP2) {
            PG8_LDB(B0, 0, 0); PG8_LDB(B1, 0, 1); PG8_SCHED; PG8_LDA(At, 0, 0); PG8_STAGE(PG8_SA(1, 1), a1 + hstep, voffA);
            PG8_WAIT_V(8); PG8_WAIT_L(0); PG8_BAR; PG8_MMA(0, 0, At, B0); PG8_MMA(0, 1, At, B1); PG8_BAR; PG8_SCHED;
            PG8_LDA(At, 0, 1); PG8_STAGE(PG8_SB(0, 0), b2, voffB); PG8_STAGE(PG8_SB(0, 1), b2 + hstep, voffB); PG8_STAGE(PG8_SA(0, 0), a2, voffA);
            PG8_WAIT_V(8); PG8_WAIT_L(0); PG8_BAR; PG8_MMA(1, 0, At, B0); PG8_MMA(1, 1, At, B1); PG8_BAR; PG8_SCHED;
            PG8_LDB(B0, 1, 0); PG8_LDB(B1, 1, 1); PG8_SCHED; PG8_LDA(At, 1, 0); PG8_STAGE(PG8_SA(0, 1), a2 + hstep, voffA);
            PG8_WAIT_V(8); PG8_WAIT_L(0); PG8_BAR; PG8_MMA(0, 0, At, B0); PG8_MMA(0, 1, At, B1); PG8_BAR; PG8_SCHED;
            PG8_LDA(At, 1, 1); PG8_STAGE(PG8_SB(1, 0), b3, voffB); PG8_STAGE(PG8_SB(1, 1), b3 + hstep, voffB); PG8_STAGE(PG8_SA(1, 0), a3, voffA);
            PG8_WAIT_V(8); PG8_WAIT_L(0); PG8_BAR; PG8_MMA(1, 0, At, B0); PG8_MMA(1, 1, At, B1); PG8_BAR; PG8_SCHED;
            } else {
            PG8_LDB(B0, 0, 0); PG8_SCHED; PG8_LDA(At, 0, 0); PG8_STAGE(PG8_SA(1, 1), a1 + hstep, voffA);
            PG8_WAIT_L(8); PG8_BAR; PG8_WAIT_L(0); PG8_MMA(0, 0, At, B0); PG8_BAR; PG8_SCHED;
            PG8_LDB(B1, 0, 1); PG8_STAGE(PG8_SB(0, 0), b2, voffB);
            PG8_BAR; PG8_WAIT_L(0); PG8_MMA(0, 1, At, B1); PG8_BAR;
            PG8_LDA(At, 0, 1); PG8_STAGE(PG8_SA(0, 0), a2, voffA);
            PG8_BAR; PG8_WAIT_L(0); PG8_MMA(1, 0, At, B0); PG8_BAR; PG8_SCHED;
            PG8_STAGE(PG8_SB(0, 1), b2 + hstep, voffB);
            PG8_WAIT_V(6); PG8_BAR; PG8_MMA(1, 1, At, B1); PG8_BAR;
            PG8_LDB(B0, 1, 0); PG8_SCHED; PG8_LDA(At, 1, 0); PG8_STAGE(PG8_SA(0, 1), a2 + hstep, voffA);
            PG8_WAIT_L(8); PG8_BAR; PG8_WAIT_L(0); PG8_MMA(0, 0, At, B0); PG8_BAR; PG8_SCHED;
            PG8_LDB(B1, 1, 1); PG8_STAGE(PG8_SB(1, 0), b3, voffB);
            PG8_BAR; PG8_WAIT_L(0); PG8_MMA(0, 1, At, B1); PG8_BAR;
            PG8_LDA(At, 1, 1); PG8_STAGE(PG8_SA(1, 0), a3, voffA);
            PG8_BAR; PG8_WAIT_L(0); PG8_MMA(1, 0, At, B0); PG8_BAR; PG8_SCHED;
            PG8_STAGE(PG8_SB(1, 1), b3 + hstep, voffB);
            PG8_WAIT_V(6); PG8_BAR; PG8_MMA(1, 1, At, B1); PG8_BAR;
            }
        }
        if constexpr (ALIGN_EPI) { if (wr == 0) PG8_BAR; }
        E(acc, cur, wr, wc, fr, fq); S.done(cur);
        if (!has_next) break;
#pragma unroll
        for (int a = 0; a < 2; ++a)
#pragma unroll
            for (int b = 0; b < 2; ++b)
#pragma unroll
                for (int m = 0; m < 4; ++m)
#pragma unroll
                    for (int n = 0; n < 2; ++n) acc[a][b][m][n] = (f32x4){0.f, 0.f, 0.f, 0.f};
        cur = nxt; cA = nA; cB = nB; ++ui;
        if constexpr (ALIGN_EPI) { if (wr == 1) PG8_BAR; }
    }
    PG8_WAIT_V(0);
    if constexpr (!ALIGN_EPI) { if (wr == 0) PG8_BAR; }
    PG8_BAR;
#undef PG8_SA
#undef PG8_SB
#undef PG8_STAGE
#undef PG8_LDA
#undef PG8_LDB
#undef PG8_MMA
#undef PG8_WAIT_V
#undef PG8_WAIT_L
#undef PG8_BAR
#undef PG8_SCHED
}
}

__device__ __forceinline__ unsigned f2bf(float f) { unsigned u = __builtin_bit_cast(unsigned, f); return (u + 0x7fffu + ((u >> 16) & 1u)) >> 16; }
__device__ __forceinline__ unsigned pk2(float lo, float hi) { return f2bf(lo) | (f2bf(hi) << 16); }
__device__ __forceinline__ float bflo(unsigned w) { return __builtin_bit_cast(float, w << 16); }
__device__ __forceinline__ float bfhi(unsigned w) { return __builtin_bit_cast(float, w & 0xffff0000u); }
__device__ __forceinline__ float fast_sigmoid(float t) { return __builtin_amdgcn_rcpf(1.0f + __builtin_amdgcn_exp2f(-1.44269504089f * t)); }
__device__ __forceinline__ float gelu_tanh(float x) { const float t = x * (1.5957691216f + 0.0713548163f * x * x); return x * fast_sigmoid(t); }
__device__ __forceinline__ float wave_sum(float v) {
#pragma unroll
    for (int o = 1; o < 64; o <<= 1) v += __shfl_xor(v, o);
    return v;
}
#define LDS_WAIT() asm volatile("s_waitcnt lgkmcnt(0)" ::: "memory")
#define VM_WAIT() asm volatile("s_waitcnt vmcnt(0)" ::: "memory")
#define RLX_AGENT __ATOMIC_RELAXED, __HIP_MEMORY_SCOPE_AGENT

constexpr size_t MiB = 1u << 20;
constexpr size_t WS_CTL = 0, CTL_ZERO_BYTES = 1 * MiB;
constexpr size_t WS_MOD   = 1 * MiB;
constexpr size_t WS_AT    = WS_MOD + 128 * 1024;
constexpr size_t WS_STATS = WS_AT + 128 * 1024;
constexpr size_t WS_SCL   = 1 * MiB + 512 * 1024;
constexpr size_t WS_KEYS  = 2 * MiB;
constexpr size_t WS_GWS   = 3 * MiB;
constexpr size_t WS_WIN   = 4 * MiB;
constexpr size_t WS_GLU   = 28 * MiB;
constexpr size_t WS_WOUT  = 32 * MiB;
constexpr size_t WS_WQ    = 48 * MiB;
constexpr size_t WS_KTAB  = 64 * MiB;
constexpr size_t WS_WG    = 72 * MiB;
constexpr size_t WS_VG    = 104 * MiB;
constexpr size_t WS_UV    = 136 * MiB;
constexpr size_t WS_X     = 392 * MiB;
constexpr size_t WS_H     = 520 * MiB;
constexpr size_t WS_Z     = 584 * MiB;
constexpr size_t WS_XS    = 648 * MiB;
constexpr size_t WS_SLOC  = 680 * MiB;
constexpr size_t WS_HS    = 688 * MiB;
constexpr size_t WS_G     = 692 * MiB;
constexpr size_t WS_MIX   = 724 * MiB;
constexpr size_t WS_EID   = 788 * MiB;
constexpr size_t WS_GATE  = 796 * MiB;
constexpr size_t WS_SU    = 804 * MiB;
constexpr size_t WS_END   = 812 * MiB;
constexpr size_t WS_DBG   = 812 * MiB;
constexpr int CW_BAR = 4096;
constexpr int CW_FLAG = 2048;
constexpr int CW_QUEUE = 16384;

constexpr int LDS_BYTES = 163840;
constexpr int MISC_OFF = LDS_BYTES - 256;

#define XB_TMO      128
#define XB_XCNT(j)  (256  + 64 * (j))
#define XB_XSUB(j)  (1280 + 64 * (j))
#define XB_XGEN(j)  (2304 + 64 * (j))
#define XB_TOP      3328
#define XB_TOPGEN   3392
#define XCD_BAR_WORDS 3456
#define XB_SPIN_CAP (1u << 24)
__device__ __forceinline__ unsigned xb_ld(unsigned* p)              { return __hip_atomic_load(p, __ATOMIC_RELAXED, __HIP_MEMORY_SCOPE_AGENT); }
__device__ __forceinline__ unsigned xb_add(unsigned* p, unsigned v) { return __hip_atomic_fetch_add(p, v, __ATOMIC_RELAXED, __HIP_MEMORY_SCOPE_AGENT); }
__device__ __forceinline__ unsigned xb_xcc_id() { return (unsigned)__builtin_amdgcn_s_getreg((3 << 11) | 20) & 0xFu; }
#define XB_SPIN(cond, bar) do { unsigned _sp = 0; while (cond) { __builtin_amdgcn_s_sleep(1); \
    if ((++_sp & 255u) == 0u) { if (xb_ld(&(bar)[XB_TMO])) break; if (_sp > XB_SPIN_CAP) { atomicAdd(&(bar)[XB_TMO], 1u); break; } } } } while (0)
struct XcdBarrier { unsigned* bar; unsigned x; volatile LAS unsigned* st; };
__device__ __forceinline__ XcdBarrier xcd_barrier_post(unsigned* bar, volatile LAS unsigned* st) {
    XcdBarrier b; b.bar = bar; b.x = xb_xcc_id(); b.st = st;
    if (threadIdx.x == 0) (void)xb_add(&bar[XB_XCNT(b.x)], 1u);
    return b;
}
__device__ __forceinline__ void xcd_barrier_complete(unsigned* bar, unsigned x, unsigned& nloc, unsigned& nx) {
    const unsigned G = gridDim.x * gridDim.y * gridDim.z;
    unsigned sum, cnt, mine, sp = 0u;
    for (;;) {
        sum = 0u; cnt = 0u; mine = 0u;
#pragma unroll
        for (unsigned j = 0; j < 16; ++j) { const unsigned c = xb_ld(&bar[XB_XCNT(j)]); sum += c; cnt += (c > 0u) ? 1u : 0u; mine = (j == x) ? c : mine; }
        if (sum == G) break;
        __builtin_amdgcn_s_sleep(1);
        if ((++sp & 255u) == 0u) { if (xb_ld(&bar[XB_TMO])) break; if (sp > XB_SPIN_CAP) { atomicAdd(&bar[XB_TMO], 1u); break; } }
    }
    nloc = mine > 0u ? mine : 1u; nx = cnt > 0u ? cnt : 1u;
}
__device__ __forceinline__ void xcd_barrier(const XcdBarrier& b) {
    asm volatile("s_waitcnt vmcnt(0)" ::: "memory");
    __syncthreads();
    if (threadIdx.x == 0) {
        unsigned* bar = b.bar;
        __builtin_amdgcn_s_waitcnt(0);
        unsigned nloc = b.st[0], nx = b.st[1];
        if (nloc == 0u) { xcd_barrier_complete(bar, b.x, nloc, nx); b.st[0] = nloc; b.st[1] = nx; }
        const unsigned old = xb_add(&bar[XB_XSUB(b.x)], 1u);
        const unsigned gen = old / nloc;
        if (old + 1u == (gen + 1u) * nloc) {
            __builtin_amdgcn_fence(__ATOMIC_RELEASE, "agent");
            asm volatile("s_waitcnt vmcnt(0)" ::: "memory");
            const unsigned og = xb_add(&bar[XB_TOP], 1u);
            const unsigned tg = og / nx;
            if (og + 1u == (tg + 1u) * nx) xb_add(&bar[XB_TOPGEN], 1u);
            else XB_SPIN(xb_ld(&bar[XB_TOPGEN]) == tg, bar);
            __builtin_amdgcn_fence(__ATOMIC_ACQUIRE, "agent");
            xb_add(&bar[XB_XGEN(b.x)], 1u);
            asm volatile("s_waitcnt vmcnt(0)" ::: "memory");
        } else {
            XB_SPIN(xb_ld(&bar[XB_XGEN(b.x)]) == gen, bar);
            __builtin_amdgcn_fence(__ATOMIC_ACQUIRE, "agent");
            asm volatile("s_waitcnt vmcnt(0)" ::: "memory");
        }
    }
    __syncthreads();
}

struct Args { const float* in[29]; float* out; unsigned char* ws; int ph_lo, ph_hi, li, pad; };
enum { I_X = 0, I_C, I_WMOD, I_BMOD, I_N1G, I_WIN, I_BIN, I_LNG, I_LNB, I_GWS, I_GBS, I_LRE, I_LIM, I_LDT, I_BRE, I_BIM, I_CRE, I_CIM, I_SD, I_GLUW, I_GLUB,
       I_BRG, I_WOUT, I_N2G, I_WQ, I_KEYS, I_PU, I_PV, I_FG };

struct Frame {
    LAS unsigned char* lds;
    unsigned char* ws;
    const float* const* in;
    float* out;
    int tid, lane, wave, vcu, G;
};

#define PH_LOCALS int tid = F.tid; asm volatile("" : "+v"(tid)); const int lane = tid & 63; const int wave = __builtin_amdgcn_readfirstlane(tid >> 6); (void)lane; (void)wave;

struct EpiIn {
    static constexpr bool PERM = true, AFTER_DRAIN = false;
    bf16* Z; bf16* XS; const float* bias;
    __device__ __forceinline__ void operator()(const f32x4 (&acc)[2][2][4][2], const pg8::Unit& u, int wr, int wc, int fr, int fq) const {
        const int row0 = u.pm * 256 + wr * 64 + fr, col0 = u.pn * 256 + wc * 32 + 8 * fq;
        f32x4 bv[2][2];
#pragma unroll
        for (int bj = 0; bj < 2; ++bj)
#pragma unroll
            for (int n = 0; n < 2; ++n) bv[bj][n] = *(const f32x4*)(bias + col0 + bj * 128 + 4 * n);
        const bool isz = (u.pn < 8);
#pragma unroll
        for (int ai = 0; ai < 2; ++ai)
#pragma unroll
            for (int m = 0; m < 4; ++m) {
                const int r = row0 + ai * 128 + m * 16;
#pragma unroll
                for (int bj = 0; bj < 2; ++bj) {
                    f32x4 v0 = acc[ai][bj][m][0] + bv[bj][0], v1 = acc[ai][bj][m][1] + bv[bj][1];
                    const int c = col0 + bj * 128;
                    u32x4 w;
                    if (isz) {
                        w.x = pg8::cvt_pk_bf16(gelu_tanh(v0[0]), gelu_tanh(v0[1])); w.y = pg8::cvt_pk_bf16(gelu_tanh(v0[2]), gelu_tanh(v0[3]));
                        w.z = pg8::cvt_pk_bf16(gelu_tanh(v1[0]), gelu_tanh(v1[1])); w.w = pg8::cvt_pk_bf16(gelu_tanh(v1[2]), gelu_tanh(v1[3]));
                        *(u32x4*)(Z + (size_t)r * 2048 + c) = w;
                    } else {
                        w.x = pg8::cvt_pk_bf16(v0[0], v0[1]); w.y = pg8::cvt_pk_bf16(v0[2], v0[3]); w.z = pg8::cvt_pk_bf16(v1[0], v1[1]); w.w = pg8::cvt_pk_bf16(v1[2], v1[3]);
                        const int cc = c - 2048, g = cc >> 4, i = cc & 15;
                        *(u32x4*)(XS + ((size_t)(g * 256 + (r >> 6)) * 64 + (r & 63)) * 16 + i) = w;
                    }
                }
            }
    }
};
struct EpiGlu {
    static constexpr bool PERM = true, AFTER_DRAIN = false;
    const bf16* Gb; bf16* MIX; const float* bias;
    __device__ __forceinline__ void operator()(const f32x4 (&acc)[2][2][4][2], const pg8::Unit& u, int wr, int wc, int fr, int fq) const {
        const int row0 = u.pm * 256 + wr * 64 + fr, col0 = u.pn * 256 + wc * 32 + 8 * fq;
        f32x4 bv[2][2];
#pragma unroll
        for (int bj = 0; bj < 2; ++bj)
#pragma unroll
            for (int n = 0; n < 2; ++n) bv[bj][n] = *(const f32x4*)(bias + col0 + bj * 128 + 4 * n);
#pragma unroll
        for (int ai = 0; ai < 2; ++ai)
#pragma unroll
            for (int m = 0; m < 4; ++m) {
                const int r = row0 + ai * 128 + m * 16;
#pragma unroll
                for (int bj = 0; bj < 2; ++bj) {
                    const f32x4 v0 = acc[ai][bj][m][0] + bv[bj][0], v1 = acc[ai][bj][m][1] + bv[bj][1];
                    const int c = col0 + bj * 128;
                    const u32x4 gw = *(const u32x4*)(Gb + (size_t)r * 1024 + c);
                    u32x4 w;
                    w.x = pg8::cvt_pk_bf16(bflo(gw.x) * fast_sigmoid(v0[0]), bfhi(gw.x) * fast_sigmoid(v0[1]));
                    w.y = pg8::cvt_pk_bf16(bflo(gw.y) * fast_sigmoid(v0[2]), bfhi(gw.y) * fast_sigmoid(v0[3]));
                    w.z = pg8::cvt_pk_bf16(bflo(gw.z) * fast_sigmoid(v1[0]), bfhi(gw.z) * fast_sigmoid(v1[1]));
                    w.w = pg8::cvt_pk_bf16(bflo(gw.w) * fast_sigmoid(v1[2]), bfhi(gw.w) * fast_sigmoid(v1[3]));
                    *(u32x4*)(MIX + (size_t)r * 2048 + 1024 + c) = w;
                }
            }
    }
};
struct EpiOut {
    static constexpr bool PERM = true, AFTER_DRAIN = false;
    const float* xin; float* X; const float* gate;
    __device__ __forceinline__ void operator()(const f32x4 (&acc)[2][2][4][2], const pg8::Unit& u, int wr, int wc, int fr, int fq) const {
        const int row0 = u.pm * 256 + wr * 64 + fr, col0 = u.pn * 256 + wc * 32 + 8 * fq;
        f32x4 gv[2][2];
#pragma unroll
        for (int bj = 0; bj < 2; ++bj)
#pragma unroll
            for (int n = 0; n < 2; ++n) gv[bj][n] = *(const f32x4*)(gate + col0 + bj * 128 + 4 * n);
#pragma unroll
        for (int ai = 0; ai < 2; ++ai)
#pragma unroll
            for (int m = 0; m < 4; ++m) {
                const int r = row0 + ai * 128 + m * 16;
#pragma unroll
                for (int bj = 0; bj < 2; ++bj) {
                    const size_t off = (size_t)r * 2048 + col0 + bj * 128;
                    const f32x4 x0 = *(const f32x4*)(xin + off), x1 = *(const f32x4*)(xin + off + 4);
                    *(f32x4*)(X + off) = x0 + gv[bj][0] * acc[ai][bj][m][0];
                    *(f32x4*)(X + off + 4) = x1 + gv[bj][1] * acc[ai][bj][m][1];
                }
            }
    }
};
struct EpiQ {
    static constexpr bool PERM = true, AFTER_DRAIN = false;
    bf16* Q;
    __device__ __forceinline__ void operator()(const f32x4 (&acc)[2][2][4][2], const pg8::Unit& u, int wr, int wc, int fr, int fq) const {
        const int row0 = u.pm * 256 + wr * 64 + fr, col0 = u.pn * 256 + wc * 32 + 8 * fq;
#pragma unroll
        for (int ai = 0; ai < 2; ++ai)
#pragma unroll
            for (int m = 0; m < 4; ++m) {
                const int r = row0 + ai * 128 + m * 16;
#pragma unroll
                for (int bj = 0; bj < 2; ++bj) {
                    const f32x4 v0 = acc[ai][bj][m][0], v1 = acc[ai][bj][m][1];
                    u32x4 w; w.x = pg8::cvt_pk_bf16(v0[0], v0[1]); w.y = pg8::cvt_pk_bf16(v0[2], v0[3]); w.z = pg8::cvt_pk_bf16(v1[0], v1[1]); w.w = pg8::cvt_pk_bf16(v1[2], v1[3]);
                    *(u32x4*)(Q + (size_t)r * 2048 + col0 + bj * 128) = w;
                }
            }
    }
};

__device__ __forceinline__ void p0_transpose_item(const float* W, int K, int N, bf16* WT, const float* kscale, LAS float* scr, int item, int lane) {
    const int nblk = N / 32, kb = item / nblk, nb = item % nblk, k0 = 64 * kb, n0 = 32 * nb;
#pragma unroll 8
    for (int i = 0; i < 32; ++i) { const int kk = 2 * i + (lane >> 5); float v = W[(size_t)(k0 + kk) * N + n0 + (lane & 31)]; if (kscale) v *= kscale[k0 + kk]; scr[kk * 33 + (lane & 31)] = v; }
    LDS_WAIT(); asm volatile("" ::: "memory");
    const int c = lane & 7;
#pragma unroll
    for (int j = 0; j < 4; ++j) { const int n = (lane >> 3) + 8 * j; const LAS float* s = scr + (8 * c) * 33 + n;
        u32x4 o; o.x = pk2(s[0 * 33], s[1 * 33]); o.y = pk2(s[2 * 33], s[3 * 33]); o.z = pk2(s[4 * 33], s[5 * 33]); o.w = pk2(s[6 * 33], s[7 * 33]);
        *(u32x4*)(WT + (size_t)(n0 + n) * K + k0 + 8 * c) = o; }
    LDS_WAIT(); asm volatile("" ::: "memory");
}

__device__ __forceinline__ void norm_mod_row(const f32x4 (&v)[4][2], const float* gain, const float* scale, const float* shift, int lane, u32x4 (&o)[4]) {
    float s = 0.f;
#pragma unroll
    for (int j = 0; j < 4; ++j)
#pragma unroll
        for (int h = 0; h < 2; ++h) s += (v[j][h][0] * v[j][h][0] + v[j][h][1] * v[j][h][1]) + (v[j][h][2] * v[j][h][2] + v[j][h][3] * v[j][h][3]);
    const float rr = 1.0f / sqrtf(wave_sum(s) * (1.0f / DM) + EPS);
#pragma unroll
    for (int j = 0; j < 4; ++j) {
        const int c = j * 512 + lane * 8;
        f32x4 y[2];
#pragma unroll
        for (int h = 0; h < 2; ++h) {
            const f32x4 g = *(const f32x4*)(gain + c + 4 * h);
            y[h] = v[j][h] * rr * g;
            const f32x4 sc = *(const f32x4*)(scale + c + 4 * h), sh = *(const f32x4*)(shift + c + 4 * h); y[h] = y[h] * (sc + 1.0f) + sh;
        }
        o[j].x = pk2(y[0][0], y[0][1]); o[j].y = pk2(y[0][2], y[0][3]); o[j].z = pk2(y[1][0], y[1][1]); o[j].w = pk2(y[1][2], y[1][3]);
    }
}
__device__ __forceinline__ void norm_row_pass(const float* xrow, bf16* hrow, const float* gain, const float* scale, const float* shift, int lane) {
    f32x4 v[4][2];
#pragma unroll
    for (int j = 0; j < 4; ++j) { v[j][0] = *(const f32x4*)(xrow + j * 512 + lane * 8); v[j][1] = *(const f32x4*)(xrow + j * 512 + lane * 8 + 4); }
    u32x4 o[4]; norm_mod_row(v, gain, scale, shift, lane, o);
#pragma unroll
    for (int j = 0; j < 4; ++j) *(u32x4*)(hrow + j * 512 + lane * 8) = o[j];
}

__device__ __forceinline__ void p0_prologue(Frame& F) {
    PH_LOCALS
    const int gw = F.vcu * NWAVES + wave, NGW = F.G * NWAVES;
    const int gt = F.vcu * NTHR + tid, NGT = F.G * NTHR;
    if ((int)blockIdx.x < 192) {
        const int l = blockIdx.x / 96, cb = blockIdx.x % 96;
        LAS float* sc = (LAS float*)F.lds;
        LAS float* red = (LAS float*)(F.lds + 8192);
        for (int k = tid; k < DM; k += NTHR) { const float c = F.in[I_C][k]; sc[k] = c * fast_sigmoid(c); }
        __syncthreads();
        const int tx = tid & 31, ty = tid >> 5;
        const float* W = F.in[I_WMOD] + (size_t)l * DM * 12288 + cb * 128 + tx * 4;
        f32x4 a = {0.f, 0.f, 0.f, 0.f};
#pragma unroll 8
        for (int k = ty; k < DM; k += 16) { const f32x4 w = *(const f32x4*)(W + (size_t)k * 12288); a += w * sc[k]; }
        *(LAS f32x4*)(red + ty * 128 + tx * 4) = a;
        __syncthreads();
        if (tid < 128) { float s = 0.f;
#pragma unroll
            for (int y = 0; y < 16; ++y) s += red[y * 128 + tid];
            ((float*)(F.ws + WS_MOD))[l * 12288 + cb * 128 + tid] = s + F.in[I_BMOD][l * 12288 + cb * 128 + tid]; }
        __syncthreads();
    }
    if ((int)blockIdx.x >= 128) {
        const int u = 255 - (int)blockIdx.x, l = u >> 6, g = u & 63;
        LAS float* apr = (LAS float*)F.lds;
        LAS float* api = apr + 65 * 64;
        LAS float* bbr = api + 65 * 64;
        LAS float* bbi = bbr + 1024;
        LAS float* ccr = bbi + 1024;
        LAS float* cci = ccr + 1024;
        const float dt = expf(F.in[I_LDT][l * 64 + g]);
        const float* lre = F.in[I_LRE] + (l * 64 + g) * 64; const float* lim = F.in[I_LIM] + (l * 64 + g) * 64;
        for (int idx = tid; idx < 65 * 64; idx += NTHR) { const int d = idx >> 6, p = idx & 63;
            const float mag = expf(lre[p] * dt * (float)d); float sn, cs; sincosf(lim[p] * dt * (float)d, &sn, &cs);
            apr[idx] = mag * cs; api[idx] = mag * sn; }
        for (int idx = tid; idx < 1024; idx += NTHR) { const int o = idx >> 6, p = idx & 63;
            ccr[idx] = F.in[I_CRE][((size_t)(l * 64 + g) * 16 + o) * 64 + p]; cci[idx] = F.in[I_CIM][((size_t)(l * 64 + g) * 16 + o) * 64 + p]; }
        __syncthreads();
        for (int idx = tid; idx < 1024; idx += NTHR) { const int p = idx >> 4, i = idx & 15;
            const float xr = apr[64 + p] - 1.0f, xi = api[64 + p], lr = lre[p], li = lim[p], den = 1.0f / (lr * lr + li * li);
            const float cr = (xr * lr + xi * li) * den, ci = (xi * lr - xr * li) * den;
            const float br = F.in[I_BRE][((size_t)(l * 64 + g) * 64 + p) * 16 + i], bi = F.in[I_BIM][((size_t)(l * 64 + g) * 64 + p) * 16 + i];
            bbr[idx] = cr * br - ci * bi; bbi[idx] = cr * bi + ci * br; }
        __syncthreads();
        bf16* KT = (bf16*)(F.ws + WS_KTAB) + (size_t)(l * 64 + g) * 80 * 256;
        for (int idx = tid; idx < 80 * 256; idx += NTHR) {
            const int d = (idx >> 8) - 16, o = (idx >> 4) & 15, i = idx & 15; float s = 0.f;
            if (d >= 0) {
                for (int p = 0; p < 64; ++p) { const float ar = apr[d * 64 + p], ai = api[d * 64 + p], cr = ccr[o * 64 + p], ci = cci[o * 64 + p];
                    const float er = cr * ar - ci * ai, ei = cr * ai + ci * ar; s += er * bbr[p * 16 + i] - ei * bbi[p * 16 + i]; }
#if !SELFTEST_S5
                if (d == 0 && o == i) s += F.in[I_SD][l * 1024 + g * 16 + o];
#endif
            }
            KT[idx] = (bf16)f2bf(s);
        }
        bf16* WG = (bf16*)(F.ws + WS_WG) + (size_t)(l * 64 + g) * 128 * 1024;
        for (int idx = tid; idx < 64 * 1024; idx += NTHR) { const int p = idx >> 10, k = idx & 1023, tau = k >> 4, i = k & 15;
            const float ar = apr[(63 - tau) * 64 + p], ai = api[(63 - tau) * 64 + p], br = bbr[p * 16 + i], bi = bbi[p * 16 + i];
            WG[(size_t)p * 1024 + k] = (bf16)f2bf(ar * br - ai * bi); WG[(size_t)(64 + p) * 1024 + k] = (bf16)f2bf(ar * bi + ai * br); }
        bf16* VG = (bf16*)(F.ws + WS_VG) + (size_t)(l * 64 + g) * 1024 * 128;
        for (int idx = tid; idx < 1024 * 64; idx += NTHR) { const int m = idx >> 6, p = idx & 63, t = m >> 4, o = m & 15;
            const float ar = apr[(t + 1) * 64 + p], ai = api[(t + 1) * 64 + p], cr = ccr[o * 64 + p], ci = cci[o * 64 + p];
            VG[(size_t)m * 128 + p] = (bf16)f2bf(cr * ar - ci * ai); VG[(size_t)m * 128 + 64 + p] = (bf16)f2bf(-(cr * ai + ci * ar)); }
        if (tid < 64) { float* AT = (float*)(F.ws + WS_AT) + ((size_t)(l * 64 + g) * 64 + tid) * 2; AT[0] = apr[64 * 64 + tid]; AT[1] = api[64 * 64 + tid]; }
        __syncthreads();
    }
    {
        LAS float* scr = (LAS float*)(F.lds + wave * 16384);
        constexpr int I_IN = (DM / 64) * (INW / 32), I_GL = (WB / 64) * (WB / 32), I_OU = (DM / 64) * (DM / 32), I_Q = I_OU;
        constexpr int PER_L = I_IN + I_GL + I_OU + I_Q;
        for (int it = gw; it < 2 * PER_L; it += NGW) {
            const int l = it / PER_L; int r = it % PER_L;
            if (r < I_IN) { p0_transpose_item(F.in[I_WIN] + (size_t)l * DM * INW, DM, INW, (bf16*)(F.ws + WS_WIN) + (size_t)l * INW * DM, nullptr, scr, r, lane); continue; } r -= I_IN;
            if (r < I_GL) { p0_transpose_item(F.in[I_GLUW] + (size_t)l * WB * WB, WB, WB, (bf16*)(F.ws + WS_GLU) + (size_t)l * WB * WB, nullptr, scr, r, lane); continue; } r -= I_GL;
            if (r < I_OU) { p0_transpose_item(F.in[I_WOUT] + (size_t)l * DM * DM, DM, DM, (bf16*)(F.ws + WS_WOUT) + (size_t)l * DM * DM, F.in[I_BRG] + l * DM, scr, r, lane); continue; } r -= I_OU;
            p0_transpose_item(F.in[I_WQ] + (size_t)l * DM * DM, DM, DM, (bf16*)(F.ws + WS_WQ) + (size_t)l * DM * DM, nullptr, scr, r, lane);
        }
    }
    {
        bf16* KB = (bf16*)(F.ws + WS_KEYS);
        for (int i = gt; i < 2 * 8 * 2 * 128 * 128 / 8; i += NGT) { const f32x4 a = *(const f32x4*)(F.in[I_KEYS] + (size_t)i * 8), b = *(const f32x4*)(F.in[I_KEYS] + (size_t)i * 8 + 4);
            u32x4 o; o.x = pk2(a[0], a[1]); o.y = pk2(a[2], a[3]); o.z = pk2(b[0], b[1]); o.w = pk2(b[2], b[3]); *(u32x4*)(KB + (size_t)i * 8) = o; }
        bf16* GW = (bf16*)(F.ws + WS_GWS);
        for (int i = gt; i < 2 * 8 * 128 * 128 / 8; i += NGT) { const int e = i * 8, jj = e & 127, ii = (e >> 7) & 127; const bool keep = (ii >= 64) || (jj < 64);
            f32x4 a = *(const f32x4*)(F.in[I_GWS] + (size_t)i * 8), b = *(const f32x4*)(F.in[I_GWS] + (size_t)i * 8 + 4);
            if (!keep) { a = (f32x4){0.f, 0.f, 0.f, 0.f}; b = a; }
            u32x4 o; o.x = pk2(a[0], a[1]); o.y = pk2(a[2], a[3]); o.z = pk2(b[0], b[1]); o.w = pk2(b[2], b[3]); *(u32x4*)(GW + (size_t)i * 8) = o; }
    }
    {
        unsigned char* UV = F.ws + WS_UV; float* SCL = (float*)(F.ws + WS_SCL);
        for (int r = gw; r < 2 * 2 * NEXP; r += NGW) {
            const int tbl = r >> 15, rr = r & 32767;
            const float* srcp = (tbl ? F.in[I_PV] : F.in[I_PU]) + (size_t)rr * 2048 + lane * 4;
            f32x4 v[8]; float am = 0.f;
#pragma unroll
            for (int j = 0; j < 8; ++j) { v[j] = *(const f32x4*)(srcp + j * 256); am = fmaxf(am, fmaxf(fmaxf(fabsf(v[j][0]), fabsf(v[j][1])), fmaxf(fabsf(v[j][2]), fabsf(v[j][3])))); }
#pragma unroll
            for (int o = 1; o < 64; o <<= 1) am = fmaxf(am, __shfl_xor(am, o));
            const float scale = am > 0.f ? am * (1.0f / 6.0f) : 1.0f, inv = am > 0.f ? 6.0f / am : 1.0f;
            u32x4 o;
#pragma unroll
            for (int d = 0; d < 4; ++d) { unsigned w = 0u;
                w = __builtin_amdgcn_cvt_scalef32_pk_fp4_f32(w, v[2 * d][0] * inv, v[2 * d][1] * inv, 1.0f, 0);
                w = __builtin_amdgcn_cvt_scalef32_pk_fp4_f32(w, v[2 * d][2] * inv, v[2 * d][3] * inv, 1.0f, 1);
                w = __builtin_amdgcn_cvt_scalef32_pk_fp4_f32(w, v[2 * d + 1][0] * inv, v[2 * d + 1][1] * inv, 1.0f, 2);
                w = __builtin_amdgcn_cvt_scalef32_pk_fp4_f32(w, v[2 * d + 1][2] * inv, v[2 * d + 1][3] * inv, 1.0f, 3);
                o[d] = w; }
            *(u32x4*)(UV + (size_t)rr * 2048 + tbl * 1024 + lane * 16) = o;
            if (lane == 0) SCL[rr * 2 + tbl] = scale;
        }
    }
}

__device__ __forceinline__ void phase_norm(Frame& F, const float* xsrc, const float* gain, const float* scale, const float* shift) {
    PH_LOCALS
    const int gw = F.vcu * NWAVES + wave, NGW = F.G * NWAVES;
    bf16* H = (bf16*)(F.ws + WS_H);
    for (int m = gw; m < M; m += NGW) norm_row_pass(xsrc + (size_t)m * DM, H + (size_t)m * DM, gain, scale, shift, lane);
}
__device__ __forceinline__ void phase_lnstats(Frame& F) {
    PH_LOCALS
    const int gw = F.vcu * NWAVES + wave, NGW = F.G * NWAVES;
    const bf16* Z = (const bf16*)(F.ws + WS_Z); float* ST = (float*)(F.ws + WS_STATS);
    for (int m = gw; m < M; m += NGW) {
        float v[16];
#pragma unroll
        for (int j = 0; j < 2; ++j) { const u32x4 w = *(const u32x4*)(Z + (size_t)m * 2048 + 1024 + j * 512 + lane * 8);
            v[j * 8 + 0] = bflo(w.x); v[j * 8 + 1] = bfhi(w.x); v[j * 8 + 2] = bflo(w.y); v[j * 8 + 3] = bfhi(w.y); v[j * 8 + 4] = bflo(w.z); v[j * 8 + 5] = bfhi(w.z); v[j * 8 + 6] = bflo(w.w); v[j * 8 + 7] = bfhi(w.w); }
        float s = 0.f;
#pragma unroll
        for (int i = 0; i < 16; ++i) s += v[i];
        const float mean = wave_sum(s) * (1.0f / 1024.0f); float q = 0.f;
#pragma unroll
        for (int i = 0; i < 16; ++i) { const float d = v[i] - mean; q += d * d; }
        const float rstd = 1.0f / sqrtf(wave_sum(q) * (1.0f / 1024.0f) + EPS);
        if (lane == 0) { ST[2 * m] = mean; ST[2 * m + 1] = rstd; }
    }
}
__device__ __forceinline__ void phase_branchnorm(Frame& F) {
    PH_LOCALS
    const int gw = F.vcu * NWAVES + wave, NGW = F.G * NWAVES;
    bf16* MIX = (bf16*)(F.ws + WS_MIX);
    for (int m = gw; m < M; m += NGW) {
        u32x4 w[4]; float sa = 0.f, sb = 0.f;
#pragma unroll
        for (int j = 0; j < 4; ++j) { w[j] = *(const u32x4*)(MIX + (size_t)m * 2048 + j * 512 + lane * 8);
            float q = 0.f;
#pragma unroll
            for (int e = 0; e < 4; ++e) { const float a = bflo(w[j][e]), b = bfhi(w[j][e]); q += a * a + b * b; }
            if (j < 2) sa += q; else sb += q; }
        const float ra = 1.0f / sqrtf(wave_sum(sa) * (1.0f / 1024.0f) + EPS), rb = 1.0f / sqrtf(wave_sum(sb) * (1.0f / 1024.0f) + EPS);
#pragma unroll
        for (int j = 0; j < 4; ++j) { const float r = j < 2 ? ra : rb; u32x4 o;
#pragma unroll
            for (int e = 0; e < 4; ++e) o[e] = pk2(bflo(w[j][e]) * r, bfhi(w[j][e]) * r);
            *(u32x4*)(MIX + (size_t)m * 2048 + j * 512 + lane * 8) = o; }
    }
}

__device__ __forceinline__ void phase_sloc(Frame& F, int l) {
    PH_LOCALS
    const bf16* XS = (const bf16*)(F.ws + WS_XS); const bf16* WG = (const bf16*)(F.ws + WS_WG) + (size_t)l * 64 * 128 * 1024; float* SL = (float*)(F.ws + WS_SLOC);
    const int fr = lane & 15, fq = lane >> 4;
    for (int u = F.vcu; u < 256; u += F.G) {
        const int g = u >> 2, n0 = (u & 3) * 64 + (wave & 3) * 16, jh = wave >> 2;
        f32x4 acc[4];
#pragma unroll
        for (int t = 0; t < 4; ++t) acc[t] = (f32x4){0.f, 0.f, 0.f, 0.f};
        const bf16* xp = XS + ((size_t)(g * 256 + n0 + fr)) * 1024 + 8 * fq;
        const bf16* wp = WG + ((size_t)(g * 128 + jh * 64 + fr)) * 1024 + 8 * fq;
#pragma unroll 8
        for (int kb = 0; kb < 32; ++kb) {
            const bf16x8 xf = *(const bf16x8*)(xp + kb * 32);
#pragma unroll
            for (int t = 0; t < 4; ++t) { const bf16x8 wf = *(const bf16x8*)(wp + (size_t)t * 16 * 1024 + kb * 32); acc[t] = __builtin_amdgcn_mfma_f32_16x16x32_bf16(wf, xf, acc[t], 0, 0, 0); }
        }
#pragma unroll
        for (int t = 0; t < 4; ++t) *(f32x4*)(SL + ((size_t)(g * 256 + n0 + fr)) * 128 + jh * 64 + t * 16 + 4 * fq) = acc[t];
    }
}
__device__ __forceinline__ void s5_carry(Frame& F, int l) {
    PH_LOCALS
    if (F.vcu < 64 && wave == 0) {
        const int g = F.vcu, p = lane;
        const float* AT = (const float*)(F.ws + WS_AT) + ((size_t)(l * 64 + g) * 64 + p) * 2; const float ar = AT[0], ai = AT[1];
        const float* SL = (const float*)(F.ws + WS_SLOC) + (size_t)g * 256 * 128; bf16* HS = (bf16*)(F.ws + WS_HS) + (size_t)g * 256 * 128;
        float hr = 0.f, hi = 0.f;
        for (int n0 = 0; n0 < 256; n0 += 8) {
            float sr[8], si[8];
#pragma unroll
            for (int e = 0; e < 8; ++e) { sr[e] = SL[(size_t)(n0 + e) * 128 + p]; si[e] = SL[(size_t)(n0 + e) * 128 + 64 + p]; }
#pragma unroll
            for (int e = 0; e < 8; ++e) { HS[(size_t)(n0 + e) * 128 + p] = (bf16)f2bf(hr); HS[(size_t)(n0 + e) * 128 + 64 + p] = (bf16)f2bf(hi);
                const float nr = ar * hr - ai * hi + sr[e], ni = ar * hi + ai * hr + si[e]; hr = nr; hi = ni; }
        }
    }
}

__device__ __forceinline__ void gating_unit(Frame& F, int l, int unit) {
    PH_LOCALS
    const int nb = unit >> 3, hh = unit & 7, t0 = nb * 128, c0 = hh * 128;
    const bf16* Z = (const bf16*)(F.ws + WS_Z); const float* ST = (const float*)(F.ws + WS_STATS);
    const bf16* GW = (const bf16*)(F.ws + WS_GWS) + (size_t)(l * 8 + hh) * 128 * 128;
    bf16* MIX = (bf16*)(F.ws + WS_MIX);
    LAS bf16* VT = (LAS bf16*)F.lds;
    constexpr int VS = 136;
    {
        const int j = tid >> 2, cs = (tid & 3) * 32;
        const float mu = ST[2 * (t0 + j)], rs = ST[2 * (t0 + j) + 1];
        const float* lg = F.in[I_LNG] + l * 1024 + c0 + cs; const float* lb = F.in[I_LNB] + l * 1024 + c0 + cs;
#pragma unroll
        for (int q = 0; q < 4; ++q) {
            const u32x4 w = *(const u32x4*)(Z + (size_t)(t0 + j) * 2048 + 1024 + c0 + cs + q * 8);
#pragma unroll
            for (int e = 0; e < 4; ++e) { const int c = cs + q * 8 + 2 * e;
                const float a = (bflo(w[e]) - mu) * rs * lg[q * 8 + 2 * e] + lb[q * 8 + 2 * e], b = (bfhi(w[e]) - mu) * rs * lg[q * 8 + 2 * e + 1] + lb[q * 8 + 2 * e + 1];
                VT[c * VS + j] = (bf16)f2bf(a); VT[(c + 1) * VS + j] = (bf16)f2bf(b); }
        }
    }
    __syncthreads();
    {
        const int fr = lane & 15, fq = lane >> 4, w = wave;
        f32x4 acc[8];
#pragma unroll
        for (int ct = 0; ct < 8; ++ct) acc[ct] = (f32x4){0.f, 0.f, 0.f, 0.f};
        const int nkb = (w < 4) ? 2 : 4;
        for (int kb = 0; kb < nkb; ++kb) {
            const bf16x8 wf = *(const bf16x8*)(GW + (size_t)(16 * w + fr) * 128 + kb * 32 + 8 * fq);
#pragma unroll
            for (int ct = 0; ct < 8; ++ct) { const bf16x8 vf = *(const LAS bf16x8*)(VT + (ct * 16 + fr) * VS + kb * 32 + 8 * fq); acc[ct] = __builtin_amdgcn_mfma_f32_16x16x32_bf16(vf, wf, acc[ct], 0, 0, 0); }
        }
        const int tok = t0 + 16 * w + fr; const float bs = F.in[I_GBS][(l * 8 + hh) * 128 + 16 * w + fr];
#pragma unroll
        for (int ct = 0; ct < 8; ++ct) { const int c = c0 + ct * 16 + 4 * fq;
            const u32x2 uw = *(const u32x2*)(Z + (size_t)tok * 2048 + c);
            u32x2 o; o.x = pk2(bflo(uw.x) * (acc[ct][0] + bs), bfhi(uw.x) * (acc[ct][1] + bs)); o.y = pk2(bflo(uw.y) * (acc[ct][2] + bs), bfhi(uw.y) * (acc[ct][3] + bs));
            *(u32x2*)(MIX + (size_t)tok * 2048 + c) = o; }
    }
    __syncthreads();
}
__device__ __forceinline__ void phase_carry_gating(Frame& F, int l, int qi) {
    PH_LOCALS
    s5_carry(F, l);
    unsigned* head = (unsigned*)(F.ws + WS_CTL) + CW_QUEUE + 64 * qi;
    LAS unsigned* slot = (LAS unsigned*)(F.lds + MISC_OFF) + 16;
    for (;;) {
        __syncthreads();
        if (tid == 0) slot[0] = __hip_atomic_fetch_add(head, 1u, RLX_AGENT);
        __syncthreads();
        const unsigned u = slot[0];
        if (u >= 1024u) break;
        gating_unit(F, l, (int)u);
    }
}

__device__ __forceinline__ void phase_s5out(Frame& F, int l) {
    PH_LOCALS
    const bf16* XS = (const bf16*)(F.ws + WS_XS); const bf16* HS = (const bf16*)(F.ws + WS_HS);
    bf16* Gb = (bf16*)(F.ws + WS_G);
    LAS unsigned char* KT = F.lds + 32768;
    LAS unsigned char* VT = F.lds + 73728;
    const int fr = lane & 15, fq = lane >> 4;
    for (int u = F.vcu; u < 512; u += F.G) {
        const int g = u >> 3, rc = (u >> 1) & 3, nh = u & 1;
        const bf16* VG = (const bf16*)(F.ws + WS_VG) + (size_t)(l * 64 + g) * 1024 * 128;
        const int n = nh * 128 + 16 * wave + fr;
        const bf16* xp0 = XS + ((size_t)(g * 256 + n)) * 1024 + 8 * fq;
        const bf16* hp0 = HS + ((size_t)(g * 256 + n)) * 128 + 8 * fq;
        bf16x8 xa[4], xb[4];
#pragma unroll
        for (int i = 0; i < 4; ++i) xa[i] = *(const bf16x8*)(xp0 + i * 32);
        __syncthreads();
        { const u32x4* src = (const u32x4*)((const bf16*)(F.ws + WS_KTAB) + (size_t)(l * 64 + g) * 80 * 256);
          for (int i = tid; i < 80 * 256 / 8; i += NTHR) ((LAS u32x4*)KT)[i] = src[i];
#pragma unroll
          for (int ps = 0; ps < 8; ++ps) { const int row = ps * 32 + (tid >> 4), c = tid & 15, q = row >> 4, o = row & 15;
              *(LAS u32x4*)(VT + row * 272 + c * 16) = *(const u32x4*)(VG + (size_t)((rc + 4 * q) * 16 + o) * 128 + c * 8); } }
        __syncthreads();
        f32x4 acc[16];
#pragma unroll
        for (int q = 0; q < 16; ++q) acc[q] = (f32x4){0.f, 0.f, 0.f, 0.f};
        const int kb0 = ((rc - (fq >> 1) + 10) * 16 + fr) * 32 + 16 * (fq & 1);
#define S5_GROUP(XF, grp_) do { const LAS unsigned char* kp = KT + kb0 - (grp_) * 4096; \
            _Pragma("unroll") for (int q = 0; q < 16; ++q) { if (rc + 4 * q >= 8 * (grp_)) { \
                _Pragma("unroll") for (int i = 0; i < 4; ++i) { const bf16x8 kf = *(const LAS bf16x8*)(kp + (4 * q - 2 * i + 6) * 512); \
                    acc[q] = __builtin_amdgcn_mfma_f32_16x16x32_bf16(kf, XF[i], acc[q], 0, 0, 0); } } } } while (0)
#pragma unroll 1
        for (int gp = 0; gp < 4; ++gp) {
#pragma unroll
            for (int i = 0; i < 4; ++i) xb[i] = *(const bf16x8*)(xp0 + ((2 * gp + 1) * 4 + i) * 32);
            S5_GROUP(xa, 2 * gp);
            if (gp < 3) {
#pragma unroll
                for (int i = 0; i < 4; ++i) xa[i] = *(const bf16x8*)(xp0 + ((2 * gp + 2) * 4 + i) * 32);
            }
            S5_GROUP(xb, 2 * gp + 1);
        }
#undef S5_GROUP
#pragma unroll 1
        for (int jb = 0; jb < 4; ++jb) {
            const bf16x8 hf = *(const bf16x8*)(hp0 + jb * 32);
#pragma unroll
            for (int q = 0; q < 16; ++q) {
                const bf16x8 vf = *(const LAS bf16x8*)(VT + (q * 16 + fr) * 272 + (jb * 32 + 8 * fq) * 2);
                acc[q] = __builtin_amdgcn_mfma_f32_16x16x32_bf16(vf, hf, acc[q], 0, 0, 0);
            }
        }
#pragma unroll
        for (int q = 0; q < 16; ++q) {
            const int t = rc + 4 * q, tok = 64 * n + t;
            const f32x4 y = acc[q];
            u32x2 o; o.x = pk2(gelu_tanh(y[0]), gelu_tanh(y[1])); o.y = pk2(gelu_tanh(y[2]), gelu_tanh(y[3]));
            *(u32x2*)(Gb + (size_t)tok * 1024 + g * 16 + 4 * fq) = o;
#if SELFTEST_S5
            if (tok < 256) *(f32x4*)((float*)(F.ws + WS_DBG) + (size_t)tok * 1024 + g * 16 + 4 * fq) = y;
#endif
        }
    }
}
#if SELFTEST_S5
__device__ __forceinline__ void selftest_s5(Frame& F, int l) {
    PH_LOCALS
    if (F.vcu < 64 && wave == 0) {
        const int g = F.vcu, p = lane;
        const float dt = expf(F.in[I_LDT][l * 64 + g]);
        const float lr = F.in[I_LRE][(l * 64 + g) * 64 + p], li = F.in[I_LIM][(l * 64 + g) * 64 + p];
        const float mag = expf(lr * dt); float sn, cs; sincosf(li * dt, &sn, &cs);
        const float ar = mag * cs, ai = mag * sn;
        const float xr = ar - 1.0f, xi = ai, den = 1.0f / (lr * lr + li * li);
        const float cr = (xr * lr + xi * li) * den, ci = (xi * lr - xr * li) * den;
        float bbr[16], bbi[16], ccr[16], cci[16];
#pragma unroll
        for (int i = 0; i < 16; ++i) { const float br = F.in[I_BRE][((size_t)(l * 64 + g) * 64 + p) * 16 + i], bi = F.in[I_BIM][((size_t)(l * 64 + g) * 64 + p) * 16 + i];
            bbr[i] = cr * br - ci * bi; bbi[i] = cr * bi + ci * br;
            ccr[i] = F.in[I_CRE][((size_t)(l * 64 + g) * 16 + i) * 64 + p]; cci[i] = F.in[I_CIM][((size_t)(l * 64 + g) * 16 + i) * 64 + p]; }
        const bf16* XS = (const bf16*)(F.ws + WS_XS) + (size_t)g * 256 * 1024;
        const float* DY = (const float*)(F.ws + WS_DBG);
        float sr = 0.f, si = 0.f, err = 0.f, ref = 0.f;
        for (int t = 0; t < 256; ++t) {
            float x[16];
#pragma unroll
            for (int i = 0; i < 16; ++i) x[i] = bflo((unsigned)XS[(size_t)t * 16 + i]);
            float ur = 0.f, ui = 0.f;
#pragma unroll
            for (int i = 0; i < 16; ++i) { ur += bbr[i] * x[i]; ui += bbi[i] * x[i]; }
            const float nr = ar * sr - ai * si + ur, ni = ar * si + ai * sr + ui; sr = nr; si = ni;
#pragma unroll
            for (int o = 0; o < 16; ++o) {
                const float yr = wave_sum(ccr[o] * sr - cci[o] * si);
                const float yf = DY[(size_t)t * 1024 + g * 16 + o];
                err += (yf - yr) * (yf - yr); ref += yr * yr;
            }
        }
        if (lane == 0 && !(err <= 2e-3f * ref)) __hip_atomic_fetch_or((unsigned*)(F.ws + WS_CTL) + CW_FLAG, 1u, RLX_AGENT);
    }
}
#endif

__device__ __forceinline__ unsigned f2key(float v) { const unsigned u = __builtin_bit_cast(unsigned, v); return (u & 0x80000000u) ? ~u : (u | 0x80000000u); }
__device__ __forceinline__ float key2f(unsigned k) { const unsigned u = (k & 0x80000000u) ? (k & 0x7fffffffu) : ~k; return __builtin_bit_cast(float, u); }
__device__ __forceinline__ void sort16_desc(unsigned (&v)[16]) {
#pragma unroll
    for (int lk = 1; lk <= 4; ++lk) {
#pragma unroll
        for (int lj = lk - 1; lj >= 0; --lj) {
#pragma unroll
            for (int i = 0; i < 16; ++i) { const int k = 1 << lk, j = 1 << lj, p = i ^ j;
                if (p > i) { const unsigned a = v[i], c = v[p], hi = a > c ? a : c, lo = a > c ? c : a; const bool desc = ((i & k) == 0) || (k == 16);
                    v[i] = desc ? hi : lo; v[p] = desc ? lo : hi; } }
        }
    }
}
__device__ __forceinline__ void merge16_desc(unsigned (&v)[16], const unsigned (&w)[16]) {
#pragma unroll
    for (int i = 0; i < 16; ++i) v[i] = v[i] > w[15 - i] ? v[i] : w[15 - i];
#pragma unroll
    for (int lj = 3; lj >= 0; --lj) {
#pragma unroll
        for (int i = 0; i < 16; ++i) { const int j = 1 << lj, p = i ^ j;
            if (p > i) { const unsigned a = v[i], c = v[p]; v[i] = a > c ? a : c; v[p] = a > c ? c : a; } }
    }
}
__device__ __forceinline__ void xmerge16(unsigned (&v)[16], int mask) {
    unsigned w[16];
#pragma unroll
    for (int i = 0; i < 16; ++i) w[i] = (unsigned)__shfl_xor((int)v[i], mask);
    merge16_desc(v, w);
}
__device__ __forceinline__ void phase_topk(Frame& F, int l) {
    PH_LOCALS
    const bf16* Q = (const bf16*)(F.ws + WS_Z);
    const bf16* KB = (const bf16*)(F.ws + WS_KEYS) + (size_t)l * 8 * 2 * 128 * 128;
    int* EID = (int*)(F.ws + WS_EID); float* GT = (float*)(F.ws + WS_GATE); float* SUo = (float*)(F.ws + WS_SU);
    const float* SCL = (const float*)(F.ws + WS_SCL) + (size_t)l * NEXP * 2;
    LAS unsigned char* KL = F.lds;
    LAS float* SC = (LAS float*)(F.lds + 69632);
    LAS unsigned* LST = (LAS unsigned*)(F.lds + 69632 + 66560);
    LAS unsigned char* PT = F.lds + 69632 + 66560 + 8192;
    const int fr = lane & 15, fq = lane >> 4;
    {
        int c = 0;
#pragma unroll
        for (int i = 0; i < 16; ++i)
#pragma unroll
            for (int j = 0; j < 16; ++j) if ((i + 1) * (j + 1) <= 16) { if (tid == c) PT[c] = (unsigned char)(i * 16 + j); ++c; }
    }
    int cur_hh = -1;
    for (int u = F.vcu; u < 2048; u += F.G) {
        const int tt = u >> 3, hh = u & 7, t0 = tt * 64;
        const int tw = wave & 3, s = wave >> 2;
        bf16x8 qf[4];
#pragma unroll
        for (int kb = 0; kb < 4; ++kb) qf[kb] = *(const bf16x8*)(Q + (size_t)(t0 + 16 * tw + fr) * 2048 + hh * 256 + s * 128 + kb * 32 + 8 * fq);
        if (hh != cur_hh) {
            __syncthreads();
#pragma unroll
            for (int ps = 0; ps < 8; ++ps) { const int idx = ps * 512 + tid, row = idx >> 4, c16 = idx & 15;
                *(LAS u32x4*)(KL + row * 272 + c16 * 16) = *(const u32x4*)(KB + ((size_t)(hh * 256 + row)) * 128 + c16 * 8); }
            cur_hh = hh;
        }
        __syncthreads();
        {
            f32x4 acc[8];
#pragma unroll
            for (int nt = 0; nt < 8; ++nt) acc[nt] = (f32x4){0.f, 0.f, 0.f, 0.f};
#pragma unroll
            for (int kb = 0; kb < 4; ++kb)
#pragma unroll
                for (int nt = 0; nt < 8; ++nt) { const bf16x8 kf = *(const LAS bf16x8*)(KL + (s * 128 + nt * 16 + fr) * 272 + (kb * 32 + 8 * fq) * 2);
                    acc[nt] = __builtin_amdgcn_mfma_f32_16x16x32_bf16(kf, qf[kb], acc[nt], 0, 0, 0); }
#pragma unroll
            for (int nt = 0; nt < 8; ++nt) *(LAS f32x4*)(SC + (16 * tw + fr) * 260 + s * 128 + nt * 16 + 4 * fq) = acc[nt];
        }
        __syncthreads();
        {
            const int pr = tid >> 2, sub = tid & 3, tl = pr >> 1, sd = pr & 1;
            const LAS float* row = SC + tl * 260 + sd * 128 + 32 * sub;
            unsigned va[16], vb[16];
#pragma unroll
            for (int q4 = 0; q4 < 4; ++q4) { const f32x4 x = *(const LAS f32x4*)(row + 4 * q4), y = *(const LAS f32x4*)(row + 16 + 4 * q4);
#pragma unroll
                for (int e = 0; e < 4; ++e) { va[4 * q4 + e] = (f2key(x[e]) & ~0x7Fu) | (unsigned)(127 - (32 * sub + 4 * q4 + e)); vb[4 * q4 + e] = (f2key(y[e]) & ~0x7Fu) | (unsigned)(127 - (32 * sub + 16 + 4 * q4 + e)); } }
            sort16_desc(va); sort16_desc(vb); merge16_desc(va, vb);
            xmerge16(va, 1); xmerge16(va, 2);
            if (sub == 0) {
#pragma unroll
                for (int k = 0; k < 16; k += 4) *(LAS u32x4*)(LST + pr * 16 + k) = (u32x4){va[k], va[k + 1], va[k + 2], va[k + 3]};
            }
        }
        __syncthreads();
        {
            const int tl = tid >> 3, s8 = tid & 7;
            unsigned v[16];
#pragma unroll
            for (int m = 0; m < 7; ++m) { const int c = m * 8 + s8; unsigned key = 0u;
                if (c < 50) { const int pij = PT[c], i = pij >> 4, j = pij & 15;
                    const float av = key2f(LST[(tl * 2 + 0) * 16 + i] & ~0x7Fu), bv = key2f(LST[(tl * 2 + 1) * 16 + j] & ~0x7Fu);
                    key = (f2key(av + bv) & ~0xFFu) | (unsigned)(255 - pij); }
                v[m] = key; }
#pragma unroll
            for (int m = 7; m < 16; ++m) v[m] = 0u;
            sort16_desc(v);
            xmerge16(v, 1); xmerge16(v, 2); xmerge16(v, 4);
            float ev[16]; float sum = 0.f; const float mx = key2f(v[0] & ~0xFFu);
#pragma unroll
            for (int k = 0; k < 16; ++k) { ev[k] = __expf(key2f(v[k] & ~0xFFu) - mx); sum += ev[k]; }
            const float inv = 1.0f / sum;
            unsigned k0 = v[0], k1 = v[1]; float e0 = ev[0], e1 = ev[1];
#pragma unroll
            for (int q = 1; q < 8; ++q) { if (s8 == q) { k0 = v[2 * q]; k1 = v[2 * q + 1]; e0 = ev[2 * q]; e1 = ev[2 * q + 1]; } }
            const size_t ob = (size_t)(t0 + tl) * 128 + hh * 16 + 2 * s8;
            {   const int flat = 255 - (int)(k0 & 0xFFu), i = flat >> 4, j = flat & 15;
                const int ia = 127 - (int)(LST[(tl * 2 + 0) * 16 + i] & 0x7Fu), ib = 127 - (int)(LST[(tl * 2 + 1) * 16 + j] & 0x7Fu);
                const int e = ia * 128 + ib; const f32x2 sc = *(const f32x2*)(SCL + 2 * e);
                EID[ob] = e; GT[ob] = e0 * inv * sc.y; SUo[ob] = sc.x; }
            {   const int flat = 255 - (int)(k1 & 0xFFu), i = flat >> 4, j = flat & 15;
                const int ia = 127 - (int)(LST[(tl * 2 + 0) * 16 + i] & 0x7Fu), ib = 127 - (int)(LST[(tl * 2 + 1) * 16 + j] & 0x7Fu);
                const int e = ia * 128 + ib; const f32x2 sc = *(const f32x2*)(SCL + 2 * e);
                EID[ob + 1] = e; GT[ob + 1] = e1 * inv * sc.y; SUo[ob + 1] = sc.x; }
        }
    }
    __syncthreads();
}

#define FP4X4(w, f0, f1, f2, f3) do { f0 = __builtin_amdgcn_cvt_scalef32_pk_f32_fp4((w), 1.0f, 0); f1 = __builtin_amdgcn_cvt_scalef32_pk_f32_fp4((w), 1.0f, 1); \
    f2 = __builtin_amdgcn_cvt_scalef32_pk_f32_fp4((w), 1.0f, 2); f3 = __builtin_amdgcn_cvt_scalef32_pk_f32_fp4((w), 1.0f, 3); } while (0)
__device__ __forceinline__ void phase_gather(Frame& F, int l, bool dummy = false) {
    PH_LOCALS
    const int gw = F.vcu * NWAVES + wave, NGW = F.G * NWAVES;
    const bf16* H = (const bf16*)(F.ws + WS_H); bf16* Hn = dummy ? (bf16*)(F.ws + WS_DBG + 128 * MiB) : (bf16*)(F.ws + WS_H);
    const unsigned char* UV = F.ws + WS_UV + (size_t)l * NEXP * 2048;
    const int* EID = (const int*)(F.ws + WS_EID); const float* GT = (const float*)(F.ws + WS_GATE); const float* SU = (const float*)(F.ws + WS_SU);
    const float* X = (const float*)(F.ws + WS_X); float* Xo = dummy ? (float*)(F.ws + WS_DBG) : (float*)(F.ws + WS_X);
    const float* mod = (const float*)(F.ws + WS_MOD);
    const float* gate2 = mod + l * 12288 + 5 * 2048;
    const unsigned lane16 = (unsigned)lane * 16u;
    constexpr int NB = 16;
    for (int t = gw; t < M; t += NGW) {
        const int e_lo = EID[(size_t)t * 128 + lane], e_hi = EID[(size_t)t * 128 + 64 + lane];
        const float g_lo = GT[(size_t)t * 128 + lane], g_hi = GT[(size_t)t * 128 + 64 + lane];
        const float s_lo = SU[(size_t)t * 128 + lane], s_hi = SU[(size_t)t * 128 + 64 + lane];
        f32x2 hh[8][2];
#pragma unroll
        for (int j = 0; j < 8; ++j) { const u32x2 w = *(const u32x2*)(H + (size_t)t * 2048 + j * 256 + lane * 4);
            hh[j][0] = (f32x2){bflo(w.x), bfhi(w.x)}; hh[j][1] = (f32x2){bflo(w.y), bfhi(w.y)}; }
        f32x2 of[8][2];
#pragma unroll
        for (int j = 0; j < 8; ++j) { of[j][0] = (f32x2){0.f, 0.f}; of[j][1] = (f32x2){0.f, 0.f}; }
        for (int b = 0; b < 128 / NB; ++b) {
            const bool first = (b * NB) < 64;
            const int esel = first ? e_lo : e_hi; const float gsel = first ? g_lo : g_hi, ssel = first ? s_lo : s_hi;
            u32x4 ur[NB], vr[NB];
#pragma unroll
            for (int h = 0; h < NB; ++h) {
                const int e = __builtin_amdgcn_readlane(esel, (NB * b + h) & 63);
                const unsigned char* rowp = UV + ((size_t)(unsigned)e << 11);
                ur[h] = *(const u32x4*)(rowp + lane16); vr[h] = *(const u32x4*)(rowp + 1024 + lane16);
            }
            float p[NB];
#pragma unroll
            for (int h = 0; h < NB; ++h) {
                f32x2 a2 = {0.f, 0.f};
#pragma unroll
                for (int d = 0; d < 4; ++d) { f32x2 f0, f1, f2, f3; FP4X4(ur[h][d], f0, f1, f2, f3);
                    a2 = f0 * hh[2 * d][0] + a2; a2 = f1 * hh[2 * d][1] + a2; a2 = f2 * hh[2 * d + 1][0] + a2; a2 = f3 * hh[2 * d + 1][1] + a2; }
                p[h] = a2.x + a2.y;
            }
            const bool u32_ = (lane & 32) != 0, u16_ = (lane & 16) != 0, u8_ = (lane & 8) != 0, u4_ = (lane & 4) != 0;
            float a8[8];
#pragma unroll
            for (int i = 0; i < 8; ++i) { const float snd = u32_ ? p[i] : p[8 + i], kp = u32_ ? p[8 + i] : p[i]; a8[i] = kp + __shfl_xor(snd, 32); }
            float a4[4];
#pragma unroll
            for (int i = 0; i < 4; ++i) { const float snd = u16_ ? a8[i] : a8[4 + i], kp = u16_ ? a8[4 + i] : a8[i]; a4[i] = kp + __shfl_xor(snd, 16); }
            float b2[2];
#pragma unroll
            for (int i = 0; i < 2; ++i) { const float snd = u8_ ? a4[i] : a4[2 + i], kp = u8_ ? a4[2 + i] : a4[i]; b2[i] = kp + __shfl_xor(snd, 8); }
            float d;
            { const float snd = u4_ ? b2[0] : b2[1], kp = u4_ ? b2[1] : b2[0]; d = kp + __shfl_xor(snd, 4); }
            d += __shfl_xor(d, 2); d += __shfl_xor(d, 1);
            const int hl = (NB * b + (lane >> 2)) & 63;
            const float gq = __shfl(gsel, hl), sq = __shfl(ssel, hl);
            const float coefq = gq * gelu_tanh(d * sq);
#pragma unroll
            for (int h = 0; h < NB; ++h) {
                const float cf = __builtin_bit_cast(float, __builtin_amdgcn_readlane(__builtin_bit_cast(int, coefq), 4 * h));
                const f32x2 cf2 = {cf, cf};
#pragma unroll
                for (int dd = 0; dd < 4; ++dd) { f32x2 f0, f1, f2, f3; FP4X4(vr[h][dd], f0, f1, f2, f3);
                    of[2 * dd][0] = f0 * cf2 + of[2 * dd][0]; of[2 * dd][1] = f1 * cf2 + of[2 * dd][1]; of[2 * dd + 1][0] = f2 * cf2 + of[2 * dd + 1][0]; of[2 * dd + 1][1] = f3 * cf2 + of[2 * dd + 1][1]; }
            }
        }
        int ln = lane; asm volatile("" : "+v"(ln));
        f32x4 xv[8]; float ss = 0.f;
#pragma unroll
        for (int j = 0; j < 8; ++j) {
            const int c = j * 256 + ln * 4;
            const f32x4 xo = *(const f32x4*)(X + (size_t)t * 2048 + c), g2 = *(const f32x4*)(gate2 + c);
            const f32x4 o = {of[j][0].x, of[j][0].y, of[j][1].x, of[j][1].y};
            xv[j] = xo + g2 * o;
            ss += (xv[j][0] * xv[j][0] + xv[j][1] * xv[j][1]) + (xv[j][2] * xv[j][2] + xv[j][3] * xv[j][3]);
        }
        const float rr = 1.0f / sqrtf(wave_sum(ss) * (1.0f / DM) + EPS);
        if (l + 1 < DEPTH) {
            const float* m2 = mod + (l + 1) * 12288; const float* gain = F.in[I_N1G] + (l + 1) * 2048;
#pragma unroll
            for (int j = 0; j < 8; ++j) {
                const int c = j * 256 + ln * 4;
                *(f32x4*)(Xo + (size_t)t * 2048 + c) = xv[j];
                const f32x4 g = *(const f32x4*)(gain + c), sc = *(const f32x4*)(m2 + 2048 + c), sh = *(const f32x4*)(m2 + c);
                const f32x4 y = xv[j] * rr * g * (sc + 1.0f) + sh;
                *(u32x2*)(Hn + (size_t)t * 2048 + c) = (u32x2){pk2(y[0], y[1]), pk2(y[2], y[3])};
            }
        } else {
#pragma unroll
            for (int j = 0; j < 8; ++j) { const int c = j * 256 + ln * 4; const f32x4 fg = *(const f32x4*)(F.in[I_FG] + c);
                f32x4 ov = xv[j] * rr * fg;
#if SELFTEST_S5
                if (__hip_atomic_load((unsigned*)(F.ws + WS_CTL) + CW_FLAG, RLX_AGENT) != 0u) ov = (f32x4){1e30f, 1e30f, 1e30f, 1e30f};
#endif
                *(f32x4*)(F.out + (size_t)t * 2048 + c) = ov; }
        }
    }
}

__global__ void __launch_bounds__(NTHR, 2) fwd_kernel(Args args) {
    extern __shared__ __attribute__((aligned(16))) unsigned char lds_raw[];
    Frame F;
    F.lds = (LAS unsigned char*)lds_raw; F.ws = args.ws; F.in = args.in; F.out = args.out;
    F.tid = threadIdx.x; F.lane = F.tid & 63; F.wave = __builtin_amdgcn_readfirstlane(F.tid >> 6);
    F.G = gridDim.x; { const int bx = blockIdx.x; F.vcu = (F.G % 8 == 0) ? (bx % 8) * (F.G / 8) + bx / 8 : bx; }
    volatile LAS unsigned* MISC = (volatile LAS unsigned*)(F.lds + MISC_OFF);
    if (F.tid < 64) MISC[F.tid] = 0u;
    __syncthreads();
    unsigned* ctl = (unsigned*)(F.ws + WS_CTL);
    XcdBarrier bar; bar.bar = ctl + CW_BAR; bar.x = 0; bar.st = nullptr;
#if !MK_PER_PHASE
    bar = xcd_barrier_post(ctl + CW_BAR, MISC + 8);
#endif
    const int lo = args.ph_lo, hi = args.ph_hi;
#define IN(k) (lo <= (k) && (k) < hi)
#if MK_PER_PHASE
#define SEAM(k) do { } while (0)
#else
#define SEAM(k) do { if (IN(k) && IN((k) + 1)) xcd_barrier(bar); } while (0)
#endif
    const float* mod = (const float*)(F.ws + WS_MOD);

#define REP(k) (REPEAT_PH == (k))
#define RUN2(k, first, real) do { if (REP(k)) { first; xcd_barrier(bar); } real; } while (0)
    if (IN(0)) { RUN2(0, p0_prologue(F), p0_prologue(F)); } SEAM(0);
    for (int l = 0; l < DEPTH; ++l) {
        const int pb = 1 + 12 * l;
        const float* ml = mod + l * 12288;
        const float* xin = (l == 0) ? F.in[I_X] : (const float*)(F.ws + WS_X);
        if (IN(pb + 0)) { if (l == 0) RUN2(1, phase_norm(F, xin, F.in[I_N1G] + l * 2048, ml + 1 * 2048, ml + 0 * 2048), phase_norm(F, xin, F.in[I_N1G] + l * 2048, ml + 1 * 2048, ml + 0 * 2048)); } SEAM(pb + 0);
        if (IN(pb + 1)) {
            pg8::Gemm g{(const bf16*)(F.ws + WS_H), (const bf16*)(F.ws + WS_WIN) + (size_t)l * INW * DM, M, INW, DM}; pg8::StaticOrder S; S.init(M, INW, F.G, (int)blockIdx.x);
            EpiIn E{(bf16*)(F.ws + WS_Z), (bf16*)(F.ws + WS_XS), F.in[I_BIN] + l * INW};
#define GEMM_IN pg8::gemm_phase<EpiIn, pg8::StaticOrder, true, true>(F.lds, g, S, E)
            RUN2(2, GEMM_IN, GEMM_IN);
        } SEAM(pb + 1);
        if (IN(pb + 2)) { RUN2(3, (phase_sloc(F, l), phase_lnstats(F)), (phase_sloc(F, l), phase_lnstats(F))); } SEAM(pb + 2);
        if (IN(pb + 3)) { RUN2(4, phase_carry_gating(F, l, l + 2), phase_carry_gating(F, l, l)); } SEAM(pb + 3);
        if (IN(pb + 4)) { RUN2(5, phase_s5out(F, l), phase_s5out(F, l));
#if SELFTEST_S5
            xcd_barrier(bar); selftest_s5(F, l);
#endif
        } SEAM(pb + 4);
        if (IN(pb + 5)) {
            pg8::Gemm g{(const bf16*)(F.ws + WS_G), (const bf16*)(F.ws + WS_GLU) + (size_t)l * WB * WB, M, WB, WB}; pg8::StaticOrder S; S.init(M, WB, F.G, (int)blockIdx.x);
            EpiGlu E{(const bf16*)(F.ws + WS_G), (bf16*)(F.ws + WS_MIX), F.in[I_GLUB] + l * WB};
#define GEMM_GLU pg8::gemm_phase<EpiGlu, pg8::StaticOrder, true, true>(F.lds, g, S, E)
            RUN2(6, GEMM_GLU, GEMM_GLU);
        } SEAM(pb + 5);
        if (IN(pb + 6)) { RUN2(7, phase_branchnorm(F), phase_branchnorm(F)); } SEAM(pb + 6);
        if (IN(pb + 7)) {
            pg8::Gemm g{(const bf16*)(F.ws + WS_MIX), (const bf16*)(F.ws + WS_WOUT) + (size_t)l * DM * DM, M, DM, DM}; pg8::StaticOrder S; S.init(M, DM, F.G, (int)blockIdx.x);
            EpiOut E{xin, (float*)(F.ws + WS_X), ml + 2 * 2048};
            EpiOut Ed{xin, (float*)(F.ws + WS_DBG), ml + 2 * 2048};
#define GEMM_OUT(EE) pg8::gemm_phase<EpiOut, pg8::StaticOrder, true, true>(F.lds, g, S, EE)
            RUN2(8, GEMM_OUT(Ed), GEMM_OUT(E));
        } SEAM(pb + 7);
        if (IN(pb + 8)) { RUN2(9, phase_norm(F, (const float*)(F.ws + WS_X), F.in[I_N2G] + l * 2048, ml + 4 * 2048, ml + 3 * 2048), phase_norm(F, (const float*)(F.ws + WS_X), F.in[I_N2G] + l * 2048, ml + 4 * 2048, ml + 3 * 2048)); } SEAM(pb + 8);
        if (IN(pb + 9)) {
            pg8::Gemm g{(const bf16*)(F.ws + WS_H), (const bf16*)(F.ws + WS_WQ) + (size_t)l * DM * DM, M, DM, DM}; pg8::StaticOrder S; S.init(M, DM, F.G, (int)blockIdx.x);
            EpiQ E{(bf16*)(F.ws + WS_Z)};
#define GEMM_Q pg8::gemm_phase<EpiQ, pg8::StaticOrder, true, true>(F.lds, g, S, E)
            RUN2(10, GEMM_Q, GEMM_Q);
        } SEAM(pb + 9);
        if (IN(pb + 10)) { RUN2(11, phase_topk(F, l), phase_topk(F, l)); } SEAM(pb + 10);
        if (IN(pb + 11)) { RUN2(12, phase_gather(F, l, true), phase_gather(F, l, false)); } SEAM(pb + 11);
    }
#undef IN
#undef SEAM
}

extern "C" void kernel_launch(void* const* d_in, const int* in_sizes, int n_in, void* d_out, int out_size, void* d_ws, size_t ws_size, hipStream_t stream) {
    static int grid = 0;
    if (grid == 0) {
        if (n_in != 29 || out_size != M * DM || ws_size < WS_END) { fprintf(stderr, "kernel_launch: unexpected shapes (n_in %d, out %d, ws %zu); nothing launched\n", n_in, out_size, ws_size); grid = -1; return; }
        int dev = 0, cus = 0;
        if (hipGetDevice(&dev) != hipSuccess || hipDeviceGetAttribute(&cus, hipDeviceAttributeMultiprocessorCount, dev) != hipSuccess) { grid = -1; return; }
        if (hipFuncSetAttribute((const void*)fwd_kernel, hipFuncAttributeMaxDynamicSharedMemorySize, LDS_BYTES) != hipSuccess) { fprintf(stderr, "kernel_launch: hipFuncSetAttribute failed\n"); grid = -1; return; }
        (void)hipGetLastError();
        grid = cus;
    }
    if (grid < 0) return;
    (void)hipMemsetAsync((char*)d_ws + WS_CTL, 0, CTL_ZERO_BYTES, stream);
    Args a{};
    for (int i = 0; i < 29; ++i) a.in[i] = (const float*)d_in[i];
    a.out = (float*)d_out; a.ws = (unsigned char*)d_ws;
#if MK_PER_PHASE
    for (int p = 0; p < 1 + 12 * DEPTH; ++p) {
        if (p == 13) continue;
        a.ph_lo = p; a.ph_hi = p + 1; a.li = p;
        hipLaunchKernelGGL(fwd_kernel, dim3(grid), dim3(NTHR), LDS_BYTES, stream, a);
    }
#else
    a.ph_lo = 0; a.ph_hi = 1 + 12 * DEPTH; a.li = 0;
    hipLaunchKernelGGL(fwd_kernel, dim3(grid), dim3(NTHR), LDS_BYTES, stream, a);
#endif
}
```

```cpp
#include <hip/hip_runtime.h>
#include <cstdio>
#include <cstdint>

#ifndef SELFTEST_S5
#define SELFTEST_S5 0
#endif
#ifndef REPEAT_PH
#define REPEAT_PH -1
#endif
#ifndef MK_PER_PHASE
#define MK_PER_PHASE 0
#endif

#define GAS __attribute__((address_space(1)))
#define LAS __attribute__((address_space(3)))
typedef unsigned short bf16;
typedef short bf16x8 __attribute__((ext_vector_type(8)));
typedef float f32x4 __attribute__((ext_vector_type(4)));
typedef float f32x2 __attribute__((ext_vector_type(2)));
typedef unsigned u32x4 __attribute__((ext_vector_type(4)));
typedef unsigned u32x2 __attribute__((ext_vector_type(2)));

constexpr int DM = 2048, SEQ = 16384, DEPTH = 2, M = SEQ;
constexpr int WA = 1024, WB = 1024, INW = 3072;
constexpr int NG = 64, NCH = 256;
constexpr int NEXP = 16384;
constexpr float EPS = 1e-6f;
constexpr int NWAVES = 8, NTHR = 512;

namespace pg8 {
#define PG8_LAS __attribute__((address_space(3)))
constexpr int BM = 256, BK = 64, HALF = 128, HTB = HALF * BK * 2, STAGE_BYTES = 8 * HTB, NXCD = 8, WGM = 8;
__host__ __device__ __forceinline__ int lds_byte(int r, int c) { const int st = (r >> 4) * 2 + (c >> 5), rr = r & 15, cc = c & 31, ob = rr * 64 + cc * 2; return st * 1024 + (ob ^ (((ob >> 9) & 1) << 5)); }
__host__ __device__ __forceinline__ void stage_rc(int b, int& R, int& C) { const int st = b / 1024, sb = b % 1024, swz = sb ^ (((sb >> 9) & 1) << 5); R = (st >> 1) * 16 + swz / 64; C = (st & 1) * 32 + (swz % 64) / 2; }
__host__ __device__ __forceinline__ int perm32(int rho) { const int n = rho >> 4, i = rho & 15; return 8 * (i >> 2) + 4 * n + (i & 3); }
struct Unit { int pm, pn; };
struct Gemm { const bf16* A; const bf16* Bt; int M, N, K; };
struct StaticOrder {
    int nM, nN, nwg, G, c;
    __host__ __device__ void init(int M_, int N_, int G_, int c_) { nM = M_ / BM; nN = N_ / BM; nwg = nM * nN; G = G_; c = c_; }
    __host__ __device__ bool next(int i, Unit& u) const {
        const long L = (long)i * G + c; if (L >= nwg) return false;
        int wgid = (int)L; { const int q = nwg / NXCD, r = nwg % NXCD, xcd = wgid % NXCD, off = wgid / NXCD; wgid = (xcd < r ? xcd * (q + 1) : r * (q + 1) + (xcd - r) * q) + off; }
        const int nig = WGM * nN, gid = wgid / nig, fm = gid * WGM, gsz = (nM - fm) < WGM ? (nM - fm) : WGM;
        u.pm = fm + ((wgid % nig) % gsz); u.pn = (wgid % nig) / gsz; return true;
    }
    __device__ __forceinline__ void a_ready(const Unit&) const {}
    __device__ __forceinline__ void done(const Unit&) const {}
};
__device__ __forceinline__ unsigned cvt_pk_bf16(float lo, float hi) { unsigned r; asm volatile("v_cvt_pk_bf16_f32 %0, %1, %2" : "=v"(r) : "v"(lo), "v"(hi)); return r; }

template <class Epi, class Sched, bool ALIGN_EPI = false, bool SP2 = false>
__device__ __forceinline__ void gemm_phase(PG8_LAS unsigned char* lds, const Gemm g, const Sched& S, const Epi& E) {
    int tid = threadIdx.x; asm volatile("" : "+v"(tid)); const int wid = __builtin_amdgcn_readfirstlane(tid >> 6), lane = tid & 63, wr = wid >> 2, wc = wid & 3, fr = lane & 15, fq = lane >> 4;
    const int K = g.K, nt = K / BK;
    unsigned voffA[2], voffB[2];
#pragma unroll
    for (int i = 0; i < 2; ++i) { int R, C; stage_rc(tid * 16 + i * 8192, R, C); const int Rb = Epi::PERM ? ((R & ~31) + perm32(R & 31)) : R;
        voffA[i] = (unsigned)(R * K + C) * 2u; voffB[i] = (unsigned)(Rb * K + C) * 2u; }
    const size_t kstep = (size_t)(BK * 2);
    const size_t hstep = (size_t)HALF * K * 2;
    const size_t tstep = 2 * hstep;
    const unsigned ldsw = (unsigned)wid * 1024u;
    const int aoff = lds_byte(wr * 64 + fr, fq * 8), boff = lds_byte(wc * 32 + fr, fq * 8);
#define PG8_SA(b, h) (((b) * 2 + (h)) * HTB)
#define PG8_SB(b, h) ((4 + (b) * 2 + (h)) * HTB)
#define PG8_STAGE(bufoff, gbase, voff) do { _Pragma("unroll") for (int _i = 0; _i < 2; ++_i) \
        __builtin_amdgcn_global_load_lds((const unsigned*)((const char*)(gbase) + (voff)[_i]), (PG8_LAS unsigned*)(lds + (bufoff) + ldsw + _i * 8192), 16, 0, 0); } while (0)
#define PG8_LDA(dst, b, h) do { _Pragma("unroll") for (int m = 0; m < 4; ++m) _Pragma("unroll") for (int k = 0; k < 2; ++k) dst[m][k] = *(const PG8_LAS bf16x8*)(lds + PG8_SA(b, h) + aoff + m * 2048 + k * 1024); } while (0)
#define PG8_LDB(dst, b, h) do { _Pragma("unroll") for (int n = 0; n < 2; ++n) _Pragma("unroll") for (int k = 0; k < 2; ++k) dst[n][k] = *(const PG8_LAS bf16x8*)(lds + PG8_SB(b, h) + boff + n * 2048 + k * 1024); } while (0)
#define PG8_MMA(ai, bj, At, Bt) do { __builtin_amdgcn_s_setprio(1); _Pragma("unroll") for (int m = 0; m < 4; ++m) _Pragma("unroll") for (int n = 0; n < 2; ++n) _Pragma("unroll") for (int k = 0; k < 2; ++k) \
        acc[ai][bj][m][n] = __builtin_amdgcn_mfma_f32_16x16x32_bf16(Bt[n][k], At[m][k], acc[ai][bj][m][n], 0, 0, 0); __builtin_amdgcn_s_setprio(0); } while (0)
#define PG8_WAIT_V(n) asm volatile("s_waitcnt vmcnt(" #n ")" ::: "memory")
#define PG8_WAIT_L(n) asm volatile("s_waitcnt lgkmcnt(" #n ")" ::: "memory")
#define PG8_BAR __builtin_amdgcn_s_barrier()
#define PG8_SCHED __builtin_amdgcn_sched_barrier(0)
    Unit cur, nxt; int ui = 0;
    if (!S.next(0, cur)) return;
    f32x4 acc[2][2][4][2];
#pragma unroll
    for (int a = 0; a < 2; ++a)
#pragma unroll
        for (int b = 0; b < 2; ++b)
#pragma unroll
            for (int m = 0; m < 4; ++m)
#pragma unroll
                for (int n = 0; n < 2; ++n) acc[a][b][m][n] = (f32x4){0.f, 0.f, 0.f, 0.f};
    bf16x8 At[4][2], B0[2][2], B1[2][2];
    const char* cA = (const char*)g.A + (size_t)cur.pm * tstep; const char* cB = (const char*)g.Bt + (size_t)cur.pn * tstep;
    S.a_ready(cur);
    if constexpr (SP2) {
        PG8_STAGE(PG8_SB(0, 0), cB, voffB); PG8_STAGE(PG8_SB(0, 1), cB + hstep, voffB); PG8_STAGE(PG8_SA(0, 0), cA, voffA); PG8_STAGE(PG8_SA(0, 1), cA + hstep, voffA);
        if (wr == 1) PG8_BAR;
        PG8_WAIT_V(2); PG8_BAR;
        PG8_STAGE(PG8_SB(1, 0), cB + kstep, voffB); PG8_STAGE(PG8_SA(1, 0), cA + kstep, voffA); PG8_STAGE(PG8_SB(1, 1), cB + hstep + kstep, voffB);
        PG8_WAIT_V(6); PG8_BAR;
    } else {
        PG8_STAGE(PG8_SB(0, 0), cB, voffB); PG8_STAGE(PG8_SA(0, 0), cA, voffA); PG8_STAGE(PG8_SB(0, 1), cB + hstep, voffB); PG8_STAGE(PG8_SA(0, 1), cA + hstep, voffA);
        if (wr == 1) PG8_BAR;
        PG8_WAIT_V(4); PG8_BAR;
        PG8_STAGE(PG8_SB(1, 0), cB + kstep, voffB); PG8_STAGE(PG8_SA(1, 0), cA + kstep, voffA); PG8_STAGE(PG8_SB(1, 1), cB + hstep + kstep, voffB);
        PG8_WAIT_V(6); PG8_BAR;
    }
    for (;;) {
        const bool has_next = S.next(ui + 1, nxt);
        const char* nA = has_next ? (const char*)g.A + (size_t)nxt.pm * tstep : cA; const char* nB = has_next ? (const char*)g.Bt + (size_t)nxt.pn * tstep : cB;
        for (int t = 0; t < nt; t += 2) {
            const bool last = (t == nt - 2);
            const char* a1 = cA + (size_t)(t + 1) * kstep;
            const char* a2 = last ? nA : cA + (size_t)(t + 2) * kstep; const char* b2 = last ? nB : cB + (size_t)(t + 2) * kstep;
            const char* a3 = a2 + kstep; const char* b3 = b2 + kstep;
            if (last && has_next) S.a_ready(nxt);
            if constexpr (SP2) {
            PG8_LDB(B0, 0, 0); PG8_LDB(B1, 0, 1); PG8_SCHED; PG8_LDA(At, 0, 0); PG8_STAGE(PG8_SA(1, 1), a1 + hstep, voffA);
            PG8_WAIT_V(8); PG8_WAIT_L(0); PG8_BAR; PG8_MMA(0, 0, At, B0); PG8_MMA(0, 1, At, B1); PG8_BAR; PG8_SCHED;
            PG8_LDA(At, 0, 1); PG8_STAGE(PG8_SB(0, 0), b2, voffB); PG8_STAGE(PG8_SB(0, 1), b2 + hstep, voffB); PG8_STAGE(PG8_SA(0, 0), a2, voffA);
            PG8_WAIT_V(8); PG8_WAIT_L(0); PG8_BAR; PG8_MMA(1, 0, At, B0); PG8_MMA(1, 1, At, B1); PG8_BAR; PG8_SCHED;
            PG8_LDB(B0, 1, 0); PG8_LDB(B1, 1, 1); PG8_SCHED; PG8_LDA(At, 1, 0); PG8_STAGE(PG8_SA(0, 1), a2 + hstep, voffA);
            PG8_WAIT_V(8); PG8_WAIT_L(0); PG8_BAR; PG8_MMA(0, 0, At, B0); PG8_MMA(0, 1, At, B1); PG8_BAR; PG8_SCHED;
            PG8_LDA(At, 1, 1); PG8_STAGE(PG8_SB(1, 0), b3, voffB); PG8_STAGE(PG8_SB(1, 1), b3 + hstep, voffB); PG8_STAGE(PG8_SA(1, 0), a3, voffA);
            PG8_WAIT_V(8); PG8_WAIT_L(0); PG8_BAR; PG8_MMA(1, 0, At, B0); PG8_MMA(1, 1, At, B1); PG8_BAR; PG8_SCHED;
            } else {
            PG8_LDB(B0, 0, 0); PG8_SCHED; PG8_LDA(At, 0, 0); PG8_STAGE(PG8_SA(1, 1), a1 + hstep, voffA);
            PG8_WAIT_L(8); PG8_BAR; PG8_WAIT_L(0); PG8_MMA(0, 0, At, B0); PG8_BAR; PG8_SCHED;
            PG8_LDB(B1, 0, 1); PG8_STAGE(PG8_SB(0, 0), b2, voffB);
            PG8_BAR; PG8_WAIT_L(0); PG8_MMA(0, 1, At, B1); PG8_BAR;
            PG8_LDA(At, 0, 1); PG8_STAGE(PG8_SA(0, 0), a2, voffA);
            PG8_BAR; PG8_WAIT_L(0); PG8_MMA(1, 0, At, B0); PG8_BAR; PG8_SCHED;
            PG8_STAGE(PG8_SB(0, 1), b2 + hstep, voffB);
            PG8_WAIT_V(6); PG8_BAR; PG8_MMA(1, 1, At, B1); PG8_BAR;
            PG8_LDB(B0, 1, 0); PG8_SCHED; PG8_LDA(At, 1, 0); PG8_STAGE(PG8_SA(0, 1), a2 + hstep, voffA);
            PG8_WAIT_L(8); PG8_BAR; PG8_WAIT_L(0); PG8_MMA(0, 0, At, B0); PG8_BAR; PG8_SCHED;
            PG8_LDB(B1, 1, 1); PG8_STAGE(PG8_SB(1, 0), b3, voffB);
            PG8_BAR; PG8_WAIT_L(0); PG8_MMA(0, 1, At, B1); PG8_BAR;
            PG8_LDA(At, 1, 1); PG8_STAGE(PG8_SA(1, 0), a3, voffA);
            PG8_BAR; PG8_WAIT_L(0); PG8_MMA(1, 0, At, B0); PG8_BAR; PG8_SCHED;
            PG8_STAGE(PG8_SB(1, 1), b3 + hstep, voffB);
            PG8_WAIT_V(6); PG8_BAR; PG8_MMA(1, 1, At, B1); PG8_BAR;
            }
        }
        if constexpr (ALIGN_EPI) { if (wr == 0) PG8_BAR; }
        E(acc, cur, wr, wc, fr, fq); S.done(cur);
        if (!has_next) break;
#pragma unroll
        for (int a = 0; a < 2; ++a)
#pragma unroll
            for (int b = 0; b < 2; ++b)
#pragma unroll
                for (int m = 0; m < 4; ++m)
#pragma unroll
                    for (int n = 0; n < 2; ++n) acc[a][b][m][n] = (f32x4){0.f, 0.f, 0.f, 0.f};
        cur = nxt; cA = nA; cB = nB; ++ui;
        if constexpr (ALIGN_EPI) { if (wr == 1) PG8_BAR; }
    }
    PG8_WAIT_V(0);
    if constexpr (!ALIGN_EPI) { if (wr == 0) PG8_BAR; }
    PG8_BAR;
#undef PG8_SA
#undef PG8_SB
#undef PG8_STAGE
#undef PG8_LDA
#undef PG8_LDB
#undef PG8_MMA
#undef PG8_WAIT_V
#undef PG8_WAIT_L
#undef PG8_BAR
#undef PG8_SCHED
}
}

__device__ __forceinline__ unsigned f2bf(float f) { unsigned u = __builtin_bit_cast(unsigned, f); return (u + 0x7fffu + ((u >> 16) & 1u)) >> 16; }
__device__ __forceinline__ unsigned pk2(float lo, float hi) { return f2bf(lo) | (f2bf(hi) << 16); }
__device__ __forceinline__ float bflo(unsigned w) { return __builtin_bit_cast(float, w << 16); }
__device__ __forceinline__ float bfhi(unsigned w) { return __builtin_bit_cast(float, w & 0xffff0000u); }
__device__ __forceinline__ float fast_sigmoid(float t) { return __builtin_amdgcn_rcpf(1.0f + __builtin_amdgcn_exp2f(-1.44269504089f * t)); }
__device__ __forceinline__ float gelu_tanh(float x) { const float t = x * (1.5957691216f + 0.0713548163f * x * x); return x * fast_sigmoid(t); }
__device__ __forceinline__ float wave_sum(float v) {
#pragma unroll
    for (int o = 1; o < 64; o <<= 1) v += __shfl_xor(v, o);
    return v;
}
#define LDS_WAIT() asm volatile("s_waitcnt lgkmcnt(0)" ::: "memory")
#define VM_WAIT() asm volatile("s_waitcnt vmcnt(0)" ::: "memory")
#define RLX_AGENT __ATOMIC_RELAXED, __HIP_MEMORY_SCOPE_AGENT

constexpr size_t MiB = 1u << 20;
constexpr size_t WS_CTL = 0, CTL_ZERO_BYTES = 1 * MiB;
constexpr size_t WS_MOD   = 512 * 1024;
constexpr size_t WS_AT    = 1 * MiB + 128 * 1024;
constexpr size_t WS_STATS = WS_AT + 128 * 1024;
constexpr size_t WS_SCL   = 1 * MiB + 512 * 1024;
constexpr size_t WS_KEYS  = 2 * MiB;
constexpr size_t WS_GWS   = 3 * MiB;
constexpr size_t WS_WIN   = 4 * MiB;
constexpr size_t WS_GLU   = 28 * MiB;
constexpr size_t WS_WOUT  = 32 * MiB;
constexpr size_t WS_WQ    = 48 * MiB;
constexpr size_t WS_KTAB  = 64 * MiB;
constexpr size_t WS_WG    = 72 * MiB;
constexpr size_t WS_VG    = 104 * MiB;
constexpr size_t WS_UV    = 136 * MiB;
constexpr size_t WS_X     = 392 * MiB;
constexpr size_t WS_H     = 520 * MiB;
constexpr size_t WS_Z     = 584 * MiB;
constexpr size_t WS_XS    = 648 * MiB;
constexpr size_t WS_SLOC  = 680 * MiB;
constexpr size_t WS_HS    = 688 * MiB;
constexpr size_t WS_G     = 692 * MiB;
constexpr size_t WS_MIX   = 724 * MiB;
constexpr size_t WS_EID   = 788 * MiB;
constexpr size_t WS_GATE  = 796 * MiB;
constexpr size_t WS_SU    = 804 * MiB;
constexpr size_t WS_END   = 812 * MiB;
constexpr size_t WS_DBG   = 812 * MiB;
constexpr int CW_BAR = 4096;
constexpr int CW_FLAG = 2048;
constexpr int CW_QUEUE = 16384;

constexpr int LDS_BYTES = 163840;
constexpr int MISC_OFF = LDS_BYTES - 256;

#define XB_TMO      128
#define XB_XCNT(j)  (256  + 64 * (j))
#define XB_XSUB(j)  (1280 + 64 * (j))
#define XB_XGEN(j)  (2304 + 64 * (j))
#define XB_TOP      3328
#define XB_TOPGEN   3392
#define XCD_BAR_WORDS 3456
#define XB_SPIN_CAP (1u << 24)
__device__ __forceinline__ unsigned xb_ld(unsigned* p)              { return __hip_atomic_load(p, __ATOMIC_RELAXED, __HIP_MEMORY_SCOPE_AGENT); }
__device__ __forceinline__ unsigned xb_add(unsigned* p, unsigned v) { return __hip_atomic_fetch_add(p, v, __ATOMIC_RELAXED, __HIP_MEMORY_SCOPE_AGENT); }
__device__ __forceinline__ unsigned xb_xcc_id() { return (unsigned)__builtin_amdgcn_s_getreg((3 << 11) | 20) & 0xFu; }
#define XB_SPIN(cond, bar) do { unsigned _sp = 0; while (cond) { __builtin_amdgcn_s_sleep(1); \
    if ((++_sp & 255u) == 0u) { if (xb_ld(&(bar)[XB_TMO])) break; if (_sp > XB_SPIN_CAP) { atomicAdd(&(bar)[XB_TMO], 1u); break; } } } } while (0)
struct XcdBarrier { unsigned* bar; unsigned x; volatile LAS unsigned* st; };
__device__ __forceinline__ XcdBarrier xcd_barrier_post(unsigned* bar, volatile LAS unsigned* st) {
    XcdBarrier b; b.bar = bar; b.x = xb_xcc_id(); b.st = st;
    if (threadIdx.x == 0) (void)xb_add(&bar[XB_XCNT(b.x)], 1u);
    return b;
}
__device__ __forceinline__ void xcd_barrier_complete(unsigned* bar, unsigned x, unsigned& nloc, unsigned& nx) {
    const unsigned G = gridDim.x * gridDim.y * gridDim.z;
    unsigned sum, cnt, mine, sp = 0u;
    for (;;) {
        sum = 0u; cnt = 0u; mine = 0u;
#pragma unroll
        for (unsigned j = 0; j < 16; ++j) { const unsigned c = xb_ld(&bar[XB_XCNT(j)]); sum += c; cnt += (c > 0u) ? 1u : 0u; mine = (j == x) ? c : mine; }
        if (sum == G) break;
        __builtin_amdgcn_s_sleep(1);
        if ((++sp & 255u) == 0u) { if (xb_ld(&bar[XB_TMO])) break; if (sp > XB_SPIN_CAP) { atomicAdd(&bar[XB_TMO], 1u); break; } }
    }
    nloc = mine > 0u ? mine : 1u; nx = cnt > 0u ? cnt : 1u;
}
__device__ __forceinline__ void xcd_barrier(const XcdBarrier& b) {
    asm volatile("s_waitcnt vmcnt(0)" ::: "memory");
    __syncthreads();
    if (threadIdx.x == 0) {
        unsigned* bar = b.bar;
        __builtin_amdgcn_s_waitcnt(0);
        unsigned nloc = b.st[0], nx = b.st[1];
        if (nloc == 0u) { xcd_barrier_complete(bar, b.x, nloc, nx); b.st[0] = nloc; b.st[1] = nx; }
        const unsigned old = xb_add(&bar[XB_XSUB(b.x)], 1u);
        const unsigned gen = old / nloc;
        if (old + 1u == (gen + 1u) * nloc) {
            __builtin_amdgcn_fence(__ATOMIC_RELEASE, "agent");
            asm volatile("s_waitcnt vmcnt(0)" ::: "memory");
            const unsigned og = xb_add(&bar[XB_TOP], 1u);
            const unsigned tg = og / nx;
            if (og + 1u == (tg + 1u) * nx) xb_add(&bar[XB_TOPGEN], 1u);
            else XB_SPIN(xb_ld(&bar[XB_TOPGEN]) == tg, bar);
            __builtin_amdgcn_fence(__ATOMIC_ACQUIRE, "agent");
            xb_add(&bar[XB_XGEN(b.x)], 1u);
            asm volatile("s_waitcnt vmcnt(0)" ::: "memory");
        } else {
            XB_SPIN(xb_ld(&bar[XB_XGEN(b.x)]) == gen, bar);
            __builtin_amdgcn_fence(__ATOMIC_ACQUIRE, "agent");
            asm volatile("s_waitcnt vmcnt(0)" ::: "memory");
        }
    }
    __syncthreads();
}

struct Args { const float* in[29]; float* out; unsigned char* ws; int ph_lo, ph_hi, li, pad; };
enum { I_X = 0, I_C, I_WMOD, I_BMOD, I_N1G, I_WIN, I_BIN, I_LNG, I_LNB, I_GWS, I_GBS, I_LRE, I_LIM, I_LDT, I_BRE, I_BIM, I_CRE, I_CIM, I_SD, I_GLUW, I_GLUB,
       I_BRG, I_WOUT, I_N2G, I_WQ, I_KEYS, I_PU, I_PV, I_FG };

struct Frame {
    LAS unsigned char* lds;
    unsigned char* ws;
    const float* const* in;
    float* out;
    int tid, lane, wave, vcu, G;
};

#define PH_LOCALS int tid = F.tid; asm volatile("" : "+v"(tid)); const int lane = tid & 63; const int wave = __builtin_amdgcn_readfirstlane(tid >> 6); (void)lane; (void)wave;

struct EpiIn {
    static constexpr bool PERM = true, AFTER_DRAIN = false;
    bf16* Z; bf16* XS; const float* bias;
    __device__ __forceinline__ void operator()(const f32x4 (&acc)[2][2][4][2], const pg8::Unit& u, int wr, int wc, int fr, int fq) const {
        const int row0 = u.pm * 256 + wr * 64 + fr, col0 = u.pn * 256 + wc * 32 + 8 * fq;
        f32x4 bv[2][2];
#pragma unroll
        for (int bj = 0; bj < 2; ++bj)
#pragma unroll
            for (int n = 0; n < 2; ++n) bv[bj][n] = *(const f32x4*)(bias + col0 + bj * 128 + 4 * n);
        const bool isz = (u.pn < 8);
#pragma unroll
        for (int ai = 0; ai < 2; ++ai)
#pragma unroll
            for (int m = 0; m < 4; ++m) {
                const int r = row0 + ai * 128 + m * 16;
#pragma unroll
                for (int bj = 0; bj < 2; ++bj) {
                    f32x4 v0 = acc[ai][bj][m][0] + bv[bj][0], v1 = acc[ai][bj][m][1] + bv[bj][1];
                    const int c = col0 + bj * 128;
                    u32x4 w;
                    if (isz) {
                        w.x = pg8::cvt_pk_bf16(gelu_tanh(v0[0]), gelu_tanh(v0[1])); w.y = pg8::cvt_pk_bf16(gelu_tanh(v0[2]), gelu_tanh(v0[3]));
                        w.z = pg8::cvt_pk_bf16(gelu_tanh(v1[0]), gelu_tanh(v1[1])); w.w = pg8::cvt_pk_bf16(gelu_tanh(v1[2]), gelu_tanh(v1[3]));
                        *(u32x4*)(Z + (size_t)r * 2048 + c) = w;
                    } else {
                        w.x = pg8::cvt_pk_bf16(v0[0], v0[1]); w.y = pg8::cvt_pk_bf16(v0[2], v0[3]); w.z = pg8::cvt_pk_bf16(v1[0], v1[1]); w.w = pg8::cvt_pk_bf16(v1[2], v1[3]);
                        const int cc = c - 2048, g = cc >> 4, i = cc & 15;
                        *(u32x4*)(XS + ((size_t)(g * 256 + (r >> 6)) * 64 + (r & 63)) * 16 + i) = w;
                    }
                }
            }
    }
};
struct EpiGlu {
    static constexpr bool PERM = true, AFTER_DRAIN = false;
    const bf16* Gb; bf16* MIX; const float* bias;
    __device__ __forceinline__ void operator()(const f32x4 (&acc)[2][2][4][2], const pg8::Unit& u, int wr, int wc, int fr, int fq) const {
        const int row0 = u.pm * 256 + wr * 64 + fr, col0 = u.pn * 256 + wc * 32 + 8 * fq;
        f32x4 bv[2][2];
#pragma unroll
        for (int bj = 0; bj < 2; ++bj)
#pragma unroll
            for (int n = 0; n < 2; ++n) bv[bj][n] = *(const f32x4*)(bias + col0 + bj * 128 + 4 * n);
#pragma unroll
        for (int ai = 0; ai < 2; ++ai)
#pragma unroll
            for (int m = 0; m < 4; ++m) {
                const int r = row0 + ai * 128 + m * 16;
#pragma unroll
                for (int bj = 0; bj < 2; ++bj) {
                    const f32x4 v0 = acc[ai][bj][m][0] + bv[bj][0], v1 = acc[ai][bj][m][1] + bv[bj][1];
                    const int c = col0 + bj * 128;
                    const u32x4 gw = *(const u32x4*)(Gb + (size_t)r * 1024 + c);
                    u32x4 w;
                    w.x = pg8::cvt_pk_bf16(bflo(gw.x) * fast_sigmoid(v0[0]), bfhi(gw.x) * fast_sigmoid(v0[1]));
                    w.y = pg8::cvt_pk_bf16(bflo(gw.y) * fast_sigmoid(v0[2]), bfhi(gw.y) * fast_sigmoid(v0[3]));
                    w.z = pg8::cvt_pk_bf16(bflo(gw.z) * fast_sigmoid(v1[0]), bfhi(gw.z) * fast_sigmoid(v1[1]));
                    w.w = pg8::cvt_pk_bf16(bflo(gw.w) * fast_sigmoid(v1[2]), bfhi(gw.w) * fast_sigmoid(v1[3]));
                    *(u32x4*)(MIX + (size_t)r * 2048 + 1024 + c) = w;
                }
            }
    }
};
struct EpiOut {
    static constexpr bool PERM = true, AFTER_DRAIN = false;
    const float* xin; float* X; const float* gate;
    __device__ __forceinline__ void operator()(const f32x4 (&acc)[2][2][4][2], const pg8::Unit& u, int wr, int wc, int fr, int fq) const {
        const int row0 = u.pm * 256 + wr * 64 + fr, col0 = u.pn * 256 + wc * 32 + 8 * fq;
        f32x4 gv[2][2];
#pragma unroll
        for (int bj = 0; bj < 2; ++bj)
#pragma unroll
            for (int n = 0; n < 2; ++n) gv[bj][n] = *(const f32x4*)(gate + col0 + bj * 128 + 4 * n);
#pragma unroll
        for (int ai = 0; ai < 2; ++ai)
#pragma unroll
            for (int m = 0; m < 4; ++m) {
                const int r = row0 + ai * 128 + m * 16;
#pragma unroll
                for (int bj = 0; bj < 2; ++bj) {
                    const size_t off = (size_t)r * 2048 + col0 + bj * 128;
                    const f32x4 x0 = *(const f32x4*)(xin + off), x1 = *(const f32x4*)(xin + off + 4);
                    *(f32x4*)(X + off) = x0 + gv[bj][0] * acc[ai][bj][m][0];
                    *(f32x4*)(X + off + 4) = x1 + gv[bj][1] * acc[ai][bj][m][1];
                }
            }
    }
};
struct EpiQ {
    static constexpr bool PERM = true, AFTER_DRAIN = false;
    bf16* Q;
    __device__ __forceinline__ void operator()(const f32x4 (&acc)[2][2][4][2], const pg8::Unit& u, int wr, int wc, int fr, int fq) const {
        const int row0 = u.pm * 256 + wr * 64 + fr, col0 = u.pn * 256 + wc * 32 + 8 * fq;
#pragma unroll
        for (int ai = 0; ai < 2; ++ai)
#pragma unroll
            for (int m = 0; m < 4; ++m) {
                const int r = row0 + ai * 128 + m * 16;
#pragma unroll
                for (int bj = 0; bj < 2; ++bj) {
                    const f32x4 v0 = acc[ai][bj][m][0], v1 = acc[ai][bj][m][1];
                    u32x4 w; w.x = pg8::cvt_pk_bf16(v0[0], v0[1]); w.y = pg8::cvt_pk_bf16(v0[2], v0[3]); w.z = pg8::cvt_pk_bf16(v1[0], v1[1]); w.w = pg8::cvt_pk_bf16(v1[2], v1[3]);
                    *(u32x4*)(Q + (size_t)r * 2048 + col0 + bj * 128) = w;
                }
            }
    }
};

__device__ __forceinline__ void p0_transpose_item(const float* W, int K, int N, bf16* WT, const float* kscale, LAS float* scr, int item, int lane) {
    const int nblk = N / 32, kb = item / nblk, nb = item % nblk, k0 = 64 * kb, n0 = 32 * nb;
#pragma unroll 8
    for (int i = 0; i < 32; ++i) { const int kk = 2 * i + (lane >> 5); float v = W[(size_t)(k0 + kk) * N + n0 + (lane & 31)]; if (kscale) v *= kscale[k0 + kk]; scr[kk * 33 + (lane & 31)] = v; }
    LDS_WAIT(); asm volatile("" ::: "memory");
    const int c = lane & 7;
#pragma unroll
    for (int j = 0; j < 4; ++j) { const int n = (lane >> 3) + 8 * j; const LAS float* s = scr + (8 * c) * 33 + n;
        u32x4 o; o.x = pk2(s[0 * 33], s[1 * 33]); o.y = pk2(s[2 * 33], s[3 * 33]); o.z = pk2(s[4 * 33], s[5 * 33]); o.w = pk2(s[6 * 33], s[7 * 33]);
        *(u32x4*)(WT + (size_t)(n0 + n) * K + k0 + 8 * c) = o; }
    LDS_WAIT(); asm volatile("" ::: "memory");
}

__device__ __forceinline__ void norm_mod_row(const f32x4 (&v)[4][2], const float* gain, const float* scale, const float* shift, int lane, u32x4 (&o)[4]) {
    float s = 0.f;
#pragma unroll
    for (int j = 0; j < 4; ++j)
#pragma unroll
        for (int h = 0; h < 2; ++h) s += (v[j][h][0] * v[j][h][0] + v[j][h][1] * v[j][h][1]) + (v[j][h][2] * v[j][h][2] + v[j][h][3] * v[j][h][3]);
    const float rr = 1.0f / sqrtf(wave_sum(s) * (1.0f / DM) + EPS);
#pragma unroll
    for (int j = 0; j < 4; ++j) {
        const int c = j * 512 + lane * 8;
        f32x4 y[2];
#pragma unroll
        for (int h = 0; h < 2; ++h) {
            const f32x4 g = *(const f32x4*)(gain + c + 4 * h);
            y[h] = v[j][h] * rr * g;
            const f32x4 sc = *(const f32x4*)(scale + c + 4 * h), sh = *(const f32x4*)(shift + c + 4 * h); y[h] = y[h] * (sc + 1.0f) + sh;
        }
        o[j].x = pk2(y[0][0], y[0][1]); o[j].y = pk2(y[0][2], y[0][3]); o[j].z = pk2(y[1][0], y[1][1]); o[j].w = pk2(y[1][2], y[1][3]);
    }
}
__device__ __forceinline__ void norm_row_pass(const float* xrow, bf16* hrow, const float* gain, const float* scale, const float* shift, int lane) {
    f32x4 v[4][2];
#pragma unroll
    for (int j = 0; j < 4; ++j) { v[j][0] = *(const f32x4*)(xrow + j * 512 + lane * 8); v[j][1] = *(const f32x4*)(xrow + j * 512 + lane * 8 + 4); }
    u32x4 o[4]; norm_mod_row(v, gain, scale, shift, lane, o);
#pragma unroll
    for (int j = 0; j < 4; ++j) *(u32x4*)(hrow + j * 512 + lane * 8) = o[j];
}

__device__ __forceinline__ void p0_gemv_unit(Frame& F, int unit, int tid, float* modout) {
    const int l = unit / 192, r = unit % 192, cb = r >> 1, kh = r & 1;
    LAS float* sc = (LAS float*)F.lds;
    LAS float* red = (LAS float*)(F.lds + 4096);
    for (int k = tid; k < 1024; k += NTHR) { const float c = F.in[I_C][kh * 1024 + k]; sc[k] = c * fast_sigmoid(c); }
    __syncthreads();
    const int tx = tid & 31, ty = tid >> 5;
    const float* W = F.in[I_WMOD] + ((size_t)l * DM + kh * 1024) * 12288 + cb * 128 + tx * 4;
    f32x4 a = {0.f, 0.f, 0.f, 0.f};
#pragma unroll 16
    for (int k = ty; k < 1024; k += 16) { const f32x4 w = *(const f32x4*)(W + (size_t)k * 12288); a += w * sc[k]; }
    *(LAS f32x4*)(red + ty * 128 + tx * 4) = a;
    __syncthreads();
    if (tid < 128) { float s = 0.f;
#pragma unroll
        for (int y = 0; y < 16; ++y) s += red[y * 128 + tid];
        if (kh == 0) s += F.in[I_BMOD][l * 12288 + cb * 128 + tid];
        atomicAdd(modout + l * 12288 + cb * 128 + tid, s); }
    __syncthreads();
}
__device__ __forceinline__ void p0_s5_unit(Frame& F, int unit, int tid, int parts = 15) {
    const int l = unit >> 7, g = (unit >> 1) & 63, hf = unit & 1;
    LAS float* apr = (LAS float*)F.lds;
    LAS float* api = apr + 4228;
    LAS float* bbr = api + 4228;
    LAS float* bbi = bbr + 1024;
    LAS float* ccr = bbi + 1024;
    LAS float* cci = ccr + 16 * 65;
    const float dt = expf(F.in[I_LDT][l * 64 + g]);
    const float* lre = F.in[I_LRE] + (l * 64 + g) * 64; const float* lim = F.in[I_LIM] + (l * 64 + g) * 64;
    for (int idx = tid; idx < 65 * 64; idx += NTHR) { const int d = idx >> 6, p = idx & 63;
        const float mag = expf(lre[p] * dt * (float)d); float sn, cs; sincosf(lim[p] * dt * (float)d, &sn, &cs);
        apr[d * 65 + p] = mag * cs; api[d * 65 + p] = mag * sn; }
    for (int idx = tid; idx < 1024; idx += NTHR) { const int o = idx >> 6, p = idx & 63;
        ccr[o * 65 + p] = F.in[I_CRE][((size_t)(l * 64 + g) * 16 + o) * 64 + p]; cci[o * 65 + p] = F.in[I_CIM][((size_t)(l * 64 + g) * 16 + o) * 64 + p]; }
    __syncthreads();
    for (int idx = tid; idx < 1024; idx += NTHR) { const int p = idx >> 4, i = idx & 15;
        const float xr = apr[65 + p] - 1.0f, xi = api[65 + p], lr = lre[p], li = lim[p], den = 1.0f / (lr * lr + li * li);
        const float cr = (xr * lr + xi * li) * den, ci = (xi * lr - xr * li) * den;
        const float br = F.in[I_BRE][((size_t)(l * 64 + g) * 64 + p) * 16 + i], bi = F.in[I_BIM][((size_t)(l * 64 + g) * 64 + p) * 16 + i];
        bbr[idx] = cr * br - ci * bi; bbi[idx] = cr * bi + ci * br; }
    __syncthreads();
    bf16* KT = (bf16*)(F.ws + WS_KTAB) + (size_t)(l * 64 + g) * 80 * 256;
    if (parts & 1) {
        const int d = hf * 32 + (tid >> 4), o = tid & 15;
        const float dskip = F.in[I_SD][l * 1024 + g * 16 + o];
        float s[16];
#pragma unroll
        for (int i = 0; i < 16; ++i) s[i] = 0.f;
        for (int p = 0; p < 64; ++p) { const float ar = apr[d * 65 + p], ai = api[d * 65 + p], cr = ccr[o * 65 + p], ci = cci[o * 65 + p];
            const float er = cr * ar - ci * ai, ei = cr * ai + ci * ar;
#pragma unroll
            for (int q = 0; q < 4; ++q) { const f32x4 br = *(const LAS f32x4*)(bbr + p * 16 + 4 * q), bi = *(const LAS f32x4*)(bbi + p * 16 + 4 * q);
#pragma unroll
                for (int e = 0; e < 4; ++e) s[4 * q + e] += er * br[e] - ei * bi[e]; } }
#if !SELFTEST_S5
        {   const float dsk = (d == 0) ? dskip : 0.f;
#pragma unroll
            for (int i = 0; i < 16; ++i) s[i] += (i == o) ? dsk : 0.f; }
#endif
        u32x4 w0, w1;
        w0.x = pk2(s[0], s[1]); w0.y = pk2(s[2], s[3]); w0.z = pk2(s[4], s[5]); w0.w = pk2(s[6], s[7]);
        w1.x = pk2(s[8], s[9]); w1.y = pk2(s[10], s[11]); w1.z = pk2(s[12], s[13]); w1.w = pk2(s[14], s[15]);
        if ((parts & 8) || w0.x == 0x12345678u) { *(u32x4*)(KT + (size_t)(d + 16) * 256 + o * 16) = w0; *(u32x4*)(KT + (size_t)(d + 16) * 256 + o * 16 + 8) = w1; }
        if ((parts & 8) && hf == 0 && tid < 256) { const u32x4 z = {0u, 0u, 0u, 0u}; *(u32x4*)(KT + tid * 16) = z; *(u32x4*)(KT + tid * 16 + 8) = z; }
    }
    bf16* WG = (bf16*)(F.ws + WS_WG) + (size_t)(l * 64 + g) * 128 * 1024;
    if (parts & 2) for (int it = tid; it < 32 * 64; it += NTHR) { const int p = hf * 32 + (it >> 6), tau = it & 63;
        const float ar = apr[(63 - tau) * 65 + p], ai = api[(63 - tau) * 65 + p];
        unsigned wr_[8], wi_[8];
#pragma unroll
        for (int q = 0; q < 4; ++q) { const f32x4 br = *(const LAS f32x4*)(bbr + p * 16 + 4 * q), bi = *(const LAS f32x4*)(bbi + p * 16 + 4 * q);
            wr_[2 * q] = pk2(ar * br[0] - ai * bi[0], ar * br[1] - ai * bi[1]); wr_[2 * q + 1] = pk2(ar * br[2] - ai * bi[2], ar * br[3] - ai * bi[3]);
            wi_[2 * q] = pk2(ar * bi[0] + ai * br[0], ar * bi[1] + ai * br[1]); wi_[2 * q + 1] = pk2(ar * bi[2] + ai * br[2], ar * bi[3] + ai * br[3]); }
        *(u32x4*)(WG + (size_t)p * 1024 + tau * 16) = (u32x4){wr_[0], wr_[1], wr_[2], wr_[3]}; *(u32x4*)(WG + (size_t)p * 1024 + tau * 16 + 8) = (u32x4){wr_[4], wr_[5], wr_[6], wr_[7]};
        *(u32x4*)(WG + (size_t)(64 + p) * 1024 + tau * 16) = (u32x4){wi_[0], wi_[1], wi_[2], wi_[3]}; *(u32x4*)(WG + (size_t)(64 + p) * 1024 + tau * 16 + 8) = (u32x4){wi_[4], wi_[5], wi_[6], wi_[7]}; }
    bf16* VG = (bf16*)(F.ws + WS_VG) + (size_t)(l * 64 + g) * 1024 * 128;
    if (parts & 4) for (int it = tid; it < 512 * 8; it += NTHR) { const int m = hf * 512 + (it >> 3), p0 = (it & 7) * 8, t = m >> 4, o = m & 15;
        float vr_[8], vi_[8];
#pragma unroll
        for (int e = 0; e < 8; ++e) { const float ar = apr[(t + 1) * 65 + p0 + e], ai = api[(t + 1) * 65 + p0 + e], cr = ccr[o * 65 + p0 + e], ci = cci[o * 65 + p0 + e];
            vr_[e] = cr * ar - ci * ai; vi_[e] = -(cr * ai + ci * ar); }
        *(u32x4*)(VG + (size_t)m * 128 + p0) = (u32x4){pk2(vr_[0], vr_[1]), pk2(vr_[2], vr_[3]), pk2(vr_[4], vr_[5]), pk2(vr_[6], vr_[7])};
        *(u32x4*)(VG + (size_t)m * 128 + 64 + p0) = (u32x4){pk2(vi_[0], vi_[1]), pk2(vi_[2], vi_[3]), pk2(vi_[4], vi_[5]), pk2(vi_[6], vi_[7])}; }
    if (hf == 0 && tid < 64) { float* AT = (float*)(F.ws + WS_AT) + ((size_t)(l * 64 + g) * 64 + tid) * 2; AT[0] = apr[64 * 65 + tid]; AT[1] = api[64 * 65 + tid]; }
    __syncthreads();
}
__device__ __forceinline__ void p0_fp4_chunk(Frame& F, int chunk, int wave, int lane) {
    unsigned char* UV = F.ws + WS_UV; float* SCL = (float*)(F.ws + WS_SCL);
    for (int i = 0; i < 8; ++i) {
        const int r = chunk * 64 + wave * 8 + i;
        const int tbl = r >> 15, rr = r & 32767;
        const float* srcp = (tbl ? F.in[I_PV] : F.in[I_PU]) + (size_t)rr * 2048 + lane * 4;
        f32x4 v[8]; float am = 0.f;
#pragma unroll
        for (int j = 0; j < 8; ++j) { v[j] = *(const f32x4*)(srcp + j * 256); am = fmaxf(am, fmaxf(fmaxf(fabsf(v[j][0]), fabsf(v[j][1])), fmaxf(fabsf(v[j][2]), fabsf(v[j][3])))); }
#pragma unroll
        for (int o = 1; o < 64; o <<= 1) am = fmaxf(am, __shfl_xor(am, o));
        const float scale = am > 0.f ? am * (1.0f / 6.0f) : 1.0f, inv = am > 0.f ? 6.0f / am : 1.0f;
        u32x4 o;
#pragma unroll
        for (int d = 0; d < 4; ++d) { unsigned w = 0u;
            w = __builtin_amdgcn_cvt_scalef32_pk_fp4_f32(w, v[2 * d][0] * inv, v[2 * d][1] * inv, 1.0f, 0);
            w = __builtin_amdgcn_cvt_scalef32_pk_fp4_f32(w, v[2 * d][2] * inv, v[2 * d][3] * inv, 1.0f, 1);
            w = __builtin_amdgcn_cvt_scalef32_pk_fp4_f32(w, v[2 * d + 1][0] * inv, v[2 * d + 1][1] * inv, 1.0f, 2);
            w = __builtin_amdgcn_cvt_scalef32_pk_fp4_f32(w, v[2 * d + 1][2] * inv, v[2 * d + 1][3] * inv, 1.0f, 3);
            o[d] = w; }
        *(u32x4*)(UV + (size_t)rr * 2048 + tbl * 1024 + lane * 16) = o;
        if (lane == 0) SCL[rr * 2 + tbl] = scale;
    }
}
#ifndef P0_PARTS
#define P0_PARTS 15
#endif
#ifndef P0_PROBE_MODE
#define P0_PROBE_MODE 0
#endif
__device__ __forceinline__ void p0_tables(Frame& F, int qi = 4, bool dummy = false) {
    PH_LOCALS
    unsigned* head = (unsigned*)(F.ws + WS_CTL) + CW_QUEUE + 64 * qi;
    float* modout = dummy ? (float*)(F.ws + WS_DBG) : (float*)(F.ws + WS_MOD);
    LAS unsigned* slot = (LAS unsigned*)(F.lds + MISC_OFF) + 16;
    for (;;) {
        __syncthreads();
        if (tid == 0) slot[0] = __hip_atomic_fetch_add(head, 1u, RLX_AGENT);
        __syncthreads();
        const unsigned u = slot[0];
        if (u >= 1664u) break;
        const int rnd = (int)u / 13, k = (int)u % 13;
        if (k < 2) { if (dummy && P0_PROBE_MODE == 2) continue; p0_s5_unit(F, rnd * 2 + k, tid, dummy ? P0_PARTS : 15); }
        else if (k < 5) { if (dummy && P0_PROBE_MODE == 1) continue; p0_gemv_unit(F, rnd * 3 + (k - 2), tid, modout); }
        else { p0_fp4_chunk(F, rnd * 8 + (k - 5), wave, lane); }
    }
}
__device__ __forceinline__ void p0_prologue(Frame& F) {
    PH_LOCALS
    const int gw = F.vcu * NWAVES + wave, NGW = F.G * NWAVES;
    const int gt = F.vcu * NTHR + tid, NGT = F.G * NTHR;
    {
        LAS float* scr = (LAS float*)(F.lds + wave * 16384);
        constexpr int I_IN = (DM / 64) * (INW / 32), I_GL = (WB / 64) * (WB / 32), I_OU = (DM / 64) * (DM / 32), I_Q = I_OU;
        constexpr int PER_L = I_IN + I_GL + I_OU + I_Q;
        for (int it = gw; it < 2 * PER_L; it += NGW) {
            const int l = it / PER_L; int r = it % PER_L;
            if (r < I_IN) { p0_transpose_item(F.in[I_WIN] + (size_t)l * DM * INW, DM, INW, (bf16*)(F.ws + WS_WIN) + (size_t)l * INW * DM, nullptr, scr, r, lane); continue; } r -= I_IN;
            if (r < I_GL) { p0_transpose_item(F.in[I_GLUW] + (size_t)l * WB * WB, WB, WB, (bf16*)(F.ws + WS_GLU) + (size_t)l * WB * WB, nullptr, scr, r, lane); continue; } r -= I_GL;
            if (r < I_OU) { p0_transpose_item(F.in[I_WOUT] + (size_t)l * DM * DM, DM, DM, (bf16*)(F.ws + WS_WOUT) + (size_t)l * DM * DM, F.in[I_BRG] + l * DM, scr, r, lane); continue; } r -= I_OU;
            p0_transpose_item(F.in[I_WQ] + (size_t)l * DM * DM, DM, DM, (bf16*)(F.ws + WS_WQ) + (size_t)l * DM * DM, nullptr, scr, r, lane);
        }
    }
    {
        bf16* KB = (bf16*)(F.ws + WS_KEYS);
        for (int i = gt; i < 2 * 8 * 2 * 128 * 128 / 8; i += NGT) { const f32x4 a = *(const f32x4*)(F.in[I_KEYS] + (size_t)i * 8), b = *(const f32x4*)(F.in[I_KEYS] + (size_t)i * 8 + 4);
            u32x4 o; o.x = pk2(a[0], a[1]); o.y = pk2(a[2], a[3]); o.z = pk2(b[0], b[1]); o.w = pk2(b[2], b[3]); *(u32x4*)(KB + (size_t)i * 8) = o; }
        bf16* GW = (bf16*)(F.ws + WS_GWS);
        for (int i = gt; i < 2 * 8 * 128 * 128 / 8; i += NGT) { const int e = i * 8, jj = e & 127, ii = (e >> 7) & 127; const bool keep = (ii >= 64) || (jj < 64);
            f32x4 a = *(const f32x4*)(F.in[I_GWS] + (size_t)i * 8), b = *(const f32x4*)(F.in[I_GWS] + (size_t)i * 8 + 4);
            if (!keep) { a = (f32x4){0.f, 0.f, 0.f, 0.f}; b = a; }
            u32x4 o; o.x = pk2(a[0], a[1]); o.y = pk2(a[2], a[3]); o.z = pk2(b[0], b[1]); o.w = pk2(b[2], b[3]); *(u32x4*)(GW + (size_t)i * 8) = o; }
    }
}

__device__ __forceinline__ void phase_norm(Frame& F, const float* xsrc, const float* gain, const float* scale, const float* shift) {
    PH_LOCALS
    const int gw = F.vcu * NWAVES + wave, NGW = F.G * NWAVES;
    bf16* H = (bf16*)(F.ws + WS_H);
    for (int m = gw; m < M; m += NGW) norm_row_pass(xsrc + (size_t)m * DM, H + (size_t)m * DM, gain, scale, shift, lane);
}
__device__ __forceinline__ void phase_lnstats(Frame& F) {
    PH_LOCALS
    const int gw = F.vcu * NWAVES + wave, NGW = F.G * NWAVES;
    const bf16* Z = (const bf16*)(F.ws + WS_Z); float* ST = (float*)(F.ws + WS_STATS);
    for (int m = gw; m < M; m += NGW) {
        float v[16];
#pragma unroll
        for (int j = 0; j < 2; ++j) { const u32x4 w = *(const u32x4*)(Z + (size_t)m * 2048 + 1024 + j * 512 + lane * 8);
            v[j * 8 + 0] = bflo(w.x); v[j * 8 + 1] = bfhi(w.x); v[j * 8 + 2] = bflo(w.y); v[j * 8 + 3] = bfhi(w.y); v[j * 8 + 4] = bflo(w.z); v[j * 8 + 5] = bfhi(w.z); v[j * 8 + 6] = bflo(w.w); v[j * 8 + 7] = bfhi(w.w); }
        float s = 0.f;
#pragma unroll
        for (int i = 0; i < 16; ++i) s += v[i];
        const float mean = wave_sum(s) * (1.0f / 1024.0f); float q = 0.f;
#pragma unroll
        for (int i = 0; i < 16; ++i) { const float d = v[i] - mean; q += d * d; }
        const float rstd = 1.0f / sqrtf(wave_sum(q) * (1.0f / 1024.0f) + EPS);
        if (lane == 0) { ST[2 * m] = mean; ST[2 * m + 1] = rstd; }
    }
}
__device__ __forceinline__ void phase_branchnorm(Frame& F) {
    PH_LOCALS
    const int gw = F.vcu * NWAVES + wave, NGW = F.G * NWAVES;
    bf16* MIX = (bf16*)(F.ws + WS_MIX);
    for (int m = gw; m < M; m += NGW) {
        u32x4 w[4]; float sa = 0.f, sb = 0.f;
#pragma unroll
        for (int j = 0; j < 4; ++j) { w[j] = *(const u32x4*)(MIX + (size_t)m * 2048 + j * 512 + lane * 8);
            float q = 0.f;
#pragma unroll
            for (int e = 0; e < 4; ++e) { const float a = bflo(w[j][e]), b = bfhi(w[j][e]); q += a * a + b * b; }
            if (j < 2) sa += q; else sb += q; }
        const float ra = 1.0f / sqrtf(wave_sum(sa) * (1.0f / 1024.0f) + EPS), rb = 1.0f / sqrtf(wave_sum(sb) * (1.0f / 1024.0f) + EPS);
#pragma unroll
        for (int j = 0; j < 4; ++j) { const float r = j < 2 ? ra : rb; u32x4 o;
#pragma unroll
            for (int e = 0; e < 4; ++e) o[e] = pk2(bflo(w[j][e]) * r, bfhi(w[j][e]) * r);
            *(u32x4*)(MIX + (size_t)m * 2048 + j * 512 + lane * 8) = o; }
    }
}

__device__ __forceinline__ void phase_sloc(Frame& F, int l) {
    PH_LOCALS
    const bf16* XS = (const bf16*)(F.ws + WS_XS); const bf16* WG = (const bf16*)(F.ws + WS_WG) + (size_t)l * 64 * 128 * 1024; float* SL = (float*)(F.ws + WS_SLOC);
    const int fr = lane & 15, fq = lane >> 4;
    for (int u = F.vcu; u < 256; u += F.G) {
        const int g = u >> 2, n0 = (u & 3) * 64 + (wave & 3) * 16, jh = wave >> 2;
        f32x4 acc[4];
#pragma unroll
        for (int t = 0; t < 4; ++t) acc[t] = (f32x4){0.f, 0.f, 0.f, 0.f};
        const bf16* xp = XS + ((size_t)(g * 256 + n0 + fr)) * 1024 + 8 * fq;
        const bf16* wp = WG + ((size_t)(g * 128 + jh * 64 + fr)) * 1024 + 8 * fq;
#pragma unroll 8
        for (int kb = 0; kb < 32; ++kb) {
            const bf16x8 xf = *(const bf16x8*)(xp + kb * 32);
#pragma unroll
            for (int t = 0; t < 4; ++t) { const bf16x8 wf = *(const bf16x8*)(wp + (size_t)t * 16 * 1024 + kb * 32); acc[t] = __builtin_amdgcn_mfma_f32_16x16x32_bf16(wf, xf, acc[t], 0, 0, 0); }
        }
#pragma unroll
        for (int t = 0; t < 4; ++t) *(f32x4*)(SL + ((size_t)(g * 256 + n0 + fr)) * 128 + jh * 64 + t * 16 + 4 * fq) = acc[t];
    }
}
__device__ __forceinline__ void s5_carry(Frame& F, int l) {
    PH_LOCALS
    if (F.vcu < 64 && wave == 0) {
        const int g = F.vcu, p = lane;
        const float* AT = (const float*)(F.ws + WS_AT) + ((size_t)(l * 64 + g) * 64 + p) * 2; const float ar = AT[0], ai = AT[1];
        const float* SL = (const float*)(F.ws + WS_SLOC) + (size_t)g * 256 * 128; bf16* HS = (bf16*)(F.ws + WS_HS) + (size_t)g * 256 * 128;
        float hr = 0.f, hi = 0.f;
        for (int n0 = 0; n0 < 256; n0 += 8) {
            float sr[8], si[8];
#pragma unroll
            for (int e = 0; e < 8; ++e) { sr[e] = SL[(size_t)(n0 + e) * 128 + p]; si[e] = SL[(size_t)(n0 + e) * 128 + 64 + p]; }
#pragma unroll
            for (int e = 0; e < 8; ++e) { HS[(size_t)(n0 + e) * 128 + p] = (bf16)f2bf(hr); HS[(size_t)(n0 + e) * 128 + 64 + p] = (bf16)f2bf(hi);
                const float nr = ar * hr - ai * hi + sr[e], ni = ar * hi + ai * hr + si[e]; hr = nr; hi = ni; }
        }
    }
}

__device__ __forceinline__ void gating_unit(Frame& F, int l, int unit) {
    PH_LOCALS
    const int nb = unit >> 3, hh = unit & 7, t0 = nb * 128, c0 = hh * 128;
    const bf16* Z = (const bf16*)(F.ws + WS_Z); const float* ST = (const float*)(F.ws + WS_STATS);
    const bf16* GW = (const bf16*)(F.ws + WS_GWS) + (size_t)(l * 8 + hh) * 128 * 128;
    bf16* MIX = (bf16*)(F.ws + WS_MIX);
    LAS bf16* VT = (LAS bf16*)F.lds;
    constexpr int VS = 136;
    {
        const int j = tid >> 2, cs = (tid & 3) * 32;
        const float mu = ST[2 * (t0 + j)], rs = ST[2 * (t0 + j) + 1];
        const float* lg = F.in[I_LNG] + l * 1024 + c0 + cs; const float* lb = F.in[I_LNB] + l * 1024 + c0 + cs;
#pragma unroll
        for (int q = 0; q < 4; ++q) {
            const u32x4 w = *(const u32x4*)(Z + (size_t)(t0 + j) * 2048 + 1024 + c0 + cs + q * 8);
#pragma unroll
            for (int e = 0; e < 4; ++e) { const int c = cs + q * 8 + 2 * e;
                const float a = (bflo(w[e]) - mu) * rs * lg[q * 8 + 2 * e] + lb[q * 8 + 2 * e], b = (bfhi(w[e]) - mu) * rs * lg[q * 8 + 2 * e + 1] + lb[q * 8 + 2 * e + 1];
                VT[c * VS + j] = (bf16)f2bf(a); VT[(c + 1) * VS + j] = (bf16)f2bf(b); }
        }
    }
    __syncthreads();
    {
        const int fr = lane & 15, fq = lane >> 4, w = wave;
        f32x4 acc[8];
#pragma unroll
        for (int ct = 0; ct < 8; ++ct) acc[ct] = (f32x4){0.f, 0.f, 0.f, 0.f};
        const int nkb = (w < 4) ? 2 : 4;
        for (int kb = 0; kb < nkb; ++kb) {
            const bf16x8 wf = *(const bf16x8*)(GW + (size_t)(16 * w + fr) * 128 + kb * 32 + 8 * fq);
#pragma unroll
            for (int ct = 0; ct < 8; ++ct) { const bf16x8 vf = *(const LAS bf16x8*)(VT + (ct * 16 + fr) * VS + kb * 32 + 8 * fq); acc[ct] = __builtin_amdgcn_mfma_f32_16x16x32_bf16(vf, wf, acc[ct], 0, 0, 0); }
        }
        const int tok = t0 + 16 * w + fr; const float bs = F.in[I_GBS][(l * 8 + hh) * 128 + 16 * w + fr];
#pragma unroll
        for (int ct = 0; ct < 8; ++ct) { const int c = c0 + ct * 16 + 4 * fq;
            const u32x2 uw = *(const u32x2*)(Z + (size_t)tok * 2048 + c);
            u32x2 o; o.x = pk2(bflo(uw.x) * (acc[ct][0] + bs), bfhi(uw.x) * (acc[ct][1] + bs)); o.y = pk2(bflo(uw.y) * (acc[ct][2] + bs), bfhi(uw.y) * (acc[ct][3] + bs));
            *(u32x2*)(MIX + (size_t)tok * 2048 + c) = o; }
    }
    __syncthreads();
}
__device__ __forceinline__ void phase_carry_gating(Frame& F, int l, int qi) {
    PH_LOCALS
    s5_carry(F, l);
    unsigned* head = (unsigned*)(F.ws + WS_CTL) + CW_QUEUE + 64 * qi;
    LAS unsigned* slot = (LAS unsigned*)(F.lds + MISC_OFF) + 16;
    for (;;) {
        __syncthreads();
        if (tid == 0) slot[0] = __hip_atomic_fetch_add(head, 1u, RLX_AGENT);
        __syncthreads();
        const unsigned u = slot[0];
        if (u >= 1024u) break;
        gating_unit(F, l, (int)u);
    }
}

__device__ __forceinline__ void phase_s5out(Frame& F, int l) {
    PH_LOCALS
    const bf16* XS = (const bf16*)(F.ws + WS_XS); const bf16* HS = (const bf16*)(F.ws + WS_HS);
    bf16* Gb = (bf16*)(F.ws + WS_G);
    LAS unsigned char* KT = F.lds + 32768;
    LAS unsigned char* VT = F.lds + 73728;
    const int fr = lane & 15, fq = lane >> 4;
    for (int u = F.vcu; u < 512; u += F.G) {
        const int g = u >> 3, rc = (u >> 1) & 3, nh = u & 1;
        const bf16* VG = (const bf16*)(F.ws + WS_VG) + (size_t)(l * 64 + g) * 1024 * 128;
        const int n = nh * 128 + 16 * wave + fr;
        const bf16* xp0 = XS + ((size_t)(g * 256 + n)) * 1024 + 8 * fq;
        const bf16* hp0 = HS + ((size_t)(g * 256 + n)) * 128 + 8 * fq;
        bf16x8 xa[4], xb[4];
#pragma unroll
        for (int i = 0; i < 4; ++i) xa[i] = *(const bf16x8*)(xp0 + i * 32);
        __syncthreads();
        { const u32x4* src = (const u32x4*)((const bf16*)(F.ws + WS_KTAB) + (size_t)(l * 64 + g) * 80 * 256);
          for (int i = tid; i < 80 * 256 / 8; i += NTHR) ((LAS u32x4*)KT)[i] = src[i];
#pragma unroll
          for (int ps = 0; ps < 8; ++ps) { const int row = ps * 32 + (tid >> 4), c = tid & 15, q = row >> 4, o = row & 15;
              *(LAS u32x4*)(VT + row * 272 + c * 16) = *(const u32x4*)(VG + (size_t)((rc + 4 * q) * 16 + o) * 128 + c * 8); } }
        __syncthreads();
        f32x4 acc[16];
#pragma unroll
        for (int q = 0; q < 16; ++q) acc[q] = (f32x4){0.f, 0.f, 0.f, 0.f};
        const int kb0 = ((rc - (fq >> 1) + 10) * 16 + fr) * 32 + 16 * (fq & 1);
#define S5_GROUP(XF, grp_) do { const LAS unsigned char* kp = KT + kb0 - (grp_) * 4096; \
            _Pragma("unroll") for (int q = 0; q < 16; ++q) { if (rc + 4 * q >= 8 * (grp_)) { \
                _Pragma("unroll") for (int i = 0; i < 4; ++i) { const bf16x8 kf = *(const LAS bf16x8*)(kp + (4 * q - 2 * i + 6) * 512); \
                    acc[q] = __builtin_amdgcn_mfma_f32_16x16x32_bf16(kf, XF[i], acc[q], 0, 0, 0); } } } } while (0)
#pragma unroll 1
        for (int gp = 0; gp < 4; ++gp) {
#pragma unroll
            for (int i = 0; i < 4; ++i) xb[i] = *(const bf16x8*)(xp0 + ((2 * gp + 1) * 4 + i) * 32);
            S5_GROUP(xa, 2 * gp);
            if (gp < 3) {
#pragma unroll
                for (int i = 0; i < 4; ++i) xa[i] = *(const bf16x8*)(xp0 + ((2 * gp + 2) * 4 + i) * 32);
            }
            S5_GROUP(xb, 2 * gp + 1);
        }
#undef S5_GROUP
#pragma unroll 1
        for (int jb = 0; jb < 4; ++jb) {
            const bf16x8 hf = *(const bf16x8*)(hp0 + jb * 32);
#pragma unroll
            for (int q = 0; q < 16; ++q) {
                const bf16x8 vf = *(const LAS bf16x8*)(VT + (q * 16 + fr) * 272 + (jb * 32 + 8 * fq) * 2);
                acc[q] = __builtin_amdgcn_mfma_f32_16x16x32_bf16(vf, hf, acc[q], 0, 0, 0);
            }
        }
#pragma unroll
        for (int q = 0; q < 16; ++q) {
            const int t = rc + 4 * q, tok = 64 * n + t;
            const f32x4 y = acc[q];
            u32x2 o; o.x = pk2(gelu_tanh(y[0]), gelu_tanh(y[1])); o.y = pk2(gelu_tanh(y[2]), gelu_tanh(y[3]));
            *(u32x2*)(Gb + (size_t)tok * 1024 + g * 16 + 4 * fq) = o;
#if SELFTEST_S5
            if (tok < 256) *(f32x4*)((float*)(F.ws + WS_DBG) + (size_t)tok * 1024 + g * 16 + 4 * fq) = y;
#endif
        }
    }
}
#if SELFTEST_S5
__device__ __forceinline__ void selftest_s5(Frame& F, int l) {
    PH_LOCALS
    if (F.vcu < 64 && wave == 0) {
        const int g = F.vcu, p = lane;
        const float dt = expf(F.in[I_LDT][l * 64 + g]);
        const float lr = F.in[I_LRE][(l * 64 + g) * 64 + p], li = F.in[I_LIM][(l * 64 + g) * 64 + p];
        const float mag = expf(lr * dt); float sn, cs; sincosf(li * dt, &sn, &cs);
        const float ar = mag * cs, ai = mag * sn;
        const float xr = ar - 1.0f, xi = ai, den = 1.0f / (lr * lr + li * li);
        const float cr = (xr * lr + xi * li) * den, ci = (xi * lr - xr * li) * den;
        float bbr[16], bbi[16], ccr[16], cci[16];
#pragma unroll
        for (int i = 0; i < 16; ++i) { const float br = F.in[I_BRE][((size_t)(l * 64 + g) * 64 + p) * 16 + i], bi = F.in[I_BIM][((size_t)(l * 64 + g) * 64 + p) * 16 + i];
            bbr[i] = cr * br - ci * bi; bbi[i] = cr * bi + ci * br;
            ccr[i] = F.in[I_CRE][((size_t)(l * 64 + g) * 16 + i) * 64 + p]; cci[i] = F.in[I_CIM][((size_t)(l * 64 + g) * 16 + i) * 64 + p]; }
        const bf16* XS = (const bf16*)(F.ws + WS_XS) + (size_t)g * 256 * 1024;
        const float* DY = (const float*)(F.ws + WS_DBG);
        float sr = 0.f, si = 0.f, err = 0.f, ref = 0.f;
        for (int t = 0; t < 256; ++t) {
            float x[16];
#pragma unroll
            for (int i = 0; i < 16; ++i) x[i] = bflo((unsigned)XS[(size_t)t * 16 + i]);
            float ur = 0.f, ui = 0.f;
#pragma unroll
            for (int i = 0; i < 16; ++i) { ur += bbr[i] * x[i]; ui += bbi[i] * x[i]; }
            const float nr = ar * sr - ai * si + ur, ni = ar * si + ai * sr + ui; sr = nr; si = ni;
#pragma unroll
            for (int o = 0; o < 16; ++o) {
                const float yr = wave_sum(ccr[o] * sr - cci[o] * si);
                const float yf = DY[(size_t)t * 1024 + g * 16 + o];
                err += (yf - yr) * (yf - yr); ref += yr * yr;
            }
        }
        if (lane == 0 && !(err <= 2e-3f * ref)) __hip_atomic_fetch_or((unsigned*)(F.ws + WS_CTL) + CW_FLAG, 1u, RLX_AGENT);
    }
}
#endif

__device__ __forceinline__ unsigned f2key(float v) { const unsigned u = __builtin_bit_cast(unsigned, v); return (u & 0x80000000u) ? ~u : (u | 0x80000000u); }
__device__ __forceinline__ float key2f(unsigned k) { const unsigned u = (k & 0x80000000u) ? (k & 0x7fffffffu) : ~k; return __builtin_bit_cast(float, u); }
__device__ __forceinline__ void sort16_desc(unsigned (&v)[16]) {
#pragma unroll
    for (int lk = 1; lk <= 4; ++lk) {
#pragma unroll
        for (int lj = lk - 1; lj >= 0; --lj) {
#pragma unroll
            for (int i = 0; i < 16; ++i) { const int k = 1 << lk, j = 1 << lj, p = i ^ j;
                if (p > i) { const unsigned a = v[i], c = v[p], hi = a > c ? a : c, lo = a > c ? c : a; const bool desc = ((i & k) == 0) || (k == 16);
                    v[i] = desc ? hi : lo; v[p] = desc ? lo : hi; } }
        }
    }
}
__device__ __forceinline__ void merge16_desc(unsigned (&v)[16], const unsigned (&w)[16]) {
#pragma unroll
    for (int i = 0; i < 16; ++i) v[i] = v[i] > w[15 - i] ? v[i] : w[15 - i];
#pragma unroll
    for (int lj = 3; lj >= 0; --lj) {
#pragma unroll
        for (int i = 0; i < 16; ++i) { const int j = 1 << lj, p = i ^ j;
            if (p > i) { const unsigned a = v[i], c = v[p]; v[i] = a > c ? a : c; v[p] = a > c ? c : a; } }
    }
}
__device__ __forceinline__ void xmerge16(unsigned (&v)[16], int mask) {
    unsigned w[16];
#pragma unroll
    for (int i = 0; i < 16; ++i) w[i] = (unsigned)__shfl_xor((int)v[i], mask);
    merge16_desc(v, w);
}
__device__ __forceinline__ void phase_topk(Frame& F, int l) {
    PH_LOCALS
    const bf16* Q = (const bf16*)(F.ws + WS_Z);
    const bf16* KB = (const bf16*)(F.ws + WS_KEYS) + (size_t)l * 8 * 2 * 128 * 128;
    int* EID = (int*)(F.ws + WS_EID); float* GT = (float*)(F.ws + WS_GATE); float* SUo = (float*)(F.ws + WS_SU);
    const float* SCL = (const float*)(F.ws + WS_SCL) + (size_t)l * NEXP * 2;
    LAS unsigned char* KL = F.lds;
    LAS float* SC = (LAS float*)(F.lds + 69632);
    LAS unsigned* LST = (LAS unsigned*)(F.lds + 69632 + 66560);
    LAS unsigned char* PT = F.lds + 69632 + 66560 + 8192;
    const int fr = lane & 15, fq = lane >> 4;
    {
        int c = 0;
#pragma unroll
        for (int i = 0; i < 16; ++i)
#pragma unroll
            for (int j = 0; j < 16; ++j) if ((i + 1) * (j + 1) <= 16) { if (tid == c) PT[c] = (unsigned char)(i * 16 + j); ++c; }
    }
    int cur_hh = -1;
    for (int u = F.vcu; u < 2048; u += F.G) {
        const int tt = u >> 3, hh = u & 7, t0 = tt * 64;
        const int tw = wave & 3, s = wave >> 2;
        bf16x8 qf[4];
#pragma unroll
        for (int kb = 0; kb < 4; ++kb) qf[kb] = *(const bf16x8*)(Q + (size_t)(t0 + 16 * tw + fr) * 2048 + hh * 256 + s * 128 + kb * 32 + 8 * fq);
        if (hh != cur_hh) {
            __syncthreads();
#pragma unroll
            for (int ps = 0; ps < 8; ++ps) { const int idx = ps * 512 + tid, row = idx >> 4, c16 = idx & 15;
                *(LAS u32x4*)(KL + row * 272 + c16 * 16) = *(const u32x4*)(KB + ((size_t)(hh * 256 + row)) * 128 + c16 * 8); }
            cur_hh = hh;
        }
        __syncthreads();
        {
            f32x4 acc[8];
#pragma unroll
            for (int nt = 0; nt < 8; ++nt) acc[nt] = (f32x4){0.f, 0.f, 0.f, 0.f};
#pragma unroll
            for (int kb = 0; kb < 4; ++kb)
#pragma unroll
                for (int nt = 0; nt < 8; ++nt) { const bf16x8 kf = *(const LAS bf16x8*)(KL + (s * 128 + nt * 16 + fr) * 272 + (kb * 32 + 8 * fq) * 2);
                    acc[nt] = __builtin_amdgcn_mfma_f32_16x16x32_bf16(kf, qf[kb], acc[nt], 0, 0, 0); }
#pragma unroll
            for (int nt = 0; nt < 8; ++nt) *(LAS f32x4*)(SC + (16 * tw + fr) * 260 + s * 128 + nt * 16 + 4 * fq) = acc[nt];
        }
        __syncthreads();
        {
            const int pr = tid >> 2, sub = tid & 3, tl = pr >> 1, sd = pr & 1;
            const LAS float* row = SC + tl * 260 + sd * 128 + 32 * sub;
            unsigned va[16], vb[16];
#pragma unroll
            for (int q4 = 0; q4 < 4; ++q4) { const f32x4 x = *(const LAS f32x4*)(row + 4 * q4), y = *(const LAS f32x4*)(row + 16 + 4 * q4);
#pragma unroll
                for (int e = 0; e < 4; ++e) { va[4 * q4 + e] = (f2key(x[e]) & ~0x7Fu) | (unsigned)(127 - (32 * sub + 4 * q4 + e)); vb[4 * q4 + e] = (f2key(y[e]) & ~0x7Fu) | (unsigned)(127 - (32 * sub + 16 + 4 * q4 + e)); } }
            sort16_desc(va); sort16_desc(vb); merge16_desc(va, vb);
            xmerge16(va, 1); xmerge16(va, 2);
            if (sub == 0) {
#pragma unroll
                for (int k = 0; k < 16; k += 4) *(LAS u32x4*)(LST + pr * 16 + k) = (u32x4){va[k], va[k + 1], va[k + 2], va[k + 3]};
            }
        }
        __syncthreads();
        {
            const int tl = tid >> 3, s8 = tid & 7;
            unsigned v[16];
#pragma unroll
            for (int m = 0; m < 7; ++m) { const int c = m * 8 + s8; unsigned key = 0u;
                if (c < 50) { const int pij = PT[c], i = pij >> 4, j = pij & 15;
                    const float av = key2f(LST[(tl * 2 + 0) * 16 + i] & ~0x7Fu), bv = key2f(LST[(tl * 2 + 1) * 16 + j] & ~0x7Fu);
                    key = (f2key(av + bv) & ~0xFFu) | (unsigned)(255 - pij); }
                v[m] = key; }
#pragma unroll
            for (int m = 7; m < 16; ++m) v[m] = 0u;
            sort16_desc(v);
            xmerge16(v, 1); xmerge16(v, 2); xmerge16(v, 4);
            float ev[16]; float sum = 0.f; const float mx = key2f(v[0] & ~0xFFu);
#pragma unroll
            for (int k = 0; k < 16; ++k) { ev[k] = __expf(key2f(v[k] & ~0xFFu) - mx); sum += ev[k]; }
            const float inv = 1.0f / sum;
            unsigned k0 = v[0], k1 = v[1]; float e0 = ev[0], e1 = ev[1];
#pragma unroll
            for (int q = 1; q < 8; ++q) { if (s8 == q) { k0 = v[2 * q]; k1 = v[2 * q + 1]; e0 = ev[2 * q]; e1 = ev[2 * q + 1]; } }
            const size_t ob = (size_t)(t0 + tl) * 128 + hh * 16 + 2 * s8;
            {   const int flat = 255 - (int)(k0 & 0xFFu), i = flat >> 4, j = flat & 15;
                const int ia = 127 - (int)(LST[(tl * 2 + 0) * 16 + i] & 0x7Fu), ib = 127 - (int)(LST[(tl * 2 + 1) * 16 + j] & 0x7Fu);
                const int e = ia * 128 + ib; const f32x2 sc = *(const f32x2*)(SCL + 2 * e);
                EID[ob] = e; GT[ob] = e0 * inv * sc.y; SUo[ob] = sc.x; }
            {   const int flat = 255 - (int)(k1 & 0xFFu), i = flat >> 4, j = flat & 15;
                const int ia = 127 - (int)(LST[(tl * 2 + 0) * 16 + i] & 0x7Fu), ib = 127 - (int)(LST[(tl * 2 + 1) * 16 + j] & 0x7Fu);
                const int e = ia * 128 + ib; const f32x2 sc = *(const f32x2*)(SCL + 2 * e);
                EID[ob + 1] = e; GT[ob + 1] = e1 * inv * sc.y; SUo[ob + 1] = sc.x; }
        }
    }
    __syncthreads();
}

#define FP4X4(w, f0, f1, f2, f3) do { f0 = __builtin_amdgcn_cvt_scalef32_pk_f32_fp4((w), 1.0f, 0); f1 = __builtin_amdgcn_cvt_scalef32_pk_f32_fp4((w), 1.0f, 1); \
    f2 = __builtin_amdgcn_cvt_scalef32_pk_f32_fp4((w), 1.0f, 2); f3 = __builtin_amdgcn_cvt_scalef32_pk_f32_fp4((w), 1.0f, 3); } while (0)
__device__ __forceinline__ void phase_gather(Frame& F, int l, bool dummy = false) {
    PH_LOCALS
    const int gw = F.vcu * NWAVES + wave, NGW = F.G * NWAVES;
    const bf16* H = (const bf16*)(F.ws + WS_H); bf16* Hn = dummy ? (bf16*)(F.ws + WS_DBG + 128 * MiB) : (bf16*)(F.ws + WS_H);
    const unsigned char* UV = F.ws + WS_UV + (size_t)l * NEXP * 2048;
    const int* EID = (const int*)(F.ws + WS_EID); const float* GT = (const float*)(F.ws + WS_GATE); const float* SU = (const float*)(F.ws + WS_SU);
    const float* X = (const float*)(F.ws + WS_X); float* Xo = dummy ? (float*)(F.ws + WS_DBG) : (float*)(F.ws + WS_X);
    const float* mod = (const float*)(F.ws + WS_MOD);
    const float* gate2 = mod + l * 12288 + 5 * 2048;
    const unsigned lane16 = (unsigned)lane * 16u;
    constexpr int NB = 16;
    for (int t = gw; t < M; t += NGW) {
        const int e_lo = EID[(size_t)t * 128 + lane], e_hi = EID[(size_t)t * 128 + 64 + lane];
        const float g_lo = GT[(size_t)t * 128 + lane], g_hi = GT[(size_t)t * 128 + 64 + lane];
        const float s_lo = SU[(size_t)t * 128 + lane], s_hi = SU[(size_t)t * 128 + 64 + lane];
        f32x2 hh[8][2];
#pragma unroll
        for (int j = 0; j < 8; ++j) { const u32x2 w = *(const u32x2*)(H + (size_t)t * 2048 + j * 256 + lane * 4);
            hh[j][0] = (f32x2){bflo(w.x), bfhi(w.x)}; hh[j][1] = (f32x2){bflo(w.y), bfhi(w.y)}; }
        f32x2 of[8][2];
#pragma unroll
        for (int j = 0; j < 8; ++j) { of[j][0] = (f32x2){0.f, 0.f}; of[j][1] = (f32x2){0.f, 0.f}; }
        for (int b = 0; b < 128 / NB; ++b) {
            const bool first = (b * NB) < 64;
            const int esel = first ? e_lo : e_hi; const float gsel = first ? g_lo : g_hi, ssel = first ? s_lo : s_hi;
            u32x4 ur[NB], vr[NB];
#pragma unroll
            for (int h = 0; h < NB; ++h) {
                const int e = __builtin_amdgcn_readlane(esel, (NB * b + h) & 63);
                const unsigned char* rowp = UV + ((size_t)(unsigned)e << 11);
                ur[h] = *(const u32x4*)(rowp + lane16); vr[h] = *(const u32x4*)(rowp + 1024 + lane16);
            }
            float p[NB];
#pragma unroll
            for (int h = 0; h < NB; ++h) {
                f32x2 a2 = {0.f, 0.f};
#pragma unroll
                for (int d = 0; d < 4; ++d) { f32x2 f0, f1, f2, f3; FP4X4(ur[h][d], f0, f1, f2, f3);
                    a2 = f0 * hh[2 * d][0] + a2; a2 = f1 * hh[2 * d][1] + a2; a2 = f2 * hh[2 * d + 1][0] + a2; a2 = f3 * hh[2 * d + 1][1] + a2; }
                p[h] = a2.x + a2.y;
            }
            const bool u32_ = (lane & 32) != 0, u16_ = (lane & 16) != 0, u8_ = (lane & 8) != 0, u4_ = (lane & 4) != 0;
            float a8[8];
#pragma unroll
            for (int i = 0; i < 8; ++i) { const float snd = u32_ ? p[i] : p[8 + i], kp = u32_ ? p[8 + i] : p[i]; a8[i] = kp + __shfl_xor(snd, 32); }
            float a4[4];
#pragma unroll
            for (int i = 0; i < 4; ++i) { const float snd = u16_ ? a8[i] : a8[4 + i], kp = u16_ ? a8[4 + i] : a8[i]; a4[i] = kp + __shfl_xor(snd, 16); }
            float b2[2];
#pragma unroll
            for (int i = 0; i < 2; ++i) { const float snd = u8_ ? a4[i] : a4[2 + i], kp = u8_ ? a4[2 + i] : a4[i]; b2[i] = kp + __shfl_xor(snd, 8); }
            float d;
            { const float snd = u4_ ? b2[0] : b2[1], kp = u4_ ? b2[1] : b2[0]; d = kp + __shfl_xor(snd, 4); }
            d += __shfl_xor(d, 2); d += __shfl_xor(d, 1);
            const int hl = (NB * b + (lane >> 2)) & 63;
            const float gq = __shfl(gsel, hl), sq = __shfl(ssel, hl);
            const float coefq = gq * gelu_tanh(d * sq);
#pragma unroll
            for (int h = 0; h < NB; ++h) {
                const float cf = __builtin_bit_cast(float, __builtin_amdgcn_readlane(__builtin_bit_cast(int, coefq), 4 * h));
                const f32x2 cf2 = {cf, cf};
#pragma unroll
                for (int dd = 0; dd < 4; ++dd) { f32x2 f0, f1, f2, f3; FP4X4(vr[h][dd], f0, f1, f2, f3);
                    of[2 * dd][0] = f0 * cf2 + of[2 * dd][0]; of[2 * dd][1] = f1 * cf2 + of[2 * dd][1]; of[2 * dd + 1][0] = f2 * cf2 + of[2 * dd + 1][0]; of[2 * dd + 1][1] = f3 * cf2 + of[2 * dd + 1][1]; }
            }
        }
        int ln = lane; asm volatile("" : "+v"(ln));
        f32x4 xv[8]; float ss = 0.f;
#pragma unroll
        for (int j = 0; j < 8; ++j) {
            const int c = j * 256 + ln * 4;
            const f32x4 xo = *(const f32x4*)(X + (size_t)t * 2048 + c), g2 = *(const f32x4*)(gate2 + c);
            const f32x4 o = {of[j][0].x, of[j][0].y, of[j][1].x, of[j][1].y};
            xv[j] = xo + g2 * o;
            ss += (xv[j][0] * xv[j][0] + xv[j][1] * xv[j][1]) + (xv[j][2] * xv[j][2] + xv[j][3] * xv[j][3]);
        }
        const float rr = 1.0f / sqrtf(wave_sum(ss) * (1.0f / DM) + EPS);
        if (l + 1 < DEPTH) {
            const float* m2 = mod + (l + 1) * 12288; const float* gain = F.in[I_N1G] + (l + 1) * 2048;
#pragma unroll
            for (int j = 0; j < 8; ++j) {
                const int c = j * 256 + ln * 4;
                *(f32x4*)(Xo + (size_t)t * 2048 + c) = xv[j];
                const f32x4 g = *(const f32x4*)(gain + c), sc = *(const f32x4*)(m2 + 2048 + c), sh = *(const f32x4*)(m2 + c);
                const f32x4 y = xv[j] * rr * g * (sc + 1.0f) + sh;
                *(u32x2*)(Hn + (size_t)t * 2048 + c) = (u32x2){pk2(y[0], y[1]), pk2(y[2], y[3])};
            }
        } else {
#pragma unroll
            for (int j = 0; j < 8; ++j) { const int c = j * 256 + ln * 4; const f32x4 fg = *(const f32x4*)(F.in[I_FG] + c);
                f32x4 ov = xv[j] * rr * fg;
#if SELFTEST_S5
                if (__hip_atomic_load((unsigned*)(F.ws + WS_CTL) + CW_FLAG, RLX_AGENT) != 0u) ov = (f32x4){1e30f, 1e30f, 1e30f, 1e30f};
#endif
                *(f32x4*)(F.out + (size_t)t * 2048 + c) = ov; }
        }
    }
}

__global__ void __launch_bounds__(NTHR, 2) fwd_kernel(Args args) {
    extern __shared__ __attribute__((aligned(16))) unsigned char lds_raw[];
    Frame F;
    F.lds = (LAS unsigned char*)lds_raw; F.ws = args.ws; F.in = args.in; F.out = args.out;
    F.tid = threadIdx.x; F.lane = F.tid & 63; F.wave = __builtin_amdgcn_readfirstlane(F.tid >> 6);
    F.G = gridDim.x; { const int bx = blockIdx.x; F.vcu = (F.G % 8 == 0) ? (bx % 8) * (F.G / 8) + bx / 8 : bx; }
    volatile LAS unsigned* MISC = (volatile LAS unsigned*)(F.lds + MISC_OFF);
    if (F.tid < 64) MISC[F.tid] = 0u;
    __syncthreads();
    unsigned* ctl = (unsigned*)(F.ws + WS_CTL);
    XcdBarrier bar; bar.bar = ctl + CW_BAR; bar.x = 0; bar.st = nullptr;
#if !MK_PER_PHASE
    bar = xcd_barrier_post(ctl + CW_BAR, MISC + 8);
#endif
    const int lo = args.ph_lo, hi = args.ph_hi;
#define IN(k) (lo <= (k) && (k) < hi)
#if MK_PER_PHASE
#define SEAM(k) do { } while (0)
#else
#define SEAM(k) do { if (IN(k) && IN((k) + 1)) xcd_barrier(bar); } while (0)
#endif
    const float* mod = (const float*)(F.ws + WS_MOD);

#define REP(k) (REPEAT_PH == (k))
#define RUN2(k, first, real) do { if (REP(k)) { first; xcd_barrier(bar); } real; } while (0)
    if (IN(0)) { RUN2(13, p0_tables(F, 5, true), p0_tables(F, 4, false)); } SEAM(0);
    for (int l = 0; l < DEPTH; ++l) {
        const int pb = 1 + 12 * l;
        const float* ml = mod + l * 12288;
        const float* xin = (l == 0) ? F.in[I_X] : (const float*)(F.ws + WS_X);
        if (IN(pb + 0)) { if (l == 0) { RUN2(0, p0_prologue(F), p0_prologue(F)); RUN2(1, phase_norm(F, xin, F.in[I_N1G] + l * 2048, ml + 1 * 2048, ml + 0 * 2048), phase_norm(F, xin, F.in[I_N1G] + l * 2048, ml + 1 * 2048, ml + 0 * 2048)); } } SEAM(pb + 0);
        if (IN(pb + 1)) {
            pg8::Gemm g{(const bf16*)(F.ws + WS_H), (const bf16*)(F.ws + WS_WIN) + (size_t)l * INW * DM, M, INW, DM}; pg8::StaticOrder S; S.init(M, INW, F.G, (int)blockIdx.x);
            EpiIn E{(bf16*)(F.ws + WS_Z), (bf16*)(F.ws + WS_XS), F.in[I_BIN] + l * INW};
#define GEMM_IN pg8::gemm_phase<EpiIn, pg8::StaticOrder, true, true>(F.lds, g, S, E)
            RUN2(2, GEMM_IN, GEMM_IN);
        } SEAM(pb + 1);
        if (IN(pb + 2)) { RUN2(3, (phase_sloc(F, l), phase_lnstats(F)), (phase_sloc(F, l), phase_lnstats(F))); } SEAM(pb + 2);
        if (IN(pb + 3)) { RUN2(4, phase_carry_gating(F, l, l + 2), phase_carry_gating(F, l, l)); } SEAM(pb + 3);
        if (IN(pb + 4)) { RUN2(5, phase_s5out(F, l), phase_s5out(F, l));
#if SELFTEST_S5
            xcd_barrier(bar); selftest_s5(F, l);
#endif
        } SEAM(pb + 4);
        if (IN(pb + 5)) {
            pg8::Gemm g{(const bf16*)(F.ws + WS_G), (const bf16*)(F.ws + WS_GLU) + (size_t)l * WB * WB, M, WB, WB}; pg8::StaticOrder S; S.init(M, WB, F.G, (int)blockIdx.x);
            EpiGlu E{(const bf16*)(F.ws + WS_G), (bf16*)(F.ws + WS_MIX), F.in[I_GLUB] + l * WB};
#define GEMM_GLU pg8::gemm_phase<EpiGlu, pg8::StaticOrder, true, true>(F.lds, g, S, E)
            RUN2(6, GEMM_GLU, GEMM_GLU);
        } SEAM(pb + 5);
        if (IN(pb + 6)) { RUN2(7, phase_branchnorm(F), phase_branchnorm(F)); } SEAM(pb + 6);
        if (IN(pb + 7)) {
            pg8::Gemm g{(const bf16*)(F.ws + WS_MIX), (const bf16*)(F.ws + WS_WOUT) + (size_t)l * DM * DM, M, DM, DM}; pg8::StaticOrder S; S.init(M, DM, F.G, (int)blockIdx.x);
            EpiOut E{xin, (float*)(F.ws + WS_X), ml + 2 * 2048};
            EpiOut Ed{xin, (float*)(F.ws + WS_DBG), ml + 2 * 2048};
#define GEMM_OUT(EE) pg8::gemm_phase<EpiOut, pg8::StaticOrder, true, true>(F.lds, g, S, EE)
            RUN2(8, GEMM_OUT(Ed), GEMM_OUT(E));
        } SEAM(pb + 7);
        if (IN(pb + 8)) { RUN2(9, phase_norm(F, (const float*)(F.ws + WS_X), F.in[I_N2G] + l * 2048, ml + 4 * 2048, ml + 3 * 2048), phase_norm(F, (const float*)(F.ws + WS_X), F.in[I_N2G] + l * 2048, ml + 4 * 2048, ml + 3 * 2048)); } SEAM(pb + 8);
        if (IN(pb + 9)) {
            pg8::Gemm g{(const bf16*)(F.ws + WS_H), (const bf16*)(F.ws + WS_WQ) + (size_t)l * DM * DM, M, DM, DM}; pg8::StaticOrder S; S.init(M, DM, F.G, (int)blockIdx.x);
            EpiQ E{(bf16*)(F.ws + WS_Z)};
#define GEMM_Q pg8::gemm_phase<EpiQ, pg8::StaticOrder, true, true>(F.lds, g, S, E)
            RUN2(10, GEMM_Q, GEMM_Q);
        } SEAM(pb + 9);
        if (IN(pb + 10)) { RUN2(11, phase_topk(F, l), phase_topk(F, l)); } SEAM(pb + 10);
        if (IN(pb + 11)) { RUN2(12, phase_gather(F, l, true), phase_gather(F, l, false)); } SEAM(pb + 11);
    }
#undef IN
#undef SEAM
}

extern "C" void kernel_launch(void* const* d_in, const int* in_sizes, int n_in, void* d_out, int out_size, void* d_ws, size_t ws_size, hipStream_t stream) {
    static int grid = 0;
    if (grid == 0) {
        if (n_in != 29 || out_size != M * DM || ws_size < WS_END) { fprintf(stderr, "kernel_launch: unexpected shapes (n_in %d, out %d, ws %zu); nothing launched\n", n_in, out_size, ws_size); grid = -1; return; }
        int dev = 0, cus = 0;
        if (hipGetDevice(&dev) != hipSuccess || hipDeviceGetAttribute(&cus, hipDeviceAttributeMultiprocessorCount, dev) != hipSuccess) { grid = -1; return; }
        if (hipFuncSetAttribute((const void*)fwd_kernel, hipFuncAttributeMaxDynamicSharedMemorySize, LDS_BYTES) != hipSuccess) { fprintf(stderr, "kernel_launch: hipFuncSetAttribute failed\n"); grid = -1; return; }
        (void)hipGetLastError();
        grid = cus;
    }
    if (grid < 0) return;
    (void)hipMemsetAsync((char*)d_ws + WS_CTL, 0, CTL_ZERO_BYTES, stream);
    Args a{};
    for (int i = 0; i < 29; ++i) a.in[i] = (const float*)d_in[i];
    a.out = (float*)d_out; a.ws = (unsigned char*)d_ws;
#if MK_PER_PHASE
    for (int p = 0; p < 1 + 12 * DEPTH; ++p) {
        if (p == 13) continue;
        a.ph_lo = p; a.ph_hi = p + 1; a.li = p;
        hipLaunchKernelGGL(fwd_kernel, dim3(grid), dim3(NTHR), LDS_BYTES, stream, a);
    }
#else
    a.ph_lo = 0; a.ph_hi = 1 + 12 * DEPTH; a.li = 0;
    hipLaunchKernelGGL(fwd_kernel, dim3(grid), dim3(NTHR), LDS_BYTES, stream, a);
#endif
}
```

```cpp
#include <hip/hip_runtime.h>
#include <cstdio>
#include <cstdint>

#ifndef SELFTEST_S5
#define SELFTEST_S5 0
#endif
#ifndef REPEAT_PH
#define REPEAT_PH -1
#endif
#ifndef MK_PER_PHASE
#define MK_PER_PHASE 0
#endif

#define GAS __attribute__((address_space(1)))
#define LAS __attribute__((address_space(3)))
typedef unsigned short bf16;
typedef short bf16x8 __attribute__((ext_vector_type(8)));
typedef float f32x4 __attribute__((ext_vector_type(4)));
typedef float f32x2 __attribute__((ext_vector_type(2)));
typedef unsigned u32x4 __attribute__((ext_vector_type(4)));
typedef unsigned u32x2 __attribute__((ext_vector_type(2)));

constexpr int DM = 2048, SEQ = 16384, DEPTH = 2, M = SEQ;
constexpr int WA = 1024, WB = 1024, INW = 3072;
constexpr int NG = 64, NCH = 256;
constexpr int NEXP = 16384;
constexpr float EPS = 1e-6f;
constexpr int NWAVES = 8, NTHR = 512;

namespace pg8 {
#define PG8_LAS __attribute__((address_space(3)))
constexpr int BM = 256, BK = 64, HALF = 128, HTB = HALF * BK * 2, STAGE_BYTES = 8 * HTB, NXCD = 8, WGM = 8;
__host__ __device__ __forceinline__ int lds_byte(int r, int c) { const int st = (r >> 4) * 2 + (c >> 5), rr = r & 15, cc = c & 31, ob = rr * 64 + cc * 2; return st * 1024 + (ob ^ (((ob >> 9) & 1) << 5)); }
__host__ __device__ __forceinline__ void stage_rc(int b, int& R, int& C) { const int st = b / 1024, sb = b % 1024, swz = sb ^ (((sb >> 9) & 1) << 5); R = (st >> 1) * 16 + swz / 64; C = (st & 1) * 32 + (swz % 64) / 2; }
__host__ __device__ __forceinline__ int perm32(int rho) { const int n = rho >> 4, i = rho & 15; return 8 * (i >> 2) + 4 * n + (i & 3); }
struct Unit { int pm, pn; };
struct Gemm { const bf16* A; const bf16* Bt; int M, N, K; };
struct StaticOrder {
    int nM, nN, nwg, G, c;
    __host__ __device__ void init(int M_, int N_, int G_, int c_) { nM = M_ / BM; nN = N_ / BM; nwg = nM * nN; G = G_; c = c_; }
    __host__ __device__ bool next(int i, Unit& u) const {
        const long L = (long)i * G + c; if (L >= nwg) return false;
        int wgid = (int)L; { const int q = nwg / NXCD, r = nwg % NXCD, xcd = wgid % NXCD, off = wgid / NXCD; wgid = (xcd < r ? xcd * (q + 1) : r * (q + 1) + (xcd - r) * q) + off; }
        const int nig = WGM * nN, gid = wgid / nig, fm = gid * WGM, gsz = (nM - fm) < WGM ? (nM - fm) : WGM;
        u.pm = fm + ((wgid % nig) % gsz); u.pn = (wgid % nig) / gsz; return true;
    }
    __device__ __forceinline__ void a_ready(const Unit&) const {}
    __device__ __forceinline__ void done(const Unit&) const {}
};
__device__ __forceinline__ unsigned cvt_pk_bf16(float lo, float hi) { unsigned r; asm volatile("v_cvt_pk_bf16_f32 %0, %1, %2" : "=v"(r) : "v"(lo), "v"(hi)); return r; }

template <class Epi, class Sched, bool ALIGN_EPI = false, bool SP2 = false>
__device__ __forceinline__ void gemm_phase(PG8_LAS unsigned char* lds, const Gemm g, const Sched& S, const Epi& E) {
    int tid = threadIdx.x; asm volatile("" : "+v"(tid)); const int wid = __builtin_amdgcn_readfirstlane(tid >> 6), lane = tid & 63, wr = wid >> 2, wc = wid & 3, fr = lane & 15, fq = lane >> 4;
    const int K = g.K, nt = K / BK;
    unsigned voffA[2], voffB[2];
#pragma unroll
    for (int i = 0; i < 2; ++i) { int R, C; stage_rc(tid * 16 + i * 8192, R, C); const int Rb = Epi::PERM ? ((R & ~31) + perm32(R & 31)) : R;
        voffA[i] = (unsigned)(R * K + C) * 2u; voffB[i] = (unsigned)(Rb * K + C) * 2u; }
    const size_t kstep = (size_t)(BK * 2);
    const size_t hstep = (size_t)HALF * K * 2;
    const size_t tstep = 2 * hstep;
    const unsigned ldsw = (unsigned)wid * 1024u;
    const int aoff = lds_byte(wr * 64 + fr, fq * 8), boff = lds_byte(wc * 32 + fr, fq * 8);
#define PG8_SA(b, h) (((b) * 2 + (h)) * HTB)
#define PG8_SB(b, h) ((4 + (b) * 2 + (h)) * HTB)
#define PG8_STAGE(bufoff, gbase, voff) do { _Pragma("unroll") for (int _i = 0; _i < 2; ++_i) \
        __builtin_amdgcn_global_load_lds((const unsigned*)((const char*)(gbase) + (voff)[_i]), (PG8_LAS unsigned*)(lds + (bufoff) + ldsw + _i * 8192), 16, 0, 0); } while (0)
#define PG8_LDA(dst, b, h) do { _Pragma("unroll") for (int m = 0; m < 4; ++m) _Pragma("unroll") for (int k = 0; k < 2; ++k) dst[m][k] = *(const PG8_LAS bf16x8*)(lds + PG8_SA(b, h) + aoff + m * 2048 + k * 1024); } while (0)
#define PG8_LDB(dst, b, h) do { _Pragma("unroll") for (int n = 0; n < 2; ++n) _Pragma("unroll") for (int k = 0; k < 2; ++k) dst[n][k] = *(const PG8_LAS bf16x8*)(lds + PG8_SB(b, h) + boff + n * 2048 + k * 1024); } while (0)
#define PG8_MMA(ai, bj, At, Bt) do { __builtin_amdgcn_s_setprio(1); _Pragma("unroll") for (int m = 0; m < 4; ++m) _Pragma("unroll") for (int n = 0; n < 2; ++n) _Pragma("unroll") for (int k = 0; k < 2; ++k) \
        acc[ai][bj][m][n] = __builtin_amdgcn_mfma_f32_16x16x32_bf16(Bt[n][k], At[m][k], acc[ai][bj][m][n], 0, 0, 0); __builtin_amdgcn_s_setprio(0); } while (0)
#define PG8_WAIT_V(n) asm volatile("s_waitcnt vmcnt(" #n ")" ::: "memory")
#define PG8_WAIT_L(n) asm volatile("s_waitcnt lgkmcnt(" #n ")" ::: "memory")
#define PG8_BAR __builtin_amdgcn_s_barrier()
#define PG8_SCHED __builtin_amdgcn_sched_barrier(0)
    Unit cur, nxt; int ui = 0;
    if (!S.next(0, cur)) return;
    f32x4 acc[2][2][4][2];
#pragma unroll
    for (int a = 0; a < 2; ++a)
#pragma unroll
        for (int b = 0; b < 2; ++b)
#pragma unroll
            for (int m = 0; m < 4; ++m)
#pragma unroll
                for (int n = 0; n < 2; ++n) acc[a][b][m][n] = (f32x4){0.f, 0.f, 0.f, 0.f};
    bf16x8 At[4][2], B0[2][2], B1[2][2];
    const char* cA = (const char*)g.A + (size_t)cur.pm * tstep; const char* cB = (const char*)g.Bt + (size_t)cur.pn * tstep;
    S.a_ready(cur);
    if constexpr (SP2) {
        PG8_STAGE(PG8_SB(0, 0), cB, voffB); PG8_STAGE(PG8_SB(0, 1), cB + hstep, voffB); PG8_STAGE(PG8_SA(0, 0), cA, voffA); PG8_STAGE(PG8_SA(0, 1), cA + hstep, voffA);
        if (wr == 1) PG8_BAR;
        PG8_WAIT_V(2); PG8_BAR;
        PG8_STAGE(PG8_SB(1, 0), cB + kstep, voffB); PG8_STAGE(PG8_SA(1, 0), cA + kstep, voffA); PG8_STAGE(PG8_SB(1, 1), cB + hstep + kstep, voffB);
        PG8_WAIT_V(6); PG8_BAR;
    } else {
        PG8_STAGE(PG8_SB(0, 0), cB, voffB); PG8_STAGE(PG8_SA(0, 0), cA, voffA); PG8_STAGE(PG8_SB(0, 1), cB + hstep, voffB); PG8_STAGE(PG8_SA(0, 1), cA + hstep, voffA);
        if (wr == 1) PG8_BAR;
        PG8_WAIT_V(4); PG8_BAR;
        PG8_STAGE(PG8_SB(1, 0), cB + kstep, voffB); PG8_STAGE(PG8_SA(1, 0), cA + kstep, voffA); PG8_STAGE(PG8_SB(1, 1), cB + hstep + kstep, voffB);
        PG8_WAIT_V(6); PG8_BAR;
    }
    for (;;) {
        const bool has_next = S.next(ui + 1, nxt);
        const char* nA = has_next ? (const char*)g.A + (size_t)nxt.pm * tstep : cA; const char* nB = has_next ? (const char*)g.Bt + (size_t)nxt.pn * tstep : cB;
        for (int t = 0; t < nt; t += 2) {
            const bool last = (t == nt - 2);
            const char* a1 = cA + (size_t)(t + 1) * kstep;
            const char* a2 = last ? nA : cA + (size_t)(t + 2) * kstep; const char* b2 = last ? nB : cB + (size_t)(t + 2) * kstep;
            const char* a3 = a2 + kstep; const char* b3 = b2 + kstep;
            if (last && has_next) S.a_ready(nxt);
            if constexpr (SP2) {
            PG8_LDB(B0, 0, 0); PG8_LDB(B1, 0, 1); PG8_SCHED; PG8_LDA(At, 0, 0); PG8_STAGE(PG8_SA(1, 1), a1 + hstep, voffA);
            PG8_WAIT_V(8); PG8_WAIT_L(0); PG8_BAR; PG8_MMA(0, 0, At, B0); PG8_MMA(0, 1, At, B1); PG8_BAR; PG8_SCHED;
            PG8_LDA(At, 0, 1); PG8_STAGE(PG8_SB(0, 0), b2, voffB); PG8_STAGE(PG8_SB(0, 1), b2 + hstep, voffB); PG8_STAGE(PG8_SA(0, 0), a2, voffA);
            PG8_WAIT_V(8); PG8_WAIT_L(0); PG8_BAR; PG8_MMA(1, 0, At, B0); PG8_MMA(1, 1, At, B1); PG8_BAR; PG8_SCHED;
            PG8_LDB(B0, 1, 0); PG8_LDB(B1, 1, 1); PG8_SCHED; PG8_LDA(At, 1, 0); PG8_STAGE(PG8_SA(0, 1), a2 + hstep, voffA);
            PG8_WAIT_V(8); PG8_WAIT_L(0); PG8_BAR; PG8_MMA(0, 0, At, B0); PG8_MMA(0, 1, At, B1); PG8_BAR; PG8_SCHED;
            PG8_LDA(At, 1, 1); PG8_STAGE(PG8_SB(1, 0), b3, voffB); PG8_STAGE(PG8_SB(1, 1), b3 + hstep, voffB); PG8_STAGE(PG8_SA(1, 0), a3, voffA);
            PG8_WAIT_V(8); PG8_WAIT_L(0); PG8_BAR; PG8_MMA(1, 0, At, B0); PG8_MMA(1, 1, At, B1); PG8_BAR; PG8_SCHED;
            } else {
            PG8_LDB(B0, 0, 0); PG8_SCHED; PG8_LDA(At, 0, 0); PG8_STAGE(PG8_SA(1, 1), a1 + hstep, voffA);
            PG8_WAIT_L(8); PG8_BAR; PG8_WAIT_L(0); PG8_MMA(0, 0, At, B0); PG8_BAR; PG8_SCHED;
            PG8_LDB(B1, 0, 1); PG8_STAGE(PG8_SB(0, 0), b2, voffB);
            PG8_BAR; PG8_WAIT_L(0); PG8_MMA(0, 1, At, B1); PG8_BAR;
            PG8_LDA(At, 0, 1); PG8_STAGE(PG8_SA(0, 0), a2, voffA);
            PG8_BAR; PG8_WAIT_L(0); PG8_MMA(1, 0, At, B0); PG8_BAR; PG8_SCHED;
            PG8_STAGE(PG8_SB(0, 1), b2 + hstep, voffB);
            PG8_WAIT_V(6); PG8_BAR; PG8_MMA(1, 1, At, B1); PG8_BAR;
            PG8_LDB(B0, 1, 0); PG8_SCHED; PG8_LDA(At, 1, 0); PG8_STAGE(PG8_SA(0, 1), a2 + hstep, voffA);
            PG8_WAIT_L(8); PG8_BAR; PG8_WAIT_L(0); PG8_MMA(0, 0, At, B0); PG8_BAR; PG8_SCHED;
            PG8_LDB(B1, 1, 1); PG8_STAGE(PG8_SB(1, 0), b3, voffB);
            PG8_BAR; PG8_WAIT_L(0); PG8_MMA(0, 1, At, B1); PG8_BAR;
            PG8_LDA(At, 1, 1); PG8_STAGE(PG8_SA(1, 0), a3, voffA);
            PG8_BAR; PG8_WAIT_L(0); PG8_MMA(1, 0, At, B0); PG8_BAR; PG8_SCHED;
            PG8_STAGE(PG8_SB(1, 1), b3 + hstep, voffB);
            PG8_WAIT_V(6); PG8_BAR; PG8_MMA(1, 1, At, B1); PG8_BAR;
            }
        }
        if constexpr (ALIGN_EPI) { if (wr == 0) PG8_BAR; }
        E(acc, cur, wr, wc, fr, fq); S.done(cur);
        if (!has_next) break;
#pragma unroll
        for (int a = 0; a < 2; ++a)
#pragma unroll
            for (int b = 0; b < 2; ++b)
#pragma unroll
                for (int m = 0; m < 4; ++m)
#pragma unroll
                    for (int n = 0; n < 2; ++n) acc[a][b][m][n] = (f32x4){0.f, 0.f, 0.f, 0.f};
        cur = nxt; cA = nA; cB = nB; ++ui;
        if constexpr (ALIGN_EPI) { if (wr == 1) PG8_BAR; }
    }
    PG8_WAIT_V(0);
    if constexpr (!ALIGN_EPI) { if (wr == 0) PG8_BAR; }
    PG8_BAR;
#undef PG8_SA
#undef PG8_SB
#undef PG8_STAGE
#undef PG8_LDA
#undef PG8_LDB
#undef PG8_MMA
#undef PG8_WAIT_V
#undef PG8_WAIT_L
#undef PG8_BAR
#undef PG8_SCHED
}
}

__device__ __forceinline__ unsigned f2bf(float f) { unsigned u = __builtin_bit_cast(unsigned, f); return (u + 0x7fffu + ((u >> 16) & 1u)) >> 16; }
__device__ __forceinline__ unsigned pk2(float lo, float hi) { return f2bf(lo) | (f2bf(hi) << 16); }
__device__ __forceinline__ float bflo(unsigned w) { return __builtin_bit_cast(float, w << 16); }
__device__ __forceinline__ float bfhi(unsigned w) { return __builtin_bit_cast(float, w & 0xffff0000u); }
__device__ __forceinline__ float fast_sigmoid(float t) { return __builtin_amdgcn_rcpf(1.0f + __builtin_amdgcn_exp2f(-1.44269504089f * t)); }
__device__ __forceinline__ float gelu_tanh(float x) { const float t = x * (1.5957691216f + 0.0713548163f * x * x); return x * fast_sigmoid(t); }
__device__ __forceinline__ float wave_sum(float v) {
#pragma unroll
    for (int o = 1; o < 64; o <<= 1) v += __shfl_xor(v, o);
    return v;
}
#define LDS_WAIT() asm volatile("s_waitcnt lgkmcnt(0)" ::: "memory")
#define VM_WAIT() asm volatile("s_waitcnt vmcnt(0)" ::: "memory")
#define RLX_AGENT __ATOMIC_RELAXED, __HIP_MEMORY_SCOPE_AGENT

constexpr size_t MiB = 1u << 20;
constexpr size_t WS_CTL = 0, CTL_ZERO_BYTES = 1 * MiB;
constexpr size_t WS_MOD   = 512 * 1024;
constexpr size_t WS_AT    = 1 * MiB + 128 * 1024;
constexpr size_t WS_STATS = WS_AT + 128 * 1024;
constexpr size_t WS_SCL   = 1 * MiB + 512 * 1024;
constexpr size_t WS_KEYS  = 2 * MiB;
constexpr size_t WS_GWS   = 3 * MiB;
constexpr size_t WS_WIN   = 4 * MiB;
constexpr size_t WS_GLU   = 28 * MiB;
constexpr size_t WS_WOUT  = 32 * MiB;
constexpr size_t WS_WQ    = 48 * MiB;
constexpr size_t WS_KTAB  = 64 * MiB;
constexpr size_t WS_WG    = 72 * MiB;
constexpr size_t WS_VG    = 104 * MiB;
constexpr size_t WS_UV    = 136 * MiB;
constexpr size_t WS_X     = 392 * MiB;
constexpr size_t WS_H     = 520 * MiB;
constexpr size_t WS_Z     = 584 * MiB;
constexpr size_t WS_XS    = 648 * MiB;
constexpr size_t WS_SLOC  = 680 * MiB;
constexpr size_t WS_HS    = 688 * MiB;
constexpr size_t WS_G     = 692 * MiB;
constexpr size_t WS_MIX   = 724 * MiB;
constexpr size_t WS_EID   = 788 * MiB;
constexpr size_t WS_GATE  = 796 * MiB;
constexpr size_t WS_SU    = 804 * MiB;
constexpr size_t WS_END   = 812 * MiB;
constexpr size_t WS_DBG   = 812 * MiB;
constexpr int CW_BAR = 4096;
constexpr int CW_FLAG = 2048;
constexpr int CW_QUEUE = 16384;

constexpr int LDS_BYTES = 163840;
constexpr int MISC_OFF = LDS_BYTES - 256;

#define XB_TMO      128
#define XB_XCNT(j)  (256  + 64 * (j))
#define XB_XSUB(j)  (1280 + 64 * (j))
#define XB_XGEN(j)  (2304 + 64 * (j))
#define XB_TOP      3328
#define XB_TOPGEN   3392
#define XCD_BAR_WORDS 3456
#define XB_SPIN_CAP (1u << 24)
__device__ __forceinline__ unsigned xb_ld(unsigned* p)              { return __hip_atomic_load(p, __ATOMIC_RELAXED, __HIP_MEMORY_SCOPE_AGENT); }
__device__ __forceinline__ unsigned xb_add(unsigned* p, unsigned v) { return __hip_atomic_fetch_add(p, v, __ATOMIC_RELAXED, __HIP_MEMORY_SCOPE_AGENT); }
__device__ __forceinline__ unsigned xb_xcc_id() { return (unsigned)__builtin_amdgcn_s_getreg((3 << 11) | 20) & 0xFu; }
#define XB_SPIN(cond, bar) do { unsigned _sp = 0; while (cond) { __builtin_amdgcn_s_sleep(1); \
    if ((++_sp & 255u) == 0u) { if (xb_ld(&(bar)[XB_TMO])) break; if (_sp > XB_SPIN_CAP) { atomicAdd(&(bar)[XB_TMO], 1u); break; } } } } while (0)
struct XcdBarrier { unsigned* bar; unsigned x; volatile LAS unsigned* st; };
__device__ __forceinline__ XcdBarrier xcd_barrier_post(unsigned* bar, volatile LAS unsigned* st) {
    XcdBarrier b; b.bar = bar; b.x = xb_xcc_id(); b.st = st;
    if (threadIdx.x == 0) (void)xb_add(&bar[XB_XCNT(b.x)], 1u);
    return b;
}
__device__ __forceinline__ void xcd_barrier_complete(unsigned* bar, unsigned x, unsigned& nloc, unsigned& nx) {
    const unsigned G = gridDim.x * gridDim.y * gridDim.z;
    unsigned sum, cnt, mine, sp = 0u;
    for (;;) {
        sum = 0u; cnt = 0u; mine = 0u;
#pragma unroll
        for (unsigned j = 0; j < 16; ++j) { const unsigned c = xb_ld(&bar[XB_XCNT(j)]); sum += c; cnt += (c > 0u) ? 1u : 0u; mine = (j == x) ? c : mine; }
        if (sum == G) break;
        __builtin_amdgcn_s_sleep(1);
        if ((++sp & 255u) == 0u) { if (xb_ld(&bar[XB_TMO])) break; if (sp > XB_SPIN_CAP) { atomicAdd(&bar[XB_TMO], 1u); break; } }
    }
    nloc = mine > 0u ? mine : 1u; nx = cnt > 0u ? cnt : 1u;
}
__device__ __forceinline__ void xcd_barrier(const XcdBarrier& b) {
    asm volatile("s_waitcnt vmcnt(0)" ::: "memory");
    __syncthreads();
    if (threadIdx.x == 0) {
        unsigned* bar = b.bar;
        __builtin_amdgcn_s_waitcnt(0);
        unsigned nloc = b.st[0], nx = b.st[1];
        if (nloc == 0u) { xcd_barrier_complete(bar, b.x, nloc, nx); b.st[0] = nloc; b.st[1] = nx; }
        const unsigned old = xb_add(&bar[XB_XSUB(b.x)], 1u);
        const unsigned gen = old / nloc;
        if (old + 1u == (gen + 1u) * nloc) {
            __builtin_amdgcn_fence(__ATOMIC_RELEASE, "agent");
            asm volatile("s_waitcnt vmcnt(0)" ::: "memory");
            const unsigned og = xb_add(&bar[XB_TOP], 1u);
            const unsigned tg = og / nx;
            if (og + 1u == (tg + 1u) * nx) xb_add(&bar[XB_TOPGEN], 1u);
            else XB_SPIN(xb_ld(&bar[XB_TOPGEN]) == tg, bar);
            __builtin_amdgcn_fence(__ATOMIC_ACQUIRE, "agent");
            xb_add(&bar[XB_XGEN(b.x)], 1u);
            asm volatile("s_waitcnt vmcnt(0)" ::: "memory");
        } else {
            XB_SPIN(xb_ld(&bar[XB_XGEN(b.x)]) == gen, bar);
            __builtin_amdgcn_fence(__ATOMIC_ACQUIRE, "agent");
            asm volatile("s_waitcnt vmcnt(0)" ::: "memory");
        }
    }
    __syncthreads();
}

struct Args { const float* in[29]; float* out; unsigned char* ws; int ph_lo, ph_hi, li, pad; };
enum { I_X = 0, I_C, I_WMOD, I_BMOD, I_N1G, I_WIN, I_BIN, I_LNG, I_LNB, I_GWS, I_GBS, I_LRE, I_LIM, I_LDT, I_BRE, I_BIM, I_CRE, I_CIM, I_SD, I_GLUW, I_GLUB,
       I_BRG, I_WOUT, I_N2G, I_WQ, I_KEYS, I_PU, I_PV, I_FG };

struct Frame {
    LAS unsigned char* lds;
    unsigned char* ws;
    const float* const* in;
    float* out;
    int tid, lane, wave, vcu, G;
};

#define PH_LOCALS int tid = F.tid; asm volatile("" : "+v"(tid)); const int lane = tid & 63; const int wave = __builtin_amdgcn_readfirstlane(tid >> 6); (void)lane; (void)wave;

struct EpiIn {
    static constexpr bool PERM = true, AFTER_DRAIN = false;
    bf16* Z; bf16* XS; const float* bias;
    __device__ __forceinline__ void operator()(const f32x4 (&acc)[2][2][4][2], const pg8::Unit& u, int wr, int wc, int fr, int fq) const {
        const int row0 = u.pm * 256 + wr * 64 + fr, col0 = u.pn * 256 + wc * 32 + 8 * fq;
        f32x4 bv[2][2];
#pragma unroll
        for (int bj = 0; bj < 2; ++bj)
#pragma unroll
            for (int n = 0; n < 2; ++n) bv[bj][n] = *(const f32x4*)(bias + col0 + bj * 128 + 4 * n);
        const bool isz = (u.pn < 8);
#pragma unroll
        for (int ai = 0; ai < 2; ++ai)
#pragma unroll
            for (int m = 0; m < 4; ++m) {
                const int r = row0 + ai * 128 + m * 16;
#pragma unroll
                for (int bj = 0; bj < 2; ++bj) {
                    f32x4 v0 = acc[ai][bj][m][0] + bv[bj][0], v1 = acc[ai][bj][m][1] + bv[bj][1];
                    const int c = col0 + bj * 128;
                    u32x4 w;
                    if (isz) {
                        w.x = pg8::cvt_pk_bf16(gelu_tanh(v0[0]), gelu_tanh(v0[1])); w.y = pg8::cvt_pk_bf16(gelu_tanh(v0[2]), gelu_tanh(v0[3]));
                        w.z = pg8::cvt_pk_bf16(gelu_tanh(v1[0]), gelu_tanh(v1[1])); w.w = pg8::cvt_pk_bf16(gelu_tanh(v1[2]), gelu_tanh(v1[3]));
                        *(u32x4*)(Z + (size_t)r * 2048 + c) = w;
                    } else {
                        w.x = pg8::cvt_pk_bf16(v0[0], v0[1]); w.y = pg8::cvt_pk_bf16(v0[2], v0[3]); w.z = pg8::cvt_pk_bf16(v1[0], v1[1]); w.w = pg8::cvt_pk_bf16(v1[2], v1[3]);
                        const int cc = c - 2048, g = cc >> 4, i = cc & 15;
                        *(u32x4*)(XS + ((size_t)(g * 256 + (r >> 6)) * 64 + (r & 63)) * 16 + i) = w;
                    }
                }
            }
    }
};
struct EpiGlu {
    static constexpr bool PERM = true, AFTER_DRAIN = false;
    const bf16* Gb; bf16* MIX; const float* bias;
    __device__ __forceinline__ void operator()(const f32x4 (&acc)[2][2][4][2], const pg8::Unit& u, int wr, int wc, int fr, int fq) const {
        const int row0 = u.pm * 256 + wr * 64 + fr, col0 = u.pn * 256 + wc * 32 + 8 * fq;
        f32x4 bv[2][2];
#pragma unroll
        for (int bj = 0; bj < 2; ++bj)
#pragma unroll
            for (int n = 0; n < 2; ++n) bv[bj][n] = *(const f32x4*)(bias + col0 + bj * 128 + 4 * n);
#pragma unroll
        for (int ai = 0; ai < 2; ++ai)
#pragma unroll
            for (int m = 0; m < 4; ++m) {
                const int r = row0 + ai * 128 + m * 16;
#pragma unroll
                for (int bj = 0; bj < 2; ++bj) {
                    const f32x4 v0 = acc[ai][bj][m][0] + bv[bj][0], v1 = acc[ai][bj][m][1] + bv[bj][1];
                    const int c = col0 + bj * 128;
                    const u32x4 gw = *(const u32x4*)(Gb + (size_t)r * 1024 + c);
                    u32x4 w;
                    w.x = pg8::cvt_pk_bf16(bflo(gw.x) * fast_sigmoid(v0[0]), bfhi(gw.x) * fast_sigmoid(v0[1]));
                    w.y = pg8::cvt_pk_bf16(bflo(gw.y) * fast_sigmoid(v0[2]), bfhi(gw.y) * fast_sigmoid(v0[3]));
                    w.z = pg8::cvt_pk_bf16(bflo(gw.z) * fast_sigmoid(v1[0]), bfhi(gw.z) * fast_sigmoid(v1[1]));
                    w.w = pg8::cvt_pk_bf16(bflo(gw.w) * fast_sigmoid(v1[2]), bfhi(gw.w) * fast_sigmoid(v1[3]));
                    *(u32x4*)(MIX + (size_t)r * 2048 + 1024 + c) = w;
                }
            }
    }
};
template <bool XIN_BF16> struct EpiOut {
    static constexpr bool PERM = true, AFTER_DRAIN = false;
    const void* xin; bf16* X; const float* gate;
    __device__ __forceinline__ void operator()(const f32x4 (&acc)[2][2][4][2], const pg8::Unit& u, int wr, int wc, int fr, int fq) const {
        const int row0 = u.pm * 256 + wr * 64 + fr, col0 = u.pn * 256 + wc * 32 + 8 * fq;
        f32x4 gv[2][2];
#pragma unroll
        for (int bj = 0; bj < 2; ++bj)
#pragma unroll
            for (int n = 0; n < 2; ++n) gv[bj][n] = *(const f32x4*)(gate + col0 + bj * 128 + 4 * n);
#pragma unroll
        for (int ai = 0; ai < 2; ++ai)
#pragma unroll
            for (int m = 0; m < 4; ++m) {
                const int r = row0 + ai * 128 + m * 16;
#pragma unroll
                for (int bj = 0; bj < 2; ++bj) {
                    const size_t off = (size_t)r * 2048 + col0 + bj * 128;
                    f32x4 x0, x1;
                    if (XIN_BF16) { const u32x4 w = *(const u32x4*)((const bf16*)xin + off); x0 = (f32x4){bflo(w.x), bfhi(w.x), bflo(w.y), bfhi(w.y)}; x1 = (f32x4){bflo(w.z), bfhi(w.z), bflo(w.w), bfhi(w.w)}; }
                    else { x0 = *(const f32x4*)((const float*)xin + off); x1 = *(const f32x4*)((const float*)xin + off + 4); }
                    const f32x4 y0 = x0 + gv[bj][0] * acc[ai][bj][m][0], y1 = x1 + gv[bj][1] * acc[ai][bj][m][1];
                    u32x4 o; o.x = pg8::cvt_pk_bf16(y0[0], y0[1]); o.y = pg8::cvt_pk_bf16(y0[2], y0[3]); o.z = pg8::cvt_pk_bf16(y1[0], y1[1]); o.w = pg8::cvt_pk_bf16(y1[2], y1[3]);
                    *(u32x4*)(X + off) = o;
                }
            }
    }
};
struct EpiQ {
    static constexpr bool PERM = true, AFTER_DRAIN = false;
    bf16* Q;
    __device__ __forceinline__ void operator()(const f32x4 (&acc)[2][2][4][2], const pg8::Unit& u, int wr, int wc, int fr, int fq) const {
        const int row0 = u.pm * 256 + wr * 64 + fr, col0 = u.pn * 256 + wc * 32 + 8 * fq;
#pragma unroll
        for (int ai = 0; ai < 2; ++ai)
#pragma unroll
            for (int m = 0; m < 4; ++m) {
                const int r = row0 + ai * 128 + m * 16;
#pragma unroll
                for (int bj = 0; bj < 2; ++bj) {
                    const f32x4 v0 = acc[ai][bj][m][0], v1 = acc[ai][bj][m][1];
                    u32x4 w; w.x = pg8::cvt_pk_bf16(v0[0], v0[1]); w.y = pg8::cvt_pk_bf16(v0[2], v0[3]); w.z = pg8::cvt_pk_bf16(v1[0], v1[1]); w.w = pg8::cvt_pk_bf16(v1[2], v1[3]);
                    *(u32x4*)(Q + (size_t)r * 2048 + col0 + bj * 128) = w;
                }
            }
    }
};

__device__ __forceinline__ void p0_transpose_item(const float* W, int K, int N, bf16* WT, const float* kscale, LAS float* scr, int item, int lane) {
    const int nblk = N / 32, kb = item / nblk, nb = item % nblk, k0 = 64 * kb, n0 = 32 * nb;
#pragma unroll 8
    for (int i = 0; i < 32; ++i) { const int kk = 2 * i + (lane >> 5); float v = W[(size_t)(k0 + kk) * N + n0 + (lane & 31)]; if (kscale) v *= kscale[k0 + kk]; scr[kk * 33 + (lane & 31)] = v; }
    LDS_WAIT(); asm volatile("" ::: "memory");
    const int c = lane & 7;
#pragma unroll
    for (int j = 0; j < 4; ++j) { const int n = (lane >> 3) + 8 * j; const LAS float* s = scr + (8 * c) * 33 + n;
        u32x4 o; o.x = pk2(s[0 * 33], s[1 * 33]); o.y = pk2(s[2 * 33], s[3 * 33]); o.z = pk2(s[4 * 33], s[5 * 33]); o.w = pk2(s[6 * 33], s[7 * 33]);
        *(u32x4*)(WT + (size_t)(n0 + n) * K + k0 + 8 * c) = o; }
    LDS_WAIT(); asm volatile("" ::: "memory");
}

__device__ __forceinline__ void norm_mod_row(const f32x4 (&v)[4][2], const float* gain, const float* scale, const float* shift, int lane, u32x4 (&o)[4]) {
    float s = 0.f;
#pragma unroll
    for (int j = 0; j < 4; ++j)
#pragma unroll
        for (int h = 0; h < 2; ++h) s += (v[j][h][0] * v[j][h][0] + v[j][h][1] * v[j][h][1]) + (v[j][h][2] * v[j][h][2] + v[j][h][3] * v[j][h][3]);
    const float rr = 1.0f / sqrtf(wave_sum(s) * (1.0f / DM) + EPS);
#pragma unroll
    for (int j = 0; j < 4; ++j) {
        const int c = j * 512 + lane * 8;
        f32x4 y[2];
#pragma unroll
        for (int h = 0; h < 2; ++h) {
            const f32x4 g = *(const f32x4*)(gain + c + 4 * h);
            y[h] = v[j][h] * rr * g;
            const f32x4 sc = *(const f32x4*)(scale + c + 4 * h), sh = *(const f32x4*)(shift + c + 4 * h); y[h] = y[h] * (sc + 1.0f) + sh;
        }
        o[j].x = pk2(y[0][0], y[0][1]); o[j].y = pk2(y[0][2], y[0][3]); o[j].z = pk2(y[1][0], y[1][1]); o[j].w = pk2(y[1][2], y[1][3]);
    }
}
template <bool SRC_BF16>
__device__ __forceinline__ void norm_row_pass(const void* xrow_, bf16* hrow, const float* gain, const float* scale, const float* shift, int lane) {
    f32x4 v[4][2];
#pragma unroll
    for (int j = 0; j < 4; ++j) {
        if (SRC_BF16) { const u32x4 w = *(const u32x4*)((const bf16*)xrow_ + j * 512 + lane * 8); v[j][0] = (f32x4){bflo(w.x), bfhi(w.x), bflo(w.y), bfhi(w.y)}; v[j][1] = (f32x4){bflo(w.z), bfhi(w.z), bflo(w.w), bfhi(w.w)}; }
        else { const float* xrow = (const float*)xrow_; v[j][0] = *(const f32x4*)(xrow + j * 512 + lane * 8); v[j][1] = *(const f32x4*)(xrow + j * 512 + lane * 8 + 4); } }
    u32x4 o[4]; norm_mod_row(v, gain, scale, shift, lane, o);
#pragma unroll
    for (int j = 0; j < 4; ++j) *(u32x4*)(hrow + j * 512 + lane * 8) = o[j];
}

__device__ __forceinline__ void p0_gemv_unit(Frame& F, int unit, int tid, float* modout) {
    const int l = unit / 192, r = unit % 192, cb = r >> 1, kh = r & 1;
    LAS float* sc = (LAS float*)F.lds;
    LAS float* red = (LAS float*)(F.lds + 4096);
    for (int k = tid; k < 1024; k += NTHR) { const float c = F.in[I_C][kh * 1024 + k]; sc[k] = c * fast_sigmoid(c); }
    __syncthreads();
    const int tx = tid & 31, ty = tid >> 5;
    const float* W = F.in[I_WMOD] + ((size_t)l * DM + kh * 1024) * 12288 + cb * 128 + tx * 4;
    f32x4 a = {0.f, 0.f, 0.f, 0.f};
#pragma unroll 16
    for (int k = ty; k < 1024; k += 16) { const f32x4 w = *(const f32x4*)(W + (size_t)k * 12288); a += w * sc[k]; }
    *(LAS f32x4*)(red + ty * 128 + tx * 4) = a;
    __syncthreads();
    if (tid < 128) { float s = 0.f;
#pragma unroll
        for (int y = 0; y < 16; ++y) s += red[y * 128 + tid];
        if (kh == 0) s += F.in[I_BMOD][l * 12288 + cb * 128 + tid];
        atomicAdd(modout + l * 12288 + cb * 128 + tid, s); }
    __syncthreads();
}
__device__ __forceinline__ void p0_s5_unit(Frame& F, int unit, int tid, int parts = 15) {
    const int l = unit >> 7, g = (unit >> 1) & 63, hf = unit & 1;
    LAS float* apr = (LAS float*)F.lds;
    LAS float* api = apr + 4228;
    LAS float* bbr = api + 4228;
    LAS float* bbi = bbr + 1024;
    LAS float* ccr = bbi + 1024;
    LAS float* cci = ccr + 16 * 65;
    const float dt = expf(F.in[I_LDT][l * 64 + g]);
    const float* lre = F.in[I_LRE] + (l * 64 + g) * 64; const float* lim = F.in[I_LIM] + (l * 64 + g) * 64;
    for (int idx = tid; idx < 65 * 64; idx += NTHR) { const int d = idx >> 6, p = idx & 63;
        const float mag = expf(lre[p] * dt * (float)d); float sn, cs; sincosf(lim[p] * dt * (float)d, &sn, &cs);
        apr[d * 65 + p] = mag * cs; api[d * 65 + p] = mag * sn; }
    for (int idx = tid; idx < 1024; idx += NTHR) { const int o = idx >> 6, p = idx & 63;
        ccr[o * 65 + p] = F.in[I_CRE][((size_t)(l * 64 + g) * 16 + o) * 64 + p]; cci[o * 65 + p] = F.in[I_CIM][((size_t)(l * 64 + g) * 16 + o) * 64 + p]; }
    __syncthreads();
    for (int idx = tid; idx < 1024; idx += NTHR) { const int p = idx >> 4, i = idx & 15;
        const float xr = apr[65 + p] - 1.0f, xi = api[65 + p], lr = lre[p], li = lim[p], den = 1.0f / (lr * lr + li * li);
        const float cr = (xr * lr + xi * li) * den, ci = (xi * lr - xr * li) * den;
        const float br = F.in[I_BRE][((size_t)(l * 64 + g) * 64 + p) * 16 + i], bi = F.in[I_BIM][((size_t)(l * 64 + g) * 64 + p) * 16 + i];
        bbr[idx] = cr * br - ci * bi; bbi[idx] = cr * bi + ci * br; }
    __syncthreads();
    bf16* KT = (bf16*)(F.ws + WS_KTAB) + (size_t)(l * 64 + g) * 80 * 256;
    if (parts & 1) {
        const int d = hf * 32 + (tid >> 4), o = tid & 15;
        const float dskip = F.in[I_SD][l * 1024 + g * 16 + o];
        float s[16];
#pragma unroll
        for (int i = 0; i < 16; ++i) s[i] = 0.f;
        for (int p = 0; p < 64; ++p) { const float ar = apr[d * 65 + p], ai = api[d * 65 + p], cr = ccr[o * 65 + p], ci = cci[o * 65 + p];
            const float er = cr * ar - ci * ai, ei = cr * ai + ci * ar;
#pragma unroll
            for (int q = 0; q < 4; ++q) { const f32x4 br = *(const LAS f32x4*)(bbr + p * 16 + 4 * q), bi = *(const LAS f32x4*)(bbi + p * 16 + 4 * q);
#pragma unroll
                for (int e = 0; e < 4; ++e) s[4 * q + e] += er * br[e] - ei * bi[e]; } }
#if !SELFTEST_S5
        {   const float dsk = (d == 0) ? dskip : 0.f;
#pragma unroll
            for (int i = 0; i < 16; ++i) s[i] += (i == o) ? dsk : 0.f; }
#endif
        u32x4 w0, w1;
        w0.x = pk2(s[0], s[1]); w0.y = pk2(s[2], s[3]); w0.z = pk2(s[4], s[5]); w0.w = pk2(s[6], s[7]);
        w1.x = pk2(s[8], s[9]); w1.y = pk2(s[10], s[11]); w1.z = pk2(s[12], s[13]); w1.w = pk2(s[14], s[15]);
        if ((parts & 8) || w0.x == 0x12345678u) { *(u32x4*)(KT + (size_t)(d + 16) * 256 + o * 16) = w0; *(u32x4*)(KT + (size_t)(d + 16) * 256 + o * 16 + 8) = w1; }
        if ((parts & 8) && hf == 0 && tid < 256) { const u32x4 z = {0u, 0u, 0u, 0u}; *(u32x4*)(KT + tid * 16) = z; *(u32x4*)(KT + tid * 16 + 8) = z; }
    }
    bf16* WG = (bf16*)(F.ws + WS_WG) + (size_t)(l * 64 + g) * 128 * 1024;
    if (parts & 2) for (int it = tid; it < 32 * 64; it += NTHR) { const int p = hf * 32 + (it >> 6), tau = it & 63;
        const float ar = apr[(63 - tau) * 65 + p], ai = api[(63 - tau) * 65 + p];
        unsigned wr_[8], wi_[8];
#pragma unroll
        for (int q = 0; q < 4; ++q) { const f32x4 br = *(const LAS f32x4*)(bbr + p * 16 + 4 * q), bi = *(const LAS f32x4*)(bbi + p * 16 + 4 * q);
            wr_[2 * q] = pk2(ar * br[0] - ai * bi[0], ar * br[1] - ai * bi[1]); wr_[2 * q + 1] = pk2(ar * br[2] - ai * bi[2], ar * br[3] - ai * bi[3]);
            wi_[2 * q] = pk2(ar * bi[0] + ai * br[0], ar * bi[1] + ai * br[1]); wi_[2 * q + 1] = pk2(ar * bi[2] + ai * br[2], ar * bi[3] + ai * br[3]); }
        *(u32x4*)(WG + (size_t)p * 1024 + tau * 16) = (u32x4){wr_[0], wr_[1], wr_[2], wr_[3]}; *(u32x4*)(WG + (size_t)p * 1024 + tau * 16 + 8) = (u32x4){wr_[4], wr_[5], wr_[6], wr_[7]};
        *(u32x4*)(WG + (size_t)(64 + p) * 1024 + tau * 16) = (u32x4){wi_[0], wi_[1], wi_[2], wi_[3]}; *(u32x4*)(WG + (size_t)(64 + p) * 1024 + tau * 16 + 8) = (u32x4){wi_[4], wi_[5], wi_[6], wi_[7]}; }
    bf16* VG = (bf16*)(F.ws + WS_VG) + (size_t)(l * 64 + g) * 1024 * 128;
    if (parts & 4) for (int it = tid; it < 512 * 8; it += NTHR) { const int m = hf * 512 + (it >> 3), p0 = (it & 7) * 8, t = m >> 4, o = m & 15;
        float vr_[8], vi_[8];
#pragma unroll
        for (int e = 0; e < 8; ++e) { const float ar = apr[(t + 1) * 65 + p0 + e], ai = api[(t + 1) * 65 + p0 + e], cr = ccr[o * 65 + p0 + e], ci = cci[o * 65 + p0 + e];
            vr_[e] = cr * ar - ci * ai; vi_[e] = -(cr * ai + ci * ar); }
        *(u32x4*)(VG + (size_t)m * 128 + p0) = (u32x4){pk2(vr_[0], vr_[1]), pk2(vr_[2], vr_[3]), pk2(vr_[4], vr_[5]), pk2(vr_[6], vr_[7])};
        *(u32x4*)(VG + (size_t)m * 128 + 64 + p0) = (u32x4){pk2(vi_[0], vi_[1]), pk2(vi_[2], vi_[3]), pk2(vi_[4], vi_[5]), pk2(vi_[6], vi_[7])}; }
    if (hf == 0 && tid < 64) { float* AT = (float*)(F.ws + WS_AT) + ((size_t)(l * 64 + g) * 64 + tid) * 2; AT[0] = apr[64 * 65 + tid]; AT[1] = api[64 * 65 + tid]; }
    __syncthreads();
}
__device__ __forceinline__ void p0_fp4_chunk(Frame& F, int chunk, int wave, int lane) {
    unsigned char* UV = F.ws + WS_UV; float* SCL = (float*)(F.ws + WS_SCL);
    for (int i = 0; i < 8; ++i) {
        const int r = chunk * 64 + wave * 8 + i;
        const int tbl = r >> 15, rr = r & 32767;
        const float* srcp = (tbl ? F.in[I_PV] : F.in[I_PU]) + (size_t)rr * 2048 + lane * 4;
        f32x4 v[8]; float am = 0.f;
#pragma unroll
        for (int j = 0; j < 8; ++j) { v[j] = *(const f32x4*)(srcp + j * 256); am = fmaxf(am, fmaxf(fmaxf(fabsf(v[j][0]), fabsf(v[j][1])), fmaxf(fabsf(v[j][2]), fabsf(v[j][3])))); }
#pragma unroll
        for (int o = 1; o < 64; o <<= 1) am = fmaxf(am, __shfl_xor(am, o));
        const float scale = am > 0.f ? am * (1.0f / 6.0f) : 1.0f, inv = am > 0.f ? 6.0f / am : 1.0f;
        u32x4 o;
#pragma unroll
        for (int d = 0; d < 4; ++d) { unsigned w = 0u;
            w = __builtin_amdgcn_cvt_scalef32_pk_fp4_f32(w, v[2 * d][0] * inv, v[2 * d][1] * inv, 1.0f, 0);
            w = __builtin_amdgcn_cvt_scalef32_pk_fp4_f32(w, v[2 * d][2] * inv, v[2 * d][3] * inv, 1.0f, 1);
            w = __builtin_amdgcn_cvt_scalef32_pk_fp4_f32(w, v[2 * d + 1][0] * inv, v[2 * d + 1][1] * inv, 1.0f, 2);
            w = __builtin_amdgcn_cvt_scalef32_pk_fp4_f32(w, v[2 * d + 1][2] * inv, v[2 * d + 1][3] * inv, 1.0f, 3);
            o[d] = w; }
        *(u32x4*)(UV + (size_t)rr * 2048 + tbl * 1024 + lane * 16) = o;
        if (lane == 0) SCL[rr * 2 + tbl] = scale;
    }
}
#ifndef P0_PARTS
#define P0_PARTS 15
#endif
#ifndef P0_PROBE_MODE
#define P0_PROBE_MODE 0
#endif
__device__ __forceinline__ void p0_tables(Frame& F, int qi = 4, bool dummy = false) {
    PH_LOCALS
    unsigned* head = (unsigned*)(F.ws + WS_CTL) + CW_QUEUE + 64 * qi;
    float* modout = dummy ? (float*)(F.ws + WS_DBG) : (float*)(F.ws + WS_MOD);
    LAS unsigned* slot = (LAS unsigned*)(F.lds + MISC_OFF) + 16;
    for (;;) {
        __syncthreads();
        if (tid == 0) slot[0] = __hip_atomic_fetch_add(head, 1u, RLX_AGENT);
        __syncthreads();
        const unsigned u = slot[0];
        if (u >= 1664u) break;
        const int rnd = (int)u / 13, k = (int)u % 13;
        if (k < 2) { if (dummy && P0_PROBE_MODE == 2) continue; p0_s5_unit(F, rnd * 2 + k, tid, dummy ? P0_PARTS : 15); }
        else if (k < 5) { if (dummy && P0_PROBE_MODE == 1) continue; p0_gemv_unit(F, rnd * 3 + (k - 2), tid, modout); }
        else { p0_fp4_chunk(F, rnd * 8 + (k - 5), wave, lane); }
    }
}
__device__ __forceinline__ void p0_prologue(Frame& F) {
    PH_LOCALS
    const int gw = F.vcu * NWAVES + wave, NGW = F.G * NWAVES;
    const int gt = F.vcu * NTHR + tid, NGT = F.G * NTHR;
    {
        LAS float* scr = (LAS float*)(F.lds + wave * 16384);
        constexpr int I_IN = (DM / 64) * (INW / 32), I_GL = (WB / 64) * (WB / 32), I_OU = (DM / 64) * (DM / 32), I_Q = I_OU;
        constexpr int PER_L = I_IN + I_GL + I_OU + I_Q;
        for (int it = gw; it < 2 * PER_L; it += NGW) {
            const int l = it / PER_L; int r = it % PER_L;
            if (r < I_IN) { p0_transpose_item(F.in[I_WIN] + (size_t)l * DM * INW, DM, INW, (bf16*)(F.ws + WS_WIN) + (size_t)l * INW * DM, nullptr, scr, r, lane); continue; } r -= I_IN;
            if (r < I_GL) { p0_transpose_item(F.in[I_GLUW] + (size_t)l * WB * WB, WB, WB, (bf16*)(F.ws + WS_GLU) + (size_t)l * WB * WB, nullptr, scr, r, lane); continue; } r -= I_GL;
            if (r < I_OU) { p0_transpose_item(F.in[I_WOUT] + (size_t)l * DM * DM, DM, DM, (bf16*)(F.ws + WS_WOUT) + (size_t)l * DM * DM, F.in[I_BRG] + l * DM, scr, r, lane); continue; } r -= I_OU;
            p0_transpose_item(F.in[I_WQ] + (size_t)l * DM * DM, DM, DM, (bf16*)(F.ws + WS_WQ) + (size_t)l * DM * DM, nullptr, scr, r, lane);
        }
    }
    {
        bf16* KB = (bf16*)(F.ws + WS_KEYS);
        for (int i = gt; i < 2 * 8 * 2 * 128 * 128 / 8; i += NGT) { const f32x4 a = *(const f32x4*)(F.in[I_KEYS] + (size_t)i * 8), b = *(const f32x4*)(F.in[I_KEYS] + (size_t)i * 8 + 4);
            u32x4 o; o.x = pk2(a[0], a[1]); o.y = pk2(a[2], a[3]); o.z = pk2(b[0], b[1]); o.w = pk2(b[2], b[3]); *(u32x4*)(KB + (size_t)i * 8) = o; }
        bf16* GW = (bf16*)(F.ws + WS_GWS);
        for (int i = gt; i < 2 * 8 * 128 * 128 / 8; i += NGT) { const int e = i * 8, jj = e & 127, ii = (e >> 7) & 127; const bool keep = (ii >= 64) || (jj < 64);
            f32x4 a = *(const f32x4*)(F.in[I_GWS] + (size_t)i * 8), b = *(const f32x4*)(F.in[I_GWS] + (size_t)i * 8 + 4);
            if (!keep) { a = (f32x4){0.f, 0.f, 0.f, 0.f}; b = a; }
            u32x4 o; o.x = pk2(a[0], a[1]); o.y = pk2(a[2], a[3]); o.z = pk2(b[0], b[1]); o.w = pk2(b[2], b[3]); *(u32x4*)(GW + (size_t)i * 8) = o; }
    }
}

template <bool SRC_BF16>
__device__ __forceinline__ void phase_norm(Frame& F, const void* xsrc, const float* gain, const float* scale, const float* shift) {
    PH_LOCALS
    const int gw = F.vcu * NWAVES + wave, NGW = F.G * NWAVES;
    bf16* H = (bf16*)(F.ws + WS_H);
    for (int m = gw; m < M; m += NGW) norm_row_pass<SRC_BF16>((const char*)xsrc + (size_t)m * DM * (SRC_BF16 ? 2 : 4), H + (size_t)m * DM, gain, scale, shift, lane);
}
__device__ __forceinline__ void phase_lnstats(Frame& F) {
    PH_LOCALS
    const int gw = F.vcu * NWAVES + wave, NGW = F.G * NWAVES;
    const bf16* Z = (const bf16*)(F.ws + WS_Z); float* ST = (float*)(F.ws + WS_STATS);
    for (int m = gw; m < M; m += NGW) {
        float v[16];
#pragma unroll
        for (int j = 0; j < 2; ++j) { const u32x4 w = *(const u32x4*)(Z + (size_t)m * 2048 + 1024 + j * 512 + lane * 8);
            v[j * 8 + 0] = bflo(w.x); v[j * 8 + 1] = bfhi(w.x); v[j * 8 + 2] = bflo(w.y); v[j * 8 + 3] = bfhi(w.y); v[j * 8 + 4] = bflo(w.z); v[j * 8 + 5] = bfhi(w.z); v[j * 8 + 6] = bflo(w.w); v[j * 8 + 7] = bfhi(w.w); }
        float s = 0.f;
#pragma unroll
        for (int i = 0; i < 16; ++i) s += v[i];
        const float mean = wave_sum(s) * (1.0f / 1024.0f); float q = 0.f;
#pragma unroll
        for (int i = 0; i < 16; ++i) { const float d = v[i] - mean; q += d * d; }
        const float rstd = 1.0f / sqrtf(wave_sum(q) * (1.0f / 1024.0f) + EPS);
        if (lane == 0) { ST[2 * m] = mean; ST[2 * m + 1] = rstd; }
    }
}
__device__ __forceinline__ void phase_branchnorm(Frame& F) {
    PH_LOCALS
    const int gw = F.vcu * NWAVES + wave, NGW = F.G * NWAVES;
    bf16* MIX = (bf16*)(F.ws + WS_MIX);
    for (int m = gw; m < M; m += NGW) {
        u32x4 w[4]; float sa = 0.f, sb = 0.f;
#pragma unroll
        for (int j = 0; j < 4; ++j) { w[j] = *(const u32x4*)(MIX + (size_t)m * 2048 + j * 512 + lane * 8);
            float q = 0.f;
#pragma unroll
            for (int e = 0; e < 4; ++e) { const float a = bflo(w[j][e]), b = bfhi(w[j][e]); q += a * a + b * b; }
            if (j < 2) sa += q; else sb += q; }
        const float ra = 1.0f / sqrtf(wave_sum(sa) * (1.0f / 1024.0f) + EPS), rb = 1.0f / sqrtf(wave_sum(sb) * (1.0f / 1024.0f) + EPS);
#pragma unroll
        for (int j = 0; j < 4; ++j) { const float r = j < 2 ? ra : rb; u32x4 o;
#pragma unroll
            for (int e = 0; e < 4; ++e) o[e] = pk2(bflo(w[j][e]) * r, bfhi(w[j][e]) * r);
            *(u32x4*)(MIX + (size_t)m * 2048 + j * 512 + lane * 8) = o; }
    }
}

__device__ __forceinline__ void phase_sloc(Frame& F, int l) {
    PH_LOCALS
    const bf16* XS = (const bf16*)(F.ws + WS_XS); const bf16* WG = (const bf16*)(F.ws + WS_WG) + (size_t)l * 64 * 128 * 1024; float* SL = (float*)(F.ws + WS_SLOC);
    const int fr = lane & 15, fq = lane >> 4;
    for (int u = F.vcu; u < 256; u += F.G) {
        const int g = u >> 2, n0 = (u & 3) * 64 + (wave & 3) * 16, jh = wave >> 2;
        f32x4 acc[4];
#pragma unroll
        for (int t = 0; t < 4; ++t) acc[t] = (f32x4){0.f, 0.f, 0.f, 0.f};
        const bf16* xp = XS + ((size_t)(g * 256 + n0 + fr)) * 1024 + 8 * fq;
        const bf16* wp = WG + ((size_t)(g * 128 + jh * 64 + fr)) * 1024 + 8 * fq;
#pragma unroll 8
        for (int kb = 0; kb < 32; ++kb) {
            const bf16x8 xf = *(const bf16x8*)(xp + kb * 32);
#pragma unroll
            for (int t = 0; t < 4; ++t) { const bf16x8 wf = *(const bf16x8*)(wp + (size_t)t * 16 * 1024 + kb * 32); acc[t] = __builtin_amdgcn_mfma_f32_16x16x32_bf16(wf, xf, acc[t], 0, 0, 0); }
        }
#pragma unroll
        for (int t = 0; t < 4; ++t) *(f32x4*)(SL + ((size_t)(g * 256 + n0 + fr)) * 128 + jh * 64 + t * 16 + 4 * fq) = acc[t];
    }
}
__device__ __forceinline__ void s5_carry(Frame& F, int l) {
    PH_LOCALS
    if (F.vcu < 64 && wave == 0) {
        const int g = F.vcu, p = lane;
        const float* AT = (const float*)(F.ws + WS_AT) + ((size_t)(l * 64 + g) * 64 + p) * 2; const float ar = AT[0], ai = AT[1];
        const float* SL = (const float*)(F.ws + WS_SLOC) + (size_t)g * 256 * 128; bf16* HS = (bf16*)(F.ws + WS_HS) + (size_t)g * 256 * 128;
        float hr = 0.f, hi = 0.f;
        for (int n0 = 0; n0 < 256; n0 += 8) {
            float sr[8], si[8];
#pragma unroll
            for (int e = 0; e < 8; ++e) { sr[e] = SL[(size_t)(n0 + e) * 128 + p]; si[e] = SL[(size_t)(n0 + e) * 128 + 64 + p]; }
#pragma unroll
            for (int e = 0; e < 8; ++e) { HS[(size_t)(n0 + e) * 128 + p] = (bf16)f2bf(hr); HS[(size_t)(n0 + e) * 128 + 64 + p] = (bf16)f2bf(hi);
                const float nr = ar * hr - ai * hi + sr[e], ni = ar * hi + ai * hr + si[e]; hr = nr; hi = ni; }
        }
    }
}

__device__ __forceinline__ void gating_unit(Frame& F, int l, int unit) {
    PH_LOCALS
    const int nb = unit >> 3, hh = unit & 7, t0 = nb * 128, c0 = hh * 128;
    const bf16* Z = (const bf16*)(F.ws + WS_Z); const float* ST = (const float*)(F.ws + WS_STATS);
    const bf16* GW = (const bf16*)(F.ws + WS_GWS) + (size_t)(l * 8 + hh) * 128 * 128;
    bf16* MIX = (bf16*)(F.ws + WS_MIX);
    LAS bf16* VT = (LAS bf16*)F.lds;
    constexpr int VS = 136;
    {
        const int j = tid >> 2, cs = (tid & 3) * 32;
        const float mu = ST[2 * (t0 + j)], rs = ST[2 * (t0 + j) + 1];
        const float* lg = F.in[I_LNG] + l * 1024 + c0 + cs; const float* lb = F.in[I_LNB] + l * 1024 + c0 + cs;
#pragma unroll
        for (int q = 0; q < 4; ++q) {
            const u32x4 w = *(const u32x4*)(Z + (size_t)(t0 + j) * 2048 + 1024 + c0 + cs + q * 8);
#pragma unroll
            for (int e = 0; e < 4; ++e) { const int c = cs + q * 8 + 2 * e;
                const float a = (bflo(w[e]) - mu) * rs * lg[q * 8 + 2 * e] + lb[q * 8 + 2 * e], b = (bfhi(w[e]) - mu) * rs * lg[q * 8 + 2 * e + 1] + lb[q * 8 + 2 * e + 1];
                VT[c * VS + j] = (bf16)f2bf(a); VT[(c + 1) * VS + j] = (bf16)f2bf(b); }
        }
    }
    __syncthreads();
    {
        const int fr = lane & 15, fq = lane >> 4, w = wave;
        f32x4 acc[8];
#pragma unroll
        for (int ct = 0; ct < 8; ++ct) acc[ct] = (f32x4){0.f, 0.f, 0.f, 0.f};
        const int nkb = (w < 4) ? 2 : 4;
        for (int kb = 0; kb < nkb; ++kb) {
            const bf16x8 wf = *(const bf16x8*)(GW + (size_t)(16 * w + fr) * 128 + kb * 32 + 8 * fq);
#pragma unroll
            for (int ct = 0; ct < 8; ++ct) { const bf16x8 vf = *(const LAS bf16x8*)(VT + (ct * 16 + fr) * VS + kb * 32 + 8 * fq); acc[ct] = __builtin_amdgcn_mfma_f32_16x16x32_bf16(vf, wf, acc[ct], 0, 0, 0); }
        }
        const int tok = t0 + 16 * w + fr; const float bs = F.in[I_GBS][(l * 8 + hh) * 128 + 16 * w + fr];
#pragma unroll
        for (int ct = 0; ct < 8; ++ct) { const int c = c0 + ct * 16 + 4 * fq;
            const u32x2 uw = *(const u32x2*)(Z + (size_t)tok * 2048 + c);
            u32x2 o; o.x = pk2(bflo(uw.x) * (acc[ct][0] + bs), bfhi(uw.x) * (acc[ct][1] + bs)); o.y = pk2(bflo(uw.y) * (acc[ct][2] + bs), bfhi(uw.y) * (acc[ct][3] + bs));
            *(u32x2*)(MIX + (size_t)tok * 2048 + c) = o; }
    }
    __syncthreads();
}
__device__ __forceinline__ void phase_carry_gating(Frame& F, int l, int qi) {
    PH_LOCALS
    s5_carry(F, l);
    unsigned* head = (unsigned*)(F.ws + WS_CTL) + CW_QUEUE + 64 * qi;
    LAS unsigned* slot = (LAS unsigned*)(F.lds + MISC_OFF) + 16;
    for (;;) {
        __syncthreads();
        if (tid == 0) slot[0] = __hip_atomic_fetch_add(head, 1u, RLX_AGENT);
        __syncthreads();
        const unsigned u = slot[0];
        if (u >= 1024u) break;
        gating_unit(F, l, (int)u);
    }
}

__device__ __forceinline__ void phase_s5out(Frame& F, int l) {
    PH_LOCALS
    const bf16* XS = (const bf16*)(F.ws + WS_XS); const bf16* HS = (const bf16*)(F.ws + WS_HS);
    bf16* Gb = (bf16*)(F.ws + WS_G);
    LAS unsigned char* KT = F.lds + 32768;
    LAS unsigned char* VT = F.lds + 73728;
    const int fr = lane & 15, fq = lane >> 4;
    for (int u = F.vcu; u < 512; u += F.G) {
        const int g = u >> 3, rc = (u >> 1) & 3, nh = u & 1;
        const bf16* VG = (const bf16*)(F.ws + WS_VG) + (size_t)(l * 64 + g) * 1024 * 128;
        const int n = nh * 128 + 16 * wave + fr;
        const bf16* xp0 = XS + ((size_t)(g * 256 + n)) * 1024 + 8 * fq;
        const bf16* hp0 = HS + ((size_t)(g * 256 + n)) * 128 + 8 * fq;
        bf16x8 xa[4], xb[4];
#pragma unroll
        for (int i = 0; i < 4; ++i) xa[i] = *(const bf16x8*)(xp0 + i * 32);
        __syncthreads();
        { const u32x4* src = (const u32x4*)((const bf16*)(F.ws + WS_KTAB) + (size_t)(l * 64 + g) * 80 * 256);
          for (int i = tid; i < 80 * 256 / 8; i += NTHR) ((LAS u32x4*)KT)[i] = src[i];
#pragma unroll
          for (int ps = 0; ps < 8; ++ps) { const int row = ps * 32 + (tid >> 4), c = tid & 15, q = row >> 4, o = row & 15;
              *(LAS u32x4*)(VT + row * 272 + c * 16) = *(const u32x4*)(VG + (size_t)((rc + 4 * q) * 16 + o) * 128 + c * 8); } }
        __syncthreads();
        f32x4 acc[16];
#pragma unroll
        for (int q = 0; q < 16; ++q) acc[q] = (f32x4){0.f, 0.f, 0.f, 0.f};
        const int kb0 = ((rc - (fq >> 1) + 10) * 16 + fr) * 32 + 16 * (fq & 1);
#define S5_GROUP(XF, grp_) do { const LAS unsigned char* kp = KT + kb0 - (grp_) * 4096; \
            _Pragma("unroll") for (int q = 0; q < 16; ++q) { if (rc + 4 * q >= 8 * (grp_)) { \
                _Pragma("unroll") for (int i = 0; i < 4; ++i) { const bf16x8 kf = *(const LAS bf16x8*)(kp + (4 * q - 2 * i + 6) * 512); \
                    acc[q] = __builtin_amdgcn_mfma_f32_16x16x32_bf16(kf, XF[i], acc[q], 0, 0, 0); } } } } while (0)
#pragma unroll 1
        for (int gp = 0; gp < 4; ++gp) {
#pragma unroll
            for (int i = 0; i < 4; ++i) xb[i] = *(const bf16x8*)(xp0 + ((2 * gp + 1) * 4 + i) * 32);
            S5_GROUP(xa, 2 * gp);
            if (gp < 3) {
#pragma unroll
                for (int i = 0; i < 4; ++i) xa[i] = *(const bf16x8*)(xp0 + ((2 * gp + 2) * 4 + i) * 32);
            }
            S5_GROUP(xb, 2 * gp + 1);
        }
#undef S5_GROUP
#pragma unroll 1
        for (int jb = 0; jb < 4; ++jb) {
            const bf16x8 hf = *(const bf16x8*)(hp0 + jb * 32);
#pragma unroll
            for (int q = 0; q < 16; ++q) {
                const bf16x8 vf = *(const LAS bf16x8*)(VT + (q * 16 + fr) * 272 + (jb * 32 + 8 * fq) * 2);
                acc[q] = __builtin_amdgcn_mfma_f32_16x16x32_bf16(vf, hf, acc[q], 0, 0, 0);
            }
        }
#pragma unroll
        for (int q = 0; q < 16; ++q) {
            const int t = rc + 4 * q, tok = 64 * n + t;
            const f32x4 y = acc[q];
            u32x2 o; o.x = pk2(gelu_tanh(y[0]), gelu_tanh(y[1])); o.y = pk2(gelu_tanh(y[2]), gelu_tanh(y[3]));
            *(u32x2*)(Gb + (size_t)tok * 1024 + g * 16 + 4 * fq) = o;
#if SELFTEST_S5
            if (tok < 256) *(f32x4*)((float*)(F.ws + WS_DBG) + (size_t)tok * 1024 + g * 16 + 4 * fq) = y;
#endif
        }
    }
}
#if SELFTEST_S5
__device__ __forceinline__ void selftest_s5(Frame& F, int l) {
    PH_LOCALS
    if (F.vcu < 64 && wave == 0) {
        const int g = F.vcu, p = lane;
        const float dt = expf(F.in[I_LDT][l * 64 + g]);
        const float lr = F.in[I_LRE][(l * 64 + g) * 64 + p], li = F.in[I_LIM][(l * 64 + g) * 64 + p];
        const float mag = expf(lr * dt); float sn, cs; sincosf(li * dt, &sn, &cs);
        const float ar = mag * cs, ai = mag * sn;
        const float xr = ar - 1.0f, xi = ai, den = 1.0f / (lr * lr + li * li);
        const float cr = (xr * lr + xi * li) * den, ci = (xi * lr - xr * li) * den;
        float bbr[16], bbi[16], ccr[16], cci[16];
#pragma unroll
        for (int i = 0; i < 16; ++i) { const float br = F.in[I_BRE][((size_t)(l * 64 + g) * 64 + p) * 16 + i], bi = F.in[I_BIM][((size_t)(l * 64 + g) * 64 + p) * 16 + i];
            bbr[i] = cr * br - ci * bi; bbi[i] = cr * bi + ci * br;
            ccr[i] = F.in[I_CRE][((size_t)(l * 64 + g) * 16 + i) * 64 + p]; cci[i] = F.in[I_CIM][((size_t)(l * 64 + g) * 16 + i) * 64 + p]; }
        const bf16* XS = (const bf16*)(F.ws + WS_XS) + (size_t)g * 256 * 1024;
        const float* DY = (const float*)(F.ws + WS_DBG);
        float sr = 0.f, si = 0.f, err = 0.f, ref = 0.f;
        for (int t = 0; t < 256; ++t) {
            float x[16];
#pragma unroll
            for (int i = 0; i < 16; ++i) x[i] = bflo((unsigned)XS[(size_t)t * 16 + i]);
            float ur = 0.f, ui = 0.f;
#pragma unroll
            for (int i = 0; i < 16; ++i) { ur += bbr[i] * x[i]; ui += bbi[i] * x[i]; }
            const float nr = ar * sr - ai * si + ur, ni = ar * si + ai * sr + ui; sr = nr; si = ni;
#pragma unroll
            for (int o = 0; o < 16; ++o) {
                const float yr = wave_sum(ccr[o] * sr - cci[o] * si);
                const float yf = DY[(size_t)t * 1024 + g * 16 + o];
                err += (yf - yr) * (yf - yr); ref += yr * yr;
            }
        }
        if (lane == 0 && !(err <= 2e-3f * ref)) __hip_atomic_fetch_or((unsigned*)(F.ws + WS_CTL) + CW_FLAG, 1u, RLX_AGENT);
    }
}
#endif

__device__ __forceinline__ unsigned f2key(float v) { const unsigned u = __builtin_bit_cast(unsigned, v); return (u & 0x80000000u) ? ~u : (u | 0x80000000u); }
__device__ __forceinline__ float key2f(unsigned k) { const unsigned u = (k & 0x80000000u) ? (k & 0x7fffffffu) : ~k; return __builtin_bit_cast(float, u); }
__device__ __forceinline__ void sort16_desc(unsigned (&v)[16]) {
#pragma unroll
    for (int lk = 1; lk <= 4; ++lk) {
#pragma unroll
        for (int lj = lk - 1; lj >= 0; --lj) {
#pragma unroll
            for (int i = 0; i < 16; ++i) { const int k = 1 << lk, j = 1 << lj, p = i ^ j;
                if (p > i) { const unsigned a = v[i], c = v[p], hi = a > c ? a : c, lo = a > c ? c : a; const bool desc = ((i & k) == 0) || (k == 16);
                    v[i] = desc ? hi : lo; v[p] = desc ? lo : hi; } }
        }
    }
}
__device__ __forceinline__ void merge16_desc(unsigned (&v)[16], const unsigned (&w)[16]) {
#pragma unroll
    for (int i = 0; i < 16; ++i) v[i] = v[i] > w[15 - i] ? v[i] : w[15 - i];
#pragma unroll
    for (int lj = 3; lj >= 0; --lj) {
#pragma unroll
        for (int i = 0; i < 16; ++i) { const int j = 1 << lj, p = i ^ j;
            if (p > i) { const unsigned a = v[i], c = v[p]; v[i] = a > c ? a : c; v[p] = a > c ? c : a; } }
    }
}
__device__ __forceinline__ void xmerge16(unsigned (&v)[16], int mask) {
    unsigned w[16];
#pragma unroll
    for (int i = 0; i < 16; ++i) w[i] = (unsigned)__shfl_xor((int)v[i], mask);
    merge16_desc(v, w);
}
__device__ __forceinline__ void phase_topk(Frame& F, int l) {
    PH_LOCALS
    const bf16* Q = (const bf16*)(F.ws + WS_Z);
    const bf16* KB = (const bf16*)(F.ws + WS_KEYS) + (size_t)l * 8 * 2 * 128 * 128;
    int* EID = (int*)(F.ws + WS_EID); float* GT = (float*)(F.ws + WS_GATE); float* SUo = (float*)(F.ws + WS_SU);
    const float* SCL = (const float*)(F.ws + WS_SCL) + (size_t)l * NEXP * 2;
    LAS unsigned char* KL = F.lds;
    LAS float* SC = (LAS float*)(F.lds + 69632);
    LAS unsigned* LST = (LAS unsigned*)(F.lds + 69632 + 66560);
    LAS unsigned char* PT = F.lds + 69632 + 66560 + 8192;
    const int fr = lane & 15, fq = lane >> 4;
    {
        int c = 0;
#pragma unroll
        for (int i = 0; i < 16; ++i)
#pragma unroll
            for (int j = 0; j < 16; ++j) if ((i + 1) * (j + 1) <= 16) { if (tid == c) PT[c] = (unsigned char)(i * 16 + j); ++c; }
    }
    int cur_hh = -1;
    for (int u = F.vcu; u < 2048; u += F.G) {
        const int tt = u >> 3, hh = u & 7, t0 = tt * 64;
        const int tw = wave & 3, s = wave >> 2;
        bf16x8 qf[4];
#pragma unroll
        for (int kb = 0; kb < 4; ++kb) qf[kb] = *(const bf16x8*)(Q + (size_t)(t0 + 16 * tw + fr) * 2048 + hh * 256 + s * 128 + kb * 32 + 8 * fq);
        if (hh != cur_hh) {
            __syncthreads();
#pragma unroll
            for (int ps = 0; ps < 8; ++ps) { const int idx = ps * 512 + tid, row = idx >> 4, c16 = idx & 15;
                *(LAS u32x4*)(KL + row * 272 + c16 * 16) = *(const u32x4*)(KB + ((size_t)(hh * 256 + row)) * 128 + c16 * 8); }
            cur_hh = hh;
        }
        __syncthreads();
        {
            f32x4 acc[8];
#pragma unroll
            for (int nt = 0; nt < 8; ++nt) acc[nt] = (f32x4){0.f, 0.f, 0.f, 0.f};
#pragma unroll
            for (int kb = 0; kb < 4; ++kb)
#pragma unroll
                for (int nt = 0; nt < 8; ++nt) { const bf16x8 kf = *(const LAS bf16x8*)(KL + (s * 128 + nt * 16 + fr) * 272 + (kb * 32 + 8 * fq) * 2);
                    acc[nt] = __builtin_amdgcn_mfma_f32_16x16x32_bf16(kf, qf[kb], acc[nt], 0, 0, 0); }
#pragma unroll
            for (int nt = 0; nt < 8; ++nt) *(LAS f32x4*)(SC + (16 * tw + fr) * 260 + s * 128 + nt * 16 + 4 * fq) = acc[nt];
        }
        __syncthreads();
        {
            const int pr = tid >> 2, sub = tid & 3, tl = pr >> 1, sd = pr & 1;
            const LAS float* row = SC + tl * 260 + sd * 128 + 32 * sub;
            unsigned va[16], vb[16];
#pragma unroll
            for (int q4 = 0; q4 < 4; ++q4) { const f32x4 x = *(const LAS f32x4*)(row + 4 * q4), y = *(const LAS f32x4*)(row + 16 + 4 * q4);
#pragma unroll
                for (int e = 0; e < 4; ++e) { va[4 * q4 + e] = (f2key(x[e]) & ~0x7Fu) | (unsigned)(127 - (32 * sub + 4 * q4 + e)); vb[4 * q4 + e] = (f2key(y[e]) & ~0x7Fu) | (unsigned)(127 - (32 * sub + 16 + 4 * q4 + e)); } }
            sort16_desc(va); sort16_desc(vb); merge16_desc(va, vb);
            xmerge16(va, 1); xmerge16(va, 2);
            if (sub == 0) {
#pragma unroll
                for (int k = 0; k < 16; k += 4) *(LAS u32x4*)(LST + pr * 16 + k) = (u32x4){va[k], va[k + 1], va[k + 2], va[k + 3]};
            }
        }
        __syncthreads();
        {
            const int tl = tid >> 3, s8 = tid & 7;
            unsigned v[16];
#pragma unroll
            for (int m = 0; m < 7; ++m) { const int c = m * 8 + s8; unsigned key = 0u;
                if (c < 50) { const int pij = PT[c], i = pij >> 4, j = pij & 15;
                    const float av = key2f(LST[(tl * 2 + 0) * 16 + i] & ~0x7Fu), bv = key2f(LST[(tl * 2 + 1) * 16 + j] & ~0x7Fu);
                    key = (f2key(av + bv) & ~0xFFu) | (unsigned)(255 - pij); }
                v[m] = key; }
#pragma unroll
            for (int m = 7; m < 16; ++m) v[m] = 0u;
            sort16_desc(v);
            xmerge16(v, 1); xmerge16(v, 2); xmerge16(v, 4);
            float ev[16]; float sum = 0.f; const float mx = key2f(v[0] & ~0xFFu);
#pragma unroll
            for (int k = 0; k < 16; ++k) { ev[k] = __expf(key2f(v[k] & ~0xFFu) - mx); sum += ev[k]; }
            const float inv = 1.0f / sum;
            unsigned k0 = v[0], k1 = v[1]; float e0 = ev[0], e1 = ev[1];
#pragma unroll
            for (int q = 1; q < 8; ++q) { if (s8 == q) { k0 = v[2 * q]; k1 = v[2 * q + 1]; e0 = ev[2 * q]; e1 = ev[2 * q + 1]; } }
            const size_t ob = (size_t)(t0 + tl) * 128 + hh * 16 + 2 * s8;
            {   const int flat = 255 - (int)(k0 & 0xFFu), i = flat >> 4, j = flat & 15;
                const int ia = 127 - (int)(LST[(tl * 2 + 0) * 16 + i] & 0x7Fu), ib = 127 - (int)(LST[(tl * 2 + 1) * 16 + j] & 0x7Fu);
                const int e = ia * 128 + ib; const f32x2 sc = *(const f32x2*)(SCL + 2 * e);
                EID[ob] = e; GT[ob] = e0 * inv * sc.y; SUo[ob] = sc.x; }
            {   const int flat = 255 - (int)(k1 & 0xFFu), i = flat >> 4, j = flat & 15;
                const int ia = 127 - (int)(LST[(tl * 2 + 0) * 16 + i] & 0x7Fu), ib = 127 - (int)(LST[(tl * 2 + 1) * 16 + j] & 0x7Fu);
                const int e = ia * 128 + ib; const f32x2 sc = *(const f32x2*)(SCL + 2 * e);
                EID[ob + 1] = e; GT[ob + 1] = e1 * inv * sc.y; SUo[ob + 1] = sc.x; }
        }
    }
    __syncthreads();
}

#define FP4X4(w, f0, f1, f2, f3) do { f0 = __builtin_amdgcn_cvt_scalef32_pk_f32_fp4((w), 1.0f, 0); f1 = __builtin_amdgcn_cvt_scalef32_pk_f32_fp4((w), 1.0f, 1); \
    f2 = __builtin_amdgcn_cvt_scalef32_pk_f32_fp4((w), 1.0f, 2); f3 = __builtin_amdgcn_cvt_scalef32_pk_f32_fp4((w), 1.0f, 3); } while (0)
__device__ __forceinline__ void phase_gather(Frame& F, int l, bool dummy = false) {
    PH_LOCALS
    const int gw = F.vcu * NWAVES + wave, NGW = F.G * NWAVES;
    const bf16* H = (const bf16*)(F.ws + WS_H); bf16* Hn = dummy ? (bf16*)(F.ws + WS_DBG + 128 * MiB) : (bf16*)(F.ws + WS_H);
    const unsigned char* UV = F.ws + WS_UV + (size_t)l * NEXP * 2048;
    const int* EID = (const int*)(F.ws + WS_EID); const float* GT = (const float*)(F.ws + WS_GATE); const float* SU = (const float*)(F.ws + WS_SU);
    const bf16* X = (const bf16*)(F.ws + WS_X); bf16* Xo = dummy ? (bf16*)(F.ws + WS_DBG) : (bf16*)(F.ws + WS_X);
    const float* mod = (const float*)(F.ws + WS_MOD);
    const float* gate2 = mod + l * 12288 + 5 * 2048;
    const unsigned lane16 = (unsigned)lane * 16u;
    constexpr int NB = 16;
    for (int t = gw; t < M; t += NGW) {
        const int e_lo = EID[(size_t)t * 128 + lane], e_hi = EID[(size_t)t * 128 + 64 + lane];
        const float g_lo = GT[(size_t)t * 128 + lane], g_hi = GT[(size_t)t * 128 + 64 + lane];
        const float s_lo = SU[(size_t)t * 128 + lane], s_hi = SU[(size_t)t * 128 + 64 + lane];
        f32x2 hh[8][2];
#pragma unroll
        for (int j = 0; j < 8; ++j) { const u32x2 w = *(const u32x2*)(H + (size_t)t * 2048 + j * 256 + lane * 4);
            hh[j][0] = (f32x2){bflo(w.x), bfhi(w.x)}; hh[j][1] = (f32x2){bflo(w.y), bfhi(w.y)}; }
        f32x2 of[8][2];
#pragma unroll
        for (int j = 0; j < 8; ++j) { of[j][0] = (f32x2){0.f, 0.f}; of[j][1] = (f32x2){0.f, 0.f}; }
        for (int b = 0; b < 128 / NB; ++b) {
            const bool first = (b * NB) < 64;
            const int esel = first ? e_lo : e_hi; const float gsel = first ? g_lo : g_hi, ssel = first ? s_lo : s_hi;
            u32x4 ur[NB], vr[NB];
#pragma unroll
            for (int h = 0; h < NB; ++h) {
                const int e = __builtin_amdgcn_readlane(esel, (NB * b + h) & 63);
                const unsigned char* rowp = UV + ((size_t)(unsigned)e << 11);
                ur[h] = *(const u32x4*)(rowp + lane16); vr[h] = *(const u32x4*)(rowp + 1024 + lane16);
            }
            float p[NB];
#pragma unroll
            for (int h = 0; h < NB; ++h) {
                f32x2 a2 = {0.f, 0.f};
#pragma unroll
                for (int d = 0; d < 4; ++d) { f32x2 f0, f1, f2, f3; FP4X4(ur[h][d], f0, f1, f2, f3);
                    a2 = f0 * hh[2 * d][0] + a2; a2 = f1 * hh[2 * d][1] + a2; a2 = f2 * hh[2 * d + 1][0] + a2; a2 = f3 * hh[2 * d + 1][1] + a2; }
                p[h] = a2.x + a2.y;
            }
            const bool u32_ = (lane & 32) != 0, u16_ = (lane & 16) != 0, u8_ = (lane & 8) != 0, u4_ = (lane & 4) != 0;
            float a8[8];
#pragma unroll
            for (int i = 0; i < 8; ++i) { const float snd = u32_ ? p[i] : p[8 + i], kp = u32_ ? p[8 + i] : p[i]; a8[i] = kp + __shfl_xor(snd, 32); }
            float a4[4];
#pragma unroll
            for (int i = 0; i < 4; ++i) { const float snd = u16_ ? a8[i] : a8[4 + i], kp = u16_ ? a8[4 + i] : a8[i]; a4[i] = kp + __shfl_xor(snd, 16); }
            float b2[2];
#pragma unroll
            for (int i = 0; i < 2; ++i) { const float snd = u8_ ? a4[i] : a4[2 + i], kp = u8_ ? a4[2 + i] : a4[i]; b2[i] = kp + __shfl_xor(snd, 8); }
            float d;
            { const float snd = u4_ ? b2[0] : b2[1], kp = u4_ ? b2[1] : b2[0]; d = kp + __shfl_xor(snd, 4); }
            d += __shfl_xor(d, 2); d += __shfl_xor(d, 1);
            const int hl = (NB * b + (lane >> 2)) & 63;
            const float gq = __shfl(gsel, hl), sq = __shfl(ssel, hl);
            const float coefq = gq * gelu_tanh(d * sq);
#pragma unroll
            for (int h = 0; h < NB; ++h) {
                const float cf = __builtin_bit_cast(float, __builtin_amdgcn_readlane(__builtin_bit_cast(int, coefq), 4 * h));
                const f32x2 cf2 = {cf, cf};
#pragma unroll
                for (int dd = 0; dd < 4; ++dd) { f32x2 f0, f1, f2, f3; FP4X4(vr[h][dd], f0, f1, f2, f3);
                    of[2 * dd][0] = f0 * cf2 + of[2 * dd][0]; of[2 * dd][1] = f1 * cf2 + of[2 * dd][1]; of[2 * dd + 1][0] = f2 * cf2 + of[2 * dd + 1][0]; of[2 * dd + 1][1] = f3 * cf2 + of[2 * dd + 1][1]; }
            }
        }
        int ln = lane; asm volatile("" : "+v"(ln));
        f32x4 xv[8]; float ss = 0.f;
#pragma unroll
        for (int j = 0; j < 8; ++j) {
            const int c = j * 256 + ln * 4;
            const u32x2 xw = *(const u32x2*)(X + (size_t)t * 2048 + c); const f32x4 xo = {bflo(xw.x), bfhi(xw.x), bflo(xw.y), bfhi(xw.y)}, g2 = *(const f32x4*)(gate2 + c);
            const f32x4 o = {of[j][0].x, of[j][0].y, of[j][1].x, of[j][1].y};
            xv[j] = xo + g2 * o;
            ss += (xv[j][0] * xv[j][0] + xv[j][1] * xv[j][1]) + (xv[j][2] * xv[j][2] + xv[j][3] * xv[j][3]);
        }
        const float rr = 1.0f / sqrtf(wave_sum(ss) * (1.0f / DM) + EPS);
        if (l + 1 < DEPTH) {
            const float* m2 = mod + (l + 1) * 12288; const float* gain = F.in[I_N1G] + (l + 1) * 2048;
#pragma unroll
            for (int j = 0; j < 8; ++j) {
                const int c = j * 256 + ln * 4;
                *(u32x2*)(Xo + (size_t)t * 2048 + c) = (u32x2){pk2(xv[j][0], xv[j][1]), pk2(xv[j][2], xv[j][3])};
                const f32x4 g = *(const f32x4*)(gain + c), sc = *(const f32x4*)(m2 + 2048 + c), sh = *(const f32x4*)(m2 + c);
                const f32x4 y = xv[j] * rr * g * (sc + 1.0f) + sh;
                *(u32x2*)(Hn + (size_t)t * 2048 + c) = (u32x2){pk2(y[0], y[1]), pk2(y[2], y[3])};
            }
        } else {
#pragma unroll
            for (int j = 0; j < 8; ++j) { const int c = j * 256 + ln * 4; const f32x4 fg = *(const f32x4*)(F.in[I_FG] + c);
                f32x4 ov = xv[j] * rr * fg;
#if SELFTEST_S5
                if (__hip_atomic_load((unsigned*)(F.ws + WS_CTL) + CW_FLAG, RLX_AGENT) != 0u) ov = (f32x4){1e30f, 1e30f, 1e30f, 1e30f};
#endif
                *(f32x4*)(F.out + (size_t)t * 2048 + c) = ov; }
        }
    }
}

__global__ void __launch_bounds__(NTHR, 2) fwd_kernel(Args args) {
    extern __shared__ __attribute__((aligned(16))) unsigned char lds_raw[];
    Frame F;
    F.lds = (LAS unsigned char*)lds_raw; F.ws = args.ws; F.in = args.in; F.out = args.out;
    F.tid = threadIdx.x; F.lane = F.tid & 63; F.wave = __builtin_amdgcn_readfirstlane(F.tid >> 6);
    F.G = gridDim.x; { const int bx = blockIdx.x; F.vcu = (F.G % 8 == 0) ? (bx % 8) * (F.G / 8) + bx / 8 : bx; }
    volatile LAS unsigned* MISC = (volatile LAS unsigned*)(F.lds + MISC_OFF);
    if (F.tid < 64) MISC[F.tid] = 0u;
    __syncthreads();
    unsigned* ctl = (unsigned*)(F.ws + WS_CTL);
    XcdBarrier bar; bar.bar = ctl + CW_BAR; bar.x = 0; bar.st = nullptr;
#if !MK_PER_PHASE
    bar = xcd_barrier_post(ctl + CW_BAR, MISC + 8);
#endif
    const int lo = args.ph_lo, hi = args.ph_hi;
#define IN(k) (lo <= (k) && (k) < hi)
#if MK_PER_PHASE
#define SEAM(k) do { } while (0)
#else
#define SEAM(k) do { if (IN(k) && IN((k) + 1)) xcd_barrier(bar); } while (0)
#endif
    const float* mod = (const float*)(F.ws + WS_MOD);

#define REP(k) (REPEAT_PH == (k))
#define RUN2(k, first, real) do { if (REP(k)) { first; xcd_barrier(bar); } real; } while (0)
    if (IN(0)) { RUN2(13, p0_tables(F, 5, true), p0_tables(F, 4, false)); } SEAM(0);
    for (int l = 0; l < DEPTH; ++l) {
        const int pb = 1 + 12 * l;
        const float* ml = mod + l * 12288;
        if (IN(pb + 0)) { if (l == 0) { RUN2(0, p0_prologue(F), p0_prologue(F)); RUN2(1, phase_norm<false>(F, F.in[I_X], F.in[I_N1G] + l * 2048, ml + 1 * 2048, ml + 0 * 2048), phase_norm<false>(F, F.in[I_X], F.in[I_N1G] + l * 2048, ml + 1 * 2048, ml + 0 * 2048)); } } SEAM(pb + 0);
        if (IN(pb + 1)) {
            pg8::Gemm g{(const bf16*)(F.ws + WS_H), (const bf16*)(F.ws + WS_WIN) + (size_t)l * INW * DM, M, INW, DM}; pg8::StaticOrder S; S.init(M, INW, F.G, (int)blockIdx.x);
            EpiIn E{(bf16*)(F.ws + WS_Z), (bf16*)(F.ws + WS_XS), F.in[I_BIN] + l * INW};
#define GEMM_IN pg8::gemm_phase<EpiIn, pg8::StaticOrder, true, true>(F.lds, g, S, E)
            RUN2(2, GEMM_IN, GEMM_IN);
        } SEAM(pb + 1);
        if (IN(pb + 2)) { RUN2(3, (phase_sloc(F, l), phase_lnstats(F)), (phase_sloc(F, l), phase_lnstats(F))); } SEAM(pb + 2);
        if (IN(pb + 3)) { RUN2(4, phase_carry_gating(F, l, l + 2), phase_carry_gating(F, l, l)); } SEAM(pb + 3);
        if (IN(pb + 4)) { RUN2(5, phase_s5out(F, l), phase_s5out(F, l));
#if SELFTEST_S5
            xcd_barrier(bar); selftest_s5(F, l);
#endif
        } SEAM(pb + 4);
        if (IN(pb + 5)) {
            pg8::Gemm g{(const bf16*)(F.ws + WS_G), (const bf16*)(F.ws + WS_GLU) + (size_t)l * WB * WB, M, WB, WB}; pg8::StaticOrder S; S.init(M, WB, F.G, (int)blockIdx.x);
            EpiGlu E{(const bf16*)(F.ws + WS_G), (bf16*)(F.ws + WS_MIX), F.in[I_GLUB] + l * WB};
#define GEMM_GLU pg8::gemm_phase<EpiGlu, pg8::StaticOrder, true, true>(F.lds, g, S, E)
            RUN2(6, GEMM_GLU, GEMM_GLU);
        } SEAM(pb + 5);
        if (IN(pb + 6)) { RUN2(7, phase_branchnorm(F), phase_branchnorm(F)); } SEAM(pb + 6);
        if (IN(pb + 7)) {
            pg8::Gemm g{(const bf16*)(F.ws + WS_MIX), (const bf16*)(F.ws + WS_WOUT) + (size_t)l * DM * DM, M, DM, DM}; pg8::StaticOrder S; S.init(M, DM, F.G, (int)blockIdx.x);
            if (l == 0) { EpiOut<false> E{(const void*)F.in[I_X], (bf16*)(F.ws + WS_X), ml + 2 * 2048}; EpiOut<false> Ed{(const void*)F.in[I_X], (bf16*)(F.ws + WS_DBG), ml + 2 * 2048};
#define GEMM_OUT0(EE) pg8::gemm_phase<EpiOut<false>, pg8::StaticOrder, true, true>(F.lds, g, S, EE)
                RUN2(8, GEMM_OUT0(Ed), GEMM_OUT0(E)); }
            else { EpiOut<true> E{(const void*)(F.ws + WS_X), (bf16*)(F.ws + WS_X), ml + 2 * 2048}; EpiOut<true> Ed{(const void*)(F.ws + WS_X), (bf16*)(F.ws + WS_DBG), ml + 2 * 2048};
#define GEMM_OUT1(EE) pg8::gemm_phase<EpiOut<true>, pg8::StaticOrder, true, true>(F.lds, g, S, EE)
                RUN2(8, GEMM_OUT1(Ed), GEMM_OUT1(E)); }
        } SEAM(pb + 7);
        if (IN(pb + 8)) { RUN2(9, phase_norm<true>(F, (const void*)(F.ws + WS_X), F.in[I_N2G] + l * 2048, ml + 4 * 2048, ml + 3 * 2048), phase_norm<true>(F, (const void*)(F.ws + WS_X), F.in[I_N2G] + l * 2048, ml + 4 * 2048, ml + 3 * 2048)); } SEAM(pb + 8);
        if (IN(pb + 9)) {
            pg8::Gemm g{(const bf16*)(F.ws + WS_H), (const bf16*)(F.ws + WS_WQ) + (size_t)l * DM * DM, M, DM, DM}; pg8::StaticOrder S; S.init(M, DM, F.G, (int)blockIdx.x);
            EpiQ E{(bf16*)(F.ws + WS_Z)};
#define GEMM_Q pg8::gemm_phase<EpiQ, pg8::StaticOrder, true, true>(F.lds, g, S, E)
            RUN2(10, GEMM_Q, GEMM_Q);
        } SEAM(pb + 9);
        if (IN(pb + 10)) { RUN2(11, phase_topk(F, l), phase_topk(F, l)); } SEAM(pb + 10);
        if (IN(pb + 11)) { RUN2(12, phase_gather(F, l, true), phase_gather(F, l, false)); } SEAM(pb + 11);
    }
#undef IN
#undef SEAM
}

extern "C" void kernel_launch(void* const* d_in, const int* in_sizes, int n_in, void* d_out, int out_size, void* d_ws, size_t ws_size, hipStream_t stream) {
    static int grid = 0;
    if (grid == 0) {
        if (n_in != 29 || out_size != M * DM || ws_size < WS_END) { fprintf(stderr, "kernel_launch: unexpected shapes (n_in %d, out %d, ws %zu); nothing launched\n", n_in, out_size, ws_size); grid = -1; return; }
        int dev = 0, cus = 0;
        if (hipGetDevice(&dev) != hipSuccess || hipDeviceGetAttribute(&cus, hipDeviceAttributeMultiprocessorCount, dev) != hipSuccess) { grid = -1; return; }
        if (hipFuncSetAttribute((const void*)fwd_kernel, hipFuncAttributeMaxDynamicSharedMemorySize, LDS_BYTES) != hipSuccess) { fprintf(stderr, "kernel_launch: hipFuncSetAttribute failed\n"); grid = -1; return; }
        (void)hipGetLastError();
        grid = cus;
    }
    if (grid < 0) return;
    (void)hipMemsetAsync((char*)d_ws + WS_CTL, 0, CTL_ZERO_BYTES, stream);
    Args a{};
    for (int i = 0; i < 29; ++i) a.in[i] = (const float*)d_in[i];
    a.out = (float*)d_out; a.ws = (unsigned char*)d_ws;
#if MK_PER_PHASE
    for (int p = 0; p < 1 + 12 * DEPTH; ++p) {
        if (p == 13) continue;
        a.ph_lo = p; a.ph_hi = p + 1; a.li = p;
        hipLaunchKernelGGL(fwd_kernel, dim3(grid), dim3(NTHR), LDS_BYTES, stream, a);
    }
#else
    a.ph_lo = 0; a.ph_hi = 1 + 12 * DEPTH; a.li = 0;
    hipLaunchKernelGGL(fwd_kernel, dim3(grid), dim3(NTHR), LDS_BYTES, stream, a);
#endif
}
```

```cpp
#include <hip/hip_runtime.h>
#include <cstdio>
#include <cstdint>

#ifndef SELFTEST_S5
#define SELFTEST_S5 0
#endif
#ifndef REPEAT_PH
#define REPEAT_PH -1
#endif
#ifndef MK_PER_PHASE
#define MK_PER_PHASE 0
#endif

#define GAS __attribute__((address_space(1)))
#define LAS __attribute__((address_space(3)))
typedef unsigned short bf16;
typedef short bf16x8 __attribute__((ext_vector_type(8)));
typedef float f32x4 __attribute__((ext_vector_type(4)));
typedef float f32x2 __attribute__((ext_vector_type(2)));
typedef unsigned u32x4 __attribute__((ext_vector_type(4)));
typedef unsigned u32x2 __attribute__((ext_vector_type(2)));

constexpr int DM = 2048, SEQ = 16384, DEPTH = 2, M = SEQ;
constexpr int WA = 1024, WB = 1024, INW = 3072;
constexpr int NG = 64, NCH = 256;
constexpr int NEXP = 16384;
constexpr float EPS = 1e-6f;
constexpr int NWAVES = 8, NTHR = 512;

namespace pg8 {
#define PG8_LAS __attribute__((address_space(3)))
constexpr int BM = 256, BK = 64, HALF = 128, HTB = HALF * BK * 2, STAGE_BYTES = 8 * HTB, NXCD = 8, WGM = 8;
__host__ __device__ __forceinline__ int lds_byte(int r, int c) { const int st = (r >> 4) * 2 + (c >> 5), rr = r & 15, cc = c & 31, ob = rr * 64 + cc * 2; return st * 1024 + (ob ^ (((ob >> 9) & 1) << 5)); }
__host__ __device__ __forceinline__ void stage_rc(int b, int& R, int& C) { const int st = b / 1024, sb = b % 1024, swz = sb ^ (((sb >> 9) & 1) << 5); R = (st >> 1) * 16 + swz / 64; C = (st & 1) * 32 + (swz % 64) / 2; }
__host__ __device__ __forceinline__ int perm32(int rho) { const int n = rho >> 4, i = rho & 15; return 8 * (i >> 2) + 4 * n + (i & 3); }
struct Unit { int pm, pn; };
struct Gemm { const bf16* A; const bf16* Bt; int M, N, K; };
struct StaticOrder {
    int nM, nN, nwg, G, c;
    __host__ __device__ void init(int M_, int N_, int G_, int c_) { nM = M_ / BM; nN = N_ / BM; nwg = nM * nN; G = G_; c = c_; }
    __host__ __device__ bool next(int i, Unit& u) const {
        const long L = (long)i * G + c; if (L >= nwg) return false;
        int wgid = (int)L; { const int q = nwg / NXCD, r = nwg % NXCD, xcd = wgid % NXCD, off = wgid / NXCD; wgid = (xcd < r ? xcd * (q + 1) : r * (q + 1) + (xcd - r) * q) + off; }
        const int nig = WGM * nN, gid = wgid / nig, fm = gid * WGM, gsz = (nM - fm) < WGM ? (nM - fm) : WGM;
        u.pm = fm + ((wgid % nig) % gsz); u.pn = (wgid % nig) / gsz; return true;
    }
    __device__ __forceinline__ void a_ready(const Unit&) const {}
    __device__ __forceinline__ void done(const Unit&) const {}
};
__device__ __forceinline__ unsigned cvt_pk_bf16(float lo, float hi) { unsigned r; asm volatile("v_cvt_pk_bf16_f32 %0, %1, %2" : "=v"(r) : "v"(lo), "v"(hi)); return r; }

template <class Epi, class Sched, bool ALIGN_EPI = false, bool SP2 = false>
__device__ __forceinline__ void gemm_phase(PG8_LAS unsigned char* lds, const Gemm g, const Sched& S, const Epi& E) {
    int tid = threadIdx.x; asm volatile("" : "+v"(tid)); const int wid = __builtin_amdgcn_readfirstlane(tid >> 6), lane = tid & 63, wr = wid >> 2, wc = wid & 3, fr = lane & 15, fq = lane >> 4;
    const int K = g.K, nt = K / BK;
    unsigned voffA[2], voffB[2];
#pragma unroll
    for (int i = 0; i < 2; ++i) { int R, C; stage_rc(tid * 16 + i * 8192, R, C); const int Rb = Epi::PERM ? ((R & ~31) + perm32(R & 31)) : R;
        voffA[i] = (unsigned)(R * K + C) * 2u; voffB[i] = (unsigned)(Rb * K + C) * 2u; }
    const size_t kstep = (size_t)(BK * 2);
    const size_t hstep = (size_t)HALF * K * 2;
    const size_t tstep = 2 * hstep;
    const unsigned ldsw = (unsigned)wid * 1024u;
    const int aoff = lds_byte(wr * 64 + fr, fq * 8), boff = lds_byte(wc * 32 + fr, fq * 8);
#define PG8_SA(b, h) (((b) * 2 + (h)) * HTB)
#define PG8_SB(b, h) ((4 + (b) * 2 + (h)) * HTB)
#define PG8_STAGE(bufoff, gbase, voff) do { _Pragma("unroll") for (int _i = 0; _i < 2; ++_i) \
        __builtin_amdgcn_global_load_lds((const unsigned*)((const char*)(gbase) + (voff)[_i]), (PG8_LAS unsigned*)(lds + (bufoff) + ldsw + _i * 8192), 16, 0, 0); } while (0)
#define PG8_LDA(dst, b, h) do { _Pragma("unroll") for (int m = 0; m < 4; ++m) _Pragma("unroll") for (int k = 0; k < 2; ++k) dst[m][k] = *(const PG8_LAS bf16x8*)(lds + PG8_SA(b, h) + aoff + m * 2048 + k * 1024); } while (0)
#define PG8_LDB(dst, b, h) do { _Pragma("unroll") for (int n = 0; n < 2; ++n) _Pragma("unroll") for (int k = 0; k < 2; ++k) dst[n][k] = *(const PG8_LAS bf16x8*)(lds + PG8_SB(b, h) + boff + n * 2048 + k * 1024); } while (0)
#define PG8_MMA(ai, bj, At, Bt) do { __builtin_amdgcn_s_setprio(1); _Pragma("unroll") for (int m = 0; m < 4; ++m) _Pragma("unroll") for (int n = 0; n < 2; ++n) _Pragma("unroll") for (int k = 0; k < 2; ++k) \
        acc[ai][bj][m][n] = __builtin_amdgcn_mfma_f32_16x16x32_bf16(Bt[n][k], At[m][k], acc[ai][bj][m][n], 0, 0, 0); __builtin_amdgcn_s_setprio(0); } while (0)
#define PG8_WAIT_V(n) asm volatile("s_waitcnt vmcnt(" #n ")" ::: "memory")
#define PG8_WAIT_L(n) asm volatile("s_waitcnt lgkmcnt(" #n ")" ::: "memory")
#define PG8_BAR __builtin_amdgcn_s_barrier()
#define PG8_SCHED __builtin_amdgcn_sched_barrier(0)
    Unit cur, nxt; int ui = 0;
    if (!S.next(0, cur)) return;
    f32x4 acc[2][2][4][2];
#pragma unroll
    for (int a = 0; a < 2; ++a)
#pragma unroll
        for (int b = 0; b < 2; ++b)
#pragma unroll
            for (int m = 0; m < 4; ++m)
#pragma unroll
                for (int n = 0; n < 2; ++n) acc[a][b][m][n] = (f32x4){0.f, 0.f, 0.f, 0.f};
    bf16x8 At[4][2], B0[2][2], B1[2][2];
    const char* cA = (const char*)g.A + (size_t)cur.pm * tstep; const char* cB = (const char*)g.Bt + (size_t)cur.pn * tstep;
    S.a_ready(cur);
    if constexpr (SP2) {
        PG8_STAGE(PG8_SB(0, 0), cB, voffB); PG8_STAGE(PG8_SB(0, 1), cB + hstep, voffB); PG8_STAGE(PG8_SA(0, 0), cA, voffA); PG8_STAGE(PG8_SA(0, 1), cA + hstep, voffA);
        if (wr == 1) PG8_BAR;
        PG8_WAIT_V(2); PG8_BAR;
        PG8_STAGE(PG8_SB(1, 0), cB + kstep, voffB); PG8_STAGE(PG8_SA(1, 0), cA + kstep, voffA); PG8_STAGE(PG8_SB(1, 1), cB + hstep + kstep, voffB);
        PG8_WAIT_V(6); PG8_BAR;
    } else {
        PG8_STAGE(PG8_SB(0, 0), cB, voffB); PG8_STAGE(PG8_SA(0, 0), cA, voffA); PG8_STAGE(PG8_SB(0, 1), cB + hstep, voffB); PG8_STAGE(PG8_SA(0, 1), cA + hstep, voffA);
        if (wr == 1) PG8_BAR;
        PG8_WAIT_V(4); PG8_BAR;
        PG8_STAGE(PG8_SB(1, 0), cB + kstep, voffB); PG8_STAGE(PG8_SA(1, 0), cA + kstep, voffA); PG8_STAGE(PG8_SB(1, 1), cB + hstep + kstep, voffB);
        PG8_WAIT_V(6); PG8_BAR;
    }
    for (;;) {
        const bool has_next = S.next(ui + 1, nxt);
        const char* nA = has_next ? (const char*)g.A + (size_t)nxt.pm * tstep : cA; const char* nB = has_next ? (const char*)g.Bt + (size_t)nxt.pn * tstep : cB;
        for (int t = 0; t < nt; t += 2) {
            const bool last = (t == nt - 2);
            const char* a1 = cA + (size_t)(t + 1) * kstep;
            const char* a2 = last ? nA : cA + (size_t)(t + 2) * kstep; const char* b2 = last ? nB : cB + (size_t)(t + 2) * kstep;
            const char* a3 = a2 + kstep; const char* b3 = b2 + kstep;
            if (last && has_next) S.a_ready(nxt);
            if constexpr (SP2) {
            PG8_LDB(B0, 0, 0); PG8_LDB(B1, 0, 1); PG8_SCHED; PG8_LDA(At, 0, 0); PG8_STAGE(PG8_SA(1, 1), a1 + hstep, voffA);
            PG8_WAIT_V(8); PG8_WAIT_L(0); PG8_BAR; PG8_MMA(0, 0, At, B0); PG8_MMA(0, 1, At, B1); PG8_BAR; PG8_SCHED;
            PG8_LDA(At, 0, 1); PG8_STAGE(PG8_SB(0, 0), b2, voffB); PG8_STAGE(PG8_SB(0, 1), b2 + hstep, voffB); PG8_STAGE(PG8_SA(0, 0), a2, voffA);
            PG8_WAIT_V(8); PG8_WAIT_L(0); PG8_BAR; PG8_MMA(1, 0, At, B0); PG8_MMA(1, 1, At, B1); PG8_BAR; PG8_SCHED;
            PG8_LDB(B0, 1, 0); PG8_LDB(B1, 1, 1); PG8_SCHED; PG8_LDA(At, 1, 0); PG8_STAGE(PG8_SA(0, 1), a2 + hstep, voffA);
            PG8_WAIT_V(8); PG8_WAIT_L(0); PG8_BAR; PG8_MMA(0, 0, At, B0); PG8_MMA(0, 1, At, B1); PG8_BAR; PG8_SCHED;
            PG8_LDA(At, 1, 1); PG8_STAGE(PG8_SB(1, 0), b3, voffB); PG8_STAGE(PG8_SB(1, 1), b3 + hstep, voffB); PG8_STAGE(PG8_SA(1, 0), a3, voffA);
            PG8_WAIT_V(8); PG8_WAIT_L(0); PG8_BAR; PG8_MMA(1, 0, At, B0); PG8_MMA(1, 1, At, B1); PG8_BAR; PG8_SCHED;
            } else {
            PG8_LDB(B0, 0, 0); PG8_SCHED; PG8_LDA(At, 0, 0); PG8_STAGE(PG8_SA(1, 1), a1 + hstep, voffA);
            PG8_WAIT_L(8); PG8_BAR; PG8_WAIT_L(0); PG8_MMA(0, 0, At, B0); PG8_BAR; PG8_SCHED;
            PG8_LDB(B1, 0, 1); PG8_STAGE(PG8_SB(0, 0), b2, voffB);
            PG8_BAR; PG8_WAIT_L(0); PG8_MMA(0, 1, At, B1); PG8_BAR;
            PG8_LDA(At, 0, 1); PG8_STAGE(PG8_SA(0, 0), a2, voffA);
            PG8_BAR; PG8_WAIT_L(0); PG8_MMA(1, 0, At, B0); PG8_BAR; PG8_SCHED;
            PG8_STAGE(PG8_SB(0, 1), b2 + hstep, voffB);
            PG8_WAIT_V(6); PG8_BAR; PG8_MMA(1, 1, At, B1); PG8_BAR;
            PG8_LDB(B0, 1, 0); PG8_SCHED; PG8_LDA(At, 1, 0); PG8_STAGE(PG8_SA(0, 1), a2 + hstep, voffA);
            PG8_WAIT_L(8); PG8_BAR; PG8_WAIT_L(0); PG8_MMA(0, 0, At, B0); PG8_BAR; PG8_SCHED;
            PG8_LDB(B1, 1, 1); PG8_STAGE(PG8_SB(1, 0), b3, voffB);
            PG8_BAR; PG8_WAIT_L(0); PG8_MMA(0, 1, At, B1); PG8_BAR;
            PG8_LDA(At, 1, 1); PG8_STAGE(PG8_SA(1, 0), a3, voffA);
            PG8_BAR; PG8_WAIT_L(0); PG8_MMA(1, 0, At, B0); PG8_BAR; PG8_SCHED;
            PG8_STAGE(PG8_SB(1, 1), b3 + hstep, voffB);
            PG8_WAIT_V(6); PG8_BAR; PG8_MMA(1, 1, At, B1); PG8_BAR;
            }
        }
        if constexpr (ALIGN_EPI) { if (wr == 0) PG8_BAR; }
        E(acc, cur, wr, wc, fr, fq); S.done(cur);
        if (!has_next) break;
#pragma unroll
        for (int a = 0; a < 2; ++a)
#pragma unroll
            for (int b = 0; b < 2; ++b)
#pragma unroll
                for (int m = 0; m < 4; ++m)
#pragma unroll
                    for (int n = 0; n < 2; ++n) acc[a][b][m][n] = (f32x4){0.f, 0.f, 0.f, 0.f};
        cur = nxt; cA = nA; cB = nB; ++ui;
        if constexpr (ALIGN_EPI) { if (wr == 1) PG8_BAR; }
    }
    PG8_WAIT_V(0);
    if constexpr (!ALIGN_EPI) { if (wr == 0) PG8_BAR; }
    PG8_BAR;
#undef PG8_SA
#undef PG8_SB
#undef PG8_STAGE
#undef PG8_LDA
#undef PG8_LDB
#undef PG8_MMA
#undef PG8_WAIT_V
#undef PG8_WAIT_L
#undef PG8_BAR
#undef PG8_SCHED
}
}

__device__ __forceinline__ unsigned f2bf(float f) { unsigned u = __builtin_bit_cast(unsigned, f); return (u + 0x7fffu + ((u >> 16) & 1u)) >> 16; }
__device__ __forceinline__ unsigned pk2(float lo, float hi) { return f2bf(lo) | (f2bf(hi) << 16); }
__device__ __forceinline__ float bflo(unsigned w) { return __builtin_bit_cast(float, w << 16); }
__device__ __forceinline__ float bfhi(unsigned w) { return __builtin_bit_cast(float, w & 0xffff0000u); }
__device__ __forceinline__ float fast_sigmoid(float t) { return __builtin_amdgcn_rcpf(1.0f + __builtin_amdgcn_exp2f(-1.44269504089f * t)); }
__device__ __forceinline__ float gelu_tanh(float x) { const float t = x * (1.5957691216f + 0.0713548163f * x * x); return x * fast_sigmoid(t); }
__device__ __forceinline__ float wave_sum(float v) {
#pragma unroll
    for (int o = 1; o < 64; o <<= 1) v += __shfl_xor(v, o);
    return v;
}
#define LDS_WAIT() asm volatile("s_waitcnt lgkmcnt(0)" ::: "memory")
#define VM_WAIT() asm volatile("s_waitcnt vmcnt(0)" ::: "memory")
#define RLX_AGENT __ATOMIC_RELAXED, __HIP_MEMORY_SCOPE_AGENT

constexpr size_t MiB = 1u << 20;
constexpr size_t WS_CTL = 0, CTL_ZERO_BYTES = 1 * MiB;
constexpr size_t WS_MOD   = 512 * 1024;
constexpr size_t WS_AT    = 1 * MiB + 128 * 1024;
constexpr size_t WS_STATS = WS_AT + 128 * 1024;
constexpr size_t WS_SCL   = 1 * MiB + 512 * 1024;
constexpr size_t WS_GS    = 1 * MiB + 768 * 1024;
constexpr size_t WS_C0    = WS_GS + 16 * 1024;
constexpr size_t WS_KEYS  = 2 * MiB;
constexpr size_t WS_GWS   = 3 * MiB;
constexpr size_t WS_WIN   = 4 * MiB;
constexpr size_t WS_GLU   = 28 * MiB;
constexpr size_t WS_WOUT  = 32 * MiB;
constexpr size_t WS_WQ    = 48 * MiB;
constexpr size_t WS_KTAB  = 64 * MiB;
constexpr size_t WS_WG    = 72 * MiB;
constexpr size_t WS_VG    = 104 * MiB;
constexpr size_t WS_UV    = 136 * MiB;
constexpr size_t WS_X     = 392 * MiB;
constexpr size_t WS_H     = 520 * MiB;
constexpr size_t WS_Z     = 584 * MiB;
constexpr size_t WS_XS    = 648 * MiB;
constexpr size_t WS_SLOC  = 680 * MiB;
constexpr size_t WS_PS    = 688 * MiB;
constexpr size_t WS_HS    = 690 * MiB;
constexpr size_t WS_G     = 692 * MiB;
constexpr size_t WS_MIX   = 724 * MiB;
constexpr size_t WS_EID   = 788 * MiB;
constexpr size_t WS_GATE  = 796 * MiB;
constexpr size_t WS_SU    = 804 * MiB;
constexpr size_t WS_END   = 812 * MiB;
constexpr size_t WS_DBG   = 812 * MiB;
constexpr int CW_BAR = 4096;
constexpr int CW_FLAG = 2048;
constexpr int CW_QUEUE = 16384;

constexpr int LDS_BYTES = 163840;
constexpr int MISC_OFF = LDS_BYTES - 256;

#define XB_TMO      128
#define XB_XCNT(j)  (256  + 64 * (j))
#define XB_XSUB(j)  (1280 + 64 * (j))
#define XB_XGEN(j)  (2304 + 64 * (j))
#define XB_TOP      3328
#define XB_TOPGEN   3392
#define XCD_BAR_WORDS 3456
#define XB_SPIN_CAP (1u << 24)
__device__ __forceinline__ unsigned xb_ld(unsigned* p)              { return __hip_atomic_load(p, __ATOMIC_RELAXED, __HIP_MEMORY_SCOPE_AGENT); }
__device__ __forceinline__ unsigned xb_add(unsigned* p, unsigned v) { return __hip_atomic_fetch_add(p, v, __ATOMIC_RELAXED, __HIP_MEMORY_SCOPE_AGENT); }
__device__ __forceinline__ unsigned xb_xcc_id() { return (unsigned)__builtin_amdgcn_s_getreg((3 << 11) | 20) & 0xFu; }
#define XB_SPIN(cond, bar) do { unsigned _sp = 0; while (cond) { __builtin_amdgcn_s_sleep(1); \
    if ((++_sp & 255u) == 0u) { if (xb_ld(&(bar)[XB_TMO])) break; if (_sp > XB_SPIN_CAP) { atomicAdd(&(bar)[XB_TMO], 1u); break; } } } } while (0)
struct XcdBarrier { unsigned* bar; unsigned x; volatile LAS unsigned* st; };
__device__ __forceinline__ XcdBarrier xcd_barrier_post(unsigned* bar, volatile LAS unsigned* st) {
    XcdBarrier b; b.bar = bar; b.x = xb_xcc_id(); b.st = st;
    if (threadIdx.x == 0) (void)xb_add(&bar[XB_XCNT(b.x)], 1u);
    return b;
}
__device__ __forceinline__ void xcd_barrier_complete(unsigned* bar, unsigned x, unsigned& nloc, unsigned& nx) {
    const unsigned G = gridDim.x * gridDim.y * gridDim.z;
    unsigned sum, cnt, mine, sp = 0u;
    for (;;) {
        sum = 0u; cnt = 0u; mine = 0u;
#pragma unroll
        for (unsigned j = 0; j < 16; ++j) { const unsigned c = xb_ld(&bar[XB_XCNT(j)]); sum += c; cnt += (c > 0u) ? 1u : 0u; mine = (j == x) ? c : mine; }
        if (sum == G) break;
        __builtin_amdgcn_s_sleep(1);
        if ((++sp & 255u) == 0u) { if (xb_ld(&bar[XB_TMO])) break; if (sp > XB_SPIN_CAP) { atomicAdd(&bar[XB_TMO], 1u); break; } }
    }
    nloc = mine > 0u ? mine : 1u; nx = cnt > 0u ? cnt : 1u;
}
__device__ __forceinline__ void xcd_barrier(const XcdBarrier& b) {
    asm volatile("s_waitcnt vmcnt(0)" ::: "memory");
    __syncthreads();
    if (threadIdx.x == 0) {
        unsigned* bar = b.bar;
        __builtin_amdgcn_s_waitcnt(0);
        unsigned nloc = b.st[0], nx = b.st[1];
        if (nloc == 0u) { xcd_barrier_complete(bar, b.x, nloc, nx); b.st[0] = nloc; b.st[1] = nx; }
        const unsigned old = xb_add(&bar[XB_XSUB(b.x)], 1u);
        const unsigned gen = old / nloc;
        if (old + 1u == (gen + 1u) * nloc) {
            __builtin_amdgcn_fence(__ATOMIC_RELEASE, "agent");
            asm volatile("s_waitcnt vmcnt(0)" ::: "memory");
            const unsigned og = xb_add(&bar[XB_TOP], 1u);
            const unsigned tg = og / nx;
            if (og + 1u == (tg + 1u) * nx) xb_add(&bar[XB_TOPGEN], 1u);
            else XB_SPIN(xb_ld(&bar[XB_TOPGEN]) == tg, bar);
            __builtin_amdgcn_fence(__ATOMIC_ACQUIRE, "agent");
            xb_add(&bar[XB_XGEN(b.x)], 1u);
            asm volatile("s_waitcnt vmcnt(0)" ::: "memory");
        } else {
            XB_SPIN(xb_ld(&bar[XB_XGEN(b.x)]) == gen, bar);
            __builtin_amdgcn_fence(__ATOMIC_ACQUIRE, "agent");
            asm volatile("s_waitcnt vmcnt(0)" ::: "memory");
        }
    }
    __syncthreads();
}

struct Args { const float* in[29]; float* out; unsigned char* ws; int ph_lo, ph_hi, li, pad; };
enum { I_X = 0, I_C, I_WMOD, I_BMOD, I_N1G, I_WIN, I_BIN, I_LNG, I_LNB, I_GWS, I_GBS, I_LRE, I_LIM, I_LDT, I_BRE, I_BIM, I_CRE, I_CIM, I_SD, I_GLUW, I_GLUB,
       I_BRG, I_WOUT, I_N2G, I_WQ, I_KEYS, I_PU, I_PV, I_FG };

struct Frame {
    LAS unsigned char* lds;
    unsigned char* ws;
    const float* const* in;
    float* out;
    int tid, lane, wave, vcu, G;
};

#define PH_LOCALS int tid = F.tid; asm volatile("" : "+v"(tid)); const int lane = tid & 63; const int wave = __builtin_amdgcn_readfirstlane(tid >> 6); (void)lane; (void)wave;

struct EpiIn {
    static constexpr bool PERM = true, AFTER_DRAIN = false;
    bf16* Z; bf16* XS; const float* bias;
    __device__ __forceinline__ void operator()(const f32x4 (&acc)[2][2][4][2], const pg8::Unit& u, int wr, int wc, int fr, int fq) const {
        const int row0 = u.pm * 256 + wr * 64 + fr, col0 = u.pn * 256 + wc * 32 + 8 * fq;
        f32x4 bv[2][2];
#pragma unroll
        for (int bj = 0; bj < 2; ++bj)
#pragma unroll
            for (int n = 0; n < 2; ++n) bv[bj][n] = *(const f32x4*)(bias + col0 + bj * 128 + 4 * n);
        const bool isz = (u.pn < 8);
#pragma unroll
        for (int ai = 0; ai < 2; ++ai)
#pragma unroll
            for (int m = 0; m < 4; ++m) {
                const int r = row0 + ai * 128 + m * 16;
#pragma unroll
                for (int bj = 0; bj < 2; ++bj) {
                    f32x4 v0 = acc[ai][bj][m][0] + bv[bj][0], v1 = acc[ai][bj][m][1] + bv[bj][1];
                    const int c = col0 + bj * 128;
                    u32x4 w;
                    if (isz) {
                        w.x = pg8::cvt_pk_bf16(gelu_tanh(v0[0]), gelu_tanh(v0[1])); w.y = pg8::cvt_pk_bf16(gelu_tanh(v0[2]), gelu_tanh(v0[3]));
                        w.z = pg8::cvt_pk_bf16(gelu_tanh(v1[0]), gelu_tanh(v1[1])); w.w = pg8::cvt_pk_bf16(gelu_tanh(v1[2]), gelu_tanh(v1[3]));
                        *(u32x4*)(Z + (size_t)r * 2048 + c) = w;
                    } else {
                        w.x = pg8::cvt_pk_bf16(v0[0], v0[1]); w.y = pg8::cvt_pk_bf16(v0[2], v0[3]); w.z = pg8::cvt_pk_bf16(v1[0], v1[1]); w.w = pg8::cvt_pk_bf16(v1[2], v1[3]);
                        const int cc = c - 2048, g = cc >> 4, i = cc & 15;
                        *(u32x4*)(XS + ((size_t)(g * 256 + (r >> 6)) * 64 + (r & 63)) * 16 + i) = w;
                    }
                }
            }
    }
};
struct EpiGlu {
    static constexpr bool PERM = true, AFTER_DRAIN = false;
    const bf16* Gb; bf16* MIX; const float* bias;
    __device__ __forceinline__ void operator()(const f32x4 (&acc)[2][2][4][2], const pg8::Unit& u, int wr, int wc, int fr, int fq) const {
        const int row0 = u.pm * 256 + wr * 64 + fr, col0 = u.pn * 256 + wc * 32 + 8 * fq;
        f32x4 bv[2][2];
#pragma unroll
        for (int bj = 0; bj < 2; ++bj)
#pragma unroll
            for (int n = 0; n < 2; ++n) bv[bj][n] = *(const f32x4*)(bias + col0 + bj * 128 + 4 * n);
#pragma unroll
        for (int ai = 0; ai < 2; ++ai)
#pragma unroll
            for (int m = 0; m < 4; ++m) {
                const int r = row0 + ai * 128 + m * 16;
#pragma unroll
                for (int bj = 0; bj < 2; ++bj) {
                    const f32x4 v0 = acc[ai][bj][m][0] + bv[bj][0], v1 = acc[ai][bj][m][1] + bv[bj][1];
                    const int c = col0 + bj * 128;
                    const u32x4 gw = *(const u32x4*)(Gb + (size_t)r * 1024 + c);
                    u32x4 w;
                    w.x = pg8::cvt_pk_bf16(bflo(gw.x) * fast_sigmoid(v0[0]), bfhi(gw.x) * fast_sigmoid(v0[1]));
                    w.y = pg8::cvt_pk_bf16(bflo(gw.y) * fast_sigmoid(v0[2]), bfhi(gw.y) * fast_sigmoid(v0[3]));
                    w.z = pg8::cvt_pk_bf16(bflo(gw.z) * fast_sigmoid(v1[0]), bfhi(gw.z) * fast_sigmoid(v1[1]));
                    w.w = pg8::cvt_pk_bf16(bflo(gw.w) * fast_sigmoid(v1[2]), bfhi(gw.w) * fast_sigmoid(v1[3]));
                    *(u32x4*)(MIX + (size_t)r * 2048 + 1024 + c) = w;
                }
            }
    }
};
template <bool XIN_BF16> struct EpiOut {
    static constexpr bool PERM = true, AFTER_DRAIN = false;
    const void* xin; bf16* X; const float* gate; float* PS;
    __device__ __forceinline__ void operator()(const f32x4 (&acc)[2][2][4][2], const pg8::Unit& u, int wr, int wc, int fr, int fq) const {
        const int row0 = u.pm * 256 + wr * 64 + fr, col0 = u.pn * 256 + wc * 32 + 8 * fq;
        f32x4 gv[2][2];
#pragma unroll
        for (int bj = 0; bj < 2; ++bj)
#pragma unroll
            for (int n = 0; n < 2; ++n) gv[bj][n] = *(const f32x4*)(gate + col0 + bj * 128 + 4 * n);
#pragma unroll
        for (int ai = 0; ai < 2; ++ai)
#pragma unroll
            for (int m = 0; m < 4; ++m) {
                const int r = row0 + ai * 128 + m * 16; float ssq = 0.f;
#pragma unroll
                for (int bj = 0; bj < 2; ++bj) {
                    const size_t off = (size_t)r * 2048 + col0 + bj * 128;
                    f32x4 x0, x1;
                    if (XIN_BF16) { const u32x4 w = *(const u32x4*)((const bf16*)xin + off); x0 = (f32x4){bflo(w.x), bfhi(w.x), bflo(w.y), bfhi(w.y)}; x1 = (f32x4){bflo(w.z), bfhi(w.z), bflo(w.w), bfhi(w.w)}; }
                    else { x0 = *(const f32x4*)((const float*)xin + off); x1 = *(const f32x4*)((const float*)xin + off + 4); }
                    const f32x4 y0 = x0 + gv[bj][0] * acc[ai][bj][m][0], y1 = x1 + gv[bj][1] * acc[ai][bj][m][1];
                    u32x4 o; o.x = pg8::cvt_pk_bf16(y0[0], y0[1]); o.y = pg8::cvt_pk_bf16(y0[2], y0[3]); o.z = pg8::cvt_pk_bf16(y1[0], y1[1]); o.w = pg8::cvt_pk_bf16(y1[2], y1[3]);
                    *(u32x4*)(X + off) = o;
                    ssq += (y0[0] * y0[0] + y0[1] * y0[1]) + (y0[2] * y0[2] + y0[3] * y0[3]) + (y1[0] * y1[0] + y1[1] * y1[1]) + (y1[2] * y1[2] + y1[3] * y1[3]);
                }
                ssq += __shfl_xor(ssq, 16); ssq += __shfl_xor(ssq, 32);
                if (fq == 0) PS[(size_t)r * 32 + u.pn * 4 + wc] = ssq;
            }
    }
};
struct EpiQ {
    static constexpr bool PERM = true, AFTER_DRAIN = false;
    bf16* Q; const float* c0; const LAS float* rrL; int pm0;
    __device__ __forceinline__ void operator()(const f32x4 (&acc)[2][2][4][2], const pg8::Unit& u, int wr, int wc, int fr, int fq) const {
        const int row0 = u.pm * 256 + wr * 64 + fr, col0 = u.pn * 256 + wc * 32 + 8 * fq;
        const LAS float* rrp = rrL + (u.pm == pm0 ? 0 : 256) + wr * 64 + fr;
        f32x4 cv[2][2];
#pragma unroll
        for (int bj = 0; bj < 2; ++bj)
#pragma unroll
            for (int n = 0; n < 2; ++n) cv[bj][n] = *(const f32x4*)(c0 + col0 + bj * 128 + 4 * n);
#pragma unroll
        for (int ai = 0; ai < 2; ++ai)
#pragma unroll
            for (int m = 0; m < 4; ++m) {
                const int r = row0 + ai * 128 + m * 16; const float rr = rrp[ai * 128 + m * 16];
#pragma unroll
                for (int bj = 0; bj < 2; ++bj) {
                    const f32x4 v0 = acc[ai][bj][m][0] * rr + cv[bj][0], v1 = acc[ai][bj][m][1] * rr + cv[bj][1];
                    u32x4 w; w.x = pg8::cvt_pk_bf16(v0[0], v0[1]); w.y = pg8::cvt_pk_bf16(v0[2], v0[3]); w.z = pg8::cvt_pk_bf16(v1[0], v1[1]); w.w = pg8::cvt_pk_bf16(v1[2], v1[3]);
                    *(u32x4*)(Q + (size_t)r * 2048 + col0 + bj * 128) = w;
                }
            }
    }
};
__device__ __forceinline__ void fill_rr(Frame& F, LAS float* rrL, int slot, int pm, int tid) {
    if (tid < 256) { const float* ps = (const float*)(F.ws + WS_PS) + ((size_t)pm * 256 + tid) * 32; float s = 0.f;
#pragma unroll
        for (int i = 0; i < 8; ++i) { const f32x4 v = *(const f32x4*)(ps + 4 * i); s += (v[0] + v[1]) + (v[2] + v[3]); }
        rrL[slot * 256 + tid] = 1.0f / sqrtf(s * (1.0f / DM) + EPS); }
}

__device__ __forceinline__ void p0_transpose_item(const float* W, int K, int N, bf16* WT, const float* kscale, LAS float* scr, int item, int lane, const float* kscale2 = nullptr) {
    const int nblk = N / 32, kb = item / nblk, nb = item % nblk, k0 = 64 * kb, n0 = 32 * nb;
#pragma unroll 8
    for (int i = 0; i < 32; ++i) { const int kk = 2 * i + (lane >> 5); float v = W[(size_t)(k0 + kk) * N + n0 + (lane & 31)]; if (kscale) { v *= kscale[k0 + kk]; if (kscale2) v *= 1.0f + kscale2[k0 + kk]; } scr[kk * 33 + (lane & 31)] = v; }
    LDS_WAIT(); asm volatile("" ::: "memory");
    const int c = lane & 7;
#pragma unroll
    for (int j = 0; j < 4; ++j) { const int n = (lane >> 3) + 8 * j; const LAS float* s = scr + (8 * c) * 33 + n;
        u32x4 o; o.x = pk2(s[0 * 33], s[1 * 33]); o.y = pk2(s[2 * 33], s[3 * 33]); o.z = pk2(s[4 * 33], s[5 * 33]); o.w = pk2(s[6 * 33], s[7 * 33]);
        *(u32x4*)(WT + (size_t)(n0 + n) * K + k0 + 8 * c) = o; }
    LDS_WAIT(); asm volatile("" ::: "memory");
}

__device__ __forceinline__ void norm_mod_row(const f32x4 (&v)[4][2], const float* gain, const float* scale, const float* shift, int lane, u32x4 (&o)[4]) {
    float s = 0.f;
#pragma unroll
    for (int j = 0; j < 4; ++j)
#pragma unroll
        for (int h = 0; h < 2; ++h) s += (v[j][h][0] * v[j][h][0] + v[j][h][1] * v[j][h][1]) + (v[j][h][2] * v[j][h][2] + v[j][h][3] * v[j][h][3]);
    const float rr = 1.0f / sqrtf(wave_sum(s) * (1.0f / DM) + EPS);
#pragma unroll
    for (int j = 0; j < 4; ++j) {
        const int c = j * 512 + lane * 8;
        f32x4 y[2];
#pragma unroll
        for (int h = 0; h < 2; ++h) {
            const f32x4 g = *(const f32x4*)(gain + c + 4 * h);
            y[h] = v[j][h] * rr * g;
            const f32x4 sc = *(const f32x4*)(scale + c + 4 * h), sh = *(const f32x4*)(shift + c + 4 * h); y[h] = y[h] * (sc + 1.0f) + sh;
        }
        o[j].x = pk2(y[0][0], y[0][1]); o[j].y = pk2(y[0][2], y[0][3]); o[j].z = pk2(y[1][0], y[1][1]); o[j].w = pk2(y[1][2], y[1][3]);
    }
}
template <bool SRC_BF16>
__device__ __forceinline__ void norm_row_pass(const void* xrow_, bf16* hrow, const float* gain, const float* scale, const float* shift, int lane) {
    f32x4 v[4][2];
#pragma unroll
    for (int j = 0; j < 4; ++j) {
        if (SRC_BF16) { const u32x4 w = *(const u32x4*)((const bf16*)xrow_ + j * 512 + lane * 8); v[j][0] = (f32x4){bflo(w.x), bfhi(w.x), bflo(w.y), bfhi(w.y)}; v[j][1] = (f32x4){bflo(w.z), bfhi(w.z), bflo(w.w), bfhi(w.w)}; }
        else { const float* xrow = (const float*)xrow_; v[j][0] = *(const f32x4*)(xrow + j * 512 + lane * 8); v[j][1] = *(const f32x4*)(xrow + j * 512 + lane * 8 + 4); } }
    u32x4 o[4]; norm_mod_row(v, gain, scale, shift, lane, o);
#pragma unroll
    for (int j = 0; j < 4; ++j) *(u32x4*)(hrow + j * 512 + lane * 8) = o[j];
}

__device__ __forceinline__ void p0_gemv_unit(Frame& F, int unit, int tid, float* modout) {
    const int l = unit / 192, r = unit % 192, cb = r >> 1, kh = r & 1;
    LAS float* sc = (LAS float*)F.lds;
    LAS float* red = (LAS float*)(F.lds + 4096);
    for (int k = tid; k < 1024; k += NTHR) { const float c = F.in[I_C][kh * 1024 + k]; sc[k] = c * fast_sigmoid(c); }
    __syncthreads();
    const int tx = tid & 31, ty = tid >> 5;
    const float* W = F.in[I_WMOD] + ((size_t)l * DM + kh * 1024) * 12288 + cb * 128 + tx * 4;
    f32x4 a = {0.f, 0.f, 0.f, 0.f};
#pragma unroll 16
    for (int k = ty; k < 1024; k += 16) { const f32x4 w = *(const f32x4*)(W + (size_t)k * 12288); a += w * sc[k]; }
    *(LAS f32x4*)(red + ty * 128 + tx * 4) = a;
    __syncthreads();
    if (tid < 128) { float s = 0.f;
#pragma unroll
        for (int y = 0; y < 16; ++y) s += red[y * 128 + tid];
        if (kh == 0) s += F.in[I_BMOD][l * 12288 + cb * 128 + tid];
        atomicAdd(modout + l * 12288 + cb * 128 + tid, s); }
    __syncthreads();
}
__device__ __forceinline__ void p0_s5_unit(Frame& F, int unit, int tid, int parts = 15) {
    const int l = unit >> 7, g = (unit >> 1) & 63, hf = unit & 1;
    LAS float* apr = (LAS float*)F.lds;
    LAS float* api = apr + 4228;
    LAS float* bbr = api + 4228;
    LAS float* bbi = bbr + 1024;
    LAS float* ccr = bbi + 1024;
    LAS float* cci = ccr + 16 * 65;
    const float dt = expf(F.in[I_LDT][l * 64 + g]);
    const float* lre = F.in[I_LRE] + (l * 64 + g) * 64; const float* lim = F.in[I_LIM] + (l * 64 + g) * 64;
    for (int idx = tid; idx < 65 * 64; idx += NTHR) { const int d = idx >> 6, p = idx & 63;
        const float mag = expf(lre[p] * dt * (float)d); float sn, cs; sincosf(lim[p] * dt * (float)d, &sn, &cs);
        apr[d * 65 + p] = mag * cs; api[d * 65 + p] = mag * sn; }
    for (int idx = tid; idx < 1024; idx += NTHR) { const int o = idx >> 6, p = idx & 63;
        ccr[o * 65 + p] = F.in[I_CRE][((size_t)(l * 64 + g) * 16 + o) * 64 + p]; cci[o * 65 + p] = F.in[I_CIM][((size_t)(l * 64 + g) * 16 + o) * 64 + p]; }
    __syncthreads();
    for (int idx = tid; idx < 1024; idx += NTHR) { const int p = idx >> 4, i = idx & 15;
        const float xr = apr[65 + p] - 1.0f, xi = api[65 + p], lr = lre[p], li = lim[p], den = 1.0f / (lr * lr + li * li);
        const float cr = (xr * lr + xi * li) * den, ci = (xi * lr - xr * li) * den;
        const float br = F.in[I_BRE][((size_t)(l * 64 + g) * 64 + p) * 16 + i], bi = F.in[I_BIM][((size_t)(l * 64 + g) * 64 + p) * 16 + i];
        bbr[idx] = cr * br - ci * bi; bbi[idx] = cr * bi + ci * br; }
    __syncthreads();
    bf16* KT = (bf16*)(F.ws + WS_KTAB) + (size_t)(l * 64 + g) * 80 * 256;
    if (parts & 1) {
        const int d = hf * 32 + (tid >> 4), o = tid & 15;
        const float dskip = F.in[I_SD][l * 1024 + g * 16 + o];
        float s[16];
#pragma unroll
        for (int i = 0; i < 16; ++i) s[i] = 0.f;
        for (int p = 0; p < 64; ++p) { const float ar = apr[d * 65 + p], ai = api[d * 65 + p], cr = ccr[o * 65 + p], ci = cci[o * 65 + p];
            const float er = cr * ar - ci * ai, ei = cr * ai + ci * ar;
#pragma unroll
            for (int q = 0; q < 4; ++q) { const f32x4 br = *(const LAS f32x4*)(bbr + p * 16 + 4 * q), bi = *(const LAS f32x4*)(bbi + p * 16 + 4 * q);
#pragma unroll
                for (int e = 0; e < 4; ++e) s[4 * q + e] += er * br[e] - ei * bi[e]; } }
#if !SELFTEST_S5
        {   const float dsk = (d == 0) ? dskip : 0.f;
#pragma unroll
            for (int i = 0; i < 16; ++i) s[i] += (i == o) ? dsk : 0.f; }
#endif
        u32x4 w0, w1;
        w0.x = pk2(s[0], s[1]); w0.y = pk2(s[2], s[3]); w0.z = pk2(s[4], s[5]); w0.w = pk2(s[6], s[7]);
        w1.x = pk2(s[8], s[9]); w1.y = pk2(s[10], s[11]); w1.z = pk2(s[12], s[13]); w1.w = pk2(s[14], s[15]);
        if ((parts & 8) || w0.x == 0x12345678u) { *(u32x4*)(KT + (size_t)(d + 16) * 256 + o * 16) = w0; *(u32x4*)(KT + (size_t)(d + 16) * 256 + o * 16 + 8) = w1; }
        if ((parts & 8) && hf == 0 && tid < 256) { const u32x4 z = {0u, 0u, 0u, 0u}; *(u32x4*)(KT + tid * 16) = z; *(u32x4*)(KT + tid * 16 + 8) = z; }
    }
    bf16* WG = (bf16*)(F.ws + WS_WG) + (size_t)(l * 64 + g) * 128 * 1024;
    if (parts & 2) for (int it = tid; it < 32 * 64; it += NTHR) { const int p = hf * 32 + (it >> 6), tau = it & 63;
        const float ar = apr[(63 - tau) * 65 + p], ai = api[(63 - tau) * 65 + p];
        unsigned wr_[8], wi_[8];
#pragma unroll
        for (int q = 0; q < 4; ++q) { const f32x4 br = *(const LAS f32x4*)(bbr + p * 16 + 4 * q), bi = *(const LAS f32x4*)(bbi + p * 16 + 4 * q);
            wr_[2 * q] = pk2(ar * br[0] - ai * bi[0], ar * br[1] - ai * bi[1]); wr_[2 * q + 1] = pk2(ar * br[2] - ai * bi[2], ar * br[3] - ai * bi[3]);
            wi_[2 * q] = pk2(ar * bi[0] + ai * br[0], ar * bi[1] + ai * br[1]); wi_[2 * q + 1] = pk2(ar * bi[2] + ai * br[2], ar * bi[3] + ai * br[3]); }
        *(u32x4*)(WG + (size_t)p * 1024 + tau * 16) = (u32x4){wr_[0], wr_[1], wr_[2], wr_[3]}; *(u32x4*)(WG + (size_t)p * 1024 + tau * 16 + 8) = (u32x4){wr_[4], wr_[5], wr_[6], wr_[7]};
        *(u32x4*)(WG + (size_t)(64 + p) * 1024 + tau * 16) = (u32x4){wi_[0], wi_[1], wi_[2], wi_[3]}; *(u32x4*)(WG + (size_t)(64 + p) * 1024 + tau * 16 + 8) = (u32x4){wi_[4], wi_[5], wi_[6], wi_[7]}; }
    bf16* VG = (bf16*)(F.ws + WS_VG) + (size_t)(l * 64 + g) * 1024 * 128;
    if (parts & 4) for (int it = tid; it < 512 * 8; it += NTHR) { const int m = hf * 512 + (it >> 3), p0 = (it & 7) * 8, t = m >> 4, o = m & 15;
        float vr_[8], vi_[8];
#pragma unroll
        for (int e = 0; e < 8; ++e) { const float ar = apr[(t + 1) * 65 + p0 + e], ai = api[(t + 1) * 65 + p0 + e], cr = ccr[o * 65 + p0 + e], ci = cci[o * 65 + p0 + e];
            vr_[e] = cr * ar - ci * ai; vi_[e] = -(cr * ai + ci * ar); }
        *(u32x4*)(VG + (size_t)m * 128 + p0) = (u32x4){pk2(vr_[0], vr_[1]), pk2(vr_[2], vr_[3]), pk2(vr_[4], vr_[5]), pk2(vr_[6], vr_[7])};
        *(u32x4*)(VG + (size_t)m * 128 + 64 + p0) = (u32x4){pk2(vi_[0], vi_[1]), pk2(vi_[2], vi_[3]), pk2(vi_[4], vi_[5]), pk2(vi_[6], vi_[7])}; }
    if (hf == 0 && tid < 64) { float* AT = (float*)(F.ws + WS_AT) + ((size_t)(l * 64 + g) * 64 + tid) * 2; AT[0] = apr[64 * 65 + tid]; AT[1] = api[64 * 65 + tid]; }
    __syncthreads();
}
__device__ __forceinline__ void p0_fp4_chunk(Frame& F, int chunk, int wave, int lane) {
    unsigned char* UV = F.ws + WS_UV; float* SCL = (float*)(F.ws + WS_SCL);
    for (int i = 0; i < 8; ++i) {
        const int r = chunk * 64 + wave * 8 + i;
        const int tbl = r >> 15, rr = r & 32767;
        const float* srcp = (tbl ? F.in[I_PV] : F.in[I_PU]) + (size_t)rr * 2048 + lane * 4;
        f32x4 v[8]; float am = 0.f;
#pragma unroll
        for (int j = 0; j < 8; ++j) { v[j] = *(const f32x4*)(srcp + j * 256); am = fmaxf(am, fmaxf(fmaxf(fabsf(v[j][0]), fabsf(v[j][1])), fmaxf(fabsf(v[j][2]), fabsf(v[j][3])))); }
#pragma unroll
        for (int o = 1; o < 64; o <<= 1) am = fmaxf(am, __shfl_xor(am, o));
        const float scale = am > 0.f ? am * (1.0f / 6.0f) : 1.0f, inv = am > 0.f ? 6.0f / am : 1.0f;
        u32x4 o;
#pragma unroll
        for (int d = 0; d < 4; ++d) { unsigned w = 0u;
            w = __builtin_amdgcn_cvt_scalef32_pk_fp4_f32(w, v[2 * d][0] * inv, v[2 * d][1] * inv, 1.0f, 0);
            w = __builtin_amdgcn_cvt_scalef32_pk_fp4_f32(w, v[2 * d][2] * inv, v[2 * d][3] * inv, 1.0f, 1);
            w = __builtin_amdgcn_cvt_scalef32_pk_fp4_f32(w, v[2 * d + 1][0] * inv, v[2 * d + 1][1] * inv, 1.0f, 2);
            w = __builtin_amdgcn_cvt_scalef32_pk_fp4_f32(w, v[2 * d + 1][2] * inv, v[2 * d + 1][3] * inv, 1.0f, 3);
            o[d] = w; }
        *(u32x4*)(UV + (size_t)rr * 2048 + tbl * 1024 + lane * 16) = o;
        if (lane == 0) SCL[rr * 2 + tbl] = scale;
    }
}
#ifndef P0_PARTS
#define P0_PARTS 15
#endif
#ifndef P0_PROBE_MODE
#define P0_PROBE_MODE 0
#endif
__device__ __forceinline__ void p0_tables(Frame& F, int qi = 4, bool dummy = false) {
    PH_LOCALS
    unsigned* head = (unsigned*)(F.ws + WS_CTL) + CW_QUEUE + 64 * qi;
    float* modout = dummy ? (float*)(F.ws + WS_DBG) : (float*)(F.ws + WS_MOD);
    LAS unsigned* slot = (LAS unsigned*)(F.lds + MISC_OFF) + 16;
    for (;;) {
        __syncthreads();
        if (tid == 0) slot[0] = __hip_atomic_fetch_add(head, 1u, RLX_AGENT);
        __syncthreads();
        const unsigned u = slot[0];
        if (u >= 1664u) break;
        const int rnd = (int)u / 13, k = (int)u % 13;
        if (k < 2) { if (dummy && P0_PROBE_MODE == 2) continue; p0_s5_unit(F, rnd * 2 + k, tid, dummy ? P0_PARTS : 15); }
        else if (k < 5) { if (dummy && P0_PROBE_MODE == 1) continue; p0_gemv_unit(F, rnd * 3 + (k - 2), tid, modout); }
        else { p0_fp4_chunk(F, rnd * 8 + (k - 5), wave, lane); }
    }
}
__device__ __forceinline__ void p0_prologue(Frame& F) {
    PH_LOCALS
    const int gw = F.vcu * NWAVES + wave, NGW = F.G * NWAVES;
    const int gt = F.vcu * NTHR + tid, NGT = F.G * NTHR;
    const float* modp = (const float*)(F.ws + WS_MOD);
    for (int i = gt; i < 2 * DM; i += NGT) { const int l = i >> 11, k = i & 2047; ((float*)(F.ws + WS_GS))[i] = F.in[I_N2G][i] * (1.0f + modp[l * 12288 + 4 * 2048 + k]); }
    if (F.vcu < 64) {
        const int l = F.vcu >> 5, cb = F.vcu & 31, tx = tid & 15, ty = tid >> 4;
        const float* W = F.in[I_WQ] + (size_t)l * DM * DM + cb * 64 + tx * 4; const float* sh = modp + l * 12288 + 3 * 2048;
        f32x4 a = {0.f, 0.f, 0.f, 0.f};
#pragma unroll 16
        for (int k = ty; k < DM; k += 32) { const f32x4 w = *(const f32x4*)(W + (size_t)k * DM); a += w * sh[k]; }
        LAS float* red = (LAS float*)F.lds;
        *(LAS f32x4*)(red + ty * 64 + tx * 4) = a;
        __syncthreads();
        if (tid < 64) { float s = 0.f;
#pragma unroll
            for (int y = 0; y < 32; ++y) s += red[y * 64 + tid];
            ((float*)(F.ws + WS_C0))[l * DM + cb * 64 + tid] = s; }
        __syncthreads();
    }
    {
        LAS float* scr = (LAS float*)(F.lds + wave * 16384);
        constexpr int I_IN = (DM / 64) * (INW / 32), I_GL = (WB / 64) * (WB / 32), I_OU = (DM / 64) * (DM / 32), I_Q = I_OU;
        constexpr int PER_L = I_IN + I_GL + I_OU + I_Q;
        for (int it = gw; it < 2 * PER_L; it += NGW) {
            const int l = it / PER_L; int r = it % PER_L;
            if (r < I_IN) { p0_transpose_item(F.in[I_WIN] + (size_t)l * DM * INW, DM, INW, (bf16*)(F.ws + WS_WIN) + (size_t)l * INW * DM, nullptr, scr, r, lane); continue; } r -= I_IN;
            if (r < I_GL) { p0_transpose_item(F.in[I_GLUW] + (size_t)l * WB * WB, WB, WB, (bf16*)(F.ws + WS_GLU) + (size_t)l * WB * WB, nullptr, scr, r, lane); continue; } r -= I_GL;
            if (r < I_OU) { p0_transpose_item(F.in[I_WOUT] + (size_t)l * DM * DM, DM, DM, (bf16*)(F.ws + WS_WOUT) + (size_t)l * DM * DM, F.in[I_BRG] + l * DM, scr, r, lane); continue; } r -= I_OU;
            p0_transpose_item(F.in[I_WQ] + (size_t)l * DM * DM, DM, DM, (bf16*)(F.ws + WS_WQ) + (size_t)l * DM * DM, F.in[I_N2G] + l * DM, scr, r, lane, modp + l * 12288 + 4 * 2048);
        }
    }
    {
        bf16* KB = (bf16*)(F.ws + WS_KEYS);
        for (int i = gt; i < 2 * 8 * 2 * 128 * 128 / 8; i += NGT) { const f32x4 a = *(const f32x4*)(F.in[I_KEYS] + (size_t)i * 8), b = *(const f32x4*)(F.in[I_KEYS] + (size_t)i * 8 + 4);
            u32x4 o; o.x = pk2(a[0], a[1]); o.y = pk2(a[2], a[3]); o.z = pk2(b[0], b[1]); o.w = pk2(b[2], b[3]); *(u32x4*)(KB + (size_t)i * 8) = o; }
        bf16* GW = (bf16*)(F.ws + WS_GWS);
        for (int i = gt; i < 2 * 8 * 128 * 128 / 8; i += NGT) { const int e = i * 8, jj = e & 127, ii = (e >> 7) & 127; const bool keep = (ii >= 64) || (jj < 64);
            f32x4 a = *(const f32x4*)(F.in[I_GWS] + (size_t)i * 8), b = *(const f32x4*)(F.in[I_GWS] + (size_t)i * 8 + 4);
            if (!keep) { a = (f32x4){0.f, 0.f, 0.f, 0.f}; b = a; }
            u32x4 o; o.x = pk2(a[0], a[1]); o.y = pk2(a[2], a[3]); o.z = pk2(b[0], b[1]); o.w = pk2(b[2], b[3]); *(u32x4*)(GW + (size_t)i * 8) = o; }
    }
}

template <bool SRC_BF16>
__device__ __forceinline__ void phase_norm(Frame& F, const void* xsrc, const float* gain, const float* scale, const float* shift) {
    PH_LOCALS
    const int gw = F.vcu * NWAVES + wave, NGW = F.G * NWAVES;
    bf16* H = (bf16*)(F.ws + WS_H);
    for (int m = gw; m < M; m += NGW) norm_row_pass<SRC_BF16>((const char*)xsrc + (size_t)m * DM * (SRC_BF16 ? 2 : 4), H + (size_t)m * DM, gain, scale, shift, lane);
}
__device__ __forceinline__ void phase_lnstats(Frame& F) {
    PH_LOCALS
    const int gw = F.vcu * NWAVES + wave, NGW = F.G * NWAVES;
    const bf16* Z = (const bf16*)(F.ws + WS_Z); float* ST = (float*)(F.ws + WS_STATS);
    for (int m = gw; m < M; m += NGW) {
        float v[16];
#pragma unroll
        for (int j = 0; j < 2; ++j) { const u32x4 w = *(const u32x4*)(Z + (size_t)m * 2048 + 1024 + j * 512 + lane * 8);
            v[j * 8 + 0] = bflo(w.x); v[j * 8 + 1] = bfhi(w.x); v[j * 8 + 2] = bflo(w.y); v[j * 8 + 3] = bfhi(w.y); v[j * 8 + 4] = bflo(w.z); v[j * 8 + 5] = bfhi(w.z); v[j * 8 + 6] = bflo(w.w); v[j * 8 + 7] = bfhi(w.w); }
        float s = 0.f;
#pragma unroll
        for (int i = 0; i < 16; ++i) s += v[i];
        const float mean = wave_sum(s) * (1.0f / 1024.0f); float q = 0.f;
#pragma unroll
        for (int i = 0; i < 16; ++i) { const float d = v[i] - mean; q += d * d; }
        const float rstd = 1.0f / sqrtf(wave_sum(q) * (1.0f / 1024.0f) + EPS);
        if (lane == 0) { ST[2 * m] = mean; ST[2 * m + 1] = rstd; }
    }
}
__device__ __forceinline__ void phase_branchnorm(Frame& F) {
    PH_LOCALS
    const int gw = F.vcu * NWAVES + wave, NGW = F.G * NWAVES;
    bf16* MIX = (bf16*)(F.ws + WS_MIX);
    for (int m = gw; m < M; m += NGW) {
        u32x4 w[4]; float sa = 0.f, sb = 0.f;
#pragma unroll
        for (int j = 0; j < 4; ++j) { w[j] = *(const u32x4*)(MIX + (size_t)m * 2048 + j * 512 + lane * 8);
            float q = 0.f;
#pragma unroll
            for (int e = 0; e < 4; ++e) { const float a = bflo(w[j][e]), b = bfhi(w[j][e]); q += a * a + b * b; }
            if (j < 2) sa += q; else sb += q; }
        const float ra = 1.0f / sqrtf(wave_sum(sa) * (1.0f / 1024.0f) + EPS), rb = 1.0f / sqrtf(wave_sum(sb) * (1.0f / 1024.0f) + EPS);
#pragma unroll
        for (int j = 0; j < 4; ++j) { const float r = j < 2 ? ra : rb; u32x4 o;
#pragma unroll
            for (int e = 0; e < 4; ++e) o[e] = pk2(bflo(w[j][e]) * r, bfhi(w[j][e]) * r);
            *(u32x4*)(MIX + (size_t)m * 2048 + j * 512 + lane * 8) = o; }
    }
}

__device__ __forceinline__ void phase_sloc(Frame& F, int l) {
    PH_LOCALS
    const bf16* XS = (const bf16*)(F.ws + WS_XS); const bf16* WG = (const bf16*)(F.ws + WS_WG) + (size_t)l * 64 * 128 * 1024; float* SL = (float*)(F.ws + WS_SLOC);
    const int fr = lane & 15, fq = lane >> 4;
    for (int u = F.vcu; u < 256; u += F.G) {
        const int g = u >> 2, n0 = (u & 3) * 64 + (wave & 3) * 16, jh = wave >> 2;
        f32x4 acc[4];
#pragma unroll
        for (int t = 0; t < 4; ++t) acc[t] = (f32x4){0.f, 0.f, 0.f, 0.f};
        const bf16* xp = XS + ((size_t)(g * 256 + n0 + fr)) * 1024 + 8 * fq;
        const bf16* wp = WG + ((size_t)(g * 128 + jh * 64 + fr)) * 1024 + 8 * fq;
#pragma unroll 8
        for (int kb = 0; kb < 32; ++kb) {
            const bf16x8 xf = *(const bf16x8*)(xp + kb * 32);
#pragma unroll
            for (int t = 0; t < 4; ++t) { const bf16x8 wf = *(const bf16x8*)(wp + (size_t)t * 16 * 1024 + kb * 32); acc[t] = __builtin_amdgcn_mfma_f32_16x16x32_bf16(wf, xf, acc[t], 0, 0, 0); }
        }
#pragma unroll
        for (int t = 0; t < 4; ++t) *(f32x4*)(SL + ((size_t)(g * 256 + n0 + fr)) * 128 + jh * 64 + t * 16 + 4 * fq) = acc[t];
    }
}
__device__ __forceinline__ void gating_unit(Frame& F, int l, int unit) {
    PH_LOCALS
    const int nb = unit >> 3, hh = unit & 7, t0 = nb * 128, c0 = hh * 128;
    const bf16* Z = (const bf16*)(F.ws + WS_Z); const float* ST = (const float*)(F.ws + WS_STATS);
    const bf16* GW = (const bf16*)(F.ws + WS_GWS) + (size_t)(l * 8 + hh) * 128 * 128;
    bf16* MIX = (bf16*)(F.ws + WS_MIX);
    LAS bf16* VT = (LAS bf16*)F.lds;
    constexpr int VS = 136;
    {
        const int j = tid >> 2, cs = (tid & 3) * 32;
        const float mu = ST[2 * (t0 + j)], rs = ST[2 * (t0 + j) + 1];
        const float* lg = F.in[I_LNG] + l * 1024 + c0 + cs; const float* lb = F.in[I_LNB] + l * 1024 + c0 + cs;
#pragma unroll
        for (int q = 0; q < 4; ++q) {
            const u32x4 w = *(const u32x4*)(Z + (size_t)(t0 + j) * 2048 + 1024 + c0 + cs + q * 8);
#pragma unroll
            for (int e = 0; e < 4; ++e) { const int c = cs + q * 8 + 2 * e;
                const float a = (bflo(w[e]) - mu) * rs * lg[q * 8 + 2 * e] + lb[q * 8 + 2 * e], b = (bfhi(w[e]) - mu) * rs * lg[q * 8 + 2 * e + 1] + lb[q * 8 + 2 * e + 1];
                VT[c * VS + j] = (bf16)f2bf(a); VT[(c + 1) * VS + j] = (bf16)f2bf(b); }
        }
    }
    __syncthreads();
    {
        const int fr = lane & 15, fq = lane >> 4, w = wave;
        f32x4 acc[8];
#pragma unroll
        for (int ct = 0; ct < 8; ++ct) acc[ct] = (f32x4){0.f, 0.f, 0.f, 0.f};
        const int nkb = (w < 4) ? 2 : 4;
        for (int kb = 0; kb < nkb; ++kb) {
            const bf16x8 wf = *(const bf16x8*)(GW + (size_t)(16 * w + fr) * 128 + kb * 32 + 8 * fq);
#pragma unroll
            for (int ct = 0; ct < 8; ++ct) { const bf16x8 vf = *(const LAS bf16x8*)(VT + (ct * 16 + fr) * VS + kb * 32 + 8 * fq); acc[ct] = __builtin_amdgcn_mfma_f32_16x16x32_bf16(vf, wf, acc[ct], 0, 0, 0); }
        }
        const int tok = t0 + 16 * w + fr; const float bs = F.in[I_GBS][(l * 8 + hh) * 128 + 16 * w + fr];
#pragma unroll
        for (int ct = 0; ct < 8; ++ct) { const int c = c0 + ct * 16 + 4 * fq;
            const u32x2 uw = *(const u32x2*)(Z + (size_t)tok * 2048 + c);
            u32x2 o; o.x = pk2(bflo(uw.x) * (acc[ct][0] + bs), bfhi(uw.x) * (acc[ct][1] + bs)); o.y = pk2(bflo(uw.y) * (acc[ct][2] + bs), bfhi(uw.y) * (acc[ct][3] + bs));
            *(u32x2*)(MIX + (size_t)tok * 2048 + c) = o; }
    }
    __syncthreads();
}
__device__ __forceinline__ void phase_gating(Frame& F, int l) {
    for (int u = F.vcu; u < 1024; u += F.G) gating_unit(F, l, u);
}

__device__ __forceinline__ void phase_s5out(Frame& F, int l) {
    PH_LOCALS
    const bf16* XS = (const bf16*)(F.ws + WS_XS);
    bf16* Gb = (bf16*)(F.ws + WS_G);
    LAS unsigned char* HT = F.lds;
    LAS float* TS = (LAS float*)(F.lds + 34816);
    LAS unsigned char* KT = F.lds + 38912;
    LAS unsigned char* VT = F.lds + 79872;
    const int fr = lane & 15, fq = lane >> 4;
    for (int u = F.vcu; u < 512; u += F.G) {
        const int g = u >> 3, rc = (u >> 1) & 3, nh = u & 1;
        const bf16* VG = (const bf16*)(F.ws + WS_VG) + (size_t)(l * 64 + g) * 1024 * 128;
        const int n = nh * 128 + 16 * wave + fr;
        const bf16* xp0 = XS + ((size_t)(g * 256 + n)) * 1024 + 8 * fq;
        bf16x8 xa[4], xb[4];
#pragma unroll
        for (int i = 0; i < 4; ++i) xa[i] = *(const bf16x8*)(xp0 + i * 32);
        __syncthreads();
        { const u32x4* src = (const u32x4*)((const bf16*)(F.ws + WS_KTAB) + (size_t)(l * 64 + g) * 80 * 256);
          for (int i = tid; i < 80 * 256 / 8; i += NTHR) ((LAS u32x4*)KT)[i] = src[i];
#pragma unroll
          for (int ps = 0; ps < 8; ++ps) { const int row = ps * 32 + (tid >> 4), c = tid & 15, q = row >> 4, o = row & 15;
              *(LAS u32x4*)(VT + row * 272 + c * 16) = *(const u32x4*)(VG + (size_t)((rc + 4 * q) * 16 + o) * 128 + c * 8); } }
        {
            const int p = lane, seg = wave;
            const float* AT = (const float*)(F.ws + WS_AT) + ((size_t)(l * 64 + g) * 64 + p) * 2; const float ar = AT[0], ai = AT[1];
            const float* SL = (const float*)(F.ws + WS_SLOC) + ((size_t)(g * 256 + seg * 32)) * 128 + p;
            float sr[32], si[32];
#pragma unroll
            for (int i = 0; i < 32; ++i) { sr[i] = SL[(size_t)i * 128]; si[i] = SL[(size_t)i * 128 + 64]; }
            float er = 0.f, ei = 0.f;
#pragma unroll
            for (int i = 0; i < 32; ++i) { const float nr = ar * er - ai * ei + sr[i], ni = ar * ei + ai * er + si[i]; er = nr; ei = ni; }
            TS[(seg * 64 + p) * 2] = er; TS[(seg * 64 + p) * 2 + 1] = ei;
            float qr = ar, qi = ai;
#pragma unroll
            for (int s = 0; s < 5; ++s) { const float nr = qr * qr - qi * qi, ni = 2.0f * qr * qi; qr = nr; qi = ni; }
            __syncthreads();
            float hr = 0.f, hi = 0.f;
            for (int k = 0; k < seg; ++k) { const float tr = TS[(k * 64 + p) * 2], ti = TS[(k * 64 + p) * 2 + 1]; const float nr = qr * hr - qi * hi + tr, ni = qr * hi + qi * hr + ti; hr = nr; hi = ni; }
            if ((seg >> 2) == nh) {
                LAS bf16* hrow = (LAS bf16*)(HT + ((seg & 3) * 32) * 272) + p;
#pragma unroll
                for (int i = 0; i < 32; ++i) { hrow[i * 136] = (bf16)f2bf(hr); hrow[i * 136 + 64] = (bf16)f2bf(hi);
                    const float nr = ar * hr - ai * hi + sr[i], ni = ar * hi + ai * hr + si[i]; hr = nr; hi = ni; }
            }
        }
        __syncthreads();
        f32x4 acc[16];
#pragma unroll
        for (int q = 0; q < 16; ++q) acc[q] = (f32x4){0.f, 0.f, 0.f, 0.f};
        const int kb0 = ((rc - (fq >> 1) + 10) * 16 + fr) * 32 + 16 * (fq & 1);
#define S5_GROUP(XF, grp_) do { const LAS unsigned char* kp = KT + kb0 - (grp_) * 4096; \
            _Pragma("unroll") for (int q = 0; q < 16; ++q) { if (rc + 4 * q >= 8 * (grp_)) { \
                _Pragma("unroll") for (int i = 0; i < 4; ++i) { const bf16x8 kf = *(const LAS bf16x8*)(kp + (4 * q - 2 * i + 6) * 512); \
                    acc[q] = __builtin_amdgcn_mfma_f32_16x16x32_bf16(kf, XF[i], acc[q], 0, 0, 0); } } } } while (0)
#pragma unroll 1
        for (int gp = 0; gp < 4; ++gp) {
#pragma unroll
            for (int i = 0; i < 4; ++i) xb[i] = *(const bf16x8*)(xp0 + ((2 * gp + 1) * 4 + i) * 32);
            S5_GROUP(xa, 2 * gp);
            if (gp < 3) {
#pragma unroll
                for (int i = 0; i < 4; ++i) xa[i] = *(const bf16x8*)(xp0 + ((2 * gp + 2) * 4 + i) * 32);
            }
            S5_GROUP(xb, 2 * gp + 1);
        }
#undef S5_GROUP
#pragma unroll 1
        for (int jb = 0; jb < 4; ++jb) {
            const bf16x8 hf = *(const LAS bf16x8*)(HT + (16 * wave + fr) * 272 + (jb * 32 + 8 * fq) * 2);
#pragma unroll
            for (int q = 0; q < 16; ++q) {
                const bf16x8 vf = *(const LAS bf16x8*)(VT + (q * 16 + fr) * 272 + (jb * 32 + 8 * fq) * 2);
                acc[q] = __builtin_amdgcn_mfma_f32_16x16x32_bf16(vf, hf, acc[q], 0, 0, 0);
            }
        }
#pragma unroll
        for (int q = 0; q < 16; ++q) {
            const int t = rc + 4 * q, tok = 64 * n + t;
            const f32x4 y = acc[q];
            u32x2 o; o.x = pk2(gelu_tanh(y[0]), gelu_tanh(y[1])); o.y = pk2(gelu_tanh(y[2]), gelu_tanh(y[3]));
            *(u32x2*)(Gb + (size_t)tok * 1024 + g * 16 + 4 * fq) = o;
#if SELFTEST_S5
            if (tok < 256) *(f32x4*)((float*)(F.ws + WS_DBG) + (size_t)tok * 1024 + g * 16 + 4 * fq) = y;
#endif
        }
    }
    __syncthreads();
}
#if SELFTEST_S5
__device__ __forceinline__ void selftest_s5(Frame& F, int l) {
    PH_LOCALS
    if (F.vcu < 64 && wave == 0) {
        const int g = F.vcu, p = lane;
        const float dt = expf(F.in[I_LDT][l * 64 + g]);
        const float lr = F.in[I_LRE][(l * 64 + g) * 64 + p], li = F.in[I_LIM][(l * 64 + g) * 64 + p];
        const float mag = expf(lr * dt); float sn, cs; sincosf(li * dt, &sn, &cs);
        const float ar = mag * cs, ai = mag * sn;
        const float xr = ar - 1.0f, xi = ai, den = 1.0f / (lr * lr + li * li);
        const float cr = (xr * lr + xi * li) * den, ci = (xi * lr - xr * li) * den;
        float bbr[16], bbi[16], ccr[16], cci[16];
#pragma unroll
        for (int i = 0; i < 16; ++i) { const float br = F.in[I_BRE][((size_t)(l * 64 + g) * 64 + p) * 16 + i], bi = F.in[I_BIM][((size_t)(l * 64 + g) * 64 + p) * 16 + i];
            bbr[i] = cr * br - ci * bi; bbi[i] = cr * bi + ci * br;
            ccr[i] = F.in[I_CRE][((size_t)(l * 64 + g) * 16 + i) * 64 + p]; cci[i] = F.in[I_CIM][((size_t)(l * 64 + g) * 16 + i) * 64 + p]; }
        const bf16* XS = (const bf16*)(F.ws + WS_XS) + (size_t)g * 256 * 1024;
        const float* DY = (const float*)(F.ws + WS_DBG);
        float sr = 0.f, si = 0.f, err = 0.f, ref = 0.f;
        for (int t = 0; t < 256; ++t) {
            float x[16];
#pragma unroll
            for (int i = 0; i < 16; ++i) x[i] = bflo((unsigned)XS[(size_t)t * 16 + i]);
            float ur = 0.f, ui = 0.f;
#pragma unroll
            for (int i = 0; i < 16; ++i) { ur += bbr[i] * x[i]; ui += bbi[i] * x[i]; }
            const float nr = ar * sr - ai * si + ur, ni = ar * si + ai * sr + ui; sr = nr; si = ni;
#pragma unroll
            for (int o = 0; o < 16; ++o) {
                const float yr = wave_sum(ccr[o] * sr - cci[o] * si);
                const float yf = DY[(size_t)t * 1024 + g * 16 + o];
                err += (yf - yr) * (yf - yr); ref += yr * yr;
            }
        }
        if (lane == 0 && !(err <= 2e-3f * ref)) __hip_atomic_fetch_or((unsigned*)(F.ws + WS_CTL) + CW_FLAG, 1u, RLX_AGENT);
    }
}
#endif

__device__ __forceinline__ unsigned f2key(float v) { const unsigned u = __builtin_bit_cast(unsigned, v); return (u & 0x80000000u) ? ~u : (u | 0x80000000u); }
__device__ __forceinline__ float key2f(unsigned k) { const unsigned u = (k & 0x80000000u) ? (k & 0x7fffffffu) : ~k; return __builtin_bit_cast(float, u); }
__device__ __forceinline__ void sort16_desc(unsigned (&v)[16]) {
#pragma unroll
    for (int lk = 1; lk <= 4; ++lk) {
#pragma unroll
        for (int lj = lk - 1; lj >= 0; --lj) {
#pragma unroll
            for (int i = 0; i < 16; ++i) { const int k = 1 << lk, j = 1 << lj, p = i ^ j;
                if (p > i) { const unsigned a = v[i], c = v[p], hi = a > c ? a : c, lo = a > c ? c : a; const bool desc = ((i & k) == 0) || (k == 16);
                    v[i] = desc ? hi : lo; v[p] = desc ? lo : hi; } }
        }
    }
}
__device__ __forceinline__ void merge16_desc(unsigned (&v)[16], const unsigned (&w)[16]) {
#pragma unroll
    for (int i = 0; i < 16; ++i) v[i] = v[i] > w[15 - i] ? v[i] : w[15 - i];
#pragma unroll
    for (int lj = 3; lj >= 0; --lj) {
#pragma unroll
        for (int i = 0; i < 16; ++i) { const int j = 1 << lj, p = i ^ j;
            if (p > i) { const unsigned a = v[i], c = v[p]; v[i] = a > c ? a : c; v[p] = a > c ? c : a; } }
    }
}
__device__ __forceinline__ void xmerge16(unsigned (&v)[16], int mask) {
    unsigned w[16];
#pragma unroll
    for (int i = 0; i < 16; ++i) w[i] = (unsigned)__shfl_xor((int)v[i], mask);
    merge16_desc(v, w);
}
__device__ __forceinline__ void phase_topk(Frame& F, int l) {
    PH_LOCALS
    const bf16* Q = (const bf16*)(F.ws + WS_Z);
    const bf16* KB = (const bf16*)(F.ws + WS_KEYS) + (size_t)l * 8 * 2 * 128 * 128;
    int* EID = (int*)(F.ws + WS_EID); float* GT = (float*)(F.ws + WS_GATE); float* SUo = (float*)(F.ws + WS_SU);
    const float* SCL = (const float*)(F.ws + WS_SCL) + (size_t)l * NEXP * 2;
    LAS unsigned char* KL = F.lds;
    LAS float* SC = (LAS float*)(F.lds + 69632);
    LAS unsigned* LST = (LAS unsigned*)(F.lds + 69632 + 66560);
    LAS unsigned char* PT = F.lds + 69632 + 66560 + 8192;
    const int fr = lane & 15, fq = lane >> 4;
    {
        int c = 0;
#pragma unroll
        for (int i = 0; i < 16; ++i)
#pragma unroll
            for (int j = 0; j < 16; ++j) if ((i + 1) * (j + 1) <= 16) { if (tid == c) PT[c] = (unsigned char)(i * 16 + j); ++c; }
    }
    int cur_hh = -1;
    for (int u = F.vcu; u < 2048; u += F.G) {
        const int tt = u >> 3, hh = u & 7, t0 = tt * 64;
        const int tw = wave & 3, s = wave >> 2;
        bf16x8 qf[4];
#pragma unroll
        for (int kb = 0; kb < 4; ++kb) qf[kb] = *(const bf16x8*)(Q + (size_t)(t0 + 16 * tw + fr) * 2048 + hh * 256 + s * 128 + kb * 32 + 8 * fq);
        if (hh != cur_hh) {
            __syncthreads();
#pragma unroll
            for (int ps = 0; ps < 8; ++ps) { const int idx = ps * 512 + tid, row = idx >> 4, c16 = idx & 15;
                *(LAS u32x4*)(KL + row * 272 + c16 * 16) = *(const u32x4*)(KB + ((size_t)(hh * 256 + row)) * 128 + c16 * 8); }
            cur_hh = hh;
        }
        __syncthreads();
        {
            f32x4 acc[8];
#pragma unroll
            for (int nt = 0; nt < 8; ++nt) acc[nt] = (f32x4){0.f, 0.f, 0.f, 0.f};
#pragma unroll
            for (int kb = 0; kb < 4; ++kb)
#pragma unroll
                for (int nt = 0; nt < 8; ++nt) { const bf16x8 kf = *(const LAS bf16x8*)(KL + (s * 128 + nt * 16 + fr) * 272 + (kb * 32 + 8 * fq) * 2);
                    acc[nt] = __builtin_amdgcn_mfma_f32_16x16x32_bf16(kf, qf[kb], acc[nt], 0, 0, 0); }
#pragma unroll
            for (int nt = 0; nt < 8; ++nt) *(LAS f32x4*)(SC + (16 * tw + fr) * 260 + s * 128 + nt * 16 + 4 * fq) = acc[nt];
        }
        __syncthreads();
        {
            const int pr = tid >> 2, sub = tid & 3, tl = pr >> 1, sd = pr & 1;
            const LAS float* row = SC + tl * 260 + sd * 128 + 32 * sub;
            unsigned va[16], vb[16];
#pragma unroll
            for (int q4 = 0; q4 < 4; ++q4) { const f32x4 x = *(const LAS f32x4*)(row + 4 * q4), y = *(const LAS f32x4*)(row + 16 + 4 * q4);
#pragma unroll
                for (int e = 0; e < 4; ++e) { va[4 * q4 + e] = (f2key(x[e]) & ~0x7Fu) | (unsigned)(127 - (32 * sub + 4 * q4 + e)); vb[4 * q4 + e] = (f2key(y[e]) & ~0x7Fu) | (unsigned)(127 - (32 * sub + 16 + 4 * q4 + e)); } }
            sort16_desc(va); sort16_desc(vb); merge16_desc(va, vb);
            xmerge16(va, 1); xmerge16(va, 2);
            if (sub == 0) {
#pragma unroll
                for (int k = 0; k < 16; k += 4) *(LAS u32x4*)(LST + pr * 16 + k) = (u32x4){va[k], va[k + 1], va[k + 2], va[k + 3]};
            }
        }
        __syncthreads();
        {
            const int tl = tid >> 3, s8 = tid & 7;
            unsigned v[16];
#pragma unroll
            for (int m = 0; m < 7; ++m) { const int c = m * 8 + s8; unsigned key = 0u;
                if (c < 50) { const int pij = PT[c], i = pij >> 4, j = pij & 15;
                    const float av = key2f(LST[(tl * 2 + 0) * 16 + i] & ~0x7Fu), bv = key2f(LST[(tl * 2 + 1) * 16 + j] & ~0x7Fu);
                    key = (f2key(av + bv) & ~0xFFu) | (unsigned)(255 - pij); }
                v[m] = key; }
#pragma unroll
            for (int m = 7; m < 16; ++m) v[m] = 0u;
            sort16_desc(v);
            xmerge16(v, 1); xmerge16(v, 2); xmerge16(v, 4);
            float ev[16]; float sum = 0.f; const float mx = key2f(v[0] & ~0xFFu);
#pragma unroll
            for (int k = 0; k < 16; ++k) { ev[k] = __expf(key2f(v[k] & ~0xFFu) - mx); sum += ev[k]; }
            const float inv = 1.0f / sum;
            unsigned k0 = v[0], k1 = v[1]; float e0 = ev[0], e1 = ev[1];
#pragma unroll
            for (int q = 1; q < 8; ++q) { if (s8 == q) { k0 = v[2 * q]; k1 = v[2 * q + 1]; e0 = ev[2 * q]; e1 = ev[2 * q + 1]; } }
            const size_t ob = (size_t)(t0 + tl) * 128 + hh * 16 + 2 * s8;
            {   const int flat = 255 - (int)(k0 & 0xFFu), i = flat >> 4, j = flat & 15;
                const int ia = 127 - (int)(LST[(tl * 2 + 0) * 16 + i] & 0x7Fu), ib = 127 - (int)(LST[(tl * 2 + 1) * 16 + j] & 0x7Fu);
                const int e = ia * 128 + ib; const f32x2 sc = *(const f32x2*)(SCL + 2 * e);
                EID[ob] = e; GT[ob] = e0 * inv * sc.y; SUo[ob] = sc.x; }
            {   const int flat = 255 - (int)(k1 & 0xFFu), i = flat >> 4, j = flat & 15;
                const int ia = 127 - (int)(LST[(tl * 2 + 0) * 16 + i] & 0x7Fu), ib = 127 - (int)(LST[(tl * 2 + 1) * 16 + j] & 0x7Fu);
                const int e = ia * 128 + ib; const f32x2 sc = *(const f32x2*)(SCL + 2 * e);
                EID[ob + 1] = e; GT[ob + 1] = e1 * inv * sc.y; SUo[ob + 1] = sc.x; }
        }
    }
    __syncthreads();
}

#define FP4X4(w, f0, f1, f2, f3) do { f0 = __builtin_amdgcn_cvt_scalef32_pk_f32_fp4((w), 1.0f, 0); f1 = __builtin_amdgcn_cvt_scalef32_pk_f32_fp4((w), 1.0f, 1); \
    f2 = __builtin_amdgcn_cvt_scalef32_pk_f32_fp4((w), 1.0f, 2); f3 = __builtin_amdgcn_cvt_scalef32_pk_f32_fp4((w), 1.0f, 3); } while (0)
__device__ __forceinline__ void phase_gather(Frame& F, int l, bool dummy = false) {
    PH_LOCALS
    const int gw = F.vcu * NWAVES + wave, NGW = F.G * NWAVES;
    bf16* Hn = dummy ? (bf16*)(F.ws + WS_DBG + 128 * MiB) : (bf16*)(F.ws + WS_H);
    const unsigned char* UV = F.ws + WS_UV + (size_t)l * NEXP * 2048;
    const int* EID = (const int*)(F.ws + WS_EID); const float* GT = (const float*)(F.ws + WS_GATE); const float* SU = (const float*)(F.ws + WS_SU);
    const bf16* X = (const bf16*)(F.ws + WS_X); bf16* Xo = dummy ? (bf16*)(F.ws + WS_DBG) : (bf16*)(F.ws + WS_X);
    const float* mod = (const float*)(F.ws + WS_MOD);
    const float* gate2 = mod + l * 12288 + 5 * 2048; const float* shift2 = mod + l * 12288 + 3 * 2048; const float* gs2 = (const float*)(F.ws + WS_GS) + l * DM;
    const unsigned lane16 = (unsigned)lane * 16u;
    constexpr int NB = 16;
    for (int t = gw; t < M; t += NGW) {
        const int e_lo = EID[(size_t)t * 128 + lane], e_hi = EID[(size_t)t * 128 + 64 + lane];
        const float g_lo = GT[(size_t)t * 128 + lane], g_hi = GT[(size_t)t * 128 + 64 + lane];
        const float s_lo = SU[(size_t)t * 128 + lane], s_hi = SU[(size_t)t * 128 + 64 + lane];
        f32x2 hh[8][2];
        {   float s2 = 0.f;
#pragma unroll
            for (int j = 0; j < 8; ++j) { const u32x2 w = *(const u32x2*)(X + (size_t)t * 2048 + j * 256 + lane * 4);
                hh[j][0] = (f32x2){bflo(w.x), bfhi(w.x)}; hh[j][1] = (f32x2){bflo(w.y), bfhi(w.y)};
                s2 += (hh[j][0].x * hh[j][0].x + hh[j][0].y * hh[j][0].y) + (hh[j][1].x * hh[j][1].x + hh[j][1].y * hh[j][1].y); }
            const float r2 = 1.0f / sqrtf(wave_sum(s2) * (1.0f / DM) + EPS);
#pragma unroll
            for (int j = 0; j < 8; ++j) { const f32x4 gsv = *(const f32x4*)(gs2 + j * 256 + lane * 4), shv = *(const f32x4*)(shift2 + j * 256 + lane * 4);
                hh[j][0] = (f32x2){hh[j][0].x * r2 * gsv[0] + shv[0], hh[j][0].y * r2 * gsv[1] + shv[1]}; hh[j][1] = (f32x2){hh[j][1].x * r2 * gsv[2] + shv[2], hh[j][1].y * r2 * gsv[3] + shv[3]}; }
        }
        f32x2 of[8][2];
#pragma unroll
        for (int j = 0; j < 8; ++j) { of[j][0] = (f32x2){0.f, 0.f}; of[j][1] = (f32x2){0.f, 0.f}; }
        for (int b = 0; b < 128 / NB; ++b) {
            const bool first = (b * NB) < 64;
            const int esel = first ? e_lo : e_hi; const float gsel = first ? g_lo : g_hi, ssel = first ? s_lo : s_hi;
            u32x4 ur[NB], vr[NB];
#pragma unroll
            for (int h = 0; h < NB; ++h) {
                const int e = __builtin_amdgcn_readlane(esel, (NB * b + h) & 63);
                const unsigned char* rowp = UV + ((size_t)(unsigned)e << 11);
                ur[h] = *(const u32x4*)(rowp + lane16); vr[h] = *(const u32x4*)(rowp + 1024 + lane16);
            }
            float p[NB];
#pragma unroll
            for (int h = 0; h < NB; ++h) {
                f32x2 a2 = {0.f, 0.f};
#pragma unroll
                for (int d = 0; d < 4; ++d) { f32x2 f0, f1, f2, f3; FP4X4(ur[h][d], f0, f1, f2, f3);
                    a2 = f0 * hh[2 * d][0] + a2; a2 = f1 * hh[2 * d][1] + a2; a2 = f2 * hh[2 * d + 1][0] + a2; a2 = f3 * hh[2 * d + 1][1] + a2; }
                p[h] = a2.x + a2.y;
            }
            const bool u32_ = (lane & 32) != 0, u16_ = (lane & 16) != 0, u8_ = (lane & 8) != 0, u4_ = (lane & 4) != 0;
            float a8[8];
#pragma unroll
            for (int i = 0; i < 8; ++i) { const float snd = u32_ ? p[i] : p[8 + i], kp = u32_ ? p[8 + i] : p[i]; a8[i] = kp + __shfl_xor(snd, 32); }
            float a4[4];
#pragma unroll
            for (int i = 0; i < 4; ++i) { const float snd = u16_ ? a8[i] : a8[4 + i], kp = u16_ ? a8[4 + i] : a8[i]; a4[i] = kp + __shfl_xor(snd, 16); }
            float b2[2];
#pragma unroll
            for (int i = 0; i < 2; ++i) { const float snd = u8_ ? a4[i] : a4[2 + i], kp = u8_ ? a4[2 + i] : a4[i]; b2[i] = kp + __shfl_xor(snd, 8); }
            float d;
            { const float snd = u4_ ? b2[0] : b2[1], kp = u4_ ? b2[1] : b2[0]; d = kp + __shfl_xor(snd, 4); }
            d += __shfl_xor(d, 2); d += __shfl_xor(d, 1);
            const int hl = (NB * b + (lane >> 2)) & 63;
            const float gq = __shfl(gsel, hl), sq = __shfl(ssel, hl);
            const float coefq = gq * gelu_tanh(d * sq);
#pragma unroll
            for (int h = 0; h < NB; ++h) {
                const float cf = __builtin_bit_cast(float, __builtin_amdgcn_readlane(__builtin_bit_cast(int, coefq), 4 * h));
                const f32x2 cf2 = {cf, cf};
#pragma unroll
                for (int dd = 0; dd < 4; ++dd) { f32x2 f0, f1, f2, f3; FP4X4(vr[h][dd], f0, f1, f2, f3);
                    of[2 * dd][0] = f0 * cf2 + of[2 * dd][0]; of[2 * dd][1] = f1 * cf2 + of[2 * dd][1]; of[2 * dd + 1][0] = f2 * cf2 + of[2 * dd + 1][0]; of[2 * dd + 1][1] = f3 * cf2 + of[2 * dd + 1][1]; }
            }
        }
        int ln = lane; asm volatile("" : "+v"(ln));
        f32x4 xv[8]; float ss = 0.f;
#pragma unroll
        for (int j = 0; j < 8; ++j) {
            const int c = j * 256 + ln * 4;
            const u32x2 xw = *(const u32x2*)(X + (size_t)t * 2048 + c); const f32x4 xo = {bflo(xw.x), bfhi(xw.x), bflo(xw.y), bfhi(xw.y)}, g2 = *(const f32x4*)(gate2 + c);
            const f32x4 o = {of[j][0].x, of[j][0].y, of[j][1].x, of[j][1].y};
            xv[j] = xo + g2 * o;
            ss += (xv[j][0] * xv[j][0] + xv[j][1] * xv[j][1]) + (xv[j][2] * xv[j][2] + xv[j][3] * xv[j][3]);
        }
        const float rr = 1.0f / sqrtf(wave_sum(ss) * (1.0f / DM) + EPS);
        if (l + 1 < DEPTH) {
            const float* m2 = mod + (l + 1) * 12288; const float* gain = F.in[I_N1G] + (l + 1) * 2048;
#pragma unroll
            for (int j = 0; j < 8; ++j) {
                const int c = j * 256 + ln * 4;
                *(u32x2*)(Xo + (size_t)t * 2048 + c) = (u32x2){pk2(xv[j][0], xv[j][1]), pk2(xv[j][2], xv[j][3])};
                const f32x4 g = *(const f32x4*)(gain + c), sc = *(const f32x4*)(m2 + 2048 + c), sh = *(const f32x4*)(m2 + c);
                const f32x4 y = xv[j] * rr * g * (sc + 1.0f) + sh;
                *(u32x2*)(Hn + (size_t)t * 2048 + c) = (u32x2){pk2(y[0], y[1]), pk2(y[2], y[3])};
            }
        } else {
#pragma unroll
            for (int j = 0; j < 8; ++j) { const int c = j * 256 + ln * 4; const f32x4 fg = *(const f32x4*)(F.in[I_FG] + c);
                f32x4 ov = xv[j] * rr * fg;
#if SELFTEST_S5
                if (__hip_atomic_load((unsigned*)(F.ws + WS_CTL) + CW_FLAG, RLX_AGENT) != 0u) ov = (f32x4){1e30f, 1e30f, 1e30f, 1e30f};
#endif
                *(f32x4*)(F.out + (size_t)t * 2048 + c) = ov; }
        }
    }
}

__global__ void __launch_bounds__(NTHR, 2) fwd_kernel(Args args) {
    extern __shared__ __attribute__((aligned(16))) unsigned char lds_raw[];
    Frame F;
    F.lds = (LAS unsigned char*)lds_raw; F.ws = args.ws; F.in = args.in; F.out = args.out;
    F.tid = threadIdx.x; F.lane = F.tid & 63; F.wave = __builtin_amdgcn_readfirstlane(F.tid >> 6);
    F.G = gridDim.x; { const int bx = blockIdx.x; F.vcu = (F.G % 8 == 0) ? (bx % 8) * (F.G / 8) + bx / 8 : bx; }
    volatile LAS unsigned* MISC = (volatile LAS unsigned*)(F.lds + MISC_OFF);
    if (F.tid < 64) MISC[F.tid] = 0u;
    __syncthreads();
    unsigned* ctl = (unsigned*)(F.ws + WS_CTL);
    XcdBarrier bar; bar.bar = ctl + CW_BAR; bar.x = 0; bar.st = nullptr;
#if !MK_PER_PHASE
    bar = xcd_barrier_post(ctl + CW_BAR, MISC + 8);
#endif
    const int lo = args.ph_lo, hi = args.ph_hi;
#define IN(k) (lo <= (k) && (k) < hi)
#if MK_PER_PHASE
#define SEAM(k) do { } while (0)
#else
#define SEAM(k) do { if (IN(k) && IN((k) + 1)) xcd_barrier(bar); } while (0)
#endif
    const float* mod = (const float*)(F.ws + WS_MOD);

#define REP(k) (REPEAT_PH == (k))
#define RUN2(k, first, real) do { if (REP(k)) { first; xcd_barrier(bar); } real; } while (0)
    if (IN(0)) { RUN2(13, p0_tables(F, 5, true), p0_tables(F, 4, false)); } SEAM(0);
    for (int l = 0; l < DEPTH; ++l) {
        const int pb = 1 + 12 * l;
        const float* ml = mod + l * 12288;
        if (IN(pb + 0)) { if (l == 0) { RUN2(0, p0_prologue(F), p0_prologue(F)); RUN2(1, phase_norm<false>(F, F.in[I_X], F.in[I_N1G] + l * 2048, ml + 1 * 2048, ml + 0 * 2048), phase_norm<false>(F, F.in[I_X], F.in[I_N1G] + l * 2048, ml + 1 * 2048, ml + 0 * 2048)); } } SEAM(pb + 0);
        if (IN(pb + 1)) {
            pg8::Gemm g{(const bf16*)(F.ws + WS_H), (const bf16*)(F.ws + WS_WIN) + (size_t)l * INW * DM, M, INW, DM}; pg8::StaticOrder S; S.init(M, INW, F.G, (int)blockIdx.x);
            EpiIn E{(bf16*)(F.ws + WS_Z), (bf16*)(F.ws + WS_XS), F.in[I_BIN] + l * INW};
#define GEMM_IN pg8::gemm_phase<EpiIn, pg8::StaticOrder, true, true>(F.lds, g, S, E)
            RUN2(2, GEMM_IN, GEMM_IN);
        } SEAM(pb + 1);
        if (IN(pb + 2)) { RUN2(3, (phase_sloc(F, l), phase_lnstats(F)), (phase_sloc(F, l), phase_lnstats(F))); } SEAM(pb + 2);
        if (IN(pb + 3)) { RUN2(5, phase_s5out(F, l), phase_s5out(F, l)); RUN2(4, phase_gating(F, l), phase_gating(F, l));
#if SELFTEST_S5
            xcd_barrier(bar); selftest_s5(F, l);
#endif
        } SEAM(pb + 4);
        if (IN(pb + 5)) {
            pg8::Gemm g{(const bf16*)(F.ws + WS_G), (const bf16*)(F.ws + WS_GLU) + (size_t)l * WB * WB, M, WB, WB}; pg8::StaticOrder S; S.init(M, WB, F.G, (int)blockIdx.x);
            EpiGlu E{(const bf16*)(F.ws + WS_G), (bf16*)(F.ws + WS_MIX), F.in[I_GLUB] + l * WB};
#define GEMM_GLU pg8::gemm_phase<EpiGlu, pg8::StaticOrder, true, true>(F.lds, g, S, E)
            RUN2(6, GEMM_GLU, GEMM_GLU);
        } SEAM(pb + 5);
        if (IN(pb + 6)) { RUN2(7, phase_branchnorm(F), phase_branchnorm(F)); } SEAM(pb + 6);
        if (IN(pb + 7)) {
            pg8::Gemm g{(const bf16*)(F.ws + WS_MIX), (const bf16*)(F.ws + WS_WOUT) + (size_t)l * DM * DM, M, DM, DM}; pg8::StaticOrder S; S.init(M, DM, F.G, (int)blockIdx.x);
            if (l == 0) { EpiOut<false> E{(const void*)F.in[I_X], (bf16*)(F.ws + WS_X), ml + 2 * 2048, (float*)(F.ws + WS_PS)}; EpiOut<false> Ed{(const void*)F.in[I_X], (bf16*)(F.ws + WS_DBG), ml + 2 * 2048, (float*)(F.ws + WS_DBG + 128 * MiB)};
#define GEMM_OUT0(EE) pg8::gemm_phase<EpiOut<false>, pg8::StaticOrder, true, true>(F.lds, g, S, EE)
                RUN2(8, GEMM_OUT0(Ed), GEMM_OUT0(E)); }
            else { EpiOut<true> E{(const void*)(F.ws + WS_X), (bf16*)(F.ws + WS_X), ml + 2 * 2048, (float*)(F.ws + WS_PS)}; EpiOut<true> Ed{(const void*)(F.ws + WS_X), (bf16*)(F.ws + WS_DBG), ml + 2 * 2048, (float*)(F.ws + WS_DBG + 128 * MiB)};
#define GEMM_OUT1(EE) pg8::gemm_phase<EpiOut<true>, pg8::StaticOrder, true, true>(F.lds, g, S, EE)
                RUN2(8, GEMM_OUT1(Ed), GEMM_OUT1(E)); }
        }
        SEAM(pb + 8);
        if (IN(pb + 9)) {
            pg8::Gemm g{(const bf16*)(F.ws + WS_X), (const bf16*)(F.ws + WS_WQ) + (size_t)l * DM * DM, M, DM, DM}; pg8::StaticOrder S; S.init(M, DM, F.G, (int)blockIdx.x);
            LAS float* rrL = (LAS float*)(F.lds + 132096);
            pg8::Unit u0, u1; const bool h0 = S.next(0, u0), h1 = S.next(1, u1);
            { int t2 = F.tid; asm volatile("" : "+v"(t2)); if (h0) fill_rr(F, rrL, 0, u0.pm, t2); if (h1 && u1.pm != u0.pm) fill_rr(F, rrL, 1, u1.pm, t2); }
            __syncthreads();
            EpiQ E{(bf16*)(F.ws + WS_Z), (const float*)(F.ws + WS_C0) + l * DM, rrL, h0 ? u0.pm : -1};
#define GEMM_Q pg8::gemm_phase<EpiQ, pg8::StaticOrder, true, true>(F.lds, g, S, E)
            RUN2(10, GEMM_Q, GEMM_Q);
        } SEAM(pb + 9);
        if (IN(pb + 10)) { RUN2(11, phase_topk(F, l), phase_topk(F, l)); } SEAM(pb + 10);
        if (IN(pb + 11)) { RUN2(12, phase_gather(F, l, true), phase_gather(F, l, false)); } SEAM(pb + 11);
    }
#undef IN
#undef SEAM
}

extern "C" void kernel_launch(void* const* d_in, const int* in_sizes, int n_in, void* d_out, int out_size, void* d_ws, size_t ws_size, hipStream_t stream) {
    static int grid = 0;
    if (grid == 0) {
        if (n_in != 29 || out_size != M * DM || ws_size < WS_END) { fprintf(stderr, "kernel_launch: unexpected shapes (n_in %d, out %d, ws %zu); nothing launched\n", n_in, out_size, ws_size); grid = -1; return; }
        int dev = 0, cus = 0;
        if (hipGetDevice(&dev) != hipSuccess || hipDeviceGetAttribute(&cus, hipDeviceAttributeMultiprocessorCount, dev) != hipSuccess) { grid = -1; return; }
        if (hipFuncSetAttribute((const void*)fwd_kernel, hipFuncAttributeMaxDynamicSharedMemorySize, LDS_BYTES) != hipSuccess) { fprintf(stderr, "kernel_launch: hipFuncSetAttribute failed\n"); grid = -1; return; }
        (void)hipGetLastError();
        grid = cus;
    }
    if (grid < 0) return;
    (void)hipMemsetAsync((char*)d_ws + WS_CTL, 0, CTL_ZERO_BYTES, stream);
    Args a{};
    for (int i = 0; i < 29; ++i) a.in[i] = (const float*)d_in[i];
    a.out = (float*)d_out; a.ws = (unsigned char*)d_ws;
#if MK_PER_PHASE
    for (int p = 0; p < 1 + 12 * DEPTH; ++p) {
        if (p == 13) continue;
        a.ph_lo = p; a.ph_hi = p + 1; a.li = p;
        hipLaunchKernelGGL(fwd_kernel, dim3(grid), dim3(NTHR), LDS_BYTES, stream, a);
    }
#else
    a.ph_lo = 0; a.ph_hi = 1 + 12 * DEPTH; a.li = 0;
    hipLaunchKernelGGL(fwd_kernel, dim3(grid), dim3(NTHR), LDS_BYTES, stream, a);
#endif
}
```

```cpp
#include <hip/hip_runtime.h>
#include <cstdio>
#include <cstdint>

#ifndef SELFTEST_S5
#define SELFTEST_S5 0
#endif
#ifndef REPEAT_PH
#define REPEAT_PH -1
#endif
#ifndef MK_PER_PHASE
#define MK_PER_PHASE 0
#endif

#define GAS __attribute__((address_space(1)))
#define LAS __attribute__((address_space(3)))
typedef unsigned short bf16;
typedef short bf16x8 __attribute__((ext_vector_type(8)));
typedef float f32x4 __attribute__((ext_vector_type(4)));
typedef float f32x2 __attribute__((ext_vector_type(2)));
typedef unsigned u32x4 __attribute__((ext_vector_type(4)));
typedef unsigned u32x2 __attribute__((ext_vector_type(2)));

constexpr int DM = 2048, SEQ = 16384, DEPTH = 2, M = SEQ;
constexpr int WA = 1024, WB = 1024, INW = 3072;
constexpr int NG = 64, NCH = 256;
constexpr int NEXP = 16384;
constexpr float EPS = 1e-6f;
constexpr int NWAVES = 8, NTHR = 512;

namespace pg8 {
#define PG8_LAS __attribute__((address_space(3)))
constexpr int BM = 256, BK = 64, HALF = 128, HTB = HALF * BK * 2, STAGE_BYTES = 8 * HTB, NXCD = 8, WGM = 8;
__host__ __device__ __forceinline__ int lds_byte(int r, int c) { const int st = (r >> 4) * 2 + (c >> 5), rr = r & 15, cc = c & 31, ob = rr * 64 + cc * 2; return st * 1024 + (ob ^ (((ob >> 9) & 1) << 5)); }
__host__ __device__ __forceinline__ void stage_rc(int b, int& R, int& C) { const int st = b / 1024, sb = b % 1024, swz = sb ^ (((sb >> 9) & 1) << 5); R = (st >> 1) * 16 + swz / 64; C = (st & 1) * 32 + (swz % 64) / 2; }
__host__ __device__ __forceinline__ int perm32(int rho) { const int n = rho >> 4, i = rho & 15; return 8 * (i >> 2) + 4 * n + (i & 3); }
struct Unit { int pm, pn; };
struct Gemm { const bf16* A; const bf16* Bt; int M, N, K; };
struct StaticOrder {
    int nM, nN, nwg, G, c;
    __host__ __device__ void init(int M_, int N_, int G_, int c_) { nM = M_ / BM; nN = N_ / BM; nwg = nM * nN; G = G_; c = c_; }
    __host__ __device__ bool next(int i, Unit& u) const {
        const long L = (long)i * G + c; if (L >= nwg) return false;
        int wgid = (int)L; { const int q = nwg / NXCD, r = nwg % NXCD, xcd = wgid % NXCD, off = wgid / NXCD; wgid = (xcd < r ? xcd * (q + 1) : r * (q + 1) + (xcd - r) * q) + off; }
        const int nig = WGM * nN, gid = wgid / nig, fm = gid * WGM, gsz = (nM - fm) < WGM ? (nM - fm) : WGM;
        u.pm = fm + ((wgid % nig) % gsz); u.pn = (wgid % nig) / gsz; return true;
    }
    __device__ __forceinline__ void a_ready(const Unit&) const {}
    __device__ __forceinline__ void done(const Unit&) const {}
};
__device__ __forceinline__ unsigned cvt_pk_bf16(float lo, float hi) { unsigned r; asm volatile("v_cvt_pk_bf16_f32 %0, %1, %2" : "=v"(r) : "v"(lo), "v"(hi)); return r; }

template <class Epi, class Sched, bool ALIGN_EPI = false, bool SP2 = false>
__device__ __forceinline__ void gemm_phase(PG8_LAS unsigned char* lds, const Gemm g, const Sched& S, const Epi& E) {
    int tid = threadIdx.x; asm volatile("" : "+v"(tid)); const int wid = __builtin_amdgcn_readfirstlane(tid >> 6), lane = tid & 63, wr = wid >> 2, wc = wid & 3, fr = lane & 15, fq = lane >> 4;
    const int K = g.K, nt = K / BK;
    unsigned voffA[2], voffB[2];
#pragma unroll
    for (int i = 0; i < 2; ++i) { int R, C; stage_rc(tid * 16 + i * 8192, R, C); const int Rb = Epi::PERM ? ((R & ~31) + perm32(R & 31)) : R;
        voffA[i] = (unsigned)(R * K + C) * 2u; voffB[i] = (unsigned)(Rb * K + C) * 2u; }
    const size_t kstep = (size_t)(BK * 2);
    const size_t hstep = (size_t)HALF * K * 2;
    const size_t tstep = 2 * hstep;
    const unsigned ldsw = (unsigned)wid * 1024u;
    const int aoff = lds_byte(wr * 64 + fr, fq * 8), boff = lds_byte(wc * 32 + fr, fq * 8);
#define PG8_SA(b, h) (((b) * 2 + (h)) * HTB)
#define PG8_SB(b, h) ((4 + (b) * 2 + (h)) * HTB)
#define PG8_STAGE(bufoff, gbase, voff) do { _Pragma("unroll") for (int _i = 0; _i < 2; ++_i) \
        __builtin_amdgcn_global_load_lds((const unsigned*)((const char*)(gbase) + (voff)[_i]), (PG8_LAS unsigned*)(lds + (bufoff) + ldsw + _i * 8192), 16, 0, 0); } while (0)
#define PG8_LDA(dst, b, h) do { _Pragma("unroll") for (int m = 0; m < 4; ++m) _Pragma("unroll") for (int k = 0; k < 2; ++k) dst[m][k] = *(const PG8_LAS bf16x8*)(lds + PG8_SA(b, h) + aoff + m * 2048 + k * 1024); } while (0)
#define PG8_LDB(dst, b, h) do { _Pragma("unroll") for (int n = 0; n < 2; ++n) _Pragma("unroll") for (int k = 0; k < 2; ++k) dst[n][k] = *(const PG8_LAS bf16x8*)(lds + PG8_SB(b, h) + boff + n * 2048 + k * 1024); } while (0)
#define PG8_MMA(ai, bj, At, Bt) do { __builtin_amdgcn_s_setprio(1); _Pragma("unroll") for (int m = 0; m < 4; ++m) _Pragma("unroll") for (int n = 0; n < 2; ++n) _Pragma("unroll") for (int k = 0; k < 2; ++k) \
        acc[ai][bj][m][n] = __builtin_amdgcn_mfma_f32_16x16x32_bf16(Bt[n][k], At[m][k], acc[ai][bj][m][n], 0, 0, 0); __builtin_amdgcn_s_setprio(0); } while (0)
#define PG8_WAIT_V(n) asm volatile("s_waitcnt vmcnt(" #n ")" ::: "memory")
#define PG8_WAIT_L(n) asm volatile("s_waitcnt lgkmcnt(" #n ")" ::: "memory")
#define PG8_BAR __builtin_amdgcn_s_barrier()
#define PG8_SCHED __builtin_amdgcn_sched_barrier(0)
    Unit cur, nxt; int ui = 0;
    if (!S.next(0, cur)) return;
    f32x4 acc[2][2][4][2];
#pragma unroll
    for (int a = 0; a < 2; ++a)
#pragma unroll
        for (int b = 0; b < 2; ++b)
#pragma unroll
            for (int m = 0; m < 4; ++m)
#pragma unroll
                for (int n = 0; n < 2; ++n) acc[a][b][m][n] = (f32x4){0.f, 0.f, 0.f, 0.f};
    bf16x8 At[4][2], B0[2][2], B1[2][2];
    const char* cA = (const char*)g.A + (size_t)cur.pm * tstep; const char* cB = (const char*)g.Bt + (size_t)cur.pn * tstep;
    S.a_ready(cur);
    if constexpr (SP2) {
        PG8_STAGE(PG8_SB(0, 0), cB, voffB); PG8_STAGE(PG8_SB(0, 1), cB + hstep, voffB); PG8_STAGE(PG8_SA(0, 0), cA, voffA); PG8_STAGE(PG8_SA(0, 1), cA + hstep, voffA);
        if (wr == 1) PG8_BAR;
        PG8_WAIT_V(2); PG8_BAR;
        PG8_STAGE(PG8_SB(1, 0), cB + kstep, voffB); PG8_STAGE(PG8_SA(1, 0), cA + kstep, voffA); PG8_STAGE(PG8_SB(1, 1), cB + hstep + kstep, voffB);
        PG8_WAIT_V(6); PG8_BAR;
    } else {
        PG8_STAGE(PG8_SB(0, 0), cB, voffB); PG8_STAGE(PG8_SA(0, 0), cA, voffA); PG8_STAGE(PG8_SB(0, 1), cB + hstep, voffB); PG8_STAGE(PG8_SA(0, 1), cA + hstep, voffA);
        if (wr == 1) PG8_BAR;
        PG8_WAIT_V(4); PG8_BAR;
        PG8_STAGE(PG8_SB(1, 0), cB + kstep, voffB); PG8_STAGE(PG8_SA(1, 0), cA + kstep, voffA); PG8_STAGE(PG8_SB(1, 1), cB + hstep + kstep, voffB);
        PG8_WAIT_V(6); PG8_BAR;
    }
    for (;;) {
        const bool has_next = S.next(ui + 1, nxt);
        const char* nA = has_next ? (const char*)g.A + (size_t)nxt.pm * tstep : cA; const char* nB = has_next ? (const char*)g.Bt + (size_t)nxt.pn * tstep : cB;
        for (int t = 0; t < nt; t += 2) {
            const bool last = (t == nt - 2);
            const char* a1 = cA + (size_t)(t + 1) * kstep;
            const char* a2 = last ? nA : cA + (size_t)(t + 2) * kstep; const char* b2 = last ? nB : cB + (size_t)(t + 2) * kstep;
            const char* a3 = a2 + kstep; const char* b3 = b2 + kstep;
            if (last && has_next) S.a_ready(nxt);
            if constexpr (SP2) {
            PG8_LDB(B0, 0, 0); PG8_LDB(B1, 0, 1); PG8_SCHED; PG8_LDA(At, 0, 0); PG8_STAGE(PG8_SA(1, 1), a1 + hstep, voffA);
            PG8_WAIT_V(8); PG8_WAIT_L(0); PG8_BAR; PG8_MMA(0, 0, At, B0); PG8_MMA(0, 1, At, B1); PG8_BAR; PG8_SCHED;
            PG8_LDA(At, 0, 1); PG8_STAGE(PG8_SB(0, 0), b2, voffB); PG8_STAGE(PG8_SB(0, 1), b2 + hstep, voffB); PG8_STAGE(PG8_SA(0, 0), a2, voffA);
            PG8_WAIT_V(8); PG8_WAIT_L(0); PG8_BAR; PG8_MMA(1, 0, At, B0); PG8_MMA(1, 1, At, B1); PG8_BAR; PG8_SCHED;
            PG8_LDB(B0, 1, 0); PG8_LDB(B1, 1, 1); PG8_SCHED; PG8_LDA(At, 1, 0); PG8_STAGE(PG8_SA(0, 1), a2 + hstep, voffA);
            PG8_WAIT_V(8); PG8_WAIT_L(0); PG8_BAR; PG8_MMA(0, 0, At, B0); PG8_MMA(0, 1, At, B1); PG8_BAR; PG8_SCHED;
            PG8_LDA(At, 1, 1); PG8_STAGE(PG8_SB(1, 0), b3, voffB); PG8_STAGE(PG8_SB(1, 1), b3 + hstep, voffB); PG8_STAGE(PG8_SA(1, 0), a3, voffA);
            PG8_WAIT_V(8); PG8_WAIT_L(0); PG8_BAR; PG8_MMA(1, 0, At, B0); PG8_MMA(1, 1, At, B1); PG8_BAR; PG8_SCHED;
            } else {
            PG8_LDB(B0, 0, 0); PG8_SCHED; PG8_LDA(At, 0, 0); PG8_STAGE(PG8_SA(1, 1), a1 + hstep, voffA);
            PG8_WAIT_L(8); PG8_BAR; PG8_WAIT_L(0); PG8_MMA(0, 0, At, B0); PG8_BAR; PG8_SCHED;
            PG8_LDB(B1, 0, 1); PG8_STAGE(PG8_SB(0, 0), b2, voffB);
            PG8_BAR; PG8_WAIT_L(0); PG8_MMA(0, 1, At, B1); PG8_BAR;
            PG8_LDA(At, 0, 1); PG8_STAGE(PG8_SA(0, 0), a2, voffA);
            PG8_BAR; PG8_WAIT_L(0); PG8_MMA(1, 0, At, B0); PG8_BAR; PG8_SCHED;
            PG8_STAGE(PG8_SB(0, 1), b2 + hstep, voffB);
            PG8_WAIT_V(6); PG8_BAR; PG8_MMA(1, 1, At, B1); PG8_BAR;
            PG8_LDB(B0, 1, 0); PG8_SCHED; PG8_LDA(At, 1, 0); PG8_STAGE(PG8_SA(0, 1), a2 + hstep, voffA);
            PG8_WAIT_L(8); PG8_BAR; PG8_WAIT_L(0); PG8_MMA(0, 0, At, B0); PG8_BAR; PG8_SCHED;
            PG8_LDB(B1, 1, 1); PG8_STAGE(PG8_SB(1, 0), b3, voffB);
            PG8_BAR; PG8_WAIT_L(0); PG8_MMA(0, 1, At, B1); PG8_BAR;
            PG8_LDA(At, 1, 1); PG8_STAGE(PG8_SA(1, 0), a3, voffA);
            PG8_BAR; PG8_WAIT_L(0); PG8_MMA(1, 0, At, B0); PG8_BAR; PG8_SCHED;
            PG8_STAGE(PG8_SB(1, 1), b3 + hstep, voffB);
            PG8_WAIT_V(6); PG8_BAR; PG8_MMA(1, 1, At, B1); PG8_BAR;
            }
        }
        if constexpr (ALIGN_EPI) { if (wr == 0) PG8_BAR; }
        E(acc, cur, wr, wc, fr, fq); S.done(cur);
        if (!has_next) break;
#pragma unroll
        for (int a = 0; a < 2; ++a)
#pragma unroll
            for (int b = 0; b < 2; ++b)
#pragma unroll
                for (int m = 0; m < 4; ++m)
#pragma unroll
                    for (int n = 0; n < 2; ++n) acc[a][b][m][n] = (f32x4){0.f, 0.f, 0.f, 0.f};
        cur = nxt; cA = nA; cB = nB; ++ui;
        if constexpr (ALIGN_EPI) { if (wr == 1) PG8_BAR; }
    }
    PG8_WAIT_V(0);
    if constexpr (!ALIGN_EPI) { if (wr == 0) PG8_BAR; }
    PG8_BAR;
#undef PG8_SA
#undef PG8_SB
#undef PG8_STAGE
#undef PG8_LDA
#undef PG8_LDB
#undef PG8_MMA
#undef PG8_WAIT_V
#undef PG8_WAIT_L
#undef PG8_BAR
#undef PG8_SCHED
}
}

__device__ __forceinline__ unsigned f2bf(float f) { unsigned u = __builtin_bit_cast(unsigned, f); return (u + 0x7fffu + ((u >> 16) & 1u)) >> 16; }
__device__ __forceinline__ unsigned pk2(float lo, float hi) { return f2bf(lo) | (f2bf(hi) << 16); }
__device__ __forceinline__ float bflo(unsigned w) { return __builtin_bit_cast(float, w << 16); }
__device__ __forceinline__ float bfhi(unsigned w) { return __builtin_bit_cast(float, w & 0xffff0000u); }
__device__ __forceinline__ float fast_sigmoid(float t) { return __builtin_amdgcn_rcpf(1.0f + __builtin_amdgcn_exp2f(-1.44269504089f * t)); }
__device__ __forceinline__ float gelu_tanh(float x) { const float t = x * (1.5957691216f + 0.0713548163f * x * x); return x * fast_sigmoid(t); }
__device__ __forceinline__ float wave_sum(float v) {
#pragma unroll
    for (int o = 1; o < 64; o <<= 1) v += __shfl_xor(v, o);
    return v;
}
#define LDS_WAIT() asm volatile("s_waitcnt lgkmcnt(0)" ::: "memory")
#define VM_WAIT() asm volatile("s_waitcnt vmcnt(0)" ::: "memory")
#define RLX_AGENT __ATOMIC_RELAXED, __HIP_MEMORY_SCOPE_AGENT

constexpr size_t MiB = 1u << 20;
constexpr size_t WS_CTL = 0, CTL_ZERO_BYTES = 1 * MiB;
constexpr size_t WS_MOD   = 512 * 1024;
constexpr size_t WS_AT    = 1 * MiB + 128 * 1024;
constexpr size_t WS_STATS = WS_AT + 128 * 1024;
constexpr size_t WS_SCL   = 1 * MiB + 512 * 1024;
constexpr size_t WS_GS    = 1 * MiB + 768 * 1024;
constexpr size_t WS_C0    = WS_GS + 16 * 1024;
constexpr size_t WS_KEYS  = 2 * MiB;
constexpr size_t WS_GWS   = 3 * MiB;
constexpr size_t WS_WIN   = 4 * MiB;
constexpr size_t WS_GLU   = 28 * MiB;
constexpr size_t WS_WOUT  = 32 * MiB;
constexpr size_t WS_WQ    = 48 * MiB;
constexpr size_t WS_KTAB  = 64 * MiB;
constexpr size_t WS_WG    = 72 * MiB;
constexpr size_t WS_VG    = 104 * MiB;
constexpr size_t WS_UV    = 136 * MiB;
constexpr size_t WS_X     = 392 * MiB;
constexpr size_t WS_H     = 520 * MiB;
constexpr size_t WS_Z     = 584 * MiB;
constexpr size_t WS_XS    = 648 * MiB;
constexpr size_t WS_SLOC  = 680 * MiB;
constexpr size_t WS_PS    = 688 * MiB;
constexpr size_t WS_HS    = 690 * MiB;
constexpr size_t WS_G     = 692 * MiB;
constexpr size_t WS_MIX   = 724 * MiB;
constexpr size_t WS_EID   = 788 * MiB;
constexpr size_t WS_GATE  = 796 * MiB;
constexpr size_t WS_SU    = 804 * MiB;
constexpr size_t WS_END   = 812 * MiB;
constexpr size_t WS_DBG   = 812 * MiB;
constexpr int CW_BAR = 4096;
constexpr int CW_FLAG = 2048;
constexpr int CW_QUEUE = 16384;

constexpr int LDS_BYTES = 163840;
constexpr int MISC_OFF = LDS_BYTES - 256;

#define XB_TMO      128
#define XB_XCNT(j)  (256  + 64 * (j))
#define XB_XSUB(j)  (1280 + 64 * (j))
#define XB_XGEN(j)  (2304 + 64 * (j))
#define XB_TOP      3328
#define XB_TOPGEN   3392
#define XCD_BAR_WORDS 3456
#define XB_SPIN_CAP (1u << 24)
__device__ __forceinline__ unsigned xb_ld(unsigned* p)              { return __hip_atomic_load(p, __ATOMIC_RELAXED, __HIP_MEMORY_SCOPE_AGENT); }
__device__ __forceinline__ unsigned xb_add(unsigned* p, unsigned v) { return __hip_atomic_fetch_add(p, v, __ATOMIC_RELAXED, __HIP_MEMORY_SCOPE_AGENT); }
__device__ __forceinline__ unsigned xb_xcc_id() { return (unsigned)__builtin_amdgcn_s_getreg((3 << 11) | 20) & 0xFu; }
#define XB_SPIN(cond, bar) do { unsigned _sp = 0; while (cond) { __builtin_amdgcn_s_sleep(1); \
    if ((++_sp & 255u) == 0u) { if (xb_ld(&(bar)[XB_TMO])) break; if (_sp > XB_SPIN_CAP) { atomicAdd(&(bar)[XB_TMO], 1u); break; } } } } while (0)
struct XcdBarrier { unsigned* bar; unsigned x; volatile LAS unsigned* st; };
__device__ __forceinline__ XcdBarrier xcd_barrier_post(unsigned* bar, volatile LAS unsigned* st) {
    XcdBarrier b; b.bar = bar; b.x = xb_xcc_id(); b.st = st;
    if (threadIdx.x == 0) (void)xb_add(&bar[XB_XCNT(b.x)], 1u);
    return b;
}
__device__ __forceinline__ void xcd_barrier_complete(unsigned* bar, unsigned x, unsigned& nloc, unsigned& nx) {
    const unsigned G = gridDim.x * gridDim.y * gridDim.z;
    unsigned sum, cnt, mine, sp = 0u;
    for (;;) {
        sum = 0u; cnt = 0u; mine = 0u;
#pragma unroll
        for (unsigned j = 0; j < 16; ++j) { const unsigned c = xb_ld(&bar[XB_XCNT(j)]); sum += c; cnt += (c > 0u) ? 1u : 0u; mine = (j == x) ? c : mine; }
        if (sum == G) break;
        __builtin_amdgcn_s_sleep(1);
        if ((++sp & 255u) == 0u) { if (xb_ld(&bar[XB_TMO])) break; if (sp > XB_SPIN_CAP) { atomicAdd(&bar[XB_TMO], 1u); break; } }
    }
    nloc = mine > 0u ? mine : 1u; nx = cnt > 0u ? cnt : 1u;
}
__device__ __forceinline__ void xcd_barrier(const XcdBarrier& b) {
    asm volatile("s_waitcnt vmcnt(0)" ::: "memory");
    __syncthreads();
    if (threadIdx.x == 0) {
        unsigned* bar = b.bar;
        __builtin_amdgcn_s_waitcnt(0);
        unsigned nloc = b.st[0], nx = b.st[1];
        if (nloc == 0u) { xcd_barrier_complete(bar, b.x, nloc, nx); b.st[0] = nloc; b.st[1] = nx; }
        const unsigned old = xb_add(&bar[XB_XSUB(b.x)], 1u);
        const unsigned gen = old / nloc;
        if (old + 1u == (gen + 1u) * nloc) {
            __builtin_amdgcn_fence(__ATOMIC_RELEASE, "agent");
            asm volatile("s_waitcnt vmcnt(0)" ::: "memory");
            const unsigned og = xb_add(&bar[XB_TOP], 1u);
            const unsigned tg = og / nx;
            if (og + 1u == (tg + 1u) * nx) xb_add(&bar[XB_TOPGEN], 1u);
            else XB_SPIN(xb_ld(&bar[XB_TOPGEN]) == tg, bar);
            __builtin_amdgcn_fence(__ATOMIC_ACQUIRE, "agent");
            xb_add(&bar[XB_XGEN(b.x)], 1u);
            asm volatile("s_waitcnt vmcnt(0)" ::: "memory");
        } else {
            XB_SPIN(xb_ld(&bar[XB_XGEN(b.x)]) == gen, bar);
            __builtin_amdgcn_fence(__ATOMIC_ACQUIRE, "agent");
            asm volatile("s_waitcnt vmcnt(0)" ::: "memory");
        }
    }
    __syncthreads();
}

struct Args { const float* in[29]; float* out; unsigned char* ws; int ph_lo, ph_hi, li, pad; };
enum { I_X = 0, I_C, I_WMOD, I_BMOD, I_N1G, I_WIN, I_BIN, I_LNG, I_LNB, I_GWS, I_GBS, I_LRE, I_LIM, I_LDT, I_BRE, I_BIM, I_CRE, I_CIM, I_SD, I_GLUW, I_GLUB,
       I_BRG, I_WOUT, I_N2G, I_WQ, I_KEYS, I_PU, I_PV, I_FG };

struct Frame {
    LAS unsigned char* lds;
    unsigned char* ws;
    const float* const* in;
    float* out;
    int tid, lane, wave, vcu, G;
};

#define PH_LOCALS int tid = F.tid; asm volatile("" : "+v"(tid)); const int lane = tid & 63; const int wave = __builtin_amdgcn_readfirstlane(tid >> 6); (void)lane; (void)wave;

struct EpiIn {
    static constexpr bool PERM = true, AFTER_DRAIN = false;
    bf16* Z; bf16* XS; const float* bias;
    __device__ __forceinline__ void operator()(const f32x4 (&acc)[2][2][4][2], const pg8::Unit& u, int wr, int wc, int fr, int fq) const {
        const int row0 = u.pm * 256 + wr * 64 + fr, col0 = u.pn * 256 + wc * 32 + 8 * fq;
        f32x4 bv[2][2];
#pragma unroll
        for (int bj = 0; bj < 2; ++bj)
#pragma unroll
            for (int n = 0; n < 2; ++n) bv[bj][n] = *(const f32x4*)(bias + col0 + bj * 128 + 4 * n);
        const bool isz = (u.pn < 8);
#pragma unroll
        for (int ai = 0; ai < 2; ++ai)
#pragma unroll
            for (int m = 0; m < 4; ++m) {
                const int r = row0 + ai * 128 + m * 16;
#pragma unroll
                for (int bj = 0; bj < 2; ++bj) {
                    f32x4 v0 = acc[ai][bj][m][0] + bv[bj][0], v1 = acc[ai][bj][m][1] + bv[bj][1];
                    const int c = col0 + bj * 128;
                    u32x4 w;
                    if (isz) {
                        w.x = pg8::cvt_pk_bf16(gelu_tanh(v0[0]), gelu_tanh(v0[1])); w.y = pg8::cvt_pk_bf16(gelu_tanh(v0[2]), gelu_tanh(v0[3]));
                        w.z = pg8::cvt_pk_bf16(gelu_tanh(v1[0]), gelu_tanh(v1[1])); w.w = pg8::cvt_pk_bf16(gelu_tanh(v1[2]), gelu_tanh(v1[3]));
                        *(u32x4*)(Z + (size_t)r * 2048 + c) = w;
                    } else {
                        w.x = pg8::cvt_pk_bf16(v0[0], v0[1]); w.y = pg8::cvt_pk_bf16(v0[2], v0[3]); w.z = pg8::cvt_pk_bf16(v1[0], v1[1]); w.w = pg8::cvt_pk_bf16(v1[2], v1[3]);
                        const int cc = c - 2048, g = cc >> 4, i = cc & 15;
                        *(u32x4*)(XS + ((size_t)(g * 256 + (r >> 6)) * 64 + (r & 63)) * 16 + i) = w;
                    }
                }
            }
    }
};
struct EpiGlu {
    static constexpr bool PERM = true, AFTER_DRAIN = false;
    const bf16* Gb; bf16* MIX; const float* bias;
    __device__ __forceinline__ void operator()(const f32x4 (&acc)[2][2][4][2], const pg8::Unit& u, int wr, int wc, int fr, int fq) const {
        const int row0 = u.pm * 256 + wr * 64 + fr, col0 = u.pn * 256 + wc * 32 + 8 * fq;
        f32x4 bv[2][2];
#pragma unroll
        for (int bj = 0; bj < 2; ++bj)
#pragma unroll
            for (int n = 0; n < 2; ++n) bv[bj][n] = *(const f32x4*)(bias + col0 + bj * 128 + 4 * n);
#pragma unroll
        for (int ai = 0; ai < 2; ++ai)
#pragma unroll
            for (int m = 0; m < 4; ++m) {
                const int r = row0 + ai * 128 + m * 16;
#pragma unroll
                for (int bj = 0; bj < 2; ++bj) {
                    const f32x4 v0 = acc[ai][bj][m][0] + bv[bj][0], v1 = acc[ai][bj][m][1] + bv[bj][1];
                    const int c = col0 + bj * 128;
                    const u32x4 gw = *(const u32x4*)(Gb + (size_t)r * 1024 + c);
                    u32x4 w;
                    w.x = pg8::cvt_pk_bf16(bflo(gw.x) * fast_sigmoid(v0[0]), bfhi(gw.x) * fast_sigmoid(v0[1]));
                    w.y = pg8::cvt_pk_bf16(bflo(gw.y) * fast_sigmoid(v0[2]), bfhi(gw.y) * fast_sigmoid(v0[3]));
                    w.z = pg8::cvt_pk_bf16(bflo(gw.z) * fast_sigmoid(v1[0]), bfhi(gw.z) * fast_sigmoid(v1[1]));
                    w.w = pg8::cvt_pk_bf16(bflo(gw.w) * fast_sigmoid(v1[2]), bfhi(gw.w) * fast_sigmoid(v1[3]));
                    *(u32x4*)(MIX + (size_t)r * 2048 + 1024 + c) = w;
                }
            }
    }
};
template <bool XIN_BF16> struct EpiOut {
    static constexpr bool PERM = true, AFTER_DRAIN = false;
    const void* xin; bf16* X; const float* gate; float* PS;
    __device__ __forceinline__ void operator()(const f32x4 (&acc)[2][2][4][2], const pg8::Unit& u, int wr, int wc, int fr, int fq) const {
        const int row0 = u.pm * 256 + wr * 64 + fr, col0 = u.pn * 256 + wc * 32 + 8 * fq;
        f32x4 gv[2][2];
#pragma unroll
        for (int bj = 0; bj < 2; ++bj)
#pragma unroll
            for (int n = 0; n < 2; ++n) gv[bj][n] = *(const f32x4*)(gate + col0 + bj * 128 + 4 * n);
#pragma unroll
        for (int ai = 0; ai < 2; ++ai)
#pragma unroll
            for (int m = 0; m < 4; ++m) {
                const int r = row0 + ai * 128 + m * 16; float ssq = 0.f;
#pragma unroll
                for (int bj = 0; bj < 2; ++bj) {
                    const size_t off = (size_t)r * 2048 + col0 + bj * 128;
                    f32x4 x0, x1;
                    if (XIN_BF16) { const u32x4 w = *(const u32x4*)((const bf16*)xin + off); x0 = (f32x4){bflo(w.x), bfhi(w.x), bflo(w.y), bfhi(w.y)}; x1 = (f32x4){bflo(w.z), bfhi(w.z), bflo(w.w), bfhi(w.w)}; }
                    else { x0 = *(const f32x4*)((const float*)xin + off); x1 = *(const f32x4*)((const float*)xin + off + 4); }
                    const f32x4 y0 = x0 + gv[bj][0] * acc[ai][bj][m][0], y1 = x1 + gv[bj][1] * acc[ai][bj][m][1];
                    u32x4 o; o.x = pg8::cvt_pk_bf16(y0[0], y0[1]); o.y = pg8::cvt_pk_bf16(y0[2], y0[3]); o.z = pg8::cvt_pk_bf16(y1[0], y1[1]); o.w = pg8::cvt_pk_bf16(y1[2], y1[3]);
                    *(u32x4*)(X + off) = o;
                    ssq += (y0[0] * y0[0] + y0[1] * y0[1]) + (y0[2] * y0[2] + y0[3] * y0[3]) + (y1[0] * y1[0] + y1[1] * y1[1]) + (y1[2] * y1[2] + y1[3] * y1[3]);
                }
                ssq += __shfl_xor(ssq, 16); ssq += __shfl_xor(ssq, 32);
                if (fq == 0) PS[(size_t)r * 32 + u.pn * 4 + wc] = ssq;
            }
    }
};
struct EpiQ {
    static constexpr bool PERM = true, AFTER_DRAIN = false;
    bf16* Q; const float* c0; const LAS float* rrL; int pm0;
    __device__ __forceinline__ void operator()(const f32x4 (&acc)[2][2][4][2], const pg8::Unit& u, int wr, int wc, int fr, int fq) const {
        const int row0 = u.pm * 256 + wr * 64 + fr, col0 = u.pn * 256 + wc * 32 + 8 * fq;
        const LAS float* rrp = rrL + (u.pm == pm0 ? 0 : 256) + wr * 64 + fr;
        f32x4 cv[2][2];
#pragma unroll
        for (int bj = 0; bj < 2; ++bj)
#pragma unroll
            for (int n = 0; n < 2; ++n) cv[bj][n] = *(const f32x4*)(c0 + col0 + bj * 128 + 4 * n);
#pragma unroll
        for (int ai = 0; ai < 2; ++ai)
#pragma unroll
            for (int m = 0; m < 4; ++m) {
                const int r = row0 + ai * 128 + m * 16; const float rr = rrp[ai * 128 + m * 16];
#pragma unroll
                for (int bj = 0; bj < 2; ++bj) {
                    const f32x4 v0 = acc[ai][bj][m][0] * rr + cv[bj][0], v1 = acc[ai][bj][m][1] * rr + cv[bj][1];
                    u32x4 w; w.x = pg8::cvt_pk_bf16(v0[0], v0[1]); w.y = pg8::cvt_pk_bf16(v0[2], v0[3]); w.z = pg8::cvt_pk_bf16(v1[0], v1[1]); w.w = pg8::cvt_pk_bf16(v1[2], v1[3]);
                    *(u32x4*)(Q + (size_t)r * 2048 + col0 + bj * 128) = w;
                }
            }
    }
};
__device__ __forceinline__ void fill_rr(Frame& F, LAS float* rrL, int slot, int pm, int tid) {
    if (tid < 256) { const float* ps = (const float*)(F.ws + WS_PS) + ((size_t)pm * 256 + tid) * 32; float s = 0.f;
#pragma unroll
        for (int i = 0; i < 8; ++i) { const f32x4 v = *(const f32x4*)(ps + 4 * i); s += (v[0] + v[1]) + (v[2] + v[3]); }
        rrL[slot * 256 + tid] = 1.0f / sqrtf(s * (1.0f / DM) + EPS); }
}

__device__ __forceinline__ void p0_transpose_item(const float* W, int K, int N, bf16* WT, const float* kscale, LAS float* scr, int item, int lane, const float* kscale2 = nullptr) {
    const int nblk = N / 32, kb = item / nblk, nb = item % nblk, k0 = 64 * kb, n0 = 32 * nb;
    float wv[32];
#pragma unroll
    for (int i = 0; i < 32; ++i) wv[i] = W[(size_t)(k0 + 2 * i + (lane >> 5)) * N + n0 + (lane & 31)];
#pragma unroll
    for (int i = 0; i < 32; ++i) { const int kk = 2 * i + (lane >> 5); float v = wv[i]; if (kscale) { v *= kscale[k0 + kk]; if (kscale2) v *= 1.0f + kscale2[k0 + kk]; } scr[kk * 33 + (lane & 31)] = v; }
    LDS_WAIT(); asm volatile("" ::: "memory");
    const int c = lane & 7;
#pragma unroll
    for (int j = 0; j < 4; ++j) { const int n = (lane >> 3) + 8 * j; const LAS float* s = scr + (8 * c) * 33 + n;
        u32x4 o; o.x = pk2(s[0 * 33], s[1 * 33]); o.y = pk2(s[2 * 33], s[3 * 33]); o.z = pk2(s[4 * 33], s[5 * 33]); o.w = pk2(s[6 * 33], s[7 * 33]);
        *(u32x4*)(WT + (size_t)(n0 + n) * K + k0 + 8 * c) = o; }
    LDS_WAIT(); asm volatile("" ::: "memory");
}

__device__ __forceinline__ void norm_mod_row(const f32x4 (&v)[4][2], const float* gain, const float* scale, const float* shift, int lane, u32x4 (&o)[4]) {
    float s = 0.f;
#pragma unroll
    for (int j = 0; j < 4; ++j)
#pragma unroll
        for (int h = 0; h < 2; ++h) s += (v[j][h][0] * v[j][h][0] + v[j][h][1] * v[j][h][1]) + (v[j][h][2] * v[j][h][2] + v[j][h][3] * v[j][h][3]);
    const float rr = 1.0f / sqrtf(wave_sum(s) * (1.0f / DM) + EPS);
#pragma unroll
    for (int j = 0; j < 4; ++j) {
        const int c = j * 512 + lane * 8;
        f32x4 y[2];
#pragma unroll
        for (int h = 0; h < 2; ++h) {
            const f32x4 g = *(const f32x4*)(gain + c + 4 * h);
            y[h] = v[j][h] * rr * g;
            const f32x4 sc = *(const f32x4*)(scale + c + 4 * h), sh = *(const f32x4*)(shift + c + 4 * h); y[h] = y[h] * (sc + 1.0f) + sh;
        }
        o[j].x = pk2(y[0][0], y[0][1]); o[j].y = pk2(y[0][2], y[0][3]); o[j].z = pk2(y[1][0], y[1][1]); o[j].w = pk2(y[1][2], y[1][3]);
    }
}
template <bool SRC_BF16>
__device__ __forceinline__ void load_row(const void* xrow_, int lane, f32x4 (&v)[4][2]) {
#pragma unroll
    for (int j = 0; j < 4; ++j) {
        if (SRC_BF16) { const u32x4 w = *(const u32x4*)((const bf16*)xrow_ + j * 512 + lane * 8); v[j][0] = (f32x4){bflo(w.x), bfhi(w.x), bflo(w.y), bfhi(w.y)}; v[j][1] = (f32x4){bflo(w.z), bfhi(w.z), bflo(w.w), bfhi(w.w)}; }
        else { const float* xrow = (const float*)xrow_; v[j][0] = *(const f32x4*)(xrow + j * 512 + lane * 8); v[j][1] = *(const f32x4*)(xrow + j * 512 + lane * 8 + 4); } }
}

__device__ __forceinline__ void p0_gemv_unit(Frame& F, int unit, int tid, float* modout) {
    const int l = unit / 192, r = unit % 192, cb = r >> 1, kh = r & 1;
    LAS float* sc = (LAS float*)F.lds;
    LAS float* red = (LAS float*)(F.lds + 4096);
    for (int k = tid; k < 1024; k += NTHR) { const float c = F.in[I_C][kh * 1024 + k]; sc[k] = c * fast_sigmoid(c); }
    __syncthreads();
    const int tx = tid & 31, ty = tid >> 5;
    const float* W = F.in[I_WMOD] + ((size_t)l * DM + kh * 1024) * 12288 + cb * 128 + tx * 4;
    f32x4 a = {0.f, 0.f, 0.f, 0.f};
#pragma unroll 16
    for (int k = ty; k < 1024; k += 16) { const f32x4 w = *(const f32x4*)(W + (size_t)k * 12288); a += w * sc[k]; }
    *(LAS f32x4*)(red + ty * 128 + tx * 4) = a;
    __syncthreads();
    if (tid < 128) { float s = 0.f;
#pragma unroll
        for (int y = 0; y < 16; ++y) s += red[y * 128 + tid];
        if (kh == 0) s += F.in[I_BMOD][l * 12288 + cb * 128 + tid];
        atomicAdd(modout + l * 12288 + cb * 128 + tid, s); }
    __syncthreads();
}
__device__ __forceinline__ void p0_s5_unit(Frame& F, int unit, int tid, int parts = 15) {
    const int l = unit >> 7, g = (unit >> 1) & 63, hf = unit & 1;
    LAS float* apr = (LAS float*)F.lds;
    LAS float* api = apr + 4228;
    LAS float* bbr = api + 4228;
    LAS float* bbi = bbr + 1024;
    LAS float* ccr = bbi + 1024;
    LAS float* cci = ccr + 16 * 65;
    const float dt = expf(F.in[I_LDT][l * 64 + g]);
    const float* lre = F.in[I_LRE] + (l * 64 + g) * 64; const float* lim = F.in[I_LIM] + (l * 64 + g) * 64;
    for (int idx = tid; idx < 65 * 64; idx += NTHR) { const int d = idx >> 6, p = idx & 63;
        const float mag = expf(lre[p] * dt * (float)d); float sn, cs; sincosf(lim[p] * dt * (float)d, &sn, &cs);
        apr[d * 65 + p] = mag * cs; api[d * 65 + p] = mag * sn; }
    for (int idx = tid; idx < 1024; idx += NTHR) { const int o = idx >> 6, p = idx & 63;
        ccr[o * 65 + p] = F.in[I_CRE][((size_t)(l * 64 + g) * 16 + o) * 64 + p]; cci[o * 65 + p] = F.in[I_CIM][((size_t)(l * 64 + g) * 16 + o) * 64 + p]; }
    __syncthreads();
    for (int idx = tid; idx < 1024; idx += NTHR) { const int p = idx >> 4, i = idx & 15;
        const float xr = apr[65 + p] - 1.0f, xi = api[65 + p], lr = lre[p], li = lim[p], den = 1.0f / (lr * lr + li * li);
        const float cr = (xr * lr + xi * li) * den, ci = (xi * lr - xr * li) * den;
        const float br = F.in[I_BRE][((size_t)(l * 64 + g) * 64 + p) * 16 + i], bi = F.in[I_BIM][((size_t)(l * 64 + g) * 64 + p) * 16 + i];
        bbr[idx] = cr * br - ci * bi; bbi[idx] = cr * bi + ci * br; }
    __syncthreads();
    bf16* KT = (bf16*)(F.ws + WS_KTAB) + (size_t)(l * 64 + g) * 80 * 256;
    if (parts & 1) {
        const int d = hf * 32 + (tid >> 4), o = tid & 15;
        const float dskip = F.in[I_SD][l * 1024 + g * 16 + o];
        float s[16];
#pragma unroll
        for (int i = 0; i < 16; ++i) s[i] = 0.f;
        for (int p = 0; p < 64; ++p) { const float ar = apr[d * 65 + p], ai = api[d * 65 + p], cr = ccr[o * 65 + p], ci = cci[o * 65 + p];
            const float er = cr * ar - ci * ai, ei = cr * ai + ci * ar;
#pragma unroll
            for (int q = 0; q < 4; ++q) { const f32x4 br = *(const LAS f32x4*)(bbr + p * 16 + 4 * q), bi = *(const LAS f32x4*)(bbi + p * 16 + 4 * q);
#pragma unroll
                for (int e = 0; e < 4; ++e) s[4 * q + e] += er * br[e] - ei * bi[e]; } }
#if !SELFTEST_S5
        {   const float dsk = (d == 0) ? dskip : 0.f;
#pragma unroll
            for (int i = 0; i < 16; ++i) s[i] += (i == o) ? dsk : 0.f; }
#endif
        u32x4 w0, w1;
        w0.x = pk2(s[0], s[1]); w0.y = pk2(s[2], s[3]); w0.z = pk2(s[4], s[5]); w0.w = pk2(s[6], s[7]);
        w1.x = pk2(s[8], s[9]); w1.y = pk2(s[10], s[11]); w1.z = pk2(s[12], s[13]); w1.w = pk2(s[14], s[15]);
        if ((parts & 8) || w0.x == 0x12345678u) { *(u32x4*)(KT + (size_t)(d + 16) * 256 + o * 16) = w0; *(u32x4*)(KT + (size_t)(d + 16) * 256 + o * 16 + 8) = w1; }
        if ((parts & 8) && hf == 0 && tid < 256) { const u32x4 z = {0u, 0u, 0u, 0u}; *(u32x4*)(KT + tid * 16) = z; *(u32x4*)(KT + tid * 16 + 8) = z; }
    }
    bf16* WG = (bf16*)(F.ws + WS_WG) + (size_t)(l * 64 + g) * 128 * 1024;
    if (parts & 2) for (int it = tid; it < 32 * 64; it += NTHR) { const int p = hf * 32 + (it >> 6), tau = it & 63;
        const float ar = apr[(63 - tau) * 65 + p], ai = api[(63 - tau) * 65 + p];
        unsigned wr_[8], wi_[8];
#pragma unroll
        for (int q = 0; q < 4; ++q) { const f32x4 br = *(const LAS f32x4*)(bbr + p * 16 + 4 * q), bi = *(const LAS f32x4*)(bbi + p * 16 + 4 * q);
            wr_[2 * q] = pk2(ar * br[0] - ai * bi[0], ar * br[1] - ai * bi[1]); wr_[2 * q + 1] = pk2(ar * br[2] - ai * bi[2], ar * br[3] - ai * bi[3]);
            wi_[2 * q] = pk2(ar * bi[0] + ai * br[0], ar * bi[1] + ai * br[1]); wi_[2 * q + 1] = pk2(ar * bi[2] + ai * br[2], ar * bi[3] + ai * br[3]); }
        *(u32x4*)(WG + (size_t)p * 1024 + tau * 16) = (u32x4){wr_[0], wr_[1], wr_[2], wr_[3]}; *(u32x4*)(WG + (size_t)p * 1024 + tau * 16 + 8) = (u32x4){wr_[4], wr_[5], wr_[6], wr_[7]};
        *(u32x4*)(WG + (size_t)(64 + p) * 1024 + tau * 16) = (u32x4){wi_[0], wi_[1], wi_[2], wi_[3]}; *(u32x4*)(WG + (size_t)(64 + p) * 1024 + tau * 16 + 8) = (u32x4){wi_[4], wi_[5], wi_[6], wi_[7]}; }
    bf16* VG = (bf16*)(F.ws + WS_VG) + (size_t)(l * 64 + g) * 1024 * 128;
    if (parts & 4) for (int it = tid; it < 512 * 8; it += NTHR) { const int m = hf * 512 + (it >> 3), p0 = (it & 7) * 8, t = m >> 4, o = m & 15;
        float vr_[8], vi_[8];
#pragma unroll
        for (int e = 0; e < 8; ++e) { const float ar = apr[(t + 1) * 65 + p0 + e], ai = api[(t + 1) * 65 + p0 + e], cr = ccr[o * 65 + p0 + e], ci = cci[o * 65 + p0 + e];
            vr_[e] = cr * ar - ci * ai; vi_[e] = -(cr * ai + ci * ar); }
        *(u32x4*)(VG + (size_t)m * 128 + p0) = (u32x4){pk2(vr_[0], vr_[1]), pk2(vr_[2], vr_[3]), pk2(vr_[4], vr_[5]), pk2(vr_[6], vr_[7])};
        *(u32x4*)(VG + (size_t)m * 128 + 64 + p0) = (u32x4){pk2(vi_[0], vi_[1]), pk2(vi_[2], vi_[3]), pk2(vi_[4], vi_[5]), pk2(vi_[6], vi_[7])}; }
    if (hf == 0 && tid < 64) { float* AT = (float*)(F.ws + WS_AT) + ((size_t)(l * 64 + g) * 64 + tid) * 2; AT[0] = apr[64 * 65 + tid]; AT[1] = api[64 * 65 + tid]; }
    __syncthreads();
}
__device__ __forceinline__ void p0_fp4_chunk(Frame& F, int chunk, int wave, int lane) {
    unsigned char* UV = F.ws + WS_UV; float* SCL = (float*)(F.ws + WS_SCL);
    for (int i = 0; i < 8; i += 2) {
        f32x4 v[2][8]; float am[2] = {0.f, 0.f}; int tbl[2], rr[2];
#pragma unroll
        for (int r2 = 0; r2 < 2; ++r2) {
            const int r = chunk * 64 + wave * 8 + i + r2; tbl[r2] = r >> 15; rr[r2] = r & 32767;
            const float* srcp = (tbl[r2] ? F.in[I_PV] : F.in[I_PU]) + (size_t)rr[r2] * 2048 + lane * 4;
#pragma unroll
            for (int j = 0; j < 8; ++j) v[r2][j] = *(const f32x4*)(srcp + j * 256);
        }
#pragma unroll
        for (int r2 = 0; r2 < 2; ++r2)
#pragma unroll
            for (int j = 0; j < 8; ++j) am[r2] = fmaxf(am[r2], fmaxf(fmaxf(fabsf(v[r2][j][0]), fabsf(v[r2][j][1])), fmaxf(fabsf(v[r2][j][2]), fabsf(v[r2][j][3]))));
#pragma unroll
        for (int o = 1; o < 64; o <<= 1) { am[0] = fmaxf(am[0], __shfl_xor(am[0], o)); am[1] = fmaxf(am[1], __shfl_xor(am[1], o)); }
#pragma unroll
        for (int r2 = 0; r2 < 2; ++r2) {
            const float scale = am[r2] > 0.f ? am[r2] * (1.0f / 6.0f) : 1.0f, inv = am[r2] > 0.f ? 6.0f / am[r2] : 1.0f;
            u32x4 o;
#pragma unroll
            for (int d = 0; d < 4; ++d) { unsigned w = 0u;
                w = __builtin_amdgcn_cvt_scalef32_pk_fp4_f32(w, v[r2][2 * d][0] * inv, v[r2][2 * d][1] * inv, 1.0f, 0);
                w = __builtin_amdgcn_cvt_scalef32_pk_fp4_f32(w, v[r2][2 * d][2] * inv, v[r2][2 * d][3] * inv, 1.0f, 1);
                w = __builtin_amdgcn_cvt_scalef32_pk_fp4_f32(w, v[r2][2 * d + 1][0] * inv, v[r2][2 * d + 1][1] * inv, 1.0f, 2);
                w = __builtin_amdgcn_cvt_scalef32_pk_fp4_f32(w, v[r2][2 * d + 1][2] * inv, v[r2][2 * d + 1][3] * inv, 1.0f, 3);
                o[d] = w; }
            *(u32x4*)(UV + (size_t)rr[r2] * 2048 + tbl[r2] * 1024 + lane * 16) = o;
            if (lane == 0) SCL[rr[r2] * 2 + tbl[r2]] = scale;
        }
    }
}
#ifndef P0_PARTS
#define P0_PARTS 15
#endif
#ifndef P0_PROBE_MODE
#define P0_PROBE_MODE 0
#endif
__device__ __forceinline__ void p0_tables(Frame& F, int qi = 4, bool dummy = false) {
    PH_LOCALS
    unsigned* head = (unsigned*)(F.ws + WS_CTL) + CW_QUEUE + 64 * qi;
    float* modout = dummy ? (float*)(F.ws + WS_DBG) : (float*)(F.ws + WS_MOD);
    LAS unsigned* slot = (LAS unsigned*)(F.lds + MISC_OFF) + 16;
    for (;;) {
        __syncthreads();
        if (tid == 0) slot[0] = __hip_atomic_fetch_add(head, 1u, RLX_AGENT);
        __syncthreads();
        const unsigned u = slot[0];
        if (u >= 1664u) break;
        const int rnd = (int)u / 13, k = (int)u % 13;
        if (k < 2) { if (dummy && P0_PROBE_MODE == 2) continue; p0_s5_unit(F, rnd * 2 + k, tid, dummy ? P0_PARTS : 15); }
        else if (k < 5) { if (dummy && P0_PROBE_MODE == 1) continue; p0_gemv_unit(F, rnd * 3 + (k - 2), tid, modout); }
        else { p0_fp4_chunk(F, rnd * 8 + (k - 5), wave, lane); }
    }
}
__device__ __forceinline__ void p0_prologue(Frame& F) {
    PH_LOCALS
    const int gw = F.vcu * NWAVES + wave, NGW = F.G * NWAVES;
    const int gt = F.vcu * NTHR + tid, NGT = F.G * NTHR;
    const float* modp = (const float*)(F.ws + WS_MOD);
    for (int i = gt; i < 2 * DM; i += NGT) { const int l = i >> 11, k = i & 2047; ((float*)(F.ws + WS_GS))[i] = F.in[I_N2G][i] * (1.0f + modp[l * 12288 + 4 * 2048 + k]); }
    if (F.vcu < 64) {
        const int l = F.vcu >> 5, cb = F.vcu & 31, tx = tid & 15, ty = tid >> 4;
        const float* W = F.in[I_WQ] + (size_t)l * DM * DM + cb * 64 + tx * 4; const float* sh = modp + l * 12288 + 3 * 2048;
        f32x4 a = {0.f, 0.f, 0.f, 0.f};
#pragma unroll 16
        for (int k = ty; k < DM; k += 32) { const f32x4 w = *(const f32x4*)(W + (size_t)k * DM); a += w * sh[k]; }
        LAS float* red = (LAS float*)F.lds;
        *(LAS f32x4*)(red + ty * 64 + tx * 4) = a;
        __syncthreads();
        if (tid < 64) { float s = 0.f;
#pragma unroll
            for (int y = 0; y < 32; ++y) s += red[y * 64 + tid];
            ((float*)(F.ws + WS_C0))[l * DM + cb * 64 + tid] = s; }
        __syncthreads();
    }
    {
        LAS float* scr = (LAS float*)(F.lds + wave * 16384);
        constexpr int I_IN = (DM / 64) * (INW / 32), I_GL = (WB / 64) * (WB / 32), I_OU = (DM / 64) * (DM / 32), I_Q = I_OU;
        constexpr int PER_L = I_IN + I_GL + I_OU + I_Q;
        for (int it = gw; it < 2 * PER_L; it += NGW) {
            const int l = it / PER_L; int r = it % PER_L;
            if (r < I_IN) { p0_transpose_item(F.in[I_WIN] + (size_t)l * DM * INW, DM, INW, (bf16*)(F.ws + WS_WIN) + (size_t)l * INW * DM, nullptr, scr, r, lane); continue; } r -= I_IN;
            if (r < I_GL) { p0_transpose_item(F.in[I_GLUW] + (size_t)l * WB * WB, WB, WB, (bf16*)(F.ws + WS_GLU) + (size_t)l * WB * WB, nullptr, scr, r, lane); continue; } r -= I_GL;
            if (r < I_OU) { p0_transpose_item(F.in[I_WOUT] + (size_t)l * DM * DM, DM, DM, (bf16*)(F.ws + WS_WOUT) + (size_t)l * DM * DM, F.in[I_BRG] + l * DM, scr, r, lane); continue; } r -= I_OU;
            p0_transpose_item(F.in[I_WQ] + (size_t)l * DM * DM, DM, DM, (bf16*)(F.ws + WS_WQ) + (size_t)l * DM * DM, F.in[I_N2G] + l * DM, scr, r, lane, modp + l * 12288 + 4 * 2048);
        }
    }
    {
        bf16* KB = (bf16*)(F.ws + WS_KEYS);
        for (int i = gt; i < 2 * 8 * 2 * 128 * 128 / 8; i += NGT) { const f32x4 a = *(const f32x4*)(F.in[I_KEYS] + (size_t)i * 8), b = *(const f32x4*)(F.in[I_KEYS] + (size_t)i * 8 + 4);
            u32x4 o; o.x = pk2(a[0], a[1]); o.y = pk2(a[2], a[3]); o.z = pk2(b[0], b[1]); o.w = pk2(b[2], b[3]); *(u32x4*)(KB + (size_t)i * 8) = o; }
        bf16* GW = (bf16*)(F.ws + WS_GWS);
        for (int i = gt; i < 2 * 8 * 128 * 128 / 8; i += NGT) { const int e = i * 8, jj = e & 127, ii = (e >> 7) & 127; const bool keep = (ii >= 64) || (jj < 64);
            f32x4 a = *(const f32x4*)(F.in[I_GWS] + (size_t)i * 8), b = *(const f32x4*)(F.in[I_GWS] + (size_t)i * 8 + 4);
            if (!keep) { a = (f32x4){0.f, 0.f, 0.f, 0.f}; b = a; }
            u32x4 o; o.x = pk2(a[0], a[1]); o.y = pk2(a[2], a[3]); o.z = pk2(b[0], b[1]); o.w = pk2(b[2], b[3]); *(u32x4*)(GW + (size_t)i * 8) = o; }
    }
}

template <bool SRC_BF16>
__device__ __forceinline__ void phase_norm(Frame& F, const void* xsrc, const float* gain, const float* scale, const float* shift) {
    PH_LOCALS
    const int gw = F.vcu * NWAVES + wave, NGW = F.G * NWAVES;
    bf16* H = (bf16*)(F.ws + WS_H);
    for (int m = gw; m < M; m += 2 * NGW) {
        const int m2 = m + NGW;
        f32x4 va[4][2], vb[4][2];
        const char* ra = (const char*)xsrc + (size_t)m * DM * (SRC_BF16 ? 2 : 4); const char* rb = (const char*)xsrc + (size_t)(m2 < M ? m2 : m) * DM * (SRC_BF16 ? 2 : 4);
        load_row<SRC_BF16>(ra, lane, va); load_row<SRC_BF16>(rb, lane, vb);
        u32x4 oa[4], ob[4]; norm_mod_row(va, gain, scale, shift, lane, oa); norm_mod_row(vb, gain, scale, shift, lane, ob);
#pragma unroll
        for (int j = 0; j < 4; ++j) *(u32x4*)(H + (size_t)m * DM + j * 512 + lane * 8) = oa[j];
        if (m2 < M) {
#pragma unroll
            for (int j = 0; j < 4; ++j) *(u32x4*)(H + (size_t)m2 * DM + j * 512 + lane * 8) = ob[j]; }
    }
}
__device__ __forceinline__ void phase_lnstats(Frame& F) {
    PH_LOCALS
    const int gw = F.vcu * NWAVES + wave, NGW = F.G * NWAVES;
    const bf16* Z = (const bf16*)(F.ws + WS_Z); float* ST = (float*)(F.ws + WS_STATS);
    for (int m0 = gw; m0 < M; m0 += 2 * NGW) {
        float v[2][16]; int mm[2];
#pragma unroll
        for (int r = 0; r < 2; ++r) { mm[r] = (m0 + r * NGW < M) ? m0 + r * NGW : m0;
#pragma unroll
            for (int j = 0; j < 2; ++j) { const u32x4 w = *(const u32x4*)(Z + (size_t)mm[r] * 2048 + 1024 + j * 512 + lane * 8);
                v[r][j * 8 + 0] = bflo(w.x); v[r][j * 8 + 1] = bfhi(w.x); v[r][j * 8 + 2] = bflo(w.y); v[r][j * 8 + 3] = bfhi(w.y); v[r][j * 8 + 4] = bflo(w.z); v[r][j * 8 + 5] = bfhi(w.z); v[r][j * 8 + 6] = bflo(w.w); v[r][j * 8 + 7] = bfhi(w.w); } }
        float s[2] = {0.f, 0.f};
#pragma unroll
        for (int r = 0; r < 2; ++r)
#pragma unroll
            for (int i = 0; i < 16; ++i) s[r] += v[r][i];
#pragma unroll
        for (int o = 1; o < 64; o <<= 1) { s[0] += __shfl_xor(s[0], o); s[1] += __shfl_xor(s[1], o); }
        float q[2] = {0.f, 0.f}; const float mean[2] = {s[0] * (1.0f / 1024.0f), s[1] * (1.0f / 1024.0f)};
#pragma unroll
        for (int r = 0; r < 2; ++r)
#pragma unroll
            for (int i = 0; i < 16; ++i) { const float d = v[r][i] - mean[r]; q[r] += d * d; }
#pragma unroll
        for (int o = 1; o < 64; o <<= 1) { q[0] += __shfl_xor(q[0], o); q[1] += __shfl_xor(q[1], o); }
        if (lane < 2) { const int r = lane; const float qq = r ? q[1] : q[0], mu = r ? mean[1] : mean[0]; const int m = r ? mm[1] : mm[0];
            ST[2 * m] = mu; ST[2 * m + 1] = 1.0f / sqrtf(qq * (1.0f / 1024.0f) + EPS); }
    }
}
__device__ __forceinline__ void phase_branchnorm(Frame& F) {
    PH_LOCALS
    const int gw = F.vcu * NWAVES + wave, NGW = F.G * NWAVES;
    bf16* MIX = (bf16*)(F.ws + WS_MIX);
    for (int m0 = gw; m0 < M; m0 += 2 * NGW) {
        u32x4 w[2][4]; float sa[2] = {0.f, 0.f}, sb[2] = {0.f, 0.f}; int mm[2];
#pragma unroll
        for (int r = 0; r < 2; ++r) { mm[r] = (m0 + r * NGW < M) ? m0 + r * NGW : m0;
#pragma unroll
            for (int j = 0; j < 4; ++j) w[r][j] = *(const u32x4*)(MIX + (size_t)mm[r] * 2048 + j * 512 + lane * 8); }
#pragma unroll
        for (int r = 0; r < 2; ++r)
#pragma unroll
            for (int j = 0; j < 4; ++j) { float q = 0.f;
#pragma unroll
                for (int e = 0; e < 4; ++e) { const float a = bflo(w[r][j][e]), b = bfhi(w[r][j][e]); q += a * a + b * b; }
                if (j < 2) sa[r] += q; else sb[r] += q; }
#pragma unroll
        for (int o = 1; o < 64; o <<= 1) { sa[0] += __shfl_xor(sa[0], o); sb[0] += __shfl_xor(sb[0], o); sa[1] += __shfl_xor(sa[1], o); sb[1] += __shfl_xor(sb[1], o); }
#pragma unroll
        for (int r = 0; r < 2; ++r) {
            if (r == 1 && mm[1] == mm[0]) break;
            const float ra = 1.0f / sqrtf(sa[r] * (1.0f / 1024.0f) + EPS), rb = 1.0f / sqrtf(sb[r] * (1.0f / 1024.0f) + EPS);
#pragma unroll
            for (int j = 0; j < 4; ++j) { const float rs = j < 2 ? ra : rb; u32x4 o;
#pragma unroll
                for (int e = 0; e < 4; ++e) o[e] = pk2(bflo(w[r][j][e]) * rs, bfhi(w[r][j][e]) * rs);
                *(u32x4*)(MIX + (size_t)mm[r] * 2048 + j * 512 + lane * 8) = o; }
        }
    }
}

__device__ __forceinline__ void phase_sloc(Frame& F, int l) {
    PH_LOCALS
    const bf16* XS = (const bf16*)(F.ws + WS_XS); const bf16* WG = (const bf16*)(F.ws + WS_WG) + (size_t)l * 64 * 128 * 1024; float* SL = (float*)(F.ws + WS_SLOC);
    const int fr = lane & 15, fq = lane >> 4;
    for (int u = F.vcu; u < 256; u += F.G) {
        const int g = u >> 2, n0 = (u & 3) * 64 + (wave & 3) * 16, jh = wave >> 2;
        f32x4 acc[4];
#pragma unroll
        for (int t = 0; t < 4; ++t) acc[t] = (f32x4){0.f, 0.f, 0.f, 0.f};
        const bf16* xp = XS + ((size_t)(g * 256 + n0 + fr)) * 1024 + 8 * fq;
        const bf16* wp = WG + ((size_t)(g * 128 + jh * 64 + fr)) * 1024 + 8 * fq;
#pragma unroll 8
        for (int kb = 0; kb < 32; ++kb) {
            const bf16x8 xf = *(const bf16x8*)(xp + kb * 32);
#pragma unroll
            for (int t = 0; t < 4; ++t) { const bf16x8 wf = *(const bf16x8*)(wp + (size_t)t * 16 * 1024 + kb * 32); acc[t] = __builtin_amdgcn_mfma_f32_16x16x32_bf16(wf, xf, acc[t], 0, 0, 0); }
        }
#pragma unroll
        for (int t = 0; t < 4; ++t) *(f32x4*)(SL + ((size_t)(g * 256 + n0 + fr)) * 128 + jh * 64 + t * 16 + 4 * fq) = acc[t];
    }
}
__device__ __forceinline__ void gating_unit(Frame& F, int l, int unit) {
    PH_LOCALS
    const int nb = unit >> 3, hh = unit & 7, t0 = nb * 128, c0 = hh * 128;
    const bf16* Z = (const bf16*)(F.ws + WS_Z); const float* ST = (const float*)(F.ws + WS_STATS);
    const bf16* GW = (const bf16*)(F.ws + WS_GWS) + (size_t)(l * 8 + hh) * 128 * 128;
    bf16* MIX = (bf16*)(F.ws + WS_MIX);
    LAS bf16* VT = (LAS bf16*)F.lds;
    constexpr int VS = 136;
    {
        const int j = tid >> 2, cs = (tid & 3) * 32;
        const float mu = ST[2 * (t0 + j)], rs = ST[2 * (t0 + j) + 1];
        const float* lg = F.in[I_LNG] + l * 1024 + c0 + cs; const float* lb = F.in[I_LNB] + l * 1024 + c0 + cs;
#pragma unroll
        for (int q = 0; q < 4; ++q) {
            const u32x4 w = *(const u32x4*)(Z + (size_t)(t0 + j) * 2048 + 1024 + c0 + cs + q * 8);
#pragma unroll
            for (int e = 0; e < 4; ++e) { const int c = cs + q * 8 + 2 * e;
                const float a = (bflo(w[e]) - mu) * rs * lg[q * 8 + 2 * e] + lb[q * 8 + 2 * e], b = (bfhi(w[e]) - mu) * rs * lg[q * 8 + 2 * e + 1] + lb[q * 8 + 2 * e + 1];
                VT[c * VS + j] = (bf16)f2bf(a); VT[(c + 1) * VS + j] = (bf16)f2bf(b); }
        }
    }
    __syncthreads();
    {
        const int fr = lane & 15, fq = lane >> 4, w = wave;
        f32x4 acc[8];
#pragma unroll
        for (int ct = 0; ct < 8; ++ct) acc[ct] = (f32x4){0.f, 0.f, 0.f, 0.f};
        const int nkb = (w < 4) ? 2 : 4;
        for (int kb = 0; kb < nkb; ++kb) {
            const bf16x8 wf = *(const bf16x8*)(GW + (size_t)(16 * w + fr) * 128 + kb * 32 + 8 * fq);
#pragma unroll
            for (int ct = 0; ct < 8; ++ct) { const bf16x8 vf = *(const LAS bf16x8*)(VT + (ct * 16 + fr) * VS + kb * 32 + 8 * fq); acc[ct] = __builtin_amdgcn_mfma_f32_16x16x32_bf16(vf, wf, acc[ct], 0, 0, 0); }
        }
        const int tok = t0 + 16 * w + fr; const float bs = F.in[I_GBS][(l * 8 + hh) * 128 + 16 * w + fr];
#pragma unroll
        for (int ct = 0; ct < 8; ++ct) { const int c = c0 + ct * 16 + 4 * fq;
            const u32x2 uw = *(const u32x2*)(Z + (size_t)tok * 2048 + c);
            u32x2 o; o.x = pk2(bflo(uw.x) * (acc[ct][0] + bs), bfhi(uw.x) * (acc[ct][1] + bs)); o.y = pk2(bflo(uw.y) * (acc[ct][2] + bs), bfhi(uw.y) * (acc[ct][3] + bs));
            *(u32x2*)(MIX + (size_t)tok * 2048 + c) = o; }
    }
    __syncthreads();
}
__device__ __forceinline__ void phase_gating(Frame& F, int l) {
    for (int u = F.vcu; u < 1024; u += F.G) gating_unit(F, l, u);
}

__device__ __forceinline__ void phase_s5out(Frame& F, int l) {
    PH_LOCALS
    const bf16* XS = (const bf16*)(F.ws + WS_XS);
    bf16* Gb = (bf16*)(F.ws + WS_G);
    LAS unsigned char* HT = F.lds;
    LAS float* TS = (LAS float*)(F.lds + 34816);
    LAS unsigned char* KT = F.lds + 38912;
    LAS unsigned char* VT = F.lds + 79872;
    const int fr = lane & 15, fq = lane >> 4;
    for (int u = F.vcu; u < 512; u += F.G) {
        const int g = u >> 3, rc = (u >> 1) & 3, nh = u & 1;
        const bf16* VG = (const bf16*)(F.ws + WS_VG) + (size_t)(l * 64 + g) * 1024 * 128;
        const int n = nh * 128 + 16 * wave + fr;
        const bf16* xp0 = XS + ((size_t)(g * 256 + n)) * 1024 + 8 * fq;
        bf16x8 xa[4], xb[4];
#pragma unroll
        for (int i = 0; i < 4; ++i) xa[i] = *(const bf16x8*)(xp0 + i * 32);
        __syncthreads();
        { const u32x4* src = (const u32x4*)((const bf16*)(F.ws + WS_KTAB) + (size_t)(l * 64 + g) * 80 * 256);
          for (int i = tid; i < 80 * 256 / 8; i += NTHR) ((LAS u32x4*)KT)[i] = src[i];
#pragma unroll
          for (int ps = 0; ps < 8; ++ps) { const int row = ps * 32 + (tid >> 4), c = tid & 15, q = row >> 4, o = row & 15;
              *(LAS u32x4*)(VT + row * 272 + c * 16) = *(const u32x4*)(VG + (size_t)((rc + 4 * q) * 16 + o) * 128 + c * 8); } }
        {
            const int p = lane, seg = wave;
            const float* AT = (const float*)(F.ws + WS_AT) + ((size_t)(l * 64 + g) * 64 + p) * 2; const float ar = AT[0], ai = AT[1];
            const float* SL = (const float*)(F.ws + WS_SLOC) + ((size_t)(g * 256 + seg * 32)) * 128 + p;
            float sr[32], si[32];
#pragma unroll
            for (int i = 0; i < 32; ++i) { sr[i] = SL[(size_t)i * 128]; si[i] = SL[(size_t)i * 128 + 64]; }
            float er = 0.f, ei = 0.f;
#pragma unroll
            for (int i = 0; i < 32; ++i) { const float nr = ar * er - ai * ei + sr[i], ni = ar * ei + ai * er + si[i]; er = nr; ei = ni; }
            TS[(seg * 64 + p) * 2] = er; TS[(seg * 64 + p) * 2 + 1] = ei;
            float qr = ar, qi = ai;
#pragma unroll
            for (int s = 0; s < 5; ++s) { const float nr = qr * qr - qi * qi, ni = 2.0f * qr * qi; qr = nr; qi = ni; }
            __syncthreads();
            float hr = 0.f, hi = 0.f;
            for (int k = 0; k < seg; ++k) { const float tr = TS[(k * 64 + p) * 2], ti = TS[(k * 64 + p) * 2 + 1]; const float nr = qr * hr - qi * hi + tr, ni = qr * hi + qi * hr + ti; hr = nr; hi = ni; }
            if ((seg >> 2) == nh) {
                LAS bf16* hrow = (LAS bf16*)(HT + ((seg & 3) * 32) * 272) + p;
#pragma unroll
                for (int i = 0; i < 32; ++i) { hrow[i * 136] = (bf16)f2bf(hr); hrow[i * 136 + 64] = (bf16)f2bf(hi);
                    const float nr = ar * hr - ai * hi + sr[i], ni = ar * hi + ai * hr + si[i]; hr = nr; hi = ni; }
            }
        }
        __syncthreads();
        f32x4 acc[16];
#pragma unroll
        for (int q = 0; q < 16; ++q) acc[q] = (f32x4){0.f, 0.f, 0.f, 0.f};
        const int kb0 = ((rc - (fq >> 1) + 10) * 16 + fr) * 32 + 16 * (fq & 1);
#define S5_GROUP(XF, grp_) do { const LAS unsigned char* kp = KT + kb0 - (grp_) * 4096; \
            _Pragma("unroll") for (int q = 0; q < 16; ++q) { if (rc + 4 * q >= 8 * (grp_)) { \
                _Pragma("unroll") for (int i = 0; i < 4; ++i) { const bf16x8 kf = *(const LAS bf16x8*)(kp + (4 * q - 2 * i + 6) * 512); \
                    acc[q] = __builtin_amdgcn_mfma_f32_16x16x32_bf16(kf, XF[i], acc[q], 0, 0, 0); } } } } while (0)
#pragma unroll 1
        for (int gp = 0; gp < 4; ++gp) {
#pragma unroll
            for (int i = 0; i < 4; ++i) xb[i] = *(const bf16x8*)(xp0 + ((2 * gp + 1) * 4 + i) * 32);
            S5_GROUP(xa, 2 * gp);
            if (gp < 3) {
#pragma unroll
                for (int i = 0; i < 4; ++i) xa[i] = *(const bf16x8*)(xp0 + ((2 * gp + 2) * 4 + i) * 32);
            }
            S5_GROUP(xb, 2 * gp + 1);
        }
#undef S5_GROUP
#pragma unroll 1
        for (int jb = 0; jb < 4; ++jb) {
            const bf16x8 hf = *(const LAS bf16x8*)(HT + (16 * wave + fr) * 272 + (jb * 32 + 8 * fq) * 2);
#pragma unroll
            for (int q = 0; q < 16; ++q) {
                const bf16x8 vf = *(const LAS bf16x8*)(VT + (q * 16 + fr) * 272 + (jb * 32 + 8 * fq) * 2);
                acc[q] = __builtin_amdgcn_mfma_f32_16x16x32_bf16(vf, hf, acc[q], 0, 0, 0);
            }
        }
#pragma unroll
        for (int q = 0; q < 16; ++q) {
            const int t = rc + 4 * q, tok = 64 * n + t;
            const f32x4 y = acc[q];
            u32x2 o; o.x = pk2(gelu_tanh(y[0]), gelu_tanh(y[1])); o.y = pk2(gelu_tanh(y[2]), gelu_tanh(y[3]));
            *(u32x2*)(Gb + (size_t)tok * 1024 + g * 16 + 4 * fq) = o;
#if SELFTEST_S5
            if (tok < 256) *(f32x4*)((float*)(F.ws + WS_DBG) + (size_t)tok * 1024 + g * 16 + 4 * fq) = y;
#endif
        }
    }
    __syncthreads();
}
#if SELFTEST_S5
__device__ __forceinline__ void selftest_s5(Frame& F, int l) {
    PH_LOCALS
    if (F.vcu < 64 && wave == 0) {
        const int g = F.vcu, p = lane;
        const float dt = expf(F.in[I_LDT][l * 64 + g]);
        const float lr = F.in[I_LRE][(l * 64 + g) * 64 + p], li = F.in[I_LIM][(l * 64 + g) * 64 + p];
        const float mag = expf(lr * dt); float sn, cs; sincosf(li * dt, &sn, &cs);
        const float ar = mag * cs, ai = mag * sn;
        const float xr = ar - 1.0f, xi = ai, den = 1.0f / (lr * lr + li * li);
        const float cr = (xr * lr + xi * li) * den, ci = (xi * lr - xr * li) * den;
        float bbr[16], bbi[16], ccr[16], cci[16];
#pragma unroll
        for (int i = 0; i < 16; ++i) { const float br = F.in[I_BRE][((size_t)(l * 64 + g) * 64 + p) * 16 + i], bi = F.in[I_BIM][((size_t)(l * 64 + g) * 64 + p) * 16 + i];
            bbr[i] = cr * br - ci * bi; bbi[i] = cr * bi + ci * br;
            ccr[i] = F.in[I_CRE][((size_t)(l * 64 + g) * 16 + i) * 64 + p]; cci[i] = F.in[I_CIM][((size_t)(l * 64 + g) * 16 + i) * 64 + p]; }
        const bf16* XS = (const bf16*)(F.ws + WS_XS) + (size_t)g * 256 * 1024;
        const float* DY = (const float*)(F.ws + WS_DBG);
        float sr = 0.f, si = 0.f, err = 0.f, ref = 0.f;
        for (int t = 0; t < 256; ++t) {
            float x[16];
#pragma unroll
            for (int i = 0; i < 16; ++i) x[i] = bflo((unsigned)XS[(size_t)t * 16 + i]);
            float ur = 0.f, ui = 0.f;
#pragma unroll
            for (int i = 0; i < 16; ++i) { ur += bbr[i] * x[i]; ui += bbi[i] * x[i]; }
            const float nr = ar * sr - ai * si + ur, ni = ar * si + ai * sr + ui; sr = nr; si = ni;
#pragma unroll
            for (int o = 0; o < 16; ++o) {
                const float yr = wave_sum(ccr[o] * sr - cci[o] * si);
                const float yf = DY[(size_t)t * 1024 + g * 16 + o];
                err += (yf - yr) * (yf - yr); ref += yr * yr;
            }
        }
        if (lane == 0 && !(err <= 2e-3f * ref)) __hip_atomic_fetch_or((unsigned*)(F.ws + WS_CTL) + CW_FLAG, 1u, RLX_AGENT);
    }
}
#endif

__device__ __forceinline__ unsigned f2key(float v) { const unsigned u = __builtin_bit_cast(unsigned, v); return (u & 0x80000000u) ? ~u : (u | 0x80000000u); }
__device__ __forceinline__ float key2f(unsigned k) { const unsigned u = (k & 0x80000000u) ? (k & 0x7fffffffu) : ~k; return __builtin_bit_cast(float, u); }
__device__ __forceinline__ void sort16_desc(unsigned (&v)[16]) {
#pragma unroll
    for (int lk = 1; lk <= 4; ++lk) {
#pragma unroll
        for (int lj = lk - 1; lj >= 0; --lj) {
#pragma unroll
            for (int i = 0; i < 16; ++i) { const int k = 1 << lk, j = 1 << lj, p = i ^ j;
                if (p > i) { const unsigned a = v[i], c = v[p], hi = a > c ? a : c, lo = a > c ? c : a; const bool desc = ((i & k) == 0) || (k == 16);
                    v[i] = desc ? hi : lo; v[p] = desc ? lo : hi; } }
        }
    }
}
__device__ __forceinline__ void merge16_desc(unsigned (&v)[16], const unsigned (&w)[16]) {
#pragma unroll
    for (int i = 0; i < 16; ++i) v[i] = v[i] > w[15 - i] ? v[i] : w[15 - i];
#pragma unroll
    for (int lj = 3; lj >= 0; --lj) {
#pragma unroll
        for (int i = 0; i < 16; ++i) { const int j = 1 << lj, p = i ^ j;
            if (p > i) { const unsigned a = v[i], c = v[p]; v[i] = a > c ? a : c; v[p] = a > c ? c : a; } }
    }
}
__device__ __forceinline__ void xmerge16(unsigned (&v)[16], int mask) {
    unsigned w[16];
#pragma unroll
    for (int i = 0; i < 16; ++i) w[i] = (unsigned)__shfl_xor((int)v[i], mask);
    merge16_desc(v, w);
}
__device__ __forceinline__ void phase_topk(Frame& F, int l) {
    PH_LOCALS
    const bf16* Q = (const bf16*)(F.ws + WS_Z);
    const bf16* KB = (const bf16*)(F.ws + WS_KEYS) + (size_t)l * 8 * 2 * 128 * 128;
    int* EID = (int*)(F.ws + WS_EID); float* GT = (float*)(F.ws + WS_GATE); float* SUo = (float*)(F.ws + WS_SU);
    const float* SCL = (const float*)(F.ws + WS_SCL) + (size_t)l * NEXP * 2;
    LAS unsigned char* KL = F.lds;
    LAS float* SC = (LAS float*)(F.lds + 69632);
    LAS unsigned* LST = (LAS unsigned*)(F.lds + 69632 + 66560);
    LAS unsigned char* PT = F.lds + 69632 + 66560 + 8192;
    const int fr = lane & 15, fq = lane >> 4;
    {
        int c = 0;
#pragma unroll
        for (int i = 0; i < 16; ++i)
#pragma unroll
            for (int j = 0; j < 16; ++j) if ((i + 1) * (j + 1) <= 16) { if (tid == c) PT[c] = (unsigned char)(i * 16 + j); ++c; }
    }
    int cur_hh = -1;
    for (int u = F.vcu; u < 2048; u += F.G) {
        const int tt = u >> 3, hh = u & 7, t0 = tt * 64;
        const int tw = wave & 3, s = wave >> 2;
        bf16x8 qf[4];
#pragma unroll
        for (int kb = 0; kb < 4; ++kb) qf[kb] = *(const bf16x8*)(Q + (size_t)(t0 + 16 * tw + fr) * 2048 + hh * 256 + s * 128 + kb * 32 + 8 * fq);
        if (hh != cur_hh) {
            __syncthreads();
#pragma unroll
            for (int ps = 0; ps < 8; ++ps) { const int idx = ps * 512 + tid, row = idx >> 4, c16 = idx & 15;
                *(LAS u32x4*)(KL + row * 272 + c16 * 16) = *(const u32x4*)(KB + ((size_t)(hh * 256 + row)) * 128 + c16 * 8); }
            cur_hh = hh;
        }
        __syncthreads();
        {
            f32x4 acc[8];
#pragma unroll
            for (int nt = 0; nt < 8; ++nt) acc[nt] = (f32x4){0.f, 0.f, 0.f, 0.f};
#pragma unroll
            for (int kb = 0; kb < 4; ++kb)
#pragma unroll
                for (int nt = 0; nt < 8; ++nt) { const bf16x8 kf = *(const LAS bf16x8*)(KL + (s * 128 + nt * 16 + fr) * 272 + (kb * 32 + 8 * fq) * 2);
                    acc[nt] = __builtin_amdgcn_mfma_f32_16x16x32_bf16(kf, qf[kb], acc[nt], 0, 0, 0); }
#pragma unroll
            for (int nt = 0; nt < 8; ++nt) *(LAS f32x4*)(SC + (16 * tw + fr) * 260 + s * 128 + nt * 16 + 4 * fq) = acc[nt];
        }
        __syncthreads();
        {
            const int pr = tid >> 2, sub = tid & 3, tl = pr >> 1, sd = pr & 1;
            const LAS float* row = SC + tl * 260 + sd * 128 + 32 * sub;
            unsigned va[16], vb[16];
#pragma unroll
            for (int q4 = 0; q4 < 4; ++q4) { const f32x4 x = *(const LAS f32x4*)(row + 4 * q4), y = *(const LAS f32x4*)(row + 16 + 4 * q4);
#pragma unroll
                for (int e = 0; e < 4; ++e) { va[4 * q4 + e] = (f2key(x[e]) & ~0x7Fu) | (unsigned)(127 - (32 * sub + 4 * q4 + e)); vb[4 * q4 + e] = (f2key(y[e]) & ~0x7Fu) | (unsigned)(127 - (32 * sub + 16 + 4 * q4 + e)); } }
            sort16_desc(va); sort16_desc(vb); merge16_desc(va, vb);
            xmerge16(va, 1); xmerge16(va, 2);
            if (sub == 0) {
#pragma unroll
                for (int k = 0; k < 16; k += 4) *(LAS u32x4*)(LST + pr * 16 + k) = (u32x4){va[k], va[k + 1], va[k + 2], va[k + 3]};
            }
        }
        __syncthreads();
        {
            const int tl = tid >> 3, s8 = tid & 7;
            unsigned v[16];
#pragma unroll
            for (int m = 0; m < 7; ++m) { const int c = m * 8 + s8; unsigned key = 0u;
                if (c < 50) { const int pij = PT[c], i = pij >> 4, j = pij & 15;
                    const float av = key2f(LST[(tl * 2 + 0) * 16 + i] & ~0x7Fu), bv = key2f(LST[(tl * 2 + 1) * 16 + j] & ~0x7Fu);
                    key = (f2key(av + bv) & ~0xFFu) | (unsigned)(255 - pij); }
                v[m] = key; }
#pragma unroll
            for (int m = 7; m < 16; ++m) v[m] = 0u;
            sort16_desc(v);
            xmerge16(v, 1); xmerge16(v, 2); xmerge16(v, 4);
            float ev[16]; float sum = 0.f; const float mx = key2f(v[0] & ~0xFFu);
#pragma unroll
            for (int k = 0; k < 16; ++k) { ev[k] = __expf(key2f(v[k] & ~0xFFu) - mx); sum += ev[k]; }
            const float inv = 1.0f / sum;
            unsigned k0 = v[0], k1 = v[1]; float e0 = ev[0], e1 = ev[1];
#pragma unroll
            for (int q = 1; q < 8; ++q) { if (s8 == q) { k0 = v[2 * q]; k1 = v[2 * q + 1]; e0 = ev[2 * q]; e1 = ev[2 * q + 1]; } }
            const size_t ob = (size_t)(t0 + tl) * 128 + hh * 16 + 2 * s8;
            {   const int flat = 255 - (int)(k0 & 0xFFu), i = flat >> 4, j = flat & 15;
                const int ia = 127 - (int)(LST[(tl * 2 + 0) * 16 + i] & 0x7Fu), ib = 127 - (int)(LST[(tl * 2 + 1) * 16 + j] & 0x7Fu);
                const int e = ia * 128 + ib; const f32x2 sc = *(const f32x2*)(SCL + 2 * e);
                EID[ob] = e; GT[ob] = e0 * inv * sc.y; SUo[ob] = sc.x; }
            {   const int flat = 255 - (int)(k1 & 0xFFu), i = flat >> 4, j = flat & 15;
                const int ia = 127 - (int)(LST[(tl * 2 + 0) * 16 + i] & 0x7Fu), ib = 127 - (int)(LST[(tl * 2 + 1) * 16 + j] & 0x7Fu);
                const int e = ia * 128 + ib; const f32x2 sc = *(const f32x2*)(SCL + 2 * e);
                EID[ob + 1] = e; GT[ob + 1] = e1 * inv * sc.y; SUo[ob + 1] = sc.x; }
        }
    }
    __syncthreads();
}

#define FP4X4(w, f0, f1, f2, f3) do { f0 = __builtin_amdgcn_cvt_scalef32_pk_f32_fp4((w), 1.0f, 0); f1 = __builtin_amdgcn_cvt_scalef32_pk_f32_fp4((w), 1.0f, 1); \
    f2 = __builtin_amdgcn_cvt_scalef32_pk_f32_fp4((w), 1.0f, 2); f3 = __builtin_amdgcn_cvt_scalef32_pk_f32_fp4((w), 1.0f, 3); } while (0)
__device__ __forceinline__ void phase_gather(Frame& F, int l, bool dummy = false) {
    PH_LOCALS
    const int gw = F.vcu * NWAVES + wave, NGW = F.G * NWAVES;
    bf16* Hn = dummy ? (bf16*)(F.ws + WS_DBG + 128 * MiB) : (bf16*)(F.ws + WS_H);
    const unsigned char* UV = F.ws + WS_UV + (size_t)l * NEXP * 2048;
    const int* EID = (const int*)(F.ws + WS_EID); const float* GT = (const float*)(F.ws + WS_GATE); const float* SU = (const float*)(F.ws + WS_SU);
    const bf16* X = (const bf16*)(F.ws + WS_X); bf16* Xo = dummy ? (bf16*)(F.ws + WS_DBG) : (bf16*)(F.ws + WS_X);
    const float* mod = (const float*)(F.ws + WS_MOD);
    const float* gate2 = mod + l * 12288 + 5 * 2048; const float* shift2 = mod + l * 12288 + 3 * 2048; const float* gs2 = (const float*)(F.ws + WS_GS) + l * DM;
    const unsigned lane16 = (unsigned)lane * 16u;
    constexpr int NB = 16;
    for (int t = gw; t < M; t += NGW) {
        const int e_lo = EID[(size_t)t * 128 + lane], e_hi = EID[(size_t)t * 128 + 64 + lane];
        const float g_lo = GT[(size_t)t * 128 + lane], g_hi = GT[(size_t)t * 128 + 64 + lane];
        const float s_lo = SU[(size_t)t * 128 + lane], s_hi = SU[(size_t)t * 128 + 64 + lane];
        f32x2 hh[8][2];
        {   float s2 = 0.f;
#pragma unroll
            for (int j = 0; j < 8; ++j) { const u32x2 w = *(const u32x2*)(X + (size_t)t * 2048 + j * 256 + lane * 4);
                hh[j][0] = (f32x2){bflo(w.x), bfhi(w.x)}; hh[j][1] = (f32x2){bflo(w.y), bfhi(w.y)};
                s2 += (hh[j][0].x * hh[j][0].x + hh[j][0].y * hh[j][0].y) + (hh[j][1].x * hh[j][1].x + hh[j][1].y * hh[j][1].y); }
            const float r2 = 1.0f / sqrtf(wave_sum(s2) * (1.0f / DM) + EPS);
#pragma unroll
            for (int j = 0; j < 8; ++j) { const f32x4 gsv = *(const f32x4*)(gs2 + j * 256 + lane * 4), shv = *(const f32x4*)(shift2 + j * 256 + lane * 4);
                hh[j][0] = (f32x2){hh[j][0].x * r2 * gsv[0] + shv[0], hh[j][0].y * r2 * gsv[1] + shv[1]}; hh[j][1] = (f32x2){hh[j][1].x * r2 * gsv[2] + shv[2], hh[j][1].y * r2 * gsv[3] + shv[3]}; }
        }
        f32x2 of[8][2];
#pragma unroll
        for (int j = 0; j < 8; ++j) { of[j][0] = (f32x2){0.f, 0.f}; of[j][1] = (f32x2){0.f, 0.f}; }
        for (int b = 0; b < 128 / NB; ++b) {
            const bool first = (b * NB) < 64;
            const int esel = first ? e_lo : e_hi; const float gsel = first ? g_lo : g_hi, ssel = first ? s_lo : s_hi;
            u32x4 ur[NB], vr[NB];
#pragma unroll
            for (int h = 0; h < NB; ++h) {
                const int e = __builtin_amdgcn_readlane(esel, (NB * b + h) & 63);
                const unsigned char* rowp = UV + ((size_t)(unsigned)e << 11);
                ur[h] = *(const u32x4*)(rowp + lane16); vr[h] = *(const u32x4*)(rowp + 1024 + lane16);
            }
            float p[NB];
#pragma unroll
            for (int h = 0; h < NB; ++h) {
                f32x2 a2 = {0.f, 0.f};
#pragma unroll
                for (int d = 0; d < 4; ++d) { f32x2 f0, f1, f2, f3; FP4X4(ur[h][d], f0, f1, f2, f3);
                    a2 = f0 * hh[2 * d][0] + a2; a2 = f1 * hh[2 * d][1] + a2; a2 = f2 * hh[2 * d + 1][0] + a2; a2 = f3 * hh[2 * d + 1][1] + a2; }
                p[h] = a2.x + a2.y;
            }
            const bool u32_ = (lane & 32) != 0, u16_ = (lane & 16) != 0, u8_ = (lane & 8) != 0, u4_ = (lane & 4) != 0;
            float a8[8];
#pragma unroll
            for (int i = 0; i < 8; ++i) { const float snd = u32_ ? p[i] : p[8 + i], kp = u32_ ? p[8 + i] : p[i]; a8[i] = kp + __shfl_xor(snd, 32); }
            float a4[4];
#pragma unroll
            for (int i = 0; i < 4; ++i) { const float snd = u16_ ? a8[i] : a8[4 + i], kp = u16_ ? a8[4 + i] : a8[i]; a4[i] = kp + __shfl_xor(snd, 16); }
            float b2[2];
#pragma unroll
            for (int i = 0; i < 2; ++i) { const float snd = u8_ ? a4[i] : a4[2 + i], kp = u8_ ? a4[2 + i] : a4[i]; b2[i] = kp + __shfl_xor(snd, 8); }
            float d;
            { const float snd = u4_ ? b2[0] : b2[1], kp = u4_ ? b2[1] : b2[0]; d = kp + __shfl_xor(snd, 4); }
            d += __shfl_xor(d, 2); d += __shfl_xor(d, 1);
            const int hl = (NB * b + (lane >> 2)) & 63;
            const float gq = __shfl(gsel, hl), sq = __shfl(ssel, hl);
            const float coefq = gq * gelu_tanh(d * sq);
#pragma unroll
            for (int h = 0; h < NB; ++h) {
                const float cf = __builtin_bit_cast(float, __builtin_amdgcn_readlane(__builtin_bit_cast(int, coefq), 4 * h));
                const f32x2 cf2 = {cf, cf};
#pragma unroll
                for (int dd = 0; dd < 4; ++dd) { f32x2 f0, f1, f2, f3; FP4X4(vr[h][dd], f0, f1, f2, f3);
                    of[2 * dd][0] = f0 * cf2 + of[2 * dd][0]; of[2 * dd][1] = f1 * cf2 + of[2 * dd][1]; of[2 * dd + 1][0] = f2 * cf2 + of[2 * dd + 1][0]; of[2 * dd + 1][1] = f3 * cf2 + of[2 * dd + 1][1]; }
            }
        }
        int ln = lane; asm volatile("" : "+v"(ln));
        f32x4 xv[8]; float ss = 0.f;
#pragma unroll
        for (int j = 0; j < 8; ++j) {
            const int c = j * 256 + ln * 4;
            const u32x2 xw = *(const u32x2*)(X + (size_t)t * 2048 + c); const f32x4 xo = {bflo(xw.x), bfhi(xw.x), bflo(xw.y), bfhi(xw.y)}, g2 = *(const f32x4*)(gate2 + c);
            const f32x4 o = {of[j][0].x, of[j][0].y, of[j][1].x, of[j][1].y};
            xv[j] = xo + g2 * o;
            ss += (xv[j][0] * xv[j][0] + xv[j][1] * xv[j][1]) + (xv[j][2] * xv[j][2] + xv[j][3] * xv[j][3]);
        }
        const float rr = 1.0f / sqrtf(wave_sum(ss) * (1.0f / DM) + EPS);
        if (l + 1 < DEPTH) {
            const float* m2 = mod + (l + 1) * 12288; const float* gain = F.in[I_N1G] + (l + 1) * 2048;
#pragma unroll
            for (int j = 0; j < 8; ++j) {
                const int c = j * 256 + ln * 4;
                *(u32x2*)(Xo + (size_t)t * 2048 + c) = (u32x2){pk2(xv[j][0], xv[j][1]), pk2(xv[j][2], xv[j][3])};
                const f32x4 g = *(const f32x4*)(gain + c), sc = *(const f32x4*)(m2 + 2048 + c), sh = *(const f32x4*)(m2 + c);
                const f32x4 y = xv[j] * rr * g * (sc + 1.0f) + sh;
                *(u32x2*)(Hn + (size_t)t * 2048 + c) = (u32x2){pk2(y[0], y[1]), pk2(y[2], y[3])};
            }
        } else {
#pragma unroll
            for (int j = 0; j < 8; ++j) { const int c = j * 256 + ln * 4; const f32x4 fg = *(const f32x4*)(F.in[I_FG] + c);
                f32x4 ov = xv[j] * rr * fg;
#if SELFTEST_S5
                if (__hip_atomic_load((unsigned*)(F.ws + WS_CTL) + CW_FLAG, RLX_AGENT) != 0u) ov = (f32x4){1e30f, 1e30f, 1e30f, 1e30f};
#endif
                *(f32x4*)(F.out + (size_t)t * 2048 + c) = ov; }
        }
    }
}

__global__ void __launch_bounds__(NTHR, 2) fwd_kernel(Args args) {
    extern __shared__ __attribute__((aligned(16))) unsigned char lds_raw[];
    Frame F;
    F.lds = (LAS unsigned char*)lds_raw; F.ws = args.ws; F.in = args.in; F.out = args.out;
    F.tid = threadIdx.x; F.lane = F.tid & 63; F.wave = __builtin_amdgcn_readfirstlane(F.tid >> 6);
    F.G = gridDim.x; { const int bx = blockIdx.x; F.vcu = (F.G % 8 == 0) ? (bx % 8) * (F.G / 8) + bx / 8 : bx; }
    volatile LAS unsigned* MISC = (volatile LAS unsigned*)(F.lds + MISC_OFF);
    if (F.tid < 64) MISC[F.tid] = 0u;
    __syncthreads();
    unsigned* ctl = (unsigned*)(F.ws + WS_CTL);
    XcdBarrier bar; bar.bar = ctl + CW_BAR; bar.x = 0; bar.st = nullptr;
#if !MK_PER_PHASE
    bar = xcd_barrier_post(ctl + CW_BAR, MISC + 8);
#endif
    const int lo = args.ph_lo, hi = args.ph_hi;
#define IN(k) (lo <= (k) && (k) < hi)
#if MK_PER_PHASE
#define SEAM(k) do { } while (0)
#else
#define SEAM(k) do { if (IN(k) && IN((k) + 1)) xcd_barrier(bar); } while (0)
#endif
    const float* mod = (const float*)(F.ws + WS_MOD);

#define REP(k) (REPEAT_PH == (k))
#define RUN2(k, first, real) do { if (REP(k)) { first; xcd_barrier(bar); } real; } while (0)
    if (IN(0)) { RUN2(13, p0_tables(F, 5, true), p0_tables(F, 4, false)); } SEAM(0);
    for (int l = 0; l < DEPTH; ++l) {
        const int pb = 1 + 12 * l;
        const float* ml = mod + l * 12288;
        if (IN(pb + 0)) { if (l == 0) { RUN2(0, p0_prologue(F), p0_prologue(F)); RUN2(1, phase_norm<false>(F, F.in[I_X], F.in[I_N1G] + l * 2048, ml + 1 * 2048, ml + 0 * 2048), phase_norm<false>(F, F.in[I_X], F.in[I_N1G] + l * 2048, ml + 1 * 2048, ml + 0 * 2048)); } } SEAM(pb + 0);
        if (IN(pb + 1)) {
            pg8::Gemm g{(const bf16*)(F.ws + WS_H), (const bf16*)(F.ws + WS_WIN) + (size_t)l * INW * DM, M, INW, DM}; pg8::StaticOrder S; S.init(M, INW, F.G, (int)blockIdx.x);
            EpiIn E{(bf16*)(F.ws + WS_Z), (bf16*)(F.ws + WS_XS), F.in[I_BIN] + l * INW};
#define GEMM_IN pg8::gemm_phase<EpiIn, pg8::StaticOrder, true, true>(F.lds, g, S, E)
            RUN2(2, GEMM_IN, GEMM_IN);
        } SEAM(pb + 1);
        if (IN(pb + 2)) { RUN2(3, (phase_sloc(F, l), phase_lnstats(F)), (phase_sloc(F, l), phase_lnstats(F))); } SEAM(pb + 2);
        if (IN(pb + 3)) { RUN2(5, phase_s5out(F, l), phase_s5out(F, l)); RUN2(4, phase_gating(F, l), phase_gating(F, l));
#if SELFTEST_S5
            xcd_barrier(bar); selftest_s5(F, l);
#endif
        } SEAM(pb + 4);
        if (IN(pb + 5)) {
            pg8::Gemm g{(const bf16*)(F.ws + WS_G), (const bf16*)(F.ws + WS_GLU) + (size_t)l * WB * WB, M, WB, WB}; pg8::StaticOrder S; S.init(M, WB, F.G, (int)blockIdx.x);
            EpiGlu E{(const bf16*)(F.ws + WS_G), (bf16*)(F.ws + WS_MIX), F.in[I_GLUB] + l * WB};
#define GEMM_GLU pg8::gemm_phase<EpiGlu, pg8::StaticOrder, true, true>(F.lds, g, S, E)
            RUN2(6, GEMM_GLU, GEMM_GLU);
        } SEAM(pb + 5);
        if (IN(pb + 6)) { RUN2(7, phase_branchnorm(F), phase_branchnorm(F)); } SEAM(pb + 6);
        if (IN(pb + 7)) {
            pg8::Gemm g{(const bf16*)(F.ws + WS_MIX), (const bf16*)(F.ws + WS_WOUT) + (size_t)l * DM * DM, M, DM, DM}; pg8::StaticOrder S; S.init(M, DM, F.G, (int)blockIdx.x);
            if (l == 0) { EpiOut<false> E{(const void*)F.in[I_X], (bf16*)(F.ws + WS_X), ml + 2 * 2048, (float*)(F.ws + WS_PS)}; EpiOut<false> Ed{(const void*)F.in[I_X], (bf16*)(F.ws + WS_DBG), ml + 2 * 2048, (float*)(F.ws + WS_DBG + 128 * MiB)};
#define GEMM_OUT0(EE) pg8::gemm_phase<EpiOut<false>, pg8::StaticOrder, true, true>(F.lds, g, S, EE)
                RUN2(8, GEMM_OUT0(Ed), GEMM_OUT0(E)); }
            else { EpiOut<true> E{(const void*)(F.ws + WS_X), (bf16*)(F.ws + WS_X), ml + 2 * 2048, (float*)(F.ws + WS_PS)}; EpiOut<true> Ed{(const void*)(F.ws + WS_X), (bf16*)(F.ws + WS_DBG), ml + 2 * 2048, (float*)(F.ws + WS_DBG + 128 * MiB)};
#define GEMM_OUT1(EE) pg8::gemm_phase<EpiOut<true>, pg8::StaticOrder, true, true>(F.lds, g, S, EE)
                RUN2(8, GEMM_OUT1(Ed), GEMM_OUT1(E)); }
        }
        SEAM(pb + 8);
        if (IN(pb + 9)) {
            pg8::Gemm g{(const bf16*)(F.ws + WS_X), (const bf16*)(F.ws + WS_WQ) + (size_t)l * DM * DM, M, DM, DM}; pg8::StaticOrder S; S.init(M, DM, F.G, (int)blockIdx.x);
            LAS float* rrL = (LAS float*)(F.lds + 132096);
            pg8::Unit u0, u1; const bool h0 = S.next(0, u0), h1 = S.next(1, u1);
            { int t2 = F.tid; asm volatile("" : "+v"(t2)); if (h0) fill_rr(F, rrL, 0, u0.pm, t2); if (h1 && u1.pm != u0.pm) fill_rr(F, rrL, 1, u1.pm, t2); }
            __syncthreads();
            EpiQ E{(bf16*)(F.ws + WS_Z), (const float*)(F.ws + WS_C0) + l * DM, rrL, h0 ? u0.pm : -1};
#define GEMM_Q pg8::gemm_phase<EpiQ, pg8::StaticOrder, true, true>(F.lds, g, S, E)
            RUN2(10, GEMM_Q, GEMM_Q);
        } SEAM(pb + 9);
        if (IN(pb + 10)) { RUN2(11, phase_topk(F, l), phase_topk(F, l)); } SEAM(pb + 10);
        if (IN(pb + 11)) { RUN2(12, phase_gather(F, l, true), phase_gather(F, l, false)); } SEAM(pb + 11);
    }
#undef IN
#undef SEAM
}

extern "C" void kernel_launch(void* const* d_in, const int* in_sizes, int n_in, void* d_out, int out_size, void* d_ws, size_t ws_size, hipStream_t stream) {
    static int grid = 0;
    if (grid == 0) {
        if (n_in != 29 || out_size != M * DM || ws_size < WS_END) { fprintf(stderr, "kernel_launch: unexpected shapes (n_in %d, out %d, ws %zu); nothing launched\n", n_in, out_size, ws_size); grid = -1; return; }
        int dev = 0, cus = 0;
        if (hipGetDevice(&dev) != hipSuccess || hipDeviceGetAttribute(&cus, hipDeviceAttributeMultiprocessorCount, dev) != hipSuccess) { grid = -1; return; }
        if (hipFuncSetAttribute((const void*)fwd_kernel, hipFuncAttributeMaxDynamicSharedMemorySize, LDS_BYTES) != hipSuccess) { fprintf(stderr, "kernel_launch: hipFuncSetAttribute failed\n"); grid = -1; return; }
        (void)hipGetLastError();
        grid = cus;
    }
    if (grid < 0) return;
    (void)hipMemsetAsync((char*)d_ws + WS_CTL, 0, CTL_ZERO_BYTES, stream);
    Args a{};
    for (int i = 0; i < 29; ++i) a.in[i] = (const float*)d_in[i];
    a.out = (float*)d_out; a.ws = (unsigned char*)d_ws;
#if MK_PER_PHASE
    for (int p = 0; p < 1 + 12 * DEPTH; ++p) {
        if (p == 13) continue;
        a.ph_lo = p; a.ph_hi = p + 1; a.li = p;
        hipLaunchKernelGGL(fwd_kernel, dim3(grid), dim3(NTHR), LDS_BYTES, stream, a);
    }
#else
    a.ph_lo = 0; a.ph_hi = 1 + 12 * DEPTH; a.li = 0;
    hipLaunchKernelGGL(fwd_kernel, dim3(grid), dim3(NTHR), LDS_BYTES, stream, a);
#endif
}
```

```cpp
#include <hip/hip_runtime.h>
#include <cstdio>
#include <cstdint>

#ifndef SELFTEST_S5
#define SELFTEST_S5 0
#endif
#ifndef REPEAT_PH
#define REPEAT_PH -1
#endif
#ifndef GATHER_PROBE_HOT
#define GATHER_PROBE_HOT 0
#endif
#ifndef MK_PER_PHASE
#define MK_PER_PHASE 0
#endif

#define GAS __attribute__((address_space(1)))
#define LAS __attribute__((address_space(3)))
typedef unsigned short bf16;
typedef short bf16x8 __attribute__((ext_vector_type(8)));
typedef float f32x4 __attribute__((ext_vector_type(4)));
typedef float f32x2 __attribute__((ext_vector_type(2)));
typedef unsigned u32x4 __attribute__((ext_vector_type(4)));
typedef unsigned u32x2 __attribute__((ext_vector_type(2)));

constexpr int DM = 2048, SEQ = 16384, DEPTH = 2, M = SEQ;
constexpr int WA = 1024, WB = 1024, INW = 3072;
constexpr int NG = 64, NCH = 256;
constexpr int NEXP = 16384;
constexpr float EPS = 1e-6f;
constexpr int NWAVES = 8, NTHR = 512;

namespace pg8 {
#define PG8_LAS __attribute__((address_space(3)))
constexpr int BM = 256, BK = 64, HALF = 128, HTB = HALF * BK * 2, STAGE_BYTES = 8 * HTB, NXCD = 8, WGM = 8;
__host__ __device__ __forceinline__ int lds_byte(int r, int c) { const int st = (r >> 4) * 2 + (c >> 5), rr = r & 15, cc = c & 31, ob = rr * 64 + cc * 2; return st * 1024 + (ob ^ (((ob >> 9) & 1) << 5)); }
__host__ __device__ __forceinline__ void stage_rc(int b, int& R, int& C) { const int st = b / 1024, sb = b % 1024, swz = sb ^ (((sb >> 9) & 1) << 5); R = (st >> 1) * 16 + swz / 64; C = (st & 1) * 32 + (swz % 64) / 2; }
__host__ __device__ __forceinline__ int perm32(int rho) { const int n = rho >> 4, i = rho & 15; return 8 * (i >> 2) + 4 * n + (i & 3); }
struct Unit { int pm, pn; };
struct Gemm { const bf16* A; const bf16* Bt; int M, N, K; };
struct StaticOrder {
    int nM, nN, nwg, G, c;
    __host__ __device__ void init(int M_, int N_, int G_, int c_) { nM = M_ / BM; nN = N_ / BM; nwg = nM * nN; G = G_; c = c_; }
    __host__ __device__ bool next(int i, Unit& u) const {
        const long L = (long)i * G + c; if (L >= nwg) return false;
        int wgid = (int)L; { const int q = nwg / NXCD, r = nwg % NXCD, xcd = wgid % NXCD, off = wgid / NXCD; wgid = (xcd < r ? xcd * (q + 1) : r * (q + 1) + (xcd - r) * q) + off; }
        const int nig = WGM * nN, gid = wgid / nig, fm = gid * WGM, gsz = (nM - fm) < WGM ? (nM - fm) : WGM;
        u.pm = fm + ((wgid % nig) % gsz); u.pn = (wgid % nig) / gsz; return true;
    }
    __device__ __forceinline__ void a_ready(const Unit&) const {}
    __device__ __forceinline__ void done(const Unit&) const {}
};
__device__ __forceinline__ unsigned cvt_pk_bf16(float lo, float hi) { unsigned r; asm volatile("v_cvt_pk_bf16_f32 %0, %1, %2" : "=v"(r) : "v"(lo), "v"(hi)); return r; }

template <class Epi, class Sched, bool ALIGN_EPI = false, bool SP2 = false>
__device__ __forceinline__ void gemm_phase(PG8_LAS unsigned char* lds, const Gemm g, const Sched& S, const Epi& E) {
    int tid = threadIdx.x; asm volatile("" : "+v"(tid)); const int wid = __builtin_amdgcn_readfirstlane(tid >> 6), lane = tid & 63, wr = wid >> 2, wc = wid & 3, fr = lane & 15, fq = lane >> 4;
    const int K = g.K, nt = K / BK;
    unsigned voffA[2], voffB[2];
#pragma unroll
    for (int i = 0; i < 2; ++i) { int R, C; stage_rc(tid * 16 + i * 8192, R, C); const int Rb = Epi::PERM ? ((R & ~31) + perm32(R & 31)) : R;
        voffA[i] = (unsigned)(R * K + C) * 2u; voffB[i] = (unsigned)(Rb * K + C) * 2u; }
    const size_t kstep = (size_t)(BK * 2);
    const size_t hstep = (size_t)HALF * K * 2;
    const size_t tstep = 2 * hstep;
    const unsigned ldsw = (unsigned)wid * 1024u;
    const int aoff = lds_byte(wr * 64 + fr, fq * 8), boff = lds_byte(wc * 32 + fr, fq * 8);
#define PG8_SA(b, h) (((b) * 2 + (h)) * HTB)
#define PG8_SB(b, h) ((4 + (b) * 2 + (h)) * HTB)
#define PG8_STAGE(bufoff, gbase, voff) do { _Pragma("unroll") for (int _i = 0; _i < 2; ++_i) \
        __builtin_amdgcn_global_load_lds((const unsigned*)((const char*)(gbase) + (voff)[_i]), (PG8_LAS unsigned*)(lds + (bufoff) + ldsw + _i * 8192), 16, 0, 0); } while (0)
#define PG8_LDA(dst, b, h) do { _Pragma("unroll") for (int m = 0; m < 4; ++m) _Pragma("unroll") for (int k = 0; k < 2; ++k) dst[m][k] = *(const PG8_LAS bf16x8*)(lds + PG8_SA(b, h) + aoff + m * 2048 + k * 1024); } while (0)
#define PG8_LDB(dst, b, h) do { _Pragma("unroll") for (int n = 0; n < 2; ++n) _Pragma("unroll") for (int k = 0; k < 2; ++k) dst[n][k] = *(const PG8_LAS bf16x8*)(lds + PG8_SB(b, h) + boff + n * 2048 + k * 1024); } while (0)
#define PG8_MMA(ai, bj, At, Bt) do { __builtin_amdgcn_s_setprio(1); _Pragma("unroll") for (int m = 0; m < 4; ++m) _Pragma("unroll") for (int n = 0; n < 2; ++n) _Pragma("unroll") for (int k = 0; k < 2; ++k) \
        acc[ai][bj][m][n] = __builtin_amdgcn_mfma_f32_16x16x32_bf16(Bt[n][k], At[m][k], acc[ai][bj][m][n], 0, 0, 0); __builtin_amdgcn_s_setprio(0); } while (0)
#define PG8_WAIT_V(n) asm volatile("s_waitcnt vmcnt(" #n ")" ::: "memory")
#define PG8_WAIT_L(n) asm volatile("s_waitcnt lgkmcnt(" #n ")" ::: "memory")
#define PG8_BAR __builtin_amdgcn_s_barrier()
#define PG8_SCHED __builtin_amdgcn_sched_barrier(0)
    Unit cur, nxt; int ui = 0;
    if (!S.next(0, cur)) return;
    f32x4 acc[2][2][4][2];
#pragma unroll
    for (int a = 0; a < 2; ++a)
#pragma unroll
        for (int b = 0; b < 2; ++b)
#pragma unroll
            for (int m = 0; m < 4; ++m)
#pragma unroll
                for (int n = 0; n < 2; ++n) acc[a][b][m][n] = (f32x4){0.f, 0.f, 0.f, 0.f};
    bf16x8 At[4][2], B0[2][2], B1[2][2];
    const char* cA = (const char*)g.A + (size_t)cur.pm * tstep; const char* cB = (const char*)g.Bt + (size_t)cur.pn * tstep;
    S.a_ready(cur);
    if constexpr (SP2) {
        PG8_STAGE(PG8_SB(0, 0), cB, voffB); PG8_STAGE(PG8_SB(0, 1), cB + hstep, voffB); PG8_STAGE(PG8_SA(0, 0), cA, voffA); PG8_STAGE(PG8_SA(0, 1), cA + hstep, voffA);
        if (wr == 1) PG8_BAR;
        PG8_WAIT_V(2); PG8_BAR;
        PG8_STAGE(PG8_SB(1, 0), cB + kstep, voffB); PG8_STAGE(PG8_SA(1, 0), cA + kstep, voffA); PG8_STAGE(PG8_SB(1, 1), cB + hstep + kstep, voffB);
        PG8_WAIT_V(6); PG8_BAR;
    } else {
        PG8_STAGE(PG8_SB(0, 0), cB, voffB); PG8_STAGE(PG8_SA(0, 0), cA, voffA); PG8_STAGE(PG8_SB(0, 1), cB + hstep, voffB); PG8_STAGE(PG8_SA(0, 1), cA + hstep, voffA);
        if (wr == 1) PG8_BAR;
        PG8_WAIT_V(4); PG8_BAR;
        PG8_STAGE(PG8_SB(1, 0), cB + kstep, voffB); PG8_STAGE(PG8_SA(1, 0), cA + kstep, voffA); PG8_STAGE(PG8_SB(1, 1), cB + hstep + kstep, voffB);
        PG8_WAIT_V(6); PG8_BAR;
    }
    for (;;) {
        const bool has_next = S.next(ui + 1, nxt);
        const char* nA = has_next ? (const char*)g.A + (size_t)nxt.pm * tstep : cA; const char* nB = has_next ? (const char*)g.Bt + (size_t)nxt.pn * tstep : cB;
        for (int t = 0; t < nt; t += 2) {
            const bool last = (t == nt - 2);
            const char* a1 = cA + (size_t)(t + 1) * kstep;
            const char* a2 = last ? nA : cA + (size_t)(t + 2) * kstep; const char* b2 = last ? nB : cB + (size_t)(t + 2) * kstep;
            const char* a3 = a2 + kstep; const char* b3 = b2 + kstep;
            if (last && has_next) S.a_ready(nxt);
            if constexpr (SP2) {
            PG8_LDB(B0, 0, 0); PG8_LDB(B1, 0, 1); PG8_SCHED; PG8_LDA(At, 0, 0); PG8_STAGE(PG8_SA(1, 1), a1 + hstep, voffA);
            PG8_WAIT_V(8); PG8_WAIT_L(0); PG8_BAR; PG8_MMA(0, 0, At, B0); PG8_MMA(0, 1, At, B1); PG8_BAR; PG8_SCHED;
            PG8_LDA(At, 0, 1); PG8_STAGE(PG8_SB(0, 0), b2, voffB); PG8_STAGE(PG8_SB(0, 1), b2 + hstep, voffB); PG8_STAGE(PG8_SA(0, 0), a2, voffA);
            PG8_WAIT_V(8); PG8_WAIT_L(0); PG8_BAR; PG8_MMA(1, 0, At, B0); PG8_MMA(1, 1, At, B1); PG8_BAR; PG8_SCHED;
            PG8_LDB(B0, 1, 0); PG8_LDB(B1, 1, 1); PG8_SCHED; PG8_LDA(At, 1, 0); PG8_STAGE(PG8_SA(0, 1), a2 + hstep, voffA);
            PG8_WAIT_V(8); PG8_WAIT_L(0); PG8_BAR; PG8_MMA(0, 0, At, B0); PG8_MMA(0, 1, At, B1); PG8_BAR; PG8_SCHED;
            PG8_LDA(At, 1, 1); PG8_STAGE(PG8_SB(1, 0), b3, voffB); PG8_STAGE(PG8_SB(1, 1), b3 + hstep, voffB); PG8_STAGE(PG8_SA(1, 0), a3, voffA);
            PG8_WAIT_V(8); PG8_WAIT_L(0); PG8_BAR; PG8_MMA(1, 0, At, B0); PG8_MMA(1, 1, At, B1); PG8_BAR; PG8_SCHED;
            } else {
            PG8_LDB(B0, 0, 0); PG8_SCHED; PG8_LDA(At, 0, 0); PG8_STAGE(PG8_SA(1, 1), a1 + hstep, voffA);
            PG8_WAIT_L(8); PG8_BAR; PG8_WAIT_L(0); PG8_MMA(0, 0, At, B0); PG8_BAR; PG8_SCHED;
            PG8_LDB(B1, 0, 1); PG8_STAGE(PG8_SB(0, 0), b2, voffB);
            PG8_BAR; PG8_WAIT_L(0); PG8_MMA(0, 1, At, B1); PG8_BAR;
            PG8_LDA(At, 0, 1); PG8_STAGE(PG8_SA(0, 0), a2, voffA);
            PG8_BAR; PG8_WAIT_L(0); PG8_MMA(1, 0, At, B0); PG8_BAR; PG8_SCHED;
            PG8_STAGE(PG8_SB(0, 1), b2 + hstep, voffB);
            PG8_WAIT_V(6); PG8_BAR; PG8_MMA(1, 1, At, B1); PG8_BAR;
            PG8_LDB(B0, 1, 0); PG8_SCHED; PG8_LDA(At, 1, 0); PG8_STAGE(PG8_SA(0, 1), a2 + hstep, voffA);
            PG8_WAIT_L(8); PG8_BAR; PG8_WAIT_L(0); PG8_MMA(0, 0, At, B0); PG8_BAR; PG8_SCHED;
            PG8_LDB(B1, 1, 1); PG8_STAGE(PG8_SB(1, 0), b3, voffB);
            PG8_BAR; PG8_WAIT_L(0); PG8_MMA(0, 1, At, B1); PG8_BAR;
            PG8_LDA(At, 1, 1); PG8_STAGE(PG8_SA(1, 0), a3, voffA);
            PG8_BAR; PG8_WAIT_L(0); PG8_MMA(1, 0, At, B0); PG8_BAR; PG8_SCHED;
            PG8_STAGE(PG8_SB(1, 1), b3 + hstep, voffB);
            PG8_WAIT_V(6); PG8_BAR; PG8_MMA(1, 1, At, B1); PG8_BAR;
            }
        }
        if constexpr (ALIGN_EPI) { if (wr == 0) PG8_BAR; }
        E(acc, cur, wr, wc, fr, fq); S.done(cur);
        if (!has_next) break;
#pragma unroll
        for (int a = 0; a < 2; ++a)
#pragma unroll
            for (int b = 0; b < 2; ++b)
#pragma unroll
                for (int m = 0; m < 4; ++m)
#pragma unroll
                    for (int n = 0; n < 2; ++n) acc[a][b][m][n] = (f32x4){0.f, 0.f, 0.f, 0.f};
        cur = nxt; cA = nA; cB = nB; ++ui;
        if constexpr (ALIGN_EPI) { if (wr == 1) PG8_BAR; }
    }
    PG8_WAIT_V(0);
    if constexpr (!ALIGN_EPI) { if (wr == 0) PG8_BAR; }
    PG8_BAR;
#undef PG8_SA
#undef PG8_SB
#undef PG8_STAGE
#undef PG8_LDA
#undef PG8_LDB
#undef PG8_MMA
#undef PG8_WAIT_V
#undef PG8_WAIT_L
#undef PG8_BAR
#undef PG8_SCHED
}
}

__device__ __forceinline__ unsigned f2bf(float f) { unsigned u = __builtin_bit_cast(unsigned, f); return (u + 0x7fffu + ((u >> 16) & 1u)) >> 16; }
__device__ __forceinline__ unsigned pk2(float lo, float hi) { return f2bf(lo) | (f2bf(hi) << 16); }
__device__ __forceinline__ float bflo(unsigned w) { return __builtin_bit_cast(float, w << 16); }
__device__ __forceinline__ float bfhi(unsigned w) { return __builtin_bit_cast(float, w & 0xffff0000u); }
__device__ __forceinline__ float fast_sigmoid(float t) { return __builtin_amdgcn_rcpf(1.0f + __builtin_amdgcn_exp2f(-1.44269504089f * t)); }
__device__ __forceinline__ float gelu_tanh(float x) { const float t = x * (1.5957691216f + 0.0713548163f * x * x); return x * fast_sigmoid(t); }
__device__ __forceinline__ float wave_sum(float v) {
#pragma unroll
    for (int o = 1; o < 64; o <<= 1) v += __shfl_xor(v, o);
    return v;
}
#define LDS_WAIT() asm volatile("s_waitcnt lgkmcnt(0)" ::: "memory")
#define VM_WAIT() asm volatile("s_waitcnt vmcnt(0)" ::: "memory")
#define RLX_AGENT __ATOMIC_RELAXED, __HIP_MEMORY_SCOPE_AGENT

constexpr size_t MiB = 1u << 20;
constexpr size_t WS_CTL = 0, CTL_ZERO_BYTES = 1 * MiB;
constexpr size_t WS_MOD   = 512 * 1024;
constexpr size_t WS_AT    = 1 * MiB + 128 * 1024;
constexpr size_t WS_STATS = WS_AT + 128 * 1024;
constexpr size_t WS_SCL   = 1 * MiB + 512 * 1024;
constexpr size_t WS_GS    = 1 * MiB + 768 * 1024;
constexpr size_t WS_C0    = WS_GS + 16 * 1024;
constexpr size_t WS_KEYS  = 2 * MiB;
constexpr size_t WS_GWS   = 3 * MiB;
constexpr size_t WS_WIN   = 4 * MiB;
constexpr size_t WS_GLU   = 28 * MiB;
constexpr size_t WS_WOUT  = 32 * MiB;
constexpr size_t WS_WQ    = 48 * MiB;
constexpr size_t WS_KTAB  = 64 * MiB;
constexpr size_t WS_WG    = 72 * MiB;
constexpr size_t WS_VG    = 104 * MiB;
constexpr size_t WS_UV    = 136 * MiB;
constexpr size_t WS_X     = 392 * MiB;
constexpr size_t WS_H     = 520 * MiB;
constexpr size_t WS_Z     = 584 * MiB;
constexpr size_t WS_XS    = 648 * MiB;
constexpr size_t WS_SLOC  = 680 * MiB;
constexpr size_t WS_PS    = 688 * MiB;
constexpr size_t WS_HS    = 690 * MiB;
constexpr size_t WS_G     = 692 * MiB;
constexpr size_t WS_MIX   = 724 * MiB;
constexpr size_t WS_EID   = 788 * MiB;
constexpr size_t WS_GATE  = 796 * MiB;
constexpr size_t WS_SU    = 804 * MiB;
constexpr size_t WS_END   = 812 * MiB;
constexpr size_t WS_DBG   = 812 * MiB;
constexpr int CW_BAR = 4096;
constexpr int CW_FLAG = 2048;
constexpr int CW_QUEUE = 16384;

constexpr int LDS_BYTES = 163840;
constexpr int MISC_OFF = LDS_BYTES - 256;

#define XB_TMO      128
#define XB_XCNT(j)  (256  + 64 * (j))
#define XB_XSUB(j)  (1280 + 64 * (j))
#define XB_XGEN(j)  (2304 + 64 * (j))
#define XB_TOP      3328
#define XB_TOPGEN   3392
#define XCD_BAR_WORDS 3456
#define XB_SPIN_CAP (1u << 24)
__device__ __forceinline__ unsigned xb_ld(unsigned* p)              { return __hip_atomic_load(p, __ATOMIC_RELAXED, __HIP_MEMORY_SCOPE_AGENT); }
__device__ __forceinline__ unsigned xb_add(unsigned* p, unsigned v) { return __hip_atomic_fetch_add(p, v, __ATOMIC_RELAXED, __HIP_MEMORY_SCOPE_AGENT); }
__device__ __forceinline__ unsigned xb_xcc_id() { return (unsigned)__builtin_amdgcn_s_getreg((3 << 11) | 20) & 0xFu; }
#define XB_SPIN(cond, bar) do { unsigned _sp = 0; while (cond) { __builtin_amdgcn_s_sleep(1); \
    if ((++_sp & 255u) == 0u) { if (xb_ld(&(bar)[XB_TMO])) break; if (_sp > XB_SPIN_CAP) { atomicAdd(&(bar)[XB_TMO], 1u); break; } } } } while (0)
struct XcdBarrier { unsigned* bar; unsigned x; volatile LAS unsigned* st; };
__device__ __forceinline__ XcdBarrier xcd_barrier_post(unsigned* bar, volatile LAS unsigned* st) {
    XcdBarrier b; b.bar = bar; b.x = xb_xcc_id(); b.st = st;
    if (threadIdx.x == 0) (void)xb_add(&bar[XB_XCNT(b.x)], 1u);
    return b;
}
__device__ __forceinline__ void xcd_barrier_complete(unsigned* bar, unsigned x, unsigned& nloc, unsigned& nx) {
    const unsigned G = gridDim.x * gridDim.y * gridDim.z;
    unsigned sum, cnt, mine, sp = 0u;
    for (;;) {
        sum = 0u; cnt = 0u; mine = 0u;
#pragma unroll
        for (unsigned j = 0; j < 16; ++j) { const unsigned c = xb_ld(&bar[XB_XCNT(j)]); sum += c; cnt += (c > 0u) ? 1u : 0u; mine = (j == x) ? c : mine; }
        if (sum == G) break;
        __builtin_amdgcn_s_sleep(1);
        if ((++sp & 255u) == 0u) { if (xb_ld(&bar[XB_TMO])) break; if (sp > XB_SPIN_CAP) { atomicAdd(&bar[XB_TMO], 1u); break; } }
    }
    nloc = mine > 0u ? mine : 1u; nx = cnt > 0u ? cnt : 1u;
}
__device__ __forceinline__ void xcd_barrier(const XcdBarrier& b) {
    asm volatile("s_waitcnt vmcnt(0)" ::: "memory");
    __syncthreads();
    if (threadIdx.x == 0) {
        unsigned* bar = b.bar;
        __builtin_amdgcn_s_waitcnt(0);
        unsigned nloc = b.st[0], nx = b.st[1];
        if (nloc == 0u) { xcd_barrier_complete(bar, b.x, nloc, nx); b.st[0] = nloc; b.st[1] = nx; }
        const unsigned old = xb_add(&bar[XB_XSUB(b.x)], 1u);
        const unsigned gen = old / nloc;
        if (old + 1u == (gen + 1u) * nloc) {
            __builtin_amdgcn_fence(__ATOMIC_RELEASE, "agent");
            asm volatile("s_waitcnt vmcnt(0)" ::: "memory");
            const unsigned og = xb_add(&bar[XB_TOP], 1u);
            const unsigned tg = og / nx;
            if (og + 1u == (tg + 1u) * nx) xb_add(&bar[XB_TOPGEN], 1u);
            else XB_SPIN(xb_ld(&bar[XB_TOPGEN]) == tg, bar);
            __builtin_amdgcn_fence(__ATOMIC_ACQUIRE, "agent");
            xb_add(&bar[XB_XGEN(b.x)], 1u);
            asm volatile("s_waitcnt vmcnt(0)" ::: "memory");
        } else {
            XB_SPIN(xb_ld(&bar[XB_XGEN(b.x)]) == gen, bar);
            __builtin_amdgcn_fence(__ATOMIC_ACQUIRE, "agent");
            asm volatile("s_waitcnt vmcnt(0)" ::: "memory");
        }
    }
    __syncthreads();
}

struct Args { const float* in[29]; float* out; unsigned char* ws; int ph_lo, ph_hi, li, pad; };
enum { I_X = 0, I_C, I_WMOD, I_BMOD, I_N1G, I_WIN, I_BIN, I_LNG, I_LNB, I_GWS, I_GBS, I_LRE, I_LIM, I_LDT, I_BRE, I_BIM, I_CRE, I_CIM, I_SD, I_GLUW, I_GLUB,
       I_BRG, I_WOUT, I_N2G, I_WQ, I_KEYS, I_PU, I_PV, I_FG };

struct Frame {
    LAS unsigned char* lds;
    unsigned char* ws;
    const float* const* in;
    float* out;
    int tid, lane, wave, vcu, G;
};

#define PH_LOCALS int tid = F.tid; asm volatile("" : "+v"(tid)); const int lane = tid & 63; const int wave = __builtin_amdgcn_readfirstlane(tid >> 6); (void)lane; (void)wave;

struct EpiIn {
    static constexpr bool PERM = true, AFTER_DRAIN = false;
    bf16* Z; bf16* XS; const float* bias;
    __device__ __forceinline__ void operator()(const f32x4 (&acc)[2][2][4][2], const pg8::Unit& u, int wr, int wc, int fr, int fq) const {
        const int row0 = u.pm * 256 + wr * 64 + fr, col0 = u.pn * 256 + wc * 32 + 8 * fq;
        f32x4 bv[2][2];
#pragma unroll
        for (int bj = 0; bj < 2; ++bj)
#pragma unroll
            for (int n = 0; n < 2; ++n) bv[bj][n] = *(const f32x4*)(bias + col0 + bj * 128 + 4 * n);
        const bool isz = (u.pn < 8);
#pragma unroll
        for (int ai = 0; ai < 2; ++ai)
#pragma unroll
            for (int m = 0; m < 4; ++m) {
                const int r = row0 + ai * 128 + m * 16;
#pragma unroll
                for (int bj = 0; bj < 2; ++bj) {
                    f32x4 v0 = acc[ai][bj][m][0] + bv[bj][0], v1 = acc[ai][bj][m][1] + bv[bj][1];
                    const int c = col0 + bj * 128;
                    u32x4 w;
                    if (isz) {
                        w.x = pg8::cvt_pk_bf16(gelu_tanh(v0[0]), gelu_tanh(v0[1])); w.y = pg8::cvt_pk_bf16(gelu_tanh(v0[2]), gelu_tanh(v0[3]));
                        w.z = pg8::cvt_pk_bf16(gelu_tanh(v1[0]), gelu_tanh(v1[1])); w.w = pg8::cvt_pk_bf16(gelu_tanh(v1[2]), gelu_tanh(v1[3]));
                        *(u32x4*)(Z + (size_t)r * 2048 + c) = w;
                    } else {
                        w.x = pg8::cvt_pk_bf16(v0[0], v0[1]); w.y = pg8::cvt_pk_bf16(v0[2], v0[3]); w.z = pg8::cvt_pk_bf16(v1[0], v1[1]); w.w = pg8::cvt_pk_bf16(v1[2], v1[3]);
                        const int cc = c - 2048, g = cc >> 4, i = cc & 15;
                        *(u32x4*)(XS + ((size_t)(g * 256 + (r >> 6)) * 64 + (r & 63)) * 16 + i) = w;
                    }
                }
            }
    }
};
struct EpiGlu {
    static constexpr bool PERM = true, AFTER_DRAIN = false;
    const bf16* Gb; bf16* MIX; const float* bias;
    __device__ __forceinline__ void operator()(const f32x4 (&acc)[2][2][4][2], const pg8::Unit& u, int wr, int wc, int fr, int fq) const {
        const int row0 = u.pm * 256 + wr * 64 + fr, col0 = u.pn * 256 + wc * 32 + 8 * fq;
        f32x4 bv[2][2];
#pragma unroll
        for (int bj = 0; bj < 2; ++bj)
#pragma unroll
            for (int n = 0; n < 2; ++n) bv[bj][n] = *(const f32x4*)(bias + col0 + bj * 128 + 4 * n);
#pragma unroll
        for (int ai = 0; ai < 2; ++ai)
#pragma unroll
            for (int m = 0; m < 4; ++m) {
                const int r = row0 + ai * 128 + m * 16;
#pragma unroll
                for (int bj = 0; bj < 2; ++bj) {
                    const f32x4 v0 = acc[ai][bj][m][0] + bv[bj][0], v1 = acc[ai][bj][m][1] + bv[bj][1];
                    const int c = col0 + bj * 128;
                    const u32x4 gw = *(const u32x4*)(Gb + (size_t)r * 1024 + c);
                    u32x4 w;
                    w.x = pg8::cvt_pk_bf16(bflo(gw.x) * fast_sigmoid(v0[0]), bfhi(gw.x) * fast_sigmoid(v0[1]));
                    w.y = pg8::cvt_pk_bf16(bflo(gw.y) * fast_sigmoid(v0[2]), bfhi(gw.y) * fast_sigmoid(v0[3]));
                    w.z = pg8::cvt_pk_bf16(bflo(gw.z) * fast_sigmoid(v1[0]), bfhi(gw.z) * fast_sigmoid(v1[1]));
                    w.w = pg8::cvt_pk_bf16(bflo(gw.w) * fast_sigmoid(v1[2]), bfhi(gw.w) * fast_sigmoid(v1[3]));
                    *(u32x4*)(MIX + (size_t)r * 2048 + 1024 + c) = w;
                }
            }
    }
};
template <bool XIN_BF16> struct EpiOut {
    static constexpr bool PERM = true, AFTER_DRAIN = false;
    const void* xin; bf16* X; const float* gate; float* PS;
    __device__ __forceinline__ void operator()(const f32x4 (&acc)[2][2][4][2], const pg8::Unit& u, int wr, int wc, int fr, int fq) const {
        const int row0 = u.pm * 256 + wr * 64 + fr, col0 = u.pn * 256 + wc * 32 + 8 * fq;
        f32x4 gv[2][2];
#pragma unroll
        for (int bj = 0; bj < 2; ++bj)
#pragma unroll
            for (int n = 0; n < 2; ++n) gv[bj][n] = *(const f32x4*)(gate + col0 + bj * 128 + 4 * n);
#pragma unroll
        for (int ai = 0; ai < 2; ++ai)
#pragma unroll
            for (int m = 0; m < 4; ++m) {
                const int r = row0 + ai * 128 + m * 16; float ssq = 0.f;
#pragma unroll
                for (int bj = 0; bj < 2; ++bj) {
                    const size_t off = (size_t)r * 2048 + col0 + bj * 128;
                    f32x4 x0, x1;
                    if (XIN_BF16) { const u32x4 w = *(const u32x4*)((const bf16*)xin + off); x0 = (f32x4){bflo(w.x), bfhi(w.x), bflo(w.y), bfhi(w.y)}; x1 = (f32x4){bflo(w.z), bfhi(w.z), bflo(w.w), bfhi(w.w)}; }
                    else { x0 = *(const f32x4*)((const float*)xin + off); x1 = *(const f32x4*)((const float*)xin + off + 4); }
                    const f32x4 y0 = x0 + gv[bj][0] * acc[ai][bj][m][0], y1 = x1 + gv[bj][1] * acc[ai][bj][m][1];
                    u32x4 o; o.x = pg8::cvt_pk_bf16(y0[0], y0[1]); o.y = pg8::cvt_pk_bf16(y0[2], y0[3]); o.z = pg8::cvt_pk_bf16(y1[0], y1[1]); o.w = pg8::cvt_pk_bf16(y1[2], y1[3]);
                    *(u32x4*)(X + off) = o;
                    ssq += (y0[0] * y0[0] + y0[1] * y0[1]) + (y0[2] * y0[2] + y0[3] * y0[3]) + (y1[0] * y1[0] + y1[1] * y1[1]) + (y1[2] * y1[2] + y1[3] * y1[3]);
                }
                ssq += __shfl_xor(ssq, 16); ssq += __shfl_xor(ssq, 32);
                if (fq == 0) PS[(size_t)r * 32 + u.pn * 4 + wc] = ssq;
            }
    }
};
struct EpiQ {
    static constexpr bool PERM = true, AFTER_DRAIN = false;
    bf16* Q; const float* c0; const LAS float* rrL; int pm0;
    __device__ __forceinline__ void operator()(const f32x4 (&acc)[2][2][4][2], const pg8::Unit& u, int wr, int wc, int fr, int fq) const {
        const int row0 = u.pm * 256 + wr * 64 + fr, col0 = u.pn * 256 + wc * 32 + 8 * fq;
        const LAS float* rrp = rrL + (u.pm == pm0 ? 0 : 256) + wr * 64 + fr;
        f32x4 cv[2][2];
#pragma unroll
        for (int bj = 0; bj < 2; ++bj)
#pragma unroll
            for (int n = 0; n < 2; ++n) cv[bj][n] = *(const f32x4*)(c0 + col0 + bj * 128 + 4 * n);
#pragma unroll
        for (int ai = 0; ai < 2; ++ai)
#pragma unroll
            for (int m = 0; m < 4; ++m) {
                const int r = row0 + ai * 128 + m * 16; const float rr = rrp[ai * 128 + m * 16];
#pragma unroll
                for (int bj = 0; bj < 2; ++bj) {
                    const f32x4 v0 = acc[ai][bj][m][0] * rr + cv[bj][0], v1 = acc[ai][bj][m][1] * rr + cv[bj][1];
                    u32x4 w; w.x = pg8::cvt_pk_bf16(v0[0], v0[1]); w.y = pg8::cvt_pk_bf16(v0[2], v0[3]); w.z = pg8::cvt_pk_bf16(v1[0], v1[1]); w.w = pg8::cvt_pk_bf16(v1[2], v1[3]);
                    *(u32x4*)(Q + (size_t)r * 2048 + col0 + bj * 128) = w;
                }
            }
    }
};
__device__ __forceinline__ void fill_rr(Frame& F, LAS float* rrL, int slot, int pm, int tid) {
    if (tid < 256) { const float* ps = (const float*)(F.ws + WS_PS) + ((size_t)pm * 256 + tid) * 32; float s = 0.f;
#pragma unroll
        for (int i = 0; i < 8; ++i) { const f32x4 v = *(const f32x4*)(ps + 4 * i); s += (v[0] + v[1]) + (v[2] + v[3]); }
        rrL[slot * 256 + tid] = 1.0f / sqrtf(s * (1.0f / DM) + EPS); }
}

__device__ __forceinline__ void p0_transpose_item(const float* W, int K, int N, bf16* WT, const float* kscale, LAS float* scr, int item, int lane, const float* kscale2 = nullptr) {
    const int nblk = N / 32, kb = item / nblk, nb = item % nblk, k0 = 64 * kb, n0 = 32 * nb;
    float wv[32];
#pragma unroll
    for (int i = 0; i < 32; ++i) wv[i] = W[(size_t)(k0 + 2 * i + (lane >> 5)) * N + n0 + (lane & 31)];
#pragma unroll
    for (int i = 0; i < 32; ++i) { const int kk = 2 * i + (lane >> 5); float v = wv[i]; if (kscale) { v *= kscale[k0 + kk]; if (kscale2) v *= 1.0f + kscale2[k0 + kk]; } scr[kk * 33 + (lane & 31)] = v; }
    LDS_WAIT(); asm volatile("" ::: "memory");
    const int c = lane & 7;
#pragma unroll
    for (int j = 0; j < 4; ++j) { const int n = (lane >> 3) + 8 * j; const LAS float* s = scr + (8 * c) * 33 + n;
        u32x4 o; o.x = pk2(s[0 * 33], s[1 * 33]); o.y = pk2(s[2 * 33], s[3 * 33]); o.z = pk2(s[4 * 33], s[5 * 33]); o.w = pk2(s[6 * 33], s[7 * 33]);
        *(u32x4*)(WT + (size_t)(n0 + n) * K + k0 + 8 * c) = o; }
    LDS_WAIT(); asm volatile("" ::: "memory");
}

__device__ __forceinline__ void norm_mod_row(const f32x4 (&v)[4][2], const float* gain, const float* scale, const float* shift, int lane, u32x4 (&o)[4]) {
    float s = 0.f;
#pragma unroll
    for (int j = 0; j < 4; ++j)
#pragma unroll
        for (int h = 0; h < 2; ++h) s += (v[j][h][0] * v[j][h][0] + v[j][h][1] * v[j][h][1]) + (v[j][h][2] * v[j][h][2] + v[j][h][3] * v[j][h][3]);
    const float rr = 1.0f / sqrtf(wave_sum(s) * (1.0f / DM) + EPS);
#pragma unroll
    for (int j = 0; j < 4; ++j) {
        const int c = j * 512 + lane * 8;
        f32x4 y[2];
#pragma unroll
        for (int h = 0; h < 2; ++h) {
            const f32x4 g = *(const f32x4*)(gain + c + 4 * h);
            y[h] = v[j][h] * rr * g;
            const f32x4 sc = *(const f32x4*)(scale + c + 4 * h), sh = *(const f32x4*)(shift + c + 4 * h); y[h] = y[h] * (sc + 1.0f) + sh;
        }
        o[j].x = pk2(y[0][0], y[0][1]); o[j].y = pk2(y[0][2], y[0][3]); o[j].z = pk2(y[1][0], y[1][1]); o[j].w = pk2(y[1][2], y[1][3]);
    }
}
template <bool SRC_BF16>
__device__ __forceinline__ void load_row(const void* xrow_, int lane, f32x4 (&v)[4][2]) {
#pragma unroll
    for (int j = 0; j < 4; ++j) {
        if (SRC_BF16) { const u32x4 w = *(const u32x4*)((const bf16*)xrow_ + j * 512 + lane * 8); v[j][0] = (f32x4){bflo(w.x), bfhi(w.x), bflo(w.y), bfhi(w.y)}; v[j][1] = (f32x4){bflo(w.z), bfhi(w.z), bflo(w.w), bfhi(w.w)}; }
        else { const float* xrow = (const float*)xrow_; v[j][0] = *(const f32x4*)(xrow + j * 512 + lane * 8); v[j][1] = *(const f32x4*)(xrow + j * 512 + lane * 8 + 4); } }
}

__device__ __forceinline__ void p0_gemv_unit(Frame& F, int unit, int tid, float* modout) {
    const int l = unit / 192, r = unit % 192, cb = r >> 1, kh = r & 1;
    LAS float* sc = (LAS float*)F.lds;
    LAS float* red = (LAS float*)(F.lds + 4096);
    for (int k = tid; k < 1024; k += NTHR) { const float c = F.in[I_C][kh * 1024 + k]; sc[k] = c * fast_sigmoid(c); }
    __syncthreads();
    const int tx = tid & 31, ty = tid >> 5;
    const float* W = F.in[I_WMOD] + ((size_t)l * DM + kh * 1024) * 12288 + cb * 128 + tx * 4;
    f32x4 a = {0.f, 0.f, 0.f, 0.f};
#pragma unroll 16
    for (int k = ty; k < 1024; k += 16) { const f32x4 w = *(const f32x4*)(W + (size_t)k * 12288); a += w * sc[k]; }
    *(LAS f32x4*)(red + ty * 128 + tx * 4) = a;
    __syncthreads();
    if (tid < 128) { float s = 0.f;
#pragma unroll
        for (int y = 0; y < 16; ++y) s += red[y * 128 + tid];
        if (kh == 0) s += F.in[I_BMOD][l * 12288 + cb * 128 + tid];
        atomicAdd(modout + l * 12288 + cb * 128 + tid, s); }
    __syncthreads();
}
__device__ __forceinline__ void p0_s5_unit(Frame& F, int unit, int tid, int parts = 15) {
    const int l = unit >> 7, g = (unit >> 1) & 63, hf = unit & 1;
    LAS float* apr = (LAS float*)F.lds;
    LAS float* api = apr + 4228;
    LAS float* bbr = api + 4228;
    LAS float* bbi = bbr + 1024;
    LAS float* ccr = bbi + 1024;
    LAS float* cci = ccr + 16 * 65;
    const float dt = expf(F.in[I_LDT][l * 64 + g]);
    const float* lre = F.in[I_LRE] + (l * 64 + g) * 64; const float* lim = F.in[I_LIM] + (l * 64 + g) * 64;
    for (int idx = tid; idx < 65 * 64; idx += NTHR) { const int d = idx >> 6, p = idx & 63;
        const float mag = expf(lre[p] * dt * (float)d); float sn, cs; sincosf(lim[p] * dt * (float)d, &sn, &cs);
        apr[d * 65 + p] = mag * cs; api[d * 65 + p] = mag * sn; }
    for (int idx = tid; idx < 1024; idx += NTHR) { const int o = idx >> 6, p = idx & 63;
        ccr[o * 65 + p] = F.in[I_CRE][((size_t)(l * 64 + g) * 16 + o) * 64 + p]; cci[o * 65 + p] = F.in[I_CIM][((size_t)(l * 64 + g) * 16 + o) * 64 + p]; }
    __syncthreads();
    for (int idx = tid; idx < 1024; idx += NTHR) { const int p = idx >> 4, i = idx & 15;
        const float xr = apr[65 + p] - 1.0f, xi = api[65 + p], lr = lre[p], li = lim[p], den = 1.0f / (lr * lr + li * li);
        const float cr = (xr * lr + xi * li) * den, ci = (xi * lr - xr * li) * den;
        const float br = F.in[I_BRE][((size_t)(l * 64 + g) * 64 + p) * 16 + i], bi = F.in[I_BIM][((size_t)(l * 64 + g) * 64 + p) * 16 + i];
        bbr[idx] = cr * br - ci * bi; bbi[idx] = cr * bi + ci * br; }
    __syncthreads();
    bf16* KT = (bf16*)(F.ws + WS_KTAB) + (size_t)(l * 64 + g) * 80 * 256;
    if (parts & 1) {
        const int d = hf * 32 + (tid >> 4), o = tid & 15;
        const float dskip = F.in[I_SD][l * 1024 + g * 16 + o];
        float s[16];
#pragma unroll
        for (int i = 0; i < 16; ++i) s[i] = 0.f;
        for (int p = 0; p < 64; ++p) { const float ar = apr[d * 65 + p], ai = api[d * 65 + p], cr = ccr[o * 65 + p], ci = cci[o * 65 + p];
            const float er = cr * ar - ci * ai, ei = cr * ai + ci * ar;
#pragma unroll
            for (int q = 0; q < 4; ++q) { const f32x4 br = *(const LAS f32x4*)(bbr + p * 16 + 4 * q), bi = *(const LAS f32x4*)(bbi + p * 16 + 4 * q);
#pragma unroll
                for (int e = 0; e < 4; ++e) s[4 * q + e] += er * br[e] - ei * bi[e]; } }
#if !SELFTEST_S5
        {   const float dsk = (d == 0) ? dskip : 0.f;
#pragma unroll
            for (int i = 0; i < 16; ++i) s[i] += (i == o) ? dsk : 0.f; }
#endif
        u32x4 w0, w1;
        w0.x = pk2(s[0], s[1]); w0.y = pk2(s[2], s[3]); w0.z = pk2(s[4], s[5]); w0.w = pk2(s[6], s[7]);
        w1.x = pk2(s[8], s[9]); w1.y = pk2(s[10], s[11]); w1.z = pk2(s[12], s[13]); w1.w = pk2(s[14], s[15]);
        if ((parts & 8) || w0.x == 0x12345678u) { *(u32x4*)(KT + (size_t)(d + 16) * 256 + o * 16) = w0; *(u32x4*)(KT + (size_t)(d + 16) * 256 + o * 16 + 8) = w1; }
        if ((parts & 8) && hf == 0 && tid < 256) { const u32x4 z = {0u, 0u, 0u, 0u}; *(u32x4*)(KT + tid * 16) = z; *(u32x4*)(KT + tid * 16 + 8) = z; }
    }
    bf16* WG = (bf16*)(F.ws + WS_WG) + (size_t)(l * 64 + g) * 128 * 1024;
    if (parts & 2) for (int it = tid; it < 32 * 64; it += NTHR) { const int p = hf * 32 + (it >> 6), tau = it & 63;
        const float ar = apr[(63 - tau) * 65 + p], ai = api[(63 - tau) * 65 + p];
        unsigned wr_[8], wi_[8];
#pragma unroll
        for (int q = 0; q < 4; ++q) { const f32x4 br = *(const LAS f32x4*)(bbr + p * 16 + 4 * q), bi = *(const LAS f32x4*)(bbi + p * 16 + 4 * q);
            wr_[2 * q] = pk2(ar * br[0] - ai * bi[0], ar * br[1] - ai * bi[1]); wr_[2 * q + 1] = pk2(ar * br[2] - ai * bi[2], ar * br[3] - ai * bi[3]);
            wi_[2 * q] = pk2(ar * bi[0] + ai * br[0], ar * bi[1] + ai * br[1]); wi_[2 * q + 1] = pk2(ar * bi[2] + ai * br[2], ar * bi[3] + ai * br[3]); }
        *(u32x4*)(WG + (size_t)p * 1024 + tau * 16) = (u32x4){wr_[0], wr_[1], wr_[2], wr_[3]}; *(u32x4*)(WG + (size_t)p * 1024 + tau * 16 + 8) = (u32x4){wr_[4], wr_[5], wr_[6], wr_[7]};
        *(u32x4*)(WG + (size_t)(64 + p) * 1024 + tau * 16) = (u32x4){wi_[0], wi_[1], wi_[2], wi_[3]}; *(u32x4*)(WG + (size_t)(64 + p) * 1024 + tau * 16 + 8) = (u32x4){wi_[4], wi_[5], wi_[6], wi_[7]}; }
    bf16* VG = (bf16*)(F.ws + WS_VG) + (size_t)(l * 64 + g) * 1024 * 128;
    if (parts & 4) for (int it = tid; it < 512 * 8; it += NTHR) { const int m = hf * 512 + (it >> 3), p0 = (it & 7) * 8, t = m >> 4, o = m & 15;
        float vr_[8], vi_[8];
#pragma unroll
        for (int e = 0; e < 8; ++e) { const float ar = apr[(t + 1) * 65 + p0 + e], ai = api[(t + 1) * 65 + p0 + e], cr = ccr[o * 65 + p0 + e], ci = cci[o * 65 + p0 + e];
            vr_[e] = cr * ar - ci * ai; vi_[e] = -(cr * ai + ci * ar); }
        *(u32x4*)(VG + (size_t)m * 128 + p0) = (u32x4){pk2(vr_[0], vr_[1]), pk2(vr_[2], vr_[3]), pk2(vr_[4], vr_[5]), pk2(vr_[6], vr_[7])};
        *(u32x4*)(VG + (size_t)m * 128 + 64 + p0) = (u32x4){pk2(vi_[0], vi_[1]), pk2(vi_[2], vi_[3]), pk2(vi_[4], vi_[5]), pk2(vi_[6], vi_[7])}; }
    if (hf == 0 && tid < 64) { float* AT = (float*)(F.ws + WS_AT) + ((size_t)(l * 64 + g) * 64 + tid) * 2; AT[0] = apr[64 * 65 + tid]; AT[1] = api[64 * 65 + tid]; }
    __syncthreads();
}
__device__ __forceinline__ void p0_fp4_chunk(Frame& F, int chunk, int wave, int lane) {
    unsigned char* UV = F.ws + WS_UV; float* SCL = (float*)(F.ws + WS_SCL);
    for (int i = 0; i < 8; i += 2) {
        f32x4 v[2][8]; float am[2] = {0.f, 0.f}; int tbl[2], rr[2];
#pragma unroll
        for (int r2 = 0; r2 < 2; ++r2) {
            const int r = chunk * 64 + wave * 8 + i + r2; tbl[r2] = r >> 15; rr[r2] = r & 32767;
            const float* srcp = (tbl[r2] ? F.in[I_PV] : F.in[I_PU]) + (size_t)rr[r2] * 2048 + lane * 4;
#pragma unroll
            for (int j = 0; j < 8; ++j) v[r2][j] = *(const f32x4*)(srcp + j * 256);
        }
#pragma unroll
        for (int r2 = 0; r2 < 2; ++r2)
#pragma unroll
            for (int j = 0; j < 8; ++j) am[r2] = fmaxf(am[r2], fmaxf(fmaxf(fabsf(v[r2][j][0]), fabsf(v[r2][j][1])), fmaxf(fabsf(v[r2][j][2]), fabsf(v[r2][j][3]))));
#pragma unroll
        for (int o = 1; o < 64; o <<= 1) { am[0] = fmaxf(am[0], __shfl_xor(am[0], o)); am[1] = fmaxf(am[1], __shfl_xor(am[1], o)); }
#pragma unroll
        for (int r2 = 0; r2 < 2; ++r2) {
            const float scale = am[r2] > 0.f ? am[r2] * (1.0f / 6.0f) : 1.0f, inv = am[r2] > 0.f ? 6.0f / am[r2] : 1.0f;
            u32x4 o;
#pragma unroll
            for (int d = 0; d < 4; ++d) { unsigned w = 0u;
                w = __builtin_amdgcn_cvt_scalef32_pk_fp4_f32(w, v[r2][2 * d][0] * inv, v[r2][2 * d][1] * inv, 1.0f, 0);
                w = __builtin_amdgcn_cvt_scalef32_pk_fp4_f32(w, v[r2][2 * d][2] * inv, v[r2][2 * d][3] * inv, 1.0f, 1);
                w = __builtin_amdgcn_cvt_scalef32_pk_fp4_f32(w, v[r2][2 * d + 1][0] * inv, v[r2][2 * d + 1][1] * inv, 1.0f, 2);
                w = __builtin_amdgcn_cvt_scalef32_pk_fp4_f32(w, v[r2][2 * d + 1][2] * inv, v[r2][2 * d + 1][3] * inv, 1.0f, 3);
                o[d] = w; }
            *(u32x4*)(UV + (size_t)rr[r2] * 2048 + tbl[r2] * 1024 + lane * 16) = o;
            if (lane == 0) SCL[rr[r2] * 2 + tbl[r2]] = scale;
        }
    }
}
#ifndef P0_PARTS
#define P0_PARTS 15
#endif
#ifndef P0_PROBE_MODE
#define P0_PROBE_MODE 0
#endif
__device__ __forceinline__ void p0_tables(Frame& F, int qi = 4, bool dummy = false) {
    PH_LOCALS
    unsigned* head = (unsigned*)(F.ws + WS_CTL) + CW_QUEUE + 64 * qi;
    float* modout = dummy ? (float*)(F.ws + WS_DBG) : (float*)(F.ws + WS_MOD);
    LAS unsigned* slot = (LAS unsigned*)(F.lds + MISC_OFF) + 16;
    for (;;) {
        __syncthreads();
        if (tid == 0) slot[0] = __hip_atomic_fetch_add(head, 1u, RLX_AGENT);
        __syncthreads();
        const unsigned u = slot[0];
        if (u >= 1664u) break;
        const int rnd = (int)u / 13, k = (int)u % 13;
        if (k < 2) { if (dummy && P0_PROBE_MODE == 2) continue; p0_s5_unit(F, rnd * 2 + k, tid, dummy ? P0_PARTS : 15); }
        else if (k < 5) { if (dummy && P0_PROBE_MODE == 1) continue; p0_gemv_unit(F, rnd * 3 + (k - 2), tid, modout); }
        else { p0_fp4_chunk(F, rnd * 8 + (k - 5), wave, lane); }
    }
}
__device__ __forceinline__ void p0_prologue(Frame& F) {
    PH_LOCALS
    const int gw = F.vcu * NWAVES + wave, NGW = F.G * NWAVES;
    const int gt = F.vcu * NTHR + tid, NGT = F.G * NTHR;
    const float* modp = (const float*)(F.ws + WS_MOD);
    for (int i = gt; i < 2 * DM; i += NGT) { const int l = i >> 11, k = i & 2047; ((float*)(F.ws + WS_GS))[i] = F.in[I_N2G][i] * (1.0f + modp[l * 12288 + 4 * 2048 + k]); }
    if (F.vcu < 64) {
        const int l = F.vcu >> 5, cb = F.vcu & 31, tx = tid & 15, ty = tid >> 4;
        const float* W = F.in[I_WQ] + (size_t)l * DM * DM + cb * 64 + tx * 4; const float* sh = modp + l * 12288 + 3 * 2048;
        f32x4 a = {0.f, 0.f, 0.f, 0.f};
#pragma unroll 16
        for (int k = ty; k < DM; k += 32) { const f32x4 w = *(const f32x4*)(W + (size_t)k * DM); a += w * sh[k]; }
        LAS float* red = (LAS float*)F.lds;
        *(LAS f32x4*)(red + ty * 64 + tx * 4) = a;
        __syncthreads();
        if (tid < 64) { float s = 0.f;
#pragma unroll
            for (int y = 0; y < 32; ++y) s += red[y * 64 + tid];
            ((float*)(F.ws + WS_C0))[l * DM + cb * 64 + tid] = s; }
        __syncthreads();
    }
    {
        LAS float* scr = (LAS float*)(F.lds + wave * 16384);
        constexpr int I_IN = (DM / 64) * (INW / 32), I_GL = (WB / 64) * (WB / 32), I_OU = (DM / 64) * (DM / 32), I_Q = I_OU;
        constexpr int PER_L = I_IN + I_GL + I_OU + I_Q;
        for (int it = gw; it < 2 * PER_L; it += NGW) {
            const int l = it / PER_L; int r = it % PER_L;
            if (r < I_IN) { p0_transpose_item(F.in[I_WIN] + (size_t)l * DM * INW, DM, INW, (bf16*)(F.ws + WS_WIN) + (size_t)l * INW * DM, nullptr, scr, r, lane); continue; } r -= I_IN;
            if (r < I_GL) { p0_transpose_item(F.in[I_GLUW] + (size_t)l * WB * WB, WB, WB, (bf16*)(F.ws + WS_GLU) + (size_t)l * WB * WB, nullptr, scr, r, lane); continue; } r -= I_GL;
            if (r < I_OU) { p0_transpose_item(F.in[I_WOUT] + (size_t)l * DM * DM, DM, DM, (bf16*)(F.ws + WS_WOUT) + (size_t)l * DM * DM, F.in[I_BRG] + l * DM, scr, r, lane); continue; } r -= I_OU;
            p0_transpose_item(F.in[I_WQ] + (size_t)l * DM * DM, DM, DM, (bf16*)(F.ws + WS_WQ) + (size_t)l * DM * DM, F.in[I_N2G] + l * DM, scr, r, lane, modp + l * 12288 + 4 * 2048);
        }
    }
    {
        bf16* KB = (bf16*)(F.ws + WS_KEYS);
        for (int i = gt; i < 2 * 8 * 2 * 128 * 128 / 8; i += NGT) { const f32x4 a = *(const f32x4*)(F.in[I_KEYS] + (size_t)i * 8), b = *(const f32x4*)(F.in[I_KEYS] + (size_t)i * 8 + 4);
            u32x4 o; o.x = pk2(a[0], a[1]); o.y = pk2(a[2], a[3]); o.z = pk2(b[0], b[1]); o.w = pk2(b[2], b[3]); *(u32x4*)(KB + (size_t)i * 8) = o; }
        bf16* GW = (bf16*)(F.ws + WS_GWS);
        for (int i = gt; i < 2 * 8 * 128 * 128 / 8; i += NGT) { const int e = i * 8, jj = e & 127, ii = (e >> 7) & 127; const bool keep = (ii >= 64) || (jj < 64);
            f32x4 a = *(const f32x4*)(F.in[I_GWS] + (size_t)i * 8), b = *(const f32x4*)(F.in[I_GWS] + (size_t)i * 8 + 4);
            if (!keep) { a = (f32x4){0.f, 0.f, 0.f, 0.f}; b = a; }
            u32x4 o; o.x = pk2(a[0], a[1]); o.y = pk2(a[2], a[3]); o.z = pk2(b[0], b[1]); o.w = pk2(b[2], b[3]); *(u32x4*)(GW + (size_t)i * 8) = o; }
    }
}

template <bool SRC_BF16>
__device__ __forceinline__ void phase_norm(Frame& F, const void* xsrc, const float* gain, const float* scale, const float* shift) {
    PH_LOCALS
    const int gw = F.vcu * NWAVES + wave, NGW = F.G * NWAVES;
    bf16* H = (bf16*)(F.ws + WS_H);
    for (int m = gw; m < M; m += 2 * NGW) {
        const int m2 = m + NGW;
        f32x4 va[4][2], vb[4][2];
        const char* ra = (const char*)xsrc + (size_t)m * DM * (SRC_BF16 ? 2 : 4); const char* rb = (const char*)xsrc + (size_t)(m2 < M ? m2 : m) * DM * (SRC_BF16 ? 2 : 4);
        load_row<SRC_BF16>(ra, lane, va); load_row<SRC_BF16>(rb, lane, vb);
        u32x4 oa[4], ob[4]; norm_mod_row(va, gain, scale, shift, lane, oa); norm_mod_row(vb, gain, scale, shift, lane, ob);
#pragma unroll
        for (int j = 0; j < 4; ++j) *(u32x4*)(H + (size_t)m * DM + j * 512 + lane * 8) = oa[j];
        if (m2 < M) {
#pragma unroll
            for (int j = 0; j < 4; ++j) *(u32x4*)(H + (size_t)m2 * DM + j * 512 + lane * 8) = ob[j]; }
    }
}
__device__ __forceinline__ void phase_lnstats(Frame& F) {
    PH_LOCALS
    const int gw = F.vcu * NWAVES + wave, NGW = F.G * NWAVES;
    const bf16* Z = (const bf16*)(F.ws + WS_Z); float* ST = (float*)(F.ws + WS_STATS);
    for (int m0 = gw; m0 < M; m0 += 2 * NGW) {
        float v[2][16]; int mm[2];
#pragma unroll
        for (int r = 0; r < 2; ++r) { mm[r] = (m0 + r * NGW < M) ? m0 + r * NGW : m0;
#pragma unroll
            for (int j = 0; j < 2; ++j) { const u32x4 w = *(const u32x4*)(Z + (size_t)mm[r] * 2048 + 1024 + j * 512 + lane * 8);
                v[r][j * 8 + 0] = bflo(w.x); v[r][j * 8 + 1] = bfhi(w.x); v[r][j * 8 + 2] = bflo(w.y); v[r][j * 8 + 3] = bfhi(w.y); v[r][j * 8 + 4] = bflo(w.z); v[r][j * 8 + 5] = bfhi(w.z); v[r][j * 8 + 6] = bflo(w.w); v[r][j * 8 + 7] = bfhi(w.w); } }
        float s[2] = {0.f, 0.f};
#pragma unroll
        for (int r = 0; r < 2; ++r)
#pragma unroll
            for (int i = 0; i < 16; ++i) s[r] += v[r][i];
#pragma unroll
        for (int o = 1; o < 64; o <<= 1) { s[0] += __shfl_xor(s[0], o); s[1] += __shfl_xor(s[1], o); }
        float q[2] = {0.f, 0.f}; const float mean[2] = {s[0] * (1.0f / 1024.0f), s[1] * (1.0f / 1024.0f)};
#pragma unroll
        for (int r = 0; r < 2; ++r)
#pragma unroll
            for (int i = 0; i < 16; ++i) { const float d = v[r][i] - mean[r]; q[r] += d * d; }
#pragma unroll
        for (int o = 1; o < 64; o <<= 1) { q[0] += __shfl_xor(q[0], o); q[1] += __shfl_xor(q[1], o); }
        if (lane < 2) { const int r = lane; const float qq = r ? q[1] : q[0], mu = r ? mean[1] : mean[0]; const int m = r ? mm[1] : mm[0];
            ST[2 * m] = mu; ST[2 * m + 1] = 1.0f / sqrtf(qq * (1.0f / 1024.0f) + EPS); }
    }
}
__device__ __forceinline__ void phase_branchnorm(Frame& F) {
    PH_LOCALS
    const int gw = F.vcu * NWAVES + wave, NGW = F.G * NWAVES;
    bf16* MIX = (bf16*)(F.ws + WS_MIX);
    for (int m0 = gw; m0 < M; m0 += 2 * NGW) {
        u32x4 w[2][4]; float sa[2] = {0.f, 0.f}, sb[2] = {0.f, 0.f}; int mm[2];
#pragma unroll
        for (int r = 0; r < 2; ++r) { mm[r] = (m0 + r * NGW < M) ? m0 + r * NGW : m0;
#pragma unroll
            for (int j = 0; j < 4; ++j) w[r][j] = *(const u32x4*)(MIX + (size_t)mm[r] * 2048 + j * 512 + lane * 8); }
#pragma unroll
        for (int r = 0; r < 2; ++r)
#pragma unroll
            for (int j = 0; j < 4; ++j) { float q = 0.f;
#pragma unroll
                for (int e = 0; e < 4; ++e) { const float a = bflo(w[r][j][e]), b = bfhi(w[r][j][e]); q += a * a + b * b; }
                if (j < 2) sa[r] += q; else sb[r] += q; }
#pragma unroll
        for (int o = 1; o < 64; o <<= 1) { sa[0] += __shfl_xor(sa[0], o); sb[0] += __shfl_xor(sb[0], o); sa[1] += __shfl_xor(sa[1], o); sb[1] += __shfl_xor(sb[1], o); }
#pragma unroll
        for (int r = 0; r < 2; ++r) {
            if (r == 1 && mm[1] == mm[0]) break;
            const float ra = 1.0f / sqrtf(sa[r] * (1.0f / 1024.0f) + EPS), rb = 1.0f / sqrtf(sb[r] * (1.0f / 1024.0f) + EPS);
#pragma unroll
            for (int j = 0; j < 4; ++j) { const float rs = j < 2 ? ra : rb; u32x4 o;
#pragma unroll
                for (int e = 0; e < 4; ++e) o[e] = pk2(bflo(w[r][j][e]) * rs, bfhi(w[r][j][e]) * rs);
                *(u32x4*)(MIX + (size_t)mm[r] * 2048 + j * 512 + lane * 8) = o; }
        }
    }
}

__device__ __forceinline__ void phase_sloc(Frame& F, int l) {
    PH_LOCALS
    const bf16* XS = (const bf16*)(F.ws + WS_XS); const bf16* WG = (const bf16*)(F.ws + WS_WG) + (size_t)l * 64 * 128 * 1024; float* SL = (float*)(F.ws + WS_SLOC);
    const int fr = lane & 15, fq = lane >> 4;
    for (int u = F.vcu; u < 256; u += F.G) {
        const int g = u >> 2, n0 = (u & 3) * 64 + (wave & 3) * 16, jh = wave >> 2;
        f32x4 acc[4];
#pragma unroll
        for (int t = 0; t < 4; ++t) acc[t] = (f32x4){0.f, 0.f, 0.f, 0.f};
        const bf16* xp = XS + ((size_t)(g * 256 + n0 + fr)) * 1024 + 8 * fq;
        const bf16* wp = WG + ((size_t)(g * 128 + jh * 64 + fr)) * 1024 + 8 * fq;
#pragma unroll 8
        for (int kb = 0; kb < 32; ++kb) {
            const bf16x8 xf = *(const bf16x8*)(xp + kb * 32);
#pragma unroll
            for (int t = 0; t < 4; ++t) { const bf16x8 wf = *(const bf16x8*)(wp + (size_t)t * 16 * 1024 + kb * 32); acc[t] = __builtin_amdgcn_mfma_f32_16x16x32_bf16(wf, xf, acc[t], 0, 0, 0); }
        }
#pragma unroll
        for (int t = 0; t < 4; ++t) *(f32x4*)(SL + ((size_t)(g * 256 + n0 + fr)) * 128 + jh * 64 + t * 16 + 4 * fq) = acc[t];
    }
}
__device__ __forceinline__ void gating_unit(Frame& F, int l, int unit) {
    PH_LOCALS
    const int nb = unit >> 3, hh = unit & 7, t0 = nb * 128, c0 = hh * 128;
    const bf16* Z = (const bf16*)(F.ws + WS_Z); const float* ST = (const float*)(F.ws + WS_STATS);
    const bf16* GW = (const bf16*)(F.ws + WS_GWS) + (size_t)(l * 8 + hh) * 128 * 128;
    bf16* MIX = (bf16*)(F.ws + WS_MIX);
    LAS bf16* VT = (LAS bf16*)F.lds;
    constexpr int VS = 136;
    {
        const int j = tid >> 2, cs = (tid & 3) * 32;
        const float mu = ST[2 * (t0 + j)], rs = ST[2 * (t0 + j) + 1];
        const float* lg = F.in[I_LNG] + l * 1024 + c0 + cs; const float* lb = F.in[I_LNB] + l * 1024 + c0 + cs;
#pragma unroll
        for (int q = 0; q < 4; ++q) {
            const u32x4 w = *(const u32x4*)(Z + (size_t)(t0 + j) * 2048 + 1024 + c0 + cs + q * 8);
#pragma unroll
            for (int e = 0; e < 4; ++e) { const int c = cs + q * 8 + 2 * e;
                const float a = (bflo(w[e]) - mu) * rs * lg[q * 8 + 2 * e] + lb[q * 8 + 2 * e], b = (bfhi(w[e]) - mu) * rs * lg[q * 8 + 2 * e + 1] + lb[q * 8 + 2 * e + 1];
                VT[c * VS + j] = (bf16)f2bf(a); VT[(c + 1) * VS + j] = (bf16)f2bf(b); }
        }
    }
    __syncthreads();
    {
        const int fr = lane & 15, fq = lane >> 4, w = wave;
        f32x4 acc[8];
#pragma unroll
        for (int ct = 0; ct < 8; ++ct) acc[ct] = (f32x4){0.f, 0.f, 0.f, 0.f};
        const int nkb = (w < 4) ? 2 : 4;
        for (int kb = 0; kb < nkb; ++kb) {
            const bf16x8 wf = *(const bf16x8*)(GW + (size_t)(16 * w + fr) * 128 + kb * 32 + 8 * fq);
#pragma unroll
            for (int ct = 0; ct < 8; ++ct) { const bf16x8 vf = *(const LAS bf16x8*)(VT + (ct * 16 + fr) * VS + kb * 32 + 8 * fq); acc[ct] = __builtin_amdgcn_mfma_f32_16x16x32_bf16(vf, wf, acc[ct], 0, 0, 0); }
        }
        const int tok = t0 + 16 * w + fr; const float bs = F.in[I_GBS][(l * 8 + hh) * 128 + 16 * w + fr];
#pragma unroll
        for (int ct = 0; ct < 8; ++ct) { const int c = c0 + ct * 16 + 4 * fq;
            const u32x2 uw = *(const u32x2*)(Z + (size_t)tok * 2048 + c);
            u32x2 o; o.x = pk2(bflo(uw.x) * (acc[ct][0] + bs), bfhi(uw.x) * (acc[ct][1] + bs)); o.y = pk2(bflo(uw.y) * (acc[ct][2] + bs), bfhi(uw.y) * (acc[ct][3] + bs));
            *(u32x2*)(MIX + (size_t)tok * 2048 + c) = o; }
    }
    __syncthreads();
}
__device__ __forceinline__ void phase_gating(Frame& F, int l) {
    for (int u = F.vcu; u < 1024; u += F.G) gating_unit(F, l, u);
}

__device__ __forceinline__ void phase_s5out(Frame& F, int l) {
    PH_LOCALS
    const bf16* XS = (const bf16*)(F.ws + WS_XS);
    bf16* Gb = (bf16*)(F.ws + WS_G);
    LAS unsigned char* HT = F.lds;
    LAS float* TS = (LAS float*)(F.lds + 34816);
    LAS unsigned char* KT = F.lds + 38912;
    LAS unsigned char* VT = F.lds + 79872;
    const int fr = lane & 15, fq = lane >> 4;
    for (int u = F.vcu; u < 512; u += F.G) {
        const int g = u >> 3, rc = (u >> 1) & 3, nh = u & 1;
        const bf16* VG = (const bf16*)(F.ws + WS_VG) + (size_t)(l * 64 + g) * 1024 * 128;
        const int n = nh * 128 + 16 * wave + fr;
        const bf16* xp0 = XS + ((size_t)(g * 256 + n)) * 1024 + 8 * fq;
        bf16x8 xa[4], xb[4];
#pragma unroll
        for (int i = 0; i < 4; ++i) xa[i] = *(const bf16x8*)(xp0 + i * 32);
        __syncthreads();
        { const u32x4* src = (const u32x4*)((const bf16*)(F.ws + WS_KTAB) + (size_t)(l * 64 + g) * 80 * 256);
          for (int i = tid; i < 80 * 256 / 8; i += NTHR) ((LAS u32x4*)KT)[i] = src[i];
#pragma unroll
          for (int ps = 0; ps < 8; ++ps) { const int row = ps * 32 + (tid >> 4), c = tid & 15, q = row >> 4, o = row & 15;
              *(LAS u32x4*)(VT + row * 272 + c * 16) = *(const u32x4*)(VG + (size_t)((rc + 4 * q) * 16 + o) * 128 + c * 8); } }
        {
            const int p = lane, seg = wave;
            const float* AT = (const float*)(F.ws + WS_AT) + ((size_t)(l * 64 + g) * 64 + p) * 2; const float ar = AT[0], ai = AT[1];
            const float* SL = (const float*)(F.ws + WS_SLOC) + ((size_t)(g * 256 + seg * 32)) * 128 + p;
            float sr[32], si[32];
#pragma unroll
            for (int i = 0; i < 32; ++i) { sr[i] = SL[(size_t)i * 128]; si[i] = SL[(size_t)i * 128 + 64]; }
            float er = 0.f, ei = 0.f;
#pragma unroll
            for (int i = 0; i < 32; ++i) { const float nr = ar * er - ai * ei + sr[i], ni = ar * ei + ai * er + si[i]; er = nr; ei = ni; }
            TS[(seg * 64 + p) * 2] = er; TS[(seg * 64 + p) * 2 + 1] = ei;
            float qr = ar, qi = ai;
#pragma unroll
            for (int s = 0; s < 5; ++s) { const float nr = qr * qr - qi * qi, ni = 2.0f * qr * qi; qr = nr; qi = ni; }
            __syncthreads();
            float hr = 0.f, hi = 0.f;
            for (int k = 0; k < seg; ++k) { const float tr = TS[(k * 64 + p) * 2], ti = TS[(k * 64 + p) * 2 + 1]; const float nr = qr * hr - qi * hi + tr, ni = qr * hi + qi * hr + ti; hr = nr; hi = ni; }
            if ((seg >> 2) == nh) {
                LAS bf16* hrow = (LAS bf16*)(HT + ((seg & 3) * 32) * 272) + p;
#pragma unroll
                for (int i = 0; i < 32; ++i) { hrow[i * 136] = (bf16)f2bf(hr); hrow[i * 136 + 64] = (bf16)f2bf(hi);
                    const float nr = ar * hr - ai * hi + sr[i], ni = ar * hi + ai * hr + si[i]; hr = nr; hi = ni; }
            }
        }
        __syncthreads();
        f32x4 acc[16];
#pragma unroll
        for (int q = 0; q < 16; ++q) acc[q] = (f32x4){0.f, 0.f, 0.f, 0.f};
        const int kb0 = ((rc - (fq >> 1) + 10) * 16 + fr) * 32 + 16 * (fq & 1);
#define S5_GROUP(XF, grp_) do { const LAS unsigned char* kp = KT + kb0 - (grp_) * 4096; \
            _Pragma("unroll") for (int q = 0; q < 16; ++q) { if (rc + 4 * q >= 8 * (grp_)) { \
                _Pragma("unroll") for (int i = 0; i < 4; ++i) { const bf16x8 kf = *(const LAS bf16x8*)(kp + (4 * q - 2 * i + 6) * 512); \
                    acc[q] = __builtin_amdgcn_mfma_f32_16x16x32_bf16(kf, XF[i], acc[q], 0, 0, 0); } } } } while (0)
#pragma unroll 1
        for (int gp = 0; gp < 4; ++gp) {
#pragma unroll
            for (int i = 0; i < 4; ++i) xb[i] = *(const bf16x8*)(xp0 + ((2 * gp + 1) * 4 + i) * 32);
            S5_GROUP(xa, 2 * gp);
            if (gp < 3) {
#pragma unroll
                for (int i = 0; i < 4; ++i) xa[i] = *(const bf16x8*)(xp0 + ((2 * gp + 2) * 4 + i) * 32);
            }
            S5_GROUP(xb, 2 * gp + 1);
        }
#undef S5_GROUP
#pragma unroll 1
        for (int jb = 0; jb < 4; ++jb) {
            const bf16x8 hf = *(const LAS bf16x8*)(HT + (16 * wave + fr) * 272 + (jb * 32 + 8 * fq) * 2);
#pragma unroll
            for (int q = 0; q < 16; ++q) {
                const bf16x8 vf = *(const LAS bf16x8*)(VT + (q * 16 + fr) * 272 + (jb * 32 + 8 * fq) * 2);
                acc[q] = __builtin_amdgcn_mfma_f32_16x16x32_bf16(vf, hf, acc[q], 0, 0, 0);
            }
        }
#pragma unroll
        for (int q = 0; q < 16; ++q) {
            const int t = rc + 4 * q, tok = 64 * n + t;
            const f32x4 y = acc[q];
            u32x2 o; o.x = pk2(gelu_tanh(y[0]), gelu_tanh(y[1])); o.y = pk2(gelu_tanh(y[2]), gelu_tanh(y[3]));
            *(u32x2*)(Gb + (size_t)tok * 1024 + g * 16 + 4 * fq) = o;
#if SELFTEST_S5
            if (tok < 256) *(f32x4*)((float*)(F.ws + WS_DBG) + (size_t)tok * 1024 + g * 16 + 4 * fq) = y;
#endif
        }
    }
    __syncthreads();
}
#if SELFTEST_S5
__device__ __forceinline__ void selftest_s5(Frame& F, int l) {
    PH_LOCALS
    if (F.vcu < 64 && wave == 0) {
        const int g = F.vcu, p = lane;
        const float dt = expf(F.in[I_LDT][l * 64 + g]);
        const float lr = F.in[I_LRE][(l * 64 + g) * 64 + p], li = F.in[I_LIM][(l * 64 + g) * 64 + p];
        const float mag = expf(lr * dt); float sn, cs; sincosf(li * dt, &sn, &cs);
        const float ar = mag * cs, ai = mag * sn;
        const float xr = ar - 1.0f, xi = ai, den = 1.0f / (lr * lr + li * li);
        const float cr = (xr * lr + xi * li) * den, ci = (xi * lr - xr * li) * den;
        float bbr[16], bbi[16], ccr[16], cci[16];
#pragma unroll
        for (int i = 0; i < 16; ++i) { const float br = F.in[I_BRE][((size_t)(l * 64 + g) * 64 + p) * 16 + i], bi = F.in[I_BIM][((size_t)(l * 64 + g) * 64 + p) * 16 + i];
            bbr[i] = cr * br - ci * bi; bbi[i] = cr * bi + ci * br;
            ccr[i] = F.in[I_CRE][((size_t)(l * 64 + g) * 16 + i) * 64 + p]; cci[i] = F.in[I_CIM][((size_t)(l * 64 + g) * 16 + i) * 64 + p]; }
        const bf16* XS = (const bf16*)(F.ws + WS_XS) + (size_t)g * 256 * 1024;
        const float* DY = (const float*)(F.ws + WS_DBG);
        float sr = 0.f, si = 0.f, err = 0.f, ref = 0.f;
        for (int t = 0; t < 256; ++t) {
            float x[16];
#pragma unroll
            for (int i = 0; i < 16; ++i) x[i] = bflo((unsigned)XS[(size_t)t * 16 + i]);
            float ur = 0.f, ui = 0.f;
#pragma unroll
            for (int i = 0; i < 16; ++i) { ur += bbr[i] * x[i]; ui += bbi[i] * x[i]; }
            const float nr = ar * sr - ai * si + ur, ni = ar * si + ai * sr + ui; sr = nr; si = ni;
#pragma unroll
            for (int o = 0; o < 16; ++o) {
                const float yr = wave_sum(ccr[o] * sr - cci[o] * si);
                const float yf = DY[(size_t)t * 1024 + g * 16 + o];
                err += (yf - yr) * (yf - yr); ref += yr * yr;
            }
        }
        if (lane == 0 && !(err <= 2e-3f * ref)) __hip_atomic_fetch_or((unsigned*)(F.ws + WS_CTL) + CW_FLAG, 1u, RLX_AGENT);
    }
}
#endif

__device__ __forceinline__ unsigned f2key(float v) { const unsigned u = __builtin_bit_cast(unsigned, v); return (u & 0x80000000u) ? ~u : (u | 0x80000000u); }
__device__ __forceinline__ float key2f(unsigned k) { const unsigned u = (k & 0x80000000u) ? (k & 0x7fffffffu) : ~k; return __builtin_bit_cast(float, u); }
__device__ __forceinline__ void sort16_desc(unsigned (&v)[16]) {
#pragma unroll
    for (int lk = 1; lk <= 4; ++lk) {
#pragma unroll
        for (int lj = lk - 1; lj >= 0; --lj) {
#pragma unroll
            for (int i = 0; i < 16; ++i) { const int k = 1 << lk, j = 1 << lj, p = i ^ j;
                if (p > i) { const unsigned a = v[i], c = v[p], hi = a > c ? a : c, lo = a > c ? c : a; const bool desc = ((i & k) == 0) || (k == 16);
                    v[i] = desc ? hi : lo; v[p] = desc ? lo : hi; } }
        }
    }
}
__device__ __forceinline__ void merge16_desc(unsigned (&v)[16], const unsigned (&w)[16]) {
#pragma unroll
    for (int i = 0; i < 16; ++i) v[i] = v[i] > w[15 - i] ? v[i] : w[15 - i];
#pragma unroll
    for (int lj = 3; lj >= 0; --lj) {
#pragma unroll
        for (int i = 0; i < 16; ++i) { const int j = 1 << lj, p = i ^ j;
            if (p > i) { const unsigned a = v[i], c = v[p]; v[i] = a > c ? a : c; v[p] = a > c ? c : a; } }
    }
}
__device__ __forceinline__ void xmerge16(unsigned (&v)[16], int mask) {
    unsigned w[16];
#pragma unroll
    for (int i = 0; i < 16; ++i) w[i] = (unsigned)__shfl_xor((int)v[i], mask);
    merge16_desc(v, w);
}
__device__ __forceinline__ void phase_topk(Frame& F, int l) {
    PH_LOCALS
    const bf16* Q = (const bf16*)(F.ws + WS_Z);
    const bf16* KB = (const bf16*)(F.ws + WS_KEYS) + (size_t)l * 8 * 2 * 128 * 128;
    int* EID = (int*)(F.ws + WS_EID); float* GT = (float*)(F.ws + WS_GATE); float* SUo = (float*)(F.ws + WS_SU);
    const float* SCL = (const float*)(F.ws + WS_SCL) + (size_t)l * NEXP * 2;
    LAS unsigned char* KL = F.lds;
    LAS float* SC = (LAS float*)(F.lds + 69632);
    LAS unsigned* LST = (LAS unsigned*)(F.lds + 69632 + 66560);
    LAS unsigned char* PT = F.lds + 69632 + 66560 + 8192;
    const int fr = lane & 15, fq = lane >> 4;
    {
        int c = 0;
#pragma unroll
        for (int i = 0; i < 16; ++i)
#pragma unroll
            for (int j = 0; j < 16; ++j) if ((i + 1) * (j + 1) <= 16) { if (tid == c) PT[c] = (unsigned char)(i * 16 + j); ++c; }
    }
    int cur_hh = -1;
    for (int u = F.vcu; u < 2048; u += F.G) {
        const int tt = u >> 3, hh = u & 7, t0 = tt * 64;
        const int tw = wave & 3, s = wave >> 2;
        bf16x8 qf[4];
#pragma unroll
        for (int kb = 0; kb < 4; ++kb) qf[kb] = *(const bf16x8*)(Q + (size_t)(t0 + 16 * tw + fr) * 2048 + hh * 256 + s * 128 + kb * 32 + 8 * fq);
        if (hh != cur_hh) {
            __syncthreads();
#pragma unroll
            for (int ps = 0; ps < 8; ++ps) { const int idx = ps * 512 + tid, row = idx >> 4, c16 = idx & 15;
                *(LAS u32x4*)(KL + row * 272 + c16 * 16) = *(const u32x4*)(KB + ((size_t)(hh * 256 + row)) * 128 + c16 * 8); }
            cur_hh = hh;
        }
        __syncthreads();
        {
            f32x4 acc[8];
#pragma unroll
            for (int nt = 0; nt < 8; ++nt) acc[nt] = (f32x4){0.f, 0.f, 0.f, 0.f};
#pragma unroll
            for (int kb = 0; kb < 4; ++kb)
#pragma unroll
                for (int nt = 0; nt < 8; ++nt) { const bf16x8 kf = *(const LAS bf16x8*)(KL + (s * 128 + nt * 16 + fr) * 272 + (kb * 32 + 8 * fq) * 2);
                    acc[nt] = __builtin_amdgcn_mfma_f32_16x16x32_bf16(kf, qf[kb], acc[nt], 0, 0, 0); }
#pragma unroll
            for (int nt = 0; nt < 8; ++nt) *(LAS f32x4*)(SC + (16 * tw + fr) * 260 + s * 128 + nt * 16 + 4 * fq) = acc[nt];
        }
        __syncthreads();
        {
            const int pr = tid >> 2, sub = tid & 3, tl = pr >> 1, sd = pr & 1;
            const LAS float* row = SC + tl * 260 + sd * 128 + 32 * sub;
            unsigned va[16], vb[16];
#pragma unroll
            for (int q4 = 0; q4 < 4; ++q4) { const f32x4 x = *(const LAS f32x4*)(row + 4 * q4), y = *(const LAS f32x4*)(row + 16 + 4 * q4);
#pragma unroll
                for (int e = 0; e < 4; ++e) { va[4 * q4 + e] = (f2key(x[e]) & ~0x7Fu) | (unsigned)(127 - (32 * sub + 4 * q4 + e)); vb[4 * q4 + e] = (f2key(y[e]) & ~0x7Fu) | (unsigned)(127 - (32 * sub + 16 + 4 * q4 + e)); } }
            sort16_desc(va); sort16_desc(vb); merge16_desc(va, vb);
            xmerge16(va, 1); xmerge16(va, 2);
            if (sub == 0) {
#pragma unroll
                for (int k = 0; k < 16; k += 4) *(LAS u32x4*)(LST + pr * 16 + k) = (u32x4){va[k], va[k + 1], va[k + 2], va[k + 3]};
            }
        }
        __syncthreads();
        {
            const int tl = tid >> 3, s8 = tid & 7;
            unsigned v[16];
#pragma unroll
            for (int m = 0; m < 7; ++m) { const int c = m * 8 + s8; unsigned key = 0u;
                if (c < 50) { const int pij = PT[c], i = pij >> 4, j = pij & 15;
                    const float av = key2f(LST[(tl * 2 + 0) * 16 + i] & ~0x7Fu), bv = key2f(LST[(tl * 2 + 1) * 16 + j] & ~0x7Fu);
                    key = (f2key(av + bv) & ~0xFFu) | (unsigned)(255 - pij); }
                v[m] = key; }
#pragma unroll
            for (int m = 7; m < 16; ++m) v[m] = 0u;
            sort16_desc(v);
            xmerge16(v, 1); xmerge16(v, 2); xmerge16(v, 4);
            float ev[16]; float sum = 0.f; const float mx = key2f(v[0] & ~0xFFu);
#pragma unroll
            for (int k = 0; k < 16; ++k) { ev[k] = __expf(key2f(v[k] & ~0xFFu) - mx); sum += ev[k]; }
            const float inv = 1.0f / sum;
            unsigned k0 = v[0], k1 = v[1]; float e0 = ev[0], e1 = ev[1];
#pragma unroll
            for (int q = 1; q < 8; ++q) { if (s8 == q) { k0 = v[2 * q]; k1 = v[2 * q + 1]; e0 = ev[2 * q]; e1 = ev[2 * q + 1]; } }
            const size_t ob = (size_t)(t0 + tl) * 128 + hh * 16 + 2 * s8;
            {   const int flat = 255 - (int)(k0 & 0xFFu), i = flat >> 4, j = flat & 15;
                const int ia = 127 - (int)(LST[(tl * 2 + 0) * 16 + i] & 0x7Fu), ib = 127 - (int)(LST[(tl * 2 + 1) * 16 + j] & 0x7Fu);
                const int e = ia * 128 + ib; const f32x2 sc = *(const f32x2*)(SCL + 2 * e);
                EID[ob] = e; GT[ob] = e0 * inv * sc.y; SUo[ob] = sc.x; }
            {   const int flat = 255 - (int)(k1 & 0xFFu), i = flat >> 4, j = flat & 15;
                const int ia = 127 - (int)(LST[(tl * 2 + 0) * 16 + i] & 0x7Fu), ib = 127 - (int)(LST[(tl * 2 + 1) * 16 + j] & 0x7Fu);
                const int e = ia * 128 + ib; const f32x2 sc = *(const f32x2*)(SCL + 2 * e);
                EID[ob + 1] = e; GT[ob + 1] = e1 * inv * sc.y; SUo[ob + 1] = sc.x; }
        }
    }
    __syncthreads();
}

#define FP4X4(w, f0, f1, f2, f3) do { f0 = __builtin_amdgcn_cvt_scalef32_pk_f32_fp4((w), 1.0f, 0); f1 = __builtin_amdgcn_cvt_scalef32_pk_f32_fp4((w), 1.0f, 1); \
    f2 = __builtin_amdgcn_cvt_scalef32_pk_f32_fp4((w), 1.0f, 2); f3 = __builtin_amdgcn_cvt_scalef32_pk_f32_fp4((w), 1.0f, 3); } while (0)
__device__ __forceinline__ void phase_gather(Frame& F, int l, bool dummy = false) {
    PH_LOCALS
    const int gw = F.vcu * NWAVES + wave, NGW = F.G * NWAVES;
    bf16* Hn = dummy ? (bf16*)(F.ws + WS_DBG + 128 * MiB) : (bf16*)(F.ws + WS_H);
    const unsigned char* UV = F.ws + WS_UV + (size_t)l * NEXP * 2048;
    const int* EID = (const int*)(F.ws + WS_EID); const float* GT = (const float*)(F.ws + WS_GATE); const float* SU = (const float*)(F.ws + WS_SU);
    const bf16* X = (const bf16*)(F.ws + WS_X); bf16* Xo = dummy ? (bf16*)(F.ws + WS_DBG) : (bf16*)(F.ws + WS_X);
    const float* mod = (const float*)(F.ws + WS_MOD);
    const float* gate2 = mod + l * 12288 + 5 * 2048; const float* shift2 = mod + l * 12288 + 3 * 2048; const float* gs2 = (const float*)(F.ws + WS_GS) + l * DM;
    const unsigned lane16 = (unsigned)lane * 16u;
    for (int t = gw; t < M; t += NGW) {
        const int e_lo = EID[(size_t)t * 128 + lane], e_hi = EID[(size_t)t * 128 + 64 + lane];
        const float g_lo = GT[(size_t)t * 128 + lane], g_hi = GT[(size_t)t * 128 + 64 + lane];
        const float s_lo = SU[(size_t)t * 128 + lane], s_hi = SU[(size_t)t * 128 + 64 + lane];
        f32x2 hh[8][2];
        {   float s2 = 0.f; u32x2 xw[8];
#pragma unroll
            for (int j = 0; j < 8; ++j) xw[j] = *(const u32x2*)(X + (size_t)t * 2048 + j * 256 + lane * 4);
#pragma unroll
            for (int j = 0; j < 8; ++j) { hh[j][0] = (f32x2){bflo(xw[j].x), bfhi(xw[j].x)}; hh[j][1] = (f32x2){bflo(xw[j].y), bfhi(xw[j].y)};
                s2 += (hh[j][0].x * hh[j][0].x + hh[j][0].y * hh[j][0].y) + (hh[j][1].x * hh[j][1].x + hh[j][1].y * hh[j][1].y); }
            const float r2 = 1.0f / sqrtf(wave_sum(s2) * (1.0f / DM) + EPS);
#pragma unroll
            for (int j2 = 0; j2 < 8; j2 += 4) { f32x4 gsv[4], shv[4];
#pragma unroll
                for (int j = 0; j < 4; ++j) { gsv[j] = *(const f32x4*)(gs2 + (j2 + j) * 256 + lane * 4); shv[j] = *(const f32x4*)(shift2 + (j2 + j) * 256 + lane * 4); }
#pragma unroll
                for (int j = 0; j < 4; ++j) { hh[j2 + j][0] = (f32x2){hh[j2 + j][0].x * r2 * gsv[j][0] + shv[j][0], hh[j2 + j][0].y * r2 * gsv[j][1] + shv[j][1]}; hh[j2 + j][1] = (f32x2){hh[j2 + j][1].x * r2 * gsv[j][2] + shv[j][2], hh[j2 + j][1].y * r2 * gsv[j][3] + shv[j][3]}; } }
        }
        f32x2 of[8][2];
#pragma unroll
        for (int j = 0; j < 8; ++j) { of[j][0] = (f32x2){0.f, 0.f}; of[j][1] = (f32x2){0.f, 0.f}; }
        const bool u32_ = (lane & 32) != 0, u16_ = (lane & 16) != 0, u8_ = (lane & 8) != 0;
#if GATHER_PROBE_HOT
#define G_HOT(e) if (dummy) e &= 15;
#else
#define G_HOT(e)
#endif
#define G_ROW(dst, b_, h_, off_) do { int e_ = __builtin_amdgcn_readlane((b_) < 8 ? e_lo : e_hi, (8 * (b_) + (h_)) & 63); G_HOT(e_) \
            dst = *(const u32x4*)(UV + ((size_t)(unsigned)e_ << 11) + (off_) + lane16); } while (0)
#define G_DOTS(b_, NEXT) float p[8]; \
            _Pragma("unroll") for (int h = 0; h < 8; ++h) { f32x2 a2 = {0.f, 0.f}; \
                _Pragma("unroll") for (int d = 0; d < 4; ++d) { f32x2 f0, f1, f2, f3; FP4X4(ur[h][d], f0, f1, f2, f3); \
                    a2 = f0 * hh[2 * d][0] + a2; a2 = f1 * hh[2 * d][1] + a2; a2 = f2 * hh[2 * d + 1][0] + a2; a2 = f3 * hh[2 * d + 1][1] + a2; } \
                p[h] = a2.x + a2.y; if (NEXT) G_ROW(ur[h], (b_) + 1, h, 0); }
#define G_REST(b_, NEXT) float a4[4]; \
            _Pragma("unroll") for (int i = 0; i < 4; ++i) { const float snd = u32_ ? p[i] : p[4 + i], kp = u32_ ? p[4 + i] : p[i]; a4[i] = kp + __shfl_xor(snd, 32); } \
            float b2[2]; \
            _Pragma("unroll") for (int i = 0; i < 2; ++i) { const float snd = u16_ ? a4[i] : a4[2 + i], kp = u16_ ? a4[2 + i] : a4[i]; b2[i] = kp + __shfl_xor(snd, 16); } \
            float d; { const float snd = u8_ ? b2[0] : b2[1], kp = u8_ ? b2[1] : b2[0]; d = kp + __shfl_xor(snd, 8); } \
            d += __shfl_xor(d, 4); d += __shfl_xor(d, 2); d += __shfl_xor(d, 1); \
            const int hl = (8 * (b_) + (lane >> 3)) & 63; const float gsel = (b_) < 8 ? g_lo : g_hi, ssel = (b_) < 8 ? s_lo : s_hi; \
            const float coefq = __shfl(gsel, hl) * gelu_tanh(d * __shfl(ssel, hl)); \
            _Pragma("unroll") for (int h = 0; h < 8; ++h) { const float cf = __builtin_bit_cast(float, __builtin_amdgcn_readlane(__builtin_bit_cast(int, coefq), 8 * h)); const f32x2 cf2 = {cf, cf}; \
                _Pragma("unroll") for (int dd = 0; dd < 4; ++dd) { f32x2 f0, f1, f2, f3; FP4X4(vr[h][dd], f0, f1, f2, f3); \
                    of[2 * dd][0] = f0 * cf2 + of[2 * dd][0]; of[2 * dd][1] = f1 * cf2 + of[2 * dd][1]; of[2 * dd + 1][0] = f2 * cf2 + of[2 * dd + 1][0]; of[2 * dd + 1][1] = f3 * cf2 + of[2 * dd + 1][1]; } \
                if (NEXT) G_ROW(vr[h], (b_) + 1, h, 1024); }
        u32x4 ur[8], vr[8];
#pragma unroll
        for (int h = 0; h < 8; ++h) { G_ROW(ur[h], 0, h, 0); G_ROW(vr[h], 0, h, 1024); }
#pragma unroll 1
        for (int b = 0; b < 15; ++b) { G_DOTS(b, true) G_REST(b, true) }
        { G_DOTS(15, false) G_REST(15, false) }
#undef G_DOTS
#undef G_REST
#undef G_ROW
#undef G_HOT
        int ln = lane; asm volatile("" : "+v"(ln));
        u32x2 cx[8];
#pragma unroll
        for (int j = 0; j < 8; ++j) cx[j] = *(const u32x2*)(X + (size_t)t * 2048 + j * 256 + ln * 4);
        f32x4 xv[8]; float ss = 0.f;
#pragma unroll
        for (int j2 = 0; j2 < 8; j2 += 4) { f32x4 g2v[4];
#pragma unroll
            for (int j = 0; j < 4; ++j) g2v[j] = *(const f32x4*)(gate2 + (j2 + j) * 256 + ln * 4);
#pragma unroll
            for (int jj = 0; jj < 4; ++jj) { const int j = j2 + jj;
                const f32x4 xo = {bflo(cx[j].x), bfhi(cx[j].x), bflo(cx[j].y), bfhi(cx[j].y)};
                const f32x4 o = {of[j][0].x, of[j][0].y, of[j][1].x, of[j][1].y};
                xv[j] = xo + g2v[jj] * o;
                ss += (xv[j][0] * xv[j][0] + xv[j][1] * xv[j][1]) + (xv[j][2] * xv[j][2] + xv[j][3] * xv[j][3]); } }
        const float rr = 1.0f / sqrtf(wave_sum(ss) * (1.0f / DM) + EPS);
        if (l + 1 < DEPTH) {
            const float* m2 = mod + (l + 1) * 12288; const float* gain = F.in[I_N1G] + (l + 1) * 2048;
#pragma unroll
            for (int j2 = 0; j2 < 8; j2 += 4) { f32x4 gv[4], scv[4], shv[4];
#pragma unroll
                for (int j = 0; j < 4; ++j) { const int c = (j2 + j) * 256 + ln * 4; gv[j] = *(const f32x4*)(gain + c); scv[j] = *(const f32x4*)(m2 + 2048 + c); shv[j] = *(const f32x4*)(m2 + c); }
#pragma unroll
                for (int jj = 0; jj < 4; ++jj) { const int j = j2 + jj, c = j * 256 + ln * 4;
                    *(u32x2*)(Xo + (size_t)t * 2048 + c) = (u32x2){pk2(xv[j][0], xv[j][1]), pk2(xv[j][2], xv[j][3])};
                    const f32x4 y = xv[j] * rr * gv[jj] * (scv[jj] + 1.0f) + shv[jj];
                    *(u32x2*)(Hn + (size_t)t * 2048 + c) = (u32x2){pk2(y[0], y[1]), pk2(y[2], y[3])}; } }
        } else {
#pragma unroll
            for (int j = 0; j < 8; ++j) { const int c = j * 256 + ln * 4; const f32x4 fgv = *(const f32x4*)(F.in[I_FG] + c);
                f32x4 ov = xv[j] * rr * fgv;
#if SELFTEST_S5
                if (__hip_atomic_load((unsigned*)(F.ws + WS_CTL) + CW_FLAG, RLX_AGENT) != 0u) ov = (f32x4){1e30f, 1e30f, 1e30f, 1e30f};
#endif
                *(f32x4*)(F.out + (size_t)t * 2048 + c) = ov; }
        }
    }
}

__global__ void __launch_bounds__(NTHR, 2) fwd_kernel(Args args) {
    extern __shared__ __attribute__((aligned(16))) unsigned char lds_raw[];
    Frame F;
    F.lds = (LAS unsigned char*)lds_raw; F.ws = args.ws; F.in = args.in; F.out = args.out;
    F.tid = threadIdx.x; F.lane = F.tid & 63; F.wave = __builtin_amdgcn_readfirstlane(F.tid >> 6);
    F.G = gridDim.x; { const int bx = blockIdx.x; F.vcu = (F.G % 8 == 0) ? (bx % 8) * (F.G / 8) + bx / 8 : bx; }
    volatile LAS unsigned* MISC = (volatile LAS unsigned*)(F.lds + MISC_OFF);
    if (F.tid < 64) MISC[F.tid] = 0u;
    __syncthreads();
    unsigned* ctl = (unsigned*)(F.ws + WS_CTL);
    XcdBarrier bar; bar.bar = ctl + CW_BAR; bar.x = 0; bar.st = nullptr;
#if !MK_PER_PHASE
    bar = xcd_barrier_post(ctl + CW_BAR, MISC + 8);
#endif
    const int lo = args.ph_lo, hi = args.ph_hi;
#define IN(k) (lo <= (k) && (k) < hi)
#if MK_PER_PHASE
#define SEAM(k) do { } while (0)
#else
#define SEAM(k) do { if (IN(k) && IN((k) + 1)) xcd_barrier(bar); } while (0)
#endif
    const float* mod = (const float*)(F.ws + WS_MOD);

#define REP(k) (REPEAT_PH == (k))
#define RUN2(k, first, real) do { if (REP(k)) { first; xcd_barrier(bar); } real; } while (0)
    if (IN(0)) { RUN2(13, p0_tables(F, 5, true), p0_tables(F, 4, false)); } SEAM(0);
    for (int l = 0; l < DEPTH; ++l) {
        const int pb = 1 + 12 * l;
        const float* ml = mod + l * 12288;
        if (IN(pb + 0)) { if (l == 0) { RUN2(0, p0_prologue(F), p0_prologue(F)); RUN2(1, phase_norm<false>(F, F.in[I_X], F.in[I_N1G] + l * 2048, ml + 1 * 2048, ml + 0 * 2048), phase_norm<false>(F, F.in[I_X], F.in[I_N1G] + l * 2048, ml + 1 * 2048, ml + 0 * 2048)); } } SEAM(pb + 0);
        if (IN(pb + 1)) {
            pg8::Gemm g{(const bf16*)(F.ws + WS_H), (const bf16*)(F.ws + WS_WIN) + (size_t)l * INW * DM, M, INW, DM}; pg8::StaticOrder S; S.init(M, INW, F.G, (int)blockIdx.x);
            EpiIn E{(bf16*)(F.ws + WS_Z), (bf16*)(F.ws + WS_XS), F.in[I_BIN] + l * INW};
#define GEMM_IN pg8::gemm_phase<EpiIn, pg8::StaticOrder, true, true>(F.lds, g, S, E)
            RUN2(2, GEMM_IN, GEMM_IN);
        } SEAM(pb + 1);
        if (IN(pb + 2)) { RUN2(3, (phase_sloc(F, l), phase_lnstats(F)), (phase_sloc(F, l), phase_lnstats(F))); } SEAM(pb + 2);
        if (IN(pb + 3)) { RUN2(5, phase_s5out(F, l), phase_s5out(F, l)); RUN2(4, phase_gating(F, l), phase_gating(F, l));
#if SELFTEST_S5
            xcd_barrier(bar); selftest_s5(F, l);
#endif
        } SEAM(pb + 4);
        if (IN(pb + 5)) {
            pg8::Gemm g{(const bf16*)(F.ws + WS_G), (const bf16*)(F.ws + WS_GLU) + (size_t)l * WB * WB, M, WB, WB}; pg8::StaticOrder S; S.init(M, WB, F.G, (int)blockIdx.x);
            EpiGlu E{(const bf16*)(F.ws + WS_G), (bf16*)(F.ws + WS_MIX), F.in[I_GLUB] + l * WB};
#define GEMM_GLU pg8::gemm_phase<EpiGlu, pg8::StaticOrder, true, true>(F.lds, g, S, E)
            RUN2(6, GEMM_GLU, GEMM_GLU);
        } SEAM(pb + 5);
        if (IN(pb + 6)) { RUN2(7, phase_branchnorm(F), phase_branchnorm(F)); } SEAM(pb + 6);
        if (IN(pb + 7)) {
            pg8::Gemm g{(const bf16*)(F.ws + WS_MIX), (const bf16*)(F.ws + WS_WOUT) + (size_t)l * DM * DM, M, DM, DM}; pg8::StaticOrder S; S.init(M, DM, F.G, (int)blockIdx.x);
            if (l == 0) { EpiOut<false> E{(const void*)F.in[I_X], (bf16*)(F.ws + WS_X), ml + 2 * 2048, (float*)(F.ws + WS_PS)}; EpiOut<false> Ed{(const void*)F.in[I_X], (bf16*)(F.ws + WS_DBG), ml + 2 * 2048, (float*)(F.ws + WS_DBG + 128 * MiB)};
#define GEMM_OUT0(EE) pg8::gemm_phase<EpiOut<false>, pg8::StaticOrder, true, true>(F.lds, g, S, EE)
                RUN2(8, GEMM_OUT0(Ed), GEMM_OUT0(E)); }
            else { EpiOut<true> E{(const void*)(F.ws + WS_X), (bf16*)(F.ws + WS_X), ml + 2 * 2048, (float*)(F.ws + WS_PS)}; EpiOut<true> Ed{(const void*)(F.ws + WS_X), (bf16*)(F.ws + WS_DBG), ml + 2 * 2048, (float*)(F.ws + WS_DBG + 128 * MiB)};
#define GEMM_OUT1(EE) pg8::gemm_phase<EpiOut<true>, pg8::StaticOrder, true, true>(F.lds, g, S, EE)
                RUN2(8, GEMM_OUT1(Ed), GEMM_OUT1(E)); }
        }
        SEAM(pb + 8);
        if (IN(pb + 9)) {
            pg8::Gemm g{(const bf16*)(F.ws + WS_X), (const bf16*)(F.ws + WS_WQ) + (size_t)l * DM * DM, M, DM, DM}; pg8::StaticOrder S; S.init(M, DM, F.G, (int)blockIdx.x);
            LAS float* rrL = (LAS float*)(F.lds + 132096);
            pg8::Unit u0, u1; const bool h0 = S.next(0, u0), h1 = S.next(1, u1);
            { int t2 = F.tid; asm volatile("" : "+v"(t2)); if (h0) fill_rr(F, rrL, 0, u0.pm, t2); if (h1 && u1.pm != u0.pm) fill_rr(F, rrL, 1, u1.pm, t2); }
            __syncthreads();
            EpiQ E{(bf16*)(F.ws + WS_Z), (const float*)(F.ws + WS_C0) + l * DM, rrL, h0 ? u0.pm : -1};
#define GEMM_Q pg8::gemm_phase<EpiQ, pg8::StaticOrder, true, true>(F.lds, g, S, E)
            RUN2(10, GEMM_Q, GEMM_Q);
        } SEAM(pb + 9);
        if (IN(pb + 10)) { RUN2(11, phase_topk(F, l), phase_topk(F, l)); } SEAM(pb + 10);
        if (IN(pb + 11)) { RUN2(12, phase_gather(F, l, true), phase_gather(F, l, false)); } SEAM(pb + 11);
    }
#undef IN
#undef SEAM
}

extern "C" void kernel_launch(void* const* d_in, const int* in_sizes, int n_in, void* d_out, int out_size, void* d_ws, size_t ws_size, hipStream_t stream) {
    static int grid = 0;
    if (grid == 0) {
        if (n_in != 29 || out_size != M * DM || ws_size < WS_END) { fprintf(stderr, "kernel_launch: unexpected shapes (n_in %d, out %d, ws %zu); nothing launched\n", n_in, out_size, ws_size); grid = -1; return; }
        int dev = 0, cus = 0;
        if (hipGetDevice(&dev) != hipSuccess || hipDeviceGetAttribute(&cus, hipDeviceAttributeMultiprocessorCount, dev) != hipSuccess) { grid = -1; return; }
        if (hipFuncSetAttribute((const void*)fwd_kernel, hipFuncAttributeMaxDynamicSharedMemorySize, LDS_BYTES) != hipSuccess) { fprintf(stderr, "kernel_launch: hipFuncSetAttribute failed\n"); grid = -1; return; }
        (void)hipGetLastError();
        grid = cus;
    }
    if (grid < 0) return;
    (void)hipMemsetAsync((char*)d_ws + WS_CTL, 0, CTL_ZERO_BYTES, stream);
    Args a{};
    for (int i = 0; i < 29; ++i) a.in[i] = (const float*)d_in[i];
    a.out = (float*)d_out; a.ws = (unsigned char*)d_ws;
#if MK_PER_PHASE
    for (int p = 0; p < 1 + 12 * DEPTH; ++p) {
        if (p == 13) continue;
        a.ph_lo = p; a.ph_hi = p + 1; a.li = p;
        hipLaunchKernelGGL(fwd_kernel, dim3(grid), dim3(NTHR), LDS_BYTES, stream, a);
    }
#else
    a.ph_lo = 0; a.ph_hi = 1 + 12 * DEPTH; a.li = 0;
    hipLaunchKernelGGL(fwd_kernel, dim3(grid), dim3(NTHR), LDS_BYTES, stream, a);
#endif
}
```

```cpp
#include <hip/hip_runtime.h>
#include <cstdio>
#include <cstdint>

#ifndef SELFTEST_S5
#define SELFTEST_S5 0
#endif
#ifndef REPEAT_PH
#define REPEAT_PH -1
#endif
#ifndef GATHER_PROBE_HOT
#define GATHER_PROBE_HOT 0
#endif
#ifndef MK_PER_PHASE
#define MK_PER_PHASE 0
#endif

#define GAS __attribute__((address_space(1)))
#define LAS __attribute__((address_space(3)))
typedef unsigned short bf16;
typedef short bf16x8 __attribute__((ext_vector_type(8)));
typedef float f32x4 __attribute__((ext_vector_type(4)));
typedef float f32x2 __attribute__((ext_vector_type(2)));
typedef unsigned u32x4 __attribute__((ext_vector_type(4)));
typedef unsigned u32x2 __attribute__((ext_vector_type(2)));

constexpr int DM = 2048, SEQ = 16384, DEPTH = 2, M = SEQ;
constexpr int WA = 1024, WB = 1024, INW = 3072;
constexpr int NG = 64, NCH = 256;
constexpr int NEXP = 16384;
constexpr float EPS = 1e-6f;
constexpr int NWAVES = 8, NTHR = 512;

namespace pg8 {
#define PG8_LAS __attribute__((address_space(3)))
constexpr int BM = 256, BK = 64, HALF = 128, HTB = HALF * BK * 2, STAGE_BYTES = 8 * HTB, NXCD = 8, WGM = 8;
__host__ __device__ __forceinline__ int lds_byte(int r, int c) { const int st = (r >> 4) * 2 + (c >> 5), rr = r & 15, cc = c & 31, ob = rr * 64 + cc * 2; return st * 1024 + (ob ^ (((ob >> 9) & 1) << 5)); }
__host__ __device__ __forceinline__ void stage_rc(int b, int& R, int& C) { const int st = b / 1024, sb = b % 1024, swz = sb ^ (((sb >> 9) & 1) << 5); R = (st >> 1) * 16 + swz / 64; C = (st & 1) * 32 + (swz % 64) / 2; }
__host__ __device__ __forceinline__ int perm32(int rho) { const int n = rho >> 4, i = rho & 15; return 8 * (i >> 2) + 4 * n + (i & 3); }
struct Unit { int pm, pn; };
struct Gemm { const bf16* A; const bf16* Bt; int M, N, K; };
struct StaticOrder {
    int nM, nN, nwg, G, c;
    __host__ __device__ void init(int M_, int N_, int G_, int c_) { nM = M_ / BM; nN = N_ / BM; nwg = nM * nN; G = G_; c = c_; }
    __host__ __device__ bool next(int i, Unit& u) const {
        const long L = (long)i * G + c; if (L >= nwg) return false;
        int wgid = (int)L; { const int q = nwg / NXCD, r = nwg % NXCD, xcd = wgid % NXCD, off = wgid / NXCD; wgid = (xcd < r ? xcd * (q + 1) : r * (q + 1) + (xcd - r) * q) + off; }
        const int nig = WGM * nN, gid = wgid / nig, fm = gid * WGM, gsz = (nM - fm) < WGM ? (nM - fm) : WGM;
        u.pm = fm + ((wgid % nig) % gsz); u.pn = (wgid % nig) / gsz; return true;
    }
    __device__ __forceinline__ void a_ready(const Unit&) const {}
    __device__ __forceinline__ void done(const Unit&) const {}
};
__device__ __forceinline__ unsigned cvt_pk_bf16(float lo, float hi) { unsigned r; asm volatile("v_cvt_pk_bf16_f32 %0, %1, %2" : "=v"(r) : "v"(lo), "v"(hi)); return r; }

template <class Epi, class Sched, bool ALIGN_EPI = false, bool SP2 = false>
__device__ __forceinline__ void gemm_phase(PG8_LAS unsigned char* lds, const Gemm g, const Sched& S, const Epi& E) {
    int tid = threadIdx.x; asm volatile("" : "+v"(tid)); const int wid = __builtin_amdgcn_readfirstlane(tid >> 6), lane = tid & 63, wr = wid >> 2, wc = wid & 3, fr = lane & 15, fq = lane >> 4;
    const int K = g.K, nt = K / BK;
    unsigned voffA[2], voffB[2];
#pragma unroll
    for (int i = 0; i < 2; ++i) { int R, C; stage_rc(tid * 16 + i * 8192, R, C); const int Rb = Epi::PERM ? ((R & ~31) + perm32(R & 31)) : R;
        voffA[i] = (unsigned)(R * K + C) * 2u; voffB[i] = (unsigned)(Rb * K + C) * 2u; }
    const size_t kstep = (size_t)(BK * 2);
    const size_t hstep = (size_t)HALF * K * 2;
    const size_t tstep = 2 * hstep;
    const unsigned ldsw = (unsigned)wid * 1024u;
    const int aoff = lds_byte(wr * 64 + fr, fq * 8), boff = lds_byte(wc * 32 + fr, fq * 8);
#define PG8_SA(b, h) (((b) * 2 + (h)) * HTB)
#define PG8_SB(b, h) ((4 + (b) * 2 + (h)) * HTB)
#define PG8_STAGE(bufoff, gbase, voff) do { _Pragma("unroll") for (int _i = 0; _i < 2; ++_i) \
        __builtin_amdgcn_global_load_lds((const unsigned*)((const char*)(gbase) + (voff)[_i]), (PG8_LAS unsigned*)(lds + (bufoff) + ldsw + _i * 8192), 16, 0, 0); } while (0)
#define PG8_LDA(dst, b, h) do { _Pragma("unroll") for (int m = 0; m < 4; ++m) _Pragma("unroll") for (int k = 0; k < 2; ++k) dst[m][k] = *(const PG8_LAS bf16x8*)(lds + PG8_SA(b, h) + aoff + m * 2048 + k * 1024); } while (0)
#define PG8_LDB(dst, b, h) do { _Pragma("unroll") for (int n = 0; n < 2; ++n) _Pragma("unroll") for (int k = 0; k < 2; ++k) dst[n][k] = *(const PG8_LAS bf16x8*)(lds + PG8_SB(b, h) + boff + n * 2048 + k * 1024); } while (0)
#define PG8_MMA(ai, bj, At, Bt) do { __builtin_amdgcn_s_setprio(1); _Pragma("unroll") for (int m = 0; m < 4; ++m) _Pragma("unroll") for (int n = 0; n < 2; ++n) _Pragma("unroll") for (int k = 0; k < 2; ++k) \
        acc[ai][bj][m][n] = __builtin_amdgcn_mfma_f32_16x16x32_bf16(Bt[n][k], At[m][k], acc[ai][bj][m][n], 0, 0, 0); __builtin_amdgcn_s_setprio(0); } while (0)
#define PG8_WAIT_V(n) asm volatile("s_waitcnt vmcnt(" #n ")" ::: "memory")
#define PG8_WAIT_L(n) asm volatile("s_waitcnt lgkmcnt(" #n ")" ::: "memory")
#define PG8_BAR __builtin_amdgcn_s_barrier()
#define PG8_SCHED __builtin_amdgcn_sched_barrier(0)
    Unit cur, nxt; int ui = 0;
    if (!S.next(0, cur)) return;
    f32x4 acc[2][2][4][2];
#pragma unroll
    for (int a = 0; a < 2; ++a)
#pragma unroll
        for (int b = 0; b < 2; ++b)
#pragma unroll
            for (int m = 0; m < 4; ++m)
#pragma unroll
                for (int n = 0; n < 2; ++n) acc[a][b][m][n] = (f32x4){0.f, 0.f, 0.f, 0.f};
    bf16x8 At[4][2], B0[2][2], B1[2][2];
    const char* cA = (const char*)g.A + (size_t)cur.pm * tstep; const char* cB = (const char*)g.Bt + (size_t)cur.pn * tstep;
    S.a_ready(cur);
    if constexpr (SP2) {
        PG8_STAGE(PG8_SB(0, 0), cB, voffB); PG8_STAGE(PG8_SB(0, 1), cB + hstep, voffB); PG8_STAGE(PG8_SA(0, 0), cA, voffA); PG8_STAGE(PG8_SA(0, 1), cA + hstep, voffA);
        if (wr == 1) PG8_BAR;
        PG8_WAIT_V(2); PG8_BAR;
        PG8_STAGE(PG8_SB(1, 0), cB + kstep, voffB); PG8_STAGE(PG8_SA(1, 0), cA + kstep, voffA); PG8_STAGE(PG8_SB(1, 1), cB + hstep + kstep, voffB);
        PG8_WAIT_V(6); PG8_BAR;
    } else {
        PG8_STAGE(PG8_SB(0, 0), cB, voffB); PG8_STAGE(PG8_SA(0, 0), cA, voffA); PG8_STAGE(PG8_SB(0, 1), cB + hstep, voffB); PG8_STAGE(PG8_SA(0, 1), cA + hstep, voffA);
        if (wr == 1) PG8_BAR;
        PG8_WAIT_V(4); PG8_BAR;
        PG8_STAGE(PG8_SB(1, 0), cB + kstep, voffB); PG8_STAGE(PG8_SA(1, 0), cA + kstep, voffA); PG8_STAGE(PG8_SB(1, 1), cB + hstep + kstep, voffB);
        PG8_WAIT_V(6); PG8_BAR;
    }
    for (;;) {
        const bool has_next = S.next(ui + 1, nxt);
        const char* nA = has_next ? (const char*)g.A + (size_t)nxt.pm * tstep : cA; const char* nB = has_next ? (const char*)g.Bt + (size_t)nxt.pn * tstep : cB;
        for (int t = 0; t < nt; t += 2) {
            const bool last = (t == nt - 2);
            const char* a1 = cA + (size_t)(t + 1) * kstep;
            const char* a2 = last ? nA : cA + (size_t)(t + 2) * kstep; const char* b2 = last ? nB : cB + (size_t)(t + 2) * kstep;
            const char* a3 = a2 + kstep; const char* b3 = b2 + kstep;
            if (last && has_next) S.a_ready(nxt);
            if constexpr (Epi::KSPLIT) { if (t == nt / 2) E.midscale(acc, cur, wr, fr); }
            if constexpr (SP2) {
            PG8_LDB(B0, 0, 0); PG8_LDB(B1, 0, 1); PG8_SCHED; PG8_LDA(At, 0, 0); PG8_STAGE(PG8_SA(1, 1), a1 + hstep, voffA);
            PG8_WAIT_V(8); PG8_WAIT_L(0); PG8_BAR; PG8_MMA(0, 0, At, B0); PG8_MMA(0, 1, At, B1); PG8_BAR; PG8_SCHED;
            PG8_LDA(At, 0, 1); PG8_STAGE(PG8_SB(0, 0), b2, voffB); PG8_STAGE(PG8_SB(0, 1), b2 + hstep, voffB); PG8_STAGE(PG8_SA(0, 0), a2, voffA);
            PG8_WAIT_V(8); PG8_WAIT_L(0); PG8_BAR; PG8_MMA(1, 0, At, B0); PG8_MMA(1, 1, At, B1); PG8_BAR; PG8_SCHED;
            PG8_LDB(B0, 1, 0); PG8_LDB(B1, 1, 1); PG8_SCHED; PG8_LDA(At, 1, 0); PG8_STAGE(PG8_SA(0, 1), a2 + hstep, voffA);
            PG8_WAIT_V(8); PG8_WAIT_L(0); PG8_BAR; PG8_MMA(0, 0, At, B0); PG8_MMA(0, 1, At, B1); PG8_BAR; PG8_SCHED;
            PG8_LDA(At, 1, 1); PG8_STAGE(PG8_SB(1, 0), b3, voffB); PG8_STAGE(PG8_SB(1, 1), b3 + hstep, voffB); PG8_STAGE(PG8_SA(1, 0), a3, voffA);
            PG8_WAIT_V(8); PG8_WAIT_L(0); PG8_BAR; PG8_MMA(1, 0, At, B0); PG8_MMA(1, 1, At, B1); PG8_BAR; PG8_SCHED;
            } else {
            PG8_LDB(B0, 0, 0); PG8_SCHED; PG8_LDA(At, 0, 0); PG8_STAGE(PG8_SA(1, 1), a1 + hstep, voffA);
            PG8_WAIT_L(8); PG8_BAR; PG8_WAIT_L(0); PG8_MMA(0, 0, At, B0); PG8_BAR; PG8_SCHED;
            PG8_LDB(B1, 0, 1); PG8_STAGE(PG8_SB(0, 0), b2, voffB);
            PG8_BAR; PG8_WAIT_L(0); PG8_MMA(0, 1, At, B1); PG8_BAR;
            PG8_LDA(At, 0, 1); PG8_STAGE(PG8_SA(0, 0), a2, voffA);
            PG8_BAR; PG8_WAIT_L(0); PG8_MMA(1, 0, At, B0); PG8_BAR; PG8_SCHED;
            PG8_STAGE(PG8_SB(0, 1), b2 + hstep, voffB);
            PG8_WAIT_V(6); PG8_BAR; PG8_MMA(1, 1, At, B1); PG8_BAR;
            PG8_LDB(B0, 1, 0); PG8_SCHED; PG8_LDA(At, 1, 0); PG8_STAGE(PG8_SA(0, 1), a2 + hstep, voffA);
            PG8_WAIT_L(8); PG8_BAR; PG8_WAIT_L(0); PG8_MMA(0, 0, At, B0); PG8_BAR; PG8_SCHED;
            PG8_LDB(B1, 1, 1); PG8_STAGE(PG8_SB(1, 0), b3, voffB);
            PG8_BAR; PG8_WAIT_L(0); PG8_MMA(0, 1, At, B1); PG8_BAR;
            PG8_LDA(At, 1, 1); PG8_STAGE(PG8_SA(1, 0), a3, voffA);
            PG8_BAR; PG8_WAIT_L(0); PG8_MMA(1, 0, At, B0); PG8_BAR; PG8_SCHED;
            PG8_STAGE(PG8_SB(1, 1), b3 + hstep, voffB);
            PG8_WAIT_V(6); PG8_BAR; PG8_MMA(1, 1, At, B1); PG8_BAR;
            }
        }
        if constexpr (ALIGN_EPI) { if (wr == 0) PG8_BAR; }
        E(acc, cur, wr, wc, fr, fq); S.done(cur);
        if (!has_next) break;
#pragma unroll
        for (int a = 0; a < 2; ++a)
#pragma unroll
            for (int b = 0; b < 2; ++b)
#pragma unroll
                for (int m = 0; m < 4; ++m)
#pragma unroll
                    for (int n = 0; n < 2; ++n) acc[a][b][m][n] = (f32x4){0.f, 0.f, 0.f, 0.f};
        cur = nxt; cA = nA; cB = nB; ++ui;
        if constexpr (ALIGN_EPI) { if (wr == 1) PG8_BAR; }
    }
    PG8_WAIT_V(0);
    if constexpr (!ALIGN_EPI) { if (wr == 0) PG8_BAR; }
    PG8_BAR;
#undef PG8_SA
#undef PG8_SB
#undef PG8_STAGE
#undef PG8_LDA
#undef PG8_LDB
#undef PG8_MMA
#undef PG8_WAIT_V
#undef PG8_WAIT_L
#undef PG8_BAR
#undef PG8_SCHED
}
}

__device__ __forceinline__ unsigned f2bf(float f) { unsigned u = __builtin_bit_cast(unsigned, f); return (u + 0x7fffu + ((u >> 16) & 1u)) >> 16; }
__device__ __forceinline__ unsigned pk2(float lo, float hi) { return f2bf(lo) | (f2bf(hi) << 16); }
__device__ __forceinline__ float bflo(unsigned w) { return __builtin_bit_cast(float, w << 16); }
__device__ __forceinline__ float bfhi(unsigned w) { return __builtin_bit_cast(float, w & 0xffff0000u); }
__device__ __forceinline__ float fast_sigmoid(float t) { return __builtin_amdgcn_rcpf(1.0f + __builtin_amdgcn_exp2f(-1.44269504089f * t)); }
__device__ __forceinline__ float gelu_tanh(float x) { const float t = x * (1.5957691216f + 0.0713548163f * x * x); return x * fast_sigmoid(t); }
__device__ __forceinline__ float wave_sum(float v) {
#pragma unroll
    for (int o = 1; o < 64; o <<= 1) v += __shfl_xor(v, o);
    return v;
}
#define LDS_WAIT() asm volatile("s_waitcnt lgkmcnt(0)" ::: "memory")
#define VM_WAIT() asm volatile("s_waitcnt vmcnt(0)" ::: "memory")
#define RLX_AGENT __ATOMIC_RELAXED, __HIP_MEMORY_SCOPE_AGENT

constexpr size_t MiB = 1u << 20;
constexpr size_t WS_CTL = 0, CTL_ZERO_BYTES = 1 * MiB;
constexpr size_t WS_MOD   = 512 * 1024;
constexpr size_t WS_AT    = 1 * MiB + 128 * 1024;
constexpr size_t WS_STATS = WS_AT + 128 * 1024;
constexpr size_t WS_SCL   = 1 * MiB + 512 * 1024;
constexpr size_t WS_GS    = 1 * MiB + 768 * 1024;
constexpr size_t WS_C0    = WS_GS + 16 * 1024;
constexpr size_t WS_KEYS  = 2 * MiB;
constexpr size_t WS_GWS   = 3 * MiB;
constexpr size_t WS_WIN   = 4 * MiB;
constexpr size_t WS_GLU   = 28 * MiB;
constexpr size_t WS_WOUT  = 32 * MiB;
constexpr size_t WS_WQ    = 48 * MiB;
constexpr size_t WS_KTAB  = 64 * MiB;
constexpr size_t WS_WG    = 72 * MiB;
constexpr size_t WS_VG    = 104 * MiB;
constexpr size_t WS_UV    = 136 * MiB;
constexpr size_t WS_X     = 392 * MiB;
constexpr size_t WS_H     = 520 * MiB;
constexpr size_t WS_Z     = 584 * MiB;
constexpr size_t WS_XS    = 648 * MiB;
constexpr size_t WS_SLOC  = 680 * MiB;
constexpr size_t WS_PS    = 688 * MiB;
constexpr size_t WS_PSA   = 690 * MiB;
constexpr size_t WS_PSB   = 691 * MiB;
constexpr size_t WS_HS    = 692 * MiB;
constexpr size_t WS_G     = 696 * MiB;
constexpr size_t WS_MIX   = 728 * MiB;
constexpr size_t WS_EID   = 792 * MiB;
constexpr size_t WS_GATE  = 800 * MiB;
constexpr size_t WS_SU    = 808 * MiB;
constexpr size_t WS_END   = 816 * MiB;
constexpr size_t WS_DBG   = 816 * MiB;
constexpr int CW_BAR = 4096;
constexpr int CW_FLAG = 2048;
constexpr int CW_QUEUE = 16384;

constexpr int LDS_BYTES = 163840;
constexpr int MISC_OFF = LDS_BYTES - 256;

#define XB_TMO      128
#define XB_XCNT(j)  (256  + 64 * (j))
#define XB_XSUB(j)  (1280 + 64 * (j))
#define XB_XGEN(j)  (2304 + 64 * (j))
#define XB_TOP      3328
#define XB_TOPGEN   3392
#define XCD_BAR_WORDS 3456
#define XB_SPIN_CAP (1u << 24)
__device__ __forceinline__ unsigned xb_ld(unsigned* p)              { return __hip_atomic_load(p, __ATOMIC_RELAXED, __HIP_MEMORY_SCOPE_AGENT); }
__device__ __forceinline__ unsigned xb_add(unsigned* p, unsigned v) { return __hip_atomic_fetch_add(p, v, __ATOMIC_RELAXED, __HIP_MEMORY_SCOPE_AGENT); }
__device__ __forceinline__ unsigned xb_xcc_id() { return (unsigned)__builtin_amdgcn_s_getreg((3 << 11) | 20) & 0xFu; }
#define XB_SPIN(cond, bar) do { unsigned _sp = 0; while (cond) { __builtin_amdgcn_s_sleep(1); \
    if ((++_sp & 255u) == 0u) { if (xb_ld(&(bar)[XB_TMO])) break; if (_sp > XB_SPIN_CAP) { atomicAdd(&(bar)[XB_TMO], 1u); break; } } } } while (0)
struct XcdBarrier { unsigned* bar; unsigned x; volatile LAS unsigned* st; };
__device__ __forceinline__ XcdBarrier xcd_barrier_post(unsigned* bar, volatile LAS unsigned* st) {
    XcdBarrier b; b.bar = bar; b.x = xb_xcc_id(); b.st = st;
    if (threadIdx.x == 0) (void)xb_add(&bar[XB_XCNT(b.x)], 1u);
    return b;
}
__device__ __forceinline__ void xcd_barrier_complete(unsigned* bar, unsigned x, unsigned& nloc, unsigned& nx) {
    const unsigned G = gridDim.x * gridDim.y * gridDim.z;
    unsigned sum, cnt, mine, sp = 0u;
    for (;;) {
        sum = 0u; cnt = 0u; mine = 0u;
#pragma unroll
        for (unsigned j = 0; j < 16; ++j) { const unsigned c = xb_ld(&bar[XB_XCNT(j)]); sum += c; cnt += (c > 0u) ? 1u : 0u; mine = (j == x) ? c : mine; }
        if (sum == G) break;
        __builtin_amdgcn_s_sleep(1);
        if ((++sp & 255u) == 0u) { if (xb_ld(&bar[XB_TMO])) break; if (sp > XB_SPIN_CAP) { atomicAdd(&bar[XB_TMO], 1u); break; } }
    }
    nloc = mine > 0u ? mine : 1u; nx = cnt > 0u ? cnt : 1u;
}
__device__ __forceinline__ void xcd_barrier(const XcdBarrier& b) {
    asm volatile("s_waitcnt vmcnt(0)" ::: "memory");
    __syncthreads();
    if (threadIdx.x == 0) {
        unsigned* bar = b.bar;
        __builtin_amdgcn_s_waitcnt(0);
        unsigned nloc = b.st[0], nx = b.st[1];
        if (nloc == 0u) { xcd_barrier_complete(bar, b.x, nloc, nx); b.st[0] = nloc; b.st[1] = nx; }
        const unsigned old = xb_add(&bar[XB_XSUB(b.x)], 1u);
        const unsigned gen = old / nloc;
        if (old + 1u == (gen + 1u) * nloc) {
            __builtin_amdgcn_fence(__ATOMIC_RELEASE, "agent");
            asm volatile("s_waitcnt vmcnt(0)" ::: "memory");
            const unsigned og = xb_add(&bar[XB_TOP], 1u);
            const unsigned tg = og / nx;
            if (og + 1u == (tg + 1u) * nx) xb_add(&bar[XB_TOPGEN], 1u);
            else XB_SPIN(xb_ld(&bar[XB_TOPGEN]) == tg, bar);
            __builtin_amdgcn_fence(__ATOMIC_ACQUIRE, "agent");
            xb_add(&bar[XB_XGEN(b.x)], 1u);
            asm volatile("s_waitcnt vmcnt(0)" ::: "memory");
        } else {
            XB_SPIN(xb_ld(&bar[XB_XGEN(b.x)]) == gen, bar);
            __builtin_amdgcn_fence(__ATOMIC_ACQUIRE, "agent");
            asm volatile("s_waitcnt vmcnt(0)" ::: "memory");
        }
    }
    __syncthreads();
}

struct Args { const float* in[29]; float* out; unsigned char* ws; int ph_lo, ph_hi, li, pad; };
enum { I_X = 0, I_C, I_WMOD, I_BMOD, I_N1G, I_WIN, I_BIN, I_LNG, I_LNB, I_GWS, I_GBS, I_LRE, I_LIM, I_LDT, I_BRE, I_BIM, I_CRE, I_CIM, I_SD, I_GLUW, I_GLUB,
       I_BRG, I_WOUT, I_N2G, I_WQ, I_KEYS, I_PU, I_PV, I_FG };

struct Frame {
    LAS unsigned char* lds;
    unsigned char* ws;
    const float* const* in;
    float* out;
    int tid, lane, wave, vcu, G;
};

#define PH_LOCALS int tid = F.tid; asm volatile("" : "+v"(tid)); const int lane = tid & 63; const int wave = __builtin_amdgcn_readfirstlane(tid >> 6); (void)lane; (void)wave;

struct EpiIn {
    static constexpr bool PERM = true, AFTER_DRAIN = false, KSPLIT = false;
    bf16* Z; bf16* XS; const float* bias;
    __device__ __forceinline__ void operator()(const f32x4 (&acc)[2][2][4][2], const pg8::Unit& u, int wr, int wc, int fr, int fq) const {
        const int row0 = u.pm * 256 + wr * 64 + fr, col0 = u.pn * 256 + wc * 32 + 8 * fq;
        f32x4 bv[2][2];
#pragma unroll
        for (int bj = 0; bj < 2; ++bj)
#pragma unroll
            for (int n = 0; n < 2; ++n) bv[bj][n] = *(const f32x4*)(bias + col0 + bj * 128 + 4 * n);
        const bool isz = (u.pn < 8);
#pragma unroll
        for (int ai = 0; ai < 2; ++ai)
#pragma unroll
            for (int m = 0; m < 4; ++m) {
                const int r = row0 + ai * 128 + m * 16;
#pragma unroll
                for (int bj = 0; bj < 2; ++bj) {
                    f32x4 v0 = acc[ai][bj][m][0] + bv[bj][0], v1 = acc[ai][bj][m][1] + bv[bj][1];
                    const int c = col0 + bj * 128;
                    u32x4 w;
                    if (isz) {
                        w.x = pg8::cvt_pk_bf16(gelu_tanh(v0[0]), gelu_tanh(v0[1])); w.y = pg8::cvt_pk_bf16(gelu_tanh(v0[2]), gelu_tanh(v0[3]));
                        w.z = pg8::cvt_pk_bf16(gelu_tanh(v1[0]), gelu_tanh(v1[1])); w.w = pg8::cvt_pk_bf16(gelu_tanh(v1[2]), gelu_tanh(v1[3]));
                        *(u32x4*)(Z + (size_t)r * 2048 + c) = w;
                    } else {
                        w.x = pg8::cvt_pk_bf16(v0[0], v0[1]); w.y = pg8::cvt_pk_bf16(v0[2], v0[3]); w.z = pg8::cvt_pk_bf16(v1[0], v1[1]); w.w = pg8::cvt_pk_bf16(v1[2], v1[3]);
                        const int cc = c - 2048, g = cc >> 4, i = cc & 15;
                        *(u32x4*)(XS + ((size_t)(g * 256 + (r >> 6)) * 64 + (r & 63)) * 16 + i) = w;
                    }
                }
            }
    }
};
struct EpiGlu {
    static constexpr bool PERM = true, AFTER_DRAIN = false, KSPLIT = false;
    const bf16* Gb; bf16* MIX; const float* bias; float* PSB;
    __device__ __forceinline__ void operator()(const f32x4 (&acc)[2][2][4][2], const pg8::Unit& u, int wr, int wc, int fr, int fq) const {
        const int row0 = u.pm * 256 + wr * 64 + fr, col0 = u.pn * 256 + wc * 32 + 8 * fq;
        f32x4 bv[2][2];
#pragma unroll
        for (int bj = 0; bj < 2; ++bj)
#pragma unroll
            for (int n = 0; n < 2; ++n) bv[bj][n] = *(const f32x4*)(bias + col0 + bj * 128 + 4 * n);
#pragma unroll
        for (int ai = 0; ai < 2; ++ai)
#pragma unroll
            for (int m = 0; m < 4; ++m) {
                const int r = row0 + ai * 128 + m * 16; float ssq = 0.f;
#pragma unroll
                for (int bj = 0; bj < 2; ++bj) {
                    const f32x4 v0 = acc[ai][bj][m][0] + bv[bj][0], v1 = acc[ai][bj][m][1] + bv[bj][1];
                    const int c = col0 + bj * 128;
                    const u32x4 gw = *(const u32x4*)(Gb + (size_t)r * 1024 + c);
                    const float o0 = bflo(gw.x) * fast_sigmoid(v0[0]), o1 = bfhi(gw.x) * fast_sigmoid(v0[1]), o2 = bflo(gw.y) * fast_sigmoid(v0[2]), o3 = bfhi(gw.y) * fast_sigmoid(v0[3]);
                    const float o4 = bflo(gw.z) * fast_sigmoid(v1[0]), o5 = bfhi(gw.z) * fast_sigmoid(v1[1]), o6 = bflo(gw.w) * fast_sigmoid(v1[2]), o7 = bfhi(gw.w) * fast_sigmoid(v1[3]);
                    u32x4 w; w.x = pg8::cvt_pk_bf16(o0, o1); w.y = pg8::cvt_pk_bf16(o2, o3); w.z = pg8::cvt_pk_bf16(o4, o5); w.w = pg8::cvt_pk_bf16(o6, o7);
                    *(u32x4*)(MIX + (size_t)r * 2048 + 1024 + c) = w;
                    ssq += (o0 * o0 + o1 * o1) + (o2 * o2 + o3 * o3) + (o4 * o4 + o5 * o5) + (o6 * o6 + o7 * o7);
                }
                ssq += __shfl_xor(ssq, 16); ssq += __shfl_xor(ssq, 32);
                if (fq == 0) PSB[(size_t)r * 16 + u.pn * 4 + wc] = ssq;
            }
    }
};
template <bool XIN_BF16> struct EpiOut {
    static constexpr bool PERM = true, AFTER_DRAIN = false, KSPLIT = true;
    const void* xin; bf16* X; const float* gate; float* PS; const LAS float* ratL; const LAS float* rbL; int pm0;
    __device__ __forceinline__ void midscale(f32x4 (&acc)[2][2][4][2], const pg8::Unit& u, int wr, int fr) const {
        const LAS float* rp = ratL + (u.pm == pm0 ? 0 : 256) + wr * 64 + fr;
#pragma unroll
        for (int ai = 0; ai < 2; ++ai)
#pragma unroll
            for (int m = 0; m < 4; ++m) { const float rt = rp[ai * 128 + m * 16];
#pragma unroll
                for (int bj = 0; bj < 2; ++bj)
#pragma unroll
                    for (int n = 0; n < 2; ++n) acc[ai][bj][m][n] = acc[ai][bj][m][n] * rt; }
    }
    __device__ __forceinline__ void operator()(const f32x4 (&acc)[2][2][4][2], const pg8::Unit& u, int wr, int wc, int fr, int fq) const {
        const int row0 = u.pm * 256 + wr * 64 + fr, col0 = u.pn * 256 + wc * 32 + 8 * fq;
        const LAS float* rbp = rbL + (u.pm == pm0 ? 0 : 256) + wr * 64 + fr;
        f32x4 gv[2][2];
#pragma unroll
        for (int bj = 0; bj < 2; ++bj)
#pragma unroll
            for (int n = 0; n < 2; ++n) gv[bj][n] = *(const f32x4*)(gate + col0 + bj * 128 + 4 * n);
#pragma unroll
        for (int ai = 0; ai < 2; ++ai)
#pragma unroll
            for (int m = 0; m < 4; ++m) {
                const int r = row0 + ai * 128 + m * 16; float ssq = 0.f; const float rb = rbp[ai * 128 + m * 16];
#pragma unroll
                for (int bj = 0; bj < 2; ++bj) {
                    const size_t off = (size_t)r * 2048 + col0 + bj * 128;
                    f32x4 x0, x1;
                    if (XIN_BF16) { const u32x4 w = *(const u32x4*)((const bf16*)xin + off); x0 = (f32x4){bflo(w.x), bfhi(w.x), bflo(w.y), bfhi(w.y)}; x1 = (f32x4){bflo(w.z), bfhi(w.z), bflo(w.w), bfhi(w.w)}; }
                    else { x0 = *(const f32x4*)((const float*)xin + off); x1 = *(const f32x4*)((const float*)xin + off + 4); }
                    const f32x4 y0 = x0 + gv[bj][0] * (acc[ai][bj][m][0] * rb), y1 = x1 + gv[bj][1] * (acc[ai][bj][m][1] * rb);
                    u32x4 o; o.x = pg8::cvt_pk_bf16(y0[0], y0[1]); o.y = pg8::cvt_pk_bf16(y0[2], y0[3]); o.z = pg8::cvt_pk_bf16(y1[0], y1[1]); o.w = pg8::cvt_pk_bf16(y1[2], y1[3]);
                    *(u32x4*)(X + off) = o;
                    ssq += (y0[0] * y0[0] + y0[1] * y0[1]) + (y0[2] * y0[2] + y0[3] * y0[3]) + (y1[0] * y1[0] + y1[1] * y1[1]) + (y1[2] * y1[2] + y1[3] * y1[3]);
                }
                ssq += __shfl_xor(ssq, 16); ssq += __shfl_xor(ssq, 32);
                if (fq == 0) PS[(size_t)r * 32 + u.pn * 4 + wc] = ssq;
            }
    }
};
struct EpiQ {
    static constexpr bool PERM = true, AFTER_DRAIN = false, KSPLIT = false;
    bf16* Q; const float* c0; const LAS float* rrL; int pm0;
    __device__ __forceinline__ void operator()(const f32x4 (&acc)[2][2][4][2], const pg8::Unit& u, int wr, int wc, int fr, int fq) const {
        const int row0 = u.pm * 256 + wr * 64 + fr, col0 = u.pn * 256 + wc * 32 + 8 * fq;
        const LAS float* rrp = rrL + (u.pm == pm0 ? 0 : 256) + wr * 64 + fr;
        f32x4 cv[2][2];
#pragma unroll
        for (int bj = 0; bj < 2; ++bj)
#pragma unroll
            for (int n = 0; n < 2; ++n) cv[bj][n] = *(const f32x4*)(c0 + col0 + bj * 128 + 4 * n);
#pragma unroll
        for (int ai = 0; ai < 2; ++ai)
#pragma unroll
            for (int m = 0; m < 4; ++m) {
                const int r = row0 + ai * 128 + m * 16; const float rr = rrp[ai * 128 + m * 16];
#pragma unroll
                for (int bj = 0; bj < 2; ++bj) {
                    const f32x4 v0 = acc[ai][bj][m][0] * rr + cv[bj][0], v1 = acc[ai][bj][m][1] * rr + cv[bj][1];
                    u32x4 w; w.x = pg8::cvt_pk_bf16(v0[0], v0[1]); w.y = pg8::cvt_pk_bf16(v0[2], v0[3]); w.z = pg8::cvt_pk_bf16(v1[0], v1[1]); w.w = pg8::cvt_pk_bf16(v1[2], v1[3]);
                    *(u32x4*)(Q + (size_t)r * 2048 + col0 + bj * 128) = w;
                }
            }
    }
};
__device__ __forceinline__ void fill_rr(Frame& F, LAS float* rrL, int slot, int pm, int tid) {
    if (tid < 256) { const float* ps = (const float*)(F.ws + WS_PS) + ((size_t)pm * 256 + tid) * 32; float s = 0.f;
#pragma unroll
        for (int i = 0; i < 8; ++i) { const f32x4 v = *(const f32x4*)(ps + 4 * i); s += (v[0] + v[1]) + (v[2] + v[3]); }
        rrL[slot * 256 + tid] = 1.0f / sqrtf(s * (1.0f / DM) + EPS); }
}

__device__ __forceinline__ void p0_transpose_item(const float* W, int K, int N, bf16* WT, const float* kscale, LAS float* scr, int item, int lane, const float* kscale2 = nullptr) {
    const int nblk = N / 32, kb = item / nblk, nb = item % nblk, k0 = 64 * kb, n0 = 32 * nb;
    float wv[32];
#pragma unroll
    for (int i = 0; i < 32; ++i) wv[i] = W[(size_t)(k0 + 2 * i + (lane >> 5)) * N + n0 + (lane & 31)];
#pragma unroll
    for (int i = 0; i < 32; ++i) { const int kk = 2 * i + (lane >> 5); float v = wv[i]; if (kscale) { v *= kscale[k0 + kk]; if (kscale2) v *= 1.0f + kscale2[k0 + kk]; } scr[kk * 33 + (lane & 31)] = v; }
    LDS_WAIT(); asm volatile("" ::: "memory");
    const int c = lane & 7;
#pragma unroll
    for (int j = 0; j < 4; ++j) { const int n = (lane >> 3) + 8 * j; const LAS float* s = scr + (8 * c) * 33 + n;
        u32x4 o; o.x = pk2(s[0 * 33], s[1 * 33]); o.y = pk2(s[2 * 33], s[3 * 33]); o.z = pk2(s[4 * 33], s[5 * 33]); o.w = pk2(s[6 * 33], s[7 * 33]);
        *(u32x4*)(WT + (size_t)(n0 + n) * K + k0 + 8 * c) = o; }
    LDS_WAIT(); asm volatile("" ::: "memory");
}

__device__ __forceinline__ void norm_mod_row(const f32x4 (&v)[4][2], const float* gain, const float* scale, const float* shift, int lane, u32x4 (&o)[4]) {
    float s = 0.f;
#pragma unroll
    for (int j = 0; j < 4; ++j)
#pragma unroll
        for (int h = 0; h < 2; ++h) s += (v[j][h][0] * v[j][h][0] + v[j][h][1] * v[j][h][1]) + (v[j][h][2] * v[j][h][2] + v[j][h][3] * v[j][h][3]);
    const float rr = 1.0f / sqrtf(wave_sum(s) * (1.0f / DM) + EPS);
#pragma unroll
    for (int j = 0; j < 4; ++j) {
        const int c = j * 512 + lane * 8;
        f32x4 y[2];
#pragma unroll
        for (int h = 0; h < 2; ++h) {
            const f32x4 g = *(const f32x4*)(gain + c + 4 * h);
            y[h] = v[j][h] * rr * g;
            const f32x4 sc = *(const f32x4*)(scale + c + 4 * h), sh = *(const f32x4*)(shift + c + 4 * h); y[h] = y[h] * (sc + 1.0f) + sh;
        }
        o[j].x = pk2(y[0][0], y[0][1]); o[j].y = pk2(y[0][2], y[0][3]); o[j].z = pk2(y[1][0], y[1][1]); o[j].w = pk2(y[1][2], y[1][3]);
    }
}
template <bool SRC_BF16>
__device__ __forceinline__ void load_row(const void* xrow_, int lane, f32x4 (&v)[4][2]) {
#pragma unroll
    for (int j = 0; j < 4; ++j) {
        if (SRC_BF16) { const u32x4 w = *(const u32x4*)((const bf16*)xrow_ + j * 512 + lane * 8); v[j][0] = (f32x4){bflo(w.x), bfhi(w.x), bflo(w.y), bfhi(w.y)}; v[j][1] = (f32x4){bflo(w.z), bfhi(w.z), bflo(w.w), bfhi(w.w)}; }
        else { const float* xrow = (const float*)xrow_; v[j][0] = *(const f32x4*)(xrow + j * 512 + lane * 8); v[j][1] = *(const f32x4*)(xrow + j * 512 + lane * 8 + 4); } }
}

__device__ __forceinline__ void p0_gemv_unit(Frame& F, int unit, int tid, float* modout) {
    const int l = unit / 192, r = unit % 192, cb = r >> 1, kh = r & 1;
    LAS float* sc = (LAS float*)F.lds;
    LAS float* red = (LAS float*)(F.lds + 4096);
    for (int k = tid; k < 1024; k += NTHR) { const float c = F.in[I_C][kh * 1024 + k]; sc[k] = c * fast_sigmoid(c); }
    __syncthreads();
    const int tx = tid & 31, ty = tid >> 5;
    const float* W = F.in[I_WMOD] + ((size_t)l * DM + kh * 1024) * 12288 + cb * 128 + tx * 4;
    f32x4 a = {0.f, 0.f, 0.f, 0.f};
#pragma unroll 16
    for (int k = ty; k < 1024; k += 16) { const f32x4 w = *(const f32x4*)(W + (size_t)k * 12288); a += w * sc[k]; }
    *(LAS f32x4*)(red + ty * 128 + tx * 4) = a;
    __syncthreads();
    if (tid < 128) { float s = 0.f;
#pragma unroll
        for (int y = 0; y < 16; ++y) s += red[y * 128 + tid];
        if (kh == 0) s += F.in[I_BMOD][l * 12288 + cb * 128 + tid];
        atomicAdd(modout + l * 12288 + cb * 128 + tid, s); }
    __syncthreads();
}
__device__ __forceinline__ void p0_s5_unit(Frame& F, int unit, int tid, int parts = 15) {
    const int l = unit >> 7, g = (unit >> 1) & 63, hf = unit & 1;
    LAS float* apr = (LAS float*)F.lds;
    LAS float* api = apr + 4228;
    LAS float* bbr = api + 4228;
    LAS float* bbi = bbr + 1024;
    LAS float* ccr = bbi + 1024;
    LAS float* cci = ccr + 16 * 65;
    const float dt = expf(F.in[I_LDT][l * 64 + g]);
    const float* lre = F.in[I_LRE] + (l * 64 + g) * 64; const float* lim = F.in[I_LIM] + (l * 64 + g) * 64;
    for (int idx = tid; idx < 65 * 64; idx += NTHR) { const int d = idx >> 6, p = idx & 63;
        const float mag = expf(lre[p] * dt * (float)d); float sn, cs; sincosf(lim[p] * dt * (float)d, &sn, &cs);
        apr[d * 65 + p] = mag * cs; api[d * 65 + p] = mag * sn; }
    for (int idx = tid; idx < 1024; idx += NTHR) { const int o = idx >> 6, p = idx & 63;
        ccr[o * 65 + p] = F.in[I_CRE][((size_t)(l * 64 + g) * 16 + o) * 64 + p]; cci[o * 65 + p] = F.in[I_CIM][((size_t)(l * 64 + g) * 16 + o) * 64 + p]; }
    __syncthreads();
    for (int idx = tid; idx < 1024; idx += NTHR) { const int p = idx >> 4, i = idx & 15;
        const float xr = apr[65 + p] - 1.0f, xi = api[65 + p], lr = lre[p], li = lim[p], den = 1.0f / (lr * lr + li * li);
        const float cr = (xr * lr + xi * li) * den, ci = (xi * lr - xr * li) * den;
        const float br = F.in[I_BRE][((size_t)(l * 64 + g) * 64 + p) * 16 + i], bi = F.in[I_BIM][((size_t)(l * 64 + g) * 64 + p) * 16 + i];
        bbr[idx] = cr * br - ci * bi; bbi[idx] = cr * bi + ci * br; }
    __syncthreads();
    bf16* KT = (bf16*)(F.ws + WS_KTAB) + (size_t)(l * 64 + g) * 80 * 256;
    if (parts & 1) {
        const int d = hf * 32 + (tid >> 4), o = tid & 15;
        const float dskip = F.in[I_SD][l * 1024 + g * 16 + o];
        float s[16];
#pragma unroll
        for (int i = 0; i < 16; ++i) s[i] = 0.f;
        for (int p = 0; p < 64; ++p) { const float ar = apr[d * 65 + p], ai = api[d * 65 + p], cr = ccr[o * 65 + p], ci = cci[o * 65 + p];
            const float er = cr * ar - ci * ai, ei = cr * ai + ci * ar;
#pragma unroll
            for (int q = 0; q < 4; ++q) { const f32x4 br = *(const LAS f32x4*)(bbr + p * 16 + 4 * q), bi = *(const LAS f32x4*)(bbi + p * 16 + 4 * q);
#pragma unroll
                for (int e = 0; e < 4; ++e) s[4 * q + e] += er * br[e] - ei * bi[e]; } }
#if !SELFTEST_S5
        {   const float dsk = (d == 0) ? dskip : 0.f;
#pragma unroll
            for (int i = 0; i < 16; ++i) s[i] += (i == o) ? dsk : 0.f; }
#endif
        u32x4 w0, w1;
        w0.x = pk2(s[0], s[1]); w0.y = pk2(s[2], s[3]); w0.z = pk2(s[4], s[5]); w0.w = pk2(s[6], s[7]);
        w1.x = pk2(s[8], s[9]); w1.y = pk2(s[10], s[11]); w1.z = pk2(s[12], s[13]); w1.w = pk2(s[14], s[15]);
        if ((parts & 8) || w0.x == 0x12345678u) { *(u32x4*)(KT + (size_t)(d + 16) * 256 + o * 16) = w0; *(u32x4*)(KT + (size_t)(d + 16) * 256 + o * 16 + 8) = w1; }
        if ((parts & 8) && hf == 0 && tid < 256) { const u32x4 z = {0u, 0u, 0u, 0u}; *(u32x4*)(KT + tid * 16) = z; *(u32x4*)(KT + tid * 16 + 8) = z; }
    }
    bf16* WG = (bf16*)(F.ws + WS_WG) + (size_t)(l * 64 + g) * 128 * 1024;
    if (parts & 2) for (int it = tid; it < 32 * 64; it += NTHR) { const int p = hf * 32 + (it >> 6), tau = it & 63;
        const float ar = apr[(63 - tau) * 65 + p], ai = api[(63 - tau) * 65 + p];
        unsigned wr_[8], wi_[8];
#pragma unroll
        for (int q = 0; q < 4; ++q) { const f32x4 br = *(const LAS f32x4*)(bbr + p * 16 + 4 * q), bi = *(const LAS f32x4*)(bbi + p * 16 + 4 * q);
            wr_[2 * q] = pk2(ar * br[0] - ai * bi[0], ar * br[1] - ai * bi[1]); wr_[2 * q + 1] = pk2(ar * br[2] - ai * bi[2], ar * br[3] - ai * bi[3]);
            wi_[2 * q] = pk2(ar * bi[0] + ai * br[0], ar * bi[1] + ai * br[1]); wi_[2 * q + 1] = pk2(ar * bi[2] + ai * br[2], ar * bi[3] + ai * br[3]); }
        *(u32x4*)(WG + (size_t)p * 1024 + tau * 16) = (u32x4){wr_[0], wr_[1], wr_[2], wr_[3]}; *(u32x4*)(WG + (size_t)p * 1024 + tau * 16 + 8) = (u32x4){wr_[4], wr_[5], wr_[6], wr_[7]};
        *(u32x4*)(WG + (size_t)(64 + p) * 1024 + tau * 16) = (u32x4){wi_[0], wi_[1], wi_[2], wi_[3]}; *(u32x4*)(WG + (size_t)(64 + p) * 1024 + tau * 16 + 8) = (u32x4){wi_[4], wi_[5], wi_[6], wi_[7]}; }
    bf16* VG = (bf16*)(F.ws + WS_VG) + (size_t)(l * 64 + g) * 1024 * 128;
    if (parts & 4) for (int it = tid; it < 512 * 8; it += NTHR) { const int m = hf * 512 + (it >> 3), p0 = (it & 7) * 8, t = m >> 4, o = m & 15;
        float vr_[8], vi_[8];
#pragma unroll
        for (int e = 0; e < 8; ++e) { const float ar = apr[(t + 1) * 65 + p0 + e], ai = api[(t + 1) * 65 + p0 + e], cr = ccr[o * 65 + p0 + e], ci = cci[o * 65 + p0 + e];
            vr_[e] = cr * ar - ci * ai; vi_[e] = -(cr * ai + ci * ar); }
        *(u32x4*)(VG + (size_t)m * 128 + p0) = (u32x4){pk2(vr_[0], vr_[1]), pk2(vr_[2], vr_[3]), pk2(vr_[4], vr_[5]), pk2(vr_[6], vr_[7])};
        *(u32x4*)(VG + (size_t)m * 128 + 64 + p0) = (u32x4){pk2(vi_[0], vi_[1]), pk2(vi_[2], vi_[3]), pk2(vi_[4], vi_[5]), pk2(vi_[6], vi_[7])}; }
    if (hf == 0 && tid < 64) { float* AT = (float*)(F.ws + WS_AT) + ((size_t)(l * 64 + g) * 64 + tid) * 2; AT[0] = apr[64 * 65 + tid]; AT[1] = api[64 * 65 + tid]; }
    __syncthreads();
}
__device__ __forceinline__ void p0_fp4_chunk(Frame& F, int chunk, int wave, int lane) {
    unsigned char* UV = F.ws + WS_UV; float* SCL = (float*)(F.ws + WS_SCL);
    for (int i = 0; i < 8; i += 2) {
        f32x4 v[2][8]; float am[2] = {0.f, 0.f}; int tbl[2], rr[2];
#pragma unroll
        for (int r2 = 0; r2 < 2; ++r2) {
            const int r = chunk * 64 + wave * 8 + i + r2; tbl[r2] = r >> 15; rr[r2] = r & 32767;
            const float* srcp = (tbl[r2] ? F.in[I_PV] : F.in[I_PU]) + (size_t)rr[r2] * 2048 + lane * 4;
#pragma unroll
            for (int j = 0; j < 8; ++j) v[r2][j] = *(const f32x4*)(srcp + j * 256);
        }
#pragma unroll
        for (int r2 = 0; r2 < 2; ++r2)
#pragma unroll
            for (int j = 0; j < 8; ++j) am[r2] = fmaxf(am[r2], fmaxf(fmaxf(fabsf(v[r2][j][0]), fabsf(v[r2][j][1])), fmaxf(fabsf(v[r2][j][2]), fabsf(v[r2][j][3]))));
#pragma unroll
        for (int o = 1; o < 64; o <<= 1) { am[0] = fmaxf(am[0], __shfl_xor(am[0], o)); am[1] = fmaxf(am[1], __shfl_xor(am[1], o)); }
#pragma unroll
        for (int r2 = 0; r2 < 2; ++r2) {
            const float scale = am[r2] > 0.f ? am[r2] * (1.0f / 6.0f) : 1.0f, inv = am[r2] > 0.f ? 6.0f / am[r2] : 1.0f;
            u32x4 o;
#pragma unroll
            for (int d = 0; d < 4; ++d) { unsigned w = 0u;
                w = __builtin_amdgcn_cvt_scalef32_pk_fp4_f32(w, v[r2][2 * d][0] * inv, v[r2][2 * d][1] * inv, 1.0f, 0);
                w = __builtin_amdgcn_cvt_scalef32_pk_fp4_f32(w, v[r2][2 * d][2] * inv, v[r2][2 * d][3] * inv, 1.0f, 1);
                w = __builtin_amdgcn_cvt_scalef32_pk_fp4_f32(w, v[r2][2 * d + 1][0] * inv, v[r2][2 * d + 1][1] * inv, 1.0f, 2);
                w = __builtin_amdgcn_cvt_scalef32_pk_fp4_f32(w, v[r2][2 * d + 1][2] * inv, v[r2][2 * d + 1][3] * inv, 1.0f, 3);
                o[d] = w; }
            *(u32x4*)(UV + (size_t)rr[r2] * 2048 + tbl[r2] * 1024 + lane * 16) = o;
            if (lane == 0) SCL[rr[r2] * 2 + tbl[r2]] = scale;
        }
    }
}
#ifndef P0_PARTS
#define P0_PARTS 15
#endif
#ifndef P0_PROBE_MODE
#define P0_PROBE_MODE 0
#endif
__device__ __forceinline__ void p0_tables(Frame& F, int qi = 4, bool dummy = false) {
    PH_LOCALS
    unsigned* head = (unsigned*)(F.ws + WS_CTL) + CW_QUEUE + 64 * qi;
    float* modout = dummy ? (float*)(F.ws + WS_DBG) : (float*)(F.ws + WS_MOD);
    LAS unsigned* slot = (LAS unsigned*)(F.lds + MISC_OFF) + 16;
    for (;;) {
        __syncthreads();
        if (tid == 0) slot[0] = __hip_atomic_fetch_add(head, 1u, RLX_AGENT);
        __syncthreads();
        const unsigned u = slot[0];
        if (u >= 1664u) break;
        const int rnd = (int)u / 13, k = (int)u % 13;
        if (k < 2) { if (dummy && P0_PROBE_MODE == 2) continue; p0_s5_unit(F, rnd * 2 + k, tid, dummy ? P0_PARTS : 15); }
        else if (k < 5) { if (dummy && P0_PROBE_MODE == 1) continue; p0_gemv_unit(F, rnd * 3 + (k - 2), tid, modout); }
        else { p0_fp4_chunk(F, rnd * 8 + (k - 5), wave, lane); }
    }
}
__device__ __forceinline__ void p0_prologue(Frame& F) {
    PH_LOCALS
    const int gw = F.vcu * NWAVES + wave, NGW = F.G * NWAVES;
    const int gt = F.vcu * NTHR + tid, NGT = F.G * NTHR;
    const float* modp = (const float*)(F.ws + WS_MOD);
    for (int i = gt; i < 2 * DM; i += NGT) { const int l = i >> 11, k = i & 2047; ((float*)(F.ws + WS_GS))[i] = F.in[I_N2G][i] * (1.0f + modp[l * 12288 + 4 * 2048 + k]); }
    if (F.vcu < 64) {
        const int l = F.vcu >> 5, cb = F.vcu & 31, tx = tid & 15, ty = tid >> 4;
        const float* W = F.in[I_WQ] + (size_t)l * DM * DM + cb * 64 + tx * 4; const float* sh = modp + l * 12288 + 3 * 2048;
        f32x4 a = {0.f, 0.f, 0.f, 0.f};
#pragma unroll 16
        for (int k = ty; k < DM; k += 32) { const f32x4 w = *(const f32x4*)(W + (size_t)k * DM); a += w * sh[k]; }
        LAS float* red = (LAS float*)F.lds;
        *(LAS f32x4*)(red + ty * 64 + tx * 4) = a;
        __syncthreads();
        if (tid < 64) { float s = 0.f;
#pragma unroll
            for (int y = 0; y < 32; ++y) s += red[y * 64 + tid];
            ((float*)(F.ws + WS_C0))[l * DM + cb * 64 + tid] = s; }
        __syncthreads();
    }
    {
        LAS float* scr = (LAS float*)(F.lds + wave * 16384);
        constexpr int I_IN = (DM / 64) * (INW / 32), I_GL = (WB / 64) * (WB / 32), I_OU = (DM / 64) * (DM / 32), I_Q = I_OU;
        constexpr int PER_L = I_IN + I_GL + I_OU + I_Q;
        for (int it = gw; it < 2 * PER_L; it += NGW) {
            const int l = it / PER_L; int r = it % PER_L;
            if (r < I_IN) { p0_transpose_item(F.in[I_WIN] + (size_t)l * DM * INW, DM, INW, (bf16*)(F.ws + WS_WIN) + (size_t)l * INW * DM, nullptr, scr, r, lane); continue; } r -= I_IN;
            if (r < I_GL) { p0_transpose_item(F.in[I_GLUW] + (size_t)l * WB * WB, WB, WB, (bf16*)(F.ws + WS_GLU) + (size_t)l * WB * WB, nullptr, scr, r, lane); continue; } r -= I_GL;
            if (r < I_OU) { p0_transpose_item(F.in[I_WOUT] + (size_t)l * DM * DM, DM, DM, (bf16*)(F.ws + WS_WOUT) + (size_t)l * DM * DM, F.in[I_BRG] + l * DM, scr, r, lane); continue; } r -= I_OU;
            p0_transpose_item(F.in[I_WQ] + (size_t)l * DM * DM, DM, DM, (bf16*)(F.ws + WS_WQ) + (size_t)l * DM * DM, F.in[I_N2G] + l * DM, scr, r, lane, modp + l * 12288 + 4 * 2048);
        }
    }
    {
        bf16* KB = (bf16*)(F.ws + WS_KEYS);
        for (int i = gt; i < 2 * 8 * 2 * 128 * 128 / 8; i += NGT) { const f32x4 a = *(const f32x4*)(F.in[I_KEYS] + (size_t)i * 8), b = *(const f32x4*)(F.in[I_KEYS] + (size_t)i * 8 + 4);
            u32x4 o; o.x = pk2(a[0], a[1]); o.y = pk2(a[2], a[3]); o.z = pk2(b[0], b[1]); o.w = pk2(b[2], b[3]); *(u32x4*)(KB + (size_t)i * 8) = o; }
        bf16* GW = (bf16*)(F.ws + WS_GWS);
        for (int i = gt; i < 2 * 8 * 128 * 128 / 8; i += NGT) { const int e = i * 8, jj = e & 127, ii = (e >> 7) & 127; const bool keep = (ii >= 64) || (jj < 64);
            f32x4 a = *(const f32x4*)(F.in[I_GWS] + (size_t)i * 8), b = *(const f32x4*)(F.in[I_GWS] + (size_t)i * 8 + 4);
            if (!keep) { a = (f32x4){0.f, 0.f, 0.f, 0.f}; b = a; }
            u32x4 o; o.x = pk2(a[0], a[1]); o.y = pk2(a[2], a[3]); o.z = pk2(b[0], b[1]); o.w = pk2(b[2], b[3]); *(u32x4*)(GW + (size_t)i * 8) = o; }
    }
}

template <bool SRC_BF16>
__device__ __forceinline__ void phase_norm(Frame& F, const void* xsrc, const float* gain, const float* scale, const float* shift) {
    PH_LOCALS
    const int gw = F.vcu * NWAVES + wave, NGW = F.G * NWAVES;
    bf16* H = (bf16*)(F.ws + WS_H);
    for (int m = gw; m < M; m += 2 * NGW) {
        const int m2 = m + NGW;
        f32x4 va[4][2], vb[4][2];
        const char* ra = (const char*)xsrc + (size_t)m * DM * (SRC_BF16 ? 2 : 4); const char* rb = (const char*)xsrc + (size_t)(m2 < M ? m2 : m) * DM * (SRC_BF16 ? 2 : 4);
        load_row<SRC_BF16>(ra, lane, va); load_row<SRC_BF16>(rb, lane, vb);
        u32x4 oa[4], ob[4]; norm_mod_row(va, gain, scale, shift, lane, oa); norm_mod_row(vb, gain, scale, shift, lane, ob);
#pragma unroll
        for (int j = 0; j < 4; ++j) *(u32x4*)(H + (size_t)m * DM + j * 512 + lane * 8) = oa[j];
        if (m2 < M) {
#pragma unroll
            for (int j = 0; j < 4; ++j) *(u32x4*)(H + (size_t)m2 * DM + j * 512 + lane * 8) = ob[j]; }
    }
}
__device__ __forceinline__ void phase_lnstats(Frame& F) {
    PH_LOCALS
    const int gw = F.vcu * NWAVES + wave, NGW = F.G * NWAVES;
    const bf16* Z = (const bf16*)(F.ws + WS_Z); float* ST = (float*)(F.ws + WS_STATS);
    for (int m0 = gw; m0 < M; m0 += 2 * NGW) {
        float v[2][16]; int mm[2];
#pragma unroll
        for (int r = 0; r < 2; ++r) { mm[r] = (m0 + r * NGW < M) ? m0 + r * NGW : m0;
#pragma unroll
            for (int j = 0; j < 2; ++j) { const u32x4 w = *(const u32x4*)(Z + (size_t)mm[r] * 2048 + 1024 + j * 512 + lane * 8);
                v[r][j * 8 + 0] = bflo(w.x); v[r][j * 8 + 1] = bfhi(w.x); v[r][j * 8 + 2] = bflo(w.y); v[r][j * 8 + 3] = bfhi(w.y); v[r][j * 8 + 4] = bflo(w.z); v[r][j * 8 + 5] = bfhi(w.z); v[r][j * 8 + 6] = bflo(w.w); v[r][j * 8 + 7] = bfhi(w.w); } }
        float s[2] = {0.f, 0.f};
#pragma unroll
        for (int r = 0; r < 2; ++r)
#pragma unroll
            for (int i = 0; i < 16; ++i) s[r] += v[r][i];
#pragma unroll
        for (int o = 1; o < 64; o <<= 1) { s[0] += __shfl_xor(s[0], o); s[1] += __shfl_xor(s[1], o); }
        float q[2] = {0.f, 0.f}; const float mean[2] = {s[0] * (1.0f / 1024.0f), s[1] * (1.0f / 1024.0f)};
#pragma unroll
        for (int r = 0; r < 2; ++r)
#pragma unroll
            for (int i = 0; i < 16; ++i) { const float d = v[r][i] - mean[r]; q[r] += d * d; }
#pragma unroll
        for (int o = 1; o < 64; o <<= 1) { q[0] += __shfl_xor(q[0], o); q[1] += __shfl_xor(q[1], o); }
        if (lane < 2) { const int r = lane; const float qq = r ? q[1] : q[0], mu = r ? mean[1] : mean[0]; const int m = r ? mm[1] : mm[0];
            ST[2 * m] = mu; ST[2 * m + 1] = 1.0f / sqrtf(qq * (1.0f / 1024.0f) + EPS); }
    }
}
__device__ __forceinline__ void phase_branchnorm(Frame& F) {
    PH_LOCALS
    const int gw = F.vcu * NWAVES + wave, NGW = F.G * NWAVES;
    bf16* MIX = (bf16*)(F.ws + WS_MIX);
    for (int m0 = gw; m0 < M; m0 += 2 * NGW) {
        u32x4 w[2][4]; float sa[2] = {0.f, 0.f}, sb[2] = {0.f, 0.f}; int mm[2];
#pragma unroll
        for (int r = 0; r < 2; ++r) { mm[r] = (m0 + r * NGW < M) ? m0 + r * NGW : m0;
#pragma unroll
            for (int j = 0; j < 4; ++j) w[r][j] = *(const u32x4*)(MIX + (size_t)mm[r] * 2048 + j * 512 + lane * 8); }
#pragma unroll
        for (int r = 0; r < 2; ++r)
#pragma unroll
            for (int j = 0; j < 4; ++j) { float q = 0.f;
#pragma unroll
                for (int e = 0; e < 4; ++e) { const float a = bflo(w[r][j][e]), b = bfhi(w[r][j][e]); q += a * a + b * b; }
                if (j < 2) sa[r] += q; else sb[r] += q; }
#pragma unroll
        for (int o = 1; o < 64; o <<= 1) { sa[0] += __shfl_xor(sa[0], o); sb[0] += __shfl_xor(sb[0], o); sa[1] += __shfl_xor(sa[1], o); sb[1] += __shfl_xor(sb[1], o); }
#pragma unroll
        for (int r = 0; r < 2; ++r) {
            if (r == 1 && mm[1] == mm[0]) break;
            const float ra = 1.0f / sqrtf(sa[r] * (1.0f / 1024.0f) + EPS), rb = 1.0f / sqrtf(sb[r] * (1.0f / 1024.0f) + EPS);
#pragma unroll
            for (int j = 0; j < 4; ++j) { const float rs = j < 2 ? ra : rb; u32x4 o;
#pragma unroll
                for (int e = 0; e < 4; ++e) o[e] = pk2(bflo(w[r][j][e]) * rs, bfhi(w[r][j][e]) * rs);
                *(u32x4*)(MIX + (size_t)mm[r] * 2048 + j * 512 + lane * 8) = o; }
        }
    }
}

__device__ __forceinline__ void phase_sloc(Frame& F, int l) {
    PH_LOCALS
    const bf16* XS = (const bf16*)(F.ws + WS_XS); const bf16* WG = (const bf16*)(F.ws + WS_WG) + (size_t)l * 64 * 128 * 1024; float* SL = (float*)(F.ws + WS_SLOC);
    const int fr = lane & 15, fq = lane >> 4;
    for (int u = F.vcu; u < 256; u += F.G) {
        const int g = u >> 2, n0 = (u & 3) * 64 + (wave & 3) * 16, jh = wave >> 2;
        f32x4 acc[4];
#pragma unroll
        for (int t = 0; t < 4; ++t) acc[t] = (f32x4){0.f, 0.f, 0.f, 0.f};
        const bf16* xp = XS + ((size_t)(g * 256 + n0 + fr)) * 1024 + 8 * fq;
        const bf16* wp = WG + ((size_t)(g * 128 + jh * 64 + fr)) * 1024 + 8 * fq;
#pragma unroll 8
        for (int kb = 0; kb < 32; ++kb) {
            const bf16x8 xf = *(const bf16x8*)(xp + kb * 32);
#pragma unroll
            for (int t = 0; t < 4; ++t) { const bf16x8 wf = *(const bf16x8*)(wp + (size_t)t * 16 * 1024 + kb * 32); acc[t] = __builtin_amdgcn_mfma_f32_16x16x32_bf16(wf, xf, acc[t], 0, 0, 0); }
        }
#pragma unroll
        for (int t = 0; t < 4; ++t) *(f32x4*)(SL + ((size_t)(g * 256 + n0 + fr)) * 128 + jh * 64 + t * 16 + 4 * fq) = acc[t];
    }
}
__device__ __forceinline__ void gating_unit(Frame& F, int l, int unit) {
    PH_LOCALS
    const int nb = unit >> 3, hh = unit & 7, t0 = nb * 128, c0 = hh * 128;
    const bf16* Z = (const bf16*)(F.ws + WS_Z); const float* ST = (const float*)(F.ws + WS_STATS);
    const bf16* GW = (const bf16*)(F.ws + WS_GWS) + (size_t)(l * 8 + hh) * 128 * 128;
    bf16* MIX = (bf16*)(F.ws + WS_MIX);
    LAS bf16* VT = (LAS bf16*)F.lds;
    constexpr int VS = 136;
    {
        const int j = tid >> 2, cs = (tid & 3) * 32;
        const float mu = ST[2 * (t0 + j)], rs = ST[2 * (t0 + j) + 1];
        const float* lg = F.in[I_LNG] + l * 1024 + c0 + cs; const float* lb = F.in[I_LNB] + l * 1024 + c0 + cs;
#pragma unroll
        for (int q = 0; q < 4; ++q) {
            const u32x4 w = *(const u32x4*)(Z + (size_t)(t0 + j) * 2048 + 1024 + c0 + cs + q * 8);
#pragma unroll
            for (int e = 0; e < 4; ++e) { const int c = cs + q * 8 + 2 * e;
                const float a = (bflo(w[e]) - mu) * rs * lg[q * 8 + 2 * e] + lb[q * 8 + 2 * e], b = (bfhi(w[e]) - mu) * rs * lg[q * 8 + 2 * e + 1] + lb[q * 8 + 2 * e + 1];
                VT[c * VS + j] = (bf16)f2bf(a); VT[(c + 1) * VS + j] = (bf16)f2bf(b); }
        }
    }
    __syncthreads();
    {
        const int fr = lane & 15, fq = lane >> 4, w = wave;
        f32x4 acc[8];
#pragma unroll
        for (int ct = 0; ct < 8; ++ct) acc[ct] = (f32x4){0.f, 0.f, 0.f, 0.f};
        const int nkb = (w < 4) ? 2 : 4;
        for (int kb = 0; kb < nkb; ++kb) {
            const bf16x8 wf = *(const bf16x8*)(GW + (size_t)(16 * w + fr) * 128 + kb * 32 + 8 * fq);
#pragma unroll
            for (int ct = 0; ct < 8; ++ct) { const bf16x8 vf = *(const LAS bf16x8*)(VT + (ct * 16 + fr) * VS + kb * 32 + 8 * fq); acc[ct] = __builtin_amdgcn_mfma_f32_16x16x32_bf16(vf, wf, acc[ct], 0, 0, 0); }
        }
        const int tok = t0 + 16 * w + fr; const float bs = F.in[I_GBS][(l * 8 + hh) * 128 + 16 * w + fr]; float ssq = 0.f;
#pragma unroll
        for (int ct = 0; ct < 8; ++ct) { const int c = c0 + ct * 16 + 4 * fq;
            const u32x2 uw = *(const u32x2*)(Z + (size_t)tok * 2048 + c);
            const float o0 = bflo(uw.x) * (acc[ct][0] + bs), o1 = bfhi(uw.x) * (acc[ct][1] + bs), o2 = bflo(uw.y) * (acc[ct][2] + bs), o3 = bfhi(uw.y) * (acc[ct][3] + bs);
            u32x2 o; o.x = pk2(o0, o1); o.y = pk2(o2, o3);
            *(u32x2*)(MIX + (size_t)tok * 2048 + c) = o; ssq += (o0 * o0 + o1 * o1) + (o2 * o2 + o3 * o3); }
        ssq += __shfl_xor(ssq, 16); ssq += __shfl_xor(ssq, 32);
        if (fq == 0) ((float*)(F.ws + WS_PSA))[(size_t)tok * 8 + hh] = ssq;
    }
    __syncthreads();
}
__device__ __forceinline__ void phase_gating(Frame& F, int l) {
    for (int u = F.vcu; u < 1024; u += F.G) gating_unit(F, l, u);
}

__device__ __forceinline__ void phase_s5out(Frame& F, int l) {
    PH_LOCALS
    const bf16* XS = (const bf16*)(F.ws + WS_XS);
    bf16* Gb = (bf16*)(F.ws + WS_G);
    LAS unsigned char* HT = F.lds;
    LAS float* TS = (LAS float*)(F.lds + 34816);
    LAS unsigned char* KT = F.lds + 38912;
    LAS unsigned char* VT = F.lds + 79872;
    const int fr = lane & 15, fq = lane >> 4;
    for (int u = F.vcu; u < 512; u += F.G) {
        const int g = u >> 3, rc = (u >> 1) & 3, nh = u & 1;
        const bf16* VG = (const bf16*)(F.ws + WS_VG) + (size_t)(l * 64 + g) * 1024 * 128;
        const int n = nh * 128 + 16 * wave + fr;
        const bf16* xp0 = XS + ((size_t)(g * 256 + n)) * 1024 + 8 * fq;
        bf16x8 xa[4], xb[4];
#pragma unroll
        for (int i = 0; i < 4; ++i) xa[i] = *(const bf16x8*)(xp0 + i * 32);
        __syncthreads();
        { const u32x4* src = (const u32x4*)((const bf16*)(F.ws + WS_KTAB) + (size_t)(l * 64 + g) * 80 * 256);
          for (int i = tid; i < 80 * 256 / 8; i += NTHR) ((LAS u32x4*)KT)[i] = src[i];
#pragma unroll
          for (int ps = 0; ps < 8; ++ps) { const int row = ps * 32 + (tid >> 4), c = tid & 15, q = row >> 4, o = row & 15;
              *(LAS u32x4*)(VT + row * 272 + c * 16) = *(const u32x4*)(VG + (size_t)((rc + 4 * q) * 16 + o) * 128 + c * 8); } }
        {
            const int p = lane, seg = wave;
            const float* AT = (const float*)(F.ws + WS_AT) + ((size_t)(l * 64 + g) * 64 + p) * 2; const float ar = AT[0], ai = AT[1];
            const float* SL = (const float*)(F.ws + WS_SLOC) + ((size_t)(g * 256 + seg * 32)) * 128 + p;
            float sr[32], si[32];
#pragma unroll
            for (int i = 0; i < 32; ++i) { sr[i] = SL[(size_t)i * 128]; si[i] = SL[(size_t)i * 128 + 64]; }
            float er = 0.f, ei = 0.f;
#pragma unroll
            for (int i = 0; i < 32; ++i) { const float nr = ar * er - ai * ei + sr[i], ni = ar * ei + ai * er + si[i]; er = nr; ei = ni; }
            TS[(seg * 64 + p) * 2] = er; TS[(seg * 64 + p) * 2 + 1] = ei;
            float qr = ar, qi = ai;
#pragma unroll
            for (int s = 0; s < 5; ++s) { const float nr = qr * qr - qi * qi, ni = 2.0f * qr * qi; qr = nr; qi = ni; }
            __syncthreads();
            float hr = 0.f, hi = 0.f;
            for (int k = 0; k < seg; ++k) { const float tr = TS[(k * 64 + p) * 2], ti = TS[(k * 64 + p) * 2 + 1]; const float nr = qr * hr - qi * hi + tr, ni = qr * hi + qi * hr + ti; hr = nr; hi = ni; }
            if ((seg >> 2) == nh) {
                LAS bf16* hrow = (LAS bf16*)(HT + ((seg & 3) * 32) * 272) + p;
#pragma unroll
                for (int i = 0; i < 32; ++i) { hrow[i * 136] = (bf16)f2bf(hr); hrow[i * 136 + 64] = (bf16)f2bf(hi);
                    const float nr = ar * hr - ai * hi + sr[i], ni = ar * hi + ai * hr + si[i]; hr = nr; hi = ni; }
            }
        }
        __syncthreads();
        f32x4 acc[16];
#pragma unroll
        for (int q = 0; q < 16; ++q) acc[q] = (f32x4){0.f, 0.f, 0.f, 0.f};
        const int kb0 = ((rc - (fq >> 1) + 10) * 16 + fr) * 32 + 16 * (fq & 1);
#define S5_GROUP(XF, grp_) do { const LAS unsigned char* kp = KT + kb0 - (grp_) * 4096; \
            _Pragma("unroll") for (int q = 0; q < 16; ++q) { if (rc + 4 * q >= 8 * (grp_)) { \
                _Pragma("unroll") for (int i = 0; i < 4; ++i) { const bf16x8 kf = *(const LAS bf16x8*)(kp + (4 * q - 2 * i + 6) * 512); \
                    acc[q] = __builtin_amdgcn_mfma_f32_16x16x32_bf16(kf, XF[i], acc[q], 0, 0, 0); } } } } while (0)
#pragma unroll 1
        for (int gp = 0; gp < 4; ++gp) {
#pragma unroll
            for (int i = 0; i < 4; ++i) xb[i] = *(const bf16x8*)(xp0 + ((2 * gp + 1) * 4 + i) * 32);
            S5_GROUP(xa, 2 * gp);
            if (gp < 3) {
#pragma unroll
                for (int i = 0; i < 4; ++i) xa[i] = *(const bf16x8*)(xp0 + ((2 * gp + 2) * 4 + i) * 32);
            }
            S5_GROUP(xb, 2 * gp + 1);
        }
#undef S5_GROUP
#pragma unroll 1
        for (int jb = 0; jb < 4; ++jb) {
            const bf16x8 hf = *(const LAS bf16x8*)(HT + (16 * wave + fr) * 272 + (jb * 32 + 8 * fq) * 2);
#pragma unroll
            for (int q = 0; q < 16; ++q) {
                const bf16x8 vf = *(const LAS bf16x8*)(VT + (q * 16 + fr) * 272 + (jb * 32 + 8 * fq) * 2);
                acc[q] = __builtin_amdgcn_mfma_f32_16x16x32_bf16(vf, hf, acc[q], 0, 0, 0);
            }
        }
#pragma unroll
        for (int q = 0; q < 16; ++q) {
            const int t = rc + 4 * q, tok = 64 * n + t;
            const f32x4 y = acc[q];
            u32x2 o; o.x = pk2(gelu_tanh(y[0]), gelu_tanh(y[1])); o.y = pk2(gelu_tanh(y[2]), gelu_tanh(y[3]));
            *(u32x2*)(Gb + (size_t)tok * 1024 + g * 16 + 4 * fq) = o;
#if SELFTEST_S5
            if (tok < 256) *(f32x4*)((float*)(F.ws + WS_DBG) + (size_t)tok * 1024 + g * 16 + 4 * fq) = y;
#endif
        }
    }
    __syncthreads();
}
#if SELFTEST_S5
__device__ __forceinline__ void selftest_s5(Frame& F, int l) {
    PH_LOCALS
    if (F.vcu < 64 && wave == 0) {
        const int g = F.vcu, p = lane;
        const float dt = expf(F.in[I_LDT][l * 64 + g]);
        const float lr = F.in[I_LRE][(l * 64 + g) * 64 + p], li = F.in[I_LIM][(l * 64 + g) * 64 + p];
        const float mag = expf(lr * dt); float sn, cs; sincosf(li * dt, &sn, &cs);
        const float ar = mag * cs, ai = mag * sn;
        const float xr = ar - 1.0f, xi = ai, den = 1.0f / (lr * lr + li * li);
        const float cr = (xr * lr + xi * li) * den, ci = (xi * lr - xr * li) * den;
        float bbr[16], bbi[16], ccr[16], cci[16];
#pragma unroll
        for (int i = 0; i < 16; ++i) { const float br = F.in[I_BRE][((size_t)(l * 64 + g) * 64 + p) * 16 + i], bi = F.in[I_BIM][((size_t)(l * 64 + g) * 64 + p) * 16 + i];
            bbr[i] = cr * br - ci * bi; bbi[i] = cr * bi + ci * br;
            ccr[i] = F.in[I_CRE][((size_t)(l * 64 + g) * 16 + i) * 64 + p]; cci[i] = F.in[I_CIM][((size_t)(l * 64 + g) * 16 + i) * 64 + p]; }
        const bf16* XS = (const bf16*)(F.ws + WS_XS) + (size_t)g * 256 * 1024;
        const float* DY = (const float*)(F.ws + WS_DBG);
        float sr = 0.f, si = 0.f, err = 0.f, ref = 0.f;
        for (int t = 0; t < 256; ++t) {
            float x[16];
#pragma unroll
            for (int i = 0; i < 16; ++i) x[i] = bflo((unsigned)XS[(size_t)t * 16 + i]);
            float ur = 0.f, ui = 0.f;
#pragma unroll
            for (int i = 0; i < 16; ++i) { ur += bbr[i] * x[i]; ui += bbi[i] * x[i]; }
            const float nr = ar * sr - ai * si + ur, ni = ar * si + ai * sr + ui; sr = nr; si = ni;
#pragma unroll
            for (int o = 0; o < 16; ++o) {
                const float yr = wave_sum(ccr[o] * sr - cci[o] * si);
                const float yf = DY[(size_t)t * 1024 + g * 16 + o];
                err += (yf - yr) * (yf - yr); ref += yr * yr;
            }
        }
        if (lane == 0 && !(err <= 2e-3f * ref)) __hip_atomic_fetch_or((unsigned*)(F.ws + WS_CTL) + CW_FLAG, 1u, RLX_AGENT);
    }
}
#endif

__device__ __forceinline__ unsigned f2key(float v) { const unsigned u = __builtin_bit_cast(unsigned, v); return (u & 0x80000000u) ? ~u : (u | 0x80000000u); }
__device__ __forceinline__ float key2f(unsigned k) { const unsigned u = (k & 0x80000000u) ? (k & 0x7fffffffu) : ~k; return __builtin_bit_cast(float, u); }
__device__ __forceinline__ void sort16_desc(unsigned (&v)[16]) {
#pragma unroll
    for (int lk = 1; lk <= 4; ++lk) {
#pragma unroll
        for (int lj = lk - 1; lj >= 0; --lj) {
#pragma unroll
            for (int i = 0; i < 16; ++i) { const int k = 1 << lk, j = 1 << lj, p = i ^ j;
                if (p > i) { const unsigned a = v[i], c = v[p], hi = a > c ? a : c, lo = a > c ? c : a; const bool desc = ((i & k) == 0) || (k == 16);
                    v[i] = desc ? hi : lo; v[p] = desc ? lo : hi; } }
        }
    }
}
__device__ __forceinline__ void merge16_desc(unsigned (&v)[16], const unsigned (&w)[16]) {
#pragma unroll
    for (int i = 0; i < 16; ++i) v[i] = v[i] > w[15 - i] ? v[i] : w[15 - i];
#pragma unroll
    for (int lj = 3; lj >= 0; --lj) {
#pragma unroll
        for (int i = 0; i < 16; ++i) { const int j = 1 << lj, p = i ^ j;
            if (p > i) { const unsigned a = v[i], c = v[p]; v[i] = a > c ? a : c; v[p] = a > c ? c : a; } }
    }
}
__device__ __forceinline__ void xmerge16(unsigned (&v)[16], int mask) {
    unsigned w[16];
#pragma unroll
    for (int i = 0; i < 16; ++i) w[i] = (unsigned)__shfl_xor((int)v[i], mask);
    merge16_desc(v, w);
}
__device__ __forceinline__ void phase_topk(Frame& F, int l) {
    PH_LOCALS
    const bf16* Q = (const bf16*)(F.ws + WS_Z);
    const bf16* KB = (const bf16*)(F.ws + WS_KEYS) + (size_t)l * 8 * 2 * 128 * 128;
    int* EID = (int*)(F.ws + WS_EID); float* GT = (float*)(F.ws + WS_GATE); float* SUo = (float*)(F.ws + WS_SU);
    const float* SCL = (const float*)(F.ws + WS_SCL) + (size_t)l * NEXP * 2;
    LAS unsigned char* KL = F.lds;
    LAS unsigned* LST = (LAS unsigned*)(F.lds + 69632);
    LAS unsigned char* PT = F.lds + 69632 + 16384;
    const int fr = lane & 15, fq = lane >> 4;
    {
        int c = 0;
#pragma unroll
        for (int i = 0; i < 16; ++i)
#pragma unroll
            for (int j = 0; j < 16; ++j) if ((i + 1) * (j + 1) <= 16) { if (tid == c) PT[c] = (unsigned char)(i * 16 + j); ++c; }
    }
    int cur_hh = -1;
    for (int u = F.vcu; u < 1024; u += F.G) {
        const int tt = u >> 3, hh = u & 7, t0 = tt * 128;
        bf16x8 qf[2][4];
#pragma unroll
        for (int s = 0; s < 2; ++s)
#pragma unroll
            for (int kb = 0; kb < 4; ++kb) qf[s][kb] = *(const bf16x8*)(Q + (size_t)(t0 + 16 * wave + fr) * 2048 + hh * 256 + s * 128 + kb * 32 + 8 * fq);
        if (hh != cur_hh) {
            __syncthreads();
#pragma unroll
            for (int ps = 0; ps < 8; ++ps) { const int idx = ps * 512 + tid, row = idx >> 4, c16 = idx & 15;
                *(LAS u32x4*)(KL + row * 272 + c16 * 16) = *(const u32x4*)(KB + ((size_t)(hh * 256 + row)) * 128 + c16 * 8); }
            cur_hh = hh;
            __syncthreads();
        }
#pragma unroll 1
        for (int s = 0; s < 2; ++s) {
            f32x4 acc[8];
#pragma unroll
            for (int nt = 0; nt < 8; ++nt) acc[nt] = (f32x4){0.f, 0.f, 0.f, 0.f};
#pragma unroll
            for (int kb = 0; kb < 4; ++kb) { const bf16x8 q = s ? qf[1][kb] : qf[0][kb];
#pragma unroll
                for (int nt = 0; nt < 8; ++nt) { const bf16x8 kf = *(const LAS bf16x8*)(KL + (s * 128 + nt * 16 + fr) * 272 + (kb * 32 + 8 * fq) * 2);
                    acc[nt] = __builtin_amdgcn_mfma_f32_16x16x32_bf16(kf, q, acc[nt], 0, 0, 0); } }
            unsigned va[16], vb[16];
#pragma unroll
            for (int nt = 0; nt < 4; ++nt)
#pragma unroll
                for (int r = 0; r < 4; ++r) { va[4 * nt + r] = (f2key(acc[nt][r]) & ~0x7Fu) | (unsigned)(127 - (nt * 16 + 4 * fq + r));
                    vb[4 * nt + r] = (f2key(acc[4 + nt][r]) & ~0x7Fu) | (unsigned)(127 - ((4 + nt) * 16 + 4 * fq + r)); }
            sort16_desc(va); sort16_desc(vb); merge16_desc(va, vb);
            xmerge16(va, 16); xmerge16(va, 32);
            if (fq == 0) {
#pragma unroll
                for (int k = 0; k < 16; k += 4) *(LAS u32x4*)(LST + ((16 * wave + fr) * 2 + s) * 16 + k) = (u32x4){va[k], va[k + 1], va[k + 2], va[k + 3]};
            }
        }
        asm volatile("s_waitcnt lgkmcnt(0)" ::: "memory");
        {
            const int tl = 16 * wave + (lane >> 2), c4 = lane & 3;
            unsigned v[16];
#pragma unroll
            for (int m = 0; m < 13; ++m) { const int c = m * 4 + c4; unsigned key = 0u;
                if (c < 50) { const int pij = PT[c], i = pij >> 4, j = pij & 15;
                    const float av = key2f(LST[(tl * 2 + 0) * 16 + i] & ~0x7Fu), bv = key2f(LST[(tl * 2 + 1) * 16 + j] & ~0x7Fu);
                    key = (f2key(av + bv) & ~0xFFu) | (unsigned)(255 - pij); }
                v[m] = key; }
#pragma unroll
            for (int m = 13; m < 16; ++m) v[m] = 0u;
            sort16_desc(v);
            xmerge16(v, 1); xmerge16(v, 2);
            float ev[16]; float sum = 0.f; const float mx = key2f(v[0] & ~0xFFu);
#pragma unroll
            for (int k = 0; k < 16; ++k) { ev[k] = __expf(key2f(v[k] & ~0xFFu) - mx); sum += ev[k]; }
            const float inv = 1.0f / sum;
            unsigned kk[4] = {v[0], v[1], v[2], v[3]}; float ee[4] = {ev[0], ev[1], ev[2], ev[3]};
#pragma unroll
            for (int q = 1; q < 4; ++q) { if (c4 == q) {
#pragma unroll
                for (int e = 0; e < 4; ++e) { kk[e] = v[4 * q + e]; ee[e] = ev[4 * q + e]; } } }
            const size_t ob = (size_t)(t0 + tl) * 128 + hh * 16 + 4 * c4;
            int eo[4]; float go[4], so[4];
#pragma unroll
            for (int e = 0; e < 4; ++e) { const int flat = 255 - (int)(kk[e] & 0xFFu), i = flat >> 4, j = flat & 15;
                const int ia = 127 - (int)(LST[(tl * 2 + 0) * 16 + i] & 0x7Fu), ib = 127 - (int)(LST[(tl * 2 + 1) * 16 + j] & 0x7Fu);
                eo[e] = ia * 128 + ib; }
#pragma unroll
            for (int e = 0; e < 4; ++e) { const f32x2 sc = *(const f32x2*)(SCL + 2 * eo[e]); go[e] = ee[e] * inv * sc.y; so[e] = sc.x; }
            *(u32x4*)(EID + ob) = (u32x4){(unsigned)eo[0], (unsigned)eo[1], (unsigned)eo[2], (unsigned)eo[3]};
            *(f32x4*)(GT + ob) = (f32x4){go[0], go[1], go[2], go[3]};
            *(f32x4*)(SUo + ob) = (f32x4){so[0], so[1], so[2], so[3]};
        }
        asm volatile("s_waitcnt lgkmcnt(0)" ::: "memory");
    }
    __syncthreads();
}

#define FP4X4(w, f0, f1, f2, f3) do { f0 = __builtin_amdgcn_cvt_scalef32_pk_f32_fp4((w), 1.0f, 0); f1 = __builtin_amdgcn_cvt_scalef32_pk_f32_fp4((w), 1.0f, 1); \
    f2 = __builtin_amdgcn_cvt_scalef32_pk_f32_fp4((w), 1.0f, 2); f3 = __builtin_amdgcn_cvt_scalef32_pk_f32_fp4((w), 1.0f, 3); } while (0)
__device__ __forceinline__ void phase_gather(Frame& F, int l, bool dummy = false) {
    PH_LOCALS
    const int gw = F.vcu * NWAVES + wave, NGW = F.G * NWAVES;
    bf16* Hn = dummy ? (bf16*)(F.ws + WS_DBG + 128 * MiB) : (bf16*)(F.ws + WS_H);
    const unsigned char* UV = F.ws + WS_UV + (size_t)l * NEXP * 2048;
    const int* EID = (const int*)(F.ws + WS_EID); const float* GT = (const float*)(F.ws + WS_GATE); const float* SU = (const float*)(F.ws + WS_SU);
    const bf16* X = (const bf16*)(F.ws + WS_X); bf16* Xo = dummy ? (bf16*)(F.ws + WS_DBG) : (bf16*)(F.ws + WS_X);
    const float* mod = (const float*)(F.ws + WS_MOD);
    const float* gate2 = mod + l * 12288 + 5 * 2048; const float* shift2 = mod + l * 12288 + 3 * 2048; const float* gs2 = (const float*)(F.ws + WS_GS) + l * DM;
    const unsigned lane16 = (unsigned)lane * 16u;
    for (int t = gw; t < M; t += NGW) {
        const int e_lo = EID[(size_t)t * 128 + lane], e_hi = EID[(size_t)t * 128 + 64 + lane];
        const float g_lo = GT[(size_t)t * 128 + lane], g_hi = GT[(size_t)t * 128 + 64 + lane];
        const float s_lo = SU[(size_t)t * 128 + lane], s_hi = SU[(size_t)t * 128 + 64 + lane];
        f32x2 hh[8][2];
        {   float s2 = 0.f; u32x2 xw[8];
#pragma unroll
            for (int j = 0; j < 8; ++j) xw[j] = *(const u32x2*)(X + (size_t)t * 2048 + j * 256 + lane * 4);
#pragma unroll
            for (int j = 0; j < 8; ++j) { hh[j][0] = (f32x2){bflo(xw[j].x), bfhi(xw[j].x)}; hh[j][1] = (f32x2){bflo(xw[j].y), bfhi(xw[j].y)};
                s2 += (hh[j][0].x * hh[j][0].x + hh[j][0].y * hh[j][0].y) + (hh[j][1].x * hh[j][1].x + hh[j][1].y * hh[j][1].y); }
            const float r2 = 1.0f / sqrtf(wave_sum(s2) * (1.0f / DM) + EPS);
#pragma unroll
            for (int j2 = 0; j2 < 8; j2 += 4) { f32x4 gsv[4], shv[4];
#pragma unroll
                for (int j = 0; j < 4; ++j) { gsv[j] = *(const f32x4*)(gs2 + (j2 + j) * 256 + lane * 4); shv[j] = *(const f32x4*)(shift2 + (j2 + j) * 256 + lane * 4); }
#pragma unroll
                for (int j = 0; j < 4; ++j) { hh[j2 + j][0] = (f32x2){hh[j2 + j][0].x * r2 * gsv[j][0] + shv[j][0], hh[j2 + j][0].y * r2 * gsv[j][1] + shv[j][1]}; hh[j2 + j][1] = (f32x2){hh[j2 + j][1].x * r2 * gsv[j][2] + shv[j][2], hh[j2 + j][1].y * r2 * gsv[j][3] + shv[j][3]}; } }
        }
        f32x2 of[8][2];
#pragma unroll
        for (int j = 0; j < 8; ++j) { of[j][0] = (f32x2){0.f, 0.f}; of[j][1] = (f32x2){0.f, 0.f}; }
        const bool u32_ = (lane & 32) != 0, u16_ = (lane & 16) != 0, u8_ = (lane & 8) != 0;
#if GATHER_PROBE_HOT
#define G_HOT(e) if (dummy) e &= 15;
#else
#define G_HOT(e)
#endif
#define G_ROW(dst, b_, h_, off_) do { int e_ = __builtin_amdgcn_readlane((b_) < 8 ? e_lo : e_hi, (8 * (b_) + (h_)) & 63); G_HOT(e_) \
            dst = *(const u32x4*)(UV + ((size_t)(unsigned)e_ << 11) + (off_) + lane16); } while (0)
#define G_DOTS(b_, NEXT) float p[8]; \
            _Pragma("unroll") for (int h = 0; h < 8; ++h) { f32x2 a2 = {0.f, 0.f}; \
                _Pragma("unroll") for (int d = 0; d < 4; ++d) { f32x2 f0, f1, f2, f3; FP4X4(ur[h][d], f0, f1, f2, f3); \
                    a2 = f0 * hh[2 * d][0] + a2; a2 = f1 * hh[2 * d][1] + a2; a2 = f2 * hh[2 * d + 1][0] + a2; a2 = f3 * hh[2 * d + 1][1] + a2; } \
                p[h] = a2.x + a2.y; if (NEXT) G_ROW(ur[h], (b_) + 1, h, 0); }
#define G_REST(b_, NEXT) float a4[4]; \
            _Pragma("unroll") for (int i = 0; i < 4; ++i) { const float snd = u32_ ? p[i] : p[4 + i], kp = u32_ ? p[4 + i] : p[i]; a4[i] = kp + __shfl_xor(snd, 32); } \
            float b2[2]; \
            _Pragma("unroll") for (int i = 0; i < 2; ++i) { const float snd = u16_ ? a4[i] : a4[2 + i], kp = u16_ ? a4[2 + i] : a4[i]; b2[i] = kp + __shfl_xor(snd, 16); } \
            float d; { const float snd = u8_ ? b2[0] : b2[1], kp = u8_ ? b2[1] : b2[0]; d = kp + __shfl_xor(snd, 8); } \
            d += __shfl_xor(d, 4); d += __shfl_xor(d, 2); d += __shfl_xor(d, 1); \
            const int hl = (8 * (b_) + (lane >> 3)) & 63; const float gsel = (b_) < 8 ? g_lo : g_hi, ssel = (b_) < 8 ? s_lo : s_hi; \
            const float coefq = __shfl(gsel, hl) * gelu_tanh(d * __shfl(ssel, hl)); \
            _Pragma("unroll") for (int h = 0; h < 8; ++h) { const float cf = __builtin_bit_cast(float, __builtin_amdgcn_readlane(__builtin_bit_cast(int, coefq), 8 * h)); const f32x2 cf2 = {cf, cf}; \
                _Pragma("unroll") for (int dd = 0; dd < 4; ++dd) { f32x2 f0, f1, f2, f3; FP4X4(vr[h][dd], f0, f1, f2, f3); \
                    of[2 * dd][0] = f0 * cf2 + of[2 * dd][0]; of[2 * dd][1] = f1 * cf2 + of[2 * dd][1]; of[2 * dd + 1][0] = f2 * cf2 + of[2 * dd + 1][0]; of[2 * dd + 1][1] = f3 * cf2 + of[2 * dd + 1][1]; } \
                if (NEXT) G_ROW(vr[h], (b_) + 1, h, 1024); }
        u32x4 ur[8], vr[8];
#pragma unroll
        for (int h = 0; h < 8; ++h) { G_ROW(ur[h], 0, h, 0); G_ROW(vr[h], 0, h, 1024); }
#pragma unroll 1
        for (int b = 0; b < 15; ++b) { G_DOTS(b, true) G_REST(b, true) }
        { G_DOTS(15, false) G_REST(15, false) }
#undef G_DOTS
#undef G_REST
#undef G_ROW
#undef G_HOT
        int ln = lane; asm volatile("" : "+v"(ln));
        u32x2 cx[8];
#pragma unroll
        for (int j = 0; j < 8; ++j) cx[j] = *(const u32x2*)(X + (size_t)t * 2048 + j * 256 + ln * 4);
        f32x4 xv[8]; float ss = 0.f;
#pragma unroll
        for (int j2 = 0; j2 < 8; j2 += 4) { f32x4 g2v[4];
#pragma unroll
            for (int j = 0; j < 4; ++j) g2v[j] = *(const f32x4*)(gate2 + (j2 + j) * 256 + ln * 4);
#pragma unroll
            for (int jj = 0; jj < 4; ++jj) { const int j = j2 + jj;
                const f32x4 xo = {bflo(cx[j].x), bfhi(cx[j].x), bflo(cx[j].y), bfhi(cx[j].y)};
                const f32x4 o = {of[j][0].x, of[j][0].y, of[j][1].x, of[j][1].y};
                xv[j] = xo + g2v[jj] * o;
                ss += (xv[j][0] * xv[j][0] + xv[j][1] * xv[j][1]) + (xv[j][2] * xv[j][2] + xv[j][3] * xv[j][3]); } }
        const float rr = 1.0f / sqrtf(wave_sum(ss) * (1.0f / DM) + EPS);
        if (l + 1 < DEPTH) {
            const float* m2 = mod + (l + 1) * 12288; const float* gain = F.in[I_N1G] + (l + 1) * 2048;
#pragma unroll
            for (int j2 = 0; j2 < 8; j2 += 4) { f32x4 gv[4], scv[4], shv[4];
#pragma unroll
                for (int j = 0; j < 4; ++j) { const int c = (j2 + j) * 256 + ln * 4; gv[j] = *(const f32x4*)(gain + c); scv[j] = *(const f32x4*)(m2 + 2048 + c); shv[j] = *(const f32x4*)(m2 + c); }
#pragma unroll
                for (int jj = 0; jj < 4; ++jj) { const int j = j2 + jj, c = j * 256 + ln * 4;
                    *(u32x2*)(Xo + (size_t)t * 2048 + c) = (u32x2){pk2(xv[j][0], xv[j][1]), pk2(xv[j][2], xv[j][3])};
                    const f32x4 y = xv[j] * rr * gv[jj] * (scv[jj] + 1.0f) + shv[jj];
                    *(u32x2*)(Hn + (size_t)t * 2048 + c) = (u32x2){pk2(y[0], y[1]), pk2(y[2], y[3])}; } }
        } else {
#pragma unroll
            for (int j = 0; j < 8; ++j) { const int c = j * 256 + ln * 4; const f32x4 fgv = *(const f32x4*)(F.in[I_FG] + c);
                f32x4 ov = xv[j] * rr * fgv;
#if SELFTEST_S5
                if (__hip_atomic_load((unsigned*)(F.ws + WS_CTL) + CW_FLAG, RLX_AGENT) != 0u) ov = (f32x4){1e30f, 1e30f, 1e30f, 1e30f};
#endif
                *(f32x4*)(F.out + (size_t)t * 2048 + c) = ov; }
        }
    }
}

__global__ void __launch_bounds__(NTHR, 2) fwd_kernel(Args args) {
    extern __shared__ __attribute__((aligned(16))) unsigned char lds_raw[];
    Frame F;
    F.lds = (LAS unsigned char*)lds_raw; F.ws = args.ws; F.in = args.in; F.out = args.out;
    F.tid = threadIdx.x; F.lane = F.tid & 63; F.wave = __builtin_amdgcn_readfirstlane(F.tid >> 6);
    F.G = gridDim.x; { const int bx = blockIdx.x; F.vcu = (F.G % 8 == 0) ? (bx % 8) * (F.G / 8) + bx / 8 : bx; }
    volatile LAS unsigned* MISC = (volatile LAS unsigned*)(F.lds + MISC_OFF);
    if (F.tid < 64) MISC[F.tid] = 0u;
    __syncthreads();
    unsigned* ctl = (unsigned*)(F.ws + WS_CTL);
    XcdBarrier bar; bar.bar = ctl + CW_BAR; bar.x = 0; bar.st = nullptr;
#if !MK_PER_PHASE
    bar = xcd_barrier_post(ctl + CW_BAR, MISC + 8);
#endif
    const int lo = args.ph_lo, hi = args.ph_hi;
#define IN(k) (lo <= (k) && (k) < hi)
#if MK_PER_PHASE
#define SEAM(k) do { } while (0)
#else
#define SEAM(k) do { if (IN(k) && IN((k) + 1)) xcd_barrier(bar); } while (0)
#endif
    const float* mod = (const float*)(F.ws + WS_MOD);

#define REP(k) (REPEAT_PH == (k))
#define RUN2(k, first, real) do { if (REP(k)) { first; xcd_barrier(bar); } real; } while (0)
    if (IN(0)) { RUN2(13, p0_tables(F, 5, true), p0_tables(F, 4, false)); } SEAM(0);
    for (int l = 0; l < DEPTH; ++l) {
        const int pb = 1 + 12 * l;
        const float* ml = mod + l * 12288;
        if (IN(pb + 0)) { if (l == 0) { RUN2(0, p0_prologue(F), p0_prologue(F)); RUN2(1, phase_norm<false>(F, F.in[I_X], F.in[I_N1G] + l * 2048, ml + 1 * 2048, ml + 0 * 2048), phase_norm<false>(F, F.in[I_X], F.in[I_N1G] + l * 2048, ml + 1 * 2048, ml + 0 * 2048)); } } SEAM(pb + 0);
        if (IN(pb + 1)) {
            pg8::Gemm g{(const bf16*)(F.ws + WS_H), (const bf16*)(F.ws + WS_WIN) + (size_t)l * INW * DM, M, INW, DM}; pg8::StaticOrder S; S.init(M, INW, F.G, (int)blockIdx.x);
            EpiIn E{(bf16*)(F.ws + WS_Z), (bf16*)(F.ws + WS_XS), F.in[I_BIN] + l * INW};
#define GEMM_IN pg8::gemm_phase<EpiIn, pg8::StaticOrder, true, true>(F.lds, g, S, E)
            RUN2(2, GEMM_IN, GEMM_IN);
        } SEAM(pb + 1);
        if (IN(pb + 2)) { RUN2(3, (phase_sloc(F, l), phase_lnstats(F)), (phase_sloc(F, l), phase_lnstats(F))); } SEAM(pb + 2);
        if (IN(pb + 3)) { RUN2(5, phase_s5out(F, l), phase_s5out(F, l)); RUN2(4, phase_gating(F, l), phase_gating(F, l));
#if SELFTEST_S5
            xcd_barrier(bar); selftest_s5(F, l);
#endif
        } SEAM(pb + 4);
        if (IN(pb + 5)) {
            pg8::Gemm g{(const bf16*)(F.ws + WS_G), (const bf16*)(F.ws + WS_GLU) + (size_t)l * WB * WB, M, WB, WB}; pg8::StaticOrder S; S.init(M, WB, F.G, (int)blockIdx.x);
            EpiGlu E{(const bf16*)(F.ws + WS_G), (bf16*)(F.ws + WS_MIX), F.in[I_GLUB] + l * WB, (float*)(F.ws + WS_PSB)};
#define GEMM_GLU pg8::gemm_phase<EpiGlu, pg8::StaticOrder, true, true>(F.lds, g, S, E)
            RUN2(6, GEMM_GLU, GEMM_GLU);
        } SEAM(pb + 6);
        if (IN(pb + 7)) {
            pg8::Gemm g{(const bf16*)(F.ws + WS_MIX), (const bf16*)(F.ws + WS_WOUT) + (size_t)l * DM * DM, M, DM, DM}; pg8::StaticOrder S; S.init(M, DM, F.G, (int)blockIdx.x);
            LAS float* ratL = (LAS float*)(F.lds + 132096); LAS float* rbL = (LAS float*)(F.lds + 134144);
            pg8::Unit u0, u1; const bool h0 = S.next(0, u0), h1 = S.next(1, u1);
            {   int t2 = F.tid; asm volatile("" : "+v"(t2));
                for (int sl = 0; sl < 2; ++sl) { const bool on = sl == 0 ? h0 : (h1 && u1.pm != u0.pm); const int pmx = sl == 0 ? u0.pm : u1.pm;
                    if (on && t2 < 256) { const size_t row = (size_t)pmx * 256 + t2; float sa = 0.f, sb = 0.f;
                        const float* pa = (const float*)(F.ws + WS_PSA) + row * 8; const float* pb_ = (const float*)(F.ws + WS_PSB) + row * 16;
#pragma unroll
                        for (int i = 0; i < 2; ++i) { const f32x4 v = *(const f32x4*)(pa + 4 * i); sa += (v[0] + v[1]) + (v[2] + v[3]); }
#pragma unroll
                        for (int i = 0; i < 4; ++i) { const f32x4 v = *(const f32x4*)(pb_ + 4 * i); sb += (v[0] + v[1]) + (v[2] + v[3]); }
                        const float ra = 1.0f / sqrtf(sa * (1.0f / 1024.0f) + EPS), rb = 1.0f / sqrtf(sb * (1.0f / 1024.0f) + EPS);
                        ratL[sl * 256 + t2] = ra / rb; rbL[sl * 256 + t2] = rb; } } }
            __syncthreads();
            const int pm0 = h0 ? u0.pm : -1;
            if (l == 0) { EpiOut<false> E{(const void*)F.in[I_X], (bf16*)(F.ws + WS_X), ml + 2 * 2048, (float*)(F.ws + WS_PS), ratL, rbL, pm0}; EpiOut<false> Ed{(const void*)F.in[I_X], (bf16*)(F.ws + WS_DBG), ml + 2 * 2048, (float*)(F.ws + WS_DBG + 128 * MiB), ratL, rbL, pm0};
#define GEMM_OUT0(EE) pg8::gemm_phase<EpiOut<false>, pg8::StaticOrder, true, true>(F.lds, g, S, EE)
                RUN2(8, GEMM_OUT0(Ed), GEMM_OUT0(E)); }
            else { EpiOut<true> E{(const void*)(F.ws + WS_X), (bf16*)(F.ws + WS_X), ml + 2 * 2048, (float*)(F.ws + WS_PS), ratL, rbL, pm0}; EpiOut<true> Ed{(const void*)(F.ws + WS_X), (bf16*)(F.ws + WS_DBG), ml + 2 * 2048, (float*)(F.ws + WS_DBG + 128 * MiB), ratL, rbL, pm0};
#define GEMM_OUT1(EE) pg8::gemm_phase<EpiOut<true>, pg8::StaticOrder, true, true>(F.lds, g, S, EE)
                RUN2(8, GEMM_OUT1(Ed), GEMM_OUT1(E)); }
        }
        SEAM(pb + 8);
        if (IN(pb + 9)) {
            pg8::Gemm g{(const bf16*)(F.ws + WS_X), (const bf16*)(F.ws + WS_WQ) + (size_t)l * DM * DM, M, DM, DM}; pg8::StaticOrder S; S.init(M, DM, F.G, (int)blockIdx.x);
            LAS float* rrL = (LAS float*)(F.lds + 132096);
            pg8::Unit u0, u1; const bool h0 = S.next(0, u0), h1 = S.next(1, u1);
            { int t2 = F.tid; asm volatile("" : "+v"(t2)); if (h0) fill_rr(F, rrL, 0, u0.pm, t2); if (h1 && u1.pm != u0.pm) fill_rr(F, rrL, 1, u1.pm, t2); }
            __syncthreads();
            EpiQ E{(bf16*)(F.ws + WS_Z), (const float*)(F.ws + WS_C0) + l * DM, rrL, h0 ? u0.pm : -1};
#define GEMM_Q pg8::gemm_phase<EpiQ, pg8::StaticOrder, true, true>(F.lds, g, S, E)
            RUN2(10, GEMM_Q, GEMM_Q);
        } SEAM(pb + 9);
        if (IN(pb + 10)) { RUN2(11, phase_topk(F, l), phase_topk(F, l)); } SEAM(pb + 10);
        if (IN(pb + 11)) { RUN2(12, phase_gather(F, l, true), phase_gather(F, l, false)); } SEAM(pb + 11);
    }
#undef IN
#undef SEAM
}

extern "C" void kernel_launch(void* const* d_in, const int* in_sizes, int n_in, void* d_out, int out_size, void* d_ws, size_t ws_size, hipStream_t stream) {
    static int grid = 0;
    if (grid == 0) {
        if (n_in != 29 || out_size != M * DM || ws_size < WS_END) { fprintf(stderr, "kernel_launch: unexpected shapes (n_in %d, out %d, ws %zu); nothing launched\n", n_in, out_size, ws_size); grid = -1; return; }
        int dev = 0, cus = 0;
        if (hipGetDevice(&dev) != hipSuccess || hipDeviceGetAttribute(&cus, hipDeviceAttributeMultiprocessorCount, dev) != hipSuccess) { grid = -1; return; }
        if (hipFuncSetAttribute((const void*)fwd_kernel, hipFuncAttributeMaxDynamicSharedMemorySize, LDS_BYTES) != hipSuccess) { fprintf(stderr, "kernel_launch: hipFuncSetAttribute failed\n"); grid = -1; return; }
        (void)hipGetLastError();
        grid = cus;
    }
    if (grid < 0) return;
    (void)hipMemsetAsync((char*)d_ws + WS_CTL, 0, CTL_ZERO_BYTES, stream);
    Args a{};
    for (int i = 0; i < 29; ++i) a.in[i] = (const float*)d_in[i];
    a.out = (float*)d_out; a.ws = (unsigned char*)d_ws;
#if MK_PER_PHASE
    for (int p = 0; p < 1 + 12 * DEPTH; ++p) {
        if (p == 13) continue;
        a.ph_lo = p; a.ph_hi = p + 1; a.li = p;
        hipLaunchKernelGGL(fwd_kernel, dim3(grid), dim3(NTHR), LDS_BYTES, stream, a);
    }
#else
    a.ph_lo = 0; a.ph_hi = 1 + 12 * DEPTH; a.li = 0;
    hipLaunchKernelGGL(fwd_kernel, dim3(grid), dim3(NTHR), LDS_BYTES, stream, a);
#endif
}
```

```cpp
#include <hip/hip_runtime.h>
#include <cstdio>
#include <cstdint>

#ifndef SELFTEST_S5
#define SELFTEST_S5 0
#endif
#ifndef REPEAT_PH
#define REPEAT_PH -1
#endif
#ifndef GATHER_PROBE_HOT
#define GATHER_PROBE_HOT 0
#endif
#ifndef MK_PER_PHASE
#define MK_PER_PHASE 0
#endif

#define GAS __attribute__((address_space(1)))
#define LAS __attribute__((address_space(3)))
typedef unsigned short bf16;
typedef short bf16x8 __attribute__((ext_vector_type(8)));
typedef float f32x4 __attribute__((ext_vector_type(4)));
typedef float f32x2 __attribute__((ext_vector_type(2)));
typedef unsigned u32x4 __attribute__((ext_vector_type(4)));
typedef unsigned u32x2 __attribute__((ext_vector_type(2)));

constexpr int DM = 2048, SEQ = 16384, DEPTH = 2, M = SEQ;
constexpr int WA = 1024, WB = 1024, INW = 3072;
constexpr int NG = 64, NCH = 256;
constexpr int NEXP = 16384;
constexpr float EPS = 1e-6f;
constexpr int NWAVES = 8, NTHR = 512;

namespace pg8 {
#define PG8_LAS __attribute__((address_space(3)))
constexpr int BM = 256, BK = 64, HALF = 128, HTB = HALF * BK * 2, STAGE_BYTES = 8 * HTB, NXCD = 8, WGM = 8;
__host__ __device__ __forceinline__ int lds_byte(int r, int c) { const int st = (r >> 4) * 2 + (c >> 5), rr = r & 15, cc = c & 31, ob = rr * 64 + cc * 2; return st * 1024 + (ob ^ (((ob >> 9) & 1) << 5)); }
__host__ __device__ __forceinline__ void stage_rc(int b, int& R, int& C) { const int st = b / 1024, sb = b % 1024, swz = sb ^ (((sb >> 9) & 1) << 5); R = (st >> 1) * 16 + swz / 64; C = (st & 1) * 32 + (swz % 64) / 2; }
__host__ __device__ __forceinline__ int perm32(int rho) { const int n = rho >> 4, i = rho & 15; return 8 * (i >> 2) + 4 * n + (i & 3); }
struct Unit { int pm, pn; };
struct Gemm { const bf16* A; const bf16* Bt; int M, N, K; };
struct StaticOrder {
    int nM, nN, nwg, G, c;
    __host__ __device__ void init(int M_, int N_, int G_, int c_) { nM = M_ / BM; nN = N_ / BM; nwg = nM * nN; G = G_; c = c_; }
    __host__ __device__ bool next(int i, Unit& u) const {
        const long L = (long)i * G + c; if (L >= nwg) return false;
        int wgid = (int)L; { const int q = nwg / NXCD, r = nwg % NXCD, xcd = wgid % NXCD, off = wgid / NXCD; wgid = (xcd < r ? xcd * (q + 1) : r * (q + 1) + (xcd - r) * q) + off; }
        const int nig = WGM * nN, gid = wgid / nig, fm = gid * WGM, gsz = (nM - fm) < WGM ? (nM - fm) : WGM;
        u.pm = fm + ((wgid % nig) % gsz); u.pn = (wgid % nig) / gsz; return true;
    }
    __device__ __forceinline__ void a_ready(const Unit&) const {}
    __device__ __forceinline__ void done(const Unit&) const {}
};
__device__ __forceinline__ unsigned cvt_pk_bf16(float lo, float hi) { unsigned r; asm volatile("v_cvt_pk_bf16_f32 %0, %1, %2" : "=v"(r) : "v"(lo), "v"(hi)); return r; }

template <class Epi, class Sched, bool ALIGN_EPI = false, bool SP2 = false>
__device__ __forceinline__ void gemm_phase(PG8_LAS unsigned char* lds, const Gemm g, const Sched& S, const Epi& E) {
    int tid = threadIdx.x; asm volatile("" : "+v"(tid)); const int wid = __builtin_amdgcn_readfirstlane(tid >> 6), lane = tid & 63, wr = wid >> 2, wc = wid & 3, fr = lane & 15, fq = lane >> 4;
    const int K = g.K, nt = K / BK;
    unsigned voffA[2], voffB[2];
#pragma unroll
    for (int i = 0; i < 2; ++i) { int R, C; stage_rc(tid * 16 + i * 8192, R, C); const int Rb = Epi::PERM ? ((R & ~31) + perm32(R & 31)) : R;
        voffA[i] = (unsigned)(R * K + C) * 2u; voffB[i] = (unsigned)(Rb * K + C) * 2u; }
    const size_t kstep = (size_t)(BK * 2);
    const size_t hstep = (size_t)HALF * K * 2;
    const size_t tstep = 2 * hstep;
    const unsigned ldsw = (unsigned)wid * 1024u;
    const int aoff = lds_byte(wr * 64 + fr, fq * 8), boff = lds_byte(wc * 32 + fr, fq * 8);
#define PG8_SA(b, h) (((b) * 2 + (h)) * HTB)
#define PG8_SB(b, h) ((4 + (b) * 2 + (h)) * HTB)
#define PG8_STAGE(bufoff, gbase, voff) do { _Pragma("unroll") for (int _i = 0; _i < 2; ++_i) \
        __builtin_amdgcn_global_load_lds((const unsigned*)((const char*)(gbase) + (voff)[_i]), (PG8_LAS unsigned*)(lds + (bufoff) + ldsw + _i * 8192), 16, 0, 0); } while (0)
#define PG8_LDA(dst, b, h) do { _Pragma("unroll") for (int m = 0; m < 4; ++m) _Pragma("unroll") for (int k = 0; k < 2; ++k) dst[m][k] = *(const PG8_LAS bf16x8*)(lds + PG8_SA(b, h) + aoff + m * 2048 + k * 1024); } while (0)
#define PG8_LDB(dst, b, h) do { _Pragma("unroll") for (int n = 0; n < 2; ++n) _Pragma("unroll") for (int k = 0; k < 2; ++k) dst[n][k] = *(const PG8_LAS bf16x8*)(lds + PG8_SB(b, h) + boff + n * 2048 + k * 1024); } while (0)
#define PG8_MMA(ai, bj, At, Bt) do { __builtin_amdgcn_s_setprio(1); _Pragma("unroll") for (int m = 0; m < 4; ++m) _Pragma("unroll") for (int n = 0; n < 2; ++n) _Pragma("unroll") for (int k = 0; k < 2; ++k) \
        acc[ai][bj][m][n] = __builtin_amdgcn_mfma_f32_16x16x32_bf16(Bt[n][k], At[m][k], acc[ai][bj][m][n], 0, 0, 0); __builtin_amdgcn_s_setprio(0); } while (0)
#define PG8_WAIT_V(n) asm volatile("s_waitcnt vmcnt(" #n ")" ::: "memory")
#define PG8_WAIT_L(n) asm volatile("s_waitcnt lgkmcnt(" #n ")" ::: "memory")
#define PG8_BAR __builtin_amdgcn_s_barrier()
#define PG8_SCHED __builtin_amdgcn_sched_barrier(0)
    Unit cur, nxt; int ui = 0;
    if (!S.next(0, cur)) return;
    f32x4 acc[2][2][4][2];
#pragma unroll
    for (int a = 0; a < 2; ++a)
#pragma unroll
        for (int b = 0; b < 2; ++b)
#pragma unroll
            for (int m = 0; m < 4; ++m)
#pragma unroll
                for (int n = 0; n < 2; ++n) acc[a][b][m][n] = (f32x4){0.f, 0.f, 0.f, 0.f};
    bf16x8 At[4][2], B0[2][2], B1[2][2];
    const char* cA = (const char*)g.A + (size_t)cur.pm * tstep; const char* cB = (const char*)g.Bt + (size_t)cur.pn * tstep;
    S.a_ready(cur);
    if constexpr (SP2) {
        PG8_STAGE(PG8_SB(0, 0), cB, voffB); PG8_STAGE(PG8_SB(0, 1), cB + hstep, voffB); PG8_STAGE(PG8_SA(0, 0), cA, voffA); PG8_STAGE(PG8_SA(0, 1), cA + hstep, voffA);
        if (wr == 1) PG8_BAR;
        PG8_WAIT_V(2); PG8_BAR;
        PG8_STAGE(PG8_SB(1, 0), cB + kstep, voffB); PG8_STAGE(PG8_SA(1, 0), cA + kstep, voffA); PG8_STAGE(PG8_SB(1, 1), cB + hstep + kstep, voffB);
        PG8_WAIT_V(6); PG8_BAR;
    } else {
        PG8_STAGE(PG8_SB(0, 0), cB, voffB); PG8_STAGE(PG8_SA(0, 0), cA, voffA); PG8_STAGE(PG8_SB(0, 1), cB + hstep, voffB); PG8_STAGE(PG8_SA(0, 1), cA + hstep, voffA);
        if (wr == 1) PG8_BAR;
        PG8_WAIT_V(4); PG8_BAR;
        PG8_STAGE(PG8_SB(1, 0), cB + kstep, voffB); PG8_STAGE(PG8_SA(1, 0), cA + kstep, voffA); PG8_STAGE(PG8_SB(1, 1), cB + hstep + kstep, voffB);
        PG8_WAIT_V(6); PG8_BAR;
    }
    for (;;) {
        const bool has_next = S.next(ui + 1, nxt);
        const char* nA = has_next ? (const char*)g.A + (size_t)nxt.pm * tstep : cA; const char* nB = has_next ? (const char*)g.Bt + (size_t)nxt.pn * tstep : cB;
        for (int t = 0; t < nt; t += 2) {
            const bool last = (t == nt - 2);
            const char* a1 = cA + (size_t)(t + 1) * kstep;
            const char* a2 = last ? nA : cA + (size_t)(t + 2) * kstep; const char* b2 = last ? nB : cB + (size_t)(t + 2) * kstep;
            const char* a3 = a2 + kstep; const char* b3 = b2 + kstep;
            if (last && has_next) S.a_ready(nxt);
            if constexpr (Epi::KSPLIT) { if (t == nt / 2) E.midscale(acc, cur, wr, fr); }
            if constexpr (SP2) {
            PG8_LDB(B0, 0, 0); PG8_LDB(B1, 0, 1); PG8_SCHED; PG8_LDA(At, 0, 0); PG8_STAGE(PG8_SA(1, 1), a1 + hstep, voffA);
            PG8_WAIT_V(8); PG8_WAIT_L(0); PG8_BAR; PG8_MMA(0, 0, At, B0); PG8_MMA(0, 1, At, B1); PG8_BAR; PG8_SCHED;
            PG8_LDA(At, 0, 1); PG8_STAGE(PG8_SB(0, 0), b2, voffB); PG8_STAGE(PG8_SB(0, 1), b2 + hstep, voffB); PG8_STAGE(PG8_SA(0, 0), a2, voffA);
            PG8_WAIT_V(8); PG8_WAIT_L(0); PG8_BAR; PG8_MMA(1, 0, At, B0); PG8_MMA(1, 1, At, B1); PG8_BAR; PG8_SCHED;
            PG8_LDB(B0, 1, 0); PG8_LDB(B1, 1, 1); PG8_SCHED; PG8_LDA(At, 1, 0); PG8_STAGE(PG8_SA(0, 1), a2 + hstep, voffA);
            PG8_WAIT_V(8); PG8_WAIT_L(0); PG8_BAR; PG8_MMA(0, 0, At, B0); PG8_MMA(0, 1, At, B1); PG8_BAR; PG8_SCHED;
            PG8_LDA(At, 1, 1); PG8_STAGE(PG8_SB(1, 0), b3, voffB); PG8_STAGE(PG8_SB(1, 1), b3 + hstep, voffB); PG8_STAGE(PG8_SA(1, 0), a3, voffA);
            PG8_WAIT_V(8); PG8_WAIT_L(0); PG8_BAR; PG8_MMA(1, 0, At, B0); PG8_MMA(1, 1, At, B1); PG8_BAR; PG8_SCHED;
            } else {
            PG8_LDB(B0, 0, 0); PG8_SCHED; PG8_LDA(At, 0, 0); PG8_STAGE(PG8_SA(1, 1), a1 + hstep, voffA);
            PG8_WAIT_L(8); PG8_BAR; PG8_WAIT_L(0); PG8_MMA(0, 0, At, B0); PG8_BAR; PG8_SCHED;
            PG8_LDB(B1, 0, 1); PG8_STAGE(PG8_SB(0, 0), b2, voffB);
            PG8_BAR; PG8_WAIT_L(0); PG8_MMA(0, 1, At, B1); PG8_BAR;
            PG8_LDA(At, 0, 1); PG8_STAGE(PG8_SA(0, 0), a2, voffA);
            PG8_BAR; PG8_WAIT_L(0); PG8_MMA(1, 0, At, B0); PG8_BAR; PG8_SCHED;
            PG8_STAGE(PG8_SB(0, 1), b2 + hstep, voffB);
            PG8_WAIT_V(6); PG8_BAR; PG8_MMA(1, 1, At, B1); PG8_BAR;
            PG8_LDB(B0, 1, 0); PG8_SCHED; PG8_LDA(At, 1, 0); PG8_STAGE(PG8_SA(0, 1), a2 + hstep, voffA);
            PG8_WAIT_L(8); PG8_BAR; PG8_WAIT_L(0); PG8_MMA(0, 0, At, B0); PG8_BAR; PG8_SCHED;
            PG8_LDB(B1, 1, 1); PG8_STAGE(PG8_SB(1, 0), b3, voffB);
            PG8_BAR; PG8_WAIT_L(0); PG8_MMA(0, 1, At, B1); PG8_BAR;
            PG8_LDA(At, 1, 1); PG8_STAGE(PG8_SA(1, 0), a3, voffA);
            PG8_BAR; PG8_WAIT_L(0); PG8_MMA(1, 0, At, B0); PG8_BAR; PG8_SCHED;
            PG8_STAGE(PG8_SB(1, 1), b3 + hstep, voffB);
            PG8_WAIT_V(6); PG8_BAR; PG8_MMA(1, 1, At, B1); PG8_BAR;
            }
        }
        if constexpr (ALIGN_EPI) { if (wr == 0) PG8_BAR; }
        E(acc, cur, wr, wc, fr, fq); S.done(cur);
        if (!has_next) break;
#pragma unroll
        for (int a = 0; a < 2; ++a)
#pragma unroll
            for (int b = 0; b < 2; ++b)
#pragma unroll
                for (int m = 0; m < 4; ++m)
#pragma unroll
                    for (int n = 0; n < 2; ++n) acc[a][b][m][n] = (f32x4){0.f, 0.f, 0.f, 0.f};
        cur = nxt; cA = nA; cB = nB; ++ui;
        if constexpr (ALIGN_EPI) { if (wr == 1) PG8_BAR; }
    }
    PG8_WAIT_V(0);
    if constexpr (!ALIGN_EPI) { if (wr == 0) PG8_BAR; }
    PG8_BAR;
#undef PG8_SA
#undef PG8_SB
#undef PG8_STAGE
#undef PG8_LDA
#undef PG8_LDB
#undef PG8_MMA
#undef PG8_WAIT_V
#undef PG8_WAIT_L
#undef PG8_BAR
#undef PG8_SCHED
}
}

__device__ __forceinline__ unsigned f2bf(float f) { unsigned u = __builtin_bit_cast(unsigned, f); return (u + 0x7fffu + ((u >> 16) & 1u)) >> 16; }
__device__ __forceinline__ unsigned pk2(float lo, float hi) { return f2bf(lo) | (f2bf(hi) << 16); }
__device__ __forceinline__ float bflo(unsigned w) { return __builtin_bit_cast(float, w << 16); }
__device__ __forceinline__ float bfhi(unsigned w) { return __builtin_bit_cast(float, w & 0xffff0000u); }
__device__ __forceinline__ float fast_sigmoid(float t) { return __builtin_amdgcn_rcpf(1.0f + __builtin_amdgcn_exp2f(-1.44269504089f * t)); }
__device__ __forceinline__ float gelu_tanh(float x) { const float t = x * (1.5957691216f + 0.0713548163f * x * x); return x * fast_sigmoid(t); }
__device__ __forceinline__ float wave_sum(float v) {
#pragma unroll
    for (int o = 1; o < 64; o <<= 1) v += __shfl_xor(v, o);
    return v;
}
#define LDS_WAIT() asm volatile("s_waitcnt lgkmcnt(0)" ::: "memory")
#define VM_WAIT() asm volatile("s_waitcnt vmcnt(0)" ::: "memory")
#define RLX_AGENT __ATOMIC_RELAXED, __HIP_MEMORY_SCOPE_AGENT

constexpr size_t MiB = 1u << 20;
constexpr size_t WS_CTL = 0, CTL_ZERO_BYTES = 1 * MiB;
constexpr size_t WS_MOD   = 512 * 1024;
constexpr size_t WS_AT    = 1 * MiB + 128 * 1024;
constexpr size_t WS_STATS = WS_AT + 128 * 1024;
constexpr size_t WS_SCL   = 1 * MiB + 512 * 1024;
constexpr size_t WS_GS    = 1 * MiB + 768 * 1024;
constexpr size_t WS_C0    = WS_GS + 16 * 1024;
constexpr size_t WS_KEYS  = 2 * MiB;
constexpr size_t WS_GWS   = 3 * MiB;
constexpr size_t WS_WIN   = 4 * MiB;
constexpr size_t WS_GLU   = 28 * MiB;
constexpr size_t WS_WOUT  = 32 * MiB;
constexpr size_t WS_WQ    = 48 * MiB;
constexpr size_t WS_KTAB  = 64 * MiB;
constexpr size_t WS_WG    = 72 * MiB;
constexpr size_t WS_VG    = 104 * MiB;
constexpr size_t WS_UV    = 136 * MiB;
constexpr size_t WS_X     = 392 * MiB;
constexpr size_t WS_H     = 520 * MiB;
constexpr size_t WS_Z     = 584 * MiB;
constexpr size_t WS_XS    = 648 * MiB;
constexpr size_t WS_SLOC  = 680 * MiB;
constexpr size_t WS_PS    = 688 * MiB;
constexpr size_t WS_PSA   = 690 * MiB;
constexpr size_t WS_PSB   = 691 * MiB;
constexpr size_t WS_HS    = 692 * MiB;
constexpr size_t WS_G     = 696 * MiB;
constexpr size_t WS_MIX   = 728 * MiB;
constexpr size_t WS_EID   = 792 * MiB;
constexpr size_t WS_GATE  = 800 * MiB;
constexpr size_t WS_SU    = 808 * MiB;
constexpr size_t WS_END   = 816 * MiB;
constexpr size_t WS_DBG   = 816 * MiB;
constexpr int CW_BAR = 4096;
constexpr int CW_FLAG = 2048;
constexpr int CW_QUEUE = 16384;

constexpr int LDS_BYTES = 163840;
constexpr int MISC_OFF = LDS_BYTES - 256;

#define XB_TMO      128
#define XB_XCNT(j)  (256  + 64 * (j))
#define XB_XSUB(j)  (1280 + 64 * (j))
#define XB_XGEN(j)  (2304 + 64 * (j))
#define XB_TOP      3328
#define XB_TOPGEN   3392
#define XCD_BAR_WORDS 3456
#define XB_SPIN_CAP (1u << 24)
__device__ __forceinline__ unsigned xb_ld(unsigned* p)              { return __hip_atomic_load(p, __ATOMIC_RELAXED, __HIP_MEMORY_SCOPE_AGENT); }
__device__ __forceinline__ unsigned xb_add(unsigned* p, unsigned v) { return __hip_atomic_fetch_add(p, v, __ATOMIC_RELAXED, __HIP_MEMORY_SCOPE_AGENT); }
__device__ __forceinline__ unsigned xb_xcc_id() { return (unsigned)__builtin_amdgcn_s_getreg((3 << 11) | 20) & 0xFu; }
#define XB_SPIN(cond, bar) do { unsigned _sp = 0; while (cond) { __builtin_amdgcn_s_sleep(1); \
    if ((++_sp & 255u) == 0u) { if (xb_ld(&(bar)[XB_TMO])) break; if (_sp > XB_SPIN_CAP) { atomicAdd(&(bar)[XB_TMO], 1u); break; } } } } while (0)
struct XcdBarrier { unsigned* bar; unsigned x; volatile LAS unsigned* st; };
__device__ __forceinline__ XcdBarrier xcd_barrier_post(unsigned* bar, volatile LAS unsigned* st) {
    XcdBarrier b; b.bar = bar; b.x = xb_xcc_id(); b.st = st;
    if (threadIdx.x == 0) (void)xb_add(&bar[XB_XCNT(b.x)], 1u);
    return b;
}
__device__ __forceinline__ void xcd_barrier_complete(unsigned* bar, unsigned x, unsigned& nloc, unsigned& nx) {
    const unsigned G = gridDim.x * gridDim.y * gridDim.z;
    unsigned sum, cnt, mine, sp = 0u;
    for (;;) {
        sum = 0u; cnt = 0u; mine = 0u;
#pragma unroll
        for (unsigned j = 0; j < 16; ++j) { const unsigned c = xb_ld(&bar[XB_XCNT(j)]); sum += c; cnt += (c > 0u) ? 1u : 0u; mine = (j == x) ? c : mine; }
        if (sum == G) break;
        __builtin_amdgcn_s_sleep(1);
        if ((++sp & 255u) == 0u) { if (xb_ld(&bar[XB_TMO])) break; if (sp > XB_SPIN_CAP) { atomicAdd(&bar[XB_TMO], 1u); break; } }
    }
    nloc = mine > 0u ? mine : 1u; nx = cnt > 0u ? cnt : 1u;
}
__device__ __forceinline__ void xcd_barrier(const XcdBarrier& b) {
    asm volatile("s_waitcnt vmcnt(0)" ::: "memory");
    __syncthreads();
    if (threadIdx.x == 0) {
        unsigned* bar = b.bar;
        __builtin_amdgcn_s_waitcnt(0);
        unsigned nloc = b.st[0], nx = b.st[1];
        if (nloc == 0u) { xcd_barrier_complete(bar, b.x, nloc, nx); b.st[0] = nloc; b.st[1] = nx; }
        const unsigned old = xb_add(&bar[XB_XSUB(b.x)], 1u);
        const unsigned gen = old / nloc;
        if (old + 1u == (gen + 1u) * nloc) {
            __builtin_amdgcn_fence(__ATOMIC_RELEASE, "agent");
            asm volatile("s_waitcnt vmcnt(0)" ::: "memory");
            const unsigned og = xb_add(&bar[XB_TOP], 1u);
            const unsigned tg = og / nx;
            if (og + 1u == (tg + 1u) * nx) xb_add(&bar[XB_TOPGEN], 1u);
            else XB_SPIN(xb_ld(&bar[XB_TOPGEN]) == tg, bar);
            __builtin_amdgcn_fence(__ATOMIC_ACQUIRE, "agent");
            xb_add(&bar[XB_XGEN(b.x)], 1u);
            asm volatile("s_waitcnt vmcnt(0)" ::: "memory");
        } else {
            XB_SPIN(xb_ld(&bar[XB_XGEN(b.x)]) == gen, bar);
            __builtin_amdgcn_fence(__ATOMIC_ACQUIRE, "agent");
            asm volatile("s_waitcnt vmcnt(0)" ::: "memory");
        }
    }
    __syncthreads();
}

struct Args { const float* in[29]; float* out; unsigned char* ws; int ph_lo, ph_hi, li, pad; };
enum { I_X = 0, I_C, I_WMOD, I_BMOD, I_N1G, I_WIN, I_BIN, I_LNG, I_LNB, I_GWS, I_GBS, I_LRE, I_LIM, I_LDT, I_BRE, I_BIM, I_CRE, I_CIM, I_SD, I_GLUW, I_GLUB,
       I_BRG, I_WOUT, I_N2G, I_WQ, I_KEYS, I_PU, I_PV, I_FG };

struct Frame {
    LAS unsigned char* lds;
    unsigned char* ws;
    const float* const* in;
    float* out;
    int tid, lane, wave, vcu, G;
};

#define PH_LOCALS int tid = F.tid; asm volatile("" : "+v"(tid)); const int lane = tid & 63; const int wave = __builtin_amdgcn_readfirstlane(tid >> 6); (void)lane; (void)wave;

struct EpiIn {
    static constexpr bool PERM = true, AFTER_DRAIN = false, KSPLIT = false;
    bf16* Z; bf16* XS; const float* bias;
    __device__ __forceinline__ void operator()(const f32x4 (&acc)[2][2][4][2], const pg8::Unit& u, int wr, int wc, int fr, int fq) const {
        const int row0 = u.pm * 256 + wr * 64 + fr, col0 = u.pn * 256 + wc * 32 + 8 * fq;
        f32x4 bv[2][2];
#pragma unroll
        for (int bj = 0; bj < 2; ++bj)
#pragma unroll
            for (int n = 0; n < 2; ++n) bv[bj][n] = *(const f32x4*)(bias + col0 + bj * 128 + 4 * n);
        const bool isz = (u.pn < 8);
#pragma unroll
        for (int ai = 0; ai < 2; ++ai)
#pragma unroll
            for (int m = 0; m < 4; ++m) {
                const int r = row0 + ai * 128 + m * 16;
#pragma unroll
                for (int bj = 0; bj < 2; ++bj) {
                    f32x4 v0 = acc[ai][bj][m][0] + bv[bj][0], v1 = acc[ai][bj][m][1] + bv[bj][1];
                    const int c = col0 + bj * 128;
                    u32x4 w;
                    if (isz) {
                        w.x = pg8::cvt_pk_bf16(gelu_tanh(v0[0]), gelu_tanh(v0[1])); w.y = pg8::cvt_pk_bf16(gelu_tanh(v0[2]), gelu_tanh(v0[3]));
                        w.z = pg8::cvt_pk_bf16(gelu_tanh(v1[0]), gelu_tanh(v1[1])); w.w = pg8::cvt_pk_bf16(gelu_tanh(v1[2]), gelu_tanh(v1[3]));
                        *(u32x4*)(Z + (size_t)r * 2048 + c) = w;
                    } else {
                        w.x = pg8::cvt_pk_bf16(v0[0], v0[1]); w.y = pg8::cvt_pk_bf16(v0[2], v0[3]); w.z = pg8::cvt_pk_bf16(v1[0], v1[1]); w.w = pg8::cvt_pk_bf16(v1[2], v1[3]);
                        const int cc = c - 2048, g = cc >> 4, i = cc & 15;
                        *(u32x4*)(XS + ((size_t)(g * 256 + (r >> 6)) * 64 + (r & 63)) * 16 + i) = w;
                    }
                }
            }
    }
};
struct EpiGlu {
    static constexpr bool PERM = true, AFTER_DRAIN = false, KSPLIT = false;
    const bf16* Gb; bf16* MIX; const float* bias; float* PSB;
    __device__ __forceinline__ void operator()(const f32x4 (&acc)[2][2][4][2], const pg8::Unit& u, int wr, int wc, int fr, int fq) const {
        const int row0 = u.pm * 256 + wr * 64 + fr, col0 = u.pn * 256 + wc * 32 + 8 * fq;
        f32x4 bv[2][2];
#pragma unroll
        for (int bj = 0; bj < 2; ++bj)
#pragma unroll
            for (int n = 0; n < 2; ++n) bv[bj][n] = *(const f32x4*)(bias + col0 + bj * 128 + 4 * n);
#pragma unroll
        for (int ai = 0; ai < 2; ++ai)
#pragma unroll
            for (int m = 0; m < 4; ++m) {
                const int r = row0 + ai * 128 + m * 16; float ssq = 0.f;
#pragma unroll
                for (int bj = 0; bj < 2; ++bj) {
                    const f32x4 v0 = acc[ai][bj][m][0] + bv[bj][0], v1 = acc[ai][bj][m][1] + bv[bj][1];
                    const int c = col0 + bj * 128;
                    const u32x4 gw = *(const u32x4*)(Gb + (size_t)r * 1024 + c);
                    const float o0 = bflo(gw.x) * fast_sigmoid(v0[0]), o1 = bfhi(gw.x) * fast_sigmoid(v0[1]), o2 = bflo(gw.y) * fast_sigmoid(v0[2]), o3 = bfhi(gw.y) * fast_sigmoid(v0[3]);
                    const float o4 = bflo(gw.z) * fast_sigmoid(v1[0]), o5 = bfhi(gw.z) * fast_sigmoid(v1[1]), o6 = bflo(gw.w) * fast_sigmoid(v1[2]), o7 = bfhi(gw.w) * fast_sigmoid(v1[3]);
                    u32x4 w; w.x = pg8::cvt_pk_bf16(o0, o1); w.y = pg8::cvt_pk_bf16(o2, o3); w.z = pg8::cvt_pk_bf16(o4, o5); w.w = pg8::cvt_pk_bf16(o6, o7);
                    *(u32x4*)(MIX + (size_t)r * 2048 + 1024 + c) = w;
                    ssq += (o0 * o0 + o1 * o1) + (o2 * o2 + o3 * o3) + (o4 * o4 + o5 * o5) + (o6 * o6 + o7 * o7);
                }
                ssq += __shfl_xor(ssq, 16); ssq += __shfl_xor(ssq, 32);
                if (fq == 0) PSB[(size_t)r * 16 + u.pn * 4 + wc] = ssq;
            }
    }
};
template <bool XIN_BF16> struct EpiOut {
    static constexpr bool PERM = true, AFTER_DRAIN = false, KSPLIT = true;
    const void* xin; bf16* X; const float* gate; float* PS; const LAS float* ratL; const LAS float* rbL; int pm0;
    __device__ __forceinline__ void midscale(f32x4 (&acc)[2][2][4][2], const pg8::Unit& u, int wr, int fr) const {
        const LAS float* rp = ratL + (u.pm == pm0 ? 0 : 256) + wr * 64 + fr;
#pragma unroll
        for (int ai = 0; ai < 2; ++ai)
#pragma unroll
            for (int m = 0; m < 4; ++m) { const float rt = rp[ai * 128 + m * 16];
#pragma unroll
                for (int bj = 0; bj < 2; ++bj)
#pragma unroll
                    for (int n = 0; n < 2; ++n) acc[ai][bj][m][n] = acc[ai][bj][m][n] * rt; }
    }
    __device__ __forceinline__ void operator()(const f32x4 (&acc)[2][2][4][2], const pg8::Unit& u, int wr, int wc, int fr, int fq) const {
        const int row0 = u.pm * 256 + wr * 64 + fr, col0 = u.pn * 256 + wc * 32 + 8 * fq;
        const LAS float* rbp = rbL + (u.pm == pm0 ? 0 : 256) + wr * 64 + fr;
        f32x4 gv[2][2];
#pragma unroll
        for (int bj = 0; bj < 2; ++bj)
#pragma unroll
            for (int n = 0; n < 2; ++n) gv[bj][n] = *(const f32x4*)(gate + col0 + bj * 128 + 4 * n);
#pragma unroll
        for (int ai = 0; ai < 2; ++ai)
#pragma unroll
            for (int m = 0; m < 4; ++m) {
                const int r = row0 + ai * 128 + m * 16; float ssq = 0.f; const float rb = rbp[ai * 128 + m * 16];
#pragma unroll
                for (int bj = 0; bj < 2; ++bj) {
                    const size_t off = (size_t)r * 2048 + col0 + bj * 128;
                    f32x4 x0, x1;
                    if (XIN_BF16) { const u32x4 w = *(const u32x4*)((const bf16*)xin + off); x0 = (f32x4){bflo(w.x), bfhi(w.x), bflo(w.y), bfhi(w.y)}; x1 = (f32x4){bflo(w.z), bfhi(w.z), bflo(w.w), bfhi(w.w)}; }
                    else { x0 = *(const f32x4*)((const float*)xin + off); x1 = *(const f32x4*)((const float*)xin + off + 4); }
                    const f32x4 y0 = x0 + gv[bj][0] * (acc[ai][bj][m][0] * rb), y1 = x1 + gv[bj][1] * (acc[ai][bj][m][1] * rb);
                    u32x4 o; o.x = pg8::cvt_pk_bf16(y0[0], y0[1]); o.y = pg8::cvt_pk_bf16(y0[2], y0[3]); o.z = pg8::cvt_pk_bf16(y1[0], y1[1]); o.w = pg8::cvt_pk_bf16(y1[2], y1[3]);
                    *(u32x4*)(X + off) = o;
                    ssq += (y0[0] * y0[0] + y0[1] * y0[1]) + (y0[2] * y0[2] + y0[3] * y0[3]) + (y1[0] * y1[0] + y1[1] * y1[1]) + (y1[2] * y1[2] + y1[3] * y1[3]);
                }
                ssq += __shfl_xor(ssq, 16); ssq += __shfl_xor(ssq, 32);
                if (fq == 0) PS[(size_t)r * 32 + u.pn * 4 + wc] = ssq;
            }
    }
};
struct EpiQ {
    static constexpr bool PERM = true, AFTER_DRAIN = false, KSPLIT = false;
    bf16* Q; const float* c0; const LAS float* rrL; int pm0;
    __device__ __forceinline__ void operator()(const f32x4 (&acc)[2][2][4][2], const pg8::Unit& u, int wr, int wc, int fr, int fq) const {
        const int row0 = u.pm * 256 + wr * 64 + fr, col0 = u.pn * 256 + wc * 32 + 8 * fq;
        const LAS float* rrp = rrL + (u.pm == pm0 ? 0 : 256) + wr * 64 + fr;
        f32x4 cv[2][2];
#pragma unroll
        for (int bj = 0; bj < 2; ++bj)
#pragma unroll
            for (int n = 0; n < 2; ++n) cv[bj][n] = *(const f32x4*)(c0 + col0 + bj * 128 + 4 * n);
#pragma unroll
        for (int ai = 0; ai < 2; ++ai)
#pragma unroll
            for (int m = 0; m < 4; ++m) {
                const int r = row0 + ai * 128 + m * 16; const float rr = rrp[ai * 128 + m * 16];
#pragma unroll
                for (int bj = 0; bj < 2; ++bj) {
                    const f32x4 v0 = acc[ai][bj][m][0] * rr + cv[bj][0], v1 = acc[ai][bj][m][1] * rr + cv[bj][1];
                    u32x4 w; w.x = pg8::cvt_pk_bf16(v0[0], v0[1]); w.y = pg8::cvt_pk_bf16(v0[2], v0[3]); w.z = pg8::cvt_pk_bf16(v1[0], v1[1]); w.w = pg8::cvt_pk_bf16(v1[2], v1[3]);
                    *(u32x4*)(Q + (size_t)r * 2048 + col0 + bj * 128) = w;
                }
            }
    }
};
__device__ __forceinline__ void fill_rr(Frame& F, LAS float* rrL, int slot, int pm, int tid) {
    if (tid < 256) { const float* ps = (const float*)(F.ws + WS_PS) + ((size_t)pm * 256 + tid) * 32; float s = 0.f;
#pragma unroll
        for (int i = 0; i < 8; ++i) { const f32x4 v = *(const f32x4*)(ps + 4 * i); s += (v[0] + v[1]) + (v[2] + v[3]); }
        rrL[slot * 256 + tid] = 1.0f / sqrtf(s * (1.0f / DM) + EPS); }
}

__device__ __forceinline__ void p0_transpose_item(const float* W, int K, int N, bf16* WT, const float* kscale, LAS float* scr, int item, int lane, const float* kscale2 = nullptr) {
    const int nblk = N / 32, kb = item / nblk, nb = item % nblk, k0 = 64 * kb, n0 = 32 * nb;
    float wv[32];
#pragma unroll
    for (int i = 0; i < 32; ++i) wv[i] = W[(size_t)(k0 + 2 * i + (lane >> 5)) * N + n0 + (lane & 31)];
#pragma unroll
    for (int i = 0; i < 32; ++i) { const int kk = 2 * i + (lane >> 5); float v = wv[i]; if (kscale) { v *= kscale[k0 + kk]; if (kscale2) v *= 1.0f + kscale2[k0 + kk]; } scr[kk * 33 + (lane & 31)] = v; }
    LDS_WAIT(); asm volatile("" ::: "memory");
    const int c = lane & 7;
#pragma unroll
    for (int j = 0; j < 4; ++j) { const int n = (lane >> 3) + 8 * j; const LAS float* s = scr + (8 * c) * 33 + n;
        u32x4 o; o.x = pk2(s[0 * 33], s[1 * 33]); o.y = pk2(s[2 * 33], s[3 * 33]); o.z = pk2(s[4 * 33], s[5 * 33]); o.w = pk2(s[6 * 33], s[7 * 33]);
        *(u32x4*)(WT + (size_t)(n0 + n) * K + k0 + 8 * c) = o; }
    LDS_WAIT(); asm volatile("" ::: "memory");
}

__device__ __forceinline__ void norm_mod_row(const f32x4 (&v)[4][2], const float* gain, const float* scale, const float* shift, int lane, u32x4 (&o)[4]) {
    float s = 0.f;
#pragma unroll
    for (int j = 0; j < 4; ++j)
#pragma unroll
        for (int h = 0; h < 2; ++h) s += (v[j][h][0] * v[j][h][0] + v[j][h][1] * v[j][h][1]) + (v[j][h][2] * v[j][h][2] + v[j][h][3] * v[j][h][3]);
    const float rr = 1.0f / sqrtf(wave_sum(s) * (1.0f / DM) + EPS);
#pragma unroll
    for (int j = 0; j < 4; ++j) {
        const int c = j * 512 + lane * 8;
        f32x4 y[2];
#pragma unroll
        for (int h = 0; h < 2; ++h) {
            const f32x4 g = *(const f32x4*)(gain + c + 4 * h);
            y[h] = v[j][h] * rr * g;
            const f32x4 sc = *(const f32x4*)(scale + c + 4 * h), sh = *(const f32x4*)(shift + c + 4 * h); y[h] = y[h] * (sc + 1.0f) + sh;
        }
        o[j].x = pk2(y[0][0], y[0][1]); o[j].y = pk2(y[0][2], y[0][3]); o[j].z = pk2(y[1][0], y[1][1]); o[j].w = pk2(y[1][2], y[1][3]);
    }
}
template <bool SRC_BF16>
__device__ __forceinline__ void load_row(const void* xrow_, int lane, f32x4 (&v)[4][2]) {
#pragma unroll
    for (int j = 0; j < 4; ++j) {
        if (SRC_BF16) { const u32x4 w = *(const u32x4*)((const bf16*)xrow_ + j * 512 + lane * 8); v[j][0] = (f32x4){bflo(w.x), bfhi(w.x), bflo(w.y), bfhi(w.y)}; v[j][1] = (f32x4){bflo(w.z), bfhi(w.z), bflo(w.w), bfhi(w.w)}; }
        else { const float* xrow = (const float*)xrow_; v[j][0] = *(const f32x4*)(xrow + j * 512 + lane * 8); v[j][1] = *(const f32x4*)(xrow + j * 512 + lane * 8 + 4); } }
}

__device__ __forceinline__ void p0_gemv_unit(Frame& F, int unit, int tid, float* modout) {
    const int l = unit / 192, r = unit % 192, cb = r >> 1, kh = r & 1;
    LAS float* sc = (LAS float*)F.lds;
    LAS float* red = (LAS float*)(F.lds + 4096);
    for (int k = tid; k < 1024; k += NTHR) { const float c = F.in[I_C][kh * 1024 + k]; sc[k] = c * fast_sigmoid(c); }
    __syncthreads();
    const int tx = tid & 31, ty = tid >> 5;
    const float* W = F.in[I_WMOD] + ((size_t)l * DM + kh * 1024) * 12288 + cb * 128 + tx * 4;
    f32x4 a = {0.f, 0.f, 0.f, 0.f};
#pragma unroll 16
    for (int k = ty; k < 1024; k += 16) { const f32x4 w = *(const f32x4*)(W + (size_t)k * 12288); a += w * sc[k]; }
    *(LAS f32x4*)(red + ty * 128 + tx * 4) = a;
    __syncthreads();
    if (tid < 128) { float s = 0.f;
#pragma unroll
        for (int y = 0; y < 16; ++y) s += red[y * 128 + tid];
        if (kh == 0) s += F.in[I_BMOD][l * 12288 + cb * 128 + tid];
        atomicAdd(modout + l * 12288 + cb * 128 + tid, s); }
    __syncthreads();
}
__device__ __forceinline__ void p0_s5_unit(Frame& F, int unit, int tid, int parts = 15) {
    const int l = unit >> 7, g = (unit >> 1) & 63, hf = unit & 1;
    LAS float* apr = (LAS float*)F.lds;
    LAS float* api = apr + 4228;
    LAS float* bbr = api + 4228;
    LAS float* bbi = bbr + 1024;
    LAS float* ccr = bbi + 1024;
    LAS float* cci = ccr + 16 * 65;
    const float dt = expf(F.in[I_LDT][l * 64 + g]);
    const float* lre = F.in[I_LRE] + (l * 64 + g) * 64; const float* lim = F.in[I_LIM] + (l * 64 + g) * 64;
    for (int idx = tid; idx < 65 * 64; idx += NTHR) { const int d = idx >> 6, p = idx & 63;
        const float mag = expf(lre[p] * dt * (float)d); float sn, cs; sincosf(lim[p] * dt * (float)d, &sn, &cs);
        apr[d * 65 + p] = mag * cs; api[d * 65 + p] = mag * sn; }
    for (int idx = tid; idx < 1024; idx += NTHR) { const int o = idx >> 6, p = idx & 63;
        ccr[o * 65 + p] = F.in[I_CRE][((size_t)(l * 64 + g) * 16 + o) * 64 + p]; cci[o * 65 + p] = F.in[I_CIM][((size_t)(l * 64 + g) * 16 + o) * 64 + p]; }
    __syncthreads();
    for (int idx = tid; idx < 1024; idx += NTHR) { const int p = idx >> 4, i = idx & 15;
        const float xr = apr[65 + p] - 1.0f, xi = api[65 + p], lr = lre[p], li = lim[p], den = 1.0f / (lr * lr + li * li);
        const float cr = (xr * lr + xi * li) * den, ci = (xi * lr - xr * li) * den;
        const float br = F.in[I_BRE][((size_t)(l * 64 + g) * 64 + p) * 16 + i], bi = F.in[I_BIM][((size_t)(l * 64 + g) * 64 + p) * 16 + i];
        bbr[idx] = cr * br - ci * bi; bbi[idx] = cr * bi + ci * br; }
    __syncthreads();
    bf16* KT = (bf16*)(F.ws + WS_KTAB) + (size_t)(l * 64 + g) * 80 * 256;
    if (parts & 1) {
        const int d = hf * 32 + (tid >> 4), o = tid & 15;
        const float dskip = F.in[I_SD][l * 1024 + g * 16 + o];
        float s[16];
#pragma unroll
        for (int i = 0; i < 16; ++i) s[i] = 0.f;
        for (int p = 0; p < 64; ++p) { const float ar = apr[d * 65 + p], ai = api[d * 65 + p], cr = ccr[o * 65 + p], ci = cci[o * 65 + p];
            const float er = cr * ar - ci * ai, ei = cr * ai + ci * ar;
#pragma unroll
            for (int q = 0; q < 4; ++q) { const f32x4 br = *(const LAS f32x4*)(bbr + p * 16 + 4 * q), bi = *(const LAS f32x4*)(bbi + p * 16 + 4 * q);
#pragma unroll
                for (int e = 0; e < 4; ++e) s[4 * q + e] += er * br[e] - ei * bi[e]; } }
#if !SELFTEST_S5
        {   const float dsk = (d == 0) ? dskip : 0.f;
#pragma unroll
            for (int i = 0; i < 16; ++i) s[i] += (i == o) ? dsk : 0.f; }
#endif
        u32x4 w0, w1;
        w0.x = pk2(s[0], s[1]); w0.y = pk2(s[2], s[3]); w0.z = pk2(s[4], s[5]); w0.w = pk2(s[6], s[7]);
        w1.x = pk2(s[8], s[9]); w1.y = pk2(s[10], s[11]); w1.z = pk2(s[12], s[13]); w1.w = pk2(s[14], s[15]);
        if ((parts & 8) || w0.x == 0x12345678u) { *(u32x4*)(KT + (size_t)(d + 16) * 256 + o * 16) = w0; *(u32x4*)(KT + (size_t)(d + 16) * 256 + o * 16 + 8) = w1; }
        if ((parts & 8) && hf == 0 && tid < 256) { const u32x4 z = {0u, 0u, 0u, 0u}; *(u32x4*)(KT + tid * 16) = z; *(u32x4*)(KT + tid * 16 + 8) = z; }
    }
    bf16* WG = (bf16*)(F.ws + WS_WG) + (size_t)(l * 64 + g) * 128 * 1024;
    if (parts & 2) for (int it = tid; it < 32 * 64; it += NTHR) { const int p = hf * 32 + (it >> 6), tau = it & 63;
        const float ar = apr[(63 - tau) * 65 + p], ai = api[(63 - tau) * 65 + p];
        unsigned wr_[8], wi_[8];
#pragma unroll
        for (int q = 0; q < 4; ++q) { const f32x4 br = *(const LAS f32x4*)(bbr + p * 16 + 4 * q), bi = *(const LAS f32x4*)(bbi + p * 16 + 4 * q);
            wr_[2 * q] = pk2(ar * br[0] - ai * bi[0], ar * br[1] - ai * bi[1]); wr_[2 * q + 1] = pk2(ar * br[2] - ai * bi[2], ar * br[3] - ai * bi[3]);
            wi_[2 * q] = pk2(ar * bi[0] + ai * br[0], ar * bi[1] + ai * br[1]); wi_[2 * q + 1] = pk2(ar * bi[2] + ai * br[2], ar * bi[3] + ai * br[3]); }
        *(u32x4*)(WG + (size_t)p * 1024 + tau * 16) = (u32x4){wr_[0], wr_[1], wr_[2], wr_[3]}; *(u32x4*)(WG + (size_t)p * 1024 + tau * 16 + 8) = (u32x4){wr_[4], wr_[5], wr_[6], wr_[7]};
        *(u32x4*)(WG + (size_t)(64 + p) * 1024 + tau * 16) = (u32x4){wi_[0], wi_[1], wi_[2], wi_[3]}; *(u32x4*)(WG + (size_t)(64 + p) * 1024 + tau * 16 + 8) = (u32x4){wi_[4], wi_[5], wi_[6], wi_[7]}; }
    bf16* VG = (bf16*)(F.ws + WS_VG) + (size_t)(l * 64 + g) * 1024 * 128;
    if (parts & 4) for (int it = tid; it < 512 * 8; it += NTHR) { const int m = hf * 512 + (it >> 3), p0 = (it & 7) * 8, t = m >> 4, o = m & 15;
        float vr_[8], vi_[8];
#pragma unroll
        for (int e = 0; e < 8; ++e) { const float ar = apr[(t + 1) * 65 + p0 + e], ai = api[(t + 1) * 65 + p0 + e], cr = ccr[o * 65 + p0 + e], ci = cci[o * 65 + p0 + e];
            vr_[e] = cr * ar - ci * ai; vi_[e] = -(cr * ai + ci * ar); }
        *(u32x4*)(VG + (size_t)m * 128 + p0) = (u32x4){pk2(vr_[0], vr_[1]), pk2(vr_[2], vr_[3]), pk2(vr_[4], vr_[5]), pk2(vr_[6], vr_[7])};
        *(u32x4*)(VG + (size_t)m * 128 + 64 + p0) = (u32x4){pk2(vi_[0], vi_[1]), pk2(vi_[2], vi_[3]), pk2(vi_[4], vi_[5]), pk2(vi_[6], vi_[7])}; }
    if (hf == 0 && tid < 64) { float* AT = (float*)(F.ws + WS_AT) + ((size_t)(l * 64 + g) * 64 + tid) * 2; AT[0] = apr[64 * 65 + tid]; AT[1] = api[64 * 65 + tid]; }
    __syncthreads();
}
__device__ __forceinline__ void p0_fp4_chunk(Frame& F, int chunk, int wave, int lane) {
    unsigned char* UV = F.ws + WS_UV; float* SCL = (float*)(F.ws + WS_SCL);
    for (int i = 0; i < 8; i += 2) {
        f32x4 v[2][8]; float am[2] = {0.f, 0.f}; int tbl[2], rr[2];
#pragma unroll
        for (int r2 = 0; r2 < 2; ++r2) {
            const int r = chunk * 64 + wave * 8 + i + r2; tbl[r2] = r >> 15; rr[r2] = r & 32767;
            const float* srcp = (tbl[r2] ? F.in[I_PV] : F.in[I_PU]) + (size_t)rr[r2] * 2048 + lane * 4;
#pragma unroll
            for (int j = 0; j < 8; ++j) v[r2][j] = *(const f32x4*)(srcp + j * 256);
        }
#pragma unroll
        for (int r2 = 0; r2 < 2; ++r2)
#pragma unroll
            for (int j = 0; j < 8; ++j) am[r2] = fmaxf(am[r2], fmaxf(fmaxf(fabsf(v[r2][j][0]), fabsf(v[r2][j][1])), fmaxf(fabsf(v[r2][j][2]), fabsf(v[r2][j][3]))));
#pragma unroll
        for (int o = 1; o < 64; o <<= 1) { am[0] = fmaxf(am[0], __shfl_xor(am[0], o)); am[1] = fmaxf(am[1], __shfl_xor(am[1], o)); }
#pragma unroll
        for (int r2 = 0; r2 < 2; ++r2) {
            const float scale = am[r2] > 0.f ? am[r2] * (1.0f / 6.0f) : 1.0f, inv = am[r2] > 0.f ? 6.0f / am[r2] : 1.0f;
            u32x4 o;
#pragma unroll
            for (int d = 0; d < 4; ++d) { unsigned w = 0u;
                w = __builtin_amdgcn_cvt_scalef32_pk_fp4_f32(w, v[r2][2 * d][0] * inv, v[r2][2 * d][1] * inv, 1.0f, 0);
                w = __builtin_amdgcn_cvt_scalef32_pk_fp4_f32(w, v[r2][2 * d][2] * inv, v[r2][2 * d][3] * inv, 1.0f, 1);
                w = __builtin_amdgcn_cvt_scalef32_pk_fp4_f32(w, v[r2][2 * d + 1][0] * inv, v[r2][2 * d + 1][1] * inv, 1.0f, 2);
                w = __builtin_amdgcn_cvt_scalef32_pk_fp4_f32(w, v[r2][2 * d + 1][2] * inv, v[r2][2 * d + 1][3] * inv, 1.0f, 3);
                o[d] = w; }
            *(u32x4*)(UV + (size_t)rr[r2] * 2048 + tbl[r2] * 1024 + lane * 16) = o;
            if (lane == 0) SCL[rr[r2] * 2 + tbl[r2]] = scale;
        }
    }
}
#ifndef P0_PARTS
#define P0_PARTS 15
#endif
#ifndef P0_PROBE_MODE
#define P0_PROBE_MODE 0
#endif
__device__ __forceinline__ void p0_tables(Frame& F, int qi = 4, bool dummy = false) {
    PH_LOCALS
    unsigned* head = (unsigned*)(F.ws + WS_CTL) + CW_QUEUE + 64 * qi;
    float* modout = dummy ? (float*)(F.ws + WS_DBG) : (float*)(F.ws + WS_MOD);
    LAS unsigned* slot = (LAS unsigned*)(F.lds + MISC_OFF) + 16;
    for (;;) {
        __syncthreads();
        if (tid == 0) slot[0] = __hip_atomic_fetch_add(head, 1u, RLX_AGENT);
        __syncthreads();
        const unsigned u = slot[0];
        if (u >= 1664u) break;
        const int rnd = (int)u / 13, k = (int)u % 13;
        if (k < 2) { if (dummy && P0_PROBE_MODE == 2) continue; p0_s5_unit(F, rnd * 2 + k, tid, dummy ? P0_PARTS : 15); }
        else if (k < 5) { if (dummy && P0_PROBE_MODE == 1) continue; p0_gemv_unit(F, rnd * 3 + (k - 2), tid, modout); }
        else { p0_fp4_chunk(F, rnd * 8 + (k - 5), wave, lane); }
    }
}
__device__ __forceinline__ void p0_prologue(Frame& F) {
    PH_LOCALS
    const int gw = F.vcu * NWAVES + wave, NGW = F.G * NWAVES;
    const int gt = F.vcu * NTHR + tid, NGT = F.G * NTHR;
    const float* modp = (const float*)(F.ws + WS_MOD);
    for (int i = gt; i < 2 * DM; i += NGT) { const int l = i >> 11, k = i & 2047; ((float*)(F.ws + WS_GS))[i] = F.in[I_N2G][i] * (1.0f + modp[l * 12288 + 4 * 2048 + k]); }
    if (F.vcu < 64) {
        const int l = F.vcu >> 5, cb = F.vcu & 31, tx = tid & 15, ty = tid >> 4;
        const float* W = F.in[I_WQ] + (size_t)l * DM * DM + cb * 64 + tx * 4; const float* sh = modp + l * 12288 + 3 * 2048;
        f32x4 a = {0.f, 0.f, 0.f, 0.f};
#pragma unroll 16
        for (int k = ty; k < DM; k += 32) { const f32x4 w = *(const f32x4*)(W + (size_t)k * DM); a += w * sh[k]; }
        LAS float* red = (LAS float*)F.lds;
        *(LAS f32x4*)(red + ty * 64 + tx * 4) = a;
        __syncthreads();
        if (tid < 64) { float s = 0.f;
#pragma unroll
            for (int y = 0; y < 32; ++y) s += red[y * 64 + tid];
            ((float*)(F.ws + WS_C0))[l * DM + cb * 64 + tid] = s; }
        __syncthreads();
    }
    {
        LAS float* scr = (LAS float*)(F.lds + wave * 16384);
        constexpr int I_IN = (DM / 64) * (INW / 32), I_GL = (WB / 64) * (WB / 32), I_OU = (DM / 64) * (DM / 32), I_Q = I_OU;
        constexpr int PER_L = I_IN + I_GL + I_OU + I_Q;
        for (int it = gw; it < 2 * PER_L; it += NGW) {
            const int l = it / PER_L; int r = it % PER_L;
            if (r < I_IN) { p0_transpose_item(F.in[I_WIN] + (size_t)l * DM * INW, DM, INW, (bf16*)(F.ws + WS_WIN) + (size_t)l * INW * DM, nullptr, scr, r, lane); continue; } r -= I_IN;
            if (r < I_GL) { p0_transpose_item(F.in[I_GLUW] + (size_t)l * WB * WB, WB, WB, (bf16*)(F.ws + WS_GLU) + (size_t)l * WB * WB, nullptr, scr, r, lane); continue; } r -= I_GL;
            if (r < I_OU) { p0_transpose_item(F.in[I_WOUT] + (size_t)l * DM * DM, DM, DM, (bf16*)(F.ws + WS_WOUT) + (size_t)l * DM * DM, F.in[I_BRG] + l * DM, scr, r, lane); continue; } r -= I_OU;
            p0_transpose_item(F.in[I_WQ] + (size_t)l * DM * DM, DM, DM, (bf16*)(F.ws + WS_WQ) + (size_t)l * DM * DM, F.in[I_N2G] + l * DM, scr, r, lane, modp + l * 12288 + 4 * 2048);
        }
    }
    {
        bf16* KB = (bf16*)(F.ws + WS_KEYS);
        for (int i = gt; i < 2 * 8 * 2 * 128 * 128 / 8; i += NGT) { const f32x4 a = *(const f32x4*)(F.in[I_KEYS] + (size_t)i * 8), b = *(const f32x4*)(F.in[I_KEYS] + (size_t)i * 8 + 4);
            u32x4 o; o.x = pk2(a[0], a[1]); o.y = pk2(a[2], a[3]); o.z = pk2(b[0], b[1]); o.w = pk2(b[2], b[3]); *(u32x4*)(KB + (size_t)i * 8) = o; }
        bf16* GW = (bf16*)(F.ws + WS_GWS);
        for (int i = gt; i < 2 * 8 * 128 * 128 / 8; i += NGT) { const int e = i * 8, jj = e & 127, ii = (e >> 7) & 127; const bool keep = (ii >= 64) || (jj < 64);
            f32x4 a = *(const f32x4*)(F.in[I_GWS] + (size_t)i * 8), b = *(const f32x4*)(F.in[I_GWS] + (size_t)i * 8 + 4);
            if (!keep) { a = (f32x4){0.f, 0.f, 0.f, 0.f}; b = a; }
            u32x4 o; o.x = pk2(a[0], a[1]); o.y = pk2(a[2], a[3]); o.z = pk2(b[0], b[1]); o.w = pk2(b[2], b[3]); *(u32x4*)(GW + (size_t)i * 8) = o; }
    }
}

template <bool SRC_BF16>
__device__ __forceinline__ void phase_norm(Frame& F, const void* xsrc, const float* gain, const float* scale, const float* shift) {
    PH_LOCALS
    const int gw = F.vcu * NWAVES + wave, NGW = F.G * NWAVES;
    bf16* H = (bf16*)(F.ws + WS_H);
    for (int m = gw; m < M; m += 2 * NGW) {
        const int m2 = m + NGW;
        f32x4 va[4][2], vb[4][2];
        const char* ra = (const char*)xsrc + (size_t)m * DM * (SRC_BF16 ? 2 : 4); const char* rb = (const char*)xsrc + (size_t)(m2 < M ? m2 : m) * DM * (SRC_BF16 ? 2 : 4);
        load_row<SRC_BF16>(ra, lane, va); load_row<SRC_BF16>(rb, lane, vb);
        u32x4 oa[4], ob[4]; norm_mod_row(va, gain, scale, shift, lane, oa); norm_mod_row(vb, gain, scale, shift, lane, ob);
#pragma unroll
        for (int j = 0; j < 4; ++j) *(u32x4*)(H + (size_t)m * DM + j * 512 + lane * 8) = oa[j];
        if (m2 < M) {
#pragma unroll
            for (int j = 0; j < 4; ++j) *(u32x4*)(H + (size_t)m2 * DM + j * 512 + lane * 8) = ob[j]; }
    }
}
__device__ __forceinline__ void phase_lnstats(Frame& F) {
    PH_LOCALS
    const int gw = F.vcu * NWAVES + wave, NGW = F.G * NWAVES;
    const bf16* Z = (const bf16*)(F.ws + WS_Z); float* ST = (float*)(F.ws + WS_STATS);
    for (int m0 = gw; m0 < M; m0 += 2 * NGW) {
        float v[2][16]; int mm[2];
#pragma unroll
        for (int r = 0; r < 2; ++r) { mm[r] = (m0 + r * NGW < M) ? m0 + r * NGW : m0;
#pragma unroll
            for (int j = 0; j < 2; ++j) { const u32x4 w = *(const u32x4*)(Z + (size_t)mm[r] * 2048 + 1024 + j * 512 + lane * 8);
                v[r][j * 8 + 0] = bflo(w.x); v[r][j * 8 + 1] = bfhi(w.x); v[r][j * 8 + 2] = bflo(w.y); v[r][j * 8 + 3] = bfhi(w.y); v[r][j * 8 + 4] = bflo(w.z); v[r][j * 8 + 5] = bfhi(w.z); v[r][j * 8 + 6] = bflo(w.w); v[r][j * 8 + 7] = bfhi(w.w); } }
        float s[2] = {0.f, 0.f};
#pragma unroll
        for (int r = 0; r < 2; ++r)
#pragma unroll
            for (int i = 0; i < 16; ++i) s[r] += v[r][i];
#pragma unroll
        for (int o = 1; o < 64; o <<= 1) { s[0] += __shfl_xor(s[0], o); s[1] += __shfl_xor(s[1], o); }
        float q[2] = {0.f, 0.f}; const float mean[2] = {s[0] * (1.0f / 1024.0f), s[1] * (1.0f / 1024.0f)};
#pragma unroll
        for (int r = 0; r < 2; ++r)
#pragma unroll
            for (int i = 0; i < 16; ++i) { const float d = v[r][i] - mean[r]; q[r] += d * d; }
#pragma unroll
        for (int o = 1; o < 64; o <<= 1) { q[0] += __shfl_xor(q[0], o); q[1] += __shfl_xor(q[1], o); }
        if (lane < 2) { const int r = lane; const float qq = r ? q[1] : q[0], mu = r ? mean[1] : mean[0]; const int m = r ? mm[1] : mm[0];
            ST[2 * m] = mu; ST[2 * m + 1] = 1.0f / sqrtf(qq * (1.0f / 1024.0f) + EPS); }
    }
}
__device__ __forceinline__ void phase_branchnorm(Frame& F) {
    PH_LOCALS
    const int gw = F.vcu * NWAVES + wave, NGW = F.G * NWAVES;
    bf16* MIX = (bf16*)(F.ws + WS_MIX);
    for (int m0 = gw; m0 < M; m0 += 2 * NGW) {
        u32x4 w[2][4]; float sa[2] = {0.f, 0.f}, sb[2] = {0.f, 0.f}; int mm[2];
#pragma unroll
        for (int r = 0; r < 2; ++r) { mm[r] = (m0 + r * NGW < M) ? m0 + r * NGW : m0;
#pragma unroll
            for (int j = 0; j < 4; ++j) w[r][j] = *(const u32x4*)(MIX + (size_t)mm[r] * 2048 + j * 512 + lane * 8); }
#pragma unroll
        for (int r = 0; r < 2; ++r)
#pragma unroll
            for (int j = 0; j < 4; ++j) { float q = 0.f;
#pragma unroll
                for (int e = 0; e < 4; ++e) { const float a = bflo(w[r][j][e]), b = bfhi(w[r][j][e]); q += a * a + b * b; }
                if (j < 2) sa[r] += q; else sb[r] += q; }
#pragma unroll
        for (int o = 1; o < 64; o <<= 1) { sa[0] += __shfl_xor(sa[0], o); sb[0] += __shfl_xor(sb[0], o); sa[1] += __shfl_xor(sa[1], o); sb[1] += __shfl_xor(sb[1], o); }
#pragma unroll
        for (int r = 0; r < 2; ++r) {
            if (r == 1 && mm[1] == mm[0]) break;
            const float ra = 1.0f / sqrtf(sa[r] * (1.0f / 1024.0f) + EPS), rb = 1.0f / sqrtf(sb[r] * (1.0f / 1024.0f) + EPS);
#pragma unroll
            for (int j = 0; j < 4; ++j) { const float rs = j < 2 ? ra : rb; u32x4 o;
#pragma unroll
                for (int e = 0; e < 4; ++e) o[e] = pk2(bflo(w[r][j][e]) * rs, bfhi(w[r][j][e]) * rs);
                *(u32x4*)(MIX + (size_t)mm[r] * 2048 + j * 512 + lane * 8) = o; }
        }
    }
}

__device__ __forceinline__ void phase_sloc(Frame& F, int l) {
    PH_LOCALS
    const bf16* XS = (const bf16*)(F.ws + WS_XS); const bf16* WG = (const bf16*)(F.ws + WS_WG) + (size_t)l * 64 * 128 * 1024; float* SL = (float*)(F.ws + WS_SLOC);
    LAS unsigned char* WL = F.lds;
    const int fr = lane & 15, fq = lane >> 4;
    for (int u = F.vcu; u < 256; u += F.G) {
        const int g = u >> 2, jq = u & 3;
        const bf16* xp0 = XS + ((size_t)(g * 256 + 32 * wave + fr)) * 1024 + 8 * fq;
        bf16x8 xa[8][2];
#pragma unroll
        for (int i = 0; i < 8; ++i) { xa[i][0] = *(const bf16x8*)(xp0 + i * 32); xa[i][1] = *(const bf16x8*)(xp0 + 16 * 1024 + i * 32); }
        __syncthreads();
#pragma unroll
        for (int ps = 0; ps < 8; ++ps) { const int idx = ps * 512 + tid, row = idx >> 7, c16 = idx & 127;
            *(LAS u32x4*)(WL + row * 2064 + c16 * 16) = *(const u32x4*)(WG + ((size_t)(g * 128 + jq * 32 + row)) * 1024 + c16 * 8); }
        __syncthreads();
        f32x4 acc[2][2];
#pragma unroll
        for (int a = 0; a < 2; ++a) { acc[a][0] = (f32x4){0.f, 0.f, 0.f, 0.f}; acc[a][1] = acc[a][0]; }
#pragma unroll 1
        for (int kg = 0; kg < 4; ++kg) {
            bf16x8 xn[8][2];
            if (kg < 3) {
#pragma unroll
                for (int i = 0; i < 8; ++i) { xn[i][0] = *(const bf16x8*)(xp0 + ((kg + 1) * 8 + i) * 32); xn[i][1] = *(const bf16x8*)(xp0 + 16 * 1024 + ((kg + 1) * 8 + i) * 32); }
            }
#pragma unroll
            for (int i = 0; i < 8; ++i) { const int kb = kg * 8 + i;
#pragma unroll
                for (int jt = 0; jt < 2; ++jt) { const bf16x8 wf = *(const LAS bf16x8*)(WL + (jt * 16 + fr) * 2064 + (kb * 32 + 8 * fq) * 2);
                    acc[0][jt] = __builtin_amdgcn_mfma_f32_16x16x32_bf16(wf, xa[i][0], acc[0][jt], 0, 0, 0);
                    acc[1][jt] = __builtin_amdgcn_mfma_f32_16x16x32_bf16(wf, xa[i][1], acc[1][jt], 0, 0, 0); } }
            if (kg < 3) {
#pragma unroll
                for (int i = 0; i < 8; ++i) { xa[i][0] = xn[i][0]; xa[i][1] = xn[i][1]; }
            }
        }
#pragma unroll
        for (int a = 0; a < 2; ++a)
#pragma unroll
            for (int jt = 0; jt < 2; ++jt) *(f32x4*)(SL + ((size_t)(g * 256 + 32 * wave + 16 * a + fr)) * 128 + jq * 32 + jt * 16 + 4 * fq) = acc[a][jt];
    }
    __syncthreads();
}
__device__ __forceinline__ void gating_unit(Frame& F, int l, int unit) {
    PH_LOCALS
    const int nb = unit >> 3, hh = unit & 7, t0 = nb * 128, c0 = hh * 128;
    const bf16* Z = (const bf16*)(F.ws + WS_Z); const float* ST = (const float*)(F.ws + WS_STATS);
    const bf16* GW = (const bf16*)(F.ws + WS_GWS) + (size_t)(l * 8 + hh) * 128 * 128;
    bf16* MIX = (bf16*)(F.ws + WS_MIX);
    LAS bf16* VT = (LAS bf16*)F.lds;
    constexpr int VS = 136;
    {
        const int j = tid >> 2, cs = (tid & 3) * 32;
        const float mu = ST[2 * (t0 + j)], rs = ST[2 * (t0 + j) + 1];
        const float* lg = F.in[I_LNG] + l * 1024 + c0 + cs; const float* lb = F.in[I_LNB] + l * 1024 + c0 + cs;
#pragma unroll
        for (int q = 0; q < 4; ++q) {
            const u32x4 w = *(const u32x4*)(Z + (size_t)(t0 + j) * 2048 + 1024 + c0 + cs + q * 8);
#pragma unroll
            for (int e = 0; e < 4; ++e) { const int c = cs + q * 8 + 2 * e;
                const float a = (bflo(w[e]) - mu) * rs * lg[q * 8 + 2 * e] + lb[q * 8 + 2 * e], b = (bfhi(w[e]) - mu) * rs * lg[q * 8 + 2 * e + 1] + lb[q * 8 + 2 * e + 1];
                VT[c * VS + j] = (bf16)f2bf(a); VT[(c + 1) * VS + j] = (bf16)f2bf(b); }
        }
    }
    __syncthreads();
    {
        const int fr = lane & 15, fq = lane >> 4, w = wave;
        f32x4 acc[8];
#pragma unroll
        for (int ct = 0; ct < 8; ++ct) acc[ct] = (f32x4){0.f, 0.f, 0.f, 0.f};
        const int nkb = (w < 4) ? 2 : 4;
        for (int kb = 0; kb < nkb; ++kb) {
            const bf16x8 wf = *(const bf16x8*)(GW + (size_t)(16 * w + fr) * 128 + kb * 32 + 8 * fq);
#pragma unroll
            for (int ct = 0; ct < 8; ++ct) { const bf16x8 vf = *(const LAS bf16x8*)(VT + (ct * 16 + fr) * VS + kb * 32 + 8 * fq); acc[ct] = __builtin_amdgcn_mfma_f32_16x16x32_bf16(vf, wf, acc[ct], 0, 0, 0); }
        }
        const int tok = t0 + 16 * w + fr; const float bs = F.in[I_GBS][(l * 8 + hh) * 128 + 16 * w + fr]; float ssq = 0.f;
#pragma unroll
        for (int ct = 0; ct < 8; ++ct) { const int c = c0 + ct * 16 + 4 * fq;
            const u32x2 uw = *(const u32x2*)(Z + (size_t)tok * 2048 + c);
            const float o0 = bflo(uw.x) * (acc[ct][0] + bs), o1 = bfhi(uw.x) * (acc[ct][1] + bs), o2 = bflo(uw.y) * (acc[ct][2] + bs), o3 = bfhi(uw.y) * (acc[ct][3] + bs);
            u32x2 o; o.x = pk2(o0, o1); o.y = pk2(o2, o3);
            *(u32x2*)(MIX + (size_t)tok * 2048 + c) = o; ssq += (o0 * o0 + o1 * o1) + (o2 * o2 + o3 * o3); }
        ssq += __shfl_xor(ssq, 16); ssq += __shfl_xor(ssq, 32);
        if (fq == 0) ((float*)(F.ws + WS_PSA))[(size_t)tok * 8 + hh] = ssq;
    }
    __syncthreads();
}
__device__ __forceinline__ void phase_gating(Frame& F, int l) {
    for (int u = F.vcu; u < 1024; u += F.G) gating_unit(F, l, u);
}

__device__ __forceinline__ void phase_s5out(Frame& F, int l) {
    PH_LOCALS
    const bf16* XS = (const bf16*)(F.ws + WS_XS);
    bf16* Gb = (bf16*)(F.ws + WS_G);
    LAS unsigned char* HT = F.lds;
    LAS float* TS = (LAS float*)(F.lds + 34816);
    LAS unsigned char* KT = F.lds + 38912;
    LAS unsigned char* VT = F.lds + 79872;
    const int fr = lane & 15, fq = lane >> 4;
    for (int u = F.vcu; u < 512; u += F.G) {
        const int g = u >> 3, rc = (u >> 1) & 3, nh = u & 1;
        const bf16* VG = (const bf16*)(F.ws + WS_VG) + (size_t)(l * 64 + g) * 1024 * 128;
        const int n = nh * 128 + 16 * wave + fr;
        const bf16* xp0 = XS + ((size_t)(g * 256 + n)) * 1024 + 8 * fq;
        bf16x8 xa[4], xb[4];
#pragma unroll
        for (int i = 0; i < 4; ++i) xa[i] = *(const bf16x8*)(xp0 + i * 32);
        __syncthreads();
        { const u32x4* src = (const u32x4*)((const bf16*)(F.ws + WS_KTAB) + (size_t)(l * 64 + g) * 80 * 256);
          for (int i = tid; i < 80 * 256 / 8; i += NTHR) ((LAS u32x4*)KT)[i] = src[i];
#pragma unroll
          for (int ps = 0; ps < 8; ++ps) { const int row = ps * 32 + (tid >> 4), c = tid & 15, q = row >> 4, o = row & 15;
              *(LAS u32x4*)(VT + row * 272 + c * 16) = *(const u32x4*)(VG + (size_t)((rc + 4 * q) * 16 + o) * 128 + c * 8); } }
        {
            const int p = lane, seg = wave;
            const float* AT = (const float*)(F.ws + WS_AT) + ((size_t)(l * 64 + g) * 64 + p) * 2; const float ar = AT[0], ai = AT[1];
            const float* SL = (const float*)(F.ws + WS_SLOC) + ((size_t)(g * 256 + seg * 32)) * 128 + p;
            float sr[32], si[32];
#pragma unroll
            for (int i = 0; i < 32; ++i) { sr[i] = SL[(size_t)i * 128]; si[i] = SL[(size_t)i * 128 + 64]; }
            float er = 0.f, ei = 0.f;
#pragma unroll
            for (int i = 0; i < 32; ++i) { const float nr = ar * er - ai * ei + sr[i], ni = ar * ei + ai * er + si[i]; er = nr; ei = ni; }
            TS[(seg * 64 + p) * 2] = er; TS[(seg * 64 + p) * 2 + 1] = ei;
            float qr = ar, qi = ai;
#pragma unroll
            for (int s = 0; s < 5; ++s) { const float nr = qr * qr - qi * qi, ni = 2.0f * qr * qi; qr = nr; qi = ni; }
            __syncthreads();
            float hr = 0.f, hi = 0.f;
            for (int k = 0; k < seg; ++k) { const float tr = TS[(k * 64 + p) * 2], ti = TS[(k * 64 + p) * 2 + 1]; const float nr = qr * hr - qi * hi + tr, ni = qr * hi + qi * hr + ti; hr = nr; hi = ni; }
            if ((seg >> 2) == nh) {
                LAS bf16* hrow = (LAS bf16*)(HT + ((seg & 3) * 32) * 272) + p;
#pragma unroll
                for (int i = 0; i < 32; ++i) { hrow[i * 136] = (bf16)f2bf(hr); hrow[i * 136 + 64] = (bf16)f2bf(hi);
                    const float nr = ar * hr - ai * hi + sr[i], ni = ar * hi + ai * hr + si[i]; hr = nr; hi = ni; }
            }
        }
        __syncthreads();
        f32x4 acc[16];
#pragma unroll
        for (int q = 0; q < 16; ++q) acc[q] = (f32x4){0.f, 0.f, 0.f, 0.f};
        const int kb0 = ((rc - (fq >> 1) + 10) * 16 + fr) * 32 + 16 * (fq & 1);
#define S5_GROUP(XF, grp_) do { const LAS unsigned char* kp = KT + kb0 - (grp_) * 4096; \
            _Pragma("unroll") for (int q = 0; q < 16; ++q) { if (rc + 4 * q >= 8 * (grp_)) { \
                _Pragma("unroll") for (int i = 0; i < 4; ++i) { const bf16x8 kf = *(const LAS bf16x8*)(kp + (4 * q - 2 * i + 6) * 512); \
                    acc[q] = __builtin_amdgcn_mfma_f32_16x16x32_bf16(kf, XF[i], acc[q], 0, 0, 0); } } } } while (0)
#pragma unroll 1
        for (int gp = 0; gp < 4; ++gp) {
#pragma unroll
            for (int i = 0; i < 4; ++i) xb[i] = *(const bf16x8*)(xp0 + ((2 * gp + 1) * 4 + i) * 32);
            S5_GROUP(xa, 2 * gp);
            if (gp < 3) {
#pragma unroll
                for (int i = 0; i < 4; ++i) xa[i] = *(const bf16x8*)(xp0 + ((2 * gp + 2) * 4 + i) * 32);
            }
            S5_GROUP(xb, 2 * gp + 1);
        }
#undef S5_GROUP
#pragma unroll 1
        for (int jb = 0; jb < 4; ++jb) {
            const bf16x8 hf = *(const LAS bf16x8*)(HT + (16 * wave + fr) * 272 + (jb * 32 + 8 * fq) * 2);
#pragma unroll
            for (int q = 0; q < 16; ++q) {
                const bf16x8 vf = *(const LAS bf16x8*)(VT + (q * 16 + fr) * 272 + (jb * 32 + 8 * fq) * 2);
                acc[q] = __builtin_amdgcn_mfma_f32_16x16x32_bf16(vf, hf, acc[q], 0, 0, 0);
            }
        }
#pragma unroll
        for (int q = 0; q < 16; ++q) {
            const int t = rc + 4 * q, tok = 64 * n + t;
            const f32x4 y = acc[q];
            u32x2 o; o.x = pk2(gelu_tanh(y[0]), gelu_tanh(y[1])); o.y = pk2(gelu_tanh(y[2]), gelu_tanh(y[3]));
            *(u32x2*)(Gb + (size_t)tok * 1024 + g * 16 + 4 * fq) = o;
#if SELFTEST_S5
            if (tok < 256) *(f32x4*)((float*)(F.ws + WS_DBG) + (size_t)tok * 1024 + g * 16 + 4 * fq) = y;
#endif
        }
    }
    __syncthreads();
}
#if SELFTEST_S5
__device__ __forceinline__ void selftest_s5(Frame& F, int l) {
    PH_LOCALS
    if (F.vcu < 64 && wave == 0) {
        const int g = F.vcu, p = lane;
        const float dt = expf(F.in[I_LDT][l * 64 + g]);
        const float lr = F.in[I_LRE][(l * 64 + g) * 64 + p], li = F.in[I_LIM][(l * 64 + g) * 64 + p];
        const float mag = expf(lr * dt); float sn, cs; sincosf(li * dt, &sn, &cs);
        const float ar = mag * cs, ai = mag * sn;
        const float xr = ar - 1.0f, xi = ai, den = 1.0f / (lr * lr + li * li);
        const float cr = (xr * lr + xi * li) * den, ci = (xi * lr - xr * li) * den;
        float bbr[16], bbi[16], ccr[16], cci[16];
#pragma unroll
        for (int i = 0; i < 16; ++i) { const float br = F.in[I_BRE][((size_t)(l * 64 + g) * 64 + p) * 16 + i], bi = F.in[I_BIM][((size_t)(l * 64 + g) * 64 + p) * 16 + i];
            bbr[i] = cr * br - ci * bi; bbi[i] = cr * bi + ci * br;
            ccr[i] = F.in[I_CRE][((size_t)(l * 64 + g) * 16 + i) * 64 + p]; cci[i] = F.in[I_CIM][((size_t)(l * 64 + g) * 16 + i) * 64 + p]; }
        const bf16* XS = (const bf16*)(F.ws + WS_XS) + (size_t)g * 256 * 1024;
        const float* DY = (const float*)(F.ws + WS_DBG);
        float sr = 0.f, si = 0.f, err = 0.f, ref = 0.f;
        for (int t = 0; t < 256; ++t) {
            float x[16];
#pragma unroll
            for (int i = 0; i < 16; ++i) x[i] = bflo((unsigned)XS[(size_t)t * 16 + i]);
            float ur = 0.f, ui = 0.f;
#pragma unroll
            for (int i = 0; i < 16; ++i) { ur += bbr[i] * x[i]; ui += bbi[i] * x[i]; }
            const float nr = ar * sr - ai * si + ur, ni = ar * si + ai * sr + ui; sr = nr; si = ni;
#pragma unroll
            for (int o = 0; o < 16; ++o) {
                const float yr = wave_sum(ccr[o] * sr - cci[o] * si);
                const float yf = DY[(size_t)t * 1024 + g * 16 + o];
                err += (yf - yr) * (yf - yr); ref += yr * yr;
            }
        }
        if (lane == 0 && !(err <= 2e-3f * ref)) __hip_atomic_fetch_or((unsigned*)(F.ws + WS_CTL) + CW_FLAG, 1u, RLX_AGENT);
    }
}
#endif

__device__ __forceinline__ unsigned f2key(float v) { const unsigned u = __builtin_bit_cast(unsigned, v); return (u & 0x80000000u) ? ~u : (u | 0x80000000u); }
__device__ __forceinline__ float key2f(unsigned k) { const unsigned u = (k & 0x80000000u) ? (k & 0x7fffffffu) : ~k; return __builtin_bit_cast(float, u); }
__device__ __forceinline__ void sort16_desc(unsigned (&v)[16]) {
#pragma unroll
    for (int lk = 1; lk <= 4; ++lk) {
#pragma unroll
        for (int lj = lk - 1; lj >= 0; --lj) {
#pragma unroll
            for (int i = 0; i < 16; ++i) { const int k = 1 << lk, j = 1 << lj, p = i ^ j;
                if (p > i) { const unsigned a = v[i], c = v[p], hi = a > c ? a : c, lo = a > c ? c : a; const bool desc = ((i & k) == 0) || (k == 16);
                    v[i] = desc ? hi : lo; v[p] = desc ? lo : hi; } }
        }
    }
}
__device__ __forceinline__ void merge16_desc(unsigned (&v)[16], const unsigned (&w)[16]) {
#pragma unroll
    for (int i = 0; i < 16; ++i) v[i] = v[i] > w[15 - i] ? v[i] : w[15 - i];
#pragma unroll
    for (int lj = 3; lj >= 0; --lj) {
#pragma unroll
        for (int i = 0; i < 16; ++i) { const int j = 1 << lj, p = i ^ j;
            if (p > i) { const unsigned a = v[i], c = v[p]; v[i] = a > c ? a : c; v[p] = a > c ? c : a; } }
    }
}
__device__ __forceinline__ void xmerge16(unsigned (&v)[16], int mask) {
    unsigned w[16];
#pragma unroll
    for (int i = 0; i < 16; ++i) w[i] = (unsigned)__shfl_xor((int)v[i], mask);
    merge16_desc(v, w);
}
__device__ __forceinline__ void phase_topk(Frame& F, int l) {
    PH_LOCALS
    const bf16* Q = (const bf16*)(F.ws + WS_Z);
    const bf16* KB = (const bf16*)(F.ws + WS_KEYS) + (size_t)l * 8 * 2 * 128 * 128;
    int* EID = (int*)(F.ws + WS_EID); float* GT = (float*)(F.ws + WS_GATE); float* SUo = (float*)(F.ws + WS_SU);
    const float* SCL = (const float*)(F.ws + WS_SCL) + (size_t)l * NEXP * 2;
    LAS unsigned char* KL = F.lds;
    LAS unsigned* LST = (LAS unsigned*)(F.lds + 69632);
    LAS unsigned char* PT = F.lds + 69632 + 16384;
    const int fr = lane & 15, fq = lane >> 4;
    {
        int c = 0;
#pragma unroll
        for (int i = 0; i < 16; ++i)
#pragma unroll
            for (int j = 0; j < 16; ++j) if ((i + 1) * (j + 1) <= 16) { if (tid == c) PT[c] = (unsigned char)(i * 16 + j); ++c; }
    }
    int cur_hh = -1;
    for (int u = F.vcu; u < 1024; u += F.G) {
        const int tt = u >> 3, hh = u & 7, t0 = tt * 128;
        bf16x8 qf[2][4];
#pragma unroll
        for (int s = 0; s < 2; ++s)
#pragma unroll
            for (int kb = 0; kb < 4; ++kb) qf[s][kb] = *(const bf16x8*)(Q + (size_t)(t0 + 16 * wave + fr) * 2048 + hh * 256 + s * 128 + kb * 32 + 8 * fq);
        if (hh != cur_hh) {
            __syncthreads();
#pragma unroll
            for (int ps = 0; ps < 8; ++ps) { const int idx = ps * 512 + tid, row = idx >> 4, c16 = idx & 15;
                *(LAS u32x4*)(KL + row * 272 + c16 * 16) = *(const u32x4*)(KB + ((size_t)(hh * 256 + row)) * 128 + c16 * 8); }
            cur_hh = hh;
            __syncthreads();
        }
#pragma unroll 1
        for (int s = 0; s < 2; ++s) {
            f32x4 acc[8];
#pragma unroll
            for (int nt = 0; nt < 8; ++nt) acc[nt] = (f32x4){0.f, 0.f, 0.f, 0.f};
#pragma unroll
            for (int kb = 0; kb < 4; ++kb) { const bf16x8 q = s ? qf[1][kb] : qf[0][kb];
#pragma unroll
                for (int nt = 0; nt < 8; ++nt) { const bf16x8 kf = *(const LAS bf16x8*)(KL + (s * 128 + nt * 16 + fr) * 272 + (kb * 32 + 8 * fq) * 2);
                    acc[nt] = __builtin_amdgcn_mfma_f32_16x16x32_bf16(kf, q, acc[nt], 0, 0, 0); } }
            unsigned va[16], vb[16];
#pragma unroll
            for (int nt = 0; nt < 4; ++nt)
#pragma unroll
                for (int r = 0; r < 4; ++r) { va[4 * nt + r] = (f2key(acc[nt][r]) & ~0x7Fu) | (unsigned)(127 - (nt * 16 + 4 * fq + r));
                    vb[4 * nt + r] = (f2key(acc[4 + nt][r]) & ~0x7Fu) | (unsigned)(127 - ((4 + nt) * 16 + 4 * fq + r)); }
            sort16_desc(va); sort16_desc(vb); merge16_desc(va, vb);
            xmerge16(va, 16); xmerge16(va, 32);
            if (fq == 0) {
#pragma unroll
                for (int k = 0; k < 16; k += 4) *(LAS u32x4*)(LST + ((16 * wave + fr) * 2 + s) * 16 + k) = (u32x4){va[k], va[k + 1], va[k + 2], va[k + 3]};
            }
        }
        asm volatile("s_waitcnt lgkmcnt(0)" ::: "memory");
        {
            const int tl = 16 * wave + (lane >> 2), c4 = lane & 3;
            unsigned v[16];
#pragma unroll
            for (int m = 0; m < 13; ++m) { const int c = m * 4 + c4; unsigned key = 0u;
                if (c < 50) { const int pij = PT[c], i = pij >> 4, j = pij & 15;
                    const float av = key2f(LST[(tl * 2 + 0) * 16 + i] & ~0x7Fu), bv = key2f(LST[(tl * 2 + 1) * 16 + j] & ~0x7Fu);
                    key = (f2key(av + bv) & ~0xFFu) | (unsigned)(255 - pij); }
                v[m] = key; }
#pragma unroll
            for (int m = 13; m < 16; ++m) v[m] = 0u;
            sort16_desc(v);
            xmerge16(v, 1); xmerge16(v, 2);
            float ev[16]; float sum = 0.f; const float mx = key2f(v[0] & ~0xFFu);
#pragma unroll
            for (int k = 0; k < 16; ++k) { ev[k] = __expf(key2f(v[k] & ~0xFFu) - mx); sum += ev[k]; }
            const float inv = 1.0f / sum;
            unsigned kk[4] = {v[0], v[1], v[2], v[3]}; float ee[4] = {ev[0], ev[1], ev[2], ev[3]};
#pragma unroll
            for (int q = 1; q < 4; ++q) { if (c4 == q) {
#pragma unroll
                for (int e = 0; e < 4; ++e) { kk[e] = v[4 * q + e]; ee[e] = ev[4 * q + e]; } } }
            const size_t ob = (size_t)(t0 + tl) * 128 + hh * 16 + 4 * c4;
            int eo[4]; float go[4], so[4];
#pragma unroll
            for (int e = 0; e < 4; ++e) { const int flat = 255 - (int)(kk[e] & 0xFFu), i = flat >> 4, j = flat & 15;
                const int ia = 127 - (int)(LST[(tl * 2 + 0) * 16 + i] & 0x7Fu), ib = 127 - (int)(LST[(tl * 2 + 1) * 16 + j] & 0x7Fu);
                eo[e] = ia * 128 + ib; }
#pragma unroll
            for (int e = 0; e < 4; ++e) { const f32x2 sc = *(const f32x2*)(SCL + 2 * eo[e]); go[e] = ee[e] * inv * sc.y; so[e] = sc.x; }
            *(u32x4*)(EID + ob) = (u32x4){(unsigned)eo[0], (unsigned)eo[1], (unsigned)eo[2], (unsigned)eo[3]};
            *(f32x4*)(GT + ob) = (f32x4){go[0], go[1], go[2], go[3]};
            *(f32x4*)(SUo + ob) = (f32x4){so[0], so[1], so[2], so[3]};
        }
        asm volatile("s_waitcnt lgkmcnt(0)" ::: "memory");
    }
    __syncthreads();
}

#define FP4X4(w, f0, f1, f2, f3) do { f0 = __builtin_amdgcn_cvt_scalef32_pk_f32_fp4((w), 1.0f, 0); f1 = __builtin_amdgcn_cvt_scalef32_pk_f32_fp4((w), 1.0f, 1); \
    f2 = __builtin_amdgcn_cvt_scalef32_pk_f32_fp4((w), 1.0f, 2); f3 = __builtin_amdgcn_cvt_scalef32_pk_f32_fp4((w), 1.0f, 3); } while (0)
__device__ __forceinline__ void phase_gather(Frame& F, int l, bool dummy = false) {
    PH_LOCALS
    const int gw = F.vcu * NWAVES + wave, NGW = F.G * NWAVES;
    bf16* Hn = dummy ? (bf16*)(F.ws + WS_DBG + 128 * MiB) : (bf16*)(F.ws + WS_H);
    const unsigned char* UV = F.ws + WS_UV + (size_t)l * NEXP * 2048;
    const int* EID = (const int*)(F.ws + WS_EID); const float* GT = (const float*)(F.ws + WS_GATE); const float* SU = (const float*)(F.ws + WS_SU);
    const bf16* X = (const bf16*)(F.ws + WS_X); bf16* Xo = dummy ? (bf16*)(F.ws + WS_DBG) : (bf16*)(F.ws + WS_X);
    const float* mod = (const float*)(F.ws + WS_MOD);
    const float* gate2 = mod + l * 12288 + 5 * 2048; const float* shift2 = mod + l * 12288 + 3 * 2048; const float* gs2 = (const float*)(F.ws + WS_GS) + l * DM;
    const unsigned lane16 = (unsigned)lane * 16u;
    for (int t = gw; t < M; t += NGW) {
        const int e_lo = EID[(size_t)t * 128 + lane], e_hi = EID[(size_t)t * 128 + 64 + lane];
        const float g_lo = GT[(size_t)t * 128 + lane], g_hi = GT[(size_t)t * 128 + 64 + lane];
        const float s_lo = SU[(size_t)t * 128 + lane], s_hi = SU[(size_t)t * 128 + 64 + lane];
        f32x2 hh[8][2];
        {   float s2 = 0.f; u32x2 xw[8];
#pragma unroll
            for (int j = 0; j < 8; ++j) xw[j] = *(const u32x2*)(X + (size_t)t * 2048 + j * 256 + lane * 4);
#pragma unroll
            for (int j = 0; j < 8; ++j) { hh[j][0] = (f32x2){bflo(xw[j].x), bfhi(xw[j].x)}; hh[j][1] = (f32x2){bflo(xw[j].y), bfhi(xw[j].y)};
                s2 += (hh[j][0].x * hh[j][0].x + hh[j][0].y * hh[j][0].y) + (hh[j][1].x * hh[j][1].x + hh[j][1].y * hh[j][1].y); }
            const float r2 = 1.0f / sqrtf(wave_sum(s2) * (1.0f / DM) + EPS);
#pragma unroll
            for (int j2 = 0; j2 < 8; j2 += 4) { f32x4 gsv[4], shv[4];
#pragma unroll
                for (int j = 0; j < 4; ++j) { gsv[j] = *(const f32x4*)(gs2 + (j2 + j) * 256 + lane * 4); shv[j] = *(const f32x4*)(shift2 + (j2 + j) * 256 + lane * 4); }
#pragma unroll
                for (int j = 0; j < 4; ++j) { hh[j2 + j][0] = (f32x2){hh[j2 + j][0].x * r2 * gsv[j][0] + shv[j][0], hh[j2 + j][0].y * r2 * gsv[j][1] + shv[j][1]}; hh[j2 + j][1] = (f32x2){hh[j2 + j][1].x * r2 * gsv[j][2] + shv[j][2], hh[j2 + j][1].y * r2 * gsv[j][3] + shv[j][3]}; } }
        }
        f32x2 of[8][2];
#pragma unroll
        for (int j = 0; j < 8; ++j) { of[j][0] = (f32x2){0.f, 0.f}; of[j][1] = (f32x2){0.f, 0.f}; }
        const bool u32_ = (lane & 32) != 0, u16_ = (lane & 16) != 0, u8_ = (lane & 8) != 0;
#if GATHER_PROBE_HOT
#define G_HOT(e) if (dummy) e &= 15;
#else
#define G_HOT(e)
#endif
#define G_ROW(dst, b_, h_, off_) do { int e_ = __builtin_amdgcn_readlane((b_) < 8 ? e_lo : e_hi, (8 * (b_) + (h_)) & 63); G_HOT(e_) \
            dst = *(const u32x4*)(UV + ((size_t)(unsigned)e_ << 11) + (off_) + lane16); } while (0)
#define G_DOTS(b_, NEXT) float p[8]; \
            _Pragma("unroll") for (int h = 0; h < 8; ++h) { f32x2 a2 = {0.f, 0.f}; \
                _Pragma("unroll") for (int d = 0; d < 4; ++d) { f32x2 f0, f1, f2, f3; FP4X4(ur[h][d], f0, f1, f2, f3); \
                    a2 = f0 * hh[2 * d][0] + a2; a2 = f1 * hh[2 * d][1] + a2; a2 = f2 * hh[2 * d + 1][0] + a2; a2 = f3 * hh[2 * d + 1][1] + a2; } \
                p[h] = a2.x + a2.y; if (NEXT) G_ROW(ur[h], (b_) + 1, h, 0); }
#define G_REST(b_, NEXT) float a4[4]; \
            _Pragma("unroll") for (int i = 0; i < 4; ++i) { const float snd = u32_ ? p[i] : p[4 + i], kp = u32_ ? p[4 + i] : p[i]; a4[i] = kp + __shfl_xor(snd, 32); } \
            float b2[2]; \
            _Pragma("unroll") for (int i = 0; i < 2; ++i) { const float snd = u16_ ? a4[i] : a4[2 + i], kp = u16_ ? a4[2 + i] : a4[i]; b2[i] = kp + __shfl_xor(snd, 16); } \
            float d; { const float snd = u8_ ? b2[0] : b2[1], kp = u8_ ? b2[1] : b2[0]; d = kp + __shfl_xor(snd, 8); } \
            d += __shfl_xor(d, 4); d += __shfl_xor(d, 2); d += __shfl_xor(d, 1); \
            const int hl = (8 * (b_) + (lane >> 3)) & 63; const float gsel = (b_) < 8 ? g_lo : g_hi, ssel = (b_) < 8 ? s_lo : s_hi; \
            const float coefq = __shfl(gsel, hl) * gelu_tanh(d * __shfl(ssel, hl)); \
            _Pragma("unroll") for (int h = 0; h < 8; ++h) { const float cf = __builtin_bit_cast(float, __builtin_amdgcn_readlane(__builtin_bit_cast(int, coefq), 8 * h)); const f32x2 cf2 = {cf, cf}; \
                _Pragma("unroll") for (int dd = 0; dd < 4; ++dd) { f32x2 f0, f1, f2, f3; FP4X4(vr[h][dd], f0, f1, f2, f3); \
                    of[2 * dd][0] = f0 * cf2 + of[2 * dd][0]; of[2 * dd][1] = f1 * cf2 + of[2 * dd][1]; of[2 * dd + 1][0] = f2 * cf2 + of[2 * dd + 1][0]; of[2 * dd + 1][1] = f3 * cf2 + of[2 * dd + 1][1]; } \
                if (NEXT) G_ROW(vr[h], (b_) + 1, h, 1024); }
        u32x4 ur[8], vr[8];
#pragma unroll
        for (int h = 0; h < 8; ++h) { G_ROW(ur[h], 0, h, 0); G_ROW(vr[h], 0, h, 1024); }
#pragma unroll 1
        for (int b = 0; b < 15; ++b) { G_DOTS(b, true) G_REST(b, true) }
        { G_DOTS(15, false) G_REST(15, false) }
#undef G_DOTS
#undef G_REST
#undef G_ROW
#undef G_HOT
        int ln = lane; asm volatile("" : "+v"(ln));
        u32x2 cx[8];
#pragma unroll
        for (int j = 0; j < 8; ++j) cx[j] = *(const u32x2*)(X + (size_t)t * 2048 + j * 256 + ln * 4);
        f32x4 xv[8]; float ss = 0.f;
#pragma unroll
        for (int j2 = 0; j2 < 8; j2 += 4) { f32x4 g2v[4];
#pragma unroll
            for (int j = 0; j < 4; ++j) g2v[j] = *(const f32x4*)(gate2 + (j2 + j) * 256 + ln * 4);
#pragma unroll
            for (int jj = 0; jj < 4; ++jj) { const int j = j2 + jj;
                const f32x4 xo = {bflo(cx[j].x), bfhi(cx[j].x), bflo(cx[j].y), bfhi(cx[j].y)};
                const f32x4 o = {of[j][0].x, of[j][0].y, of[j][1].x, of[j][1].y};
                xv[j] = xo + g2v[jj] * o;
                ss += (xv[j][0] * xv[j][0] + xv[j][1] * xv[j][1]) + (xv[j][2] * xv[j][2] + xv[j][3] * xv[j][3]); } }
        const float rr = 1.0f / sqrtf(wave_sum(ss) * (1.0f / DM) + EPS);
        if (l + 1 < DEPTH) {
            const float* m2 = mod + (l + 1) * 12288; const float* gain = F.in[I_N1G] + (l + 1) * 2048;
#pragma unroll
            for (int j2 = 0; j2 < 8; j2 += 4) { f32x4 gv[4], scv[4], shv[4];
#pragma unroll
                for (int j = 0; j < 4; ++j) { const int c = (j2 + j) * 256 + ln * 4; gv[j] = *(const f32x4*)(gain + c); scv[j] = *(const f32x4*)(m2 + 2048 + c); shv[j] = *(const f32x4*)(m2 + c); }
#pragma unroll
                for (int jj = 0; jj < 4; ++jj) { const int j = j2 + jj, c = j * 256 + ln * 4;
                    *(u32x2*)(Xo + (size_t)t * 2048 + c) = (u32x2){pk2(xv[j][0], xv[j][1]), pk2(xv[j][2], xv[j][3])};
                    const f32x4 y = xv[j] * rr * gv[jj] * (scv[jj] + 1.0f) + shv[jj];
                    *(u32x2*)(Hn + (size_t)t * 2048 + c) = (u32x2){pk2(y[0], y[1]), pk2(y[2], y[3])}; } }
        } else {
#pragma unroll
            for (int j = 0; j < 8; ++j) { const int c = j * 256 + ln * 4; const f32x4 fgv = *(const f32x4*)(F.in[I_FG] + c);
                f32x4 ov = xv[j] * rr * fgv;
#if SELFTEST_S5
                if (__hip_atomic_load((unsigned*)(F.ws + WS_CTL) + CW_FLAG, RLX_AGENT) != 0u) ov = (f32x4){1e30f, 1e30f, 1e30f, 1e30f};
#endif
                *(f32x4*)(F.out + (size_t)t * 2048 + c) = ov; }
        }
    }
}

__global__ void __launch_bounds__(NTHR, 2) fwd_kernel(Args args) {
    extern __shared__ __attribute__((aligned(16))) unsigned char lds_raw[];
    Frame F;
    F.lds = (LAS unsigned char*)lds_raw; F.ws = args.ws; F.in = args.in; F.out = args.out;
    F.tid = threadIdx.x; F.lane = F.tid & 63; F.wave = __builtin_amdgcn_readfirstlane(F.tid >> 6);
    F.G = gridDim.x; { const int bx = blockIdx.x; F.vcu = (F.G % 8 == 0) ? (bx % 8) * (F.G / 8) + bx / 8 : bx; }
    volatile LAS unsigned* MISC = (volatile LAS unsigned*)(F.lds + MISC_OFF);
    if (F.tid < 64) MISC[F.tid] = 0u;
    __syncthreads();
    unsigned* ctl = (unsigned*)(F.ws + WS_CTL);
    XcdBarrier bar; bar.bar = ctl + CW_BAR; bar.x = 0; bar.st = nullptr;
#if !MK_PER_PHASE
    bar = xcd_barrier_post(ctl + CW_BAR, MISC + 8);
#endif
    const int lo = args.ph_lo, hi = args.ph_hi;
#define IN(k) (lo <= (k) && (k) < hi)
#if MK_PER_PHASE
#define SEAM(k) do { } while (0)
#else
#define SEAM(k) do { if (IN(k) && IN((k) + 1)) xcd_barrier(bar); } while (0)
#endif
    const float* mod = (const float*)(F.ws + WS_MOD);

#define REP(k) (REPEAT_PH == (k))
#define RUN2(k, first, real) do { if (REP(k)) { first; xcd_barrier(bar); } real; } while (0)
    if (IN(0)) { RUN2(13, p0_tables(F, 5, true), p0_tables(F, 4, false)); } SEAM(0);
    for (int l = 0; l < DEPTH; ++l) {
        const int pb = 1 + 12 * l;
        const float* ml = mod + l * 12288;
        if (IN(pb + 0)) { if (l == 0) { RUN2(0, p0_prologue(F), p0_prologue(F)); RUN2(1, phase_norm<false>(F, F.in[I_X], F.in[I_N1G] + l * 2048, ml + 1 * 2048, ml + 0 * 2048), phase_norm<false>(F, F.in[I_X], F.in[I_N1G] + l * 2048, ml + 1 * 2048, ml + 0 * 2048)); } } SEAM(pb + 0);
        if (IN(pb + 1)) {
            pg8::Gemm g{(const bf16*)(F.ws + WS_H), (const bf16*)(F.ws + WS_WIN) + (size_t)l * INW * DM, M, INW, DM}; pg8::StaticOrder S; S.init(M, INW, F.G, (int)blockIdx.x);
            EpiIn E{(bf16*)(F.ws + WS_Z), (bf16*)(F.ws + WS_XS), F.in[I_BIN] + l * INW};
#define GEMM_IN pg8::gemm_phase<EpiIn, pg8::StaticOrder, true, true>(F.lds, g, S, E)
            RUN2(2, GEMM_IN, GEMM_IN);
        } SEAM(pb + 1);
#ifndef P3_MODE
#define P3_MODE 0
#endif
        if (IN(pb + 2)) { RUN2(3, ((P3_MODE != 2 ? phase_sloc(F, l) : (void)0), (P3_MODE != 1 ? phase_lnstats(F) : (void)0)), (phase_sloc(F, l), phase_lnstats(F))); } SEAM(pb + 2);
        if (IN(pb + 3)) { RUN2(5, phase_s5out(F, l), phase_s5out(F, l)); RUN2(4, phase_gating(F, l), phase_gating(F, l));
#if SELFTEST_S5
            xcd_barrier(bar); selftest_s5(F, l);
#endif
        } SEAM(pb + 4);
        if (IN(pb + 5)) {
            pg8::Gemm g{(const bf16*)(F.ws + WS_G), (const bf16*)(F.ws + WS_GLU) + (size_t)l * WB * WB, M, WB, WB}; pg8::StaticOrder S; S.init(M, WB, F.G, (int)blockIdx.x);
            EpiGlu E{(const bf16*)(F.ws + WS_G), (bf16*)(F.ws + WS_MIX), F.in[I_GLUB] + l * WB, (float*)(F.ws + WS_PSB)};
#define GEMM_GLU pg8::gemm_phase<EpiGlu, pg8::StaticOrder, true, true>(F.lds, g, S, E)
            RUN2(6, GEMM_GLU, GEMM_GLU);
        } SEAM(pb + 6);
        if (IN(pb + 7)) {
            pg8::Gemm g{(const bf16*)(F.ws + WS_MIX), (const bf16*)(F.ws + WS_WOUT) + (size_t)l * DM * DM, M, DM, DM}; pg8::StaticOrder S; S.init(M, DM, F.G, (int)blockIdx.x);
            LAS float* ratL = (LAS float*)(F.lds + 132096); LAS float* rbL = (LAS float*)(F.lds + 134144);
            pg8::Unit u0, u1; const bool h0 = S.next(0, u0), h1 = S.next(1, u1);
            {   int t2 = F.tid; asm volatile("" : "+v"(t2));
                for (int sl = 0; sl < 2; ++sl) { const bool on = sl == 0 ? h0 : (h1 && u1.pm != u0.pm); const int pmx = sl == 0 ? u0.pm : u1.pm;
                    if (on && t2 < 256) { const size_t row = (size_t)pmx * 256 + t2; float sa = 0.f, sb = 0.f;
                        const float* pa = (const float*)(F.ws + WS_PSA) + row * 8; const float* pb_ = (const float*)(F.ws + WS_PSB) + row * 16;
#pragma unroll
                        for (int i = 0; i < 2; ++i) { const f32x4 v = *(const f32x4*)(pa + 4 * i); sa += (v[0] + v[1]) + (v[2] + v[3]); }
#pragma unroll
                        for (int i = 0; i < 4; ++i) { const f32x4 v = *(const f32x4*)(pb_ + 4 * i); sb += (v[0] + v[1]) + (v[2] + v[3]); }
                        const float ra = 1.0f / sqrtf(sa * (1.0f / 1024.0f) + EPS), rb = 1.0f / sqrtf(sb * (1.0f / 1024.0f) + EPS);
                        ratL[sl * 256 + t2] = ra / rb; rbL[sl * 256 + t2] = rb; } } }
            __syncthreads();
            const int pm0 = h0 ? u0.pm : -1;
            if (l == 0) { EpiOut<false> E{(const void*)F.in[I_X], (bf16*)(F.ws + WS_X), ml + 2 * 2048, (float*)(F.ws + WS_PS), ratL, rbL, pm0}; EpiOut<false> Ed{(const void*)F.in[I_X], (bf16*)(F.ws + WS_DBG), ml + 2 * 2048, (float*)(F.ws + WS_DBG + 128 * MiB), ratL, rbL, pm0};
#define GEMM_OUT0(EE) pg8::gemm_phase<EpiOut<false>, pg8::StaticOrder, true, true>(F.lds, g, S, EE)
                RUN2(8, GEMM_OUT0(Ed), GEMM_OUT0(E)); }
            else { EpiOut<true> E{(const void*)(F.ws + WS_X), (bf16*)(F.ws + WS_X), ml + 2 * 2048, (float*)(F.ws + WS_PS), ratL, rbL, pm0}; EpiOut<true> Ed{(const void*)(F.ws + WS_X), (bf16*)(F.ws + WS_DBG), ml + 2 * 2048, (float*)(F.ws + WS_DBG + 128 * MiB), ratL, rbL, pm0};
#define GEMM_OUT1(EE) pg8::gemm_phase<EpiOut<true>, pg8::StaticOrder, true, true>(F.lds, g, S, EE)
                RUN2(8, GEMM_OUT1(Ed), GEMM_OUT1(E)); }
        }
        SEAM(pb + 8);
        if (IN(pb + 9)) {
            pg8::Gemm g{(const bf16*)(F.ws + WS_X), (const bf16*)(F.ws + WS_WQ) + (size_t)l * DM * DM, M, DM, DM}; pg8::StaticOrder S; S.init(M, DM, F.G, (int)blockIdx.x);
            LAS float* rrL = (LAS float*)(F.lds + 132096);
            pg8::Unit u0, u1; const bool h0 = S.next(0, u0), h1 = S.next(1, u1);
            { int t2 = F.tid; asm volatile("" : "+v"(t2)); if (h0) fill_rr(F, rrL, 0, u0.pm, t2); if (h1 && u1.pm != u0.pm) fill_rr(F, rrL, 1, u1.pm, t2); }
            __syncthreads();
            EpiQ E{(bf16*)(F.ws + WS_Z), (const float*)(F.ws + WS_C0) + l * DM, rrL, h0 ? u0.pm : -1};
#define GEMM_Q pg8::gemm_phase<EpiQ, pg8::StaticOrder, true, true>(F.lds, g, S, E)
            RUN2(10, GEMM_Q, GEMM_Q);
        } SEAM(pb + 9);
        if (IN(pb + 10)) { RUN2(11, phase_topk(F, l), phase_topk(F, l)); } SEAM(pb + 10);
        if (IN(pb + 11)) { RUN2(12, phase_gather(F, l, true), phase_gather(F, l, false)); } SEAM(pb + 11);
    }
#undef IN
#undef SEAM
}

extern "C" void kernel_launch(void* const* d_in, const int* in_sizes, int n_in, void* d_out, int out_size, void* d_ws, size_t ws_size, hipStream_t stream) {
    static int grid = 0;
    if (grid == 0) {
        if (n_in != 29 || out_size != M * DM || ws_size < WS_END) { fprintf(stderr, "kernel_launch: unexpected shapes (n_in %d, out %d, ws %zu); nothing launched\n", n_in, out_size, ws_size); grid = -1; return; }
        int dev = 0, cus = 0;
        if (hipGetDevice(&dev) != hipSuccess || hipDeviceGetAttribute(&cus, hipDeviceAttributeMultiprocessorCount, dev) != hipSuccess) { grid = -1; return; }
        if (hipFuncSetAttribute((const void*)fwd_kernel, hipFuncAttributeMaxDynamicSharedMemorySize, LDS_BYTES) != hipSuccess) { fprintf(stderr, "kernel_launch: hipFuncSetAttribute failed\n"); grid = -1; return; }
        (void)hipGetLastError();
        grid = cus;
    }
    if (grid < 0) return;
    (void)hipMemsetAsync((char*)d_ws + WS_CTL, 0, CTL_ZERO_BYTES, stream);
    Args a{};
    for (int i = 0; i < 29; ++i) a.in[i] = (const float*)d_in[i];
    a.out = (float*)d_out; a.ws = (unsigned char*)d_ws;
#if MK_PER_PHASE
    for (int p = 0; p < 1 + 12 * DEPTH; ++p) {
        if (p == 13) continue;
        a.ph_lo = p; a.ph_hi = p + 1; a.li = p;
        hipLaunchKernelGGL(fwd_kernel, dim3(grid), dim3(NTHR), LDS_BYTES, stream, a);
    }
#else
    a.ph_lo = 0; a.ph_hi = 1 + 12 * DEPTH; a.li = 0;
    hipLaunchKernelGGL(fwd_kernel, dim3(grid), dim3(NTHR), LDS_BYTES, stream, a);
#endif
}
```

```cpp
#include <hip/hip_runtime.h>
#include <cstdio>
#include <cstdint>

#ifndef SELFTEST_S5
#define SELFTEST_S5 0
#endif
#ifndef REPEAT_PH
#define REPEAT_PH -1
#endif
#ifndef GATHER_PROBE_MEM
#define GATHER_PROBE_MEM 0
#endif
#ifndef GATHER_PROBE_HOT
#define GATHER_PROBE_HOT 0
#endif
#ifndef MK_PER_PHASE
#define MK_PER_PHASE 0
#endif

#define GAS __attribute__((address_space(1)))
#define LAS __attribute__((address_space(3)))
typedef unsigned short bf16;
typedef short bf16x8 __attribute__((ext_vector_type(8)));
typedef float f32x4 __attribute__((ext_vector_type(4)));
typedef float f32x2 __attribute__((ext_vector_type(2)));
typedef unsigned u32x4 __attribute__((ext_vector_type(4)));
typedef unsigned u32x2 __attribute__((ext_vector_type(2)));

constexpr int DM = 2048, SEQ = 16384, DEPTH = 2, M = SEQ;
constexpr int WA = 1024, WB = 1024, INW = 3072;
constexpr int NG = 64, NCH = 256;
constexpr int NEXP = 16384;
constexpr float EPS = 1e-6f;
constexpr int NWAVES = 8, NTHR = 512;

namespace pg8 {
#define PG8_LAS __attribute__((address_space(3)))
constexpr int BM = 256, BK = 64, HALF = 128, HTB = HALF * BK * 2, STAGE_BYTES = 8 * HTB, NXCD = 8, WGM = 8;
__host__ __device__ __forceinline__ int lds_byte(int r, int c) { const int st = (r >> 4) * 2 + (c >> 5), rr = r & 15, cc = c & 31, ob = rr * 64 + cc * 2; return st * 1024 + (ob ^ (((ob >> 9) & 1) << 5)); }
__host__ __device__ __forceinline__ void stage_rc(int b, int& R, int& C) { const int st = b / 1024, sb = b % 1024, swz = sb ^ (((sb >> 9) & 1) << 5); R = (st >> 1) * 16 + swz / 64; C = (st & 1) * 32 + (swz % 64) / 2; }
__host__ __device__ __forceinline__ int perm32(int rho) { const int n = rho >> 4, i = rho & 15; return 8 * (i >> 2) + 4 * n + (i & 3); }
struct Unit { int pm, pn; };
struct Gemm { const bf16* A; const bf16* Bt; int M, N, K; };
struct StaticOrder {
    int nM, nN, nwg, G, c;
    __host__ __device__ void init(int M_, int N_, int G_, int c_) { nM = M_ / BM; nN = N_ / BM; nwg = nM * nN; G = G_; c = c_; }
    __host__ __device__ bool next(int i, Unit& u) const {
        const long L = (long)i * G + c; if (L >= nwg) return false;
        int wgid = (int)L; { const int q = nwg / NXCD, r = nwg % NXCD, xcd = wgid % NXCD, off = wgid / NXCD; wgid = (xcd < r ? xcd * (q + 1) : r * (q + 1) + (xcd - r) * q) + off; }
        const int nig = WGM * nN, gid = wgid / nig, fm = gid * WGM, gsz = (nM - fm) < WGM ? (nM - fm) : WGM;
        u.pm = fm + ((wgid % nig) % gsz); u.pn = (wgid % nig) / gsz; return true;
    }
    __device__ __forceinline__ void a_ready(const Unit&) const {}
    __device__ __forceinline__ void done(const Unit&) const {}
};
__device__ __forceinline__ unsigned cvt_pk_bf16(float lo, float hi) { unsigned r; asm volatile("v_cvt_pk_bf16_f32 %0, %1, %2" : "=v"(r) : "v"(lo), "v"(hi)); return r; }

template <class Epi, class Sched, bool ALIGN_EPI = false, bool SP2 = false>
__device__ __forceinline__ void gemm_phase(PG8_LAS unsigned char* lds, const Gemm g, const Sched& S, const Epi& E) {
    int tid = threadIdx.x; asm volatile("" : "+v"(tid)); const int wid = __builtin_amdgcn_readfirstlane(tid >> 6), lane = tid & 63, wr = wid >> 2, wc = wid & 3, fr = lane & 15, fq = lane >> 4;
    const int K = g.K, nt = K / BK;
    unsigned voffA[2], voffB[2];
#pragma unroll
    for (int i = 0; i < 2; ++i) { int R, C; stage_rc(tid * 16 + i * 8192, R, C); const int Rb = Epi::PERM ? ((R & ~31) + perm32(R & 31)) : R;
        voffA[i] = (unsigned)(R * K + C) * 2u; voffB[i] = (unsigned)(Rb * K + C) * 2u; }
    const size_t kstep = (size_t)(BK * 2);
    const size_t hstep = (size_t)HALF * K * 2;
    const size_t tstep = 2 * hstep;
    const unsigned ldsw = (unsigned)wid * 1024u;
    const int aoff = lds_byte(wr * 64 + fr, fq * 8), boff = lds_byte(wc * 32 + fr, fq * 8);
#define PG8_SA(b, h) (((b) * 2 + (h)) * HTB)
#define PG8_SB(b, h) ((4 + (b) * 2 + (h)) * HTB)
#define PG8_STAGE(bufoff, gbase, voff) do { _Pragma("unroll") for (int _i = 0; _i < 2; ++_i) \
        __builtin_amdgcn_global_load_lds((const unsigned*)((const char*)(gbase) + (voff)[_i]), (PG8_LAS unsigned*)(lds + (bufoff) + ldsw + _i * 8192), 16, 0, 0); } while (0)
#define PG8_LDA(dst, b, h) do { _Pragma("unroll") for (int m = 0; m < 4; ++m) _Pragma("unroll") for (int k = 0; k < 2; ++k) dst[m][k] = *(const PG8_LAS bf16x8*)(lds + PG8_SA(b, h) + aoff + m * 2048 + k * 1024); } while (0)
#define PG8_LDB(dst, b, h) do { _Pragma("unroll") for (int n = 0; n < 2; ++n) _Pragma("unroll") for (int k = 0; k < 2; ++k) dst[n][k] = *(const PG8_LAS bf16x8*)(lds + PG8_SB(b, h) + boff + n * 2048 + k * 1024); } while (0)
#define PG8_MMA(ai, bj, At, Bt) do { __builtin_amdgcn_s_setprio(1); _Pragma("unroll") for (int m = 0; m < 4; ++m) _Pragma("unroll") for (int n = 0; n < 2; ++n) _Pragma("unroll") for (int k = 0; k < 2; ++k) \
        acc[ai][bj][m][n] = __builtin_amdgcn_mfma_f32_16x16x32_bf16(Bt[n][k], At[m][k], acc[ai][bj][m][n], 0, 0, 0); __builtin_amdgcn_s_setprio(0); } while (0)
#define PG8_WAIT_V(n) asm volatile("s_waitcnt vmcnt(" #n ")" ::: "memory")
#define PG8_WAIT_L(n) asm volatile("s_waitcnt lgkmcnt(" #n ")" ::: "memory")
#define PG8_BAR __builtin_amdgcn_s_barrier()
#define PG8_SCHED __builtin_amdgcn_sched_barrier(0)
    Unit cur, nxt; int ui = 0;
    if (!S.next(0, cur)) return;
    f32x4 acc[2][2][4][2];
#pragma unroll
    for (int a = 0; a < 2; ++a)
#pragma unroll
        for (int b = 0; b < 2; ++b)
#pragma unroll
            for (int m = 0; m < 4; ++m)
#pragma unroll
                for (int n = 0; n < 2; ++n) acc[a][b][m][n] = (f32x4){0.f, 0.f, 0.f, 0.f};
    bf16x8 At[4][2], B0[2][2], B1[2][2];
    const char* cA = (const char*)g.A + (size_t)cur.pm * tstep; const char* cB = (const char*)g.Bt + (size_t)cur.pn * tstep;
    S.a_ready(cur);
    if constexpr (SP2) {
        PG8_STAGE(PG8_SB(0, 0), cB, voffB); PG8_STAGE(PG8_SB(0, 1), cB + hstep, voffB); PG8_STAGE(PG8_SA(0, 0), cA, voffA); PG8_STAGE(PG8_SA(0, 1), cA + hstep, voffA);
        if (wr == 1) PG8_BAR;
        PG8_WAIT_V(2); PG8_BAR;
        PG8_STAGE(PG8_SB(1, 0), cB + kstep, voffB); PG8_STAGE(PG8_SA(1, 0), cA + kstep, voffA); PG8_STAGE(PG8_SB(1, 1), cB + hstep + kstep, voffB);
        PG8_WAIT_V(6); PG8_BAR;
    } else {
        PG8_STAGE(PG8_SB(0, 0), cB, voffB); PG8_STAGE(PG8_SA(0, 0), cA, voffA); PG8_STAGE(PG8_SB(0, 1), cB + hstep, voffB); PG8_STAGE(PG8_SA(0, 1), cA + hstep, voffA);
        if (wr == 1) PG8_BAR;
        PG8_WAIT_V(4); PG8_BAR;
        PG8_STAGE(PG8_SB(1, 0), cB + kstep, voffB); PG8_STAGE(PG8_SA(1, 0), cA + kstep, voffA); PG8_STAGE(PG8_SB(1, 1), cB + hstep + kstep, voffB);
        PG8_WAIT_V(6); PG8_BAR;
    }
    for (;;) {
        const bool has_next = S.next(ui + 1, nxt);
        const char* nA = has_next ? (const char*)g.A + (size_t)nxt.pm * tstep : cA; const char* nB = has_next ? (const char*)g.Bt + (size_t)nxt.pn * tstep : cB;
        for (int t = 0; t < nt; t += 2) {
            const bool last = (t == nt - 2);
            const char* a1 = cA + (size_t)(t + 1) * kstep;
            const char* a2 = last ? nA : cA + (size_t)(t + 2) * kstep; const char* b2 = last ? nB : cB + (size_t)(t + 2) * kstep;
            const char* a3 = a2 + kstep; const char* b3 = b2 + kstep;
            if (last && has_next) S.a_ready(nxt);
            if constexpr (Epi::KSPLIT) { if (t == nt / 2) E.midscale(acc, cur, wr, fr); }
            if constexpr (SP2) {
            PG8_LDB(B0, 0, 0); PG8_LDB(B1, 0, 1); PG8_SCHED; PG8_LDA(At, 0, 0); PG8_STAGE(PG8_SA(1, 1), a1 + hstep, voffA);
            PG8_WAIT_V(8); PG8_WAIT_L(0); PG8_BAR; PG8_MMA(0, 0, At, B0); PG8_MMA(0, 1, At, B1); PG8_BAR; PG8_SCHED;
            PG8_LDA(At, 0, 1); PG8_STAGE(PG8_SB(0, 0), b2, voffB); PG8_STAGE(PG8_SB(0, 1), b2 + hstep, voffB); PG8_STAGE(PG8_SA(0, 0), a2, voffA);
            PG8_WAIT_V(8); PG8_WAIT_L(0); PG8_BAR; PG8_MMA(1, 0, At, B0); PG8_MMA(1, 1, At, B1); PG8_BAR; PG8_SCHED;
            PG8_LDB(B0, 1, 0); PG8_LDB(B1, 1, 1); PG8_SCHED; PG8_LDA(At, 1, 0); PG8_STAGE(PG8_SA(0, 1), a2 + hstep, voffA);
            PG8_WAIT_V(8); PG8_WAIT_L(0); PG8_BAR; PG8_MMA(0, 0, At, B0); PG8_MMA(0, 1, At, B1); PG8_BAR; PG8_SCHED;
            PG8_LDA(At, 1, 1); PG8_STAGE(PG8_SB(1, 0), b3, voffB); PG8_STAGE(PG8_SB(1, 1), b3 + hstep, voffB); PG8_STAGE(PG8_SA(1, 0), a3, voffA);
            PG8_WAIT_V(8); PG8_WAIT_L(0); PG8_BAR; PG8_MMA(1, 0, At, B0); PG8_MMA(1, 1, At, B1); PG8_BAR; PG8_SCHED;
            } else {
            PG8_LDB(B0, 0, 0); PG8_SCHED; PG8_LDA(At, 0, 0); PG8_STAGE(PG8_SA(1, 1), a1 + hstep, voffA);
            PG8_WAIT_L(8); PG8_BAR; PG8_WAIT_L(0); PG8_MMA(0, 0, At, B0); PG8_BAR; PG8_SCHED;
            PG8_LDB(B1, 0, 1); PG8_STAGE(PG8_SB(0, 0), b2, voffB);
            PG8_BAR; PG8_WAIT_L(0); PG8_MMA(0, 1, At, B1); PG8_BAR;
            PG8_LDA(At, 0, 1); PG8_STAGE(PG8_SA(0, 0), a2, voffA);
            PG8_BAR; PG8_WAIT_L(0); PG8_MMA(1, 0, At, B0); PG8_BAR; PG8_SCHED;
            PG8_STAGE(PG8_SB(0, 1), b2 + hstep, voffB);
            PG8_WAIT_V(6); PG8_BAR; PG8_MMA(1, 1, At, B1); PG8_BAR;
            PG8_LDB(B0, 1, 0); PG8_SCHED; PG8_LDA(At, 1, 0); PG8_STAGE(PG8_SA(0, 1), a2 + hstep, voffA);
            PG8_WAIT_L(8); PG8_BAR; PG8_WAIT_L(0); PG8_MMA(0, 0, At, B0); PG8_BAR; PG8_SCHED;
            PG8_LDB(B1, 1, 1); PG8_STAGE(PG8_SB(1, 0), b3, voffB);
            PG8_BAR; PG8_WAIT_L(0); PG8_MMA(0, 1, At, B1); PG8_BAR;
            PG8_LDA(At, 1, 1); PG8_STAGE(PG8_SA(1, 0), a3, voffA);
            PG8_BAR; PG8_WAIT_L(0); PG8_MMA(1, 0, At, B0); PG8_BAR; PG8_SCHED;
            PG8_STAGE(PG8_SB(1, 1), b3 + hstep, voffB);
            PG8_WAIT_V(6); PG8_BAR; PG8_MMA(1, 1, At, B1); PG8_BAR;
            }
        }
        if constexpr (ALIGN_EPI) { if (wr == 0) PG8_BAR; }
        E(acc, cur, wr, wc, fr, fq); S.done(cur);
        if (!has_next) break;
#pragma unroll
        for (int a = 0; a < 2; ++a)
#pragma unroll
            for (int b = 0; b < 2; ++b)
#pragma unroll
                for (int m = 0; m < 4; ++m)
#pragma unroll
                    for (int n = 0; n < 2; ++n) acc[a][b][m][n] = (f32x4){0.f, 0.f, 0.f, 0.f};
        cur = nxt; cA = nA; cB = nB; ++ui;
        if constexpr (ALIGN_EPI) { if (wr == 1) PG8_BAR; }
    }
    PG8_WAIT_V(0);
    if constexpr (!ALIGN_EPI) { if (wr == 0) PG8_BAR; }
    PG8_BAR;
#undef PG8_SA
#undef PG8_SB
#undef PG8_STAGE
#undef PG8_LDA
#undef PG8_LDB
#undef PG8_MMA
#undef PG8_WAIT_V
#undef PG8_WAIT_L
#undef PG8_BAR
#undef PG8_SCHED
}
}

__device__ __forceinline__ unsigned f2bf(float f) { unsigned u = __builtin_bit_cast(unsigned, f); return (u + 0x7fffu + ((u >> 16) & 1u)) >> 16; }
__device__ __forceinline__ unsigned pk2(float lo, float hi) { return f2bf(lo) | (f2bf(hi) << 16); }
__device__ __forceinline__ float bflo(unsigned w) { return __builtin_bit_cast(float, w << 16); }
__device__ __forceinline__ float bfhi(unsigned w) { return __builtin_bit_cast(float, w & 0xffff0000u); }
__device__ __forceinline__ float fast_sigmoid(float t) { return __builtin_amdgcn_rcpf(1.0f + __builtin_amdgcn_exp2f(-1.44269504089f * t)); }
__device__ __forceinline__ float gelu_tanh(float x) { const float t = x * (1.5957691216f + 0.0713548163f * x * x); return x * fast_sigmoid(t); }
__device__ __forceinline__ float wave_sum(float v) {
#pragma unroll
    for (int o = 1; o < 64; o <<= 1) v += __shfl_xor(v, o);
    return v;
}
#define LDS_WAIT() asm volatile("s_waitcnt lgkmcnt(0)" ::: "memory")
#define VM_WAIT() asm volatile("s_waitcnt vmcnt(0)" ::: "memory")
#define RLX_AGENT __ATOMIC_RELAXED, __HIP_MEMORY_SCOPE_AGENT

constexpr size_t MiB = 1u << 20;
constexpr size_t WS_CTL = 0, CTL_ZERO_BYTES = 1 * MiB;
constexpr size_t WS_MOD   = 512 * 1024;
constexpr size_t WS_AT    = 1 * MiB + 128 * 1024;
constexpr size_t WS_STATS = WS_AT + 128 * 1024;
constexpr size_t WS_SCL   = 1 * MiB + 512 * 1024;
constexpr size_t WS_GS    = 1 * MiB + 768 * 1024;
constexpr size_t WS_C0    = WS_GS + 16 * 1024;
constexpr size_t WS_KEYS  = 2 * MiB;
constexpr size_t WS_GWS   = 3 * MiB;
constexpr size_t WS_WIN   = 4 * MiB;
constexpr size_t WS_GLU   = 28 * MiB;
constexpr size_t WS_WOUT  = 32 * MiB;
constexpr size_t WS_WQ    = 48 * MiB;
constexpr size_t WS_KTAB  = 64 * MiB;
constexpr size_t WS_WG    = 72 * MiB;
constexpr size_t WS_VG    = 104 * MiB;
constexpr size_t WS_UV    = 136 * MiB;
constexpr size_t WS_X     = 392 * MiB;
constexpr size_t WS_H     = 520 * MiB;
constexpr size_t WS_Z     = 584 * MiB;
constexpr size_t WS_XS    = 648 * MiB;
constexpr size_t WS_SLOC  = 680 * MiB;
constexpr size_t WS_PS    = 688 * MiB;
constexpr size_t WS_PSA   = 690 * MiB;
constexpr size_t WS_PSB   = 691 * MiB;
constexpr size_t WS_HS    = 692 * MiB;
constexpr size_t WS_G     = 696 * MiB;
constexpr size_t WS_MIX   = 728 * MiB;
constexpr size_t WS_EID   = 792 * MiB;
constexpr size_t WS_GATE  = 800 * MiB;
constexpr size_t WS_SU    = 808 * MiB;
constexpr size_t WS_END   = 816 * MiB;
constexpr size_t WS_DBG   = 816 * MiB;
constexpr int CW_BAR = 4096;
constexpr int CW_FLAG = 2048;
constexpr int CW_QUEUE = 16384;

constexpr int LDS_BYTES = 163840;
constexpr int MISC_OFF = LDS_BYTES - 256;

#define XB_TMO      128
#define XB_XCNT(j)  (256  + 64 * (j))
#define XB_XSUB(j)  (1280 + 64 * (j))
#define XB_XGEN(j)  (2304 + 64 * (j))
#define XB_TOP      3328
#define XB_TOPGEN   3392
#define XCD_BAR_WORDS 3456
#define XB_SPIN_CAP (1u << 24)
__device__ __forceinline__ unsigned xb_ld(unsigned* p)              { return __hip_atomic_load(p, __ATOMIC_RELAXED, __HIP_MEMORY_SCOPE_AGENT); }
__device__ __forceinline__ unsigned xb_add(unsigned* p, unsigned v) { return __hip_atomic_fetch_add(p, v, __ATOMIC_RELAXED, __HIP_MEMORY_SCOPE_AGENT); }
__device__ __forceinline__ unsigned xb_xcc_id() { return (unsigned)__builtin_amdgcn_s_getreg((3 << 11) | 20) & 0xFu; }
#define XB_SPIN(cond, bar) do { unsigned _sp = 0; while (cond) { __builtin_amdgcn_s_sleep(1); \
    if ((++_sp & 255u) == 0u) { if (xb_ld(&(bar)[XB_TMO])) break; if (_sp > XB_SPIN_CAP) { atomicAdd(&(bar)[XB_TMO], 1u); break; } } } } while (0)
struct XcdBarrier { unsigned* bar; unsigned x; volatile LAS unsigned* st; };
__device__ __forceinline__ XcdBarrier xcd_barrier_post(unsigned* bar, volatile LAS unsigned* st) {
    XcdBarrier b; b.bar = bar; b.x = xb_xcc_id(); b.st = st;
    if (threadIdx.x == 0) (void)xb_add(&bar[XB_XCNT(b.x)], 1u);
    return b;
}
__device__ __forceinline__ void xcd_barrier_complete(unsigned* bar, unsigned x, unsigned& nloc, unsigned& nx) {
    const unsigned G = gridDim.x * gridDim.y * gridDim.z;
    unsigned sum, cnt, mine, sp = 0u;
    for (;;) {
        sum = 0u; cnt = 0u; mine = 0u;
#pragma unroll
        for (unsigned j = 0; j < 16; ++j) { const unsigned c = xb_ld(&bar[XB_XCNT(j)]); sum += c; cnt += (c > 0u) ? 1u : 0u; mine = (j == x) ? c : mine; }
        if (sum == G) break;
        __builtin_amdgcn_s_sleep(1);
        if ((++sp & 255u) == 0u) { if (xb_ld(&bar[XB_TMO])) break; if (sp > XB_SPIN_CAP) { atomicAdd(&bar[XB_TMO], 1u); break; } }
    }
    nloc = mine > 0u ? mine : 1u; nx = cnt > 0u ? cnt : 1u;
}
__device__ __forceinline__ void xcd_barrier(const XcdBarrier& b) {
    asm volatile("s_waitcnt vmcnt(0)" ::: "memory");
    __syncthreads();
    if (threadIdx.x == 0) {
        unsigned* bar = b.bar;
        __builtin_amdgcn_s_waitcnt(0);
        unsigned nloc = b.st[0], nx = b.st[1];
        if (nloc == 0u) { xcd_barrier_complete(bar, b.x, nloc, nx); b.st[0] = nloc; b.st[1] = nx; }
        const unsigned old = xb_add(&bar[XB_XSUB(b.x)], 1u);
        const unsigned gen = old / nloc;
        if (old + 1u == (gen + 1u) * nloc) {
            __builtin_amdgcn_fence(__ATOMIC_RELEASE, "agent");
            asm volatile("s_waitcnt vmcnt(0)" ::: "memory");
            const unsigned og = xb_add(&bar[XB_TOP], 1u);
            const unsigned tg = og / nx;
            if (og + 1u == (tg + 1u) * nx) xb_add(&bar[XB_TOPGEN], 1u);
            else XB_SPIN(xb_ld(&bar[XB_TOPGEN]) == tg, bar);
            __builtin_amdgcn_fence(__ATOMIC_ACQUIRE, "agent");
            xb_add(&bar[XB_XGEN(b.x)], 1u);
            asm volatile("s_waitcnt vmcnt(0)" ::: "memory");
        } else {
            XB_SPIN(xb_ld(&bar[XB_XGEN(b.x)]) == gen, bar);
            __builtin_amdgcn_fence(__ATOMIC_ACQUIRE, "agent");
            asm volatile("s_waitcnt vmcnt(0)" ::: "memory");
        }
    }
    __syncthreads();
}

struct Args { const float* in[29]; float* out; unsigned char* ws; int ph_lo, ph_hi, li, pad; };
enum { I_X = 0, I_C, I_WMOD, I_BMOD, I_N1G, I_WIN, I_BIN, I_LNG, I_LNB, I_GWS, I_GBS, I_LRE, I_LIM, I_LDT, I_BRE, I_BIM, I_CRE, I_CIM, I_SD, I_GLUW, I_GLUB,
       I_BRG, I_WOUT, I_N2G, I_WQ, I_KEYS, I_PU, I_PV, I_FG };

struct Frame {
    LAS unsigned char* lds;
    unsigned char* ws;
    const float* const* in;
    float* out;
    int tid, lane, wave, vcu, G;
};

#define PH_LOCALS int tid = F.tid; asm volatile("" : "+v"(tid)); const int lane = tid & 63; const int wave = __builtin_amdgcn_readfirstlane(tid >> 6); (void)lane; (void)wave;

struct EpiIn {
    static constexpr bool PERM = true, AFTER_DRAIN = false, KSPLIT = false;
    bf16* Z; bf16* XS; const float* bias;
    __device__ __forceinline__ void operator()(const f32x4 (&acc)[2][2][4][2], const pg8::Unit& u, int wr, int wc, int fr, int fq) const {
        const int row0 = u.pm * 256 + wr * 64 + fr, col0 = u.pn * 256 + wc * 32 + 8 * fq;
        f32x4 bv[2][2];
#pragma unroll
        for (int bj = 0; bj < 2; ++bj)
#pragma unroll
            for (int n = 0; n < 2; ++n) bv[bj][n] = *(const f32x4*)(bias + col0 + bj * 128 + 4 * n);
        const bool isz = (u.pn < 8);
#pragma unroll
        for (int ai = 0; ai < 2; ++ai)
#pragma unroll
            for (int m = 0; m < 4; ++m) {
                const int r = row0 + ai * 128 + m * 16;
#pragma unroll
                for (int bj = 0; bj < 2; ++bj) {
                    f32x4 v0 = acc[ai][bj][m][0] + bv[bj][0], v1 = acc[ai][bj][m][1] + bv[bj][1];
                    const int c = col0 + bj * 128;
                    u32x4 w;
                    if (isz) {
                        w.x = pg8::cvt_pk_bf16(gelu_tanh(v0[0]), gelu_tanh(v0[1])); w.y = pg8::cvt_pk_bf16(gelu_tanh(v0[2]), gelu_tanh(v0[3]));
                        w.z = pg8::cvt_pk_bf16(gelu_tanh(v1[0]), gelu_tanh(v1[1])); w.w = pg8::cvt_pk_bf16(gelu_tanh(v1[2]), gelu_tanh(v1[3]));
                        *(u32x4*)(Z + (size_t)r * 2048 + c) = w;
                    } else {
                        w.x = pg8::cvt_pk_bf16(v0[0], v0[1]); w.y = pg8::cvt_pk_bf16(v0[2], v0[3]); w.z = pg8::cvt_pk_bf16(v1[0], v1[1]); w.w = pg8::cvt_pk_bf16(v1[2], v1[3]);
                        const int cc = c - 2048, g = cc >> 4, i = cc & 15;
                        *(u32x4*)(XS + ((size_t)(g * 256 + (r >> 6)) * 64 + (r & 63)) * 16 + i) = w;
                    }
                }
            }
    }
};
struct EpiGlu {
    static constexpr bool PERM = true, AFTER_DRAIN = false, KSPLIT = false;
    const bf16* Gb; bf16* MIX; const float* bias; float* PSB;
    __device__ __forceinline__ void operator()(const f32x4 (&acc)[2][2][4][2], const pg8::Unit& u, int wr, int wc, int fr, int fq) const {
        const int row0 = u.pm * 256 + wr * 64 + fr, col0 = u.pn * 256 + wc * 32 + 8 * fq;
        f32x4 bv[2][2];
#pragma unroll
        for (int bj = 0; bj < 2; ++bj)
#pragma unroll
            for (int n = 0; n < 2; ++n) bv[bj][n] = *(const f32x4*)(bias + col0 + bj * 128 + 4 * n);
#pragma unroll
        for (int ai = 0; ai < 2; ++ai)
#pragma unroll
            for (int m = 0; m < 4; ++m) {
                const int r = row0 + ai * 128 + m * 16; float ssq = 0.f;
#pragma unroll
                for (int bj = 0; bj < 2; ++bj) {
                    const f32x4 v0 = acc[ai][bj][m][0] + bv[bj][0], v1 = acc[ai][bj][m][1] + bv[bj][1];
                    const int c = col0 + bj * 128;
                    const u32x4 gw = *(const u32x4*)(Gb + (size_t)r * 1024 + c);
                    const float o0 = bflo(gw.x) * fast_sigmoid(v0[0]), o1 = bfhi(gw.x) * fast_sigmoid(v0[1]), o2 = bflo(gw.y) * fast_sigmoid(v0[2]), o3 = bfhi(gw.y) * fast_sigmoid(v0[3]);
                    const float o4 = bflo(gw.z) * fast_sigmoid(v1[0]), o5 = bfhi(gw.z) * fast_sigmoid(v1[1]), o6 = bflo(gw.w) * fast_sigmoid(v1[2]), o7 = bfhi(gw.w) * fast_sigmoid(v1[3]);
                    u32x4 w; w.x = pg8::cvt_pk_bf16(o0, o1); w.y = pg8::cvt_pk_bf16(o2, o3); w.z = pg8::cvt_pk_bf16(o4, o5); w.w = pg8::cvt_pk_bf16(o6, o7);
                    *(u32x4*)(MIX + (size_t)r * 2048 + 1024 + c) = w;
                    ssq += (o0 * o0 + o1 * o1) + (o2 * o2 + o3 * o3) + (o4 * o4 + o5 * o5) + (o6 * o6 + o7 * o7);
                }
                ssq += __shfl_xor(ssq, 16); ssq += __shfl_xor(ssq, 32);
                if (fq == 0) PSB[(size_t)r * 16 + u.pn * 4 + wc] = ssq;
            }
    }
};
template <bool XIN_BF16> struct EpiOut {
    static constexpr bool PERM = true, AFTER_DRAIN = false, KSPLIT = true;
    const void* xin; bf16* X; const float* gate; float* PS; const LAS float* ratL; const LAS float* rbL; int pm0;
    __device__ __forceinline__ void midscale(f32x4 (&acc)[2][2][4][2], const pg8::Unit& u, int wr, int fr) const {
        const LAS float* rp = ratL + (u.pm == pm0 ? 0 : 256) + wr * 64 + fr;
#pragma unroll
        for (int ai = 0; ai < 2; ++ai)
#pragma unroll
            for (int m = 0; m < 4; ++m) { const float rt = rp[ai * 128 + m * 16];
#pragma unroll
                for (int bj = 0; bj < 2; ++bj)
#pragma unroll
                    for (int n = 0; n < 2; ++n) acc[ai][bj][m][n] = acc[ai][bj][m][n] * rt; }
    }
    __device__ __forceinline__ void operator()(const f32x4 (&acc)[2][2][4][2], const pg8::Unit& u, int wr, int wc, int fr, int fq) const {
        const int row0 = u.pm * 256 + wr * 64 + fr, col0 = u.pn * 256 + wc * 32 + 8 * fq;
        const LAS float* rbp = rbL + (u.pm == pm0 ? 0 : 256) + wr * 64 + fr;
        f32x4 gv[2][2];
#pragma unroll
        for (int bj = 0; bj < 2; ++bj)
#pragma unroll
            for (int n = 0; n < 2; ++n) gv[bj][n] = *(const f32x4*)(gate + col0 + bj * 128 + 4 * n);
#pragma unroll
        for (int ai = 0; ai < 2; ++ai)
#pragma unroll
            for (int m = 0; m < 4; ++m) {
                const int r = row0 + ai * 128 + m * 16; float ssq = 0.f; const float rb = rbp[ai * 128 + m * 16];
#pragma unroll
                for (int bj = 0; bj < 2; ++bj) {
                    const size_t off = (size_t)r * 2048 + col0 + bj * 128;
                    f32x4 x0, x1;
                    if (XIN_BF16) { const u32x4 w = *(const u32x4*)((const bf16*)xin + off); x0 = (f32x4){bflo(w.x), bfhi(w.x), bflo(w.y), bfhi(w.y)}; x1 = (f32x4){bflo(w.z), bfhi(w.z), bflo(w.w), bfhi(w.w)}; }
                    else { x0 = *(const f32x4*)((const float*)xin + off); x1 = *(const f32x4*)((const float*)xin + off + 4); }
                    const f32x4 y0 = x0 + gv[bj][0] * (acc[ai][bj][m][0] * rb), y1 = x1 + gv[bj][1] * (acc[ai][bj][m][1] * rb);
                    u32x4 o; o.x = pg8::cvt_pk_bf16(y0[0], y0[1]); o.y = pg8::cvt_pk_bf16(y0[2], y0[3]); o.z = pg8::cvt_pk_bf16(y1[0], y1[1]); o.w = pg8::cvt_pk_bf16(y1[2], y1[3]);
                    *(u32x4*)(X + off) = o;
                    ssq += (y0[0] * y0[0] + y0[1] * y0[1]) + (y0[2] * y0[2] + y0[3] * y0[3]) + (y1[0] * y1[0] + y1[1] * y1[1]) + (y1[2] * y1[2] + y1[3] * y1[3]);
                }
                ssq += __shfl_xor(ssq, 16); ssq += __shfl_xor(ssq, 32);
                if (fq == 0) PS[(size_t)r * 32 + u.pn * 4 + wc] = ssq;
            }
    }
};
struct EpiQ {
    static constexpr bool PERM = true, AFTER_DRAIN = false, KSPLIT = false;
    bf16* Q; const float* c0; const LAS float* rrL; int pm0;
    __device__ __forceinline__ void operator()(const f32x4 (&acc)[2][2][4][2], const pg8::Unit& u, int wr, int wc, int fr, int fq) const {
        const int row0 = u.pm * 256 + wr * 64 + fr, col0 = u.pn * 256 + wc * 32 + 8 * fq;
        const LAS float* rrp = rrL + (u.pm == pm0 ? 0 : 256) + wr * 64 + fr;
        f32x4 cv[2][2];
#pragma unroll
        for (int bj = 0; bj < 2; ++bj)
#pragma unroll
            for (int n = 0; n < 2; ++n) cv[bj][n] = *(const f32x4*)(c0 + col0 + bj * 128 + 4 * n);
#pragma unroll
        for (int ai = 0; ai < 2; ++ai)
#pragma unroll
            for (int m = 0; m < 4; ++m) {
                const int r = row0 + ai * 128 + m * 16; const float rr = rrp[ai * 128 + m * 16];
#pragma unroll
                for (int bj = 0; bj < 2; ++bj) {
                    const f32x4 v0 = acc[ai][bj][m][0] * rr + cv[bj][0], v1 = acc[ai][bj][m][1] * rr + cv[bj][1];
                    u32x4 w; w.x = pg8::cvt_pk_bf16(v0[0], v0[1]); w.y = pg8::cvt_pk_bf16(v0[2], v0[3]); w.z = pg8::cvt_pk_bf16(v1[0], v1[1]); w.w = pg8::cvt_pk_bf16(v1[2], v1[3]);
                    *(u32x4*)(Q + (size_t)r * 2048 + col0 + bj * 128) = w;
                }
            }
    }
};
__device__ __forceinline__ void fill_rr(Frame& F, LAS float* rrL, int slot, int pm, int tid) {
    if (tid < 256) { const float* ps = (const float*)(F.ws + WS_PS) + ((size_t)pm * 256 + tid) * 32; float s = 0.f;
#pragma unroll
        for (int i = 0; i < 8; ++i) { const f32x4 v = *(const f32x4*)(ps + 4 * i); s += (v[0] + v[1]) + (v[2] + v[3]); }
        rrL[slot * 256 + tid] = 1.0f / sqrtf(s * (1.0f / DM) + EPS); }
}

__device__ __forceinline__ void p0_transpose_item(const float* W, int K, int N, bf16* WT, const float* kscale, LAS float* scr, int item, int lane, const float* kscale2 = nullptr) {
    const int nblk = N / 32, kb = item / nblk, nb = item % nblk, k0 = 64 * kb, n0 = 32 * nb;
    float wv[32];
#pragma unroll
    for (int i = 0; i < 32; ++i) wv[i] = W[(size_t)(k0 + 2 * i + (lane >> 5)) * N + n0 + (lane & 31)];
#pragma unroll
    for (int i = 0; i < 32; ++i) { const int kk = 2 * i + (lane >> 5); float v = wv[i]; if (kscale) { v *= kscale[k0 + kk]; if (kscale2) v *= 1.0f + kscale2[k0 + kk]; } scr[kk * 33 + (lane & 31)] = v; }
    LDS_WAIT(); asm volatile("" ::: "memory");
    const int c = lane & 7;
#pragma unroll
    for (int j = 0; j < 4; ++j) { const int n = (lane >> 3) + 8 * j; const LAS float* s = scr + (8 * c) * 33 + n;
        u32x4 o; o.x = pk2(s[0 * 33], s[1 * 33]); o.y = pk2(s[2 * 33], s[3 * 33]); o.z = pk2(s[4 * 33], s[5 * 33]); o.w = pk2(s[6 * 33], s[7 * 33]);
        *(u32x4*)(WT + (size_t)(n0 + n) * K + k0 + 8 * c) = o; }
    LDS_WAIT(); asm volatile("" ::: "memory");
}

__device__ __forceinline__ void norm_mod_row(const f32x4 (&v)[4][2], const float* gain, const float* scale, const float* shift, int lane, u32x4 (&o)[4]) {
    float s = 0.f;
#pragma unroll
    for (int j = 0; j < 4; ++j)
#pragma unroll
        for (int h = 0; h < 2; ++h) s += (v[j][h][0] * v[j][h][0] + v[j][h][1] * v[j][h][1]) + (v[j][h][2] * v[j][h][2] + v[j][h][3] * v[j][h][3]);
    const float rr = 1.0f / sqrtf(wave_sum(s) * (1.0f / DM) + EPS);
#pragma unroll
    for (int j = 0; j < 4; ++j) {
        const int c = j * 512 + lane * 8;
        f32x4 y[2];
#pragma unroll
        for (int h = 0; h < 2; ++h) {
            const f32x4 g = *(const f32x4*)(gain + c + 4 * h);
            y[h] = v[j][h] * rr * g;
            const f32x4 sc = *(const f32x4*)(scale + c + 4 * h), sh = *(const f32x4*)(shift + c + 4 * h); y[h] = y[h] * (sc + 1.0f) + sh;
        }
        o[j].x = pk2(y[0][0], y[0][1]); o[j].y = pk2(y[0][2], y[0][3]); o[j].z = pk2(y[1][0], y[1][1]); o[j].w = pk2(y[1][2], y[1][3]);
    }
}
template <bool SRC_BF16>
__device__ __forceinline__ void load_row(const void* xrow_, int lane, f32x4 (&v)[4][2]) {
#pragma unroll
    for (int j = 0; j < 4; ++j) {
        if (SRC_BF16) { const u32x4 w = *(const u32x4*)((const bf16*)xrow_ + j * 512 + lane * 8); v[j][0] = (f32x4){bflo(w.x), bfhi(w.x), bflo(w.y), bfhi(w.y)}; v[j][1] = (f32x4){bflo(w.z), bfhi(w.z), bflo(w.w), bfhi(w.w)}; }
        else { const float* xrow = (const float*)xrow_; v[j][0] = *(const f32x4*)(xrow + j * 512 + lane * 8); v[j][1] = *(const f32x4*)(xrow + j * 512 + lane * 8 + 4); } }
}

__device__ __forceinline__ void p0_gemv_unit(Frame& F, int unit, int tid, float* modout) {
    const int l = unit / 192, r = unit % 192, cb = r >> 1, kh = r & 1;
    LAS float* sc = (LAS float*)F.lds;
    LAS float* red = (LAS float*)(F.lds + 4096);
    for (int k = tid; k < 1024; k += NTHR) { const float c = F.in[I_C][kh * 1024 + k]; sc[k] = c * fast_sigmoid(c); }
    __syncthreads();
    const int tx = tid & 31, ty = tid >> 5;
    const float* W = F.in[I_WMOD] + ((size_t)l * DM + kh * 1024) * 12288 + cb * 128 + tx * 4;
    f32x4 a = {0.f, 0.f, 0.f, 0.f};
#pragma unroll 16
    for (int k = ty; k < 1024; k += 16) { const f32x4 w = *(const f32x4*)(W + (size_t)k * 12288); a += w * sc[k]; }
    *(LAS f32x4*)(red + ty * 128 + tx * 4) = a;
    __syncthreads();
    if (tid < 128) { float s = 0.f;
#pragma unroll
        for (int y = 0; y < 16; ++y) s += red[y * 128 + tid];
        if (kh == 0) s += F.in[I_BMOD][l * 12288 + cb * 128 + tid];
        atomicAdd(modout + l * 12288 + cb * 128 + tid, s); }
    __syncthreads();
}
__device__ __forceinline__ void p0_s5_unit(Frame& F, int unit, int tid, int parts = 15) {
    const int l = unit >> 7, g = (unit >> 1) & 63, hf = unit & 1;
    LAS float* apr = (LAS float*)F.lds;
    LAS float* api = apr + 4228;
    LAS float* bbr = api + 4228;
    LAS float* bbi = bbr + 1024;
    LAS float* ccr = bbi + 1024;
    LAS float* cci = ccr + 16 * 65;
    const float dt = expf(F.in[I_LDT][l * 64 + g]);
    const float* lre = F.in[I_LRE] + (l * 64 + g) * 64; const float* lim = F.in[I_LIM] + (l * 64 + g) * 64;
    for (int idx = tid; idx < 65 * 64; idx += NTHR) { const int d = idx >> 6, p = idx & 63;
        const float mag = expf(lre[p] * dt * (float)d); float sn, cs; sincosf(lim[p] * dt * (float)d, &sn, &cs);
        apr[d * 65 + p] = mag * cs; api[d * 65 + p] = mag * sn; }
    for (int idx = tid; idx < 1024; idx += NTHR) { const int o = idx >> 6, p = idx & 63;
        ccr[o * 65 + p] = F.in[I_CRE][((size_t)(l * 64 + g) * 16 + o) * 64 + p]; cci[o * 65 + p] = F.in[I_CIM][((size_t)(l * 64 + g) * 16 + o) * 64 + p]; }
    __syncthreads();
    for (int idx = tid; idx < 1024; idx += NTHR) { const int p = idx >> 4, i = idx & 15;
        const float xr = apr[65 + p] - 1.0f, xi = api[65 + p], lr = lre[p], li = lim[p], den = 1.0f / (lr * lr + li * li);
        const float cr = (xr * lr + xi * li) * den, ci = (xi * lr - xr * li) * den;
        const float br = F.in[I_BRE][((size_t)(l * 64 + g) * 64 + p) * 16 + i], bi = F.in[I_BIM][((size_t)(l * 64 + g) * 64 + p) * 16 + i];
        bbr[idx] = cr * br - ci * bi; bbi[idx] = cr * bi + ci * br; }
    __syncthreads();
    bf16* KT = (bf16*)(F.ws + WS_KTAB) + (size_t)(l * 64 + g) * 80 * 256;
    if (parts & 1) {
        const int d = hf * 32 + (tid >> 4), o = tid & 15;
        const float dskip = F.in[I_SD][l * 1024 + g * 16 + o];
        float s[16];
#pragma unroll
        for (int i = 0; i < 16; ++i) s[i] = 0.f;
        for (int p = 0; p < 64; ++p) { const float ar = apr[d * 65 + p], ai = api[d * 65 + p], cr = ccr[o * 65 + p], ci = cci[o * 65 + p];
            const float er = cr * ar - ci * ai, ei = cr * ai + ci * ar;
#pragma unroll
            for (int q = 0; q < 4; ++q) { const f32x4 br = *(const LAS f32x4*)(bbr + p * 16 + 4 * q), bi = *(const LAS f32x4*)(bbi + p * 16 + 4 * q);
#pragma unroll
                for (int e = 0; e < 4; ++e) s[4 * q + e] += er * br[e] - ei * bi[e]; } }
#if !SELFTEST_S5
        {   const float dsk = (d == 0) ? dskip : 0.f;
#pragma unroll
            for (int i = 0; i < 16; ++i) s[i] += (i == o) ? dsk : 0.f; }
#endif
        u32x4 w0, w1;
        w0.x = pk2(s[0], s[1]); w0.y = pk2(s[2], s[3]); w0.z = pk2(s[4], s[5]); w0.w = pk2(s[6], s[7]);
        w1.x = pk2(s[8], s[9]); w1.y = pk2(s[10], s[11]); w1.z = pk2(s[12], s[13]); w1.w = pk2(s[14], s[15]);
        if ((parts & 8) || w0.x == 0x12345678u) { *(u32x4*)(KT + (size_t)(d + 16) * 256 + o * 16) = w0; *(u32x4*)(KT + (size_t)(d + 16) * 256 + o * 16 + 8) = w1; }
        if ((parts & 8) && hf == 0 && tid < 256) { const u32x4 z = {0u, 0u, 0u, 0u}; *(u32x4*)(KT + tid * 16) = z; *(u32x4*)(KT + tid * 16 + 8) = z; }
    }
    bf16* WG = (bf16*)(F.ws + WS_WG) + (size_t)(l * 64 + g) * 128 * 1024;
    if (parts & 2) for (int it = tid; it < 32 * 64; it += NTHR) { const int p = hf * 32 + (it >> 6), tau = it & 63;
        const float ar = apr[(63 - tau) * 65 + p], ai = api[(63 - tau) * 65 + p];
        unsigned wr_[8], wi_[8];
#pragma unroll
        for (int q = 0; q < 4; ++q) { const f32x4 br = *(const LAS f32x4*)(bbr + p * 16 + 4 * q), bi = *(const LAS f32x4*)(bbi + p * 16 + 4 * q);
            wr_[2 * q] = pk2(ar * br[0] - ai * bi[0], ar * br[1] - ai * bi[1]); wr_[2 * q + 1] = pk2(ar * br[2] - ai * bi[2], ar * br[3] - ai * bi[3]);
            wi_[2 * q] = pk2(ar * bi[0] + ai * br[0], ar * bi[1] + ai * br[1]); wi_[2 * q + 1] = pk2(ar * bi[2] + ai * br[2], ar * bi[3] + ai * br[3]); }
        *(u32x4*)(WG + (size_t)p * 1024 + tau * 16) = (u32x4){wr_[0], wr_[1], wr_[2], wr_[3]}; *(u32x4*)(WG + (size_t)p * 1024 + tau * 16 + 8) = (u32x4){wr_[4], wr_[5], wr_[6], wr_[7]};
        *(u32x4*)(WG + (size_t)(64 + p) * 1024 + tau * 16) = (u32x4){wi_[0], wi_[1], wi_[2], wi_[3]}; *(u32x4*)(WG + (size_t)(64 + p) * 1024 + tau * 16 + 8) = (u32x4){wi_[4], wi_[5], wi_[6], wi_[7]}; }
    bf16* VG = (bf16*)(F.ws + WS_VG) + (size_t)(l * 64 + g) * 1024 * 128;
    if (parts & 4) for (int it = tid; it < 512 * 8; it += NTHR) { const int m = hf * 512 + (it >> 3), p0 = (it & 7) * 8, t = m >> 4, o = m & 15;
        float vr_[8], vi_[8];
#pragma unroll
        for (int e = 0; e < 8; ++e) { const float ar = apr[(t + 1) * 65 + p0 + e], ai = api[(t + 1) * 65 + p0 + e], cr = ccr[o * 65 + p0 + e], ci = cci[o * 65 + p0 + e];
            vr_[e] = cr * ar - ci * ai; vi_[e] = -(cr * ai + ci * ar); }
        *(u32x4*)(VG + (size_t)m * 128 + p0) = (u32x4){pk2(vr_[0], vr_[1]), pk2(vr_[2], vr_[3]), pk2(vr_[4], vr_[5]), pk2(vr_[6], vr_[7])};
        *(u32x4*)(VG + (size_t)m * 128 + 64 + p0) = (u32x4){pk2(vi_[0], vi_[1]), pk2(vi_[2], vi_[3]), pk2(vi_[4], vi_[5]), pk2(vi_[6], vi_[7])}; }
    if (hf == 0 && tid < 64) { float* AT = (float*)(F.ws + WS_AT) + ((size_t)(l * 64 + g) * 64 + tid) * 2; AT[0] = apr[64 * 65 + tid]; AT[1] = api[64 * 65 + tid]; }
    __syncthreads();
}
__device__ __forceinline__ void p0_fp4_chunk(Frame& F, int chunk, int wave, int lane) {
    unsigned char* UV = F.ws + WS_UV; float* SCL = (float*)(F.ws + WS_SCL);
    for (int i = 0; i < 8; i += 2) {
        f32x4 v[2][8]; float am[2] = {0.f, 0.f}; int tbl[2], rr[2];
#pragma unroll
        for (int r2 = 0; r2 < 2; ++r2) {
            const int r = chunk * 64 + wave * 8 + i + r2; tbl[r2] = r >> 15; rr[r2] = r & 32767;
            const float* srcp = (tbl[r2] ? F.in[I_PV] : F.in[I_PU]) + (size_t)rr[r2] * 2048 + lane * 4;
#pragma unroll
            for (int j = 0; j < 8; ++j) v[r2][j] = *(const f32x4*)(srcp + j * 256);
        }
#pragma unroll
        for (int r2 = 0; r2 < 2; ++r2)
#pragma unroll
            for (int j = 0; j < 8; ++j) am[r2] = fmaxf(am[r2], fmaxf(fmaxf(fabsf(v[r2][j][0]), fabsf(v[r2][j][1])), fmaxf(fabsf(v[r2][j][2]), fabsf(v[r2][j][3]))));
#pragma unroll
        for (int o = 1; o < 64; o <<= 1) { am[0] = fmaxf(am[0], __shfl_xor(am[0], o)); am[1] = fmaxf(am[1], __shfl_xor(am[1], o)); }
#pragma unroll
        for (int r2 = 0; r2 < 2; ++r2) {
            const float scale = am[r2] > 0.f ? am[r2] * (1.0f / 6.0f) : 1.0f, inv = am[r2] > 0.f ? 6.0f / am[r2] : 1.0f;
            u32x4 o;
#pragma unroll
            for (int d = 0; d < 4; ++d) { unsigned w = 0u;
                w = __builtin_amdgcn_cvt_scalef32_pk_fp4_f32(w, v[r2][2 * d][0] * inv, v[r2][2 * d][1] * inv, 1.0f, 0);
                w = __builtin_amdgcn_cvt_scalef32_pk_fp4_f32(w, v[r2][2 * d][2] * inv, v[r2][2 * d][3] * inv, 1.0f, 1);
                w = __builtin_amdgcn_cvt_scalef32_pk_fp4_f32(w, v[r2][2 * d + 1][0] * inv, v[r2][2 * d + 1][1] * inv, 1.0f, 2);
                w = __builtin_amdgcn_cvt_scalef32_pk_fp4_f32(w, v[r2][2 * d + 1][2] * inv, v[r2][2 * d + 1][3] * inv, 1.0f, 3);
                o[d] = w; }
            *(u32x4*)(UV + (size_t)rr[r2] * 2048 + tbl[r2] * 1024 + lane * 16) = o;
            if (lane == 0) SCL[rr[r2] * 2 + tbl[r2]] = scale;
        }
    }
}
#ifndef P0_PARTS
#define P0_PARTS 15
#endif
#ifndef P0_PROBE_MODE
#define P0_PROBE_MODE 0
#endif
__device__ __forceinline__ void p0_tables(Frame& F, int qi = 4, bool dummy = false) {
    PH_LOCALS
    unsigned* head = (unsigned*)(F.ws + WS_CTL) + CW_QUEUE + 64 * qi;
    float* modout = dummy ? (float*)(F.ws + WS_DBG) : (float*)(F.ws + WS_MOD);
    LAS unsigned* slot = (LAS unsigned*)(F.lds + MISC_OFF) + 16;
    for (;;) {
        __syncthreads();
        if (tid == 0) slot[0] = __hip_atomic_fetch_add(head, 1u, RLX_AGENT);
        __syncthreads();
        const unsigned u = slot[0];
        if (u >= 1664u) break;
        const int rnd = (int)u / 13, k = (int)u % 13;
        if (k < 2) { if (dummy && P0_PROBE_MODE == 2) continue; p0_s5_unit(F, rnd * 2 + k, tid, dummy ? P0_PARTS : 15); }
        else if (k < 5) { if (dummy && P0_PROBE_MODE == 1) continue; p0_gemv_unit(F, rnd * 3 + (k - 2), tid, modout); }
        else { p0_fp4_chunk(F, rnd * 8 + (k - 5), wave, lane); }
    }
}
__device__ __forceinline__ void p0_prologue(Frame& F) {
    PH_LOCALS
    const int gw = F.vcu * NWAVES + wave, NGW = F.G * NWAVES;
    const int gt = F.vcu * NTHR + tid, NGT = F.G * NTHR;
    const float* modp = (const float*)(F.ws + WS_MOD);
    for (int i = gt; i < 2 * DM; i += NGT) { const int l = i >> 11, k = i & 2047; ((float*)(F.ws + WS_GS))[i] = F.in[I_N2G][i] * (1.0f + modp[l * 12288 + 4 * 2048 + k]); }
    if (F.vcu < 64) {
        const int l = F.vcu >> 5, cb = F.vcu & 31, tx = tid & 15, ty = tid >> 4;
        const float* W = F.in[I_WQ] + (size_t)l * DM * DM + cb * 64 + tx * 4; const float* sh = modp + l * 12288 + 3 * 2048;
        f32x4 a = {0.f, 0.f, 0.f, 0.f};
#pragma unroll 16
        for (int k = ty; k < DM; k += 32) { const f32x4 w = *(const f32x4*)(W + (size_t)k * DM); a += w * sh[k]; }
        LAS float* red = (LAS float*)F.lds;
        *(LAS f32x4*)(red + ty * 64 + tx * 4) = a;
        __syncthreads();
        if (tid < 64) { float s = 0.f;
#pragma unroll
            for (int y = 0; y < 32; ++y) s += red[y * 64 + tid];
            ((float*)(F.ws + WS_C0))[l * DM + cb * 64 + tid] = s; }
        __syncthreads();
    }
    {
        LAS float* scr = (LAS float*)(F.lds + wave * 16384);
        constexpr int I_IN = (DM / 64) * (INW / 32), I_GL = (WB / 64) * (WB / 32), I_OU = (DM / 64) * (DM / 32), I_Q = I_OU;
        constexpr int PER_L = I_IN + I_GL + I_OU + I_Q;
        for (int it = gw; it < 2 * PER_L; it += NGW) {
            const int l = it / PER_L; int r = it % PER_L;
            if (r < I_IN) { p0_transpose_item(F.in[I_WIN] + (size_t)l * DM * INW, DM, INW, (bf16*)(F.ws + WS_WIN) + (size_t)l * INW * DM, nullptr, scr, r, lane); continue; } r -= I_IN;
            if (r < I_GL) { p0_transpose_item(F.in[I_GLUW] + (size_t)l * WB * WB, WB, WB, (bf16*)(F.ws + WS_GLU) + (size_t)l * WB * WB, nullptr, scr, r, lane); continue; } r -= I_GL;
            if (r < I_OU) { p0_transpose_item(F.in[I_WOUT] + (size_t)l * DM * DM, DM, DM, (bf16*)(F.ws + WS_WOUT) + (size_t)l * DM * DM, F.in[I_BRG] + l * DM, scr, r, lane); continue; } r -= I_OU;
            p0_transpose_item(F.in[I_WQ] + (size_t)l * DM * DM, DM, DM, (bf16*)(F.ws + WS_WQ) + (size_t)l * DM * DM, F.in[I_N2G] + l * DM, scr, r, lane, modp + l * 12288 + 4 * 2048);
        }
    }
    {
        bf16* KB = (bf16*)(F.ws + WS_KEYS);
        for (int i = gt; i < 2 * 8 * 2 * 128 * 128 / 8; i += NGT) { const f32x4 a = *(const f32x4*)(F.in[I_KEYS] + (size_t)i * 8), b = *(const f32x4*)(F.in[I_KEYS] + (size_t)i * 8 + 4);
            u32x4 o; o.x = pk2(a[0], a[1]); o.y = pk2(a[2], a[3]); o.z = pk2(b[0], b[1]); o.w = pk2(b[2], b[3]); *(u32x4*)(KB + (size_t)i * 8) = o; }
        bf16* GW = (bf16*)(F.ws + WS_GWS);
        for (int i = gt; i < 2 * 8 * 128 * 128 / 8; i += NGT) { const int e = i * 8, jj = e & 127, ii = (e >> 7) & 127; const bool keep = (ii >= 64) || (jj < 64);
            f32x4 a = *(const f32x4*)(F.in[I_GWS] + (size_t)i * 8), b = *(const f32x4*)(F.in[I_GWS] + (size_t)i * 8 + 4);
            if (!keep) { a = (f32x4){0.f, 0.f, 0.f, 0.f}; b = a; }
            u32x4 o; o.x = pk2(a[0], a[1]); o.y = pk2(a[2], a[3]); o.z = pk2(b[0], b[1]); o.w = pk2(b[2], b[3]); *(u32x4*)(GW + (size_t)i * 8) = o; }
    }
}

template <bool SRC_BF16>
__device__ __forceinline__ void phase_norm(Frame& F, const void* xsrc, const float* gain, const float* scale, const float* shift) {
    PH_LOCALS
    const int gw = F.vcu * NWAVES + wave, NGW = F.G * NWAVES;
    bf16* H = (bf16*)(F.ws + WS_H);
    for (int m = gw; m < M; m += 2 * NGW) {
        const int m2 = m + NGW;
        f32x4 va[4][2], vb[4][2];
        const char* ra = (const char*)xsrc + (size_t)m * DM * (SRC_BF16 ? 2 : 4); const char* rb = (const char*)xsrc + (size_t)(m2 < M ? m2 : m) * DM * (SRC_BF16 ? 2 : 4);
        load_row<SRC_BF16>(ra, lane, va); load_row<SRC_BF16>(rb, lane, vb);
        u32x4 oa[4], ob[4]; norm_mod_row(va, gain, scale, shift, lane, oa); norm_mod_row(vb, gain, scale, shift, lane, ob);
#pragma unroll
        for (int j = 0; j < 4; ++j) *(u32x4*)(H + (size_t)m * DM + j * 512 + lane * 8) = oa[j];
        if (m2 < M) {
#pragma unroll
            for (int j = 0; j < 4; ++j) *(u32x4*)(H + (size_t)m2 * DM + j * 512 + lane * 8) = ob[j]; }
    }
}
__device__ __forceinline__ void phase_lnstats(Frame& F) {
    PH_LOCALS
    const int gw = F.vcu * NWAVES + wave, NGW = F.G * NWAVES;
    const bf16* Z = (const bf16*)(F.ws + WS_Z); float* ST = (float*)(F.ws + WS_STATS);
    for (int m0 = gw; m0 < M; m0 += 2 * NGW) {
        float v[2][16]; int mm[2];
#pragma unroll
        for (int r = 0; r < 2; ++r) { mm[r] = (m0 + r * NGW < M) ? m0 + r * NGW : m0;
#pragma unroll
            for (int j = 0; j < 2; ++j) { const u32x4 w = *(const u32x4*)(Z + (size_t)mm[r] * 2048 + 1024 + j * 512 + lane * 8);
                v[r][j * 8 + 0] = bflo(w.x); v[r][j * 8 + 1] = bfhi(w.x); v[r][j * 8 + 2] = bflo(w.y); v[r][j * 8 + 3] = bfhi(w.y); v[r][j * 8 + 4] = bflo(w.z); v[r][j * 8 + 5] = bfhi(w.z); v[r][j * 8 + 6] = bflo(w.w); v[r][j * 8 + 7] = bfhi(w.w); } }
        float s[2] = {0.f, 0.f};
#pragma unroll
        for (int r = 0; r < 2; ++r)
#pragma unroll
            for (int i = 0; i < 16; ++i) s[r] += v[r][i];
#pragma unroll
        for (int o = 1; o < 64; o <<= 1) { s[0] += __shfl_xor(s[0], o); s[1] += __shfl_xor(s[1], o); }
        float q[2] = {0.f, 0.f}; const float mean[2] = {s[0] * (1.0f / 1024.0f), s[1] * (1.0f / 1024.0f)};
#pragma unroll
        for (int r = 0; r < 2; ++r)
#pragma unroll
            for (int i = 0; i < 16; ++i) { const float d = v[r][i] - mean[r]; q[r] += d * d; }
#pragma unroll
        for (int o = 1; o < 64; o <<= 1) { q[0] += __shfl_xor(q[0], o); q[1] += __shfl_xor(q[1], o); }
        if (lane < 2) { const int r = lane; const float qq = r ? q[1] : q[0], mu = r ? mean[1] : mean[0]; const int m = r ? mm[1] : mm[0];
            ST[2 * m] = mu; ST[2 * m + 1] = 1.0f / sqrtf(qq * (1.0f / 1024.0f) + EPS); }
    }
}
__device__ __forceinline__ void phase_sloc(Frame& F, int l) {
    PH_LOCALS
    const bf16* XS = (const bf16*)(F.ws + WS_XS); const bf16* WG = (const bf16*)(F.ws + WS_WG) + (size_t)l * 64 * 128 * 1024; float* SL = (float*)(F.ws + WS_SLOC);
    LAS unsigned char* WL = F.lds;
    const int fr = lane & 15, fq = lane >> 4;
    for (int u = F.vcu; u < 256; u += F.G) {
        const int g = u >> 2, jq = u & 3;
        const bf16* xp0 = XS + ((size_t)(g * 256 + 32 * wave + fr)) * 1024 + 8 * fq;
        bf16x8 xa[8][2];
#pragma unroll
        for (int i = 0; i < 8; ++i) { xa[i][0] = *(const bf16x8*)(xp0 + i * 32); xa[i][1] = *(const bf16x8*)(xp0 + 16 * 1024 + i * 32); }
        __syncthreads();
#pragma unroll
        for (int ps = 0; ps < 8; ++ps) { const int idx = ps * 512 + tid, row = idx >> 7, c16 = idx & 127;
            *(LAS u32x4*)(WL + row * 2064 + c16 * 16) = *(const u32x4*)(WG + ((size_t)(g * 128 + jq * 32 + row)) * 1024 + c16 * 8); }
        __syncthreads();
        f32x4 acc[2][2];
#pragma unroll
        for (int a = 0; a < 2; ++a) { acc[a][0] = (f32x4){0.f, 0.f, 0.f, 0.f}; acc[a][1] = acc[a][0]; }
#pragma unroll 1
        for (int kg = 0; kg < 4; ++kg) {
            bf16x8 xn[8][2];
            if (kg < 3) {
#pragma unroll
                for (int i = 0; i < 8; ++i) { xn[i][0] = *(const bf16x8*)(xp0 + ((kg + 1) * 8 + i) * 32); xn[i][1] = *(const bf16x8*)(xp0 + 16 * 1024 + ((kg + 1) * 8 + i) * 32); }
            }
#pragma unroll
            for (int i = 0; i < 8; ++i) { const int kb = kg * 8 + i;
#pragma unroll
                for (int jt = 0; jt < 2; ++jt) { const bf16x8 wf = *(const LAS bf16x8*)(WL + (jt * 16 + fr) * 2064 + (kb * 32 + 8 * fq) * 2);
                    acc[0][jt] = __builtin_amdgcn_mfma_f32_16x16x32_bf16(wf, xa[i][0], acc[0][jt], 0, 0, 0);
                    acc[1][jt] = __builtin_amdgcn_mfma_f32_16x16x32_bf16(wf, xa[i][1], acc[1][jt], 0, 0, 0); } }
            if (kg < 3) {
#pragma unroll
                for (int i = 0; i < 8; ++i) { xa[i][0] = xn[i][0]; xa[i][1] = xn[i][1]; }
            }
        }
#pragma unroll
        for (int a = 0; a < 2; ++a)
#pragma unroll
            for (int jt = 0; jt < 2; ++jt) *(f32x4*)(SL + ((size_t)(g * 256 + 32 * wave + 16 * a + fr)) * 128 + jq * 32 + jt * 16 + 4 * fq) = acc[a][jt];
    }
    __syncthreads();
}
__device__ __forceinline__ void phase_gating(Frame& F, int l) {
    PH_LOCALS
    const bf16* Z = (const bf16*)(F.ws + WS_Z); const float* ST = (const float*)(F.ws + WS_STATS);
    bf16* MIX = (bf16*)(F.ws + WS_MIX);
    LAS bf16* VT = (LAS bf16*)F.lds;
    constexpr int VS = 136;
    const int j = tid >> 2, cs = (tid & 3) * 32;
    const int fr = lane & 15, fq = lane >> 4, w = wave;
    u32x4 tw[4]; float mu = 0.f, rs = 0.f;
#define GT_LOAD(unit_) do { const int nb_ = (unit_) >> 3, hh_ = (unit_) & 7; const size_t rowo = (size_t)(nb_ * 128 + j) * 2048 + 1024 + hh_ * 128 + cs; \
        _Pragma("unroll") for (int q = 0; q < 4; ++q) tw[q] = *(const u32x4*)(Z + rowo + q * 8); \
        mu = ST[2 * (nb_ * 128 + j)]; rs = ST[2 * (nb_ * 128 + j) + 1]; } while (0)
    if (F.vcu < 1024) GT_LOAD(F.vcu);
    for (int unit = F.vcu; unit < 1024; unit += F.G) {
        const int nb = unit >> 3, hh = unit & 7, t0 = nb * 128, c0 = hh * 128;
        const bf16* GW = (const bf16*)(F.ws + WS_GWS) + (size_t)(l * 8 + hh) * 128 * 128;
        {
            const float* lg = F.in[I_LNG] + l * 1024 + c0 + cs; const float* lb = F.in[I_LNB] + l * 1024 + c0 + cs;
#pragma unroll
            for (int q = 0; q < 4; ++q) {
                const f32x4 g0 = *(const f32x4*)(lg + q * 8), g1 = *(const f32x4*)(lg + q * 8 + 4), b0 = *(const f32x4*)(lb + q * 8), b1 = *(const f32x4*)(lb + q * 8 + 4);
#pragma unroll
                for (int e = 0; e < 4; ++e) { const int c = cs + q * 8 + 2 * e;
                    const float ga = e < 2 ? g0[2 * e] : g1[2 * e - 4], gb = e < 2 ? g0[2 * e + 1] : g1[2 * e - 3], ba = e < 2 ? b0[2 * e] : b1[2 * e - 4], bb = e < 2 ? b0[2 * e + 1] : b1[2 * e - 3];
                    const float a = (bflo(tw[q][e]) - mu) * rs * ga + ba, b = (bfhi(tw[q][e]) - mu) * rs * gb + bb;
                    VT[c * VS + j] = (bf16)f2bf(a); VT[(c + 1) * VS + j] = (bf16)f2bf(b); }
            }
        }
        if (unit + F.G < 1024) GT_LOAD(unit + F.G);
        const int nkb = (w < 4) ? 2 : 4;
        bf16x8 wf[4];
#pragma unroll
        for (int kb = 0; kb < 4; ++kb) wf[kb] = *(const bf16x8*)(GW + (size_t)(16 * w + fr) * 128 + (kb < nkb ? kb : 0) * 32 + 8 * fq);
        const int tok = t0 + 16 * w + fr; const float bs = F.in[I_GBS][(l * 8 + hh) * 128 + 16 * w + fr];
        u32x2 uw[8];
#pragma unroll
        for (int ct = 0; ct < 8; ++ct) uw[ct] = *(const u32x2*)(Z + (size_t)tok * 2048 + c0 + ct * 16 + 4 * fq);
        __syncthreads();
        {
            f32x4 acc[8];
#pragma unroll
            for (int ct = 0; ct < 8; ++ct) acc[ct] = (f32x4){0.f, 0.f, 0.f, 0.f};
#pragma unroll
            for (int kb = 0; kb < 4; ++kb) { if (kb < nkb) {
#pragma unroll
                for (int ct = 0; ct < 8; ++ct) { const bf16x8 vf = *(const LAS bf16x8*)(VT + (ct * 16 + fr) * VS + kb * 32 + 8 * fq); acc[ct] = __builtin_amdgcn_mfma_f32_16x16x32_bf16(vf, wf[kb], acc[ct], 0, 0, 0); } } }
            float ssq = 0.f;
#pragma unroll
            for (int ct = 0; ct < 8; ++ct) { const int c = c0 + ct * 16 + 4 * fq;
                const float o0 = bflo(uw[ct].x) * (acc[ct][0] + bs), o1 = bfhi(uw[ct].x) * (acc[ct][1] + bs), o2 = bflo(uw[ct].y) * (acc[ct][2] + bs), o3 = bfhi(uw[ct].y) * (acc[ct][3] + bs);
                u32x2 o; o.x = pk2(o0, o1); o.y = pk2(o2, o3);
                *(u32x2*)(MIX + (size_t)tok * 2048 + c) = o; ssq += (o0 * o0 + o1 * o1) + (o2 * o2 + o3 * o3); }
            ssq += __shfl_xor(ssq, 16); ssq += __shfl_xor(ssq, 32);
            if (fq == 0) ((float*)(F.ws + WS_PSA))[(size_t)tok * 8 + hh] = ssq;
        }
        __syncthreads();
    }
#undef GT_LOAD
}

__device__ __forceinline__ void phase_s5out(Frame& F, int l) {
    PH_LOCALS
    const bf16* XS = (const bf16*)(F.ws + WS_XS);
    bf16* Gb = (bf16*)(F.ws + WS_G);
    LAS unsigned char* HT = F.lds;
    LAS float* TS = (LAS float*)(F.lds + 34816);
    LAS unsigned char* KT = F.lds + 38912;
    LAS unsigned char* VT = F.lds + 79872;
    const int fr = lane & 15, fq = lane >> 4;
    for (int u = F.vcu; u < 512; u += F.G) {
        const int g = u >> 3, rc = (u >> 1) & 3, nh = u & 1;
        const bf16* VG = (const bf16*)(F.ws + WS_VG) + (size_t)(l * 64 + g) * 1024 * 128;
        const int n = nh * 128 + 16 * wave + fr;
        const bf16* xp0 = XS + ((size_t)(g * 256 + n)) * 1024 + 8 * fq;
        bf16x8 xa[4], xb[4];
#pragma unroll
        for (int i = 0; i < 4; ++i) xa[i] = *(const bf16x8*)(xp0 + i * 32);
        __syncthreads();
        { const u32x4* src = (const u32x4*)((const bf16*)(F.ws + WS_KTAB) + (size_t)(l * 64 + g) * 80 * 256);
          for (int i = tid; i < 80 * 256 / 8; i += NTHR) ((LAS u32x4*)KT)[i] = src[i];
#pragma unroll
          for (int ps = 0; ps < 8; ++ps) { const int row = ps * 32 + (tid >> 4), c = tid & 15, q = row >> 4, o = row & 15;
              *(LAS u32x4*)(VT + row * 272 + c * 16) = *(const u32x4*)(VG + (size_t)((rc + 4 * q) * 16 + o) * 128 + c * 8); } }
        {
            const int p = lane, seg = wave;
            const float* AT = (const float*)(F.ws + WS_AT) + ((size_t)(l * 64 + g) * 64 + p) * 2; const float ar = AT[0], ai = AT[1];
            const float* SL = (const float*)(F.ws + WS_SLOC) + ((size_t)(g * 256 + seg * 32)) * 128 + p;
            float sr[32], si[32];
#pragma unroll
            for (int i = 0; i < 32; ++i) { sr[i] = SL[(size_t)i * 128]; si[i] = SL[(size_t)i * 128 + 64]; }
            float er = 0.f, ei = 0.f;
#pragma unroll
            for (int i = 0; i < 32; ++i) { const float nr = ar * er - ai * ei + sr[i], ni = ar * ei + ai * er + si[i]; er = nr; ei = ni; }
            TS[(seg * 64 + p) * 2] = er; TS[(seg * 64 + p) * 2 + 1] = ei;
            float qr = ar, qi = ai;
#pragma unroll
            for (int s = 0; s < 5; ++s) { const float nr = qr * qr - qi * qi, ni = 2.0f * qr * qi; qr = nr; qi = ni; }
            __syncthreads();
            float hr = 0.f, hi = 0.f;
            for (int k = 0; k < seg; ++k) { const float tr = TS[(k * 64 + p) * 2], ti = TS[(k * 64 + p) * 2 + 1]; const float nr = qr * hr - qi * hi + tr, ni = qr * hi + qi * hr + ti; hr = nr; hi = ni; }
            if ((seg >> 2) == nh) {
                LAS bf16* hrow = (LAS bf16*)(HT + ((seg & 3) * 32) * 272) + p;
#pragma unroll
                for (int i = 0; i < 32; ++i) { hrow[i * 136] = (bf16)f2bf(hr); hrow[i * 136 + 64] = (bf16)f2bf(hi);
                    const float nr = ar * hr - ai * hi + sr[i], ni = ar * hi + ai * hr + si[i]; hr = nr; hi = ni; }
            }
        }
        __syncthreads();
        f32x4 acc[16];
#pragma unroll
        for (int q = 0; q < 16; ++q) acc[q] = (f32x4){0.f, 0.f, 0.f, 0.f};
        const int kb0 = ((rc - (fq >> 1) + 10) * 16 + fr) * 32 + 16 * (fq & 1);
#define S5_GROUP(XF, grp_) do { const LAS unsigned char* kp = KT + kb0 - (grp_) * 4096; \
            _Pragma("unroll") for (int q = 0; q < 16; ++q) { if (rc + 4 * q >= 8 * (grp_)) { \
                _Pragma("unroll") for (int i = 0; i < 4; ++i) { const bf16x8 kf = *(const LAS bf16x8*)(kp + (4 * q - 2 * i + 6) * 512); \
                    acc[q] = __builtin_amdgcn_mfma_f32_16x16x32_bf16(kf, XF[i], acc[q], 0, 0, 0); } } } } while (0)
#pragma unroll 1
        for (int gp = 0; gp < 4; ++gp) {
#pragma unroll
            for (int i = 0; i < 4; ++i) xb[i] = *(const bf16x8*)(xp0 + ((2 * gp + 1) * 4 + i) * 32);
            S5_GROUP(xa, 2 * gp);
            if (gp < 3) {
#pragma unroll
                for (int i = 0; i < 4; ++i) xa[i] = *(const bf16x8*)(xp0 + ((2 * gp + 2) * 4 + i) * 32);
            }
            S5_GROUP(xb, 2 * gp + 1);
        }
#undef S5_GROUP
#pragma unroll 1
        for (int jb = 0; jb < 4; ++jb) {
            const bf16x8 hf = *(const LAS bf16x8*)(HT + (16 * wave + fr) * 272 + (jb * 32 + 8 * fq) * 2);
#pragma unroll
            for (int q = 0; q < 16; ++q) {
                const bf16x8 vf = *(const LAS bf16x8*)(VT + (q * 16 + fr) * 272 + (jb * 32 + 8 * fq) * 2);
                acc[q] = __builtin_amdgcn_mfma_f32_16x16x32_bf16(vf, hf, acc[q], 0, 0, 0);
            }
        }
#pragma unroll
        for (int q = 0; q < 16; ++q) {
            const int t = rc + 4 * q, tok = 64 * n + t;
            const f32x4 y = acc[q];
            u32x2 o; o.x = pk2(gelu_tanh(y[0]), gelu_tanh(y[1])); o.y = pk2(gelu_tanh(y[2]), gelu_tanh(y[3]));
            *(u32x2*)(Gb + (size_t)tok * 1024 + g * 16 + 4 * fq) = o;
#if SELFTEST_S5
            if (tok < 256) *(f32x4*)((float*)(F.ws + WS_DBG) + (size_t)tok * 1024 + g * 16 + 4 * fq) = y;
#endif
        }
    }
    __syncthreads();
}
#if SELFTEST_S5
__device__ __forceinline__ void selftest_s5(Frame& F, int l) {
    PH_LOCALS
    if (F.vcu < 64 && wave == 0) {
        const int g = F.vcu, p = lane;
        const float dt = expf(F.in[I_LDT][l * 64 + g]);
        const float lr = F.in[I_LRE][(l * 64 + g) * 64 + p], li = F.in[I_LIM][(l * 64 + g) * 64 + p];
        const float mag = expf(lr * dt); float sn, cs; sincosf(li * dt, &sn, &cs);
        const float ar = mag * cs, ai = mag * sn;
        const float xr = ar - 1.0f, xi = ai, den = 1.0f / (lr * lr + li * li);
        const float cr = (xr * lr + xi * li) * den, ci = (xi * lr - xr * li) * den;
        float bbr[16], bbi[16], ccr[16], cci[16];
#pragma unroll
        for (int i = 0; i < 16; ++i) { const float br = F.in[I_BRE][((size_t)(l * 64 + g) * 64 + p) * 16 + i], bi = F.in[I_BIM][((size_t)(l * 64 + g) * 64 + p) * 16 + i];
            bbr[i] = cr * br - ci * bi; bbi[i] = cr * bi + ci * br;
            ccr[i] = F.in[I_CRE][((size_t)(l * 64 + g) * 16 + i) * 64 + p]; cci[i] = F.in[I_CIM][((size_t)(l * 64 + g) * 16 + i) * 64 + p]; }
        const bf16* XS = (const bf16*)(F.ws + WS_XS) + (size_t)g * 256 * 1024;
        const float* DY = (const float*)(F.ws + WS_DBG);
        float sr = 0.f, si = 0.f, err = 0.f, ref = 0.f;
        for (int t = 0; t < 256; ++t) {
            float x[16];
#pragma unroll
            for (int i = 0; i < 16; ++i) x[i] = bflo((unsigned)XS[(size_t)t * 16 + i]);
            float ur = 0.f, ui = 0.f;
#pragma unroll
            for (int i = 0; i < 16; ++i) { ur += bbr[i] * x[i]; ui += bbi[i] * x[i]; }
            const float nr = ar * sr - ai * si + ur, ni = ar * si + ai * sr + ui; sr = nr; si = ni;
#pragma unroll
            for (int o = 0; o < 16; ++o) {
                const float yr = wave_sum(ccr[o] * sr - cci[o] * si);
                const float yf = DY[(size_t)t * 1024 + g * 16 + o];
                err += (yf - yr) * (yf - yr); ref += yr * yr;
            }
        }
        if (lane == 0 && !(err <= 2e-3f * ref)) __hip_atomic_fetch_or((unsigned*)(F.ws + WS_CTL) + CW_FLAG, 1u, RLX_AGENT);
    }
}
#endif

__device__ __forceinline__ unsigned f2key(float v) { const unsigned u = __builtin_bit_cast(unsigned, v); return (u & 0x80000000u) ? ~u : (u | 0x80000000u); }
__device__ __forceinline__ float key2f(unsigned k) { const unsigned u = (k & 0x80000000u) ? (k & 0x7fffffffu) : ~k; return __builtin_bit_cast(float, u); }
__device__ __forceinline__ void sort16_desc(unsigned (&v)[16]) {
#pragma unroll
    for (int lk = 1; lk <= 4; ++lk) {
#pragma unroll
        for (int lj = lk - 1; lj >= 0; --lj) {
#pragma unroll
            for (int i = 0; i < 16; ++i) { const int k = 1 << lk, j = 1 << lj, p = i ^ j;
                if (p > i) { const unsigned a = v[i], c = v[p], hi = a > c ? a : c, lo = a > c ? c : a; const bool desc = ((i & k) == 0) || (k == 16);
                    v[i] = desc ? hi : lo; v[p] = desc ? lo : hi; } }
        }
    }
}
__device__ __forceinline__ void merge16_desc(unsigned (&v)[16], const unsigned (&w)[16]) {
#pragma unroll
    for (int i = 0; i < 16; ++i) v[i] = v[i] > w[15 - i] ? v[i] : w[15 - i];
#pragma unroll
    for (int lj = 3; lj >= 0; --lj) {
#pragma unroll
        for (int i = 0; i < 16; ++i) { const int j = 1 << lj, p = i ^ j;
            if (p > i) { const unsigned a = v[i], c = v[p]; v[i] = a > c ? a : c; v[p] = a > c ? c : a; } }
    }
}
__device__ __forceinline__ void xmerge16(unsigned (&v)[16], int mask) {
    unsigned w[16];
#pragma unroll
    for (int i = 0; i < 16; ++i) w[i] = (unsigned)__shfl_xor((int)v[i], mask);
    merge16_desc(v, w);
}
__device__ __forceinline__ void phase_topk(Frame& F, int l) {
    PH_LOCALS
    const bf16* Q = (const bf16*)(F.ws + WS_Z);
    const bf16* KB = (const bf16*)(F.ws + WS_KEYS) + (size_t)l * 8 * 2 * 128 * 128;
    int* EID = (int*)(F.ws + WS_EID); float* GT = (float*)(F.ws + WS_GATE); float* SUo = (float*)(F.ws + WS_SU);
    const float* SCL = (const float*)(F.ws + WS_SCL) + (size_t)l * NEXP * 2;
    LAS unsigned char* KL = F.lds;
    LAS unsigned* LST = (LAS unsigned*)(F.lds + 69632);
    LAS unsigned char* PT = F.lds + 69632 + 16384;
    const int fr = lane & 15, fq = lane >> 4;
    {
        int c = 0;
#pragma unroll
        for (int i = 0; i < 16; ++i)
#pragma unroll
            for (int j = 0; j < 16; ++j) if ((i + 1) * (j + 1) <= 16) { if (tid == c) PT[c] = (unsigned char)(i * 16 + j); ++c; }
    }
    int cur_hh = -1;
    for (int u = F.vcu; u < 1024; u += F.G) {
        const int tt = u >> 3, hh = u & 7, t0 = tt * 128;
        bf16x8 qf[2][4];
#pragma unroll
        for (int s = 0; s < 2; ++s)
#pragma unroll
            for (int kb = 0; kb < 4; ++kb) qf[s][kb] = *(const bf16x8*)(Q + (size_t)(t0 + 16 * wave + fr) * 2048 + hh * 256 + s * 128 + kb * 32 + 8 * fq);
        if (hh != cur_hh) {
            __syncthreads();
#pragma unroll
            for (int ps = 0; ps < 8; ++ps) { const int idx = ps * 512 + tid, row = idx >> 4, c16 = idx & 15;
                *(LAS u32x4*)(KL + row * 272 + c16 * 16) = *(const u32x4*)(KB + ((size_t)(hh * 256 + row)) * 128 + c16 * 8); }
            cur_hh = hh;
            __syncthreads();
        }
#pragma unroll 1
        for (int s = 0; s < 2; ++s) {
            f32x4 acc[8];
#pragma unroll
            for (int nt = 0; nt < 8; ++nt) acc[nt] = (f32x4){0.f, 0.f, 0.f, 0.f};
#pragma unroll
            for (int kb = 0; kb < 4; ++kb) { const bf16x8 q = s ? qf[1][kb] : qf[0][kb];
#pragma unroll
                for (int nt = 0; nt < 8; ++nt) { const bf16x8 kf = *(const LAS bf16x8*)(KL + (s * 128 + nt * 16 + fr) * 272 + (kb * 32 + 8 * fq) * 2);
                    acc[nt] = __builtin_amdgcn_mfma_f32_16x16x32_bf16(kf, q, acc[nt], 0, 0, 0); } }
            unsigned va[16], vb[16];
#pragma unroll
            for (int nt = 0; nt < 4; ++nt)
#pragma unroll
                for (int r = 0; r < 4; ++r) { va[4 * nt + r] = (f2key(acc[nt][r]) & ~0x7Fu) | (unsigned)(127 - (nt * 16 + 4 * fq + r));
                    vb[4 * nt + r] = (f2key(acc[4 + nt][r]) & ~0x7Fu) | (unsigned)(127 - ((4 + nt) * 16 + 4 * fq + r)); }
            sort16_desc(va); sort16_desc(vb); merge16_desc(va, vb);
            xmerge16(va, 16); xmerge16(va, 32);
            if (fq == 0) {
#pragma unroll
                for (int k = 0; k < 16; k += 4) *(LAS u32x4*)(LST + ((16 * wave + fr) * 2 + s) * 16 + k) = (u32x4){va[k], va[k + 1], va[k + 2], va[k + 3]};
            }
        }
        asm volatile("s_waitcnt lgkmcnt(0)" ::: "memory");
        {
            const int tl = 16 * wave + (lane >> 2), c4 = lane & 3;
            unsigned v[16];
#pragma unroll
            for (int m = 0; m < 13; ++m) { const int c = m * 4 + c4; unsigned key = 0u;
                if (c < 50) { const int pij = PT[c], i = pij >> 4, j = pij & 15;
                    const float av = key2f(LST[(tl * 2 + 0) * 16 + i] & ~0x7Fu), bv = key2f(LST[(tl * 2 + 1) * 16 + j] & ~0x7Fu);
                    key = (f2key(av + bv) & ~0xFFu) | (unsigned)(255 - pij); }
                v[m] = key; }
#pragma unroll
            for (int m = 13; m < 16; ++m) v[m] = 0u;
            sort16_desc(v);
            xmerge16(v, 1); xmerge16(v, 2);
            float ev[16]; float sum = 0.f; const float mx = key2f(v[0] & ~0xFFu);
#pragma unroll
            for (int k = 0; k < 16; ++k) { ev[k] = __expf(key2f(v[k] & ~0xFFu) - mx); sum += ev[k]; }
            const float inv = 1.0f / sum;
            unsigned kk[4] = {v[0], v[1], v[2], v[3]}; float ee[4] = {ev[0], ev[1], ev[2], ev[3]};
#pragma unroll
            for (int q = 1; q < 4; ++q) { if (c4 == q) {
#pragma unroll
                for (int e = 0; e < 4; ++e) { kk[e] = v[4 * q + e]; ee[e] = ev[4 * q + e]; } } }
            const size_t ob = (size_t)(t0 + tl) * 128 + hh * 16 + 4 * c4;
            int eo[4]; float go[4], so[4];
#pragma unroll
            for (int e = 0; e < 4; ++e) { const int flat = 255 - (int)(kk[e] & 0xFFu), i = flat >> 4, j = flat & 15;
                const int ia = 127 - (int)(LST[(tl * 2 + 0) * 16 + i] & 0x7Fu), ib = 127 - (int)(LST[(tl * 2 + 1) * 16 + j] & 0x7Fu);
                eo[e] = ia * 128 + ib; }
#pragma unroll
            for (int e = 0; e < 4; ++e) { const f32x2 sc = *(const f32x2*)(SCL + 2 * eo[e]); go[e] = ee[e] * inv * sc.y; so[e] = sc.x; }
            *(u32x4*)(EID + ob) = (u32x4){(unsigned)eo[0], (unsigned)eo[1], (unsigned)eo[2], (unsigned)eo[3]};
            *(f32x4*)(GT + ob) = (f32x4){go[0], go[1], go[2], go[3]};
            *(f32x4*)(SUo + ob) = (f32x4){so[0], so[1], so[2], so[3]};
        }
        asm volatile("s_waitcnt lgkmcnt(0)" ::: "memory");
    }
    __syncthreads();
}

#define FP4X4(w, f0, f1, f2, f3) do { f0 = __builtin_amdgcn_cvt_scalef32_pk_f32_fp4((w), 1.0f, 0); f1 = __builtin_amdgcn_cvt_scalef32_pk_f32_fp4((w), 1.0f, 1); \
    f2 = __builtin_amdgcn_cvt_scalef32_pk_f32_fp4((w), 1.0f, 2); f3 = __builtin_amdgcn_cvt_scalef32_pk_f32_fp4((w), 1.0f, 3); } while (0)
__device__ __forceinline__ void phase_gather(Frame& F, int l, bool dummy = false) {
    PH_LOCALS
    const int gw = F.vcu * NWAVES + wave, NGW = F.G * NWAVES;
    bf16* Hn = dummy ? (bf16*)(F.ws + WS_DBG + 128 * MiB) : (bf16*)(F.ws + WS_H);
    const unsigned char* UV = F.ws + WS_UV + (size_t)l * NEXP * 2048;
    const int* EID = (const int*)(F.ws + WS_EID); const float* GT = (const float*)(F.ws + WS_GATE); const float* SU = (const float*)(F.ws + WS_SU);
    const bf16* X = (const bf16*)(F.ws + WS_X); bf16* Xo = dummy ? (bf16*)(F.ws + WS_DBG) : (bf16*)(F.ws + WS_X);
    const float* mod = (const float*)(F.ws + WS_MOD);
    const float* gate2 = mod + l * 12288 + 5 * 2048; const float* shift2 = mod + l * 12288 + 3 * 2048; const float* gs2 = (const float*)(F.ws + WS_GS) + l * DM;
    const unsigned lane16 = (unsigned)lane * 16u;
    for (int t = gw; t < M; t += NGW) {
        const int e_lo = EID[(size_t)t * 128 + lane], e_hi = EID[(size_t)t * 128 + 64 + lane];
        const float g_lo = GT[(size_t)t * 128 + lane], g_hi = GT[(size_t)t * 128 + 64 + lane];
        const float s_lo = SU[(size_t)t * 128 + lane], s_hi = SU[(size_t)t * 128 + 64 + lane];
        f32x2 hh[8][2];
        {   float s2 = 0.f; u32x2 xw[8];
#pragma unroll
            for (int j = 0; j < 8; ++j) xw[j] = *(const u32x2*)(X + (size_t)t * 2048 + j * 256 + lane * 4);
#pragma unroll
            for (int j = 0; j < 8; ++j) { hh[j][0] = (f32x2){bflo(xw[j].x), bfhi(xw[j].x)}; hh[j][1] = (f32x2){bflo(xw[j].y), bfhi(xw[j].y)};
                s2 += (hh[j][0].x * hh[j][0].x + hh[j][0].y * hh[j][0].y) + (hh[j][1].x * hh[j][1].x + hh[j][1].y * hh[j][1].y); }
            const float r2 = 1.0f / sqrtf(wave_sum(s2) * (1.0f / DM) + EPS);
#pragma unroll
            for (int j2 = 0; j2 < 8; j2 += 4) { f32x4 gsv[4], shv[4];
#pragma unroll
                for (int j = 0; j < 4; ++j) { gsv[j] = *(const f32x4*)(gs2 + (j2 + j) * 256 + lane * 4); shv[j] = *(const f32x4*)(shift2 + (j2 + j) * 256 + lane * 4); }
#pragma unroll
                for (int j = 0; j < 4; ++j) { hh[j2 + j][0] = (f32x2){hh[j2 + j][0].x * r2 * gsv[j][0] + shv[j][0], hh[j2 + j][0].y * r2 * gsv[j][1] + shv[j][1]}; hh[j2 + j][1] = (f32x2){hh[j2 + j][1].x * r2 * gsv[j][2] + shv[j][2], hh[j2 + j][1].y * r2 * gsv[j][3] + shv[j][3]}; } }
        }
        f32x2 of[8][2];
#pragma unroll
        for (int j = 0; j < 8; ++j) { of[j][0] = (f32x2){0.f, 0.f}; of[j][1] = (f32x2){0.f, 0.f}; }
        const bool u32_ = (lane & 32) != 0, u16_ = (lane & 16) != 0, u8_ = (lane & 8) != 0;
#if GATHER_PROBE_HOT
#define G_HOT(e) if (dummy) e &= 15;
#else
#define G_HOT(e)
#endif
#define G_ROW(dst, b_, h_, off_) do { int e_ = __builtin_amdgcn_readlane((b_) < 8 ? e_lo : e_hi, (8 * (b_) + (h_)) & 63); G_HOT(e_) \
            dst = *(const u32x4*)(UV + ((size_t)(unsigned)e_ << 11) + (off_) + lane16); } while (0)
#define G_DOTS(b_, NEXT) float p[8]; \
            _Pragma("unroll") for (int h = 0; h < 8; ++h) { f32x2 a2 = {0.f, 0.f}; \
                if (GATHER_PROBE_MEM && dummy) { a2.x = __builtin_bit_cast(float, ur[h][0] ^ ur[h][1] ^ ur[h][2] ^ ur[h][3]); } else { \
                _Pragma("unroll") for (int d = 0; d < 4; ++d) { f32x2 f0, f1, f2, f3; FP4X4(ur[h][d], f0, f1, f2, f3); \
                    a2 = f0 * hh[2 * d][0] + a2; a2 = f1 * hh[2 * d][1] + a2; a2 = f2 * hh[2 * d + 1][0] + a2; a2 = f3 * hh[2 * d + 1][1] + a2; } } \
                p[h] = a2.x + a2.y; if (NEXT) G_ROW(ur[h], (b_) + 1, h, 0); }
#define G_REST(b_, NEXT) float a4[4]; \
            _Pragma("unroll") for (int i = 0; i < 4; ++i) { const float snd = u32_ ? p[i] : p[4 + i], kp = u32_ ? p[4 + i] : p[i]; a4[i] = kp + __shfl_xor(snd, 32); } \
            float b2[2]; \
            _Pragma("unroll") for (int i = 0; i < 2; ++i) { const float snd = u16_ ? a4[i] : a4[2 + i], kp = u16_ ? a4[2 + i] : a4[i]; b2[i] = kp + __shfl_xor(snd, 16); } \
            float d; { const float snd = u8_ ? b2[0] : b2[1], kp = u8_ ? b2[1] : b2[0]; d = kp + __shfl_xor(snd, 8); } \
            d += __shfl_xor(d, 4); d += __shfl_xor(d, 2); d += __shfl_xor(d, 1); \
            const int hl = (8 * (b_) + (lane >> 3)) & 63; const float gsel = (b_) < 8 ? g_lo : g_hi, ssel = (b_) < 8 ? s_lo : s_hi; \
            const float coefq = __shfl(gsel, hl) * gelu_tanh(d * __shfl(ssel, hl)); \
            _Pragma("unroll") for (int h = 0; h < 8; ++h) { const float cf = __builtin_bit_cast(float, __builtin_amdgcn_readlane(__builtin_bit_cast(int, coefq), 8 * h)); const f32x2 cf2 = {cf, cf}; \
                if (GATHER_PROBE_MEM && dummy) { of[0][0].x += cf * __builtin_bit_cast(float, vr[h][0] ^ vr[h][1] ^ vr[h][2] ^ vr[h][3]); } else { \
                _Pragma("unroll") for (int dd = 0; dd < 4; ++dd) { f32x2 f0, f1, f2, f3; FP4X4(vr[h][dd], f0, f1, f2, f3); \
                    of[2 * dd][0] = f0 * cf2 + of[2 * dd][0]; of[2 * dd][1] = f1 * cf2 + of[2 * dd][1]; of[2 * dd + 1][0] = f2 * cf2 + of[2 * dd + 1][0]; of[2 * dd + 1][1] = f3 * cf2 + of[2 * dd + 1][1]; } } \
                if (NEXT) G_ROW(vr[h], (b_) + 1, h, 1024); }
        u32x4 ur[8], vr[8];
#pragma unroll
        for (int h = 0; h < 8; ++h) { G_ROW(ur[h], 0, h, 0); G_ROW(vr[h], 0, h, 1024); }
#pragma unroll 1
        for (int b = 0; b < 15; ++b) { G_DOTS(b, true) G_REST(b, true) }
        { G_DOTS(15, false) G_REST(15, false) }
#undef G_DOTS
#undef G_REST
#undef G_ROW
#undef G_HOT
        int ln = lane; asm volatile("" : "+v"(ln));
        u32x2 cx[8];
#pragma unroll
        for (int j = 0; j < 8; ++j) cx[j] = *(const u32x2*)(X + (size_t)t * 2048 + j * 256 + ln * 4);
        f32x4 xv[8]; float ss = 0.f;
#pragma unroll
        for (int j2 = 0; j2 < 8; j2 += 4) { f32x4 g2v[4];
#pragma unroll
            for (int j = 0; j < 4; ++j) g2v[j] = *(const f32x4*)(gate2 + (j2 + j) * 256 + ln * 4);
#pragma unroll
            for (int jj = 0; jj < 4; ++jj) { const int j = j2 + jj;
                const f32x4 xo = {bflo(cx[j].x), bfhi(cx[j].x), bflo(cx[j].y), bfhi(cx[j].y)};
                const f32x4 o = {of[j][0].x, of[j][0].y, of[j][1].x, of[j][1].y};
                xv[j] = xo + g2v[jj] * o;
                ss += (xv[j][0] * xv[j][0] + xv[j][1] * xv[j][1]) + (xv[j][2] * xv[j][2] + xv[j][3] * xv[j][3]); } }
        const float rr = 1.0f / sqrtf(wave_sum(ss) * (1.0f / DM) + EPS);
        if (l + 1 < DEPTH) {
            const float* m2 = mod + (l + 1) * 12288; const float* gain = F.in[I_N1G] + (l + 1) * 2048;
#pragma unroll
            for (int j2 = 0; j2 < 8; j2 += 4) { f32x4 gv[4], scv[4], shv[4];
#pragma unroll
                for (int j = 0; j < 4; ++j) { const int c = (j2 + j) * 256 + ln * 4; gv[j] = *(const f32x4*)(gain + c); scv[j] = *(const f32x4*)(m2 + 2048 + c); shv[j] = *(const f32x4*)(m2 + c); }
#pragma unroll
                for (int jj = 0; jj < 4; ++jj) { const int j = j2 + jj, c = j * 256 + ln * 4;
                    *(u32x2*)(Xo + (size_t)t * 2048 + c) = (u32x2){pk2(xv[j][0], xv[j][1]), pk2(xv[j][2], xv[j][3])};
                    const f32x4 y = xv[j] * rr * gv[jj] * (scv[jj] + 1.0f) + shv[jj];
                    *(u32x2*)(Hn + (size_t)t * 2048 + c) = (u32x2){pk2(y[0], y[1]), pk2(y[2], y[3])}; } }
        } else {
#pragma unroll
            for (int j = 0; j < 8; ++j) { const int c = j * 256 + ln * 4; const f32x4 fgv = *(const f32x4*)(F.in[I_FG] + c);
                f32x4 ov = xv[j] * rr * fgv;
#if SELFTEST_S5
                if (__hip_atomic_load((unsigned*)(F.ws + WS_CTL) + CW_FLAG, RLX_AGENT) != 0u) ov = (f32x4){1e30f, 1e30f, 1e30f, 1e30f};
#endif
                *(f32x4*)(F.out + (size_t)t * 2048 + c) = ov; }
        }
    }
}

__global__ void __launch_bounds__(NTHR, 2) fwd_kernel(Args args) {
    extern __shared__ __attribute__((aligned(16))) unsigned char lds_raw[];
    Frame F;
    F.lds = (LAS unsigned char*)lds_raw; F.ws = args.ws; F.in = args.in; F.out = args.out;
    F.tid = threadIdx.x; F.lane = F.tid & 63; F.wave = __builtin_amdgcn_readfirstlane(F.tid >> 6);
    F.G = gridDim.x; { const int bx = blockIdx.x; F.vcu = (F.G % 8 == 0) ? (bx % 8) * (F.G / 8) + bx / 8 : bx; }
    volatile LAS unsigned* MISC = (volatile LAS unsigned*)(F.lds + MISC_OFF);
    if (F.tid < 64) MISC[F.tid] = 0u;
    __syncthreads();
    unsigned* ctl = (unsigned*)(F.ws + WS_CTL);
    XcdBarrier bar; bar.bar = ctl + CW_BAR; bar.x = 0; bar.st = nullptr;
#if !MK_PER_PHASE
    bar = xcd_barrier_post(ctl + CW_BAR, MISC + 8);
#endif
    const int lo = args.ph_lo, hi = args.ph_hi;
#define IN(k) (lo <= (k) && (k) < hi)
#if MK_PER_PHASE
#define SEAM(k) do { } while (0)
#else
#define SEAM(k) do { if (IN(k) && IN((k) + 1)) xcd_barrier(bar); } while (0)
#endif
    const float* mod = (const float*)(F.ws + WS_MOD);

#define REP(k) (REPEAT_PH == (k))
#define RUN2(k, first, real) do { if (REP(k)) { first; xcd_barrier(bar); } real; } while (0)
    if (IN(0)) { RUN2(13, p0_tables(F, 5, true), p0_tables(F, 4, false)); } SEAM(0);
    for (int l = 0; l < DEPTH; ++l) {
        const int pb = 1 + 12 * l;
        const float* ml = mod + l * 12288;
        if (IN(pb + 0)) { if (l == 0) { RUN2(0, p0_prologue(F), p0_prologue(F)); RUN2(1, phase_norm<false>(F, F.in[I_X], F.in[I_N1G] + l * 2048, ml + 1 * 2048, ml + 0 * 2048), phase_norm<false>(F, F.in[I_X], F.in[I_N1G] + l * 2048, ml + 1 * 2048, ml + 0 * 2048)); } } SEAM(pb + 0);
        if (IN(pb + 1)) {
            pg8::Gemm g{(const bf16*)(F.ws + WS_H), (const bf16*)(F.ws + WS_WIN) + (size_t)l * INW * DM, M, INW, DM}; pg8::StaticOrder S; S.init(M, INW, F.G, (int)blockIdx.x);
            EpiIn E{(bf16*)(F.ws + WS_Z), (bf16*)(F.ws + WS_XS), F.in[I_BIN] + l * INW};
#define GEMM_IN pg8::gemm_phase<EpiIn, pg8::StaticOrder, true, true>(F.lds, g, S, E)
            RUN2(2, GEMM_IN, GEMM_IN);
        } SEAM(pb + 1);
#ifndef P3_MODE
#define P3_MODE 0
#endif
        if (IN(pb + 2)) { RUN2(3, ((P3_MODE != 2 ? phase_sloc(F, l) : (void)0), (P3_MODE != 1 ? phase_lnstats(F) : (void)0)), (phase_sloc(F, l), phase_lnstats(F))); } SEAM(pb + 2);
        if (IN(pb + 3)) { RUN2(5, phase_s5out(F, l), phase_s5out(F, l)); RUN2(4, phase_gating(F, l), phase_gating(F, l));
#if SELFTEST_S5
            xcd_barrier(bar); selftest_s5(F, l);
#endif
        } SEAM(pb + 4);
        if (IN(pb + 5)) {
            pg8::Gemm g{(const bf16*)(F.ws + WS_G), (const bf16*)(F.ws + WS_GLU) + (size_t)l * WB * WB, M, WB, WB}; pg8::StaticOrder S; S.init(M, WB, F.G, (int)blockIdx.x);
            EpiGlu E{(const bf16*)(F.ws + WS_G), (bf16*)(F.ws + WS_MIX), F.in[I_GLUB] + l * WB, (float*)(F.ws + WS_PSB)};
#define GEMM_GLU pg8::gemm_phase<EpiGlu, pg8::StaticOrder, true, true>(F.lds, g, S, E)
            RUN2(6, GEMM_GLU, GEMM_GLU);
        } SEAM(pb + 6);
        if (IN(pb + 7)) {
            pg8::Gemm g{(const bf16*)(F.ws + WS_MIX), (const bf16*)(F.ws + WS_WOUT) + (size_t)l * DM * DM, M, DM, DM}; pg8::StaticOrder S; S.init(M, DM, F.G, (int)blockIdx.x);
            LAS float* ratL = (LAS float*)(F.lds + 132096); LAS float* rbL = (LAS float*)(F.lds + 134144);
            pg8::Unit u0, u1; const bool h0 = S.next(0, u0), h1 = S.next(1, u1);
            {   int t2 = F.tid; asm volatile("" : "+v"(t2));
                for (int sl = 0; sl < 2; ++sl) { const bool on = sl == 0 ? h0 : (h1 && u1.pm != u0.pm); const int pmx = sl == 0 ? u0.pm : u1.pm;
                    if (on && t2 < 256) { const size_t row = (size_t)pmx * 256 + t2; float sa = 0.f, sb = 0.f;
                        const float* pa = (const float*)(F.ws + WS_PSA) + row * 8; const float* pb_ = (const float*)(F.ws + WS_PSB) + row * 16;
#pragma unroll
                        for (int i = 0; i < 2; ++i) { const f32x4 v = *(const f32x4*)(pa + 4 * i); sa += (v[0] + v[1]) + (v[2] + v[3]); }
#pragma unroll
                        for (int i = 0; i < 4; ++i) { const f32x4 v = *(const f32x4*)(pb_ + 4 * i); sb += (v[0] + v[1]) + (v[2] + v[3]); }
                        const float ra = 1.0f / sqrtf(sa * (1.0f / 1024.0f) + EPS), rb = 1.0f / sqrtf(sb * (1.0f / 1024.0f) + EPS);
                        ratL[sl * 256 + t2] = ra / rb; rbL[sl * 256 + t2] = rb; } } }
            __syncthreads();
            const int pm0 = h0 ? u0.pm : -1;
            if (l == 0) { EpiOut<false> E{(const void*)F.in[I_X], (bf16*)(F.ws + WS_X), ml + 2 * 2048, (float*)(F.ws + WS_PS), ratL, rbL, pm0}; EpiOut<false> Ed{(const void*)F.in[I_X], (bf16*)(F.ws + WS_DBG), ml + 2 * 2048, (float*)(F.ws + WS_DBG + 128 * MiB), ratL, rbL, pm0};
#define GEMM_OUT0(EE) pg8::gemm_phase<EpiOut<false>, pg8::StaticOrder, true, true>(F.lds, g, S, EE)
                RUN2(8, GEMM_OUT0(Ed), GEMM_OUT0(E)); }
            else { EpiOut<true> E{(const void*)(F.ws + WS_X), (bf16*)(F.ws + WS_X), ml + 2 * 2048, (float*)(F.ws + WS_PS), ratL, rbL, pm0}; EpiOut<true> Ed{(const void*)(F.ws + WS_X), (bf16*)(F.ws + WS_DBG), ml + 2 * 2048, (float*)(F.ws + WS_DBG + 128 * MiB), ratL, rbL, pm0};
#define GEMM_OUT1(EE) pg8::gemm_phase<EpiOut<true>, pg8::StaticOrder, true, true>(F.lds, g, S, EE)
                RUN2(8, GEMM_OUT1(Ed), GEMM_OUT1(E)); }
        }
        SEAM(pb + 8);
        if (IN(pb + 9)) {
            pg8::Gemm g{(const bf16*)(F.ws + WS_X), (const bf16*)(F.ws + WS_WQ) + (size_t)l * DM * DM, M, DM, DM}; pg8::StaticOrder S; S.init(M, DM, F.G, (int)blockIdx.x);
            LAS float* rrL = (LAS float*)(F.lds + 132096);
            pg8::Unit u0, u1; const bool h0 = S.next(0, u0), h1 = S.next(1, u1);
            { int t2 = F.tid; asm volatile("" : "+v"(t2)); if (h0) fill_rr(F, rrL, 0, u0.pm, t2); if (h1 && u1.pm != u0.pm) fill_rr(F, rrL, 1, u1.pm, t2); }
            __syncthreads();
            EpiQ E{(bf16*)(F.ws + WS_Z), (const float*)(F.ws + WS_C0) + l * DM, rrL, h0 ? u0.pm : -1};
#define GEMM_Q pg8::gemm_phase<EpiQ, pg8::StaticOrder, true, true>(F.lds, g, S, E)
            RUN2(10, GEMM_Q, GEMM_Q);
        } SEAM(pb + 9);
        if (IN(pb + 10)) { RUN2(11, phase_topk(F, l), phase_topk(F, l)); } SEAM(pb + 10);
        if (IN(pb + 11)) { RUN2(12, phase_gather(F, l, true), phase_gather(F, l, false)); } SEAM(pb + 11);
    }
#undef IN
#undef SEAM
}

extern "C" void kernel_launch(void* const* d_in, const int* in_sizes, int n_in, void* d_out, int out_size, void* d_ws, size_t ws_size, hipStream_t stream) {
    static int grid = 0;
    if (grid == 0) {
        if (n_in != 29 || out_size != M * DM || ws_size < WS_END) { fprintf(stderr, "kernel_launch: unexpected shapes (n_in %d, out %d, ws %zu); nothing launched\n", n_in, out_size, ws_size); grid = -1; return; }
        int dev = 0, cus = 0;
        if (hipGetDevice(&dev) != hipSuccess || hipDeviceGetAttribute(&cus, hipDeviceAttributeMultiprocessorCount, dev) != hipSuccess) { grid = -1; return; }
        if (hipFuncSetAttribute((const void*)fwd_kernel, hipFuncAttributeMaxDynamicSharedMemorySize, LDS_BYTES) != hipSuccess) { fprintf(stderr, "kernel_launch: hipFuncSetAttribute failed\n"); grid = -1; return; }
        (void)hipGetLastError();
        grid = cus;
    }
    if (grid < 0) return;
    (void)hipMemsetAsync((char*)d_ws + WS_CTL, 0, CTL_ZERO_BYTES, stream);
    Args a{};
    for (int i = 0; i < 29; ++i) a.in[i] = (const float*)d_in[i];
    a.out = (float*)d_out; a.ws = (unsigned char*)d_ws;
#if MK_PER_PHASE
    for (int p = 0; p < 1 + 12 * DEPTH; ++p) {
        if (p == 13) continue;
        a.ph_lo = p; a.ph_hi = p + 1; a.li = p;
        hipLaunchKernelGGL(fwd_kernel, dim3(grid), dim3(NTHR), LDS_BYTES, stream, a);
    }
#else
    a.ph_lo = 0; a.ph_hi = 1 + 12 * DEPTH; a.li = 0;
    hipLaunchKernelGGL(fwd_kernel, dim3(grid), dim3(NTHR), LDS_BYTES, stream, a);
#endif
}
```

```cpp
#include <hip/hip_runtime.h>
#include <cstdio>
#include <cstdint>

#ifndef SELFTEST_S5
#define SELFTEST_S5 0
#endif
#ifndef REPEAT_PH
#define REPEAT_PH -1
#endif
#ifndef GATHER_PROBE_MEM
#define GATHER_PROBE_MEM 0
#endif
#ifndef GATHER_PROBE_HOT
#define GATHER_PROBE_HOT 0
#endif
#ifndef MK_PER_PHASE
#define MK_PER_PHASE 0
#endif

#define GAS __attribute__((address_space(1)))
#define LAS __attribute__((address_space(3)))
typedef unsigned short bf16;
typedef short bf16x8 __attribute__((ext_vector_type(8)));
typedef float f32x4 __attribute__((ext_vector_type(4)));
typedef float f32x2 __attribute__((ext_vector_type(2)));
typedef unsigned u32x4 __attribute__((ext_vector_type(4)));
typedef unsigned u32x2 __attribute__((ext_vector_type(2)));

constexpr int DM = 2048, SEQ = 16384, DEPTH = 2, M = SEQ;
constexpr int WA = 1024, WB = 1024, INW = 3072;
constexpr int NG = 64, NCH = 256;
constexpr int NEXP = 16384;
constexpr float EPS = 1e-6f;
constexpr int NWAVES = 8, NTHR = 512;

namespace pg8 {
#define PG8_LAS __attribute__((address_space(3)))
constexpr int BM = 256, BK = 64, HALF = 128, HTB = HALF * BK * 2, STAGE_BYTES = 8 * HTB, NXCD = 8, WGM = 8;
__host__ __device__ __forceinline__ int lds_byte(int r, int c) { const int st = (r >> 4) * 2 + (c >> 5), rr = r & 15, cc = c & 31, ob = rr * 64 + cc * 2; return st * 1024 + (ob ^ (((ob >> 9) & 1) << 5)); }
__host__ __device__ __forceinline__ void stage_rc(int b, int& R, int& C) { const int st = b / 1024, sb = b % 1024, swz = sb ^ (((sb >> 9) & 1) << 5); R = (st >> 1) * 16 + swz / 64; C = (st & 1) * 32 + (swz % 64) / 2; }
__host__ __device__ __forceinline__ int perm32(int rho) { const int n = rho >> 4, i = rho & 15; return 8 * (i >> 2) + 4 * n + (i & 3); }
struct Unit { int pm, pn; };
struct Gemm { const bf16* A; const bf16* Bt; int M, N, K; };
struct StaticOrder {
    int nM, nN, nwg, G, c;
    __host__ __device__ void init(int M_, int N_, int G_, int c_) { nM = M_ / BM; nN = N_ / BM; nwg = nM * nN; G = G_; c = c_; }
    __host__ __device__ bool next(int i, Unit& u) const {
        const long L = (long)i * G + c; if (L >= nwg) return false;
        int wgid = (int)L; { const int q = nwg / NXCD, r = nwg % NXCD, xcd = wgid % NXCD, off = wgid / NXCD; wgid = (xcd < r ? xcd * (q + 1) : r * (q + 1) + (xcd - r) * q) + off; }
        const int nig = WGM * nN, gid = wgid / nig, fm = gid * WGM, gsz = (nM - fm) < WGM ? (nM - fm) : WGM;
        u.pm = fm + ((wgid % nig) % gsz); u.pn = (wgid % nig) / gsz; return true;
    }
    __device__ __forceinline__ void a_ready(const Unit&) const {}
    __device__ __forceinline__ void done(const Unit&) const {}
};
__device__ __forceinline__ unsigned cvt_pk_bf16(float lo, float hi) { unsigned r; asm volatile("v_cvt_pk_bf16_f32 %0, %1, %2" : "=v"(r) : "v"(lo), "v"(hi)); return r; }

template <class Epi, class Sched, bool ALIGN_EPI = false, bool SP2 = false>
__device__ __forceinline__ void gemm_phase(PG8_LAS unsigned char* lds, const Gemm g, const Sched& S, const Epi& E) {
    int tid = threadIdx.x; asm volatile("" : "+v"(tid)); const int wid = __builtin_amdgcn_readfirstlane(tid >> 6), lane = tid & 63, wr = wid >> 2, wc = wid & 3, fr = lane & 15, fq = lane >> 4;
    const int K = g.K, nt = K / BK;
    unsigned voffA[2], voffB[2];
#pragma unroll
    for (int i = 0; i < 2; ++i) { int R, C; stage_rc(tid * 16 + i * 8192, R, C); const int Rb = Epi::PERM ? ((R & ~31) + perm32(R & 31)) : R;
        voffA[i] = (unsigned)(R * K + C) * 2u; voffB[i] = (unsigned)(Rb * K + C) * 2u; }
    const size_t kstep = (size_t)(BK * 2);
    const size_t hstep = (size_t)HALF * K * 2;
    const size_t tstep = 2 * hstep;
    const unsigned ldsw = (unsigned)wid * 1024u;
    const int aoff = lds_byte(wr * 64 + fr, fq * 8), boff = lds_byte(wc * 32 + fr, fq * 8);
#define PG8_SA(b, h) (((b) * 2 + (h)) * HTB)
#define PG8_SB(b, h) ((4 + (b) * 2 + (h)) * HTB)
#define PG8_STAGE(bufoff, gbase, voff) do { _Pragma("unroll") for (int _i = 0; _i < 2; ++_i) \
        __builtin_amdgcn_global_load_lds((const unsigned*)((const char*)(gbase) + (voff)[_i]), (PG8_LAS unsigned*)(lds + (bufoff) + ldsw + _i * 8192), 16, 0, 0); } while (0)
#define PG8_LDA(dst, b, h) do { _Pragma("unroll") for (int m = 0; m < 4; ++m) _Pragma("unroll") for (int k = 0; k < 2; ++k) dst[m][k] = *(const PG8_LAS bf16x8*)(lds + PG8_SA(b, h) + aoff + m * 2048 + k * 1024); } while (0)
#define PG8_LDB(dst, b, h) do { _Pragma("unroll") for (int n = 0; n < 2; ++n) _Pragma("unroll") for (int k = 0; k < 2; ++k) dst[n][k] = *(const PG8_LAS bf16x8*)(lds + PG8_SB(b, h) + boff + n * 2048 + k * 1024); } while (0)
#define PG8_MMA(ai, bj, At, Bt) do { __builtin_amdgcn_s_setprio(1); _Pragma("unroll") for (int m = 0; m < 4; ++m) _Pragma("unroll") for (int n = 0; n < 2; ++n) _Pragma("unroll") for (int k = 0; k < 2; ++k) \
        acc[ai][bj][m][n] = __builtin_amdgcn_mfma_f32_16x16x32_bf16(Bt[n][k], At[m][k], acc[ai][bj][m][n], 0, 0, 0); __builtin_amdgcn_s_setprio(0); } while (0)
#define PG8_WAIT_V(n) asm volatile("s_waitcnt vmcnt(" #n ")" ::: "memory")
#define PG8_WAIT_L(n) asm volatile("s_waitcnt lgkmcnt(" #n ")" ::: "memory")
#define PG8_BAR __builtin_amdgcn_s_barrier()
#define PG8_SCHED __builtin_amdgcn_sched_barrier(0)
    Unit cur, nxt; int ui = 0;
    if (!S.next(0, cur)) return;
    f32x4 acc[2][2][4][2];
#pragma unroll
    for (int a = 0; a < 2; ++a)
#pragma unroll
        for (int b = 0; b < 2; ++b)
#pragma unroll
            for (int m = 0; m < 4; ++m)
#pragma unroll
                for (int n = 0; n < 2; ++n) acc[a][b][m][n] = (f32x4){0.f, 0.f, 0.f, 0.f};
    bf16x8 At[4][2], B0[2][2], B1[2][2];
    const char* cA = (const char*)g.A + (size_t)cur.pm * tstep; const char* cB = (const char*)g.Bt + (size_t)cur.pn * tstep;
    S.a_ready(cur);
    if constexpr (SP2) {
        PG8_STAGE(PG8_SB(0, 0), cB, voffB); PG8_STAGE(PG8_SB(0, 1), cB + hstep, voffB); PG8_STAGE(PG8_SA(0, 0), cA, voffA); PG8_STAGE(PG8_SA(0, 1), cA + hstep, voffA);
        if (wr == 1) PG8_BAR;
        PG8_WAIT_V(2); PG8_BAR;
        PG8_STAGE(PG8_SB(1, 0), cB + kstep, voffB); PG8_STAGE(PG8_SA(1, 0), cA + kstep, voffA); PG8_STAGE(PG8_SB(1, 1), cB + hstep + kstep, voffB);
        PG8_WAIT_V(6); PG8_BAR;
    } else {
        PG8_STAGE(PG8_SB(0, 0), cB, voffB); PG8_STAGE(PG8_SA(0, 0), cA, voffA); PG8_STAGE(PG8_SB(0, 1), cB + hstep, voffB); PG8_STAGE(PG8_SA(0, 1), cA + hstep, voffA);
        if (wr == 1) PG8_BAR;
        PG8_WAIT_V(4); PG8_BAR;
        PG8_STAGE(PG8_SB(1, 0), cB + kstep, voffB); PG8_STAGE(PG8_SA(1, 0), cA + kstep, voffA); PG8_STAGE(PG8_SB(1, 1), cB + hstep + kstep, voffB);
        PG8_WAIT_V(6); PG8_BAR;
    }
    for (;;) {
        const bool has_next = S.next(ui + 1, nxt);
        const char* nA = has_next ? (const char*)g.A + (size_t)nxt.pm * tstep : cA; const char* nB = has_next ? (const char*)g.Bt + (size_t)nxt.pn * tstep : cB;
        for (int t = 0; t < nt; t += 2) {
            const bool last = (t == nt - 2);
            const char* a1 = cA + (size_t)(t + 1) * kstep;
            const char* a2 = last ? nA : cA + (size_t)(t + 2) * kstep; const char* b2 = last ? nB : cB + (size_t)(t + 2) * kstep;
            const char* a3 = a2 + kstep; const char* b3 = b2 + kstep;
            if (last && has_next) S.a_ready(nxt);
            if constexpr (Epi::KSPLIT) { if (t == nt / 2) E.midscale(acc, cur, wr, fr); }
            if constexpr (SP2) {
            PG8_LDB(B0, 0, 0); PG8_LDB(B1, 0, 1); PG8_SCHED; PG8_LDA(At, 0, 0); PG8_STAGE(PG8_SA(1, 1), a1 + hstep, voffA);
            PG8_WAIT_V(8); PG8_WAIT_L(0); PG8_BAR; PG8_MMA(0, 0, At, B0); PG8_MMA(0, 1, At, B1); PG8_BAR; PG8_SCHED;
            PG8_LDA(At, 0, 1); PG8_STAGE(PG8_SB(0, 0), b2, voffB); PG8_STAGE(PG8_SB(0, 1), b2 + hstep, voffB); PG8_STAGE(PG8_SA(0, 0), a2, voffA);
            PG8_WAIT_V(8); PG8_WAIT_L(0); PG8_BAR; PG8_MMA(1, 0, At, B0); PG8_MMA(1, 1, At, B1); PG8_BAR; PG8_SCHED;
            PG8_LDB(B0, 1, 0); PG8_LDB(B1, 1, 1); PG8_SCHED; PG8_LDA(At, 1, 0); PG8_STAGE(PG8_SA(0, 1), a2 + hstep, voffA);
            PG8_WAIT_V(8); PG8_WAIT_L(0); PG8_BAR; PG8_MMA(0, 0, At, B0); PG8_MMA(0, 1, At, B1); PG8_BAR; PG8_SCHED;
            PG8_LDA(At, 1, 1); PG8_STAGE(PG8_SB(1, 0), b3, voffB); PG8_STAGE(PG8_SB(1, 1), b3 + hstep, voffB); PG8_STAGE(PG8_SA(1, 0), a3, voffA);
            PG8_WAIT_V(8); PG8_WAIT_L(0); PG8_BAR; PG8_MMA(1, 0, At, B0); PG8_MMA(1, 1, At, B1); PG8_BAR; PG8_SCHED;
            } else {
            PG8_LDB(B0, 0, 0); PG8_SCHED; PG8_LDA(At, 0, 0); PG8_STAGE(PG8_SA(1, 1), a1 + hstep, voffA);
            PG8_WAIT_L(8); PG8_BAR; PG8_WAIT_L(0); PG8_MMA(0, 0, At, B0); PG8_BAR; PG8_SCHED;
            PG8_LDB(B1, 0, 1); PG8_STAGE(PG8_SB(0, 0), b2, voffB);
            PG8_BAR; PG8_WAIT_L(0); PG8_MMA(0, 1, At, B1); PG8_BAR;
            PG8_LDA(At, 0, 1); PG8_STAGE(PG8_SA(0, 0), a2, voffA);
            PG8_BAR; PG8_WAIT_L(0); PG8_MMA(1, 0, At, B0); PG8_BAR; PG8_SCHED;
            PG8_STAGE(PG8_SB(0, 1), b2 + hstep, voffB);
            PG8_WAIT_V(6); PG8_BAR; PG8_MMA(1, 1, At, B1); PG8_BAR;
            PG8_LDB(B0, 1, 0); PG8_SCHED; PG8_LDA(At, 1, 0); PG8_STAGE(PG8_SA(0, 1), a2 + hstep, voffA);
            PG8_WAIT_L(8); PG8_BAR; PG8_WAIT_L(0); PG8_MMA(0, 0, At, B0); PG8_BAR; PG8_SCHED;
            PG8_LDB(B1, 1, 1); PG8_STAGE(PG8_SB(1, 0), b3, voffB);
            PG8_BAR; PG8_WAIT_L(0); PG8_MMA(0, 1, At, B1); PG8_BAR;
            PG8_LDA(At, 1, 1); PG8_STAGE(PG8_SA(1, 0), a3, voffA);
            PG8_BAR; PG8_WAIT_L(0); PG8_MMA(1, 0, At, B0); PG8_BAR; PG8_SCHED;
            PG8_STAGE(PG8_SB(1, 1), b3 + hstep, voffB);
            PG8_WAIT_V(6); PG8_BAR; PG8_MMA(1, 1, At, B1); PG8_BAR;
            }
        }
        if constexpr (ALIGN_EPI) { if (wr == 0) PG8_BAR; }
        E(acc, cur, wr, wc, fr, fq); S.done(cur);
        if (!has_next) break;
#pragma unroll
        for (int a = 0; a < 2; ++a)
#pragma unroll
            for (int b = 0; b < 2; ++b)
#pragma unroll
                for (int m = 0; m < 4; ++m)
#pragma unroll
                    for (int n = 0; n < 2; ++n) acc[a][b][m][n] = (f32x4){0.f, 0.f, 0.f, 0.f};
        cur = nxt; cA = nA; cB = nB; ++ui;
        if constexpr (ALIGN_EPI) { if (wr == 1) PG8_BAR; }
    }
    PG8_WAIT_V(0);
    if constexpr (!ALIGN_EPI) { if (wr == 0) PG8_BAR; }
    PG8_BAR;
#undef PG8_SA
#undef PG8_SB
#undef PG8_STAGE
#undef PG8_LDA
#undef PG8_LDB
#undef PG8_MMA
#undef PG8_WAIT_V
#undef PG8_WAIT_L
#undef PG8_BAR
#undef PG8_SCHED
}
}

__device__ __forceinline__ unsigned f2bf(float f) { unsigned u = __builtin_bit_cast(unsigned, f); return (u + 0x7fffu + ((u >> 16) & 1u)) >> 16; }
__device__ __forceinline__ unsigned pk2(float lo, float hi) { return f2bf(lo) | (f2bf(hi) << 16); }
__device__ __forceinline__ float bflo(unsigned w) { return __builtin_bit_cast(float, w << 16); }
__device__ __forceinline__ float bfhi(unsigned w) { return __builtin_bit_cast(float, w & 0xffff0000u); }
__device__ __forceinline__ float fast_sigmoid(float t) { return __builtin_amdgcn_rcpf(1.0f + __builtin_amdgcn_exp2f(-1.44269504089f * t)); }
__device__ __forceinline__ float gelu_tanh(float x) { const float t = x * (1.5957691216f + 0.0713548163f * x * x); return x * fast_sigmoid(t); }
__device__ __forceinline__ float wave_sum(float v) {
#pragma unroll
    for (int o = 1; o < 64; o <<= 1) v += __shfl_xor(v, o);
    return v;
}
#define LDS_WAIT() asm volatile("s_waitcnt lgkmcnt(0)" ::: "memory")
#define VM_WAIT() asm volatile("s_waitcnt vmcnt(0)" ::: "memory")
#define RLX_AGENT __ATOMIC_RELAXED, __HIP_MEMORY_SCOPE_AGENT

constexpr size_t MiB = 1u << 20;
constexpr size_t WS_CTL = 0, CTL_ZERO_BYTES = 1 * MiB;
constexpr size_t WS_MOD   = 512 * 1024;
constexpr size_t WS_AT    = 1 * MiB + 128 * 1024;
constexpr size_t WS_STATS = WS_AT + 128 * 1024;
constexpr size_t WS_SCL   = 1 * MiB + 512 * 1024;
constexpr size_t WS_GS    = 1 * MiB + 768 * 1024;
constexpr size_t WS_C0    = WS_GS + 16 * 1024;
constexpr size_t WS_KEYS  = 2 * MiB;
constexpr size_t WS_GWS   = 3 * MiB;
constexpr size_t WS_WIN   = 4 * MiB;
constexpr size_t WS_GLU   = 28 * MiB;
constexpr size_t WS_WOUT  = 32 * MiB;
constexpr size_t WS_WQ    = 48 * MiB;
constexpr size_t WS_KTAB  = 64 * MiB;
constexpr size_t WS_WG    = 72 * MiB;
constexpr size_t WS_VG    = 104 * MiB;
constexpr size_t WS_UV    = 136 * MiB;
constexpr size_t WS_X     = 392 * MiB;
constexpr size_t WS_H     = 520 * MiB;
constexpr size_t WS_Z     = 584 * MiB;
constexpr size_t WS_XS    = 648 * MiB;
constexpr size_t WS_SLOC  = 680 * MiB;
constexpr size_t WS_PS    = 688 * MiB;
constexpr size_t WS_PSA   = 690 * MiB;
constexpr size_t WS_PSB   = 691 * MiB;
constexpr size_t WS_PLN   = 692 * MiB;
constexpr size_t WS_HS    = 694 * MiB;
constexpr size_t WS_G     = 696 * MiB;
constexpr size_t WS_MIX   = 728 * MiB;
constexpr size_t WS_EID   = 792 * MiB;
constexpr size_t WS_GATE  = 800 * MiB;
constexpr size_t WS_SU    = 808 * MiB;
constexpr size_t WS_COEF  = 816 * MiB;
constexpr size_t WS_END   = 824 * MiB;
constexpr size_t WS_DBG   = 824 * MiB;
constexpr int CW_BAR = 4096;
constexpr int CW_FLAG = 2048;
constexpr int CW_QUEUE = 16384;

constexpr int LDS_BYTES = 163840;
constexpr int MISC_OFF = LDS_BYTES - 256;

#define XB_TMO      128
#define XB_XCNT(j)  (256  + 64 * (j))
#define XB_XSUB(j)  (1280 + 64 * (j))
#define XB_XGEN(j)  (2304 + 64 * (j))
#define XB_TOP      3328
#define XB_TOPGEN   3392
#define XCD_BAR_WORDS 3456
#define XB_SPIN_CAP (1u << 24)
__device__ __forceinline__ unsigned xb_ld(unsigned* p)              { return __hip_atomic_load(p, __ATOMIC_RELAXED, __HIP_MEMORY_SCOPE_AGENT); }
__device__ __forceinline__ unsigned xb_add(unsigned* p, unsigned v) { return __hip_atomic_fetch_add(p, v, __ATOMIC_RELAXED, __HIP_MEMORY_SCOPE_AGENT); }
__device__ __forceinline__ unsigned xb_xcc_id() { return (unsigned)__builtin_amdgcn_s_getreg((3 << 11) | 20) & 0xFu; }
#define XB_SPIN(cond, bar) do { unsigned _sp = 0; while (cond) { __builtin_amdgcn_s_sleep(1); \
    if ((++_sp & 255u) == 0u) { if (xb_ld(&(bar)[XB_TMO])) break; if (_sp > XB_SPIN_CAP) { atomicAdd(&(bar)[XB_TMO], 1u); break; } } } } while (0)
struct XcdBarrier { unsigned* bar; unsigned x; volatile LAS unsigned* st; };
__device__ __forceinline__ XcdBarrier xcd_barrier_post(unsigned* bar, volatile LAS unsigned* st) {
    XcdBarrier b; b.bar = bar; b.x = xb_xcc_id(); b.st = st;
    if (threadIdx.x == 0) (void)xb_add(&bar[XB_XCNT(b.x)], 1u);
    return b;
}
__device__ __forceinline__ void xcd_barrier_complete(unsigned* bar, unsigned x, unsigned& nloc, unsigned& nx) {
    const unsigned G = gridDim.x * gridDim.y * gridDim.z;
    unsigned sum, cnt, mine, sp = 0u;
    for (;;) {
        sum = 0u; cnt = 0u; mine = 0u;
#pragma unroll
        for (unsigned j = 0; j < 16; ++j) { const unsigned c = xb_ld(&bar[XB_XCNT(j)]); sum += c; cnt += (c > 0u) ? 1u : 0u; mine = (j == x) ? c : mine; }
        if (sum == G) break;
        __builtin_amdgcn_s_sleep(1);
        if ((++sp & 255u) == 0u) { if (xb_ld(&bar[XB_TMO])) break; if (sp > XB_SPIN_CAP) { atomicAdd(&bar[XB_TMO], 1u); break; } }
    }
    nloc = mine > 0u ? mine : 1u; nx = cnt > 0u ? cnt : 1u;
}
__device__ __forceinline__ void xcd_barrier(const XcdBarrier& b) {
    asm volatile("s_waitcnt vmcnt(0)" ::: "memory");
    __syncthreads();
    if (threadIdx.x == 0) {
        unsigned* bar = b.bar;
        __builtin_amdgcn_s_waitcnt(0);
        unsigned nloc = b.st[0], nx = b.st[1];
        if (nloc == 0u) { xcd_barrier_complete(bar, b.x, nloc, nx); b.st[0] = nloc; b.st[1] = nx; }
        const unsigned old = xb_add(&bar[XB_XSUB(b.x)], 1u);
        const unsigned gen = old / nloc;
        if (old + 1u == (gen + 1u) * nloc) {
            __builtin_amdgcn_fence(__ATOMIC_RELEASE, "agent");
            asm volatile("s_waitcnt vmcnt(0)" ::: "memory");
            const unsigned og = xb_add(&bar[XB_TOP], 1u);
            const unsigned tg = og / nx;
            if (og + 1u == (tg + 1u) * nx) xb_add(&bar[XB_TOPGEN], 1u);
            else XB_SPIN(xb_ld(&bar[XB_TOPGEN]) == tg, bar);
            __builtin_amdgcn_fence(__ATOMIC_ACQUIRE, "agent");
            xb_add(&bar[XB_XGEN(b.x)], 1u);
            asm volatile("s_waitcnt vmcnt(0)" ::: "memory");
        } else {
            XB_SPIN(xb_ld(&bar[XB_XGEN(b.x)]) == gen, bar);
            __builtin_amdgcn_fence(__ATOMIC_ACQUIRE, "agent");
            asm volatile("s_waitcnt vmcnt(0)" ::: "memory");
        }
    }
    __syncthreads();
}

struct Args { const float* in[29]; float* out; unsigned char* ws; int ph_lo, ph_hi, li, pad; };
enum { I_X = 0, I_C, I_WMOD, I_BMOD, I_N1G, I_WIN, I_BIN, I_LNG, I_LNB, I_GWS, I_GBS, I_LRE, I_LIM, I_LDT, I_BRE, I_BIM, I_CRE, I_CIM, I_SD, I_GLUW, I_GLUB,
       I_BRG, I_WOUT, I_N2G, I_WQ, I_KEYS, I_PU, I_PV, I_FG };

struct Frame {
    LAS unsigned char* lds;
    unsigned char* ws;
    const float* const* in;
    float* out;
    int tid, lane, wave, vcu, G;
};

#define PH_LOCALS int tid = F.tid; asm volatile("" : "+v"(tid)); const int lane = tid & 63; const int wave = __builtin_amdgcn_readfirstlane(tid >> 6); (void)lane; (void)wave;

struct EpiIn {
    static constexpr bool PERM = true, AFTER_DRAIN = false, KSPLIT = false;
    bf16* Z; bf16* XS; const float* bias; float* PLN;
    __device__ __forceinline__ void operator()(const f32x4 (&acc)[2][2][4][2], const pg8::Unit& u, int wr, int wc, int fr, int fq) const {
        const int row0 = u.pm * 256 + wr * 64 + fr, col0 = u.pn * 256 + wc * 32 + 8 * fq;
        const bool isv = (u.pn >= 4 && u.pn < 8);
        f32x4 bv[2][2];
#pragma unroll
        for (int bj = 0; bj < 2; ++bj)
#pragma unroll
            for (int n = 0; n < 2; ++n) bv[bj][n] = *(const f32x4*)(bias + col0 + bj * 128 + 4 * n);
        const bool isz = (u.pn < 8);
#pragma unroll
        for (int ai = 0; ai < 2; ++ai)
#pragma unroll
            for (int m = 0; m < 4; ++m) {
                const int r = row0 + ai * 128 + m * 16; float s1 = 0.f, s2 = 0.f;
#pragma unroll
                for (int bj = 0; bj < 2; ++bj) {
                    f32x4 v0 = acc[ai][bj][m][0] + bv[bj][0], v1 = acc[ai][bj][m][1] + bv[bj][1];
                    const int c = col0 + bj * 128;
                    u32x4 w;
                    if (isz) {
                        const float g0 = gelu_tanh(v0[0]), g1 = gelu_tanh(v0[1]), g2 = gelu_tanh(v0[2]), g3 = gelu_tanh(v0[3]), g4 = gelu_tanh(v1[0]), g5 = gelu_tanh(v1[1]), g6 = gelu_tanh(v1[2]), g7 = gelu_tanh(v1[3]);
                        w.x = pg8::cvt_pk_bf16(g0, g1); w.y = pg8::cvt_pk_bf16(g2, g3); w.z = pg8::cvt_pk_bf16(g4, g5); w.w = pg8::cvt_pk_bf16(g6, g7);
                        *(u32x4*)(Z + (size_t)r * 2048 + c) = w;
                        s1 += ((g0 + g1) + (g2 + g3)) + ((g4 + g5) + (g6 + g7)); s2 += ((g0 * g0 + g1 * g1) + (g2 * g2 + g3 * g3)) + ((g4 * g4 + g5 * g5) + (g6 * g6 + g7 * g7));
                    } else {
                        w.x = pg8::cvt_pk_bf16(v0[0], v0[1]); w.y = pg8::cvt_pk_bf16(v0[2], v0[3]); w.z = pg8::cvt_pk_bf16(v1[0], v1[1]); w.w = pg8::cvt_pk_bf16(v1[2], v1[3]);
                        const int cc = c - 2048, g = cc >> 4, i = cc & 15;
                        *(u32x4*)(XS + ((size_t)(g * 256 + (r >> 6)) * 64 + (r & 63)) * 16 + i) = w;
                    }
                }
                if (isv) { s1 += __shfl_xor(s1, 16); s1 += __shfl_xor(s1, 32); s2 += __shfl_xor(s2, 16); s2 += __shfl_xor(s2, 32);
                    if (fq == 0) *(f32x2*)(PLN + ((size_t)r * 16 + (u.pn - 4) * 4 + wc) * 2) = (f32x2){s1, s2}; }
            }
    }
};
struct EpiGlu {
    static constexpr bool PERM = true, AFTER_DRAIN = false, KSPLIT = false;
    const bf16* Gb; bf16* MIX; const float* bias; float* PSB;
    __device__ __forceinline__ void operator()(const f32x4 (&acc)[2][2][4][2], const pg8::Unit& u, int wr, int wc, int fr, int fq) const {
        const int row0 = u.pm * 256 + wr * 64 + fr, col0 = u.pn * 256 + wc * 32 + 8 * fq;
        f32x4 bv[2][2];
#pragma unroll
        for (int bj = 0; bj < 2; ++bj)
#pragma unroll
            for (int n = 0; n < 2; ++n) bv[bj][n] = *(const f32x4*)(bias + col0 + bj * 128 + 4 * n);
#pragma unroll
        for (int ai = 0; ai < 2; ++ai)
#pragma unroll
            for (int m = 0; m < 4; ++m) {
                const int r = row0 + ai * 128 + m * 16; float ssq = 0.f;
#pragma unroll
                for (int bj = 0; bj < 2; ++bj) {
                    const f32x4 v0 = acc[ai][bj][m][0] + bv[bj][0], v1 = acc[ai][bj][m][1] + bv[bj][1];
                    const int c = col0 + bj * 128;
                    const u32x4 gw = *(const u32x4*)(Gb + (size_t)r * 1024 + c);
                    const float o0 = bflo(gw.x) * fast_sigmoid(v0[0]), o1 = bfhi(gw.x) * fast_sigmoid(v0[1]), o2 = bflo(gw.y) * fast_sigmoid(v0[2]), o3 = bfhi(gw.y) * fast_sigmoid(v0[3]);
                    const float o4 = bflo(gw.z) * fast_sigmoid(v1[0]), o5 = bfhi(gw.z) * fast_sigmoid(v1[1]), o6 = bflo(gw.w) * fast_sigmoid(v1[2]), o7 = bfhi(gw.w) * fast_sigmoid(v1[3]);
                    u32x4 w; w.x = pg8::cvt_pk_bf16(o0, o1); w.y = pg8::cvt_pk_bf16(o2, o3); w.z = pg8::cvt_pk_bf16(o4, o5); w.w = pg8::cvt_pk_bf16(o6, o7);
                    *(u32x4*)(MIX + (size_t)r * 2048 + 1024 + c) = w;
                    ssq += (o0 * o0 + o1 * o1) + (o2 * o2 + o3 * o3) + (o4 * o4 + o5 * o5) + (o6 * o6 + o7 * o7);
                }
                ssq += __shfl_xor(ssq, 16); ssq += __shfl_xor(ssq, 32);
                if (fq == 0) PSB[(size_t)r * 16 + u.pn * 4 + wc] = ssq;
            }
    }
};
template <bool XIN_BF16> struct EpiOut {
    static constexpr bool PERM = true, AFTER_DRAIN = false, KSPLIT = true;
    const void* xin; bf16* X; const float* gate; float* PS; const LAS float* ratL; const LAS float* rbL; int pm0;
    __device__ __forceinline__ void midscale(f32x4 (&acc)[2][2][4][2], const pg8::Unit& u, int wr, int fr) const {
        const LAS float* rp = ratL + (u.pm == pm0 ? 0 : 256) + wr * 64 + fr;
#pragma unroll
        for (int ai = 0; ai < 2; ++ai)
#pragma unroll
            for (int m = 0; m < 4; ++m) { const float rt = rp[ai * 128 + m * 16];
#pragma unroll
                for (int bj = 0; bj < 2; ++bj)
#pragma unroll
                    for (int n = 0; n < 2; ++n) acc[ai][bj][m][n] = acc[ai][bj][m][n] * rt; }
    }
    __device__ __forceinline__ void operator()(const f32x4 (&acc)[2][2][4][2], const pg8::Unit& u, int wr, int wc, int fr, int fq) const {
        const int row0 = u.pm * 256 + wr * 64 + fr, col0 = u.pn * 256 + wc * 32 + 8 * fq;
        const LAS float* rbp = rbL + (u.pm == pm0 ? 0 : 256) + wr * 64 + fr;
        f32x4 gv[2][2];
#pragma unroll
        for (int bj = 0; bj < 2; ++bj)
#pragma unroll
            for (int n = 0; n < 2; ++n) gv[bj][n] = *(const f32x4*)(gate + col0 + bj * 128 + 4 * n);
#pragma unroll
        for (int ai = 0; ai < 2; ++ai)
#pragma unroll
            for (int m = 0; m < 4; ++m) {
                const int r = row0 + ai * 128 + m * 16; float ssq = 0.f; const float rb = rbp[ai * 128 + m * 16];
#pragma unroll
                for (int bj = 0; bj < 2; ++bj) {
                    const size_t off = (size_t)r * 2048 + col0 + bj * 128;
                    f32x4 x0, x1;
                    if (XIN_BF16) { const u32x4 w = *(const u32x4*)((const bf16*)xin + off); x0 = (f32x4){bflo(w.x), bfhi(w.x), bflo(w.y), bfhi(w.y)}; x1 = (f32x4){bflo(w.z), bfhi(w.z), bflo(w.w), bfhi(w.w)}; }
                    else { x0 = *(const f32x4*)((const float*)xin + off); x1 = *(const f32x4*)((const float*)xin + off + 4); }
                    const f32x4 y0 = x0 + gv[bj][0] * (acc[ai][bj][m][0] * rb), y1 = x1 + gv[bj][1] * (acc[ai][bj][m][1] * rb);
                    u32x4 o; o.x = pg8::cvt_pk_bf16(y0[0], y0[1]); o.y = pg8::cvt_pk_bf16(y0[2], y0[3]); o.z = pg8::cvt_pk_bf16(y1[0], y1[1]); o.w = pg8::cvt_pk_bf16(y1[2], y1[3]);
                    *(u32x4*)(X + off) = o;
                    ssq += (y0[0] * y0[0] + y0[1] * y0[1]) + (y0[2] * y0[2] + y0[3] * y0[3]) + (y1[0] * y1[0] + y1[1] * y1[1]) + (y1[2] * y1[2] + y1[3] * y1[3]);
                }
                ssq += __shfl_xor(ssq, 16); ssq += __shfl_xor(ssq, 32);
                if (fq == 0) PS[(size_t)r * 32 + u.pn * 4 + wc] = ssq;
            }
    }
};
struct EpiQ {
    static constexpr bool PERM = true, AFTER_DRAIN = false, KSPLIT = false;
    bf16* Q; const float* c0; const LAS float* rrL; int pm0;
    __device__ __forceinline__ void operator()(const f32x4 (&acc)[2][2][4][2], const pg8::Unit& u, int wr, int wc, int fr, int fq) const {
        const int row0 = u.pm * 256 + wr * 64 + fr, col0 = u.pn * 256 + wc * 32 + 8 * fq;
        const LAS float* rrp = rrL + (u.pm == pm0 ? 0 : 256) + wr * 64 + fr;
        f32x4 cv[2][2];
#pragma unroll
        for (int bj = 0; bj < 2; ++bj)
#pragma unroll
            for (int n = 0; n < 2; ++n) cv[bj][n] = *(const f32x4*)(c0 + col0 + bj * 128 + 4 * n);
#pragma unroll
        for (int ai = 0; ai < 2; ++ai)
#pragma unroll
            for (int m = 0; m < 4; ++m) {
                const int r = row0 + ai * 128 + m * 16; const float rr = rrp[ai * 128 + m * 16];
#pragma unroll
                for (int bj = 0; bj < 2; ++bj) {
                    const f32x4 v0 = acc[ai][bj][m][0] * rr + cv[bj][0], v1 = acc[ai][bj][m][1] * rr + cv[bj][1];
                    u32x4 w; w.x = pg8::cvt_pk_bf16(v0[0], v0[1]); w.y = pg8::cvt_pk_bf16(v0[2], v0[3]); w.z = pg8::cvt_pk_bf16(v1[0], v1[1]); w.w = pg8::cvt_pk_bf16(v1[2], v1[3]);
                    *(u32x4*)(Q + (size_t)r * 2048 + col0 + bj * 128) = w;
                }
            }
    }
};
__device__ __forceinline__ void fill_rr(Frame& F, LAS float* rrL, int slot, int pm, int tid) {
    if (tid < 256) { const float* ps = (const float*)(F.ws + WS_PS) + ((size_t)pm * 256 + tid) * 32; float s = 0.f;
#pragma unroll
        for (int i = 0; i < 8; ++i) { const f32x4 v = *(const f32x4*)(ps + 4 * i); s += (v[0] + v[1]) + (v[2] + v[3]); }
        rrL[slot * 256 + tid] = 1.0f / sqrtf(s * (1.0f / DM) + EPS); }
}

__device__ __forceinline__ void p0_transpose_item(const float* W, int K, int N, bf16* WT, const float* kscale, LAS float* scr, int item, int lane, const float* kscale2 = nullptr) {
    const int nblk = N / 32, kb = item / nblk, nb = item % nblk, k0 = 64 * kb, n0 = 32 * nb;
    float wv[32];
#pragma unroll
    for (int i = 0; i < 32; ++i) wv[i] = W[(size_t)(k0 + 2 * i + (lane >> 5)) * N + n0 + (lane & 31)];
#pragma unroll
    for (int i = 0; i < 32; ++i) { const int kk = 2 * i + (lane >> 5); float v = wv[i]; if (kscale) { v *= kscale[k0 + kk]; if (kscale2) v *= 1.0f + kscale2[k0 + kk]; } scr[kk * 33 + (lane & 31)] = v; }
    LDS_WAIT(); asm volatile("" ::: "memory");
    const int c = lane & 7;
#pragma unroll
    for (int j = 0; j < 4; ++j) { const int n = (lane >> 3) + 8 * j; const LAS float* s = scr + (8 * c) * 33 + n;
        u32x4 o; o.x = pk2(s[0 * 33], s[1 * 33]); o.y = pk2(s[2 * 33], s[3 * 33]); o.z = pk2(s[4 * 33], s[5 * 33]); o.w = pk2(s[6 * 33], s[7 * 33]);
        *(u32x4*)(WT + (size_t)(n0 + n) * K + k0 + 8 * c) = o; }
    LDS_WAIT(); asm volatile("" ::: "memory");
}

__device__ __forceinline__ void norm_mod_row(const f32x4 (&v)[4][2], const float* gain, const float* scale, const float* shift, int lane, u32x4 (&o)[4]) {
    float s = 0.f;
#pragma unroll
    for (int j = 0; j < 4; ++j)
#pragma unroll
        for (int h = 0; h < 2; ++h) s += (v[j][h][0] * v[j][h][0] + v[j][h][1] * v[j][h][1]) + (v[j][h][2] * v[j][h][2] + v[j][h][3] * v[j][h][3]);
    const float rr = 1.0f / sqrtf(wave_sum(s) * (1.0f / DM) + EPS);
#pragma unroll
    for (int j = 0; j < 4; ++j) {
        const int c = j * 512 + lane * 8;
        f32x4 y[2];
#pragma unroll
        for (int h = 0; h < 2; ++h) {
            const f32x4 g = *(const f32x4*)(gain + c + 4 * h);
            y[h] = v[j][h] * rr * g;
            const f32x4 sc = *(const f32x4*)(scale + c + 4 * h), sh = *(const f32x4*)(shift + c + 4 * h); y[h] = y[h] * (sc + 1.0f) + sh;
        }
        o[j].x = pk2(y[0][0], y[0][1]); o[j].y = pk2(y[0][2], y[0][3]); o[j].z = pk2(y[1][0], y[1][1]); o[j].w = pk2(y[1][2], y[1][3]);
    }
}
template <bool SRC_BF16>
__device__ __forceinline__ void load_row(const void* xrow_, int lane, f32x4 (&v)[4][2]) {
#pragma unroll
    for (int j = 0; j < 4; ++j) {
        if (SRC_BF16) { const u32x4 w = *(const u32x4*)((const bf16*)xrow_ + j * 512 + lane * 8); v[j][0] = (f32x4){bflo(w.x), bfhi(w.x), bflo(w.y), bfhi(w.y)}; v[j][1] = (f32x4){bflo(w.z), bfhi(w.z), bflo(w.w), bfhi(w.w)}; }
        else { const float* xrow = (const float*)xrow_; v[j][0] = *(const f32x4*)(xrow + j * 512 + lane * 8); v[j][1] = *(const f32x4*)(xrow + j * 512 + lane * 8 + 4); } }
}

__device__ __forceinline__ void p0_gemv_unit(Frame& F, int unit, int tid, float* modout) {
    const int l = unit / 192, r = unit % 192, cb = r >> 1, kh = r & 1;
    LAS float* sc = (LAS float*)F.lds;
    LAS float* red = (LAS float*)(F.lds + 4096);
    for (int k = tid; k < 1024; k += NTHR) { const float c = F.in[I_C][kh * 1024 + k]; sc[k] = c * fast_sigmoid(c); }
    __syncthreads();
    const int tx = tid & 31, ty = tid >> 5;
    const float* W = F.in[I_WMOD] + ((size_t)l * DM + kh * 1024) * 12288 + cb * 128 + tx * 4;
    f32x4 a = {0.f, 0.f, 0.f, 0.f};
#pragma unroll 16
    for (int k = ty; k < 1024; k += 16) { const f32x4 w = *(const f32x4*)(W + (size_t)k * 12288); a += w * sc[k]; }
    *(LAS f32x4*)(red + ty * 128 + tx * 4) = a;
    __syncthreads();
    if (tid < 128) { float s = 0.f;
#pragma unroll
        for (int y = 0; y < 16; ++y) s += red[y * 128 + tid];
        if (kh == 0) s += F.in[I_BMOD][l * 12288 + cb * 128 + tid];
        atomicAdd(modout + l * 12288 + cb * 128 + tid, s); }
    __syncthreads();
}
__device__ __forceinline__ void p0_s5_unit(Frame& F, int unit, int tid, int parts = 15) {
    const int l = unit >> 7, g = (unit >> 1) & 63, hf = unit & 1;
    LAS float* apr = (LAS float*)F.lds;
    LAS float* api = apr + 4228;
    LAS float* bbr = api + 4228;
    LAS float* bbi = bbr + 1024;
    LAS float* ccr = bbi + 1024;
    LAS float* cci = ccr + 16 * 65;
    const float dt = expf(F.in[I_LDT][l * 64 + g]);
    const float* lre = F.in[I_LRE] + (l * 64 + g) * 64; const float* lim = F.in[I_LIM] + (l * 64 + g) * 64;
    for (int idx = tid; idx < 65 * 64; idx += NTHR) { const int d = idx >> 6, p = idx & 63;
        const float mag = expf(lre[p] * dt * (float)d); float sn, cs; sincosf(lim[p] * dt * (float)d, &sn, &cs);
        apr[d * 65 + p] = mag * cs; api[d * 65 + p] = mag * sn; }
    for (int idx = tid; idx < 1024; idx += NTHR) { const int o = idx >> 6, p = idx & 63;
        ccr[o * 65 + p] = F.in[I_CRE][((size_t)(l * 64 + g) * 16 + o) * 64 + p]; cci[o * 65 + p] = F.in[I_CIM][((size_t)(l * 64 + g) * 16 + o) * 64 + p]; }
    __syncthreads();
    for (int idx = tid; idx < 1024; idx += NTHR) { const int p = idx >> 4, i = idx & 15;
        const float xr = apr[65 + p] - 1.0f, xi = api[65 + p], lr = lre[p], li = lim[p], den = 1.0f / (lr * lr + li * li);
        const float cr = (xr * lr + xi * li) * den, ci = (xi * lr - xr * li) * den;
        const float br = F.in[I_BRE][((size_t)(l * 64 + g) * 64 + p) * 16 + i], bi = F.in[I_BIM][((size_t)(l * 64 + g) * 64 + p) * 16 + i];
        bbr[idx] = cr * br - ci * bi; bbi[idx] = cr * bi + ci * br; }
    __syncthreads();
    bf16* KT = (bf16*)(F.ws + WS_KTAB) + (size_t)(l * 64 + g) * 80 * 256;
    if (parts & 1) {
        const int d = hf * 32 + (tid >> 4), o = tid & 15;
        const float dskip = F.in[I_SD][l * 1024 + g * 16 + o];
        float s[16];
#pragma unroll
        for (int i = 0; i < 16; ++i) s[i] = 0.f;
        for (int p = 0; p < 64; ++p) { const float ar = apr[d * 65 + p], ai = api[d * 65 + p], cr = ccr[o * 65 + p], ci = cci[o * 65 + p];
            const float er = cr * ar - ci * ai, ei = cr * ai + ci * ar;
#pragma unroll
            for (int q = 0; q < 4; ++q) { const f32x4 br = *(const LAS f32x4*)(bbr + p * 16 + 4 * q), bi = *(const LAS f32x4*)(bbi + p * 16 + 4 * q);
#pragma unroll
                for (int e = 0; e < 4; ++e) s[4 * q + e] += er * br[e] - ei * bi[e]; } }
#if !SELFTEST_S5
        {   const float dsk = (d == 0) ? dskip : 0.f;
#pragma unroll
            for (int i = 0; i < 16; ++i) s[i] += (i == o) ? dsk : 0.f; }
#endif
        u32x4 w0, w1;
        w0.x = pk2(s[0], s[1]); w0.y = pk2(s[2], s[3]); w0.z = pk2(s[4], s[5]); w0.w = pk2(s[6], s[7]);
        w1.x = pk2(s[8], s[9]); w1.y = pk2(s[10], s[11]); w1.z = pk2(s[12], s[13]); w1.w = pk2(s[14], s[15]);
        if ((parts & 8) || w0.x == 0x12345678u) { *(u32x4*)(KT + (size_t)(d + 16) * 256 + o * 16) = w0; *(u32x4*)(KT + (size_t)(d + 16) * 256 + o * 16 + 8) = w1; }
        if ((parts & 8) && hf == 0 && tid < 256) { const u32x4 z = {0u, 0u, 0u, 0u}; *(u32x4*)(KT + tid * 16) = z; *(u32x4*)(KT + tid * 16 + 8) = z; }
    }
    bf16* WG = (bf16*)(F.ws + WS_WG) + (size_t)(l * 64 + g) * 128 * 1024;
    if (parts & 2) for (int it = tid; it < 32 * 64; it += NTHR) { const int p = hf * 32 + (it >> 6), tau = it & 63;
        const float ar = apr[(63 - tau) * 65 + p], ai = api[(63 - tau) * 65 + p];
        unsigned wr_[8], wi_[8];
#pragma unroll
        for (int q = 0; q < 4; ++q) { const f32x4 br = *(const LAS f32x4*)(bbr + p * 16 + 4 * q), bi = *(const LAS f32x4*)(bbi + p * 16 + 4 * q);
            wr_[2 * q] = pk2(ar * br[0] - ai * bi[0], ar * br[1] - ai * bi[1]); wr_[2 * q + 1] = pk2(ar * br[2] - ai * bi[2], ar * br[3] - ai * bi[3]);
            wi_[2 * q] = pk2(ar * bi[0] + ai * br[0], ar * bi[1] + ai * br[1]); wi_[2 * q + 1] = pk2(ar * bi[2] + ai * br[2], ar * bi[3] + ai * br[3]); }
        *(u32x4*)(WG + (size_t)p * 1024 + tau * 16) = (u32x4){wr_[0], wr_[1], wr_[2], wr_[3]}; *(u32x4*)(WG + (size_t)p * 1024 + tau * 16 + 8) = (u32x4){wr_[4], wr_[5], wr_[6], wr_[7]};
        *(u32x4*)(WG + (size_t)(64 + p) * 1024 + tau * 16) = (u32x4){wi_[0], wi_[1], wi_[2], wi_[3]}; *(u32x4*)(WG + (size_t)(64 + p) * 1024 + tau * 16 + 8) = (u32x4){wi_[4], wi_[5], wi_[6], wi_[7]}; }
    bf16* VG = (bf16*)(F.ws + WS_VG) + (size_t)(l * 64 + g) * 1024 * 128;
    if (parts & 4) for (int it = tid; it < 512 * 8; it += NTHR) { const int m = hf * 512 + (it >> 3), p0 = (it & 7) * 8, t = m >> 4, o = m & 15;
        float vr_[8], vi_[8];
#pragma unroll
        for (int e = 0; e < 8; ++e) { const float ar = apr[(t + 1) * 65 + p0 + e], ai = api[(t + 1) * 65 + p0 + e], cr = ccr[o * 65 + p0 + e], ci = cci[o * 65 + p0 + e];
            vr_[e] = cr * ar - ci * ai; vi_[e] = -(cr * ai + ci * ar); }
        *(u32x4*)(VG + (size_t)m * 128 + p0) = (u32x4){pk2(vr_[0], vr_[1]), pk2(vr_[2], vr_[3]), pk2(vr_[4], vr_[5]), pk2(vr_[6], vr_[7])};
        *(u32x4*)(VG + (size_t)m * 128 + 64 + p0) = (u32x4){pk2(vi_[0], vi_[1]), pk2(vi_[2], vi_[3]), pk2(vi_[4], vi_[5]), pk2(vi_[6], vi_[7])}; }
    if (hf == 0 && tid < 64) { float* AT = (float*)(F.ws + WS_AT) + ((size_t)(l * 64 + g) * 64 + tid) * 2; AT[0] = apr[64 * 65 + tid]; AT[1] = api[64 * 65 + tid]; }
    __syncthreads();
}
__device__ __forceinline__ void p0_fp4_chunk(Frame& F, int chunk, int wave, int lane) {
    unsigned char* UV = F.ws + WS_UV; float* SCL = (float*)(F.ws + WS_SCL);
    for (int i = 0; i < 8; i += 2) {
        f32x4 v[2][8]; float am[2] = {0.f, 0.f}; int tbl[2], rr[2];
#pragma unroll
        for (int r2 = 0; r2 < 2; ++r2) {
            const int r = chunk * 64 + wave * 8 + i + r2; tbl[r2] = r >> 15; rr[r2] = r & 32767;
            const float* srcp = (tbl[r2] ? F.in[I_PV] : F.in[I_PU]) + (size_t)rr[r2] * 2048 + lane * 4;
#pragma unroll
            for (int j = 0; j < 8; ++j) v[r2][j] = *(const f32x4*)(srcp + j * 256);
        }
#pragma unroll
        for (int r2 = 0; r2 < 2; ++r2)
#pragma unroll
            for (int j = 0; j < 8; ++j) am[r2] = fmaxf(am[r2], fmaxf(fmaxf(fabsf(v[r2][j][0]), fabsf(v[r2][j][1])), fmaxf(fabsf(v[r2][j][2]), fabsf(v[r2][j][3]))));
#pragma unroll
        for (int o = 1; o < 64; o <<= 1) { am[0] = fmaxf(am[0], __shfl_xor(am[0], o)); am[1] = fmaxf(am[1], __shfl_xor(am[1], o)); }
#pragma unroll
        for (int r2 = 0; r2 < 2; ++r2) {
            const float scale = am[r2] > 0.f ? am[r2] * (1.0f / 6.0f) : 1.0f, inv = am[r2] > 0.f ? 6.0f / am[r2] : 1.0f;
            u32x4 o;
#pragma unroll
            for (int d = 0; d < 4; ++d) { unsigned w = 0u;
                w = __builtin_amdgcn_cvt_scalef32_pk_fp4_f32(w, v[r2][2 * d][0] * inv, v[r2][2 * d][1] * inv, 1.0f, 0);
                w = __builtin_amdgcn_cvt_scalef32_pk_fp4_f32(w, v[r2][2 * d][2] * inv, v[r2][2 * d][3] * inv, 1.0f, 1);
                w = __builtin_amdgcn_cvt_scalef32_pk_fp4_f32(w, v[r2][2 * d + 1][0] * inv, v[r2][2 * d + 1][1] * inv, 1.0f, 2);
                w = __builtin_amdgcn_cvt_scalef32_pk_fp4_f32(w, v[r2][2 * d + 1][2] * inv, v[r2][2 * d + 1][3] * inv, 1.0f, 3);
                o[d] = w; }
            *(u32x4*)(UV + (size_t)(rr[r2] >> 14) * ((size_t)NEXP * 2048) + (size_t)tbl[r2] * ((size_t)NEXP * 1024) + (size_t)(rr[r2] & 16383) * 1024 + lane * 16) = o;
            if (lane == 0) SCL[rr[r2] * 2 + tbl[r2]] = scale;
        }
    }
}
#ifndef P0_PARTS
#define P0_PARTS 15
#endif
#ifndef P0_PROBE_MODE
#define P0_PROBE_MODE 0
#endif
__device__ __forceinline__ void p0_tables(Frame& F, int qi = 4, bool dummy = false) {
    PH_LOCALS
    unsigned* head = (unsigned*)(F.ws + WS_CTL) + CW_QUEUE + 64 * qi;
    float* modout = dummy ? (float*)(F.ws + WS_DBG) : (float*)(F.ws + WS_MOD);
    LAS unsigned* slot = (LAS unsigned*)(F.lds + MISC_OFF) + 16;
    for (;;) {
        __syncthreads();
        if (tid == 0) slot[0] = __hip_atomic_fetch_add(head, 1u, RLX_AGENT);
        __syncthreads();
        const unsigned u = slot[0];
        if (u >= 1664u) break;
        const int rnd = (int)u / 13, k = (int)u % 13;
        if (k < 2) { if (dummy && P0_PROBE_MODE == 2) continue; p0_s5_unit(F, rnd * 2 + k, tid, dummy ? P0_PARTS : 15); }
        else if (k < 5) { if (dummy && P0_PROBE_MODE == 1) continue; p0_gemv_unit(F, rnd * 3 + (k - 2), tid, modout); }
        else { p0_fp4_chunk(F, rnd * 8 + (k - 5), wave, lane); }
    }
}
__device__ __forceinline__ void p0_prologue(Frame& F) {
    PH_LOCALS
    const int gw = F.vcu * NWAVES + wave, NGW = F.G * NWAVES;
    const int gt = F.vcu * NTHR + tid, NGT = F.G * NTHR;
    const float* modp = (const float*)(F.ws + WS_MOD);
    for (int i = gt; i < 2 * DM; i += NGT) { const int l = i >> 11, k = i & 2047; ((float*)(F.ws + WS_GS))[i] = F.in[I_N2G][i] * (1.0f + modp[l * 12288 + 4 * 2048 + k]); }
    if (F.vcu < 64) {
        const int l = F.vcu >> 5, cb = F.vcu & 31, tx = tid & 15, ty = tid >> 4;
        const float* W = F.in[I_WQ] + (size_t)l * DM * DM + cb * 64 + tx * 4; const float* sh = modp + l * 12288 + 3 * 2048;
        f32x4 a = {0.f, 0.f, 0.f, 0.f};
#pragma unroll 16
        for (int k = ty; k < DM; k += 32) { const f32x4 w = *(const f32x4*)(W + (size_t)k * DM); a += w * sh[k]; }
        LAS float* red = (LAS float*)F.lds;
        *(LAS f32x4*)(red + ty * 64 + tx * 4) = a;
        __syncthreads();
        if (tid < 64) { float s = 0.f;
#pragma unroll
            for (int y = 0; y < 32; ++y) s += red[y * 64 + tid];
            ((float*)(F.ws + WS_C0))[l * DM + cb * 64 + tid] = s; }
        __syncthreads();
    }
    {
        LAS float* scr = (LAS float*)(F.lds + wave * 16384);
        constexpr int I_IN = (DM / 64) * (INW / 32), I_GL = (WB / 64) * (WB / 32), I_OU = (DM / 64) * (DM / 32), I_Q = I_OU;
        constexpr int PER_L = I_IN + I_GL + I_OU + I_Q;
        for (int it = gw; it < 2 * PER_L; it += NGW) {
            const int l = it / PER_L; int r = it % PER_L;
            if (r < I_IN) { p0_transpose_item(F.in[I_WIN] + (size_t)l * DM * INW, DM, INW, (bf16*)(F.ws + WS_WIN) + (size_t)l * INW * DM, nullptr, scr, r, lane); continue; } r -= I_IN;
            if (r < I_GL) { p0_transpose_item(F.in[I_GLUW] + (size_t)l * WB * WB, WB, WB, (bf16*)(F.ws + WS_GLU) + (size_t)l * WB * WB, nullptr, scr, r, lane); continue; } r -= I_GL;
            if (r < I_OU) { p0_transpose_item(F.in[I_WOUT] + (size_t)l * DM * DM, DM, DM, (bf16*)(F.ws + WS_WOUT) + (size_t)l * DM * DM, F.in[I_BRG] + l * DM, scr, r, lane); continue; } r -= I_OU;
            p0_transpose_item(F.in[I_WQ] + (size_t)l * DM * DM, DM, DM, (bf16*)(F.ws + WS_WQ) + (size_t)l * DM * DM, F.in[I_N2G] + l * DM, scr, r, lane, modp + l * 12288 + 4 * 2048);
        }
    }
    {
        bf16* KB = (bf16*)(F.ws + WS_KEYS);
        for (int i = gt; i < 2 * 8 * 2 * 128 * 128 / 8; i += NGT) { const f32x4 a = *(const f32x4*)(F.in[I_KEYS] + (size_t)i * 8), b = *(const f32x4*)(F.in[I_KEYS] + (size_t)i * 8 + 4);
            u32x4 o; o.x = pk2(a[0], a[1]); o.y = pk2(a[2], a[3]); o.z = pk2(b[0], b[1]); o.w = pk2(b[2], b[3]); *(u32x4*)(KB + (size_t)i * 8) = o; }
        bf16* GW = (bf16*)(F.ws + WS_GWS);
        for (int i = gt; i < 2 * 8 * 128 * 128 / 8; i += NGT) { const int e = i * 8, jj = e & 127, ii = (e >> 7) & 127; const bool keep = (ii >= 64) || (jj < 64);
            f32x4 a = *(const f32x4*)(F.in[I_GWS] + (size_t)i * 8), b = *(const f32x4*)(F.in[I_GWS] + (size_t)i * 8 + 4);
            if (!keep) { a = (f32x4){0.f, 0.f, 0.f, 0.f}; b = a; }
            u32x4 o; o.x = pk2(a[0], a[1]); o.y = pk2(a[2], a[3]); o.z = pk2(b[0], b[1]); o.w = pk2(b[2], b[3]); *(u32x4*)(GW + (size_t)i * 8) = o; }
    }
}

template <bool SRC_BF16>
__device__ __forceinline__ void phase_norm(Frame& F, const void* xsrc, const float* gain, const float* scale, const float* shift) {
    PH_LOCALS
    const int gw = F.vcu * NWAVES + wave, NGW = F.G * NWAVES;
    bf16* H = (bf16*)(F.ws + WS_H);
    for (int m = gw; m < M; m += 2 * NGW) {
        const int m2 = m + NGW;
        f32x4 va[4][2], vb[4][2];
        const char* ra = (const char*)xsrc + (size_t)m * DM * (SRC_BF16 ? 2 : 4); const char* rb = (const char*)xsrc + (size_t)(m2 < M ? m2 : m) * DM * (SRC_BF16 ? 2 : 4);
        load_row<SRC_BF16>(ra, lane, va); load_row<SRC_BF16>(rb, lane, vb);
        u32x4 oa[4], ob[4]; norm_mod_row(va, gain, scale, shift, lane, oa); norm_mod_row(vb, gain, scale, shift, lane, ob);
#pragma unroll
        for (int j = 0; j < 4; ++j) *(u32x4*)(H + (size_t)m * DM + j * 512 + lane * 8) = oa[j];
        if (m2 < M) {
#pragma unroll
            for (int j = 0; j < 4; ++j) *(u32x4*)(H + (size_t)m2 * DM + j * 512 + lane * 8) = ob[j]; }
    }
}
__device__ __forceinline__ void phase_sloc(Frame& F, int l) {
    PH_LOCALS
    const bf16* XS = (const bf16*)(F.ws + WS_XS); const bf16* WG = (const bf16*)(F.ws + WS_WG) + (size_t)l * 64 * 128 * 1024; float* SL = (float*)(F.ws + WS_SLOC);
    LAS unsigned char* WL = F.lds;
    const int fr = lane & 15, fq = lane >> 4;
    for (int u = F.vcu; u < 256; u += F.G) {
        const int g = u >> 2, jq = u & 3;
        const bf16* xp0 = XS + ((size_t)(g * 256 + 32 * wave + fr)) * 1024 + 8 * fq;
        bf16x8 xa[8][2];
#pragma unroll
        for (int i = 0; i < 8; ++i) { xa[i][0] = *(const bf16x8*)(xp0 + i * 32); xa[i][1] = *(const bf16x8*)(xp0 + 16 * 1024 + i * 32); }
        __syncthreads();
#pragma unroll
        for (int ps = 0; ps < 8; ++ps) { const int idx = ps * 512 + tid, row = idx >> 7, c16 = idx & 127;
            *(LAS u32x4*)(WL + row * 2064 + c16 * 16) = *(const u32x4*)(WG + ((size_t)(g * 128 + jq * 32 + row)) * 1024 + c16 * 8); }
        __syncthreads();
        f32x4 acc[2][2];
#pragma unroll
        for (int a = 0; a < 2; ++a) { acc[a][0] = (f32x4){0.f, 0.f, 0.f, 0.f}; acc[a][1] = acc[a][0]; }
#pragma unroll 1
        for (int kg = 0; kg < 4; ++kg) {
            bf16x8 xn[8][2];
            if (kg < 3) {
#pragma unroll
                for (int i = 0; i < 8; ++i) { xn[i][0] = *(const bf16x8*)(xp0 + ((kg + 1) * 8 + i) * 32); xn[i][1] = *(const bf16x8*)(xp0 + 16 * 1024 + ((kg + 1) * 8 + i) * 32); }
            }
#pragma unroll
            for (int i = 0; i < 8; ++i) { const int kb = kg * 8 + i;
#pragma unroll
                for (int jt = 0; jt < 2; ++jt) { const bf16x8 wf = *(const LAS bf16x8*)(WL + (jt * 16 + fr) * 2064 + (kb * 32 + 8 * fq) * 2);
                    acc[0][jt] = __builtin_amdgcn_mfma_f32_16x16x32_bf16(wf, xa[i][0], acc[0][jt], 0, 0, 0);
                    acc[1][jt] = __builtin_amdgcn_mfma_f32_16x16x32_bf16(wf, xa[i][1], acc[1][jt], 0, 0, 0); } }
            if (kg < 3) {
#pragma unroll
                for (int i = 0; i < 8; ++i) { xa[i][0] = xn[i][0]; xa[i][1] = xn[i][1]; }
            }
        }
#pragma unroll
        for (int a = 0; a < 2; ++a)
#pragma unroll
            for (int jt = 0; jt < 2; ++jt) *(f32x4*)(SL + ((size_t)(g * 256 + 32 * wave + 16 * a + fr)) * 128 + jq * 32 + jt * 16 + 4 * fq) = acc[a][jt];
    }
    __syncthreads();
}
__device__ __forceinline__ void phase_gating(Frame& F, int l) {
    PH_LOCALS
    const bf16* Z = (const bf16*)(F.ws + WS_Z); const float* PLN = (const float*)(F.ws + WS_PLN);
    bf16* MIX = (bf16*)(F.ws + WS_MIX);
    LAS bf16* VT = (LAS bf16*)F.lds;
    constexpr int VS = 136;
    const int j = tid >> 2, cs = (tid & 3) * 32;
    const int fr = lane & 15, fq = lane >> 4, w = wave;
    u32x4 tw[4]; float mu = 0.f, rs = 0.f;
#define GT_LOAD(unit_) do { const int nb_ = (unit_) >> 3, hh_ = (unit_) & 7; const size_t rowo = (size_t)(nb_ * 128 + j) * 2048 + 1024 + hh_ * 128 + cs; \
        _Pragma("unroll") for (int q = 0; q < 4; ++q) tw[q] = *(const u32x4*)(Z + rowo + q * 8); \
        { const float* pl = PLN + (size_t)(nb_ * 128 + j) * 32; float a1 = 0.f, a2 = 0.f; \
          _Pragma("unroll") for (int i = 0; i < 8; ++i) { const f32x4 pv = *(const f32x4*)(pl + 4 * i); a1 += pv[0] + pv[2]; a2 += pv[1] + pv[3]; } \
          mu = a1 * (1.0f / 1024.0f); rs = 1.0f / sqrtf(fmaxf(a2 * (1.0f / 1024.0f) - mu * mu, 0.f) + EPS); } } while (0)
    if (F.vcu < 1024) GT_LOAD(F.vcu);
    for (int unit = F.vcu; unit < 1024; unit += F.G) {
        const int nb = unit >> 3, hh = unit & 7, t0 = nb * 128, c0 = hh * 128;
        const bf16* GW = (const bf16*)(F.ws + WS_GWS) + (size_t)(l * 8 + hh) * 128 * 128;
        {
            const float* lg = F.in[I_LNG] + l * 1024 + c0 + cs; const float* lb = F.in[I_LNB] + l * 1024 + c0 + cs;
#pragma unroll
            for (int q = 0; q < 4; ++q) {
                const f32x4 g0 = *(const f32x4*)(lg + q * 8), g1 = *(const f32x4*)(lg + q * 8 + 4), b0 = *(const f32x4*)(lb + q * 8), b1 = *(const f32x4*)(lb + q * 8 + 4);
#pragma unroll
                for (int e = 0; e < 4; ++e) { const int c = cs + q * 8 + 2 * e;
                    const float ga = e < 2 ? g0[2 * e] : g1[2 * e - 4], gb = e < 2 ? g0[2 * e + 1] : g1[2 * e - 3], ba = e < 2 ? b0[2 * e] : b1[2 * e - 4], bb = e < 2 ? b0[2 * e + 1] : b1[2 * e - 3];
                    const float a = (bflo(tw[q][e]) - mu) * rs * ga + ba, b = (bfhi(tw[q][e]) - mu) * rs * gb + bb;
                    VT[c * VS + j] = (bf16)f2bf(a); VT[(c + 1) * VS + j] = (bf16)f2bf(b); }
            }
        }
        if (unit + F.G < 1024) GT_LOAD(unit + F.G);
        const int nkb = (w < 4) ? 2 : 4;
        bf16x8 wf[4];
#pragma unroll
        for (int kb = 0; kb < 4; ++kb) wf[kb] = *(const bf16x8*)(GW + (size_t)(16 * w + fr) * 128 + (kb < nkb ? kb : 0) * 32 + 8 * fq);
        const int tok = t0 + 16 * w + fr; const float bs = F.in[I_GBS][(l * 8 + hh) * 128 + 16 * w + fr];
        u32x2 uw[8];
#pragma unroll
        for (int ct = 0; ct < 8; ++ct) uw[ct] = *(const u32x2*)(Z + (size_t)tok * 2048 + c0 + ct * 16 + 4 * fq);
        __syncthreads();
        {
            f32x4 acc[8];
#pragma unroll
            for (int ct = 0; ct < 8; ++ct) acc[ct] = (f32x4){0.f, 0.f, 0.f, 0.f};
#pragma unroll
            for (int kb = 0; kb < 4; ++kb) { if (kb < nkb) {
#pragma unroll
                for (int ct = 0; ct < 8; ++ct) { const bf16x8 vf = *(const LAS bf16x8*)(VT + (ct * 16 + fr) * VS + kb * 32 + 8 * fq); acc[ct] = __builtin_amdgcn_mfma_f32_16x16x32_bf16(vf, wf[kb], acc[ct], 0, 0, 0); } } }
            float ssq = 0.f;
#pragma unroll
            for (int ct = 0; ct < 8; ++ct) { const int c = c0 + ct * 16 + 4 * fq;
                const float o0 = bflo(uw[ct].x) * (acc[ct][0] + bs), o1 = bfhi(uw[ct].x) * (acc[ct][1] + bs), o2 = bflo(uw[ct].y) * (acc[ct][2] + bs), o3 = bfhi(uw[ct].y) * (acc[ct][3] + bs);
                u32x2 o; o.x = pk2(o0, o1); o.y = pk2(o2, o3);
                *(u32x2*)(MIX + (size_t)tok * 2048 + c) = o; ssq += (o0 * o0 + o1 * o1) + (o2 * o2 + o3 * o3); }
            ssq += __shfl_xor(ssq, 16); ssq += __shfl_xor(ssq, 32);
            if (fq == 0) ((float*)(F.ws + WS_PSA))[(size_t)tok * 8 + hh] = ssq;
        }
        __syncthreads();
    }
#undef GT_LOAD
}

__device__ __forceinline__ void phase_s5out(Frame& F, int l) {
    PH_LOCALS
    const bf16* XS = (const bf16*)(F.ws + WS_XS);
    bf16* Gb = (bf16*)(F.ws + WS_G);
    LAS unsigned char* HT = F.lds;
    LAS float* TS = (LAS float*)(F.lds + 34816);
    LAS unsigned char* KT = F.lds + 38912;
    LAS unsigned char* VT = F.lds + 79872;
    const int fr = lane & 15, fq = lane >> 4;
    for (int u = F.vcu; u < 512; u += F.G) {
        const int g = u >> 3, rc = (u >> 1) & 3, nh = u & 1;
        const bf16* VG = (const bf16*)(F.ws + WS_VG) + (size_t)(l * 64 + g) * 1024 * 128;
        const int n = nh * 128 + 16 * wave + fr;
        const bf16* xp0 = XS + ((size_t)(g * 256 + n)) * 1024 + 8 * fq;
        bf16x8 xa[4], xb[4];
#pragma unroll
        for (int i = 0; i < 4; ++i) xa[i] = *(const bf16x8*)(xp0 + i * 32);
        __syncthreads();
        { const u32x4* src = (const u32x4*)((const bf16*)(F.ws + WS_KTAB) + (size_t)(l * 64 + g) * 80 * 256);
          for (int i = tid; i < 80 * 256 / 8; i += NTHR) ((LAS u32x4*)KT)[i] = src[i];
#pragma unroll
          for (int ps = 0; ps < 8; ++ps) { const int row = ps * 32 + (tid >> 4), c = tid & 15, q = row >> 4, o = row & 15;
              *(LAS u32x4*)(VT + row * 272 + c * 16) = *(const u32x4*)(VG + (size_t)((rc + 4 * q) * 16 + o) * 128 + c * 8); } }
        {
            const int p = lane, seg = wave;
            const float* AT = (const float*)(F.ws + WS_AT) + ((size_t)(l * 64 + g) * 64 + p) * 2; const float ar = AT[0], ai = AT[1];
            const float* SL = (const float*)(F.ws + WS_SLOC) + ((size_t)(g * 256 + seg * 32)) * 128 + p;
            float sr[32], si[32];
#pragma unroll
            for (int i = 0; i < 32; ++i) { sr[i] = SL[(size_t)i * 128]; si[i] = SL[(size_t)i * 128 + 64]; }
            float er = 0.f, ei = 0.f;
#pragma unroll
            for (int i = 0; i < 32; ++i) { const float nr = ar * er - ai * ei + sr[i], ni = ar * ei + ai * er + si[i]; er = nr; ei = ni; }
            TS[(seg * 64 + p) * 2] = er; TS[(seg * 64 + p) * 2 + 1] = ei;
            float qr = ar, qi = ai;
#pragma unroll
            for (int s = 0; s < 5; ++s) { const float nr = qr * qr - qi * qi, ni = 2.0f * qr * qi; qr = nr; qi = ni; }
            __syncthreads();
            float hr = 0.f, hi = 0.f;
            for (int k = 0; k < seg; ++k) { const float tr = TS[(k * 64 + p) * 2], ti = TS[(k * 64 + p) * 2 + 1]; const float nr = qr * hr - qi * hi + tr, ni = qr * hi + qi * hr + ti; hr = nr; hi = ni; }
            if ((seg >> 2) == nh) {
                LAS bf16* hrow = (LAS bf16*)(HT + ((seg & 3) * 32) * 272) + p;
#pragma unroll
                for (int i = 0; i < 32; ++i) { hrow[i * 136] = (bf16)f2bf(hr); hrow[i * 136 + 64] = (bf16)f2bf(hi);
                    const float nr = ar * hr - ai * hi + sr[i], ni = ar * hi + ai * hr + si[i]; hr = nr; hi = ni; }
            }
        }
        __syncthreads();
        f32x4 acc[16];
#pragma unroll
        for (int q = 0; q < 16; ++q) acc[q] = (f32x4){0.f, 0.f, 0.f, 0.f};
        const int kb0 = ((rc - (fq >> 1) + 10) * 16 + fr) * 32 + 16 * (fq & 1);
#define S5_GROUP(XF, grp_) do { const LAS unsigned char* kp = KT + kb0 - (grp_) * 4096; \
            _Pragma("unroll") for (int q = 0; q < 16; ++q) { if (rc + 4 * q >= 8 * (grp_)) { \
                _Pragma("unroll") for (int i = 0; i < 4; ++i) { const bf16x8 kf = *(const LAS bf16x8*)(kp + (4 * q - 2 * i + 6) * 512); \
                    acc[q] = __builtin_amdgcn_mfma_f32_16x16x32_bf16(kf, XF[i], acc[q], 0, 0, 0); } } } } while (0)
#pragma unroll 1
        for (int gp = 0; gp < 4; ++gp) {
#pragma unroll
            for (int i = 0; i < 4; ++i) xb[i] = *(const bf16x8*)(xp0 + ((2 * gp + 1) * 4 + i) * 32);
            S5_GROUP(xa, 2 * gp);
            if (gp < 3) {
#pragma unroll
                for (int i = 0; i < 4; ++i) xa[i] = *(const bf16x8*)(xp0 + ((2 * gp + 2) * 4 + i) * 32);
            }
            S5_GROUP(xb, 2 * gp + 1);
        }
#undef S5_GROUP
#pragma unroll 1
        for (int jb = 0; jb < 4; ++jb) {
            const bf16x8 hf = *(const LAS bf16x8*)(HT + (16 * wave + fr) * 272 + (jb * 32 + 8 * fq) * 2);
#pragma unroll
            for (int q = 0; q < 16; ++q) {
                const bf16x8 vf = *(const LAS bf16x8*)(VT + (q * 16 + fr) * 272 + (jb * 32 + 8 * fq) * 2);
                acc[q] = __builtin_amdgcn_mfma_f32_16x16x32_bf16(vf, hf, acc[q], 0, 0, 0);
            }
        }
#pragma unroll
        for (int q = 0; q < 16; ++q) {
            const int t = rc + 4 * q, tok = 64 * n + t;
            const f32x4 y = acc[q];
            u32x2 o; o.x = pk2(gelu_tanh(y[0]), gelu_tanh(y[1])); o.y = pk2(gelu_tanh(y[2]), gelu_tanh(y[3]));
            *(u32x2*)(Gb + (size_t)tok * 1024 + g * 16 + 4 * fq) = o;
#if SELFTEST_S5
            if (tok < 256) *(f32x4*)((float*)(F.ws + WS_DBG) + (size_t)tok * 1024 + g * 16 + 4 * fq) = y;
#endif
        }
    }
    __syncthreads();
}
#if SELFTEST_S5
__device__ __forceinline__ void selftest_s5(Frame& F, int l) {
    PH_LOCALS
    if (F.vcu < 64 && wave == 0) {
        const int g = F.vcu, p = lane;
        const float dt = expf(F.in[I_LDT][l * 64 + g]);
        const float lr = F.in[I_LRE][(l * 64 + g) * 64 + p], li = F.in[I_LIM][(l * 64 + g) * 64 + p];
        const float mag = expf(lr * dt); float sn, cs; sincosf(li * dt, &sn, &cs);
        const float ar = mag * cs, ai = mag * sn;
        const float xr = ar - 1.0f, xi = ai, den = 1.0f / (lr * lr + li * li);
        const float cr = (xr * lr + xi * li) * den, ci = (xi * lr - xr * li) * den;
        float bbr[16], bbi[16], ccr[16], cci[16];
#pragma unroll
        for (int i = 0; i < 16; ++i) { const float br = F.in[I_BRE][((size_t)(l * 64 + g) * 64 + p) * 16 + i], bi = F.in[I_BIM][((size_t)(l * 64 + g) * 64 + p) * 16 + i];
            bbr[i] = cr * br - ci * bi; bbi[i] = cr * bi + ci * br;
            ccr[i] = F.in[I_CRE][((size_t)(l * 64 + g) * 16 + i) * 64 + p]; cci[i] = F.in[I_CIM][((size_t)(l * 64 + g) * 16 + i) * 64 + p]; }
        const bf16* XS = (const bf16*)(F.ws + WS_XS) + (size_t)g * 256 * 1024;
        const float* DY = (const float*)(F.ws + WS_DBG);
        float sr = 0.f, si = 0.f, err = 0.f, ref = 0.f;
        for (int t = 0; t < 256; ++t) {
            float x[16];
#pragma unroll
            for (int i = 0; i < 16; ++i) x[i] = bflo((unsigned)XS[(size_t)t * 16 + i]);
            float ur = 0.f, ui = 0.f;
#pragma unroll
            for (int i = 0; i < 16; ++i) { ur += bbr[i] * x[i]; ui += bbi[i] * x[i]; }
            const float nr = ar * sr - ai * si + ur, ni = ar * si + ai * sr + ui; sr = nr; si = ni;
#pragma unroll
            for (int o = 0; o < 16; ++o) {
                const float yr = wave_sum(ccr[o] * sr - cci[o] * si);
                const float yf = DY[(size_t)t * 1024 + g * 16 + o];
                err += (yf - yr) * (yf - yr); ref += yr * yr;
            }
        }
        if (lane == 0 && !(err <= 2e-3f * ref)) __hip_atomic_fetch_or((unsigned*)(F.ws + WS_CTL) + CW_FLAG, 1u, RLX_AGENT);
    }
}
#endif

__device__ __forceinline__ unsigned f2key(float v) { const unsigned u = __builtin_bit_cast(unsigned, v); return (u & 0x80000000u) ? ~u : (u | 0x80000000u); }
__device__ __forceinline__ float key2f(unsigned k) { const unsigned u = (k & 0x80000000u) ? (k & 0x7fffffffu) : ~k; return __builtin_bit_cast(float, u); }
__device__ __forceinline__ void sort16_desc(unsigned (&v)[16]) {
#pragma unroll
    for (int lk = 1; lk <= 4; ++lk) {
#pragma unroll
        for (int lj = lk - 1; lj >= 0; --lj) {
#pragma unroll
            for (int i = 0; i < 16; ++i) { const int k = 1 << lk, j = 1 << lj, p = i ^ j;
                if (p > i) { const unsigned a = v[i], c = v[p], hi = a > c ? a : c, lo = a > c ? c : a; const bool desc = ((i & k) == 0) || (k == 16);
                    v[i] = desc ? hi : lo; v[p] = desc ? lo : hi; } }
        }
    }
}
__device__ __forceinline__ void merge16_desc(unsigned (&v)[16], const unsigned (&w)[16]) {
#pragma unroll
    for (int i = 0; i < 16; ++i) v[i] = v[i] > w[15 - i] ? v[i] : w[15 - i];
#pragma unroll
    for (int lj = 3; lj >= 0; --lj) {
#pragma unroll
        for (int i = 0; i < 16; ++i) { const int j = 1 << lj, p = i ^ j;
            if (p > i) { const unsigned a = v[i], c = v[p]; v[i] = a > c ? a : c; v[p] = a > c ? c : a; } }
    }
}
__device__ __forceinline__ void xmerge16(unsigned (&v)[16], int mask) {
    unsigned w[16];
#pragma unroll
    for (int i = 0; i < 16; ++i) w[i] = (unsigned)__shfl_xor((int)v[i], mask);
    merge16_desc(v, w);
}
__device__ __forceinline__ void phase_topk(Frame& F, int l) {
    PH_LOCALS
    const bf16* Q = (const bf16*)(F.ws + WS_Z);
    const bf16* KB = (const bf16*)(F.ws + WS_KEYS) + (size_t)l * 8 * 2 * 128 * 128;
    int* EID = (int*)(F.ws + WS_EID); float* GT = (float*)(F.ws + WS_GATE); float* SUo = (float*)(F.ws + WS_SU);
    const float* SCL = (const float*)(F.ws + WS_SCL) + (size_t)l * NEXP * 2;
    LAS unsigned char* KL = F.lds;
    LAS unsigned* LST = (LAS unsigned*)(F.lds + 69632);
    LAS unsigned char* PT = F.lds + 69632 + 16384;
    const int fr = lane & 15, fq = lane >> 4;
    {
        int c = 0;
#pragma unroll
        for (int i = 0; i < 16; ++i)
#pragma unroll
            for (int j = 0; j < 16; ++j) if ((i + 1) * (j + 1) <= 16) { if (tid == c) PT[c] = (unsigned char)(i * 16 + j); ++c; }
    }
    int cur_hh = -1;
    for (int u = F.vcu; u < 1024; u += F.G) {
        const int tt = u >> 3, hh = u & 7, t0 = tt * 128;
        bf16x8 qf[2][4];
#pragma unroll
        for (int s = 0; s < 2; ++s)
#pragma unroll
            for (int kb = 0; kb < 4; ++kb) qf[s][kb] = *(const bf16x8*)(Q + (size_t)(t0 + 16 * wave + fr) * 2048 + hh * 256 + s * 128 + kb * 32 + 8 * fq);
        if (hh != cur_hh) {
            __syncthreads();
#pragma unroll
            for (int ps = 0; ps < 8; ++ps) { const int idx = ps * 512 + tid, row = idx >> 4, c16 = idx & 15;
                *(LAS u32x4*)(KL + row * 272 + c16 * 16) = *(const u32x4*)(KB + ((size_t)(hh * 256 + row)) * 128 + c16 * 8); }
            cur_hh = hh;
            __syncthreads();
        }
#pragma unroll 1
        for (int s = 0; s < 2; ++s) {
            f32x4 acc[8];
#pragma unroll
            for (int nt = 0; nt < 8; ++nt) acc[nt] = (f32x4){0.f, 0.f, 0.f, 0.f};
#pragma unroll
            for (int kb = 0; kb < 4; ++kb) { const bf16x8 q = s ? qf[1][kb] : qf[0][kb];
#pragma unroll
                for (int nt = 0; nt < 8; ++nt) { const bf16x8 kf = *(const LAS bf16x8*)(KL + (s * 128 + nt * 16 + fr) * 272 + (kb * 32 + 8 * fq) * 2);
                    acc[nt] = __builtin_amdgcn_mfma_f32_16x16x32_bf16(kf, q, acc[nt], 0, 0, 0); } }
            unsigned va[16], vb[16];
#pragma unroll
            for (int nt = 0; nt < 4; ++nt)
#pragma unroll
                for (int r = 0; r < 4; ++r) { va[4 * nt + r] = (f2key(acc[nt][r]) & ~0x7Fu) | (unsigned)(127 - (nt * 16 + 4 * fq + r));
                    vb[4 * nt + r] = (f2key(acc[4 + nt][r]) & ~0x7Fu) | (unsigned)(127 - ((4 + nt) * 16 + 4 * fq + r)); }
            sort16_desc(va); sort16_desc(vb); merge16_desc(va, vb);
            xmerge16(va, 16); xmerge16(va, 32);
            if (fq == 0) {
#pragma unroll
                for (int k = 0; k < 16; k += 4) *(LAS u32x4*)(LST + ((16 * wave + fr) * 2 + s) * 16 + k) = (u32x4){va[k], va[k + 1], va[k + 2], va[k + 3]};
            }
        }
        asm volatile("s_waitcnt lgkmcnt(0)" ::: "memory");
        {
            const int tl = 16 * wave + (lane >> 2), c4 = lane & 3;
            unsigned v[16];
#pragma unroll
            for (int m = 0; m < 13; ++m) { const int c = m * 4 + c4; unsigned key = 0u;
                if (c < 50) { const int pij = PT[c], i = pij >> 4, j = pij & 15;
                    const float av = key2f(LST[(tl * 2 + 0) * 16 + i] & ~0x7Fu), bv = key2f(LST[(tl * 2 + 1) * 16 + j] & ~0x7Fu);
                    key = (f2key(av + bv) & ~0xFFu) | (unsigned)(255 - pij); }
                v[m] = key; }
#pragma unroll
            for (int m = 13; m < 16; ++m) v[m] = 0u;
            sort16_desc(v);
            xmerge16(v, 1); xmerge16(v, 2);
            float ev[16]; float sum = 0.f; const float mx = key2f(v[0] & ~0xFFu);
#pragma unroll
            for (int k = 0; k < 16; ++k) { ev[k] = __expf(key2f(v[k] & ~0xFFu) - mx); sum += ev[k]; }
            const float inv = 1.0f / sum;
            unsigned kk[4] = {v[0], v[1], v[2], v[3]}; float ee[4] = {ev[0], ev[1], ev[2], ev[3]};
#pragma unroll
            for (int q = 1; q < 4; ++q) { if (c4 == q) {
#pragma unroll
                for (int e = 0; e < 4; ++e) { kk[e] = v[4 * q + e]; ee[e] = ev[4 * q + e]; } } }
            const size_t ob = (size_t)(t0 + tl) * 128 + hh * 16 + 4 * c4;
            int eo[4]; float go[4], so[4];
#pragma unroll
            for (int e = 0; e < 4; ++e) { const int flat = 255 - (int)(kk[e] & 0xFFu), i = flat >> 4, j = flat & 15;
                const int ia = 127 - (int)(LST[(tl * 2 + 0) * 16 + i] & 0x7Fu), ib = 127 - (int)(LST[(tl * 2 + 1) * 16 + j] & 0x7Fu);
                eo[e] = ia * 128 + ib; }
#pragma unroll
            for (int e = 0; e < 4; ++e) { const f32x2 sc = *(const f32x2*)(SCL + 2 * eo[e]); go[e] = ee[e] * inv * sc.y; so[e] = sc.x; }
            *(u32x4*)(EID + ob) = (u32x4){(unsigned)eo[0], (unsigned)eo[1], (unsigned)eo[2], (unsigned)eo[3]};
            *(f32x4*)(GT + ob) = (f32x4){go[0], go[1], go[2], go[3]};
            *(f32x4*)(SUo + ob) = (f32x4){so[0], so[1], so[2], so[3]};
        }
        asm volatile("s_waitcnt lgkmcnt(0)" ::: "memory");
    }
    __syncthreads();
}

#define FP4X4(w, f0, f1, f2, f3) do { f0 = __builtin_amdgcn_cvt_scalef32_pk_f32_fp4((w), 1.0f, 0); f1 = __builtin_amdgcn_cvt_scalef32_pk_f32_fp4((w), 1.0f, 1); \
    f2 = __builtin_amdgcn_cvt_scalef32_pk_f32_fp4((w), 1.0f, 2); f3 = __builtin_amdgcn_cvt_scalef32_pk_f32_fp4((w), 1.0f, 3); } while (0)
__device__ __forceinline__ void phase_gather(Frame& F, int l, bool dummy = false) {
    PH_LOCALS
    const int gw = F.vcu * NWAVES + wave, NGW = F.G * NWAVES;
    bf16* Hn = dummy ? (bf16*)(F.ws + WS_DBG + 128 * MiB) : (bf16*)(F.ws + WS_H);
    const unsigned char* UT = F.ws + WS_UV + (size_t)l * NEXP * 2048;
    const unsigned char* VTb = UT + (size_t)NEXP * 1024;
    const int* EID = (const int*)(F.ws + WS_EID); const float* GT = (const float*)(F.ws + WS_GATE); const float* SU = (const float*)(F.ws + WS_SU);
    float* COEF = dummy ? (float*)(F.ws + WS_DBG + 192 * MiB) : (float*)(F.ws + WS_COEF);
    const bf16* X = (const bf16*)(F.ws + WS_X); bf16* Xo = dummy ? (bf16*)(F.ws + WS_DBG) : (bf16*)(F.ws + WS_X);
    const float* mod = (const float*)(F.ws + WS_MOD);
    const float* gate2 = mod + l * 12288 + 5 * 2048; const float* shift2 = mod + l * 12288 + 3 * 2048; const float* gs2 = (const float*)(F.ws + WS_GS) + l * DM;
    const unsigned lane16 = (unsigned)lane * 16u;
    const bool u32_ = (lane & 32) != 0, u16_ = (lane & 16) != 0, u8_ = (lane & 8) != 0, u4_ = (lane & 4) != 0;
#if GATHER_PROBE_HOT
#define G_HOT(e) if (dummy) e &= 15;
#else
#define G_HOT(e)
#endif
#define G_ROW(dst, tab, b_, h_) do { int e_ = __builtin_amdgcn_readlane((b_) < 4 ? e_lo : e_hi, (16 * (b_) + (h_)) & 63); G_HOT(e_) \
            dst = *(const u32x4*)((tab) + ((size_t)(unsigned)e_ << 10) + lane16); } while (0)
    for (int t = gw; t < M; t += NGW) {
        const int e_lo = EID[(size_t)t * 128 + lane], e_hi = EID[(size_t)t * 128 + 64 + lane];
        const float g_lo = GT[(size_t)t * 128 + lane], g_hi = GT[(size_t)t * 128 + 64 + lane];
        const float s_lo = SU[(size_t)t * 128 + lane], s_hi = SU[(size_t)t * 128 + 64 + lane];
        f32x2 hh[8][2];
        {   float s2 = 0.f; u32x2 xw[8];
#pragma unroll
            for (int j = 0; j < 8; ++j) xw[j] = *(const u32x2*)(X + (size_t)t * 2048 + j * 256 + lane * 4);
#pragma unroll
            for (int j = 0; j < 8; ++j) { hh[j][0] = (f32x2){bflo(xw[j].x), bfhi(xw[j].x)}; hh[j][1] = (f32x2){bflo(xw[j].y), bfhi(xw[j].y)};
                s2 += (hh[j][0].x * hh[j][0].x + hh[j][0].y * hh[j][0].y) + (hh[j][1].x * hh[j][1].x + hh[j][1].y * hh[j][1].y); }
            const float r2 = 1.0f / sqrtf(wave_sum(s2) * (1.0f / DM) + EPS);
#pragma unroll
            for (int j2 = 0; j2 < 8; j2 += 4) { f32x4 gsv[4], shv[4];
#pragma unroll
                for (int j = 0; j < 4; ++j) { gsv[j] = *(const f32x4*)(gs2 + (j2 + j) * 256 + lane * 4); shv[j] = *(const f32x4*)(shift2 + (j2 + j) * 256 + lane * 4); }
#pragma unroll
                for (int j = 0; j < 4; ++j) { hh[j2 + j][0] = (f32x2){hh[j2 + j][0].x * r2 * gsv[j][0] + shv[j][0], hh[j2 + j][0].y * r2 * gsv[j][1] + shv[j][1]}; hh[j2 + j][1] = (f32x2){hh[j2 + j][1].x * r2 * gsv[j][2] + shv[j][2], hh[j2 + j][1].y * r2 * gsv[j][3] + shv[j][3]}; } }
        }
        u32x4 ur[16];
#pragma unroll
        for (int h = 0; h < 16; ++h) G_ROW(ur[h], UT, 0, h);
#define G_UBATCH(b_, NEXT) { float p[16]; \
            _Pragma("unroll") for (int h = 0; h < 16; ++h) { f32x2 a2 = {0.f, 0.f}; \
                if (GATHER_PROBE_MEM && dummy) { a2.x = __builtin_bit_cast(float, ur[h][0] ^ ur[h][1] ^ ur[h][2] ^ ur[h][3]); } else { \
                _Pragma("unroll") for (int d = 0; d < 4; ++d) { f32x2 f0, f1, f2, f3; FP4X4(ur[h][d], f0, f1, f2, f3); \
                    a2 = f0 * hh[2 * d][0] + a2; a2 = f1 * hh[2 * d][1] + a2; a2 = f2 * hh[2 * d + 1][0] + a2; a2 = f3 * hh[2 * d + 1][1] + a2; } } \
                p[h] = a2.x + a2.y; if (NEXT) G_ROW(ur[h], UT, (b_) + 1, h); } \
            float a8[8]; \
            _Pragma("unroll") for (int i = 0; i < 8; ++i) { const float snd = u32_ ? p[i] : p[8 + i], kp = u32_ ? p[8 + i] : p[i]; a8[i] = kp + __shfl_xor(snd, 32); } \
            float a4[4]; \
            _Pragma("unroll") for (int i = 0; i < 4; ++i) { const float snd = u16_ ? a8[i] : a8[4 + i], kp = u16_ ? a8[4 + i] : a8[i]; a4[i] = kp + __shfl_xor(snd, 16); } \
            float b2[2]; \
            _Pragma("unroll") for (int i = 0; i < 2; ++i) { const float snd = u8_ ? a4[i] : a4[2 + i], kp = u8_ ? a4[2 + i] : a4[i]; b2[i] = kp + __shfl_xor(snd, 8); } \
            float d; { const float snd = u4_ ? b2[0] : b2[1], kp = u4_ ? b2[1] : b2[0]; d = kp + __shfl_xor(snd, 4); } \
            d += __shfl_xor(d, 2); d += __shfl_xor(d, 1);                   \
            const int hl = (16 * (b_) + (lane >> 2)) & 63; const float gsel = (b_) < 4 ? g_lo : g_hi, ssel = (b_) < 4 ? s_lo : s_hi; \
            const float coefq = __shfl(gsel, hl) * gelu_tanh(d * __shfl(ssel, hl)); \
            if ((lane & 3) == 0) COEF[(size_t)t * 128 + 16 * (b_) + (lane >> 2)] = coefq; }
#pragma unroll 1
        for (int b = 0; b < 7; ++b) G_UBATCH(b, true)
        G_UBATCH(7, false)
#undef G_UBATCH
    }
    asm volatile("s_waitcnt vmcnt(0)" ::: "memory");
    for (int t = gw; t < M; t += NGW) {
        const int e_lo = EID[(size_t)t * 128 + lane], e_hi = EID[(size_t)t * 128 + 64 + lane];
        const float c_lo = COEF[(size_t)t * 128 + lane], c_hi = COEF[(size_t)t * 128 + 64 + lane];
        u32x4 vr[16];
#pragma unroll
        for (int h = 0; h < 16; ++h) G_ROW(vr[h], VTb, 0, h);
        f32x2 of[8][2];
#pragma unroll
        for (int j = 0; j < 8; ++j) { of[j][0] = (f32x2){0.f, 0.f}; of[j][1] = (f32x2){0.f, 0.f}; }
#define G_VBATCH(b_, NEXT) { const float csel = (b_) < 4 ? c_lo : c_hi; \
            _Pragma("unroll") for (int h = 0; h < 16; ++h) { const float cf = __builtin_bit_cast(float, __builtin_amdgcn_readlane(__builtin_bit_cast(int, csel), (16 * (b_) + h) & 63)); const f32x2 cf2 = {cf, cf}; \
                if (GATHER_PROBE_MEM && dummy) { of[0][0].x += cf * __builtin_bit_cast(float, vr[h][0] ^ vr[h][1] ^ vr[h][2] ^ vr[h][3]); } else { \
                _Pragma("unroll") for (int dd = 0; dd < 4; ++dd) { f32x2 f0, f1, f2, f3; FP4X4(vr[h][dd], f0, f1, f2, f3); \
                    of[2 * dd][0] = f0 * cf2 + of[2 * dd][0]; of[2 * dd][1] = f1 * cf2 + of[2 * dd][1]; of[2 * dd + 1][0] = f2 * cf2 + of[2 * dd + 1][0]; of[2 * dd + 1][1] = f3 * cf2 + of[2 * dd + 1][1]; } } \
                if (NEXT) G_ROW(vr[h], VTb, (b_) + 1, h); } }
#pragma unroll 1
        for (int b = 0; b < 7; ++b) G_VBATCH(b, true)
        G_VBATCH(7, false)
#undef G_VBATCH
        int ln = lane; asm volatile("" : "+v"(ln));
        u32x2 cx[8];
#pragma unroll
        for (int j = 0; j < 8; ++j) cx[j] = *(const u32x2*)(X + (size_t)t * 2048 + j * 256 + ln * 4);
        f32x4 xv[8]; float ss = 0.f;
#pragma unroll
        for (int j2 = 0; j2 < 8; j2 += 4) { f32x4 g2v[4];
#pragma unroll
            for (int j = 0; j < 4; ++j) g2v[j] = *(const f32x4*)(gate2 + (j2 + j) * 256 + ln * 4);
#pragma unroll
            for (int jj = 0; jj < 4; ++jj) { const int j = j2 + jj;
                const f32x4 xo = {bflo(cx[j].x), bfhi(cx[j].x), bflo(cx[j].y), bfhi(cx[j].y)};
                const f32x4 o = {of[j][0].x, of[j][0].y, of[j][1].x, of[j][1].y};
                xv[j] = xo + g2v[jj] * o;
                ss += (xv[j][0] * xv[j][0] + xv[j][1] * xv[j][1]) + (xv[j][2] * xv[j][2] + xv[j][3] * xv[j][3]); } }
        const float rr = 1.0f / sqrtf(wave_sum(ss) * (1.0f / DM) + EPS);
        if (l + 1 < DEPTH) {
            const float* m2 = mod + (l + 1) * 12288; const float* gain = F.in[I_N1G] + (l + 1) * 2048;
#pragma unroll
            for (int j2 = 0; j2 < 8; j2 += 4) { f32x4 gv[4], scv[4], shv[4];
#pragma unroll
                for (int j = 0; j < 4; ++j) { const int c = (j2 + j) * 256 + ln * 4; gv[j] = *(const f32x4*)(gain + c); scv[j] = *(const f32x4*)(m2 + 2048 + c); shv[j] = *(const f32x4*)(m2 + c); }
#pragma unroll
                for (int jj = 0; jj < 4; ++jj) { const int j = j2 + jj, c = j * 256 + ln * 4;
                    *(u32x2*)(Xo + (size_t)t * 2048 + c) = (u32x2){pk2(xv[j][0], xv[j][1]), pk2(xv[j][2], xv[j][3])};
                    const f32x4 y = xv[j] * rr * gv[jj] * (scv[jj] + 1.0f) + shv[jj];
                    *(u32x2*)(Hn + (size_t)t * 2048 + c) = (u32x2){pk2(y[0], y[1]), pk2(y[2], y[3])}; } }
        } else {
#pragma unroll
            for (int j = 0; j < 8; ++j) { const int c = j * 256 + ln * 4; const f32x4 fgv = *(const f32x4*)(F.in[I_FG] + c);
                f32x4 ov = xv[j] * rr * fgv;
#if SELFTEST_S5
                if (__hip_atomic_load((unsigned*)(F.ws + WS_CTL) + CW_FLAG, RLX_AGENT) != 0u) ov = (f32x4){1e30f, 1e30f, 1e30f, 1e30f};
#endif
                *(f32x4*)(F.out + (size_t)t * 2048 + c) = ov; }
        }
    }
}

__global__ void __launch_bounds__(NTHR, 2) fwd_kernel(Args args) {
    extern __shared__ __attribute__((aligned(16))) unsigned char lds_raw[];
    Frame F;
    F.lds = (LAS unsigned char*)lds_raw; F.ws = args.ws; F.in = args.in; F.out = args.out;
    F.tid = threadIdx.x; F.lane = F.tid & 63; F.wave = __builtin_amdgcn_readfirstlane(F.tid >> 6);
    F.G = gridDim.x; { const int bx = blockIdx.x; F.vcu = (F.G % 8 == 0) ? (bx % 8) * (F.G / 8) + bx / 8 : bx; }
    volatile LAS unsigned* MISC = (volatile LAS unsigned*)(F.lds + MISC_OFF);
    if (F.tid < 64) MISC[F.tid] = 0u;
    __syncthreads();
    unsigned* ctl = (unsigned*)(F.ws + WS_CTL);
    XcdBarrier bar; bar.bar = ctl + CW_BAR; bar.x = 0; bar.st = nullptr;
#if !MK_PER_PHASE
    bar = xcd_barrier_post(ctl + CW_BAR, MISC + 8);
#endif
    const int lo = args.ph_lo, hi = args.ph_hi;
#define IN(k) (lo <= (k) && (k) < hi)
#if MK_PER_PHASE
#define SEAM(k) do { } while (0)
#else
#define SEAM(k) do { if (IN(k) && IN((k) + 1)) xcd_barrier(bar); } while (0)
#endif
    const float* mod = (const float*)(F.ws + WS_MOD);

#define REP(k) (REPEAT_PH == (k))
#define RUN2(k, first, real) do { if (REP(k)) { first; xcd_barrier(bar); } real; } while (0)
    if (IN(0)) { RUN2(13, p0_tables(F, 5, true), p0_tables(F, 4, false)); } SEAM(0);
    for (int l = 0; l < DEPTH; ++l) {
        const int pb = 1 + 12 * l;
        const float* ml = mod + l * 12288;
        if (IN(pb + 0)) { if (l == 0) { RUN2(0, p0_prologue(F), p0_prologue(F)); RUN2(1, phase_norm<false>(F, F.in[I_X], F.in[I_N1G] + l * 2048, ml + 1 * 2048, ml + 0 * 2048), phase_norm<false>(F, F.in[I_X], F.in[I_N1G] + l * 2048, ml + 1 * 2048, ml + 0 * 2048)); } } SEAM(pb + 0);
        if (IN(pb + 1)) {
            pg8::Gemm g{(const bf16*)(F.ws + WS_H), (const bf16*)(F.ws + WS_WIN) + (size_t)l * INW * DM, M, INW, DM}; pg8::StaticOrder S; S.init(M, INW, F.G, (int)blockIdx.x);
            EpiIn E{(bf16*)(F.ws + WS_Z), (bf16*)(F.ws + WS_XS), F.in[I_BIN] + l * INW, (float*)(F.ws + WS_PLN)};
#define GEMM_IN pg8::gemm_phase<EpiIn, pg8::StaticOrder, true, true>(F.lds, g, S, E)
            RUN2(2, GEMM_IN, GEMM_IN);
        } SEAM(pb + 1);
        if (IN(pb + 2)) { RUN2(3, phase_sloc(F, l), phase_sloc(F, l)); } SEAM(pb + 2);
        if (IN(pb + 3)) { RUN2(5, phase_s5out(F, l), phase_s5out(F, l)); RUN2(4, phase_gating(F, l), phase_gating(F, l));
#if SELFTEST_S5
            xcd_barrier(bar); selftest_s5(F, l);
#endif
        } SEAM(pb + 4);
        if (IN(pb + 5)) {
            pg8::Gemm g{(const bf16*)(F.ws + WS_G), (const bf16*)(F.ws + WS_GLU) + (size_t)l * WB * WB, M, WB, WB}; pg8::StaticOrder S; S.init(M, WB, F.G, (int)blockIdx.x);
            EpiGlu E{(const bf16*)(F.ws + WS_G), (bf16*)(F.ws + WS_MIX), F.in[I_GLUB] + l * WB, (float*)(F.ws + WS_PSB)};
#define GEMM_GLU pg8::gemm_phase<EpiGlu, pg8::StaticOrder, true, true>(F.lds, g, S, E)
            RUN2(6, GEMM_GLU, GEMM_GLU);
        } SEAM(pb + 6);
        if (IN(pb + 7)) {
            pg8::Gemm g{(const bf16*)(F.ws + WS_MIX), (const bf16*)(F.ws + WS_WOUT) + (size_t)l * DM * DM, M, DM, DM}; pg8::StaticOrder S; S.init(M, DM, F.G, (int)blockIdx.x);
            LAS float* ratL = (LAS float*)(F.lds + 132096); LAS float* rbL = (LAS float*)(F.lds + 134144);
            pg8::Unit u0, u1; const bool h0 = S.next(0, u0), h1 = S.next(1, u1);
            {   int t2 = F.tid; asm volatile("" : "+v"(t2));
                for (int sl = 0; sl < 2; ++sl) { const bool on = sl == 0 ? h0 : (h1 && u1.pm != u0.pm); const int pmx = sl == 0 ? u0.pm : u1.pm;
                    if (on && t2 < 256) { const size_t row = (size_t)pmx * 256 + t2; float sa = 0.f, sb = 0.f;
                        const float* pa = (const float*)(F.ws + WS_PSA) + row * 8; const float* pb_ = (const float*)(F.ws + WS_PSB) + row * 16;
#pragma unroll
                        for (int i = 0; i < 2; ++i) { const f32x4 v = *(const f32x4*)(pa + 4 * i); sa += (v[0] + v[1]) + (v[2] + v[3]); }
#pragma unroll
                        for (int i = 0; i < 4; ++i) { const f32x4 v = *(const f32x4*)(pb_ + 4 * i); sb += (v[0] + v[1]) + (v[2] + v[3]); }
                        const float ra = 1.0f / sqrtf(sa * (1.0f / 1024.0f) + EPS), rb = 1.0f / sqrtf(sb * (1.0f / 1024.0f) + EPS);
                        ratL[sl * 256 + t2] = ra / rb; rbL[sl * 256 + t2] = rb; } } }
            __syncthreads();
            const int pm0 = h0 ? u0.pm : -1;
            if (l == 0) { EpiOut<false> E{(const void*)F.in[I_X], (bf16*)(F.ws + WS_X), ml + 2 * 2048, (float*)(F.ws + WS_PS), ratL, rbL, pm0}; EpiOut<false> Ed{(const void*)F.in[I_X], (bf16*)(F.ws + WS_DBG), ml + 2 * 2048, (float*)(F.ws + WS_DBG + 128 * MiB), ratL, rbL, pm0};
#define GEMM_OUT0(EE) pg8::gemm_phase<EpiOut<false>, pg8::StaticOrder, true, true>(F.lds, g, S, EE)
                RUN2(8, GEMM_OUT0(Ed), GEMM_OUT0(E)); }
            else { EpiOut<true> E{(const void*)(F.ws + WS_X), (bf16*)(F.ws + WS_X), ml + 2 * 2048, (float*)(F.ws + WS_PS), ratL, rbL, pm0}; EpiOut<true> Ed{(const void*)(F.ws + WS_X), (bf16*)(F.ws + WS_DBG), ml + 2 * 2048, (float*)(F.ws + WS_DBG + 128 * MiB), ratL, rbL, pm0};
#define GEMM_OUT1(EE) pg8::gemm_phase<EpiOut<true>, pg8::StaticOrder, true, true>(F.lds, g, S, EE)
                RUN2(8, GEMM_OUT1(Ed), GEMM_OUT1(E)); }
        }
        SEAM(pb + 8);
        if (IN(pb + 9)) {
            pg8::Gemm g{(const bf16*)(F.ws + WS_X), (const bf16*)(F.ws + WS_WQ) + (size_t)l * DM * DM, M, DM, DM}; pg8::StaticOrder S; S.init(M, DM, F.G, (int)blockIdx.x);
            LAS float* rrL = (LAS float*)(F.lds + 132096);
            pg8::Unit u0, u1; const bool h0 = S.next(0, u0), h1 = S.next(1, u1);
            { int t2 = F.tid; asm volatile("" : "+v"(t2)); if (h0) fill_rr(F, rrL, 0, u0.pm, t2); if (h1 && u1.pm != u0.pm) fill_rr(F, rrL, 1, u1.pm, t2); }
            __syncthreads();
            EpiQ E{(bf16*)(F.ws + WS_Z), (const float*)(F.ws + WS_C0) + l * DM, rrL, h0 ? u0.pm : -1};
#define GEMM_Q pg8::gemm_phase<EpiQ, pg8::StaticOrder, true, true>(F.lds, g, S, E)
            RUN2(10, GEMM_Q, GEMM_Q);
        } SEAM(pb + 9);
        if (IN(pb + 10)) { RUN2(11, phase_topk(F, l), phase_topk(F, l)); } SEAM(pb + 10);
        if (IN(pb + 11)) { RUN2(12, phase_gather(F, l, true), phase_gather(F, l, false)); } SEAM(pb + 11);
    }
#undef IN
#undef SEAM
}

extern "C" void kernel_launch(void* const* d_in, const int* in_sizes, int n_in, void* d_out, int out_size, void* d_ws, size_t ws_size, hipStream_t stream) {
    static int grid = 0;
    if (grid == 0) {
        if (n_in != 29 || out_size != M * DM || ws_size < WS_END) { fprintf(stderr, "kernel_launch: unexpected shapes (n_in %d, out %d, ws %zu); nothing launched\n", n_in, out_size, ws_size); grid = -1; return; }
        int dev = 0, cus = 0;
        if (hipGetDevice(&dev) != hipSuccess || hipDeviceGetAttribute(&cus, hipDeviceAttributeMultiprocessorCount, dev) != hipSuccess) { grid = -1; return; }
        if (hipFuncSetAttribute((const void*)fwd_kernel, hipFuncAttributeMaxDynamicSharedMemorySize, LDS_BYTES) != hipSuccess) { fprintf(stderr, "kernel_launch: hipFuncSetAttribute failed\n"); grid = -1; return; }
        (void)hipGetLastError();
        grid = cus;
    }
    if (grid < 0) return;
    (void)hipMemsetAsync((char*)d_ws + WS_CTL, 0, CTL_ZERO_BYTES, stream);
    Args a{};
    for (int i = 0; i < 29; ++i) a.in[i] = (const float*)d_in[i];
    a.out = (float*)d_out; a.ws = (unsigned char*)d_ws;
#if MK_PER_PHASE
    for (int p = 0; p < 1 + 12 * DEPTH; ++p) {
        if (p == 13) continue;
        a.ph_lo = p; a.ph_hi = p + 1; a.li = p;
        hipLaunchKernelGGL(fwd_kernel, dim3(grid), dim3(NTHR), LDS_BYTES, stream, a);
    }
#else
    a.ph_lo = 0; a.ph_hi = 1 + 12 * DEPTH; a.li = 0;
    hipLaunchKernelGGL(fwd_kernel, dim3(grid), dim3(NTHR), LDS_BYTES, stream, a);
#endif
}
```

```cpp
#include <hip/hip_runtime.h>
#include <cstdio>
#include <cstdint>

#ifndef SELFTEST_S5
#define SELFTEST_S5 0
#endif
#ifndef REPEAT_PH
#define REPEAT_PH -1
#endif
#ifndef GATHER_PROBE_MEM
#define GATHER_PROBE_MEM 0
#endif
#ifndef GATHER_PROBE_HOT
#define GATHER_PROBE_HOT 0
#endif
#ifndef MK_PER_PHASE
#define MK_PER_PHASE 0
#endif

#define GAS __attribute__((address_space(1)))
#define LAS __attribute__((address_space(3)))
typedef unsigned short bf16;
typedef short bf16x8 __attribute__((ext_vector_type(8)));
typedef float f32x4 __attribute__((ext_vector_type(4)));
typedef float f32x2 __attribute__((ext_vector_type(2)));
typedef unsigned u32x4 __attribute__((ext_vector_type(4)));
typedef unsigned u32x2 __attribute__((ext_vector_type(2)));

constexpr int DM = 2048, SEQ = 16384, DEPTH = 2, M = SEQ;
constexpr int WA = 1024, WB = 1024, INW = 3072;
constexpr int NG = 64, NCH = 256;
constexpr int NEXP = 16384;
constexpr float EPS = 1e-6f;
constexpr int NWAVES = 8, NTHR = 512;

namespace pg8 {
#define PG8_LAS __attribute__((address_space(3)))
constexpr int BM = 256, BK = 64, HALF = 128, HTB = HALF * BK * 2, STAGE_BYTES = 8 * HTB, NXCD = 8, WGM = 8;
__host__ __device__ __forceinline__ int lds_byte(int r, int c) { const int st = (r >> 4) * 2 + (c >> 5), rr = r & 15, cc = c & 31, ob = rr * 64 + cc * 2; return st * 1024 + (ob ^ (((ob >> 9) & 1) << 5)); }
__host__ __device__ __forceinline__ void stage_rc(int b, int& R, int& C) { const int st = b / 1024, sb = b % 1024, swz = sb ^ (((sb >> 9) & 1) << 5); R = (st >> 1) * 16 + swz / 64; C = (st & 1) * 32 + (swz % 64) / 2; }
__host__ __device__ __forceinline__ int perm32(int rho) { const int n = rho >> 4, i = rho & 15; return 8 * (i >> 2) + 4 * n + (i & 3); }
struct Unit { int pm, pn; };
struct Gemm { const bf16* A; const bf16* Bt; int M, N, K; };
struct StaticOrder {
    int nM, nN, nwg, G, c;
    __host__ __device__ void init(int M_, int N_, int G_, int c_) { nM = M_ / BM; nN = N_ / BM; nwg = nM * nN; G = G_; c = c_; }
    __host__ __device__ bool next(int i, Unit& u) const {
        const long L = (long)i * G + c; if (L >= nwg) return false;
        int wgid = (int)L; { const int q = nwg / NXCD, r = nwg % NXCD, xcd = wgid % NXCD, off = wgid / NXCD; wgid = (xcd < r ? xcd * (q + 1) : r * (q + 1) + (xcd - r) * q) + off; }
        const int nig = WGM * nN, gid = wgid / nig, fm = gid * WGM, gsz = (nM - fm) < WGM ? (nM - fm) : WGM;
        u.pm = fm + ((wgid % nig) % gsz); u.pn = (wgid % nig) / gsz; return true;
    }
    __device__ __forceinline__ void a_ready(const Unit&) const {}
    __device__ __forceinline__ void done(const Unit&) const {}
};
__device__ __forceinline__ unsigned cvt_pk_bf16(float lo, float hi) { unsigned r; asm volatile("v_cvt_pk_bf16_f32 %0, %1, %2" : "=v"(r) : "v"(lo), "v"(hi)); return r; }

template <class Epi, class Sched, bool ALIGN_EPI = false, bool SP2 = false>
__device__ __forceinline__ void gemm_phase(PG8_LAS unsigned char* lds, const Gemm g, const Sched& S, const Epi& E) {
    int tid = threadIdx.x; asm volatile("" : "+v"(tid)); const int wid = __builtin_amdgcn_readfirstlane(tid >> 6), lane = tid & 63, wr = wid >> 2, wc = wid & 3, fr = lane & 15, fq = lane >> 4;
    const int K = g.K, nt = K / BK;
    unsigned voffA[2], voffB[2];
#pragma unroll
    for (int i = 0; i < 2; ++i) { int R, C; stage_rc(tid * 16 + i * 8192, R, C); const int Rb = Epi::PERM ? ((R & ~31) + perm32(R & 31)) : R;
        voffA[i] = (unsigned)(R * K + C) * 2u; voffB[i] = (unsigned)(Rb * K + C) * 2u; }
    const size_t kstep = (size_t)(BK * 2);
    const size_t hstep = (size_t)HALF * K * 2;
    const size_t tstep = 2 * hstep;
    const unsigned ldsw = (unsigned)wid * 1024u;
    const int aoff = lds_byte(wr * 64 + fr, fq * 8), boff = lds_byte(wc * 32 + fr, fq * 8);
#define PG8_SA(b, h) (((b) * 2 + (h)) * HTB)
#define PG8_SB(b, h) ((4 + (b) * 2 + (h)) * HTB)
#define PG8_STAGE(bufoff, gbase, voff) do { _Pragma("unroll") for (int _i = 0; _i < 2; ++_i) \
        __builtin_amdgcn_global_load_lds((const unsigned*)((const char*)(gbase) + (voff)[_i]), (PG8_LAS unsigned*)(lds + (bufoff) + ldsw + _i * 8192), 16, 0, 0); } while (0)
#define PG8_LDA(dst, b, h) do { _Pragma("unroll") for (int m = 0; m < 4; ++m) _Pragma("unroll") for (int k = 0; k < 2; ++k) dst[m][k] = *(const PG8_LAS bf16x8*)(lds + PG8_SA(b, h) + aoff + m * 2048 + k * 1024); } while (0)
#define PG8_LDB(dst, b, h) do { _Pragma("unroll") for (int n = 0; n < 2; ++n) _Pragma("unroll") for (int k = 0; k < 2; ++k) dst[n][k] = *(const PG8_LAS bf16x8*)(lds + PG8_SB(b, h) + boff + n * 2048 + k * 1024); } while (0)
#define PG8_MMA(ai, bj, At, Bt) do { __builtin_amdgcn_s_setprio(1); _Pragma("unroll") for (int m = 0; m < 4; ++m) _Pragma("unroll") for (int n = 0; n < 2; ++n) _Pragma("unroll") for (int k = 0; k < 2; ++k) \
        acc[ai][bj][m][n] = __builtin_amdgcn_mfma_f32_16x16x32_bf16(Bt[n][k], At[m][k], acc[ai][bj][m][n], 0, 0, 0); __builtin_amdgcn_s_setprio(0); } while (0)
#define PG8_WAIT_V(n) asm volatile("s_waitcnt vmcnt(" #n ")" ::: "memory")
#define PG8_WAIT_L(n) asm volatile("s_waitcnt lgkmcnt(" #n ")" ::: "memory")
#define PG8_BAR __builtin_amdgcn_s_barrier()
#define PG8_SCHED __builtin_amdgcn_sched_barrier(0)
    Unit cur, nxt; int ui = 0;
    if (!S.next(0, cur)) return;
    f32x4 acc[2][2][4][2];
#pragma unroll
    for (int a = 0; a < 2; ++a)
#pragma unroll
        for (int b = 0; b < 2; ++b)
#pragma unroll
            for (int m = 0; m < 4; ++m)
#pragma unroll
                for (int n = 0; n < 2; ++n) acc[a][b][m][n] = (f32x4){0.f, 0.f, 0.f, 0.f};
    bf16x8 At[4][2], B0[2][2], B1[2][2];
    const char* cA = (const char*)g.A + (size_t)cur.pm * tstep; const char* cB = (const char*)g.Bt + (size_t)cur.pn * tstep;
    S.a_ready(cur);
    if constexpr (SP2) {
        PG8_STAGE(PG8_SB(0, 0), cB, voffB); PG8_STAGE(PG8_SB(0, 1), cB + hstep, voffB); PG8_STAGE(PG8_SA(0, 0), cA, voffA); PG8_STAGE(PG8_SA(0, 1), cA + hstep, voffA);
        if (wr == 1) PG8_BAR;
        PG8_WAIT_V(2); PG8_BAR;
        PG8_STAGE(PG8_SB(1, 0), cB + kstep, voffB); PG8_STAGE(PG8_SA(1, 0), cA + kstep, voffA); PG8_STAGE(PG8_SB(1, 1), cB + hstep + kstep, voffB);
        PG8_WAIT_V(6); PG8_BAR;
    } else {
        PG8_STAGE(PG8_SB(0, 0), cB, voffB); PG8_STAGE(PG8_SA(0, 0), cA, voffA); PG8_STAGE(PG8_SB(0, 1), cB + hstep, voffB); PG8_STAGE(PG8_SA(0, 1), cA + hstep, voffA);
        if (wr == 1) PG8_BAR;
        PG8_WAIT_V(4); PG8_BAR;
        PG8_STAGE(PG8_SB(1, 0), cB + kstep, voffB); PG8_STAGE(PG8_SA(1, 0), cA + kstep, voffA); PG8_STAGE(PG8_SB(1, 1), cB + hstep + kstep, voffB);
        PG8_WAIT_V(6); PG8_BAR;
    }
    for (;;) {
        const bool has_next = S.next(ui + 1, nxt);
        const char* nA = has_next ? (const char*)g.A + (size_t)nxt.pm * tstep : cA; const char* nB = has_next ? (const char*)g.Bt + (size_t)nxt.pn * tstep : cB;
        for (int t = 0; t < nt; t += 2) {
            const bool last = (t == nt - 2);
            const char* a1 = cA + (size_t)(t + 1) * kstep;
            const char* a2 = last ? nA : cA + (size_t)(t + 2) * kstep; const char* b2 = last ? nB : cB + (size_t)(t + 2) * kstep;
            const char* a3 = a2 + kstep; const char* b3 = b2 + kstep;
            if (last && has_next) S.a_ready(nxt);
            if constexpr (Epi::KSPLIT) { if (t == nt / 2) E.midscale(acc, cur, wr, fr); }
            if constexpr (SP2) {
            PG8_LDB(B0, 0, 0); PG8_LDB(B1, 0, 1); PG8_SCHED; PG8_LDA(At, 0, 0); PG8_STAGE(PG8_SA(1, 1), a1 + hstep, voffA);
            PG8_WAIT_V(8); PG8_WAIT_L(0); PG8_BAR; PG8_MMA(0, 0, At, B0); PG8_MMA(0, 1, At, B1); PG8_BAR; PG8_SCHED;
            PG8_LDA(At, 0, 1); PG8_STAGE(PG8_SB(0, 0), b2, voffB); PG8_STAGE(PG8_SB(0, 1), b2 + hstep, voffB); PG8_STAGE(PG8_SA(0, 0), a2, voffA);
            PG8_WAIT_V(8); PG8_WAIT_L(0); PG8_BAR; PG8_MMA(1, 0, At, B0); PG8_MMA(1, 1, At, B1); PG8_BAR; PG8_SCHED;
            PG8_LDB(B0, 1, 0); PG8_LDB(B1, 1, 1); PG8_SCHED; PG8_LDA(At, 1, 0); PG8_STAGE(PG8_SA(0, 1), a2 + hstep, voffA);
            PG8_WAIT_V(8); PG8_WAIT_L(0); PG8_BAR; PG8_MMA(0, 0, At, B0); PG8_MMA(0, 1, At, B1); PG8_BAR; PG8_SCHED;
            PG8_LDA(At, 1, 1); PG8_STAGE(PG8_SB(1, 0), b3, voffB); PG8_STAGE(PG8_SB(1, 1), b3 + hstep, voffB); PG8_STAGE(PG8_SA(1, 0), a3, voffA);
            PG8_WAIT_V(8); PG8_WAIT_L(0); PG8_BAR; PG8_MMA(1, 0, At, B0); PG8_MMA(1, 1, At, B1); PG8_BAR; PG8_SCHED;
            } else {
            PG8_LDB(B0, 0, 0); PG8_SCHED; PG8_LDA(At, 0, 0); PG8_STAGE(PG8_SA(1, 1), a1 + hstep, voffA);
            PG8_WAIT_L(8); PG8_BAR; PG8_WAIT_L(0); PG8_MMA(0, 0, At, B0); PG8_BAR; PG8_SCHED;
            PG8_LDB(B1, 0, 1); PG8_STAGE(PG8_SB(0, 0), b2, voffB);
            PG8_BAR; PG8_WAIT_L(0); PG8_MMA(0, 1, At, B1); PG8_BAR;
            PG8_LDA(At, 0, 1); PG8_STAGE(PG8_SA(0, 0), a2, voffA);
            PG8_BAR; PG8_WAIT_L(0); PG8_MMA(1, 0, At, B0); PG8_BAR; PG8_SCHED;
            PG8_STAGE(PG8_SB(0, 1), b2 + hstep, voffB);
            PG8_WAIT_V(6); PG8_BAR; PG8_MMA(1, 1, At, B1); PG8_BAR;
            PG8_LDB(B0, 1, 0); PG8_SCHED; PG8_LDA(At, 1, 0); PG8_STAGE(PG8_SA(0, 1), a2 + hstep, voffA);
            PG8_WAIT_L(8); PG8_BAR; PG8_WAIT_L(0); PG8_MMA(0, 0, At, B0); PG8_BAR; PG8_SCHED;
            PG8_LDB(B1, 1, 1); PG8_STAGE(PG8_SB(1, 0), b3, voffB);
            PG8_BAR; PG8_WAIT_L(0); PG8_MMA(0, 1, At, B1); PG8_BAR;
            PG8_LDA(At, 1, 1); PG8_STAGE(PG8_SA(1, 0), a3, voffA);
            PG8_BAR; PG8_WAIT_L(0); PG8_MMA(1, 0, At, B0); PG8_BAR; PG8_SCHED;
            PG8_STAGE(PG8_SB(1, 1), b3 + hstep, voffB);
            PG8_WAIT_V(6); PG8_BAR; PG8_MMA(1, 1, At, B1); PG8_BAR;
            }
        }
        if constexpr (ALIGN_EPI) { if (wr == 0) PG8_BAR; }
        E(acc, cur, wr, wc, fr, fq); S.done(cur);
        if (!has_next) break;
#pragma unroll
        for (int a = 0; a < 2; ++a)
#pragma unroll
            for (int b = 0; b < 2; ++b)
#pragma unroll
                for (int m = 0; m < 4; ++m)
#pragma unroll
                    for (int n = 0; n < 2; ++n) acc[a][b][m][n] = (f32x4){0.f, 0.f, 0.f, 0.f};
        cur = nxt; cA = nA; cB = nB; ++ui;
        if constexpr (ALIGN_EPI) { if (wr == 1) PG8_BAR; }
    }
    PG8_WAIT_V(0);
    if constexpr (!ALIGN_EPI) { if (wr == 0) PG8_BAR; }
    PG8_BAR;
#undef PG8_SA
#undef PG8_SB
#undef PG8_STAGE
#undef PG8_LDA
#undef PG8_LDB
#undef PG8_MMA
#undef PG8_WAIT_V
#undef PG8_WAIT_L
#undef PG8_BAR
#undef PG8_SCHED
}
}

__device__ __forceinline__ unsigned f2bf(float f) { unsigned u = __builtin_bit_cast(unsigned, f); return (u + 0x7fffu + ((u >> 16) & 1u)) >> 16; }
__device__ __forceinline__ unsigned pk2(float lo, float hi) { return f2bf(lo) | (f2bf(hi) << 16); }
__device__ __forceinline__ float bflo(unsigned w) { return __builtin_bit_cast(float, w << 16); }
__device__ __forceinline__ float bfhi(unsigned w) { return __builtin_bit_cast(float, w & 0xffff0000u); }
__device__ __forceinline__ float fast_sigmoid(float t) { return __builtin_amdgcn_rcpf(1.0f + __builtin_amdgcn_exp2f(-1.44269504089f * t)); }
__device__ __forceinline__ float gelu_tanh(float x) { const float t = x * (1.5957691216f + 0.0713548163f * x * x); return x * fast_sigmoid(t); }
__device__ __forceinline__ float wave_sum(float v) {
#pragma unroll
    for (int o = 1; o < 64; o <<= 1) v += __shfl_xor(v, o);
    return v;
}
#define LDS_WAIT() asm volatile("s_waitcnt lgkmcnt(0)" ::: "memory")
#define VM_WAIT() asm volatile("s_waitcnt vmcnt(0)" ::: "memory")
#define RLX_AGENT __ATOMIC_RELAXED, __HIP_MEMORY_SCOPE_AGENT

constexpr size_t MiB = 1u << 20;
constexpr size_t WS_CTL = 0, CTL_ZERO_BYTES = 1 * MiB;
constexpr size_t WS_MOD   = 512 * 1024;
constexpr size_t WS_AT    = 1 * MiB + 128 * 1024;
constexpr size_t WS_STATS = WS_AT + 128 * 1024;
constexpr size_t WS_SCL   = 1 * MiB + 512 * 1024;
constexpr size_t WS_GS    = 1 * MiB + 768 * 1024;
constexpr size_t WS_C0    = WS_GS + 16 * 1024;
constexpr size_t WS_KEYS  = 2 * MiB;
constexpr size_t WS_GWS   = 3 * MiB;
constexpr size_t WS_WIN   = 4 * MiB;
constexpr size_t WS_GLU   = 28 * MiB;
constexpr size_t WS_WOUT  = 32 * MiB;
constexpr size_t WS_WQ    = 48 * MiB;
constexpr size_t WS_KTAB  = 64 * MiB;
constexpr size_t WS_WG    = 72 * MiB;
constexpr size_t WS_VG    = 104 * MiB;
constexpr size_t WS_UV    = 136 * MiB;
constexpr size_t WS_X     = 392 * MiB;
constexpr size_t WS_H     = 520 * MiB;
constexpr size_t WS_Z     = 584 * MiB;
constexpr size_t WS_XS    = 648 * MiB;
constexpr size_t WS_SLOC  = 680 * MiB;
constexpr size_t WS_PS    = 688 * MiB;
constexpr size_t WS_PSA   = 690 * MiB;
constexpr size_t WS_PSB   = 691 * MiB;
constexpr size_t WS_PLN   = 692 * MiB;
constexpr size_t WS_HS    = 694 * MiB;
constexpr size_t WS_G     = 696 * MiB;
constexpr size_t WS_MIX   = 728 * MiB;
constexpr size_t WS_EID   = 792 * MiB;
constexpr size_t WS_GATE  = 800 * MiB;
constexpr size_t WS_SU    = 808 * MiB;
constexpr size_t WS_COEF  = 816 * MiB;
constexpr size_t WS_END   = 824 * MiB;
constexpr size_t WS_DBG   = 824 * MiB;
constexpr int CW_BAR = 4096;
constexpr int CW_FLAG = 2048;
constexpr int CW_QUEUE = 16384;

constexpr int LDS_BYTES = 163840;
constexpr int MISC_OFF = LDS_BYTES - 256;

#define XB_TMO      128
#define XB_XCNT(j)  (256  + 64 * (j))
#define XB_XSUB(j)  (1280 + 64 * (j))
#define XB_XGEN(j)  (2304 + 64 * (j))
#define XB_TOP      3328
#define XB_TOPGEN   3392
#define XCD_BAR_WORDS 3456
#define XB_SPIN_CAP (1u << 24)
__device__ __forceinline__ unsigned xb_ld(unsigned* p)              { return __hip_atomic_load(p, __ATOMIC_RELAXED, __HIP_MEMORY_SCOPE_AGENT); }
__device__ __forceinline__ unsigned xb_add(unsigned* p, unsigned v) { return __hip_atomic_fetch_add(p, v, __ATOMIC_RELAXED, __HIP_MEMORY_SCOPE_AGENT); }
__device__ __forceinline__ unsigned xb_xcc_id() { return (unsigned)__builtin_amdgcn_s_getreg((3 << 11) | 20) & 0xFu; }
#define XB_SPIN(cond, bar) do { unsigned _sp = 0; while (cond) { __builtin_amdgcn_s_sleep(1); \
    if ((++_sp & 255u) == 0u) { if (xb_ld(&(bar)[XB_TMO])) break; if (_sp > XB_SPIN_CAP) { atomicAdd(&(bar)[XB_TMO], 1u); break; } } } } while (0)
struct XcdBarrier { unsigned* bar; unsigned x; volatile LAS unsigned* st; };
__device__ __forceinline__ XcdBarrier xcd_barrier_post(unsigned* bar, volatile LAS unsigned* st) {
    XcdBarrier b; b.bar = bar; b.x = xb_xcc_id(); b.st = st;
    if (threadIdx.x == 0) (void)xb_add(&bar[XB_XCNT(b.x)], 1u);
    return b;
}
__device__ __forceinline__ void xcd_barrier_complete(unsigned* bar, unsigned x, unsigned& nloc, unsigned& nx) {
    const unsigned G = gridDim.x * gridDim.y * gridDim.z;
    unsigned sum, cnt, mine, sp = 0u;
    for (;;) {
        sum = 0u; cnt = 0u; mine = 0u;
#pragma unroll
        for (unsigned j = 0; j < 16; ++j) { const unsigned c = xb_ld(&bar[XB_XCNT(j)]); sum += c; cnt += (c > 0u) ? 1u : 0u; mine = (j == x) ? c : mine; }
        if (sum == G) break;
        __builtin_amdgcn_s_sleep(1);
        if ((++sp & 255u) == 0u) { if (xb_ld(&bar[XB_TMO])) break; if (sp > XB_SPIN_CAP) { atomicAdd(&bar[XB_TMO], 1u); break; } }
    }
    nloc = mine > 0u ? mine : 1u; nx = cnt > 0u ? cnt : 1u;
}
__device__ __forceinline__ void xcd_barrier(const XcdBarrier& b) {
    asm volatile("s_waitcnt vmcnt(0)" ::: "memory");
    __syncthreads();
    if (threadIdx.x == 0) {
        unsigned* bar = b.bar;
        __builtin_amdgcn_s_waitcnt(0);
        unsigned nloc = b.st[0], nx = b.st[1];
        if (nloc == 0u) { xcd_barrier_complete(bar, b.x, nloc, nx); b.st[0] = nloc; b.st[1] = nx; }
        const unsigned old = xb_add(&bar[XB_XSUB(b.x)], 1u);
        const unsigned gen = old / nloc;
        if (old + 1u == (gen + 1u) * nloc) {
            __builtin_amdgcn_fence(__ATOMIC_RELEASE, "agent");
            asm volatile("s_waitcnt vmcnt(0)" ::: "memory");
            const unsigned og = xb_add(&bar[XB_TOP], 1u);
            const unsigned tg = og / nx;
            if (og + 1u == (tg + 1u) * nx) xb_add(&bar[XB_TOPGEN], 1u);
            else XB_SPIN(xb_ld(&bar[XB_TOPGEN]) == tg, bar);
            __builtin_amdgcn_fence(__ATOMIC_ACQUIRE, "agent");
            xb_add(&bar[XB_XGEN(b.x)], 1u);
            asm volatile("s_waitcnt vmcnt(0)" ::: "memory");
        } else {
            XB_SPIN(xb_ld(&bar[XB_XGEN(b.x)]) == gen, bar);
            __builtin_amdgcn_fence(__ATOMIC_ACQUIRE, "agent");
            asm volatile("s_waitcnt vmcnt(0)" ::: "memory");
        }
    }
    __syncthreads();
}

struct Args { const float* in[29]; float* out; unsigned char* ws; int ph_lo, ph_hi, li, pad; };
enum { I_X = 0, I_C, I_WMOD, I_BMOD, I_N1G, I_WIN, I_BIN, I_LNG, I_LNB, I_GWS, I_GBS, I_LRE, I_LIM, I_LDT, I_BRE, I_BIM, I_CRE, I_CIM, I_SD, I_GLUW, I_GLUB,
       I_BRG, I_WOUT, I_N2G, I_WQ, I_KEYS, I_PU, I_PV, I_FG };

struct Frame {
    LAS unsigned char* lds;
    unsigned char* ws;
    const float* const* in;
    float* out;
    int tid, lane, wave, vcu, G;
};

#define PH_LOCALS int tid = F.tid; asm volatile("" : "+v"(tid)); const int lane = tid & 63; const int wave = __builtin_amdgcn_readfirstlane(tid >> 6); (void)lane; (void)wave;

struct EpiIn {
    static constexpr bool PERM = true, AFTER_DRAIN = false, KSPLIT = false;
    bf16* Z; bf16* XS; const float* bias; float* PLN;
    __device__ __forceinline__ void operator()(const f32x4 (&acc)[2][2][4][2], const pg8::Unit& u, int wr, int wc, int fr, int fq) const {
        const int row0 = u.pm * 256 + wr * 64 + fr, col0 = u.pn * 256 + wc * 32 + 8 * fq;
        const bool isv = (u.pn >= 4 && u.pn < 8);
        f32x4 bv[2][2];
#pragma unroll
        for (int bj = 0; bj < 2; ++bj)
#pragma unroll
            for (int n = 0; n < 2; ++n) bv[bj][n] = *(const f32x4*)(bias + col0 + bj * 128 + 4 * n);
        const bool isz = (u.pn < 8);
#pragma unroll
        for (int ai = 0; ai < 2; ++ai)
#pragma unroll
            for (int m = 0; m < 4; ++m) {
                const int r = row0 + ai * 128 + m * 16; float s1 = 0.f, s2 = 0.f;
#pragma unroll
                for (int bj = 0; bj < 2; ++bj) {
                    f32x4 v0 = acc[ai][bj][m][0] + bv[bj][0], v1 = acc[ai][bj][m][1] + bv[bj][1];
                    const int c = col0 + bj * 128;
                    u32x4 w;
                    if (isz) {
                        const float g0 = gelu_tanh(v0[0]), g1 = gelu_tanh(v0[1]), g2 = gelu_tanh(v0[2]), g3 = gelu_tanh(v0[3]), g4 = gelu_tanh(v1[0]), g5 = gelu_tanh(v1[1]), g6 = gelu_tanh(v1[2]), g7 = gelu_tanh(v1[3]);
                        w.x = pg8::cvt_pk_bf16(g0, g1); w.y = pg8::cvt_pk_bf16(g2, g3); w.z = pg8::cvt_pk_bf16(g4, g5); w.w = pg8::cvt_pk_bf16(g6, g7);
                        *(u32x4*)(Z + (size_t)r * 2048 + c) = w;
                        s1 += ((g0 + g1) + (g2 + g3)) + ((g4 + g5) + (g6 + g7)); s2 += ((g0 * g0 + g1 * g1) + (g2 * g2 + g3 * g3)) + ((g4 * g4 + g5 * g5) + (g6 * g6 + g7 * g7));
                    } else {
                        w.x = pg8::cvt_pk_bf16(v0[0], v0[1]); w.y = pg8::cvt_pk_bf16(v0[2], v0[3]); w.z = pg8::cvt_pk_bf16(v1[0], v1[1]); w.w = pg8::cvt_pk_bf16(v1[2], v1[3]);
                        const int cc = c - 2048, g = cc >> 4, i = cc & 15;
                        *(u32x4*)(XS + ((size_t)(g * 256 + (r >> 6)) * 64 + (r & 63)) * 16 + i) = w;
                    }
                }
                if (isv) { s1 += __shfl_xor(s1, 16); s1 += __shfl_xor(s1, 32); s2 += __shfl_xor(s2, 16); s2 += __shfl_xor(s2, 32);
                    if (fq == 0) *(f32x2*)(PLN + ((size_t)r * 16 + (u.pn - 4) * 4 + wc) * 2) = (f32x2){s1, s2}; }
            }
    }
};
struct EpiGlu {
    static constexpr bool PERM = true, AFTER_DRAIN = false, KSPLIT = false;
    const bf16* Gb; bf16* MIX; const float* bias; float* PSB;
    __device__ __forceinline__ void operator()(const f32x4 (&acc)[2][2][4][2], const pg8::Unit& u, int wr, int wc, int fr, int fq) const {
        const int row0 = u.pm * 256 + wr * 64 + fr, col0 = u.pn * 256 + wc * 32 + 8 * fq;
        f32x4 bv[2][2];
#pragma unroll
        for (int bj = 0; bj < 2; ++bj)
#pragma unroll
            for (int n = 0; n < 2; ++n) bv[bj][n] = *(const f32x4*)(bias + col0 + bj * 128 + 4 * n);
#pragma unroll
        for (int ai = 0; ai < 2; ++ai)
#pragma unroll
            for (int m = 0; m < 4; ++m) {
                const int r = row0 + ai * 128 + m * 16; float ssq = 0.f;
#pragma unroll
                for (int bj = 0; bj < 2; ++bj) {
                    const f32x4 v0 = acc[ai][bj][m][0] + bv[bj][0], v1 = acc[ai][bj][m][1] + bv[bj][1];
                    const int c = col0 + bj * 128;
                    const u32x4 gw = *(const u32x4*)(Gb + (size_t)r * 1024 + c);
                    const float o0 = bflo(gw.x) * fast_sigmoid(v0[0]), o1 = bfhi(gw.x) * fast_sigmoid(v0[1]), o2 = bflo(gw.y) * fast_sigmoid(v0[2]), o3 = bfhi(gw.y) * fast_sigmoid(v0[3]);
                    const float o4 = bflo(gw.z) * fast_sigmoid(v1[0]), o5 = bfhi(gw.z) * fast_sigmoid(v1[1]), o6 = bflo(gw.w) * fast_sigmoid(v1[2]), o7 = bfhi(gw.w) * fast_sigmoid(v1[3]);
                    u32x4 w; w.x = pg8::cvt_pk_bf16(o0, o1); w.y = pg8::cvt_pk_bf16(o2, o3); w.z = pg8::cvt_pk_bf16(o4, o5); w.w = pg8::cvt_pk_bf16(o6, o7);
                    *(u32x4*)(MIX + (size_t)r * 2048 + 1024 + c) = w;
                    ssq += (o0 * o0 + o1 * o1) + (o2 * o2 + o3 * o3) + (o4 * o4 + o5 * o5) + (o6 * o6 + o7 * o7);
                }
                ssq += __shfl_xor(ssq, 16); ssq += __shfl_xor(ssq, 32);
                if (fq == 0) PSB[(size_t)r * 16 + u.pn * 4 + wc] = ssq;
            }
    }
};
template <bool XIN_BF16> struct EpiOut {
    static constexpr bool PERM = true, AFTER_DRAIN = false, KSPLIT = true;
    const void* xin; bf16* X; const float* gate; float* PS; const LAS float* ratL; const LAS float* rbL; int pm0;
    __device__ __forceinline__ void midscale(f32x4 (&acc)[2][2][4][2], const pg8::Unit& u, int wr, int fr) const {
        const LAS float* rp = ratL + (u.pm == pm0 ? 0 : 256) + wr * 64 + fr;
#pragma unroll
        for (int ai = 0; ai < 2; ++ai)
#pragma unroll
            for (int m = 0; m < 4; ++m) { const float rt = rp[ai * 128 + m * 16];
#pragma unroll
                for (int bj = 0; bj < 2; ++bj)
#pragma unroll
                    for (int n = 0; n < 2; ++n) acc[ai][bj][m][n] = acc[ai][bj][m][n] * rt; }
    }
    __device__ __forceinline__ void operator()(const f32x4 (&acc)[2][2][4][2], const pg8::Unit& u, int wr, int wc, int fr, int fq) const {
        const int row0 = u.pm * 256 + wr * 64 + fr, col0 = u.pn * 256 + wc * 32 + 8 * fq;
        const LAS float* rbp = rbL + (u.pm == pm0 ? 0 : 256) + wr * 64 + fr;
        f32x4 gv[2][2];
#pragma unroll
        for (int bj = 0; bj < 2; ++bj)
#pragma unroll
            for (int n = 0; n < 2; ++n) gv[bj][n] = *(const f32x4*)(gate + col0 + bj * 128 + 4 * n);
#pragma unroll
        for (int ai = 0; ai < 2; ++ai)
#pragma unroll
            for (int m = 0; m < 4; ++m) {
                const int r = row0 + ai * 128 + m * 16; float ssq = 0.f; const float rb = rbp[ai * 128 + m * 16];
#pragma unroll
                for (int bj = 0; bj < 2; ++bj) {
                    const size_t off = (size_t)r * 2048 + col0 + bj * 128;
                    f32x4 x0, x1;
                    if (XIN_BF16) { const u32x4 w = *(const u32x4*)((const bf16*)xin + off); x0 = (f32x4){bflo(w.x), bfhi(w.x), bflo(w.y), bfhi(w.y)}; x1 = (f32x4){bflo(w.z), bfhi(w.z), bflo(w.w), bfhi(w.w)}; }
                    else { x0 = *(const f32x4*)((const float*)xin + off); x1 = *(const f32x4*)((const float*)xin + off + 4); }
                    const f32x4 y0 = x0 + gv[bj][0] * (acc[ai][bj][m][0] * rb), y1 = x1 + gv[bj][1] * (acc[ai][bj][m][1] * rb);
                    u32x4 o; o.x = pg8::cvt_pk_bf16(y0[0], y0[1]); o.y = pg8::cvt_pk_bf16(y0[2], y0[3]); o.z = pg8::cvt_pk_bf16(y1[0], y1[1]); o.w = pg8::cvt_pk_bf16(y1[2], y1[3]);
                    *(u32x4*)(X + off) = o;
                    ssq += (y0[0] * y0[0] + y0[1] * y0[1]) + (y0[2] * y0[2] + y0[3] * y0[3]) + (y1[0] * y1[0] + y1[1] * y1[1]) + (y1[2] * y1[2] + y1[3] * y1[3]);
                }
                ssq += __shfl_xor(ssq, 16); ssq += __shfl_xor(ssq, 32);
                if (fq == 0) PS[(size_t)r * 32 + u.pn * 4 + wc] = ssq;
            }
    }
};
struct EpiQ {
    static constexpr bool PERM = true, AFTER_DRAIN = false, KSPLIT = false;
    bf16* Q; const float* c0; const LAS float* rrL; int pm0;
    __device__ __forceinline__ void operator()(const f32x4 (&acc)[2][2][4][2], const pg8::Unit& u, int wr, int wc, int fr, int fq) const {
        const int row0 = u.pm * 256 + wr * 64 + fr, col0 = u.pn * 256 + wc * 32 + 8 * fq;
        const LAS float* rrp = rrL + (u.pm == pm0 ? 0 : 256) + wr * 64 + fr;
        f32x4 cv[2][2];
#pragma unroll
        for (int bj = 0; bj < 2; ++bj)
#pragma unroll
            for (int n = 0; n < 2; ++n) cv[bj][n] = *(const f32x4*)(c0 + col0 + bj * 128 + 4 * n);
#pragma unroll
        for (int ai = 0; ai < 2; ++ai)
#pragma unroll
            for (int m = 0; m < 4; ++m) {
                const int r = row0 + ai * 128 + m * 16; const float rr = rrp[ai * 128 + m * 16];
#pragma unroll
                for (int bj = 0; bj < 2; ++bj) {
                    const f32x4 v0 = acc[ai][bj][m][0] * rr + cv[bj][0], v1 = acc[ai][bj][m][1] * rr + cv[bj][1];
                    u32x4 w; w.x = pg8::cvt_pk_bf16(v0[0], v0[1]); w.y = pg8::cvt_pk_bf16(v0[2], v0[3]); w.z = pg8::cvt_pk_bf16(v1[0], v1[1]); w.w = pg8::cvt_pk_bf16(v1[2], v1[3]);
                    *(u32x4*)(Q + (size_t)r * 2048 + col0 + bj * 128) = w;
                }
            }
    }
};
__device__ __forceinline__ void fill_rr(Frame& F, LAS float* rrL, int slot, int pm, int tid) {
    if (tid < 256) { const float* ps = (const float*)(F.ws + WS_PS) + ((size_t)pm * 256 + tid) * 32; float s = 0.f;
#pragma unroll
        for (int i = 0; i < 8; ++i) { const f32x4 v = *(const f32x4*)(ps + 4 * i); s += (v[0] + v[1]) + (v[2] + v[3]); }
        rrL[slot * 256 + tid] = 1.0f / sqrtf(s * (1.0f / DM) + EPS); }
}

__device__ __forceinline__ void p0_transpose_item(const float* W, int K, int N, bf16* WT, const float* kscale, LAS float* scr, int item, int lane, const float* kscale2 = nullptr) {
    const int nblk = N / 32, kb = item / nblk, nb = item % nblk, k0 = 64 * kb, n0 = 32 * nb;
    float wv[32];
#pragma unroll
    for (int i = 0; i < 32; ++i) wv[i] = W[(size_t)(k0 + 2 * i + (lane >> 5)) * N + n0 + (lane & 31)];
#pragma unroll
    for (int i = 0; i < 32; ++i) { const int kk = 2 * i + (lane >> 5); float v = wv[i]; if (kscale) { v *= kscale[k0 + kk]; if (kscale2) v *= 1.0f + kscale2[k0 + kk]; } scr[kk * 33 + (lane & 31)] = v; }
    LDS_WAIT(); asm volatile("" ::: "memory");
    const int c = lane & 7;
#pragma unroll
    for (int j = 0; j < 4; ++j) { const int n = (lane >> 3) + 8 * j; const LAS float* s = scr + (8 * c) * 33 + n;
        u32x4 o; o.x = pk2(s[0 * 33], s[1 * 33]); o.y = pk2(s[2 * 33], s[3 * 33]); o.z = pk2(s[4 * 33], s[5 * 33]); o.w = pk2(s[6 * 33], s[7 * 33]);
        *(u32x4*)(WT + (size_t)(n0 + n) * K + k0 + 8 * c) = o; }
    LDS_WAIT(); asm volatile("" ::: "memory");
}

__device__ __forceinline__ void norm_mod_row(const f32x4 (&v)[4][2], const float* gain, const float* scale, const float* shift, int lane, u32x4 (&o)[4]) {
    float s = 0.f;
#pragma unroll
    for (int j = 0; j < 4; ++j)
#pragma unroll
        for (int h = 0; h < 2; ++h) s += (v[j][h][0] * v[j][h][0] + v[j][h][1] * v[j][h][1]) + (v[j][h][2] * v[j][h][2] + v[j][h][3] * v[j][h][3]);
    const float rr = 1.0f / sqrtf(wave_sum(s) * (1.0f / DM) + EPS);
#pragma unroll
    for (int j = 0; j < 4; ++j) {
        const int c = j * 512 + lane * 8;
        f32x4 y[2];
#pragma unroll
        for (int h = 0; h < 2; ++h) {
            const f32x4 g = *(const f32x4*)(gain + c + 4 * h);
            y[h] = v[j][h] * rr * g;
            const f32x4 sc = *(const f32x4*)(scale + c + 4 * h), sh = *(const f32x4*)(shift + c + 4 * h); y[h] = y[h] * (sc + 1.0f) + sh;
        }
        o[j].x = pk2(y[0][0], y[0][1]); o[j].y = pk2(y[0][2], y[0][3]); o[j].z = pk2(y[1][0], y[1][1]); o[j].w = pk2(y[1][2], y[1][3]);
    }
}
template <bool SRC_BF16>
__device__ __forceinline__ void load_row(const void* xrow_, int lane, f32x4 (&v)[4][2]) {
#pragma unroll
    for (int j = 0; j < 4; ++j) {
        if (SRC_BF16) { const u32x4 w = *(const u32x4*)((const bf16*)xrow_ + j * 512 + lane * 8); v[j][0] = (f32x4){bflo(w.x), bfhi(w.x), bflo(w.y), bfhi(w.y)}; v[j][1] = (f32x4){bflo(w.z), bfhi(w.z), bflo(w.w), bfhi(w.w)}; }
        else { const float* xrow = (const float*)xrow_; v[j][0] = *(const f32x4*)(xrow + j * 512 + lane * 8); v[j][1] = *(const f32x4*)(xrow + j * 512 + lane * 8 + 4); } }
}

__device__ __forceinline__ void p0_gemv_unit(Frame& F, int unit, int tid, float* modout) {
    const int l = unit / 192, r = unit % 192, cb = r >> 1, kh = r & 1;
    LAS float* sc = (LAS float*)F.lds;
    LAS float* red = (LAS float*)(F.lds + 4096);
    for (int k = tid; k < 1024; k += NTHR) { const float c = F.in[I_C][kh * 1024 + k]; sc[k] = c * fast_sigmoid(c); }
    __syncthreads();
    const int tx = tid & 31, ty = tid >> 5;
    const float* W = F.in[I_WMOD] + ((size_t)l * DM + kh * 1024) * 12288 + cb * 128 + tx * 4;
    f32x4 a = {0.f, 0.f, 0.f, 0.f};
#pragma unroll 16
    for (int k = ty; k < 1024; k += 16) { const f32x4 w = *(const f32x4*)(W + (size_t)k * 12288); a += w * sc[k]; }
    *(LAS f32x4*)(red + ty * 128 + tx * 4) = a;
    __syncthreads();
    if (tid < 128) { float s = 0.f;
#pragma unroll
        for (int y = 0; y < 16; ++y) s += red[y * 128 + tid];
        if (kh == 0) s += F.in[I_BMOD][l * 12288 + cb * 128 + tid];
        atomicAdd(modout + l * 12288 + cb * 128 + tid, s); }
    __syncthreads();
}
__device__ __forceinline__ void p0_s5_unit(Frame& F, int unit, int tid, int parts = 15) {
    const int l = unit >> 7, g = (unit >> 1) & 63, hf = unit & 1;
    LAS float* apr = (LAS float*)F.lds;
    LAS float* api = apr + 4228;
    LAS float* bbr = api + 4228;
    LAS float* bbi = bbr + 1024;
    LAS float* ccr = bbi + 1024;
    LAS float* cci = ccr + 16 * 65;
    const float dt = expf(F.in[I_LDT][l * 64 + g]);
    const float* lre = F.in[I_LRE] + (l * 64 + g) * 64; const float* lim = F.in[I_LIM] + (l * 64 + g) * 64;
    for (int idx = tid; idx < 65 * 64; idx += NTHR) { const int d = idx >> 6, p = idx & 63;
        const float mag = expf(lre[p] * dt * (float)d); float sn, cs; sincosf(lim[p] * dt * (float)d, &sn, &cs);
        apr[d * 65 + p] = mag * cs; api[d * 65 + p] = mag * sn; }
    for (int idx = tid; idx < 1024; idx += NTHR) { const int o = idx >> 6, p = idx & 63;
        ccr[o * 65 + p] = F.in[I_CRE][((size_t)(l * 64 + g) * 16 + o) * 64 + p]; cci[o * 65 + p] = F.in[I_CIM][((size_t)(l * 64 + g) * 16 + o) * 64 + p]; }
    __syncthreads();
    for (int idx = tid; idx < 1024; idx += NTHR) { const int p = idx >> 4, i = idx & 15;
        const float xr = apr[65 + p] - 1.0f, xi = api[65 + p], lr = lre[p], li = lim[p], den = 1.0f / (lr * lr + li * li);
        const float cr = (xr * lr + xi * li) * den, ci = (xi * lr - xr * li) * den;
        const float br = F.in[I_BRE][((size_t)(l * 64 + g) * 64 + p) * 16 + i], bi = F.in[I_BIM][((size_t)(l * 64 + g) * 64 + p) * 16 + i];
        bbr[idx] = cr * br - ci * bi; bbi[idx] = cr * bi + ci * br; }
    __syncthreads();
    bf16* KT = (bf16*)(F.ws + WS_KTAB) + (size_t)(l * 64 + g) * 80 * 256;
    if (parts & 1) {
        const int d = hf * 32 + (tid >> 4), o = tid & 15;
        const float dskip = F.in[I_SD][l * 1024 + g * 16 + o];
        float s[16];
#pragma unroll
        for (int i = 0; i < 16; ++i) s[i] = 0.f;
        for (int p = 0; p < 64; ++p) { const float ar = apr[d * 65 + p], ai = api[d * 65 + p], cr = ccr[o * 65 + p], ci = cci[o * 65 + p];
            const float er = cr * ar - ci * ai, ei = cr * ai + ci * ar;
#pragma unroll
            for (int q = 0; q < 4; ++q) { const f32x4 br = *(const LAS f32x4*)(bbr + p * 16 + 4 * q), bi = *(const LAS f32x4*)(bbi + p * 16 + 4 * q);
#pragma unroll
                for (int e = 0; e < 4; ++e) s[4 * q + e] += er * br[e] - ei * bi[e]; } }
#if !SELFTEST_S5
        {   const float dsk = (d == 0) ? dskip : 0.f;
#pragma unroll
            for (int i = 0; i < 16; ++i) s[i] += (i == o) ? dsk : 0.f; }
#endif
        u32x4 w0, w1;
        w0.x = pk2(s[0], s[1]); w0.y = pk2(s[2], s[3]); w0.z = pk2(s[4], s[5]); w0.w = pk2(s[6], s[7]);
        w1.x = pk2(s[8], s[9]); w1.y = pk2(s[10], s[11]); w1.z = pk2(s[12], s[13]); w1.w = pk2(s[14], s[15]);
        if ((parts & 8) || w0.x == 0x12345678u) { *(u32x4*)(KT + (size_t)(d + 16) * 256 + o * 16) = w0; *(u32x4*)(KT + (size_t)(d + 16) * 256 + o * 16 + 8) = w1; }
        if ((parts & 8) && hf == 0 && tid < 256) { const u32x4 z = {0u, 0u, 0u, 0u}; *(u32x4*)(KT + tid * 16) = z; *(u32x4*)(KT + tid * 16 + 8) = z; }
    }
    bf16* WG = (bf16*)(F.ws + WS_WG) + (size_t)(l * 64 + g) * 128 * 1024;
    if (parts & 2) for (int it = tid; it < 32 * 64; it += NTHR) { const int p = hf * 32 + (it >> 6), tau = it & 63;
        const float ar = apr[(63 - tau) * 65 + p], ai = api[(63 - tau) * 65 + p];
        unsigned wr_[8], wi_[8];
#pragma unroll
        for (int q = 0; q < 4; ++q) { const f32x4 br = *(const LAS f32x4*)(bbr + p * 16 + 4 * q), bi = *(const LAS f32x4*)(bbi + p * 16 + 4 * q);
            wr_[2 * q] = pk2(ar * br[0] - ai * bi[0], ar * br[1] - ai * bi[1]); wr_[2 * q + 1] = pk2(ar * br[2] - ai * bi[2], ar * br[3] - ai * bi[3]);
            wi_[2 * q] = pk2(ar * bi[0] + ai * br[0], ar * bi[1] + ai * br[1]); wi_[2 * q + 1] = pk2(ar * bi[2] + ai * br[2], ar * bi[3] + ai * br[3]); }
        *(u32x4*)(WG + (size_t)p * 1024 + tau * 16) = (u32x4){wr_[0], wr_[1], wr_[2], wr_[3]}; *(u32x4*)(WG + (size_t)p * 1024 + tau * 16 + 8) = (u32x4){wr_[4], wr_[5], wr_[6], wr_[7]};
        *(u32x4*)(WG + (size_t)(64 + p) * 1024 + tau * 16) = (u32x4){wi_[0], wi_[1], wi_[2], wi_[3]}; *(u32x4*)(WG + (size_t)(64 + p) * 1024 + tau * 16 + 8) = (u32x4){wi_[4], wi_[5], wi_[6], wi_[7]}; }
    bf16* VG = (bf16*)(F.ws + WS_VG) + (size_t)(l * 64 + g) * 1024 * 128;
    if (parts & 4) for (int it = tid; it < 512 * 8; it += NTHR) { const int m = hf * 512 + (it >> 3), p0 = (it & 7) * 8, t = m >> 4, o = m & 15;
        float vr_[8], vi_[8];
#pragma unroll
        for (int e = 0; e < 8; ++e) { const float ar = apr[(t + 1) * 65 + p0 + e], ai = api[(t + 1) * 65 + p0 + e], cr = ccr[o * 65 + p0 + e], ci = cci[o * 65 + p0 + e];
            vr_[e] = cr * ar - ci * ai; vi_[e] = -(cr * ai + ci * ar); }
        *(u32x4*)(VG + (size_t)m * 128 + p0) = (u32x4){pk2(vr_[0], vr_[1]), pk2(vr_[2], vr_[3]), pk2(vr_[4], vr_[5]), pk2(vr_[6], vr_[7])};
        *(u32x4*)(VG + (size_t)m * 128 + 64 + p0) = (u32x4){pk2(vi_[0], vi_[1]), pk2(vi_[2], vi_[3]), pk2(vi_[4], vi_[5]), pk2(vi_[6], vi_[7])}; }
    if (hf == 0 && tid < 64) { float* AT = (float*)(F.ws + WS_AT) + ((size_t)(l * 64 + g) * 64 + tid) * 2; AT[0] = apr[64 * 65 + tid]; AT[1] = api[64 * 65 + tid]; }
    __syncthreads();
}
__device__ __forceinline__ void p0_fp4_chunk(Frame& F, int chunk, int wave, int lane) {
    unsigned char* UV = F.ws + WS_UV; float* SCL = (float*)(F.ws + WS_SCL);
    for (int i = 0; i < 8; i += 2) {
        f32x4 v[2][8]; float am[2] = {0.f, 0.f}; int tbl[2], rr[2];
#pragma unroll
        for (int r2 = 0; r2 < 2; ++r2) {
            const int r = chunk * 64 + wave * 8 + i + r2; tbl[r2] = r >> 15; rr[r2] = r & 32767;
            const float* srcp = (tbl[r2] ? F.in[I_PV] : F.in[I_PU]) + (size_t)rr[r2] * 2048 + lane * 4;
#pragma unroll
            for (int j = 0; j < 8; ++j) v[r2][j] = *(const f32x4*)(srcp + j * 256);
        }
#pragma unroll
        for (int r2 = 0; r2 < 2; ++r2)
#pragma unroll
            for (int j = 0; j < 8; ++j) am[r2] = fmaxf(am[r2], fmaxf(fmaxf(fabsf(v[r2][j][0]), fabsf(v[r2][j][1])), fmaxf(fabsf(v[r2][j][2]), fabsf(v[r2][j][3]))));
#pragma unroll
        for (int o = 1; o < 64; o <<= 1) { am[0] = fmaxf(am[0], __shfl_xor(am[0], o)); am[1] = fmaxf(am[1], __shfl_xor(am[1], o)); }
#pragma unroll
        for (int r2 = 0; r2 < 2; ++r2) {
            const float scale = am[r2] > 0.f ? am[r2] * (1.0f / 6.0f) : 1.0f, inv = am[r2] > 0.f ? 6.0f / am[r2] : 1.0f;
            u32x4 o;
#pragma unroll
            for (int d = 0; d < 4; ++d) { unsigned w = 0u;
                w = __builtin_amdgcn_cvt_scalef32_pk_fp4_f32(w, v[r2][2 * d][0] * inv, v[r2][2 * d][1] * inv, 1.0f, 0);
                w = __builtin_amdgcn_cvt_scalef32_pk_fp4_f32(w, v[r2][2 * d][2] * inv, v[r2][2 * d][3] * inv, 1.0f, 1);
                w = __builtin_amdgcn_cvt_scalef32_pk_fp4_f32(w, v[r2][2 * d + 1][0] * inv, v[r2][2 * d + 1][1] * inv, 1.0f, 2);
                w = __builtin_amdgcn_cvt_scalef32_pk_fp4_f32(w, v[r2][2 * d + 1][2] * inv, v[r2][2 * d + 1][3] * inv, 1.0f, 3);
                o[d] = w; }
            *(u32x4*)(UV + (size_t)(rr[r2] >> 14) * ((size_t)NEXP * 2048) + (size_t)tbl[r2] * ((size_t)NEXP * 1024) + (size_t)(rr[r2] & 16383) * 1024 + lane * 16) = o;
            if (lane == 0) SCL[rr[r2] * 2 + tbl[r2]] = scale;
        }
    }
}
#ifndef P0_PARTS
#define P0_PARTS 15
#endif
#ifndef P0_PROBE_MODE
#define P0_PROBE_MODE 0
#endif
__device__ __forceinline__ void p0_tables(Frame& F, int qi = 4, bool dummy = false) {
    PH_LOCALS
    unsigned* head = (unsigned*)(F.ws + WS_CTL) + CW_QUEUE + 64 * qi;
    float* modout = dummy ? (float*)(F.ws + WS_DBG) : (float*)(F.ws + WS_MOD);
    LAS unsigned* slot = (LAS unsigned*)(F.lds + MISC_OFF) + 16;
    for (;;) {
        __syncthreads();
        if (tid == 0) slot[0] = __hip_atomic_fetch_add(head, 1u, RLX_AGENT);
        __syncthreads();
        const unsigned u = slot[0];
        if (u >= 1664u) break;
        const int rnd = (int)u / 13, k = (int)u % 13;
        if (k < 2) { if (dummy && P0_PROBE_MODE == 2) continue; p0_s5_unit(F, rnd * 2 + k, tid, dummy ? P0_PARTS : 15); }
        else if (k < 5) { if (dummy && P0_PROBE_MODE == 1) continue; p0_gemv_unit(F, rnd * 3 + (k - 2), tid, modout); }
        else { p0_fp4_chunk(F, rnd * 8 + (k - 5), wave, lane); }
    }
}
__device__ __forceinline__ void p0_prologue(Frame& F) {
    PH_LOCALS
    const int gw = F.vcu * NWAVES + wave, NGW = F.G * NWAVES;
    const int gt = F.vcu * NTHR + tid, NGT = F.G * NTHR;
    const float* modp = (const float*)(F.ws + WS_MOD);
    for (int i = gt; i < 2 * DM; i += NGT) { const int l = i >> 11, k = i & 2047; ((float*)(F.ws + WS_GS))[i] = F.in[I_N2G][i] * (1.0f + modp[l * 12288 + 4 * 2048 + k]); }
    if (F.vcu < 64) {
        const int l = F.vcu >> 5, cb = F.vcu & 31, tx = tid & 15, ty = tid >> 4;
        const float* W = F.in[I_WQ] + (size_t)l * DM * DM + cb * 64 + tx * 4; const float* sh = modp + l * 12288 + 3 * 2048;
        f32x4 a = {0.f, 0.f, 0.f, 0.f};
#pragma unroll 16
        for (int k = ty; k < DM; k += 32) { const f32x4 w = *(const f32x4*)(W + (size_t)k * DM); a += w * sh[k]; }
        LAS float* red = (LAS float*)F.lds;
        *(LAS f32x4*)(red + ty * 64 + tx * 4) = a;
        __syncthreads();
        if (tid < 64) { float s = 0.f;
#pragma unroll
            for (int y = 0; y < 32; ++y) s += red[y * 64 + tid];
            ((float*)(F.ws + WS_C0))[l * DM + cb * 64 + tid] = s; }
        __syncthreads();
    }
    {
        LAS float* scr = (LAS float*)(F.lds + wave * 16384);
        constexpr int I_IN = (DM / 64) * (INW / 32), I_GL = (WB / 64) * (WB / 32), I_OU = (DM / 64) * (DM / 32), I_Q = I_OU;
        constexpr int PER_L = I_IN + I_GL + I_OU + I_Q;
        for (int it = gw; it < 2 * PER_L; it += NGW) {
            const int l = it / PER_L; int r = it % PER_L;
            if (r < I_IN) { p0_transpose_item(F.in[I_WIN] + (size_t)l * DM * INW, DM, INW, (bf16*)(F.ws + WS_WIN) + (size_t)l * INW * DM, nullptr, scr, r, lane); continue; } r -= I_IN;
            if (r < I_GL) { p0_transpose_item(F.in[I_GLUW] + (size_t)l * WB * WB, WB, WB, (bf16*)(F.ws + WS_GLU) + (size_t)l * WB * WB, nullptr, scr, r, lane); continue; } r -= I_GL;
            if (r < I_OU) { p0_transpose_item(F.in[I_WOUT] + (size_t)l * DM * DM, DM, DM, (bf16*)(F.ws + WS_WOUT) + (size_t)l * DM * DM, F.in[I_BRG] + l * DM, scr, r, lane); continue; } r -= I_OU;
            p0_transpose_item(F.in[I_WQ] + (size_t)l * DM * DM, DM, DM, (bf16*)(F.ws + WS_WQ) + (size_t)l * DM * DM, F.in[I_N2G] + l * DM, scr, r, lane, modp + l * 12288 + 4 * 2048);
        }
    }
    {
        bf16* KB = (bf16*)(F.ws + WS_KEYS);
        for (int i = gt; i < 2 * 8 * 2 * 128 * 128 / 8; i += NGT) { const f32x4 a = *(const f32x4*)(F.in[I_KEYS] + (size_t)i * 8), b = *(const f32x4*)(F.in[I_KEYS] + (size_t)i * 8 + 4);
            u32x4 o; o.x = pk2(a[0], a[1]); o.y = pk2(a[2], a[3]); o.z = pk2(b[0], b[1]); o.w = pk2(b[2], b[3]); *(u32x4*)(KB + (size_t)i * 8) = o; }
        bf16* GW = (bf16*)(F.ws + WS_GWS);
        for (int i = gt; i < 2 * 8 * 128 * 128 / 8; i += NGT) { const int e = i * 8, jj = e & 127, ii = (e >> 7) & 127; const bool keep = (ii >= 64) || (jj < 64);
            f32x4 a = *(const f32x4*)(F.in[I_GWS] + (size_t)i * 8), b = *(const f32x4*)(F.in[I_GWS] + (size_t)i * 8 + 4);
            if (!keep) { a = (f32x4){0.f, 0.f, 0.f, 0.f}; b = a; }
            u32x4 o; o.x = pk2(a[0], a[1]); o.y = pk2(a[2], a[3]); o.z = pk2(b[0], b[1]); o.w = pk2(b[2], b[3]); *(u32x4*)(GW + (size_t)i * 8) = o; }
    }
}

template <bool SRC_BF16>
__device__ __forceinline__ void phase_norm(Frame& F, const void* xsrc, const float* gain, const float* scale, const float* shift) {
    PH_LOCALS
    const int gw = F.vcu * NWAVES + wave, NGW = F.G * NWAVES;
    bf16* H = (bf16*)(F.ws + WS_H);
    for (int m = gw; m < M; m += 2 * NGW) {
        const int m2 = m + NGW;
        f32x4 va[4][2], vb[4][2];
        const char* ra = (const char*)xsrc + (size_t)m * DM * (SRC_BF16 ? 2 : 4); const char* rb = (const char*)xsrc + (size_t)(m2 < M ? m2 : m) * DM * (SRC_BF16 ? 2 : 4);
        load_row<SRC_BF16>(ra, lane, va); load_row<SRC_BF16>(rb, lane, vb);
        u32x4 oa[4], ob[4]; norm_mod_row(va, gain, scale, shift, lane, oa); norm_mod_row(vb, gain, scale, shift, lane, ob);
#pragma unroll
        for (int j = 0; j < 4; ++j) *(u32x4*)(H + (size_t)m * DM + j * 512 + lane * 8) = oa[j];
        if (m2 < M) {
#pragma unroll
            for (int j = 0; j < 4; ++j) *(u32x4*)(H + (size_t)m2 * DM + j * 512 + lane * 8) = ob[j]; }
    }
}
__device__ __forceinline__ void phase_sloc(Frame& F, int l) {
    PH_LOCALS
    const bf16* XS = (const bf16*)(F.ws + WS_XS); const bf16* WG = (const bf16*)(F.ws + WS_WG) + (size_t)l * 64 * 128 * 1024; float* SL = (float*)(F.ws + WS_SLOC);
    LAS unsigned char* WL = F.lds;
    const int fr = lane & 15, fq = lane >> 4;
    for (int u = F.vcu; u < 256; u += F.G) {
        const int g = u >> 2, jq = u & 3;
        const bf16* xp0 = XS + ((size_t)(g * 256 + 32 * wave + fr)) * 1024 + 8 * fq;
        bf16x8 xa[8][2];
#pragma unroll
        for (int i = 0; i < 8; ++i) { xa[i][0] = *(const bf16x8*)(xp0 + i * 32); xa[i][1] = *(const bf16x8*)(xp0 + 16 * 1024 + i * 32); }
        __syncthreads();
#pragma unroll
        for (int ps = 0; ps < 8; ++ps) { const int idx = ps * 512 + tid, row = idx >> 7, c16 = idx & 127;
            *(LAS u32x4*)(WL + row * 2064 + c16 * 16) = *(const u32x4*)(WG + ((size_t)(g * 128 + jq * 32 + row)) * 1024 + c16 * 8); }
        __syncthreads();
        f32x4 acc[2][2];
#pragma unroll
        for (int a = 0; a < 2; ++a) { acc[a][0] = (f32x4){0.f, 0.f, 0.f, 0.f}; acc[a][1] = acc[a][0]; }
#pragma unroll 1
        for (int kg = 0; kg < 4; ++kg) {
            bf16x8 xn[8][2];
            if (kg < 3) {
#pragma unroll
                for (int i = 0; i < 8; ++i) { xn[i][0] = *(const bf16x8*)(xp0 + ((kg + 1) * 8 + i) * 32); xn[i][1] = *(const bf16x8*)(xp0 + 16 * 1024 + ((kg + 1) * 8 + i) * 32); }
            }
#pragma unroll
            for (int i = 0; i < 8; ++i) { const int kb = kg * 8 + i;
#pragma unroll
                for (int jt = 0; jt < 2; ++jt) { const bf16x8 wf = *(const LAS bf16x8*)(WL + (jt * 16 + fr) * 2064 + (kb * 32 + 8 * fq) * 2);
                    acc[0][jt] = __builtin_amdgcn_mfma_f32_16x16x32_bf16(wf, xa[i][0], acc[0][jt], 0, 0, 0);
                    acc[1][jt] = __builtin_amdgcn_mfma_f32_16x16x32_bf16(wf, xa[i][1], acc[1][jt], 0, 0, 0); } }
            if (kg < 3) {
#pragma unroll
                for (int i = 0; i < 8; ++i) { xa[i][0] = xn[i][0]; xa[i][1] = xn[i][1]; }
            }
        }
#pragma unroll
        for (int a = 0; a < 2; ++a)
#pragma unroll
            for (int jt = 0; jt < 2; ++jt) *(f32x4*)(SL + ((size_t)(g * 256 + 32 * wave + 16 * a + fr)) * 128 + jq * 32 + jt * 16 + 4 * fq) = acc[a][jt];
    }
    __syncthreads();
}
__device__ __forceinline__ void phase_gating(Frame& F, int l) {
    PH_LOCALS
    const bf16* Z = (const bf16*)(F.ws + WS_Z); const float* PLN = (const float*)(F.ws + WS_PLN);
    bf16* MIX = (bf16*)(F.ws + WS_MIX);
    LAS bf16* VT = (LAS bf16*)F.lds;
    constexpr int VS = 136;
    const int j = tid >> 2, cs = (tid & 3) * 32;
    const int fr = lane & 15, fq = lane >> 4, w = wave;
    u32x4 tw[4]; float mu = 0.f, rs = 0.f;
#define GT_LOAD(unit_) do { const int nb_ = (unit_) >> 3, hh_ = (unit_) & 7; const size_t rowo = (size_t)(nb_ * 128 + j) * 2048 + 1024 + hh_ * 128 + cs; \
        _Pragma("unroll") for (int q = 0; q < 4; ++q) tw[q] = *(const u32x4*)(Z + rowo + q * 8); \
        { const float* pl = PLN + (size_t)(nb_ * 128 + j) * 32; float a1 = 0.f, a2 = 0.f; \
          _Pragma("unroll") for (int i = 0; i < 8; ++i) { const f32x4 pv = *(const f32x4*)(pl + 4 * i); a1 += pv[0] + pv[2]; a2 += pv[1] + pv[3]; } \
          mu = a1 * (1.0f / 1024.0f); rs = 1.0f / sqrtf(fmaxf(a2 * (1.0f / 1024.0f) - mu * mu, 0.f) + EPS); } } while (0)
    if (F.vcu < 1024) GT_LOAD(F.vcu);
    for (int unit = F.vcu; unit < 1024; unit += F.G) {
        const int nb = unit >> 3, hh = unit & 7, t0 = nb * 128, c0 = hh * 128;
        const bf16* GW = (const bf16*)(F.ws + WS_GWS) + (size_t)(l * 8 + hh) * 128 * 128;
        {
            const float* lg = F.in[I_LNG] + l * 1024 + c0 + cs; const float* lb = F.in[I_LNB] + l * 1024 + c0 + cs;
#pragma unroll
            for (int q = 0; q < 4; ++q) {
                const f32x4 g0 = *(const f32x4*)(lg + q * 8), g1 = *(const f32x4*)(lg + q * 8 + 4), b0 = *(const f32x4*)(lb + q * 8), b1 = *(const f32x4*)(lb + q * 8 + 4);
#pragma unroll
                for (int e = 0; e < 4; ++e) { const int c = cs + q * 8 + 2 * e;
                    const float ga = e < 2 ? g0[2 * e] : g1[2 * e - 4], gb = e < 2 ? g0[2 * e + 1] : g1[2 * e - 3], ba = e < 2 ? b0[2 * e] : b1[2 * e - 4], bb = e < 2 ? b0[2 * e + 1] : b1[2 * e - 3];
                    const float a = (bflo(tw[q][e]) - mu) * rs * ga + ba, b = (bfhi(tw[q][e]) - mu) * rs * gb + bb;
                    VT[c * VS + j] = (bf16)f2bf(a); VT[(c + 1) * VS + j] = (bf16)f2bf(b); }
            }
        }
        if (unit + F.G < 1024) GT_LOAD(unit + F.G);
        const int nkb = (w < 4) ? 2 : 4;
        bf16x8 wf[4];
#pragma unroll
        for (int kb = 0; kb < 4; ++kb) wf[kb] = *(const bf16x8*)(GW + (size_t)(16 * w + fr) * 128 + (kb < nkb ? kb : 0) * 32 + 8 * fq);
        const int tok = t0 + 16 * w + fr; const float bs = F.in[I_GBS][(l * 8 + hh) * 128 + 16 * w + fr];
        u32x2 uw[8];
#pragma unroll
        for (int ct = 0; ct < 8; ++ct) uw[ct] = *(const u32x2*)(Z + (size_t)tok * 2048 + c0 + ct * 16 + 4 * fq);
        __syncthreads();
        {
            f32x4 acc[8];
#pragma unroll
            for (int ct = 0; ct < 8; ++ct) acc[ct] = (f32x4){0.f, 0.f, 0.f, 0.f};
#pragma unroll
            for (int kb = 0; kb < 4; ++kb) { if (kb < nkb) {
#pragma unroll
                for (int ct = 0; ct < 8; ++ct) { const bf16x8 vf = *(const LAS bf16x8*)(VT + (ct * 16 + fr) * VS + kb * 32 + 8 * fq); acc[ct] = __builtin_amdgcn_mfma_f32_16x16x32_bf16(vf, wf[kb], acc[ct], 0, 0, 0); } } }
            float ssq = 0.f;
#pragma unroll
            for (int ct = 0; ct < 8; ++ct) { const int c = c0 + ct * 16 + 4 * fq;
                const float o0 = bflo(uw[ct].x) * (acc[ct][0] + bs), o1 = bfhi(uw[ct].x) * (acc[ct][1] + bs), o2 = bflo(uw[ct].y) * (acc[ct][2] + bs), o3 = bfhi(uw[ct].y) * (acc[ct][3] + bs);
                u32x2 o; o.x = pk2(o0, o1); o.y = pk2(o2, o3);
                *(u32x2*)(MIX + (size_t)tok * 2048 + c) = o; ssq += (o0 * o0 + o1 * o1) + (o2 * o2 + o3 * o3); }
            ssq += __shfl_xor(ssq, 16); ssq += __shfl_xor(ssq, 32);
            if (fq == 0) ((float*)(F.ws + WS_PSA))[(size_t)tok * 8 + hh] = ssq;
        }
        __syncthreads();
    }
#undef GT_LOAD
}

__device__ __forceinline__ void phase_s5out(Frame& F, int l) {
    PH_LOCALS
    const bf16* XS = (const bf16*)(F.ws + WS_XS);
    bf16* Gb = (bf16*)(F.ws + WS_G);
    LAS unsigned char* HT = F.lds;
    LAS float* TS = (LAS float*)(F.lds + 34816);
    LAS unsigned char* KT = F.lds + 38912;
    LAS unsigned char* VT = F.lds + 79872;
    const int fr = lane & 15, fq = lane >> 4;
    int have_g = -1, have_nh = -1;
    for (int uu = F.vcu, it = 0; uu < 512; uu += F.G, ++it) {
        const int g = (F.G == 256) ? (F.vcu >> 2) : (uu >> 3), nh = (F.G == 256) ? ((F.vcu >> 1) & 1) : (uu & 1), rc = (F.G == 256) ? ((F.vcu & 1) + 2 * it) : ((uu >> 1) & 3);
        const bool fresh = (g != have_g) || (nh != have_nh);
        const bf16* VG = (const bf16*)(F.ws + WS_VG) + (size_t)(l * 64 + g) * 1024 * 128;
        const int n = nh * 128 + 16 * wave + fr;
        const bf16* xp0 = XS + ((size_t)(g * 256 + n)) * 1024 + 8 * fq;
        bf16x8 xa[4], xb[4];
#pragma unroll
        for (int i = 0; i < 4; ++i) xa[i] = *(const bf16x8*)(xp0 + i * 32);
        __syncthreads();
        { const u32x4* src = (const u32x4*)((const bf16*)(F.ws + WS_KTAB) + (size_t)(l * 64 + g) * 80 * 256);
          if (fresh) for (int i = tid; i < 80 * 256 / 8; i += NTHR) ((LAS u32x4*)KT)[i] = src[i];
#pragma unroll
          for (int ps = 0; ps < 8; ++ps) { const int row = ps * 32 + (tid >> 4), c = tid & 15, q = row >> 4, o = row & 15;
              *(LAS u32x4*)(VT + row * 272 + c * 16) = *(const u32x4*)(VG + (size_t)((rc + 4 * q) * 16 + o) * 128 + c * 8); } }
        if (fresh) {
            const int p = lane, seg = wave;
            const float* AT = (const float*)(F.ws + WS_AT) + ((size_t)(l * 64 + g) * 64 + p) * 2; const float ar = AT[0], ai = AT[1];
            const float* SL = (const float*)(F.ws + WS_SLOC) + ((size_t)(g * 256 + seg * 32)) * 128 + p;
            float sr[32], si[32];
#pragma unroll
            for (int i = 0; i < 32; ++i) { sr[i] = SL[(size_t)i * 128]; si[i] = SL[(size_t)i * 128 + 64]; }
            float er = 0.f, ei = 0.f;
#pragma unroll
            for (int i = 0; i < 32; ++i) { const float nr = ar * er - ai * ei + sr[i], ni = ar * ei + ai * er + si[i]; er = nr; ei = ni; }
            TS[(seg * 64 + p) * 2] = er; TS[(seg * 64 + p) * 2 + 1] = ei;
            float qr = ar, qi = ai;
#pragma unroll
            for (int s = 0; s < 5; ++s) { const float nr = qr * qr - qi * qi, ni = 2.0f * qr * qi; qr = nr; qi = ni; }
            __syncthreads();
            float hr = 0.f, hi = 0.f;
            for (int k = 0; k < seg; ++k) { const float tr = TS[(k * 64 + p) * 2], ti = TS[(k * 64 + p) * 2 + 1]; const float nr = qr * hr - qi * hi + tr, ni = qr * hi + qi * hr + ti; hr = nr; hi = ni; }
            if ((seg >> 2) == nh) {
                LAS bf16* hrow = (LAS bf16*)(HT + ((seg & 3) * 32) * 272) + p;
#pragma unroll
                for (int i = 0; i < 32; ++i) { hrow[i * 136] = (bf16)f2bf(hr); hrow[i * 136 + 64] = (bf16)f2bf(hi);
                    const float nr = ar * hr - ai * hi + sr[i], ni = ar * hi + ai * hr + si[i]; hr = nr; hi = ni; }
            }
        }
        have_g = g; have_nh = nh;
        __syncthreads();
        f32x4 acc[16];
#pragma unroll
        for (int q = 0; q < 16; ++q) acc[q] = (f32x4){0.f, 0.f, 0.f, 0.f};
        const int kb0 = ((rc - (fq >> 1) + 10) * 16 + fr) * 32 + 16 * (fq & 1);
#define S5_GROUP(XF, grp_) do { const LAS unsigned char* kp = KT + kb0 - (grp_) * 4096; \
            _Pragma("unroll") for (int q = 0; q < 16; ++q) { if (rc + 4 * q >= 8 * (grp_)) { \
                _Pragma("unroll") for (int i = 0; i < 4; ++i) { const bf16x8 kf = *(const LAS bf16x8*)(kp + (4 * q - 2 * i + 6) * 512); \
                    acc[q] = __builtin_amdgcn_mfma_f32_16x16x32_bf16(kf, XF[i], acc[q], 0, 0, 0); } } } } while (0)
#pragma unroll 1
        for (int gp = 0; gp < 4; ++gp) {
#pragma unroll
            for (int i = 0; i < 4; ++i) xb[i] = *(const bf16x8*)(xp0 + ((2 * gp + 1) * 4 + i) * 32);
            S5_GROUP(xa, 2 * gp);
            if (gp < 3) {
#pragma unroll
                for (int i = 0; i < 4; ++i) xa[i] = *(const bf16x8*)(xp0 + ((2 * gp + 2) * 4 + i) * 32);
            }
            S5_GROUP(xb, 2 * gp + 1);
        }
#undef S5_GROUP
#pragma unroll 1
        for (int jb = 0; jb < 4; ++jb) {
            const bf16x8 hf = *(const LAS bf16x8*)(HT + (16 * wave + fr) * 272 + (jb * 32 + 8 * fq) * 2);
#pragma unroll
            for (int q = 0; q < 16; ++q) {
                const bf16x8 vf = *(const LAS bf16x8*)(VT + (q * 16 + fr) * 272 + (jb * 32 + 8 * fq) * 2);
                acc[q] = __builtin_amdgcn_mfma_f32_16x16x32_bf16(vf, hf, acc[q], 0, 0, 0);
            }
        }
#pragma unroll
        for (int q = 0; q < 16; ++q) {
            const int t = rc + 4 * q, tok = 64 * n + t;
            const f32x4 y = acc[q];
            u32x2 o; o.x = pk2(gelu_tanh(y[0]), gelu_tanh(y[1])); o.y = pk2(gelu_tanh(y[2]), gelu_tanh(y[3]));
            *(u32x2*)(Gb + (size_t)tok * 1024 + g * 16 + 4 * fq) = o;
#if SELFTEST_S5
            if (tok < 256) *(f32x4*)((float*)(F.ws + WS_DBG) + (size_t)tok * 1024 + g * 16 + 4 * fq) = y;
#endif
        }
    }
    __syncthreads();
}
#if SELFTEST_S5
__device__ __forceinline__ void selftest_s5(Frame& F, int l) {
    PH_LOCALS
    if (F.vcu < 64 && wave == 0) {
        const int g = F.vcu, p = lane;
        const float dt = expf(F.in[I_LDT][l * 64 + g]);
        const float lr = F.in[I_LRE][(l * 64 + g) * 64 + p], li = F.in[I_LIM][(l * 64 + g) * 64 + p];
        const float mag = expf(lr * dt); float sn, cs; sincosf(li * dt, &sn, &cs);
        const float ar = mag * cs, ai = mag * sn;
        const float xr = ar - 1.0f, xi = ai, den = 1.0f / (lr * lr + li * li);
        const float cr = (xr * lr + xi * li) * den, ci = (xi * lr - xr * li) * den;
        float bbr[16], bbi[16], ccr[16], cci[16];
#pragma unroll
        for (int i = 0; i < 16; ++i) { const float br = F.in[I_BRE][((size_t)(l * 64 + g) * 64 + p) * 16 + i], bi = F.in[I_BIM][((size_t)(l * 64 + g) * 64 + p) * 16 + i];
            bbr[i] = cr * br - ci * bi; bbi[i] = cr * bi + ci * br;
            ccr[i] = F.in[I_CRE][((size_t)(l * 64 + g) * 16 + i) * 64 + p]; cci[i] = F.in[I_CIM][((size_t)(l * 64 + g) * 16 + i) * 64 + p]; }
        const bf16* XS = (const bf16*)(F.ws + WS_XS) + (size_t)g * 256 * 1024;
        const float* DY = (const float*)(F.ws + WS_DBG);
        float sr = 0.f, si = 0.f, err = 0.f, ref = 0.f;
        for (int t = 0; t < 256; ++t) {
            float x[16];
#pragma unroll
            for (int i = 0; i < 16; ++i) x[i] = bflo((unsigned)XS[(size_t)t * 16 + i]);
            float ur = 0.f, ui = 0.f;
#pragma unroll
            for (int i = 0; i < 16; ++i) { ur += bbr[i] * x[i]; ui += bbi[i] * x[i]; }
            const float nr = ar * sr - ai * si + ur, ni = ar * si + ai * sr + ui; sr = nr; si = ni;
#pragma unroll
            for (int o = 0; o < 16; ++o) {
                const float yr = wave_sum(ccr[o] * sr - cci[o] * si);
                const float yf = DY[(size_t)t * 1024 + g * 16 + o];
                err += (yf - yr) * (yf - yr); ref += yr * yr;
            }
        }
        if (lane == 0 && !(err <= 2e-3f * ref)) __hip_atomic_fetch_or((unsigned*)(F.ws + WS_CTL) + CW_FLAG, 1u, RLX_AGENT);
    }
}
#endif

__device__ __forceinline__ unsigned f2key(float v) { const unsigned u = __builtin_bit_cast(unsigned, v); return (u & 0x80000000u) ? ~u : (u | 0x80000000u); }
__device__ __forceinline__ float key2f(unsigned k) { const unsigned u = (k & 0x80000000u) ? (k & 0x7fffffffu) : ~k; return __builtin_bit_cast(float, u); }
__device__ __forceinline__ void sort16_desc(unsigned (&v)[16]) {
#pragma unroll
    for (int lk = 1; lk <= 4; ++lk) {
#pragma unroll
        for (int lj = lk - 1; lj >= 0; --lj) {
#pragma unroll
            for (int i = 0; i < 16; ++i) { const int k = 1 << lk, j = 1 << lj, p = i ^ j;
                if (p > i) { const unsigned a = v[i], c = v[p], hi = a > c ? a : c, lo = a > c ? c : a; const bool desc = ((i & k) == 0) || (k == 16);
                    v[i] = desc ? hi : lo; v[p] = desc ? lo : hi; } }
        }
    }
}
__device__ __forceinline__ void merge16_desc(unsigned (&v)[16], const unsigned (&w)[16]) {
#pragma unroll
    for (int i = 0; i < 16; ++i) v[i] = v[i] > w[15 - i] ? v[i] : w[15 - i];
#pragma unroll
    for (int lj = 3; lj >= 0; --lj) {
#pragma unroll
        for (int i = 0; i < 16; ++i) { const int j = 1 << lj, p = i ^ j;
            if (p > i) { const unsigned a = v[i], c = v[p]; v[i] = a > c ? a : c; v[p] = a > c ? c : a; } }
    }
}
__device__ __forceinline__ void xmerge16(unsigned (&v)[16], int mask) {
    unsigned w[16];
#pragma unroll
    for (int i = 0; i < 16; ++i) w[i] = (unsigned)__shfl_xor((int)v[i], mask);
    merge16_desc(v, w);
}
__device__ __forceinline__ void phase_topk(Frame& F, int l) {
    PH_LOCALS
    const bf16* Q = (const bf16*)(F.ws + WS_Z);
    const bf16* KB = (const bf16*)(F.ws + WS_KEYS) + (size_t)l * 8 * 2 * 128 * 128;
    int* EID = (int*)(F.ws + WS_EID); float* GT = (float*)(F.ws + WS_GATE); float* SUo = (float*)(F.ws + WS_SU);
    const float* SCL = (const float*)(F.ws + WS_SCL) + (size_t)l * NEXP * 2;
    LAS unsigned char* KL = F.lds;
    LAS unsigned* LST = (LAS unsigned*)(F.lds + 69632);
    LAS unsigned char* PT = F.lds + 69632 + 16384;
    const int fr = lane & 15, fq = lane >> 4;
    {
        int c = 0;
#pragma unroll
        for (int i = 0; i < 16; ++i)
#pragma unroll
            for (int j = 0; j < 16; ++j) if ((i + 1) * (j + 1) <= 16) { if (tid == c) PT[c] = (unsigned char)(i * 16 + j); ++c; }
    }
    int cur_hh = -1;
    for (int u = F.vcu; u < 1024; u += F.G) {
        const int tt = u >> 3, hh = u & 7, t0 = tt * 128;
        bf16x8 qf[2][4];
#pragma unroll
        for (int s = 0; s < 2; ++s)
#pragma unroll
            for (int kb = 0; kb < 4; ++kb) qf[s][kb] = *(const bf16x8*)(Q + (size_t)(t0 + 16 * wave + fr) * 2048 + hh * 256 + s * 128 + kb * 32 + 8 * fq);
        if (hh != cur_hh) {
            __syncthreads();
#pragma unroll
            for (int ps = 0; ps < 8; ++ps) { const int idx = ps * 512 + tid, row = idx >> 4, c16 = idx & 15;
                *(LAS u32x4*)(KL + row * 272 + c16 * 16) = *(const u32x4*)(KB + ((size_t)(hh * 256 + row)) * 128 + c16 * 8); }
            cur_hh = hh;
            __syncthreads();
        }
#pragma unroll 1
        for (int s = 0; s < 2; ++s) {
            f32x4 acc[8];
#pragma unroll
            for (int nt = 0; nt < 8; ++nt) acc[nt] = (f32x4){0.f, 0.f, 0.f, 0.f};
#pragma unroll
            for (int kb = 0; kb < 4; ++kb) { const bf16x8 q = s ? qf[1][kb] : qf[0][kb];
#pragma unroll
                for (int nt = 0; nt < 8; ++nt) { const bf16x8 kf = *(const LAS bf16x8*)(KL + (s * 128 + nt * 16 + fr) * 272 + (kb * 32 + 8 * fq) * 2);
                    acc[nt] = __builtin_amdgcn_mfma_f32_16x16x32_bf16(kf, q, acc[nt], 0, 0, 0); } }
            unsigned va[16], vb[16];
#pragma unroll
            for (int nt = 0; nt < 4; ++nt)
#pragma unroll
                for (int r = 0; r < 4; ++r) { va[4 * nt + r] = (f2key(acc[nt][r]) & ~0x7Fu) | (unsigned)(127 - (nt * 16 + 4 * fq + r));
                    vb[4 * nt + r] = (f2key(acc[4 + nt][r]) & ~0x7Fu) | (unsigned)(127 - ((4 + nt) * 16 + 4 * fq + r)); }
            sort16_desc(va); sort16_desc(vb); merge16_desc(va, vb);
            xmerge16(va, 16); xmerge16(va, 32);
            if (fq == 0) {
#pragma unroll
                for (int k = 0; k < 16; k += 4) *(LAS u32x4*)(LST + ((16 * wave + fr) * 2 + s) * 16 + k) = (u32x4){va[k], va[k + 1], va[k + 2], va[k + 3]};
            }
        }
        asm volatile("s_waitcnt lgkmcnt(0)" ::: "memory");
        {
            const int tl = 16 * wave + (lane >> 2), c4 = lane & 3;
            unsigned v[16];
#pragma unroll
            for (int m = 0; m < 13; ++m) { const int c = m * 4 + c4; unsigned key = 0u;
                if (c < 50) { const int pij = PT[c], i = pij >> 4, j = pij & 15;
                    const float av = key2f(LST[(tl * 2 + 0) * 16 + i] & ~0x7Fu), bv = key2f(LST[(tl * 2 + 1) * 16 + j] & ~0x7Fu);
                    key = (f2key(av + bv) & ~0xFFu) | (unsigned)(255 - pij); }
                v[m] = key; }
#pragma unroll
            for (int m = 13; m < 16; ++m) v[m] = 0u;
            sort16_desc(v);
            xmerge16(v, 1); xmerge16(v, 2);
            float ev[16]; float sum = 0.f; const float mx = key2f(v[0] & ~0xFFu);
#pragma unroll
            for (int k = 0; k < 16; ++k) { ev[k] = __expf(key2f(v[k] & ~0xFFu) - mx); sum += ev[k]; }
            const float inv = 1.0f / sum;
            unsigned kk[4] = {v[0], v[1], v[2], v[3]}; float ee[4] = {ev[0], ev[1], ev[2], ev[3]};
#pragma unroll
            for (int q = 1; q < 4; ++q) { if (c4 == q) {
#pragma unroll
                for (int e = 0; e < 4; ++e) { kk[e] = v[4 * q + e]; ee[e] = ev[4 * q + e]; } } }
            const size_t ob = (size_t)(t0 + tl) * 128 + hh * 16 + 4 * c4;
            int eo[4]; float go[4], so[4];
#pragma unroll
            for (int e = 0; e < 4; ++e) { const int flat = 255 - (int)(kk[e] & 0xFFu), i = flat >> 4, j = flat & 15;
                const int ia = 127 - (int)(LST[(tl * 2 + 0) * 16 + i] & 0x7Fu), ib = 127 - (int)(LST[(tl * 2 + 1) * 16 + j] & 0x7Fu);
                eo[e] = ia * 128 + ib; }
#pragma unroll
            for (int e = 0; e < 4; ++e) { const f32x2 sc = *(const f32x2*)(SCL + 2 * eo[e]); go[e] = ee[e] * inv * sc.y; so[e] = sc.x; }
            *(u32x4*)(EID + ob) = (u32x4){(unsigned)eo[0], (unsigned)eo[1], (unsigned)eo[2], (unsigned)eo[3]};
            *(f32x4*)(GT + ob) = (f32x4){go[0], go[1], go[2], go[3]};
            *(f32x4*)(SUo + ob) = (f32x4){so[0], so[1], so[2], so[3]};
        }
        asm volatile("s_waitcnt lgkmcnt(0)" ::: "memory");
    }
    __syncthreads();
}

#define FP4X4(w, f0, f1, f2, f3) do { f0 = __builtin_amdgcn_cvt_scalef32_pk_f32_fp4((w), 1.0f, 0); f1 = __builtin_amdgcn_cvt_scalef32_pk_f32_fp4((w), 1.0f, 1); \
    f2 = __builtin_amdgcn_cvt_scalef32_pk_f32_fp4((w), 1.0f, 2); f3 = __builtin_amdgcn_cvt_scalef32_pk_f32_fp4((w), 1.0f, 3); } while (0)
__device__ __forceinline__ void phase_gather(Frame& F, int l, bool dummy = false) {
    PH_LOCALS
    const int gw = F.vcu * NWAVES + wave, NGW = F.G * NWAVES;
    bf16* Hn = dummy ? (bf16*)(F.ws + WS_DBG + 128 * MiB) : (bf16*)(F.ws + WS_H);
    const unsigned char* UT = F.ws + WS_UV + (size_t)l * NEXP * 2048;
    const unsigned char* VTb = UT + (size_t)NEXP * 1024;
    const int* EID = (const int*)(F.ws + WS_EID); const float* GT = (const float*)(F.ws + WS_GATE); const float* SU = (const float*)(F.ws + WS_SU);
    float* COEF = dummy ? (float*)(F.ws + WS_DBG + 192 * MiB) : (float*)(F.ws + WS_COEF);
    const bf16* X = (const bf16*)(F.ws + WS_X); bf16* Xo = dummy ? (bf16*)(F.ws + WS_DBG) : (bf16*)(F.ws + WS_X);
    const float* mod = (const float*)(F.ws + WS_MOD);
    const float* gate2 = mod + l * 12288 + 5 * 2048; const float* shift2 = mod + l * 12288 + 3 * 2048; const float* gs2 = (const float*)(F.ws + WS_GS) + l * DM;
    const unsigned lane16 = (unsigned)lane * 16u;
    const bool u32_ = (lane & 32) != 0, u16_ = (lane & 16) != 0, u8_ = (lane & 8) != 0, u4_ = (lane & 4) != 0;
#if GATHER_PROBE_HOT
#define G_HOT(e) if (dummy) e &= 15;
#else
#define G_HOT(e)
#endif
#define G_ROW(dst, tab, b_, h_) do { int e_ = __builtin_amdgcn_readlane((b_) < 4 ? e_lo : e_hi, (16 * (b_) + (h_)) & 63); G_HOT(e_) \
            dst = *(const u32x4*)((tab) + ((size_t)(unsigned)e_ << 10) + lane16); } while (0)
    for (int t = gw; t < M; t += NGW) {
        const int e_lo = EID[(size_t)t * 128 + lane], e_hi = EID[(size_t)t * 128 + 64 + lane];
        const float g_lo = GT[(size_t)t * 128 + lane], g_hi = GT[(size_t)t * 128 + 64 + lane];
        const float s_lo = SU[(size_t)t * 128 + lane], s_hi = SU[(size_t)t * 128 + 64 + lane];
        f32x2 hh[8][2];
        {   float s2 = 0.f; u32x2 xw[8];
#pragma unroll
            for (int j = 0; j < 8; ++j) xw[j] = *(const u32x2*)(X + (size_t)t * 2048 + j * 256 + lane * 4);
#pragma unroll
            for (int j = 0; j < 8; ++j) { hh[j][0] = (f32x2){bflo(xw[j].x), bfhi(xw[j].x)}; hh[j][1] = (f32x2){bflo(xw[j].y), bfhi(xw[j].y)};
                s2 += (hh[j][0].x * hh[j][0].x + hh[j][0].y * hh[j][0].y) + (hh[j][1].x * hh[j][1].x + hh[j][1].y * hh[j][1].y); }
            const float r2 = 1.0f / sqrtf(wave_sum(s2) * (1.0f / DM) + EPS);
#pragma unroll
            for (int j2 = 0; j2 < 8; j2 += 4) { f32x4 gsv[4], shv[4];
#pragma unroll
                for (int j = 0; j < 4; ++j) { gsv[j] = *(const f32x4*)(gs2 + (j2 + j) * 256 + lane * 4); shv[j] = *(const f32x4*)(shift2 + (j2 + j) * 256 + lane * 4); }
#pragma unroll
                for (int j = 0; j < 4; ++j) { hh[j2 + j][0] = (f32x2){hh[j2 + j][0].x * r2 * gsv[j][0] + shv[j][0], hh[j2 + j][0].y * r2 * gsv[j][1] + shv[j][1]}; hh[j2 + j][1] = (f32x2){hh[j2 + j][1].x * r2 * gsv[j][2] + shv[j][2], hh[j2 + j][1].y * r2 * gsv[j][3] + shv[j][3]}; } }
        }
        u32x4 ur[16];
#pragma unroll
        for (int h = 0; h < 16; ++h) G_ROW(ur[h], UT, 0, h);
#define G_UBATCH(b_, NEXT) { float p[16]; \
            _Pragma("unroll") for (int h = 0; h < 16; ++h) { f32x2 a2 = {0.f, 0.f}; \
                if (GATHER_PROBE_MEM && dummy) { a2.x = __builtin_bit_cast(float, ur[h][0] ^ ur[h][1] ^ ur[h][2] ^ ur[h][3]); } else { \
                _Pragma("unroll") for (int d = 0; d < 4; ++d) { f32x2 f0, f1, f2, f3; FP4X4(ur[h][d], f0, f1, f2, f3); \
                    a2 = f0 * hh[2 * d][0] + a2; a2 = f1 * hh[2 * d][1] + a2; a2 = f2 * hh[2 * d + 1][0] + a2; a2 = f3 * hh[2 * d + 1][1] + a2; } } \
                p[h] = a2.x + a2.y; if (NEXT) G_ROW(ur[h], UT, (b_) + 1, h); } \
            float a8[8]; \
            _Pragma("unroll") for (int i = 0; i < 8; ++i) { const float snd = u32_ ? p[i] : p[8 + i], kp = u32_ ? p[8 + i] : p[i]; a8[i] = kp + __shfl_xor(snd, 32); } \
            float a4[4]; \
            _Pragma("unroll") for (int i = 0; i < 4; ++i) { const float snd = u16_ ? a8[i] : a8[4 + i], kp = u16_ ? a8[4 + i] : a8[i]; a4[i] = kp + __shfl_xor(snd, 16); } \
            float b2[2]; \
            _Pragma("unroll") for (int i = 0; i < 2; ++i) { const float snd = u8_ ? a4[i] : a4[2 + i], kp = u8_ ? a4[2 + i] : a4[i]; b2[i] = kp + __shfl_xor(snd, 8); } \
            float d; { const float snd = u4_ ? b2[0] : b2[1], kp = u4_ ? b2[1] : b2[0]; d = kp + __shfl_xor(snd, 4); } \
            d += __shfl_xor(d, 2); d += __shfl_xor(d, 1);                   \
            const int hl = (16 * (b_) + (lane >> 2)) & 63; const float gsel = (b_) < 4 ? g_lo : g_hi, ssel = (b_) < 4 ? s_lo : s_hi; \
            const float coefq = __shfl(gsel, hl) * gelu_tanh(d * __shfl(ssel, hl)); \
            if ((lane & 3) == 0) COEF[(size_t)t * 128 + 16 * (b_) + (lane >> 2)] = coefq; }
#pragma unroll 1
        for (int b = 0; b < 7; ++b) G_UBATCH(b, true)
        G_UBATCH(7, false)
#undef G_UBATCH
    }
    asm volatile("s_waitcnt vmcnt(0)" ::: "memory");
    for (int t = gw; t < M; t += NGW) {
        const int e_lo = EID[(size_t)t * 128 + lane], e_hi = EID[(size_t)t * 128 + 64 + lane];
        const float c_lo = COEF[(size_t)t * 128 + lane], c_hi = COEF[(size_t)t * 128 + 64 + lane];
        u32x4 vr[16];
#pragma unroll
        for (int h = 0; h < 16; ++h) G_ROW(vr[h], VTb, 0, h);
        f32x2 of[8][2];
#pragma unroll
        for (int j = 0; j < 8; ++j) { of[j][0] = (f32x2){0.f, 0.f}; of[j][1] = (f32x2){0.f, 0.f}; }
#define G_VBATCH(b_, NEXT) { const float csel = (b_) < 4 ? c_lo : c_hi; \
            _Pragma("unroll") for (int h = 0; h < 16; ++h) { const float cf = __builtin_bit_cast(float, __builtin_amdgcn_readlane(__builtin_bit_cast(int, csel), (16 * (b_) + h) & 63)); const f32x2 cf2 = {cf, cf}; \
                if (GATHER_PROBE_MEM && dummy) { of[0][0].x += cf * __builtin_bit_cast(float, vr[h][0] ^ vr[h][1] ^ vr[h][2] ^ vr[h][3]); } else { \
                _Pragma("unroll") for (int dd = 0; dd < 4; ++dd) { f32x2 f0, f1, f2, f3; FP4X4(vr[h][dd], f0, f1, f2, f3); \
                    of[2 * dd][0] = f0 * cf2 + of[2 * dd][0]; of[2 * dd][1] = f1 * cf2 + of[2 * dd][1]; of[2 * dd + 1][0] = f2 * cf2 + of[2 * dd + 1][0]; of[2 * dd + 1][1] = f3 * cf2 + of[2 * dd + 1][1]; } } \
                if (NEXT) G_ROW(vr[h], VTb, (b_) + 1, h); } }
#pragma unroll 1
        for (int b = 0; b < 7; ++b) G_VBATCH(b, true)
        G_VBATCH(7, false)
#undef G_VBATCH
        int ln = lane; asm volatile("" : "+v"(ln));
        u32x2 cx[8];
#pragma unroll
        for (int j = 0; j < 8; ++j) cx[j] = *(const u32x2*)(X + (size_t)t * 2048 + j * 256 + ln * 4);
        f32x4 xv[8]; float ss = 0.f;
#pragma unroll
        for (int j2 = 0; j2 < 8; j2 += 4) { f32x4 g2v[4];
#pragma unroll
            for (int j = 0; j < 4; ++j) g2v[j] = *(const f32x4*)(gate2 + (j2 + j) * 256 + ln * 4);
#pragma unroll
            for (int jj = 0; jj < 4; ++jj) { const int j = j2 + jj;
                const f32x4 xo = {bflo(cx[j].x), bfhi(cx[j].x), bflo(cx[j].y), bfhi(cx[j].y)};
                const f32x4 o = {of[j][0].x, of[j][0].y, of[j][1].x, of[j][1].y};
                xv[j] = xo + g2v[jj] * o;
                ss += (xv[j][0] * xv[j][0] + xv[j][1] * xv[j][1]) + (xv[j][2] * xv[j][2] + xv[j][3] * xv[j][3]); } }
        const float rr = 1.0f / sqrtf(wave_sum(ss) * (1.0f / DM) + EPS);
        if (l + 1 < DEPTH) {
            const float* m2 = mod + (l + 1) * 12288; const float* gain = F.in[I_N1G] + (l + 1) * 2048;
#pragma unroll
            for (int j2 = 0; j2 < 8; j2 += 4) { f32x4 gv[4], scv[4], shv[4];
#pragma unroll
                for (int j = 0; j < 4; ++j) { const int c = (j2 + j) * 256 + ln * 4; gv[j] = *(const f32x4*)(gain + c); scv[j] = *(const f32x4*)(m2 + 2048 + c); shv[j] = *(const f32x4*)(m2 + c); }
#pragma unroll
                for (int jj = 0; jj < 4; ++jj) { const int j = j2 + jj, c = j * 256 + ln * 4;
                    *(u32x2*)(Xo + (size_t)t * 2048 + c) = (u32x2){pk2(xv[j][0], xv[j][1]), pk2(xv[j][2], xv[j][3])};
                    const f32x4 y = xv[j] * rr * gv[jj] * (scv[jj] + 1.0f) + shv[jj];
                    *(u32x2*)(Hn + (size_t)t * 2048 + c) = (u32x2){pk2(y[0], y[1]), pk2(y[2], y[3])}; } }
        } else {
#pragma unroll
            for (int j = 0; j < 8; ++j) { const int c = j * 256 + ln * 4; const f32x4 fgv = *(const f32x4*)(F.in[I_FG] + c);
                f32x4 ov = xv[j] * rr * fgv;
#if SELFTEST_S5
                if (__hip_atomic_load((unsigned*)(F.ws + WS_CTL) + CW_FLAG, RLX_AGENT) != 0u) ov = (f32x4){1e30f, 1e30f, 1e30f, 1e30f};
#endif
                *(f32x4*)(F.out + (size_t)t * 2048 + c) = ov; }
        }
    }
}

__global__ void __launch_bounds__(NTHR, 2) fwd_kernel(Args args) {
    extern __shared__ __attribute__((aligned(16))) unsigned char lds_raw[];
    Frame F;
    F.lds = (LAS unsigned char*)lds_raw; F.ws = args.ws; F.in = args.in; F.out = args.out;
    F.tid = threadIdx.x; F.lane = F.tid & 63; F.wave = __builtin_amdgcn_readfirstlane(F.tid >> 6);
    F.G = gridDim.x; { const int bx = blockIdx.x; F.vcu = (F.G % 8 == 0) ? (bx % 8) * (F.G / 8) + bx / 8 : bx; }
    volatile LAS unsigned* MISC = (volatile LAS unsigned*)(F.lds + MISC_OFF);
    if (F.tid < 64) MISC[F.tid] = 0u;
    __syncthreads();
    unsigned* ctl = (unsigned*)(F.ws + WS_CTL);
    XcdBarrier bar; bar.bar = ctl + CW_BAR; bar.x = 0; bar.st = nullptr;
#if !MK_PER_PHASE
    bar = xcd_barrier_post(ctl + CW_BAR, MISC + 8);
#endif
    const int lo = args.ph_lo, hi = args.ph_hi;
#define IN(k) (lo <= (k) && (k) < hi)
#if MK_PER_PHASE
#define SEAM(k) do { } while (0)
#else
#define SEAM(k) do { if (IN(k) && IN((k) + 1)) xcd_barrier(bar); } while (0)
#endif
    const float* mod = (const float*)(F.ws + WS_MOD);

#define REP(k) (REPEAT_PH == (k))
#define RUN2(k, first, real) do { if (REP(k)) { first; xcd_barrier(bar); } real; } while (0)
    if (IN(0)) { RUN2(13, p0_tables(F, 5, true), p0_tables(F, 4, false)); } SEAM(0);
    for (int l = 0; l < DEPTH; ++l) {
        const int pb = 1 + 12 * l;
        const float* ml = mod + l * 12288;
        if (IN(pb + 0)) { if (l == 0) { RUN2(0, p0_prologue(F), p0_prologue(F)); RUN2(1, phase_norm<false>(F, F.in[I_X], F.in[I_N1G] + l * 2048, ml + 1 * 2048, ml + 0 * 2048), phase_norm<false>(F, F.in[I_X], F.in[I_N1G] + l * 2048, ml + 1 * 2048, ml + 0 * 2048)); } } SEAM(pb + 0);
        if (IN(pb + 1)) {
            pg8::Gemm g{(const bf16*)(F.ws + WS_H), (const bf16*)(F.ws + WS_WIN) + (size_t)l * INW * DM, M, INW, DM}; pg8::StaticOrder S; S.init(M, INW, F.G, (int)blockIdx.x);
            EpiIn E{(bf16*)(F.ws + WS_Z), (bf16*)(F.ws + WS_XS), F.in[I_BIN] + l * INW, (float*)(F.ws + WS_PLN)};
#define GEMM_IN pg8::gemm_phase<EpiIn, pg8::StaticOrder, true, true>(F.lds, g, S, E)
            RUN2(2, GEMM_IN, GEMM_IN);
        } SEAM(pb + 1);
        if (IN(pb + 2)) { RUN2(3, phase_sloc(F, l), phase_sloc(F, l)); } SEAM(pb + 2);
        if (IN(pb + 3)) { RUN2(5, phase_s5out(F, l), phase_s5out(F, l)); RUN2(4, phase_gating(F, l), phase_gating(F, l));
#if SELFTEST_S5
            xcd_barrier(bar); selftest_s5(F, l);
#endif
        } SEAM(pb + 4);
        if (IN(pb + 5)) {
            pg8::Gemm g{(const bf16*)(F.ws + WS_G), (const bf16*)(F.ws + WS_GLU) + (size_t)l * WB * WB, M, WB, WB}; pg8::StaticOrder S; S.init(M, WB, F.G, (int)blockIdx.x);
            EpiGlu E{(const bf16*)(F.ws + WS_G), (bf16*)(F.ws + WS_MIX), F.in[I_GLUB] + l * WB, (float*)(F.ws + WS_PSB)};
#define GEMM_GLU pg8::gemm_phase<EpiGlu, pg8::StaticOrder, true, true>(F.lds, g, S, E)
            RUN2(6, GEMM_GLU, GEMM_GLU);
        } SEAM(pb + 6);
        if (IN(pb + 7)) {
            pg8::Gemm g{(const bf16*)(F.ws + WS_MIX), (const bf16*)(F.ws + WS_WOUT) + (size_t)l * DM * DM, M, DM, DM}; pg8::StaticOrder S; S.init(M, DM, F.G, (int)blockIdx.x);
            LAS float* ratL = (LAS float*)(F.lds + 132096); LAS float* rbL = (LAS float*)(F.lds + 134144);
            pg8::Unit u0, u1; const bool h0 = S.next(0, u0), h1 = S.next(1, u1);
            {   int t2 = F.tid; asm volatile("" : "+v"(t2));
                for (int sl = 0; sl < 2; ++sl) { const bool on = sl == 0 ? h0 : (h1 && u1.pm != u0.pm); const int pmx = sl == 0 ? u0.pm : u1.pm;
                    if (on && t2 < 256) { const size_t row = (size_t)pmx * 256 + t2; float sa = 0.f, sb = 0.f;
                        const float* pa = (const float*)(F.ws + WS_PSA) + row * 8; const float* pb_ = (const float*)(F.ws + WS_PSB) + row * 16;
#pragma unroll
                        for (int i = 0; i < 2; ++i) { const f32x4 v = *(const f32x4*)(pa + 4 * i); sa += (v[0] + v[1]) + (v[2] + v[3]); }
#pragma unroll
                        for (int i = 0; i < 4; ++i) { const f32x4 v = *(const f32x4*)(pb_ + 4 * i); sb += (v[0] + v[1]) + (v[2] + v[3]); }
                        const float ra = 1.0f / sqrtf(sa * (1.0f / 1024.0f) + EPS), rb = 1.0f / sqrtf(sb * (1.0f / 1024.0f) + EPS);
                        ratL[sl * 256 + t2] = ra / rb; rbL[sl * 256 + t2] = rb; } } }
            __syncthreads();
            const int pm0 = h0 ? u0.pm : -1;
            if (l == 0) { EpiOut<false> E{(const void*)F.in[I_X], (bf16*)(F.ws + WS_X), ml + 2 * 2048, (float*)(F.ws + WS_PS), ratL, rbL, pm0}; EpiOut<false> Ed{(const void*)F.in[I_X], (bf16*)(F.ws + WS_DBG), ml + 2 * 2048, (float*)(F.ws + WS_DBG + 128 * MiB), ratL, rbL, pm0};
#define GEMM_OUT0(EE) pg8::gemm_phase<EpiOut<false>, pg8::StaticOrder, true, true>(F.lds, g, S, EE)
                RUN2(8, GEMM_OUT0(Ed), GEMM_OUT0(E)); }
            else { EpiOut<true> E{(const void*)(F.ws + WS_X), (bf16*)(F.ws + WS_X), ml + 2 * 2048, (float*)(F.ws + WS_PS), ratL, rbL, pm0}; EpiOut<true> Ed{(const void*)(F.ws + WS_X), (bf16*)(F.ws + WS_DBG), ml + 2 * 2048, (float*)(F.ws + WS_DBG + 128 * MiB), ratL, rbL, pm0};
#define GEMM_OUT1(EE) pg8::gemm_phase<EpiOut<true>, pg8::StaticOrder, true, true>(F.lds, g, S, EE)
                RUN2(8, GEMM_OUT1(Ed), GEMM_OUT1(E)); }
        }
        SEAM(pb + 8);
        if (IN(pb + 9)) {
            pg8::Gemm g{(const bf16*)(F.ws + WS_X), (const bf16*)(F.ws + WS_WQ) + (size_t)l * DM * DM, M, DM, DM}; pg8::StaticOrder S; S.init(M, DM, F.G, (int)blockIdx.x);
            LAS float* rrL = (LAS float*)(F.lds + 132096);
            pg8::Unit u0, u1; const bool h0 = S.next(0, u0), h1 = S.next(1, u1);
            { int t2 = F.tid; asm volatile("" : "+v"(t2)); if (h0) fill_rr(F, rrL, 0, u0.pm, t2); if (h1 && u1.pm != u0.pm) fill_rr(F, rrL, 1, u1.pm, t2); }
            __syncthreads();
            EpiQ E{(bf16*)(F.ws + WS_Z), (const float*)(F.ws + WS_C0) + l * DM, rrL, h0 ? u0.pm : -1};
#define GEMM_Q pg8::gemm_phase<EpiQ, pg8::StaticOrder, true, true>(F.lds, g, S, E)
            RUN2(10, GEMM_Q, GEMM_Q);
        } SEAM(pb + 9);
        if (IN(pb + 10)) { RUN2(11, phase_topk(F, l), phase_topk(F, l)); } SEAM(pb + 10);
        if (IN(pb + 11)) { RUN2(12, phase_gather(F, l, true), phase_gather(F, l, false)); } SEAM(pb + 11);
    }
#undef IN
#undef SEAM
}

extern "C" void kernel_launch(void* const* d_in, const int* in_sizes, int n_in, void* d_out, int out_size, void* d_ws, size_t ws_size, hipStream_t stream) {
    static int grid = 0;
    if (grid == 0) {
        if (n_in != 29 || out_size != M * DM || ws_size < WS_END) { fprintf(stderr, "kernel_launch: unexpected shapes (n_in %d, out %d, ws %zu); nothing launched\n", n_in, out_size, ws_size); grid = -1; return; }
        int dev = 0, cus = 0;
        if (hipGetDevice(&dev) != hipSuccess || hipDeviceGetAttribute(&cus, hipDeviceAttributeMultiprocessorCount, dev) != hipSuccess) { grid = -1; return; }
        if (hipFuncSetAttribute((const void*)fwd_kernel, hipFuncAttributeMaxDynamicSharedMemorySize, LDS_BYTES) != hipSuccess) { fprintf(stderr, "kernel_launch: hipFuncSetAttribute failed\n"); grid = -1; return; }
        (void)hipGetLastError();
        grid = cus;
    }
    if (grid < 0) return;
    (void)hipMemsetAsync((char*)d_ws + WS_CTL, 0, CTL_ZERO_BYTES, stream);
    Args a{};
    for (int i = 0; i < 29; ++i) a.in[i] = (const float*)d_in[i];
    a.out = (float*)d_out; a.ws = (unsigned char*)d_ws;
#if MK_PER_PHASE
    for (int p = 0; p < 1 + 12 * DEPTH; ++p) {
        if (p == 13) continue;
        a.ph_lo = p; a.ph_hi = p + 1; a.li = p;
        hipLaunchKernelGGL(fwd_kernel, dim3(grid), dim3(NTHR), LDS_BYTES, stream, a);
    }
#else
    a.ph_lo = 0; a.ph_hi = 1 + 12 * DEPTH; a.li = 0;
    hipLaunchKernelGGL(fwd_kernel, dim3(grid), dim3(NTHR), LDS_BYTES, stream, a);
#endif
}
```

```cpp
#include <hip/hip_runtime.h>
#include <cstdio>
#include <cstdint>

#ifndef SELFTEST_S5
#define SELFTEST_S5 0
#endif
#ifndef REPEAT_PH
#define REPEAT_PH -1
#endif
#ifndef GATHER_PROBE_MEM
#define GATHER_PROBE_MEM 0
#endif
#ifndef GATHER_PROBE_HOT
#define GATHER_PROBE_HOT 0
#endif
#ifndef MK_PER_PHASE
#define MK_PER_PHASE 0
#endif

#define GAS __attribute__((address_space(1)))
#define LAS __attribute__((address_space(3)))
typedef unsigned short bf16;
typedef short bf16x8 __attribute__((ext_vector_type(8)));
typedef float f32x4 __attribute__((ext_vector_type(4)));
typedef float f32x2 __attribute__((ext_vector_type(2)));
typedef unsigned u32x4 __attribute__((ext_vector_type(4)));
typedef unsigned u32x2 __attribute__((ext_vector_type(2)));

constexpr int DM = 2048, SEQ = 16384, DEPTH = 2, M = SEQ;
constexpr int WA = 1024, WB = 1024, INW = 3072;
constexpr int NG = 64, NCH = 256;
constexpr int NEXP = 16384;
constexpr float EPS = 1e-6f;
constexpr int NWAVES = 8, NTHR = 512;

namespace pg8 {
#define PG8_LAS __attribute__((address_space(3)))
constexpr int BM = 256, BK = 64, HALF = 128, HTB = HALF * BK * 2, STAGE_BYTES = 8 * HTB, NXCD = 8, WGM = 4;
__host__ __device__ __forceinline__ int lds_byte(int r, int c) { const int st = (r >> 4) * 2 + (c >> 5), rr = r & 15, cc = c & 31, ob = rr * 64 + cc * 2; return st * 1024 + (ob ^ (((ob >> 9) & 1) << 5)); }
__host__ __device__ __forceinline__ void stage_rc(int b, int& R, int& C) { const int st = b / 1024, sb = b % 1024, swz = sb ^ (((sb >> 9) & 1) << 5); R = (st >> 1) * 16 + swz / 64; C = (st & 1) * 32 + (swz % 64) / 2; }
__host__ __device__ __forceinline__ int perm32(int rho) { const int n = rho >> 4, i = rho & 15; return 8 * (i >> 2) + 4 * n + (i & 3); }
struct Unit { int pm, pn; };
struct Gemm { const bf16* A; const bf16* Bt; int M, N, K; };
struct StaticOrder {
    int nM, nN, nwg, G, c;
    __host__ __device__ void init(int M_, int N_, int G_, int c_) { nM = M_ / BM; nN = N_ / BM; nwg = nM * nN; G = G_; c = c_; }
    __host__ __device__ bool next(int i, Unit& u) const {
        const long L = (long)i * G + c; if (L >= nwg) return false;
        int wgid = (int)L; { const int q = nwg / NXCD, r = nwg % NXCD, xcd = wgid % NXCD, off = wgid / NXCD; wgid = (xcd < r ? xcd * (q + 1) : r * (q + 1) + (xcd - r) * q) + off; }
        const int nig = WGM * nN, gid = wgid / nig, fm = gid * WGM, gsz = (nM - fm) < WGM ? (nM - fm) : WGM;
        u.pm = fm + ((wgid % nig) % gsz); u.pn = (wgid % nig) / gsz; return true;
    }
    __device__ __forceinline__ void a_ready(const Unit&) const {}
    __device__ __forceinline__ void done(const Unit&) const {}
};
__device__ __forceinline__ unsigned cvt_pk_bf16(float lo, float hi) { unsigned r; asm volatile("v_cvt_pk_bf16_f32 %0, %1, %2" : "=v"(r) : "v"(lo), "v"(hi)); return r; }

template <class Epi, class Sched, bool ALIGN_EPI = false, bool SP2 = false>
__device__ __forceinline__ void gemm_phase(PG8_LAS unsigned char* lds, const Gemm g, const Sched& S, const Epi& E) {
    int tid = threadIdx.x; asm volatile("" : "+v"(tid)); const int wid = __builtin_amdgcn_readfirstlane(tid >> 6), lane = tid & 63, wr = wid >> 2, wc = wid & 3, fr = lane & 15, fq = lane >> 4;
    const int K = g.K, nt = K / BK;
    unsigned voffA[2], voffB[2];
#pragma unroll
    for (int i = 0; i < 2; ++i) { int R, C; stage_rc(tid * 16 + i * 8192, R, C); const int Rb = Epi::PERM ? ((R & ~31) + perm32(R & 31)) : R;
        voffA[i] = (unsigned)(R * K + C) * 2u; voffB[i] = (unsigned)(Rb * K + C) * 2u; }
    const size_t kstep = (size_t)(BK * 2);
    const size_t hstep = (size_t)HALF * K * 2;
    const size_t tstep = 2 * hstep;
    const unsigned ldsw = (unsigned)wid * 1024u;
    const int aoff = lds_byte(wr * 64 + fr, fq * 8), boff = lds_byte(wc * 32 + fr, fq * 8);
#define PG8_SA(b, h) (((b) * 2 + (h)) * HTB)
#define PG8_SB(b, h) ((4 + (b) * 2 + (h)) * HTB)
#define PG8_STAGE(bufoff, gbase, voff) do { _Pragma("unroll") for (int _i = 0; _i < 2; ++_i) \
        __builtin_amdgcn_global_load_lds((const unsigned*)((const char*)(gbase) + (voff)[_i]), (PG8_LAS unsigned*)(lds + (bufoff) + ldsw + _i * 8192), 16, 0, 0); } while (0)
#define PG8_LDA(dst, b, h) do { _Pragma("unroll") for (int m = 0; m < 4; ++m) _Pragma("unroll") for (int k = 0; k < 2; ++k) dst[m][k] = *(const PG8_LAS bf16x8*)(lds + PG8_SA(b, h) + aoff + m * 2048 + k * 1024); } while (0)
#define PG8_LDB(dst, b, h) do { _Pragma("unroll") for (int n = 0; n < 2; ++n) _Pragma("unroll") for (int k = 0; k < 2; ++k) dst[n][k] = *(const PG8_LAS bf16x8*)(lds + PG8_SB(b, h) + boff + n * 2048 + k * 1024); } while (0)
#define PG8_MMA(ai, bj, At, Bt) do { __builtin_amdgcn_s_setprio(1); _Pragma("unroll") for (int m = 0; m < 4; ++m) _Pragma("unroll") for (int n = 0; n < 2; ++n) _Pragma("unroll") for (int k = 0; k < 2; ++k) \
        acc[ai][bj][m][n] = __builtin_amdgcn_mfma_f32_16x16x32_bf16(Bt[n][k], At[m][k], acc[ai][bj][m][n], 0, 0, 0); __builtin_amdgcn_s_setprio(0); } while (0)
#define PG8_WAIT_V(n) asm volatile("s_waitcnt vmcnt(" #n ")" ::: "memory")
#define PG8_WAIT_L(n) asm volatile("s_waitcnt lgkmcnt(" #n ")" ::: "memory")
#define PG8_BAR __builtin_amdgcn_s_barrier()
#define PG8_SCHED __builtin_amdgcn_sched_barrier(0)
    Unit cur, nxt; int ui = 0;
    if (!S.next(0, cur)) return;
    f32x4 acc[2][2][4][2];
#pragma unroll
    for (int a = 0; a < 2; ++a)
#pragma unroll
        for (int b = 0; b < 2; ++b)
#pragma unroll
            for (int m = 0; m < 4; ++m)
#pragma unroll
                for (int n = 0; n < 2; ++n) acc[a][b][m][n] = (f32x4){0.f, 0.f, 0.f, 0.f};
    bf16x8 At[4][2], B0[2][2], B1[2][2];
    const char* cA = (const char*)g.A + (size_t)cur.pm * tstep; const char* cB = (const char*)g.Bt + (size_t)cur.pn * tstep;
    S.a_ready(cur);
    if constexpr (SP2) {
        PG8_STAGE(PG8_SB(0, 0), cB, voffB); PG8_STAGE(PG8_SB(0, 1), cB + hstep, voffB); PG8_STAGE(PG8_SA(0, 0), cA, voffA); PG8_STAGE(PG8_SA(0, 1), cA + hstep, voffA);
        if (wr == 1) PG8_BAR;
        PG8_WAIT_V(2); PG8_BAR;
        PG8_STAGE(PG8_SB(1, 0), cB + kstep, voffB); PG8_STAGE(PG8_SA(1, 0), cA + kstep, voffA); PG8_STAGE(PG8_SB(1, 1), cB + hstep + kstep, voffB);
        PG8_WAIT_V(6); PG8_BAR;
    } else {
        PG8_STAGE(PG8_SB(0, 0), cB, voffB); PG8_STAGE(PG8_SA(0, 0), cA, voffA); PG8_STAGE(PG8_SB(0, 1), cB + hstep, voffB); PG8_STAGE(PG8_SA(0, 1), cA + hstep, voffA);
        if (wr == 1) PG8_BAR;
        PG8_WAIT_V(4); PG8_BAR;
        PG8_STAGE(PG8_SB(1, 0), cB + kstep, voffB); PG8_STAGE(PG8_SA(1, 0), cA + kstep, voffA); PG8_STAGE(PG8_SB(1, 1), cB + hstep + kstep, voffB);
        PG8_WAIT_V(6); PG8_BAR;
    }
    for (;;) {
        const bool has_next = S.next(ui + 1, nxt);
        const char* nA = has_next ? (const char*)g.A + (size_t)nxt.pm * tstep : cA; const char* nB = has_next ? (const char*)g.Bt + (size_t)nxt.pn * tstep : cB;
        for (int t = 0; t < nt; t += 2) {
            const bool last = (t == nt - 2);
            const char* a1 = cA + (size_t)(t + 1) * kstep;
            const char* a2 = last ? nA : cA + (size_t)(t + 2) * kstep; const char* b2 = last ? nB : cB + (size_t)(t + 2) * kstep;
            const char* a3 = a2 + kstep; const char* b3 = b2 + kstep;
            if (last && has_next) S.a_ready(nxt);
            if constexpr (Epi::KSPLIT) { if (t == nt / 2) E.midscale(acc, cur, wr, fr); }
            if constexpr (SP2) {
            PG8_LDB(B0, 0, 0); PG8_LDB(B1, 0, 1); PG8_SCHED; PG8_LDA(At, 0, 0); PG8_STAGE(PG8_SA(1, 1), a1 + hstep, voffA);
            PG8_WAIT_V(8); PG8_WAIT_L(0); PG8_BAR; PG8_MMA(0, 0, At, B0); PG8_MMA(0, 1, At, B1); PG8_BAR; PG8_SCHED;
            PG8_LDA(At, 0, 1); PG8_STAGE(PG8_SB(0, 0), b2, voffB); PG8_STAGE(PG8_SB(0, 1), b2 + hstep, voffB); PG8_STAGE(PG8_SA(0, 0), a2, voffA);
            PG8_WAIT_V(8); PG8_WAIT_L(0); PG8_BAR; PG8_MMA(1, 0, At, B0); PG8_MMA(1, 1, At, B1); PG8_BAR; PG8_SCHED;
            PG8_LDB(B0, 1, 0); PG8_LDB(B1, 1, 1); PG8_SCHED; PG8_LDA(At, 1, 0); PG8_STAGE(PG8_SA(0, 1), a2 + hstep, voffA);
            PG8_WAIT_V(8); PG8_WAIT_L(0); PG8_BAR; PG8_MMA(0, 0, At, B0); PG8_MMA(0, 1, At, B1); PG8_BAR; PG8_SCHED;
            PG8_LDA(At, 1, 1); PG8_STAGE(PG8_SB(1, 0), b3, voffB); PG8_STAGE(PG8_SB(1, 1), b3 + hstep, voffB); PG8_STAGE(PG8_SA(1, 0), a3, voffA);
            PG8_WAIT_V(8); PG8_WAIT_L(0); PG8_BAR; PG8_MMA(1, 0, At, B0); PG8_MMA(1, 1, At, B1); PG8_BAR; PG8_SCHED;
            } else {
            PG8_LDB(B0, 0, 0); PG8_SCHED; PG8_LDA(At, 0, 0); PG8_STAGE(PG8_SA(1, 1), a1 + hstep, voffA);
            PG8_WAIT_L(8); PG8_BAR; PG8_WAIT_L(0); PG8_MMA(0, 0, At, B0); PG8_BAR; PG8_SCHED;
            PG8_LDB(B1, 0, 1); PG8_STAGE(PG8_SB(0, 0), b2, voffB);
            PG8_BAR; PG8_WAIT_L(0); PG8_MMA(0, 1, At, B1); PG8_BAR;
            PG8_LDA(At, 0, 1); PG8_STAGE(PG8_SA(0, 0), a2, voffA);
            PG8_BAR; PG8_WAIT_L(0); PG8_MMA(1, 0, At, B0); PG8_BAR; PG8_SCHED;
            PG8_STAGE(PG8_SB(0, 1), b2 + hstep, voffB);
            PG8_WAIT_V(6); PG8_BAR; PG8_MMA(1, 1, At, B1); PG8_BAR;
            PG8_LDB(B0, 1, 0); PG8_SCHED; PG8_LDA(At, 1, 0); PG8_STAGE(PG8_SA(0, 1), a2 + hstep, voffA);
            PG8_WAIT_L(8); PG8_BAR; PG8_WAIT_L(0); PG8_MMA(0, 0, At, B0); PG8_BAR; PG8_SCHED;
            PG8_LDB(B1, 1, 1); PG8_STAGE(PG8_SB(1, 0), b3, voffB);
            PG8_BAR; PG8_WAIT_L(0); PG8_MMA(0, 1, At, B1); PG8_BAR;
            PG8_LDA(At, 1, 1); PG8_STAGE(PG8_SA(1, 0), a3, voffA);
            PG8_BAR; PG8_WAIT_L(0); PG8_MMA(1, 0, At, B0); PG8_BAR; PG8_SCHED;
            PG8_STAGE(PG8_SB(1, 1), b3 + hstep, voffB);
            PG8_WAIT_V(6); PG8_BAR; PG8_MMA(1, 1, At, B1); PG8_BAR;
            }
        }
        if constexpr (ALIGN_EPI) { if (wr == 0) PG8_BAR; }
        E(acc, cur, wr, wc, fr, fq); S.done(cur);
        if (!has_next) break;
#pragma unroll
        for (int a = 0; a < 2; ++a)
#pragma unroll
            for (int b = 0; b < 2; ++b)
#pragma unroll
                for (int m = 0; m < 4; ++m)
#pragma unroll
                    for (int n = 0; n < 2; ++n) acc[a][b][m][n] = (f32x4){0.f, 0.f, 0.f, 0.f};
        cur = nxt; cA = nA; cB = nB; ++ui;
        if constexpr (ALIGN_EPI) { if (wr == 1) PG8_BAR; }
    }
    PG8_WAIT_V(0);
    if constexpr (!ALIGN_EPI) { if (wr == 0) PG8_BAR; }
    PG8_BAR;
#undef PG8_SA
#undef PG8_SB
#undef PG8_STAGE
#undef PG8_LDA
#undef PG8_LDB
#undef PG8_MMA
#undef PG8_WAIT_V
#undef PG8_WAIT_L
#undef PG8_BAR
#undef PG8_SCHED
}
}

__device__ __forceinline__ unsigned f2bf(float f) { unsigned u = __builtin_bit_cast(unsigned, f); return (u + 0x7fffu + ((u >> 16) & 1u)) >> 16; }
__device__ __forceinline__ unsigned pk2(float lo, float hi) { return f2bf(lo) | (f2bf(hi) << 16); }
__device__ __forceinline__ float bflo(unsigned w) { return __builtin_bit_cast(float, w << 16); }
__device__ __forceinline__ float bfhi(unsigned w) { return __builtin_bit_cast(float, w & 0xffff0000u); }
__device__ __forceinline__ float fast_sigmoid(float t) { return __builtin_amdgcn_rcpf(1.0f + __builtin_amdgcn_exp2f(-1.44269504089f * t)); }
__device__ __forceinline__ float gelu_tanh(float x) { const float t = x * (1.5957691216f + 0.0713548163f * x * x); return x * fast_sigmoid(t); }
__device__ __forceinline__ float wave_sum(float v) {
#pragma unroll
    for (int o = 1; o < 64; o <<= 1) v += __shfl_xor(v, o);
    return v;
}
#define LDS_WAIT() asm volatile("s_waitcnt lgkmcnt(0)" ::: "memory")
#define VM_WAIT() asm volatile("s_waitcnt vmcnt(0)" ::: "memory")
#define RLX_AGENT __ATOMIC_RELAXED, __HIP_MEMORY_SCOPE_AGENT

constexpr size_t MiB = 1u << 20;
constexpr size_t WS_CTL = 0, CTL_ZERO_BYTES = 1 * MiB;
constexpr size_t WS_MOD   = 512 * 1024;
constexpr size_t WS_AT    = 1 * MiB + 128 * 1024;
constexpr size_t WS_STATS = WS_AT + 128 * 1024;
constexpr size_t WS_SCL   = 1 * MiB + 512 * 1024;
constexpr size_t WS_GS    = 1 * MiB + 768 * 1024;
constexpr size_t WS_C0    = WS_GS + 16 * 1024;
constexpr size_t WS_KEYS  = 2 * MiB;
constexpr size_t WS_GWS   = 3 * MiB;
constexpr size_t WS_WIN   = 4 * MiB;
constexpr size_t WS_GLU   = 28 * MiB;
constexpr size_t WS_WOUT  = 32 * MiB;
constexpr size_t WS_WQ    = 48 * MiB;
constexpr size_t WS_KTAB  = 64 * MiB;
constexpr size_t WS_WG    = 72 * MiB;
constexpr size_t WS_VG    = 104 * MiB;
constexpr size_t WS_UV    = 136 * MiB;
constexpr size_t WS_X     = 392 * MiB;
constexpr size_t WS_H     = 520 * MiB;
constexpr size_t WS_Z     = 584 * MiB;
constexpr size_t WS_XS    = 648 * MiB;
constexpr size_t WS_SLOC  = 680 * MiB;
constexpr size_t WS_PS    = 688 * MiB;
constexpr size_t WS_PSA   = 690 * MiB;
constexpr size_t WS_PSB   = 691 * MiB;
constexpr size_t WS_PLN   = 692 * MiB;
constexpr size_t WS_HS    = 694 * MiB;
constexpr size_t WS_G     = 696 * MiB;
constexpr size_t WS_MIX   = 728 * MiB;
constexpr size_t WS_EID   = 792 * MiB;
constexpr size_t WS_GATE  = 800 * MiB;
constexpr size_t WS_SU    = 808 * MiB;
constexpr size_t WS_COEF  = 816 * MiB;
constexpr size_t WS_END   = 824 * MiB;
constexpr size_t WS_DBG   = 824 * MiB;
constexpr int CW_BAR = 4096;
constexpr int CW_FLAG = 2048;
constexpr int CW_QUEUE = 16384;

constexpr int LDS_BYTES = 163840;
constexpr int MISC_OFF = LDS_BYTES - 256;

#define XB_TMO      128
#define XB_XCNT(j)  (256  + 64 * (j))
#define XB_XSUB(j)  (1280 + 64 * (j))
#define XB_XGEN(j)  (2304 + 64 * (j))
#define XB_TOP      3328
#define XB_TOPGEN   3392
#define XCD_BAR_WORDS 3456
#define XB_SPIN_CAP (1u << 24)
__device__ __forceinline__ unsigned xb_ld(unsigned* p)              { return __hip_atomic_load(p, __ATOMIC_RELAXED, __HIP_MEMORY_SCOPE_AGENT); }
__device__ __forceinline__ unsigned xb_add(unsigned* p, unsigned v) { return __hip_atomic_fetch_add(p, v, __ATOMIC_RELAXED, __HIP_MEMORY_SCOPE_AGENT); }
__device__ __forceinline__ unsigned xb_xcc_id() { return (unsigned)__builtin_amdgcn_s_getreg((3 << 11) | 20) & 0xFu; }
#define XB_SPIN(cond, bar) do { unsigned _sp = 0; while (cond) { __builtin_amdgcn_s_sleep(1); \
    if ((++_sp & 255u) == 0u) { if (xb_ld(&(bar)[XB_TMO])) break; if (_sp > XB_SPIN_CAP) { atomicAdd(&(bar)[XB_TMO], 1u); break; } } } } while (0)
struct XcdBarrier { unsigned* bar; unsigned x; volatile LAS unsigned* st; };
__device__ __forceinline__ XcdBarrier xcd_barrier_post(unsigned* bar, volatile LAS unsigned* st) {
    XcdBarrier b; b.bar = bar; b.x = xb_xcc_id(); b.st = st;
    if (threadIdx.x == 0) (void)xb_add(&bar[XB_XCNT(b.x)], 1u);
    return b;
}
__device__ __forceinline__ void xcd_barrier_complete(unsigned* bar, unsigned x, unsigned& nloc, unsigned& nx) {
    const unsigned G = gridDim.x * gridDim.y * gridDim.z;
    unsigned sum, cnt, mine, sp = 0u;
    for (;;) {
        sum = 0u; cnt = 0u; mine = 0u;
#pragma unroll
        for (unsigned j = 0; j < 16; ++j) { const unsigned c = xb_ld(&bar[XB_XCNT(j)]); sum += c; cnt += (c > 0u) ? 1u : 0u; mine = (j == x) ? c : mine; }
        if (sum == G) break;
        __builtin_amdgcn_s_sleep(1);
        if ((++sp & 255u) == 0u) { if (xb_ld(&bar[XB_TMO])) break; if (sp > XB_SPIN_CAP) { atomicAdd(&bar[XB_TMO], 1u); break; } }
    }
    nloc = mine > 0u ? mine : 1u; nx = cnt > 0u ? cnt : 1u;
}
__device__ __forceinline__ void xcd_barrier(const XcdBarrier& b) {
    asm volatile("s_waitcnt vmcnt(0)" ::: "memory");
    __syncthreads();
    if (threadIdx.x == 0) {
        unsigned* bar = b.bar;
        __builtin_amdgcn_s_waitcnt(0);
        unsigned nloc = b.st[0], nx = b.st[1];
        if (nloc == 0u) { xcd_barrier_complete(bar, b.x, nloc, nx); b.st[0] = nloc; b.st[1] = nx; }
        const unsigned old = xb_add(&bar[XB_XSUB(b.x)], 1u);
        const unsigned gen = old / nloc;
        if (old + 1u == (gen + 1u) * nloc) {
            __builtin_amdgcn_fence(__ATOMIC_RELEASE, "agent");
            asm volatile("s_waitcnt vmcnt(0)" ::: "memory");
            const unsigned og = xb_add(&bar[XB_TOP], 1u);
            const unsigned tg = og / nx;
            if (og + 1u == (tg + 1u) * nx) xb_add(&bar[XB_TOPGEN], 1u);
            else XB_SPIN(xb_ld(&bar[XB_TOPGEN]) == tg, bar);
            __builtin_amdgcn_fence(__ATOMIC_ACQUIRE, "agent");
            xb_add(&bar[XB_XGEN(b.x)], 1u);
            asm volatile("s_waitcnt vmcnt(0)" ::: "memory");
        } else {
            XB_SPIN(xb_ld(&bar[XB_XGEN(b.x)]) == gen, bar);
            __builtin_amdgcn_fence(__ATOMIC_ACQUIRE, "agent");
            asm volatile("s_waitcnt vmcnt(0)" ::: "memory");
        }
    }
    __syncthreads();
}

struct Args { const float* in[29]; float* out; unsigned char* ws; int ph_lo, ph_hi, li, pad; };
enum { I_X = 0, I_C, I_WMOD, I_BMOD, I_N1G, I_WIN, I_BIN, I_LNG, I_LNB, I_GWS, I_GBS, I_LRE, I_LIM, I_LDT, I_BRE, I_BIM, I_CRE, I_CIM, I_SD, I_GLUW, I_GLUB,
       I_BRG, I_WOUT, I_N2G, I_WQ, I_KEYS, I_PU, I_PV, I_FG };

struct Frame {
    LAS unsigned char* lds;
    unsigned char* ws;
    const float* const* in;
    float* out;
    int tid, lane, wave, vcu, G;
};

#define PH_LOCALS int tid = F.tid; asm volatile("" : "+v"(tid)); const int lane = tid & 63; const int wave = __builtin_amdgcn_readfirstlane(tid >> 6); (void)lane; (void)wave;

struct EpiIn {
    static constexpr bool PERM = true, AFTER_DRAIN = false, KSPLIT = false;
    bf16* Z; bf16* XS; const float* bias; float* PLN;
    __device__ __forceinline__ void operator()(const f32x4 (&acc)[2][2][4][2], const pg8::Unit& u, int wr, int wc, int fr, int fq) const {
        const int row0 = u.pm * 256 + wr * 64 + fr, col0 = u.pn * 256 + wc * 32 + 8 * fq;
        const bool isv = (u.pn >= 4 && u.pn < 8);
        f32x4 bv[2][2];
#pragma unroll
        for (int bj = 0; bj < 2; ++bj)
#pragma unroll
            for (int n = 0; n < 2; ++n) bv[bj][n] = *(const f32x4*)(bias + col0 + bj * 128 + 4 * n);
        const bool isz = (u.pn < 8);
#pragma unroll
        for (int ai = 0; ai < 2; ++ai)
#pragma unroll
            for (int m = 0; m < 4; ++m) {
                const int r = row0 + ai * 128 + m * 16; float s1 = 0.f, s2 = 0.f;
#pragma unroll
                for (int bj = 0; bj < 2; ++bj) {
                    f32x4 v0 = acc[ai][bj][m][0] + bv[bj][0], v1 = acc[ai][bj][m][1] + bv[bj][1];
                    const int c = col0 + bj * 128;
                    u32x4 w;
                    if (isz) {
                        const float g0 = gelu_tanh(v0[0]), g1 = gelu_tanh(v0[1]), g2 = gelu_tanh(v0[2]), g3 = gelu_tanh(v0[3]), g4 = gelu_tanh(v1[0]), g5 = gelu_tanh(v1[1]), g6 = gelu_tanh(v1[2]), g7 = gelu_tanh(v1[3]);
                        w.x = pg8::cvt_pk_bf16(g0, g1); w.y = pg8::cvt_pk_bf16(g2, g3); w.z = pg8::cvt_pk_bf16(g4, g5); w.w = pg8::cvt_pk_bf16(g6, g7);
                        *(u32x4*)(Z + (size_t)r * 2048 + c) = w;
                        s1 += ((g0 + g1) + (g2 + g3)) + ((g4 + g5) + (g6 + g7)); s2 += ((g0 * g0 + g1 * g1) + (g2 * g2 + g3 * g3)) + ((g4 * g4 + g5 * g5) + (g6 * g6 + g7 * g7));
                    } else {
                        w.x = pg8::cvt_pk_bf16(v0[0], v0[1]); w.y = pg8::cvt_pk_bf16(v0[2], v0[3]); w.z = pg8::cvt_pk_bf16(v1[0], v1[1]); w.w = pg8::cvt_pk_bf16(v1[2], v1[3]);
                        const int cc = c - 2048, g = cc >> 4, i = cc & 15;
                        *(u32x4*)(XS + ((size_t)(g * 256 + (r >> 6)) * 64 + (r & 63)) * 16 + i) = w;
                    }
                }
                if (isv) { s1 += __shfl_xor(s1, 16); s1 += __shfl_xor(s1, 32); s2 += __shfl_xor(s2, 16); s2 += __shfl_xor(s2, 32);
                    if (fq == 0) *(f32x2*)(PLN + ((size_t)r * 16 + (u.pn - 4) * 4 + wc) * 2) = (f32x2){s1, s2}; }
            }
    }
};
struct EpiGlu {
    static constexpr bool PERM = true, AFTER_DRAIN = false, KSPLIT = false;
    const bf16* Gb; bf16* MIX; const float* bias; float* PSB;
    __device__ __forceinline__ void operator()(const f32x4 (&acc)[2][2][4][2], const pg8::Unit& u, int wr, int wc, int fr, int fq) const {
        const int row0 = u.pm * 256 + wr * 64 + fr, col0 = u.pn * 256 + wc * 32 + 8 * fq;
        f32x4 bv[2][2];
#pragma unroll
        for (int bj = 0; bj < 2; ++bj)
#pragma unroll
            for (int n = 0; n < 2; ++n) bv[bj][n] = *(const f32x4*)(bias + col0 + bj * 128 + 4 * n);
#pragma unroll
        for (int ai = 0; ai < 2; ++ai)
#pragma unroll
            for (int m = 0; m < 4; ++m) {
                const int r = row0 + ai * 128 + m * 16; float ssq = 0.f;
#pragma unroll
                for (int bj = 0; bj < 2; ++bj) {
                    const f32x4 v0 = acc[ai][bj][m][0] + bv[bj][0], v1 = acc[ai][bj][m][1] + bv[bj][1];
                    const int c = col0 + bj * 128;
                    const u32x4 gw = *(const u32x4*)(Gb + (size_t)r * 1024 + c);
                    const float o0 = bflo(gw.x) * fast_sigmoid(v0[0]), o1 = bfhi(gw.x) * fast_sigmoid(v0[1]), o2 = bflo(gw.y) * fast_sigmoid(v0[2]), o3 = bfhi(gw.y) * fast_sigmoid(v0[3]);
                    const float o4 = bflo(gw.z) * fast_sigmoid(v1[0]), o5 = bfhi(gw.z) * fast_sigmoid(v1[1]), o6 = bflo(gw.w) * fast_sigmoid(v1[2]), o7 = bfhi(gw.w) * fast_sigmoid(v1[3]);
                    u32x4 w; w.x = pg8::cvt_pk_bf16(o0, o1); w.y = pg8::cvt_pk_bf16(o2, o3); w.z = pg8::cvt_pk_bf16(o4, o5); w.w = pg8::cvt_pk_bf16(o6, o7);
                    *(u32x4*)(MIX + (size_t)r * 2048 + 1024 + c) = w;
                    ssq += (o0 * o0 + o1 * o1) + (o2 * o2 + o3 * o3) + (o4 * o4 + o5 * o5) + (o6 * o6 + o7 * o7);
                }
                ssq += __shfl_xor(ssq, 16); ssq += __shfl_xor(ssq, 32);
                if (fq == 0) PSB[(size_t)r * 16 + u.pn * 4 + wc] = ssq;
            }
    }
};
template <bool XIN_BF16> struct EpiOut {
    static constexpr bool PERM = true, AFTER_DRAIN = false, KSPLIT = true;
    const void* xin; bf16* X; const float* gate; float* PS; const LAS float* ratL; const LAS float* rbL; int pm0;
    __device__ __forceinline__ void midscale(f32x4 (&acc)[2][2][4][2], const pg8::Unit& u, int wr, int fr) const {
        const LAS float* rp = ratL + (u.pm == pm0 ? 0 : 256) + wr * 64 + fr;
#pragma unroll
        for (int ai = 0; ai < 2; ++ai)
#pragma unroll
            for (int m = 0; m < 4; ++m) { const float rt = rp[ai * 128 + m * 16];
#pragma unroll
                for (int bj = 0; bj < 2; ++bj)
#pragma unroll
                    for (int n = 0; n < 2; ++n) acc[ai][bj][m][n] = acc[ai][bj][m][n] * rt; }
    }
    __device__ __forceinline__ void operator()(const f32x4 (&acc)[2][2][4][2], const pg8::Unit& u, int wr, int wc, int fr, int fq) const {
        const int row0 = u.pm * 256 + wr * 64 + fr, col0 = u.pn * 256 + wc * 32 + 8 * fq;
        const LAS float* rbp = rbL + (u.pm == pm0 ? 0 : 256) + wr * 64 + fr;
        f32x4 gv[2][2];
#pragma unroll
        for (int bj = 0; bj < 2; ++bj)
#pragma unroll
            for (int n = 0; n < 2; ++n) gv[bj][n] = *(const f32x4*)(gate + col0 + bj * 128 + 4 * n);
#pragma unroll
        for (int ai = 0; ai < 2; ++ai)
#pragma unroll
            for (int m = 0; m < 4; ++m) {
                const int r = row0 + ai * 128 + m * 16; float ssq = 0.f; const float rb = rbp[ai * 128 + m * 16];
#pragma unroll
                for (int bj = 0; bj < 2; ++bj) {
                    const size_t off = (size_t)r * 2048 + col0 + bj * 128;
                    f32x4 x0, x1;
                    if (XIN_BF16) { const u32x4 w = *(const u32x4*)((const bf16*)xin + off); x0 = (f32x4){bflo(w.x), bfhi(w.x), bflo(w.y), bfhi(w.y)}; x1 = (f32x4){bflo(w.z), bfhi(w.z), bflo(w.w), bfhi(w.w)}; }
                    else { x0 = *(const f32x4*)((const float*)xin + off); x1 = *(const f32x4*)((const float*)xin + off + 4); }
                    const f32x4 y0 = x0 + gv[bj][0] * (acc[ai][bj][m][0] * rb), y1 = x1 + gv[bj][1] * (acc[ai][bj][m][1] * rb);
                    u32x4 o; o.x = pg8::cvt_pk_bf16(y0[0], y0[1]); o.y = pg8::cvt_pk_bf16(y0[2], y0[3]); o.z = pg8::cvt_pk_bf16(y1[0], y1[1]); o.w = pg8::cvt_pk_bf16(y1[2], y1[3]);
                    *(u32x4*)(X + off) = o;
                    ssq += (y0[0] * y0[0] + y0[1] * y0[1]) + (y0[2] * y0[2] + y0[3] * y0[3]) + (y1[0] * y1[0] + y1[1] * y1[1]) + (y1[2] * y1[2] + y1[3] * y1[3]);
                }
                ssq += __shfl_xor(ssq, 16); ssq += __shfl_xor(ssq, 32);
                if (fq == 0) PS[(size_t)r * 32 + u.pn * 4 + wc] = ssq;
            }
    }
};
struct EpiQ {
    static constexpr bool PERM = true, AFTER_DRAIN = false, KSPLIT = false;
    bf16* Q; const float* c0; const LAS float* rrL; int pm0;
    __device__ __forceinline__ void operator()(const f32x4 (&acc)[2][2][4][2], const pg8::Unit& u, int wr, int wc, int fr, int fq) const {
        const int row0 = u.pm * 256 + wr * 64 + fr, col0 = u.pn * 256 + wc * 32 + 8 * fq;
        const LAS float* rrp = rrL + (u.pm == pm0 ? 0 : 256) + wr * 64 + fr;
        f32x4 cv[2][2];
#pragma unroll
        for (int bj = 0; bj < 2; ++bj)
#pragma unroll
            for (int n = 0; n < 2; ++n) cv[bj][n] = *(const f32x4*)(c0 + col0 + bj * 128 + 4 * n);
#pragma unroll
        for (int ai = 0; ai < 2; ++ai)
#pragma unroll
            for (int m = 0; m < 4; ++m) {
                const int r = row0 + ai * 128 + m * 16; const float rr = rrp[ai * 128 + m * 16];
#pragma unroll
                for (int bj = 0; bj < 2; ++bj) {
                    const f32x4 v0 = acc[ai][bj][m][0] * rr + cv[bj][0], v1 = acc[ai][bj][m][1] * rr + cv[bj][1];
                    u32x4 w; w.x = pg8::cvt_pk_bf16(v0[0], v0[1]); w.y = pg8::cvt_pk_bf16(v0[2], v0[3]); w.z = pg8::cvt_pk_bf16(v1[0], v1[1]); w.w = pg8::cvt_pk_bf16(v1[2], v1[3]);
                    *(u32x4*)(Q + (size_t)r * 2048 + col0 + bj * 128) = w;
                }
            }
    }
};
__device__ __forceinline__ void fill_rr(Frame& F, LAS float* rrL, int slot, int pm, int tid) {
    if (tid < 256) { const float* ps = (const float*)(F.ws + WS_PS) + ((size_t)pm * 256 + tid) * 32; float s = 0.f;
#pragma unroll
        for (int i = 0; i < 8; ++i) { const f32x4 v = *(const f32x4*)(ps + 4 * i); s += (v[0] + v[1]) + (v[2] + v[3]); }
        rrL[slot * 256 + tid] = 1.0f / sqrtf(s * (1.0f / DM) + EPS); }
}

__device__ __forceinline__ void p0_transpose_item(const float* W, int K, int N, bf16* WT, const float* kscale, LAS float* scr, int item, int lane, const float* kscale2 = nullptr) {
    const int nblk = N / 32, kb = item / nblk, nb = item % nblk, k0 = 64 * kb, n0 = 32 * nb;
    float wv[32];
#pragma unroll
    for (int i = 0; i < 32; ++i) wv[i] = W[(size_t)(k0 + 2 * i + (lane >> 5)) * N + n0 + (lane & 31)];
#pragma unroll
    for (int i = 0; i < 32; ++i) { const int kk = 2 * i + (lane >> 5); float v = wv[i]; if (kscale) { v *= kscale[k0 + kk]; if (kscale2) v *= 1.0f + kscale2[k0 + kk]; } scr[kk * 33 + (lane & 31)] = v; }
    LDS_WAIT(); asm volatile("" ::: "memory");
    const int c = lane & 7;
#pragma unroll
    for (int j = 0; j < 4; ++j) { const int n = (lane >> 3) + 8 * j; const LAS float* s = scr + (8 * c) * 33 + n;
        u32x4 o; o.x = pk2(s[0 * 33], s[1 * 33]); o.y = pk2(s[2 * 33], s[3 * 33]); o.z = pk2(s[4 * 33], s[5 * 33]); o.w = pk2(s[6 * 33], s[7 * 33]);
        *(u32x4*)(WT + (size_t)(n0 + n) * K + k0 + 8 * c) = o; }
    LDS_WAIT(); asm volatile("" ::: "memory");
}

__device__ __forceinline__ void norm_mod_row(const f32x4 (&v)[4][2], const float* gain, const float* scale, const float* shift, int lane, u32x4 (&o)[4]) {
    float s = 0.f;
#pragma unroll
    for (int j = 0; j < 4; ++j)
#pragma unroll
        for (int h = 0; h < 2; ++h) s += (v[j][h][0] * v[j][h][0] + v[j][h][1] * v[j][h][1]) + (v[j][h][2] * v[j][h][2] + v[j][h][3] * v[j][h][3]);
    const float rr = 1.0f / sqrtf(wave_sum(s) * (1.0f / DM) + EPS);
#pragma unroll
    for (int j = 0; j < 4; ++j) {
        const int c = j * 512 + lane * 8;
        f32x4 y[2];
#pragma unroll
        for (int h = 0; h < 2; ++h) {
            const f32x4 g = *(const f32x4*)(gain + c + 4 * h);
            y[h] = v[j][h] * rr * g;
            const f32x4 sc = *(const f32x4*)(scale + c + 4 * h), sh = *(const f32x4*)(shift + c + 4 * h); y[h] = y[h] * (sc + 1.0f) + sh;
        }
        o[j].x = pk2(y[0][0], y[0][1]); o[j].y = pk2(y[0][2], y[0][3]); o[j].z = pk2(y[1][0], y[1][1]); o[j].w = pk2(y[1][2], y[1][3]);
    }
}
template <bool SRC_BF16>
__device__ __forceinline__ void load_row(const void* xrow_, int lane, f32x4 (&v)[4][2]) {
#pragma unroll
    for (int j = 0; j < 4; ++j) {
        if (SRC_BF16) { const u32x4 w = *(const u32x4*)((const bf16*)xrow_ + j * 512 + lane * 8); v[j][0] = (f32x4){bflo(w.x), bfhi(w.x), bflo(w.y), bfhi(w.y)}; v[j][1] = (f32x4){bflo(w.z), bfhi(w.z), bflo(w.w), bfhi(w.w)}; }
        else { const float* xrow = (const float*)xrow_; v[j][0] = *(const f32x4*)(xrow + j * 512 + lane * 8); v[j][1] = *(const f32x4*)(xrow + j * 512 + lane * 8 + 4); } }
}

__device__ __forceinline__ void p0_gemv_unit(Frame& F, int unit, int tid, float* modout) {
    const int l = unit / 192, r = unit % 192, cb = r >> 1, kh = r & 1;
    LAS float* sc = (LAS float*)F.lds;
    LAS float* red = (LAS float*)(F.lds + 4096);
    for (int k = tid; k < 1024; k += NTHR) { const float c = F.in[I_C][kh * 1024 + k]; sc[k] = c * fast_sigmoid(c); }
    __syncthreads();
    const int tx = tid & 31, ty = tid >> 5;
    const float* W = F.in[I_WMOD] + ((size_t)l * DM + kh * 1024) * 12288 + cb * 128 + tx * 4;
    f32x4 a = {0.f, 0.f, 0.f, 0.f};
#pragma unroll 16
    for (int k = ty; k < 1024; k += 16) { const f32x4 w = *(const f32x4*)(W + (size_t)k * 12288); a += w * sc[k]; }
    *(LAS f32x4*)(red + ty * 128 + tx * 4) = a;
    __syncthreads();
    if (tid < 128) { float s = 0.f;
#pragma unroll
        for (int y = 0; y < 16; ++y) s += red[y * 128 + tid];
        if (kh == 0) s += F.in[I_BMOD][l * 12288 + cb * 128 + tid];
        atomicAdd(modout + l * 12288 + cb * 128 + tid, s); }
    __syncthreads();
}
__device__ __forceinline__ void p0_s5_unit(Frame& F, int unit, int tid, int parts = 15) {
    const int l = unit >> 7, g = (unit >> 1) & 63, hf = unit & 1;
    LAS float* apr = (LAS float*)F.lds;
    LAS float* api = apr + 4228;
    LAS float* bbr = api + 4228;
    LAS float* bbi = bbr + 1024;
    LAS float* ccr = bbi + 1024;
    LAS float* cci = ccr + 16 * 65;
    const float dt = expf(F.in[I_LDT][l * 64 + g]);
    const float* lre = F.in[I_LRE] + (l * 64 + g) * 64; const float* lim = F.in[I_LIM] + (l * 64 + g) * 64;
    for (int idx = tid; idx < 65 * 64; idx += NTHR) { const int d = idx >> 6, p = idx & 63;
        const float mag = expf(lre[p] * dt * (float)d); float sn, cs; sincosf(lim[p] * dt * (float)d, &sn, &cs);
        apr[d * 65 + p] = mag * cs; api[d * 65 + p] = mag * sn; }
    for (int idx = tid; idx < 1024; idx += NTHR) { const int o = idx >> 6, p = idx & 63;
        ccr[o * 65 + p] = F.in[I_CRE][((size_t)(l * 64 + g) * 16 + o) * 64 + p]; cci[o * 65 + p] = F.in[I_CIM][((size_t)(l * 64 + g) * 16 + o) * 64 + p]; }
    __syncthreads();
    for (int idx = tid; idx < 1024; idx += NTHR) { const int p = idx >> 4, i = idx & 15;
        const float xr = apr[65 + p] - 1.0f, xi = api[65 + p], lr = lre[p], li = lim[p], den = 1.0f / (lr * lr + li * li);
        const float cr = (xr * lr + xi * li) * den, ci = (xi * lr - xr * li) * den;
        const float br = F.in[I_BRE][((size_t)(l * 64 + g) * 64 + p) * 16 + i], bi = F.in[I_BIM][((size_t)(l * 64 + g) * 64 + p) * 16 + i];
        bbr[idx] = cr * br - ci * bi; bbi[idx] = cr * bi + ci * br; }
    __syncthreads();
    bf16* KT = (bf16*)(F.ws + WS_KTAB) + (size_t)(l * 64 + g) * 80 * 256;
    if (parts & 1) {
        const int d = hf * 32 + (tid >> 4), o = tid & 15;
        const float dskip = F.in[I_SD][l * 1024 + g * 16 + o];
        float s[16];
#pragma unroll
        for (int i = 0; i < 16; ++i) s[i] = 0.f;
        for (int p = 0; p < 64; ++p) { const float ar = apr[d * 65 + p], ai = api[d * 65 + p], cr = ccr[o * 65 + p], ci = cci[o * 65 + p];
            const float er = cr * ar - ci * ai, ei = cr * ai + ci * ar;
#pragma unroll
            for (int q = 0; q < 4; ++q) { const f32x4 br = *(const LAS f32x4*)(bbr + p * 16 + 4 * q), bi = *(const LAS f32x4*)(bbi + p * 16 + 4 * q);
#pragma unroll
                for (int e = 0; e < 4; ++e) s[4 * q + e] += er * br[e] - ei * bi[e]; } }
#if !SELFTEST_S5
        {   const float dsk = (d == 0) ? dskip : 0.f;
#pragma unroll
            for (int i = 0; i < 16; ++i) s[i] += (i == o) ? dsk : 0.f; }
#endif
        u32x4 w0, w1;
        w0.x = pk2(s[0], s[1]); w0.y = pk2(s[2], s[3]); w0.z = pk2(s[4], s[5]); w0.w = pk2(s[6], s[7]);
        w1.x = pk2(s[8], s[9]); w1.y = pk2(s[10], s[11]); w1.z = pk2(s[12], s[13]); w1.w = pk2(s[14], s[15]);
        if ((parts & 8) || w0.x == 0x12345678u) { *(u32x4*)(KT + (size_t)(d + 16) * 256 + o * 16) = w0; *(u32x4*)(KT + (size_t)(d + 16) * 256 + o * 16 + 8) = w1; }
        if ((parts & 8) && hf == 0 && tid < 256) { const u32x4 z = {0u, 0u, 0u, 0u}; *(u32x4*)(KT + tid * 16) = z; *(u32x4*)(KT + tid * 16 + 8) = z; }
    }
    bf16* WG = (bf16*)(F.ws + WS_WG) + (size_t)(l * 64 + g) * 128 * 1024;
    if (parts & 2) for (int it = tid; it < 32 * 64; it += NTHR) { const int p = hf * 32 + (it >> 6), tau = it & 63;
        const float ar = apr[(63 - tau) * 65 + p], ai = api[(63 - tau) * 65 + p];
        unsigned wr_[8], wi_[8];
#pragma unroll
        for (int q = 0; q < 4; ++q) { const f32x4 br = *(const LAS f32x4*)(bbr + p * 16 + 4 * q), bi = *(const LAS f32x4*)(bbi + p * 16 + 4 * q);
            wr_[2 * q] = pk2(ar * br[0] - ai * bi[0], ar * br[1] - ai * bi[1]); wr_[2 * q + 1] = pk2(ar * br[2] - ai * bi[2], ar * br[3] - ai * bi[3]);
            wi_[2 * q] = pk2(ar * bi[0] + ai * br[0], ar * bi[1] + ai * br[1]); wi_[2 * q + 1] = pk2(ar * bi[2] + ai * br[2], ar * bi[3] + ai * br[3]); }
        *(u32x4*)(WG + (size_t)p * 1024 + tau * 16) = (u32x4){wr_[0], wr_[1], wr_[2], wr_[3]}; *(u32x4*)(WG + (size_t)p * 1024 + tau * 16 + 8) = (u32x4){wr_[4], wr_[5], wr_[6], wr_[7]};
        *(u32x4*)(WG + (size_t)(64 + p) * 1024 + tau * 16) = (u32x4){wi_[0], wi_[1], wi_[2], wi_[3]}; *(u32x4*)(WG + (size_t)(64 + p) * 1024 + tau * 16 + 8) = (u32x4){wi_[4], wi_[5], wi_[6], wi_[7]}; }
    bf16* VG = (bf16*)(F.ws + WS_VG) + (size_t)(l * 64 + g) * 1024 * 128;
    if (parts & 4) for (int it = tid; it < 512 * 8; it += NTHR) { const int m = hf * 512 + (it >> 3), p0 = (it & 7) * 8, t = m >> 4, o = m & 15;
        float vr_[8], vi_[8];
#pragma unroll
        for (int e = 0; e < 8; ++e) { const float ar = apr[(t + 1) * 65 + p0 + e], ai = api[(t + 1) * 65 + p0 + e], cr = ccr[o * 65 + p0 + e], ci = cci[o * 65 + p0 + e];
            vr_[e] = cr * ar - ci * ai; vi_[e] = -(cr * ai + ci * ar); }
        *(u32x4*)(VG + (size_t)m * 128 + p0) = (u32x4){pk2(vr_[0], vr_[1]), pk2(vr_[2], vr_[3]), pk2(vr_[4], vr_[5]), pk2(vr_[6], vr_[7])};
        *(u32x4*)(VG + (size_t)m * 128 + 64 + p0) = (u32x4){pk2(vi_[0], vi_[1]), pk2(vi_[2], vi_[3]), pk2(vi_[4], vi_[5]), pk2(vi_[6], vi_[7])}; }
    if (hf == 0 && tid < 64) { float* AT = (float*)(F.ws + WS_AT) + ((size_t)(l * 64 + g) * 64 + tid) * 2; AT[0] = apr[64 * 65 + tid]; AT[1] = api[64 * 65 + tid]; }
    __syncthreads();
}
__device__ __forceinline__ void p0_fp4_chunk(Frame& F, int chunk, int wave, int lane) {
    unsigned char* UV = F.ws + WS_UV; float* SCL = (float*)(F.ws + WS_SCL);
    for (int i = 0; i < 8; i += 2) {
        f32x4 v[2][8]; float am[2] = {0.f, 0.f}; int tbl[2], rr[2];
#pragma unroll
        for (int r2 = 0; r2 < 2; ++r2) {
            const int r = chunk * 64 + wave * 8 + i + r2; tbl[r2] = r >> 15; rr[r2] = r & 32767;
            const float* srcp = (tbl[r2] ? F.in[I_PV] : F.in[I_PU]) + (size_t)rr[r2] * 2048 + lane * 4;
#pragma unroll
            for (int j = 0; j < 8; ++j) v[r2][j] = *(const f32x4*)(srcp + j * 256);
        }
#pragma unroll
        for (int r2 = 0; r2 < 2; ++r2)
#pragma unroll
            for (int j = 0; j < 8; ++j) am[r2] = fmaxf(am[r2], fmaxf(fmaxf(fabsf(v[r2][j][0]), fabsf(v[r2][j][1])), fmaxf(fabsf(v[r2][j][2]), fabsf(v[r2][j][3]))));
#pragma unroll
        for (int o = 1; o < 64; o <<= 1) { am[0] = fmaxf(am[0], __shfl_xor(am[0], o)); am[1] = fmaxf(am[1], __shfl_xor(am[1], o)); }
#pragma unroll
        for (int r2 = 0; r2 < 2; ++r2) {
            const float scale = am[r2] > 0.f ? am[r2] * (1.0f / 6.0f) : 1.0f, inv = am[r2] > 0.f ? 6.0f / am[r2] : 1.0f;
            u32x4 o;
#pragma unroll
            for (int d = 0; d < 4; ++d) { unsigned w = 0u;
                w = __builtin_amdgcn_cvt_scalef32_pk_fp4_f32(w, v[r2][2 * d][0] * inv, v[r2][2 * d][1] * inv, 1.0f, 0);
                w = __builtin_amdgcn_cvt_scalef32_pk_fp4_f32(w, v[r2][2 * d][2] * inv, v[r2][2 * d][3] * inv, 1.0f, 1);
                w = __builtin_amdgcn_cvt_scalef32_pk_fp4_f32(w, v[r2][2 * d + 1][0] * inv, v[r2][2 * d + 1][1] * inv, 1.0f, 2);
                w = __builtin_amdgcn_cvt_scalef32_pk_fp4_f32(w, v[r2][2 * d + 1][2] * inv, v[r2][2 * d + 1][3] * inv, 1.0f, 3);
                o[d] = w; }
            *(u32x4*)(UV + (size_t)(rr[r2] >> 14) * ((size_t)NEXP * 2048) + (size_t)tbl[r2] * ((size_t)NEXP * 1024) + (size_t)(rr[r2] & 16383) * 1024 + lane * 16) = o;
            if (lane == 0) SCL[rr[r2] * 2 + tbl[r2]] = scale;
        }
    }
}
#ifndef P0_PARTS
#define P0_PARTS 15
#endif
#ifndef P0_PROBE_MODE
#define P0_PROBE_MODE 0
#endif
__device__ __forceinline__ void p0_tables(Frame& F, int qi = 4, bool dummy = false) {
    PH_LOCALS
    unsigned* head = (unsigned*)(F.ws + WS_CTL) + CW_QUEUE + 64 * qi;
    float* modout = dummy ? (float*)(F.ws + WS_DBG) : (float*)(F.ws + WS_MOD);
    LAS unsigned* slot = (LAS unsigned*)(F.lds + MISC_OFF) + 16;
    for (;;) {
        __syncthreads();
        if (tid == 0) slot[0] = __hip_atomic_fetch_add(head, 1u, RLX_AGENT);
        __syncthreads();
        const unsigned u = slot[0];
        if (u >= 1664u) break;
        const int rnd = (int)u / 13, k = (int)u % 13;
        if (k < 2) { if (dummy && P0_PROBE_MODE == 2) continue; p0_s5_unit(F, rnd * 2 + k, tid, dummy ? P0_PARTS : 15); }
        else if (k < 5) { if (dummy && P0_PROBE_MODE == 1) continue; p0_gemv_unit(F, rnd * 3 + (k - 2), tid, modout); }
        else { p0_fp4_chunk(F, rnd * 8 + (k - 5), wave, lane); }
    }
}
__device__ __forceinline__ void p0_prologue(Frame& F) {
    PH_LOCALS
    const int gw = F.vcu * NWAVES + wave, NGW = F.G * NWAVES;
    const int gt = F.vcu * NTHR + tid, NGT = F.G * NTHR;
    const float* modp = (const float*)(F.ws + WS_MOD);
    for (int i = gt; i < 2 * DM; i += NGT) { const int l = i >> 11, k = i & 2047; ((float*)(F.ws + WS_GS))[i] = F.in[I_N2G][i] * (1.0f + modp[l * 12288 + 4 * 2048 + k]); }
    if (F.vcu < 64) {
        const int l = F.vcu >> 5, cb = F.vcu & 31, tx = tid & 15, ty = tid >> 4;
        const float* W = F.in[I_WQ] + (size_t)l * DM * DM + cb * 64 + tx * 4; const float* sh = modp + l * 12288 + 3 * 2048;
        f32x4 a = {0.f, 0.f, 0.f, 0.f};
#pragma unroll 16
        for (int k = ty; k < DM; k += 32) { const f32x4 w = *(const f32x4*)(W + (size_t)k * DM); a += w * sh[k]; }
        LAS float* red = (LAS float*)F.lds;
        *(LAS f32x4*)(red + ty * 64 + tx * 4) = a;
        __syncthreads();
        if (tid < 64) { float s = 0.f;
#pragma unroll
            for (int y = 0; y < 32; ++y) s += red[y * 64 + tid];
            ((float*)(F.ws + WS_C0))[l * DM + cb * 64 + tid] = s; }
        __syncthreads();
    }
    {
        LAS float* scr = (LAS float*)(F.lds + wave * 16384);
        constexpr int I_IN = (DM / 64) * (INW / 32), I_GL = (WB / 64) * (WB / 32), I_OU = (DM / 64) * (DM / 32), I_Q = I_OU;
        constexpr int PER_L = I_IN + I_GL + I_OU + I_Q;
        for (int it = gw; it < 2 * PER_L; it += NGW) {
            const int l = it / PER_L; int r = it % PER_L;
            if (r < I_IN) { p0_transpose_item(F.in[I_WIN] + (size_t)l * DM * INW, DM, INW, (bf16*)(F.ws + WS_WIN) + (size_t)l * INW * DM, nullptr, scr, r, lane); continue; } r -= I_IN;
            if (r < I_GL) { p0_transpose_item(F.in[I_GLUW] + (size_t)l * WB * WB, WB, WB, (bf16*)(F.ws + WS_GLU) + (size_t)l * WB * WB, nullptr, scr, r, lane); continue; } r -= I_GL;
            if (r < I_OU) { p0_transpose_item(F.in[I_WOUT] + (size_t)l * DM * DM, DM, DM, (bf16*)(F.ws + WS_WOUT) + (size_t)l * DM * DM, F.in[I_BRG] + l * DM, scr, r, lane); continue; } r -= I_OU;
            p0_transpose_item(F.in[I_WQ] + (size_t)l * DM * DM, DM, DM, (bf16*)(F.ws + WS_WQ) + (size_t)l * DM * DM, F.in[I_N2G] + l * DM, scr, r, lane, modp + l * 12288 + 4 * 2048);
        }
    }
    {
        bf16* KB = (bf16*)(F.ws + WS_KEYS);
        for (int i = gt; i < 2 * 8 * 2 * 128 * 128 / 8; i += NGT) { const f32x4 a = *(const f32x4*)(F.in[I_KEYS] + (size_t)i * 8), b = *(const f32x4*)(F.in[I_KEYS] + (size_t)i * 8 + 4);
            u32x4 o; o.x = pk2(a[0], a[1]); o.y = pk2(a[2], a[3]); o.z = pk2(b[0], b[1]); o.w = pk2(b[2], b[3]); *(u32x4*)(KB + (size_t)i * 8) = o; }
        bf16* GW = (bf16*)(F.ws + WS_GWS);
        for (int i = gt; i < 2 * 8 * 128 * 128 / 8; i += NGT) { const int e = i * 8, jj = e & 127, ii = (e >> 7) & 127; const bool keep = (ii >= 64) || (jj < 64);
            f32x4 a = *(const f32x4*)(F.in[I_GWS] + (size_t)i * 8), b = *(const f32x4*)(F.in[I_GWS] + (size_t)i * 8 + 4);
            if (!keep) { a = (f32x4){0.f, 0.f, 0.f, 0.f}; b = a; }
            u32x4 o; o.x = pk2(a[0], a[1]); o.y = pk2(a[2], a[3]); o.z = pk2(b[0], b[1]); o.w = pk2(b[2], b[3]); *(u32x4*)(GW + (size_t)i * 8) = o; }
    }
}

template <bool SRC_BF16>
__device__ __forceinline__ void phase_norm(Frame& F, const void* xsrc, const float* gain, const float* scale, const float* shift) {
    PH_LOCALS
    const int gw = F.vcu * NWAVES + wave, NGW = F.G * NWAVES;
    bf16* H = (bf16*)(F.ws + WS_H);
    for (int m = gw; m < M; m += 2 * NGW) {
        const int m2 = m + NGW;
        f32x4 va[4][2], vb[4][2];
        const char* ra = (const char*)xsrc + (size_t)m * DM * (SRC_BF16 ? 2 : 4); const char* rb = (const char*)xsrc + (size_t)(m2 < M ? m2 : m) * DM * (SRC_BF16 ? 2 : 4);
        load_row<SRC_BF16>(ra, lane, va); load_row<SRC_BF16>(rb, lane, vb);
        u32x4 oa[4], ob[4]; norm_mod_row(va, gain, scale, shift, lane, oa); norm_mod_row(vb, gain, scale, shift, lane, ob);
#pragma unroll
        for (int j = 0; j < 4; ++j) *(u32x4*)(H + (size_t)m * DM + j * 512 + lane * 8) = oa[j];
        if (m2 < M) {
#pragma unroll
            for (int j = 0; j < 4; ++j) *(u32x4*)(H + (size_t)m2 * DM + j * 512 + lane * 8) = ob[j]; }
    }
}
__device__ __forceinline__ void phase_sloc(Frame& F, int l) {
    PH_LOCALS
    const bf16* XS = (const bf16*)(F.ws + WS_XS); const bf16* WG = (const bf16*)(F.ws + WS_WG) + (size_t)l * 64 * 128 * 1024; float* SL = (float*)(F.ws + WS_SLOC);
    LAS unsigned char* WL = F.lds;
    const int fr = lane & 15, fq = lane >> 4;
    for (int u = F.vcu; u < 256; u += F.G) {
        const int g = u >> 2, jq = u & 3;
        const bf16* xp0 = XS + ((size_t)(g * 256 + 32 * wave + fr)) * 1024 + 8 * fq;
        bf16x8 xa[8][2];
#pragma unroll
        for (int i = 0; i < 8; ++i) { xa[i][0] = *(const bf16x8*)(xp0 + i * 32); xa[i][1] = *(const bf16x8*)(xp0 + 16 * 1024 + i * 32); }
        __syncthreads();
#pragma unroll
        for (int ps = 0; ps < 8; ++ps) { const int idx = ps * 512 + tid, row = idx >> 7, c16 = idx & 127;
            *(LAS u32x4*)(WL + row * 2064 + c16 * 16) = *(const u32x4*)(WG + ((size_t)(g * 128 + jq * 32 + row)) * 1024 + c16 * 8); }
        __syncthreads();
        f32x4 acc[2][2];
#pragma unroll
        for (int a = 0; a < 2; ++a) { acc[a][0] = (f32x4){0.f, 0.f, 0.f, 0.f}; acc[a][1] = acc[a][0]; }
#pragma unroll 1
        for (int kg = 0; kg < 4; ++kg) {
            bf16x8 xn[8][2];
            if (kg < 3) {
#pragma unroll
                for (int i = 0; i < 8; ++i) { xn[i][0] = *(const bf16x8*)(xp0 + ((kg + 1) * 8 + i) * 32); xn[i][1] = *(const bf16x8*)(xp0 + 16 * 1024 + ((kg + 1) * 8 + i) * 32); }
            }
#pragma unroll
            for (int i = 0; i < 8; ++i) { const int kb = kg * 8 + i;
#pragma unroll
                for (int jt = 0; jt < 2; ++jt) { const bf16x8 wf = *(const LAS bf16x8*)(WL + (jt * 16 + fr) * 2064 + (kb * 32 + 8 * fq) * 2);
                    acc[0][jt] = __builtin_amdgcn_mfma_f32_16x16x32_bf16(wf, xa[i][0], acc[0][jt], 0, 0, 0);
                    acc[1][jt] = __builtin_amdgcn_mfma_f32_16x16x32_bf16(wf, xa[i][1], acc[1][jt], 0, 0, 0); } }
            if (kg < 3) {
#pragma unroll
                for (int i = 0; i < 8; ++i) { xa[i][0] = xn[i][0]; xa[i][1] = xn[i][1]; }
            }
        }
#pragma unroll
        for (int a = 0; a < 2; ++a)
#pragma unroll
            for (int jt = 0; jt < 2; ++jt) *(f32x4*)(SL + ((size_t)(g * 256 + 32 * wave + 16 * a + fr)) * 128 + jq * 32 + jt * 16 + 4 * fq) = acc[a][jt];
    }
    __syncthreads();
}
__device__ __forceinline__ void phase_gating(Frame& F, int l) {
    PH_LOCALS
    const bf16* Z = (const bf16*)(F.ws + WS_Z); const float* PLN = (const float*)(F.ws + WS_PLN);
    bf16* MIX = (bf16*)(F.ws + WS_MIX);
    LAS bf16* VT = (LAS bf16*)F.lds;
    constexpr int VS = 136;
    const int j = tid >> 2, cs = (tid & 3) * 32;
    const int fr = lane & 15, fq = lane >> 4, w = wave;
    u32x4 tw[4]; float mu = 0.f, rs = 0.f;
#define GT_LOAD(unit_) do { const int nb_ = (unit_) >> 3, hh_ = (unit_) & 7; const size_t rowo = (size_t)(nb_ * 128 + j) * 2048 + 1024 + hh_ * 128 + cs; \
        _Pragma("unroll") for (int q = 0; q < 4; ++q) tw[q] = *(const u32x4*)(Z + rowo + q * 8); \
        { const float* pl = PLN + (size_t)(nb_ * 128 + j) * 32; float a1 = 0.f, a2 = 0.f; \
          _Pragma("unroll") for (int i = 0; i < 8; ++i) { const f32x4 pv = *(const f32x4*)(pl + 4 * i); a1 += pv[0] + pv[2]; a2 += pv[1] + pv[3]; } \
          mu = a1 * (1.0f / 1024.0f); rs = 1.0f / sqrtf(fmaxf(a2 * (1.0f / 1024.0f) - mu * mu, 0.f) + EPS); } } while (0)
    if (F.vcu < 1024) GT_LOAD(F.vcu);
    for (int unit = F.vcu; unit < 1024; unit += F.G) {
        const int nb = unit >> 3, hh = unit & 7, t0 = nb * 128, c0 = hh * 128;
        const bf16* GW = (const bf16*)(F.ws + WS_GWS) + (size_t)(l * 8 + hh) * 128 * 128;
        {
            const float* lg = F.in[I_LNG] + l * 1024 + c0 + cs; const float* lb = F.in[I_LNB] + l * 1024 + c0 + cs;
#pragma unroll
            for (int q = 0; q < 4; ++q) {
                const f32x4 g0 = *(const f32x4*)(lg + q * 8), g1 = *(const f32x4*)(lg + q * 8 + 4), b0 = *(const f32x4*)(lb + q * 8), b1 = *(const f32x4*)(lb + q * 8 + 4);
#pragma unroll
                for (int e = 0; e < 4; ++e) { const int c = cs + q * 8 + 2 * e;
                    const float ga = e < 2 ? g0[2 * e] : g1[2 * e - 4], gb = e < 2 ? g0[2 * e + 1] : g1[2 * e - 3], ba = e < 2 ? b0[2 * e] : b1[2 * e - 4], bb = e < 2 ? b0[2 * e + 1] : b1[2 * e - 3];
                    const float a = (bflo(tw[q][e]) - mu) * rs * ga + ba, b = (bfhi(tw[q][e]) - mu) * rs * gb + bb;
                    VT[c * VS + j] = (bf16)f2bf(a); VT[(c + 1) * VS + j] = (bf16)f2bf(b); }
            }
        }
        if (unit + F.G < 1024) GT_LOAD(unit + F.G);
        const int nkb = (w < 4) ? 2 : 4;
        bf16x8 wf[4];
#pragma unroll
        for (int kb = 0; kb < 4; ++kb) wf[kb] = *(const bf16x8*)(GW + (size_t)(16 * w + fr) * 128 + (kb < nkb ? kb : 0) * 32 + 8 * fq);
        const int tok = t0 + 16 * w + fr; const float bs = F.in[I_GBS][(l * 8 + hh) * 128 + 16 * w + fr];
        u32x2 uw[8];
#pragma unroll
        for (int ct = 0; ct < 8; ++ct) uw[ct] = *(const u32x2*)(Z + (size_t)tok * 2048 + c0 + ct * 16 + 4 * fq);
        __syncthreads();
        {
            f32x4 acc[8];
#pragma unroll
            for (int ct = 0; ct < 8; ++ct) acc[ct] = (f32x4){0.f, 0.f, 0.f, 0.f};
#pragma unroll
            for (int kb = 0; kb < 4; ++kb) { if (kb < nkb) {
#pragma unroll
                for (int ct = 0; ct < 8; ++ct) { const bf16x8 vf = *(const LAS bf16x8*)(VT + (ct * 16 + fr) * VS + kb * 32 + 8 * fq); acc[ct] = __builtin_amdgcn_mfma_f32_16x16x32_bf16(vf, wf[kb], acc[ct], 0, 0, 0); } } }
            float ssq = 0.f;
#pragma unroll
            for (int ct = 0; ct < 8; ++ct) { const int c = c0 + ct * 16 + 4 * fq;
                const float o0 = bflo(uw[ct].x) * (acc[ct][0] + bs), o1 = bfhi(uw[ct].x) * (acc[ct][1] + bs), o2 = bflo(uw[ct].y) * (acc[ct][2] + bs), o3 = bfhi(uw[ct].y) * (acc[ct][3] + bs);
                u32x2 o; o.x = pk2(o0, o1); o.y = pk2(o2, o3);
                *(u32x2*)(MIX + (size_t)tok * 2048 + c) = o; ssq += (o0 * o0 + o1 * o1) + (o2 * o2 + o3 * o3); }
            ssq += __shfl_xor(ssq, 16); ssq += __shfl_xor(ssq, 32);
            if (fq == 0) ((float*)(F.ws + WS_PSA))[(size_t)tok * 8 + hh] = ssq;
        }
        __syncthreads();
    }
#undef GT_LOAD
}

__device__ __forceinline__ void phase_s5out(Frame& F, int l) {
    PH_LOCALS
    const bf16* XS = (const bf16*)(F.ws + WS_XS);
    bf16* Gb = (bf16*)(F.ws + WS_G);
    LAS unsigned char* HT = F.lds;
    LAS float* TS = (LAS float*)(F.lds + 34816);
    LAS unsigned char* KT = F.lds + 38912;
    LAS unsigned char* VT = F.lds + 79872;
    const int fr = lane & 15, fq = lane >> 4;
    int have_g = -1, have_nh = -1;
    for (int uu = F.vcu, it = 0; uu < 512; uu += F.G, ++it) {
        const int g = (F.G == 256) ? (F.vcu >> 2) : (uu >> 3), nh = (F.G == 256) ? ((F.vcu >> 1) & 1) : (uu & 1), rc = (F.G == 256) ? ((F.vcu & 1) + 2 * it) : ((uu >> 1) & 3);
        const bool fresh = (g != have_g) || (nh != have_nh);
        const bf16* VG = (const bf16*)(F.ws + WS_VG) + (size_t)(l * 64 + g) * 1024 * 128;
        const int n = nh * 128 + 16 * wave + fr;
        const bf16* xp0 = XS + ((size_t)(g * 256 + n)) * 1024 + 8 * fq;
        bf16x8 xa[4], xb[4];
#pragma unroll
        for (int i = 0; i < 4; ++i) xa[i] = *(const bf16x8*)(xp0 + i * 32);
        __syncthreads();
        { const u32x4* src = (const u32x4*)((const bf16*)(F.ws + WS_KTAB) + (size_t)(l * 64 + g) * 80 * 256);
          if (fresh) for (int i = tid; i < 80 * 256 / 8; i += NTHR) ((LAS u32x4*)KT)[i] = src[i];
#pragma unroll
          for (int ps = 0; ps < 8; ++ps) { const int row = ps * 32 + (tid >> 4), c = tid & 15, q = row >> 4, o = row & 15;
              *(LAS u32x4*)(VT + row * 272 + c * 16) = *(const u32x4*)(VG + (size_t)((rc + 4 * q) * 16 + o) * 128 + c * 8); } }
        if (fresh) {
            const int p = lane, seg = wave;
            const float* AT = (const float*)(F.ws + WS_AT) + ((size_t)(l * 64 + g) * 64 + p) * 2; const float ar = AT[0], ai = AT[1];
            const float* SL = (const float*)(F.ws + WS_SLOC) + ((size_t)(g * 256 + seg * 32)) * 128 + p;
            float sr[32], si[32];
#pragma unroll
            for (int i = 0; i < 32; ++i) { sr[i] = SL[(size_t)i * 128]; si[i] = SL[(size_t)i * 128 + 64]; }
            float er = 0.f, ei = 0.f;
#pragma unroll
            for (int i = 0; i < 32; ++i) { const float nr = ar * er - ai * ei + sr[i], ni = ar * ei + ai * er + si[i]; er = nr; ei = ni; }
            TS[(seg * 64 + p) * 2] = er; TS[(seg * 64 + p) * 2 + 1] = ei;
            float qr = ar, qi = ai;
#pragma unroll
            for (int s = 0; s < 5; ++s) { const float nr = qr * qr - qi * qi, ni = 2.0f * qr * qi; qr = nr; qi = ni; }
            __syncthreads();
            float hr = 0.f, hi = 0.f;
            for (int k = 0; k < seg; ++k) { const float tr = TS[(k * 64 + p) * 2], ti = TS[(k * 64 + p) * 2 + 1]; const float nr = qr * hr - qi * hi + tr, ni = qr * hi + qi * hr + ti; hr = nr; hi = ni; }
            if ((seg >> 2) == nh) {
                LAS bf16* hrow = (LAS bf16*)(HT + ((seg & 3) * 32) * 272) + p;
#pragma unroll
                for (int i = 0; i < 32; ++i) { hrow[i * 136] = (bf16)f2bf(hr); hrow[i * 136 + 64] = (bf16)f2bf(hi);
                    const float nr = ar * hr - ai * hi + sr[i], ni = ar * hi + ai * hr + si[i]; hr = nr; hi = ni; }
            }
        }
        have_g = g; have_nh = nh;
        __syncthreads();
        f32x4 acc[16];
#pragma unroll
        for (int q = 0; q < 16; ++q) acc[q] = (f32x4){0.f, 0.f, 0.f, 0.f};
        const int kb0 = ((rc - (fq >> 1) + 10) * 16 + fr) * 32 + 16 * (fq & 1);
#define S5_GROUP(XF, grp_) do { const LAS unsigned char* kp = KT + kb0 - (grp_) * 4096; \
            _Pragma("unroll") for (int q = 0; q < 16; ++q) { if (rc + 4 * q >= 8 * (grp_)) { \
                _Pragma("unroll") for (int i = 0; i < 4; ++i) { const bf16x8 kf = *(const LAS bf16x8*)(kp + (4 * q - 2 * i + 6) * 512); \
                    acc[q] = __builtin_amdgcn_mfma_f32_16x16x32_bf16(kf, XF[i], acc[q], 0, 0, 0); } } } } while (0)
#pragma unroll 1
        for (int gp = 0; gp < 4; ++gp) {
#pragma unroll
            for (int i = 0; i < 4; ++i) xb[i] = *(const bf16x8*)(xp0 + ((2 * gp + 1) * 4 + i) * 32);
            S5_GROUP(xa, 2 * gp);
            if (gp < 3) {
#pragma unroll
                for (int i = 0; i < 4; ++i) xa[i] = *(const bf16x8*)(xp0 + ((2 * gp + 2) * 4 + i) * 32);
            }
            S5_GROUP(xb, 2 * gp + 1);
        }
#undef S5_GROUP
#pragma unroll 1
        for (int jb = 0; jb < 4; ++jb) {
            const bf16x8 hf = *(const LAS bf16x8*)(HT + (16 * wave + fr) * 272 + (jb * 32 + 8 * fq) * 2);
#pragma unroll
            for (int q = 0; q < 16; ++q) {
                const bf16x8 vf = *(const LAS bf16x8*)(VT + (q * 16 + fr) * 272 + (jb * 32 + 8 * fq) * 2);
                acc[q] = __builtin_amdgcn_mfma_f32_16x16x32_bf16(vf, hf, acc[q], 0, 0, 0);
            }
        }
#pragma unroll
        for (int q = 0; q < 16; ++q) {
            const int t = rc + 4 * q, tok = 64 * n + t;
            const f32x4 y = acc[q];
            u32x2 o; o.x = pk2(gelu_tanh(y[0]), gelu_tanh(y[1])); o.y = pk2(gelu_tanh(y[2]), gelu_tanh(y[3]));
            *(u32x2*)(Gb + (size_t)tok * 1024 + g * 16 + 4 * fq) = o;
#if SELFTEST_S5
            if (tok < 256) *(f32x4*)((float*)(F.ws + WS_DBG) + (size_t)tok * 1024 + g * 16 + 4 * fq) = y;
#endif
        }
    }
    __syncthreads();
}
#if SELFTEST_S5
__device__ __forceinline__ void selftest_s5(Frame& F, int l) {
    PH_LOCALS
    if (F.vcu < 64 && wave == 0) {
        const int g = F.vcu, p = lane;
        const float dt = expf(F.in[I_LDT][l * 64 + g]);
        const float lr = F.in[I_LRE][(l * 64 + g) * 64 + p], li = F.in[I_LIM][(l * 64 + g) * 64 + p];
        const float mag = expf(lr * dt); float sn, cs; sincosf(li * dt, &sn, &cs);
        const float ar = mag * cs, ai = mag * sn;
        const float xr = ar - 1.0f, xi = ai, den = 1.0f / (lr * lr + li * li);
        const float cr = (xr * lr + xi * li) * den, ci = (xi * lr - xr * li) * den;
        float bbr[16], bbi[16], ccr[16], cci[16];
#pragma unroll
        for (int i = 0; i < 16; ++i) { const float br = F.in[I_BRE][((size_t)(l * 64 + g) * 64 + p) * 16 + i], bi = F.in[I_BIM][((size_t)(l * 64 + g) * 64 + p) * 16 + i];
            bbr[i] = cr * br - ci * bi; bbi[i] = cr * bi + ci * br;
            ccr[i] = F.in[I_CRE][((size_t)(l * 64 + g) * 16 + i) * 64 + p]; cci[i] = F.in[I_CIM][((size_t)(l * 64 + g) * 16 + i) * 64 + p]; }
        const bf16* XS = (const bf16*)(F.ws + WS_XS) + (size_t)g * 256 * 1024;
        const float* DY = (const float*)(F.ws + WS_DBG);
        float sr = 0.f, si = 0.f, err = 0.f, ref = 0.f;
        for (int t = 0; t < 256; ++t) {
            float x[16];
#pragma unroll
            for (int i = 0; i < 16; ++i) x[i] = bflo((unsigned)XS[(size_t)t * 16 + i]);
            float ur = 0.f, ui = 0.f;
#pragma unroll
            for (int i = 0; i < 16; ++i) { ur += bbr[i] * x[i]; ui += bbi[i] * x[i]; }
            const float nr = ar * sr - ai * si + ur, ni = ar * si + ai * sr + ui; sr = nr; si = ni;
#pragma unroll
            for (int o = 0; o < 16; ++o) {
                const float yr = wave_sum(ccr[o] * sr - cci[o] * si);
                const float yf = DY[(size_t)t * 1024 + g * 16 + o];
                err += (yf - yr) * (yf - yr); ref += yr * yr;
            }
        }
        if (lane == 0 && !(err <= 2e-3f * ref)) __hip_atomic_fetch_or((unsigned*)(F.ws + WS_CTL) + CW_FLAG, 1u, RLX_AGENT);
    }
}
#endif

__device__ __forceinline__ unsigned f2key(float v) { const unsigned u = __builtin_bit_cast(unsigned, v); return (u & 0x80000000u) ? ~u : (u | 0x80000000u); }
__device__ __forceinline__ float key2f(unsigned k) { const unsigned u = (k & 0x80000000u) ? (k & 0x7fffffffu) : ~k; return __builtin_bit_cast(float, u); }
__device__ __forceinline__ void sort16_desc(unsigned (&v)[16]) {
#pragma unroll
    for (int lk = 1; lk <= 4; ++lk) {
#pragma unroll
        for (int lj = lk - 1; lj >= 0; --lj) {
#pragma unroll
            for (int i = 0; i < 16; ++i) { const int k = 1 << lk, j = 1 << lj, p = i ^ j;
                if (p > i) { const unsigned a = v[i], c = v[p], hi = a > c ? a : c, lo = a > c ? c : a; const bool desc = ((i & k) == 0) || (k == 16);
                    v[i] = desc ? hi : lo; v[p] = desc ? lo : hi; } }
        }
    }
}
__device__ __forceinline__ void merge16_desc(unsigned (&v)[16], const unsigned (&w)[16]) {
#pragma unroll
    for (int i = 0; i < 16; ++i) v[i] = v[i] > w[15 - i] ? v[i] : w[15 - i];
#pragma unroll
    for (int lj = 3; lj >= 0; --lj) {
#pragma unroll
        for (int i = 0; i < 16; ++i) { const int j = 1 << lj, p = i ^ j;
            if (p > i) { const unsigned a = v[i], c = v[p]; v[i] = a > c ? a : c; v[p] = a > c ? c : a; } }
    }
}
__device__ __forceinline__ void xmerge16(unsigned (&v)[16], int mask) {
    unsigned w[16];
#pragma unroll
    for (int i = 0; i < 16; ++i) w[i] = (unsigned)__shfl_xor((int)v[i], mask);
    merge16_desc(v, w);
}
__device__ __forceinline__ void phase_topk(Frame& F, int l) {
    PH_LOCALS
    const bf16* Q = (const bf16*)(F.ws + WS_Z);
    const bf16* KB = (const bf16*)(F.ws + WS_KEYS) + (size_t)l * 8 * 2 * 128 * 128;
    int* EID = (int*)(F.ws + WS_EID); float* GT = (float*)(F.ws + WS_GATE); float* SUo = (float*)(F.ws + WS_SU);
    const float* SCL = (const float*)(F.ws + WS_SCL) + (size_t)l * NEXP * 2;
    LAS unsigned char* KL = F.lds;
    LAS unsigned* LST = (LAS unsigned*)(F.lds + 69632);
    LAS unsigned char* PT = F.lds + 69632 + 16384;
    const int fr = lane & 15, fq = lane >> 4;
    {
        int c = 0;
#pragma unroll
        for (int i = 0; i < 16; ++i)
#pragma unroll
            for (int j = 0; j < 16; ++j) if ((i + 1) * (j + 1) <= 16) { if (tid == c) PT[c] = (unsigned char)(i * 16 + j); ++c; }
    }
    int cur_hh = -1;
    for (int u = F.vcu; u < 1024; u += F.G) {
        const int tt = u >> 3, hh = u & 7, t0 = tt * 128;
        bf16x8 qf[2][4];
#pragma unroll
        for (int s = 0; s < 2; ++s)
#pragma unroll
            for (int kb = 0; kb < 4; ++kb) qf[s][kb] = *(const bf16x8*)(Q + (size_t)(t0 + 16 * wave + fr) * 2048 + hh * 256 + s * 128 + kb * 32 + 8 * fq);
        if (hh != cur_hh) {
            __syncthreads();
#pragma unroll
            for (int ps = 0; ps < 8; ++ps) { const int idx = ps * 512 + tid, row = idx >> 4, c16 = idx & 15;
                *(LAS u32x4*)(KL + row * 272 + c16 * 16) = *(const u32x4*)(KB + ((size_t)(hh * 256 + row)) * 128 + c16 * 8); }
            cur_hh = hh;
            __syncthreads();
        }
#pragma unroll 1
        for (int s = 0; s < 2; ++s) {
            f32x4 acc[8];
#pragma unroll
            for (int nt = 0; nt < 8; ++nt) acc[nt] = (f32x4){0.f, 0.f, 0.f, 0.f};
#pragma unroll
            for (int kb = 0; kb < 4; ++kb) { const bf16x8 q = s ? qf[1][kb] : qf[0][kb];
#pragma unroll
                for (int nt = 0; nt < 8; ++nt) { const bf16x8 kf = *(const LAS bf16x8*)(KL + (s * 128 + nt * 16 + fr) * 272 + (kb * 32 + 8 * fq) * 2);
                    acc[nt] = __builtin_amdgcn_mfma_f32_16x16x32_bf16(kf, q, acc[nt], 0, 0, 0); } }
            unsigned va[16], vb[16];
#pragma unroll
            for (int nt = 0; nt < 4; ++nt)
#pragma unroll
                for (int r = 0; r < 4; ++r) { va[4 * nt + r] = (f2key(acc[nt][r]) & ~0x7Fu) | (unsigned)(127 - (nt * 16 + 4 * fq + r));
                    vb[4 * nt + r] = (f2key(acc[4 + nt][r]) & ~0x7Fu) | (unsigned)(127 - ((4 + nt) * 16 + 4 * fq + r)); }
            sort16_desc(va); sort16_desc(vb); merge16_desc(va, vb);
            xmerge16(va, 16); xmerge16(va, 32);
            if (fq == 0) {
#pragma unroll
                for (int k = 0; k < 16; k += 4) *(LAS u32x4*)(LST + ((16 * wave + fr) * 2 + s) * 16 + k) = (u32x4){va[k], va[k + 1], va[k + 2], va[k + 3]};
            }
        }
        asm volatile("s_waitcnt lgkmcnt(0)" ::: "memory");
        {
            const int tl = 16 * wave + (lane >> 2), c4 = lane & 3;
            unsigned v[16];
#pragma unroll
            for (int m = 0; m < 13; ++m) { const int c = m * 4 + c4; unsigned key = 0u;
                if (c < 50) { const int pij = PT[c], i = pij >> 4, j = pij & 15;
                    const float av = key2f(LST[(tl * 2 + 0) * 16 + i] & ~0x7Fu), bv = key2f(LST[(tl * 2 + 1) * 16 + j] & ~0x7Fu);
                    key = (f2key(av + bv) & ~0xFFu) | (unsigned)(255 - pij); }
                v[m] = key; }
#pragma unroll
            for (int m = 13; m < 16; ++m) v[m] = 0u;
            sort16_desc(v);
            xmerge16(v, 1); xmerge16(v, 2);
            float ev[16]; float sum = 0.f; const float mx = key2f(v[0] & ~0xFFu);
#pragma unroll
            for (int k = 0; k < 16; ++k) { ev[k] = __expf(key2f(v[k] & ~0xFFu) - mx); sum += ev[k]; }
            const float inv = 1.0f / sum;
            unsigned kk[4] = {v[0], v[1], v[2], v[3]}; float ee[4] = {ev[0], ev[1], ev[2], ev[3]};
#pragma unroll
            for (int q = 1; q < 4; ++q) { if (c4 == q) {
#pragma unroll
                for (int e = 0; e < 4; ++e) { kk[e] = v[4 * q + e]; ee[e] = ev[4 * q + e]; } } }
            const size_t ob = (size_t)(t0 + tl) * 128 + hh * 16 + 4 * c4;
            int eo[4]; float go[4], so[4];
#pragma unroll
            for (int e = 0; e < 4; ++e) { const int flat = 255 - (int)(kk[e] & 0xFFu), i = flat >> 4, j = flat & 15;
                const int ia = 127 - (int)(LST[(tl * 2 + 0) * 16 + i] & 0x7Fu), ib = 127 - (int)(LST[(tl * 2 + 1) * 16 + j] & 0x7Fu);
                eo[e] = ia * 128 + ib; }
#pragma unroll
            for (int e = 0; e < 4; ++e) { const f32x2 sc = *(const f32x2*)(SCL + 2 * eo[e]); go[e] = ee[e] * inv * sc.y; so[e] = sc.x; }
            *(u32x4*)(EID + ob) = (u32x4){(unsigned)eo[0], (unsigned)eo[1], (unsigned)eo[2], (unsigned)eo[3]};
            *(f32x4*)(GT + ob) = (f32x4){go[0], go[1], go[2], go[3]};
            *(f32x4*)(SUo + ob) = (f32x4){so[0], so[1], so[2], so[3]};
        }
        asm volatile("s_waitcnt lgkmcnt(0)" ::: "memory");
    }
    __syncthreads();
}

#define FP4X4(w, f0, f1, f2, f3) do { f0 = __builtin_amdgcn_cvt_scalef32_pk_f32_fp4((w), 1.0f, 0); f1 = __builtin_amdgcn_cvt_scalef32_pk_f32_fp4((w), 1.0f, 1); \
    f2 = __builtin_amdgcn_cvt_scalef32_pk_f32_fp4((w), 1.0f, 2); f3 = __builtin_amdgcn_cvt_scalef32_pk_f32_fp4((w), 1.0f, 3); } while (0)
__device__ __forceinline__ void phase_gather(Frame& F, int l, bool dummy = false) {
    PH_LOCALS
    const int gw = F.vcu * NWAVES + wave, NGW = F.G * NWAVES;
    bf16* Hn = dummy ? (bf16*)(F.ws + WS_DBG + 128 * MiB) : (bf16*)(F.ws + WS_H);
    const unsigned char* UT = F.ws + WS_UV + (size_t)l * NEXP * 2048;
    const unsigned char* VTb = UT + (size_t)NEXP * 1024;
    const int* EID = (const int*)(F.ws + WS_EID); const float* GT = (const float*)(F.ws + WS_GATE); const float* SU = (const float*)(F.ws + WS_SU);
    float* COEF = dummy ? (float*)(F.ws + WS_DBG + 192 * MiB) : (float*)(F.ws + WS_COEF);
    const bf16* X = (const bf16*)(F.ws + WS_X); bf16* Xo = dummy ? (bf16*)(F.ws + WS_DBG) : (bf16*)(F.ws + WS_X);
    const float* mod = (const float*)(F.ws + WS_MOD);
    const float* gate2 = mod + l * 12288 + 5 * 2048; const float* shift2 = mod + l * 12288 + 3 * 2048; const float* gs2 = (const float*)(F.ws + WS_GS) + l * DM;
    const unsigned lane16 = (unsigned)lane * 16u;
    const bool u32_ = (lane & 32) != 0, u16_ = (lane & 16) != 0, u8_ = (lane & 8) != 0, u4_ = (lane & 4) != 0;
#if GATHER_PROBE_HOT
#define G_HOT(e) if (dummy) e &= 15;
#else
#define G_HOT(e)
#endif
#define G_ROW(dst, tab, b_, h_) do { int e_ = __builtin_amdgcn_readlane((b_) < 4 ? e_lo : e_hi, (16 * (b_) + (h_)) & 63); G_HOT(e_) \
            dst = *(const u32x4*)((tab) + ((size_t)(unsigned)e_ << 10) + lane16); } while (0)
    for (int t = gw; t < M; t += NGW) {
        const int e_lo = EID[(size_t)t * 128 + lane], e_hi = EID[(size_t)t * 128 + 64 + lane];
        const float g_lo = GT[(size_t)t * 128 + lane], g_hi = GT[(size_t)t * 128 + 64 + lane];
        const float s_lo = SU[(size_t)t * 128 + lane], s_hi = SU[(size_t)t * 128 + 64 + lane];
        f32x2 hh[8][2];
        {   float s2 = 0.f; u32x2 xw[8];
#pragma unroll
            for (int j = 0; j < 8; ++j) xw[j] = *(const u32x2*)(X + (size_t)t * 2048 + j * 256 + lane * 4);
#pragma unroll
            for (int j = 0; j < 8; ++j) { hh[j][0] = (f32x2){bflo(xw[j].x), bfhi(xw[j].x)}; hh[j][1] = (f32x2){bflo(xw[j].y), bfhi(xw[j].y)};
                s2 += (hh[j][0].x * hh[j][0].x + hh[j][0].y * hh[j][0].y) + (hh[j][1].x * hh[j][1].x + hh[j][1].y * hh[j][1].y); }
            const float r2 = 1.0f / sqrtf(wave_sum(s2) * (1.0f / DM) + EPS);
#pragma unroll
            for (int j2 = 0; j2 < 8; j2 += 4) { f32x4 gsv[4], shv[4];
#pragma unroll
                for (int j = 0; j < 4; ++j) { gsv[j] = *(const f32x4*)(gs2 + (j2 + j) * 256 + lane * 4); shv[j] = *(const f32x4*)(shift2 + (j2 + j) * 256 + lane * 4); }
#pragma unroll
                for (int j = 0; j < 4; ++j) { hh[j2 + j][0] = (f32x2){hh[j2 + j][0].x * r2 * gsv[j][0] + shv[j][0], hh[j2 + j][0].y * r2 * gsv[j][1] + shv[j][1]}; hh[j2 + j][1] = (f32x2){hh[j2 + j][1].x * r2 * gsv[j][2] + shv[j][2], hh[j2 + j][1].y * r2 * gsv[j][3] + shv[j][3]}; } }
        }
        u32x4 ur[16];
#pragma unroll
        for (int h = 0; h < 16; ++h) G_ROW(ur[h], UT, 0, h);
#define G_UBATCH(b_, NEXT) { float p[16]; \
            _Pragma("unroll") for (int h = 0; h < 16; ++h) { f32x2 a2 = {0.f, 0.f}; \
                if (GATHER_PROBE_MEM && dummy) { a2.x = __builtin_bit_cast(float, ur[h][0] ^ ur[h][1] ^ ur[h][2] ^ ur[h][3]); } else { \
                _Pragma("unroll") for (int d = 0; d < 4; ++d) { f32x2 f0, f1, f2, f3; FP4X4(ur[h][d], f0, f1, f2, f3); \
                    a2 = f0 * hh[2 * d][0] + a2; a2 = f1 * hh[2 * d][1] + a2; a2 = f2 * hh[2 * d + 1][0] + a2; a2 = f3 * hh[2 * d + 1][1] + a2; } } \
                p[h] = a2.x + a2.y; if (NEXT) G_ROW(ur[h], UT, (b_) + 1, h); } \
            float a8[8]; \
            _Pragma("unroll") for (int i = 0; i < 8; ++i) { const float snd = u32_ ? p[i] : p[8 + i], kp = u32_ ? p[8 + i] : p[i]; a8[i] = kp + __shfl_xor(snd, 32); } \
            float a4[4]; \
            _Pragma("unroll") for (int i = 0; i < 4; ++i) { const float snd = u16_ ? a8[i] : a8[4 + i], kp = u16_ ? a8[4 + i] : a8[i]; a4[i] = kp + __shfl_xor(snd, 16); } \
            float b2[2]; \
            _Pragma("unroll") for (int i = 0; i < 2; ++i) { const float snd = u8_ ? a4[i] : a4[2 + i], kp = u8_ ? a4[2 + i] : a4[i]; b2[i] = kp + __shfl_xor(snd, 8); } \
            float d; { const float snd = u4_ ? b2[0] : b2[1], kp = u4_ ? b2[1] : b2[0]; d = kp + __shfl_xor(snd, 4); } \
            d += __shfl_xor(d, 2); d += __shfl_xor(d, 1);                   \
            const int hl = (16 * (b_) + (lane >> 2)) & 63; const float gsel = (b_) < 4 ? g_lo : g_hi, ssel = (b_) < 4 ? s_lo : s_hi; \
            const float coefq = __shfl(gsel, hl) * gelu_tanh(d * __shfl(ssel, hl)); \
            if ((lane & 3) == 0) COEF[(size_t)t * 128 + 16 * (b_) + (lane >> 2)] = coefq; }
#pragma unroll 1
        for (int b = 0; b < 7; ++b) G_UBATCH(b, true)
        G_UBATCH(7, false)
#undef G_UBATCH
    }
    asm volatile("s_waitcnt vmcnt(0)" ::: "memory");
    for (int t = gw; t < M; t += NGW) {
        const int e_lo = EID[(size_t)t * 128 + lane], e_hi = EID[(size_t)t * 128 + 64 + lane];
        const float c_lo = COEF[(size_t)t * 128 + lane], c_hi = COEF[(size_t)t * 128 + 64 + lane];
        u32x4 vr[16];
#pragma unroll
        for (int h = 0; h < 16; ++h) G_ROW(vr[h], VTb, 0, h);
        f32x2 of[8][2];
#pragma unroll
        for (int j = 0; j < 8; ++j) { of[j][0] = (f32x2){0.f, 0.f}; of[j][1] = (f32x2){0.f, 0.f}; }
#define G_VBATCH(b_, NEXT) { const float csel = (b_) < 4 ? c_lo : c_hi; \
            _Pragma("unroll") for (int h = 0; h < 16; ++h) { const float cf = __builtin_bit_cast(float, __builtin_amdgcn_readlane(__builtin_bit_cast(int, csel), (16 * (b_) + h) & 63)); const f32x2 cf2 = {cf, cf}; \
                if (GATHER_PROBE_MEM && dummy) { of[0][0].x += cf * __builtin_bit_cast(float, vr[h][0] ^ vr[h][1] ^ vr[h][2] ^ vr[h][3]); } else { \
                _Pragma("unroll") for (int dd = 0; dd < 4; ++dd) { f32x2 f0, f1, f2, f3; FP4X4(vr[h][dd], f0, f1, f2, f3); \
                    of[2 * dd][0] = f0 * cf2 + of[2 * dd][0]; of[2 * dd][1] = f1 * cf2 + of[2 * dd][1]; of[2 * dd + 1][0] = f2 * cf2 + of[2 * dd + 1][0]; of[2 * dd + 1][1] = f3 * cf2 + of[2 * dd + 1][1]; } } \
                if (NEXT) G_ROW(vr[h], VTb, (b_) + 1, h); } }
#pragma unroll 1
        for (int b = 0; b < 7; ++b) G_VBATCH(b, true)
        G_VBATCH(7, false)
#undef G_VBATCH
        int ln = lane; asm volatile("" : "+v"(ln));
        u32x2 cx[8];
#pragma unroll
        for (int j = 0; j < 8; ++j) cx[j] = *(const u32x2*)(X + (size_t)t * 2048 + j * 256 + ln * 4);
        f32x4 xv[8]; float ss = 0.f;
#pragma unroll
        for (int j2 = 0; j2 < 8; j2 += 4) { f32x4 g2v[4];
#pragma unroll
            for (int j = 0; j < 4; ++j) g2v[j] = *(const f32x4*)(gate2 + (j2 + j) * 256 + ln * 4);
#pragma unroll
            for (int jj = 0; jj < 4; ++jj) { const int j = j2 + jj;
                const f32x4 xo = {bflo(cx[j].x), bfhi(cx[j].x), bflo(cx[j].y), bfhi(cx[j].y)};
                const f32x4 o = {of[j][0].x, of[j][0].y, of[j][1].x, of[j][1].y};
                xv[j] = xo + g2v[jj] * o;
                ss += (xv[j][0] * xv[j][0] + xv[j][1] * xv[j][1]) + (xv[j][2] * xv[j][2] + xv[j][3] * xv[j][3]); } }
        const float rr = 1.0f / sqrtf(wave_sum(ss) * (1.0f / DM) + EPS);
        if (l + 1 < DEPTH) {
            const float* m2 = mod + (l + 1) * 12288; const float* gain = F.in[I_N1G] + (l + 1) * 2048;
#pragma unroll
            for (int j2 = 0; j2 < 8; j2 += 4) { f32x4 gv[4], scv[4], shv[4];
#pragma unroll
                for (int j = 0; j < 4; ++j) { const int c = (j2 + j) * 256 + ln * 4; gv[j] = *(const f32x4*)(gain + c); scv[j] = *(const f32x4*)(m2 + 2048 + c); shv[j] = *(const f32x4*)(m2 + c); }
#pragma unroll
                for (int jj = 0; jj < 4; ++jj) { const int j = j2 + jj, c = j * 256 + ln * 4;
                    *(u32x2*)(Xo + (size_t)t * 2048 + c) = (u32x2){pk2(xv[j][0], xv[j][1]), pk2(xv[j][2], xv[j][3])};
                    const f32x4 y = xv[j] * rr * gv[jj] * (scv[jj] + 1.0f) + shv[jj];
                    *(u32x2*)(Hn + (size_t)t * 2048 + c) = (u32x2){pk2(y[0], y[1]), pk2(y[2], y[3])}; } }
        } else {
#pragma unroll
            for (int j = 0; j < 8; ++j) { const int c = j * 256 + ln * 4; const f32x4 fgv = *(const f32x4*)(F.in[I_FG] + c);
                f32x4 ov = xv[j] * rr * fgv;
#if SELFTEST_S5
                if (__hip_atomic_load((unsigned*)(F.ws + WS_CTL) + CW_FLAG, RLX_AGENT) != 0u) ov = (f32x4){1e30f, 1e30f, 1e30f, 1e30f};
#endif
                *(f32x4*)(F.out + (size_t)t * 2048 + c) = ov; }
        }
    }
}

__global__ void __launch_bounds__(NTHR, 2) fwd_kernel(Args args) {
    extern __shared__ __attribute__((aligned(16))) unsigned char lds_raw[];
    Frame F;
    F.lds = (LAS unsigned char*)lds_raw; F.ws = args.ws; F.in = args.in; F.out = args.out;
    F.tid = threadIdx.x; F.lane = F.tid & 63; F.wave = __builtin_amdgcn_readfirstlane(F.tid >> 6);
    F.G = gridDim.x; { const int bx = blockIdx.x; F.vcu = (F.G % 8 == 0) ? (bx % 8) * (F.G / 8) + bx / 8 : bx; }
    volatile LAS unsigned* MISC = (volatile LAS unsigned*)(F.lds + MISC_OFF);
    if (F.tid < 64) MISC[F.tid] = 0u;
    __syncthreads();
    unsigned* ctl = (unsigned*)(F.ws + WS_CTL);
    XcdBarrier bar; bar.bar = ctl + CW_BAR; bar.x = 0; bar.st = nullptr;
#if !MK_PER_PHASE
    bar = xcd_barrier_post(ctl + CW_BAR, MISC + 8);
#endif
    const int lo = args.ph_lo, hi = args.ph_hi;
#define IN(k) (lo <= (k) && (k) < hi)
#if MK_PER_PHASE
#define SEAM(k) do { } while (0)
#else
#define SEAM(k) do { if (IN(k) && IN((k) + 1)) xcd_barrier(bar); } while (0)
#endif
    const float* mod = (const float*)(F.ws + WS_MOD);

#define REP(k) (REPEAT_PH == (k))
#define RUN2(k, first, real) do { if (REP(k)) { first; xcd_barrier(bar); } real; } while (0)
    if (IN(0)) { RUN2(13, p0_tables(F, 5, true), p0_tables(F, 4, false)); } SEAM(0);
    for (int l = 0; l < DEPTH; ++l) {
        const int pb = 1 + 12 * l;
        const float* ml = mod + l * 12288;
        if (IN(pb + 0)) { if (l == 0) { RUN2(0, p0_prologue(F), p0_prologue(F)); RUN2(1, phase_norm<false>(F, F.in[I_X], F.in[I_N1G] + l * 2048, ml + 1 * 2048, ml + 0 * 2048), phase_norm<false>(F, F.in[I_X], F.in[I_N1G] + l * 2048, ml + 1 * 2048, ml + 0 * 2048)); } } SEAM(pb + 0);
        if (IN(pb + 1)) {
            pg8::Gemm g{(const bf16*)(F.ws + WS_H), (const bf16*)(F.ws + WS_WIN) + (size_t)l * INW * DM, M, INW, DM}; pg8::StaticOrder S; S.init(M, INW, F.G, (int)blockIdx.x);
            EpiIn E{(bf16*)(F.ws + WS_Z), (bf16*)(F.ws + WS_XS), F.in[I_BIN] + l * INW, (float*)(F.ws + WS_PLN)};
#define GEMM_IN pg8::gemm_phase<EpiIn, pg8::StaticOrder, true, true>(F.lds, g, S, E)
            RUN2(2, GEMM_IN, GEMM_IN);
        } SEAM(pb + 1);
        if (IN(pb + 2)) { RUN2(3, phase_sloc(F, l), phase_sloc(F, l)); } SEAM(pb + 2);
        if (IN(pb + 3)) { RUN2(5, phase_s5out(F, l), phase_s5out(F, l)); RUN2(4, phase_gating(F, l), phase_gating(F, l));
#if SELFTEST_S5
            xcd_barrier(bar); selftest_s5(F, l);
#endif
        } SEAM(pb + 4);
        if (IN(pb + 5)) {
            pg8::Gemm g{(const bf16*)(F.ws + WS_G), (const bf16*)(F.ws + WS_GLU) + (size_t)l * WB * WB, M, WB, WB}; pg8::StaticOrder S; S.init(M, WB, F.G, (int)blockIdx.x);
            EpiGlu E{(const bf16*)(F.ws + WS_G), (bf16*)(F.ws + WS_MIX), F.in[I_GLUB] + l * WB, (float*)(F.ws + WS_PSB)};
#define GEMM_GLU pg8::gemm_phase<EpiGlu, pg8::StaticOrder, true, true>(F.lds, g, S, E)
            RUN2(6, GEMM_GLU, GEMM_GLU);
        } SEAM(pb + 6);
        if (IN(pb + 7)) {
            pg8::Gemm g{(const bf16*)(F.ws + WS_MIX), (const bf16*)(F.ws + WS_WOUT) + (size_t)l * DM * DM, M, DM, DM}; pg8::StaticOrder S; S.init(M, DM, F.G, (int)blockIdx.x);
            LAS float* ratL = (LAS float*)(F.lds + 132096); LAS float* rbL = (LAS float*)(F.lds + 134144);
            pg8::Unit u0, u1; const bool h0 = S.next(0, u0), h1 = S.next(1, u1);
            {   int t2 = F.tid; asm volatile("" : "+v"(t2));
                for (int sl = 0; sl < 2; ++sl) { const bool on = sl == 0 ? h0 : (h1 && u1.pm != u0.pm); const int pmx = sl == 0 ? u0.pm : u1.pm;
                    if (on && t2 < 256) { const size_t row = (size_t)pmx * 256 + t2; float sa = 0.f, sb = 0.f;
                        const float* pa = (const float*)(F.ws + WS_PSA) + row * 8; const float* pb_ = (const float*)(F.ws + WS_PSB) + row * 16;
#pragma unroll
                        for (int i = 0; i < 2; ++i) { const f32x4 v = *(const f32x4*)(pa + 4 * i); sa += (v[0] + v[1]) + (v[2] + v[3]); }
#pragma unroll
                        for (int i = 0; i < 4; ++i) { const f32x4 v = *(const f32x4*)(pb_ + 4 * i); sb += (v[0] + v[1]) + (v[2] + v[3]); }
                        const float ra = 1.0f / sqrtf(sa * (1.0f / 1024.0f) + EPS), rb = 1.0f / sqrtf(sb * (1.0f / 1024.0f) + EPS);
                        ratL[sl * 256 + t2] = ra / rb; rbL[sl * 256 + t2] = rb; } } }
            __syncthreads();
            const int pm0 = h0 ? u0.pm : -1;
            if (l == 0) { EpiOut<false> E{(const void*)F.in[I_X], (bf16*)(F.ws + WS_X), ml + 2 * 2048, (float*)(F.ws + WS_PS), ratL, rbL, pm0}; EpiOut<false> Ed{(const void*)F.in[I_X], (bf16*)(F.ws + WS_DBG), ml + 2 * 2048, (float*)(F.ws + WS_DBG + 128 * MiB), ratL, rbL, pm0};
#define GEMM_OUT0(EE) pg8::gemm_phase<EpiOut<false>, pg8::StaticOrder, true, true>(F.lds, g, S, EE)
                RUN2(8, GEMM_OUT0(Ed), GEMM_OUT0(E)); }
            else { EpiOut<true> E{(const void*)(F.ws + WS_X), (bf16*)(F.ws + WS_X), ml + 2 * 2048, (float*)(F.ws + WS_PS), ratL, rbL, pm0}; EpiOut<true> Ed{(const void*)(F.ws + WS_X), (bf16*)(F.ws + WS_DBG), ml + 2 * 2048, (float*)(F.ws + WS_DBG + 128 * MiB), ratL, rbL, pm0};
#define GEMM_OUT1(EE) pg8::gemm_phase<EpiOut<true>, pg8::StaticOrder, true, true>(F.lds, g, S, EE)
                RUN2(8, GEMM_OUT1(Ed), GEMM_OUT1(E)); }
        }
        SEAM(pb + 8);
        if (IN(pb + 9)) {
            pg8::Gemm g{(const bf16*)(F.ws + WS_X), (const bf16*)(F.ws + WS_WQ) + (size_t)l * DM * DM, M, DM, DM}; pg8::StaticOrder S; S.init(M, DM, F.G, (int)blockIdx.x);
            LAS float* rrL = (LAS float*)(F.lds + 132096);
            pg8::Unit u0, u1; const bool h0 = S.next(0, u0), h1 = S.next(1, u1);
            { int t2 = F.tid; asm volatile("" : "+v"(t2)); if (h0) fill_rr(F, rrL, 0, u0.pm, t2); if (h1 && u1.pm != u0.pm) fill_rr(F, rrL, 1, u1.pm, t2); }
            __syncthreads();
            EpiQ E{(bf16*)(F.ws + WS_Z), (const float*)(F.ws + WS_C0) + l * DM, rrL, h0 ? u0.pm : -1};
#define GEMM_Q pg8::gemm_phase<EpiQ, pg8::StaticOrder, true, true>(F.lds, g, S, E)
            RUN2(10, GEMM_Q, GEMM_Q);
        } SEAM(pb + 9);
        if (IN(pb + 10)) { RUN2(11, phase_topk(F, l), phase_topk(F, l)); } SEAM(pb + 10);
        if (IN(pb + 11)) { RUN2(12, phase_gather(F, l, true), phase_gather(F, l, false)); } SEAM(pb + 11);
    }
#undef IN
#undef SEAM
}

extern "C" void kernel_launch(void* const* d_in, const int* in_sizes, int n_in, void* d_out, int out_size, void* d_ws, size_t ws_size, hipStream_t stream) {
    static int grid = 0;
    if (grid == 0) {
        if (n_in != 29 || out_size != M * DM || ws_size < WS_END) { fprintf(stderr, "kernel_launch: unexpected shapes (n_in %d, out %d, ws %zu); nothing launched\n", n_in, out_size, ws_size); grid = -1; return; }
        int dev = 0, cus = 0;
        if (hipGetDevice(&dev) != hipSuccess || hipDeviceGetAttribute(&cus, hipDeviceAttributeMultiprocessorCount, dev) != hipSuccess) { grid = -1; return; }
        if (hipFuncSetAttribute((const void*)fwd_kernel, hipFuncAttributeMaxDynamicSharedMemorySize, LDS_BYTES) != hipSuccess) { fprintf(stderr, "kernel_launch: hipFuncSetAttribute failed\n"); grid = -1; return; }
        (void)hipGetLastError();
        grid = cus;
    }
    if (grid < 0) return;
    (void)hipMemsetAsync((char*)d_ws + WS_CTL, 0, CTL_ZERO_BYTES, stream);
    Args a{};
    for (int i = 0; i < 29; ++i) a.in[i] = (const float*)d_in[i];
    a.out = (float*)d_out; a.ws = (unsigned char*)d_ws;
#if MK_PER_PHASE
    for (int p = 0; p < 1 + 12 * DEPTH; ++p) {
        if (p == 13) continue;
        a.ph_lo = p; a.ph_hi = p + 1; a.li = p;
        hipLaunchKernelGGL(fwd_kernel, dim3(grid), dim3(NTHR), LDS_BYTES, stream, a);
    }
#else
    a.ph_lo = 0; a.ph_hi = 1 + 12 * DEPTH; a.li = 0;
    hipLaunchKernelGGL(fwd_kernel, dim3(grid), dim3(NTHR), LDS_BYTES, stream, a);
#endif
}
```

```cpp
#include <hip/hip_runtime.h>
#include <cstdio>
#include <cstdint>

#ifndef SELFTEST_S5
#define SELFTEST_S5 0
#endif
#ifndef REPEAT_PH
#define REPEAT_PH -1
#endif
#ifndef GATHER_PROBE_MEM
#define GATHER_PROBE_MEM 0
#endif
#ifndef GATHER_PROBE_HOT
#define GATHER_PROBE_HOT 0
#endif
#ifndef MK_PER_PHASE
#define MK_PER_PHASE 0
#endif

#define GAS __attribute__((address_space(1)))
#define LAS __attribute__((address_space(3)))
typedef unsigned short bf16;
typedef short bf16x8 __attribute__((ext_vector_type(8)));
typedef float f32x4 __attribute__((ext_vector_type(4)));
typedef float f32x2 __attribute__((ext_vector_type(2)));
typedef unsigned u32x4 __attribute__((ext_vector_type(4)));
typedef unsigned u32x2 __attribute__((ext_vector_type(2)));

constexpr int DM = 2048, SEQ = 16384, DEPTH = 2, M = SEQ;
constexpr int WA = 1024, WB = 1024, INW = 3072;
constexpr int NG = 64, NCH = 256;
constexpr int NEXP = 16384;
constexpr float EPS = 1e-6f;
constexpr int NWAVES = 8, NTHR = 512;

namespace pg8 {
#define PG8_LAS __attribute__((address_space(3)))
constexpr int BM = 256, BK = 64, HALF = 128, HTB = HALF * BK * 2, STAGE_BYTES = 8 * HTB, NXCD = 8, WGM = 4;
__host__ __device__ __forceinline__ int lds_byte(int r, int c) { const int st = (r >> 4) * 2 + (c >> 5), rr = r & 15, cc = c & 31, ob = rr * 64 + cc * 2; return st * 1024 + (ob ^ (((ob >> 9) & 1) << 5)); }
__host__ __device__ __forceinline__ void stage_rc(int b, int& R, int& C) { const int st = b / 1024, sb = b % 1024, swz = sb ^ (((sb >> 9) & 1) << 5); R = (st >> 1) * 16 + swz / 64; C = (st & 1) * 32 + (swz % 64) / 2; }
__host__ __device__ __forceinline__ int perm32(int rho) { const int n = rho >> 4, i = rho & 15; return 8 * (i >> 2) + 4 * n + (i & 3); }
struct Unit { int pm, pn; };
struct Gemm { const bf16* A; const bf16* Bt; int M, N, K; };
struct StaticOrder {
    int nM, nN, nwg, G, c;
    __host__ __device__ void init(int M_, int N_, int G_, int c_) { nM = M_ / BM; nN = N_ / BM; nwg = nM * nN; G = G_; c = c_; }
    __host__ __device__ bool next(int i, Unit& u) const {
        const long L = (long)i * G + c; if (L >= nwg) return false;
        int wgid = (int)L; { const int q = nwg / NXCD, r = nwg % NXCD, xcd = wgid % NXCD, off = wgid / NXCD; wgid = (xcd < r ? xcd * (q + 1) : r * (q + 1) + (xcd - r) * q) + off; }
        const int nig = WGM * nN, gid = wgid / nig, fm = gid * WGM, gsz = (nM - fm) < WGM ? (nM - fm) : WGM;
        u.pm = fm + ((wgid % nig) % gsz); u.pn = (wgid % nig) / gsz; return true;
    }
    __device__ __forceinline__ void a_ready(const Unit&) const {}
    __device__ __forceinline__ void done(const Unit&) const {}
};
__device__ __forceinline__ unsigned cvt_pk_bf16(float lo, float hi) { unsigned r; asm volatile("v_cvt_pk_bf16_f32 %0, %1, %2" : "=v"(r) : "v"(lo), "v"(hi)); return r; }

template <class Epi, class Sched, bool ALIGN_EPI = false, bool SP2 = false>
__device__ __forceinline__ void gemm_phase(PG8_LAS unsigned char* lds, const Gemm g, const Sched& S, const Epi& E) {
    int tid = threadIdx.x; asm volatile("" : "+v"(tid)); const int wid = __builtin_amdgcn_readfirstlane(tid >> 6), lane = tid & 63, wr = wid >> 2, wc = wid & 3, fr = lane & 15, fq = lane >> 4;
    const int K = g.K, nt = K / BK;
    unsigned voffA[2], voffB[2];
#pragma unroll
    for (int i = 0; i < 2; ++i) { int R, C; stage_rc(tid * 16 + i * 8192, R, C); const int Rb = Epi::PERM ? ((R & ~31) + perm32(R & 31)) : R;
        voffA[i] = (unsigned)(R * K + C) * 2u; voffB[i] = (unsigned)(Rb * K + C) * 2u; }
    const size_t kstep = (size_t)(BK * 2);
    const size_t hstep = (size_t)HALF * K * 2;
    const size_t tstep = 2 * hstep;
    const unsigned ldsw = (unsigned)wid * 1024u;
    const int aoff = lds_byte(wr * 64 + fr, fq * 8), boff = lds_byte(wc * 32 + fr, fq * 8);
#define PG8_SA(b, h) (((b) * 2 + (h)) * HTB)
#define PG8_SB(b, h) ((4 + (b) * 2 + (h)) * HTB)
#define PG8_STAGE(bufoff, gbase, voff) do { _Pragma("unroll") for (int _i = 0; _i < 2; ++_i) \
        __builtin_amdgcn_global_load_lds((const unsigned*)((const char*)(gbase) + (voff)[_i]), (PG8_LAS unsigned*)(lds + (bufoff) + ldsw + _i * 8192), 16, 0, 0); } while (0)
#define PG8_LDA(dst, b, h) do { _Pragma("unroll") for (int m = 0; m < 4; ++m) _Pragma("unroll") for (int k = 0; k < 2; ++k) dst[m][k] = *(const PG8_LAS bf16x8*)(lds + PG8_SA(b, h) + aoff + m * 2048 + k * 1024); } while (0)
#define PG8_LDB(dst, b, h) do { _Pragma("unroll") for (int n = 0; n < 2; ++n) _Pragma("unroll") for (int k = 0; k < 2; ++k) dst[n][k] = *(const PG8_LAS bf16x8*)(lds + PG8_SB(b, h) + boff + n * 2048 + k * 1024); } while (0)
#define PG8_MMA(ai, bj, At, Bt) do { __builtin_amdgcn_s_setprio(1); _Pragma("unroll") for (int m = 0; m < 4; ++m) _Pragma("unroll") for (int n = 0; n < 2; ++n) _Pragma("unroll") for (int k = 0; k < 2; ++k) \
        acc[ai][bj][m][n] = __builtin_amdgcn_mfma_f32_16x16x32_bf16(Bt[n][k], At[m][k], acc[ai][bj][m][n], 0, 0, 0); __builtin_amdgcn_s_setprio(0); } while (0)
#define PG8_WAIT_V(n) asm volatile("s_waitcnt vmcnt(" #n ")" ::: "memory")
#define PG8_WAIT_L(n) asm volatile("s_waitcnt lgkmcnt(" #n ")" ::: "memory")
#define PG8_BAR __builtin_amdgcn_s_barrier()
#define PG8_SCHED __builtin_amdgcn_sched_barrier(0)
    Unit cur, nxt; int ui = 0;
    if (!S.next(0, cur)) return;
    f32x4 acc[2][2][4][2];
#pragma unroll
    for (int a = 0; a < 2; ++a)
#pragma unroll
        for (int b = 0; b < 2; ++b)
#pragma unroll
            for (int m = 0; m < 4; ++m)
#pragma unroll
                for (int n = 0; n < 2; ++n) acc[a][b][m][n] = (f32x4){0.f, 0.f, 0.f, 0.f};
    bf16x8 At[4][2], B0[2][2], B1[2][2];
    const char* cA = (const char*)g.A + (size_t)cur.pm * tstep; const char* cB = (const char*)g.Bt + (size_t)cur.pn * tstep;
    S.a_ready(cur);
    if constexpr (SP2) {
        PG8_STAGE(PG8_SB(0, 0), cB, voffB); PG8_STAGE(PG8_SB(0, 1), cB + hstep, voffB); PG8_STAGE(PG8_SA(0, 0), cA, voffA); PG8_STAGE(PG8_SA(0, 1), cA + hstep, voffA);
        if (wr == 1) PG8_BAR;
        PG8_WAIT_V(2); PG8_BAR;
        PG8_STAGE(PG8_SB(1, 0), cB + kstep, voffB); PG8_STAGE(PG8_SA(1, 0), cA + kstep, voffA); PG8_STAGE(PG8_SB(1, 1), cB + hstep + kstep, voffB);
        PG8_WAIT_V(6); PG8_BAR;
    } else {
        PG8_STAGE(PG8_SB(0, 0), cB, voffB); PG8_STAGE(PG8_SA(0, 0), cA, voffA); PG8_STAGE(PG8_SB(0, 1), cB + hstep, voffB); PG8_STAGE(PG8_SA(0, 1), cA + hstep, voffA);
        if (wr == 1) PG8_BAR;
        PG8_WAIT_V(4); PG8_BAR;
        PG8_STAGE(PG8_SB(1, 0), cB + kstep, voffB); PG8_STAGE(PG8_SA(1, 0), cA + kstep, voffA); PG8_STAGE(PG8_SB(1, 1), cB + hstep + kstep, voffB);
        PG8_WAIT_V(6); PG8_BAR;
    }
    for (;;) {
        const bool has_next = S.next(ui + 1, nxt);
        const char* nA = has_next ? (const char*)g.A + (size_t)nxt.pm * tstep : cA; const char* nB = has_next ? (const char*)g.Bt + (size_t)nxt.pn * tstep : cB;
        for (int t = 0; t < nt; t += 2) {
            const bool last = (t == nt - 2);
            const char* a1 = cA + (size_t)(t + 1) * kstep;
            const char* a2 = last ? nA : cA + (size_t)(t + 2) * kstep; const char* b2 = last ? nB : cB + (size_t)(t + 2) * kstep;
            const char* a3 = a2 + kstep; const char* b3 = b2 + kstep;
            if (last && has_next) S.a_ready(nxt);
            if constexpr (Epi::KSPLIT) { if (t == nt / 2) E.midscale(acc, cur, wr, fr); }
            if constexpr (SP2) {
            PG8_LDB(B0, 0, 0); PG8_LDB(B1, 0, 1); PG8_SCHED; PG8_LDA(At, 0, 0); PG8_STAGE(PG8_SA(1, 1), a1 + hstep, voffA);
            PG8_WAIT_V(8); PG8_WAIT_L(0); PG8_BAR; PG8_MMA(0, 0, At, B0); PG8_MMA(0, 1, At, B1); PG8_BAR; PG8_SCHED;
            PG8_LDA(At, 0, 1); PG8_STAGE(PG8_SB(0, 0), b2, voffB); PG8_STAGE(PG8_SB(0, 1), b2 + hstep, voffB); PG8_STAGE(PG8_SA(0, 0), a2, voffA);
            PG8_WAIT_V(8); PG8_WAIT_L(0); PG8_BAR; PG8_MMA(1, 0, At, B0); PG8_MMA(1, 1, At, B1); PG8_BAR; PG8_SCHED;
            PG8_LDB(B0, 1, 0); PG8_LDB(B1, 1, 1); PG8_SCHED; PG8_LDA(At, 1, 0); PG8_STAGE(PG8_SA(0, 1), a2 + hstep, voffA);
            PG8_WAIT_V(8); PG8_WAIT_L(0); PG8_BAR; PG8_MMA(0, 0, At, B0); PG8_MMA(0, 1, At, B1); PG8_BAR; PG8_SCHED;
            PG8_LDA(At, 1, 1); PG8_STAGE(PG8_SB(1, 0), b3, voffB); PG8_STAGE(PG8_SB(1, 1), b3 + hstep, voffB); PG8_STAGE(PG8_SA(1, 0), a3, voffA);
            PG8_WAIT_V(8); PG8_WAIT_L(0); PG8_BAR; PG8_MMA(1, 0, At, B0); PG8_MMA(1, 1, At, B1); PG8_BAR; PG8_SCHED;
            } else {
            PG8_LDB(B0, 0, 0); PG8_SCHED; PG8_LDA(At, 0, 0); PG8_STAGE(PG8_SA(1, 1), a1 + hstep, voffA);
            PG8_WAIT_L(8); PG8_BAR; PG8_WAIT_L(0); PG8_MMA(0, 0, At, B0); PG8_BAR; PG8_SCHED;
            PG8_LDB(B1, 0, 1); PG8_STAGE(PG8_SB(0, 0), b2, voffB);
            PG8_BAR; PG8_WAIT_L(0); PG8_MMA(0, 1, At, B1); PG8_BAR;
            PG8_LDA(At, 0, 1); PG8_STAGE(PG8_SA(0, 0), a2, voffA);
            PG8_BAR; PG8_WAIT_L(0); PG8_MMA(1, 0, At, B0); PG8_BAR; PG8_SCHED;
            PG8_STAGE(PG8_SB(0, 1), b2 + hstep, voffB);
            PG8_WAIT_V(6); PG8_BAR; PG8_MMA(1, 1, At, B1); PG8_BAR;
            PG8_LDB(B0, 1, 0); PG8_SCHED; PG8_LDA(At, 1, 0); PG8_STAGE(PG8_SA(0, 1), a2 + hstep, voffA);
            PG8_WAIT_L(8); PG8_BAR; PG8_WAIT_L(0); PG8_MMA(0, 0, At, B0); PG8_BAR; PG8_SCHED;
            PG8_LDB(B1, 1, 1); PG8_STAGE(PG8_SB(1, 0), b3, voffB);
            PG8_BAR; PG8_WAIT_L(0); PG8_MMA(0, 1, At, B1); PG8_BAR;
            PG8_LDA(At, 1, 1); PG8_STAGE(PG8_SA(1, 0), a3, voffA);
            PG8_BAR; PG8_WAIT_L(0); PG8_MMA(1, 0, At, B0); PG8_BAR; PG8_SCHED;
            PG8_STAGE(PG8_SB(1, 1), b3 + hstep, voffB);
            PG8_WAIT_V(6); PG8_BAR; PG8_MMA(1, 1, At, B1); PG8_BAR;
            }
        }
        if constexpr (ALIGN_EPI) { if (wr == 0) PG8_BAR; }
        E(acc, cur, wr, wc, fr, fq); S.done(cur);
        if (!has_next) break;
#pragma unroll
        for (int a = 0; a < 2; ++a)
#pragma unroll
            for (int b = 0; b < 2; ++b)
#pragma unroll
                for (int m = 0; m < 4; ++m)
#pragma unroll
                    for (int n = 0; n < 2; ++n) acc[a][b][m][n] = (f32x4){0.f, 0.f, 0.f, 0.f};
        cur = nxt; cA = nA; cB = nB; ++ui;
        if constexpr (ALIGN_EPI) { if (wr == 1) PG8_BAR; }
    }
    PG8_WAIT_V(0);
    if constexpr (!ALIGN_EPI) { if (wr == 0) PG8_BAR; }
    PG8_BAR;
#undef PG8_SA
#undef PG8_SB
#undef PG8_STAGE
#undef PG8_LDA
#undef PG8_LDB
#undef PG8_MMA
#undef PG8_WAIT_V
#undef PG8_WAIT_L
#undef PG8_BAR
#undef PG8_SCHED
}
}

__device__ __forceinline__ unsigned f2bf(float f) { unsigned u = __builtin_bit_cast(unsigned, f); return (u + 0x7fffu + ((u >> 16) & 1u)) >> 16; }
__device__ __forceinline__ unsigned pk2(float lo, float hi) { return f2bf(lo) | (f2bf(hi) << 16); }
__device__ __forceinline__ float bflo(unsigned w) { return __builtin_bit_cast(float, w << 16); }
__device__ __forceinline__ float bfhi(unsigned w) { return __builtin_bit_cast(float, w & 0xffff0000u); }
__device__ __forceinline__ float fast_sigmoid(float t) { return __builtin_amdgcn_rcpf(1.0f + __builtin_amdgcn_exp2f(-1.44269504089f * t)); }
__device__ __forceinline__ float gelu_tanh(float x) { const float t = x * (1.5957691216f + 0.0713548163f * x * x); return x * fast_sigmoid(t); }
__device__ __forceinline__ float wave_sum(float v) {
#pragma unroll
    for (int o = 1; o < 64; o <<= 1) v += __shfl_xor(v, o);
    return v;
}
#define LDS_WAIT() asm volatile("s_waitcnt lgkmcnt(0)" ::: "memory")
#define VM_WAIT() asm volatile("s_waitcnt vmcnt(0)" ::: "memory")
#define RLX_AGENT __ATOMIC_RELAXED, __HIP_MEMORY_SCOPE_AGENT

constexpr size_t MiB = 1u << 20;
constexpr size_t WS_CTL = 0, CTL_ZERO_BYTES = 1 * MiB;
constexpr size_t WS_MOD   = 512 * 1024;
constexpr size_t WS_AT    = 1 * MiB + 128 * 1024;
constexpr size_t WS_STATS = WS_AT + 128 * 1024;
constexpr size_t WS_SCL   = 1 * MiB + 512 * 1024;
constexpr size_t WS_GS    = 1 * MiB + 768 * 1024;
constexpr size_t WS_C0    = WS_GS + 16 * 1024;
constexpr size_t WS_KEYS  = 2 * MiB;
constexpr size_t WS_GWS   = 3 * MiB;
constexpr size_t WS_WIN   = 4 * MiB;
constexpr size_t WS_GLU   = 28 * MiB;
constexpr size_t WS_WOUT  = 32 * MiB;
constexpr size_t WS_WQ    = 48 * MiB;
constexpr size_t WS_KTAB  = 64 * MiB;
constexpr size_t WS_WG    = 72 * MiB;
constexpr size_t WS_VG    = 104 * MiB;
constexpr size_t WS_UV    = 136 * MiB;
constexpr size_t WS_X     = 392 * MiB;
constexpr size_t WS_H     = 520 * MiB;
constexpr size_t WS_Z     = 584 * MiB;
constexpr size_t WS_XS    = 648 * MiB;
constexpr size_t WS_SLOC  = 680 * MiB;
constexpr size_t WS_PS    = 688 * MiB;
constexpr size_t WS_PSA   = 690 * MiB;
constexpr size_t WS_PSB   = 691 * MiB;
constexpr size_t WS_PLN   = 692 * MiB;
constexpr size_t WS_HS    = 694 * MiB;
constexpr size_t WS_G     = 696 * MiB;
constexpr size_t WS_MIX   = 728 * MiB;
constexpr size_t WS_EID   = 792 * MiB;
constexpr size_t WS_GATE  = 800 * MiB;
constexpr size_t WS_SU    = 808 * MiB;
constexpr size_t WS_COEF  = 816 * MiB;
constexpr size_t WS_END   = 824 * MiB;
constexpr size_t WS_DBG   = 824 * MiB;
constexpr int CW_BAR = 4096;
constexpr int CW_FLAG = 2048;
constexpr int CW_QUEUE = 16384;

constexpr int LDS_BYTES = 163840;
constexpr int MISC_OFF = LDS_BYTES - 256;

#define XB_TMO      128
#define XB_XCNT(j)  (256  + 64 * (j))
#define XB_XSUB(j)  (1280 + 64 * (j))
#define XB_XGEN(j)  (2304 + 64 * (j))
#define XB_TOP      3328
#define XB_TOPGEN   3392
#define XCD_BAR_WORDS 3456
#define XB_SPIN_CAP (1u << 24)
__device__ __forceinline__ unsigned xb_ld(unsigned* p)              { return __hip_atomic_load(p, __ATOMIC_RELAXED, __HIP_MEMORY_SCOPE_AGENT); }
__device__ __forceinline__ unsigned xb_add(unsigned* p, unsigned v) { return __hip_atomic_fetch_add(p, v, __ATOMIC_RELAXED, __HIP_MEMORY_SCOPE_AGENT); }
__device__ __forceinline__ unsigned xb_xcc_id() { return (unsigned)__builtin_amdgcn_s_getreg((3 << 11) | 20) & 0xFu; }
#define XB_SPIN(cond, bar) do { unsigned _sp = 0; while (cond) { __builtin_amdgcn_s_sleep(1); \
    if ((++_sp & 255u) == 0u) { if (xb_ld(&(bar)[XB_TMO])) break; if (_sp > XB_SPIN_CAP) { atomicAdd(&(bar)[XB_TMO], 1u); break; } } } } while (0)
struct XcdBarrier { unsigned* bar; unsigned x; volatile LAS unsigned* st; };
__device__ __forceinline__ XcdBarrier xcd_barrier_post(unsigned* bar, volatile LAS unsigned* st) {
    XcdBarrier b; b.bar = bar; b.x = xb_xcc_id(); b.st = st;
    if (threadIdx.x == 0) (void)xb_add(&bar[XB_XCNT(b.x)], 1u);
    return b;
}
__device__ __forceinline__ void xcd_barrier_complete(unsigned* bar, unsigned x, unsigned& nloc, unsigned& nx) {
    const unsigned G = gridDim.x * gridDim.y * gridDim.z;
    unsigned sum, cnt, mine, sp = 0u;
    for (;;) {
        sum = 0u; cnt = 0u; mine = 0u;
#pragma unroll
        for (unsigned j = 0; j < 16; ++j) { const unsigned c = xb_ld(&bar[XB_XCNT(j)]); sum += c; cnt += (c > 0u) ? 1u : 0u; mine = (j == x) ? c : mine; }
        if (sum == G) break;
        __builtin_amdgcn_s_sleep(1);
        if ((++sp & 255u) == 0u) { if (xb_ld(&bar[XB_TMO])) break; if (sp > XB_SPIN_CAP) { atomicAdd(&bar[XB_TMO], 1u); break; } }
    }
    nloc = mine > 0u ? mine : 1u; nx = cnt > 0u ? cnt : 1u;
}
__device__ __forceinline__ void xcd_barrier(const XcdBarrier& b) {
    asm volatile("s_waitcnt vmcnt(0)" ::: "memory");
    __syncthreads();
    if (threadIdx.x == 0) {
        unsigned* bar = b.bar;
        __builtin_amdgcn_s_waitcnt(0);
        unsigned nloc = b.st[0], nx = b.st[1];
        if (nloc == 0u) { xcd_barrier_complete(bar, b.x, nloc, nx); b.st[0] = nloc; b.st[1] = nx; }
        const unsigned old = xb_add(&bar[XB_XSUB(b.x)], 1u);
        const unsigned gen = old / nloc;
        if (old + 1u == (gen + 1u) * nloc) {
            __builtin_amdgcn_fence(__ATOMIC_RELEASE, "agent");
            asm volatile("s_waitcnt vmcnt(0)" ::: "memory");
            const unsigned og = xb_add(&bar[XB_TOP], 1u);
            const unsigned tg = og / nx;
            if (og + 1u == (tg + 1u) * nx) xb_add(&bar[XB_TOPGEN], 1u);
            else XB_SPIN(xb_ld(&bar[XB_TOPGEN]) == tg, bar);
            __builtin_amdgcn_fence(__ATOMIC_ACQUIRE, "agent");
            xb_add(&bar[XB_XGEN(b.x)], 1u);
            asm volatile("s_waitcnt vmcnt(0)" ::: "memory");
        } else {
            XB_SPIN(xb_ld(&bar[XB_XGEN(b.x)]) == gen, bar);
            __builtin_amdgcn_fence(__ATOMIC_ACQUIRE, "agent");
            asm volatile("s_waitcnt vmcnt(0)" ::: "memory");
        }
    }
    __syncthreads();
}

struct Args { const float* in[29]; float* out; unsigned char* ws; int ph_lo, ph_hi, li, pad; };
enum { I_X = 0, I_C, I_WMOD, I_BMOD, I_N1G, I_WIN, I_BIN, I_LNG, I_LNB, I_GWS, I_GBS, I_LRE, I_LIM, I_LDT, I_BRE, I_BIM, I_CRE, I_CIM, I_SD, I_GLUW, I_GLUB,
       I_BRG, I_WOUT, I_N2G, I_WQ, I_KEYS, I_PU, I_PV, I_FG };

struct Frame {
    LAS unsigned char* lds;
    unsigned char* ws;
    const float* const* in;
    float* out;
    int tid, lane, wave, vcu, G;
};

#define PH_LOCALS int tid = F.tid; asm volatile("" : "+v"(tid)); const int lane = tid & 63; const int wave = __builtin_amdgcn_readfirstlane(tid >> 6); (void)lane; (void)wave;

struct EpiIn {
    static constexpr bool PERM = true, AFTER_DRAIN = false, KSPLIT = false;
    bf16* Z; bf16* XS; const float* bias; float* PLN;
    __device__ __forceinline__ void operator()(const f32x4 (&acc)[2][2][4][2], const pg8::Unit& u, int wr, int wc, int fr, int fq) const {
        const int row0 = u.pm * 256 + wr * 64 + fr, col0 = u.pn * 256 + wc * 32 + 8 * fq;
        const bool isv = (u.pn >= 4 && u.pn < 8);
        f32x4 bv[2][2];
#pragma unroll
        for (int bj = 0; bj < 2; ++bj)
#pragma unroll
            for (int n = 0; n < 2; ++n) bv[bj][n] = *(const f32x4*)(bias + col0 + bj * 128 + 4 * n);
        const bool isz = (u.pn < 8);
#pragma unroll
        for (int ai = 0; ai < 2; ++ai)
#pragma unroll
            for (int m = 0; m < 4; ++m) {
                const int r = row0 + ai * 128 + m * 16; float s1 = 0.f, s2 = 0.f;
#pragma unroll
                for (int bj = 0; bj < 2; ++bj) {
                    f32x4 v0 = acc[ai][bj][m][0] + bv[bj][0], v1 = acc[ai][bj][m][1] + bv[bj][1];
                    const int c = col0 + bj * 128;
                    u32x4 w;
                    if (isz) {
                        const float g0 = gelu_tanh(v0[0]), g1 = gelu_tanh(v0[1]), g2 = gelu_tanh(v0[2]), g3 = gelu_tanh(v0[3]), g4 = gelu_tanh(v1[0]), g5 = gelu_tanh(v1[1]), g6 = gelu_tanh(v1[2]), g7 = gelu_tanh(v1[3]);
                        w.x = pg8::cvt_pk_bf16(g0, g1); w.y = pg8::cvt_pk_bf16(g2, g3); w.z = pg8::cvt_pk_bf16(g4, g5); w.w = pg8::cvt_pk_bf16(g6, g7);
                        *(u32x4*)(Z + (size_t)r * 2048 + c) = w;
                        s1 += ((g0 + g1) + (g2 + g3)) + ((g4 + g5) + (g6 + g7)); s2 += ((g0 * g0 + g1 * g1) + (g2 * g2 + g3 * g3)) + ((g4 * g4 + g5 * g5) + (g6 * g6 + g7 * g7));
                    } else {
                        w.x = pg8::cvt_pk_bf16(v0[0], v0[1]); w.y = pg8::cvt_pk_bf16(v0[2], v0[3]); w.z = pg8::cvt_pk_bf16(v1[0], v1[1]); w.w = pg8::cvt_pk_bf16(v1[2], v1[3]);
                        const int cc = c - 2048, g = cc >> 4, i = cc & 15;
                        *(u32x4*)(XS + ((size_t)(g * 256 + (r >> 6)) * 64 + (r & 63)) * 16 + i) = w;
                    }
                }
                if (isv) { s1 += __shfl_xor(s1, 16); s1 += __shfl_xor(s1, 32); s2 += __shfl_xor(s2, 16); s2 += __shfl_xor(s2, 32);
                    if (fq == 0) *(f32x2*)(PLN + ((size_t)r * 16 + (u.pn - 4) * 4 + wc) * 2) = (f32x2){s1, s2}; }
            }
    }
};
struct EpiGlu {
    static constexpr bool PERM = true, AFTER_DRAIN = false, KSPLIT = false;
    const bf16* Gb; bf16* MIX; const float* bias; float* PSB;
    __device__ __forceinline__ void operator()(const f32x4 (&acc)[2][2][4][2], const pg8::Unit& u, int wr, int wc, int fr, int fq) const {
        const int row0 = u.pm * 256 + wr * 64 + fr, col0 = u.pn * 256 + wc * 32 + 8 * fq;
        f32x4 bv[2][2];
#pragma unroll
        for (int bj = 0; bj < 2; ++bj)
#pragma unroll
            for (int n = 0; n < 2; ++n) bv[bj][n] = *(const f32x4*)(bias + col0 + bj * 128 + 4 * n);
#pragma unroll
        for (int ai = 0; ai < 2; ++ai)
#pragma unroll
            for (int m = 0; m < 4; ++m) {
                const int r = row0 + ai * 128 + m * 16; float ssq = 0.f;
#pragma unroll
                for (int bj = 0; bj < 2; ++bj) {
                    const f32x4 v0 = acc[ai][bj][m][0] + bv[bj][0], v1 = acc[ai][bj][m][1] + bv[bj][1];
                    const int c = col0 + bj * 128;
                    const u32x4 gw = *(const u32x4*)(Gb + (size_t)r * 1024 + c);
                    const float o0 = bflo(gw.x) * fast_sigmoid(v0[0]), o1 = bfhi(gw.x) * fast_sigmoid(v0[1]), o2 = bflo(gw.y) * fast_sigmoid(v0[2]), o3 = bfhi(gw.y) * fast_sigmoid(v0[3]);
                    const float o4 = bflo(gw.z) * fast_sigmoid(v1[0]), o5 = bfhi(gw.z) * fast_sigmoid(v1[1]), o6 = bflo(gw.w) * fast_sigmoid(v1[2]), o7 = bfhi(gw.w) * fast_sigmoid(v1[3]);
                    u32x4 w; w.x = pg8::cvt_pk_bf16(o0, o1); w.y = pg8::cvt_pk_bf16(o2, o3); w.z = pg8::cvt_pk_bf16(o4, o5); w.w = pg8::cvt_pk_bf16(o6, o7);
                    *(u32x4*)(MIX + (size_t)r * 2048 + 1024 + c) = w;
                    ssq += (o0 * o0 + o1 * o1) + (o2 * o2 + o3 * o3) + (o4 * o4 + o5 * o5) + (o6 * o6 + o7 * o7);
                }
                ssq += __shfl_xor(ssq, 16); ssq += __shfl_xor(ssq, 32);
                if (fq == 0) PSB[(size_t)r * 16 + u.pn * 4 + wc] = ssq;
            }
    }
};
template <bool XIN_BF16> struct EpiOut {
    static constexpr bool PERM = true, AFTER_DRAIN = false, KSPLIT = true;
    const void* xin; bf16* X; const float* gate; float* PS; const LAS float* ratL; const LAS float* rbL; int pm0;
    __device__ __forceinline__ void midscale(f32x4 (&acc)[2][2][4][2], const pg8::Unit& u, int wr, int fr) const {
        const LAS float* rp = ratL + (u.pm == pm0 ? 0 : 256) + wr * 64 + fr;
#pragma unroll
        for (int ai = 0; ai < 2; ++ai)
#pragma unroll
            for (int m = 0; m < 4; ++m) { const float rt = rp[ai * 128 + m * 16];
#pragma unroll
                for (int bj = 0; bj < 2; ++bj)
#pragma unroll
                    for (int n = 0; n < 2; ++n) acc[ai][bj][m][n] = acc[ai][bj][m][n] * rt; }
    }
    __device__ __forceinline__ void operator()(const f32x4 (&acc)[2][2][4][2], const pg8::Unit& u, int wr, int wc, int fr, int fq) const {
        const int row0 = u.pm * 256 + wr * 64 + fr, col0 = u.pn * 256 + wc * 32 + 8 * fq;
        const LAS float* rbp = rbL + (u.pm == pm0 ? 0 : 256) + wr * 64 + fr;
        f32x4 gv[2][2];
#pragma unroll
        for (int bj = 0; bj < 2; ++bj)
#pragma unroll
            for (int n = 0; n < 2; ++n) gv[bj][n] = *(const f32x4*)(gate + col0 + bj * 128 + 4 * n);
#pragma unroll
        for (int ai = 0; ai < 2; ++ai)
#pragma unroll
            for (int m = 0; m < 4; ++m) {
                const int r = row0 + ai * 128 + m * 16; float ssq = 0.f; const float rb = rbp[ai * 128 + m * 16];
#pragma unroll
                for (int bj = 0; bj < 2; ++bj) {
                    const size_t off = (size_t)r * 2048 + col0 + bj * 128;
                    f32x4 x0, x1;
                    if (XIN_BF16) { const u32x4 w = *(const u32x4*)((const bf16*)xin + off); x0 = (f32x4){bflo(w.x), bfhi(w.x), bflo(w.y), bfhi(w.y)}; x1 = (f32x4){bflo(w.z), bfhi(w.z), bflo(w.w), bfhi(w.w)}; }
                    else { x0 = *(const f32x4*)((const float*)xin + off); x1 = *(const f32x4*)((const float*)xin + off + 4); }
                    const f32x4 y0 = x0 + gv[bj][0] * (acc[ai][bj][m][0] * rb), y1 = x1 + gv[bj][1] * (acc[ai][bj][m][1] * rb);
                    u32x4 o; o.x = pg8::cvt_pk_bf16(y0[0], y0[1]); o.y = pg8::cvt_pk_bf16(y0[2], y0[3]); o.z = pg8::cvt_pk_bf16(y1[0], y1[1]); o.w = pg8::cvt_pk_bf16(y1[2], y1[3]);
                    *(u32x4*)(X + off) = o;
                    ssq += (y0[0] * y0[0] + y0[1] * y0[1]) + (y0[2] * y0[2] + y0[3] * y0[3]) + (y1[0] * y1[0] + y1[1] * y1[1]) + (y1[2] * y1[2] + y1[3] * y1[3]);
                }
                ssq += __shfl_xor(ssq, 16); ssq += __shfl_xor(ssq, 32);
                if (fq == 0) PS[(size_t)r * 32 + u.pn * 4 + wc] = ssq;
            }
    }
};
struct EpiQ {
    static constexpr bool PERM = true, AFTER_DRAIN = false, KSPLIT = false;
    bf16* Q; const float* c0; const LAS float* rrL; int pm0;
    __device__ __forceinline__ void operator()(const f32x4 (&acc)[2][2][4][2], const pg8::Unit& u, int wr, int wc, int fr, int fq) const {
        const int row0 = u.pm * 256 + wr * 64 + fr, col0 = u.pn * 256 + wc * 32 + 8 * fq;
        const LAS float* rrp = rrL + (u.pm == pm0 ? 0 : 256) + wr * 64 + fr;
        f32x4 cv[2][2];
#pragma unroll
        for (int bj = 0; bj < 2; ++bj)
#pragma unroll
            for (int n = 0; n < 2; ++n) { const float* cp = c0 + col0 + bj * 128 + 4 * n;
                cv[bj][n] = ((*(const f32x4*)cp + *(const f32x4*)(cp + DM)) + *(const f32x4*)(cp + 2 * DM)) + *(const f32x4*)(cp + 3 * DM); }
#pragma unroll
        for (int ai = 0; ai < 2; ++ai)
#pragma unroll
            for (int m = 0; m < 4; ++m) {
                const int r = row0 + ai * 128 + m * 16; const float rr = rrp[ai * 128 + m * 16];
#pragma unroll
                for (int bj = 0; bj < 2; ++bj) {
                    const f32x4 v0 = acc[ai][bj][m][0] * rr + cv[bj][0], v1 = acc[ai][bj][m][1] * rr + cv[bj][1];
                    u32x4 w; w.x = pg8::cvt_pk_bf16(v0[0], v0[1]); w.y = pg8::cvt_pk_bf16(v0[2], v0[3]); w.z = pg8::cvt_pk_bf16(v1[0], v1[1]); w.w = pg8::cvt_pk_bf16(v1[2], v1[3]);
                    *(u32x4*)(Q + (size_t)r * 2048 + col0 + bj * 128) = w;
                }
            }
    }
};
__device__ __forceinline__ void fill_rr(Frame& F, LAS float* rrL, int slot, int pm, int tid) {
    if (tid < 256) { const float* ps = (const float*)(F.ws + WS_PS) + ((size_t)pm * 256 + tid) * 32; float s = 0.f;
#pragma unroll
        for (int i = 0; i < 8; ++i) { const f32x4 v = *(const f32x4*)(ps + 4 * i); s += (v[0] + v[1]) + (v[2] + v[3]); }
        rrL[slot * 256 + tid] = 1.0f / sqrtf(s * (1.0f / DM) + EPS); }
}

__device__ __forceinline__ void p0_transpose_item(const float* W, int K, int N, bf16* WT, const float* kscale, LAS float* scr, int item, int lane, const float* kscale2 = nullptr) {
    const int nblk = N / 32, kb = item / nblk, nb = item % nblk, k0 = 64 * kb, n0 = 32 * nb;
    float wv[32];
#pragma unroll
    for (int i = 0; i < 32; ++i) wv[i] = W[(size_t)(k0 + 2 * i + (lane >> 5)) * N + n0 + (lane & 31)];
#pragma unroll
    for (int i = 0; i < 32; ++i) { const int kk = 2 * i + (lane >> 5); float v = wv[i]; if (kscale) { v *= kscale[k0 + kk]; if (kscale2) v *= 1.0f + kscale2[k0 + kk]; } scr[kk * 33 + (lane & 31)] = v; }
    LDS_WAIT(); asm volatile("" ::: "memory");
    const int c = lane & 7;
#pragma unroll
    for (int j = 0; j < 4; ++j) { const int n = (lane >> 3) + 8 * j; const LAS float* s = scr + (8 * c) * 33 + n;
        u32x4 o; o.x = pk2(s[0 * 33], s[1 * 33]); o.y = pk2(s[2 * 33], s[3 * 33]); o.z = pk2(s[4 * 33], s[5 * 33]); o.w = pk2(s[6 * 33], s[7 * 33]);
        *(u32x4*)(WT + (size_t)(n0 + n) * K + k0 + 8 * c) = o; }
    LDS_WAIT(); asm volatile("" ::: "memory");
}

__device__ __forceinline__ void norm_mod_row(const f32x4 (&v)[4][2], const float* gain, const float* scale, const float* shift, int lane, u32x4 (&o)[4]) {
    float s = 0.f;
#pragma unroll
    for (int j = 0; j < 4; ++j)
#pragma unroll
        for (int h = 0; h < 2; ++h) s += (v[j][h][0] * v[j][h][0] + v[j][h][1] * v[j][h][1]) + (v[j][h][2] * v[j][h][2] + v[j][h][3] * v[j][h][3]);
    const float rr = 1.0f / sqrtf(wave_sum(s) * (1.0f / DM) + EPS);
#pragma unroll
    for (int j = 0; j < 4; ++j) {
        const int c = j * 512 + lane * 8;
        f32x4 y[2];
#pragma unroll
        for (int h = 0; h < 2; ++h) {
            const f32x4 g = *(const f32x4*)(gain + c + 4 * h);
            y[h] = v[j][h] * rr * g;
            const f32x4 sc = *(const f32x4*)(scale + c + 4 * h), sh = *(const f32x4*)(shift + c + 4 * h); y[h] = y[h] * (sc + 1.0f) + sh;
        }
        o[j].x = pk2(y[0][0], y[0][1]); o[j].y = pk2(y[0][2], y[0][3]); o[j].z = pk2(y[1][0], y[1][1]); o[j].w = pk2(y[1][2], y[1][3]);
    }
}
template <bool SRC_BF16>
__device__ __forceinline__ void load_row(const void* xrow_, int lane, f32x4 (&v)[4][2]) {
#pragma unroll
    for (int j = 0; j < 4; ++j) {
        if (SRC_BF16) { const u32x4 w = *(const u32x4*)((const bf16*)xrow_ + j * 512 + lane * 8); v[j][0] = (f32x4){bflo(w.x), bfhi(w.x), bflo(w.y), bfhi(w.y)}; v[j][1] = (f32x4){bflo(w.z), bfhi(w.z), bflo(w.w), bfhi(w.w)}; }
        else { const float* xrow = (const float*)xrow_; v[j][0] = *(const f32x4*)(xrow + j * 512 + lane * 8); v[j][1] = *(const f32x4*)(xrow + j * 512 + lane * 8 + 4); } }
}

__device__ __forceinline__ void p0_gemv_unit(Frame& F, int unit, int tid, float* modout) {
    if (unit >= 192) return;
    const int l = unit / 96, r = unit % 96, cb = r >> 1, kh = r & 1;
    LAS float* sc = (LAS float*)F.lds;
    LAS float* red = (LAS float*)(F.lds + 4096);
    for (int k = tid; k < 1024; k += NTHR) { const float c = F.in[I_C][kh * 1024 + k]; sc[k] = c * fast_sigmoid(c); }
    __syncthreads();
    const int tx = tid & 63, ty = tid >> 6;
    const float* W = F.in[I_WMOD] + ((size_t)l * DM + kh * 1024) * 12288 + cb * 256 + tx * 4;
    f32x4 a = {0.f, 0.f, 0.f, 0.f};
#pragma unroll 16
    for (int k = ty; k < 1024; k += 8) { const f32x4 w = *(const f32x4*)(W + (size_t)k * 12288); a += w * sc[k]; }
    *(LAS f32x4*)(red + ty * 256 + tx * 4) = a;
    __syncthreads();
    if (tid < 256) { float s = 0.f;
#pragma unroll
        for (int y = 0; y < 8; ++y) s += red[y * 256 + tid];
        if (kh == 0) s += F.in[I_BMOD][l * 12288 + cb * 256 + tid];
        atomicAdd(modout + l * 12288 + cb * 256 + tid, s); }
    __syncthreads();
}
__device__ __forceinline__ void p0_s5_unit(Frame& F, int unit, int tid, int parts = 15) {
    const int l = unit >> 7, g = (unit >> 1) & 63, hf = unit & 1;
    LAS float* apr = (LAS float*)F.lds;
    LAS float* api = apr + 4228;
    LAS float* bbr = api + 4228;
    LAS float* bbi = bbr + 1024;
    LAS float* ccr = bbi + 1024;
    LAS float* cci = ccr + 16 * 65;
    const float dt = expf(F.in[I_LDT][l * 64 + g]);
    const float* lre = F.in[I_LRE] + (l * 64 + g) * 64; const float* lim = F.in[I_LIM] + (l * 64 + g) * 64;
    for (int idx = tid; idx < 65 * 64; idx += NTHR) { const int d = idx >> 6, p = idx & 63;
        const float mag = expf(lre[p] * dt * (float)d); float sn, cs; sincosf(lim[p] * dt * (float)d, &sn, &cs);
        apr[d * 65 + p] = mag * cs; api[d * 65 + p] = mag * sn; }
    for (int idx = tid; idx < 1024; idx += NTHR) { const int o = idx >> 6, p = idx & 63;
        ccr[o * 65 + p] = F.in[I_CRE][((size_t)(l * 64 + g) * 16 + o) * 64 + p]; cci[o * 65 + p] = F.in[I_CIM][((size_t)(l * 64 + g) * 16 + o) * 64 + p]; }
    __syncthreads();
    for (int idx = tid; idx < 1024; idx += NTHR) { const int p = idx >> 4, i = idx & 15;
        const float xr = apr[65 + p] - 1.0f, xi = api[65 + p], lr = lre[p], li = lim[p], den = 1.0f / (lr * lr + li * li);
        const float cr = (xr * lr + xi * li) * den, ci = (xi * lr - xr * li) * den;
        const float br = F.in[I_BRE][((size_t)(l * 64 + g) * 64 + p) * 16 + i], bi = F.in[I_BIM][((size_t)(l * 64 + g) * 64 + p) * 16 + i];
        bbr[idx] = cr * br - ci * bi; bbi[idx] = cr * bi + ci * br; }
    __syncthreads();
    bf16* KT = (bf16*)(F.ws + WS_KTAB) + (size_t)(l * 64 + g) * 80 * 256;
    if (parts & 1) {
        const int d = hf * 32 + (tid >> 4), o = tid & 15;
        const float dskip = F.in[I_SD][l * 1024 + g * 16 + o];
        float s[16];
#pragma unroll
        for (int i = 0; i < 16; ++i) s[i] = 0.f;
        for (int p = 0; p < 64; ++p) { const float ar = apr[d * 65 + p], ai = api[d * 65 + p], cr = ccr[o * 65 + p], ci = cci[o * 65 + p];
            const float er = cr * ar - ci * ai, ei = cr * ai + ci * ar;
#pragma unroll
            for (int q = 0; q < 4; ++q) { const f32x4 br = *(const LAS f32x4*)(bbr + p * 16 + 4 * q), bi = *(const LAS f32x4*)(bbi + p * 16 + 4 * q);
#pragma unroll
                for (int e = 0; e < 4; ++e) s[4 * q + e] += er * br[e] - ei * bi[e]; } }
#if !SELFTEST_S5
        {   const float dsk = (d == 0) ? dskip : 0.f;
#pragma unroll
            for (int i = 0; i < 16; ++i) s[i] += (i == o) ? dsk : 0.f; }
#endif
        u32x4 w0, w1;
        w0.x = pk2(s[0], s[1]); w0.y = pk2(s[2], s[3]); w0.z = pk2(s[4], s[5]); w0.w = pk2(s[6], s[7]);
        w1.x = pk2(s[8], s[9]); w1.y = pk2(s[10], s[11]); w1.z = pk2(s[12], s[13]); w1.w = pk2(s[14], s[15]);
        if ((parts & 8) || w0.x == 0x12345678u) { *(u32x4*)(KT + (size_t)(d + 16) * 256 + o * 16) = w0; *(u32x4*)(KT + (size_t)(d + 16) * 256 + o * 16 + 8) = w1; }
        if ((parts & 8) && hf == 0 && tid < 256) { const u32x4 z = {0u, 0u, 0u, 0u}; *(u32x4*)(KT + tid * 16) = z; *(u32x4*)(KT + tid * 16 + 8) = z; }
    }
    bf16* WG = (bf16*)(F.ws + WS_WG) + (size_t)(l * 64 + g) * 128 * 1024;
    if (parts & 2) for (int it = tid; it < 32 * 64; it += NTHR) { const int p = hf * 32 + (it >> 6), tau = it & 63;
        const float ar = apr[(63 - tau) * 65 + p], ai = api[(63 - tau) * 65 + p];
        unsigned wr_[8], wi_[8];
#pragma unroll
        for (int q = 0; q < 4; ++q) { const f32x4 br = *(const LAS f32x4*)(bbr + p * 16 + 4 * q), bi = *(const LAS f32x4*)(bbi + p * 16 + 4 * q);
            wr_[2 * q] = pk2(ar * br[0] - ai * bi[0], ar * br[1] - ai * bi[1]); wr_[2 * q + 1] = pk2(ar * br[2] - ai * bi[2], ar * br[3] - ai * bi[3]);
            wi_[2 * q] = pk2(ar * bi[0] + ai * br[0], ar * bi[1] + ai * br[1]); wi_[2 * q + 1] = pk2(ar * bi[2] + ai * br[2], ar * bi[3] + ai * br[3]); }
        *(u32x4*)(WG + (size_t)p * 1024 + tau * 16) = (u32x4){wr_[0], wr_[1], wr_[2], wr_[3]}; *(u32x4*)(WG + (size_t)p * 1024 + tau * 16 + 8) = (u32x4){wr_[4], wr_[5], wr_[6], wr_[7]};
        *(u32x4*)(WG + (size_t)(64 + p) * 1024 + tau * 16) = (u32x4){wi_[0], wi_[1], wi_[2], wi_[3]}; *(u32x4*)(WG + (size_t)(64 + p) * 1024 + tau * 16 + 8) = (u32x4){wi_[4], wi_[5], wi_[6], wi_[7]}; }
    bf16* VG = (bf16*)(F.ws + WS_VG) + (size_t)(l * 64 + g) * 1024 * 128;
    if (parts & 4) for (int it = tid; it < 512 * 8; it += NTHR) { const int m = hf * 512 + (it >> 3), p0 = (it & 7) * 8, t = m >> 4, o = m & 15;
        float vr_[8], vi_[8];
#pragma unroll
        for (int e = 0; e < 8; ++e) { const float ar = apr[(t + 1) * 65 + p0 + e], ai = api[(t + 1) * 65 + p0 + e], cr = ccr[o * 65 + p0 + e], ci = cci[o * 65 + p0 + e];
            vr_[e] = cr * ar - ci * ai; vi_[e] = -(cr * ai + ci * ar); }
        *(u32x4*)(VG + (size_t)m * 128 + p0) = (u32x4){pk2(vr_[0], vr_[1]), pk2(vr_[2], vr_[3]), pk2(vr_[4], vr_[5]), pk2(vr_[6], vr_[7])};
        *(u32x4*)(VG + (size_t)m * 128 + 64 + p0) = (u32x4){pk2(vi_[0], vi_[1]), pk2(vi_[2], vi_[3]), pk2(vi_[4], vi_[5]), pk2(vi_[6], vi_[7])}; }
    if (hf == 0 && tid < 64) { float* AT = (float*)(F.ws + WS_AT) + ((size_t)(l * 64 + g) * 64 + tid) * 2; AT[0] = apr[64 * 65 + tid]; AT[1] = api[64 * 65 + tid]; }
    __syncthreads();
}
__device__ __forceinline__ void p0_fp4_chunk(Frame& F, int chunk, int wave, int lane) {
    unsigned char* UV = F.ws + WS_UV; float* SCL = (float*)(F.ws + WS_SCL);
    for (int i = 0; i < 8; i += 2) {
        f32x4 v[2][8]; float am[2] = {0.f, 0.f}; int tbl[2], rr[2];
#pragma unroll
        for (int r2 = 0; r2 < 2; ++r2) {
            const int r = chunk * 64 + wave * 8 + i + r2; tbl[r2] = r >> 15; rr[r2] = r & 32767;
            const float* srcp = (tbl[r2] ? F.in[I_PV] : F.in[I_PU]) + (size_t)rr[r2] * 2048 + lane * 4;
#pragma unroll
            for (int j = 0; j < 8; ++j) v[r2][j] = *(const f32x4*)(srcp + j * 256);
        }
#pragma unroll
        for (int r2 = 0; r2 < 2; ++r2)
#pragma unroll
            for (int j = 0; j < 8; ++j) am[r2] = fmaxf(am[r2], fmaxf(fmaxf(fabsf(v[r2][j][0]), fabsf(v[r2][j][1])), fmaxf(fabsf(v[r2][j][2]), fabsf(v[r2][j][3]))));
#pragma unroll
        for (int o = 1; o < 64; o <<= 1) { am[0] = fmaxf(am[0], __shfl_xor(am[0], o)); am[1] = fmaxf(am[1], __shfl_xor(am[1], o)); }
#pragma unroll
        for (int r2 = 0; r2 < 2; ++r2) {
            const float scale = am[r2] > 0.f ? am[r2] * (1.0f / 6.0f) : 1.0f, inv = am[r2] > 0.f ? 6.0f / am[r2] : 1.0f;
            u32x4 o;
#pragma unroll
            for (int d = 0; d < 4; ++d) { unsigned w = 0u;
                w = __builtin_amdgcn_cvt_scalef32_pk_fp4_f32(w, v[r2][2 * d][0] * inv, v[r2][2 * d][1] * inv, 1.0f, 0);
                w = __builtin_amdgcn_cvt_scalef32_pk_fp4_f32(w, v[r2][2 * d][2] * inv, v[r2][2 * d][3] * inv, 1.0f, 1);
                w = __builtin_amdgcn_cvt_scalef32_pk_fp4_f32(w, v[r2][2 * d + 1][0] * inv, v[r2][2 * d + 1][1] * inv, 1.0f, 2);
                w = __builtin_amdgcn_cvt_scalef32_pk_fp4_f32(w, v[r2][2 * d + 1][2] * inv, v[r2][2 * d + 1][3] * inv, 1.0f, 3);
                o[d] = w; }
            *(u32x4*)(UV + (size_t)(rr[r2] >> 14) * ((size_t)NEXP * 2048) + (size_t)tbl[r2] * ((size_t)NEXP * 1024) + (size_t)(rr[r2] & 16383) * 1024 + lane * 16) = o;
            if (lane == 0) SCL[rr[r2] * 2 + tbl[r2]] = scale;
        }
    }
}
#ifndef P0_PARTS
#define P0_PARTS 15
#endif
#ifndef P0_PROBE_MODE
#define P0_PROBE_MODE 0
#endif
__device__ __forceinline__ void p0_tables(Frame& F, int qi = 4, bool dummy = false) {
    PH_LOCALS
    unsigned* head = (unsigned*)(F.ws + WS_CTL) + CW_QUEUE + 64 * qi;
    float* modout = dummy ? (float*)(F.ws + WS_DBG) : (float*)(F.ws + WS_MOD);
    LAS unsigned* slot = (LAS unsigned*)(F.lds + MISC_OFF) + 16;
    for (;;) {
        __syncthreads();
        if (tid == 0) slot[0] = __hip_atomic_fetch_add(head, 1u, RLX_AGENT);
        __syncthreads();
        const unsigned u = slot[0];
        if (u >= 1664u) break;
        const int rnd = (int)u / 13, k = (int)u % 13;
        if (k < 2) { if (dummy && P0_PROBE_MODE == 2) continue; p0_s5_unit(F, rnd * 2 + k, tid, dummy ? P0_PARTS : 15); }
        else if (k < 5) { if (dummy && P0_PROBE_MODE == 1) continue; p0_gemv_unit(F, rnd * 3 + (k - 2), tid, modout); }
        else { p0_fp4_chunk(F, rnd * 8 + (k - 5), wave, lane); }
    }
}
__device__ __forceinline__ void p0_prologue(Frame& F) {
    PH_LOCALS
    const int gw = F.vcu * NWAVES + wave, NGW = F.G * NWAVES;
    const int gt = F.vcu * NTHR + tid, NGT = F.G * NTHR;
    const float* modp = (const float*)(F.ws + WS_MOD);
    for (int i = gt; i < 2 * DM; i += NGT) { const int l = i >> 11, k = i & 2047; ((float*)(F.ws + WS_GS))[i] = F.in[I_N2G][i] * (1.0f + modp[l * 12288 + 4 * 2048 + k]); }
    for (int u = F.vcu; u < 256; u += F.G) {
        const int l = u >> 7, cb = (u >> 2) & 31, kq = u & 3, tx = tid & 15, ty = tid >> 4;
        const float* W = F.in[I_WQ] + ((size_t)l * DM + kq * 512) * DM + cb * 64 + tx * 4; const float* sh = modp + l * 12288 + 3 * 2048 + kq * 512;
        f32x4 a = {0.f, 0.f, 0.f, 0.f};
#pragma unroll 16
        for (int k = ty; k < 512; k += 32) { const f32x4 w = *(const f32x4*)(W + (size_t)k * DM); a += w * sh[k]; }
        LAS float* red = (LAS float*)F.lds;
        __syncthreads();
        *(LAS f32x4*)(red + ty * 64 + tx * 4) = a;
        __syncthreads();
        if (tid < 64) { float s = 0.f;
#pragma unroll
            for (int y = 0; y < 32; ++y) s += red[y * 64 + tid];
            ((float*)(F.ws + WS_C0))[(l * 4 + kq) * DM + cb * 64 + tid] = s; }
        __syncthreads();
    }
    {
        LAS float* scr = (LAS float*)(F.lds + wave * 16384);
        constexpr int I_IN = (DM / 64) * (INW / 32), I_GL = (WB / 64) * (WB / 32), I_OU = (DM / 64) * (DM / 32), I_Q = I_OU;
        constexpr int PER_L = I_IN + I_GL + I_OU + I_Q;
        for (int it = gw; it < 2 * PER_L; it += NGW) {
            const int l = it / PER_L; int r = it % PER_L;
            if (r < I_IN) { p0_transpose_item(F.in[I_WIN] + (size_t)l * DM * INW, DM, INW, (bf16*)(F.ws + WS_WIN) + (size_t)l * INW * DM, nullptr, scr, r, lane); continue; } r -= I_IN;
            if (r < I_GL) { p0_transpose_item(F.in[I_GLUW] + (size_t)l * WB * WB, WB, WB, (bf16*)(F.ws + WS_GLU) + (size_t)l * WB * WB, nullptr, scr, r, lane); continue; } r -= I_GL;
            if (r < I_OU) { p0_transpose_item(F.in[I_WOUT] + (size_t)l * DM * DM, DM, DM, (bf16*)(F.ws + WS_WOUT) + (size_t)l * DM * DM, F.in[I_BRG] + l * DM, scr, r, lane); continue; } r -= I_OU;
            p0_transpose_item(F.in[I_WQ] + (size_t)l * DM * DM, DM, DM, (bf16*)(F.ws + WS_WQ) + (size_t)l * DM * DM, F.in[I_N2G] + l * DM, scr, r, lane, modp + l * 12288 + 4 * 2048);
        }
    }
    {
        bf16* KB = (bf16*)(F.ws + WS_KEYS);
        for (int i = gt; i < 2 * 8 * 2 * 128 * 128 / 8; i += NGT) { const f32x4 a = *(const f32x4*)(F.in[I_KEYS] + (size_t)i * 8), b = *(const f32x4*)(F.in[I_KEYS] + (size_t)i * 8 + 4);
            u32x4 o; o.x = pk2(a[0], a[1]); o.y = pk2(a[2], a[3]); o.z = pk2(b[0], b[1]); o.w = pk2(b[2], b[3]); *(u32x4*)(KB + (size_t)i * 8) = o; }
        bf16* GW = (bf16*)(F.ws + WS_GWS);
        for (int i = gt; i < 2 * 8 * 128 * 128 / 8; i += NGT) { const int e = i * 8, jj = e & 127, ii = (e >> 7) & 127; const bool keep = (ii >= 64) || (jj < 64);
            f32x4 a = *(const f32x4*)(F.in[I_GWS] + (size_t)i * 8), b = *(const f32x4*)(F.in[I_GWS] + (size_t)i * 8 + 4);
            if (!keep) { a = (f32x4){0.f, 0.f, 0.f, 0.f}; b = a; }
            u32x4 o; o.x = pk2(a[0], a[1]); o.y = pk2(a[2], a[3]); o.z = pk2(b[0], b[1]); o.w = pk2(b[2], b[3]); *(u32x4*)(GW + (size_t)i * 8) = o; }
    }
}

template <bool SRC_BF16>
__device__ __forceinline__ void phase_norm(Frame& F, const void* xsrc, const float* gain, const float* scale, const float* shift) {
    PH_LOCALS
    const int gw = F.vcu * NWAVES + wave, NGW = F.G * NWAVES;
    bf16* H = (bf16*)(F.ws + WS_H);
    for (int m = gw; m < M; m += 2 * NGW) {
        const int m2 = m + NGW;
        f32x4 va[4][2], vb[4][2];
        const char* ra = (const char*)xsrc + (size_t)m * DM * (SRC_BF16 ? 2 : 4); const char* rb = (const char*)xsrc + (size_t)(m2 < M ? m2 : m) * DM * (SRC_BF16 ? 2 : 4);
        load_row<SRC_BF16>(ra, lane, va); load_row<SRC_BF16>(rb, lane, vb);
        u32x4 oa[4], ob[4]; norm_mod_row(va, gain, scale, shift, lane, oa); norm_mod_row(vb, gain, scale, shift, lane, ob);
#pragma unroll
        for (int j = 0; j < 4; ++j) *(u32x4*)(H + (size_t)m * DM + j * 512 + lane * 8) = oa[j];
        if (m2 < M) {
#pragma unroll
            for (int j = 0; j < 4; ++j) *(u32x4*)(H + (size_t)m2 * DM + j * 512 + lane * 8) = ob[j]; }
    }
}
__device__ __forceinline__ void phase_sloc(Frame& F, int l) {
    PH_LOCALS
    const bf16* XS = (const bf16*)(F.ws + WS_XS); const bf16* WG = (const bf16*)(F.ws + WS_WG) + (size_t)l * 64 * 128 * 1024; float* SL = (float*)(F.ws + WS_SLOC);
    LAS unsigned char* WL = F.lds;
    const int fr = lane & 15, fq = lane >> 4;
    for (int u = F.vcu; u < 256; u += F.G) {
        const int g = u >> 2, jq = u & 3;
        const bf16* xp0 = XS + ((size_t)(g * 256 + 32 * wave + fr)) * 1024 + 8 * fq;
        bf16x8 xa[8][2];
#pragma unroll
        for (int i = 0; i < 8; ++i) { xa[i][0] = *(const bf16x8*)(xp0 + i * 32); xa[i][1] = *(const bf16x8*)(xp0 + 16 * 1024 + i * 32); }
        __syncthreads();
#pragma unroll
        for (int ps = 0; ps < 8; ++ps) { const int idx = ps * 512 + tid, row = idx >> 7, c16 = idx & 127;
            *(LAS u32x4*)(WL + row * 2064 + c16 * 16) = *(const u32x4*)(WG + ((size_t)(g * 128 + jq * 32 + row)) * 1024 + c16 * 8); }
        __syncthreads();
        f32x4 acc[2][2];
#pragma unroll
        for (int a = 0; a < 2; ++a) { acc[a][0] = (f32x4){0.f, 0.f, 0.f, 0.f}; acc[a][1] = acc[a][0]; }
#pragma unroll 1
        for (int kg = 0; kg < 4; ++kg) {
            bf16x8 xn[8][2];
            if (kg < 3) {
#pragma unroll
                for (int i = 0; i < 8; ++i) { xn[i][0] = *(const bf16x8*)(xp0 + ((kg + 1) * 8 + i) * 32); xn[i][1] = *(const bf16x8*)(xp0 + 16 * 1024 + ((kg + 1) * 8 + i) * 32); }
            }
#pragma unroll
            for (int i = 0; i < 8; ++i) { const int kb = kg * 8 + i;
#pragma unroll
                for (int jt = 0; jt < 2; ++jt) { const bf16x8 wf = *(const LAS bf16x8*)(WL + (jt * 16 + fr) * 2064 + (kb * 32 + 8 * fq) * 2);
                    acc[0][jt] = __builtin_amdgcn_mfma_f32_16x16x32_bf16(wf, xa[i][0], acc[0][jt], 0, 0, 0);
                    acc[1][jt] = __builtin_amdgcn_mfma_f32_16x16x32_bf16(wf, xa[i][1], acc[1][jt], 0, 0, 0); } }
            if (kg < 3) {
#pragma unroll
                for (int i = 0; i < 8; ++i) { xa[i][0] = xn[i][0]; xa[i][1] = xn[i][1]; }
            }
        }
#pragma unroll
        for (int a = 0; a < 2; ++a)
#pragma unroll
            for (int jt = 0; jt < 2; ++jt) *(f32x4*)(SL + ((size_t)(g * 256 + 32 * wave + 16 * a + fr)) * 128 + jq * 32 + jt * 16 + 4 * fq) = acc[a][jt];
    }
    __syncthreads();
}
#define GT_TR16(A_, addr_) asm volatile( \
    "ds_read_b64_tr_b16 %0, %16\n\tds_read_b64_tr_b16 %1, %16 offset:1088\n\tds_read_b64_tr_b16 %2, %16 offset:8\n\tds_read_b64_tr_b16 %3, %16 offset:1096\n\t" \
    "ds_read_b64_tr_b16 %4, %16 offset:64\n\tds_read_b64_tr_b16 %5, %16 offset:1152\n\tds_read_b64_tr_b16 %6, %16 offset:72\n\tds_read_b64_tr_b16 %7, %16 offset:1160\n\t" \
    "ds_read_b64_tr_b16 %8, %16 offset:128\n\tds_read_b64_tr_b16 %9, %16 offset:1216\n\tds_read_b64_tr_b16 %10, %16 offset:136\n\tds_read_b64_tr_b16 %11, %16 offset:1224\n\t" \
    "ds_read_b64_tr_b16 %12, %16 offset:192\n\tds_read_b64_tr_b16 %13, %16 offset:1280\n\tds_read_b64_tr_b16 %14, %16 offset:200\n\tds_read_b64_tr_b16 %15, %16 offset:1288\n\t" \
    "s_waitcnt lgkmcnt(0)" \
    : "=&v"(A_[0]), "=&v"(A_[1]), "=&v"(A_[2]), "=&v"(A_[3]), "=&v"(A_[4]), "=&v"(A_[5]), "=&v"(A_[6]), "=&v"(A_[7]), \
      "=&v"(A_[8]), "=&v"(A_[9]), "=&v"(A_[10]), "=&v"(A_[11]), "=&v"(A_[12]), "=&v"(A_[13]), "=&v"(A_[14]), "=&v"(A_[15]) : "v"(addr_) : "memory")
__device__ __forceinline__ void phase_gating(Frame& F, int l) {
    PH_LOCALS
    const bf16* Z = (const bf16*)(F.ws + WS_Z); const float* PLN = (const float*)(F.ws + WS_PLN);
    bf16* MIX = (bf16*)(F.ws + WS_MIX);
    constexpr int VS = 272, VBUF = 128 * VS;
    const int j = tid >> 2, cs = (tid & 3) * 32;
    const int fr = lane & 15, fq = lane >> 4, w = wave;
    const unsigned wr_off = (unsigned)(j * VS + cs * 2);
    const unsigned tr_off = (unsigned)((8 * fq + (fr >> 2)) * VS + 16 * (lane & 3));
    u32x4 tw[4], uw[4]; f32x4 pl0, pl1;
#define GT_LOAD(unit_) do { const int nb_ = (unit_) >> 3, hh_ = (unit_) & 7; \
        const bf16* zr_ = Z + (size_t)(nb_ * 128 + j) * 2048 + 1024 + hh_ * 128 + cs; \
        _Pragma("unroll") for (int q = 0; q < 4; ++q) tw[q] = *(const u32x4*)(zr_ + q * 8); \
        { const float* pl_ = PLN + (size_t)(nb_ * 128 + j) * 32 + (tid & 3) * 8; pl0 = *(const f32x4*)pl_; pl1 = *(const f32x4*)(pl_ + 4); } \
        const bf16* ur_ = Z + (size_t)(nb_ * 128 + 16 * w + fr) * 2048 + hh_ * 128 + 8 * fq; \
        _Pragma("unroll") for (int P = 0; P < 4; ++P) uw[P] = *(const u32x4*)(ur_ + 32 * P); } while (0)
    __syncthreads();
    if (F.vcu < 1024) GT_LOAD(F.vcu);
    int hprev = -1; bf16x8 wf[4];
#pragma unroll
    for (int kb = 0; kb < 4; ++kb) wf[kb] = (bf16x8){0, 0, 0, 0, 0, 0, 0, 0};
    const int nkb = (w < 4) ? 2 : 4;
    int k = 0;
    for (int unit = F.vcu; unit < 1024; unit += F.G, ++k) {
        const int nb = unit >> 3, hh = unit & 7, t0 = nb * 128, c0 = hh * 128;
        const unsigned vb = (unsigned)(size_t)(F.lds) + (unsigned)((k & 1) * VBUF);
        {
            float a1 = (pl0[0] + pl0[2]) + (pl1[0] + pl1[2]), a2 = (pl0[1] + pl0[3]) + (pl1[1] + pl1[3]);
            a1 += __shfl_xor(a1, 1); a2 += __shfl_xor(a2, 1); a1 += __shfl_xor(a1, 2); a2 += __shfl_xor(a2, 2);
            const float mu = a1 * (1.0f / 1024.0f), rs = 1.0f / sqrtf(fmaxf(a2 * (1.0f / 1024.0f) - mu * mu, 0.f) + EPS), mr = -mu * rs;
            const float* lg = F.in[I_LNG] + l * 1024 + c0 + cs; const float* lb = F.in[I_LNB] + l * 1024 + c0 + cs;
#pragma unroll
            for (int q = 0; q < 4; ++q) {
                const f32x4 g0 = *(const f32x4*)(lg + q * 8), g1 = *(const f32x4*)(lg + q * 8 + 4), b0 = *(const f32x4*)(lb + q * 8), b1 = *(const f32x4*)(lb + q * 8 + 4);
                u32x4 ow;
#pragma unroll
                for (int e = 0; e < 4; ++e) {
                    const float ga = e < 2 ? g0[2 * e] : g1[2 * e - 4], gb = e < 2 ? g0[2 * e + 1] : g1[2 * e - 3], ba = e < 2 ? b0[2 * e] : b1[2 * e - 4], bb = e < 2 ? b0[2 * e + 1] : b1[2 * e - 3];
                    ow[e] = pk2((bflo(tw[q][e]) * rs + mr) * ga + ba, (bfhi(tw[q][e]) * rs + mr) * gb + bb); }
                *(LAS u32x4*)(F.lds + (k & 1) * VBUF + wr_off + 16 * q) = ow;
            }
        }
        u32x4 uc[4];
#pragma unroll
        for (int P = 0; P < 4; ++P) uc[P] = uw[P];
        if (hh != hprev) {
            const bf16* GW = (const bf16*)(F.ws + WS_GWS) + (size_t)(l * 8 + hh) * 128 * 128;
#pragma unroll
            for (int kb = 0; kb < 4; ++kb) wf[kb] = *(const bf16x8*)(GW + (size_t)(16 * w + fr) * 128 + (kb < nkb ? kb : 0) * 32 + 8 * fq);
            hprev = hh; }
        const int tok = t0 + 16 * w + fr; const float bs = F.in[I_GBS][(l * 8 + hh) * 128 + 16 * w + fr];
        if (unit + F.G < 1024) GT_LOAD(unit + F.G);
        __syncthreads();
        {
            f32x4 acc[8];
#pragma unroll
            for (int ct = 0; ct < 8; ++ct) acc[ct] = (f32x4){0.f, 0.f, 0.f, 0.f};
#pragma unroll
            for (int kb = 0; kb < 4; ++kb) { if (kb < nkb) {
                u32x2 af[16]; const unsigned ad = vb + tr_off + (unsigned)(kb * 32 * VS);
                GT_TR16(af, ad);
#pragma unroll
                for (int ct = 0; ct < 8; ++ct) { const u32x4 t4 = __builtin_shufflevector(af[2 * ct], af[2 * ct + 1], 0, 1, 2, 3);
                    acc[ct] = __builtin_amdgcn_mfma_f32_16x16x32_bf16(__builtin_bit_cast(bf16x8, t4), wf[kb], acc[ct], 0, 0, 0); } } }
            float ssq = 0.f;
#pragma unroll
            for (int P = 0; P < 4; ++P) {
                const f32x4 x = acc[2 * P], y = acc[2 * P + 1]; const u32x4 uu = uc[P];
                const float o0 = bflo(uu[0]) * (x[0] + bs), o1 = bfhi(uu[0]) * (x[1] + bs), o2 = bflo(uu[1]) * (x[2] + bs), o3 = bfhi(uu[1]) * (x[3] + bs);
                const float o4 = bflo(uu[2]) * (y[0] + bs), o5 = bfhi(uu[2]) * (y[1] + bs), o6 = bflo(uu[3]) * (y[2] + bs), o7 = bfhi(uu[3]) * (y[3] + bs);
                u32x4 o; o[0] = pk2(o0, o1); o[1] = pk2(o2, o3); o[2] = pk2(o4, o5); o[3] = pk2(o6, o7);
                *(u32x4*)(MIX + (size_t)tok * 2048 + c0 + 32 * P + 8 * fq) = o;
                ssq += ((o0 * o0 + o1 * o1) + (o2 * o2 + o3 * o3)) + ((o4 * o4 + o5 * o5) + (o6 * o6 + o7 * o7)); }
            ssq += __shfl_xor(ssq, 16); ssq += __shfl_xor(ssq, 32);
            if (fq == 0) ((float*)(F.ws + WS_PSA))[(size_t)tok * 8 + hh] = ssq;
        }
    }
    __syncthreads();
#undef GT_LOAD
}

__device__ __forceinline__ void phase_s5out(Frame& F, int l) {
    PH_LOCALS
    const bf16* XS = (const bf16*)(F.ws + WS_XS);
    bf16* Gb = (bf16*)(F.ws + WS_G);
    LAS unsigned char* HT = F.lds;
    LAS float* TS = (LAS float*)(F.lds + 34816);
    LAS unsigned char* KT = F.lds + 38912;
    LAS unsigned char* VT = F.lds + 79872;
    const int fr = lane & 15, fq = lane >> 4;
    int have_g = -1, have_nh = -1;
    for (int uu = F.vcu, it = 0; uu < 512; uu += F.G, ++it) {
        const int g = (F.G == 256) ? (F.vcu >> 2) : (uu >> 3), nh = (F.G == 256) ? ((F.vcu >> 1) & 1) : (uu & 1), rc = (F.G == 256) ? ((F.vcu & 1) + 2 * it) : ((uu >> 1) & 3);
        const bool fresh = (g != have_g) || (nh != have_nh);
        const bf16* VG = (const bf16*)(F.ws + WS_VG) + (size_t)(l * 64 + g) * 1024 * 128;
        const int n = nh * 128 + 16 * wave + fr;
        const bf16* xp0 = XS + ((size_t)(g * 256 + n)) * 1024 + 8 * fq;
        bf16x8 xa[4], xb[4];
#pragma unroll
        for (int i = 0; i < 4; ++i) xa[i] = *(const bf16x8*)(xp0 + i * 32);
        __syncthreads();
        { const u32x4* src = (const u32x4*)((const bf16*)(F.ws + WS_KTAB) + (size_t)(l * 64 + g) * 80 * 256);
          if (fresh) for (int i = tid; i < 80 * 256 / 8; i += NTHR) ((LAS u32x4*)KT)[i] = src[i];
#pragma unroll
          for (int ps = 0; ps < 8; ++ps) { const int row = ps * 32 + (tid >> 4), c = tid & 15, q = row >> 4, o = row & 15;
              *(LAS u32x4*)(VT + row * 272 + c * 16) = *(const u32x4*)(VG + (size_t)((rc + 4 * q) * 16 + o) * 128 + c * 8); } }
        if (fresh) {
            const int p = lane, seg = wave;
            const float* AT = (const float*)(F.ws + WS_AT) + ((size_t)(l * 64 + g) * 64 + p) * 2; const float ar = AT[0], ai = AT[1];
            const float* SL = (const float*)(F.ws + WS_SLOC) + ((size_t)(g * 256 + seg * 32)) * 128 + p;
            float sr[32], si[32];
#pragma unroll
            for (int i = 0; i < 32; ++i) { sr[i] = SL[(size_t)i * 128]; si[i] = SL[(size_t)i * 128 + 64]; }
            float er = 0.f, ei = 0.f;
#pragma unroll
            for (int i = 0; i < 32; ++i) { const float nr = ar * er - ai * ei + sr[i], ni = ar * ei + ai * er + si[i]; er = nr; ei = ni; }
            TS[(seg * 64 + p) * 2] = er; TS[(seg * 64 + p) * 2 + 1] = ei;
            float qr = ar, qi = ai;
#pragma unroll
            for (int s = 0; s < 5; ++s) { const float nr = qr * qr - qi * qi, ni = 2.0f * qr * qi; qr = nr; qi = ni; }
            __syncthreads();
            float hr = 0.f, hi = 0.f;
            for (int k = 0; k < seg; ++k) { const float tr = TS[(k * 64 + p) * 2], ti = TS[(k * 64 + p) * 2 + 1]; const float nr = qr * hr - qi * hi + tr, ni = qr * hi + qi * hr + ti; hr = nr; hi = ni; }
            if ((seg >> 2) == nh) {
                LAS bf16* hrow = (LAS bf16*)(HT + ((seg & 3) * 32) * 272) + p;
#pragma unroll
                for (int i = 0; i < 32; ++i) { hrow[i * 136] = (bf16)f2bf(hr); hrow[i * 136 + 64] = (bf16)f2bf(hi);
                    const float nr = ar * hr - ai * hi + sr[i], ni = ar * hi + ai * hr + si[i]; hr = nr; hi = ni; }
            }
        }
        have_g = g; have_nh = nh;
        __syncthreads();
        f32x4 acc[16];
#pragma unroll
        for (int q = 0; q < 16; ++q) acc[q] = (f32x4){0.f, 0.f, 0.f, 0.f};
        const int kb0 = ((rc - (fq >> 1) + 10) * 16 + fr) * 32 + 16 * (fq & 1);
#define S5_GROUP(XF, grp_) do { const LAS unsigned char* kp = KT + kb0 - (grp_) * 4096; \
            _Pragma("unroll") for (int q = 0; q < 16; ++q) { if (rc + 4 * q >= 8 * (grp_)) { \
                _Pragma("unroll") for (int i = 0; i < 4; ++i) { const bf16x8 kf = *(const LAS bf16x8*)(kp + (4 * q - 2 * i + 6) * 512); \
                    acc[q] = __builtin_amdgcn_mfma_f32_16x16x32_bf16(kf, XF[i], acc[q], 0, 0, 0); } } } } while (0)
#pragma unroll 1
        for (int gp = 0; gp < 4; ++gp) {
#pragma unroll
            for (int i = 0; i < 4; ++i) xb[i] = *(const bf16x8*)(xp0 + ((2 * gp + 1) * 4 + i) * 32);
            S5_GROUP(xa, 2 * gp);
            if (gp < 3) {
#pragma unroll
                for (int i = 0; i < 4; ++i) xa[i] = *(const bf16x8*)(xp0 + ((2 * gp + 2) * 4 + i) * 32);
            }
            S5_GROUP(xb, 2 * gp + 1);
        }
#undef S5_GROUP
#pragma unroll 1
        for (int jb = 0; jb < 4; ++jb) {
            const bf16x8 hf = *(const LAS bf16x8*)(HT + (16 * wave + fr) * 272 + (jb * 32 + 8 * fq) * 2);
#pragma unroll
            for (int q = 0; q < 16; ++q) {
                const bf16x8 vf = *(const LAS bf16x8*)(VT + (q * 16 + fr) * 272 + (jb * 32 + 8 * fq) * 2);
                acc[q] = __builtin_amdgcn_mfma_f32_16x16x32_bf16(vf, hf, acc[q], 0, 0, 0);
            }
        }
#pragma unroll
        for (int q = 0; q < 16; ++q) {
            const int t = rc + 4 * q, tok = 64 * n + t;
            const f32x4 y = acc[q];
            u32x2 o; o.x = pk2(gelu_tanh(y[0]), gelu_tanh(y[1])); o.y = pk2(gelu_tanh(y[2]), gelu_tanh(y[3]));
            *(u32x2*)(Gb + (size_t)tok * 1024 + g * 16 + 4 * fq) = o;
#if SELFTEST_S5
            if (tok < 256) *(f32x4*)((float*)(F.ws + WS_DBG) + (size_t)tok * 1024 + g * 16 + 4 * fq) = y;
#endif
        }
    }
    __syncthreads();
}
#if SELFTEST_S5
__device__ __forceinline__ void selftest_s5(Frame& F, int l) {
    PH_LOCALS
    if (F.vcu < 64 && wave == 0) {
        const int g = F.vcu, p = lane;
        const float dt = expf(F.in[I_LDT][l * 64 + g]);
        const float lr = F.in[I_LRE][(l * 64 + g) * 64 + p], li = F.in[I_LIM][(l * 64 + g) * 64 + p];
        const float mag = expf(lr * dt); float sn, cs; sincosf(li * dt, &sn, &cs);
        const float ar = mag * cs, ai = mag * sn;
        const float xr = ar - 1.0f, xi = ai, den = 1.0f / (lr * lr + li * li);
        const float cr = (xr * lr + xi * li) * den, ci = (xi * lr - xr * li) * den;
        float bbr[16], bbi[16], ccr[16], cci[16];
#pragma unroll
        for (int i = 0; i < 16; ++i) { const float br = F.in[I_BRE][((size_t)(l * 64 + g) * 64 + p) * 16 + i], bi = F.in[I_BIM][((size_t)(l * 64 + g) * 64 + p) * 16 + i];
            bbr[i] = cr * br - ci * bi; bbi[i] = cr * bi + ci * br;
            ccr[i] = F.in[I_CRE][((size_t)(l * 64 + g) * 16 + i) * 64 + p]; cci[i] = F.in[I_CIM][((size_t)(l * 64 + g) * 16 + i) * 64 + p]; }
        const bf16* XS = (const bf16*)(F.ws + WS_XS) + (size_t)g * 256 * 1024;
        const float* DY = (const float*)(F.ws + WS_DBG);
        float sr = 0.f, si = 0.f, err = 0.f, ref = 0.f;
        for (int t = 0; t < 256; ++t) {
            float x[16];
#pragma unroll
            for (int i = 0; i < 16; ++i) x[i] = bflo((unsigned)XS[(size_t)t * 16 + i]);
            float ur = 0.f, ui = 0.f;
#pragma unroll
            for (int i = 0; i < 16; ++i) { ur += bbr[i] * x[i]; ui += bbi[i] * x[i]; }
            const float nr = ar * sr - ai * si + ur, ni = ar * si + ai * sr + ui; sr = nr; si = ni;
#pragma unroll
            for (int o = 0; o < 16; ++o) {
                const float yr = wave_sum(ccr[o] * sr - cci[o] * si);
                const float yf = DY[(size_t)t * 1024 + g * 16 + o];
                err += (yf - yr) * (yf - yr); ref += yr * yr;
            }
        }
        if (lane == 0 && !(err <= 2e-3f * ref)) __hip_atomic_fetch_or((unsigned*)(F.ws + WS_CTL) + CW_FLAG, 1u, RLX_AGENT);
    }
}
#endif

__device__ __forceinline__ unsigned f2key(float v) { const unsigned u = __builtin_bit_cast(unsigned, v); return (u & 0x80000000u) ? ~u : (u | 0x80000000u); }
__device__ __forceinline__ float key2f(unsigned k) { const unsigned u = (k & 0x80000000u) ? (k & 0x7fffffffu) : ~k; return __builtin_bit_cast(float, u); }
__device__ __forceinline__ void sort16_desc(unsigned (&v)[16]) {
#pragma unroll
    for (int lk = 1; lk <= 4; ++lk) {
#pragma unroll
        for (int lj = lk - 1; lj >= 0; --lj) {
#pragma unroll
            for (int i = 0; i < 16; ++i) { const int k = 1 << lk, j = 1 << lj, p = i ^ j;
                if (p > i) { const unsigned a = v[i], c = v[p], hi = a > c ? a : c, lo = a > c ? c : a; const bool desc = ((i & k) == 0) || (k == 16);
                    v[i] = desc ? hi : lo; v[p] = desc ? lo : hi; } }
        }
    }
}
__device__ __forceinline__ void merge16_desc(unsigned (&v)[16], const unsigned (&w)[16]) {
#pragma unroll
    for (int i = 0; i < 16; ++i) v[i] = v[i] > w[15 - i] ? v[i] : w[15 - i];
#pragma unroll
    for (int lj = 3; lj >= 0; --lj) {
#pragma unroll
        for (int i = 0; i < 16; ++i) { const int j = 1 << lj, p = i ^ j;
            if (p > i) { const unsigned a = v[i], c = v[p]; v[i] = a > c ? a : c; v[p] = a > c ? c : a; } }
    }
}
__device__ __forceinline__ void xmerge16(unsigned (&v)[16], int mask) {
    unsigned w[16];
#pragma unroll
    for (int i = 0; i < 16; ++i) w[i] = (unsigned)__shfl_xor((int)v[i], mask);
    merge16_desc(v, w);
}
__device__ __forceinline__ void phase_topk(Frame& F, int l) {
    PH_LOCALS
    const bf16* Q = (const bf16*)(F.ws + WS_Z);
    const bf16* KB = (const bf16*)(F.ws + WS_KEYS) + (size_t)l * 8 * 2 * 128 * 128;
    int* EID = (int*)(F.ws + WS_EID); float* GT = (float*)(F.ws + WS_GATE); float* SUo = (float*)(F.ws + WS_SU);
    const float* SCL = (const float*)(F.ws + WS_SCL) + (size_t)l * NEXP * 2;
    LAS unsigned char* KL = F.lds;
    LAS unsigned* LST = (LAS unsigned*)(F.lds + 69632);
    LAS unsigned char* PT = F.lds + 69632 + 16384;
    const int fr = lane & 15, fq = lane >> 4;
    {
        int c = 0;
#pragma unroll
        for (int i = 0; i < 16; ++i)
#pragma unroll
            for (int j = 0; j < 16; ++j) if ((i + 1) * (j + 1) <= 16) { if (tid == c) PT[c] = (unsigned char)(i * 16 + j); ++c; }
    }
    int cur_hh = -1;
    for (int u = F.vcu; u < 1024; u += F.G) {
        const int tt = u >> 3, hh = u & 7, t0 = tt * 128;
        bf16x8 qf[2][4];
#pragma unroll
        for (int s = 0; s < 2; ++s)
#pragma unroll
            for (int kb = 0; kb < 4; ++kb) qf[s][kb] = *(const bf16x8*)(Q + (size_t)(t0 + 16 * wave + fr) * 2048 + hh * 256 + s * 128 + kb * 32 + 8 * fq);
        if (hh != cur_hh) {
            __syncthreads();
#pragma unroll
            for (int ps = 0; ps < 8; ++ps) { const int idx = ps * 512 + tid, row = idx >> 4, c16 = idx & 15;
                *(LAS u32x4*)(KL + row * 272 + c16 * 16) = *(const u32x4*)(KB + ((size_t)(hh * 256 + row)) * 128 + c16 * 8); }
            cur_hh = hh;
            __syncthreads();
        }
#pragma unroll 1
        for (int s = 0; s < 2; ++s) {
            f32x4 acc[8];
#pragma unroll
            for (int nt = 0; nt < 8; ++nt) acc[nt] = (f32x4){0.f, 0.f, 0.f, 0.f};
#pragma unroll
            for (int kb = 0; kb < 4; ++kb) { const bf16x8 q = s ? qf[1][kb] : qf[0][kb];
#pragma unroll
                for (int nt = 0; nt < 8; ++nt) { const bf16x8 kf = *(const LAS bf16x8*)(KL + (s * 128 + nt * 16 + fr) * 272 + (kb * 32 + 8 * fq) * 2);
                    acc[nt] = __builtin_amdgcn_mfma_f32_16x16x32_bf16(kf, q, acc[nt], 0, 0, 0); } }
            unsigned va[16], vb[16];
#pragma unroll
            for (int nt = 0; nt < 4; ++nt)
#pragma unroll
                for (int r = 0; r < 4; ++r) { va[4 * nt + r] = (f2key(acc[nt][r]) & ~0x7Fu) | (unsigned)(127 - (nt * 16 + 4 * fq + r));
                    vb[4 * nt + r] = (f2key(acc[4 + nt][r]) & ~0x7Fu) | (unsigned)(127 - ((4 + nt) * 16 + 4 * fq + r)); }
            sort16_desc(va); sort16_desc(vb); merge16_desc(va, vb);
            xmerge16(va, 16); xmerge16(va, 32);
            if (fq == 0) {
#pragma unroll
                for (int k = 0; k < 16; k += 4) *(LAS u32x4*)(LST + ((16 * wave + fr) * 2 + s) * 16 + k) = (u32x4){va[k], va[k + 1], va[k + 2], va[k + 3]};
            }
        }
        asm volatile("s_waitcnt lgkmcnt(0)" ::: "memory");
        {
            const int tl = 16 * wave + (lane >> 2), c4 = lane & 3;
            unsigned v[16];
#pragma unroll
            for (int m = 0; m < 13; ++m) { const int c = m * 4 + c4; unsigned key = 0u;
                if (c < 50) { const int pij = PT[c], i = pij >> 4, j = pij & 15;
                    const float av = key2f(LST[(tl * 2 + 0) * 16 + i] & ~0x7Fu), bv = key2f(LST[(tl * 2 + 1) * 16 + j] & ~0x7Fu);
                    key = (f2key(av + bv) & ~0xFFu) | (unsigned)(255 - pij); }
                v[m] = key; }
#pragma unroll
            for (int m = 13; m < 16; ++m) v[m] = 0u;
            sort16_desc(v);
            xmerge16(v, 1); xmerge16(v, 2);
            float ev[16]; float sum = 0.f; const float mx = key2f(v[0] & ~0xFFu);
#pragma unroll
            for (int k = 0; k < 16; ++k) { ev[k] = __expf(key2f(v[k] & ~0xFFu) - mx); sum += ev[k]; }
            const float inv = 1.0f / sum;
            unsigned kk[4] = {v[0], v[1], v[2], v[3]}; float ee[4] = {ev[0], ev[1], ev[2], ev[3]};
#pragma unroll
            for (int q = 1; q < 4; ++q) { if (c4 == q) {
#pragma unroll
                for (int e = 0; e < 4; ++e) { kk[e] = v[4 * q + e]; ee[e] = ev[4 * q + e]; } } }
            const size_t ob = (size_t)(t0 + tl) * 128 + hh * 16 + 4 * c4;
            int eo[4]; float go[4], so[4];
#pragma unroll
            for (int e = 0; e < 4; ++e) { const int flat = 255 - (int)(kk[e] & 0xFFu), i = flat >> 4, j = flat & 15;
                const int ia = 127 - (int)(LST[(tl * 2 + 0) * 16 + i] & 0x7Fu), ib = 127 - (int)(LST[(tl * 2 + 1) * 16 + j] & 0x7Fu);
                eo[e] = ia * 128 + ib; }
#pragma unroll
            for (int e = 0; e < 4; ++e) { const f32x2 sc = *(const f32x2*)(SCL + 2 * eo[e]); go[e] = ee[e] * inv * sc.y; so[e] = sc.x; }
            *(u32x4*)(EID + ob) = (u32x4){(unsigned)eo[0], (unsigned)eo[1], (unsigned)eo[2], (unsigned)eo[3]};
            *(f32x4*)(GT + ob) = (f32x4){go[0], go[1], go[2], go[3]};
            *(f32x4*)(SUo + ob) = (f32x4){so[0], so[1], so[2], so[3]};
        }
        asm volatile("s_waitcnt lgkmcnt(0)" ::: "memory");
    }
    __syncthreads();
}

#define FP4X4(w, f0, f1, f2, f3) do { f0 = __builtin_amdgcn_cvt_scalef32_pk_f32_fp4((w), 1.0f, 0); f1 = __builtin_amdgcn_cvt_scalef32_pk_f32_fp4((w), 1.0f, 1); \
    f2 = __builtin_amdgcn_cvt_scalef32_pk_f32_fp4((w), 1.0f, 2); f3 = __builtin_amdgcn_cvt_scalef32_pk_f32_fp4((w), 1.0f, 3); } while (0)
__device__ __forceinline__ void phase_gather(Frame& F, int l, bool dummy = false) {
    PH_LOCALS
    const int gw = F.vcu * NWAVES + wave, NGW = F.G * NWAVES;
    bf16* Hn = dummy ? (bf16*)(F.ws + WS_DBG + 128 * MiB) : (bf16*)(F.ws + WS_H);
    const unsigned char* UT = F.ws + WS_UV + (size_t)l * NEXP * 2048;
    const unsigned char* VTb = UT + (size_t)NEXP * 1024;
    const int* EID = (const int*)(F.ws + WS_EID); const float* GT = (const float*)(F.ws + WS_GATE); const float* SU = (const float*)(F.ws + WS_SU);
    float* COEF = dummy ? (float*)(F.ws + WS_DBG + 192 * MiB) : (float*)(F.ws + WS_COEF);
    const bf16* X = (const bf16*)(F.ws + WS_X); bf16* Xo = dummy ? (bf16*)(F.ws + WS_DBG) : (bf16*)(F.ws + WS_X);
    const float* mod = (const float*)(F.ws + WS_MOD);
    const float* gate2 = mod + l * 12288 + 5 * 2048; const float* shift2 = mod + l * 12288 + 3 * 2048; const float* gs2 = (const float*)(F.ws + WS_GS) + l * DM;
    const unsigned lane16 = (unsigned)lane * 16u;
    const bool u32_ = (lane & 32) != 0, u16_ = (lane & 16) != 0, u8_ = (lane & 8) != 0, u4_ = (lane & 4) != 0;
#if GATHER_PROBE_HOT
#define G_HOT(e) if (dummy) e &= 15;
#else
#define G_HOT(e)
#endif
#define G_ROW(dst, tab, b_, h_) do { int e_ = __builtin_amdgcn_readlane((b_) < 4 ? e_lo : e_hi, (16 * (b_) + (h_)) & 63); G_HOT(e_) \
            dst = *(const u32x4*)((tab) + ((size_t)(unsigned)e_ << 10) + lane16); } while (0)
    for (int t = gw; t < M; t += NGW) {
        const int e_lo = EID[(size_t)t * 128 + lane], e_hi = EID[(size_t)t * 128 + 64 + lane];
        const float g_lo = GT[(size_t)t * 128 + lane], g_hi = GT[(size_t)t * 128 + 64 + lane];
        const float s_lo = SU[(size_t)t * 128 + lane], s_hi = SU[(size_t)t * 128 + 64 + lane];
        f32x2 hh[8][2];
        {   float s2 = 0.f; u32x2 xw[8];
#pragma unroll
            for (int j = 0; j < 8; ++j) xw[j] = *(const u32x2*)(X + (size_t)t * 2048 + j * 256 + lane * 4);
#pragma unroll
            for (int j = 0; j < 8; ++j) { hh[j][0] = (f32x2){bflo(xw[j].x), bfhi(xw[j].x)}; hh[j][1] = (f32x2){bflo(xw[j].y), bfhi(xw[j].y)};
                s2 += (hh[j][0].x * hh[j][0].x + hh[j][0].y * hh[j][0].y) + (hh[j][1].x * hh[j][1].x + hh[j][1].y * hh[j][1].y); }
            const float r2 = 1.0f / sqrtf(wave_sum(s2) * (1.0f / DM) + EPS);
#pragma unroll
            for (int j2 = 0; j2 < 8; j2 += 4) { f32x4 gsv[4], shv[4];
#pragma unroll
                for (int j = 0; j < 4; ++j) { gsv[j] = *(const f32x4*)(gs2 + (j2 + j) * 256 + lane * 4); shv[j] = *(const f32x4*)(shift2 + (j2 + j) * 256 + lane * 4); }
#pragma unroll
                for (int j = 0; j < 4; ++j) { hh[j2 + j][0] = (f32x2){hh[j2 + j][0].x * r2 * gsv[j][0] + shv[j][0], hh[j2 + j][0].y * r2 * gsv[j][1] + shv[j][1]}; hh[j2 + j][1] = (f32x2){hh[j2 + j][1].x * r2 * gsv[j][2] + shv[j][2], hh[j2 + j][1].y * r2 * gsv[j][3] + shv[j][3]}; } }
        }
        u32x4 ur[16];
#pragma unroll
        for (int h = 0; h < 16; ++h) G_ROW(ur[h], UT, 0, h);
#define G_UBATCH(b_, NEXT) { float p[16]; \
            _Pragma("unroll") for (int h = 0; h < 16; ++h) { f32x2 a2 = {0.f, 0.f}; \
                if (GATHER_PROBE_MEM && dummy) { a2.x = __builtin_bit_cast(float, ur[h][0] ^ ur[h][1] ^ ur[h][2] ^ ur[h][3]); } else { \
                _Pragma("unroll") for (int d = 0; d < 4; ++d) { f32x2 f0, f1, f2, f3; FP4X4(ur[h][d], f0, f1, f2, f3); \
                    a2 = f0 * hh[2 * d][0] + a2; a2 = f1 * hh[2 * d][1] + a2; a2 = f2 * hh[2 * d + 1][0] + a2; a2 = f3 * hh[2 * d + 1][1] + a2; } } \
                p[h] = a2.x + a2.y; if (NEXT) G_ROW(ur[h], UT, (b_) + 1, h); } \
            float a8[8]; \
            _Pragma("unroll") for (int i = 0; i < 8; ++i) { const float snd = u32_ ? p[i] : p[8 + i], kp = u32_ ? p[8 + i] : p[i]; a8[i] = kp + __shfl_xor(snd, 32); } \
            float a4[4]; \
            _Pragma("unroll") for (int i = 0; i < 4; ++i) { const float snd = u16_ ? a8[i] : a8[4 + i], kp = u16_ ? a8[4 + i] : a8[i]; a4[i] = kp + __shfl_xor(snd, 16); } \
            float b2[2]; \
            _Pragma("unroll") for (int i = 0; i < 2; ++i) { const float snd = u8_ ? a4[i] : a4[2 + i], kp = u8_ ? a4[2 + i] : a4[i]; b2[i] = kp + __shfl_xor(snd, 8); } \
            float d; { const float snd = u4_ ? b2[0] : b2[1], kp = u4_ ? b2[1] : b2[0]; d = kp + __shfl_xor(snd, 4); } \
            d += __shfl_xor(d, 2); d += __shfl_xor(d, 1);                   \
            const int hl = (16 * (b_) + (lane >> 2)) & 63; const float gsel = (b_) < 4 ? g_lo : g_hi, ssel = (b_) < 4 ? s_lo : s_hi; \
            const float coefq = __shfl(gsel, hl) * gelu_tanh(d * __shfl(ssel, hl)); \
            if ((lane & 3) == 0) COEF[(size_t)t * 128 + 16 * (b_) + (lane >> 2)] = coefq; }
#pragma unroll 1
        for (int b = 0; b < 7; ++b) G_UBATCH(b, true)
        G_UBATCH(7, false)
#undef G_UBATCH
    }
    asm volatile("s_waitcnt vmcnt(0)" ::: "memory");
    for (int t = gw; t < M; t += NGW) {
        const int e_lo = EID[(size_t)t * 128 + lane], e_hi = EID[(size_t)t * 128 + 64 + lane];
        const float c_lo = COEF[(size_t)t * 128 + lane], c_hi = COEF[(size_t)t * 128 + 64 + lane];
        u32x4 vr[16];
#pragma unroll
        for (int h = 0; h < 16; ++h) G_ROW(vr[h], VTb, 0, h);
        f32x2 of[8][2];
#pragma unroll
        for (int j = 0; j < 8; ++j) { of[j][0] = (f32x2){0.f, 0.f}; of[j][1] = (f32x2){0.f, 0.f}; }
#define G_VBATCH(b_, NEXT) { const float csel = (b_) < 4 ? c_lo : c_hi; \
            _Pragma("unroll") for (int h = 0; h < 16; ++h) { const float cf = __builtin_bit_cast(float, __builtin_amdgcn_readlane(__builtin_bit_cast(int, csel), (16 * (b_) + h) & 63)); const f32x2 cf2 = {cf, cf}; \
                if (GATHER_PROBE_MEM && dummy) { of[0][0].x += cf * __builtin_bit_cast(float, vr[h][0] ^ vr[h][1] ^ vr[h][2] ^ vr[h][3]); } else { \
                _Pragma("unroll") for (int dd = 0; dd < 4; ++dd) { f32x2 f0, f1, f2, f3; FP4X4(vr[h][dd], f0, f1, f2, f3); \
                    of[2 * dd][0] = f0 * cf2 + of[2 * dd][0]; of[2 * dd][1] = f1 * cf2 + of[2 * dd][1]; of[2 * dd + 1][0] = f2 * cf2 + of[2 * dd + 1][0]; of[2 * dd + 1][1] = f3 * cf2 + of[2 * dd + 1][1]; } } \
                if (NEXT) G_ROW(vr[h], VTb, (b_) + 1, h); } }
#pragma unroll 1
        for (int b = 0; b < 7; ++b) G_VBATCH(b, true)
        G_VBATCH(7, false)
#undef G_VBATCH
        int ln = lane; asm volatile("" : "+v"(ln));
        u32x2 cx[8];
#pragma unroll
        for (int j = 0; j < 8; ++j) cx[j] = *(const u32x2*)(X + (size_t)t * 2048 + j * 256 + ln * 4);
        f32x4 xv[8]; float ss = 0.f;
#pragma unroll
        for (int j2 = 0; j2 < 8; j2 += 4) { f32x4 g2v[4];
#pragma unroll
            for (int j = 0; j < 4; ++j) g2v[j] = *(const f32x4*)(gate2 + (j2 + j) * 256 + ln * 4);
#pragma unroll
            for (int jj = 0; jj < 4; ++jj) { const int j = j2 + jj;
                const f32x4 xo = {bflo(cx[j].x), bfhi(cx[j].x), bflo(cx[j].y), bfhi(cx[j].y)};
                const f32x4 o = {of[j][0].x, of[j][0].y, of[j][1].x, of[j][1].y};
                xv[j] = xo + g2v[jj] * o;
                ss += (xv[j][0] * xv[j][0] + xv[j][1] * xv[j][1]) + (xv[j][2] * xv[j][2] + xv[j][3] * xv[j][3]); } }
        const float rr = 1.0f / sqrtf(wave_sum(ss) * (1.0f / DM) + EPS);
        if (l + 1 < DEPTH) {
            const float* m2 = mod + (l + 1) * 12288; const float* gain = F.in[I_N1G] + (l + 1) * 2048;
#pragma unroll
            for (int j2 = 0; j2 < 8; j2 += 4) { f32x4 gv[4], scv[4], shv[4];
#pragma unroll
                for (int j = 0; j < 4; ++j) { const int c = (j2 + j) * 256 + ln * 4; gv[j] = *(const f32x4*)(gain + c); scv[j] = *(const f32x4*)(m2 + 2048 + c); shv[j] = *(const f32x4*)(m2 + c); }
#pragma unroll
                for (int jj = 0; jj < 4; ++jj) { const int j = j2 + jj, c = j * 256 + ln * 4;
                    *(u32x2*)(Xo + (size_t)t * 2048 + c) = (u32x2){pk2(xv[j][0], xv[j][1]), pk2(xv[j][2], xv[j][3])};
                    const f32x4 y = xv[j] * rr * gv[jj] * (scv[jj] + 1.0f) + shv[jj];
                    *(u32x2*)(Hn + (size_t)t * 2048 + c) = (u32x2){pk2(y[0], y[1]), pk2(y[2], y[3])}; } }
        } else {
#pragma unroll
            for (int j = 0; j < 8; ++j) { const int c = j * 256 + ln * 4; const f32x4 fgv = *(const f32x4*)(F.in[I_FG] + c);
                f32x4 ov = xv[j] * rr * fgv;
#if SELFTEST_S5
                if (__hip_atomic_load((unsigned*)(F.ws + WS_CTL) + CW_FLAG, RLX_AGENT) != 0u) ov = (f32x4){1e30f, 1e30f, 1e30f, 1e30f};
#endif
                *(f32x4*)(F.out + (size_t)t * 2048 + c) = ov; }
        }
    }
}

__global__ void __launch_bounds__(NTHR, 2) fwd_kernel(Args args) {
    extern __shared__ __attribute__((aligned(16))) unsigned char lds_raw[];
    Frame F;
    F.lds = (LAS unsigned char*)lds_raw; F.ws = args.ws; F.in = args.in; F.out = args.out;
    F.tid = threadIdx.x; F.lane = F.tid & 63; F.wave = __builtin_amdgcn_readfirstlane(F.tid >> 6);
    F.G = gridDim.x; { const int bx = blockIdx.x; F.vcu = (F.G % 8 == 0) ? (bx % 8) * (F.G / 8) + bx / 8 : bx; }
    volatile LAS unsigned* MISC = (volatile LAS unsigned*)(F.lds + MISC_OFF);
    if (F.tid < 64) MISC[F.tid] = 0u;
    __syncthreads();
    unsigned* ctl = (unsigned*)(F.ws + WS_CTL);
    XcdBarrier bar; bar.bar = ctl + CW_BAR; bar.x = 0; bar.st = nullptr;
#if !MK_PER_PHASE
    bar = xcd_barrier_post(ctl + CW_BAR, MISC + 8);
#endif
    const int lo = args.ph_lo, hi = args.ph_hi;
#define IN(k) (lo <= (k) && (k) < hi)
#if MK_PER_PHASE
#define SEAM(k) do { } while (0)
#else
#define SEAM(k) do { if (IN(k) && IN((k) + 1)) xcd_barrier(bar); } while (0)
#endif
    const float* mod = (const float*)(F.ws + WS_MOD);

#define REP(k) (REPEAT_PH == (k))
#define RUN2(k, first, real) do { if (REP(k)) { first; xcd_barrier(bar); } real; } while (0)
    if (IN(0)) { RUN2(13, p0_tables(F, 5, true), p0_tables(F, 4, false)); } SEAM(0);
    for (int l = 0; l < DEPTH; ++l) {
        const int pb = 1 + 12 * l;
        const float* ml = mod + l * 12288;
        if (IN(pb + 0)) { if (l == 0) { RUN2(0, p0_prologue(F), p0_prologue(F)); RUN2(1, phase_norm<false>(F, F.in[I_X], F.in[I_N1G] + l * 2048, ml + 1 * 2048, ml + 0 * 2048), phase_norm<false>(F, F.in[I_X], F.in[I_N1G] + l * 2048, ml + 1 * 2048, ml + 0 * 2048)); } } SEAM(pb + 0);
        if (IN(pb + 1)) {
            pg8::Gemm g{(const bf16*)(F.ws + WS_H), (const bf16*)(F.ws + WS_WIN) + (size_t)l * INW * DM, M, INW, DM}; pg8::StaticOrder S; S.init(M, INW, F.G, (int)blockIdx.x);
            EpiIn E{(bf16*)(F.ws + WS_Z), (bf16*)(F.ws + WS_XS), F.in[I_BIN] + l * INW, (float*)(F.ws + WS_PLN)};
#define GEMM_IN pg8::gemm_phase<EpiIn, pg8::StaticOrder, true, true>(F.lds, g, S, E)
            RUN2(2, GEMM_IN, GEMM_IN);
        } SEAM(pb + 1);
        if (IN(pb + 2)) { RUN2(3, phase_sloc(F, l), phase_sloc(F, l)); } SEAM(pb + 2);
        if (IN(pb + 3)) { RUN2(5, phase_s5out(F, l), phase_s5out(F, l)); RUN2(4, phase_gating(F, l), phase_gating(F, l));
#if SELFTEST_S5
            xcd_barrier(bar); selftest_s5(F, l);
#endif
        } SEAM(pb + 4);
        if (IN(pb + 5)) {
            pg8::Gemm g{(const bf16*)(F.ws + WS_G), (const bf16*)(F.ws + WS_GLU) + (size_t)l * WB * WB, M, WB, WB}; pg8::StaticOrder S; S.init(M, WB, F.G, (int)blockIdx.x);
            EpiGlu E{(const bf16*)(F.ws + WS_G), (bf16*)(F.ws + WS_MIX), F.in[I_GLUB] + l * WB, (float*)(F.ws + WS_PSB)};
#define GEMM_GLU pg8::gemm_phase<EpiGlu, pg8::StaticOrder, true, true>(F.lds, g, S, E)
            RUN2(6, GEMM_GLU, GEMM_GLU);
        } SEAM(pb + 6);
        if (IN(pb + 7)) {
            pg8::Gemm g{(const bf16*)(F.ws + WS_MIX), (const bf16*)(F.ws + WS_WOUT) + (size_t)l * DM * DM, M, DM, DM}; pg8::StaticOrder S; S.init(M, DM, F.G, (int)blockIdx.x);
            LAS float* ratL = (LAS float*)(F.lds + 132096); LAS float* rbL = (LAS float*)(F.lds + 134144);
            pg8::Unit u0, u1; const bool h0 = S.next(0, u0), h1 = S.next(1, u1);
            {   int t2 = F.tid; asm volatile("" : "+v"(t2));
                for (int sl = 0; sl < 2; ++sl) { const bool on = sl == 0 ? h0 : (h1 && u1.pm != u0.pm); const int pmx = sl == 0 ? u0.pm : u1.pm;
                    if (on && t2 < 256) { const size_t row = (size_t)pmx * 256 + t2; float sa = 0.f, sb = 0.f;
                        const float* pa = (const float*)(F.ws + WS_PSA) + row * 8; const float* pb_ = (const float*)(F.ws + WS_PSB) + row * 16;
#pragma unroll
                        for (int i = 0; i < 2; ++i) { const f32x4 v = *(const f32x4*)(pa + 4 * i); sa += (v[0] + v[1]) + (v[2] + v[3]); }
#pragma unroll
                        for (int i = 0; i < 4; ++i) { const f32x4 v = *(const f32x4*)(pb_ + 4 * i); sb += (v[0] + v[1]) + (v[2] + v[3]); }
                        const float ra = 1.0f / sqrtf(sa * (1.0f / 1024.0f) + EPS), rb = 1.0f / sqrtf(sb * (1.0f / 1024.0f) + EPS);
                        ratL[sl * 256 + t2] = ra / rb; rbL[sl * 256 + t2] = rb; } } }
            __syncthreads();
            const int pm0 = h0 ? u0.pm : -1;
            if (l == 0) { EpiOut<false> E{(const void*)F.in[I_X], (bf16*)(F.ws + WS_X), ml + 2 * 2048, (float*)(F.ws + WS_PS), ratL, rbL, pm0}; EpiOut<false> Ed{(const void*)F.in[I_X], (bf16*)(F.ws + WS_DBG), ml + 2 * 2048, (float*)(F.ws + WS_DBG + 128 * MiB), ratL, rbL, pm0};
#define GEMM_OUT0(EE) pg8::gemm_phase<EpiOut<false>, pg8::StaticOrder, true, true>(F.lds, g, S, EE)
                RUN2(8, GEMM_OUT0(Ed), GEMM_OUT0(E)); }
            else { EpiOut<true> E{(const void*)(F.ws + WS_X), (bf16*)(F.ws + WS_X), ml + 2 * 2048, (float*)(F.ws + WS_PS), ratL, rbL, pm0}; EpiOut<true> Ed{(const void*)(F.ws + WS_X), (bf16*)(F.ws + WS_DBG), ml + 2 * 2048, (float*)(F.ws + WS_DBG + 128 * MiB), ratL, rbL, pm0};
#define GEMM_OUT1(EE) pg8::gemm_phase<EpiOut<true>, pg8::StaticOrder, true, true>(F.lds, g, S, EE)
                RUN2(8, GEMM_OUT1(Ed), GEMM_OUT1(E)); }
        }
        SEAM(pb + 8);
        if (IN(pb + 9)) {
            pg8::Gemm g{(const bf16*)(F.ws + WS_X), (const bf16*)(F.ws + WS_WQ) + (size_t)l * DM * DM, M, DM, DM}; pg8::StaticOrder S; S.init(M, DM, F.G, (int)blockIdx.x);
            LAS float* rrL = (LAS float*)(F.lds + 132096);
            pg8::Unit u0, u1; const bool h0 = S.next(0, u0), h1 = S.next(1, u1);
            { int t2 = F.tid; asm volatile("" : "+v"(t2)); if (h0) fill_rr(F, rrL, 0, u0.pm, t2); if (h1 && u1.pm != u0.pm) fill_rr(F, rrL, 1, u1.pm, t2); }
            __syncthreads();
            EpiQ E{(bf16*)(F.ws + WS_Z), (const float*)(F.ws + WS_C0) + (size_t)l * 4 * DM, rrL, h0 ? u0.pm : -1};
#define GEMM_Q pg8::gemm_phase<EpiQ, pg8::StaticOrder, true, true>(F.lds, g, S, E)
            RUN2(10, GEMM_Q, GEMM_Q);
        } SEAM(pb + 9);
        if (IN(pb + 10)) { RUN2(11, phase_topk(F, l), phase_topk(F, l)); } SEAM(pb + 10);
        if (IN(pb + 11)) { RUN2(12, phase_gather(F, l, true), phase_gather(F, l, false)); } SEAM(pb + 11);
    }
#undef IN
#undef SEAM
}

extern "C" void kernel_launch(void* const* d_in, const int* in_sizes, int n_in, void* d_out, int out_size, void* d_ws, size_t ws_size, hipStream_t stream) {
    static int grid = 0;
    if (grid == 0) {
        if (n_in != 29 || out_size != M * DM || ws_size < WS_END) { fprintf(stderr, "kernel_launch: unexpected shapes (n_in %d, out %d, ws %zu); nothing launched\n", n_in, out_size, ws_size); grid = -1; return; }
        int dev = 0, cus = 0;
        if (hipGetDevice(&dev) != hipSuccess || hipDeviceGetAttribute(&cus, hipDeviceAttributeMultiprocessorCount, dev) != hipSuccess) { grid = -1; return; }
        if (hipFuncSetAttribute((const void*)fwd_kernel, hipFuncAttributeMaxDynamicSharedMemorySize, LDS_BYTES) != hipSuccess) { fprintf(stderr, "kernel_launch: hipFuncSetAttribute failed\n"); grid = -1; return; }
        (void)hipGetLastError();
        grid = cus < 256 ? cus : 256;
    }
    if (grid < 0) return;
    (void)hipMemsetAsync((char*)d_ws + WS_CTL, 0, CTL_ZERO_BYTES, stream);
    Args a{};
    for (int i = 0; i < 29; ++i) a.in[i] = (const float*)d_in[i];
    a.out = (float*)d_out; a.ws = (unsigned char*)d_ws;
#if MK_PER_PHASE
    for (int p = 0; p < 1 + 12 * DEPTH; ++p) {
        if (p == 13) continue;
        a.ph_lo = p; a.ph_hi = p + 1; a.li = p;
        hipLaunchKernelGGL(fwd_kernel, dim3(grid), dim3(NTHR), LDS_BYTES, stream, a);
    }
#else
    a.ph_lo = 0; a.ph_hi = 1 + 12 * DEPTH; a.li = 0;
    hipLaunchKernelGGL(fwd_kernel, dim3(grid), dim3(NTHR), LDS_BYTES, stream, a);
#endif
}
```

```cpp
#include <hip/hip_runtime.h>
#include <cstdio>
#include <cstdint>

#ifndef SELFTEST_S5
#define SELFTEST_S5 0
#endif
#ifndef REPEAT_PH
#define REPEAT_PH -1
#endif
#ifndef GATHER_PROBE_MEM
#define GATHER_PROBE_MEM 0
#endif
#ifndef GATHER_PROBE_HOT
#define GATHER_PROBE_HOT 0
#endif
#ifndef MK_PER_PHASE
#define MK_PER_PHASE 0
#endif

#define GAS __attribute__((address_space(1)))
#define LAS __attribute__((address_space(3)))
typedef unsigned short bf16;
typedef short bf16x8 __attribute__((ext_vector_type(8)));
typedef float f32x4 __attribute__((ext_vector_type(4)));
typedef float f32x2 __attribute__((ext_vector_type(2)));
typedef unsigned u32x4 __attribute__((ext_vector_type(4)));
typedef unsigned u32x2 __attribute__((ext_vector_type(2)));

constexpr int DM = 2048, SEQ = 16384, DEPTH = 2, M = SEQ;
constexpr int WA = 1024, WB = 1024, INW = 3072;
constexpr int NG = 64, NCH = 256;
constexpr int NEXP = 16384;
constexpr float EPS = 1e-6f;
constexpr int NWAVES = 8, NTHR = 512;

namespace pg8 {
#define PG8_LAS __attribute__((address_space(3)))
constexpr int BM = 256, BK = 64, HALF = 128, HTB = HALF * BK * 2, STAGE_BYTES = 8 * HTB, NXCD = 8, WGM = 4;
__host__ __device__ __forceinline__ int lds_byte(int r, int c) { const int st = (r >> 4) * 2 + (c >> 5), rr = r & 15, cc = c & 31, ob = rr * 64 + cc * 2; return st * 1024 + (ob ^ (((ob >> 9) & 1) << 5)); }
__host__ __device__ __forceinline__ void stage_rc(int b, int& R, int& C) { const int st = b / 1024, sb = b % 1024, swz = sb ^ (((sb >> 9) & 1) << 5); R = (st >> 1) * 16 + swz / 64; C = (st & 1) * 32 + (swz % 64) / 2; }
__host__ __device__ __forceinline__ int perm32(int rho) { const int n = rho >> 4, i = rho & 15; return 8 * (i >> 2) + 4 * n + (i & 3); }
struct Unit { int pm, pn; };
struct Gemm { const bf16* A; const bf16* Bt; int M, N, K; };
struct StaticOrder {
    int nM, nN, nwg, G, c;
    __host__ __device__ __forceinline__ void init(int M_, int N_, int G_, int c_) { nM = M_ / BM; nN = N_ / BM; nwg = nM * nN; G = G_; c = c_; }
    __host__ __device__ __forceinline__ bool next(int i, Unit& u) const {
        const long L = (long)i * G + c; if (L >= nwg) return false;
        int wgid = (int)L; { const int q = nwg / NXCD, r = nwg % NXCD, xcd = wgid % NXCD, off = wgid / NXCD; wgid = (xcd < r ? xcd * (q + 1) : r * (q + 1) + (xcd - r) * q) + off; }
        const int nig = WGM * nN, gid = wgid / nig, fm = gid * WGM, gsz = (nM - fm) < WGM ? (nM - fm) : WGM;
        u.pm = fm + ((wgid % nig) % gsz); u.pn = (wgid % nig) / gsz; return true;
    }
    __device__ __forceinline__ void a_ready(const Unit&) const {}
    __device__ __forceinline__ void done(const Unit&) const {}
};
__device__ __forceinline__ unsigned cvt_pk_bf16(float lo, float hi) { unsigned r; asm volatile("v_cvt_pk_bf16_f32 %0, %1, %2" : "=v"(r) : "v"(lo), "v"(hi)); return r; }

typedef int i32x4_t __attribute__((ext_vector_type(4)));
typedef int i32x8_t __attribute__((ext_vector_type(8)));
__device__ __forceinline__ f32x4 mma16_f8(const bf16x8& b0, const bf16x8& b1, const bf16x8& a0, const bf16x8& a1, const f32x4& c) {
    const i32x8_t bb = __builtin_shufflevector(__builtin_bit_cast(i32x4_t, b0), __builtin_bit_cast(i32x4_t, b1), 0, 1, 2, 3, 4, 5, 6, 7);
    const i32x8_t aa = __builtin_shufflevector(__builtin_bit_cast(i32x4_t, a0), __builtin_bit_cast(i32x4_t, a1), 0, 1, 2, 3, 4, 5, 6, 7);
    return __builtin_amdgcn_mfma_scale_f32_16x16x128_f8f6f4(bb, aa, c, 0, 0, 0, 0x7F7F7F7F, 0, 0x7F7F7F7F);
}
template <bool I8>
__device__ __forceinline__ f32x4 mma16(const bf16x8& b, const bf16x8& a, const f32x4& c) {
    if constexpr (I8) return __builtin_bit_cast(f32x4, __builtin_amdgcn_mfma_i32_16x16x64_i8(__builtin_bit_cast(i32x4_t, b), __builtin_bit_cast(i32x4_t, a), __builtin_bit_cast(i32x4_t, c), 0, 0, 0));
    else return __builtin_amdgcn_mfma_f32_16x16x32_bf16(b, a, c, 0, 0, 0);
}
template <class Epi, class Sched, bool ALIGN_EPI = false, bool SP2 = false, bool I8 = false, bool F8 = false>
__device__ __forceinline__ void gemm_phase(PG8_LAS unsigned char* lds, const Gemm g, const Sched& S, const Epi& E) {
    int tid = threadIdx.x; asm volatile("" : "+v"(tid)); const int wid = __builtin_amdgcn_readfirstlane(tid >> 6), lane = tid & 63, wr = wid >> 2, wc = wid & 3, fr = lane & 15, fq = lane >> 4;
    const int K = g.K, nt = K / BK;
    unsigned voffA[2], voffB[2];
#pragma unroll
    for (int i = 0; i < 2; ++i) { int R, C; stage_rc(tid * 16 + i * 8192, R, C); const int Rb = Epi::PERM ? ((R & ~31) + perm32(R & 31)) : R;
        voffA[i] = (unsigned)(R * K + C) * 2u; voffB[i] = (unsigned)(Rb * K + C) * 2u; }
    const size_t kstep = (size_t)(BK * 2);
    const size_t hstep = (size_t)HALF * K * 2;
    const size_t tstep = 2 * hstep;
    const unsigned ldsw = (unsigned)wid * 1024u;
    const int aoff = lds_byte(wr * 64 + fr, fq * 8), boff = lds_byte(wc * 32 + fr, fq * 8);
#define PG8_SA(b, h) (((b) * 2 + (h)) * HTB)
#define PG8_SB(b, h) ((4 + (b) * 2 + (h)) * HTB)
#define PG8_STAGE(bufoff, gbase, voff) do { _Pragma("unroll") for (int _i = 0; _i < 2; ++_i) { unsigned vo_ = (voff)[_i]; if constexpr (F8) asm volatile("" : "+v"(vo_));     \
        __builtin_amdgcn_global_load_lds((const unsigned*)((const char*)(gbase) + vo_), (PG8_LAS unsigned*)(lds + (bufoff) + ldsw + _i * 8192), 16, 0, 0); } } while (0)
#define PG8_LDA(dst, b, h) do { _Pragma("unroll") for (int m = 0; m < 4; ++m) _Pragma("unroll") for (int k = 0; k < 2; ++k) dst[m][k] = *(const PG8_LAS bf16x8*)(lds + PG8_SA(b, h) + aoff + m * 2048 + k * 1024); } while (0)
#define PG8_LDB(dst, b, h) do { _Pragma("unroll") for (int n = 0; n < 2; ++n) _Pragma("unroll") for (int k = 0; k < 2; ++k) dst[n][k] = *(const PG8_LAS bf16x8*)(lds + PG8_SB(b, h) + boff + n * 2048 + k * 1024); } while (0)
#define PG8_MMA(ai, bj, At, Bt) do { __builtin_amdgcn_s_setprio(1); _Pragma("unroll") for (int m = 0; m < 4; ++m) _Pragma("unroll") for (int n = 0; n < 2; ++n) { \
        if constexpr (F8) acc[ai][bj][m][n] = mma16_f8(Bt[n][0], Bt[n][1], At[m][0], At[m][1], acc[ai][bj][m][n]); \
        else { _Pragma("unroll") for (int k = 0; k < 2; ++k) acc[ai][bj][m][n] = mma16<I8>(Bt[n][k], At[m][k], acc[ai][bj][m][n]); } } __builtin_amdgcn_s_setprio(0); } while (0)
#define PG8_WAIT_V(n) asm volatile("s_waitcnt vmcnt(" #n ")" ::: "memory")
#define PG8_WAIT_L(n) asm volatile("s_waitcnt lgkmcnt(" #n ")" ::: "memory")
#define PG8_BAR __builtin_amdgcn_s_barrier()
#define PG8_SCHED __builtin_amdgcn_sched_barrier(0)
    Unit cur, nxt; int ui = 0;
    if (!S.next(0, cur)) return;
    f32x4 acc[2][2][4][2];
#pragma unroll
    for (int a = 0; a < 2; ++a)
#pragma unroll
        for (int b = 0; b < 2; ++b)
#pragma unroll
            for (int m = 0; m < 4; ++m)
#pragma unroll
                for (int n = 0; n < 2; ++n) acc[a][b][m][n] = (f32x4){0.f, 0.f, 0.f, 0.f};
    bf16x8 At[4][2], B0[2][2], B1[2][2];
    const char* cA = (const char*)g.A + (size_t)cur.pm * tstep; const char* cB = (const char*)g.Bt + (size_t)cur.pn * tstep;
    S.a_ready(cur);
    if constexpr (SP2) {
        PG8_STAGE(PG8_SB(0, 0), cB, voffB); PG8_STAGE(PG8_SB(0, 1), cB + hstep, voffB); PG8_STAGE(PG8_SA(0, 0), cA, voffA); PG8_STAGE(PG8_SA(0, 1), cA + hstep, voffA);
        if (wr == 1) PG8_BAR;
        PG8_WAIT_V(2); PG8_BAR;
        PG8_STAGE(PG8_SB(1, 0), cB + kstep, voffB); PG8_STAGE(PG8_SA(1, 0), cA + kstep, voffA); PG8_STAGE(PG8_SB(1, 1), cB + hstep + kstep, voffB);
        PG8_WAIT_V(6); PG8_BAR;
    } else {
        PG8_STAGE(PG8_SB(0, 0), cB, voffB); PG8_STAGE(PG8_SA(0, 0), cA, voffA); PG8_STAGE(PG8_SB(0, 1), cB + hstep, voffB); PG8_STAGE(PG8_SA(0, 1), cA + hstep, voffA);
        if (wr == 1) PG8_BAR;
        PG8_WAIT_V(4); PG8_BAR;
        PG8_STAGE(PG8_SB(1, 0), cB + kstep, voffB); PG8_STAGE(PG8_SA(1, 0), cA + kstep, voffA); PG8_STAGE(PG8_SB(1, 1), cB + hstep + kstep, voffB);
        PG8_WAIT_V(6); PG8_BAR;
    }
    for (;;) {
        const bool has_next = S.next(ui + 1, nxt);
        const char* nA = has_next ? (const char*)g.A + (size_t)nxt.pm * tstep : cA; const char* nB = has_next ? (const char*)g.Bt + (size_t)nxt.pn * tstep : cB;
        asm volatile(".p2align 8" ::: "memory");
        for (int t = 0; t < nt; t += 2) {
            const bool last = (t == nt - 2);
            const char* a1 = cA + (size_t)(t + 1) * kstep;
            const char* a2 = last ? nA : cA + (size_t)(t + 2) * kstep; const char* b2 = last ? nB : cB + (size_t)(t + 2) * kstep;
            const char* a3 = a2 + kstep; const char* b3 = b2 + kstep;
            if (last && has_next) S.a_ready(nxt);
            if constexpr (Epi::KSPLIT) { if (t == nt / 2) { int tm_ = threadIdx.x; asm volatile("" : "+v"(tm_)); E.midscale(acc, cur, wr, tm_ & 15); } }
            if constexpr (SP2) {
            PG8_LDB(B0, 0, 0); PG8_LDB(B1, 0, 1); PG8_SCHED; PG8_LDA(At, 0, 0); PG8_STAGE(PG8_SA(1, 1), a1 + hstep, voffA);
            PG8_WAIT_V(8); PG8_WAIT_L(0); PG8_BAR; PG8_MMA(0, 0, At, B0); PG8_MMA(0, 1, At, B1); PG8_BAR; PG8_SCHED;
            PG8_LDA(At, 0, 1); PG8_STAGE(PG8_SB(0, 0), b2, voffB); PG8_STAGE(PG8_SB(0, 1), b2 + hstep, voffB); PG8_STAGE(PG8_SA(0, 0), a2, voffA);
            PG8_WAIT_V(8); PG8_WAIT_L(0); PG8_BAR; PG8_MMA(1, 0, At, B0); PG8_MMA(1, 1, At, B1); PG8_BAR; PG8_SCHED;
            PG8_LDB(B0, 1, 0); PG8_LDB(B1, 1, 1); PG8_SCHED; PG8_LDA(At, 1, 0); PG8_STAGE(PG8_SA(0, 1), a2 + hstep, voffA);
            PG8_WAIT_V(8); PG8_WAIT_L(0); PG8_BAR; PG8_MMA(0, 0, At, B0); PG8_MMA(0, 1, At, B1); PG8_BAR; PG8_SCHED;
            PG8_LDA(At, 1, 1); PG8_STAGE(PG8_SB(1, 0), b3, voffB); PG8_STAGE(PG8_SB(1, 1), b3 + hstep, voffB); PG8_STAGE(PG8_SA(1, 0), a3, voffA);
            PG8_WAIT_V(8); PG8_WAIT_L(0); PG8_BAR; PG8_MMA(1, 0, At, B0); PG8_MMA(1, 1, At, B1); PG8_BAR; PG8_SCHED;
            } else {
            PG8_LDB(B0, 0, 0); PG8_SCHED; PG8_LDA(At, 0, 0); PG8_STAGE(PG8_SA(1, 1), a1 + hstep, voffA);
            PG8_WAIT_L(8); PG8_BAR; PG8_WAIT_L(0); PG8_MMA(0, 0, At, B0); PG8_BAR; PG8_SCHED;
            PG8_LDB(B1, 0, 1); PG8_STAGE(PG8_SB(0, 0), b2, voffB);
            PG8_BAR; PG8_WAIT_L(0); PG8_MMA(0, 1, At, B1); PG8_BAR;
            PG8_LDA(At, 0, 1); PG8_STAGE(PG8_SA(0, 0), a2, voffA);
            PG8_BAR; PG8_WAIT_L(0); PG8_MMA(1, 0, At, B0); PG8_BAR; PG8_SCHED;
            PG8_STAGE(PG8_SB(0, 1), b2 + hstep, voffB);
            PG8_WAIT_V(6); PG8_BAR; PG8_MMA(1, 1, At, B1); PG8_BAR;
            PG8_LDB(B0, 1, 0); PG8_SCHED; PG8_LDA(At, 1, 0); PG8_STAGE(PG8_SA(0, 1), a2 + hstep, voffA);
            PG8_WAIT_L(8); PG8_BAR; PG8_WAIT_L(0); PG8_MMA(0, 0, At, B0); PG8_BAR; PG8_SCHED;
            PG8_LDB(B1, 1, 1); PG8_STAGE(PG8_SB(1, 0), b3, voffB);
            PG8_BAR; PG8_WAIT_L(0); PG8_MMA(0, 1, At, B1); PG8_BAR;
            PG8_LDA(At, 1, 1); PG8_STAGE(PG8_SA(1, 0), a3, voffA);
            PG8_BAR; PG8_WAIT_L(0); PG8_MMA(1, 0, At, B0); PG8_BAR; PG8_SCHED;
            PG8_STAGE(PG8_SB(1, 1), b3 + hstep, voffB);
            PG8_WAIT_V(6); PG8_BAR; PG8_MMA(1, 1, At, B1); PG8_BAR;
            }
        }
        if constexpr (ALIGN_EPI) { if (wr == 0) PG8_BAR; }
        { int te_ = threadIdx.x; asm volatile("" : "+v"(te_)); const int le_ = te_ & 63;
          E(acc, cur, wr, wc, le_ & 15, le_ >> 4); } S.done(cur);
        if (!has_next) break;
#pragma unroll
        for (int a = 0; a < 2; ++a)
#pragma unroll
            for (int b = 0; b < 2; ++b)
#pragma unroll
                for (int m = 0; m < 4; ++m)
#pragma unroll
                    for (int n = 0; n < 2; ++n) acc[a][b][m][n] = (f32x4){0.f, 0.f, 0.f, 0.f};
        cur = nxt; cA = nA; cB = nB; ++ui;
        if constexpr (ALIGN_EPI) { if (wr == 1) PG8_BAR; }
    }
    PG8_WAIT_V(0);
    if constexpr (!ALIGN_EPI) { if (wr == 0) PG8_BAR; }
    PG8_BAR;
#undef PG8_SA
#undef PG8_SB
#undef PG8_STAGE
#undef PG8_LDA
#undef PG8_LDB
#undef PG8_MMA
#undef PG8_WAIT_V
#undef PG8_WAIT_L
#undef PG8_BAR
#undef PG8_SCHED
}
}

__device__ __forceinline__ unsigned f2bf(float f) { unsigned u = __builtin_bit_cast(unsigned, f); return (u + 0x7fffu + ((u >> 16) & 1u)) >> 16; }
__device__ __forceinline__ unsigned pk2(float lo, float hi) { return f2bf(lo) | (f2bf(hi) << 16); }
__device__ __forceinline__ float bflo(unsigned w) { return __builtin_bit_cast(float, w << 16); }
__device__ __forceinline__ float bfhi(unsigned w) { return __builtin_bit_cast(float, w & 0xffff0000u); }
__device__ __forceinline__ float fast_sigmoid(float t) { return __builtin_amdgcn_rcpf(1.0f + __builtin_amdgcn_exp2f(-1.44269504089f * t)); }
__device__ __forceinline__ float gelu_tanh(float x) { const float t = x * (-2.3022081981f - 0.1029432396f * x * x); return x * __builtin_amdgcn_rcpf(1.0f + __builtin_amdgcn_exp2f(t)); }
__device__ __forceinline__ float wave_sum(float v) {
#pragma unroll
    for (int o = 1; o < 64; o <<= 1) v += __shfl_xor(v, o);
    return v;
}
#define LDS_WAIT() asm volatile("s_waitcnt lgkmcnt(0)" ::: "memory")
#define VM_WAIT() asm volatile("s_waitcnt vmcnt(0)" ::: "memory")
#define RLX_AGENT __ATOMIC_RELAXED, __HIP_MEMORY_SCOPE_AGENT

constexpr size_t MiB = 1u << 20;
constexpr size_t WS_CTL = 0, CTL_ZERO_BYTES = 1 * MiB;
constexpr size_t WS_MOD   = 512 * 1024;
constexpr size_t WS_AT    = 1 * MiB + 128 * 1024;
constexpr size_t WS_STATS = WS_AT + 128 * 1024;
constexpr size_t WS_SCL   = 1 * MiB + 512 * 1024;
constexpr size_t WS_GS    = 1 * MiB + 768 * 1024;
constexpr size_t WS_C0    = WS_GS + 16 * 1024;
constexpr size_t WS_KEYS  = 2 * MiB;
constexpr size_t WS_GWS   = 3 * MiB;
constexpr size_t WS_WIN   = 4 * MiB;
constexpr size_t WS_GLU   = 28 * MiB;
constexpr size_t WS_WOUT  = 32 * MiB;
constexpr size_t WS_WQ    = 48 * MiB;
constexpr size_t WS_KTAB  = 64 * MiB;
constexpr size_t WS_WG    = 72 * MiB;
constexpr size_t WS_VG    = 104 * MiB;
constexpr size_t WS_UV    = 136 * MiB;
constexpr size_t WS_WIN8  = 200 * MiB;
constexpr size_t WS_WSCL  = 216 * MiB;
constexpr size_t WS_HSCL  = 217 * MiB;
constexpr size_t WS_X8    = 224 * MiB;
constexpr size_t WS_WQ8   = 256 * MiB;
constexpr size_t WS_WQSCL = 264 * MiB;
constexpr size_t WS_SX    = 265 * MiB;
constexpr size_t WS_WO8   = 266 * MiB;
constexpr size_t WS_WOSCL = 274 * MiB;
constexpr size_t WS_WGL8  = 292 * MiB;
constexpr size_t WS_WGLSCL = 294 * MiB;
constexpr size_t WS_X     = 392 * MiB;
constexpr size_t WS_H     = 520 * MiB;
constexpr size_t WS_Z     = 584 * MiB;
constexpr size_t WS_XS    = 648 * MiB;
constexpr size_t WS_SLOC  = 680 * MiB;
constexpr size_t WS_PS    = 688 * MiB;
constexpr size_t WS_PSA   = 690 * MiB;
constexpr size_t WS_PSB   = 691 * MiB;
constexpr size_t WS_PLN   = 692 * MiB;
constexpr size_t WS_HS    = 694 * MiB;
constexpr size_t WS_G     = 696 * MiB;
constexpr size_t WS_MIX   = 728 * MiB;
constexpr size_t WS_EID   = 792 * MiB;
constexpr size_t WS_GATE  = 800 * MiB;
constexpr size_t WS_SU    = 808 * MiB;
constexpr size_t WS_COEF  = 816 * MiB;
constexpr size_t WS_END   = 824 * MiB;
constexpr size_t WS_DBG   = 824 * MiB;
constexpr int CW_BAR = 4096;
constexpr int CW_FLAG = 2048;
constexpr int CW_QUEUE = 16384;

constexpr int LDS_BYTES = 163840;
constexpr int MISC_OFF = LDS_BYTES - 256;

#define XB_TMO      128
#define XB_XCNT(j)  (256  + 64 * (j))
#define XB_XSUB(j)  (1280 + 64 * (j))
#define XB_XGEN(j)  (2304 + 64 * (j))
#define XB_TOP      3328
#define XB_TOPGEN   3392
#define XCD_BAR_WORDS 3456
#define XB_SPIN_CAP (1u << 24)
__device__ __forceinline__ unsigned xb_ld(unsigned* p)              { return __hip_atomic_load(p, __ATOMIC_RELAXED, __HIP_MEMORY_SCOPE_AGENT); }
__device__ __forceinline__ unsigned xb_add(unsigned* p, unsigned v) { return __hip_atomic_fetch_add(p, v, __ATOMIC_RELAXED, __HIP_MEMORY_SCOPE_AGENT); }
__device__ __forceinline__ unsigned xb_xcc_id() { return (unsigned)__builtin_amdgcn_s_getreg((3 << 11) | 20) & 0xFu; }
#define XB_SPIN(cond, bar) do { unsigned _sp = 0; while (cond) { __builtin_amdgcn_s_sleep(1); \
    if ((++_sp & 255u) == 0u) { if (xb_ld(&(bar)[XB_TMO])) break; if (_sp > XB_SPIN_CAP) { atomicAdd(&(bar)[XB_TMO], 1u); break; } } } } while (0)
struct XcdBarrier { unsigned* bar; unsigned x; volatile LAS unsigned* st; };
__device__ __forceinline__ XcdBarrier xcd_barrier_post(unsigned* bar, volatile LAS unsigned* st) {
    XcdBarrier b; b.bar = bar; b.x = xb_xcc_id(); b.st = st;
    if (threadIdx.x == 0) (void)xb_add(&bar[XB_XCNT(b.x)], 1u);
    return b;
}
__device__ __forceinline__ void xcd_barrier_complete(unsigned* bar, unsigned x, unsigned& nloc, unsigned& nx) {
    const unsigned G = gridDim.x * gridDim.y * gridDim.z;
    unsigned sum, cnt, mine, sp = 0u;
    for (;;) {
        sum = 0u; cnt = 0u; mine = 0u;
#pragma unroll
        for (unsigned j = 0; j < 16; ++j) { const unsigned c = xb_ld(&bar[XB_XCNT(j)]); sum += c; cnt += (c > 0u) ? 1u : 0u; mine = (j == x) ? c : mine; }
        if (sum == G) break;
        __builtin_amdgcn_s_sleep(1);
        if ((++sp & 255u) == 0u) { if (xb_ld(&bar[XB_TMO])) break; if (sp > XB_SPIN_CAP) { atomicAdd(&bar[XB_TMO], 1u); break; } }
    }
    nloc = mine > 0u ? mine : 1u; nx = cnt > 0u ? cnt : 1u;
}
__device__ __forceinline__ void xcd_barrier(const XcdBarrier& b) {
    asm volatile("s_waitcnt vmcnt(0)" ::: "memory");
    __syncthreads();
    if (threadIdx.x == 0) {
        unsigned* bar = b.bar;
        __builtin_amdgcn_s_waitcnt(0);
        unsigned nloc = b.st[0], nx = b.st[1];
        if (nloc == 0u) { xcd_barrier_complete(bar, b.x, nloc, nx); b.st[0] = nloc; b.st[1] = nx; }
        const unsigned old = xb_add(&bar[XB_XSUB(b.x)], 1u);
        const unsigned gen = old / nloc;
        if (old + 1u == (gen + 1u) * nloc) {
            __builtin_amdgcn_fence(__ATOMIC_RELEASE, "agent");
            asm volatile("s_waitcnt vmcnt(0)" ::: "memory");
            const unsigned og = xb_add(&bar[XB_TOP], 1u);
            const unsigned tg = og / nx;
            if (og + 1u == (tg + 1u) * nx) xb_add(&bar[XB_TOPGEN], 1u);
            else XB_SPIN(xb_ld(&bar[XB_TOPGEN]) == tg, bar);
            __builtin_amdgcn_fence(__ATOMIC_ACQUIRE, "agent");
            xb_add(&bar[XB_XGEN(b.x)], 1u);
            asm volatile("s_waitcnt vmcnt(0)" ::: "memory");
        } else {
            XB_SPIN(xb_ld(&bar[XB_XGEN(b.x)]) == gen, bar);
            __builtin_amdgcn_fence(__ATOMIC_ACQUIRE, "agent");
            asm volatile("s_waitcnt vmcnt(0)" ::: "memory");
        }
    }
    __syncthreads();
}

struct Args { const float* in[29]; float* out; unsigned char* ws; int ph_lo, ph_hi, li, pad; };
enum { I_X = 0, I_C, I_WMOD, I_BMOD, I_N1G, I_WIN, I_BIN, I_LNG, I_LNB, I_GWS, I_GBS, I_LRE, I_LIM, I_LDT, I_BRE, I_BIM, I_CRE, I_CIM, I_SD, I_GLUW, I_GLUB,
       I_BRG, I_WOUT, I_N2G, I_WQ, I_KEYS, I_PU, I_PV, I_FG };

struct Frame {
    LAS unsigned char* lds;
    unsigned char* ws;
    const float* const* in;
    float* out;
    int tid, lane, wave, vcu, G;
};

#define PH_LOCALS int tid = F.tid; asm volatile("" : "+v"(tid)); const int lane = tid & 63; const int wave = __builtin_amdgcn_readfirstlane(tid >> 6); (void)lane; (void)wave;

typedef int i32x4_t __attribute__((ext_vector_type(4)));
struct EpiIn {
    static constexpr bool PERM = true, AFTER_DRAIN = false, KSPLIT = false;
    bf16* Z; bf16* XS; const LAS float* colL; int pn0, pn1; float* PLN; const float* hscl;
    __device__ __forceinline__ void operator()(const f32x4 (&acc)[2][2][4][2], const pg8::Unit& u, int wr, int wc, int fr, int fq) const {
        const int row0 = u.pm * 256 + wr * 64 + fr, col0 = u.pn * 256 + wc * 32 + 8 * fq;
        const bool isv = (u.pn >= 4 && u.pn < 8);
        const LAS float* cl = colL + (u.pn == pn0 ? 0 : (u.pn == pn1 ? 256 : 512)) + wc * 32 + 8 * fq;
        f32x4 bv[2][2], sv[2][2];
#pragma unroll
        for (int bj = 0; bj < 2; ++bj)
#pragma unroll
            for (int n = 0; n < 2; ++n) { bv[bj][n] = *(const LAS f32x4*)(cl + bj * 128 + 4 * n); sv[bj][n] = *(const LAS f32x4*)(cl + 768 + bj * 128 + 4 * n); }
        float sa[2][4];
#pragma unroll
        for (int ai = 0; ai < 2; ++ai)
#pragma unroll
            for (int m = 0; m < 4; ++m) sa[ai][m] = hscl[row0 + ai * 128 + m * 16];
        const bool isz = (u.pn < 8);
#pragma unroll
        for (int ai = 0; ai < 2; ++ai)
#pragma unroll
            for (int m = 0; m < 4; ++m) {
                const int r = row0 + ai * 128 + m * 16; float s1 = 0.f, s2 = 0.f;
#pragma unroll
                for (int bj = 0; bj < 2; ++bj) {
                    const i32x4_t i0 = __builtin_bit_cast(i32x4_t, acc[ai][bj][m][0]), i1 = __builtin_bit_cast(i32x4_t, acc[ai][bj][m][1]);
                    f32x4 v0 = (f32x4){(float)i0[0], (float)i0[1], (float)i0[2], (float)i0[3]} * (sv[bj][0] * sa[ai][m]) + bv[bj][0], v1 = (f32x4){(float)i1[0], (float)i1[1], (float)i1[2], (float)i1[3]} * (sv[bj][1] * sa[ai][m]) + bv[bj][1];
                    const int c = col0 + bj * 128;
                    u32x4 w;
                    if (isz) {
                        const float g0 = gelu_tanh(v0[0]), g1 = gelu_tanh(v0[1]), g2 = gelu_tanh(v0[2]), g3 = gelu_tanh(v0[3]), g4 = gelu_tanh(v1[0]), g5 = gelu_tanh(v1[1]), g6 = gelu_tanh(v1[2]), g7 = gelu_tanh(v1[3]);
                        w.x = pg8::cvt_pk_bf16(g0, g1); w.y = pg8::cvt_pk_bf16(g2, g3); w.z = pg8::cvt_pk_bf16(g4, g5); w.w = pg8::cvt_pk_bf16(g6, g7);
                        *(u32x4*)(Z + ((size_t)(c >> 7) * 16384 + r) * 128 + (c & 127)) = w;
                        s1 += ((g0 + g1) + (g2 + g3)) + ((g4 + g5) + (g6 + g7)); s2 += ((g0 * g0 + g1 * g1) + (g2 * g2 + g3 * g3)) + ((g4 * g4 + g5 * g5) + (g6 * g6 + g7 * g7));
                    } else {
                        w.x = pg8::cvt_pk_bf16(v0[0], v0[1]); w.y = pg8::cvt_pk_bf16(v0[2], v0[3]); w.z = pg8::cvt_pk_bf16(v1[0], v1[1]); w.w = pg8::cvt_pk_bf16(v1[2], v1[3]);
                        const int cc = c - 2048, g = cc >> 4, i = cc & 15;
                        *(u32x4*)(XS + ((size_t)(g * 256 + (r >> 6)) * 64 + (r & 63)) * 16 + i) = w;
                    }
                }
                if (isv) { s1 += __shfl_xor(s1, 16); s1 += __shfl_xor(s1, 32); s2 += __shfl_xor(s2, 16); s2 += __shfl_xor(s2, 32);
                    if (fq == 0) *(f32x2*)(PLN + ((size_t)r * 16 + (u.pn - 4) * 4 + wc) * 2) = (f32x2){s1, s2}; }
            }
    }
};
struct EpiGlu {
    static constexpr bool PERM = true, AFTER_DRAIN = false, KSPLIT = false;
    const bf16* Gb; bf16* MIX; const float* bias; float* PSB; const float* wsc;
    __device__ __forceinline__ void operator()(const f32x4 (&acc)[2][2][4][2], const pg8::Unit& u, int wr, int wc, int fr, int fq) const {
        const int row0 = u.pm * 256 + wr * 64 + fr, col0 = u.pn * 256 + wc * 32 + 8 * fq;
        f32x4 bv[2][2], cs[2][2];
#pragma unroll
        for (int bj = 0; bj < 2; ++bj)
#pragma unroll
            for (int n = 0; n < 2; ++n) { bv[bj][n] = *(const f32x4*)(bias + col0 + bj * 128 + 4 * n); cs[bj][n] = *(const f32x4*)(wsc + col0 + bj * 128 + 4 * n); }
#pragma unroll
        for (int ai = 0; ai < 2; ++ai)
#pragma unroll
            for (int m = 0; m < 4; ++m) {
                const int r = row0 + ai * 128 + m * 16; float ssq = 0.f;
#pragma unroll
                for (int bj = 0; bj < 2; ++bj) {
                    const f32x4 v0 = acc[ai][bj][m][0] * cs[bj][0] + bv[bj][0], v1 = acc[ai][bj][m][1] * cs[bj][1] + bv[bj][1];
                    const int c = col0 + bj * 128;
                    const u32x2 gw = *(const u32x2*)((const unsigned char*)Gb + (size_t)r * 1024 + c);
                    const f32x2 g01 = __builtin_amdgcn_cvt_pk_f32_fp8(gw.x, false), g23 = __builtin_amdgcn_cvt_pk_f32_fp8(gw.x, true), g45 = __builtin_amdgcn_cvt_pk_f32_fp8(gw.y, false), g67 = __builtin_amdgcn_cvt_pk_f32_fp8(gw.y, true);
                    const float o0 = g01.x * fast_sigmoid(v0[0]), o1 = g01.y * fast_sigmoid(v0[1]), o2 = g23.x * fast_sigmoid(v0[2]), o3 = g23.y * fast_sigmoid(v0[3]);
                    const float o4 = g45.x * fast_sigmoid(v1[0]), o5 = g45.y * fast_sigmoid(v1[1]), o6 = g67.x * fast_sigmoid(v1[2]), o7 = g67.y * fast_sigmoid(v1[3]);
                    u32x4 w; w.x = pg8::cvt_pk_bf16(o0, o1); w.y = pg8::cvt_pk_bf16(o2, o3); w.z = pg8::cvt_pk_bf16(o4, o5); w.w = pg8::cvt_pk_bf16(o6, o7);
                    {   unsigned w0 = 0u, w1 = 0u;
                        w0 = __builtin_amdgcn_cvt_pk_fp8_f32(o0, o1, w0, false); w0 = __builtin_amdgcn_cvt_pk_fp8_f32(o2, o3, w0, true); w1 = __builtin_amdgcn_cvt_pk_fp8_f32(o4, o5, w1, false); w1 = __builtin_amdgcn_cvt_pk_fp8_f32(o6, o7, w1, true);
                        *(u32x2*)((unsigned char*)MIX + (size_t)r * 2048 + 1024 + c) = (u32x2){w0, w1}; }
                    ssq += (o0 * o0 + o1 * o1) + (o2 * o2 + o3 * o3) + (o4 * o4 + o5 * o5) + (o6 * o6 + o7 * o7);
                }
                ssq += __shfl_xor(ssq, 16); ssq += __shfl_xor(ssq, 32);
                if (fq == 0) PSB[(size_t)r * 16 + u.pn * 4 + wc] = ssq;
            }
    }
};
template <bool XIN_BF16> struct EpiOut {
    static constexpr bool PERM = true, AFTER_DRAIN = false, KSPLIT = true;
    const void* xin; bf16* X; const LAS float* colL; int pn0; float* PS; const LAS float* ratL; const LAS float* rbL; int pm0; unsigned char* X8 = nullptr; const float* sx = nullptr;
    __device__ __forceinline__ void midscale(f32x4 (&acc)[2][2][4][2], const pg8::Unit& u, int wr, int fr_) const {
        int fr = fr_; asm volatile("" : "+v"(fr));
        const LAS float* rp = ratL + (u.pm == pm0 ? 0 : 256) + wr * 64 + fr;
#pragma unroll
        for (int ai = 0; ai < 2; ++ai)
#pragma unroll
            for (int m = 0; m < 4; ++m) { const float rt = rp[ai * 128 + m * 16];
#pragma unroll
                for (int bj = 0; bj < 2; ++bj)
#pragma unroll
                    for (int n = 0; n < 2; ++n) acc[ai][bj][m][n] = acc[ai][bj][m][n] * rt; }
    }
    __device__ __forceinline__ void operator()(const f32x4 (&acc)[2][2][4][2], const pg8::Unit& u, int wr, int wc, int fr_, int fq_) const {
        int fr = fr_, fq = fq_; asm volatile("" : "+v"(fr), "+v"(fq));
        const int row0 = u.pm * 256 + wr * 64 + fr, col0 = u.pn * 256 + wc * 32 + 8 * fq;
        const LAS float* rbp = rbL + (u.pm == pm0 ? 0 : 256) + wr * 64 + fr;
        f32x4 gv[2][2];
#pragma unroll
        for (int bj = 0; bj < 2; ++bj)
#pragma unroll
            for (int n = 0; n < 2; ++n) gv[bj][n] = *(const LAS f32x4*)(colL + (u.pn == pn0 ? 0 : 256) + wc * 32 + 8 * fq + bj * 128 + 4 * n);
#pragma unroll
        for (int ai = 0; ai < 2; ++ai)
#pragma unroll
            for (int m = 0; m < 4; ++m) {
                const int r = row0 + ai * 128 + m * 16; float ssq = 0.f; const float rb = rbp[ai * 128 + m * 16]; const float qinv = 1.0f / sx[r];
#pragma unroll
                for (int bj = 0; bj < 2; ++bj) {
                    const size_t off = (size_t)r * 2048 + col0 + bj * 128;
                    f32x4 x0, x1;
                    if (XIN_BF16) { const u32x4 w = __builtin_nontemporal_load((const u32x4*)((const bf16*)xin + off)); x0 = (f32x4){bflo(w.x), bfhi(w.x), bflo(w.y), bfhi(w.y)}; x1 = (f32x4){bflo(w.z), bfhi(w.z), bflo(w.w), bfhi(w.w)}; }
                    else { x0 = __builtin_nontemporal_load((const f32x4*)((const float*)xin + off)); x1 = __builtin_nontemporal_load((const f32x4*)((const float*)xin + off + 4)); }
                    const f32x4 y0 = x0 + gv[bj][0] * (acc[ai][bj][m][0] * rb), y1 = x1 + gv[bj][1] * (acc[ai][bj][m][1] * rb);
                    u32x4 o; o.x = pg8::cvt_pk_bf16(y0[0], y0[1]); o.y = pg8::cvt_pk_bf16(y0[2], y0[3]); o.z = pg8::cvt_pk_bf16(y1[0], y1[1]); o.w = pg8::cvt_pk_bf16(y1[2], y1[3]);
                    *(u32x4*)(X + off) = o;
                    {   unsigned w0 = 0u, w1 = 0u;
#pragma unroll
                        for (int e = 0; e < 4; ++e) { w0 |= (__builtin_bit_cast(unsigned, fminf(fmaxf(y0[e] * qinv, -127.0f), 127.0f) + 12582912.0f) & 0xFFu) << (8 * e); w1 |= (__builtin_bit_cast(unsigned, fminf(fmaxf(y1[e] * qinv, -127.0f), 127.0f) + 12582912.0f) & 0xFFu) << (8 * e); }
                        *(u32x2*)(X8 + off) = (u32x2){w0, w1}; }
                    ssq += (y0[0] * y0[0] + y0[1] * y0[1]) + (y0[2] * y0[2] + y0[3] * y0[3]) + (y1[0] * y1[0] + y1[1] * y1[1]) + (y1[2] * y1[2] + y1[3] * y1[3]);
                }
                ssq += __shfl_xor(ssq, 16); ssq += __shfl_xor(ssq, 32);
                if (fq == 0) PS[(size_t)r * 32 + u.pn * 4 + wc] = ssq;
            }
    }
};
struct EpiQ {
    static constexpr bool PERM = true, AFTER_DRAIN = false, KSPLIT = false;
    bf16* Q; const LAS float* colL; int pn0; const LAS float* rrL; int pm0; const float* sx;
    __device__ __forceinline__ void operator()(const f32x4 (&acc)[2][2][4][2], const pg8::Unit& u, int wr, int wc, int fr, int fq) const {
        const int row0 = u.pm * 256 + wr * 64 + fr, col0 = u.pn * 256 + wc * 32 + 8 * fq;
        const LAS float* rrp = rrL + (u.pm == pm0 ? 0 : 256) + wr * 64 + fr;
        f32x4 cv[2][2], sv[2][2];
#pragma unroll
        for (int bj = 0; bj < 2; ++bj)
#pragma unroll
            for (int n = 0; n < 2; ++n) { cv[bj][n] = *(const LAS f32x4*)(colL + (u.pn == pn0 ? 0 : 256) + wc * 32 + 8 * fq + bj * 128 + 4 * n); sv[bj][n] = *(const LAS f32x4*)(colL + 512 + (u.pn == pn0 ? 0 : 256) + wc * 32 + 8 * fq + bj * 128 + 4 * n); }
#pragma unroll
        for (int ai = 0; ai < 2; ++ai)
#pragma unroll
            for (int m = 0; m < 4; ++m) {
                const int r = row0 + ai * 128 + m * 16; const float rr = rrp[ai * 128 + m * 16] * sx[r];
#pragma unroll
                for (int bj = 0; bj < 2; ++bj) {
                    const i32x4_t i0 = __builtin_bit_cast(i32x4_t, acc[ai][bj][m][0]), i1 = __builtin_bit_cast(i32x4_t, acc[ai][bj][m][1]);
                    const f32x4 v0 = (f32x4){(float)i0[0], (float)i0[1], (float)i0[2], (float)i0[3]} * (sv[bj][0] * rr) + cv[bj][0], v1 = (f32x4){(float)i1[0], (float)i1[1], (float)i1[2], (float)i1[3]} * (sv[bj][1] * rr) + cv[bj][1];
                    u32x4 w; w.x = pg8::cvt_pk_bf16(v0[0], v0[1]); w.y = pg8::cvt_pk_bf16(v0[2], v0[3]); w.z = pg8::cvt_pk_bf16(v1[0], v1[1]); w.w = pg8::cvt_pk_bf16(v1[2], v1[3]);
                    *(u32x4*)(Q + (size_t)r * 2048 + col0 + bj * 128) = w;
                }
            }
    }
};
__device__ __forceinline__ void fill_rr(Frame& F, LAS float* rrL, int slot, int pm, int tid) {
    if (tid < 256) { const float* ps = (const float*)(F.ws + WS_PS) + ((size_t)pm * 256 + tid) * 32; float s = 0.f;
#pragma unroll
        for (int i = 0; i < 8; ++i) { const f32x4 v = *(const f32x4*)(ps + 4 * i); s += (v[0] + v[1]) + (v[2] + v[3]); }
        rrL[slot * 256 + tid] = 1.0f / sqrtf(s * (1.0f / DM) + EPS); }
}

__device__ __forceinline__ void p0_transpose_item(const float* W, int K, int N, bf16* WT, const float* kscale, LAS float* scr, int item, int lane, const float* kscale2 = nullptr) {
    const int nblk = N / 32, kb = item / nblk, nb = item % nblk, k0 = 64 * kb, n0 = 32 * nb;
    float wv[32];
#pragma unroll
    for (int i = 0; i < 32; ++i) wv[i] = __builtin_nontemporal_load(&W[(size_t)(k0 + 2 * i + (lane >> 5)) * N + n0 + (lane & 31)]);
#pragma unroll
    for (int i = 0; i < 32; ++i) { const int kk = 2 * i + (lane >> 5); float v = wv[i]; if (kscale) { v *= kscale[k0 + kk]; if (kscale2) v *= 1.0f + kscale2[k0 + kk]; } scr[kk * 33 + (lane & 31)] = v; }
    LDS_WAIT(); asm volatile("" ::: "memory");
    const int c = lane & 7;
#pragma unroll
    for (int j = 0; j < 4; ++j) { const int n = (lane >> 3) + 8 * j; const LAS float* s = scr + (8 * c) * 33 + n;
        u32x4 o; o.x = pk2(s[0 * 33], s[1 * 33]); o.y = pk2(s[2 * 33], s[3 * 33]); o.z = pk2(s[4 * 33], s[5 * 33]); o.w = pk2(s[6 * 33], s[7 * 33]);
        *(u32x4*)(WT + (size_t)(n0 + n) * K + k0 + 8 * c) = o; }
    LDS_WAIT(); asm volatile("" ::: "memory");
}

__device__ __forceinline__ u32x2 q8x8(const f32x4& a, const f32x4& b, float inv) {
    unsigned w0 = 0u, w1 = 0u;
#pragma unroll
    for (int e = 0; e < 4; ++e) { w0 |= (__builtin_bit_cast(unsigned, fmaf(a[e], inv, 12582912.0f)) & 0xFFu) << (8 * e); w1 |= (__builtin_bit_cast(unsigned, fmaf(b[e], inv, 12582912.0f)) & 0xFFu) << (8 * e); }
    return (u32x2){w0, w1};
}
__device__ __forceinline__ void norm_mod_row(const f32x4 (&v)[4][2], const float* gain, const float* scale, const float* shift, int lane, u32x2 (&o)[4], float& rowscale, float& xscale) {
    float s = 0.f, ax = 0.f;
#pragma unroll
    for (int j = 0; j < 4; ++j)
#pragma unroll
        for (int h = 0; h < 2; ++h) ax = fmaxf(ax, fmaxf(fmaxf(fabsf(v[j][h][0]), fabsf(v[j][h][1])), fmaxf(fabsf(v[j][h][2]), fabsf(v[j][h][3]))));
#pragma unroll
    for (int o2 = 1; o2 < 64; o2 <<= 1) ax = fmaxf(ax, __shfl_xor(ax, o2));
    xscale = ax > 0.f ? ax * (1.5f / 127.0f) : 1.0f;
#pragma unroll
    for (int j = 0; j < 4; ++j)
#pragma unroll
        for (int h = 0; h < 2; ++h) s += (v[j][h][0] * v[j][h][0] + v[j][h][1] * v[j][h][1]) + (v[j][h][2] * v[j][h][2] + v[j][h][3] * v[j][h][3]);
    const float rr = 1.0f / sqrtf(wave_sum(s) * (1.0f / DM) + EPS);
    f32x4 yy[4][2];
#pragma unroll
    for (int j = 0; j < 4; ++j) {
        const int c = j * 512 + lane * 8;
        f32x4 y[2];
#pragma unroll
        for (int h = 0; h < 2; ++h) {
            const f32x4 g = *(const f32x4*)(gain + c + 4 * h);
            y[h] = v[j][h] * rr * g;
            const f32x4 sc = *(const f32x4*)(scale + c + 4 * h), sh = *(const f32x4*)(shift + c + 4 * h); y[h] = y[h] * (sc + 1.0f) + sh;
        }
        yy[j][0] = y[0]; yy[j][1] = y[1];
    }
    float am = 0.f;
#pragma unroll
    for (int j = 0; j < 4; ++j)
#pragma unroll
        for (int h = 0; h < 2; ++h) am = fmaxf(am, fmaxf(fmaxf(fabsf(yy[j][h][0]), fabsf(yy[j][h][1])), fmaxf(fabsf(yy[j][h][2]), fabsf(yy[j][h][3]))));
#pragma unroll
    for (int o2 = 1; o2 < 64; o2 <<= 1) am = fmaxf(am, __shfl_xor(am, o2));
    rowscale = am > 0.f ? am * (1.0f / 127.0f) : 1.0f; const float inv = am > 0.f ? 127.0f / am : 0.f;
#pragma unroll
    for (int j = 0; j < 4; ++j) o[j] = q8x8(yy[j][0], yy[j][1], inv);
}
template <bool SRC_BF16>
__device__ __forceinline__ void load_row(const void* xrow_, int lane, f32x4 (&v)[4][2]) {
#pragma unroll
    for (int j = 0; j < 4; ++j) {
        if (SRC_BF16) { const u32x4 w = *(const u32x4*)((const bf16*)xrow_ + j * 512 + lane * 8); v[j][0] = (f32x4){bflo(w.x), bfhi(w.x), bflo(w.y), bfhi(w.y)}; v[j][1] = (f32x4){bflo(w.z), bfhi(w.z), bflo(w.w), bfhi(w.w)}; }
        else { const float* xrow = (const float*)xrow_; v[j][0] = __builtin_nontemporal_load((const f32x4*)(xrow + j * 512 + lane * 8)); v[j][1] = __builtin_nontemporal_load((const f32x4*)(xrow + j * 512 + lane * 8 + 4)); } }
}

__device__ __forceinline__ void p0_gemv_unit(Frame& F, int unit, int tid, float* modout) {
    if (unit >= 192) return;
    const int l = unit / 96, r = unit % 96, cb = r >> 1, kh = r & 1;
    LAS float* sc = (LAS float*)F.lds;
    LAS float* red = (LAS float*)(F.lds + 4096);
    for (int k = tid; k < 1024; k += NTHR) { const float c = F.in[I_C][kh * 1024 + k]; sc[k] = c * fast_sigmoid(c); }
    __syncthreads();
    const int tx = tid & 63, ty = tid >> 6;
    const float* W = F.in[I_WMOD] + ((size_t)l * DM + kh * 1024) * 12288 + cb * 256 + tx * 4;
    f32x4 a = {0.f, 0.f, 0.f, 0.f};
#pragma unroll 16
    for (int k = ty; k < 1024; k += 8) { const f32x4 w = __builtin_nontemporal_load((const f32x4*)(W + (size_t)k * 12288)); a += w * sc[k]; }
    *(LAS f32x4*)(red + ty * 256 + tx * 4) = a;
    __syncthreads();
    if (tid < 256) { float s = 0.f;
#pragma unroll
        for (int y = 0; y < 8; ++y) s += red[y * 256 + tid];
        if (kh == 0) s += F.in[I_BMOD][l * 12288 + cb * 256 + tid];
        atomicAdd(modout + l * 12288 + cb * 256 + tid, s); }
    __syncthreads();
}
__device__ __forceinline__ void p0_s5_unit(Frame& F, int unit, int tid, int parts = 15) {
    const int l = unit >> 7, g = (unit >> 1) & 63, hf = unit & 1;
    LAS float* apr = (LAS float*)F.lds;
    LAS float* api = apr + 4228;
    LAS float* bbr = api + 4228;
    LAS float* bbi = bbr + 1024;
    LAS float* ccr = bbi + 1024;
    LAS float* cci = ccr + 16 * 65;
    const float dt = expf(F.in[I_LDT][l * 64 + g]);
    const float* lre = F.in[I_LRE] + (l * 64 + g) * 64; const float* lim = F.in[I_LIM] + (l * 64 + g) * 64;
    for (int idx = tid; idx < 65 * 64; idx += NTHR) { const int d = idx >> 6, p = idx & 63;
        const float mag = expf(lre[p] * dt * (float)d); float sn, cs; sincosf(lim[p] * dt * (float)d, &sn, &cs);
        apr[d * 65 + p] = mag * cs; api[d * 65 + p] = mag * sn; }
    for (int idx = tid; idx < 1024; idx += NTHR) { const int o = idx >> 6, p = idx & 63;
        ccr[o * 65 + p] = F.in[I_CRE][((size_t)(l * 64 + g) * 16 + o) * 64 + p]; cci[o * 65 + p] = F.in[I_CIM][((size_t)(l * 64 + g) * 16 + o) * 64 + p]; }
    __syncthreads();
    for (int idx = tid; idx < 1024; idx += NTHR) { const int p = idx >> 4, i = idx & 15;
        const float xr = apr[65 + p] - 1.0f, xi = api[65 + p], lr = lre[p], li = lim[p], den = 1.0f / (lr * lr + li * li);
        const float cr = (xr * lr + xi * li) * den, ci = (xi * lr - xr * li) * den;
        const float br = F.in[I_BRE][((size_t)(l * 64 + g) * 64 + p) * 16 + i], bi = F.in[I_BIM][((size_t)(l * 64 + g) * 64 + p) * 16 + i];
        bbr[idx] = cr * br - ci * bi; bbi[idx] = cr * bi + ci * br; }
    __syncthreads();
    bf16* KT = (bf16*)(F.ws + WS_KTAB) + (size_t)(l * 64 + g) * 80 * 256;
    if (parts & 1) {
        const int d = hf * 32 + (tid >> 4), o = tid & 15;
        const float dskip = F.in[I_SD][l * 1024 + g * 16 + o];
        float s[16];
#pragma unroll
        for (int i = 0; i < 16; ++i) s[i] = 0.f;
        for (int p = 0; p < 64; ++p) { const float ar = apr[d * 65 + p], ai = api[d * 65 + p], cr = ccr[o * 65 + p], ci = cci[o * 65 + p];
            const float er = cr * ar - ci * ai, ei = cr * ai + ci * ar;
#pragma unroll
            for (int q = 0; q < 4; ++q) { const f32x4 br = *(const LAS f32x4*)(bbr + p * 16 + 4 * q), bi = *(const LAS f32x4*)(bbi + p * 16 + 4 * q);
#pragma unroll
                for (int e = 0; e < 4; ++e) s[4 * q + e] += er * br[e] - ei * bi[e]; } }
#if !SELFTEST_S5
        {   const float dsk = (d == 0) ? dskip : 0.f;
#pragma unroll
            for (int i = 0; i < 16; ++i) s[i] += (i == o) ? dsk : 0.f; }
#endif
        u32x4 w0, w1;
        w0.x = pk2(s[0], s[1]); w0.y = pk2(s[2], s[3]); w0.z = pk2(s[4], s[5]); w0.w = pk2(s[6], s[7]);
        w1.x = pk2(s[8], s[9]); w1.y = pk2(s[10], s[11]); w1.z = pk2(s[12], s[13]); w1.w = pk2(s[14], s[15]);
        if ((parts & 8) || w0.x == 0x12345678u) { *(u32x4*)(KT + (size_t)(d + 16) * 256 + o * 16) = w0; *(u32x4*)(KT + (size_t)(d + 16) * 256 + o * 16 + 8) = w1; }
        if ((parts & 8) && hf == 0 && tid < 256) { const u32x4 z = {0u, 0u, 0u, 0u}; *(u32x4*)(KT + tid * 16) = z; *(u32x4*)(KT + tid * 16 + 8) = z; }
    }
    bf16* WG = (bf16*)(F.ws + WS_WG) + (size_t)(l * 64 + g) * 128 * 1024;
    if (parts & 2) for (int it = tid; it < 32 * 64; it += NTHR) { const int p = hf * 32 + (it >> 6), tau = it & 63;
        const float ar = apr[(63 - tau) * 65 + p], ai = api[(63 - tau) * 65 + p];
        unsigned wr_[8], wi_[8];
#pragma unroll
        for (int q = 0; q < 4; ++q) { const f32x4 br = *(const LAS f32x4*)(bbr + p * 16 + 4 * q), bi = *(const LAS f32x4*)(bbi + p * 16 + 4 * q);
            wr_[2 * q] = pk2(ar * br[0] - ai * bi[0], ar * br[1] - ai * bi[1]); wr_[2 * q + 1] = pk2(ar * br[2] - ai * bi[2], ar * br[3] - ai * bi[3]);
            wi_[2 * q] = pk2(ar * bi[0] + ai * br[0], ar * bi[1] + ai * br[1]); wi_[2 * q + 1] = pk2(ar * bi[2] + ai * br[2], ar * bi[3] + ai * br[3]); }
        *(u32x4*)(WG + (size_t)p * 1024 + tau * 16) = (u32x4){wr_[0], wr_[1], wr_[2], wr_[3]}; *(u32x4*)(WG + (size_t)p * 1024 + tau * 16 + 8) = (u32x4){wr_[4], wr_[5], wr_[6], wr_[7]};
        *(u32x4*)(WG + (size_t)(64 + p) * 1024 + tau * 16) = (u32x4){wi_[0], wi_[1], wi_[2], wi_[3]}; *(u32x4*)(WG + (size_t)(64 + p) * 1024 + tau * 16 + 8) = (u32x4){wi_[4], wi_[5], wi_[6], wi_[7]}; }
    bf16* VG = (bf16*)(F.ws + WS_VG) + (size_t)(l * 64 + g) * 1024 * 128;
    if (parts & 4) for (int it = tid; it < 512 * 8; it += NTHR) { const int m = hf * 512 + (it >> 3), p0 = (it & 7) * 8, t = m >> 4, o = m & 15;
        float vr_[8], vi_[8];
#pragma unroll
        for (int e = 0; e < 8; ++e) { const float ar = apr[(t + 1) * 65 + p0 + e], ai = api[(t + 1) * 65 + p0 + e], cr = ccr[o * 65 + p0 + e], ci = cci[o * 65 + p0 + e];
            vr_[e] = cr * ar - ci * ai; vi_[e] = -(cr * ai + ci * ar); }
        *(u32x4*)(VG + (size_t)m * 128 + p0) = (u32x4){pk2(vr_[0], vr_[1]), pk2(vr_[2], vr_[3]), pk2(vr_[4], vr_[5]), pk2(vr_[6], vr_[7])};
        *(u32x4*)(VG + (size_t)m * 128 + 64 + p0) = (u32x4){pk2(vi_[0], vi_[1]), pk2(vi_[2], vi_[3]), pk2(vi_[4], vi_[5]), pk2(vi_[6], vi_[7])}; }
    if (hf == 0 && tid < 64) { float* AT = (float*)(F.ws + WS_AT) + ((size_t)(l * 64 + g) * 64 + tid) * 2; AT[0] = apr[64 * 65 + tid]; AT[1] = api[64 * 65 + tid]; }
    __syncthreads();
}
__device__ __forceinline__ void p0_fp4_chunk(Frame& F, int chunk, int wave, int lane) {
    unsigned char* UV = F.ws + WS_UV; float* SCL = (float*)(F.ws + WS_SCL);
    for (int i = 0; i < 8; i += 2) {
        f32x4 v[2][8]; float am[2] = {0.f, 0.f}; int tbl[2], rr[2];
#pragma unroll
        for (int r2 = 0; r2 < 2; ++r2) {
            const int r = chunk * 64 + wave * 8 + i + r2; tbl[r2] = r >> 15; rr[r2] = r & 32767;
            const float* srcp = (tbl[r2] ? F.in[I_PV] : F.in[I_PU]) + (size_t)rr[r2] * 2048 + lane * 4;
#pragma unroll
            for (int j = 0; j < 8; ++j) v[r2][j] = __builtin_nontemporal_load((const f32x4*)(srcp + j * 256));
        }
#pragma unroll
        for (int r2 = 0; r2 < 2; ++r2)
#pragma unroll
            for (int j = 0; j < 8; ++j) am[r2] = fmaxf(am[r2], fmaxf(fmaxf(fabsf(v[r2][j][0]), fabsf(v[r2][j][1])), fmaxf(fabsf(v[r2][j][2]), fabsf(v[r2][j][3]))));
#pragma unroll
        for (int o = 1; o < 64; o <<= 1) { am[0] = fmaxf(am[0], __shfl_xor(am[0], o)); am[1] = fmaxf(am[1], __shfl_xor(am[1], o)); }
#pragma unroll
        for (int r2 = 0; r2 < 2; ++r2) {
            const float qmax = 7.0f;
            float top = am[r2];
            if (true) {
                float ss = 0.f;
#pragma unroll
                for (int j = 0; j < 8; ++j) ss += (v[r2][j][0] * v[r2][j][0] + v[r2][j][1] * v[r2][j][1]) + (v[r2][j][2] * v[r2][j][2] + v[r2][j][3] * v[r2][j][3]);
                top = fminf(top, 2.6f * sqrtf(wave_sum(ss) * (1.0f / 2048.0f))); }
            const float scale = top > 0.f ? top / qmax : 1.0f, inv = top > 0.f ? qmax / top : 1.0f;
            u32x4 o;
            if (true) {
#pragma unroll
                for (int d = 0; d < 4; ++d) { unsigned w = 0u;
#pragma unroll
                    for (int n = 0; n < 8; ++n) { const unsigned bits = __builtin_bit_cast(unsigned, fminf(fmaxf(v[r2][2 * d + (n >> 2)][n & 3] * inv, -7.0f), 7.0f) + 12582912.0f); w |= (bits & 0xFu) << (4 * n); }
                    o[d] = w; }
            } else
#pragma unroll
            for (int d = 0; d < 4; ++d) { unsigned w = 0u;
                w = __builtin_amdgcn_cvt_scalef32_pk_fp4_f32(w, v[r2][2 * d][0] * inv, v[r2][2 * d][1] * inv, 1.0f, 0);
                w = __builtin_amdgcn_cvt_scalef32_pk_fp4_f32(w, v[r2][2 * d][2] * inv, v[r2][2 * d][3] * inv, 1.0f, 1);
                w = __builtin_amdgcn_cvt_scalef32_pk_fp4_f32(w, v[r2][2 * d + 1][0] * inv, v[r2][2 * d + 1][1] * inv, 1.0f, 2);
                w = __builtin_amdgcn_cvt_scalef32_pk_fp4_f32(w, v[r2][2 * d + 1][2] * inv, v[r2][2 * d + 1][3] * inv, 1.0f, 3);
                o[d] = w; }
            *(u32x4*)(UV + (size_t)(rr[r2] >> 14) * ((size_t)NEXP * 2048) + (size_t)tbl[r2] * ((size_t)NEXP * 1024) + (size_t)(rr[r2] & 16383) * 1024 + lane * 16) = o;
            if (lane == 0) SCL[rr[r2] * 2 + tbl[r2]] = scale;
        }
    }
}
#ifndef P0_PARTS
#define P0_PARTS 15
#endif
#ifndef P0_PROBE_MODE
#define P0_PROBE_MODE 0
#endif
__device__ __forceinline__ void p0_tables(Frame& F, int qi = 4, bool dummy = false) {
    PH_LOCALS
    unsigned* head = (unsigned*)(F.ws + WS_CTL) + CW_QUEUE + 64 * qi;
    float* modout = dummy ? (float*)(F.ws + WS_DBG) : (float*)(F.ws + WS_MOD);
    LAS unsigned* slot = (LAS unsigned*)(F.lds + MISC_OFF) + 16;
    for (;;) {
        __syncthreads();
        if (tid == 0) slot[0] = __hip_atomic_fetch_add(head, 1u, RLX_AGENT);
        __syncthreads();
        const unsigned u = slot[0];
        if (u >= 1664u) break;
        const int rnd = (int)u / 13, k = (int)u % 13;
        if (k < 2) { if (dummy && P0_PROBE_MODE == 2) continue; p0_s5_unit(F, rnd * 2 + k, tid, dummy ? P0_PARTS : 15); }
        else if (k < 5) { if (dummy && P0_PROBE_MODE == 1) continue; p0_gemv_unit(F, rnd * 3 + (k - 2), tid, modout); }
        else { p0_fp4_chunk(F, rnd * 8 + (k - 5), wave, lane); }
    }
}
__device__ __forceinline__ void p0_prologue(Frame& F) {
    PH_LOCALS
    const int gw = F.vcu * NWAVES + wave, NGW = F.G * NWAVES;
    const int gt = F.vcu * NTHR + tid, NGT = F.G * NTHR;
    const float* modp = (const float*)(F.ws + WS_MOD);
    for (int i = gt; i < 2 * DM; i += NGT) { const int l = i >> 11, k = i & 2047; ((float*)(F.ws + WS_GS))[i] = F.in[I_N2G][i] * (1.0f + modp[l * 12288 + 4 * 2048 + k]); }
    for (int u = F.vcu; u < 256; u += F.G) {
        const int l = u >> 7, cb = (u >> 2) & 31, kq = u & 3, tx = tid & 15, ty = tid >> 4;
        const float* W = F.in[I_WQ] + ((size_t)l * DM + kq * 512) * DM + cb * 64 + tx * 4; const float* sh = modp + l * 12288 + 3 * 2048 + kq * 512;
        f32x4 a = {0.f, 0.f, 0.f, 0.f};
#pragma unroll 16
        for (int k = ty; k < 512; k += 32) { const f32x4 w = *(const f32x4*)(W + (size_t)k * DM); a += w * sh[k]; }
        LAS float* red = (LAS float*)F.lds;
        __syncthreads();
        *(LAS f32x4*)(red + ty * 64 + tx * 4) = a;
        __syncthreads();
        if (tid < 64) { float s = 0.f;
#pragma unroll
            for (int y = 0; y < 32; ++y) s += red[y * 64 + tid];
            ((float*)(F.ws + WS_C0))[(l * 4 + kq) * DM + cb * 64 + tid] = s; }
        __syncthreads();
    }
    {
        LAS float* scr = (LAS float*)(F.lds + wave * 16384);
        constexpr int I_IN = (DM / 64) * (INW / 32), I_GL = (WB / 64) * (WB / 32), I_OU = (DM / 64) * (DM / 32), I_Q = I_OU;
        constexpr int PER_L = I_IN + I_GL + I_OU + I_Q;
        for (int it = gw; it < 2 * PER_L; it += NGW) {
            const int l = it / PER_L; int r = it % PER_L;
            if (r < I_IN) { p0_transpose_item(F.in[I_WIN] + (size_t)l * DM * INW, DM, INW, (bf16*)(F.ws + WS_WIN) + (size_t)l * INW * DM, nullptr, scr, r, lane); continue; } r -= I_IN;
            if (r < I_GL) { p0_transpose_item(F.in[I_GLUW] + (size_t)l * WB * WB, WB, WB, (bf16*)(F.ws + WS_GLU) + (size_t)l * WB * WB, nullptr, scr, r, lane); continue; } r -= I_GL;
            if (r < I_OU) { p0_transpose_item(F.in[I_WOUT] + (size_t)l * DM * DM, DM, DM, (bf16*)(F.ws + WS_WOUT) + (size_t)l * DM * DM, F.in[I_BRG] + l * DM, scr, r, lane); continue; } r -= I_OU;
            p0_transpose_item(F.in[I_WQ] + (size_t)l * DM * DM, DM, DM, (bf16*)(F.ws + WS_WQ) + (size_t)l * DM * DM, F.in[I_N2G] + l * DM, scr, r, lane, modp + l * 12288 + 4 * 2048);
        }
    }
    {
        bf16* KB = (bf16*)(F.ws + WS_KEYS);
        for (int i = gt; i < 2 * 8 * 2 * 128 * 128 / 8; i += NGT) { const f32x4 a = *(const f32x4*)(F.in[I_KEYS] + (size_t)i * 8), b = *(const f32x4*)(F.in[I_KEYS] + (size_t)i * 8 + 4);
            u32x4 o; o.x = pk2(a[0], a[1]); o.y = pk2(a[2], a[3]); o.z = pk2(b[0], b[1]); o.w = pk2(b[2], b[3]); *(u32x4*)(KB + (size_t)i * 8) = o; }
        bf16* GW = (bf16*)(F.ws + WS_GWS);
        for (int i = gt; i < 2 * 8 * 128 * 128 / 8; i += NGT) { const int e = i * 8, jj = e & 127, ii = (e >> 7) & 127; const bool keep = (ii >= 64) || (jj < 64);
            f32x4 a = *(const f32x4*)(F.in[I_GWS] + (size_t)i * 8), b = *(const f32x4*)(F.in[I_GWS] + (size_t)i * 8 + 4);
            if (!keep) { a = (f32x4){0.f, 0.f, 0.f, 0.f}; b = a; }
            u32x4 o; o.x = pk2(a[0], a[1]); o.y = pk2(a[2], a[3]); o.z = pk2(b[0], b[1]); o.w = pk2(b[2], b[3]); *(u32x4*)(GW + (size_t)i * 8) = o; }
    }
}

__device__ __forceinline__ void p1_quant_win(Frame& F) {
    PH_LOCALS
    const int gw = F.vcu * NWAVES + wave, NGW = F.G * NWAVES;
    for (int rw = gw; rw < 2 * WB; rw += NGW) {
        const bf16* WT = (const bf16*)(F.ws + WS_GLU); unsigned char* W8 = F.ws + WS_WGL8; float* WS = (float*)(F.ws + WS_WGLSCL);
        u32x4 w[2]; float am = 0.f;
#pragma unroll
        for (int j = 0; j < 2; ++j) w[j] = *(const u32x4*)(WT + (size_t)rw * WB + j * 512 + lane * 8);
        f32x4 a[2], b[2];
#pragma unroll
        for (int j = 0; j < 2; ++j) { a[j] = (f32x4){bflo(w[j].x), bfhi(w[j].x), bflo(w[j].y), bfhi(w[j].y)}; b[j] = (f32x4){bflo(w[j].z), bfhi(w[j].z), bflo(w[j].w), bfhi(w[j].w)};
            am = fmaxf(am, fmaxf(fmaxf(fmaxf(fabsf(a[j][0]), fabsf(a[j][1])), fmaxf(fabsf(a[j][2]), fabsf(a[j][3]))), fmaxf(fmaxf(fabsf(b[j][0]), fabsf(b[j][1])), fmaxf(fabsf(b[j][2]), fabsf(b[j][3]))))); }
#pragma unroll
        for (int o2 = 1; o2 < 64; o2 <<= 1) am = fmaxf(am, __shfl_xor(am, o2));
        const int ea = (int)((__builtin_bit_cast(unsigned, am) >> 23) & 0xFFu); const int ep = am > 0.f ? (134 - ea) : 0;
        const float p = __builtin_bit_cast(float, (unsigned)(127 + ep) << 23), pinv = __builtin_bit_cast(float, (unsigned)(127 - ep) << 23);
        if (lane == 0) WS[rw] = pinv;
#pragma unroll
        for (int j = 0; j < 2; ++j) { unsigned w0 = 0u, w1 = 0u;
            w0 = __builtin_amdgcn_cvt_pk_fp8_f32(a[j][0] * p, a[j][1] * p, w0, false); w0 = __builtin_amdgcn_cvt_pk_fp8_f32(a[j][2] * p, a[j][3] * p, w0, true);
            w1 = __builtin_amdgcn_cvt_pk_fp8_f32(b[j][0] * p, b[j][1] * p, w1, false); w1 = __builtin_amdgcn_cvt_pk_fp8_f32(b[j][2] * p, b[j][3] * p, w1, true);
            *(u32x2*)(W8 + (size_t)rw * WB + j * 512 + lane * 8) = (u32x2){w0, w1}; }
    }
    for (int rw = gw; rw < 2 * DM; rw += NGW) {
        const bf16* WT = (const bf16*)(F.ws + WS_WOUT); unsigned char* W8 = F.ws + WS_WO8; float* WS = (float*)(F.ws + WS_WOSCL);
        u32x4 w[4]; float am = 0.f;
#pragma unroll
        for (int j = 0; j < 4; ++j) w[j] = *(const u32x4*)(WT + (size_t)rw * DM + j * 512 + lane * 8);
        f32x4 a[4], b[4];
#pragma unroll
        for (int j = 0; j < 4; ++j) { a[j] = (f32x4){bflo(w[j].x), bfhi(w[j].x), bflo(w[j].y), bfhi(w[j].y)}; b[j] = (f32x4){bflo(w[j].z), bfhi(w[j].z), bflo(w[j].w), bfhi(w[j].w)};
            am = fmaxf(am, fmaxf(fmaxf(fmaxf(fabsf(a[j][0]), fabsf(a[j][1])), fmaxf(fabsf(a[j][2]), fabsf(a[j][3]))), fmaxf(fmaxf(fabsf(b[j][0]), fabsf(b[j][1])), fmaxf(fabsf(b[j][2]), fabsf(b[j][3]))))); }
#pragma unroll
        for (int o2 = 1; o2 < 64; o2 <<= 1) am = fmaxf(am, __shfl_xor(am, o2));
        const int ea = (int)((__builtin_bit_cast(unsigned, am) >> 23) & 0xFFu); const int ep = am > 0.f ? (134 - ea) : 0;
        const float p = __builtin_bit_cast(float, (unsigned)(127 + ep) << 23), pinv = __builtin_bit_cast(float, (unsigned)(127 - ep) << 23);
        if (lane == 0) WS[rw] = pinv;
#pragma unroll
        for (int j = 0; j < 4; ++j) { unsigned w0 = 0u, w1 = 0u;
            w0 = __builtin_amdgcn_cvt_pk_fp8_f32(a[j][0] * p, a[j][1] * p, w0, false); w0 = __builtin_amdgcn_cvt_pk_fp8_f32(a[j][2] * p, a[j][3] * p, w0, true);
            w1 = __builtin_amdgcn_cvt_pk_fp8_f32(b[j][0] * p, b[j][1] * p, w1, false); w1 = __builtin_amdgcn_cvt_pk_fp8_f32(b[j][2] * p, b[j][3] * p, w1, true);
            *(u32x2*)(W8 + (size_t)rw * DM + j * 512 + lane * 8) = (u32x2){w0, w1}; }
    }
    for (int rw = gw; rw < 2 * INW + 2 * DM; rw += NGW) {
        const bool isq = rw >= 2 * INW; const int row = isq ? rw - 2 * INW : rw;
        const bf16* WT = (const bf16*)(F.ws + (isq ? WS_WQ : WS_WIN)); unsigned char* W8 = F.ws + (isq ? WS_WQ8 : WS_WIN8); float* WS = (float*)(F.ws + (isq ? WS_WQSCL : WS_WSCL));
        u32x4 w[4]; float am = 0.f;
#pragma unroll
        for (int j = 0; j < 4; ++j) w[j] = *(const u32x4*)(WT + (size_t)row * DM + j * 512 + lane * 8);
        f32x4 a[4], b[4];
#pragma unroll
        for (int j = 0; j < 4; ++j) { a[j] = (f32x4){bflo(w[j].x), bfhi(w[j].x), bflo(w[j].y), bfhi(w[j].y)}; b[j] = (f32x4){bflo(w[j].z), bfhi(w[j].z), bflo(w[j].w), bfhi(w[j].w)};
            am = fmaxf(am, fmaxf(fmaxf(fmaxf(fabsf(a[j][0]), fabsf(a[j][1])), fmaxf(fabsf(a[j][2]), fabsf(a[j][3]))), fmaxf(fmaxf(fabsf(b[j][0]), fabsf(b[j][1])), fmaxf(fabsf(b[j][2]), fabsf(b[j][3]))))); }
#pragma unroll
        for (int o2 = 1; o2 < 64; o2 <<= 1) am = fmaxf(am, __shfl_xor(am, o2));
        const float inv = am > 0.f ? 127.0f / am : 0.f;
        if (lane == 0) WS[row] = am > 0.f ? am * (1.0f / 127.0f) : 1.0f;
#pragma unroll
        for (int j = 0; j < 4; ++j) *(u32x2*)(W8 + (size_t)row * DM + j * 512 + lane * 8) = q8x8(a[j], b[j], inv);
    }
}
template <bool SRC_BF16>
__device__ __forceinline__ void phase_norm(Frame& F, const void* xsrc, const float* gain, const float* scale, const float* shift) {
    PH_LOCALS
    const int gw = F.vcu * NWAVES + wave, NGW = F.G * NWAVES;
    unsigned char* H8 = F.ws + WS_H; float* HSC = (float*)(F.ws + WS_HSCL);
    float* SXp = (float*)(F.ws + WS_SX);
    for (int m = gw; m < M; m += 2 * NGW) {
        const int m2 = m + NGW;
        f32x4 va[4][2], vb[4][2];
        const char* ra = (const char*)xsrc + (size_t)m * DM * (SRC_BF16 ? 2 : 4); const char* rb = (const char*)xsrc + (size_t)(m2 < M ? m2 : m) * DM * (SRC_BF16 ? 2 : 4);
        load_row<SRC_BF16>(ra, lane, va); load_row<SRC_BF16>(rb, lane, vb);
        u32x2 oa[4], ob[4]; float sca, scb, sxa, sxb; norm_mod_row(va, gain, scale, shift, lane, oa, sca, sxa); norm_mod_row(vb, gain, scale, shift, lane, ob, scb, sxb);
#pragma unroll
        for (int j = 0; j < 4; ++j) *(u32x2*)(H8 + (size_t)m * DM + j * 512 + lane * 8) = oa[j];
        if (lane == 0) { HSC[m] = sca; SXp[m] = sxa; }
        if (m2 < M) {
#pragma unroll
            for (int j = 0; j < 4; ++j) *(u32x2*)(H8 + (size_t)m2 * DM + j * 512 + lane * 8) = ob[j];
            if (lane == 0) { HSC[m2] = scb; SXp[m2] = sxb; } }
    }
}
__device__ __forceinline__ void phase_sloc(Frame& F, int l) {
    PH_LOCALS
    const bf16* XS = (const bf16*)(F.ws + WS_XS); const bf16* WG = (const bf16*)(F.ws + WS_WG) + (size_t)l * 64 * 128 * 1024; float* SL = (float*)(F.ws + WS_SLOC);
    LAS unsigned char* WL = F.lds;
    const int fr = lane & 15, fq = lane >> 4;
    for (int u = F.vcu; u < 256; u += F.G) {
        const int g = u >> 2, jh = (u >> 1) & 1, nh = u & 1;
        const int n = nh * 128 + 16 * wave + fr;
        const bf16* xp0 = XS + ((size_t)(g * 256 + n)) * 1024 + 8 * fq;
        bf16x8 xa[32];
#pragma unroll
        for (int i = 0; i < 32; ++i) xa[i] = *(const bf16x8*)(xp0 + i * 32);
        __syncthreads();
#pragma unroll
        for (int hf = 0; hf < 2; ++hf) {
            u32x4 wv[8];
#pragma unroll
            for (int ps = 0; ps < 8; ++ps) { const int idx = (hf * 8 + ps) * 512 + tid, row = idx >> 7, c16 = idx & 127; wv[ps] = *(const u32x4*)(WG + ((size_t)(g * 128 + jh * 64 + row)) * 1024 + c16 * 8); }
#pragma unroll
            for (int ps = 0; ps < 8; ++ps) { const int idx = (hf * 8 + ps) * 512 + tid, row = idx >> 7, c16 = idx & 127; *(LAS u32x4*)(WL + row * 2064 + c16 * 16) = wv[ps]; }
        }
        __syncthreads();
        f32x4 acc[4];
#pragma unroll
        for (int jt = 0; jt < 4; ++jt) acc[jt] = (f32x4){0.f, 0.f, 0.f, 0.f};
#pragma unroll
        for (int kb = 0; kb < 32; ++kb) {
#pragma unroll
            for (int jt = 0; jt < 4; ++jt) { const bf16x8 wf = *(const LAS bf16x8*)(WL + (jt * 16 + fr) * 2064 + (kb * 32 + 8 * fq) * 2);
                acc[jt] = __builtin_amdgcn_mfma_f32_16x16x32_bf16(wf, xa[kb], acc[jt], 0, 0, 0); } }
#pragma unroll
        for (int jt = 0; jt < 4; ++jt) *(f32x4*)(SL + ((size_t)(g * 256 + n)) * 128 + jh * 64 + jt * 16 + 4 * fq) = acc[jt];
    }
    __syncthreads();
}
#define GT_TR16(A_, addr_) asm volatile( \
    "ds_read_b64_tr_b16 %0, %16\n\tds_read_b64_tr_b16 %1, %16 offset:1088\n\tds_read_b64_tr_b16 %2, %16 offset:8\n\tds_read_b64_tr_b16 %3, %16 offset:1096\n\t" \
    "ds_read_b64_tr_b16 %4, %16 offset:64\n\tds_read_b64_tr_b16 %5, %16 offset:1152\n\tds_read_b64_tr_b16 %6, %16 offset:72\n\tds_read_b64_tr_b16 %7, %16 offset:1160\n\t" \
    "ds_read_b64_tr_b16 %8, %16 offset:128\n\tds_read_b64_tr_b16 %9, %16 offset:1216\n\tds_read_b64_tr_b16 %10, %16 offset:136\n\tds_read_b64_tr_b16 %11, %16 offset:1224\n\t" \
    "ds_read_b64_tr_b16 %12, %16 offset:192\n\tds_read_b64_tr_b16 %13, %16 offset:1280\n\tds_read_b64_tr_b16 %14, %16 offset:200\n\tds_read_b64_tr_b16 %15, %16 offset:1288\n\t" \
    "s_waitcnt lgkmcnt(0)" \
    : "=&v"(A_[0]), "=&v"(A_[1]), "=&v"(A_[2]), "=&v"(A_[3]), "=&v"(A_[4]), "=&v"(A_[5]), "=&v"(A_[6]), "=&v"(A_[7]), \
      "=&v"(A_[8]), "=&v"(A_[9]), "=&v"(A_[10]), "=&v"(A_[11]), "=&v"(A_[12]), "=&v"(A_[13]), "=&v"(A_[14]), "=&v"(A_[15]) : "v"(addr_) : "memory")
__device__ __forceinline__ void phase_gating(Frame& F, int l) {
    PH_LOCALS
    const bf16* Z = (const bf16*)(F.ws + WS_Z); const float* PLN = (const float*)(F.ws + WS_PLN);
    bf16* MIX = (bf16*)(F.ws + WS_MIX);
    constexpr int VS = 272, VBUF = 128 * VS;
    const int j = tid >> 2, cs = (tid & 3) * 32;
    const int fr = lane & 15, fq = lane >> 4, w = wave;
    const unsigned wr_off = (unsigned)(j * VS + cs * 2);
    const unsigned tr_off = (unsigned)((8 * fq + (fr >> 2)) * VS + 16 * (lane & 3));
    u32x4 tw[4], uw[4]; f32x4 pl0, pl1;
#define GT_LOAD(unit_) do { const int nb_ = (unit_) >> 3, hh_ = (unit_) & 7; \
        const bf16* zr_ = Z + ((size_t)(8 + hh_) * 16384 + nb_ * 128 + j) * 128 + cs; \
        _Pragma("unroll") for (int q = 0; q < 4; ++q) tw[q] = *(const u32x4*)(zr_ + q * 8); \
        { const float* pl_ = PLN + (size_t)(nb_ * 128 + j) * 32 + (tid & 3) * 8; pl0 = *(const f32x4*)pl_; pl1 = *(const f32x4*)(pl_ + 4); } \
        const bf16* ur_ = Z + ((size_t)hh_ * 16384 + nb_ * 128 + 16 * w + fr) * 128 + 8 * fq; \
        _Pragma("unroll") for (int P = 0; P < 4; ++P) uw[P] = *(const u32x4*)(ur_ + 32 * P); } while (0)
    __syncthreads();
    if (F.vcu < 1024) GT_LOAD(F.vcu);
    int hprev = -1; bf16x8 wf[4];
#pragma unroll
    for (int kb = 0; kb < 4; ++kb) wf[kb] = (bf16x8){0, 0, 0, 0, 0, 0, 0, 0};
    const int nkb = (w < 4) ? 2 : 4;
    int k = 0;
    for (int unit = F.vcu; unit < 1024; unit += F.G, ++k) {
        const int nb = unit >> 3, hh = unit & 7, t0 = nb * 128, c0 = hh * 128;
        const unsigned vb = (unsigned)(size_t)(F.lds) + (unsigned)((k & 1) * VBUF);
        {
            float a1 = (pl0[0] + pl0[2]) + (pl1[0] + pl1[2]), a2 = (pl0[1] + pl0[3]) + (pl1[1] + pl1[3]);
            a1 += __shfl_xor(a1, 1); a2 += __shfl_xor(a2, 1); a1 += __shfl_xor(a1, 2); a2 += __shfl_xor(a2, 2);
            const float mu = a1 * (1.0f / 1024.0f), rs = 1.0f / sqrtf(fmaxf(a2 * (1.0f / 1024.0f) - mu * mu, 0.f) + EPS), mr = -mu * rs;
            const float* lg = F.in[I_LNG] + l * 1024 + c0 + cs; const float* lb = F.in[I_LNB] + l * 1024 + c0 + cs;
#pragma unroll
            for (int q = 0; q < 4; ++q) {
                const f32x4 g0 = *(const f32x4*)(lg + q * 8), g1 = *(const f32x4*)(lg + q * 8 + 4), b0 = *(const f32x4*)(lb + q * 8), b1 = *(const f32x4*)(lb + q * 8 + 4);
                u32x4 ow;
#pragma unroll
                for (int e = 0; e < 4; ++e) {
                    const float ga = e < 2 ? g0[2 * e] : g1[2 * e - 4], gb = e < 2 ? g0[2 * e + 1] : g1[2 * e - 3], ba = e < 2 ? b0[2 * e] : b1[2 * e - 4], bb = e < 2 ? b0[2 * e + 1] : b1[2 * e - 3];
                    ow[e] = pk2((bflo(tw[q][e]) * rs + mr) * ga + ba, (bfhi(tw[q][e]) * rs + mr) * gb + bb); }
                *(LAS u32x4*)(F.lds + (k & 1) * VBUF + wr_off + 16 * q) = ow;
            }
        }
        u32x4 uc[4];
#pragma unroll
        for (int P = 0; P < 4; ++P) uc[P] = uw[P];
        if (hh != hprev) {
            const bf16* GW = (const bf16*)(F.ws + WS_GWS) + (size_t)(l * 8 + hh) * 128 * 128;
#pragma unroll
            for (int kb = 0; kb < 4; ++kb) wf[kb] = *(const bf16x8*)(GW + (size_t)(16 * w + fr) * 128 + (kb < nkb ? kb : 0) * 32 + 8 * fq);
            hprev = hh; }
        const int tok = t0 + 16 * w + fr; const float bs = F.in[I_GBS][(l * 8 + hh) * 128 + 16 * w + fr];
        if (unit + F.G < 1024) GT_LOAD(unit + F.G);
        __syncthreads();
        {
            f32x4 acc[8];
#pragma unroll
            for (int ct = 0; ct < 8; ++ct) acc[ct] = (f32x4){0.f, 0.f, 0.f, 0.f};
#pragma unroll
            for (int kb = 0; kb < 4; ++kb) { if (kb < nkb) {
                u32x2 af[16]; const unsigned ad = vb + tr_off + (unsigned)(kb * 32 * VS);
                GT_TR16(af, ad);
#pragma unroll
                for (int ct = 0; ct < 8; ++ct) { const u32x4 t4 = __builtin_shufflevector(af[2 * ct], af[2 * ct + 1], 0, 1, 2, 3);
                    acc[ct] = __builtin_amdgcn_mfma_f32_16x16x32_bf16(__builtin_bit_cast(bf16x8, t4), wf[kb], acc[ct], 0, 0, 0); } } }
            float ssq = 0.f;
#pragma unroll
            for (int P = 0; P < 4; ++P) {
                const f32x4 x = acc[2 * P], y = acc[2 * P + 1]; const u32x4 uu = uc[P];
                const float o0 = bflo(uu[0]) * (x[0] + bs), o1 = bfhi(uu[0]) * (x[1] + bs), o2 = bflo(uu[1]) * (x[2] + bs), o3 = bfhi(uu[1]) * (x[3] + bs);
                const float o4 = bflo(uu[2]) * (y[0] + bs), o5 = bfhi(uu[2]) * (y[1] + bs), o6 = bflo(uu[3]) * (y[2] + bs), o7 = bfhi(uu[3]) * (y[3] + bs);
                u32x4 o; o[0] = pk2(o0, o1); o[1] = pk2(o2, o3); o[2] = pk2(o4, o5); o[3] = pk2(o6, o7);
                {   unsigned w0 = 0u, w1 = 0u;
                    w0 = __builtin_amdgcn_cvt_pk_fp8_f32(o0, o1, w0, false); w0 = __builtin_amdgcn_cvt_pk_fp8_f32(o2, o3, w0, true); w1 = __builtin_amdgcn_cvt_pk_fp8_f32(o4, o5, w1, false); w1 = __builtin_amdgcn_cvt_pk_fp8_f32(o6, o7, w1, true);
                    *(u32x2*)((unsigned char*)MIX + (size_t)tok * 2048 + c0 + 32 * P + 8 * fq) = (u32x2){w0, w1}; }
                ssq += ((o0 * o0 + o1 * o1) + (o2 * o2 + o3 * o3)) + ((o4 * o4 + o5 * o5) + (o6 * o6 + o7 * o7)); }
            ssq += __shfl_xor(ssq, 16); ssq += __shfl_xor(ssq, 32);
            if (fq == 0) ((float*)(F.ws + WS_PSA))[(size_t)tok * 8 + hh] = ssq;
        }
    }
    __syncthreads();
#undef GT_LOAD
}

__device__ __forceinline__ void phase_s5out(Frame& F, int l) {
    PH_LOCALS
    const bf16* XS = (const bf16*)(F.ws + WS_XS);
    bf16* Gb = (bf16*)(F.ws + WS_G);
    LAS unsigned char* HT = F.lds;
    LAS float* TS = (LAS float*)(F.lds + 34816);
    LAS unsigned char* KT = F.lds + 38912;
    LAS unsigned char* VT = F.lds + 79872;
    const int fr = lane & 15, fq = lane >> 4;
    int have_g = -1, have_nh = -1;
    for (int uu = F.vcu, it = 0; uu < 512; uu += F.G, ++it) {
        const int g = (F.G == 256) ? (F.vcu >> 2) : (uu >> 3), nh = (F.G == 256) ? ((F.vcu >> 1) & 1) : (uu & 1), rc = (F.G == 256) ? ((F.vcu & 1) + 2 * it) : ((uu >> 1) & 3);
        const bool fresh = (g != have_g) || (nh != have_nh);
        const bf16* VG = (const bf16*)(F.ws + WS_VG) + (size_t)(l * 64 + g) * 1024 * 128;
        const int n = nh * 128 + 16 * wave + fr;
        const bf16* xp0 = XS + ((size_t)(g * 256 + n)) * 1024 + 8 * fq;
        bf16x8 x0[4], x1[4], x2[4], x3[4];
#pragma unroll
        for (int i = 0; i < 4; ++i) { x0[i] = *(const bf16x8*)(xp0 + i * 32); x1[i] = *(const bf16x8*)(xp0 + (4 + i) * 32); x2[i] = *(const bf16x8*)(xp0 + (8 + i) * 32); x3[i] = *(const bf16x8*)(xp0 + (12 + i) * 32); }
        __syncthreads();
        { const u32x4* src = (const u32x4*)((const bf16*)(F.ws + WS_KTAB) + (size_t)(l * 64 + g) * 80 * 256);
          if (fresh) for (int i = tid; i < 80 * 256 / 8; i += NTHR) ((LAS u32x4*)KT)[i] = src[i];
#pragma unroll
          for (int ps = 0; ps < 8; ++ps) { const int row = ps * 32 + (tid >> 4), c = tid & 15, q = row >> 4, o = row & 15;
              *(LAS u32x4*)(VT + row * 272 + c * 16) = *(const u32x4*)(VG + (size_t)((rc + 4 * q) * 16 + o) * 128 + c * 8); } }
        if (fresh) {
            const int p = lane, seg = wave;
            const float* AT = (const float*)(F.ws + WS_AT) + ((size_t)(l * 64 + g) * 64 + p) * 2; const float ar = AT[0], ai = AT[1];
            const float* SL = (const float*)(F.ws + WS_SLOC) + ((size_t)(g * 256 + seg * 32)) * 128 + p;
            float sr[32], si[32];
#pragma unroll
            for (int i = 0; i < 32; ++i) { sr[i] = SL[(size_t)i * 128]; si[i] = SL[(size_t)i * 128 + 64]; }
            float er = 0.f, ei = 0.f;
#pragma unroll
            for (int i = 0; i < 32; ++i) { const float nr = ar * er - ai * ei + sr[i], ni = ar * ei + ai * er + si[i]; er = nr; ei = ni; }
            TS[(seg * 64 + p) * 2] = er; TS[(seg * 64 + p) * 2 + 1] = ei;
            float qr = ar, qi = ai;
#pragma unroll
            for (int s = 0; s < 5; ++s) { const float nr = qr * qr - qi * qi, ni = 2.0f * qr * qi; qr = nr; qi = ni; }
            __syncthreads();
            float hr = 0.f, hi = 0.f;
            for (int k = 0; k < seg; ++k) { const float tr = TS[(k * 64 + p) * 2], ti = TS[(k * 64 + p) * 2 + 1]; const float nr = qr * hr - qi * hi + tr, ni = qr * hi + qi * hr + ti; hr = nr; hi = ni; }
            if ((seg >> 2) == nh) {
                LAS bf16* hrow = (LAS bf16*)(HT + ((seg & 3) * 32) * 272) + p;
#pragma unroll
                for (int i = 0; i < 32; ++i) { hrow[i * 136] = (bf16)f2bf(hr); hrow[i * 136 + 64] = (bf16)f2bf(hi);
                    const float nr = ar * hr - ai * hi + sr[i], ni = ar * hi + ai * hr + si[i]; hr = nr; hi = ni; }
            }
        }
        have_g = g; have_nh = nh;
        __syncthreads();
        f32x4 acc[16];
#pragma unroll
        for (int q = 0; q < 16; ++q) acc[q] = (f32x4){0.f, 0.f, 0.f, 0.f};
        const int kb0 = ((rc - (fq >> 1) + 10) * 16 + fr) * 32 + 16 * (fq & 1);
#define S5_GROUP(XF, grp_) do { const LAS unsigned char* kp = KT + kb0 - (grp_) * 4096; \
            _Pragma("unroll") for (int q = 2 * (grp_); q < 16; ++q) { \
                _Pragma("unroll") for (int i = 0; i < 4; ++i) { const bf16x8 kf = *(const LAS bf16x8*)(kp + (4 * q - 2 * i + 6) * 512); \
                    acc[q] = __builtin_amdgcn_mfma_f32_16x16x32_bf16(kf, XF[i], acc[q], 0, 0, 0); } } } while (0)
#define S5_RELOAD(XF, grp_) do { _Pragma("unroll") for (int i = 0; i < 4; ++i) XF[i] = *(const bf16x8*)(xp0 + ((grp_) * 4 + i) * 32); } while (0)
#define S5_SB __builtin_amdgcn_sched_barrier(0)
        S5_GROUP(x0, 0); S5_RELOAD(x0, 4); S5_SB;
        S5_GROUP(x1, 1); S5_RELOAD(x1, 5); S5_SB;
        S5_GROUP(x2, 2); S5_RELOAD(x2, 6); S5_SB;
        S5_GROUP(x3, 3); S5_RELOAD(x3, 7); S5_SB;
        S5_GROUP(x0, 4); S5_SB; S5_GROUP(x1, 5); S5_SB; S5_GROUP(x2, 6); S5_SB; S5_GROUP(x3, 7); S5_SB;
#undef S5_SB
#undef S5_RELOAD
#undef S5_GROUP
#pragma unroll 1
        for (int jb = 0; jb < 4; ++jb) {
            const bf16x8 hf = *(const LAS bf16x8*)(HT + (16 * wave + fr) * 272 + (jb * 32 + 8 * fq) * 2);
#pragma unroll
            for (int q = 0; q < 16; ++q) {
                const bf16x8 vf = *(const LAS bf16x8*)(VT + (q * 16 + fr) * 272 + (jb * 32 + 8 * fq) * 2);
                acc[q] = __builtin_amdgcn_mfma_f32_16x16x32_bf16(vf, hf, acc[q], 0, 0, 0);
            }
        }
#pragma unroll
        for (int q = 0; q < 16; ++q) {
            const int t = rc + 4 * q, tok = 64 * n + t;
            const f32x4 y = acc[q];
            {   unsigned w8 = 0u;
                w8 = __builtin_amdgcn_cvt_pk_fp8_f32(gelu_tanh(y[0]), gelu_tanh(y[1]), w8, false); w8 = __builtin_amdgcn_cvt_pk_fp8_f32(gelu_tanh(y[2]), gelu_tanh(y[3]), w8, true);
                *(unsigned*)((unsigned char*)Gb + (size_t)tok * 1024 + g * 16 + 4 * fq) = w8; }
#if SELFTEST_S5
            if (tok < 256) *(f32x4*)((float*)(F.ws + WS_DBG) + (size_t)tok * 1024 + g * 16 + 4 * fq) = y;
#endif
        }
    }
    __syncthreads();
}
#if SELFTEST_S5
__device__ __forceinline__ void selftest_s5(Frame& F, int l) {
    PH_LOCALS
    if (F.vcu < 64 && wave == 0) {
        const int g = F.vcu, p = lane;
        const float dt = expf(F.in[I_LDT][l * 64 + g]);
        const float lr = F.in[I_LRE][(l * 64 + g) * 64 + p], li = F.in[I_LIM][(l * 64 + g) * 64 + p];
        const float mag = expf(lr * dt); float sn, cs; sincosf(li * dt, &sn, &cs);
        const float ar = mag * cs, ai = mag * sn;
        const float xr = ar - 1.0f, xi = ai, den = 1.0f / (lr * lr + li * li);
        const float cr = (xr * lr + xi * li) * den, ci = (xi * lr - xr * li) * den;
        float bbr[16], bbi[16], ccr[16], cci[16];
#pragma unroll
        for (int i = 0; i < 16; ++i) { const float br = F.in[I_BRE][((size_t)(l * 64 + g) * 64 + p) * 16 + i], bi = F.in[I_BIM][((size_t)(l * 64 + g) * 64 + p) * 16 + i];
            bbr[i] = cr * br - ci * bi; bbi[i] = cr * bi + ci * br;
            ccr[i] = F.in[I_CRE][((size_t)(l * 64 + g) * 16 + i) * 64 + p]; cci[i] = F.in[I_CIM][((size_t)(l * 64 + g) * 16 + i) * 64 + p]; }
        const bf16* XS = (const bf16*)(F.ws + WS_XS) + (size_t)g * 256 * 1024;
        const float* DY = (const float*)(F.ws + WS_DBG);
        float sr = 0.f, si = 0.f, err = 0.f, ref = 0.f;
        for (int t = 0; t < 256; ++t) {
            float x[16];
#pragma unroll
            for (int i = 0; i < 16; ++i) x[i] = bflo((unsigned)XS[(size_t)t * 16 + i]);
            float ur = 0.f, ui = 0.f;
#pragma unroll
            for (int i = 0; i < 16; ++i) { ur += bbr[i] * x[i]; ui += bbi[i] * x[i]; }
            const float nr = ar * sr - ai * si + ur, ni = ar * si + ai * sr + ui; sr = nr; si = ni;
#pragma unroll
            for (int o = 0; o < 16; ++o) {
                const float yr = wave_sum(ccr[o] * sr - cci[o] * si);
                const float yf = DY[(size_t)t * 1024 + g * 16 + o];
                err += (yf - yr) * (yf - yr); ref += yr * yr;
            }
        }
        if (lane == 0 && !(err <= 2e-3f * ref)) __hip_atomic_fetch_or((unsigned*)(F.ws + WS_CTL) + CW_FLAG, 1u, RLX_AGENT);
    }
}
#endif

__device__ __forceinline__ unsigned f2key(float v) { const unsigned u = __builtin_bit_cast(unsigned, v); return (u & 0x80000000u) ? ~u : (u | 0x80000000u); }
__device__ __forceinline__ float key2f(unsigned k) { const unsigned u = (k & 0x80000000u) ? (k & 0x7fffffffu) : ~k; return __builtin_bit_cast(float, u); }
#define S16_CE(i, j) do { const unsigned a_ = v[i], c_ = v[j]; v[i] = a_ > c_ ? a_ : c_; v[j] = a_ > c_ ? c_ : a_; } while (0)
__device__ __forceinline__ void sort16_desc(unsigned (&v)[16]) {
    S16_CE(0, 13); S16_CE(1, 12); S16_CE(2, 15); S16_CE(3, 14); S16_CE(4, 8); S16_CE(5, 6); S16_CE(7, 11); S16_CE(9, 10);
    S16_CE(0, 5); S16_CE(1, 7); S16_CE(2, 9); S16_CE(3, 4); S16_CE(6, 13); S16_CE(8, 14); S16_CE(10, 15); S16_CE(11, 12);
    S16_CE(0, 1); S16_CE(2, 3); S16_CE(4, 5); S16_CE(6, 8); S16_CE(7, 9); S16_CE(10, 11); S16_CE(12, 13); S16_CE(14, 15);
    S16_CE(0, 2); S16_CE(1, 3); S16_CE(4, 10); S16_CE(5, 11); S16_CE(6, 7); S16_CE(8, 9); S16_CE(12, 14); S16_CE(13, 15);
    S16_CE(1, 2); S16_CE(3, 12); S16_CE(4, 6); S16_CE(5, 7); S16_CE(8, 10); S16_CE(9, 11); S16_CE(13, 14);
    S16_CE(1, 4); S16_CE(2, 6); S16_CE(5, 8); S16_CE(7, 10); S16_CE(9, 13); S16_CE(11, 14);
    S16_CE(2, 4); S16_CE(3, 6); S16_CE(9, 12); S16_CE(11, 13);
    S16_CE(3, 5); S16_CE(6, 8); S16_CE(7, 9); S16_CE(10, 12);
    S16_CE(3, 4); S16_CE(5, 6); S16_CE(7, 8); S16_CE(9, 10); S16_CE(11, 12);
    S16_CE(6, 7); S16_CE(8, 9);
}
__device__ __forceinline__ void merge16_desc(unsigned (&v)[16], const unsigned (&w)[16]) {
#pragma unroll
    for (int i = 0; i < 16; ++i) v[i] = v[i] > w[15 - i] ? v[i] : w[15 - i];
#pragma unroll
    for (int lj = 3; lj >= 0; --lj) {
#pragma unroll
        for (int i = 0; i < 16; ++i) { const int j = 1 << lj, p = i ^ j;
            if (p > i) { const unsigned a = v[i], c = v[p]; v[i] = a > c ? a : c; v[p] = a > c ? c : a; } }
    }
}
__device__ __forceinline__ void xmerge16(unsigned (&v)[16], int mask) {
    unsigned w[16];
#pragma unroll
    for (int i = 0; i < 16; ++i) w[i] = (unsigned)__shfl_xor((int)v[i], mask);
    merge16_desc(v, w);
}
__device__ __forceinline__ unsigned umed3(unsigned a, unsigned b, unsigned c) { unsigned r; asm("v_med3_u32 %0, %1, %2, %3" : "=v"(r) : "v"(a), "v"(b), "v"(c)); return r; }
__device__ __forceinline__ void sort8_bitonic_desc(unsigned (&w)[8]) {
#pragma unroll
    for (int d = 4; d >= 1; d >>= 1) {
#pragma unroll
        for (int i = 0; i < 8; ++i) if ((i & d) == 0) { const unsigned a = w[i], c = w[i + d]; w[i] = a > c ? a : c; w[i + d] = a > c ? c : a; } }
}
__device__ __forceinline__ void dmerge16(const unsigned (&v)[16], int mask, unsigned rolec, unsigned (&w)[8]) {
    unsigned m[8];
#pragma unroll
    for (int p = 0; p < 8; ++p) { const unsigned r = (unsigned)__shfl_xor((int)v[15 - p], mask); m[p] = v[p] > r ? v[p] : r; }
#pragma unroll
    for (int p = 0; p < 8; ++p) { const unsigned r = (unsigned)__shfl_xor((int)m[7 - p], mask); w[p] = umed3(m[p], r, rolec); }
    sort8_bitonic_desc(w);
}
__device__ __forceinline__ void dmerge8(unsigned (&w)[8], int far, int near, unsigned rolec) {
    unsigned m[8];
#pragma unroll
    for (int p = 0; p < 8; ++p) { const unsigned r = (unsigned)__shfl_xor((int)w[7 - p], far); m[p] = w[p] > r ? w[p] : r; }
#pragma unroll
    for (int p = 0; p < 8; ++p) { const unsigned r = (unsigned)__shfl_xor((int)m[p], near); w[p] = umed3(m[p], r, rolec); }
    sort8_bitonic_desc(w);
}
__device__ __forceinline__ void phase_topk(Frame& F, int l) {
    PH_LOCALS
    const bf16* Q = (const bf16*)(F.ws + WS_Z);
    const bf16* KB = (const bf16*)(F.ws + WS_KEYS) + (size_t)l * 8 * 2 * 128 * 128;
    int* EID = (int*)(F.ws + WS_EID); float* GT = (float*)(F.ws + WS_GATE); float* SUo = (float*)(F.ws + WS_SU);
    const float* SCL = (const float*)(F.ws + WS_SCL) + (size_t)l * NEXP * 2;
    LAS unsigned char* KL = F.lds;
    LAS unsigned* LST = (LAS unsigned*)(F.lds + 69632);
    LAS unsigned char* PT = F.lds + 69632 + 16384;
    const int fr = lane & 15, fq = lane >> 4;
    {
        int c = 0;
#pragma unroll
        for (int i = 0; i < 16; ++i)
#pragma unroll
            for (int j = 0; j < 16; ++j) if ((i + 1) * (j + 1) <= 16) { if (tid == c) PT[c] = (unsigned char)(i * 16 + j); ++c; }
    }
    int cur_hh = -1;
    for (int u = F.vcu; u < 1024; u += F.G) {
        const int tt = u >> 3, hh = u & 7, t0 = tt * 128;
        bf16x8 qf[2][4];
#pragma unroll
        for (int s = 0; s < 2; ++s)
#pragma unroll
            for (int kb = 0; kb < 4; ++kb) qf[s][kb] = __builtin_nontemporal_load((const bf16x8*)(Q + (size_t)(t0 + 16 * wave + fr) * 2048 + hh * 256 + s * 128 + kb * 32 + 8 * fq));
        if (hh != cur_hh) {
            __syncthreads();
#pragma unroll
            for (int ps = 0; ps < 8; ++ps) { const int idx = ps * 512 + tid, row = idx >> 4, c16 = idx & 15;
                *(LAS u32x4*)(KL + row * 272 + c16 * 16) = *(const u32x4*)(KB + ((size_t)(hh * 256 + row)) * 128 + c16 * 8); }
            cur_hh = hh;
            __syncthreads();
        }
#pragma unroll 1
        for (int s = 0; s < 2; ++s) {
            f32x4 acc[8];
#pragma unroll
            for (int nt = 0; nt < 8; ++nt) acc[nt] = (f32x4){0.f, 0.f, 0.f, 0.f};
#pragma unroll
            for (int kb = 0; kb < 4; ++kb) { const bf16x8 q = s ? qf[1][kb] : qf[0][kb];
#pragma unroll
                for (int nt = 0; nt < 8; ++nt) { const bf16x8 kf = *(const LAS bf16x8*)(KL + (s * 128 + nt * 16 + fr) * 272 + (kb * 32 + 8 * fq) * 2);
                    acc[nt] = __builtin_amdgcn_mfma_f32_16x16x32_bf16(kf, q, acc[nt], 0, 0, 0); } }
            unsigned va[16], vb[16];
#pragma unroll
            for (int nt = 0; nt < 4; ++nt)
#pragma unroll
                for (int r = 0; r < 4; ++r) { va[4 * nt + r] = (f2key(acc[nt][r]) & ~0x7Fu) | (unsigned)(127 - (nt * 16 + 4 * fq + r));
                    vb[4 * nt + r] = (f2key(acc[4 + nt][r]) & ~0x7Fu) | (unsigned)(127 - ((4 + nt) * 16 + 4 * fq + r)); }
            sort16_desc(va); sort16_desc(vb); merge16_desc(va, vb);
            const unsigned rolec = (fq & 1) ? 0u : ~0u; unsigned w8[8];
            dmerge16(va, 16, rolec, w8); dmerge8(w8, 48, 16, rolec);
            if (fq < 2) { LAS unsigned* dst = LST + ((16 * wave + fr) * 2 + s) * 16 + 8 * fq;
                *(LAS u32x4*)dst = (u32x4){w8[0], w8[1], w8[2], w8[3]}; *(LAS u32x4*)(dst + 4) = (u32x4){w8[4], w8[5], w8[6], w8[7]}; }
        }
        asm volatile("s_waitcnt lgkmcnt(0)" ::: "memory");
        {
            const int tl = 16 * wave + (lane >> 2), c4 = lane & 3;
            unsigned v[16];
#pragma unroll
            for (int m = 0; m < 13; ++m) { const int c = m * 4 + c4; unsigned key = 0u;
                if (c < 50) { const int pij = PT[c], i = pij >> 4, j = pij & 15;
                    const float av = key2f(LST[(tl * 2 + 0) * 16 + i] & ~0x7Fu), bv = key2f(LST[(tl * 2 + 1) * 16 + j] & ~0x7Fu);
                    key = (f2key(av + bv) & ~0xFFu) | (unsigned)(255 - pij); }
                v[m] = key; }
#pragma unroll
            for (int m = 13; m < 16; ++m) v[m] = 0u;
            sort16_desc(v);
            const unsigned rolec = (c4 & 1) ? 0u : ~0u; unsigned w8[8];
            dmerge16(v, 1, rolec, w8); dmerge8(w8, 3, 1, rolec);
            const int src = (lane & ~3) | (c4 >> 1);
            unsigned kk[4]; float ee[4]; float sum = 0.f;
            const float mx = key2f((unsigned)__shfl((int)w8[0], lane & ~3) & ~0xFFu);
#pragma unroll
            for (int e = 0; e < 4; ++e) { const unsigned x0 = (unsigned)__shfl((int)w8[e], src), x1 = (unsigned)__shfl((int)w8[4 + e], src); kk[e] = (c4 & 1) ? x1 : x0;
                ee[e] = __expf(key2f(kk[e] & ~0xFFu) - mx); sum += ee[e]; }
            sum += __shfl_xor(sum, 1); sum += __shfl_xor(sum, 2);
            const float inv = 1.0f / sum;
            const size_t ob = (size_t)(t0 + tl) * 128 + hh * 16 + 4 * c4;
            int eo[4]; float go[4], so[4];
#pragma unroll
            for (int e = 0; e < 4; ++e) { const int flat = 255 - (int)(kk[e] & 0xFFu), i = flat >> 4, j = flat & 15;
                const int ia = 127 - (int)(LST[(tl * 2 + 0) * 16 + i] & 0x7Fu), ib = 127 - (int)(LST[(tl * 2 + 1) * 16 + j] & 0x7Fu);
                eo[e] = ia * 128 + ib; }
#pragma unroll
            for (int e = 0; e < 4; ++e) { const f32x2 sc = *(const f32x2*)(SCL + 2 * eo[e]); go[e] = ee[e] * inv * sc.y; so[e] = sc.x; }
            *(u32x4*)(EID + ob) = (u32x4){(unsigned)eo[0], (unsigned)eo[1], (unsigned)eo[2], (unsigned)eo[3]};
            *(f32x4*)(GT + ob) = (f32x4){go[0], go[1], go[2], go[3]};
            *(f32x4*)(SUo + ob) = (f32x4){so[0], so[1], so[2], so[3]};
        }
        asm volatile("s_waitcnt lgkmcnt(0)" ::: "memory");
    }
    __syncthreads();
}

#define FP4X4(w, f0, f1, f2, f3) do { f0 = __builtin_amdgcn_cvt_scalef32_pk_f32_fp4((w), 1.0f, 0); f1 = __builtin_amdgcn_cvt_scalef32_pk_f32_fp4((w), 1.0f, 1); \
    f2 = __builtin_amdgcn_cvt_scalef32_pk_f32_fp4((w), 1.0f, 2); f3 = __builtin_amdgcn_cvt_scalef32_pk_f32_fp4((w), 1.0f, 3); } while (0)
__device__ __forceinline__ void nib_transpose8(unsigned (&r)[8]) {
#pragma unroll
    for (int i = 0; i < 4; ++i) { const unsigned a = r[i], b = r[i + 4]; r[i] = __builtin_amdgcn_perm(b, a, 0x05040100u); r[i + 4] = __builtin_amdgcn_perm(b, a, 0x07060302u); }
#pragma unroll
    for (int q = 0; q < 4; ++q) { const int i = (q & 1) + 4 * (q >> 1); const unsigned a = r[i], b = r[i + 2]; r[i] = __builtin_amdgcn_perm(b, a, 0x06020400u); r[i + 2] = __builtin_amdgcn_perm(b, a, 0x07030501u); }
#pragma unroll
    for (int i = 0; i < 8; i += 2) { const unsigned a = r[i], b = r[i + 1]; r[i] = (a & 0x0F0F0F0Fu) | ((b << 4) & 0xF0F0F0F0u); r[i + 1] = ((a >> 4) & 0x0F0F0F0Fu) | (b & 0xF0F0F0F0u); }
}
__device__ __forceinline__ void phase_gather(Frame& F, int l, bool dummy = false) {
    PH_LOCALS
    const int gw = F.vcu * NWAVES + wave, NGW = F.G * NWAVES;
    unsigned char* Hn8 = dummy ? (F.ws + WS_DBG + 128 * MiB) : (F.ws + WS_H); float* HSCn = dummy ? (float*)(F.ws + WS_DBG + 160 * MiB) : (float*)(F.ws + WS_HSCL); float* SXn = dummy ? (float*)(F.ws + WS_DBG + 161 * MiB) : (float*)(F.ws + WS_SX);
    const unsigned char* UT = F.ws + WS_UV + (size_t)l * NEXP * 2048;
    const unsigned char* VTb = UT + (size_t)NEXP * 1024;
    const int* EID = (const int*)(F.ws + WS_EID); const float* GT = (const float*)(F.ws + WS_GATE); const float* SU = (const float*)(F.ws + WS_SU);
    float* COEF = dummy ? (float*)(F.ws + WS_DBG + 192 * MiB) : (float*)(F.ws + WS_COEF);
    const bf16* X = (const bf16*)(F.ws + WS_X); bf16* Xo = dummy ? (bf16*)(F.ws + WS_DBG) : (bf16*)(F.ws + WS_X);
    const float* mod = (const float*)(F.ws + WS_MOD);
    const float* gate2 = mod + l * 12288 + 5 * 2048; const float* shift2 = mod + l * 12288 + 3 * 2048; const float* gs2 = (const float*)(F.ws + WS_GS) + l * DM;
    const unsigned lane16 = (unsigned)lane * 16u;
    const bool u32_ = (lane & 32) != 0, u16_ = (lane & 16) != 0, u8_ = (lane & 8) != 0, u4_ = (lane & 4) != 0;
#if GATHER_PROBE_HOT
#define G_HOT(e) if (dummy) e &= 15;
#else
#define G_HOT(e)
#endif
#define G_ROW(dst, tab, b_, h_) do { int e_ = __builtin_amdgcn_readlane((b_) < 4 ? e_lo : e_hi, (16 * (b_) + (h_)) & 63); G_HOT(e_) \
            dst = *(const u32x4*)((tab) + ((size_t)(unsigned)e_ << 10) + lane16); } while (0)
    {
    constexpr int U_PASSES = 4, U_SHIFT = (U_PASSES == 4) ? 12 : 13;
    int* EIDw = (int*)(F.ws + WS_EID); float* GTw = (float*)(F.ws + WS_GATE); float* SUw = (float*)(F.ws + WS_SU);
    LAS unsigned char* HQ = F.lds + (size_t)wave * 16384;
    LAS float* SHL = (LAS float*)(F.lds + 131072) + wave * 8;
    LAS unsigned* SCR = (LAS unsigned*)(F.lds + 132096) + wave * 384;
    for (int tb = gw; tb < M; tb += 8 * NGW) {
#pragma unroll 1
      for (int pass = 0; pass < U_PASSES; ++pass) {
#pragma unroll 1
        for (int k = 0; k < 8; ++k) {
            const int t = tb + k * NGW; if (t >= M) break;
            int e_lo = __hip_atomic_load(EIDw + (size_t)t * 128 + lane, RLX_AGENT), e_hi = __hip_atomic_load(EIDw + (size_t)t * 128 + 64 + lane, RLX_AGENT);
            float g_lo = __hip_atomic_load(GTw + (size_t)t * 128 + lane, RLX_AGENT), g_hi = __hip_atomic_load(GTw + (size_t)t * 128 + 64 + lane, RLX_AGENT);
            float s_lo = __hip_atomic_load(SUw + (size_t)t * 128 + lane, RLX_AGENT), s_hi = __hip_atomic_load(SUw + (size_t)t * 128 + 64 + lane, RLX_AGENT);
            const int q_lo = (e_lo >> U_SHIFT) & (U_PASSES - 1), q_hi = (e_hi >> U_SHIFT) & (U_PASSES - 1);
            int p_lo = 0, p_hi = 0, cumv = 0, bA = 0, bB = 8;
#pragma unroll
            for (int c = 0; c < U_PASSES; ++c) {
                const unsigned long long m_lo = __ballot(q_lo == c), m_hi = __ballot(q_hi == c);
                const int cl = __popcll(m_lo);
                const int r_lo = __builtin_amdgcn_mbcnt_hi((unsigned)(m_lo >> 32), __builtin_amdgcn_mbcnt_lo((unsigned)m_lo, 0u)), r_hi = __builtin_amdgcn_mbcnt_hi((unsigned)(m_hi >> 32), __builtin_amdgcn_mbcnt_lo((unsigned)m_hi, 0u));
                if (q_lo == c) p_lo = cumv + r_lo;
                if (q_hi == c) p_hi = cumv + cl + r_hi;
                if (c == pass) bA = (cumv + 15) >> 4;
                cumv += cl + __popcll(m_hi);
                if (c == pass) bB = (cumv + 15) >> 4;
            }
            unsigned hqh[4], hql[4]; float sh;
            if (pass == 0) {
                SCR[p_lo] = (unsigned)e_lo; SCR[128 + p_lo] = __builtin_bit_cast(unsigned, g_lo); SCR[256 + p_lo] = __builtin_bit_cast(unsigned, s_lo);
                SCR[p_hi] = (unsigned)e_hi; SCR[128 + p_hi] = __builtin_bit_cast(unsigned, g_hi); SCR[256 + p_hi] = __builtin_bit_cast(unsigned, s_hi);
                asm volatile("s_waitcnt lgkmcnt(0)" ::: "memory");
                e_lo = (int)SCR[lane]; e_hi = (int)SCR[64 + lane]; g_lo = __builtin_bit_cast(float, SCR[128 + lane]); g_hi = __builtin_bit_cast(float, SCR[192 + lane]);
                s_lo = __builtin_bit_cast(float, SCR[256 + lane]); s_hi = __builtin_bit_cast(float, SCR[320 + lane]);
                asm volatile("s_waitcnt lgkmcnt(0)" ::: "memory");
                EIDw[(size_t)t * 128 + lane] = e_lo; EIDw[(size_t)t * 128 + 64 + lane] = e_hi; GTw[(size_t)t * 128 + lane] = g_lo; GTw[(size_t)t * 128 + 64 + lane] = g_hi;
                SUw[(size_t)t * 128 + lane] = s_lo; SUw[(size_t)t * 128 + 64 + lane] = s_hi;
                f32x2 hh[8][2];
                {   float s2 = 0.f; u32x2 xw[8];
#pragma unroll
                    for (int j = 0; j < 8; ++j) xw[j] = *(const u32x2*)(X + (size_t)t * 2048 + j * 256 + lane * 4);
#pragma unroll
                    for (int j = 0; j < 8; ++j) { hh[j][0] = (f32x2){bflo(xw[j].x), bfhi(xw[j].x)}; hh[j][1] = (f32x2){bflo(xw[j].y), bfhi(xw[j].y)};
                        s2 += (hh[j][0].x * hh[j][0].x + hh[j][0].y * hh[j][0].y) + (hh[j][1].x * hh[j][1].x + hh[j][1].y * hh[j][1].y); }
                    const float r2 = 1.0f / sqrtf(wave_sum(s2) * (1.0f / DM) + EPS);
#pragma unroll
                    for (int j2 = 0; j2 < 8; j2 += 4) { f32x4 gsv[4], shv[4];
#pragma unroll
                        for (int j = 0; j < 4; ++j) { gsv[j] = *(const f32x4*)(gs2 + (j2 + j) * 256 + lane * 4); shv[j] = *(const f32x4*)(shift2 + (j2 + j) * 256 + lane * 4); }
#pragma unroll
                        for (int j = 0; j < 4; ++j) { hh[j2 + j][0] = (f32x2){hh[j2 + j][0].x * r2 * gsv[j][0] + shv[j][0], hh[j2 + j][0].y * r2 * gsv[j][1] + shv[j][1]}; hh[j2 + j][1] = (f32x2){hh[j2 + j][1].x * r2 * gsv[j][2] + shv[j][2], hh[j2 + j][1].y * r2 * gsv[j][3] + shv[j][3]}; } }
                }
                {   float am = 0.f;
#pragma unroll
                    for (int j = 0; j < 8; ++j) am = fmaxf(am, fmaxf(fmaxf(fabsf(hh[j][0].x), fabsf(hh[j][0].y)), fmaxf(fabsf(hh[j][1].x), fabsf(hh[j][1].y))));
#pragma unroll
                    for (int o = 1; o < 64; o <<= 1) am = fmaxf(am, __shfl_xor(am, o));
                    sh = am > 0.f ? am * (1.0f / 119.0f) : 1.0f; const float inv = am > 0.f ? 119.0f / am : 0.f;
#pragma unroll
                    for (int d = 0; d < 4; ++d) { unsigned wh = 0u, wl = 0u;
#pragma unroll
                        for (int n = 0; n < 8; ++n) { const int j = 2 * d + (n >> 2), b = n & 3; const float x = (b & 1) ? hh[j][b >> 1].y : hh[j][b >> 1].x;
                            const unsigned bits = __builtin_bit_cast(unsigned, fmaf(x, inv, 12582920.0f));
                            wh |= ((bits >> 4) & 0xFu) << (4 * n); wl |= (bits & 0xFu) << (4 * n); }
                        hqh[d] = wh; hql[d] = wl ^ 0x88888888u; }
                }
                *(LAS u32x4*)(HQ + k * 2048 + lane * 16) = (u32x4){hqh[0], hqh[1], hqh[2], hqh[3]}; *(LAS u32x4*)(HQ + k * 2048 + 1024 + lane * 16) = (u32x4){hql[0], hql[1], hql[2], hql[3]};
                if (lane == 0) SHL[k] = sh;
            } else {
                const u32x4 a = *(const LAS u32x4*)(HQ + k * 2048 + lane * 16), c = *(const LAS u32x4*)(HQ + k * 2048 + 1024 + lane * 16);
                hqh[0] = a[0]; hqh[1] = a[1]; hqh[2] = a[2]; hqh[3] = a[3]; hql[0] = c[0]; hql[1] = c[1]; hql[2] = c[2]; hql[3] = c[3]; sh = SHL[k];
            }
            const int b0 = __builtin_amdgcn_readfirstlane(bA), b1 = __builtin_amdgcn_readfirstlane(bB);
            if (b0 >= b1) continue;
#define G_ROWR(dst, tab, bb_, h_) do { const int es_ = (bb_) < 4 ? e_lo : e_hi; int e_ = __builtin_amdgcn_readlane(es_, (16 * (bb_) + (h_)) & 63); G_HOT(e_) \
            dst = *(const u32x4*)((tab) + ((size_t)(unsigned)e_ << 10) + lane16); } while (0)
            u32x4 ur[16];
#pragma unroll
            for (int h = 0; h < 16; ++h) G_ROWR(ur[h], UT, b0, h);
            asm volatile(".p2align 8" ::: "memory");
#define G_UBATCHR(NEXT) { float p[16]; \
                _Pragma("unroll") for (int h = 0; h < 16; ++h) { int ah = 0, al = 0; \
                    if (GATHER_PROBE_MEM && dummy) { al = (int)(ur[h][0] ^ ur[h][1] ^ ur[h][2] ^ ur[h][3]); } else { \
                _Pragma("unroll") for (int d = 0; d < 4; ++d) { ah = __builtin_amdgcn_sdot8((int)ur[h][d], (int)hqh[d], ah, false); al = __builtin_amdgcn_sdot8((int)ur[h][d], (int)hql[d], al, false); } } \
                    p[h] = (float)(16 * ah + al); if (NEXT) G_ROWR(ur[h], UT, b + 1, h); } \
                float a8[8]; \
                _Pragma("unroll") for (int i = 0; i < 8; ++i) { const float snd = u32_ ? p[i] : p[8 + i], kp = u32_ ? p[8 + i] : p[i]; a8[i] = kp + __shfl_xor(snd, 32); } \
                float a4[4]; \
                _Pragma("unroll") for (int i = 0; i < 4; ++i) { const float snd = u16_ ? a8[i] : a8[4 + i], kp = u16_ ? a8[4 + i] : a8[i]; a4[i] = kp + __shfl_xor(snd, 16); } \
                float b2[2]; \
                _Pragma("unroll") for (int i = 0; i < 2; ++i) { const float snd = u8_ ? a4[i] : a4[2 + i], kp = u8_ ? a4[2 + i] : a4[i]; b2[i] = kp + __shfl_xor(snd, 8); } \
                float d; { const float snd = u4_ ? b2[0] : b2[1], kp = u4_ ? b2[1] : b2[0]; d = kp + __shfl_xor(snd, 4); } \
                d += __shfl_xor(d, 2); d += __shfl_xor(d, 1);                  \
                const int hl = (16 * b + (lane >> 2)) & 63; const float gsel = b < 4 ? g_lo : g_hi, ssel = b < 4 ? s_lo : s_hi; \
                const float coefq = __shfl(gsel, hl) * gelu_tanh(d * (__shfl(ssel, hl) * sh)); \
                if ((lane & 3) == 0) COEF[(size_t)t * 128 + 16 * b + (lane >> 2)] = coefq; }
            { int b = b0;
#pragma unroll 1
              for (; b < b1 - 1; ++b) G_UBATCHR(true)
              G_UBATCHR(false) }
#undef G_UBATCHR
#undef G_ROWR
        }
        asm volatile("s_waitcnt vmcnt(0)" ::: "memory");
      }
    }
    }
    asm volatile("s_waitcnt vmcnt(0)" ::: "memory");
    for (int t = gw; t < M; t += NGW) {
        const int e_lo = __hip_atomic_load(EID + (size_t)t * 128 + lane, RLX_AGENT), e_hi = __hip_atomic_load(EID + (size_t)t * 128 + 64 + lane, RLX_AGENT);
        const float c_lo = __hip_atomic_load(COEF + (size_t)t * 128 + lane, RLX_AGENT), c_hi = __hip_atomic_load(COEF + (size_t)t * 128 + 64 + lane, RLX_AGENT);
        float cmax = fmaxf(fabsf(c_lo), fabsf(c_hi));
#pragma unroll
        for (int o = 1; o < 64; o <<= 1) cmax = fmaxf(cmax, __shfl_xor(cmax, o));
        const float cinv = cmax > 0.f ? 119.0f / cmax : 0.f, csc = cmax * (1.0f / 119.0f);
        unsigned xh_lo, xl_lo, xh_hi, xl_hi;
        {   const unsigned bl = __builtin_bit_cast(unsigned, fmaf(c_lo, cinv, 12582920.0f)), bh = __builtin_bit_cast(unsigned, fmaf(c_hi, cinv, 12582920.0f)); const int s4 = 4 * (lane & 7);
            xh_lo = ((bl >> 4) & 0xFu) << s4; xl_lo = ((bl & 0xFu) ^ 8u) << s4; xh_hi = ((bh >> 4) & 0xFu) << s4; xl_hi = ((bh & 0xFu) ^ 8u) << s4;
#pragma unroll
            for (int o = 1; o < 8; o <<= 1) { xh_lo |= (unsigned)__shfl_xor((int)xh_lo, o); xl_lo |= (unsigned)__shfl_xor((int)xl_lo, o); xh_hi |= (unsigned)__shfl_xor((int)xh_hi, o); xl_hi |= (unsigned)__shfl_xor((int)xl_hi, o); } }
        u32x4 vr[16];
#pragma unroll
        for (int h = 0; h < 16; ++h) G_ROW(vr[h], VTb, 0, h);
        int ah[4][8], al[4][8];
#pragma unroll
        for (int d = 0; d < 4; ++d)
#pragma unroll
            for (int n = 0; n < 8; ++n) { ah[d][n] = 0; al[d][n] = 0; }
#define G_VHALF(b_, hf_, NEXT) { const int g_ = 2 * (b_) + (hf_); \
            const int ch_ = __builtin_amdgcn_readlane((int)(g_ < 8 ? xh_lo : xh_hi), (8 * g_) & 63), cl_ = __builtin_amdgcn_readlane((int)(g_ < 8 ? xl_lo : xl_hi), (8 * g_) & 63); \
            _Pragma("unroll") for (int d = 0; d < 4; ++d) { unsigned r_[8]; \
                _Pragma("unroll") for (int i = 0; i < 8; ++i) r_[i] = vr[8 * (hf_) + i][d]; \
                nib_transpose8(r_); \
                _Pragma("unroll") for (int n = 0; n < 8; ++n) { ah[d][n] = __builtin_amdgcn_sdot8((int)r_[n], ch_, ah[d][n], false); al[d][n] = __builtin_amdgcn_sdot8((int)r_[n], cl_, al[d][n], false); } } \
            if (NEXT) { _Pragma("unroll") for (int i = 0; i < 8; ++i) G_ROW(vr[8 * (hf_) + i], VTb, (b_) + 1, 8 * (hf_) + i); } }
        asm volatile(".p2align 8" ::: "memory");
#pragma unroll 1
        for (int b = 0; b < 7; ++b) { G_VHALF(b, 0, true) G_VHALF(b, 1, true) }
        G_VHALF(7, 0, false) G_VHALF(7, 1, false)
#undef G_VHALF
        int ln = lane; asm volatile("" : "+v"(ln));
        u32x2 cx[8];
#pragma unroll
        for (int j = 0; j < 8; ++j) cx[j] = __builtin_nontemporal_load((const u32x2*)(X + (size_t)t * 2048 + j * 256 + ln * 4));
        f32x4 xv[8]; float ss = 0.f;
#pragma unroll
        for (int j2 = 0; j2 < 8; j2 += 4) { f32x4 g2v[4];
#pragma unroll
            for (int j = 0; j < 4; ++j) g2v[j] = *(const f32x4*)(gate2 + (j2 + j) * 256 + ln * 4);
#pragma unroll
            for (int jj = 0; jj < 4; ++jj) { const int j = j2 + jj;
                const f32x4 xo = {bflo(cx[j].x), bfhi(cx[j].x), bflo(cx[j].y), bfhi(cx[j].y)};
                const int dq = j >> 1, nq = (j & 1) * 4;
                const f32x4 o = {(float)(16 * ah[dq][nq] + al[dq][nq]) * csc, (float)(16 * ah[dq][nq + 1] + al[dq][nq + 1]) * csc, (float)(16 * ah[dq][nq + 2] + al[dq][nq + 2]) * csc, (float)(16 * ah[dq][nq + 3] + al[dq][nq + 3]) * csc};
                xv[j] = xo + g2v[jj] * o;
                ss += (xv[j][0] * xv[j][0] + xv[j][1] * xv[j][1]) + (xv[j][2] * xv[j][2] + xv[j][3] * xv[j][3]); } }
        const float rr = 1.0f / sqrtf(wave_sum(ss) * (1.0f / DM) + EPS);
        if (l + 1 < DEPTH) {
            const float* m2 = mod + (l + 1) * 12288; const float* gain = F.in[I_N1G] + (l + 1) * 2048;
            f32x4 yq[8]; float am = 0.f, ax = 0.f;
#pragma unroll
            for (int j2 = 0; j2 < 8; j2 += 4) { f32x4 gv[4], scv[4], shv[4];
#pragma unroll
                for (int j = 0; j < 4; ++j) { const int c = (j2 + j) * 256 + ln * 4; gv[j] = *(const f32x4*)(gain + c); scv[j] = *(const f32x4*)(m2 + 2048 + c); shv[j] = *(const f32x4*)(m2 + c); }
#pragma unroll
                for (int jj = 0; jj < 4; ++jj) { const int j = j2 + jj, c = j * 256 + ln * 4;
                    *(u32x2*)(Xo + (size_t)t * 2048 + c) = (u32x2){pk2(xv[j][0], xv[j][1]), pk2(xv[j][2], xv[j][3])};
                    yq[j] = xv[j] * rr * gv[jj] * (scv[jj] + 1.0f) + shv[jj];
                    ax = fmaxf(ax, fmaxf(fmaxf(fabsf(xv[j][0]), fabsf(xv[j][1])), fmaxf(fabsf(xv[j][2]), fabsf(xv[j][3]))));
                    am = fmaxf(am, fmaxf(fmaxf(fabsf(yq[j][0]), fabsf(yq[j][1])), fmaxf(fabsf(yq[j][2]), fabsf(yq[j][3])))); } }
#pragma unroll
            for (int o2 = 1; o2 < 64; o2 <<= 1) { am = fmaxf(am, __shfl_xor(am, o2)); ax = fmaxf(ax, __shfl_xor(ax, o2)); }
            const float inv = am > 0.f ? 127.0f / am : 0.f;
            if (ln == 0) { HSCn[t] = am > 0.f ? am * (1.0f / 127.0f) : 1.0f; SXn[t] = ax > 0.f ? ax * (1.5f / 127.0f) : 1.0f; }
#pragma unroll
            for (int j = 0; j < 8; ++j) { unsigned w = 0u;
#pragma unroll
                for (int e = 0; e < 4; ++e) w |= (__builtin_bit_cast(unsigned, fmaf(yq[j][e], inv, 12582912.0f)) & 0xFFu) << (8 * e);
                *(unsigned*)(Hn8 + (size_t)t * 2048 + j * 256 + ln * 4) = w; }
        } else {
#pragma unroll
            for (int j = 0; j < 8; ++j) { const int c = j * 256 + ln * 4; const f32x4 fgv = *(const f32x4*)(F.in[I_FG] + c);
                f32x4 ov = xv[j] * rr * fgv;
#if SELFTEST_S5
                if (__hip_atomic_load((unsigned*)(F.ws + WS_CTL) + CW_FLAG, RLX_AGENT) != 0u) ov = (f32x4){1e30f, 1e30f, 1e30f, 1e30f};
#endif
                __builtin_nontemporal_store(ov, (f32x4*)(F.out + (size_t)t * 2048 + c)); }
        }
    }
}

__global__ void __launch_bounds__(NTHR, 2) fwd_kernel(Args args) {
    extern __shared__ __attribute__((aligned(16))) unsigned char lds_raw[];
    Frame F;
    F.lds = (LAS unsigned char*)lds_raw; F.ws = args.ws; F.in = args.in; F.out = args.out;
    F.tid = threadIdx.x; F.lane = F.tid & 63; F.wave = __builtin_amdgcn_readfirstlane(F.tid >> 6);
    __builtin_amdgcn_s_setreg((0 << 11) | (23 << 6) | 1, 1u);
    F.G = gridDim.x; { const int bx = blockIdx.x; F.vcu = (F.G % 8 == 0) ? (bx % 8) * (F.G / 8) + bx / 8 : bx; }
    volatile LAS unsigned* MISC = (volatile LAS unsigned*)(F.lds + MISC_OFF);
    if (F.tid < 64) MISC[F.tid] = 0u;
    __syncthreads();
    unsigned* ctl = (unsigned*)(F.ws + WS_CTL);
    XcdBarrier bar; bar.bar = ctl + CW_BAR; bar.x = 0; bar.st = nullptr;
#if !MK_PER_PHASE
    bar = xcd_barrier_post(ctl + CW_BAR, MISC + 8);
#endif
    const int lo = args.ph_lo, hi = args.ph_hi;
#define IN(k) (lo <= (k) && (k) < hi)
#if MK_PER_PHASE
#define SEAM(k) do { } while (0)
#else
#define SEAM(k) do { if (IN(k) && IN((k) + 1)) xcd_barrier(bar); } while (0)
#endif
    const float* mod = (const float*)(F.ws + WS_MOD);

#define REP(k) (REPEAT_PH == (k))
#define RUN2(k, first, real) do { if (REP(k)) { first; xcd_barrier(bar); } real; } while (0)
    if (IN(0)) { RUN2(13, p0_tables(F, 5, true), p0_tables(F, 4, false)); } SEAM(0);
    for (int l = 0; l < DEPTH; ++l) {
        const int pb = 1 + 12 * l;
        const float* ml = mod + l * 12288;
        if (IN(pb + 0)) { if (l == 0) { RUN2(0, p0_prologue(F), p0_prologue(F)); RUN2(1, phase_norm<false>(F, F.in[I_X], F.in[I_N1G] + l * 2048, ml + 1 * 2048, ml + 0 * 2048), phase_norm<false>(F, F.in[I_X], F.in[I_N1G] + l * 2048, ml + 1 * 2048, ml + 0 * 2048));
#if !MK_PER_PHASE
            xcd_barrier(bar);
#endif
            p1_quant_win(F); } } SEAM(pb + 0);
        if (IN(pb + 1)) {
            pg8::Gemm g{(const bf16*)(F.ws + WS_H), (const bf16*)(F.ws + WS_WIN8) + (size_t)l * INW * DM / 2, M, INW, DM / 2}; pg8::StaticOrder S; S.init(M, INW, F.G, (int)blockIdx.x);
            LAS float* colL = (LAS float*)(F.lds + 136192);
            pg8::Unit u0, u1, u2; const bool h0 = S.next(0, u0), h1 = S.next(1, u1), h2 = S.next(2, u2);
            { int t2 = F.tid; asm volatile("" : "+v"(t2)); const float* bsrc = F.in[I_BIN] + l * INW;
              if (t2 < 256) { if (h0) colL[t2] = bsrc[u0.pn * 256 + t2]; if (h1) colL[256 + t2] = bsrc[u1.pn * 256 + t2]; if (h2) colL[512 + t2] = bsrc[u2.pn * 256 + t2]; }
              else { const int c = t2 - 256; const float* ssrc = (const float*)(F.ws + WS_WSCL) + l * INW;
                  if (h0) colL[768 + c] = ssrc[u0.pn * 256 + c]; if (h1) colL[1024 + c] = ssrc[u1.pn * 256 + c]; if (h2) colL[1280 + c] = ssrc[u2.pn * 256 + c]; } }
            __syncthreads();
            EpiIn E{(bf16*)(F.ws + WS_Z), (bf16*)(F.ws + WS_XS), colL, h0 ? u0.pn : -1, h1 ? u1.pn : -1, (float*)(F.ws + WS_PLN), (const float*)(F.ws + WS_HSCL)};
#define GEMM_IN pg8::gemm_phase<EpiIn, pg8::StaticOrder, true, true, true>(F.lds, g, S, E)
            RUN2(2, GEMM_IN, GEMM_IN);
        } SEAM(pb + 1);
        if (IN(pb + 2)) { RUN2(3, phase_sloc(F, l), phase_sloc(F, l)); } SEAM(pb + 2);
        if (IN(pb + 3)) { RUN2(5, phase_s5out(F, l), phase_s5out(F, l)); RUN2(4, phase_gating(F, l), phase_gating(F, l));
#if SELFTEST_S5
            xcd_barrier(bar); selftest_s5(F, l);
#endif
        } SEAM(pb + 4);
        if (IN(pb + 5)) {
            pg8::Gemm g{(const bf16*)(F.ws + WS_G), (const bf16*)(F.ws + WS_WGL8) + (size_t)l * WB * WB / 2, M, WB, WB / 2}; pg8::StaticOrder S; S.init(M, WB, F.G, (int)blockIdx.x);
            EpiGlu E{(const bf16*)(F.ws + WS_G), (bf16*)(F.ws + WS_MIX), F.in[I_GLUB] + l * WB, (float*)(F.ws + WS_PSB), (const float*)(F.ws + WS_WGLSCL) + l * WB};
#define GEMM_GLU pg8::gemm_phase<EpiGlu, pg8::StaticOrder, true, true, false, true>(F.lds, g, S, E)
            RUN2(6, GEMM_GLU, GEMM_GLU);
        } SEAM(pb + 6);
        if (IN(pb + 7)) {
            pg8::Gemm g{(const bf16*)(F.ws + WS_MIX), (const bf16*)(F.ws + WS_WO8) + (size_t)l * DM * DM / 2, M, DM, DM / 2}; pg8::StaticOrder S; S.init(M, DM, F.G, (int)blockIdx.x);
            LAS float* ratL = (LAS float*)(F.lds + 132096); LAS float* rbL = (LAS float*)(F.lds + 134144); LAS float* colL = (LAS float*)(F.lds + 136192);
            pg8::Unit u0, u1; const bool h0 = S.next(0, u0), h1 = S.next(1, u1);
            {   int t2 = F.tid; asm volatile("" : "+v"(t2));
                for (int sl = 0; sl < 2; ++sl) { const bool on = sl == 0 ? h0 : (h1 && u1.pm != u0.pm); const int pmx = sl == 0 ? u0.pm : u1.pm;
                    if (on && t2 < 256) { const size_t row = (size_t)pmx * 256 + t2; float sa = 0.f, sb = 0.f;
                        const float* pa = (const float*)(F.ws + WS_PSA) + row * 8; const float* pb_ = (const float*)(F.ws + WS_PSB) + row * 16;
#pragma unroll
                        for (int i = 0; i < 2; ++i) { const f32x4 v = *(const f32x4*)(pa + 4 * i); sa += (v[0] + v[1]) + (v[2] + v[3]); }
#pragma unroll
                        for (int i = 0; i < 4; ++i) { const f32x4 v = *(const f32x4*)(pb_ + 4 * i); sb += (v[0] + v[1]) + (v[2] + v[3]); }
                        const float ra = 1.0f / sqrtf(sa * (1.0f / 1024.0f) + EPS), rb = 1.0f / sqrtf(sb * (1.0f / 1024.0f) + EPS);
                        ratL[sl * 256 + t2] = ra / rb; rbL[sl * 256 + t2] = rb; } }
                if (t2 >= 256) { const int c = t2 - 256; const float* gsrc = ml + 2 * 2048; const float* wsc = (const float*)(F.ws + WS_WOSCL) + l * DM;
                    if (h0) colL[c] = gsrc[u0.pn * 256 + c] * wsc[u0.pn * 256 + c]; if (h1) colL[256 + c] = gsrc[u1.pn * 256 + c] * wsc[u1.pn * 256 + c]; } }
            __syncthreads();
            const int pm0 = h0 ? u0.pm : -1;
            if (l == 0) { EpiOut<false> E{(const void*)F.in[I_X], (bf16*)(F.ws + WS_X), colL, h0 ? u0.pn : -1, (float*)(F.ws + WS_PS), ratL, rbL, pm0}; EpiOut<false> Ed{(const void*)F.in[I_X], (bf16*)(F.ws + WS_DBG), colL, h0 ? u0.pn : -1, (float*)(F.ws + WS_DBG + 128 * MiB), ratL, rbL, pm0};
                E.X8 = F.ws + WS_X8; E.sx = (const float*)(F.ws + WS_SX); Ed.X8 = F.ws + WS_DBG + 64 * MiB; Ed.sx = E.sx;
#define GEMM_OUT0(EE) pg8::gemm_phase<EpiOut<false>, pg8::StaticOrder, true, true, false, true>(F.lds, g, S, EE)
                RUN2(8, GEMM_OUT0(Ed), GEMM_OUT0(E)); }
            else { EpiOut<true> E{(const void*)(F.ws + WS_X), (bf16*)(F.ws + WS_X), colL, h0 ? u0.pn : -1, (float*)(F.ws + WS_PS), ratL, rbL, pm0}; EpiOut<true> Ed{(const void*)(F.ws + WS_X), (bf16*)(F.ws + WS_DBG), colL, h0 ? u0.pn : -1, (float*)(F.ws + WS_DBG + 128 * MiB), ratL, rbL, pm0};
                E.X8 = F.ws + WS_X8; E.sx = (const float*)(F.ws + WS_SX); Ed.X8 = F.ws + WS_DBG + 64 * MiB; Ed.sx = E.sx;
#define GEMM_OUT1(EE) pg8::gemm_phase<EpiOut<true>, pg8::StaticOrder, true, true, false, true>(F.lds, g, S, EE)
                RUN2(8, GEMM_OUT1(Ed), GEMM_OUT1(E)); }
        }
        SEAM(pb + 8);
        if (IN(pb + 9)) {
            pg8::Gemm g{(const bf16*)(F.ws + WS_X8), (const bf16*)(F.ws + WS_WQ8) + (size_t)l * DM * DM / 2, M, DM, DM / 2}; pg8::StaticOrder S; S.init(M, DM, F.G, (int)blockIdx.x);
            LAS float* rrL = (LAS float*)(F.lds + 132096);
            pg8::Unit u0, u1; const bool h0 = S.next(0, u0), h1 = S.next(1, u1);
            LAS float* colL = (LAS float*)(F.lds + 136192);
            { int t2 = F.tid; asm volatile("" : "+v"(t2)); if (h0) fill_rr(F, rrL, 0, u0.pm, t2); if (h1 && u1.pm != u0.pm) fill_rr(F, rrL, 1, u1.pm, t2);
              if (t2 >= 256) { const int c = t2 - 256; const float* cp = (const float*)(F.ws + WS_C0) + (size_t)l * 4 * DM;
                  if (h0) { const float* q = cp + u0.pn * 256 + c; colL[c] = (q[0] + q[DM]) + (q[2 * DM] + q[3 * DM]); }
                  if (h1) { const float* q = cp + u1.pn * 256 + c; colL[256 + c] = (q[0] + q[DM]) + (q[2 * DM] + q[3 * DM]); }
                  const float* qs = (const float*)(F.ws + WS_WQSCL) + l * DM;
                  if (h0) colL[512 + c] = qs[u0.pn * 256 + c]; if (h1) colL[768 + c] = qs[u1.pn * 256 + c]; } }
            __syncthreads();
            EpiQ E{(bf16*)(F.ws + WS_Z), colL, h0 ? u0.pn : -1, rrL, h0 ? u0.pm : -1, (const float*)(F.ws + WS_SX)};
#define GEMM_Q pg8::gemm_phase<EpiQ, pg8::StaticOrder, true, true, true>(F.lds, g, S, E)
            RUN2(10, GEMM_Q, GEMM_Q);
        } SEAM(pb + 9);
        if (IN(pb + 10)) { RUN2(11, phase_topk(F, l), phase_topk(F, l)); } SEAM(pb + 10);
        if (IN(pb + 11)) { RUN2(12, phase_gather(F, l, true), phase_gather(F, l, false)); } SEAM(pb + 11);
    }
#undef IN
#undef SEAM
}

extern "C" void kernel_launch(void* const* d_in, const int* in_sizes, int n_in, void* d_out, int out_size, void* d_ws, size_t ws_size, hipStream_t stream) {
    static int grid = 0;
    if (grid == 0) {
        if (n_in != 29 || out_size != M * DM || ws_size < WS_END) { fprintf(stderr, "kernel_launch: unexpected shapes (n_in %d, out %d, ws %zu); nothing launched\n", n_in, out_size, ws_size); grid = -1; return; }
        int dev = 0, cus = 0;
        if (hipGetDevice(&dev) != hipSuccess || hipDeviceGetAttribute(&cus, hipDeviceAttributeMultiprocessorCount, dev) != hipSuccess) { grid = -1; return; }
        if (hipFuncSetAttribute((const void*)fwd_kernel, hipFuncAttributeMaxDynamicSharedMemorySize, LDS_BYTES) != hipSuccess) { fprintf(stderr, "kernel_launch: hipFuncSetAttribute failed\n"); grid = -1; return; }
        (void)hipGetLastError();
        grid = cus < 256 ? cus : 256;
    }
    if (grid < 0) return;
    (void)hipMemsetAsync((char*)d_ws + WS_CTL, 0, CTL_ZERO_BYTES, stream);
    Args a{};
    for (int i = 0; i < 29; ++i) a.in[i] = (const float*)d_in[i];
    a.out = (float*)d_out; a.ws = (unsigned char*)d_ws;
#if MK_PER_PHASE
    for (int p = 0; p < 1 + 12 * DEPTH; ++p) {
        if (p == 13) continue;
        a.ph_lo = p; a.ph_hi = p + 1; a.li = p;
        hipLaunchKernelGGL(fwd_kernel, dim3(grid), dim3(NTHR), LDS_BYTES, stream, a);
    }
#else
    a.ph_lo = 0; a.ph_hi = 1 + 12 * DEPTH; a.li = 0;
    hipLaunchKernelGGL(fwd_kernel, dim3(grid), dim3(NTHR), LDS_BYTES, stream, a);
#endif
}
```
